# Optimizing an MI355X kernel written in HIP

```python
import jax, jax.numpy as jnp
from jax import lax
import numpy as np

D_MODEL = 1024
BATCH = 1
SEQ = 16384
DEPTH = 2

HEAD_DIM = 64
NSA_HEADS = 8
NSA_GROUPS = 2
CMP_LEN = 32
CMP_STRIDE = 16
SLC_BLOCK = 64
SLC_TOPK = 16
WINDOW = 512
FOX_HEADS = 8
MLA_HEADS = 16
Q_LORA = 384
KV_LORA = 256
QK_NOPE = 64
QK_ROPE = 32
V_HEAD = 64
N_EXPERTS = 64
TOP_K = 8
N_GROUPS = 8
TOPK_GROUPS = 4
EXPERT_FF = 256
SHARED_FF = 256
ROUTED_SCALE = 2.5
ROW_BLOCK = 128
Q_BLOCK = 128
ROPE_THETA = 10000.0
EPS = 1e-6
NEG = -1e30
BIG = 1e6
N_EVEN = (DEPTH + 1) // 2
N_ODD = DEPTH // 2
NSA_Q_COLS = NSA_HEADS * HEAD_DIM
NSA_KV_COLS = 6 * NSA_GROUPS * HEAD_DIM
NSA_GATE_COLS = 3 * NSA_HEADS
FOX_QKV_COLS = 3 * FOX_HEADS * HEAD_DIM
FOX_F_COLS = FOX_HEADS
HY_IN = NSA_Q_COLS + NSA_KV_COLS + NSA_GATE_COLS + FOX_QKV_COLS + FOX_F_COLS
HY_OUT = (NSA_HEADS + FOX_HEADS) * HEAD_DIM
MLA_IN = Q_LORA + KV_LORA + QK_ROPE
MLA_OUT = MLA_HEADS * V_HEAD

kernel_name = "hybrid_nsa_fox_mla_moe_adaln"

F32 = jnp.float32


def rms_norm(x, g):
    x32 = x.astype(F32)
    y = x32 * lax.rsqrt(jnp.mean(x32 * x32, axis=-1, keepdims=True) + EPS)
    return (y * g.astype(F32)).astype(x.dtype)


def rope_cos_sin(positions, dim):
    inv = ROPE_THETA ** (-jnp.arange(0, dim, 2, dtype=F32) / dim)
    ang = positions.astype(F32)[..., None] * inv
    return jnp.cos(ang)[:, :, None, :], jnp.sin(ang)[:, :, None, :]


def apply_rope(x, cos, sin):
    x32 = x.astype(F32)
    x1, x2 = jnp.split(x32, 2, axis=-1)
    return jnp.concatenate([x1 * cos - x2 * sin, x2 * cos + x1 * sin], axis=-1).astype(x.dtype)


def masked_softmax(s, mask):
    s = jnp.where(mask, s, NEG)
    m = jnp.max(s, axis=-1, keepdims=True)
    e = jnp.where(mask, jnp.exp(s - m), 0.0)
    return e / jnp.maximum(jnp.sum(e, axis=-1, keepdims=True), 1e-30)


def causal_attention(q, k, v, scale, log_cum=None):
    B, S, H, _ = q.shape
    dv = v.shape[-1]
    nb = S // Q_BLOCK

    def q_block(i):
        qs = i * Q_BLOCK
        qb = lax.dynamic_slice_in_dim(q, qs, Q_BLOCK, 1).astype(F32)
        tq = qs + jnp.arange(Q_BLOCK)
        cq = None if log_cum is None else lax.dynamic_slice_in_dim(log_cum, qs, Q_BLOCK, 1).transpose(0, 2, 1)

        def kv_step(j, carry):
            m, l, acc = carry
            ks = j * Q_BLOCK
            kb = lax.dynamic_slice_in_dim(k, ks, Q_BLOCK, 1).astype(F32)
            vb = lax.dynamic_slice_in_dim(v, ks, Q_BLOCK, 1).astype(F32)
            s = jnp.einsum('bqhd,bkhd->bhqk', qb, kb) * scale
            if log_cum is not None:
                ck = lax.dynamic_slice_in_dim(log_cum, ks, Q_BLOCK, 1).transpose(0, 2, 1)
                s = s + cq[..., :, None] - ck[..., None, :]
            tk = ks + jnp.arange(Q_BLOCK)
            s = jnp.where((tk[None, :] <= tq[:, None])[None, None], s, NEG)
            m_new = jnp.maximum(m, jnp.max(s, axis=-1))
            a = jnp.exp(m - m_new)
            p = jnp.exp(s - m_new[..., None])
            l = l * a + jnp.sum(p, axis=-1)
            acc = acc * a[..., None] + jnp.einsum('bhqk,bkhd->bhqd', p, vb)
            return m_new, l, acc

        init = (jnp.full((B, H, Q_BLOCK), NEG, F32), jnp.zeros((B, H, Q_BLOCK), F32),
                jnp.zeros((B, H, Q_BLOCK, dv), F32))
        m, l, acc = lax.fori_loop(0, i + 1, kv_step, init)
        return (acc / l[..., None]).transpose(0, 2, 1, 3)

    out = lax.map(q_block, jnp.arange(nb))
    return out.transpose(1, 0, 2, 3, 4).reshape(B, S, H, dv).astype(v.dtype)


def nsa_attention(q, k_cmp_tok, v_cmp_tok, k_slc, v_slc, k_win, v_win, gates, cmp_pe, w_cmp, k_norm):
    B, S, H, dh = q.shape
    G = NSA_GROUPS
    hpg = H // G
    scale = dh ** -0.5
    r = CMP_LEN // CMP_STRIDE
    n_chunks = S // CMP_STRIDE
    n_cmp = n_chunks - r + 1

    def compress(t, pe, w):
        ch = t.reshape(B, n_chunks, CMP_STRIDE, G, dh)
        blocks = jnp.concatenate([ch[:, j:j + n_cmp] for j in range(r)], axis=2)
        blocks = blocks + pe[None, None, :, None, :].astype(t.dtype)
        return jnp.einsum('bnlgd,lde->bnge', blocks, w.reshape(CMP_LEN, dh, dh))

    k_cmp = rms_norm(compress(k_cmp_tok, cmp_pe[0], w_cmp[0]), k_norm).astype(F32)
    v_cmp = compress(v_cmp_tok, cmp_pe[1], w_cmp[1]).astype(F32)
    cmp_start = jnp.arange(n_cmp) * CMP_STRIDE
    cmp_end = cmp_start + CMP_LEN - 1
    n_slc = S // SLC_BLOCK
    n_sel = min(SLC_TOPK, n_slc)
    slc_start = jnp.arange(n_slc) * SLC_BLOCK
    overlap = jnp.clip(jnp.minimum(cmp_start[:, None] + CMP_LEN, slc_start[None, :] + SLC_BLOCK)
                       - jnp.maximum(cmp_start[:, None], slc_start[None, :]), 0, None).astype(F32) / CMP_STRIDE
    k_slc_b = k_slc.reshape(B, n_slc, SLC_BLOCK, G, dh).transpose(0, 3, 1, 2, 4)
    v_slc_b = v_slc.reshape(B, n_slc, SLC_BLOCK, G, dh).transpose(0, 3, 1, 2, 4)
    k_win_p = jnp.pad(k_win, ((0, 0), (WINDOW, 0), (0, 0), (0, 0)))
    v_win_p = jnp.pad(v_win, ((0, 0), (WINDOW, 0), (0, 0), (0, 0)))
    bi = jnp.arange(B)[:, None, None, None]
    gi = jnp.arange(G)[None, None, :, None]
    jj = jnp.arange(n_slc)

    def block(i):
        qs = i * Q_BLOCK
        tq = qs + jnp.arange(Q_BLOCK)
        qb = lax.dynamic_slice_in_dim(q, qs, Q_BLOCK, 1).reshape(B, Q_BLOCK, G, hpg, dh).astype(F32)
        s = jnp.einsum('bqghd,bngd->bqghn', qb, k_cmp) * scale
        p_cmp = masked_softmax(s, (cmp_end[None, :] <= tq[:, None])[None, :, None, None, :])
        o_cmp = jnp.einsum('bqghn,bngd->bqghd', p_cmp, v_cmp)
        imp = jnp.einsum('bqghn,nj->bqgj', p_cmp, overlap)
        cur = (tq // SLC_BLOCK)[:, None]
        forced = (jj[None, :] == 0) | (jj[None, :] == cur) | (jj[None, :] == cur - 1)
        imp = jnp.where(forced[None, :, None, :], imp + BIG, imp)
        imp = jnp.where((jj[None, :] * SLC_BLOCK <= tq[:, None])[None, :, None, :], imp, NEG)
        _, idx = lax.top_k(imp, n_sel)
        ksel = k_slc_b[bi, gi, idx].reshape(B, Q_BLOCK, G, n_sel * SLC_BLOCK, dh).astype(F32)
        vsel = v_slc_b[bi, gi, idx].reshape(B, Q_BLOCK, G, n_sel * SLC_BLOCK, dh).astype(F32)
        kpos = (idx[..., None] * SLC_BLOCK + jnp.arange(SLC_BLOCK)).reshape(B, Q_BLOCK, G, n_sel * SLC_BLOCK)
        s = jnp.einsum('bqghd,bqgkd->bqghk', qb, ksel) * scale
        p = masked_softmax(s, (kpos <= tq[None, :, None, None])[:, :, :, None, :])
        o_slc = jnp.einsum('bqghk,bqgkd->bqghd', p, vsel)
        kw = lax.dynamic_slice_in_dim(k_win_p, qs, WINDOW + Q_BLOCK, 1).astype(F32)
        vw = lax.dynamic_slice_in_dim(v_win_p, qs, WINDOW + Q_BLOCK, 1).astype(F32)
        wpos = qs - WINDOW + jnp.arange(WINDOW + Q_BLOCK)
        dist = tq[:, None] - wpos[None, :]
        wmask = (dist >= 0) & (dist < WINDOW) & (wpos[None, :] >= 0)
        s = jnp.einsum('bqghd,bkgd->bqghk', qb, kw) * scale
        p = masked_softmax(s, wmask[None, :, None, None, :])
        o_win = jnp.einsum('bqghk,bkgd->bqghd', p, vw)
        return jnp.stack([o_cmp, o_slc, o_win], axis=-2)

    out = lax.map(block, jnp.arange(S // Q_BLOCK))
    out = out.transpose(1, 0, 2, 3, 4, 5, 6).reshape(B, S, H, 3, dh)
    return jnp.einsum('bshr,bshrd->bshd', gates.astype(F32), out).astype(q.dtype)


def hybrid_mixer(h, cos, sin, w_in, fox_f_bias, nsa_q_norm, nsa_k_norm, nsa_cmp_pe, nsa_w_cmp,
                 fox_q_norm, fox_k_norm, w_out):
    B, S, _ = h.shape
    proj = h @ w_in
    cuts = list(np.cumsum([NSA_Q_COLS, NSA_KV_COLS, NSA_GATE_COLS, FOX_QKV_COLS]))
    nq, nkv, ng, fqkv, ff = jnp.split(proj, cuts, axis=-1)
    q = apply_rope(rms_norm(nq.reshape(B, S, NSA_HEADS, HEAD_DIM), nsa_q_norm), cos, sin)
    kv = nkv.reshape(B, S, 6, NSA_GROUPS, HEAD_DIM)
    k_cmp = apply_rope(kv[:, :, 0], cos, sin)
    k_slc = apply_rope(rms_norm(kv[:, :, 2], nsa_k_norm), cos, sin)
    k_win = apply_rope(rms_norm(kv[:, :, 4], nsa_k_norm), cos, sin)
    gates = jax.nn.sigmoid(ng.reshape(B, S, NSA_HEADS, 3))
    o_a = nsa_attention(q, k_cmp, kv[:, :, 1], k_slc, kv[:, :, 3], k_win, kv[:, :, 5], gates,
                        nsa_cmp_pe, nsa_w_cmp, nsa_k_norm)
    fqkv = fqkv.reshape(B, S, 3, FOX_HEADS, HEAD_DIM)
    fq = rms_norm(fqkv[:, :, 0], fox_q_norm)
    fk = rms_norm(fqkv[:, :, 1], fox_k_norm)
    log_f = jax.nn.log_sigmoid(ff.astype(F32) + fox_f_bias.astype(F32))
    o_b = causal_attention(fq, fk, fqkv[:, :, 2], HEAD_DIM ** -0.5, jnp.cumsum(log_f, axis=1))
    o = jnp.concatenate([o_a.reshape(B, S, -1), o_b.reshape(B, S, -1)], axis=-1)
    return o @ w_out


def mla_mixer(h, cos, sin, w_in, q_a_norm, kv_a_norm, w_uq, w_ukv, qn_norm, kn_norm, qr_norm, kr_norm, w_out):
    B, S, _ = h.shape
    proj = h @ w_in
    cq, ckv, kr = jnp.split(proj, [Q_LORA, Q_LORA + KV_LORA], axis=-1)
    q = (rms_norm(cq, q_a_norm) @ w_uq).reshape(B, S, MLA_HEADS, QK_NOPE + QK_ROPE)
    kv = (rms_norm(ckv, kv_a_norm) @ w_ukv).reshape(B, S, MLA_HEADS, QK_NOPE + V_HEAD)
    q_nope = rms_norm(q[..., :QK_NOPE], qn_norm)
    q_rope = apply_rope(rms_norm(q[..., QK_NOPE:], qr_norm), cos, sin)
    k_nope = rms_norm(kv[..., :QK_NOPE], kn_norm)
    v = kv[..., QK_NOPE:]
    k_rope = apply_rope(rms_norm(kr.reshape(B, S, 1, QK_ROPE), kr_norm), cos, sin)
    qf = jnp.concatenate([q_nope, q_rope], axis=-1)
    kf = jnp.concatenate([k_nope, jnp.broadcast_to(k_rope, (B, S, MLA_HEADS, QK_ROPE))], axis=-1)
    o = causal_attention(qf, kf, v, (QK_NOPE + QK_ROPE) ** -0.5)
    return o.reshape(B, S, -1) @ w_out


def moe_ffn(h, w_router, router_bias, w_gate, w_up, w_down, ws_gate, ws_up, ws_down):
    B, S, D = h.shape
    N = B * S
    NK = N * TOP_K
    xt = h.reshape(N, D)
    scores = jax.nn.sigmoid((xt @ w_router).astype(F32))
    sel = scores + router_bias.astype(F32)
    grp = sel.reshape(N, N_GROUPS, N_EXPERTS // N_GROUPS)
    grp_score = jnp.sum(lax.top_k(grp, 2)[0], axis=-1)
    _, gidx = lax.top_k(grp_score, TOPK_GROUPS)
    gmask = jnp.any(gidx[..., None] == jnp.arange(N_GROUPS), axis=-2)
    emask = jnp.repeat(gmask, N_EXPERTS // N_GROUPS, axis=-1)
    _, eidx = lax.top_k(jnp.where(emask, sel, NEG), TOP_K)
    w = jnp.take_along_axis(scores, eidx, axis=-1)
    w = w / jnp.sum(w, axis=-1, keepdims=True) * ROUTED_SCALE
    flat_e = eidx.reshape(-1)
    flat_t = jnp.repeat(jnp.arange(N, dtype=jnp.int32), TOP_K)
    flat_w = w.reshape(-1)
    order = jnp.argsort(flat_e)
    se, st, sw = flat_e[order], flat_t[order], flat_w[order]
    counts = jnp.bincount(flat_e, length=N_EXPERTS)
    start = jnp.cumsum(counts) - counts
    padded = (counts + ROW_BLOCK - 1) // ROW_BLOCK * ROW_BLOCK
    pend = jnp.cumsum(padded)
    pstart = pend - padded
    dest = pstart[se] + jnp.arange(NK) - start[se]
    n_blocks = (NK + N_EXPERTS * (ROW_BLOCK - 1) + ROW_BLOCK - 1) // ROW_BLOCK
    rows = n_blocks * ROW_BLOCK
    row_tok = jnp.full((rows,), N, jnp.int32).at[dest].set(st)
    row_w = jnp.zeros((rows,), F32).at[dest].set(sw)
    blk_e = jnp.minimum(jnp.searchsorted(pend, jnp.arange(n_blocks) * ROW_BLOCK, side='right'), N_EXPERTS - 1)
    x_pad = jnp.concatenate([xt, jnp.zeros((1, D), xt.dtype)], axis=0)

    def expert_block(args):
        tok, wr, e = args
        xb = x_pad[tok]
        a = jax.nn.silu(xb @ w_gate[e]) * (xb @ w_up[e])
        return (a @ w_down[e]) * wr[:, None].astype(xb.dtype)

    y_rows = lax.map(expert_block, (row_tok.reshape(n_blocks, ROW_BLOCK), row_w.reshape(n_blocks, ROW_BLOCK), blk_e))
    routed = jax.ops.segment_sum(y_rows.reshape(rows, D), row_tok, num_segments=N + 1)[:N]
    shared = (jax.nn.silu(xt @ ws_gate) * (xt @ ws_up)) @ ws_down
    return (routed + shared).reshape(B, S, D)


def setup_inputs(seed: int = 0) -> dict:
    key = jax.random.key(seed)
    ks = iter(jax.random.split(key, 64))

    def nrm(shape, scale):
        return scale * jax.random.normal(next(ks), shape, F32)

    def gain(shape):
        return 1.0 + nrm(shape, 0.1)

    D = D_MODEL
    x = nrm((BATCH, SEQ, D), 1.0)
    c = nrm((BATCH, D), 1.0)
    positions = (jax.random.randint(next(ks), (BATCH, 1), 0, 4096, dtype=jnp.int32)
                 + jnp.arange(SEQ, dtype=jnp.int32)[None, :])
    return {
        "x": x, "c": c, "positions": positions,
        "norm_attn": gain((DEPTH, D)), "norm_ffn": gain((DEPTH, D)),
        "w_ada": nrm((DEPTH, D, 6 * D), 0.25 * D ** -0.5), "b_ada": nrm((DEPTH, 6 * D), 0.01),
        "hy_w_in": nrm((N_EVEN, D, HY_IN), D ** -0.5),
        "fox_f_bias": 2.0 + nrm((N_EVEN, FOX_HEADS), 0.5),
        "nsa_q_norm": gain((N_EVEN, HEAD_DIM)), "nsa_k_norm": gain((N_EVEN, HEAD_DIM)),
        "nsa_cmp_pe": nrm((N_EVEN, 2, CMP_LEN, HEAD_DIM), 0.5),
        "nsa_w_cmp": nrm((N_EVEN, 2, CMP_LEN * HEAD_DIM, HEAD_DIM), (CMP_LEN * HEAD_DIM) ** -0.5),
        "fox_q_norm": gain((N_EVEN, HEAD_DIM)), "fox_k_norm": gain((N_EVEN, HEAD_DIM)),
        "hy_w_out": nrm((N_EVEN, HY_OUT, D), HY_OUT ** -0.5),
        "mla_w_in": nrm((N_ODD, D, MLA_IN), D ** -0.5),
        "mla_q_a_norm": gain((N_ODD, Q_LORA)), "mla_kv_a_norm": gain((N_ODD, KV_LORA)),
        "mla_w_uq": nrm((N_ODD, Q_LORA, MLA_HEADS * (QK_NOPE + QK_ROPE)), Q_LORA ** -0.5),
        "mla_w_ukv": nrm((N_ODD, KV_LORA, MLA_HEADS * (QK_NOPE + V_HEAD)), KV_LORA ** -0.5),
        "mla_qn_norm": gain((N_ODD, QK_NOPE)), "mla_kn_norm": gain((N_ODD, QK_NOPE)),
        "mla_qr_norm": gain((N_ODD, QK_ROPE)), "mla_kr_norm": gain((N_ODD, QK_ROPE)),
        "mla_w_out": nrm((N_ODD, MLA_OUT, D), MLA_OUT ** -0.5),
        "moe_w_router": nrm((DEPTH, D, N_EXPERTS), D ** -0.5),
        "moe_router_bias": nrm((DEPTH, N_EXPERTS), 0.01),
        "moe_w_gate": nrm((DEPTH, N_EXPERTS, D, EXPERT_FF), D ** -0.5),
        "moe_w_up": nrm((DEPTH, N_EXPERTS, D, EXPERT_FF), D ** -0.5),
        "moe_w_down": nrm((DEPTH, N_EXPERTS, EXPERT_FF, D), EXPERT_FF ** -0.5),
        "moe_ws_gate": nrm((DEPTH, D, SHARED_FF), D ** -0.5),
        "moe_ws_up": nrm((DEPTH, D, SHARED_FF), D ** -0.5),
        "moe_ws_down": nrm((DEPTH, SHARED_FF, D), SHARED_FF ** -0.5),
    }


def reference(x, c, positions, norm_attn, norm_ffn, w_ada, b_ada,
              hy_w_in, fox_f_bias, nsa_q_norm, nsa_k_norm, nsa_cmp_pe, nsa_w_cmp, fox_q_norm, fox_k_norm, hy_w_out,
              mla_w_in, mla_q_a_norm, mla_kv_a_norm, mla_w_uq, mla_w_ukv, mla_qn_norm, mla_kn_norm,
              mla_qr_norm, mla_kr_norm, mla_w_out,
              moe_w_router, moe_router_bias, moe_w_gate, moe_w_up, moe_w_down, moe_ws_gate, moe_ws_up, moe_ws_down):
    cond = jax.nn.silu(c)
    cos_a, sin_a = rope_cos_sin(positions, HEAD_DIM)
    cos_c, sin_c = rope_cos_sin(positions, QK_ROPE)
    for layer in range(DEPTH):
        mod = cond @ w_ada[layer] + b_ada[layer]
        sh1, sc1, g1, sh2, sc2, g2 = jnp.split(mod[:, None, :], 6, axis=-1)
        h = rms_norm(x, norm_attn[layer]) * (1.0 + sc1) + sh1
        i = layer // 2
        if layer % 2 == 0:
            y = hybrid_mixer(h, cos_a, sin_a, hy_w_in[i], fox_f_bias[i], nsa_q_norm[i], nsa_k_norm[i],
                             nsa_cmp_pe[i], nsa_w_cmp[i], fox_q_norm[i], fox_k_norm[i], hy_w_out[i])
        else:
            y = mla_mixer(h, cos_c, sin_c, mla_w_in[i], mla_q_a_norm[i], mla_kv_a_norm[i], mla_w_uq[i],
                          mla_w_ukv[i], mla_qn_norm[i], mla_kn_norm[i], mla_qr_norm[i], mla_kr_norm[i], mla_w_out[i])
        x = x + g1 * y
        h = rms_norm(x, norm_ffn[layer]) * (1.0 + sc2) + sh2
        x = x + g2 * moe_ffn(h, moe_w_router[layer], moe_router_bias[layer], moe_w_gate[layer], moe_w_up[layer],
                             moe_w_down[layer], moe_ws_gate[layer], moe_ws_up[layer], moe_ws_down[layer])
    return x
```

```cpp
#include <hip/hip_runtime.h>
#include <stdint.h>

#define S_ 16384
#define D_ 1024
#define HYIN 2848
#define NEXP 64
#define EPSF 1e-6f

__device__ __forceinline__ float wsum(float v) {
#pragma unroll
    for (int o = 32; o > 0; o >>= 1) v += __shfl_xor(v, o);
    return v;
}
__device__ __forceinline__ float siluf(float x) { return x / (1.f + expf(-x)); }
__device__ __forceinline__ float sigmf(float x) { return 1.f / (1.f + expf(-x)); }
__device__ __forceinline__ float logsigmf(float x) { return fminf(x, 0.f) - log1pf(expf(-fabsf(x))); }

__global__ void k_rope(const int* __restrict__ pos, float* __restrict__ cosT, float* __restrict__ sinT) {
    int idx = blockIdx.x * 256 + threadIdx.x;
    if (idx >= S_ * 48) return;
    int t = idx / 48, i = idx % 48;
    double ex = (i < 32) ? (double)(2 * i) / 64.0 : (double)(2 * (i - 32)) / 32.0;
    double freq = exp(-ex * 9.210340371976184);
    double a = (double)pos[t] * freq;
    double n = rint(a * 0.15915494309189535);
    double r = a - n * 6.283185307179586;
    float rf = (float)r;
    cosT[idx] = cosf(rf);
    sinT[idx] = sinf(rf);
}

__global__ void k_mod(const float* __restrict__ c, const float* __restrict__ w, const float* __restrict__ b, float* __restrict__ mod) {
    int idx = blockIdx.x * 256 + threadIdx.x;
    int l = idx / 6144, n = idx % 6144;
    const float* wl = w + (size_t)l * 1024 * 6144;
    float acc = 0.f;
    for (int k = 0; k < 1024; ++k) acc += siluf(c[k]) * wl[(size_t)k * 6144 + n];
    mod[idx] = acc + b[idx];
}

__global__ void k_normmod(const float* __restrict__ x, const float* __restrict__ g, const float* __restrict__ sc, const float* __restrict__ sh, float* __restrict__ out) {
    __shared__ float red[4];
    int t = blockIdx.x, tid = threadIdx.x;
    const float4 v = ((const float4*)(x + (size_t)t * D_))[tid];
    float s = v.x * v.x + v.y * v.y + v.z * v.z + v.w * v.w;
    s = wsum(s);
    if ((tid & 63) == 0) red[tid >> 6] = s;
    __syncthreads();
    float tot = red[0] + red[1] + red[2] + red[3];
    float r = rsqrtf(tot * (1.f / D_) + EPSF);
    const float4 gg = ((const float4*)g)[tid], cc = ((const float4*)sc)[tid], hh = ((const float4*)sh)[tid];
    float4 o;
    o.x = v.x * r * gg.x * (1.f + cc.x) + hh.x;
    o.y = v.y * r * gg.y * (1.f + cc.y) + hh.y;
    o.z = v.z * r * gg.z * (1.f + cc.z) + hh.z;
    o.w = v.w * r * gg.w * (1.f + cc.w) + hh.w;
    ((float4*)(out + (size_t)t * D_))[tid] = o;
}

template <int EPI>
__global__ __launch_bounds__(256) void k_gemm(const float* __restrict__ A, int lda, const float* __restrict__ W, int N, int K,
                                               float* C, int ldc, const float* res, const float* __restrict__ gate) {
    int n = blockIdx.x * 256 + threadIdx.x;
    int m0 = blockIdx.y * 8;
    if (n >= N) return;
    float acc[8];
#pragma unroll
    for (int i = 0; i < 8; ++i) acc[i] = 0.f;
    for (int k = 0; k < K; k += 4) {
        float w0 = W[(size_t)k * N + n], w1 = W[(size_t)(k + 1) * N + n], w2 = W[(size_t)(k + 2) * N + n], w3 = W[(size_t)(k + 3) * N + n];
#pragma unroll
        for (int i = 0; i < 8; ++i) {
            const float4 a = *(const float4*)(A + (size_t)(m0 + i) * lda + k);
            acc[i] += a.x * w0; acc[i] += a.y * w1; acc[i] += a.z * w2; acc[i] += a.w * w3;
        }
    }
#pragma unroll
    for (int i = 0; i < 8; ++i) {
        size_t o = (size_t)(m0 + i) * ldc + n;
        if (EPI == 0) C[o] = acc[i];
        else C[o] = res[o] + gate[n] * acc[i];
    }
}

__global__ __launch_bounds__(256) void k_post0(float* proj, const float* __restrict__ cosT, const float* __restrict__ sinT,
                                                const float* __restrict__ qn, const float* __restrict__ kn, const float* __restrict__ fqn,
                                                const float* __restrict__ fkn, const float* __restrict__ fbias) {
    int t = blockIdx.x, tid = threadIdx.x, wave = tid >> 6, lane = tid & 63;
    float* p = proj + (size_t)t * HYIN;
    for (int hv = wave; hv < 30; hv += 4) {
        int col; const float* nw; bool rope;
        if (hv < 8) { col = hv * 64; nw = qn; rope = true; }
        else if (hv < 10) { col = 512 + 0 * 128 + (hv - 8) * 64; nw = nullptr; rope = true; }
        else if (hv < 12) { col = 512 + 2 * 128 + (hv - 10) * 64; nw = kn; rope = true; }
        else if (hv < 14) { col = 512 + 4 * 128 + (hv - 12) * 64; nw = kn; rope = true; }
        else if (hv < 22) { col = 1304 + (hv - 14) * 64; nw = fqn; rope = false; }
        else { col = 1304 + 512 + (hv - 22) * 64; nw = fkn; rope = false; }
        float v = p[col + lane];
        if (nw) { float ss = wsum(v * v); v = v * rsqrtf(ss * (1.f / 64.f) + EPSF) * nw[lane]; }
        if (rope) {
            float o = __shfl_xor(v, 32);
            int i = lane & 31;
            float c = cosT[t * 48 + i], s = sinT[t * 48 + i];
            v = (lane < 32) ? (v * c - o * s) : (v * c + o * s);
        }
        p[col + lane] = v;
    }
    if (tid < 24) p[1280 + tid] = sigmf(p[1280 + tid]);
    if (tid >= 64 && tid < 72) { int h = tid - 64; p[2840 + h] = logsigmf(p[2840 + h] + fbias[h]); }
}

__global__ __launch_bounds__(1024) void k_cumsum(const float* __restrict__ proj, float* __restrict__ cum) {
    __shared__ double part[1024];
    int tid = threadIdx.x;
    for (int h = 0; h < 8; ++h) {
        double s = 0.0;
        for (int i = 0; i < 16; ++i) s += (double)proj[(size_t)(tid * 16 + i) * HYIN + 2840 + h];
        part[tid] = s;
        __syncthreads();
        for (int o = 1; o < 1024; o <<= 1) {
            double v = (tid >= o) ? part[tid - o] : 0.0;
            __syncthreads();
            part[tid] += v;
            __syncthreads();
        }
        double base = (tid > 0) ? part[tid - 1] : 0.0;
        __syncthreads();
        double a = base;
        for (int i = 0; i < 16; ++i) { a += (double)proj[(size_t)(tid * 16 + i) * HYIN + 2840 + h]; cum[(size_t)(tid * 16 + i) * 8 + h] = (float)a; }
    }
}

__global__ __launch_bounds__(64) void k_compress(const float* __restrict__ proj, const float* __restrict__ pe, const float* __restrict__ w,
                                                  const float* __restrict__ kn, float* __restrict__ kcmp, float* __restrict__ vcmp) {
    int b = blockIdx.x, e = threadIdx.x;
    int n = b % 1023, g = (b / 1023) & 1, kv = b / 2046;
    const float* wk = w + (size_t)kv * 2048 * 64;
    const float* pk = pe + (size_t)kv * 2048;
    float acc = 0.f;
    for (int l = 0; l < 32; ++l) {
        const float* tp = proj + (size_t)(16 * n + l) * HYIN + 512 + kv * 128 + g * 64;
        for (int d = 0; d < 64; ++d) acc += (tp[d] + pk[l * 64 + d]) * wk[(size_t)(l * 64 + d) * 64 + e];
    }
    if (kv == 0) {
        float ss = wsum(acc * acc);
        kcmp[(size_t)(g * 1023 + n) * 64 + e] = acc * rsqrtf(ss * (1.f / 64.f) + EPSF) * kn[e];
    } else vcmp[(size_t)(g * 1023 + n) * 64 + e] = acc;
}

#define DOT64(sc, q, kp) { sc = 0.f; _Pragma("unroll") for (int d4 = 0; d4 < 16; ++d4) { const float4 kk = ((const float4*)(kp))[d4]; \
    sc += q[4 * d4] * kk.x; sc += q[4 * d4 + 1] * kk.y; sc += q[4 * d4 + 2] * kk.z; sc += q[4 * d4 + 3] * kk.w; } }
#define AXPY64(acc, p, vp) { _Pragma("unroll") for (int d4 = 0; d4 < 16; ++d4) { const float4 vv = ((const float4*)(vp))[d4]; \
    acc[4 * d4] += p * vv.x; acc[4 * d4 + 1] += p * vv.y; acc[4 * d4 + 2] += p * vv.z; acc[4 * d4 + 3] += p * vv.w; } }
#define ONLINE(sc, m, l, acc) { if (sc > m) { float a_ = expf(m - sc); l *= a_; _Pragma("unroll") for (int d = 0; d < 64; ++d) acc[d] *= a_; m = sc; } }

__global__ __launch_bounds__(64) void k_nsa_cmp(const float* __restrict__ proj, const float* __restrict__ kcmp, const float* __restrict__ vcmp,
                                                 float* __restrict__ imp, float* __restrict__ oattn) {
    int t = blockIdx.x * 64 + threadIdx.x, g = blockIdx.y;
    int nmax = (t >= 31) ? ((t - 31) >> 4) : -1;
    int nmaxw = (blockIdx.x * 64 + 63 - 31) >> 4;
    float* ir = imp + (size_t)(t * 2 + g) * 256;
    for (int j = 0; j < 256; ++j) ir[j] = 0.f;
    const float* kc = kcmp + (size_t)g * 1023 * 64;
    const float* vc = vcmp + (size_t)g * 1023 * 64;
    for (int hh = 0; hh < 4; ++hh) {
        int h = g * 4 + hh;
        float q[64];
        const float* qp = proj + (size_t)t * HYIN + h * 64;
#pragma unroll
        for (int d = 0; d < 64; ++d) q[d] = qp[d] * 0.125f;
        float m = -INFINITY, l = 0.f;
        for (int n = 0; n <= nmaxw; ++n) {
            float sc; DOT64(sc, q, kc + (size_t)n * 64);
            if (n <= nmax) { if (sc > m) { l *= expf(m - sc); m = sc; } l += expf(sc - m); }
        }
        float il = (l > 0.f) ? 1.f / l : 0.f;
        float acc[64];
#pragma unroll
        for (int d = 0; d < 64; ++d) acc[d] = 0.f;
        float cur = 0.f;
        for (int n = 0; n <= nmaxw; ++n) {
            float sc; DOT64(sc, q, kc + (size_t)n * 64);
            float p = (n <= nmax) ? expf(sc - m) * il : 0.f;
            AXPY64(acc, p, vc + (size_t)n * 64);
            int r = n & 3;
            if (r < 3) cur += 2.f * p;
            else { cur += p; ir[n >> 2] += cur; cur = p; }
        }
        { int jn = (nmaxw + 1) >> 2; if (jn < 256) ir[jn] += cur; }
        float gt = proj[(size_t)t * HYIN + 1280 + h * 3 + 0];
        float* op = oattn + (size_t)t * D_ + h * 64;
#pragma unroll
        for (int d = 0; d < 64; ++d) op[d] = gt * acc[d];
    }
}

__global__ void k_nsa_topk(float* imp, int* __restrict__ sel) {
    int idx = blockIdx.x * 256 + threadIdx.x;
    int t = idx >> 1;
    int cur = t >> 6;
    float* ir = imp + (size_t)idx * 256;
    for (int i = 0; i < 16; ++i) {
        float best = -INFINITY; int bj = -1;
        for (int j = 0; j <= cur; ++j) {
            float v = ir[j];
            if (j == 0 || j == cur || j == cur - 1) v = v + 1e6f;
            if (v > best) { best = v; bj = j; }
        }
        sel[(size_t)idx * 16 + i] = bj;
        if (bj >= 0) ir[bj] = -INFINITY;
    }
}

__global__ __launch_bounds__(64) void k_nsa_slc(const float* __restrict__ proj, const int* __restrict__ sel, float* __restrict__ oattn) {
    int t = blockIdx.x * 64 + threadIdx.x, h = blockIdx.y, g = h >> 2;
    float q[64];
    const float* qp = proj + (size_t)t * HYIN + h * 64;
#pragma unroll
    for (int d = 0; d < 64; ++d) q[d] = qp[d] * 0.125f;
    float m = -INFINITY, l = 0.f, acc[64];
#pragma unroll
    for (int d = 0; d < 64; ++d) acc[d] = 0.f;
    for (int i = 0; i < 16; ++i) {
        int blk = sel[(size_t)(t * 2 + g) * 16 + i];
        for (int kk = 0; kk < 64; ++kk) {
            int s = blk * 64 + kk;
            if (blk >= 0 && s <= t) {
                const float* kp = proj + (size_t)s * HYIN + 512 + 2 * 128 + g * 64;
                float sc; DOT64(sc, q, kp);
                ONLINE(sc, m, l, acc);
                float p = expf(sc - m); l += p;
                AXPY64(acc, p, kp + 128);
            }
        }
    }
    float gt = proj[(size_t)t * HYIN + 1280 + h * 3 + 1] / l;
    float* op = oattn + (size_t)t * D_ + h * 64;
#pragma unroll
    for (int d = 0; d < 64; ++d) op[d] += gt * acc[d];
}

__global__ __launch_bounds__(64) void k_nsa_win(const float* __restrict__ proj, float* __restrict__ oattn) {
    int t0 = blockIdx.x * 64, t = t0 + threadIdx.x, h = blockIdx.y, g = h >> 2;
    float q[64];
    const float* qp = proj + (size_t)t * HYIN + h * 64;
#pragma unroll
    for (int d = 0; d < 64; ++d) q[d] = qp[d] * 0.125f;
    float m = -INFINITY, l = 0.f, acc[64];
#pragma unroll
    for (int d = 0; d < 64; ++d) acc[d] = 0.f;
    int s0 = t0 - 511; if (s0 < 0) s0 = 0;
    for (int s = s0; s <= t0 + 63; ++s) {
        const float* kp = proj + (size_t)s * HYIN + 512 + 4 * 128 + g * 64;
        float sc; DOT64(sc, q, kp);
        if (s <= t && t - s < 512) {
            ONLINE(sc, m, l, acc);
            float p = expf(sc - m); l += p;
            AXPY64(acc, p, kp + 128);
        }
    }
    float gt = proj[(size_t)t * HYIN + 1280 + h * 3 + 2] / l;
    float* op = oattn + (size_t)t * D_ + h * 64;
#pragma unroll
    for (int d = 0; d < 64; ++d) op[d] += gt * acc[d];
}

__global__ __launch_bounds__(64) void k_fox(const float* __restrict__ proj, const float* __restrict__ cum, float* __restrict__ oattn) {
    int t0 = blockIdx.x * 64, t = t0 + threadIdx.x, h = blockIdx.y;
    float q[64];
    const float* qp = proj + (size_t)t * HYIN + 1304 + h * 64;
#pragma unroll
    for (int d = 0; d < 64; ++d) q[d] = qp[d] * 0.125f;
    float ct = cum[(size_t)t * 8 + h];
    float m = -INFINITY, l = 0.f, acc[64];
#pragma unroll
    for (int d = 0; d < 64; ++d) acc[d] = 0.f;
    for (int s = 0; s <= t0 + 63; ++s) {
        const float* kp = proj + (size_t)s * HYIN + 1304 + 512 + h * 64;
        float sc; DOT64(sc, q, kp);
        sc += ct - cum[(size_t)s * 8 + h];
        if (s <= t) {
            ONLINE(sc, m, l, acc);
            float p = expf(sc - m); l += p;
            AXPY64(acc, p, kp + 512);
        }
    }
    float il = 1.f / l;
    float* op = oattn + (size_t)t * D_ + 512 + h * 64;
#pragma unroll
    for (int d = 0; d < 64; ++d) op[d] = il * acc[d];
}

__global__ __launch_bounds__(256) void k_route(const float* __restrict__ h, const float* __restrict__ wr, const float* __restrict__ rb,
                                                int* __restrict__ eidx, float* __restrict__ ew) {
    int t = blockIdx.x * 4 + (threadIdx.x >> 6), lane = threadIdx.x & 63;
    const float* hp = h + (size_t)t * D_;
    float acc = 0.f;
    for (int k = 0; k < 1024; ++k) acc += hp[k] * wr[k * 64 + lane];
    float score = sigmf(acc);
    float sv = score + rb[lane];
    float m1 = sv;
    m1 = fmaxf(m1, __shfl_xor(m1, 1)); m1 = fmaxf(m1, __shfl_xor(m1, 2)); m1 = fmaxf(m1, __shfl_xor(m1, 4));
    int am = (sv == m1) ? (lane & 7) : 8;
    am = min(am, __shfl_xor(am, 1)); am = min(am, __shfl_xor(am, 2)); am = min(am, __shfl_xor(am, 4));
    float m2 = ((lane & 7) == am) ? -INFINITY : sv;
    m2 = fmaxf(m2, __shfl_xor(m2, 1)); m2 = fmaxf(m2, __shfl_xor(m2, 2)); m2 = fmaxf(m2, __shfl_xor(m2, 4));
    float gs = m1 + m2;
    int gi = lane >> 3, grank = 0;
#pragma unroll
    for (int gj = 0; gj < 8; ++gj) { float o = __shfl(gs, gj * 8); grank += (o > gs || (o == gs && gj < gi)) ? 1 : 0; }
    float msk = (grank < 4) ? sv : -1e30f;
    int rank = 0;
    for (int e = 0; e < 64; ++e) { float o = __shfl(msk, e); rank += (o > msk || (o == msk && e < lane)) ? 1 : 0; }
    bool selb = rank < 8;
    float wsel = selb ? score : 0.f;
    float tot = wsum(wsel);
    if (selb) { eidx[(size_t)t * 8 + rank] = lane; ew[(size_t)t * 8 + rank] = score / tot * 2.5f; }
}

__global__ __launch_bounds__(256) void k_moe_hid(const float* __restrict__ h, const int* __restrict__ eidx, const float* __restrict__ wg,
                                                  const float* __restrict__ wu, float* __restrict__ hid, int shared) {
    int b = blockIdx.x, f = threadIdx.x;
    int t = shared ? b : (b >> 3);
    int e = shared ? 0 : eidx[b];
    const float* hp = h + (size_t)t * D_;
    const float* g = wg + (size_t)e * 1024 * 256 + f;
    const float* u = wu + (size_t)e * 1024 * 256 + f;
    float ag = 0.f, au = 0.f;
    for (int d = 0; d < 1024; d += 4) {
        const float4 hv = *(const float4*)(hp + d);
        ag += hv.x * g[(size_t)d * 256]; au += hv.x * u[(size_t)d * 256];
        ag += hv.y * g[(size_t)(d + 1) * 256]; au += hv.y * u[(size_t)(d + 1) * 256];
        ag += hv.z * g[(size_t)(d + 2) * 256]; au += hv.z * u[(size_t)(d + 2) * 256];
        ag += hv.w * g[(size_t)(d + 3) * 256]; au += hv.w * u[(size_t)(d + 3) * 256];
    }
    hid[(size_t)b * 256 + f] = siluf(ag) * au;
}

__global__ __launch_bounds__(256) void k_moe_out(const float* __restrict__ hid, const float* __restrict__ hids, const int* __restrict__ eidx,
                                                  const float* __restrict__ ew, const float* __restrict__ wd, const float* __restrict__ wsd,
                                                  const float* __restrict__ g2, float* xio) {
    int t = blockIdx.x, col = blockIdx.y * 256 + threadIdx.x;
    float acc = 0.f;
    for (int k = 0; k < 8; ++k) {
        int e = eidx[(size_t)t * 8 + k]; float w = ew[(size_t)t * 8 + k];
        const float* hp = hid + (size_t)(t * 8 + k) * 256;
        const float* wp = wd + (size_t)e * 256 * 1024 + col;
        float a = 0.f;
        for (int f = 0; f < 256; ++f) a += hp[f] * wp[(size_t)f * 1024];
        acc += w * a;
    }
    {
        const float* hp = hids + (size_t)t * 256;
        const float* wp = wsd + col;
        float a = 0.f;
        for (int f = 0; f < 256; ++f) a += hp[f] * wp[(size_t)f * 1024];
        acc += a;
    }
    size_t o = (size_t)t * D_ + col;
    xio[o] = xio[o] + g2[col] * acc;
}

__global__ __launch_bounds__(256) void k_post1a(float* proj, const float* __restrict__ cosT, const float* __restrict__ sinT,
                                                 const float* __restrict__ qa, const float* __restrict__ kva, const float* __restrict__ krn) {
    int t = blockIdx.x, wave = threadIdx.x >> 6, lane = threadIdx.x & 63;
    float* p = proj + (size_t)t * 672;
    if (wave == 0) {
        float v[6]; float ss = 0.f;
#pragma unroll
        for (int i = 0; i < 6; ++i) { v[i] = p[i * 64 + lane]; ss += v[i] * v[i]; }
        ss = wsum(ss); float r = rsqrtf(ss * (1.f / 384.f) + EPSF);
#pragma unroll
        for (int i = 0; i < 6; ++i) p[i * 64 + lane] = v[i] * r * qa[i * 64 + lane];
    } else if (wave == 1) {
        float v[4]; float ss = 0.f;
#pragma unroll
        for (int i = 0; i < 4; ++i) { v[i] = p[384 + i * 64 + lane]; ss += v[i] * v[i]; }
        ss = wsum(ss); float r = rsqrtf(ss * (1.f / 256.f) + EPSF);
#pragma unroll
        for (int i = 0; i < 4; ++i) p[384 + i * 64 + lane] = v[i] * r * kva[i * 64 + lane];
    } else if (wave == 2) {
        float v = (lane < 32) ? p[640 + lane] : 0.f;
        float ss = wsum(v * v);
        v = v * rsqrtf(ss * (1.f / 32.f) + EPSF) * ((lane < 32) ? krn[lane] : 0.f);
        float o = __shfl_xor(v, 16);
        int i = lane & 15;
        float c = cosT[t * 48 + 32 + i], s = sinT[t * 48 + 32 + i];
        v = ((lane & 16) == 0) ? (v * c - o * s) : (v * c + o * s);
        if (lane < 32) p[640 + lane] = v;
    }
}

__global__ __launch_bounds__(256) void k_post1b(float* q1, float* kv1, const float* __restrict__ cosT, const float* __restrict__ sinT,
                                                 const float* __restrict__ qn, const float* __restrict__ knn, const float* __restrict__ qr) {
    int t = blockIdx.x, wave = threadIdx.x >> 6, lane = threadIdx.x & 63;
    for (int it = wave; it < 48; it += 4) {
        if (it < 16) {
            float* p = q1 + (size_t)t * 1536 + it * 96;
            float v = p[lane]; float ss = wsum(v * v);
            p[lane] = v * rsqrtf(ss * (1.f / 64.f) + EPSF) * qn[lane];
        } else if (it < 32) {
            float* p = q1 + (size_t)t * 1536 + (it - 16) * 96 + 64;
            float v = (lane < 32) ? p[lane] : 0.f;
            float ss = wsum(v * v);
            v = v * rsqrtf(ss * (1.f / 32.f) + EPSF) * ((lane < 32) ? qr[lane] : 0.f);
            float o = __shfl_xor(v, 16);
            int i = lane & 15;
            float c = cosT[t * 48 + 32 + i], s = sinT[t * 48 + 32 + i];
            v = ((lane & 16) == 0) ? (v * c - o * s) : (v * c + o * s);
            if (lane < 32) p[lane] = v;
        } else {
            float* p = kv1 + (size_t)t * 2048 + (it - 32) * 128;
            float v = p[lane]; float ss = wsum(v * v);
            p[lane] = v * rsqrtf(ss * (1.f / 64.f) + EPSF) * knn[lane];
        }
    }
}

__global__ __launch_bounds__(64) void k_mla(const float* __restrict__ q1, const float* __restrict__ kv1, const float* __restrict__ proj1, float* __restrict__ oattn) {
    int t0 = blockIdx.x * 64, t = t0 + threadIdx.x, h = blockIdx.y;
    const float scale = 0.10206207261596577f;
    float q[64], qr[32];
    const float* qp = q1 + (size_t)t * 1536 + h * 96;
#pragma unroll
    for (int d = 0; d < 64; ++d) q[d] = qp[d] * scale;
#pragma unroll
    for (int d = 0; d < 32; ++d) qr[d] = qp[64 + d] * scale;
    float m = -INFINITY, l = 0.f, acc[64];
#pragma unroll
    for (int d = 0; d < 64; ++d) acc[d] = 0.f;
    for (int s = 0; s <= t0 + 63; ++s) {
        const float* kp = kv1 + (size_t)s * 2048 + h * 128;
        const float* rp = proj1 + (size_t)s * 672 + 640;
        float sc; DOT64(sc, q, kp);
#pragma unroll
        for (int d4 = 0; d4 < 8; ++d4) { const float4 kk = ((const float4*)rp)[d4];
            sc += qr[4 * d4] * kk.x; sc += qr[4 * d4 + 1] * kk.y; sc += qr[4 * d4 + 2] * kk.z; sc += qr[4 * d4 + 3] * kk.w; }
        if (s <= t) {
            ONLINE(sc, m, l, acc);
            float p = expf(sc - m); l += p;
            AXPY64(acc, p, kp + 64);
        }
    }
    float il = 1.f / l;
    float* op = oattn + (size_t)t * D_ + h * 64;
#pragma unroll
    for (int d = 0; d < 64; ++d) op[d] = il * acc[d];
}

#define LAS __attribute__((address_space(3)))
#define GAS __attribute__((address_space(1)))
typedef unsigned short bf16_t;
typedef short bf16x8 __attribute__((ext_vector_type(8)));
typedef float f32x4 __attribute__((ext_vector_type(4)));
typedef float f32x2 __attribute__((ext_vector_type(2)));
typedef unsigned u32x4 __attribute__((ext_vector_type(4)));
typedef unsigned u32x2 __attribute__((ext_vector_type(2)));
typedef __bf16 bf16x2_t __attribute__((ext_vector_type(2)));

__device__ __forceinline__ unsigned cvtpk(float lo, float hi) { f32x2 v = {lo, hi}; bf16x2_t b = __builtin_convertvector(v, bf16x2_t); return __builtin_bit_cast(unsigned, b); }
__device__ __forceinline__ float bf2f(bf16_t v) { return __uint_as_float(((unsigned)v) << 16); }
__device__ __forceinline__ bf16_t f2bf(float f) { return (bf16_t)(cvtpk(f, 0.f) & 0xffffu); }

namespace pg {
constexpr int BM = 256, BK = 64, HALF = 128, HTB = HALF * BK * 2, STAGE_BYTES = 8 * HTB;
__device__ __forceinline__ int lds_byte(int r, int c) { const int st = (r >> 4) * 2 + (c >> 5), rr = r & 15, cc = c & 31, ob = rr * 64 + cc * 2; return st * 1024 + (ob ^ (((ob >> 9) & 1) << 5)); }
__device__ __forceinline__ void stage_rc(int b, int& R, int& C) { const int st = b / 1024, sb = b % 1024, swz = sb ^ (((sb >> 9) & 1) << 5); R = (st >> 1) * 16 + swz / 64; C = (st & 1) * 32 + (swz % 64) / 2; }

struct Unit { int pm, pn, aux; const char* A; const char* B; unsigned ra[4]; };

template <class Epi, class Sched>
__device__ __forceinline__ void gemm_run(LAS unsigned char* lds, const int K, const Sched& S, const Epi& E) {
    int tid_ = threadIdx.x; asm volatile("" : "+v"(tid_));
    const int tid = tid_, wid = __builtin_amdgcn_readfirstlane(tid >> 6), lane = tid & 63, wr = wid >> 2, wc = wid & 3, fr = lane & 15, fq = lane >> 4;
    int nt_ = K / BK; asm volatile("" : "+s"(nt_)); const int nt = nt_;
    int R0, C0; stage_rc(tid * 16, R0, C0);
    unsigned voffB[2];
#pragma unroll
    for (int i = 0; i < 2; ++i) voffB[i] = (unsigned)((R0 + 64 * i) * K + C0) * 2u;
    const size_t kstep = (size_t)(BK * 2);
    const size_t hstep = (size_t)HALF * K * 2;
    const unsigned ldsw = (unsigned)wid * 1024u;
    const int aoff = lds_byte(wr * 64 + fr, fq * 8), boff = lds_byte(wc * 32 + fr, fq * 8);
#define PG_SA(b, h) (((b) * 2 + (h)) * HTB)
#define PG_SB(b, h) ((4 + (b) * 2 + (h)) * HTB)
#define PG_STAGE2(bufoff, gbase, v0, v1) do { \
        __builtin_amdgcn_global_load_lds((const unsigned*)((const char*)(gbase) + (v0)), (LAS unsigned*)(lds + (bufoff) + ldsw), 16, 0, 0); \
        __builtin_amdgcn_global_load_lds((const unsigned*)((const char*)(gbase) + (v1)), (LAS unsigned*)(lds + (bufoff) + ldsw + 8192), 16, 0, 0); } while (0)
#define PG_STAGEB(bufoff, gbase) PG_STAGE2(bufoff, gbase, voffB[0], voffB[1])
#define PG_LDA(dst, b, h) do { _Pragma("unroll") for (int m = 0; m < 4; ++m) _Pragma("unroll") for (int k = 0; k < 2; ++k) dst[m][k] = *(const LAS bf16x8*)(lds + PG_SA(b, h) + aoff + m * 2048 + k * 1024); } while (0)
#define PG_LDB(dst, b, h) do { _Pragma("unroll") for (int n = 0; n < 2; ++n) _Pragma("unroll") for (int k = 0; k < 2; ++k) dst[n][k] = *(const LAS bf16x8*)(lds + PG_SB(b, h) + boff + n * 2048 + k * 1024); } while (0)
#define PG_MMA(ai, bj, At, Bt) do { __builtin_amdgcn_s_setprio(1); _Pragma("unroll") for (int m = 0; m < 4; ++m) _Pragma("unroll") for (int n = 0; n < 2; ++n) _Pragma("unroll") for (int k = 0; k < 2; ++k) \
        acc[ai][bj][m][n] = __builtin_amdgcn_mfma_f32_16x16x32_bf16(Bt[n][k], At[m][k], acc[ai][bj][m][n], 0, 0, 0); __builtin_amdgcn_s_setprio(0); } while (0)
#define PG_WAIT_V(n) asm volatile("s_waitcnt vmcnt(" #n ")" ::: "memory")
#define PG_WAIT_L(n) asm volatile("s_waitcnt lgkmcnt(" #n ")" ::: "memory")
#define PG_BAR __builtin_amdgcn_s_barrier()
#define PG_SCHED __builtin_amdgcn_sched_barrier(0)
    Unit cur, nxt; int ui = 0;
    if (!S.next(0, cur, R0, C0)) return;
    f32x4 acc[2][2][4][2];
#pragma unroll
    for (int a = 0; a < 2; ++a)
#pragma unroll
        for (int b = 0; b < 2; ++b)
#pragma unroll
            for (int m = 0; m < 4; ++m)
#pragma unroll
                for (int n = 0; n < 2; ++n) acc[a][b][m][n] = (f32x4){0.f, 0.f, 0.f, 0.f};
    bf16x8 At[4][2], B0[2][2], B1[2][2];
    const char* cA = cur.A; const char* cB = cur.B;
    PG_STAGEB(PG_SB(0, 0), cB); PG_STAGEB(PG_SB(0, 1), cB + hstep); PG_STAGE2(PG_SA(0, 0), cA, cur.ra[0], cur.ra[1]); PG_STAGE2(PG_SA(0, 1), cA, cur.ra[2], cur.ra[3]);
    if (wr == 1) PG_BAR;
    PG_WAIT_V(2); PG_BAR;
    PG_STAGEB(PG_SB(1, 0), cB + kstep); PG_STAGE2(PG_SA(1, 0), cA + kstep, cur.ra[0], cur.ra[1]); PG_STAGEB(PG_SB(1, 1), cB + hstep + kstep);
    PG_WAIT_V(6); PG_BAR;
    for (;;) {
        const bool has_next = S.next(ui + 1, nxt, R0, C0);
        if (!has_next) nxt = cur;
        const char* nA = nxt.A; const char* nB = nxt.B;
#pragma unroll 1
        for (int t = 0; t < nt; t += 2) {
            const bool last = (t == nt - 2);
            const char* a1 = cA + (size_t)(t + 1) * kstep;
            const char* a2 = last ? nA : cA + (size_t)(t + 2) * kstep; const char* b2 = last ? nB : cB + (size_t)(t + 2) * kstep;
            const char* a3 = a2 + kstep; const char* b3 = b2 + kstep;
            const unsigned r0 = last ? nxt.ra[0] : cur.ra[0], r1 = last ? nxt.ra[1] : cur.ra[1], r2 = last ? nxt.ra[2] : cur.ra[2], r3 = last ? nxt.ra[3] : cur.ra[3];
            PG_LDB(B0, 0, 0); PG_LDB(B1, 0, 1); PG_SCHED; PG_LDA(At, 0, 0); PG_STAGE2(PG_SA(1, 1), a1, cur.ra[2], cur.ra[3]);
            PG_WAIT_V(8); PG_WAIT_L(0); PG_BAR; PG_MMA(0, 0, At, B0); PG_MMA(0, 1, At, B1); PG_BAR; PG_SCHED;
            PG_LDA(At, 0, 1); PG_STAGEB(PG_SB(0, 0), b2); PG_STAGEB(PG_SB(0, 1), b2 + hstep); PG_STAGE2(PG_SA(0, 0), a2, r0, r1);
            PG_WAIT_V(8); PG_WAIT_L(0); PG_BAR; PG_MMA(1, 0, At, B0); PG_MMA(1, 1, At, B1); PG_BAR; PG_SCHED;
            PG_LDB(B0, 1, 0); PG_LDB(B1, 1, 1); PG_SCHED; PG_LDA(At, 1, 0); PG_STAGE2(PG_SA(0, 1), a2, r2, r3);
            PG_WAIT_V(8); PG_WAIT_L(0); PG_BAR; PG_MMA(0, 0, At, B0); PG_MMA(0, 1, At, B1); PG_BAR; PG_SCHED;
            PG_LDA(At, 1, 1); PG_STAGEB(PG_SB(1, 0), b3); PG_STAGEB(PG_SB(1, 1), b3 + hstep); PG_STAGE2(PG_SA(1, 0), a3, r0, r1);
            PG_WAIT_V(8); PG_WAIT_L(0); PG_BAR; PG_MMA(1, 0, At, B0); PG_MMA(1, 1, At, B1); PG_BAR; PG_SCHED;
        }
        if (wr == 0) PG_BAR;
        E(acc, cur, wid, wr, wc, fr, fq);
        if (!has_next) break;
#pragma unroll
        for (int a = 0; a < 2; ++a)
#pragma unroll
            for (int b = 0; b < 2; ++b)
#pragma unroll
                for (int m = 0; m < 4; ++m)
#pragma unroll
                    for (int n = 0; n < 2; ++n) acc[a][b][m][n] = (f32x4){0.f, 0.f, 0.f, 0.f};
        cur = nxt; cA = nA; cB = nB; ++ui;
        if (wr == 1) PG_BAR;
    }
    PG_WAIT_V(0);
    PG_BAR;
#undef PG_SA
#undef PG_SB
#undef PG_STAGE2
#undef PG_STAGEB
#undef PG_LDA
#undef PG_LDB
#undef PG_MMA
}

struct DenseSched {
    const char* A; const char* Bt; int K, nM, nN, nwg, G, c;
    __device__ __forceinline__ void init(const void* A_, const void* Bt_, int M, int N, int K_, int G_, int c_) { A = (const char*)A_; Bt = (const char*)Bt_; K = K_; nM = M / BM; nN = N / BM; nwg = nM * nN; G = G_; c = c_; }
    __device__ __forceinline__ bool next(int i, Unit& u, int R0, int C0) const {
        const long L = (long)i * G + c; if (L >= nwg) return false;
        int wgid = (int)L; { const int q = nwg / 8, r = nwg % 8, xcd = wgid % 8, off = wgid / 8; wgid = (xcd < r ? xcd * (q + 1) : r * (q + 1) + (xcd - r) * q) + off; }
        const int nig = 8 * nN, gid = wgid / nig, fm = gid * 8, gsz = (nM - fm) < 8 ? (nM - fm) : 8;
        u.pm = fm + ((wgid % nig) % gsz); u.pn = (wgid % nig) / gsz; u.aux = 0;
        u.A = A + (size_t)u.pm * BM * K * 2; u.B = Bt + (size_t)u.pn * BM * K * 2;
#pragma unroll
        for (int q = 0; q < 4; ++q) u.ra[q] = (unsigned)((R0 + 64 * q) * K + C0) * 2u;
        return true;
    }
};
}
namespace att {
using s16x4 = __attribute__((ext_vector_type(4))) short;
using f32x16 = __attribute__((ext_vector_type(16))) float;
typedef __attribute__((address_space(3))) const char* lds_cptr;
typedef short v4i16_t __attribute__((ext_vector_type(4)));
constexpr int NSLOT = 3, VSLOT = 8192;
template <int DQ> struct Geo {
    static constexpr int NK = DQ / 16;
    static constexpr int KSLOT = (DQ == 64) ? 8192 : 16384;
    static constexpr int QWAVE = (DQ == 64) ? 4096 : 6144;
    static constexpr int LDS_K = 0, LDS_V = NSLOT * KSLOT, LDS_WS = LDS_V + NSLOT * VSLOT, LDS_OST = LDS_WS + 8 * 64 * 4, LDS_BYTES = LDS_OST + 8 * QWAVE;
};
constexpr int LDS_BIAS = Geo<64>::LDS_BYTES;
#define ASBAR() __builtin_amdgcn_sched_barrier(0)
#define AWAIT_BAR(N) asm volatile("s_waitcnt vmcnt(" #N ") lgkmcnt(0)\n\ts_barrier" ::: "memory")
__device__ __forceinline__ int crow(int r, int hi) { return (r & 3) + 8 * (r >> 2) + 4 * hi; }
__device__ __forceinline__ void glds16(const void* gsrc, unsigned lds_dst) { unsigned keep;
    asm volatile("s_mov_b32 %0, m0\n\ts_mov_b32 m0, %2\n\ts_nop 0\n\tglobal_load_lds_dwordx4 %1, off\n\ts_mov_b32 m0, %0" : "=&s"(keep) : "v"(gsrc), "s"(lds_dst) : "memory"); }
__device__ __forceinline__ float fadd_s(float a, float b) { float r; asm("v_add_f32_e32 %0, %1, %2" : "=v"(r) : "v"(a), "v"(b)); return r; }
__device__ __forceinline__ float fsub_s(float a, float b) { float r; asm("v_sub_f32_e32 %0, %1, %2" : "=v"(r) : "v"(a), "v"(b)); return r; }
__device__ __forceinline__ float max3f(float a, float b, float c) { float r; asm("v_max3_f32 %0, %1, %2, %3" : "=v"(r) : "v"(a), "v"(b), "v"(c)); return r; }
__device__ __forceinline__ float max2f(float a, float b) { float r; asm("v_max_f32_e32 %0, %1, %2" : "=v"(r) : "v"(a), "v"(b)); return r; }
__device__ __forceinline__ s16x4 vtr(lds_cptr p) { return __builtin_bit_cast(s16x4, __builtin_amdgcn_ds_read_tr16_b64_v4i16((__attribute__((address_space(3))) v4i16_t*)p)); }
template <int NK> __device__ __forceinline__ void kloadall(bf16x8* kf, lds_cptr kp) {
#pragma unroll
    for (int j = 0; j < NK; ++j) { kf[2 * j] = *(const LAS bf16x8*)(kp + j * 2048); kf[2 * j + 1] = *(const LAS bf16x8*)(kp + j * 2048 + 512); } }
__device__ __forceinline__ void kload2(bf16x8* kf, lds_cptr kp, int j) { kf[2 * j] = *(const LAS bf16x8*)(kp + j * 2048); kf[2 * j + 1] = *(const LAS bf16x8*)(kp + j * 2048 + 512); }
__device__ __forceinline__ void cmask(f32x16& p0, f32x16& p1, int koff, int qtok, int hi) {
    const int x = qtok - koff - 4 * hi;
#pragma unroll
    for (int r = 0; r < 16; ++r) { const int c = (r & 3) + 8 * (r >> 2); if (c > x) p0[r] = -INFINITY; if (c + 32 > x) p1[r] = -INFINITY; }
}
__device__ __forceinline__ void wmask(f32x16& p0, f32x16& p1, int thr, int hi) {
    const int y = thr - 4 * hi;
#pragma unroll
    for (int r = 0; r < 16; ++r) { const int c = (r & 3) + 8 * (r >> 2); if (c < y) p0[r] = -INFINITY; if (c + 32 < y) p1[r] = -INFINITY; }
}
__device__ __forceinline__ float rowmax(const f32x16& p0, const f32x16& p1) {
    float a = max3f(p0[0], p0[1], p1[0]), b = max3f(p0[2], p0[3], p1[1]); a = max3f(a, p1[2], p1[3]);
#pragma unroll
    for (int r = 4; r < 16; r += 4) { a = max3f(a, p0[r], p0[r + 1]); b = max3f(b, p0[r + 2], p0[r + 3]); a = max3f(a, p1[r], p1[r + 1]); b = max3f(b, p1[r + 2], p1[r + 3]); }
    const float m = max2f(a, b);
    auto rr = __builtin_amdgcn_permlane32_swap(__float_as_uint(m), __float_as_uint(m), false, false);
    return max2f(__uint_as_float(rr[0]), __uint_as_float(rr[1]));
}

enum { MODE_CAUSAL = 0, MODE_FOX = 1, MODE_WIN = 2 };
struct UnitArgs {
    const bf16_t* qrow;
    const bf16_t* K; const bf16_t* V; int kvpitch, vpitch;
    bf16_t* obase; int opitch;
    int qtok;
    int abase;
    int nsteps;
    const LAS float* bias;
};

template <int NB> __device__ __forceinline__ int seq(int i, int abase) { return (i < NB) ? abase + i : abase + NB - 1 - i; }

template <int MODE, bool GQA4, int THRL, int DQ>
__device__ __forceinline__ void attn_unit(const UnitArgs& A, char* shm) {
    constexpr int NB = GQA4 ? 1 : 4;
    typedef Geo<DQ> G; constexpr int NK = G::NK, KSLOT = G::KSLOT, LDS_K = G::LDS_K, LDS_V = G::LDS_V, LDS_WS = G::LDS_WS, LDS_OST = G::LDS_OST, QWAVE = G::QWAVE;
    constexpr bool USE_NEGM = (MODE != MODE_FOX) && (DQ == 64);
    int tid_ = threadIdx.x; asm volatile("" : "+v"(tid_));
    const int tid = tid_, lane = tid & 63, r32 = lane & 31, hi = lane >> 5; const int wid = __builtin_amdgcn_readfirstlane(tid >> 6);
    const unsigned lds0 = (unsigned)(uintptr_t)shm;
    float* wsf = (float*)(shm + LDS_WS) + wid * 64;
    const int NT = A.nsteps, abase = A.abase; const long kvp = A.kvpitch, vvp = A.vpitch;
    const bf16_t* ksrc = A.K + (long)lane * kvp + wid * 8;
    const bf16_t* ksrc2 = A.K + (long)lane * kvp + (8 + (wid & 3)) * 8;
    const bf16_t* vsrc = A.V + (long)(16 * (wid & 3) + (lane >> 2)) * vvp + (wid >> 2) * 32 + (lane & 3) * 8;
    const unsigned kdst = lds0 + LDS_K + wid * 1024, vdst = lds0 + LDS_V + wid * 1024, kdst2 = lds0 + LDS_K + (8 + wid) * 1024;
#define TILE_OF(t) ({ int a_ = seq<NB>((t), abase); a_ < 0 ? 0 : a_; })
#define DMA_K(t, slot) do { const long to_ = (long)TILE_OF(t) * 64 * kvp; glds16(ksrc + to_, (unsigned)__builtin_amdgcn_readfirstlane(kdst + (slot) * KSLOT)); \
        if (DQ == 96) glds16(ksrc2 + to_, (unsigned)__builtin_amdgcn_readfirstlane(kdst2 + (slot) * KSLOT)); } while (0)
#define DMA_V(t, slot) glds16(vsrc + (long)TILE_OF(t) * 64 * vvp, (unsigned)__builtin_amdgcn_readfirstlane(vdst + (slot) * VSLOT))
    const lds_cptr shm3 = (lds_cptr)shm; const lds_cptr kp0 = shm3 + LDS_K + hi * 1024 + r32 * 16;
    const lds_cptr vp0 = shm3 + LDS_V + ((lane >> 4) & 1) * 32 + (lane & 3) * 8 + (4 * hi + ((lane & 15) >> 2)) * 64;
    const int vb0 = (int)(lds0 + LDS_V) + ((lane >> 4) & 1) * 32 + (lane & 3) * 8 + (4 * hi + ((lane & 15) >> 2)) * 64;
    DMA_K(0, 0); DMA_V(0, 0); DMA_K(1, 1);
    bf16x8 qr[NK];
#pragma unroll
    for (int d0 = 0; d0 < NK; ++d0) qr[d0] = *reinterpret_cast<const bf16x8*>(A.qrow + d0 * 16 + hi * 8);
    const lds_cptr qlp = shm3 + LDS_OST + wid * QWAVE + hi * 512 + r32 * 16;
    if (DQ == 96) {
#pragma unroll
        for (int d0 = 0; d0 < NK; ++d0) *(LAS bf16x8*)(const_cast<__attribute__((address_space(3))) char*>(qlp) + d0 * 1024) = qr[d0];
    }
#define QL(d0) (*(const LAS bf16x8*)(qlp + (d0) * 1024))
    float mhat = 0.f, l_reg = 0.f; f32x16 o[2]; o[0] = f32x16{}; o[1] = f32x16{};
    f32x16 negm = f32x16{}; if (USE_NEGM) asm volatile("" : "+v"(negm));
    const int qtok = A.qtok;
#define CMASK(P0, P1, t) do { const int t_ = (t); if (t_ < NB) cmask(P0, P1, 64 * t_, qtok, hi); \
        else { const int a_ = abase + NB - 1 - t_; if (a_ < 0) wmask(P0, P1, 64, hi); \
               else if (MODE == MODE_WIN) { const int thr_ = qtok - 511 + 64 * (abase - a_); if (thr_ > 0) wmask(P0, P1, thr_, hi); } } } while (0)
#define CINIT1(C, t, OFF) do { if (MODE == MODE_FOX) { const LAS float* bt_ = A.bias + 64 * (seq<NB>((t), abase) - (abase + NB - NT)) + 4 * hi + (OFF); const float nm_ = -mhat; \
        _Pragma("unroll") for (int g_ = 0; g_ < 4; ++g_) { const f32x4 b_ = *(const LAS f32x4*)(bt_ + 8 * g_); C[4 * g_] = b_.x; C[4 * g_ + 1] = b_.y; C[4 * g_ + 2] = b_.z; C[4 * g_ + 3] = b_.w; } \
        _Pragma("unroll") for (int r_ = 0; r_ < 16; ++r_) C[r_] += nm_; asm volatile("" : "+v"(C)); } \
      else if (USE_NEGM) { C = negm; } \
      else { const float nm_ = -mhat; _Pragma("unroll") for (int r_ = 0; r_ < 16; ++r_) C[r_] = nm_; asm volatile("" : "+v"(C)); } } while (0)
#define CINIT(C0, C1, t) do { CINIT1(C0, t, 0); CINIT1(C1, t, 32); } while (0)
    bool resc = false;
#define START(P0, P1) do { const float rm = rowmax(P0, P1); resc = false; \
    { const float dl = rm; mhat = fadd_s(mhat, dl); \
      _Pragma("unroll") for (int r = 0; r < 16; ++r) { P0[r] = fsub_s(P0[r], dl); P1[r] = fsub_s(P1[r], dl); } \
      if (USE_NEGM) { _Pragma("unroll") for (int r = 0; r < 16; ++r) negm[r] = -mhat; asm volatile("" : "+v"(negm)); } } \
    _Pragma("unroll") for (int r = 0; r < 16; ++r) P0[r] = __builtin_amdgcn_exp2f(P0[r]); } while (0)
#define RESC() do { if (resc) { asm volatile("s_waitcnt lgkmcnt(0)" ::: "memory"); \
      const float* wsh_ = wsf + 4 * hi; \
      _Pragma("unroll") for (int d_ = 0; d_ < 2; ++d_) _Pragma("unroll") for (int r = 0; r < 16; ++r) o[d_][r] *= wsh_[(r & 3) + 8 * (r >> 2)]; } } while (0)
    f32x16 pA0, pA1, pB0, pB1; bf16x8 kf[2 * NK];
    int sl_prev = 0, sl_cur = 0, sl_next = 1;
#define ROT() do { sl_prev = sl_cur; sl_cur = sl_next; sl_next = (sl_next == NSLOT - 1) ? 0 : sl_next + 1; } while (0)
    DMA_K(2, 2);
    if (DQ == 96) { AWAIT_BAR(5); } else { AWAIT_BAR(3); }
    { const char* kb = shm + LDS_K + hi * 1024 + r32 * 16;
      CINIT(pA0, pA1, 0);
#pragma unroll
      for (int d0 = 0; d0 < NK; ++d0) {
          const bf16x8 b0 = *reinterpret_cast<const bf16x8*>(kb + d0 * 2048);
          const bf16x8 b1 = *reinterpret_cast<const bf16x8*>(kb + d0 * 2048 + 512);
          pA0 = __builtin_amdgcn_mfma_f32_32x32x16_bf16(b0, qr[d0], pA0, 0, 0, 0); pA1 = __builtin_amdgcn_mfma_f32_32x32x16_bf16(b1, qr[d0], pA1, 0, 0, 0); } }
    asm volatile("s_nop 15\n\ts_nop 7" : "+v"(pA0), "+v"(pA1)); CMASK(pA0, pA1, 0);
    START(pA0, pA1);
    _Pragma("unroll") for (int r = 0; r < 16; ++r) pA1[r] = __builtin_amdgcn_exp2f(pA1[r]);
    AWAIT_BAR(0);
    DMA_K(3, 0); DMA_V(1, 1);
    ROT();
    kloadall<NK>(kf, kp0 + sl_cur * KSLOT);
    if (DQ == 96) { AWAIT_BAR(3); } else { AWAIT_BAR(2); }
    s16x4 vlo[(DQ == 96) ? 4 : 8], vhi[(DQ == 96) ? 4 : 8]; u32x4 pw0, pw1, pw2, pw3;
#define PKW(P, B) cvtpk(P[B], P[B + 1])
#define PAF(k) __builtin_bit_cast(bf16x8, pw##k)
#define VFR(i) (bf16x8){vlo[i][0], vlo[i][1], vlo[i][2], vlo[i][3], vhi[i][0], vhi[i][1], vhi[i][2], vhi[i][3]}
#define PIN(x) asm volatile("" : "+v"(x))
#define MX3(a, b, c) __builtin_fmaxf(__builtin_fmaxf((a), (b)), (c))
#define GAPA(MF, A0, A1, A2, A3, W0, W1, PW) do { MF; sacc += A0; sacc += A1; sacc += A2; sacc += A3; PIN(sacc); W0; W1; PIN(PW); ASBAR(); } while (0)
#define EX(v) __builtin_amdgcn_exp2f(v)
#define GAPB(MF, X, B) do { MF; X[B] = EX(X[B]); X[B + 1] = EX(X[B + 1]); X[B + 2] = EX(X[B + 2]); X[B + 3] = EX(X[B + 3]); PIN(X); ASBAR(); } while (0)
#define VRD(i) do { vlo[i] = vtr(vp_ + (((i) >> 2) * 4096 + ((i) & 3) * 1024)); vhi[i] = vtr(vp_ + (((i) >> 2) * 4096 + ((i) & 3) * 1024 + 512)); } while (0)
#define KRD(G_, j) do { if (G_) { kload2(kf, kp0 + sl_next * KSLOT, j); ASBAR(); } } while (0)
#define MFMA32(a, b, c) __builtin_amdgcn_mfma_f32_32x32x16_bf16(a, b, c, 0, 0, 0)
#define STEP64(C0, C1, P0, P1, t, GK, GV, GL, DOMASK) do { ASBAR(); \
    const lds_cptr vp_ = vp0 + sl_prev * VSLOT; \
    CINIT1(C0, t, 0); ASBAR(); \
    VRD(0); ASBAR(); float sacc = (P0[0] + P0[1]); \
    GAPA(C0 = MFMA32(kf[0], qr[0], C0), P0[2], P0[3], P0[4], P0[5],     pw0[0] = PKW(P0, 0), pw0[1] = PKW(P0, 2), pw0); \
    CINIT1(C1, t, 32); ASBAR(); \
    VRD(4); ASBAR(); GAPA(C1 = MFMA32(kf[1], qr[0], C1), P0[6], P0[7], P0[8], P0[9],     pw0[2] = PKW(P0, 4), pw0[3] = PKW(P0, 6), pw0); \
    VRD(1); ASBAR(); GAPA(C0 = MFMA32(kf[2], qr[1], C0),   P0[10], P0[11], P0[12], P0[13], pw1[0] = PKW(P0, 8), pw1[1] = PKW(P0, 10), pw1); \
    VRD(5); ASBAR(); GAPA(C1 = MFMA32(kf[3], qr[1], C1),   P0[14], P0[15], P1[0], P1[1],   pw1[2] = PKW(P0, 12), pw1[3] = PKW(P0, 14), pw1); \
    VRD(2); ASBAR(); GAPA(C0 = MFMA32(kf[4], qr[2], C0),   P1[2], P1[3], P1[4], P1[5],     pw2[0] = PKW(P1, 0), pw2[1] = PKW(P1, 2), pw2); \
    VRD(6); ASBAR(); GAPA(C1 = MFMA32(kf[5], qr[2], C1),   P1[6], P1[7], P1[8], P1[9],     pw2[2] = PKW(P1, 4), pw2[3] = PKW(P1, 6), pw2); \
    VRD(3); ASBAR(); GAPA(C0 = MFMA32(kf[6], qr[3], C0),   P1[10], P1[11], P1[12], P1[13], pw3[0] = PKW(P1, 8), pw3[1] = PKW(P1, 10), pw3); \
    VRD(7); ASBAR(); GAPA(C1 = MFMA32(kf[7], qr[3], C1),   P1[14], P1[15], 0.f, 0.f,       pw3[2] = PKW(P1, 12), pw3[3] = PKW(P1, 14), pw3); \
    l_reg += sacc; \
    if (GK) { DMA_K((t) + 3, sl_cur); } if (GV) { DMA_V((t) + 1, sl_next); } \
    if (DOMASK) CMASK(C0, C1, t); \
    { float a = MX3(C0[0], C0[1], C1[0]), b = MX3(C0[2], C0[3], C1[1]); a = MX3(a, C1[2], C1[3]); \
      _Pragma("unroll") for (int r = 4; r < 16; r += 4) { a = MX3(a, C0[r], C0[r + 1]); b = MX3(b, C0[r + 2], C0[r + 3]); a = MX3(a, C1[r], C1[r + 1]); b = MX3(b, C1[r + 2], C1[r + 3]); } \
      float rm = __builtin_fmaxf(a, b); { auto rr = __builtin_amdgcn_permlane32_swap(__float_as_uint(rm), __float_as_uint(rm), false, false); rm = __builtin_fmaxf(__uint_as_float(rr[0]), __uint_as_float(rr[1])); } \
      resc = false; \
      if (__builtin_expect(__any(rm > (float)THRL), 0)) { const float dl = __builtin_fmaxf(rm, 0.f); mhat += dl; \
        _Pragma("unroll") for (int r = 0; r < 16; ++r) { C0[r] -= dl; C1[r] -= dl; } \
        if (USE_NEGM) { _Pragma("unroll") for (int r = 0; r < 16; ++r) negm[r] = -mhat; asm volatile("" : "+v"(negm)); } \
        const float f = __builtin_amdgcn_exp2f(-dl); l_reg *= f; if (hi == 0) wsf[r32] = f; resc = true; } } \
    ASBAR(); \
    GAPB(o[0] = MFMA32(PAF(0), VFR(0), o[0]), C0, 0); \
    GAPB(o[1] = MFMA32(PAF(0), VFR(4), o[1]), C0, 4); \
    KRD(GL, 0); GAPB(o[0] = MFMA32(PAF(1), VFR(1), o[0]), C0, 8); \
    KRD(GL, 1); GAPB(o[1] = MFMA32(PAF(1), VFR(5), o[1]), C0, 12); \
    KRD(GL, 2); GAPB(o[0] = MFMA32(PAF(2), VFR(2), o[0]), C1, 0); \
    KRD(GL, 3); GAPB(o[1] = MFMA32(PAF(2), VFR(6), o[1]), C1, 4); \
    GAPB(o[0] = MFMA32(PAF(3), VFR(3), o[0]), C1, 8); \
    GAPB(o[1] = MFMA32(PAF(3), VFR(7), o[1]), C1, 12); \
    } while (0)
#define AWAIT_STEADY() do { if (DQ == 96) { AWAIT_BAR(3); } else { AWAIT_BAR(2); } } while (0)
#define VRD4(i, b) do { vlo[b] = vtr(vp_ + (((i) >> 2) * 4096 + ((i) & 3) * 1024)); vhi[b] = vtr(vp_ + (((i) >> 2) * 4096 + ((i) & 3) * 1024 + 512)); } while (0)
#define VFR4(b) (bf16x8){vlo[b][0], vlo[b][1], vlo[b][2], vlo[b][3], vhi[b][0], vhi[b][1], vhi[b][2], vhi[b][3]}
#define GAPQ(MF, QLD, A0, A1, A2, A3, W0, W1, PW) do { MF; QLD; sacc += A0; sacc += A1; sacc += A2; sacc += A3; PIN(sacc); W0; W1; PIN(PW); ASBAR(); } while (0)
#define STEP96(C0, C1, P0, P1, t, GK, GV, GL, DOMASK) do { ASBAR(); \
    const lds_cptr vp_ = vp0 + sl_prev * VSLOT; \
    CINIT1(C0, t, 0); CINIT1(C1, t, 32); bf16x8 qa = QL(0), qb; ASBAR(); \
    float sacc = (P0[0] + P0[1]); \
    GAPQ(C0 = MFMA32(kf[0], qa, C0), qb = QL(1), P0[2], P0[3], P0[4], P0[5],     pw0[0] = PKW(P0, 0), pw0[1] = PKW(P0, 2), pw0); \
    GAPQ(C1 = MFMA32(kf[1], qa, C1), (void)0,    P0[6], P0[7], P0[8], P0[9],     pw0[2] = PKW(P0, 4), pw0[3] = PKW(P0, 6), pw0); \
    GAPQ(C0 = MFMA32(kf[2], qb, C0), qa = QL(2), P0[10], P0[11], P0[12], P0[13], pw1[0] = PKW(P0, 8), pw1[1] = PKW(P0, 10), pw1); \
    GAPQ(C1 = MFMA32(kf[3], qb, C1), (void)0,    P0[14], P0[15], P1[0], P1[1],   pw1[2] = PKW(P0, 12), pw1[3] = PKW(P0, 14), pw1); \
    GAPQ(C0 = MFMA32(kf[4], qa, C0), qb = QL(3), P1[2], P1[3], P1[4], P1[5],     pw2[0] = PKW(P1, 0), pw2[1] = PKW(P1, 2), pw2); \
    GAPQ(C1 = MFMA32(kf[5], qa, C1), (void)0,    P1[6], P1[7], P1[8], P1[9],     pw2[2] = PKW(P1, 4), pw2[3] = PKW(P1, 6), pw2); \
    GAPQ(C0 = MFMA32(kf[6], qb, C0), qa = QL(4), P1[10], P1[11], P1[12], P1[13], pw3[0] = PKW(P1, 8), pw3[1] = PKW(P1, 10), pw3); \
    GAPQ(C1 = MFMA32(kf[7], qb, C1), (void)0,    P1[14], P1[15], 0.f, 0.f,       pw3[2] = PKW(P1, 12), pw3[3] = PKW(P1, 14), pw3); \
    C0 = MFMA32(kf[8], qa, C0); qb = QL(5); VRD4(0, 0); ASBAR(); \
    C1 = MFMA32(kf[9], qa, C1); VRD4(4, 1); ASBAR(); \
    C0 = MFMA32(kf[10], qb, C0); ASBAR(); \
    C1 = MFMA32(kf[11], qb, C1); ASBAR(); \
    l_reg += sacc; \
    if (GK) { DMA_K((t) + 3, sl_cur); } if (GV) { DMA_V((t) + 1, sl_next); } \
    if (DOMASK) CMASK(C0, C1, t); \
    { float a = MX3(C0[0], C0[1], C1[0]), b = MX3(C0[2], C0[3], C1[1]); a = MX3(a, C1[2], C1[3]); \
      _Pragma("unroll") for (int r = 4; r < 16; r += 4) { a = MX3(a, C0[r], C0[r + 1]); b = MX3(b, C0[r + 2], C0[r + 3]); a = MX3(a, C1[r], C1[r + 1]); b = MX3(b, C1[r + 2], C1[r + 3]); } \
      float rm = __builtin_fmaxf(a, b); { auto rr = __builtin_amdgcn_permlane32_swap(__float_as_uint(rm), __float_as_uint(rm), false, false); rm = __builtin_fmaxf(__uint_as_float(rr[0]), __uint_as_float(rr[1])); } \
      resc = false; \
      if (__builtin_expect(__any(rm > (float)THRL), 0)) { const float dl = __builtin_fmaxf(rm, 0.f); mhat += dl; \
        _Pragma("unroll") for (int r = 0; r < 16; ++r) { C0[r] -= dl; C1[r] -= dl; } \
        const float f = __builtin_amdgcn_exp2f(-dl); l_reg *= f; if (hi == 0) wsf[r32] = f; resc = true; } } \
    ASBAR(); \
    VRD4(1, 2); ASBAR(); GAPB(o[0] = MFMA32(PAF(0), VFR4(0), o[0]), C0, 0); \
    VRD4(5, 3); ASBAR(); GAPB(o[1] = MFMA32(PAF(0), VFR4(1), o[1]), C0, 4); \
    VRD4(2, 0); KRD(GL, 0); GAPB(o[0] = MFMA32(PAF(1), VFR4(2), o[0]), C0, 8); \
    VRD4(6, 1); KRD(GL, 1); GAPB(o[1] = MFMA32(PAF(1), VFR4(3), o[1]), C0, 12); \
    VRD4(3, 2); KRD(GL, 2); GAPB(o[0] = MFMA32(PAF(2), VFR4(0), o[0]), C1, 0); \
    VRD4(7, 3); KRD(GL, 3); GAPB(o[1] = MFMA32(PAF(2), VFR4(1), o[1]), C1, 4); \
    KRD(GL, 4); GAPB(o[0] = MFMA32(PAF(3), VFR4(2), o[0]), C1, 8); \
    KRD(GL, 5); GAPB(o[1] = MFMA32(PAF(3), VFR4(3), o[1]), C1, 12); \
    } while (0)
#define STEP(C0, C1, P0, P1, t, GK, GV, GL, DOMASK) do { if constexpr (DQ == 96) { STEP96(C0, C1, P0, P1, t, GK, GV, GL, DOMASK); } else { STEP64(C0, C1, P0, P1, t, GK, GV, GL, DOMASK); } } while (0)
#define ENDW(tt) do { if ((tt) + 3 < NT) { AWAIT_STEADY(); } else if ((tt) + 2 < NT) { AWAIT_BAR(1); } else { AWAIT_BAR(0); } } while (0)
    int t = 1;
    for (; t < 5 && t + 1 < NT; t += 2) {
        STEP(pB0, pB1, pA0, pA1, t, (t + 3 < NT), (t + 1 < NT), (t + 1 < NT), true);       ENDW(t);     RESC(); ROT();
        STEP(pA0, pA1, pB0, pB1, t + 1, (t + 4 < NT), (t + 2 < NT), (t + 2 < NT), true);   ENDW(t + 1); RESC(); ROT();
    }
    for (; t + 5 < NT; t += 2) {
        STEP(pB0, pB1, pA0, pA1, t, true, true, true, false);     AWAIT_STEADY(); RESC(); ROT();
        STEP(pA0, pA1, pB0, pB1, t + 1, true, true, true, false); AWAIT_STEADY(); RESC(); ROT();
    }
    for (; t + 1 < NT; t += 2) {
        STEP(pB0, pB1, pA0, pA1, t, (t + 3 < NT), (t + 1 < NT), (t + 1 < NT), true);       ENDW(t);     RESC(); ROT();
        STEP(pA0, pA1, pB0, pB1, t + 1, (t + 4 < NT), (t + 2 < NT), (t + 2 < NT), true);   ENDW(t + 1); RESC(); ROT();
    }
    STEP(pB0, pB1, pA0, pA1, NT - 1, false, false, false, true); RESC();
    { float sacc = pB0[0] + pB0[1];
      _Pragma("unroll") for (int r = 2; r < 16; ++r) sacc += pB0[r];
      _Pragma("unroll") for (int r = 0; r < 16; ++r) sacc += pB1[r];
      l_reg += sacc;
      pw0 = (u32x4){PKW(pB0, 0), PKW(pB0, 2), PKW(pB0, 4), PKW(pB0, 6)}; pw1 = (u32x4){PKW(pB0, 8), PKW(pB0, 10), PKW(pB0, 12), PKW(pB0, 14)};
      pw2 = (u32x4){PKW(pB1, 0), PKW(pB1, 2), PKW(pB1, 4), PKW(pB1, 6)}; pw3 = (u32x4){PKW(pB1, 8), PKW(pB1, 10), PKW(pB1, 12), PKW(pB1, 14)};
      ASBAR();
      const int vb = vb0 + sl_cur * VSLOT;
#pragma unroll
      for (int d0 = 0; d0 < 2; ++d0) { s16x4 lo[4], hh[4];
#pragma unroll
          for (int ks = 0; ks < 4; ++ks) {
              asm volatile("ds_read_b64_tr_b16 %0,%1 offset:%c2" : "=&v"(lo[ks]) : "v"(vb), "i"(d0 * 4096 + ks * 1024) : "memory");
              asm volatile("ds_read_b64_tr_b16 %0,%1 offset:%c2" : "=&v"(hh[ks]) : "v"(vb), "i"(d0 * 4096 + ks * 1024 + 512) : "memory"); }
          asm volatile("s_waitcnt lgkmcnt(0)" ::: "memory"); ASBAR();
#define PK(k) (bf16x8){lo[k][0], lo[k][1], lo[k][2], lo[k][3], hh[k][0], hh[k][1], hh[k][2], hh[k][3]}
          o[d0] = MFMA32(PAF(0), PK(0), o[d0]); o[d0] = MFMA32(PAF(1), PK(1), o[d0]); o[d0] = MFMA32(PAF(2), PK(2), o[d0]); o[d0] = MFMA32(PAF(3), PK(3), o[d0]);
#undef PK
      } }
    { auto rr = __builtin_amdgcn_permlane32_swap(__float_as_uint(l_reg), __float_as_uint(l_reg), false, false); l_reg = __uint_as_float(rr[0]) + __uint_as_float(rr[1]); }
    if (hi == 0) wsf[32 + r32] = l_reg; asm volatile("s_waitcnt lgkmcnt(0)" ::: "memory");
    int lane_e = lane; asm volatile("" : "+v"(lane_e)); const int hi_e = lane_e >> 5, r32_e = lane_e & 31;
    float rli[16];
    { const float* wl_ = wsf + 32 + 4 * hi_e;
#pragma unroll
      for (int r = 0; r < 16; ++r) rli[r] = __builtin_amdgcn_rcpf(wl_[(r & 3) + 8 * (r >> 2)]); }
    { bf16_t* stg = (bf16_t*)(shm + LDS_OST + wid * QWAVE);
      bf16_t* stl = stg + (4 * hi_e) * 64 + r32_e;
#pragma unroll
      for (int r = 0; r < 16; ++r) {
#pragma unroll
          for (int d0 = 0; d0 < 2; ++d0) stl[((r & 3) + 8 * (r >> 2)) * 64 + d0 * 32] = f2bf(o[d0][r] * rli[r]); }
      asm volatile("s_waitcnt lgkmcnt(0)" ::: "memory");
#pragma unroll
      for (int i = 0; i < 4; ++i) { const int row = i * 8 + (lane_e >> 3), ch = lane_e & 7; const u32x4 v = *(const u32x4*)(stg + row * 64 + ch * 8);
          bf16_t* dst = GQA4 ? (A.obase + (long)(8 * wid + (row >> 2)) * A.opitch + (row & 3) * 64) : (A.obase + (long)(32 * wid + row) * A.opitch);
          *(u32x4*)(dst + ch * 8) = v; } }
    asm volatile("s_waitcnt lgkmcnt(0)\n\ts_barrier" ::: "memory");
#undef TILE_OF
#undef DMA_K
#undef DMA_V
#undef CMASK
#undef CINIT
#undef START
#undef RESC
#undef ROT
#undef PKW
#undef PAF
#undef VFR
#undef PIN
#undef MX3
#undef GAPA
#undef GAPB
#undef EX
#undef VRD
#undef KRD
#undef MFMA32
#undef STEP
#undef STEP64
#undef STEP96
#undef VRD4
#undef VFR4
#undef GAPQ
#undef QL
#undef ENDW
#undef AWAIT_STEADY
}
}
constexpr int MK_THREADS = 512;
constexpr int LDS_RING = 131072;
constexpr int LDS_X = LDS_RING;
constexpr int LDS_MOD = LDS_RING + 8192;
constexpr int LDS_TOTAL = 155648;

#define C2Q 0.18033688011112042f
#define LOG2E 1.4426950408889634f

struct BlkDesc { bf16_t* dst; const float* gain; int pitch; int flags; float scale; int csoff; };
#define C2M 0.14724312203508865f
struct MKP {
    const float* in[34];
    float* out;
    float* modpart;
    float* mod;
    float* cosT; float* sinT;
    bf16_t* W_in0t;
    bf16_t* W_out0t;
    bf16_t* XN;
    bf16_t* OATT;
    bf16_t* QN;
    bf16_t* KV6;
    bf16_t* FQ; bf16_t* FK; bf16_t* FV;
    float* GATES;
    float* LOGF;
    BlkDesc* desc0;
    float* CUMB;
    BlkDesc* desc_uq;
    BlkDesc* desc_ukv;
    bf16_t* W_in1t;
    bf16_t* W_uqt;
    bf16_t* W_ukvt;
    bf16_t* W_out1t;
    bf16_t* P1;
    bf16_t* CQN;
    bf16_t* CKVN;
    bf16_t* Q96;
    bf16_t* K96;
    bf16_t* V1;
    bf16_t* Wgu;
    bf16_t* Wd;
    bf16_t* HID;
    bf16_t* YBUF;
    int* gcnt;
    int* list;
    float* ew;
    int ph_lo, ph_hi;
};

__device__ __forceinline__ int swap45(int p) { return (p & 15) | ((p & 16) << 1) | ((p & 32) >> 1); }

template <class Map>
__device__ __forceinline__ void tr_item(const float* __restrict__ W, int ldw, int K, bf16_t* WT, LAS float* scr, int kb, int nb, int lane, const Map& cmap, const float* kscale) {
    const int k0 = 64 * kb, n0 = 32 * nb;
    const int sc = cmap(n0 + (lane & 31));
#pragma unroll 8
    for (int i = 0; i < 32; ++i) {
        const int kk = 2 * i + (lane >> 5);
        float v = 0.f;
        if (sc >= 0) { v = W[(size_t)(k0 + kk) * ldw + sc]; if (kscale) v *= kscale[k0 + kk]; }
        scr[kk * 33 + (lane & 31)] = v;
    }
    asm volatile("s_waitcnt lgkmcnt(0)" ::: "memory");
    const int c = lane & 7;
#pragma unroll
    for (int j = 0; j < 4; ++j) {
        const int n = (lane >> 3) + 8 * j; const LAS float* s = scr + (8 * c) * 33 + n;
        u32x4 o; o.x = cvtpk(s[0 * 33], s[1 * 33]); o.y = cvtpk(s[2 * 33], s[3 * 33]); o.z = cvtpk(s[4 * 33], s[5 * 33]); o.w = cvtpk(s[6 * 33], s[7 * 33]);
        *(u32x4*)(WT + (size_t)(n0 + n) * K + k0 + 8 * c) = o;
    }
    asm volatile("s_waitcnt lgkmcnt(0)" ::: "memory");
}
struct MapIn0 {
    __device__ __forceinline__ int operator()(int nn) const {
        const int blk = nn >> 6, p = nn & 63;
        if (blk < 8) return blk * 64 + swap45(p);
        if (blk < 20) return 512 + (blk - 8) * 64 + swap45(p);
        if (blk < 44) return 1304 + (blk - 20) * 64 + swap45(p);
        if (blk == 44) { if (p < 24) return 1280 + p; if (p < 32) return 2840 + (p - 24); return -1; }
        return -1;
    }
};
struct MapId { __device__ __forceinline__ int operator()(int nn) const { return nn; } };
struct MapIn1 { __device__ __forceinline__ int operator()(int nn) const { return nn < 672 ? nn : -1; } };
struct MapUq { __device__ __forceinline__ int operator()(int nn) const { if (nn < 1024) return (nn >> 6) * 96 + swap45(nn & 63); const int r = nn - 1024; return (r >> 5) * 96 + 64 + (r & 31); } };
struct MapUkv { __device__ __forceinline__ int operator()(int nn) const { if (nn < 1024) return (nn >> 6) * 128 + swap45(nn & 63); const int r = nn - 1024; return (r >> 6) * 128 + 64 + swap45(r & 63); } };

__device__ __forceinline__ void phase_prologue(const MKP& p, LAS unsigned char* lds) {
    const int tid = threadIdx.x, lane = tid & 63, wave = tid >> 6;
    const int gw = blockIdx.x * 8 + wave, NGW = gridDim.x * 8;
    LAS float* scr = (LAS float*)(lds + wave * 16384);
    for (int it = gw; it < 8 * 192; it += NGW) {
        const int kc = it / 192, ch = it % 192, idx = ch * 64 + lane, l = idx / 6144, n = idx % 6144;
        const float* w = p.in[5] + (size_t)l * 1024 * 6144 + n;
        const float* c = p.in[1];
        float acc = 0.f;
#pragma unroll 8
        for (int k = kc * 128; k < kc * 128 + 128; ++k) { const float cv = c[k]; acc += (cv / (1.f + __expf(-cv))) * w[(size_t)k * 6144]; }
        p.modpart[kc * 12288 + idx] = acc;
    }
    if (blockIdx.x == 1 && tid < 128) p.gcnt[tid] = 0;
    if (blockIdx.x == 0 && tid < 96 + 48 + 64) {
        BlkDesc d; d.dst = nullptr; d.gain = nullptr; d.pitch = 0; d.flags = 4; d.scale = 1.f; d.csoff = 0;
        if (tid < 96) {
            const int blk = (tid >> 3) * 4 + ((tid >> 2) & 1) * 2 + ((tid >> 1) & 1);
            d.flags = 0;
            if (blk < 8) { d.dst = p.QN + blk * 64; d.pitch = 512; d.gain = p.in[9]; d.flags = 1; d.scale = C2Q; }
            else if (blk < 20) { const int j = (blk - 8) >> 1, g = (blk - 8) & 1; d.dst = p.KV6 + (size_t)(j * 2 + g) * S_ * 64; d.pitch = 64;
                d.gain = (j == 2 || j == 4) ? p.in[10] : nullptr; d.flags = (j == 0 || j == 2 || j == 4) ? 1 : 0; }
            else if (blk < 28) { d.dst = p.FQ + (blk - 20) * 64; d.pitch = 512; d.gain = p.in[13]; d.scale = C2Q; }
            else if (blk < 36) { d.dst = p.FK + (blk - 28) * 64; d.pitch = 512; d.gain = p.in[14]; }
            else if (blk < 44) { d.dst = p.FV + (blk - 36) * 64; d.pitch = 512; }
            else if (blk == 44) d.flags = 2;
            else d.flags = 4;
            p.desc0[tid] = d;
        } else if (tid < 96 + 48) {
            const int e = tid - 96, pn = e >> 3, bj = (e >> 2) & 1, wc = e & 3;
            if (pn < 4) { const int h = pn * 4 + bj * 2 + (wc >> 1); d.dst = p.Q96 + (size_t)h * S_ * 96; d.pitch = 96; d.gain = p.in[21]; d.flags = 0; d.scale = C2M; }
            else { const int h = (pn - 4) * 8 + bj * 4 + wc; d.dst = p.Q96 + (size_t)h * S_ * 96 + 64; d.pitch = 96; d.gain = p.in[23]; d.flags = 1 | 8; d.scale = C2M; d.csoff = 32; }
            p.desc_uq[e] = d;
        } else {
            const int e = tid - 144, pn = e >> 3, bj = (e >> 2) & 1, wc = e & 3;
            const int h = (pn & 3) * 4 + bj * 2 + (wc >> 1);
            if (pn < 4) { d.dst = p.K96 + (size_t)h * S_ * 96; d.pitch = 96; d.gain = p.in[22]; d.flags = 0; }
            else { d.dst = p.V1 + (size_t)h * S_ * 64; d.pitch = 64; d.gain = nullptr; d.flags = 0; }
            p.desc_ukv[e] = d;
        }
    }
    constexpr int I_IN0 = 16 * 96, I_OUT0 = 16 * 32, I_IN1 = 16 * 24, I_UQ = 6 * 48, I_UKV = 4 * 64, I_OUT1 = 16 * 32;
    for (int it = gw; it < I_IN0 + I_OUT0 + I_IN1 + I_UQ + I_UKV + I_OUT1; it += NGW) {
        int r = it;
        if (r < I_IN0) { tr_item(p.in[7], HYIN, 1024, p.W_in0t, scr, r / 96, r % 96, lane, MapIn0(), nullptr); continue; } r -= I_IN0;
        if (r < I_OUT0) { tr_item(p.in[15], 1024, 1024, p.W_out0t, scr, r / 32, r % 32, lane, MapId(), nullptr); continue; } r -= I_OUT0;
        if (r < I_IN1) { tr_item(p.in[16], 672, 1024, p.W_in1t, scr, r / 24, r % 24, lane, MapIn1(), nullptr); continue; } r -= I_IN1;
        if (r < I_UQ) { tr_item(p.in[19], 1536, 384, p.W_uqt, scr, r / 48, r % 48, lane, MapUq(), p.in[17]); continue; } r -= I_UQ;
        if (r < I_UKV) { tr_item(p.in[20], 2048, 256, p.W_ukvt, scr, r / 64, r % 64, lane, MapUkv(), p.in[18]); continue; } r -= I_UKV;
        tr_item(p.in[25], 1024, 1024, p.W_out1t, scr, r / 32, r % 32, lane, MapId(), nullptr);
    }
}

__device__ __forceinline__ void phase_norm(const MKP& p, LAS unsigned char* lds, const float* x, const float* gw_, int layer, int sc_idx, int sh_idx, bool finalize_mod) {
    const int tid = threadIdx.x, lane = tid & 63, wave = tid >> 6;
    LAS float* msc = (LAS float*)(lds + LDS_MOD);
    LAS float* msh = msc + 1024;
    const float* b_ada = p.in[6];
    if (finalize_mod) {
        for (int i = tid; i < 2048; i += MK_THREADS) {
            const int idx = layer * 6144 + ((i < 1024) ? sc_idx * 1024 + i : sh_idx * 1024 + (i - 1024));
            float a = b_ada[idx];
#pragma unroll
            for (int kc = 0; kc < 8; ++kc) a += p.modpart[kc * 12288 + idx];
            msc[i] = a;
        }
        for (int idx = blockIdx.x * MK_THREADS + tid; idx < 12288; idx += gridDim.x * MK_THREADS) {
            float a = b_ada[idx];
#pragma unroll
            for (int kc = 0; kc < 8; ++kc) a += p.modpart[kc * 12288 + idx];
            p.mod[idx] = a;
        }
    } else {
        for (int i = tid; i < 2048; i += MK_THREADS)
            msc[i] = p.mod[layer * 6144 + ((i < 1024) ? sc_idx * 1024 + i : sh_idx * 1024 + (i - 1024))];
    }
    __syncthreads();
    const int gwv = blockIdx.x * 8 + wave, NGW = gridDim.x * 8;
    for (int m = gwv; m < S_; m += NGW) {
        const f32x4* xr = (const f32x4*)(x + (size_t)m * D_) + lane;
        f32x4 v[4]; float s = 0.f;
#pragma unroll
        for (int j = 0; j < 4; ++j) { v[j] = xr[64 * j]; s += (v[j].x * v[j].x + v[j].y * v[j].y) + (v[j].z * v[j].z + v[j].w * v[j].w); }
        s = wsum(s);
        const float rstd = rsqrtf(s * (1.f / D_) + EPSF);
        u32x2* o8 = (u32x2*)(p.XN + (size_t)m * D_) + lane;
#pragma unroll
        for (int j = 0; j < 4; ++j) {
            const int c0 = 256 * j + 4 * lane;
            const f32x4 g = *(const f32x4*)(gw_ + c0);
            const f32x4 sc = *(const LAS f32x4*)(msc + c0), sh = *(const LAS f32x4*)(msh + c0);
            const f32x4 y = v[j] * rstd * g * (sc + 1.f) + sh;
            u32x2 w; w.x = cvtpk(y.x, y.y); w.y = cvtpk(y.z, y.w);
            o8[64 * j] = w;
        }
    }
}

struct EpiResid {
    const float* xin; float* out; const float* gate;
    __device__ __forceinline__ void operator()(const f32x4 (&acc)[2][2][4][2], const pg::Unit& u, int wid, int wr, int wc, int fr_, int fq_) const {
        int fr = fr_, fq = fq_; asm volatile("" : "+v"(fr), "+v"(fq));
        const int col0 = u.pn * 256 + wc * 32 + 4 * fq;
        f32x4 g[2][2];
#pragma unroll
        for (int bj = 0; bj < 2; ++bj)
#pragma unroll
            for (int n = 0; n < 2; ++n) g[bj][n] = *(const f32x4*)(gate + col0 + bj * 128 + n * 16);
#pragma unroll
        for (int ai = 0; ai < 2; ++ai)
#pragma unroll
            for (int m = 0; m < 4; ++m) {
                const size_t off = (size_t)(u.pm * 256 + ai * 128 + wr * 64 + m * 16 + fr) * 1024 + col0;
#pragma unroll
                for (int bj = 0; bj < 2; ++bj)
#pragma unroll
                    for (int n = 0; n < 2; ++n) {
                        const f32x4 xv = *(const f32x4*)(xin + off + bj * 128 + n * 16);
                        *(f32x4*)(out + off + bj * 128 + n * 16) = xv + g[bj][n] * acc[ai][bj][m][n];
                    }
                asm volatile("" ::: "memory");
            }
    }
};

struct EpiHeads {
    const BlkDesc* tab; const float* cosT; const float* sinT; float* GATES; float* LOGF; LAS float* X;
    __device__ __forceinline__ void operator()(const f32x4 (&acc)[2][2][4][2], const pg::Unit& u, int wid, int wr, int wc, int fr_, int fq_) const {
        int fr = fr_, fq = fq_; asm volatile("" : "+v"(fr), "+v"(fq));
        const int w1 = wc & 1;
#pragma unroll
        for (int ai = 0; ai < 2; ++ai)
#pragma unroll
            for (int bj = 0; bj < 2; ++bj)
#pragma unroll
                for (int m = 0; m < 4; ++m) {
                    const f32x4 a = acc[ai][bj][m][0], b = acc[ai][bj][m][1];
                    float s = (a.x * a.x + a.y * a.y) + (a.z * a.z + a.w * a.w) + (b.x * b.x + b.y * b.y) + (b.z * b.z + b.w * b.w);
                    s += __shfl_xor(s, 16); s += __shfl_xor(s, 32);
                    if (fq == 0) X[wid * 256 + ((ai * 2 + bj) * 4 + m) * 16 + fr] = s;
                }
        asm volatile("s_waitcnt lgkmcnt(0)" ::: "memory"); __builtin_amdgcn_s_barrier(); asm volatile("" ::: "memory");
#pragma unroll
        for (int bj = 0; bj < 2; ++bj) {
            const BlkDesc d = tab[8 * u.pn + 4 * bj + wc];
            const int row0 = u.pm * 256 + wr * 64 + fr;
            if (d.flags & 4) continue;
            if (d.flags & 2) {
                if (w1 == 0) {
#pragma unroll
                    for (int ai = 0; ai < 2; ++ai)
#pragma unroll
                        for (int m = 0; m < 4; ++m) {
                            const int row = row0 + ai * 128 + m * 16;
#pragma unroll
                            for (int n = 0; n < 2; ++n) {
                                const f32x4 v = acc[ai][bj][m][n];
                                const int pc = 16 * n + 4 * fq;
                                if (pc < 24) *(f32x4*)(GATES + (size_t)row * 24 + pc) = v;
                                else *(f32x4*)(LOGF + (size_t)row * 8 + (pc - 24)) = v;
                            }
                            asm volatile("" ::: "memory");
                        }
                }
                continue;
            }
            const bool half = (d.flags & 8) != 0, has_gain = d.gain != nullptr, rope = (d.flags & 1) != 0;
            const int d0 = half ? 4 * fq : 16 * w1 + 4 * fq;
            const int dn1 = half ? 16 : 32;
            const float invn = half ? (1.f / 32.f) : (1.f / 64.f);
            const GAS float* gp = (const GAS float*)(has_gain ? d.gain : cosT);
            f32x4 g0 = *(const GAS f32x4*)(gp + d0), g1 = *(const GAS f32x4*)(gp + dn1 + d0);
            if (!has_gain) { g0 = (f32x4){1.f, 1.f, 1.f, 1.f}; g1 = g0; }
            g0 = g0 * d.scale; g1 = g1 * d.scale;
            const int cso = d.csoff + d0;
#pragma unroll
            for (int ai = 0; ai < 2; ++ai)
#pragma unroll
                for (int m = 0; m < 4; ++m) {
                    const int row = row0 + ai * 128 + m * 16;
                    const int xi = ((ai * 2 + bj) * 4 + m) * 16 + fr;
                    float ssq = X[wid * 256 + xi]; const float ssp = X[(wid ^ 1) * 256 + xi];
                    if (!half) ssq += ssp;
                    const float rs = has_gain ? rsqrtf(ssq * invn + EPSF) : 1.f;
                    f32x4 x1 = acc[ai][bj][m][0] * rs * g0, x2 = acc[ai][bj][m][1] * rs * g1;
                    f32x4 c = *(const f32x4*)(cosT + (size_t)row * 48 + cso), sn = *(const f32x4*)(sinT + (size_t)row * 48 + cso);
                    if (!rope) { c = (f32x4){1.f, 1.f, 1.f, 1.f}; sn = (f32x4){0.f, 0.f, 0.f, 0.f}; }
                    const f32x4 o1 = x1 * c - x2 * sn, o2 = x2 * c + x1 * sn;
                    u32x2 wa, wb; wa.x = cvtpk(o1.x, o1.y); wa.y = cvtpk(o1.z, o1.w); wb.x = cvtpk(o2.x, o2.y); wb.y = cvtpk(o2.z, o2.w);
                    GAS bf16_t* dr = (GAS bf16_t*)d.dst + (size_t)row * d.pitch + d0;
                    *(GAS u32x2*)dr = wa; *(GAS u32x2*)(dr + dn1) = wb;
                    asm volatile("" ::: "memory");
                }
        }
    }
};

struct EpiPlain {
    bf16_t* O; int ldc;
    __device__ __forceinline__ void operator()(const f32x4 (&acc)[2][2][4][2], const pg::Unit& u, int wid, int wr, int wc, int fr_, int fq_) const {
        int fr = fr_, fq = fq_; asm volatile("" : "+v"(fr), "+v"(fq));
        const int col0 = u.pn * 256 + wc * 32 + 4 * fq;
#pragma unroll
        for (int ai = 0; ai < 2; ++ai)
#pragma unroll
            for (int m = 0; m < 4; ++m) {
                bf16_t* rp = O + (size_t)(u.pm * 256 + ai * 128 + wr * 64 + m * 16 + fr) * ldc + col0;
#pragma unroll
                for (int bj = 0; bj < 2; ++bj)
#pragma unroll
                    for (int n = 0; n < 2; ++n) { const f32x4 v = acc[ai][bj][m][n]; u32x2 w; w.x = cvtpk(v.x, v.y); w.y = cvtpk(v.z, v.w); *(u32x2*)(rp + bj * 128 + n * 16) = w; }
            }
    }
};

__device__ __forceinline__ void phase_post1a(const MKP& p) {
    int tid_ = threadIdx.x; asm volatile("" : "+v"(tid_));
    const int tid = tid_, lane = tid & 63, wave = tid >> 6;
    const int gwv = blockIdx.x * 8 + wave, NGW = gridDim.x * 8;
    for (int t = gwv; t < S_; t += NGW) {
        const u32x2* row = (const u32x2*)(p.P1 + (size_t)t * 768);
        f32x4 v[3]; float sq = 0.f, skv = 0.f, skr = 0.f;
#pragma unroll
        for (int j = 0; j < 3; ++j) {
            const int g = lane + 64 * j;
            f32x4 x = (f32x4){0.f, 0.f, 0.f, 0.f};
            if (g < 168) { const u32x2 w = row[g]; x.x = __uint_as_float(w.x << 16); x.y = __uint_as_float(w.x & 0xffff0000u); x.z = __uint_as_float(w.y << 16); x.w = __uint_as_float(w.y & 0xffff0000u); }
            v[j] = x;
            const float s = (x.x * x.x + x.y * x.y) + (x.z * x.z + x.w * x.w);
            if (g < 96) sq += s; else if (g < 160) skv += s; else skr += s;
        }
        sq = wsum(sq); skv = wsum(skv); skr = wsum(skr);
        const float rq = rsqrtf(sq * (1.f / 384.f) + EPSF), rkv = rsqrtf(skv * (1.f / 256.f) + EPSF), rkr = rsqrtf(skr * (1.f / 32.f) + EPSF);
#pragma unroll
        for (int j = 0; j < 3; ++j) {
            const int g = lane + 64 * j;
            if (g < 96) { const f32x4 y = v[j] * rq; u32x2 w; w.x = cvtpk(y.x, y.y); w.y = cvtpk(y.z, y.w); *(u32x2*)(p.CQN + (size_t)t * 384 + 4 * g) = w; }
            else if (g < 160) { const f32x4 y = v[j] * rkv; u32x2 w; w.x = cvtpk(y.x, y.y); w.y = cvtpk(y.z, y.w); *(u32x2*)(p.CKVN + (size_t)t * 256 + 4 * (g - 96)) = w; }
        }
        {
            const int dl = (lane - 32) & 7;
            const int dd = 4 * dl;
            const int fi = 4 * (dl & 3);
            f32x4 x = v[2] * rkr;
            const f32x4 gn = *(const f32x4*)(p.in[24] + (dd & 31));
            x = x * gn;
            f32x4 o; o.x = __shfl_xor(x.x, 4); o.y = __shfl_xor(x.y, 4); o.z = __shfl_xor(x.z, 4); o.w = __shfl_xor(x.w, 4);
            const f32x4 c = *(const f32x4*)(p.cosT + (size_t)t * 48 + 32 + fi), sn = *(const f32x4*)(p.sinT + (size_t)t * 48 + 32 + fi);
            const f32x4 y = (dl < 4) ? (x * c - o * sn) : (x * c + o * sn);
            if (lane >= 32 && lane < 40) {
                u32x2 w; w.x = cvtpk(y.x, y.y); w.y = cvtpk(y.z, y.w);
#pragma unroll
                for (int h = 0; h < 16; ++h) *(u32x2*)(p.K96 + ((size_t)h * S_ + t) * 96 + 64 + dd) = w;
            }
        }
    }
}

__device__ __forceinline__ void mla_unit(const MKP& p, char* shm, int h, int qb) {
    int tid_ = threadIdx.x; asm volatile("" : "+v"(tid_));
    const int tid = tid_, lane = tid & 63, r32 = lane & 31; const int wid = __builtin_amdgcn_readfirstlane(tid >> 6);
    const int q0 = qb * 256;
    att::UnitArgs A;
    A.qrow = p.Q96 + ((size_t)h * S_ + q0 + 32 * wid + r32) * 96;
    A.K = p.K96 + (size_t)h * S_ * 96; A.kvpitch = 96; A.V = p.V1 + (size_t)h * S_ * 64; A.vpitch = 64;
    A.obase = p.OATT + (size_t)q0 * 1024 + h * 64; A.opitch = 1024;
    A.qtok = 32 * wid + r32; A.abase = 4 * qb; A.nsteps = 4 * qb + 4; A.bias = nullptr;
    att::attn_unit<att::MODE_CAUSAL, false, 8, 96>(A, shm);
}
__device__ __forceinline__ void phase_mla(const MKP& p, char* shm) {
    const int G = gridDim.x, bx = blockIdx.x;
    const int vcu = (G % 8 == 0) ? (bx % 8) * (G / 8) + bx / 8 : bx;
    for (int u = vcu; u < 256; u += G) {
        const int h = u >> 4, s = u & 15;
#pragma unroll 1
        for (int rep = 0; rep < 4; ++rep) mla_unit(p, shm, h, rep == 0 ? s : rep == 1 ? 31 - s : rep == 2 ? 32 + s : 63 - s);
    }
}

__device__ __forceinline__ void phase_scan(const MKP& p, LAS unsigned char* lds) {
    if (blockIdx.x >= 8) return;
    const int h = blockIdx.x, tid = threadIdx.x;
    LAS double* part = (LAS double*)lds;
    const float fb = p.in[8][h];
    double s = 0.0;
    for (int i = 0; i < 32; ++i) s += (double)logsigmf(p.LOGF[(size_t)(tid * 32 + i) * 8 + h] + fb);
    part[tid] = s;
    __syncthreads();
    for (int o = 1; o < MK_THREADS; o <<= 1) {
        const double v = (tid >= o) ? part[tid - o] : 0.0;
        __syncthreads();
        part[tid] += v;
        __syncthreads();
    }
    double a = (tid > 0) ? part[tid - 1] : 0.0;
    for (int i = 0; i < 32; ++i) { a += (double)logsigmf(p.LOGF[(size_t)(tid * 32 + i) * 8 + h] + fb); p.CUMB[(size_t)h * S_ + tid * 32 + i] = (float)(a * 1.4426950408889634); }
}

__device__ __forceinline__ void fox_unit(const MKP& p, char* shm, int h, int qb) {
    int tid_ = threadIdx.x; asm volatile("" : "+v"(tid_));
    const int tid = tid_, lane = tid & 63, r32 = lane & 31; const int wid = __builtin_amdgcn_readfirstlane(tid >> 6);
    const int q0 = qb * 256, abase = 4 * qb;
    const float* cb = p.CUMB + (size_t)h * S_;
    LAS float* bias = (LAS float*)(LAS unsigned char*)(shm + att::LDS_BIAS);
    LAS int* cnt = (LAS int*)(LAS unsigned char*)(shm + att::Geo<64>::LDS_WS);
    float gq = 0.f, gk = 0.f;
    for (int i = 0; i < 64; ++i) { gq = fmaxf(gq, fabsf(p.in[13][i])); gk = fmaxf(gk, fabsf(p.in[14][i])); }
    const float TH = 150.f + 2.f * (64.f * gq * gk * C2Q * 1.05f);
    const float c0 = cb[q0], cref = cb[q0 + 255];
    const bool skip = (tid < abase) && (cb[64 * tid + 63] - c0 > TH);
    const unsigned long long bal = __ballot(skip);
    if (lane == 0) cnt[wid] = __popcll(bal);
    __syncthreads();
    int alo = 0;
#pragma unroll
    for (int w = 0; w < 8; ++w) alo += cnt[w];
    int NT = abase + 4 - alo;
    if (NT & 1) { alo -= 1; NT += 1; }
    for (int i = tid; i < NT * 64; i += MK_THREADS) bias[i] = cref - cb[64 * alo + i];
    __syncthreads();
    att::UnitArgs A;
    A.qrow = p.FQ + (size_t)(q0 + 32 * wid + r32) * 512 + h * 64;
    A.K = p.FK + h * 64; A.V = p.FV + h * 64; A.kvpitch = 512; A.vpitch = 512;
    A.obase = p.OATT + (size_t)q0 * 1024 + 512 + h * 64; A.opitch = 1024;
    A.qtok = 32 * wid + r32; A.abase = abase; A.nsteps = NT; A.bias = bias;
    att::attn_unit<att::MODE_FOX, false, 8, 64>(A, shm);
}
__device__ __forceinline__ void phase_fox(const MKP& p, char* shm) {
    const int G = gridDim.x, bx = blockIdx.x;
    const int vcu = (G % 8 == 0) ? (bx % 8) * (G / 8) + bx / 8 : bx;
    for (int u = vcu; u < 256; u += G) {
        const int h = u >> 5, s = u & 31;
#pragma unroll 1
        for (int rep = 0; rep < 2; ++rep) fox_unit(p, shm, h, rep ? 63 - s : s);
    }
}


struct MapOff { int off; __device__ __forceinline__ int operator()(int nn) const { return off + (nn & 31); } };
__device__ __forceinline__ void phase_moe_weights(const MKP& p, LAS unsigned char* lds, int layer) {
    int tid_ = threadIdx.x; asm volatile("" : "+v"(tid_));
    const int tid = tid_, lane = tid & 63, wave = tid >> 6;
    const int gw = blockIdx.x * 8 + wave, NGW = gridDim.x * 8;
    LAS float* scr = (LAS float*)(lds + wave * 16384);
    constexpr int IG = 16 * 16, ID = 4 * 32, IE = IG + ID;
    for (int it = gw; it < 65 * IE; it += NGW) {
        const int e = it / IE; int r = it % IE;
        if (r < IG) {
            const int kb = r / 16, nb = r % 16;
            const int n0 = nb * 32, up = (n0 >> 7) & 1, f0 = (n0 >> 8) * 128 + (n0 & 127);
            const float* W = (e < 64) ? ((up ? p.in[29] : p.in[28]) + ((size_t)layer * 64 + e) * 1024 * 256) : ((up ? p.in[32] : p.in[31]) + (size_t)layer * 1024 * 256);
            MapOff mo{f0};
            tr_item(W, 256, 1024, p.Wgu + (size_t)e * 512 * 1024, scr, kb, nb, lane, mo, nullptr);
        } else {
            r -= IG; const int kb = r / 32, nb = r % 32;
            const float* W = (e < 64) ? (p.in[30] + ((size_t)layer * 64 + e) * 256 * 1024) : (p.in[33] + (size_t)layer * 256 * 1024);
            tr_item(W, 1024, 256, p.Wd + (size_t)e * 1024 * 256, scr, kb, nb, lane, MapId(), nullptr);
        }
    }
}

template <bool COMBINE>
__device__ __forceinline__ void phase_moe_route(const MKP& p, LAS unsigned char* lds, int layer) {
    int tid_ = threadIdx.x; asm volatile("" : "+v"(tid_));
    const int tid = tid_, lane = tid & 63, wave = tid >> 6;
    LAS float* msc = (LAS float*)(lds + LDS_MOD);
    LAS float* msh = msc + 1024;
    LAS float* hrow = (LAS float*)lds;
    LAS int* cntl = (LAS int*)(lds + LDS_X);
    LAS int* basel = cntl + 64;
    const float* gnorm = p.in[4] + layer * 1024;
    const float* wr = p.in[26] + (size_t)layer * 1024 * 64;
    const float rb = p.in[27][layer * 64 + lane];
    for (int i = tid; i < 2048; i += MK_THREADS) msc[i] = p.mod[layer * 6144 + ((i < 1024) ? 4 * 1024 + i : 3 * 1024 + (i - 1024))];
    __syncthreads();
    for (int batch = blockIdx.x; batch < S_ / 32; batch += gridDim.x) {
        if (tid < 64) cntl[tid] = 0;
#pragma unroll 1
        for (int i = 0; i < 4; ++i) {
            const int t = batch * 32 + wave * 4 + i;
            const f32x4* xr = (const f32x4*)(p.out + (size_t)t * D_) + lane;
            f32x4 v[4]; float s = 0.f;
#pragma unroll
            for (int j = 0; j < 4; ++j) { v[j] = xr[64 * j]; s += (v[j].x * v[j].x + v[j].y * v[j].y) + (v[j].z * v[j].z + v[j].w * v[j].w); }
            s = wsum(s);
            const float rstd = rsqrtf(s * (1.f / D_) + EPSF);
            u32x2* o8 = (u32x2*)(p.XN + (size_t)t * D_) + lane;
            LAS f32x4* hr = (LAS f32x4*)(hrow + (wave * 4 + i) * 1024) + lane;
#pragma unroll
            for (int j = 0; j < 4; ++j) {
                const int c0 = 256 * j + 4 * lane;
                const f32x4 g = *(const f32x4*)(gnorm + c0);
                const f32x4 sc = *(const LAS f32x4*)(msc + c0), sh = *(const LAS f32x4*)(msh + c0);
                const f32x4 y = v[j] * rstd * g * (sc + 1.f) + sh;
                u32x2 w; w.x = cvtpk(y.x, y.y); w.y = cvtpk(y.z, y.w);
                o8[64 * j] = w; hr[64 * j] = y;
            }
        }
        __syncthreads();
        float acc0 = 0.f, acc1 = 0.f, acc2 = 0.f, acc3 = 0.f;
        const LAS float* h0 = hrow + (wave * 4) * 1024;
#pragma unroll 4
        for (int k = 0; k < 1024; k += 4) {
            const float w0 = wr[(k + 0) * 64 + lane], w1 = wr[(k + 1) * 64 + lane], w2 = wr[(k + 2) * 64 + lane], w3 = wr[(k + 3) * 64 + lane];
            const f32x4 a = *(const LAS f32x4*)(h0 + k), b = *(const LAS f32x4*)(h0 + 1024 + k), c = *(const LAS f32x4*)(h0 + 2048 + k), d = *(const LAS f32x4*)(h0 + 3072 + k);
            acc0 += a.x * w0; acc0 += a.y * w1; acc0 += a.z * w2; acc0 += a.w * w3;
            acc1 += b.x * w0; acc1 += b.y * w1; acc1 += b.z * w2; acc1 += b.w * w3;
            acc2 += c.x * w0; acc2 += c.y * w1; acc2 += c.z * w2; acc2 += c.w * w3;
            acc3 += d.x * w0; acc3 += d.y * w1; acc3 += d.z * w2; acc3 += d.w * w3;
        }
        int myrank[4], mypos[4]; float myw[4];
#pragma unroll
        for (int i = 0; i < 4; ++i) {
            const float logit = (i == 0) ? acc0 : (i == 1) ? acc1 : (i == 2) ? acc2 : acc3;
            const float score = 1.f / (1.f + expf(-logit));
            const float sv = score + rb;
            float m1 = sv;
            m1 = fmaxf(m1, __shfl_xor(m1, 1)); m1 = fmaxf(m1, __shfl_xor(m1, 2)); m1 = fmaxf(m1, __shfl_xor(m1, 4));
            int am = (sv == m1) ? (lane & 7) : 8;
            am = min(am, __shfl_xor(am, 1)); am = min(am, __shfl_xor(am, 2)); am = min(am, __shfl_xor(am, 4));
            float m2 = ((lane & 7) == am) ? -INFINITY : sv;
            m2 = fmaxf(m2, __shfl_xor(m2, 1)); m2 = fmaxf(m2, __shfl_xor(m2, 2)); m2 = fmaxf(m2, __shfl_xor(m2, 4));
            const float gs = m1 + m2;
            const int gi = lane >> 3; int grank = 0;
#pragma unroll
            for (int gj = 0; gj < 8; ++gj) { const float o = __shfl(gs, gj * 8); grank += (o > gs || (o == gs && gj < gi)) ? 1 : 0; }
            const float msk = (grank < 4) ? sv : -1e30f;
            int rank = 0;
#pragma unroll 8
            for (int e = 0; e < 64; ++e) { const float o = __shfl(msk, e); rank += (o > msk || (o == msk && e < lane)) ? 1 : 0; }
            const bool selb = rank < 8;
            const float tot = wsum(selb ? score : 0.f);
            myrank[i] = selb ? rank : -1; myw[i] = score / tot * 2.5f;
            mypos[i] = selb ? atomicAdd((int*)(cntl + lane), 1) : 0;
        }
        __syncthreads();
        if (tid < 64) basel[tid] = (cntl[tid] > 0) ? atomicAdd(p.gcnt + layer * 64 + tid, cntl[tid]) : 0;
        __syncthreads();
#pragma unroll
        for (int i = 0; i < 4; ++i) if (myrank[i] >= 0) {
            const int t = batch * 32 + wave * 4 + i, slot = t * 8 + myrank[i];
            p.list[(size_t)lane * 16384 + basel[lane] + mypos[i]] = slot;
            p.ew[slot] = myw[i];
        }
        __syncthreads();
    }
}

struct MoeSched {
    const char* A; const char* Bt; const int* list; const LAS int* ustart; const LAS int* hbase; const LAS int* cnt;
    int K, NP, G, c; bool gather; int nexp;
    __device__ __forceinline__ static void tables(LAS int* ustart, LAS int* hbase, LAS int* cnt, const int* gcnt, int NP) {
        const int tid = threadIdx.x;
        if (tid == 0) {
            int us = 0, hb = 0;
            for (int e = 0; e < 65; ++e) { const int c = (e < 64) ? gcnt[e] : S_; const int nrb = (c + 255) >> 8; cnt[e] = c; ustart[e] = us; hbase[e] = hb; us += nrb * NP; hb += nrb * 256; }
            ustart[65] = us; hbase[65] = hb;
        }
        __syncthreads();
    }
    __device__ __forceinline__ bool next(int i, pg::Unit& u, int R0, int C0) const {
        const int L = i * G + c; if (L >= ustart[nexp]) return false;
        const int lane = threadIdx.x & 63;
        const unsigned long long bal = __ballot(lane < 65 && ustart[lane] <= L);
        int e = __popcll(bal) - 1; if (ustart[64] <= L) e = 64;
        const int r = L - ustart[e], rb = r / NP, pn = r % NP;
        u.pm = (hbase[e] >> 8) + rb; u.pn = pn; u.aux = e | (rb << 8);
        u.B = Bt + ((size_t)e * NP + pn) * 256 * K * 2;
        if (gather) {
            u.A = A; const int ce = cnt[e];
#pragma unroll
            for (int q = 0; q < 4; ++q) { const int pos = rb * 256 + R0 + 64 * q; int tok = 0; if (pos < ce) tok = (e < 64) ? (list[(size_t)e * 16384 + pos] >> 3) : pos; u.ra[q] = (unsigned)(tok * K + C0) * 2u; }
        } else {
            u.A = A + (size_t)u.pm * 256 * K * 2;
#pragma unroll
            for (int q = 0; q < 4; ++q) u.ra[q] = (unsigned)((R0 + 64 * q) * K + C0) * 2u;
        }
        return true;
    }
};
struct EpiGateUp {
    bf16_t* HID;
    __device__ __forceinline__ void operator()(const f32x4 (&acc)[2][2][4][2], const pg::Unit& u, int wid, int wr, int wc, int fr_, int fq_) const {
        int fr = fr_, fq = fq_; asm volatile("" : "+v"(fr), "+v"(fq));
        const int col0 = u.pn * 128 + wc * 32 + 4 * fq;
#pragma unroll
        for (int ai = 0; ai < 2; ++ai)
#pragma unroll
            for (int m = 0; m < 4; ++m) {
                bf16_t* rp = HID + (size_t)(u.pm * 256 + ai * 128 + wr * 64 + m * 16 + fr) * 256 + col0;
#pragma unroll
                for (int n = 0; n < 2; ++n) {
                    const f32x4 g = acc[ai][0][m][n], up = acc[ai][1][m][n];
                    f32x4 h; h.x = g.x / (1.f + __expf(-g.x)) * up.x; h.y = g.y / (1.f + __expf(-g.y)) * up.y; h.z = g.z / (1.f + __expf(-g.z)) * up.z; h.w = g.w / (1.f + __expf(-g.w)) * up.w;
                    u32x2 w; w.x = cvtpk(h.x, h.y); w.y = cvtpk(h.z, h.w); *(u32x2*)(rp + n * 16) = w;
                }
            }
    }
};
struct EpiDown {
    bf16_t* YBUF; const int* list; const float* ew; const LAS int* cnt;
    __device__ __forceinline__ void operator()(const f32x4 (&acc)[2][2][4][2], const pg::Unit& u, int wid, int wr, int wc, int fr_, int fq_) const {
        int fr = fr_, fq = fq_; asm volatile("" : "+v"(fr), "+v"(fq));
        const int e = u.aux & 0xff, rb = u.aux >> 8, ce = cnt[e];
        const unsigned colb = (unsigned)(u.pn * 256 + wc * 32 + 4 * fq) * 2u;
        const int* le = list + (size_t)e * 16384 + rb * 256 + wr * 64 + fr;
#pragma unroll
        for (int ai = 0; ai < 2; ++ai)
#pragma unroll
            for (int m = 0; m < 4; ++m) {
                const int pr = ai * 128 + m * 16;
                if (rb * 256 + wr * 64 + fr + pr < ce) {
                    const int slot = le[pr]; const float w = ew[slot];
                    char* rp = (char*)YBUF + ((unsigned)slot * 2048u + colb);
#pragma unroll
                    for (int bj = 0; bj < 2; ++bj)
#pragma unroll
                        for (int n = 0; n < 2; ++n) { const f32x4 v = acc[ai][bj][m][n] * w; u32x2 o; o.x = cvtpk(v.x, v.y); o.y = cvtpk(v.z, v.w); *(u32x2*)(rp + bj * 256 + n * 32) = o; }
                }
                asm volatile("" ::: "memory");
            }
    }
};
__device__ __forceinline__ void phase_moe_gemm1(const MKP& p, LAS unsigned char* lds, int layer) {
    LAS int* tb = (LAS int*)(lds + LDS_X);
    MoeSched::tables(tb, tb + 66, tb + 132, p.gcnt + layer * 64, 2);
    const int G = gridDim.x, bx = blockIdx.x, vcu = (G % 8 == 0) ? (bx % 8) * (G / 8) + bx / 8 : bx;
    MoeSched S{(const char*)p.XN, (const char*)p.Wgu, p.list, tb, tb + 66, tb + 132, 1024, 2, G, vcu, true, 65};
    EpiGateUp E{p.HID};
    pg::gemm_run(lds, 1024, S, E);
}
__device__ __forceinline__ void phase_moe_gemm2(const MKP& p, LAS unsigned char* lds, int layer) {
    LAS int* tb = (LAS int*)(lds + LDS_X);
    MoeSched::tables(tb, tb + 66, tb + 132, p.gcnt + layer * 64, 4);
    const int G = gridDim.x, bx = blockIdx.x, vcu = (G % 8 == 0) ? (bx % 8) * (G / 8) + bx / 8 : bx;
    { MoeSched S{(const char*)p.HID, (const char*)p.Wd, p.list, tb, tb + 66, tb + 132, 256, 4, G, vcu, false, 64};
      EpiDown E{p.YBUF, p.list, p.ew, tb + 132};
      pg::gemm_run(lds, 256, S, E); }
    {
      pg::DenseSched S; S.init(p.HID + (size_t)tb[66 + 64] * 256, p.Wd + (size_t)64 * 1024 * 256, S_, 1024, 256, G, bx);
      EpiResid E{p.out, p.out, p.mod + layer * 6144 + 5 * 1024};
      pg::gemm_run(lds, 256, S, E); }
}
__device__ __forceinline__ void phase_moe_combine(const MKP& p, int layer) {
    int tid_ = threadIdx.x; asm volatile("" : "+v"(tid_));
    const int tid = tid_, lane = tid & 63, wave = tid >> 6;
    const int gwv = blockIdx.x * 8 + wave, NGW = gridDim.x * 8;
    const float* g2 = p.mod + layer * 6144 + 5 * 1024;
    for (int t = gwv; t < S_; t += NGW) {
        f32x4* xr = (f32x4*)(p.out + (size_t)t * D_) + lane;
#pragma unroll
        for (int j = 0; j < 4; ++j) {
            f32x4 s = (f32x4){0.f, 0.f, 0.f, 0.f};
#pragma unroll
            for (int k = 0; k < 8; ++k) {
                const u32x2 w = *((const u32x2*)(p.YBUF + ((size_t)t * 8 + k) * 1024) + lane + 64 * j);
                s.x += __uint_as_float(w.x << 16); s.y += __uint_as_float(w.x & 0xffff0000u); s.z += __uint_as_float(w.y << 16); s.w += __uint_as_float(w.y & 0xffff0000u);
            }
            const f32x4 g = *(const f32x4*)(g2 + 256 * j + 4 * lane);
            xr[64 * j] = xr[64 * j] + g * s;
        }
    }
}

__global__ void __launch_bounds__(MK_THREADS, 2) mega(MKP p) {
    extern __shared__ __attribute__((aligned(16))) unsigned char lds_raw[];
    LAS unsigned char* lds = (LAS unsigned char*)lds_raw;
    const int lo = p.ph_lo, hi = p.ph_hi;
#define IN(k) (lo <= (k) && (k) < hi)
    if (IN(0)) phase_prologue(p, lds);
    if (IN(1)) phase_norm(p, lds, p.in[0], p.in[3], 0, 1, 0, true);
    if (IN(2)) {
        pg::DenseSched S; S.init(p.XN, p.W_in0t, S_, 3072, 1024, gridDim.x, blockIdx.x);
        EpiHeads E{p.desc0, p.cosT, p.sinT, p.GATES, p.LOGF, (LAS float*)(lds + LDS_X)};
        pg::gemm_run(lds, 1024, S, E);
    }
    if (IN(3)) phase_scan(p, lds);
    if (IN(4)) phase_fox(p, (char*)lds_raw);
    if (IN(5)) {
        pg::DenseSched S; S.init(p.OATT, p.W_out0t, S_, 1024, 1024, gridDim.x, blockIdx.x);
        EpiResid E{p.in[0], p.out, p.mod + 2 * 1024};
        pg::gemm_run(lds, 1024, S, E);
    }
    if (IN(20)) phase_moe_weights(p, lds, 0);
    if (IN(6)) phase_moe_route<false>(p, lds, 0);
    if (IN(7)) phase_moe_gemm1(p, lds, 0);
    if (IN(8)) phase_moe_gemm2(p, lds, 0);
    if (IN(9)) phase_moe_combine(p, 0);
    if (IN(21)) phase_moe_weights(p, lds, 1);
    if (IN(10)) phase_norm(p, lds, p.out, p.in[3] + 1024, 1, 1, 0, false);
    if (IN(11)) {
        pg::DenseSched S; S.init(p.XN, p.W_in1t, S_, 768, 1024, gridDim.x, blockIdx.x);
        EpiPlain E{p.P1, 768};
        pg::gemm_run(lds, 1024, S, E);
    }
    if (IN(12)) phase_post1a(p);
    if (IN(13)) {
        { pg::DenseSched S; S.init(p.CQN, p.W_uqt, S_, 1536, 384, gridDim.x, blockIdx.x);
          EpiHeads E{p.desc_uq, p.cosT, p.sinT, nullptr, nullptr, (LAS float*)(lds + LDS_X)};
          pg::gemm_run(lds, 384, S, E); }
        { pg::DenseSched S; S.init(p.CKVN, p.W_ukvt, S_, 2048, 256, gridDim.x, blockIdx.x);
          EpiHeads E{p.desc_ukv, p.cosT, p.sinT, nullptr, nullptr, (LAS float*)(lds + LDS_X)};
          pg::gemm_run(lds, 256, S, E); }
    }
    if (IN(14)) phase_mla(p, (char*)lds_raw);
    if (IN(15)) {
        pg::DenseSched S; S.init(p.OATT, p.W_out1t, S_, 1024, 1024, gridDim.x, blockIdx.x);
        EpiResid E{p.out, p.out, p.mod + 6144 + 2 * 1024};
        pg::gemm_run(lds, 1024, S, E);
    }
    if (IN(16)) phase_moe_route<false>(p, lds, 1);
    if (IN(17)) phase_moe_gemm1(p, lds, 1);
    if (IN(18)) phase_moe_gemm2(p, lds, 1);
    if (IN(19)) phase_moe_combine(p, 1);
#undef IN
}

__global__ void k_adapt_proj0(MKP p, float* proj0) {
    const int t = blockIdx.x;
    float* pr = proj0 + (size_t)t * HYIN;
    for (int c = threadIdx.x; c < HYIN; c += 256) {
        float v;
        if (c < 512) v = bf2f(p.QN[(size_t)t * 512 + c]) * (1.f / C2Q);
        else if (c < 1280) { const int r = c - 512, j = r >> 7, g = (r >> 6) & 1, d = r & 63; v = bf2f(p.KV6[((size_t)(j * 2 + g) * S_ + t) * 64 + d]); }
        else if (c < 1304) v = sigmf(p.GATES[(size_t)t * 24 + (c - 1280)]);
        else if (c < 1304 + 512) v = bf2f(p.FQ[(size_t)t * 512 + (c - 1304)]) * (1.f / C2Q);
        else if (c < 1304 + 1024) v = bf2f(p.FK[(size_t)t * 512 + (c - 1304 - 512)]);
        else if (c < 2840) v = bf2f(p.FV[(size_t)t * 512 + (c - 1304 - 1024)]);
        else v = logsigmf(p.LOGF[(size_t)t * 8 + (c - 2840)] + p.in[8][c - 2840]);
        pr[c] = v;
    }
}
__global__ void k_adapt_f2b(const float* src, bf16_t* dst, size_t n) {
    size_t i = (size_t)blockIdx.x * 256 + threadIdx.x;
    if (i < n) dst[i] = f2bf(src[i]);
}

__global__ void k_adapt_f2b_cols(const float* src, bf16_t* dst, int ncols) {
    size_t i = (size_t)blockIdx.x * 256 + threadIdx.x;
    size_t t = i / ncols; int c = (int)(i % ncols);
    if (t < S_) dst[t * 1024 + c] = f2bf(src[t * 1024 + c]);
}
static void launch_mega(MKP p, int lo, int hi, int grid, hipStream_t s) { p.ph_lo = lo; p.ph_hi = hi; hipLaunchKernelGGL(mega, dim3(grid), dim3(MK_THREADS), LDS_TOTAL, s, p); }

extern "C" void kernel_launch(void* const* d_in, const int* in_sizes, int n_in, void* d_out, int out_size, void* d_ws, size_t ws_size, hipStream_t stream) {
    static int grid = 0;
    if (!grid) {
        int dev = 0, cus = 0; (void)hipGetDevice(&dev); (void)hipDeviceGetAttribute(&cus, hipDeviceAttributeMultiprocessorCount, dev);
        (void)hipFuncSetAttribute((const void*)mega, hipFuncAttributeMaxDynamicSharedMemorySize, LDS_TOTAL);
        grid = cus > 0 ? cus : 256;
    }
    const int* pos = (const int*)d_in[2];
    const float* nsa_k_norm = (const float*)d_in[10];
    const float* nsa_cmp_pe = (const float*)d_in[11];
    const float* nsa_w_cmp = (const float*)d_in[12];
    float* out = (float*)d_out;
    constexpr size_t MiB = 1u << 20;
    char* wsb = (char*)d_ws;
    float* ws = (float*)d_ws;
    size_t o = 0;
    float* mod = ws + o; o += 2 * 6144;
    float* cosT = ws + o; o += (size_t)S_ * 48;
    float* sinT = ws + o; o += (size_t)S_ * 48;
    float* kcmp = ws + o; o += 2 * 1023 * 64 + 64;
    float* vcmp = ws + o; o += 2 * 1023 * 64 + 64;
    int* sel = (int*)(ws + o); o += (size_t)S_ * 2 * 16;
    MKP p{};
    for (int i = 0; i < 34; ++i) p.in[i] = (const float*)d_in[i];
    p.out = out; p.mod = mod; p.cosT = cosT; p.sinT = sinT;
    p.modpart = ws + o; o += 8 * 12288;
    p.desc0 = (BlkDesc*)(ws + o); o += 96 * 8;
    p.desc_uq = (BlkDesc*)(ws + o); o += 48 * 8;
    p.desc_ukv = (BlkDesc*)(ws + o); o += 64 * 8;
    p.CUMB = ws + o; o += (size_t)8 * S_;
    p.gcnt = (int*)(ws + o); o += 128;
    p.ew = ws + o; o += (size_t)S_ * 8;
    p.list = (int*)(ws + o); o += (size_t)64 * 16384;
    if (o * 4 > 15 * MiB) return;
    p.XN = (bf16_t*)(wsb + 15 * MiB); p.OATT = (bf16_t*)(wsb + 47 * MiB);
    char* big = wsb + 79 * MiB;
    float* oattn = (float*)big; float* imp = (float*)(big + 64 * MiB); float* proj0 = (float*)(big + 96 * MiB);
    {   bf16_t* b = (bf16_t*)big;
        p.QN = b; b += (size_t)S_ * 512; p.KV6 = b; b += (size_t)12 * S_ * 64; p.FQ = b; b += (size_t)S_ * 512; p.FK = b; b += (size_t)S_ * 512; p.FV = b; b += (size_t)S_ * 512;
        p.GATES = (float*)b; p.LOGF = p.GATES + (size_t)S_ * 24; }
    {   bf16_t* b = (bf16_t*)(big + 96 * MiB);
        p.P1 = b; b += (size_t)S_ * 768; p.CQN = b; b += (size_t)S_ * 384; p.CKVN = b; b += (size_t)S_ * 256;
        p.Q96 = b; b += (size_t)16 * S_ * 96; p.K96 = b; b += (size_t)16 * S_ * 96; p.V1 = b; b += (size_t)16 * S_ * 64; }
    p.YBUF = (bf16_t*)big; p.HID = (bf16_t*)(big + 256 * MiB);
    p.Wgu = (bf16_t*)(wsb + 415 * MiB); p.Wd = p.Wgu + (size_t)65 * 512 * 1024;
    {   bf16_t* b = (bf16_t*)(wsb + 513 * MiB);
        p.W_in0t = b; b += (size_t)3072 * 1024; p.W_out0t = b; b += (size_t)1024 * 1024; p.W_in1t = b; b += (size_t)768 * 1024;
        p.W_uqt = b; b += (size_t)1536 * 384; p.W_ukvt = b; b += (size_t)2048 * 256; p.W_out1t = b; b += (size_t)1024 * 1024;
        if ((size_t)((char*)b - wsb) > ws_size) return; }

    k_rope<<<(S_ * 48 + 255) / 256, 256, 0, stream>>>(pos, cosT, sinT);
    launch_mega(p, 0, 1, grid, stream);
    launch_mega(p, 20, 21, grid, stream);
    launch_mega(p, 1, 2, grid, stream);
    launch_mega(p, 2, 3, grid, stream);
    k_adapt_proj0<<<S_, 256, 0, stream>>>(p, proj0);
    launch_mega(p, 3, 4, grid, stream);
    launch_mega(p, 4, 5, grid, stream);
    k_compress<<<1023 * 4, 64, 0, stream>>>(proj0, nsa_cmp_pe, nsa_w_cmp, nsa_k_norm, kcmp, vcmp);
    k_nsa_cmp<<<dim3(S_ / 64, 2), 64, 0, stream>>>(proj0, kcmp, vcmp, imp, oattn);
    k_nsa_topk<<<S_ * 2 / 256, 256, 0, stream>>>(imp, sel);
    k_nsa_slc<<<dim3(S_ / 64, 8), 64, 0, stream>>>(proj0, sel, oattn);
    k_nsa_win<<<dim3(S_ / 64, 8), 64, 0, stream>>>(proj0, oattn);
    k_adapt_f2b_cols<<<(S_ * 512 + 255) / 256, 256, 0, stream>>>(oattn, p.OATT, 512);
    for (int ph = 5; ph <= 9; ++ph) launch_mega(p, ph, ph + 1, grid, stream);
    launch_mega(p, 21, 22, grid, stream);
    for (int ph = 10; ph <= 19; ++ph) launch_mega(p, ph, ph + 1, grid, stream);
}
```

```cpp
#include <hip/hip_runtime.h>
#include <hip/hip_cooperative_groups.h>
#include <stdint.h>

#define S_ 16384
#define D_ 1024
#define HYIN 2848
#define NEXP 64
#define EPSF 1e-6f

__device__ __forceinline__ float wsum(float v) {
#pragma unroll
    for (int o = 32; o > 0; o >>= 1) v += __shfl_xor(v, o);
    return v;
}
__device__ __forceinline__ float sigmf(float x) { return 1.f / (1.f + expf(-x)); }
__device__ __forceinline__ float logsigmf(float x) { return fminf(x, 0.f) - log1pf(expf(-fabsf(x))); }
#define LAS __attribute__((address_space(3)))
#define GAS __attribute__((address_space(1)))
typedef unsigned short bf16_t;
typedef short bf16x8 __attribute__((ext_vector_type(8)));
typedef float f32x4 __attribute__((ext_vector_type(4)));
typedef float f32x2 __attribute__((ext_vector_type(2)));
typedef unsigned u32x4 __attribute__((ext_vector_type(4)));
typedef unsigned u32x2 __attribute__((ext_vector_type(2)));
typedef __bf16 bf16x2_t __attribute__((ext_vector_type(2)));

__device__ __forceinline__ unsigned cvtpk(float lo, float hi) { f32x2 v = {lo, hi}; bf16x2_t b = __builtin_convertvector(v, bf16x2_t); return __builtin_bit_cast(unsigned, b); }
__device__ __forceinline__ float bf2f(bf16_t v) { return __uint_as_float(((unsigned)v) << 16); }
__device__ __forceinline__ bf16_t f2bf(float f) { return (bf16_t)(cvtpk(f, 0.f) & 0xffffu); }

namespace pg {
constexpr int BM = 256, BK = 64, HALF = 128, HTB = HALF * BK * 2, STAGE_BYTES = 8 * HTB;
__device__ __forceinline__ int lds_byte(int r, int c) { const int st = (r >> 4) * 2 + (c >> 5), rr = r & 15, cc = c & 31, ob = rr * 64 + cc * 2; return st * 1024 + (ob ^ (((ob >> 9) & 1) << 5)); }
__device__ __forceinline__ void stage_rc(int b, int& R, int& C) { const int st = b / 1024, sb = b % 1024, swz = sb ^ (((sb >> 9) & 1) << 5); R = (st >> 1) * 16 + swz / 64; C = (st & 1) * 32 + (swz % 64) / 2; }

struct Unit { int pm, pn, aux; const char* A; const char* B; unsigned ra[4]; };

template <class Epi, class Sched>
__device__ __forceinline__ void gemm_run(LAS unsigned char* lds, const int K, const Sched& S, const Epi& E) {
    int tid_ = threadIdx.x; asm volatile("" : "+v"(tid_));
    const int tid = tid_, wid = __builtin_amdgcn_readfirstlane(tid >> 6), lane = tid & 63, wr = wid >> 2, wc = wid & 3, fr = lane & 15, fq = lane >> 4;
    int nt_ = K / BK; asm volatile("" : "+s"(nt_)); const int nt = nt_;
    int R0, C0; stage_rc(tid * 16, R0, C0);
    unsigned voffB[2];
#pragma unroll
    for (int i = 0; i < 2; ++i) voffB[i] = (unsigned)((R0 + 64 * i) * K + C0) * 2u;
    const size_t kstep = (size_t)(BK * 2);
    const size_t hstep = (size_t)HALF * K * 2;
    const unsigned ldsw = (unsigned)wid * 1024u;
    const int aoff = lds_byte(wr * 64 + fr, fq * 8), boff = lds_byte(wc * 32 + fr, fq * 8);
#define PG_SA(b, h) (((b) * 2 + (h)) * HTB)
#define PG_SB(b, h) ((4 + (b) * 2 + (h)) * HTB)
#define PG_STAGE2(bufoff, gbase, v0, v1) do { \
        __builtin_amdgcn_global_load_lds((const unsigned*)((const char*)(gbase) + (v0)), (LAS unsigned*)(lds + (bufoff) + ldsw), 16, 0, 0); \
        __builtin_amdgcn_global_load_lds((const unsigned*)((const char*)(gbase) + (v1)), (LAS unsigned*)(lds + (bufoff) + ldsw + 8192), 16, 0, 0); } while (0)
#define PG_STAGEB(bufoff, gbase) PG_STAGE2(bufoff, gbase, voffB[0], voffB[1])
#define PG_LDA(dst, b, h) do { _Pragma("unroll") for (int m = 0; m < 4; ++m) _Pragma("unroll") for (int k = 0; k < 2; ++k) dst[m][k] = *(const LAS bf16x8*)(lds + PG_SA(b, h) + aoff + m * 2048 + k * 1024); } while (0)
#define PG_LDB(dst, b, h) do { _Pragma("unroll") for (int n = 0; n < 2; ++n) _Pragma("unroll") for (int k = 0; k < 2; ++k) dst[n][k] = *(const LAS bf16x8*)(lds + PG_SB(b, h) + boff + n * 2048 + k * 1024); } while (0)
#define PG_MMA(ai, bj, At, Bt) do { __builtin_amdgcn_s_setprio(1); _Pragma("unroll") for (int m = 0; m < 4; ++m) _Pragma("unroll") for (int n = 0; n < 2; ++n) _Pragma("unroll") for (int k = 0; k < 2; ++k) \
        acc[ai][bj][m][n] = __builtin_amdgcn_mfma_f32_16x16x32_bf16(Bt[n][k], At[m][k], acc[ai][bj][m][n], 0, 0, 0); __builtin_amdgcn_s_setprio(0); } while (0)
#define PG_WAIT_V(n) asm volatile("s_waitcnt vmcnt(" #n ")" ::: "memory")
#define PG_WAIT_L(n) asm volatile("s_waitcnt lgkmcnt(" #n ")" ::: "memory")
#define PG_BAR __builtin_amdgcn_s_barrier()
#define PG_SCHED __builtin_amdgcn_sched_barrier(0)
    Unit cur, nxt; int ui = 0;
    if (!S.next(0, cur, R0, C0)) return;
    f32x4 acc[2][2][4][2];
#pragma unroll
    for (int a = 0; a < 2; ++a)
#pragma unroll
        for (int b = 0; b < 2; ++b)
#pragma unroll
            for (int m = 0; m < 4; ++m)
#pragma unroll
                for (int n = 0; n < 2; ++n) acc[a][b][m][n] = (f32x4){0.f, 0.f, 0.f, 0.f};
    bf16x8 At[4][2], B0[2][2], B1[2][2];
    const char* cA = cur.A; const char* cB = cur.B;
    PG_STAGEB(PG_SB(0, 0), cB); PG_STAGEB(PG_SB(0, 1), cB + hstep); PG_STAGE2(PG_SA(0, 0), cA, cur.ra[0], cur.ra[1]); PG_STAGE2(PG_SA(0, 1), cA, cur.ra[2], cur.ra[3]);
    if (wr == 1) PG_BAR;
    PG_WAIT_V(2); PG_BAR;
    PG_STAGEB(PG_SB(1, 0), cB + kstep); PG_STAGE2(PG_SA(1, 0), cA + kstep, cur.ra[0], cur.ra[1]); PG_STAGEB(PG_SB(1, 1), cB + hstep + kstep);
    PG_WAIT_V(6); PG_BAR;
    for (;;) {
        const bool has_next = S.next(ui + 1, nxt, R0, C0);
        if (!has_next) nxt = cur;
        const char* nA = nxt.A; const char* nB = nxt.B;
#pragma unroll 1
        for (int t = 0; t < nt; t += 2) {
            const bool last = (t == nt - 2);
            const char* a1 = cA + (size_t)(t + 1) * kstep;
            const char* a2 = last ? nA : cA + (size_t)(t + 2) * kstep; const char* b2 = last ? nB : cB + (size_t)(t + 2) * kstep;
            const char* a3 = a2 + kstep; const char* b3 = b2 + kstep;
            const unsigned r0 = last ? nxt.ra[0] : cur.ra[0], r1 = last ? nxt.ra[1] : cur.ra[1], r2 = last ? nxt.ra[2] : cur.ra[2], r3 = last ? nxt.ra[3] : cur.ra[3];
            PG_LDB(B0, 0, 0); PG_LDB(B1, 0, 1); PG_SCHED; PG_LDA(At, 0, 0); PG_STAGE2(PG_SA(1, 1), a1, cur.ra[2], cur.ra[3]);
            PG_WAIT_V(8); PG_WAIT_L(0); PG_BAR; PG_MMA(0, 0, At, B0); PG_MMA(0, 1, At, B1); PG_BAR; PG_SCHED;
            PG_LDA(At, 0, 1); PG_STAGEB(PG_SB(0, 0), b2); PG_STAGEB(PG_SB(0, 1), b2 + hstep); PG_STAGE2(PG_SA(0, 0), a2, r0, r1);
            PG_WAIT_V(8); PG_WAIT_L(0); PG_BAR; PG_MMA(1, 0, At, B0); PG_MMA(1, 1, At, B1); PG_BAR; PG_SCHED;
            PG_LDB(B0, 1, 0); PG_LDB(B1, 1, 1); PG_SCHED; PG_LDA(At, 1, 0); PG_STAGE2(PG_SA(0, 1), a2, r2, r3);
            PG_WAIT_V(8); PG_WAIT_L(0); PG_BAR; PG_MMA(0, 0, At, B0); PG_MMA(0, 1, At, B1); PG_BAR; PG_SCHED;
            PG_LDA(At, 1, 1); PG_STAGEB(PG_SB(1, 0), b3); PG_STAGEB(PG_SB(1, 1), b3 + hstep); PG_STAGE2(PG_SA(1, 0), a3, r0, r1);
            PG_WAIT_V(8); PG_WAIT_L(0); PG_BAR; PG_MMA(1, 0, At, B0); PG_MMA(1, 1, At, B1); PG_BAR; PG_SCHED;
        }
        if (wr == 0) PG_BAR;
        E(acc, cur, wid, wr, wc, fr, fq);
        if (!has_next) break;
#pragma unroll
        for (int a = 0; a < 2; ++a)
#pragma unroll
            for (int b = 0; b < 2; ++b)
#pragma unroll
                for (int m = 0; m < 4; ++m)
#pragma unroll
                    for (int n = 0; n < 2; ++n) acc[a][b][m][n] = (f32x4){0.f, 0.f, 0.f, 0.f};
        cur = nxt; cA = nA; cB = nB; ++ui;
        if (wr == 1) PG_BAR;
    }
    PG_WAIT_V(0);
    PG_BAR;
#undef PG_SA
#undef PG_SB
#undef PG_STAGE2
#undef PG_STAGEB
#undef PG_LDA
#undef PG_LDB
#undef PG_MMA
}

struct DenseSched {
    const char* A; const char* Bt; int K, nM, nN, nwg, G, c;
    __device__ __forceinline__ void init(const void* A_, const void* Bt_, int M, int N, int K_, int G_, int c_) { A = (const char*)A_; Bt = (const char*)Bt_; K = K_; nM = M / BM; nN = N / BM; nwg = nM * nN; G = G_; c = c_; }
    __device__ __forceinline__ bool next(int i, Unit& u, int R0, int C0) const {
        const long L = (long)i * G + c; if (L >= nwg) return false;
        int wgid = (int)L; { const int q = nwg / 8, r = nwg % 8, xcd = wgid % 8, off = wgid / 8; wgid = (xcd < r ? xcd * (q + 1) : r * (q + 1) + (xcd - r) * q) + off; }
        const int nig = 8 * nN, gid = wgid / nig, fm = gid * 8, gsz = (nM - fm) < 8 ? (nM - fm) : 8;
        u.pm = fm + ((wgid % nig) % gsz); u.pn = (wgid % nig) / gsz; u.aux = 0;
        u.A = A + (size_t)u.pm * BM * K * 2; u.B = Bt + (size_t)u.pn * BM * K * 2;
#pragma unroll
        for (int q = 0; q < 4; ++q) u.ra[q] = (unsigned)((R0 + 64 * q) * K + C0) * 2u;
        return true;
    }
};
}
namespace att {
using s16x4 = __attribute__((ext_vector_type(4))) short;
using f32x16 = __attribute__((ext_vector_type(16))) float;
typedef __attribute__((address_space(3))) const char* lds_cptr;
typedef short v4i16_t __attribute__((ext_vector_type(4)));
constexpr int NSLOT = 3, VSLOT = 8192;
template <int DQ> struct Geo {
    static constexpr int NK = DQ / 16;
    static constexpr int KSLOT = (DQ == 64) ? 8192 : 16384;
    static constexpr int QWAVE = (DQ == 64) ? 4096 : 6144;
    static constexpr int LDS_K = 0, LDS_V = NSLOT * KSLOT, LDS_WS = LDS_V + NSLOT * VSLOT, LDS_OST = LDS_WS + 8 * 64 * 4, LDS_BYTES = LDS_OST + 8 * QWAVE;
};
constexpr int LDS_BIAS = Geo<64>::LDS_BYTES;
#define ASBAR() __builtin_amdgcn_sched_barrier(0)
#define AWAIT_BAR(N) asm volatile("s_waitcnt vmcnt(" #N ") lgkmcnt(0)\n\ts_barrier" ::: "memory")
__device__ __forceinline__ int crow(int r, int hi) { return (r & 3) + 8 * (r >> 2) + 4 * hi; }
__device__ __forceinline__ void glds16(const void* gsrc, unsigned lds_dst) { unsigned keep;
    asm volatile("s_mov_b32 %0, m0\n\ts_mov_b32 m0, %2\n\ts_nop 0\n\tglobal_load_lds_dwordx4 %1, off\n\ts_mov_b32 m0, %0" : "=&s"(keep) : "v"(gsrc), "s"(lds_dst) : "memory"); }
__device__ __forceinline__ float fadd_s(float a, float b) { float r; asm("v_add_f32_e32 %0, %1, %2" : "=v"(r) : "v"(a), "v"(b)); return r; }
__device__ __forceinline__ float fsub_s(float a, float b) { float r; asm("v_sub_f32_e32 %0, %1, %2" : "=v"(r) : "v"(a), "v"(b)); return r; }
__device__ __forceinline__ float max3f(float a, float b, float c) { float r; asm("v_max3_f32 %0, %1, %2, %3" : "=v"(r) : "v"(a), "v"(b), "v"(c)); return r; }
__device__ __forceinline__ float max2f(float a, float b) { float r; asm("v_max_f32_e32 %0, %1, %2" : "=v"(r) : "v"(a), "v"(b)); return r; }
__device__ __forceinline__ s16x4 vtr(lds_cptr p) { return __builtin_bit_cast(s16x4, __builtin_amdgcn_ds_read_tr16_b64_v4i16((__attribute__((address_space(3))) v4i16_t*)p)); }
template <int NK> __device__ __forceinline__ void kloadall(bf16x8* kf, lds_cptr kp) {
#pragma unroll
    for (int j = 0; j < NK; ++j) { kf[2 * j] = *(const LAS bf16x8*)(kp + j * 2048); kf[2 * j + 1] = *(const LAS bf16x8*)(kp + j * 2048 + 512); } }
__device__ __forceinline__ void kload2(bf16x8* kf, lds_cptr kp, int j) { kf[2 * j] = *(const LAS bf16x8*)(kp + j * 2048); kf[2 * j + 1] = *(const LAS bf16x8*)(kp + j * 2048 + 512); }
__device__ __forceinline__ void cmask(f32x16& p0, f32x16& p1, int koff, int qtok, int hi) {
    const int x = qtok - koff - 4 * hi;
#pragma unroll
    for (int r = 0; r < 16; ++r) { const int c = (r & 3) + 8 * (r >> 2); if (c > x) p0[r] = -INFINITY; if (c + 32 > x) p1[r] = -INFINITY; }
}
__device__ __forceinline__ void wmask(f32x16& p0, f32x16& p1, int thr, int hi) {
    const int y = thr - 4 * hi;
#pragma unroll
    for (int r = 0; r < 16; ++r) { const int c = (r & 3) + 8 * (r >> 2); if (c < y) p0[r] = -INFINITY; if (c + 32 < y) p1[r] = -INFINITY; }
}
__device__ __forceinline__ float rowmax(const f32x16& p0, const f32x16& p1) {
    float a = max3f(p0[0], p0[1], p1[0]), b = max3f(p0[2], p0[3], p1[1]); a = max3f(a, p1[2], p1[3]);
#pragma unroll
    for (int r = 4; r < 16; r += 4) { a = max3f(a, p0[r], p0[r + 1]); b = max3f(b, p0[r + 2], p0[r + 3]); a = max3f(a, p1[r], p1[r + 1]); b = max3f(b, p1[r + 2], p1[r + 3]); }
    const float m = max2f(a, b);
    auto rr = __builtin_amdgcn_permlane32_swap(__float_as_uint(m), __float_as_uint(m), false, false);
    return max2f(__uint_as_float(rr[0]), __uint_as_float(rr[1]));
}

enum { MODE_CAUSAL = 0, MODE_FOX = 1, MODE_WIN = 2 };
struct UnitArgs {
    const bf16_t* qrow;
    const bf16_t* K; const bf16_t* V; int kvpitch, vpitch;
    bf16_t* obase; int opitch;
    int qtok;
    int abase;
    int nsteps;
    const LAS float* bias;
};

template <int NB> __device__ __forceinline__ int seq(int i, int abase) { return (i < NB) ? abase + i : abase + NB - 1 - i; }

template <int MODE, bool GQA4, int THRL, int DQ>
__device__ __forceinline__ void attn_unit(const UnitArgs& A, char* shm) {
    constexpr int NB = GQA4 ? 1 : 4;
    typedef Geo<DQ> G; constexpr int NK = G::NK, KSLOT = G::KSLOT, LDS_K = G::LDS_K, LDS_V = G::LDS_V, LDS_WS = G::LDS_WS, LDS_OST = G::LDS_OST, QWAVE = G::QWAVE;
    constexpr bool USE_NEGM = (MODE != MODE_FOX) && (DQ == 64);
    int tid_ = threadIdx.x; asm volatile("" : "+v"(tid_));
    const int tid = tid_, lane = tid & 63, r32 = lane & 31, hi = lane >> 5; const int wid = __builtin_amdgcn_readfirstlane(tid >> 6);
    const unsigned lds0 = (unsigned)(uintptr_t)shm;
    float* wsf = (float*)(shm + LDS_WS) + wid * 64;
    const int NT = A.nsteps, abase = A.abase; const long kvp = A.kvpitch, vvp = A.vpitch;
    const bf16_t* ksrc = A.K + (long)lane * kvp + wid * 8;
    const bf16_t* ksrc2 = A.K + (long)lane * kvp + (8 + (wid & 3)) * 8;
    const bf16_t* vsrc = A.V + (long)(16 * (wid & 3) + (lane >> 2)) * vvp + (wid >> 2) * 32 + (lane & 3) * 8;
    const unsigned kdst = lds0 + LDS_K + wid * 1024, vdst = lds0 + LDS_V + wid * 1024, kdst2 = lds0 + LDS_K + (8 + wid) * 1024;
#define TILE_OF(t) ({ int a_ = seq<NB>((t), abase); a_ < 0 ? 0 : a_; })
#define DMA_K(t, slot) do { const long to_ = (long)TILE_OF(t) * 64 * kvp; glds16(ksrc + to_, (unsigned)__builtin_amdgcn_readfirstlane(kdst + (slot) * KSLOT)); \
        if (DQ == 96) glds16(ksrc2 + to_, (unsigned)__builtin_amdgcn_readfirstlane(kdst2 + (slot) * KSLOT)); } while (0)
#define DMA_V(t, slot) glds16(vsrc + (long)TILE_OF(t) * 64 * vvp, (unsigned)__builtin_amdgcn_readfirstlane(vdst + (slot) * VSLOT))
    const lds_cptr shm3 = (lds_cptr)shm; const lds_cptr kp0 = shm3 + LDS_K + hi * 1024 + r32 * 16;
    const lds_cptr vp0 = shm3 + LDS_V + ((lane >> 4) & 1) * 32 + (lane & 3) * 8 + (4 * hi + ((lane & 15) >> 2)) * 64;
    const int vb0 = (int)(lds0 + LDS_V) + ((lane >> 4) & 1) * 32 + (lane & 3) * 8 + (4 * hi + ((lane & 15) >> 2)) * 64;
    DMA_K(0, 0); DMA_V(0, 0); DMA_K(1, 1);
    bf16x8 qr[NK];
#pragma unroll
    for (int d0 = 0; d0 < NK; ++d0) qr[d0] = *reinterpret_cast<const bf16x8*>(A.qrow + d0 * 16 + hi * 8);
    const lds_cptr qlp = shm3 + LDS_OST + wid * QWAVE + hi * 512 + r32 * 16;
    if (DQ == 96) {
#pragma unroll
        for (int d0 = 0; d0 < NK; ++d0) *(LAS bf16x8*)(const_cast<__attribute__((address_space(3))) char*>(qlp) + d0 * 1024) = qr[d0];
    }
#define QL(d0) (*(const LAS bf16x8*)(qlp + (d0) * 1024))
    float mhat = 0.f, l_reg = 0.f; f32x16 o[2]; o[0] = f32x16{}; o[1] = f32x16{};
    f32x16 negm = f32x16{}; if (USE_NEGM) asm volatile("" : "+v"(negm));
    const int qtok = A.qtok;
#define CMASK(P0, P1, t) do { const int t_ = (t); if (t_ < NB) cmask(P0, P1, 64 * t_, qtok, hi); \
        else { const int a_ = abase + NB - 1 - t_; if (a_ < 0) wmask(P0, P1, 64, hi); \
               else if (MODE == MODE_WIN) { const int thr_ = qtok - 511 + 64 * (abase - a_); if (thr_ > 0) wmask(P0, P1, thr_, hi); } } } while (0)
#define CINIT1(C, t, OFF) do { if (MODE == MODE_FOX) { const LAS float* bt_ = A.bias + 64 * (seq<NB>((t), abase) - (abase + NB - NT)) + 4 * hi + (OFF); const float nm_ = -mhat; \
        _Pragma("unroll") for (int g_ = 0; g_ < 4; ++g_) { const f32x4 b_ = *(const LAS f32x4*)(bt_ + 8 * g_); C[4 * g_] = b_.x; C[4 * g_ + 1] = b_.y; C[4 * g_ + 2] = b_.z; C[4 * g_ + 3] = b_.w; } \
        _Pragma("unroll") for (int r_ = 0; r_ < 16; ++r_) C[r_] += nm_; asm volatile("" : "+v"(C)); } \
      else if (USE_NEGM) { C = negm; } \
      else { const float nm_ = -mhat; _Pragma("unroll") for (int r_ = 0; r_ < 16; ++r_) C[r_] = nm_; asm volatile("" : "+v"(C)); } } while (0)
#define CINIT(C0, C1, t) do { CINIT1(C0, t, 0); CINIT1(C1, t, 32); } while (0)
    bool resc = false;
#define START(P0, P1) do { const float rm = rowmax(P0, P1); resc = false; \
    { const float dl = rm; mhat = fadd_s(mhat, dl); \
      _Pragma("unroll") for (int r = 0; r < 16; ++r) { P0[r] = fsub_s(P0[r], dl); P1[r] = fsub_s(P1[r], dl); } \
      if (USE_NEGM) { _Pragma("unroll") for (int r = 0; r < 16; ++r) negm[r] = -mhat; asm volatile("" : "+v"(negm)); } } \
    _Pragma("unroll") for (int r = 0; r < 16; ++r) P0[r] = __builtin_amdgcn_exp2f(P0[r]); } while (0)
#define RESC() do { if (resc) { asm volatile("s_waitcnt lgkmcnt(0)" ::: "memory"); \
      const float* wsh_ = wsf + 4 * hi; \
      _Pragma("unroll") for (int d_ = 0; d_ < 2; ++d_) _Pragma("unroll") for (int r = 0; r < 16; ++r) o[d_][r] *= wsh_[(r & 3) + 8 * (r >> 2)]; } } while (0)
    f32x16 pA0, pA1, pB0, pB1; bf16x8 kf[2 * NK];
    int sl_prev = 0, sl_cur = 0, sl_next = 1;
#define ROT() do { sl_prev = sl_cur; sl_cur = sl_next; sl_next = (sl_next == NSLOT - 1) ? 0 : sl_next + 1; } while (0)
    DMA_K(2, 2);
    if (DQ == 96) { AWAIT_BAR(5); } else { AWAIT_BAR(3); }
    { const char* kb = shm + LDS_K + hi * 1024 + r32 * 16;
      CINIT(pA0, pA1, 0);
#pragma unroll
      for (int d0 = 0; d0 < NK; ++d0) {
          const bf16x8 b0 = *reinterpret_cast<const bf16x8*>(kb + d0 * 2048);
          const bf16x8 b1 = *reinterpret_cast<const bf16x8*>(kb + d0 * 2048 + 512);
          pA0 = __builtin_amdgcn_mfma_f32_32x32x16_bf16(b0, qr[d0], pA0, 0, 0, 0); pA1 = __builtin_amdgcn_mfma_f32_32x32x16_bf16(b1, qr[d0], pA1, 0, 0, 0); } }
    asm volatile("s_nop 15\n\ts_nop 7" : "+v"(pA0), "+v"(pA1)); CMASK(pA0, pA1, 0);
    START(pA0, pA1);
    _Pragma("unroll") for (int r = 0; r < 16; ++r) pA1[r] = __builtin_amdgcn_exp2f(pA1[r]);
    AWAIT_BAR(0);
    DMA_K(3, 0); DMA_V(1, 1);
    ROT();
    kloadall<NK>(kf, kp0 + sl_cur * KSLOT);
    if (DQ == 96) { AWAIT_BAR(3); } else { AWAIT_BAR(2); }
    s16x4 vlo[(DQ == 96) ? 4 : 8], vhi[(DQ == 96) ? 4 : 8]; u32x4 pw0, pw1, pw2, pw3;
#define PKW(P, B) cvtpk(P[B], P[B + 1])
#define PAF(k) __builtin_bit_cast(bf16x8, pw##k)
#define VFR(i) (bf16x8){vlo[i][0], vlo[i][1], vlo[i][2], vlo[i][3], vhi[i][0], vhi[i][1], vhi[i][2], vhi[i][3]}
#define PIN(x) asm volatile("" : "+v"(x))
#define MX3(a, b, c) __builtin_fmaxf(__builtin_fmaxf((a), (b)), (c))
#define GAPA(MF, A0, A1, A2, A3, W0, W1, PW) do { MF; sacc += A0; sacc += A1; sacc += A2; sacc += A3; PIN(sacc); W0; W1; PIN(PW); ASBAR(); } while (0)
#define EX(v) __builtin_amdgcn_exp2f(v)
#define GAPB(MF, X, B) do { MF; X[B] = EX(X[B]); X[B + 1] = EX(X[B + 1]); X[B + 2] = EX(X[B + 2]); X[B + 3] = EX(X[B + 3]); PIN(X); ASBAR(); } while (0)
#define VRD(i) do { vlo[i] = vtr(vp_ + (((i) >> 2) * 4096 + ((i) & 3) * 1024)); vhi[i] = vtr(vp_ + (((i) >> 2) * 4096 + ((i) & 3) * 1024 + 512)); } while (0)
#define KRD(G_, j) do { if (G_) { kload2(kf, kp0 + sl_next * KSLOT, j); ASBAR(); } } while (0)
#define MFMA32(a, b, c) __builtin_amdgcn_mfma_f32_32x32x16_bf16(a, b, c, 0, 0, 0)
#define STEP64(C0, C1, P0, P1, t, GK, GV, GL, DOMASK) do { ASBAR(); \
    const lds_cptr vp_ = vp0 + sl_prev * VSLOT; \
    CINIT1(C0, t, 0); ASBAR(); \
    VRD(0); ASBAR(); float sacc = (P0[0] + P0[1]); \
    GAPA(C0 = MFMA32(kf[0], qr[0], C0), P0[2], P0[3], P0[4], P0[5],     pw0[0] = PKW(P0, 0), pw0[1] = PKW(P0, 2), pw0); \
    CINIT1(C1, t, 32); ASBAR(); \
    VRD(4); ASBAR(); GAPA(C1 = MFMA32(kf[1], qr[0], C1), P0[6], P0[7], P0[8], P0[9],     pw0[2] = PKW(P0, 4), pw0[3] = PKW(P0, 6), pw0); \
    VRD(1); ASBAR(); GAPA(C0 = MFMA32(kf[2], qr[1], C0),   P0[10], P0[11], P0[12], P0[13], pw1[0] = PKW(P0, 8), pw1[1] = PKW(P0, 10), pw1); \
    VRD(5); ASBAR(); GAPA(C1 = MFMA32(kf[3], qr[1], C1),   P0[14], P0[15], P1[0], P1[1],   pw1[2] = PKW(P0, 12), pw1[3] = PKW(P0, 14), pw1); \
    VRD(2); ASBAR(); GAPA(C0 = MFMA32(kf[4], qr[2], C0),   P1[2], P1[3], P1[4], P1[5],     pw2[0] = PKW(P1, 0), pw2[1] = PKW(P1, 2), pw2); \
    VRD(6); ASBAR(); GAPA(C1 = MFMA32(kf[5], qr[2], C1),   P1[6], P1[7], P1[8], P1[9],     pw2[2] = PKW(P1, 4), pw2[3] = PKW(P1, 6), pw2); \
    VRD(3); ASBAR(); GAPA(C0 = MFMA32(kf[6], qr[3], C0),   P1[10], P1[11], P1[12], P1[13], pw3[0] = PKW(P1, 8), pw3[1] = PKW(P1, 10), pw3); \
    VRD(7); ASBAR(); GAPA(C1 = MFMA32(kf[7], qr[3], C1),   P1[14], P1[15], 0.f, 0.f,       pw3[2] = PKW(P1, 12), pw3[3] = PKW(P1, 14), pw3); \
    l_reg += sacc; \
    if (GK) { DMA_K((t) + 3, sl_cur); } if (GV) { DMA_V((t) + 1, sl_next); } \
    if (DOMASK) CMASK(C0, C1, t); \
    { float a = MX3(C0[0], C0[1], C1[0]), b = MX3(C0[2], C0[3], C1[1]); a = MX3(a, C1[2], C1[3]); \
      _Pragma("unroll") for (int r = 4; r < 16; r += 4) { a = MX3(a, C0[r], C0[r + 1]); b = MX3(b, C0[r + 2], C0[r + 3]); a = MX3(a, C1[r], C1[r + 1]); b = MX3(b, C1[r + 2], C1[r + 3]); } \
      float rm = __builtin_fmaxf(a, b); { auto rr = __builtin_amdgcn_permlane32_swap(__float_as_uint(rm), __float_as_uint(rm), false, false); rm = __builtin_fmaxf(__uint_as_float(rr[0]), __uint_as_float(rr[1])); } \
      resc = false; \
      if (__builtin_expect(__any(rm > (float)THRL), 0)) { const float dl = __builtin_fmaxf(rm, 0.f); mhat += dl; \
        _Pragma("unroll") for (int r = 0; r < 16; ++r) { C0[r] -= dl; C1[r] -= dl; } \
        if (USE_NEGM) { _Pragma("unroll") for (int r = 0; r < 16; ++r) negm[r] = -mhat; asm volatile("" : "+v"(negm)); } \
        const float f = __builtin_amdgcn_exp2f(-dl); l_reg *= f; if (hi == 0) wsf[r32] = f; resc = true; } } \
    ASBAR(); \
    GAPB(o[0] = MFMA32(PAF(0), VFR(0), o[0]), C0, 0); \
    GAPB(o[1] = MFMA32(PAF(0), VFR(4), o[1]), C0, 4); \
    KRD(GL, 0); GAPB(o[0] = MFMA32(PAF(1), VFR(1), o[0]), C0, 8); \
    KRD(GL, 1); GAPB(o[1] = MFMA32(PAF(1), VFR(5), o[1]), C0, 12); \
    KRD(GL, 2); GAPB(o[0] = MFMA32(PAF(2), VFR(2), o[0]), C1, 0); \
    KRD(GL, 3); GAPB(o[1] = MFMA32(PAF(2), VFR(6), o[1]), C1, 4); \
    GAPB(o[0] = MFMA32(PAF(3), VFR(3), o[0]), C1, 8); \
    GAPB(o[1] = MFMA32(PAF(3), VFR(7), o[1]), C1, 12); \
    } while (0)
#define AWAIT_STEADY() do { if (DQ == 96) { AWAIT_BAR(3); } else { AWAIT_BAR(2); } } while (0)
#define VRD4(i, b) do { vlo[b] = vtr(vp_ + (((i) >> 2) * 4096 + ((i) & 3) * 1024)); vhi[b] = vtr(vp_ + (((i) >> 2) * 4096 + ((i) & 3) * 1024 + 512)); } while (0)
#define VFR4(b) (bf16x8){vlo[b][0], vlo[b][1], vlo[b][2], vlo[b][3], vhi[b][0], vhi[b][1], vhi[b][2], vhi[b][3]}
#define GAPQ(MF, QLD, A0, A1, A2, A3, W0, W1, PW) do { MF; QLD; sacc += A0; sacc += A1; sacc += A2; sacc += A3; PIN(sacc); W0; W1; PIN(PW); ASBAR(); } while (0)
#define STEP96(C0, C1, P0, P1, t, GK, GV, GL, DOMASK) do { ASBAR(); \
    const lds_cptr vp_ = vp0 + sl_prev * VSLOT; \
    CINIT1(C0, t, 0); CINIT1(C1, t, 32); bf16x8 qa = QL(0), qb; ASBAR(); \
    float sacc = (P0[0] + P0[1]); \
    GAPQ(C0 = MFMA32(kf[0], qa, C0), qb = QL(1), P0[2], P0[3], P0[4], P0[5],     pw0[0] = PKW(P0, 0), pw0[1] = PKW(P0, 2), pw0); \
    GAPQ(C1 = MFMA32(kf[1], qa, C1), (void)0,    P0[6], P0[7], P0[8], P0[9],     pw0[2] = PKW(P0, 4), pw0[3] = PKW(P0, 6), pw0); \
    GAPQ(C0 = MFMA32(kf[2], qb, C0), qa = QL(2), P0[10], P0[11], P0[12], P0[13], pw1[0] = PKW(P0, 8), pw1[1] = PKW(P0, 10), pw1); \
    GAPQ(C1 = MFMA32(kf[3], qb, C1), (void)0,    P0[14], P0[15], P1[0], P1[1],   pw1[2] = PKW(P0, 12), pw1[3] = PKW(P0, 14), pw1); \
    GAPQ(C0 = MFMA32(kf[4], qa, C0), qb = QL(3), P1[2], P1[3], P1[4], P1[5],     pw2[0] = PKW(P1, 0), pw2[1] = PKW(P1, 2), pw2); \
    GAPQ(C1 = MFMA32(kf[5], qa, C1), (void)0,    P1[6], P1[7], P1[8], P1[9],     pw2[2] = PKW(P1, 4), pw2[3] = PKW(P1, 6), pw2); \
    GAPQ(C0 = MFMA32(kf[6], qb, C0), qa = QL(4), P1[10], P1[11], P1[12], P1[13], pw3[0] = PKW(P1, 8), pw3[1] = PKW(P1, 10), pw3); \
    GAPQ(C1 = MFMA32(kf[7], qb, C1), (void)0,    P1[14], P1[15], 0.f, 0.f,       pw3[2] = PKW(P1, 12), pw3[3] = PKW(P1, 14), pw3); \
    C0 = MFMA32(kf[8], qa, C0); qb = QL(5); VRD4(0, 0); ASBAR(); \
    C1 = MFMA32(kf[9], qa, C1); VRD4(4, 1); ASBAR(); \
    C0 = MFMA32(kf[10], qb, C0); ASBAR(); \
    C1 = MFMA32(kf[11], qb, C1); ASBAR(); \
    l_reg += sacc; \
    if (GK) { DMA_K((t) + 3, sl_cur); } if (GV) { DMA_V((t) + 1, sl_next); } \
    if (DOMASK) CMASK(C0, C1, t); \
    { float a = MX3(C0[0], C0[1], C1[0]), b = MX3(C0[2], C0[3], C1[1]); a = MX3(a, C1[2], C1[3]); \
      _Pragma("unroll") for (int r = 4; r < 16; r += 4) { a = MX3(a, C0[r], C0[r + 1]); b = MX3(b, C0[r + 2], C0[r + 3]); a = MX3(a, C1[r], C1[r + 1]); b = MX3(b, C1[r + 2], C1[r + 3]); } \
      float rm = __builtin_fmaxf(a, b); { auto rr = __builtin_amdgcn_permlane32_swap(__float_as_uint(rm), __float_as_uint(rm), false, false); rm = __builtin_fmaxf(__uint_as_float(rr[0]), __uint_as_float(rr[1])); } \
      resc = false; \
      if (__builtin_expect(__any(rm > (float)THRL), 0)) { const float dl = __builtin_fmaxf(rm, 0.f); mhat += dl; \
        _Pragma("unroll") for (int r = 0; r < 16; ++r) { C0[r] -= dl; C1[r] -= dl; } \
        const float f = __builtin_amdgcn_exp2f(-dl); l_reg *= f; if (hi == 0) wsf[r32] = f; resc = true; } } \
    ASBAR(); \
    VRD4(1, 2); ASBAR(); GAPB(o[0] = MFMA32(PAF(0), VFR4(0), o[0]), C0, 0); \
    VRD4(5, 3); ASBAR(); GAPB(o[1] = MFMA32(PAF(0), VFR4(1), o[1]), C0, 4); \
    VRD4(2, 0); KRD(GL, 0); GAPB(o[0] = MFMA32(PAF(1), VFR4(2), o[0]), C0, 8); \
    VRD4(6, 1); KRD(GL, 1); GAPB(o[1] = MFMA32(PAF(1), VFR4(3), o[1]), C0, 12); \
    VRD4(3, 2); KRD(GL, 2); GAPB(o[0] = MFMA32(PAF(2), VFR4(0), o[0]), C1, 0); \
    VRD4(7, 3); KRD(GL, 3); GAPB(o[1] = MFMA32(PAF(2), VFR4(1), o[1]), C1, 4); \
    KRD(GL, 4); GAPB(o[0] = MFMA32(PAF(3), VFR4(2), o[0]), C1, 8); \
    KRD(GL, 5); GAPB(o[1] = MFMA32(PAF(3), VFR4(3), o[1]), C1, 12); \
    } while (0)
#define STEP(C0, C1, P0, P1, t, GK, GV, GL, DOMASK) do { if constexpr (DQ == 96) { STEP96(C0, C1, P0, P1, t, GK, GV, GL, DOMASK); } else { STEP64(C0, C1, P0, P1, t, GK, GV, GL, DOMASK); } } while (0)
#define ENDW(tt) do { if ((tt) + 3 < NT) { AWAIT_STEADY(); } else if ((tt) + 2 < NT) { AWAIT_BAR(1); } else { AWAIT_BAR(0); } } while (0)
    int t = 1;
    for (; t < 5 && t + 1 < NT; t += 2) {
        STEP(pB0, pB1, pA0, pA1, t, (t + 3 < NT), (t + 1 < NT), (t + 1 < NT), true);       ENDW(t);     RESC(); ROT();
        STEP(pA0, pA1, pB0, pB1, t + 1, (t + 4 < NT), (t + 2 < NT), (t + 2 < NT), true);   ENDW(t + 1); RESC(); ROT();
    }
    for (; t + 5 < NT; t += 2) {
        STEP(pB0, pB1, pA0, pA1, t, true, true, true, false);     AWAIT_STEADY(); RESC(); ROT();
        STEP(pA0, pA1, pB0, pB1, t + 1, true, true, true, false); AWAIT_STEADY(); RESC(); ROT();
    }
    for (; t + 1 < NT; t += 2) {
        STEP(pB0, pB1, pA0, pA1, t, (t + 3 < NT), (t + 1 < NT), (t + 1 < NT), true);       ENDW(t);     RESC(); ROT();
        STEP(pA0, pA1, pB0, pB1, t + 1, (t + 4 < NT), (t + 2 < NT), (t + 2 < NT), true);   ENDW(t + 1); RESC(); ROT();
    }
    STEP(pB0, pB1, pA0, pA1, NT - 1, false, false, false, true); RESC();
    { float sacc = pB0[0] + pB0[1];
      _Pragma("unroll") for (int r = 2; r < 16; ++r) sacc += pB0[r];
      _Pragma("unroll") for (int r = 0; r < 16; ++r) sacc += pB1[r];
      l_reg += sacc;
      pw0 = (u32x4){PKW(pB0, 0), PKW(pB0, 2), PKW(pB0, 4), PKW(pB0, 6)}; pw1 = (u32x4){PKW(pB0, 8), PKW(pB0, 10), PKW(pB0, 12), PKW(pB0, 14)};
      pw2 = (u32x4){PKW(pB1, 0), PKW(pB1, 2), PKW(pB1, 4), PKW(pB1, 6)}; pw3 = (u32x4){PKW(pB1, 8), PKW(pB1, 10), PKW(pB1, 12), PKW(pB1, 14)};
      ASBAR();
      const int vb = vb0 + sl_cur * VSLOT;
#pragma unroll
      for (int d0 = 0; d0 < 2; ++d0) { s16x4 lo[4], hh[4];
#pragma unroll
          for (int ks = 0; ks < 4; ++ks) {
              asm volatile("ds_read_b64_tr_b16 %0,%1 offset:%c2" : "=&v"(lo[ks]) : "v"(vb), "i"(d0 * 4096 + ks * 1024) : "memory");
              asm volatile("ds_read_b64_tr_b16 %0,%1 offset:%c2" : "=&v"(hh[ks]) : "v"(vb), "i"(d0 * 4096 + ks * 1024 + 512) : "memory"); }
          asm volatile("s_waitcnt lgkmcnt(0)" ::: "memory"); ASBAR();
#define PK(k) (bf16x8){lo[k][0], lo[k][1], lo[k][2], lo[k][3], hh[k][0], hh[k][1], hh[k][2], hh[k][3]}
          o[d0] = MFMA32(PAF(0), PK(0), o[d0]); o[d0] = MFMA32(PAF(1), PK(1), o[d0]); o[d0] = MFMA32(PAF(2), PK(2), o[d0]); o[d0] = MFMA32(PAF(3), PK(3), o[d0]);
#undef PK
      } }
    { auto rr = __builtin_amdgcn_permlane32_swap(__float_as_uint(l_reg), __float_as_uint(l_reg), false, false); l_reg = __uint_as_float(rr[0]) + __uint_as_float(rr[1]); }
    if (hi == 0) wsf[32 + r32] = l_reg; asm volatile("s_waitcnt lgkmcnt(0)" ::: "memory");
    int lane_e = lane; asm volatile("" : "+v"(lane_e)); const int hi_e = lane_e >> 5, r32_e = lane_e & 31;
    float rli[16];
    { const float* wl_ = wsf + 32 + 4 * hi_e;
#pragma unroll
      for (int r = 0; r < 16; ++r) rli[r] = __builtin_amdgcn_rcpf(wl_[(r & 3) + 8 * (r >> 2)]); }
    { bf16_t* stg = (bf16_t*)(shm + LDS_OST + wid * QWAVE);
      bf16_t* stl = stg + (4 * hi_e) * 64 + r32_e;
#pragma unroll
      for (int r = 0; r < 16; ++r) {
#pragma unroll
          for (int d0 = 0; d0 < 2; ++d0) stl[((r & 3) + 8 * (r >> 2)) * 64 + d0 * 32] = f2bf(o[d0][r] * rli[r]); }
      asm volatile("s_waitcnt lgkmcnt(0)" ::: "memory");
#pragma unroll
      for (int i = 0; i < 4; ++i) { const int row = i * 8 + (lane_e >> 3), ch = lane_e & 7; const u32x4 v = *(const u32x4*)(stg + row * 64 + ch * 8);
          bf16_t* dst = GQA4 ? (A.obase + (long)(8 * wid + (row >> 2)) * A.opitch + (row & 3) * 64) : (A.obase + (long)(32 * wid + row) * A.opitch);
          *(u32x4*)(dst + ch * 8) = v; } }
    asm volatile("s_waitcnt lgkmcnt(0)\n\ts_barrier" ::: "memory");
#undef TILE_OF
#undef DMA_K
#undef DMA_V
#undef CMASK
#undef CINIT
#undef START
#undef RESC
#undef ROT
#undef PKW
#undef PAF
#undef VFR
#undef PIN
#undef MX3
#undef GAPA
#undef GAPB
#undef EX
#undef VRD
#undef KRD
#undef MFMA32
#undef STEP
#undef STEP64
#undef STEP96
#undef VRD4
#undef VFR4
#undef GAPQ
#undef QL
#undef ENDW
#undef AWAIT_STEADY
}
}
constexpr int MK_THREADS = 512;
constexpr int LDS_RING = 131072;
constexpr int LDS_X = LDS_RING;
constexpr int LDS_MOD = LDS_RING + 8192;
constexpr int LDS_BARST = 155648 - 16;
constexpr int LDS_TOTAL = 155648;

#define C2Q 0.18033688011112042f
#define LOG2E 1.4426950408889634f

struct BlkDesc { bf16_t* dst; const float* gain; int pitch; int flags; float scale; int csoff; };
#define C2M 0.14724312203508865f
struct MKP {
    const float* in[34];
    float* out;
    float* modpart;
    float* mod;
    float* cosT; float* sinT;
    bf16_t* W_in0t;
    bf16_t* W_out0t;
    bf16_t* XN;
    bf16_t* OATT;
    bf16_t* QN;
    bf16_t* KV6;
    bf16_t* FQ; bf16_t* FK; bf16_t* FV;
    float* GATES;
    float* LOGF;
    BlkDesc* desc0;
    float* CUMB;
    BlkDesc* desc_uq;
    BlkDesc* desc_ukv;
    bf16_t* W_in1t;
    bf16_t* W_uqt;
    bf16_t* W_ukvt;
    bf16_t* W_out1t;
    bf16_t* P1;
    bf16_t* CQN;
    bf16_t* CKVN;
    bf16_t* Q96;
    bf16_t* K96;
    bf16_t* V1;
    bf16_t* WcT;
    bf16_t* KCMP;
    bf16_t* VCT;
    bf16_t* VSLT;
    bf16_t* OCMP;
    bf16_t* OWIN;
    const int* pos;
    bf16_t* Wgu;
    bf16_t* Wd;
    bf16_t* HID;
    bf16_t* YBUF;
    int* gcnt;
    int* list;
    float* ew;
    unsigned* barw;
    int ph_lo, ph_hi, dbg_flags, pad_;
};

__device__ __forceinline__ int swap45(int p) { return (p & 15) | ((p & 16) << 1) | ((p & 32) >> 1); }

template <class Map>
__device__ __forceinline__ void tr_item(const float* __restrict__ W, int ldw, int K, bf16_t* WT, LAS float* scr, int kb, int nb, int lane, const Map& cmap, const float* kscale) {
    const int k0 = 64 * kb, n0 = 32 * nb;
    const int sc = cmap(n0 + (lane & 31));
#pragma unroll 8
    for (int i = 0; i < 32; ++i) {
        const int kk = 2 * i + (lane >> 5);
        float v = 0.f;
        if (sc >= 0) { v = W[(size_t)(k0 + kk) * ldw + sc]; if (kscale) v *= kscale[k0 + kk]; }
        scr[kk * 33 + (lane & 31)] = v;
    }
    asm volatile("s_waitcnt lgkmcnt(0)" ::: "memory");
    const int c = lane & 7;
#pragma unroll
    for (int j = 0; j < 4; ++j) {
        const int n = (lane >> 3) + 8 * j; const LAS float* s = scr + (8 * c) * 33 + n;
        u32x4 o; o.x = cvtpk(s[0 * 33], s[1 * 33]); o.y = cvtpk(s[2 * 33], s[3 * 33]); o.z = cvtpk(s[4 * 33], s[5 * 33]); o.w = cvtpk(s[6 * 33], s[7 * 33]);
        *(u32x4*)(WT + (size_t)(n0 + n) * K + k0 + 8 * c) = o;
    }
    asm volatile("s_waitcnt lgkmcnt(0)" ::: "memory");
}
struct MapIn0 {
    __device__ __forceinline__ int operator()(int nn) const {
        const int blk = nn >> 6, p = nn & 63;
        if (blk < 8) return blk * 64 + swap45(p);
        if (blk < 20) return 512 + (blk - 8) * 64 + swap45(p);
        if (blk < 44) return 1304 + (blk - 20) * 64 + swap45(p);
        if (blk == 44) { if (p < 24) return 1280 + p; if (p < 32) return 2840 + (p - 24); return -1; }
        return -1;
    }
};
struct MapId { __device__ __forceinline__ int operator()(int nn) const { return nn; } };
struct MapIn1 { __device__ __forceinline__ int operator()(int nn) const { return nn < 672 ? nn : -1; } };
struct MapUq { __device__ __forceinline__ int operator()(int nn) const { if (nn < 1024) return (nn >> 6) * 96 + swap45(nn & 63); const int r = nn - 1024; return (r >> 5) * 96 + 64 + (r & 31); } };
struct MapUkv { __device__ __forceinline__ int operator()(int nn) const { if (nn < 1024) return (nn >> 6) * 128 + swap45(nn & 63); const int r = nn - 1024; return (r >> 6) * 128 + 64 + swap45(r & 63); } };

namespace nsa {
using att::f32x16; using att::crow;
#define NMFMA32(a, b, c) __builtin_amdgcn_mfma_f32_32x32x16_bf16(a, b, c, 0, 0, 0)
#define NMFMA16(a, b, c) __builtin_amdgcn_mfma_f32_16x16x32_bf16(a, b, c, 0, 0, 0)
#define RLF(x, l) __uint_as_float(__builtin_amdgcn_readlane((int)__float_as_uint(x), (l)))

__device__ __forceinline__ void compress_job(const MKP& p, LAS float* scr, int job, int lane) {
    const int nt = job & 31, g = (job >> 5) & 1, kv = job >> 6;
    const int r32 = lane & 31, hi = lane >> 5, n0 = nt * 32;
    const bf16_t* tok = p.KV6 + (size_t)(kv * 2 + g) * S_ * 64;
    const bf16_t* wt = p.WcT + (size_t)kv * 64 * 2048;
    { const float* w = p.in[12] + (size_t)kv * 2048 * 64 + lane; const float* pe = p.in[11] + kv * 2048; float b = 0.f;
#pragma unroll 8
      for (int k = 0; k < 2048; ++k) b += pe[k] * w[(size_t)k * 64];
      scr[lane] = b; }
    asm volatile("s_waitcnt lgkmcnt(0)" ::: "memory");
    int nrow = n0 + r32; if (nrow > 1022) nrow = 1022;
    const bf16_t* ta = tok + (size_t)(16 * nrow) * 64 + 8 * hi;
    const bf16_t* wa0 = wt + (size_t)r32 * 2048 + 8 * hi;
    const bf16_t* wa1 = wa0 + (size_t)32 * 2048;
    f32x16 c0 = f32x16{}, c1 = f32x16{};
    if (kv == 0) {
#pragma unroll 4
        for (int s = 0; s < 128; ++s) {
            const bf16x8 tf = *(const bf16x8*)(ta + 16 * s), w0 = *(const bf16x8*)(wa0 + 16 * s), w1 = *(const bf16x8*)(wa1 + 16 * s);
            c0 = NMFMA32(w0, tf, c0); c1 = NMFMA32(w1, tf, c1);
        }
        float ss = 0.f;
#pragma unroll
        for (int r = 0; r < 16; ++r) { c0[r] += scr[crow(r, hi)]; c1[r] += scr[32 + crow(r, hi)]; ss += c0[r] * c0[r] + c1[r] * c1[r]; }
        { auto rr = __builtin_amdgcn_permlane32_swap(__float_as_uint(ss), __float_as_uint(ss), false, false); ss = __uint_as_float(rr[0]) + __uint_as_float(rr[1]); }
        const float rs = rsqrtf(ss * (1.f / 64.f) + EPSF);
        const float* gn = p.in[10];
        if (n0 + r32 < 1023) {
            bf16_t* dst = p.KCMP + ((size_t)g * 1024 + n0 + r32) * 64;
#pragma unroll
            for (int q = 0; q < 4; ++q) {
                const int e0 = 8 * q + 4 * hi;
                const f32x4 ga = *(const f32x4*)(gn + e0), gb = *(const f32x4*)(gn + 32 + e0);
                u32x2 wa, wb;
                wa.x = cvtpk(c0[4 * q] * rs * ga.x, c0[4 * q + 1] * rs * ga.y); wa.y = cvtpk(c0[4 * q + 2] * rs * ga.z, c0[4 * q + 3] * rs * ga.w);
                wb.x = cvtpk(c1[4 * q] * rs * gb.x, c1[4 * q + 1] * rs * gb.y); wb.y = cvtpk(c1[4 * q + 2] * rs * gb.z, c1[4 * q + 3] * rs * gb.w);
                *(u32x2*)(dst + e0) = wa; *(u32x2*)(dst + 32 + e0) = wb;
            }
        }
    } else {
#pragma unroll 4
        for (int s = 0; s < 128; ++s) {
            const bf16x8 tf = *(const bf16x8*)(ta + 16 * s), w0 = *(const bf16x8*)(wa0 + 16 * s), w1 = *(const bf16x8*)(wa1 + 16 * s);
            c0 = NMFMA32(tf, w0, c0); c1 = NMFMA32(tf, w1, c1);
        }
        const float b0 = scr[r32], b1 = scr[32 + r32];
#pragma unroll
        for (int G = 0; G < 2; ++G) {
            u32x4 va, vb;
            va.x = cvtpk(c0[8 * G] + b0, c0[8 * G + 1] + b0); va.y = cvtpk(c0[8 * G + 2] + b0, c0[8 * G + 3] + b0); va.z = cvtpk(c0[8 * G + 4] + b0, c0[8 * G + 5] + b0); va.w = cvtpk(c0[8 * G + 6] + b0, c0[8 * G + 7] + b0);
            vb.x = cvtpk(c1[8 * G] + b1, c1[8 * G + 1] + b1); vb.y = cvtpk(c1[8 * G + 2] + b1, c1[8 * G + 3] + b1); vb.z = cvtpk(c1[8 * G + 4] + b1, c1[8 * G + 5] + b1); vb.w = cvtpk(c1[8 * G + 6] + b1, c1[8 * G + 7] + b1);
            *(u32x4*)(p.VCT + ((size_t)g * 64 + r32) * 1024 + n0 + 16 * G + 8 * hi) = va;
            *(u32x4*)(p.VCT + ((size_t)g * 64 + 32 + r32) * 1024 + n0 + 16 * G + 8 * hi) = vb;
        }
    }
    asm volatile("s_waitcnt lgkmcnt(0)" ::: "memory");
}

__device__ __forceinline__ void vslt_job(const MKP& p, int job, int lane) {
    const int g = job >> 8, blk = job & 255;
    const bf16_t* v = p.KV6 + (size_t)(3 * 2 + g) * S_ * 64 + (size_t)blk * 64 * 64 + lane;
    unsigned pk[32];
#pragma unroll
    for (int ch = 0; ch < 2; ++ch)
#pragma unroll
        for (int u = 0; u < 4; ++u)
#pragma unroll
            for (int jj = 0; jj < 4; ++jj) {
                const int j0 = 2 * jj, j1 = 2 * jj + 1;
                const int k0 = 32 * ch + ((j0 < 4) ? 4 * u + j0 : 16 + 4 * u + (j0 - 4)), k1 = 32 * ch + ((j1 < 4) ? 4 * u + j1 : 16 + 4 * u + (j1 - 4));
                pk[ch * 16 + u * 4 + jj] = (unsigned)v[(size_t)k0 * 64] | ((unsigned)v[(size_t)k1 * 64] << 16);
            }
    u32x4* dst = (u32x4*)(p.VSLT + (((size_t)g * 256 + blk) * 64 + lane) * 64);
#pragma unroll
    for (int q = 0; q < 8; ++q) dst[q] = (u32x4){pk[4 * q], pk[4 * q + 1], pk[4 * q + 2], pk[4 * q + 3]};
}

constexpr int IMP_LD = 272;
__device__ __forceinline__ void cmp_wave(const MKP& p, int g, int t0w, LAS float* imp, LAS unsigned char* stg, int lane) {
    const int r32 = lane & 31, hi = lane >> 5;
    const int tq = t0w + (r32 >> 2), head = g * 4 + (r32 & 3);
    const int nmax = (tq >= 31) ? ((tq - 31) >> 4) : -1;
    const int nmaxw = (t0w + 7 >= 31) ? ((t0w + 7 - 31) >> 4) : -1;
    const int ntile = (nmaxw >> 6) + 1;
    for (int i = lane; i < 8 * IMP_LD; i += 64) imp[i] = 0.f;
    bf16x8 qr[4];
#pragma unroll
    for (int d0 = 0; d0 < 4; ++d0) qr[d0] = *(const bf16x8*)(p.QN + (size_t)tq * 512 + head * 64 + d0 * 16 + hi * 8);
    const bf16_t* kc = p.KCMP + (size_t)g * 1024 * 64 + (size_t)r32 * 64 + 8 * hi;
    bf16x8 ovf[4];
#pragma unroll
    for (int ks = 0; ks < 4; ++ks)
#pragma unroll
        for (int j = 0; j < 8; ++j) {
            const int nrel = 16 * ks + ((j < 4) ? 4 * hi + j : 8 + 4 * hi + (j - 4));
            const int dlt = nrel - 4 * r32;
            const float w = (dlt >= 0 && dlt <= 2) ? 2.f : ((dlt == 3 || dlt == -1) ? 1.f : 0.f);
            ovf[ks][j] = (short)f2bf(w);
        }
    float m = -INFINITY, l = 0.f;
    for (int c = 0; c < ntile; ++c) {
        f32x16 s0 = f32x16{}, s1 = f32x16{};
        const bf16_t* kt = kc + (size_t)c * 64 * 64;
#pragma unroll
        for (int d0 = 0; d0 < 4; ++d0) { const bf16x8 k0 = *(const bf16x8*)(kt + 16 * d0), k1 = *(const bf16x8*)(kt + 32 * 64 + 16 * d0); s0 = NMFMA32(k0, qr[d0], s0); s1 = NMFMA32(k1, qr[d0], s1); }
        const int x = nmax - 64 * c - 4 * hi;
        float tm = -INFINITY;
#pragma unroll
        for (int r = 0; r < 16; ++r) { const int cc = (r & 3) + 8 * (r >> 2); if (cc > x) s0[r] = -INFINITY; if (cc + 32 > x) s1[r] = -INFINITY; tm = fmaxf(tm, fmaxf(s0[r], s1[r])); }
        if (tm > m) { l *= __builtin_amdgcn_exp2f(m - tm); m = tm; }
        if (m > -INFINITY) {
            float sum = 0.f;
#pragma unroll
            for (int r = 0; r < 16; ++r) sum += __builtin_amdgcn_exp2f(s0[r] - m) + __builtin_amdgcn_exp2f(s1[r] - m);
            l += sum;
        }
    }
    { auto rm = __builtin_amdgcn_permlane32_swap(__float_as_uint(m), __float_as_uint(m), false, false);
      auto rl = __builtin_amdgcn_permlane32_swap(__float_as_uint(l), __float_as_uint(l), false, false);
      const float ma = __uint_as_float(rm[0]), mb = __uint_as_float(rm[1]), la = __uint_as_float(rl[0]), lb = __uint_as_float(rl[1]);
      const float mm = fmaxf(ma, mb);
      if (mm > -INFINITY) { l = ((ma > -INFINITY) ? la * __builtin_amdgcn_exp2f(ma - mm) : 0.f) + ((mb > -INFINITY) ? lb * __builtin_amdgcn_exp2f(mb - mm) : 0.f); m = mm; }
      else { l = 0.f; m = 0.f; } }
    const float invl = (l > 0.f) ? 1.f / l : 0.f;
    f32x16 o0 = f32x16{}, o1 = f32x16{};
    const bf16_t* vc = p.VCT + (size_t)g * 64 * 1024 + (size_t)r32 * 1024 + 8 * hi;
    for (int c = 0; c < ntile; ++c) {
        f32x16 s0 = f32x16{}, s1 = f32x16{};
        const bf16_t* kt = kc + (size_t)c * 64 * 64;
#pragma unroll
        for (int d0 = 0; d0 < 4; ++d0) { const bf16x8 k0 = *(const bf16x8*)(kt + 16 * d0), k1 = *(const bf16x8*)(kt + 32 * 64 + 16 * d0); s0 = NMFMA32(k0, qr[d0], s0); s1 = NMFMA32(k1, qr[d0], s1); }
        const int x = nmax - 64 * c - 4 * hi;
#pragma unroll
        for (int r = 0; r < 16; ++r) { const int cc = (r & 3) + 8 * (r >> 2);
            s0[r] = (cc > x) ? 0.f : __builtin_amdgcn_exp2f(s0[r] - m) * invl; s1[r] = (cc + 32 > x) ? 0.f : __builtin_amdgcn_exp2f(s1[r] - m) * invl; }
        u32x4 pw[4];
        pw[0] = (u32x4){cvtpk(s0[0], s0[1]), cvtpk(s0[2], s0[3]), cvtpk(s0[4], s0[5]), cvtpk(s0[6], s0[7])};
        pw[1] = (u32x4){cvtpk(s0[8], s0[9]), cvtpk(s0[10], s0[11]), cvtpk(s0[12], s0[13]), cvtpk(s0[14], s0[15])};
        pw[2] = (u32x4){cvtpk(s1[0], s1[1]), cvtpk(s1[2], s1[3]), cvtpk(s1[4], s1[5]), cvtpk(s1[6], s1[7])};
        pw[3] = (u32x4){cvtpk(s1[8], s1[9]), cvtpk(s1[10], s1[11]), cvtpk(s1[12], s1[13]), cvtpk(s1[14], s1[15])};
        f32x16 im = f32x16{};
        const bf16_t* vt = vc + c * 64;
#pragma unroll
        for (int ks = 0; ks < 4; ++ks) {
            const bf16x8 pa = __builtin_bit_cast(bf16x8, pw[ks]);
            const bf16x8 v0 = *(const bf16x8*)(vt + 16 * ks), v1 = *(const bf16x8*)(vt + 32 * 1024 + 16 * ks);
            o0 = NMFMA32(pa, v0, o0); o1 = NMFMA32(pa, v1, o1); im = NMFMA32(pa, ovf[ks], im);
        }
        if (r32 <= 16 && 16 * c + r32 < 256) {
#pragma unroll
            for (int k = 0; k < 4; ++k) { const float v = (im[4 * k] + im[4 * k + 1]) + (im[4 * k + 2] + im[4 * k + 3]); atomicAdd((float*)(imp + (2 * k + hi) * IMP_LD + 16 * c + r32), v); }
        }
    }
    { bf16_t* st = (bf16_t*)stg; bf16_t* stl = st + (4 * hi) * 64 + r32;
#pragma unroll
      for (int r = 0; r < 16; ++r) { stl[((r & 3) + 8 * (r >> 2)) * 64] = f2bf(o0[r]); stl[((r & 3) + 8 * (r >> 2)) * 64 + 32] = f2bf(o1[r]); }
      asm volatile("s_waitcnt lgkmcnt(0)" ::: "memory");
#pragma unroll
      for (int i = 0; i < 4; ++i) { const int row = i * 8 + (lane >> 3), ch = lane & 7; const u32x4 v = *(const u32x4*)(st + row * 64 + ch * 8);
          *(u32x4*)(p.OCMP + (size_t)(t0w + (row >> 2)) * 512 + (g * 4 + (row & 3)) * 64 + ch * 8) = v; }
      asm volatile("s_waitcnt lgkmcnt(0)" ::: "memory"); }
}

__device__ __forceinline__ void select_wave(int t0w, const LAS float* imp, LAS int* sel, int lane) {
#pragma unroll 1
    for (int tk = 0; tk < 8; ++tk) {
        const int tq = t0w + tk, cur = tq >> 6;
        float v[4];
#pragma unroll
        for (int i = 0; i < 4; ++i) { const int j = lane + 64 * i; float x = imp[tk * IMP_LD + j]; if (j == 0 || j == cur || j == cur - 1) x += 1e6f; v[i] = (j <= cur) ? x : -INFINITY; }
#pragma unroll 1
        for (int it = 0; it < 16; ++it) {
            float bv = v[0]; int bj = lane;
#pragma unroll
            for (int i = 1; i < 4; ++i) if (v[i] > bv) { bv = v[i]; bj = lane + 64 * i; }
#pragma unroll
            for (int o = 1; o < 64; o <<= 1) { const float ov = __shfl_xor(bv, o); const int oj = __shfl_xor(bj, o); if (ov > bv || (ov == bv && oj < bj)) { bv = ov; bj = oj; } }
            const bool any = bv > -INFINITY;
            if (lane == 0) sel[tk * 16 + it] = any ? bj : -1;
            if (any && (bj & 63) == lane) {
#pragma unroll
                for (int i = 0; i < 4; ++i) if ((bj >> 6) == i) v[i] = -INFINITY;
            }
        }
    }
    asm volatile("s_waitcnt lgkmcnt(0)" ::: "memory");
}

__device__ __forceinline__ void slc_token(const MKP& p, int g, int tq, const LAS int* selt, int lane) {
    const int c16 = lane & 15, u = lane >> 4;
    bf16x8 q0 = (bf16x8){0, 0, 0, 0, 0, 0, 0, 0}, q1 = q0;
    if (c16 < 4) { const bf16_t* qp = p.QN + (size_t)tq * 512 + (g * 4 + c16) * 64 + 8 * u; q0 = *(const bf16x8*)qp; q1 = *(const bf16x8*)(qp + 32); }
    const bf16_t* kb = p.KV6 + (size_t)(2 * 2 + g) * S_ * 64 + (size_t)c16 * 64 + 8 * u;
    const bf16_t* vb = p.VSLT + (size_t)g * 256 * 4096 + (size_t)c16 * 64 + 8 * u;
    float m = -INFINITY, l = 0.f;
    f32x4 o[4]; o[0] = o[1] = o[2] = o[3] = (f32x4){0.f, 0.f, 0.f, 0.f};
    const int cur = tq >> 6;
#pragma unroll 1
    for (int it = 0; it < 16; ++it) {
        const int blk = selt[it];
        if (blk < 0) break;
        const bf16_t* kp = kb + (size_t)blk * 64 * 64;
        f32x4 s[4];
#pragma unroll
        for (int kg = 0; kg < 4; ++kg) {
            const bf16x8 a0 = *(const bf16x8*)(kp + kg * 16 * 64), a1 = *(const bf16x8*)(kp + kg * 16 * 64 + 32);
            f32x4 c = (f32x4){0.f, 0.f, 0.f, 0.f};
            c = NMFMA16(a0, q0, c); c = NMFMA16(a1, q1, c);
            s[kg] = c;
        }
        if (blk == cur) {
            const int x = tq - 64 * blk - 4 * u;
#pragma unroll
            for (int kg = 0; kg < 4; ++kg) { if (16 * kg > x) s[kg].x = -INFINITY; if (16 * kg + 1 > x) s[kg].y = -INFINITY; if (16 * kg + 2 > x) s[kg].z = -INFINITY; if (16 * kg + 3 > x) s[kg].w = -INFINITY; }
        }
        float tm = -INFINITY;
#pragma unroll
        for (int kg = 0; kg < 4; ++kg) tm = fmaxf(tm, fmaxf(fmaxf(s[kg].x, s[kg].y), fmaxf(s[kg].z, s[kg].w)));
        tm = fmaxf(tm, __shfl_xor(tm, 16)); tm = fmaxf(tm, __shfl_xor(tm, 32));
        float alpha = 1.f;
        if (tm > m) { alpha = __builtin_amdgcn_exp2f(m - tm); m = tm; }
        l *= alpha;
        float sum = 0.f;
#pragma unroll
        for (int kg = 0; kg < 4; ++kg) { s[kg].x = __builtin_amdgcn_exp2f(s[kg].x - m); s[kg].y = __builtin_amdgcn_exp2f(s[kg].y - m); s[kg].z = __builtin_amdgcn_exp2f(s[kg].z - m); s[kg].w = __builtin_amdgcn_exp2f(s[kg].w - m);
            sum += (s[kg].x + s[kg].y) + (s[kg].z + s[kg].w); }
        l += sum;
        { const float a0 = RLF(alpha, 0), a1 = RLF(alpha, 1), a2 = RLF(alpha, 2), a3 = RLF(alpha, 3);
#pragma unroll
          for (int dg = 0; dg < 4; ++dg) { o[dg].x *= a0; o[dg].y *= a1; o[dg].z *= a2; o[dg].w *= a3; } }
        const bf16_t* vp = vb + (size_t)blk * 4096;
#pragma unroll
        for (int ch = 0; ch < 2; ++ch) {
            u32x4 pw; pw.x = cvtpk(s[2 * ch].x, s[2 * ch].y); pw.y = cvtpk(s[2 * ch].z, s[2 * ch].w); pw.z = cvtpk(s[2 * ch + 1].x, s[2 * ch + 1].y); pw.w = cvtpk(s[2 * ch + 1].z, s[2 * ch + 1].w);
            const bf16x8 pa = __builtin_bit_cast(bf16x8, pw);
#pragma unroll
            for (int dg = 0; dg < 4; ++dg) { const bf16x8 vf = *(const bf16x8*)(vp + dg * 1024 + ch * 32); o[dg] = NMFMA16(pa, vf, o[dg]); }
        }
    }
    l += __shfl_xor(l, 16); l += __shfl_xor(l, 32);
    const float il = (l > 0.f) ? 1.f / l : 0.f;
    const float i0 = RLF(il, 0), i1 = RLF(il, 1), i2 = RLF(il, 2), i3 = RLF(il, 3);
    if (lane < 16) {
        const float* gt = p.GATES + (size_t)tq * 24 + g * 12;
#pragma unroll
        for (int r = 0; r < 4; ++r) {
            const float gc = 1.f / (1.f + __expf(-gt[3 * r])), gs = 1.f / (1.f + __expf(-gt[3 * r + 1])), gw = 1.f / (1.f + __expf(-gt[3 * r + 2]));
            const float ir = (r == 0) ? i0 : (r == 1) ? i1 : (r == 2) ? i2 : i3;
            const size_t col = (size_t)tq * 512 + (g * 4 + r) * 64 + lane;
#pragma unroll
            for (int dg = 0; dg < 4; ++dg) {
                const float os = ((r == 0) ? o[dg].x : (r == 1) ? o[dg].y : (r == 2) ? o[dg].z : o[dg].w) * ir;
                const float v = gs * os + gc * bf2f(p.OCMP[col + 16 * dg]) + gw * bf2f(p.OWIN[col + 16 * dg]);
                p.OATT[(size_t)tq * 1024 + (g * 4 + r) * 64 + 16 * dg + lane] = f2bf(v);
            }
        }
    }
}

__device__ __forceinline__ void nsa_unit(const MKP& p, char* shm, int g, int tile) {
    int tid_ = threadIdx.x; asm volatile("" : "+v"(tid_));
    const int tid = tid_, lane = tid & 63, r32 = lane & 31; const int wid = __builtin_amdgcn_readfirstlane(tid >> 6);
    const int t0 = tile * 64;
    {   att::UnitArgs A;
        A.qrow = p.QN + (size_t)(t0 + 8 * wid + (r32 >> 2)) * 512 + (g * 4 + (r32 & 3)) * 64;
        A.K = p.KV6 + (size_t)(4 * 2 + g) * S_ * 64; A.V = p.KV6 + (size_t)(5 * 2 + g) * S_ * 64; A.kvpitch = 64; A.vpitch = 64;
        A.obase = p.OWIN + (size_t)t0 * 512 + g * 256; A.opitch = 512;
        A.qtok = 8 * wid + (r32 >> 2); A.abase = tile;
        const int real = (tile + 1 < 9) ? tile + 1 : 9; int nt = (real + 1) & ~1; if (nt < 4) nt = 4;
        A.nsteps = nt; A.bias = nullptr;
        att::attn_unit<att::MODE_WIN, true, 8, 64>(A, shm);
    }
    LAS unsigned char* l3 = (LAS unsigned char*)shm;
    LAS float* imp = (LAS float*)(l3 + wid * (8 * IMP_LD * 4));
    LAS int* sel = (LAS int*)(l3 + 8 * (8 * IMP_LD * 4) + wid * 512);
    LAS unsigned char* stg = l3 + 8 * (8 * IMP_LD * 4) + 8 * 512 + wid * 4096;
    const int t0w = t0 + 8 * wid;
    cmp_wave(p, g, t0w, imp, stg, lane);
    asm volatile("s_waitcnt vmcnt(0) lgkmcnt(0)" ::: "memory");
    select_wave(t0w, imp, sel, lane);
#pragma unroll 1
    for (int tk = 0; tk < 8; ++tk) slc_token(p, g, t0w + tk, sel + tk * 16, lane);
    asm volatile("s_waitcnt vmcnt(0) lgkmcnt(0)\n\ts_barrier" ::: "memory");
}
#undef NMFMA32
#undef NMFMA16
#undef RLF
}

__device__ __forceinline__ void phase_prologue(const MKP& p, LAS unsigned char* lds) {
    const int tid = threadIdx.x, lane = tid & 63, wave = tid >> 6;
    const int gw = blockIdx.x * 8 + wave, NGW = gridDim.x * 8;
    LAS float* scr = (LAS float*)(lds + wave * 16384);
    for (int it = gw; it < 8 * 192; it += NGW) {
        const int kc = it / 192, ch = it % 192, idx = ch * 64 + lane, l = idx / 6144, n = idx % 6144;
        const float* w = p.in[5] + (size_t)l * 1024 * 6144 + n;
        const float* c = p.in[1];
        float acc = 0.f;
#pragma unroll 8
        for (int k = kc * 128; k < kc * 128 + 128; ++k) { const float cv = c[k]; acc += (cv / (1.f + __expf(-cv))) * w[(size_t)k * 6144]; }
        p.modpart[kc * 12288 + idx] = acc;
    }
    if (blockIdx.x == 1 && tid < 128) p.gcnt[tid] = 0;
    if (blockIdx.x == 0 && tid < 96 + 48 + 64) {
        BlkDesc d; d.dst = nullptr; d.gain = nullptr; d.pitch = 0; d.flags = 4; d.scale = 1.f; d.csoff = 0;
        if (tid < 96) {
            const int blk = (tid >> 3) * 4 + ((tid >> 2) & 1) * 2 + ((tid >> 1) & 1);
            d.flags = 0;
            if (blk < 8) { d.dst = p.QN + blk * 64; d.pitch = 512; d.gain = p.in[9]; d.flags = 1; d.scale = C2Q; }
            else if (blk < 20) { const int j = (blk - 8) >> 1, g = (blk - 8) & 1; d.dst = p.KV6 + (size_t)(j * 2 + g) * S_ * 64; d.pitch = 64;
                d.gain = (j == 2 || j == 4) ? p.in[10] : nullptr; d.flags = (j == 0 || j == 2 || j == 4) ? 1 : 0; }
            else if (blk < 28) { d.dst = p.FQ + (blk - 20) * 64; d.pitch = 512; d.gain = p.in[13]; d.scale = C2Q; }
            else if (blk < 36) { d.dst = p.FK + (blk - 28) * 64; d.pitch = 512; d.gain = p.in[14]; }
            else if (blk < 44) { d.dst = p.FV + (blk - 36) * 64; d.pitch = 512; }
            else if (blk == 44) d.flags = 2;
            else d.flags = 4;
            p.desc0[tid] = d;
        } else if (tid < 96 + 48) {
            const int e = tid - 96, pn = e >> 3, bj = (e >> 2) & 1, wc = e & 3;
            if (pn < 4) { const int h = pn * 4 + bj * 2 + (wc >> 1); d.dst = p.Q96 + (size_t)h * S_ * 96; d.pitch = 96; d.gain = p.in[21]; d.flags = 0; d.scale = C2M; }
            else { const int h = (pn - 4) * 8 + bj * 4 + wc; d.dst = p.Q96 + (size_t)h * S_ * 96 + 64; d.pitch = 96; d.gain = p.in[23]; d.flags = 1 | 8; d.scale = C2M; d.csoff = 32; }
            p.desc_uq[e] = d;
        } else {
            const int e = tid - 144, pn = e >> 3, bj = (e >> 2) & 1, wc = e & 3;
            const int h = (pn & 3) * 4 + bj * 2 + (wc >> 1);
            if (pn < 4) { d.dst = p.K96 + (size_t)h * S_ * 96; d.pitch = 96; d.gain = p.in[22]; d.flags = 0; }
            else { d.dst = p.V1 + (size_t)h * S_ * 64; d.pitch = 64; d.gain = nullptr; d.flags = 0; }
            p.desc_ukv[e] = d;
        }
    }
    for (int idx = blockIdx.x * MK_THREADS + tid; idx < S_ * 48; idx += gridDim.x * MK_THREADS) {
        const int t = idx / 48, i = idx % 48;
        const double ex = (i < 32) ? (double)(2 * i) / 64.0 : (double)(2 * (i - 32)) / 32.0;
        const double a = (double)p.pos[t] * exp(-ex * 9.210340371976184);
        const double r = a - rint(a * 0.15915494309189535) * 6.283185307179586;
        const float rf = (float)r;
        p.cosT[idx] = cosf(rf); p.sinT[idx] = sinf(rf);
    }
    for (int it = gw; it < 2 * 32 * 2; it += NGW) { const int kv = it >> 6, r = it & 63; tr_item(p.in[12] + (size_t)kv * 2048 * 64, 64, 2048, p.WcT + (size_t)kv * 64 * 2048, scr, r >> 1, r & 1, lane, MapId(), nullptr); }
    constexpr int I_IN0 = 16 * 96, I_OUT0 = 16 * 32, I_IN1 = 16 * 24, I_UQ = 6 * 48, I_UKV = 4 * 64, I_OUT1 = 16 * 32;
    for (int it = gw; it < I_IN0 + I_OUT0 + I_IN1 + I_UQ + I_UKV + I_OUT1; it += NGW) {
        int r = it;
        if (r < I_IN0) { tr_item(p.in[7], HYIN, 1024, p.W_in0t, scr, r / 96, r % 96, lane, MapIn0(), nullptr); continue; } r -= I_IN0;
        if (r < I_OUT0) { tr_item(p.in[15], 1024, 1024, p.W_out0t, scr, r / 32, r % 32, lane, MapId(), nullptr); continue; } r -= I_OUT0;
        if (r < I_IN1) { tr_item(p.in[16], 672, 1024, p.W_in1t, scr, r / 24, r % 24, lane, MapIn1(), nullptr); continue; } r -= I_IN1;
        if (r < I_UQ) { tr_item(p.in[19], 1536, 384, p.W_uqt, scr, r / 48, r % 48, lane, MapUq(), p.in[17]); continue; } r -= I_UQ;
        if (r < I_UKV) { tr_item(p.in[20], 2048, 256, p.W_ukvt, scr, r / 64, r % 64, lane, MapUkv(), p.in[18]); continue; } r -= I_UKV;
        tr_item(p.in[25], 1024, 1024, p.W_out1t, scr, r / 32, r % 32, lane, MapId(), nullptr);
    }
}

__device__ __forceinline__ void phase_norm(const MKP& p, LAS unsigned char* lds, const float* x, const float* gw_, int layer, int sc_idx, int sh_idx, bool finalize_mod) {
    const int tid = threadIdx.x, lane = tid & 63, wave = tid >> 6;
    LAS float* msc = (LAS float*)(lds + LDS_MOD);
    LAS float* msh = msc + 1024;
    const float* b_ada = p.in[6];
    if (finalize_mod) {
        for (int i = tid; i < 2048; i += MK_THREADS) {
            const int idx = layer * 6144 + ((i < 1024) ? sc_idx * 1024 + i : sh_idx * 1024 + (i - 1024));
            float a = b_ada[idx];
#pragma unroll
            for (int kc = 0; kc < 8; ++kc) a += p.modpart[kc * 12288 + idx];
            msc[i] = a;
        }
        for (int idx = blockIdx.x * MK_THREADS + tid; idx < 12288; idx += gridDim.x * MK_THREADS) {
            float a = b_ada[idx];
#pragma unroll
            for (int kc = 0; kc < 8; ++kc) a += p.modpart[kc * 12288 + idx];
            p.mod[idx] = a;
        }
    } else {
        for (int i = tid; i < 2048; i += MK_THREADS)
            msc[i] = p.mod[layer * 6144 + ((i < 1024) ? sc_idx * 1024 + i : sh_idx * 1024 + (i - 1024))];
    }
    __syncthreads();
    const int gwv = blockIdx.x * 8 + wave, NGW = gridDim.x * 8;
    for (int m = gwv; m < S_; m += NGW) {
        const f32x4* xr = (const f32x4*)(x + (size_t)m * D_) + lane;
        f32x4 v[4]; float s = 0.f;
#pragma unroll
        for (int j = 0; j < 4; ++j) { v[j] = xr[64 * j]; s += (v[j].x * v[j].x + v[j].y * v[j].y) + (v[j].z * v[j].z + v[j].w * v[j].w); }
        s = wsum(s);
        const float rstd = rsqrtf(s * (1.f / D_) + EPSF);
        u32x2* o8 = (u32x2*)(p.XN + (size_t)m * D_) + lane;
#pragma unroll
        for (int j = 0; j < 4; ++j) {
            const int c0 = 256 * j + 4 * lane;
            const f32x4 g = *(const f32x4*)(gw_ + c0);
            const f32x4 sc = *(const LAS f32x4*)(msc + c0), sh = *(const LAS f32x4*)(msh + c0);
            const f32x4 y = v[j] * rstd * g * (sc + 1.f) + sh;
            u32x2 w; w.x = cvtpk(y.x, y.y); w.y = cvtpk(y.z, y.w);
            o8[64 * j] = w;
        }
    }
}

struct EpiResid {
    const float* xin; float* out; const float* gate;
    __device__ __forceinline__ void operator()(const f32x4 (&acc)[2][2][4][2], const pg::Unit& u, int wid, int wr, int wc, int fr_, int fq_) const {
        int fr = fr_, fq = fq_; asm volatile("" : "+v"(fr), "+v"(fq));
        const int col0 = u.pn * 256 + wc * 32 + 4 * fq;
        f32x4 g[2][2];
#pragma unroll
        for (int bj = 0; bj < 2; ++bj)
#pragma unroll
            for (int n = 0; n < 2; ++n) g[bj][n] = *(const f32x4*)(gate + col0 + bj * 128 + n * 16);
#pragma unroll
        for (int ai = 0; ai < 2; ++ai)
#pragma unroll
            for (int m = 0; m < 4; ++m) {
                const size_t off = (size_t)(u.pm * 256 + ai * 128 + wr * 64 + m * 16 + fr) * 1024 + col0;
#pragma unroll
                for (int bj = 0; bj < 2; ++bj)
#pragma unroll
                    for (int n = 0; n < 2; ++n) {
                        const f32x4 xv = *(const f32x4*)(xin + off + bj * 128 + n * 16);
                        *(f32x4*)(out + off + bj * 128 + n * 16) = xv + g[bj][n] * acc[ai][bj][m][n];
                    }
                asm volatile("" ::: "memory");
            }
    }
};

struct EpiHeads {
    const BlkDesc* tab; const float* cosT; const float* sinT; float* GATES; float* LOGF; LAS float* X;
    __device__ __forceinline__ void operator()(const f32x4 (&acc)[2][2][4][2], const pg::Unit& u, int wid, int wr, int wc, int fr_, int fq_) const {
        int fr = fr_, fq = fq_; asm volatile("" : "+v"(fr), "+v"(fq));
        const int w1 = wc & 1;
#pragma unroll
        for (int ai = 0; ai < 2; ++ai)
#pragma unroll
            for (int bj = 0; bj < 2; ++bj)
#pragma unroll
                for (int m = 0; m < 4; ++m) {
                    const f32x4 a = acc[ai][bj][m][0], b = acc[ai][bj][m][1];
                    float s = (a.x * a.x + a.y * a.y) + (a.z * a.z + a.w * a.w) + (b.x * b.x + b.y * b.y) + (b.z * b.z + b.w * b.w);
                    s += __shfl_xor(s, 16); s += __shfl_xor(s, 32);
                    if (fq == 0) X[wid * 256 + ((ai * 2 + bj) * 4 + m) * 16 + fr] = s;
                }
        asm volatile("s_waitcnt lgkmcnt(0)" ::: "memory"); __builtin_amdgcn_s_barrier(); asm volatile("" ::: "memory");
#pragma unroll
        for (int bj = 0; bj < 2; ++bj) {
            const BlkDesc d = tab[8 * u.pn + 4 * bj + wc];
            const int row0 = u.pm * 256 + wr * 64 + fr;
            if (d.flags & 4) continue;
            if (d.flags & 2) {
                if (w1 == 0) {
#pragma unroll
                    for (int ai = 0; ai < 2; ++ai)
#pragma unroll
                        for (int m = 0; m < 4; ++m) {
                            const int row = row0 + ai * 128 + m * 16;
#pragma unroll
                            for (int n = 0; n < 2; ++n) {
                                const f32x4 v = acc[ai][bj][m][n];
                                const int pc = 16 * n + 4 * fq;
                                if (pc < 24) *(f32x4*)(GATES + (size_t)row * 24 + pc) = v;
                                else *(f32x4*)(LOGF + (size_t)row * 8 + (pc - 24)) = v;
                            }
                            asm volatile("" ::: "memory");
                        }
                }
                continue;
            }
            const bool half = (d.flags & 8) != 0, has_gain = d.gain != nullptr, rope = (d.flags & 1) != 0;
            const int d0 = half ? 4 * fq : 16 * w1 + 4 * fq;
            const int dn1 = half ? 16 : 32;
            const float invn = half ? (1.f / 32.f) : (1.f / 64.f);
            const GAS float* gp = (const GAS float*)(has_gain ? d.gain : cosT);
            f32x4 g0 = *(const GAS f32x4*)(gp + d0), g1 = *(const GAS f32x4*)(gp + dn1 + d0);
            if (!has_gain) { g0 = (f32x4){1.f, 1.f, 1.f, 1.f}; g1 = g0; }
            g0 = g0 * d.scale; g1 = g1 * d.scale;
            const int cso = d.csoff + d0;
#pragma unroll
            for (int ai = 0; ai < 2; ++ai)
#pragma unroll
                for (int m = 0; m < 4; ++m) {
                    const int row = row0 + ai * 128 + m * 16;
                    const int xi = ((ai * 2 + bj) * 4 + m) * 16 + fr;
                    float ssq = X[wid * 256 + xi]; const float ssp = X[(wid ^ 1) * 256 + xi];
                    if (!half) ssq += ssp;
                    const float rs = has_gain ? rsqrtf(ssq * invn + EPSF) : 1.f;
                    f32x4 x1 = acc[ai][bj][m][0] * rs * g0, x2 = acc[ai][bj][m][1] * rs * g1;
                    f32x4 c = *(const f32x4*)(cosT + (size_t)row * 48 + cso), sn = *(const f32x4*)(sinT + (size_t)row * 48 + cso);
                    if (!rope) { c = (f32x4){1.f, 1.f, 1.f, 1.f}; sn = (f32x4){0.f, 0.f, 0.f, 0.f}; }
                    const f32x4 o1 = x1 * c - x2 * sn, o2 = x2 * c + x1 * sn;
                    u32x2 wa, wb; wa.x = cvtpk(o1.x, o1.y); wa.y = cvtpk(o1.z, o1.w); wb.x = cvtpk(o2.x, o2.y); wb.y = cvtpk(o2.z, o2.w);
                    GAS bf16_t* dr = (GAS bf16_t*)d.dst + (size_t)row * d.pitch + d0;
                    *(GAS u32x2*)dr = wa; *(GAS u32x2*)(dr + dn1) = wb;
                    asm volatile("" ::: "memory");
                }
        }
    }
};

struct EpiPlain {
    bf16_t* O; int ldc;
    __device__ __forceinline__ void operator()(const f32x4 (&acc)[2][2][4][2], const pg::Unit& u, int wid, int wr, int wc, int fr_, int fq_) const {
        int fr = fr_, fq = fq_; asm volatile("" : "+v"(fr), "+v"(fq));
        const int col0 = u.pn * 256 + wc * 32 + 4 * fq;
#pragma unroll
        for (int ai = 0; ai < 2; ++ai)
#pragma unroll
            for (int m = 0; m < 4; ++m) {
                bf16_t* rp = O + (size_t)(u.pm * 256 + ai * 128 + wr * 64 + m * 16 + fr) * ldc + col0;
#pragma unroll
                for (int bj = 0; bj < 2; ++bj)
#pragma unroll
                    for (int n = 0; n < 2; ++n) { const f32x4 v = acc[ai][bj][m][n]; u32x2 w; w.x = cvtpk(v.x, v.y); w.y = cvtpk(v.z, v.w); *(u32x2*)(rp + bj * 128 + n * 16) = w; }
            }
    }
};

__device__ __forceinline__ void phase_post1a(const MKP& p) {
    int tid_ = threadIdx.x; asm volatile("" : "+v"(tid_));
    const int tid = tid_, lane = tid & 63, wave = tid >> 6;
    const int gwv = blockIdx.x * 8 + wave, NGW = gridDim.x * 8;
    for (int t = gwv; t < S_; t += NGW) {
        const u32x2* row = (const u32x2*)(p.P1 + (size_t)t * 768);
        f32x4 v[3]; float sq = 0.f, skv = 0.f, skr = 0.f;
#pragma unroll
        for (int j = 0; j < 3; ++j) {
            const int g = lane + 64 * j;
            f32x4 x = (f32x4){0.f, 0.f, 0.f, 0.f};
            if (g < 168) { const u32x2 w = row[g]; x.x = __uint_as_float(w.x << 16); x.y = __uint_as_float(w.x & 0xffff0000u); x.z = __uint_as_float(w.y << 16); x.w = __uint_as_float(w.y & 0xffff0000u); }
            v[j] = x;
            const float s = (x.x * x.x + x.y * x.y) + (x.z * x.z + x.w * x.w);
            if (g < 96) sq += s; else if (g < 160) skv += s; else skr += s;
        }
        sq = wsum(sq); skv = wsum(skv); skr = wsum(skr);
        const float rq = rsqrtf(sq * (1.f / 384.f) + EPSF), rkv = rsqrtf(skv * (1.f / 256.f) + EPSF), rkr = rsqrtf(skr * (1.f / 32.f) + EPSF);
#pragma unroll
        for (int j = 0; j < 3; ++j) {
            const int g = lane + 64 * j;
            if (g < 96) { const f32x4 y = v[j] * rq; u32x2 w; w.x = cvtpk(y.x, y.y); w.y = cvtpk(y.z, y.w); *(u32x2*)(p.CQN + (size_t)t * 384 + 4 * g) = w; }
            else if (g < 160) { const f32x4 y = v[j] * rkv; u32x2 w; w.x = cvtpk(y.x, y.y); w.y = cvtpk(y.z, y.w); *(u32x2*)(p.CKVN + (size_t)t * 256 + 4 * (g - 96)) = w; }
        }
        {
            const int dl = (lane - 32) & 7;
            const int dd = 4 * dl;
            const int fi = 4 * (dl & 3);
            f32x4 x = v[2] * rkr;
            const f32x4 gn = *(const f32x4*)(p.in[24] + (dd & 31));
            x = x * gn;
            f32x4 o; o.x = __shfl_xor(x.x, 4); o.y = __shfl_xor(x.y, 4); o.z = __shfl_xor(x.z, 4); o.w = __shfl_xor(x.w, 4);
            const f32x4 c = *(const f32x4*)(p.cosT + (size_t)t * 48 + 32 + fi), sn = *(const f32x4*)(p.sinT + (size_t)t * 48 + 32 + fi);
            const f32x4 y = (dl < 4) ? (x * c - o * sn) : (x * c + o * sn);
            if (lane >= 32 && lane < 40) {
                u32x2 w; w.x = cvtpk(y.x, y.y); w.y = cvtpk(y.z, y.w);
#pragma unroll
                for (int h = 0; h < 16; ++h) *(u32x2*)(p.K96 + ((size_t)h * S_ + t) * 96 + 64 + dd) = w;
            }
        }
    }
}

__device__ __forceinline__ void mla_unit(const MKP& p, char* shm, int h, int qb) {
    int tid_ = threadIdx.x; asm volatile("" : "+v"(tid_));
    const int tid = tid_, lane = tid & 63, r32 = lane & 31; const int wid = __builtin_amdgcn_readfirstlane(tid >> 6);
    const int q0 = qb * 256;
    att::UnitArgs A;
    A.qrow = p.Q96 + ((size_t)h * S_ + q0 + 32 * wid + r32) * 96;
    A.K = p.K96 + (size_t)h * S_ * 96; A.kvpitch = 96; A.V = p.V1 + (size_t)h * S_ * 64; A.vpitch = 64;
    A.obase = p.OATT + (size_t)q0 * 1024 + h * 64; A.opitch = 1024;
    A.qtok = 32 * wid + r32; A.abase = 4 * qb; A.nsteps = 4 * qb + 4; A.bias = nullptr;
    att::attn_unit<att::MODE_CAUSAL, false, 8, 96>(A, shm);
}
__device__ __forceinline__ void phase_mla(const MKP& p, char* shm) {
    const int G = gridDim.x, bx = blockIdx.x;
    const int vcu = (G % 8 == 0) ? (bx % 8) * (G / 8) + bx / 8 : bx;
    for (int u = vcu; u < 256; u += G) {
        const int h = u >> 4, s = u & 15;
#pragma unroll 1
        for (int rep = 0; rep < 4; ++rep) mla_unit(p, shm, h, rep == 0 ? s : rep == 1 ? 31 - s : rep == 2 ? 32 + s : 63 - s);
    }
}

__device__ __forceinline__ void phase_scan(const MKP& p, LAS unsigned char* lds) {
    if (blockIdx.x >= 8) {
        int tid_ = threadIdx.x; asm volatile("" : "+v"(tid_));
        const int lane = tid_ & 63, wave = tid_ >> 6;
        const int gw = (blockIdx.x - 8) * 8 + wave, NGW = (gridDim.x - 8) * 8;
        LAS float* scr = (LAS float*)(lds + wave * 256);
        for (int j = gw; j < 128 + 512; j += NGW) { if (j < 128) nsa::compress_job(p, scr, j, lane); else nsa::vslt_job(p, j - 128, lane); }
        return;
    }
    const int h = blockIdx.x, tid = threadIdx.x;
    LAS double* part = (LAS double*)lds;
    const float fb = p.in[8][h];
    double s = 0.0;
    for (int i = 0; i < 32; ++i) s += (double)logsigmf(p.LOGF[(size_t)(tid * 32 + i) * 8 + h] + fb);
    part[tid] = s;
    __syncthreads();
    for (int o = 1; o < MK_THREADS; o <<= 1) {
        const double v = (tid >= o) ? part[tid - o] : 0.0;
        __syncthreads();
        part[tid] += v;
        __syncthreads();
    }
    double a = (tid > 0) ? part[tid - 1] : 0.0;
    for (int i = 0; i < 32; ++i) { a += (double)logsigmf(p.LOGF[(size_t)(tid * 32 + i) * 8 + h] + fb); p.CUMB[(size_t)h * S_ + tid * 32 + i] = (float)(a * 1.4426950408889634); }
}

__device__ __forceinline__ void fox_unit(const MKP& p, char* shm, int h, int qb) {
    int tid_ = threadIdx.x; asm volatile("" : "+v"(tid_));
    const int tid = tid_, lane = tid & 63, r32 = lane & 31; const int wid = __builtin_amdgcn_readfirstlane(tid >> 6);
    const int q0 = qb * 256, abase = 4 * qb;
    const float* cb = p.CUMB + (size_t)h * S_;
    LAS float* bias = (LAS float*)(LAS unsigned char*)(shm + att::LDS_BIAS);
    LAS int* cnt = (LAS int*)(LAS unsigned char*)(shm + att::Geo<64>::LDS_WS);
    float gq = 0.f, gk = 0.f;
    for (int i = 0; i < 64; ++i) { gq = fmaxf(gq, fabsf(p.in[13][i])); gk = fmaxf(gk, fabsf(p.in[14][i])); }
    const float TH = 150.f + 2.f * (64.f * gq * gk * C2Q * 1.05f);
    const float c0 = cb[q0], cref = cb[q0 + 255];
    const bool skip = (tid < abase) && (cb[64 * tid + 63] - c0 > TH);
    const unsigned long long bal = __ballot(skip);
    if (lane == 0) cnt[wid] = __popcll(bal);
    __syncthreads();
    int alo = 0;
#pragma unroll
    for (int w = 0; w < 8; ++w) alo += cnt[w];
    int NT = abase + 4 - alo;
    if (NT & 1) { alo -= 1; NT += 1; }
    for (int i = tid; i < NT * 64; i += MK_THREADS) bias[i] = cref - cb[64 * alo + i];
    __syncthreads();
    att::UnitArgs A;
    A.qrow = p.FQ + (size_t)(q0 + 32 * wid + r32) * 512 + h * 64;
    A.K = p.FK + h * 64; A.V = p.FV + h * 64; A.kvpitch = 512; A.vpitch = 512;
    A.obase = p.OATT + (size_t)q0 * 1024 + 512 + h * 64; A.opitch = 1024;
    A.qtok = 32 * wid + r32; A.abase = abase; A.nsteps = NT; A.bias = bias;
    att::attn_unit<att::MODE_FOX, false, 8, 64>(A, shm);
}
__device__ __forceinline__ void phase_fox(const MKP& p, char* shm) {
    const int G = gridDim.x, bx = blockIdx.x;
    const int vcu = (G % 8 == 0) ? (bx % 8) * (G / 8) + bx / 8 : bx;
    for (int u = vcu; u < 256; u += G) {
        const int h = u >> 5, s = u & 31;
#pragma unroll 1
        for (int rep = 0; rep < 2; ++rep) fox_unit(p, shm, h, rep ? 63 - s : s);
    }
    if (p.dbg_flags & 1) return;
    for (int u = vcu; u < 256; u += G) {
#pragma unroll 1
        for (int rep = 0; rep < 2; ++rep) nsa::nsa_unit(p, shm, rep, rep ? 255 - u : u);
    }
}


struct MapOff { int off; __device__ __forceinline__ int operator()(int nn) const { return off + (nn & 31); } };
__device__ __forceinline__ void phase_moe_weights(const MKP& p, LAS unsigned char* lds, int layer) {
    int tid_ = threadIdx.x; asm volatile("" : "+v"(tid_));
    const int tid = tid_, lane = tid & 63, wave = tid >> 6;
    const int gw = blockIdx.x * 8 + wave, NGW = gridDim.x * 8;
    LAS float* scr = (LAS float*)(lds + wave * 16384);
    constexpr int IG = 16 * 16, ID = 4 * 32, IE = IG + ID;
    for (int it = gw; it < 65 * IE; it += NGW) {
        const int e = it / IE; int r = it % IE;
        if (r < IG) {
            const int kb = r / 16, nb = r % 16;
            const int n0 = nb * 32, up = (n0 >> 7) & 1, f0 = (n0 >> 8) * 128 + (n0 & 127);
            const float* W = (e < 64) ? ((up ? p.in[29] : p.in[28]) + ((size_t)layer * 64 + e) * 1024 * 256) : ((up ? p.in[32] : p.in[31]) + (size_t)layer * 1024 * 256);
            MapOff mo{f0};
            tr_item(W, 256, 1024, p.Wgu + (size_t)e * 512 * 1024, scr, kb, nb, lane, mo, nullptr);
        } else {
            r -= IG; const int kb = r / 32, nb = r % 32;
            const float* W = (e < 64) ? (p.in[30] + ((size_t)layer * 64 + e) * 256 * 1024) : (p.in[33] + (size_t)layer * 256 * 1024);
            tr_item(W, 1024, 256, p.Wd + (size_t)e * 1024 * 256, scr, kb, nb, lane, MapId(), nullptr);
        }
    }
}

template <bool COMBINE>
__device__ __forceinline__ void phase_moe_route(const MKP& p, LAS unsigned char* lds, int layer) {
    int tid_ = threadIdx.x; asm volatile("" : "+v"(tid_));
    const int tid = tid_, lane = tid & 63, wave = tid >> 6;
    LAS float* msc = (LAS float*)(lds + LDS_MOD);
    LAS float* msh = msc + 1024;
    LAS float* hrow = (LAS float*)lds;
    LAS int* cntl = (LAS int*)(lds + LDS_X);
    LAS int* basel = cntl + 64;
    const float* gnorm = p.in[4] + layer * 1024;
    const float* wr = p.in[26] + (size_t)layer * 1024 * 64;
    const float rb = p.in[27][layer * 64 + lane];
    for (int i = tid; i < 2048; i += MK_THREADS) msc[i] = p.mod[layer * 6144 + ((i < 1024) ? 4 * 1024 + i : 3 * 1024 + (i - 1024))];
    __syncthreads();
    for (int batch = blockIdx.x; batch < S_ / 32; batch += gridDim.x) {
        if (tid < 64) cntl[tid] = 0;
#pragma unroll 1
        for (int i = 0; i < 4; ++i) {
            const int t = batch * 32 + wave * 4 + i;
            const f32x4* xr = (const f32x4*)(p.out + (size_t)t * D_) + lane;
            f32x4 v[4]; float s = 0.f;
#pragma unroll
            for (int j = 0; j < 4; ++j) { v[j] = xr[64 * j]; s += (v[j].x * v[j].x + v[j].y * v[j].y) + (v[j].z * v[j].z + v[j].w * v[j].w); }
            s = wsum(s);
            const float rstd = rsqrtf(s * (1.f / D_) + EPSF);
            u32x2* o8 = (u32x2*)(p.XN + (size_t)t * D_) + lane;
            LAS f32x4* hr = (LAS f32x4*)(hrow + (wave * 4 + i) * 1024) + lane;
#pragma unroll
            for (int j = 0; j < 4; ++j) {
                const int c0 = 256 * j + 4 * lane;
                const f32x4 g = *(const f32x4*)(gnorm + c0);
                const f32x4 sc = *(const LAS f32x4*)(msc + c0), sh = *(const LAS f32x4*)(msh + c0);
                const f32x4 y = v[j] * rstd * g * (sc + 1.f) + sh;
                u32x2 w; w.x = cvtpk(y.x, y.y); w.y = cvtpk(y.z, y.w);
                o8[64 * j] = w; hr[64 * j] = y;
            }
        }
        __syncthreads();
        float acc0 = 0.f, acc1 = 0.f, acc2 = 0.f, acc3 = 0.f;
        const LAS float* h0 = hrow + (wave * 4) * 1024;
#pragma unroll 4
        for (int k = 0; k < 1024; k += 4) {
            const float w0 = wr[(k + 0) * 64 + lane], w1 = wr[(k + 1) * 64 + lane], w2 = wr[(k + 2) * 64 + lane], w3 = wr[(k + 3) * 64 + lane];
            const f32x4 a = *(const LAS f32x4*)(h0 + k), b = *(const LAS f32x4*)(h0 + 1024 + k), c = *(const LAS f32x4*)(h0 + 2048 + k), d = *(const LAS f32x4*)(h0 + 3072 + k);
            acc0 += a.x * w0; acc0 += a.y * w1; acc0 += a.z * w2; acc0 += a.w * w3;
            acc1 += b.x * w0; acc1 += b.y * w1; acc1 += b.z * w2; acc1 += b.w * w3;
            acc2 += c.x * w0; acc2 += c.y * w1; acc2 += c.z * w2; acc2 += c.w * w3;
            acc3 += d.x * w0; acc3 += d.y * w1; acc3 += d.z * w2; acc3 += d.w * w3;
        }
        int myrank[4], mypos[4]; float myw[4];
#pragma unroll
        for (int i = 0; i < 4; ++i) {
            const float logit = (i == 0) ? acc0 : (i == 1) ? acc1 : (i == 2) ? acc2 : acc3;
            const float score = 1.f / (1.f + expf(-logit));
            const float sv = score + rb;
            float m1 = sv;
            m1 = fmaxf(m1, __shfl_xor(m1, 1)); m1 = fmaxf(m1, __shfl_xor(m1, 2)); m1 = fmaxf(m1, __shfl_xor(m1, 4));
            int am = (sv == m1) ? (lane & 7) : 8;
            am = min(am, __shfl_xor(am, 1)); am = min(am, __shfl_xor(am, 2)); am = min(am, __shfl_xor(am, 4));
            float m2 = ((lane & 7) == am) ? -INFINITY : sv;
            m2 = fmaxf(m2, __shfl_xor(m2, 1)); m2 = fmaxf(m2, __shfl_xor(m2, 2)); m2 = fmaxf(m2, __shfl_xor(m2, 4));
            const float gs = m1 + m2;
            const int gi = lane >> 3; int grank = 0;
#pragma unroll
            for (int gj = 0; gj < 8; ++gj) { const float o = __shfl(gs, gj * 8); grank += (o > gs || (o == gs && gj < gi)) ? 1 : 0; }
            const float msk = (grank < 4) ? sv : -1e30f;
            int rank = 0;
#pragma unroll 8
            for (int e = 0; e < 64; ++e) { const float o = __shfl(msk, e); rank += (o > msk || (o == msk && e < lane)) ? 1 : 0; }
            const bool selb = rank < 8;
            const float tot = wsum(selb ? score : 0.f);
            myrank[i] = selb ? rank : -1; myw[i] = score / tot * 2.5f;
            mypos[i] = selb ? atomicAdd((int*)(cntl + lane), 1) : 0;
        }
        __syncthreads();
        if (tid < 64) basel[tid] = (cntl[tid] > 0) ? atomicAdd(p.gcnt + layer * 64 + tid, cntl[tid]) : 0;
        __syncthreads();
#pragma unroll
        for (int i = 0; i < 4; ++i) if (myrank[i] >= 0) {
            const int t = batch * 32 + wave * 4 + i, slot = t * 8 + myrank[i];
            p.list[(size_t)lane * 16384 + basel[lane] + mypos[i]] = slot;
            p.ew[slot] = myw[i];
        }
        __syncthreads();
    }
}

struct MoeSched {
    const char* A; const char* Bt; const int* list; const LAS int* ustart; const LAS int* hbase; const LAS int* cnt;
    int K, NP, G, c; bool gather; int nexp;
    __device__ __forceinline__ static void tables(LAS int* ustart, LAS int* hbase, LAS int* cnt, const int* gcnt, int NP) {
        const int tid = threadIdx.x;
        if (tid == 0) {
            int us = 0, hb = 0;
            for (int e = 0; e < 65; ++e) { const int c = (e < 64) ? gcnt[e] : S_; const int nrb = (c + 255) >> 8; cnt[e] = c; ustart[e] = us; hbase[e] = hb; us += nrb * NP; hb += nrb * 256; }
            ustart[65] = us; hbase[65] = hb;
        }
        __syncthreads();
    }
    __device__ __forceinline__ bool next(int i, pg::Unit& u, int R0, int C0) const {
        const int L = i * G + c; if (L >= ustart[nexp]) return false;
        const int lane = threadIdx.x & 63;
        const unsigned long long bal = __ballot(lane < 65 && ustart[lane] <= L);
        int e = __popcll(bal) - 1; if (ustart[64] <= L) e = 64;
        const int r = L - ustart[e], rb = r / NP, pn = r % NP;
        u.pm = (hbase[e] >> 8) + rb; u.pn = pn; u.aux = e | (rb << 8);
        u.B = Bt + ((size_t)e * NP + pn) * 256 * K * 2;
        if (gather) {
            u.A = A; const int ce = cnt[e];
#pragma unroll
            for (int q = 0; q < 4; ++q) { const int pos = rb * 256 + R0 + 64 * q; int tok = 0; if (pos < ce) tok = (e < 64) ? (list[(size_t)e * 16384 + pos] >> 3) : pos; u.ra[q] = (unsigned)(tok * K + C0) * 2u; }
        } else {
            u.A = A + (size_t)u.pm * 256 * K * 2;
#pragma unroll
            for (int q = 0; q < 4; ++q) u.ra[q] = (unsigned)((R0 + 64 * q) * K + C0) * 2u;
        }
        return true;
    }
};
struct EpiGateUp {
    bf16_t* HID;
    __device__ __forceinline__ void operator()(const f32x4 (&acc)[2][2][4][2], const pg::Unit& u, int wid, int wr, int wc, int fr_, int fq_) const {
        int fr = fr_, fq = fq_; asm volatile("" : "+v"(fr), "+v"(fq));
        const int col0 = u.pn * 128 + wc * 32 + 4 * fq;
#pragma unroll
        for (int ai = 0; ai < 2; ++ai)
#pragma unroll
            for (int m = 0; m < 4; ++m) {
                bf16_t* rp = HID + (size_t)(u.pm * 256 + ai * 128 + wr * 64 + m * 16 + fr) * 256 + col0;
#pragma unroll
                for (int n = 0; n < 2; ++n) {
                    const f32x4 g = acc[ai][0][m][n], up = acc[ai][1][m][n];
                    f32x4 h; h.x = g.x / (1.f + __expf(-g.x)) * up.x; h.y = g.y / (1.f + __expf(-g.y)) * up.y; h.z = g.z / (1.f + __expf(-g.z)) * up.z; h.w = g.w / (1.f + __expf(-g.w)) * up.w;
                    u32x2 w; w.x = cvtpk(h.x, h.y); w.y = cvtpk(h.z, h.w); *(u32x2*)(rp + n * 16) = w;
                }
            }
    }
};
struct EpiDown {
    bf16_t* YBUF; const int* list; const float* ew; const LAS int* cnt;
    __device__ __forceinline__ void operator()(const f32x4 (&acc)[2][2][4][2], const pg::Unit& u, int wid, int wr, int wc, int fr_, int fq_) const {
        int fr = fr_, fq = fq_; asm volatile("" : "+v"(fr), "+v"(fq));
        const int e = u.aux & 0xff, rb = u.aux >> 8, ce = cnt[e];
        const unsigned colb = (unsigned)(u.pn * 256 + wc * 32 + 4 * fq) * 2u;
        const int* le = list + (size_t)e * 16384 + rb * 256 + wr * 64 + fr;
#pragma unroll
        for (int ai = 0; ai < 2; ++ai)
#pragma unroll
            for (int m = 0; m < 4; ++m) {
                const int pr = ai * 128 + m * 16;
                if (rb * 256 + wr * 64 + fr + pr < ce) {
                    const int slot = le[pr]; const float w = ew[slot];
                    char* rp = (char*)YBUF + ((unsigned)slot * 2048u + colb);
#pragma unroll
                    for (int bj = 0; bj < 2; ++bj)
#pragma unroll
                        for (int n = 0; n < 2; ++n) { const f32x4 v = acc[ai][bj][m][n] * w; u32x2 o; o.x = cvtpk(v.x, v.y); o.y = cvtpk(v.z, v.w); *(u32x2*)(rp + bj * 256 + n * 32) = o; }
                }
                asm volatile("" ::: "memory");
            }
    }
};
__device__ __forceinline__ void phase_moe_gemm1(const MKP& p, LAS unsigned char* lds, int layer) {
    LAS int* tb = (LAS int*)(lds + LDS_X);
    MoeSched::tables(tb, tb + 66, tb + 132, p.gcnt + layer * 64, 2);
    const int G = gridDim.x, bx = blockIdx.x, vcu = (G % 8 == 0) ? (bx % 8) * (G / 8) + bx / 8 : bx;
    MoeSched S{(const char*)p.XN, (const char*)p.Wgu, p.list, tb, tb + 66, tb + 132, 1024, 2, G, vcu, true, 65};
    EpiGateUp E{p.HID};
    pg::gemm_run(lds, 1024, S, E);
}
__device__ __forceinline__ void phase_moe_gemm2(const MKP& p, LAS unsigned char* lds, int layer) {
    LAS int* tb = (LAS int*)(lds + LDS_X);
    MoeSched::tables(tb, tb + 66, tb + 132, p.gcnt + layer * 64, 4);
    const int G = gridDim.x, bx = blockIdx.x, vcu = (G % 8 == 0) ? (bx % 8) * (G / 8) + bx / 8 : bx;
    { MoeSched S{(const char*)p.HID, (const char*)p.Wd, p.list, tb, tb + 66, tb + 132, 256, 4, G, vcu, false, 64};
      EpiDown E{p.YBUF, p.list, p.ew, tb + 132};
      pg::gemm_run(lds, 256, S, E); }
    {
      pg::DenseSched S; S.init(p.HID + (size_t)tb[66 + 64] * 256, p.Wd + (size_t)64 * 1024 * 256, S_, 1024, 256, G, bx);
      EpiResid E{p.out, p.out, p.mod + layer * 6144 + 5 * 1024};
      pg::gemm_run(lds, 256, S, E); }
}
__device__ __forceinline__ void phase_moe_combine(const MKP& p, int layer) {
    int tid_ = threadIdx.x; asm volatile("" : "+v"(tid_));
    const int tid = tid_, lane = tid & 63, wave = tid >> 6;
    const int gwv = blockIdx.x * 8 + wave, NGW = gridDim.x * 8;
    const float* g2 = p.mod + layer * 6144 + 5 * 1024;
    for (int t = gwv; t < S_; t += NGW) {
        f32x4* xr = (f32x4*)(p.out + (size_t)t * D_) + lane;
#pragma unroll
        for (int j = 0; j < 4; ++j) {
            f32x4 s = (f32x4){0.f, 0.f, 0.f, 0.f};
#pragma unroll
            for (int k = 0; k < 8; ++k) {
                const u32x2 w = *((const u32x2*)(p.YBUF + ((size_t)t * 8 + k) * 1024) + lane + 64 * j);
                s.x += __uint_as_float(w.x << 16); s.y += __uint_as_float(w.x & 0xffff0000u); s.z += __uint_as_float(w.y << 16); s.w += __uint_as_float(w.y & 0xffff0000u);
            }
            const f32x4 g = *(const f32x4*)(g2 + 256 * j + 4 * lane);
            xr[64 * j] = xr[64 * j] + g * s;
        }
    }
}

#define XB_TMO      128
#define XB_XCNT(j)  (256  + 64 * (j))
#define XB_XSUB(j)  (1280 + 64 * (j))
#define XB_XGEN(j)  (2304 + 64 * (j))
#define XB_TOP      3328
#define XB_TOPGEN   3392
#define XCD_BAR_WORDS 3456
#define XB_SPIN_CAP (1u << 22)
__device__ __forceinline__ unsigned xb_ld(unsigned* p)              { return __hip_atomic_load(p, __ATOMIC_RELAXED, __HIP_MEMORY_SCOPE_AGENT); }
__device__ __forceinline__ unsigned xb_add(unsigned* p, unsigned v) { return __hip_atomic_fetch_add(p, v, __ATOMIC_RELAXED, __HIP_MEMORY_SCOPE_AGENT); }
__device__ __forceinline__ unsigned xb_xcc_id() { return (unsigned)__builtin_amdgcn_s_getreg((3 << 11) | 20) & 0xFu; }
#define XB_SPIN(cond, bar) do { unsigned _sp = 0; while (cond) { __builtin_amdgcn_s_sleep(1); \
    if ((++_sp & 255u) == 0u) { if (xb_ld(&(bar)[XB_TMO])) break; if (_sp > XB_SPIN_CAP) { atomicAdd(&(bar)[XB_TMO], 1u); break; } } } } while (0)
struct XcdBarrier { unsigned* bar; unsigned x; volatile LAS unsigned* st; };
__device__ __forceinline__ XcdBarrier xcd_barrier_post(unsigned* bar, volatile LAS unsigned* st) {
    XcdBarrier b; b.bar = bar; b.x = xb_xcc_id(); b.st = st;
    if (threadIdx.x == 0) (void)xb_add(&bar[XB_XCNT(b.x)], 1u);
    return b;
}
__device__ __forceinline__ void xcd_barrier_complete(unsigned* bar, unsigned x, unsigned& nloc, unsigned& nx) {
    const unsigned G = gridDim.x * gridDim.y * gridDim.z;
    unsigned sum, cnt, mine, sp = 0u;
    for (;;) {
        sum = 0u; cnt = 0u; mine = 0u;
#pragma unroll
        for (unsigned j = 0; j < 16; ++j) { const unsigned c = xb_ld(&bar[XB_XCNT(j)]); sum += c; cnt += (c > 0u) ? 1u : 0u; mine = (j == x) ? c : mine; }
        if (sum == G) break;
        __builtin_amdgcn_s_sleep(1);
        if ((++sp & 255u) == 0u) { if (xb_ld(&bar[XB_TMO])) break; if (sp > XB_SPIN_CAP) { atomicAdd(&bar[XB_TMO], 1u); break; } }
    }
    nloc = mine > 0u ? mine : 1u; nx = cnt > 0u ? cnt : 1u;
}
__device__ __forceinline__ void xcd_barrier(const XcdBarrier& b) {
    asm volatile("s_waitcnt vmcnt(0)" ::: "memory");
    __syncthreads();
    if (threadIdx.x == 0) {
        unsigned* bar = b.bar;
        __builtin_amdgcn_s_waitcnt(0);
        unsigned nloc = b.st[0], nx = b.st[1];
        if (nloc == 0u) { xcd_barrier_complete(bar, b.x, nloc, nx); b.st[0] = nloc; b.st[1] = nx; }
        const unsigned old = xb_add(&bar[XB_XSUB(b.x)], 1u);
        const unsigned gen = old / nloc;
        if (old + 1u == (gen + 1u) * nloc) {
            __builtin_amdgcn_fence(__ATOMIC_RELEASE, "agent");
            asm volatile("s_waitcnt vmcnt(0)" ::: "memory");
            const unsigned og = xb_add(&bar[XB_TOP], 1u);
            const unsigned tg = og / nx;
            if (og + 1u == (tg + 1u) * nx) xb_add(&bar[XB_TOPGEN], 1u);
            else XB_SPIN(xb_ld(&bar[XB_TOPGEN]) == tg, bar);
            __builtin_amdgcn_fence(__ATOMIC_ACQUIRE, "agent");
            xb_add(&bar[XB_XGEN(b.x)], 1u);
            asm volatile("s_waitcnt vmcnt(0)" ::: "memory");
        } else {
            XB_SPIN(xb_ld(&bar[XB_XGEN(b.x)]) == gen, bar);
            __builtin_amdgcn_fence(__ATOMIC_ACQUIRE, "agent");
            asm volatile("s_waitcnt vmcnt(0)" ::: "memory");
        }
    }
    __syncthreads();
}

__global__ void __launch_bounds__(MK_THREADS, 2) mega(MKP p) {
    extern __shared__ __attribute__((aligned(16))) unsigned char lds_raw[];
    LAS unsigned char* lds = (LAS unsigned char*)lds_raw;
    const int lo = p.ph_lo, hi = p.ph_hi;
    const bool multi = hi - lo > 1;
    volatile LAS unsigned* bst = (volatile LAS unsigned*)(lds + LDS_BARST);
    XcdBarrier bar; bar.bar = p.barw; bar.x = 0; bar.st = bst;
    if (multi) {
        if (threadIdx.x < 2) bst[threadIdx.x] = 0u;
        if (blockIdx.x == 0) for (int i = threadIdx.x; i < XCD_BAR_WORDS; i += MK_THREADS) p.barw[i] = 0u;
    }
    int nbar = 0;
#define IN(k) (lo <= (k) && (k) < hi)
#define SEAM(k) do { if (IN(k) && IN((k) + 1)) { if (nbar == 0) { __threadfence(); cooperative_groups::this_grid().sync(); __builtin_amdgcn_fence(__ATOMIC_ACQUIRE, "agent"); bar = xcd_barrier_post(p.barw, bst); } else xcd_barrier(bar); ++nbar; } } while (0)
    if (IN(0)) { phase_prologue(p, lds); phase_moe_weights(p, lds, 0); }
    SEAM(0);
    if (IN(1)) phase_norm(p, lds, p.in[0], p.in[3], 0, 1, 0, true);
    SEAM(1);
    if (IN(2)) {
        pg::DenseSched S; S.init(p.XN, p.W_in0t, S_, 3072, 1024, gridDim.x, blockIdx.x);
        EpiHeads E{p.desc0, p.cosT, p.sinT, p.GATES, p.LOGF, (LAS float*)(lds + LDS_X)};
        pg::gemm_run(lds, 1024, S, E);
    }
    SEAM(2);
    if (IN(3)) phase_scan(p, lds);
    SEAM(3);
    if (IN(4)) phase_fox(p, (char*)lds_raw);
    SEAM(4);
    if (IN(5)) {
        pg::DenseSched S; S.init(p.OATT, p.W_out0t, S_, 1024, 1024, gridDim.x, blockIdx.x);
        EpiResid E{p.in[0], p.out, p.mod + 2 * 1024};
        pg::gemm_run(lds, 1024, S, E);
    }
    SEAM(5);
    if (IN(6)) phase_moe_route<false>(p, lds, 0);
    SEAM(6);
    if (IN(7)) phase_moe_gemm1(p, lds, 0);
    SEAM(7);
    if (IN(8)) phase_moe_gemm2(p, lds, 0);
    SEAM(8);
    if (IN(9)) { phase_moe_combine(p, 0); phase_moe_weights(p, lds, 1); }
    SEAM(9);
    if (IN(10)) phase_norm(p, lds, p.out, p.in[3] + 1024, 1, 1, 0, false);
    SEAM(10);
    if (IN(11)) {
        pg::DenseSched S; S.init(p.XN, p.W_in1t, S_, 768, 1024, gridDim.x, blockIdx.x);
        EpiPlain E{p.P1, 768};
        pg::gemm_run(lds, 1024, S, E);
    }
    SEAM(11);
    if (IN(12)) phase_post1a(p);
    SEAM(12);
    if (IN(13)) {
        { pg::DenseSched S; S.init(p.CQN, p.W_uqt, S_, 1536, 384, gridDim.x, blockIdx.x);
          EpiHeads E{p.desc_uq, p.cosT, p.sinT, nullptr, nullptr, (LAS float*)(lds + LDS_X)};
          pg::gemm_run(lds, 384, S, E); }
        { pg::DenseSched S; S.init(p.CKVN, p.W_ukvt, S_, 2048, 256, gridDim.x, blockIdx.x);
          EpiHeads E{p.desc_ukv, p.cosT, p.sinT, nullptr, nullptr, (LAS float*)(lds + LDS_X)};
          pg::gemm_run(lds, 256, S, E); }
    }
    SEAM(13);
    if (IN(14)) phase_mla(p, (char*)lds_raw);
    SEAM(14);
    if (IN(15)) {
        pg::DenseSched S; S.init(p.OATT, p.W_out1t, S_, 1024, 1024, gridDim.x, blockIdx.x);
        EpiResid E{p.out, p.out, p.mod + 6144 + 2 * 1024};
        pg::gemm_run(lds, 1024, S, E);
    }
    SEAM(15);
    if (IN(16)) phase_moe_route<false>(p, lds, 1);
    SEAM(16);
    if (IN(17)) phase_moe_gemm1(p, lds, 1);
    SEAM(17);
    if (IN(18)) phase_moe_gemm2(p, lds, 1);
    SEAM(18);
    if (IN(19)) phase_moe_combine(p, 1);
#undef IN
#undef SEAM
}
extern "C" void kernel_launch(void* const* d_in, const int* in_sizes, int n_in, void* d_out, int out_size, void* d_ws, size_t ws_size, hipStream_t stream) {
    static int grid = 0;
    if (!grid) {
        int dev = 0, cus = 0, per_cu = 0;
        (void)hipGetDevice(&dev); (void)hipDeviceGetAttribute(&cus, hipDeviceAttributeMultiprocessorCount, dev);
        (void)hipFuncSetAttribute((const void*)mega, hipFuncAttributeMaxDynamicSharedMemorySize, LDS_TOTAL);
        (void)hipOccupancyMaxActiveBlocksPerMultiprocessor(&per_cu, (const void*)mega, MK_THREADS, LDS_TOTAL);
        (void)hipGetLastError();
        grid = (cus > 0 && per_cu >= 1) ? cus : -1;
    }
    if (grid < 0) return;
    constexpr size_t MiB = 1u << 20;
    if (ws_size < 528 * MiB || n_in != 34) return;
    char* wsb = (char*)d_ws;
    float* ws = (float*)d_ws;
    size_t o = 0;
    MKP p{};
    for (int i = 0; i < 34; ++i) p.in[i] = (const float*)d_in[i];
    p.out = (float*)d_out; p.pos = (const int*)d_in[2];
    p.mod = ws + o; o += 2 * 6144;
    p.cosT = ws + o; o += (size_t)S_ * 48;
    p.sinT = ws + o; o += (size_t)S_ * 48;
    p.modpart = ws + o; o += 8 * 12288;
    p.desc0 = (BlkDesc*)(ws + o); o += 96 * 8;
    p.desc_uq = (BlkDesc*)(ws + o); o += 48 * 8;
    p.desc_ukv = (BlkDesc*)(ws + o); o += 64 * 8;
    p.CUMB = ws + o; o += (size_t)8 * S_;
    p.gcnt = (int*)(ws + o); o += 128;
    p.barw = (unsigned*)(ws + o); o += 4096;
    p.ew = ws + o; o += (size_t)S_ * 8;
    p.list = (int*)(ws + o); o += (size_t)64 * 16384;
    p.WcT = (bf16_t*)(ws + o); o += (size_t)2 * 64 * 2048 / 2;
    p.KCMP = (bf16_t*)(ws + o); o += (size_t)2 * 1024 * 64 / 2;
    p.VCT = (bf16_t*)(ws + o); o += (size_t)2 * 64 * 1024 / 2;
    if (o * 4 > 15 * MiB) return;
    p.XN = (bf16_t*)(wsb + 15 * MiB); p.OATT = (bf16_t*)(wsb + 47 * MiB);
    char* big = wsb + 79 * MiB;
    {   bf16_t* b = (bf16_t*)big;
        p.QN = b; b += (size_t)S_ * 512; p.KV6 = b; b += (size_t)12 * S_ * 64; p.FQ = b; b += (size_t)S_ * 512; p.FK = b; b += (size_t)S_ * 512; p.FV = b; b += (size_t)S_ * 512;
        p.GATES = (float*)b; p.LOGF = p.GATES + (size_t)S_ * 24; }
    p.VSLT = (bf16_t*)(big + 96 * MiB); p.OCMP = (bf16_t*)(big + 100 * MiB); p.OWIN = (bf16_t*)(big + 116 * MiB);
    {   bf16_t* b = (bf16_t*)(big + 96 * MiB);
        p.P1 = b; b += (size_t)S_ * 768; p.CQN = b; b += (size_t)S_ * 384; p.CKVN = b; b += (size_t)S_ * 256;
        p.Q96 = b; b += (size_t)16 * S_ * 96; p.K96 = b; b += (size_t)16 * S_ * 96; p.V1 = b; b += (size_t)16 * S_ * 64; }
    p.YBUF = (bf16_t*)big; p.HID = (bf16_t*)(big + 256 * MiB);
    p.Wgu = (bf16_t*)(wsb + 415 * MiB); p.Wd = p.Wgu + (size_t)65 * 512 * 1024;
    {   bf16_t* b = (bf16_t*)(wsb + 513 * MiB);
        p.W_in0t = b; b += (size_t)3072 * 1024; p.W_out0t = b; b += (size_t)1024 * 1024; p.W_in1t = b; b += (size_t)768 * 1024;
        p.W_uqt = b; b += (size_t)1536 * 384; p.W_ukvt = b; b += (size_t)2048 * 256; p.W_out1t = b; b += (size_t)1024 * 1024; }
    p.ph_lo = 0; p.ph_hi = 20;
    void* args[] = {&p};
    (void)hipLaunchCooperativeKernel((const void*)mega, dim3(grid), dim3(MK_THREADS), args, LDS_TOTAL, stream);
}
```

```cpp
#include <hip/hip_runtime.h>
#include <hip/hip_cooperative_groups.h>
#include <stdint.h>

#define S_ 16384
#define D_ 1024
#define HYIN 2848
#define NEXP 64
#define EPSF 1e-6f

__device__ __forceinline__ float wsum(float v) {
#pragma unroll
    for (int o = 32; o > 0; o >>= 1) v += __shfl_xor(v, o);
    return v;
}
__device__ __forceinline__ float sigmf(float x) { return 1.f / (1.f + expf(-x)); }
__device__ __forceinline__ float logsigmf(float x) { return fminf(x, 0.f) - log1pf(expf(-fabsf(x))); }
#define LAS __attribute__((address_space(3)))
#define GAS __attribute__((address_space(1)))
typedef unsigned short bf16_t;
typedef short bf16x8 __attribute__((ext_vector_type(8)));
typedef float f32x4 __attribute__((ext_vector_type(4)));
typedef float f32x2 __attribute__((ext_vector_type(2)));
typedef unsigned u32x4 __attribute__((ext_vector_type(4)));
typedef unsigned u32x2 __attribute__((ext_vector_type(2)));
typedef __bf16 bf16x2_t __attribute__((ext_vector_type(2)));

__device__ __forceinline__ unsigned cvtpk(float lo, float hi) { f32x2 v = {lo, hi}; bf16x2_t b = __builtin_convertvector(v, bf16x2_t); return __builtin_bit_cast(unsigned, b); }
__device__ __forceinline__ float bf2f(bf16_t v) { return __uint_as_float(((unsigned)v) << 16); }
__device__ __forceinline__ bf16_t f2bf(float f) { return (bf16_t)(cvtpk(f, 0.f) & 0xffffu); }

namespace pg {
constexpr int BM = 256, BK = 64, HALF = 128, HTB = HALF * BK * 2, STAGE_BYTES = 8 * HTB;
__device__ __forceinline__ int lds_byte(int r, int c) { const int st = (r >> 4) * 2 + (c >> 5), rr = r & 15, cc = c & 31, ob = rr * 64 + cc * 2; return st * 1024 + (ob ^ (((ob >> 9) & 1) << 5)); }
__device__ __forceinline__ void stage_rc(int b, int& R, int& C) { const int st = b / 1024, sb = b % 1024, swz = sb ^ (((sb >> 9) & 1) << 5); R = (st >> 1) * 16 + swz / 64; C = (st & 1) * 32 + (swz % 64) / 2; }

struct Unit { int pm, pn, aux; const char* A; const char* B; unsigned ra[4]; };

template <class Epi, class Sched>
__device__ __forceinline__ void gemm_run(LAS unsigned char* lds, const int K, const Sched& S, const Epi& E) {
    int tid_ = threadIdx.x; asm volatile("" : "+v"(tid_));
    const int tid = tid_, wid = __builtin_amdgcn_readfirstlane(tid >> 6), lane = tid & 63, wr = wid >> 2, wc = wid & 3, fr = lane & 15, fq = lane >> 4;
    int nt_ = K / BK; asm volatile("" : "+s"(nt_)); const int nt = nt_;
    int R0, C0; stage_rc(tid * 16, R0, C0);
    unsigned voffB[2];
#pragma unroll
    for (int i = 0; i < 2; ++i) voffB[i] = (unsigned)((R0 + 64 * i) * K + C0) * 2u;
    const size_t kstep = (size_t)(BK * 2);
    const size_t hstep = (size_t)HALF * K * 2;
    const unsigned ldsw = (unsigned)wid * 1024u;
    const int aoff = lds_byte(wr * 64 + fr, fq * 8), boff = lds_byte(wc * 32 + fr, fq * 8);
#define PG_SA(b, h) (((b) * 2 + (h)) * HTB)
#define PG_SB(b, h) ((4 + (b) * 2 + (h)) * HTB)
#define PG_STAGE2(bufoff, gbase, v0, v1) do { \
        __builtin_amdgcn_global_load_lds((const unsigned*)((const char*)(gbase) + (v0)), (LAS unsigned*)(lds + (bufoff) + ldsw), 16, 0, 0); \
        __builtin_amdgcn_global_load_lds((const unsigned*)((const char*)(gbase) + (v1)), (LAS unsigned*)(lds + (bufoff) + ldsw + 8192), 16, 0, 0); } while (0)
#define PG_STAGEB(bufoff, gbase) PG_STAGE2(bufoff, gbase, voffB[0], voffB[1])
#define PG_LDA(dst, b, h) do { _Pragma("unroll") for (int m = 0; m < 4; ++m) _Pragma("unroll") for (int k = 0; k < 2; ++k) dst[m][k] = *(const LAS bf16x8*)(lds + PG_SA(b, h) + aoff + m * 2048 + k * 1024); } while (0)
#define PG_LDB(dst, b, h) do { _Pragma("unroll") for (int n = 0; n < 2; ++n) _Pragma("unroll") for (int k = 0; k < 2; ++k) dst[n][k] = *(const LAS bf16x8*)(lds + PG_SB(b, h) + boff + n * 2048 + k * 1024); } while (0)
#define PG_MMA(ai, bj, At, Bt) do { __builtin_amdgcn_s_setprio(1); _Pragma("unroll") for (int m = 0; m < 4; ++m) _Pragma("unroll") for (int n = 0; n < 2; ++n) _Pragma("unroll") for (int k = 0; k < 2; ++k) \
        acc[ai][bj][m][n] = __builtin_amdgcn_mfma_f32_16x16x32_bf16(Bt[n][k], At[m][k], acc[ai][bj][m][n], 0, 0, 0); __builtin_amdgcn_s_setprio(0); } while (0)
#define PG_WAIT_V(n) asm volatile("s_waitcnt vmcnt(" #n ")" ::: "memory")
#define PG_WAIT_L(n) asm volatile("s_waitcnt lgkmcnt(" #n ")" ::: "memory")
#define PG_BAR __builtin_amdgcn_s_barrier()
#define PG_SCHED __builtin_amdgcn_sched_barrier(0)
    Unit cur, nxt; int ui = 0;
    if (!S.next(0, cur, R0, C0)) return;
    f32x4 acc[2][2][4][2];
#pragma unroll
    for (int a = 0; a < 2; ++a)
#pragma unroll
        for (int b = 0; b < 2; ++b)
#pragma unroll
            for (int m = 0; m < 4; ++m)
#pragma unroll
                for (int n = 0; n < 2; ++n) acc[a][b][m][n] = (f32x4){0.f, 0.f, 0.f, 0.f};
    bf16x8 At[4][2], B0[2][2], B1[2][2];
    const char* cA = cur.A; const char* cB = cur.B;
    PG_STAGEB(PG_SB(0, 0), cB); PG_STAGEB(PG_SB(0, 1), cB + hstep); PG_STAGE2(PG_SA(0, 0), cA, cur.ra[0], cur.ra[1]); PG_STAGE2(PG_SA(0, 1), cA, cur.ra[2], cur.ra[3]);
    if (wr == 1) PG_BAR;
    PG_WAIT_V(2); PG_BAR;
    PG_STAGEB(PG_SB(1, 0), cB + kstep); PG_STAGE2(PG_SA(1, 0), cA + kstep, cur.ra[0], cur.ra[1]); PG_STAGEB(PG_SB(1, 1), cB + hstep + kstep);
    PG_WAIT_V(6); PG_BAR;
    for (;;) {
        const bool has_next = S.next(ui + 1, nxt, R0, C0);
        if (!has_next) nxt = cur;
        const char* nA = nxt.A; const char* nB = nxt.B;
#pragma unroll 1
        for (int t = 0; t < nt; t += 2) {
            const bool last = (t == nt - 2);
            const char* a1 = cA + (size_t)(t + 1) * kstep;
            const char* a2 = last ? nA : cA + (size_t)(t + 2) * kstep; const char* b2 = last ? nB : cB + (size_t)(t + 2) * kstep;
            const char* a3 = a2 + kstep; const char* b3 = b2 + kstep;
            const unsigned r0 = last ? nxt.ra[0] : cur.ra[0], r1 = last ? nxt.ra[1] : cur.ra[1], r2 = last ? nxt.ra[2] : cur.ra[2], r3 = last ? nxt.ra[3] : cur.ra[3];
            PG_LDB(B0, 0, 0); PG_LDB(B1, 0, 1); PG_SCHED; PG_LDA(At, 0, 0); PG_STAGE2(PG_SA(1, 1), a1, cur.ra[2], cur.ra[3]);
            PG_WAIT_V(8); PG_WAIT_L(0); PG_BAR; PG_MMA(0, 0, At, B0); PG_MMA(0, 1, At, B1); PG_BAR; PG_SCHED;
            PG_LDA(At, 0, 1); PG_STAGEB(PG_SB(0, 0), b2); PG_STAGEB(PG_SB(0, 1), b2 + hstep); PG_STAGE2(PG_SA(0, 0), a2, r0, r1);
            PG_WAIT_V(8); PG_WAIT_L(0); PG_BAR; PG_MMA(1, 0, At, B0); PG_MMA(1, 1, At, B1); PG_BAR; PG_SCHED;
            PG_LDB(B0, 1, 0); PG_LDB(B1, 1, 1); PG_SCHED; PG_LDA(At, 1, 0); PG_STAGE2(PG_SA(0, 1), a2, r2, r3);
            PG_WAIT_V(8); PG_WAIT_L(0); PG_BAR; PG_MMA(0, 0, At, B0); PG_MMA(0, 1, At, B1); PG_BAR; PG_SCHED;
            PG_LDA(At, 1, 1); PG_STAGEB(PG_SB(1, 0), b3); PG_STAGEB(PG_SB(1, 1), b3 + hstep); PG_STAGE2(PG_SA(1, 0), a3, r0, r1);
            PG_WAIT_V(8); PG_WAIT_L(0); PG_BAR; PG_MMA(1, 0, At, B0); PG_MMA(1, 1, At, B1); PG_BAR; PG_SCHED;
        }
        if (wr == 0) PG_BAR;
        E(acc, cur, wid, wr, wc, fr, fq);
        if (!has_next) break;
#pragma unroll
        for (int a = 0; a < 2; ++a)
#pragma unroll
            for (int b = 0; b < 2; ++b)
#pragma unroll
                for (int m = 0; m < 4; ++m)
#pragma unroll
                    for (int n = 0; n < 2; ++n) acc[a][b][m][n] = (f32x4){0.f, 0.f, 0.f, 0.f};
        cur = nxt; cA = nA; cB = nB; ++ui;
        if (wr == 1) PG_BAR;
    }
    PG_WAIT_V(0);
    PG_BAR;
#undef PG_SA
#undef PG_SB
#undef PG_STAGE2
#undef PG_STAGEB
#undef PG_LDA
#undef PG_LDB
#undef PG_MMA
}

struct DenseSched {
    const char* A; const char* Bt; int K, nM, nN, nwg, G, c;
    __device__ __forceinline__ void init(const void* A_, const void* Bt_, int M, int N, int K_, int G_, int c_) { A = (const char*)A_; Bt = (const char*)Bt_; K = K_; nM = M / BM; nN = N / BM; nwg = nM * nN; G = G_; c = c_; }
    __device__ __forceinline__ bool next(int i, Unit& u, int R0, int C0) const {
        const long L = (long)i * G + c; if (L >= nwg) return false;
        int wgid = (int)L; { const int q = nwg / 8, r = nwg % 8, xcd = wgid % 8, off = wgid / 8; wgid = (xcd < r ? xcd * (q + 1) : r * (q + 1) + (xcd - r) * q) + off; }
        const int nig = 8 * nN, gid = wgid / nig, fm = gid * 8, gsz = (nM - fm) < 8 ? (nM - fm) : 8;
        u.pm = fm + ((wgid % nig) % gsz); u.pn = (wgid % nig) / gsz; u.aux = 0;
        u.A = A + (size_t)u.pm * BM * K * 2; u.B = Bt + (size_t)u.pn * BM * K * 2;
#pragma unroll
        for (int q = 0; q < 4; ++q) u.ra[q] = (unsigned)((R0 + 64 * q) * K + C0) * 2u;
        return true;
    }
};
}
namespace att {
using s16x4 = __attribute__((ext_vector_type(4))) short;
using f32x16 = __attribute__((ext_vector_type(16))) float;
typedef __attribute__((address_space(3))) const char* lds_cptr;
typedef short v4i16_t __attribute__((ext_vector_type(4)));
constexpr int NSLOT = 3, VSLOT = 8192;
template <int DQ> struct Geo {
    static constexpr int NK = DQ / 16;
    static constexpr int KSLOT = (DQ == 64) ? 8192 : 16384;
    static constexpr int QWAVE = (DQ == 64) ? 4096 : 6144;
    static constexpr int LDS_K = 0, LDS_V = NSLOT * KSLOT, LDS_WS = LDS_V + NSLOT * VSLOT, LDS_OST = LDS_WS + 8 * 64 * 4, LDS_BYTES = LDS_OST + 8 * QWAVE;
};
constexpr int LDS_BIAS = Geo<64>::LDS_BYTES;
#define ASBAR() __builtin_amdgcn_sched_barrier(0)
#define AWAIT_BAR(N) asm volatile("s_waitcnt vmcnt(" #N ") lgkmcnt(0)\n\ts_barrier" ::: "memory")
__device__ __forceinline__ int crow(int r, int hi) { return (r & 3) + 8 * (r >> 2) + 4 * hi; }
__device__ __forceinline__ void glds16(const void* gsrc, unsigned lds_dst) { unsigned keep;
    asm volatile("s_mov_b32 %0, m0\n\ts_mov_b32 m0, %2\n\ts_nop 0\n\tglobal_load_lds_dwordx4 %1, off\n\ts_mov_b32 m0, %0" : "=&s"(keep) : "v"(gsrc), "s"(lds_dst) : "memory"); }
__device__ __forceinline__ float fadd_s(float a, float b) { float r; asm("v_add_f32_e32 %0, %1, %2" : "=v"(r) : "v"(a), "v"(b)); return r; }
__device__ __forceinline__ float fsub_s(float a, float b) { float r; asm("v_sub_f32_e32 %0, %1, %2" : "=v"(r) : "v"(a), "v"(b)); return r; }
__device__ __forceinline__ float max3f(float a, float b, float c) { float r; asm("v_max3_f32 %0, %1, %2, %3" : "=v"(r) : "v"(a), "v"(b), "v"(c)); return r; }
__device__ __forceinline__ float max2f(float a, float b) { float r; asm("v_max_f32_e32 %0, %1, %2" : "=v"(r) : "v"(a), "v"(b)); return r; }
__device__ __forceinline__ s16x4 vtr(lds_cptr p) { return __builtin_bit_cast(s16x4, __builtin_amdgcn_ds_read_tr16_b64_v4i16((__attribute__((address_space(3))) v4i16_t*)p)); }
template <int NK> __device__ __forceinline__ void kloadall(bf16x8* kf, lds_cptr kp) {
#pragma unroll
    for (int j = 0; j < NK; ++j) { kf[2 * j] = *(const LAS bf16x8*)(kp + j * 2048); kf[2 * j + 1] = *(const LAS bf16x8*)(kp + j * 2048 + 512); } }
__device__ __forceinline__ void kload2(bf16x8* kf, lds_cptr kp, int j) { kf[2 * j] = *(const LAS bf16x8*)(kp + j * 2048); kf[2 * j + 1] = *(const LAS bf16x8*)(kp + j * 2048 + 512); }
__device__ __forceinline__ void cmask(f32x16& p0, f32x16& p1, int koff, int qtok, int hi) {
    const int x = qtok - koff - 4 * hi;
#pragma unroll
    for (int r = 0; r < 16; ++r) { const int c = (r & 3) + 8 * (r >> 2); if (c > x) p0[r] = -INFINITY; if (c + 32 > x) p1[r] = -INFINITY; }
}
__device__ __forceinline__ void wmask(f32x16& p0, f32x16& p1, int thr, int hi) {
    const int y = thr - 4 * hi;
#pragma unroll
    for (int r = 0; r < 16; ++r) { const int c = (r & 3) + 8 * (r >> 2); if (c < y) p0[r] = -INFINITY; if (c + 32 < y) p1[r] = -INFINITY; }
}
__device__ __forceinline__ float rowmax(const f32x16& p0, const f32x16& p1) {
    float a = max3f(p0[0], p0[1], p1[0]), b = max3f(p0[2], p0[3], p1[1]); a = max3f(a, p1[2], p1[3]);
#pragma unroll
    for (int r = 4; r < 16; r += 4) { a = max3f(a, p0[r], p0[r + 1]); b = max3f(b, p0[r + 2], p0[r + 3]); a = max3f(a, p1[r], p1[r + 1]); b = max3f(b, p1[r + 2], p1[r + 3]); }
    const float m = max2f(a, b);
    auto rr = __builtin_amdgcn_permlane32_swap(__float_as_uint(m), __float_as_uint(m), false, false);
    return max2f(__uint_as_float(rr[0]), __uint_as_float(rr[1]));
}

enum { MODE_CAUSAL = 0, MODE_FOX = 1, MODE_WIN = 2 };
struct UnitArgs {
    const bf16_t* qrow;
    const bf16_t* K; const bf16_t* V; int kvpitch, vpitch;
    bf16_t* obase; int opitch;
    int qtok;
    int abase;
    int nsteps;
    const LAS float* bias;
};

template <int NB> __device__ __forceinline__ int seq(int i, int abase) { return (i < NB) ? abase + i : abase + NB - 1 - i; }

template <int MODE, bool GQA4, int THRL, int DQ>
__device__ __forceinline__ void attn_unit(const UnitArgs& A, char* shm) {
    constexpr int NB = GQA4 ? 1 : 4;
    typedef Geo<DQ> G; constexpr int NK = G::NK, KSLOT = G::KSLOT, LDS_K = G::LDS_K, LDS_V = G::LDS_V, LDS_WS = G::LDS_WS, LDS_OST = G::LDS_OST, QWAVE = G::QWAVE;
    constexpr bool USE_NEGM = (MODE != MODE_FOX) && (DQ == 64);
    int tid_ = threadIdx.x; asm volatile("" : "+v"(tid_));
    const int tid = tid_, lane = tid & 63, r32 = lane & 31, hi = lane >> 5; const int wid = __builtin_amdgcn_readfirstlane(tid >> 6);
    const unsigned lds0 = (unsigned)(uintptr_t)shm;
    float* wsf = (float*)(shm + LDS_WS) + wid * 64;
    const int NT = A.nsteps, abase = A.abase; const long kvp = A.kvpitch, vvp = A.vpitch;
    const bf16_t* ksrc = A.K + (long)lane * kvp + wid * 8;
    const bf16_t* ksrc2 = A.K + (long)lane * kvp + (8 + (wid & 3)) * 8;
    const bf16_t* vsrc = A.V + (long)(16 * (wid & 3) + (lane >> 2)) * vvp + (wid >> 2) * 32 + (lane & 3) * 8;
    const unsigned kdst = lds0 + LDS_K + wid * 1024, vdst = lds0 + LDS_V + wid * 1024, kdst2 = lds0 + LDS_K + (8 + wid) * 1024;
#define TILE_OF(t) ({ int a_ = seq<NB>((t), abase); a_ < 0 ? 0 : a_; })
#define DMA_K(t, slot) do { const long to_ = (long)TILE_OF(t) * 64 * kvp; glds16(ksrc + to_, (unsigned)__builtin_amdgcn_readfirstlane(kdst + (slot) * KSLOT)); \
        if (DQ == 96) glds16(ksrc2 + to_, (unsigned)__builtin_amdgcn_readfirstlane(kdst2 + (slot) * KSLOT)); } while (0)
#define DMA_V(t, slot) glds16(vsrc + (long)TILE_OF(t) * 64 * vvp, (unsigned)__builtin_amdgcn_readfirstlane(vdst + (slot) * VSLOT))
    const lds_cptr shm3 = (lds_cptr)shm; const lds_cptr kp0 = shm3 + LDS_K + hi * 1024 + r32 * 16;
    const lds_cptr vp0 = shm3 + LDS_V + ((lane >> 4) & 1) * 32 + (lane & 3) * 8 + (4 * hi + ((lane & 15) >> 2)) * 64;
    const int vb0 = (int)(lds0 + LDS_V) + ((lane >> 4) & 1) * 32 + (lane & 3) * 8 + (4 * hi + ((lane & 15) >> 2)) * 64;
    DMA_K(0, 0); DMA_V(0, 0); DMA_K(1, 1);
    bf16x8 qr[NK];
#pragma unroll
    for (int d0 = 0; d0 < NK; ++d0) qr[d0] = *reinterpret_cast<const bf16x8*>(A.qrow + d0 * 16 + hi * 8);
    const lds_cptr qlp = shm3 + LDS_OST + wid * QWAVE + hi * 512 + r32 * 16;
    if (DQ == 96) {
#pragma unroll
        for (int d0 = 0; d0 < NK; ++d0) *(LAS bf16x8*)(const_cast<__attribute__((address_space(3))) char*>(qlp) + d0 * 1024) = qr[d0];
    }
#define QL(d0) (*(const LAS bf16x8*)(qlp + (d0) * 1024))
    float mhat = 0.f, l_reg = 0.f; f32x16 o[2]; o[0] = f32x16{}; o[1] = f32x16{};
    f32x16 negm = f32x16{}; if (USE_NEGM) asm volatile("" : "+v"(negm));
    const int qtok = A.qtok;
#define CMASK(P0, P1, t) do { const int t_ = (t); if (t_ < NB) cmask(P0, P1, 64 * t_, qtok, hi); \
        else { const int a_ = abase + NB - 1 - t_; if (a_ < 0) wmask(P0, P1, 64, hi); \
               else if (MODE == MODE_WIN) { const int thr_ = qtok - 511 + 64 * (abase - a_); if (thr_ > 0) wmask(P0, P1, thr_, hi); } } } while (0)
#define CINIT1(C, t, OFF) do { if (MODE == MODE_FOX) { const LAS float* bt_ = A.bias + 64 * (seq<NB>((t), abase) - (abase + NB - NT)) + 4 * hi + (OFF); const float nm_ = -mhat; \
        _Pragma("unroll") for (int g_ = 0; g_ < 4; ++g_) { const f32x4 b_ = *(const LAS f32x4*)(bt_ + 8 * g_); C[4 * g_] = b_.x; C[4 * g_ + 1] = b_.y; C[4 * g_ + 2] = b_.z; C[4 * g_ + 3] = b_.w; } \
        _Pragma("unroll") for (int r_ = 0; r_ < 16; ++r_) C[r_] += nm_; asm volatile("" : "+v"(C)); } \
      else if (USE_NEGM) { C = negm; } \
      else { const float nm_ = -mhat; _Pragma("unroll") for (int r_ = 0; r_ < 16; ++r_) C[r_] = nm_; asm volatile("" : "+v"(C)); } } while (0)
#define CINIT(C0, C1, t) do { CINIT1(C0, t, 0); CINIT1(C1, t, 32); } while (0)
    bool resc = false;
#define START(P0, P1) do { const float rm = rowmax(P0, P1); resc = false; \
    { const float dl = rm; mhat = fadd_s(mhat, dl); \
      _Pragma("unroll") for (int r = 0; r < 16; ++r) { P0[r] = fsub_s(P0[r], dl); P1[r] = fsub_s(P1[r], dl); } \
      if (USE_NEGM) { _Pragma("unroll") for (int r = 0; r < 16; ++r) negm[r] = -mhat; asm volatile("" : "+v"(negm)); } } \
    _Pragma("unroll") for (int r = 0; r < 16; ++r) P0[r] = __builtin_amdgcn_exp2f(P0[r]); } while (0)
#define RESC() do { if (resc) { asm volatile("s_waitcnt lgkmcnt(0)" ::: "memory"); \
      const float* wsh_ = wsf + 4 * hi; \
      _Pragma("unroll") for (int d_ = 0; d_ < 2; ++d_) _Pragma("unroll") for (int r = 0; r < 16; ++r) o[d_][r] *= wsh_[(r & 3) + 8 * (r >> 2)]; } } while (0)
    f32x16 pA0, pA1, pB0, pB1; bf16x8 kf[2 * NK];
    int sl_prev = 0, sl_cur = 0, sl_next = 1;
#define ROT() do { sl_prev = sl_cur; sl_cur = sl_next; sl_next = (sl_next == NSLOT - 1) ? 0 : sl_next + 1; } while (0)
    DMA_K(2, 2);
    if (DQ == 96) { AWAIT_BAR(5); } else { AWAIT_BAR(3); }
    { const char* kb = shm + LDS_K + hi * 1024 + r32 * 16;
      CINIT(pA0, pA1, 0);
#pragma unroll
      for (int d0 = 0; d0 < NK; ++d0) {
          const bf16x8 b0 = *reinterpret_cast<const bf16x8*>(kb + d0 * 2048);
          const bf16x8 b1 = *reinterpret_cast<const bf16x8*>(kb + d0 * 2048 + 512);
          pA0 = __builtin_amdgcn_mfma_f32_32x32x16_bf16(b0, qr[d0], pA0, 0, 0, 0); pA1 = __builtin_amdgcn_mfma_f32_32x32x16_bf16(b1, qr[d0], pA1, 0, 0, 0); } }
    asm volatile("s_nop 15\n\ts_nop 7" : "+v"(pA0), "+v"(pA1)); CMASK(pA0, pA1, 0);
    START(pA0, pA1);
    _Pragma("unroll") for (int r = 0; r < 16; ++r) pA1[r] = __builtin_amdgcn_exp2f(pA1[r]);
    AWAIT_BAR(0);
    DMA_K(3, 0); DMA_V(1, 1);
    ROT();
    kloadall<NK>(kf, kp0 + sl_cur * KSLOT);
    if (DQ == 96) { AWAIT_BAR(3); } else { AWAIT_BAR(2); }
    s16x4 vlo[(DQ == 96) ? 4 : 8], vhi[(DQ == 96) ? 4 : 8]; u32x4 pw0, pw1, pw2, pw3;
#define PKW(P, B) cvtpk(P[B], P[B + 1])
#define PAF(k) __builtin_bit_cast(bf16x8, pw##k)
#define VFR(i) (bf16x8){vlo[i][0], vlo[i][1], vlo[i][2], vlo[i][3], vhi[i][0], vhi[i][1], vhi[i][2], vhi[i][3]}
#define PIN(x) asm volatile("" : "+v"(x))
#define MX3(a, b, c) __builtin_fmaxf(__builtin_fmaxf((a), (b)), (c))
#define GAPA(MF, A0, A1, A2, A3, W0, W1, PW) do { MF; sacc += A0; sacc += A1; sacc += A2; sacc += A3; PIN(sacc); W0; W1; PIN(PW); ASBAR(); } while (0)
#define EX(v) __builtin_amdgcn_exp2f(v)
#define GAPB(MF, X, B) do { MF; X[B] = EX(X[B]); X[B + 1] = EX(X[B + 1]); X[B + 2] = EX(X[B + 2]); X[B + 3] = EX(X[B + 3]); PIN(X); ASBAR(); } while (0)
#define VRD(i) do { vlo[i] = vtr(vp_ + (((i) >> 2) * 4096 + ((i) & 3) * 1024)); vhi[i] = vtr(vp_ + (((i) >> 2) * 4096 + ((i) & 3) * 1024 + 512)); } while (0)
#define KRD(G_, j) do { if (G_) { kload2(kf, kp0 + sl_next * KSLOT, j); ASBAR(); } } while (0)
#define MFMA32(a, b, c) __builtin_amdgcn_mfma_f32_32x32x16_bf16(a, b, c, 0, 0, 0)
#define STEP64(C0, C1, P0, P1, t, GK, GV, GL, DOMASK) do { ASBAR(); \
    const lds_cptr vp_ = vp0 + sl_prev * VSLOT; \
    CINIT1(C0, t, 0); ASBAR(); \
    VRD(0); ASBAR(); float sacc = (P0[0] + P0[1]); \
    GAPA(C0 = MFMA32(kf[0], qr[0], C0), P0[2], P0[3], P0[4], P0[5],     pw0[0] = PKW(P0, 0), pw0[1] = PKW(P0, 2), pw0); \
    CINIT1(C1, t, 32); ASBAR(); \
    VRD(4); ASBAR(); GAPA(C1 = MFMA32(kf[1], qr[0], C1), P0[6], P0[7], P0[8], P0[9],     pw0[2] = PKW(P0, 4), pw0[3] = PKW(P0, 6), pw0); \
    VRD(1); ASBAR(); GAPA(C0 = MFMA32(kf[2], qr[1], C0),   P0[10], P0[11], P0[12], P0[13], pw1[0] = PKW(P0, 8), pw1[1] = PKW(P0, 10), pw1); \
    VRD(5); ASBAR(); GAPA(C1 = MFMA32(kf[3], qr[1], C1),   P0[14], P0[15], P1[0], P1[1],   pw1[2] = PKW(P0, 12), pw1[3] = PKW(P0, 14), pw1); \
    VRD(2); ASBAR(); GAPA(C0 = MFMA32(kf[4], qr[2], C0),   P1[2], P1[3], P1[4], P1[5],     pw2[0] = PKW(P1, 0), pw2[1] = PKW(P1, 2), pw2); \
    VRD(6); ASBAR(); GAPA(C1 = MFMA32(kf[5], qr[2], C1),   P1[6], P1[7], P1[8], P1[9],     pw2[2] = PKW(P1, 4), pw2[3] = PKW(P1, 6), pw2); \
    VRD(3); ASBAR(); GAPA(C0 = MFMA32(kf[6], qr[3], C0),   P1[10], P1[11], P1[12], P1[13], pw3[0] = PKW(P1, 8), pw3[1] = PKW(P1, 10), pw3); \
    VRD(7); ASBAR(); GAPA(C1 = MFMA32(kf[7], qr[3], C1),   P1[14], P1[15], 0.f, 0.f,       pw3[2] = PKW(P1, 12), pw3[3] = PKW(P1, 14), pw3); \
    l_reg += sacc; \
    if (GK) { DMA_K((t) + 3, sl_cur); } if (GV) { DMA_V((t) + 1, sl_next); } \
    if (DOMASK) CMASK(C0, C1, t); \
    { float a = MX3(C0[0], C0[1], C1[0]), b = MX3(C0[2], C0[3], C1[1]); a = MX3(a, C1[2], C1[3]); \
      _Pragma("unroll") for (int r = 4; r < 16; r += 4) { a = MX3(a, C0[r], C0[r + 1]); b = MX3(b, C0[r + 2], C0[r + 3]); a = MX3(a, C1[r], C1[r + 1]); b = MX3(b, C1[r + 2], C1[r + 3]); } \
      float rm = __builtin_fmaxf(a, b); { auto rr = __builtin_amdgcn_permlane32_swap(__float_as_uint(rm), __float_as_uint(rm), false, false); rm = __builtin_fmaxf(__uint_as_float(rr[0]), __uint_as_float(rr[1])); } \
      resc = false; \
      if (__builtin_expect(__any(rm > (float)THRL), 0)) { const float dl = __builtin_fmaxf(rm, 0.f); mhat += dl; \
        _Pragma("unroll") for (int r = 0; r < 16; ++r) { C0[r] -= dl; C1[r] -= dl; } \
        if (USE_NEGM) { _Pragma("unroll") for (int r = 0; r < 16; ++r) negm[r] = -mhat; asm volatile("" : "+v"(negm)); } \
        const float f = __builtin_amdgcn_exp2f(-dl); l_reg *= f; if (hi == 0) wsf[r32] = f; resc = true; } } \
    ASBAR(); \
    GAPB(o[0] = MFMA32(PAF(0), VFR(0), o[0]), C0, 0); \
    GAPB(o[1] = MFMA32(PAF(0), VFR(4), o[1]), C0, 4); \
    KRD(GL, 0); GAPB(o[0] = MFMA32(PAF(1), VFR(1), o[0]), C0, 8); \
    KRD(GL, 1); GAPB(o[1] = MFMA32(PAF(1), VFR(5), o[1]), C0, 12); \
    KRD(GL, 2); GAPB(o[0] = MFMA32(PAF(2), VFR(2), o[0]), C1, 0); \
    KRD(GL, 3); GAPB(o[1] = MFMA32(PAF(2), VFR(6), o[1]), C1, 4); \
    GAPB(o[0] = MFMA32(PAF(3), VFR(3), o[0]), C1, 8); \
    GAPB(o[1] = MFMA32(PAF(3), VFR(7), o[1]), C1, 12); \
    } while (0)
#define AWAIT_STEADY() do { if (DQ == 96) { AWAIT_BAR(3); } else { AWAIT_BAR(2); } } while (0)
#define VRD4(i, b) do { vlo[b] = vtr(vp_ + (((i) >> 2) * 4096 + ((i) & 3) * 1024)); vhi[b] = vtr(vp_ + (((i) >> 2) * 4096 + ((i) & 3) * 1024 + 512)); } while (0)
#define VFR4(b) (bf16x8){vlo[b][0], vlo[b][1], vlo[b][2], vlo[b][3], vhi[b][0], vhi[b][1], vhi[b][2], vhi[b][3]}
#define GAPQ(MF, QLD, A0, A1, A2, A3, W0, W1, PW) do { MF; QLD; sacc += A0; sacc += A1; sacc += A2; sacc += A3; PIN(sacc); W0; W1; PIN(PW); ASBAR(); } while (0)
#define STEP96(C0, C1, P0, P1, t, GK, GV, GL, DOMASK) do { ASBAR(); \
    const lds_cptr vp_ = vp0 + sl_prev * VSLOT; \
    CINIT1(C0, t, 0); CINIT1(C1, t, 32); bf16x8 qa = QL(0), qb; ASBAR(); \
    float sacc = (P0[0] + P0[1]); \
    GAPQ(C0 = MFMA32(kf[0], qa, C0), qb = QL(1), P0[2], P0[3], P0[4], P0[5],     pw0[0] = PKW(P0, 0), pw0[1] = PKW(P0, 2), pw0); \
    GAPQ(C1 = MFMA32(kf[1], qa, C1), (void)0,    P0[6], P0[7], P0[8], P0[9],     pw0[2] = PKW(P0, 4), pw0[3] = PKW(P0, 6), pw0); \
    GAPQ(C0 = MFMA32(kf[2], qb, C0), qa = QL(2), P0[10], P0[11], P0[12], P0[13], pw1[0] = PKW(P0, 8), pw1[1] = PKW(P0, 10), pw1); \
    GAPQ(C1 = MFMA32(kf[3], qb, C1), (void)0,    P0[14], P0[15], P1[0], P1[1],   pw1[2] = PKW(P0, 12), pw1[3] = PKW(P0, 14), pw1); \
    GAPQ(C0 = MFMA32(kf[4], qa, C0), qb = QL(3), P1[2], P1[3], P1[4], P1[5],     pw2[0] = PKW(P1, 0), pw2[1] = PKW(P1, 2), pw2); \
    GAPQ(C1 = MFMA32(kf[5], qa, C1), (void)0,    P1[6], P1[7], P1[8], P1[9],     pw2[2] = PKW(P1, 4), pw2[3] = PKW(P1, 6), pw2); \
    GAPQ(C0 = MFMA32(kf[6], qb, C0), qa = QL(4), P1[10], P1[11], P1[12], P1[13], pw3[0] = PKW(P1, 8), pw3[1] = PKW(P1, 10), pw3); \
    GAPQ(C1 = MFMA32(kf[7], qb, C1), (void)0,    P1[14], P1[15], 0.f, 0.f,       pw3[2] = PKW(P1, 12), pw3[3] = PKW(P1, 14), pw3); \
    C0 = MFMA32(kf[8], qa, C0); qb = QL(5); VRD4(0, 0); ASBAR(); \
    C1 = MFMA32(kf[9], qa, C1); VRD4(4, 1); ASBAR(); \
    C0 = MFMA32(kf[10], qb, C0); ASBAR(); \
    C1 = MFMA32(kf[11], qb, C1); ASBAR(); \
    l_reg += sacc; \
    if (GK) { DMA_K((t) + 3, sl_cur); } if (GV) { DMA_V((t) + 1, sl_next); } \
    if (DOMASK) CMASK(C0, C1, t); \
    { float a = MX3(C0[0], C0[1], C1[0]), b = MX3(C0[2], C0[3], C1[1]); a = MX3(a, C1[2], C1[3]); \
      _Pragma("unroll") for (int r = 4; r < 16; r += 4) { a = MX3(a, C0[r], C0[r + 1]); b = MX3(b, C0[r + 2], C0[r + 3]); a = MX3(a, C1[r], C1[r + 1]); b = MX3(b, C1[r + 2], C1[r + 3]); } \
      float rm = __builtin_fmaxf(a, b); { auto rr = __builtin_amdgcn_permlane32_swap(__float_as_uint(rm), __float_as_uint(rm), false, false); rm = __builtin_fmaxf(__uint_as_float(rr[0]), __uint_as_float(rr[1])); } \
      resc = false; \
      if (__builtin_expect(__any(rm > (float)THRL), 0)) { const float dl = __builtin_fmaxf(rm, 0.f); mhat += dl; \
        _Pragma("unroll") for (int r = 0; r < 16; ++r) { C0[r] -= dl; C1[r] -= dl; } \
        const float f = __builtin_amdgcn_exp2f(-dl); l_reg *= f; if (hi == 0) wsf[r32] = f; resc = true; } } \
    ASBAR(); \
    VRD4(1, 2); ASBAR(); GAPB(o[0] = MFMA32(PAF(0), VFR4(0), o[0]), C0, 0); \
    VRD4(5, 3); ASBAR(); GAPB(o[1] = MFMA32(PAF(0), VFR4(1), o[1]), C0, 4); \
    VRD4(2, 0); KRD(GL, 0); GAPB(o[0] = MFMA32(PAF(1), VFR4(2), o[0]), C0, 8); \
    VRD4(6, 1); KRD(GL, 1); GAPB(o[1] = MFMA32(PAF(1), VFR4(3), o[1]), C0, 12); \
    VRD4(3, 2); KRD(GL, 2); GAPB(o[0] = MFMA32(PAF(2), VFR4(0), o[0]), C1, 0); \
    VRD4(7, 3); KRD(GL, 3); GAPB(o[1] = MFMA32(PAF(2), VFR4(1), o[1]), C1, 4); \
    KRD(GL, 4); GAPB(o[0] = MFMA32(PAF(3), VFR4(2), o[0]), C1, 8); \
    KRD(GL, 5); GAPB(o[1] = MFMA32(PAF(3), VFR4(3), o[1]), C1, 12); \
    } while (0)
#define STEP(C0, C1, P0, P1, t, GK, GV, GL, DOMASK) do { if constexpr (DQ == 96) { STEP96(C0, C1, P0, P1, t, GK, GV, GL, DOMASK); } else { STEP64(C0, C1, P0, P1, t, GK, GV, GL, DOMASK); } } while (0)
#define ENDW(tt) do { if ((tt) + 3 < NT) { AWAIT_STEADY(); } else if ((tt) + 2 < NT) { AWAIT_BAR(1); } else { AWAIT_BAR(0); } } while (0)
    int t = 1;
    for (; t < 5 && t + 1 < NT; t += 2) {
        STEP(pB0, pB1, pA0, pA1, t, (t + 3 < NT), (t + 1 < NT), (t + 1 < NT), true);       ENDW(t);     RESC(); ROT();
        STEP(pA0, pA1, pB0, pB1, t + 1, (t + 4 < NT), (t + 2 < NT), (t + 2 < NT), true);   ENDW(t + 1); RESC(); ROT();
    }
    for (; t + 5 < NT; t += 2) {
        STEP(pB0, pB1, pA0, pA1, t, true, true, true, false);     AWAIT_STEADY(); RESC(); ROT();
        STEP(pA0, pA1, pB0, pB1, t + 1, true, true, true, false); AWAIT_STEADY(); RESC(); ROT();
    }
    for (; t + 1 < NT; t += 2) {
        STEP(pB0, pB1, pA0, pA1, t, (t + 3 < NT), (t + 1 < NT), (t + 1 < NT), true);       ENDW(t);     RESC(); ROT();
        STEP(pA0, pA1, pB0, pB1, t + 1, (t + 4 < NT), (t + 2 < NT), (t + 2 < NT), true);   ENDW(t + 1); RESC(); ROT();
    }
    STEP(pB0, pB1, pA0, pA1, NT - 1, false, false, false, true); RESC();
    { float sacc = pB0[0] + pB0[1];
      _Pragma("unroll") for (int r = 2; r < 16; ++r) sacc += pB0[r];
      _Pragma("unroll") for (int r = 0; r < 16; ++r) sacc += pB1[r];
      l_reg += sacc;
      pw0 = (u32x4){PKW(pB0, 0), PKW(pB0, 2), PKW(pB0, 4), PKW(pB0, 6)}; pw1 = (u32x4){PKW(pB0, 8), PKW(pB0, 10), PKW(pB0, 12), PKW(pB0, 14)};
      pw2 = (u32x4){PKW(pB1, 0), PKW(pB1, 2), PKW(pB1, 4), PKW(pB1, 6)}; pw3 = (u32x4){PKW(pB1, 8), PKW(pB1, 10), PKW(pB1, 12), PKW(pB1, 14)};
      ASBAR();
      const int vb = vb0 + sl_cur * VSLOT;
#pragma unroll
      for (int d0 = 0; d0 < 2; ++d0) { s16x4 lo[4], hh[4];
#pragma unroll
          for (int ks = 0; ks < 4; ++ks) {
              asm volatile("ds_read_b64_tr_b16 %0,%1 offset:%c2" : "=&v"(lo[ks]) : "v"(vb), "i"(d0 * 4096 + ks * 1024) : "memory");
              asm volatile("ds_read_b64_tr_b16 %0,%1 offset:%c2" : "=&v"(hh[ks]) : "v"(vb), "i"(d0 * 4096 + ks * 1024 + 512) : "memory"); }
          asm volatile("s_waitcnt lgkmcnt(0)" ::: "memory"); ASBAR();
#define PK(k) (bf16x8){lo[k][0], lo[k][1], lo[k][2], lo[k][3], hh[k][0], hh[k][1], hh[k][2], hh[k][3]}
          o[d0] = MFMA32(PAF(0), PK(0), o[d0]); o[d0] = MFMA32(PAF(1), PK(1), o[d0]); o[d0] = MFMA32(PAF(2), PK(2), o[d0]); o[d0] = MFMA32(PAF(3), PK(3), o[d0]);
#undef PK
      } }
    { auto rr = __builtin_amdgcn_permlane32_swap(__float_as_uint(l_reg), __float_as_uint(l_reg), false, false); l_reg = __uint_as_float(rr[0]) + __uint_as_float(rr[1]); }
    if (hi == 0) wsf[32 + r32] = l_reg; asm volatile("s_waitcnt lgkmcnt(0)" ::: "memory");
    int lane_e = lane; asm volatile("" : "+v"(lane_e)); const int hi_e = lane_e >> 5, r32_e = lane_e & 31;
    float rli[16];
    { const float* wl_ = wsf + 32 + 4 * hi_e;
#pragma unroll
      for (int r = 0; r < 16; ++r) rli[r] = __builtin_amdgcn_rcpf(wl_[(r & 3) + 8 * (r >> 2)]); }
    { bf16_t* stg = (bf16_t*)(shm + LDS_OST + wid * QWAVE);
      bf16_t* stl = stg + (4 * hi_e) * 64 + r32_e;
#pragma unroll
      for (int r = 0; r < 16; ++r) {
#pragma unroll
          for (int d0 = 0; d0 < 2; ++d0) stl[((r & 3) + 8 * (r >> 2)) * 64 + d0 * 32] = f2bf(o[d0][r] * rli[r]); }
      asm volatile("s_waitcnt lgkmcnt(0)" ::: "memory");
#pragma unroll
      for (int i = 0; i < 4; ++i) { const int row = i * 8 + (lane_e >> 3), ch = lane_e & 7; const u32x4 v = *(const u32x4*)(stg + row * 64 + ch * 8);
          bf16_t* dst = GQA4 ? (A.obase + (long)(8 * wid + (row >> 2)) * A.opitch + (row & 3) * 64) : (A.obase + (long)(32 * wid + row) * A.opitch);
          *(u32x4*)(dst + ch * 8) = v; } }
    asm volatile("s_waitcnt lgkmcnt(0)\n\ts_barrier" ::: "memory");
#undef TILE_OF
#undef DMA_K
#undef DMA_V
#undef CMASK
#undef CINIT
#undef START
#undef RESC
#undef ROT
#undef PKW
#undef PAF
#undef VFR
#undef PIN
#undef MX3
#undef GAPA
#undef GAPB
#undef EX
#undef VRD
#undef KRD
#undef MFMA32
#undef STEP
#undef STEP64
#undef STEP96
#undef VRD4
#undef VFR4
#undef GAPQ
#undef QL
#undef ENDW
#undef AWAIT_STEADY
}
}
constexpr int MK_THREADS = 512;
constexpr int LDS_RING = 131072;
constexpr int LDS_X = LDS_RING;
constexpr int LDS_MOD = LDS_RING + 8192;
constexpr int LDS_BARST = 155648 - 16;
constexpr int LDS_TOTAL = 155648;

#define C2Q 0.18033688011112042f
#define LOG2E 1.4426950408889634f

struct BlkDesc { bf16_t* dst; const float* gain; int pitch; int flags; float scale; int csoff; };
#define C2M 0.14724312203508865f
struct MKP {
    const float* in[34];
    float* out;
    float* modpart;
    float* mod;
    float* cosT; float* sinT;
    bf16_t* W_in0t;
    bf16_t* W_out0t;
    bf16_t* XN;
    bf16_t* OATT;
    bf16_t* QN;
    bf16_t* KV6;
    bf16_t* FQ; bf16_t* FK; bf16_t* FV;
    float* GATES;
    float* LOGF;
    BlkDesc* desc0;
    float* CUMB;
    BlkDesc* desc_uq;
    BlkDesc* desc_ukv;
    bf16_t* W_in1t;
    bf16_t* W_uqt;
    bf16_t* W_ukvt;
    bf16_t* W_out1t;
    bf16_t* P1;
    bf16_t* CQN;
    bf16_t* CKVN;
    bf16_t* Q96;
    bf16_t* K96;
    bf16_t* V1;
    bf16_t* WcT;
    float* CBIAS;
    bf16_t* KCMP;
    bf16_t* VCT;
    bf16_t* KSLF;
    bf16_t* VSLF;
    bf16_t* OCMP;
    bf16_t* OWIN;
    const int* pos;
    bf16_t* Wgu;
    bf16_t* Wd;
    bf16_t* HID;
    bf16_t* YBUF;
    int* gcnt;
    int* list;
    float* ew;
    unsigned* barw;
    int ph_lo, ph_hi, dbg_flags, pad_;
};

__device__ __forceinline__ int swap45(int p) { return (p & 15) | ((p & 16) << 1) | ((p & 32) >> 1); }

template <class Map>
__device__ __forceinline__ void tr_item(const float* __restrict__ W, int ldw, int K, bf16_t* WT, LAS float* scr, int kb, int nb, int lane, const Map& cmap, const float* kscale) {
    const int k0 = 64 * kb, n0 = 32 * nb;
    const int sc = cmap(n0 + (lane & 31));
    float v[32];
    const float* src = W + (size_t)(k0 + (lane >> 5)) * ldw + (sc >= 0 ? sc : 0);
#pragma unroll
    for (int i = 0; i < 32; ++i) v[i] = src[(size_t)(2 * i) * ldw];
    if (kscale) {
#pragma unroll
        for (int i = 0; i < 32; ++i) v[i] *= kscale[k0 + 2 * i + (lane >> 5)];
    }
#pragma unroll
    for (int i = 0; i < 32; ++i) scr[(2 * i + (lane >> 5)) * 33 + (lane & 31)] = (sc >= 0) ? v[i] : 0.f;
    asm volatile("s_waitcnt lgkmcnt(0)" ::: "memory");
    const int c = lane & 7;
#pragma unroll
    for (int j = 0; j < 4; ++j) {
        const int n = (lane >> 3) + 8 * j; const LAS float* s = scr + (8 * c) * 33 + n;
        u32x4 o; o.x = cvtpk(s[0 * 33], s[1 * 33]); o.y = cvtpk(s[2 * 33], s[3 * 33]); o.z = cvtpk(s[4 * 33], s[5 * 33]); o.w = cvtpk(s[6 * 33], s[7 * 33]);
        *(u32x4*)(WT + (size_t)(n0 + n) * K + k0 + 8 * c) = o;
    }
    asm volatile("s_waitcnt lgkmcnt(0)" ::: "memory");
}
struct MapIn0 {
    __device__ __forceinline__ int operator()(int nn) const {
        const int blk = nn >> 6, p = nn & 63;
        if (blk < 8) return blk * 64 + swap45(p);
        if (blk < 20) return 512 + (blk - 8) * 64 + swap45(p);
        if (blk < 44) return 1304 + (blk - 20) * 64 + swap45(p);
        if (blk == 44) { if (p < 24) return 1280 + p; if (p < 32) return 2840 + (p - 24); return -1; }
        return -1;
    }
};
struct MapId { __device__ __forceinline__ int operator()(int nn) const { return nn; } };
struct MapIn1 { __device__ __forceinline__ int operator()(int nn) const { return nn < 672 ? nn : -1; } };
struct MapUq { __device__ __forceinline__ int operator()(int nn) const { if (nn < 1024) return (nn >> 6) * 96 + swap45(nn & 63); const int r = nn - 1024; return (r >> 5) * 96 + 64 + (r & 31); } };
struct MapUkv { __device__ __forceinline__ int operator()(int nn) const { if (nn < 1024) return (nn >> 6) * 128 + swap45(nn & 63); const int r = nn - 1024; return (r >> 6) * 128 + 64 + swap45(r & 63); } };

namespace nsa {
using att::f32x16; using att::crow;
#define NMFMA32(a, b, c) __builtin_amdgcn_mfma_f32_32x32x16_bf16(a, b, c, 0, 0, 0)
#define NMFMA16(a, b, c) __builtin_amdgcn_mfma_f32_16x16x32_bf16(a, b, c, 0, 0, 0)
#define RLF(x, l) __uint_as_float(__builtin_amdgcn_readlane((int)__float_as_uint(x), (l)))

__device__ __forceinline__ void compress_job(const MKP& p, LAS float* scr, int job, int lane) {
    const int nt = job & 31, g = (job >> 5) & 1, kv = job >> 6;
    const int r32 = lane & 31, hi = lane >> 5, n0 = nt * 32;
    const bf16_t* tok = p.KV6 + (size_t)(kv * 2 + g) * S_ * 64;
    const bf16_t* wt = p.WcT + (size_t)kv * 64 * 2048;
    scr[lane] = p.CBIAS[kv * 64 + lane];
    asm volatile("s_waitcnt lgkmcnt(0)" ::: "memory");
    int nrow = n0 + r32; if (nrow > 1022) nrow = 1022;
    const bf16_t* ta = tok + (size_t)(16 * nrow) * 64 + 8 * hi;
    const bf16_t* wa0 = wt + (size_t)r32 * 2048 + 8 * hi;
    const bf16_t* wa1 = wa0 + (size_t)32 * 2048;
    f32x16 c0 = f32x16{}, c1 = f32x16{};
    if (kv == 0) {
#pragma unroll 8
        for (int s = 0; s < 128; ++s) {
            const bf16x8 tf = *(const bf16x8*)(ta + 16 * s), w0 = *(const bf16x8*)(wa0 + 16 * s), w1 = *(const bf16x8*)(wa1 + 16 * s);
            c0 = NMFMA32(w0, tf, c0); c1 = NMFMA32(w1, tf, c1);
        }
        float ss = 0.f;
#pragma unroll
        for (int r = 0; r < 16; ++r) { c0[r] += scr[crow(r, hi)]; c1[r] += scr[32 + crow(r, hi)]; ss += c0[r] * c0[r] + c1[r] * c1[r]; }
        { auto rr = __builtin_amdgcn_permlane32_swap(__float_as_uint(ss), __float_as_uint(ss), false, false); ss = __uint_as_float(rr[0]) + __uint_as_float(rr[1]); }
        const float rs = rsqrtf(ss * (1.f / 64.f) + EPSF);
        const float* gn = p.in[10];
        if (n0 + r32 < 1023) {
            bf16_t* dst = p.KCMP + ((size_t)g * 1024 + n0 + r32) * 64;
#pragma unroll
            for (int q = 0; q < 4; ++q) {
                const int e0 = 8 * q + 4 * hi;
                const f32x4 ga = *(const f32x4*)(gn + e0), gb = *(const f32x4*)(gn + 32 + e0);
                u32x2 wa, wb;
                wa.x = cvtpk(c0[4 * q] * rs * ga.x, c0[4 * q + 1] * rs * ga.y); wa.y = cvtpk(c0[4 * q + 2] * rs * ga.z, c0[4 * q + 3] * rs * ga.w);
                wb.x = cvtpk(c1[4 * q] * rs * gb.x, c1[4 * q + 1] * rs * gb.y); wb.y = cvtpk(c1[4 * q + 2] * rs * gb.z, c1[4 * q + 3] * rs * gb.w);
                *(u32x2*)(dst + e0) = wa; *(u32x2*)(dst + 32 + e0) = wb;
            }
        }
    } else {
#pragma unroll 8
        for (int s = 0; s < 128; ++s) {
            const bf16x8 tf = *(const bf16x8*)(ta + 16 * s), w0 = *(const bf16x8*)(wa0 + 16 * s), w1 = *(const bf16x8*)(wa1 + 16 * s);
            c0 = NMFMA32(tf, w0, c0); c1 = NMFMA32(tf, w1, c1);
        }
        const float b0 = scr[r32], b1 = scr[32 + r32];
#pragma unroll
        for (int G = 0; G < 2; ++G) {
            u32x4 va, vb;
            va.x = cvtpk(c0[8 * G] + b0, c0[8 * G + 1] + b0); va.y = cvtpk(c0[8 * G + 2] + b0, c0[8 * G + 3] + b0); va.z = cvtpk(c0[8 * G + 4] + b0, c0[8 * G + 5] + b0); va.w = cvtpk(c0[8 * G + 6] + b0, c0[8 * G + 7] + b0);
            vb.x = cvtpk(c1[8 * G] + b1, c1[8 * G + 1] + b1); vb.y = cvtpk(c1[8 * G + 2] + b1, c1[8 * G + 3] + b1); vb.z = cvtpk(c1[8 * G + 4] + b1, c1[8 * G + 5] + b1); vb.w = cvtpk(c1[8 * G + 6] + b1, c1[8 * G + 7] + b1);
            *(u32x4*)(p.VCT + ((size_t)g * 64 + r32) * 1024 + n0 + 16 * G + 8 * hi) = va;
            *(u32x4*)(p.VCT + ((size_t)g * 64 + 32 + r32) * 1024 + n0 + 16 * G + 8 * hi) = vb;
        }
    }
    asm volatile("s_waitcnt lgkmcnt(0)" ::: "memory");
}

__device__ __forceinline__ void slcfrag_job(const MKP& p, int job, int lane) {
    const int g = job >> 8, blk = job & 255, c16 = lane & 15, u = lane >> 4;
    const bf16_t* k = p.KV6 + (size_t)(2 * 2 + g) * S_ * 64 + (size_t)blk * 64 * 64;
    const bf16_t* v = p.KV6 + (size_t)(3 * 2 + g) * S_ * 64 + (size_t)blk * 64 * 64;
    bf16_t* kd = p.KSLF + ((size_t)g * 256 + blk) * 4096 + lane * 8;
    bf16_t* vd = p.VSLF + ((size_t)g * 256 + blk) * 4096 + lane * 8;
#pragma unroll
    for (int kg = 0; kg < 4; ++kg)
#pragma unroll
        for (int sx = 0; sx < 2; ++sx) *(u32x4*)(kd + (kg * 2 + sx) * 512) = *(const u32x4*)(k + (size_t)(16 * kg + c16) * 64 + 32 * sx + 8 * u);
#pragma unroll
    for (int dg = 0; dg < 4; ++dg)
#pragma unroll
        for (int ch = 0; ch < 2; ++ch) {
            unsigned pk[4];
#pragma unroll
            for (int jj = 0; jj < 4; ++jj) {
                const int j0 = 2 * jj, j1 = 2 * jj + 1;
                const int k0 = 32 * ch + ((j0 < 4) ? 4 * u + j0 : 16 + 4 * u + (j0 - 4)), k1 = 32 * ch + ((j1 < 4) ? 4 * u + j1 : 16 + 4 * u + (j1 - 4));
                pk[jj] = (unsigned)v[(size_t)k0 * 64 + 16 * dg + c16] | ((unsigned)v[(size_t)k1 * 64 + 16 * dg + c16] << 16);
            }
            *(u32x4*)(vd + (dg * 2 + ch) * 512) = (u32x4){pk[0], pk[1], pk[2], pk[3]};
        }
}

constexpr int IMP_LD = 272;
__device__ __forceinline__ void cmp_wave(const MKP& p, int g, int t0w, LAS float* imp, LAS unsigned char* stg, int lane) {
    const int r32 = lane & 31, hi = lane >> 5;
    const int tq = t0w + (r32 >> 2), head = g * 4 + (r32 & 3);
    const int nmax = (tq >= 31) ? ((tq - 31) >> 4) : -1;
    const int nmaxw = (t0w + 7 >= 31) ? ((t0w + 7 - 31) >> 4) : -1;
    const int ntile = (nmaxw >> 6) + 1;
    for (int i = lane; i < 8 * IMP_LD; i += 64) imp[i] = 0.f;
    bf16x8 qr[4];
#pragma unroll
    for (int d0 = 0; d0 < 4; ++d0) qr[d0] = *(const bf16x8*)(p.QN + (size_t)tq * 512 + head * 64 + d0 * 16 + hi * 8);
    const bf16_t* kc = p.KCMP + (size_t)g * 1024 * 64 + (size_t)r32 * 64 + 8 * hi;
    bf16x8 ovf[4];
#pragma unroll
    for (int ks = 0; ks < 4; ++ks)
#pragma unroll
        for (int j = 0; j < 8; ++j) {
            const int nrel = 16 * ks + ((j < 4) ? 4 * hi + j : 8 + 4 * hi + (j - 4));
            const int dlt = nrel - 4 * r32;
            const float w = (dlt >= 0 && dlt <= 2) ? 2.f : ((dlt == 3 || dlt == -1) ? 1.f : 0.f);
            ovf[ks][j] = (short)f2bf(w);
        }
    float m = -INFINITY, l = 0.f;
    for (int c = 0; c < ntile; ++c) {
        f32x16 s0 = f32x16{}, s1 = f32x16{};
        const bf16_t* kt = kc + (size_t)c * 64 * 64;
#pragma unroll
        for (int d0 = 0; d0 < 4; ++d0) { const bf16x8 k0 = *(const bf16x8*)(kt + 16 * d0), k1 = *(const bf16x8*)(kt + 32 * 64 + 16 * d0); s0 = NMFMA32(k0, qr[d0], s0); s1 = NMFMA32(k1, qr[d0], s1); }
        const int x = nmax - 64 * c - 4 * hi;
        float tm = -INFINITY;
#pragma unroll
        for (int r = 0; r < 16; ++r) { const int cc = (r & 3) + 8 * (r >> 2); if (cc > x) s0[r] = -INFINITY; if (cc + 32 > x) s1[r] = -INFINITY; tm = fmaxf(tm, fmaxf(s0[r], s1[r])); }
        if (tm > m) { l *= __builtin_amdgcn_exp2f(m - tm); m = tm; }
        if (m > -INFINITY) {
            float sum = 0.f;
#pragma unroll
            for (int r = 0; r < 16; ++r) sum += __builtin_amdgcn_exp2f(s0[r] - m) + __builtin_amdgcn_exp2f(s1[r] - m);
            l += sum;
        }
    }
    { auto rm = __builtin_amdgcn_permlane32_swap(__float_as_uint(m), __float_as_uint(m), false, false);
      auto rl = __builtin_amdgcn_permlane32_swap(__float_as_uint(l), __float_as_uint(l), false, false);
      const float ma = __uint_as_float(rm[0]), mb = __uint_as_float(rm[1]), la = __uint_as_float(rl[0]), lb = __uint_as_float(rl[1]);
      const float mm = fmaxf(ma, mb);
      if (mm > -INFINITY) { l = ((ma > -INFINITY) ? la * __builtin_amdgcn_exp2f(ma - mm) : 0.f) + ((mb > -INFINITY) ? lb * __builtin_amdgcn_exp2f(mb - mm) : 0.f); m = mm; }
      else { l = 0.f; m = 0.f; } }
    const float invl = (l > 0.f) ? 1.f / l : 0.f;
    f32x16 o0 = f32x16{}, o1 = f32x16{};
    const bf16_t* vc = p.VCT + (size_t)g * 64 * 1024 + (size_t)r32 * 1024 + 8 * hi;
    for (int c = 0; c < ntile; ++c) {
        f32x16 s0 = f32x16{}, s1 = f32x16{};
        const bf16_t* kt = kc + (size_t)c * 64 * 64;
#pragma unroll
        for (int d0 = 0; d0 < 4; ++d0) { const bf16x8 k0 = *(const bf16x8*)(kt + 16 * d0), k1 = *(const bf16x8*)(kt + 32 * 64 + 16 * d0); s0 = NMFMA32(k0, qr[d0], s0); s1 = NMFMA32(k1, qr[d0], s1); }
        const int x = nmax - 64 * c - 4 * hi;
#pragma unroll
        for (int r = 0; r < 16; ++r) { const int cc = (r & 3) + 8 * (r >> 2);
            s0[r] = (cc > x) ? 0.f : __builtin_amdgcn_exp2f(s0[r] - m) * invl; s1[r] = (cc + 32 > x) ? 0.f : __builtin_amdgcn_exp2f(s1[r] - m) * invl; }
        u32x4 pw[4];
        pw[0] = (u32x4){cvtpk(s0[0], s0[1]), cvtpk(s0[2], s0[3]), cvtpk(s0[4], s0[5]), cvtpk(s0[6], s0[7])};
        pw[1] = (u32x4){cvtpk(s0[8], s0[9]), cvtpk(s0[10], s0[11]), cvtpk(s0[12], s0[13]), cvtpk(s0[14], s0[15])};
        pw[2] = (u32x4){cvtpk(s1[0], s1[1]), cvtpk(s1[2], s1[3]), cvtpk(s1[4], s1[5]), cvtpk(s1[6], s1[7])};
        pw[3] = (u32x4){cvtpk(s1[8], s1[9]), cvtpk(s1[10], s1[11]), cvtpk(s1[12], s1[13]), cvtpk(s1[14], s1[15])};
        f32x16 im = f32x16{};
        const bf16_t* vt = vc + c * 64;
#pragma unroll
        for (int ks = 0; ks < 4; ++ks) {
            const bf16x8 pa = __builtin_bit_cast(bf16x8, pw[ks]);
            const bf16x8 v0 = *(const bf16x8*)(vt + 16 * ks), v1 = *(const bf16x8*)(vt + 32 * 1024 + 16 * ks);
            o0 = NMFMA32(pa, v0, o0); o1 = NMFMA32(pa, v1, o1); im = NMFMA32(pa, ovf[ks], im);
        }
        if (r32 <= 16 && 16 * c + r32 < 256) {
#pragma unroll
            for (int k = 0; k < 4; ++k) { const float v = (im[4 * k] + im[4 * k + 1]) + (im[4 * k + 2] + im[4 * k + 3]); atomicAdd((float*)(imp + (2 * k + hi) * IMP_LD + 16 * c + r32), v); }
        }
    }
    { bf16_t* st = (bf16_t*)stg; bf16_t* stl = st + (4 * hi) * 64 + r32;
#pragma unroll
      for (int r = 0; r < 16; ++r) { stl[((r & 3) + 8 * (r >> 2)) * 64] = f2bf(o0[r]); stl[((r & 3) + 8 * (r >> 2)) * 64 + 32] = f2bf(o1[r]); }
      asm volatile("s_waitcnt lgkmcnt(0)" ::: "memory");
#pragma unroll
      for (int i = 0; i < 4; ++i) { const int row = i * 8 + (lane >> 3), ch = lane & 7; const u32x4 v = *(const u32x4*)(st + row * 64 + ch * 8);
          *(u32x4*)(p.OCMP + (size_t)(t0w + (row >> 2)) * 512 + (g * 4 + (row & 3)) * 64 + ch * 8) = v; }
      asm volatile("s_waitcnt lgkmcnt(0)" ::: "memory"); }
}

__device__ __forceinline__ void select_wave(int t0w, const LAS float* imp, LAS int* sel, int lane) {
    const int sub = lane & 31;
#pragma unroll 1
    for (int h = 0; h < 4; ++h) {
        const int tk = 2 * h + (lane >> 5);
        const int tq = t0w + tk, cur = tq >> 6;
        float v[8];
#pragma unroll
        for (int i = 0; i < 8; ++i) { const int j = sub + 32 * i; float x = imp[tk * IMP_LD + j]; if (j == 0 || j == cur || j == cur - 1) x += 1e6f; v[i] = (j <= cur) ? x : -INFINITY; }
#pragma unroll 1
        for (int it = 0; it < 16; ++it) {
            float bv = v[0]; int bi = 0;
#pragma unroll
            for (int i = 1; i < 8; ++i) if (v[i] > bv) { bv = v[i]; bi = i; }
            int bj = sub + 32 * bi;
#pragma unroll
            for (int o = 1; o < 32; o <<= 1) { const float ov = __shfl_xor(bv, o); const int oj = __shfl_xor(bj, o); if (ov > bv || (ov == bv && oj < bj)) { bv = ov; bj = oj; } }
            const bool any = bv > -INFINITY;
            if (sub == 0) sel[tk * 16 + it] = any ? bj : -1;
            if (any && (bj & 31) == sub) { const int wi = bj >> 5;
#pragma unroll
                for (int i = 0; i < 8; ++i) if (i == wi) v[i] = -INFINITY; }
        }
    }
    asm volatile("s_waitcnt lgkmcnt(0)" ::: "memory");
}

__device__ __forceinline__ void slc_wave(const MKP& p, int g, int t0w, const LAS int* sel, LAS float* oslc, int lane) {
    const int c16 = lane & 15, u = lane >> 4;
    const bf16_t* kb = p.KSLF + (size_t)g * 256 * 4096 + lane * 8;
    const bf16_t* vb = p.VSLF + (size_t)g * 256 * 4096 + lane * 8;
#define KLOAD(dst, blk_) do { const bf16_t* kp_ = kb + (size_t)(blk_) * 4096; _Pragma("unroll") for (int f_ = 0; f_ < 8; ++f_) dst[f_] = *(const bf16x8*)(kp_ + f_ * 512); } while (0)
    int tk = 0, it = 0;
    int blk = sel[0];
    bf16x8 kA[8], kB[8], vf[8];
    const bf16x8 zf = (bf16x8){0, 0, 0, 0, 0, 0, 0, 0};
    const bf16_t* qb = p.QN + (size_t)t0w * 512 + (g * 4 + (c16 & 3)) * 64 + 8 * u;
    bf16x8 q0 = *(const bf16x8*)qb, q1 = *(const bf16x8*)(qb + 32), qn0 = zf, qn1 = zf;
    KLOAD(kA, blk);
    if (c16 >= 4) { q0 = zf; q1 = zf; }
    float m = -INFINITY, l = 0.f;
    f32x4 o[4]; o[0] = o[1] = o[2] = o[3] = (f32x4){0.f, 0.f, 0.f, 0.f};
    bool done = false;
#define SLC_PAIR(KC, KN) do { \
        const int tq = t0w + tk; \
        int ntk = tk, nit = it + 1, nblk = -1; \
        if (nit < 16) nblk = sel[tk * 16 + nit]; \
        if (nblk < 0) { ntk = tk + 1; nit = 0; nblk = (ntk < 8) ? sel[ntk * 16] : -1; } \
          \
        if (ntk != tk && ntk < 8) { qn0 = *(const bf16x8*)(qb + (size_t)ntk * 512); qn1 = *(const bf16x8*)(qb + (size_t)ntk * 512 + 32); } \
        { const bf16_t* vp = vb + (size_t)blk * 4096; \
          _Pragma("unroll") for (int ch = 0; ch < 2; ++ch) _Pragma("unroll") for (int dg = 0; dg < 4; ++dg) vf[ch * 4 + dg] = *(const bf16x8*)(vp + (dg * 2 + ch) * 512); } \
        { const int kblk = nblk < 0 ? 0 : nblk; KLOAD(KN, kblk); }        \
        f32x4 s[4]; \
        _Pragma("unroll") for (int kg = 0; kg < 4; ++kg) { f32x4 c = (f32x4){0.f, 0.f, 0.f, 0.f}; c = NMFMA16(KC[2 * kg], q0, c); c = NMFMA16(KC[2 * kg + 1], q1, c); s[kg] = c; } \
        if (blk == (tq >> 6)) { const int x = tq - 64 * blk - 4 * u; \
            _Pragma("unroll") for (int kg = 0; kg < 4; ++kg) { if (16 * kg > x) s[kg].x = -INFINITY; if (16 * kg + 1 > x) s[kg].y = -INFINITY; if (16 * kg + 2 > x) s[kg].z = -INFINITY; if (16 * kg + 3 > x) s[kg].w = -INFINITY; } } \
        float tm = -INFINITY; \
        _Pragma("unroll") for (int kg = 0; kg < 4; ++kg) tm = fmaxf(tm, fmaxf(fmaxf(s[kg].x, s[kg].y), fmaxf(s[kg].z, s[kg].w))); \
        tm = fmaxf(tm, __shfl_xor(tm, 16)); tm = fmaxf(tm, __shfl_xor(tm, 32)); \
        float alpha = 1.f; \
        if (tm > m) { alpha = __builtin_amdgcn_exp2f(m - tm); m = tm; } \
        l *= alpha; \
        float sum = 0.f; \
        _Pragma("unroll") for (int kg = 0; kg < 4; ++kg) { s[kg].x = __builtin_amdgcn_exp2f(s[kg].x - m); s[kg].y = __builtin_amdgcn_exp2f(s[kg].y - m); s[kg].z = __builtin_amdgcn_exp2f(s[kg].z - m); s[kg].w = __builtin_amdgcn_exp2f(s[kg].w - m); \
            sum += (s[kg].x + s[kg].y) + (s[kg].z + s[kg].w); } \
        l += sum; \
        { const float a0 = RLF(alpha, 0), a1 = RLF(alpha, 1), a2 = RLF(alpha, 2), a3 = RLF(alpha, 3); \
          _Pragma("unroll") for (int dg = 0; dg < 4; ++dg) { o[dg].x *= a0; o[dg].y *= a1; o[dg].z *= a2; o[dg].w *= a3; } } \
        _Pragma("unroll") for (int ch = 0; ch < 2; ++ch) { \
            u32x4 pw; pw.x = cvtpk(s[2 * ch].x, s[2 * ch].y); pw.y = cvtpk(s[2 * ch].z, s[2 * ch].w); pw.z = cvtpk(s[2 * ch + 1].x, s[2 * ch + 1].y); pw.w = cvtpk(s[2 * ch + 1].z, s[2 * ch + 1].w); \
            const bf16x8 pa = __builtin_bit_cast(bf16x8, pw); \
            _Pragma("unroll") for (int dg = 0; dg < 4; ++dg) o[dg] = NMFMA16(pa, vf[ch * 4 + dg], o[dg]); } \
        if (ntk != tk) { \
            float lt = l; lt += __shfl_xor(lt, 16); lt += __shfl_xor(lt, 32); \
            const float il = (lt > 0.f) ? 1.f / lt : 0.f; \
            const float i0 = RLF(il, 0), i1 = RLF(il, 1), i2 = RLF(il, 2), i3 = RLF(il, 3); \
            if (lane < 16) { LAS float* op = oslc + tk * 256 + lane; \
                _Pragma("unroll") for (int dg = 0; dg < 4; ++dg) { op[16 * dg] = o[dg].x * i0; op[64 + 16 * dg] = o[dg].y * i1; op[128 + 16 * dg] = o[dg].z * i2; op[192 + 16 * dg] = o[dg].w * i3; } } \
            m = -INFINITY; l = 0.f; o[0] = o[1] = o[2] = o[3] = (f32x4){0.f, 0.f, 0.f, 0.f}; \
            q0 = (c16 < 4) ? qn0 : zf; q1 = (c16 < 4) ? qn1 : zf; } \
        if (nblk < 0) done = true; \
        tk = ntk; it = nit; blk = nblk; } while (0)
#pragma unroll 1
    for (;;) {
        SLC_PAIR(kA, kB); if (done) break;
        SLC_PAIR(kB, kA); if (done) break;
    }
#undef SLC_PAIR
#undef KLOAD
    asm volatile("s_waitcnt lgkmcnt(0)" ::: "memory");
    {
        const int tkl = lane >> 3, cc = (lane & 7) * 32, hh = cc >> 6;
        const int tq = t0w + tkl;
        const float* gt = p.GATES + (size_t)tq * 24 + (g * 4 + hh) * 3;
        const float gc = 1.f / (1.f + __expf(-gt[0])), gs = 1.f / (1.f + __expf(-gt[1])), gw = 1.f / (1.f + __expf(-gt[2]));
        const size_t col = (size_t)tq * 512 + g * 256 + cc;
        const LAS float* os = oslc + tkl * 256 + cc;
#pragma unroll
        for (int q = 0; q < 4; ++q) {
            const u32x4 wc = *(const u32x4*)(p.OCMP + col + 8 * q), ww = *(const u32x4*)(p.OWIN + col + 8 * q);
            const f32x4 sa = *(const LAS f32x4*)(os + 8 * q), sb = *(const LAS f32x4*)(os + 8 * q + 4);
            u32x4 r;
            r.x = cvtpk(gs * sa.x + gc * __uint_as_float(wc.x << 16) + gw * __uint_as_float(ww.x << 16), gs * sa.y + gc * __uint_as_float(wc.x & 0xffff0000u) + gw * __uint_as_float(ww.x & 0xffff0000u));
            r.y = cvtpk(gs * sa.z + gc * __uint_as_float(wc.y << 16) + gw * __uint_as_float(ww.y << 16), gs * sa.w + gc * __uint_as_float(wc.y & 0xffff0000u) + gw * __uint_as_float(ww.y & 0xffff0000u));
            r.z = cvtpk(gs * sb.x + gc * __uint_as_float(wc.z << 16) + gw * __uint_as_float(ww.z << 16), gs * sb.y + gc * __uint_as_float(wc.z & 0xffff0000u) + gw * __uint_as_float(ww.z & 0xffff0000u));
            r.w = cvtpk(gs * sb.z + gc * __uint_as_float(wc.w << 16) + gw * __uint_as_float(ww.w << 16), gs * sb.w + gc * __uint_as_float(wc.w & 0xffff0000u) + gw * __uint_as_float(ww.w & 0xffff0000u));
            *(u32x4*)(p.OATT + (size_t)tq * 1024 + g * 256 + cc + 8 * q) = r;
        }
    }
}

__device__ __forceinline__ void nsa_unit(const MKP& p, char* shm, int g, int tile) {
    int tid_ = threadIdx.x; asm volatile("" : "+v"(tid_));
    const int tid = tid_, lane = tid & 63, r32 = lane & 31; const int wid = __builtin_amdgcn_readfirstlane(tid >> 6);
    const int t0 = tile * 64;
    {   att::UnitArgs A;
        A.qrow = p.QN + (size_t)(t0 + 8 * wid + (r32 >> 2)) * 512 + (g * 4 + (r32 & 3)) * 64;
        A.K = p.KV6 + (size_t)(4 * 2 + g) * S_ * 64; A.V = p.KV6 + (size_t)(5 * 2 + g) * S_ * 64; A.kvpitch = 64; A.vpitch = 64;
        A.obase = p.OWIN + (size_t)t0 * 512 + g * 256; A.opitch = 512;
        A.qtok = 8 * wid + (r32 >> 2); A.abase = tile;
        const int real = (tile + 1 < 9) ? tile + 1 : 9; int nt = (real + 1) & ~1; if (nt < 4) nt = 4;
        A.nsteps = nt; A.bias = nullptr;
        att::attn_unit<att::MODE_WIN, true, 8, 64>(A, shm);
    }
    LAS unsigned char* l3 = (LAS unsigned char*)shm;
    LAS float* imp = (LAS float*)(l3 + wid * (8 * IMP_LD * 4));
    LAS int* sel = (LAS int*)(l3 + 8 * (8 * IMP_LD * 4) + wid * 512);
    LAS unsigned char* stg = l3 + 8 * (8 * IMP_LD * 4) + 8 * 512 + wid * 4096;
    const int t0w = t0 + 8 * wid;
    cmp_wave(p, g, t0w, imp, stg, lane);
    asm volatile("s_waitcnt vmcnt(0) lgkmcnt(0)" ::: "memory");
    select_wave(t0w, imp, sel, lane);
    slc_wave(p, g, t0w, sel, imp, lane);
    asm volatile("s_waitcnt vmcnt(0) lgkmcnt(0)\n\ts_barrier" ::: "memory");
}
#undef NMFMA32
#undef NMFMA16
#undef RLF
}

__device__ __forceinline__ void phase_prologue(const MKP& p, LAS unsigned char* lds) {
    const int tid = threadIdx.x, lane = tid & 63, wave = tid >> 6;
    const int gw = blockIdx.x * 8 + wave, NGW = gridDim.x * 8;
    LAS float* scr = (LAS float*)(lds + wave * 16384);
    for (int it = gw; it < 8 * 192; it += NGW) {
        const int kc = it / 192, ch = it % 192, idx = ch * 64 + lane, l = idx / 6144, n = idx % 6144;
        const float* w = p.in[5] + (size_t)l * 1024 * 6144 + n;
        const float* c = p.in[1];
        float acc = 0.f;
#pragma unroll 8
        for (int k = kc * 128; k < kc * 128 + 128; ++k) { const float cv = c[k]; acc += (cv / (1.f + __expf(-cv))) * w[(size_t)k * 6144]; }
        p.modpart[kc * 12288 + idx] = acc;
    }
    if (blockIdx.x == 1 && tid < 128) p.gcnt[tid] = 0;
    if (blockIdx.x == 0 && tid < 96 + 48 + 64) {
        BlkDesc d; d.dst = nullptr; d.gain = nullptr; d.pitch = 0; d.flags = 4; d.scale = 1.f; d.csoff = 0;
        if (tid < 96) {
            const int blk = (tid >> 3) * 4 + ((tid >> 2) & 1) * 2 + ((tid >> 1) & 1);
            d.flags = 0;
            if (blk < 8) { d.dst = p.QN + blk * 64; d.pitch = 512; d.gain = p.in[9]; d.flags = 1; d.scale = C2Q; }
            else if (blk < 20) { const int j = (blk - 8) >> 1, g = (blk - 8) & 1; d.dst = p.KV6 + (size_t)(j * 2 + g) * S_ * 64; d.pitch = 64;
                d.gain = (j == 2 || j == 4) ? p.in[10] : nullptr; d.flags = (j == 0 || j == 2 || j == 4) ? 1 : 0; }
            else if (blk < 28) { d.dst = p.FQ + (blk - 20) * 64; d.pitch = 512; d.gain = p.in[13]; d.scale = C2Q; }
            else if (blk < 36) { d.dst = p.FK + (blk - 28) * 64; d.pitch = 512; d.gain = p.in[14]; }
            else if (blk < 44) { d.dst = p.FV + (blk - 36) * 64; d.pitch = 512; }
            else if (blk == 44) d.flags = 2;
            else d.flags = 4;
            p.desc0[tid] = d;
        } else if (tid < 96 + 48) {
            const int e = tid - 96, pn = e >> 3, bj = (e >> 2) & 1, wc = e & 3;
            if (pn < 4) { const int h = pn * 4 + bj * 2 + (wc >> 1); d.dst = p.Q96 + (size_t)h * S_ * 96; d.pitch = 96; d.gain = p.in[21]; d.flags = 0; d.scale = C2M; }
            else { const int h = (pn - 4) * 8 + bj * 4 + wc; d.dst = p.Q96 + (size_t)h * S_ * 96 + 64; d.pitch = 96; d.gain = p.in[23]; d.flags = 1 | 8; d.scale = C2M; d.csoff = 32; }
            p.desc_uq[e] = d;
        } else {
            const int e = tid - 144, pn = e >> 3, bj = (e >> 2) & 1, wc = e & 3;
            const int h = (pn & 3) * 4 + bj * 2 + (wc >> 1);
            if (pn < 4) { d.dst = p.K96 + (size_t)h * S_ * 96; d.pitch = 96; d.gain = p.in[22]; d.flags = 0; }
            else { d.dst = p.V1 + (size_t)h * S_ * 64; d.pitch = 64; d.gain = nullptr; d.flags = 0; }
            p.desc_ukv[e] = d;
        }
    }
    if (blockIdx.x == 2 || blockIdx.x == 3) {
        const int kv = blockIdx.x - 2, e = tid & 63, sl = tid >> 6;
        const float* w = p.in[12] + (size_t)kv * 2048 * 64 + e; const float* pe = p.in[11] + kv * 2048;
        float b = 0.f;
#pragma unroll 8
        for (int k = sl * 256; k < sl * 256 + 256; ++k) b += pe[k] * w[(size_t)k * 64];
        LAS float* red = (LAS float*)(lds + 140000);
        red[tid] = b;
        __syncthreads();
        if (tid < 64) { float a = 0.f;
#pragma unroll
            for (int q = 0; q < 8; ++q) a += red[q * 64 + tid];
            p.CBIAS[kv * 64 + tid] = a; }
    }
    for (int idx = blockIdx.x * MK_THREADS + tid; idx < S_ * 48; idx += gridDim.x * MK_THREADS) {
        const int t = idx / 48, i = idx % 48;
        const double ex = (i < 32) ? (double)(2 * i) / 64.0 : (double)(2 * (i - 32)) / 32.0;
        const double a = (double)p.pos[t] * exp(-ex * 9.210340371976184);
        const double r = a - rint(a * 0.15915494309189535) * 6.283185307179586;
        const float rf = (float)r;
        p.cosT[idx] = cosf(rf); p.sinT[idx] = sinf(rf);
    }
    for (int it = gw; it < 2 * 32 * 2; it += NGW) { const int kv = it >> 6, r = it & 63; tr_item(p.in[12] + (size_t)kv * 2048 * 64, 64, 2048, p.WcT + (size_t)kv * 64 * 2048, scr, r >> 1, r & 1, lane, MapId(), nullptr); }
    constexpr int I_IN0 = 16 * 96, I_OUT0 = 16 * 32, I_IN1 = 16 * 24, I_UQ = 6 * 48, I_UKV = 4 * 64, I_OUT1 = 16 * 32;
    for (int it = gw; it < I_IN0 + I_OUT0 + I_IN1 + I_UQ + I_UKV + I_OUT1; it += NGW) {
        int r = it;
        if (r < I_IN0) { tr_item(p.in[7], HYIN, 1024, p.W_in0t, scr, r / 96, r % 96, lane, MapIn0(), nullptr); continue; } r -= I_IN0;
        if (r < I_OUT0) { tr_item(p.in[15], 1024, 1024, p.W_out0t, scr, r / 32, r % 32, lane, MapId(), nullptr); continue; } r -= I_OUT0;
        if (r < I_IN1) { tr_item(p.in[16], 672, 1024, p.W_in1t, scr, r / 24, r % 24, lane, MapIn1(), nullptr); continue; } r -= I_IN1;
        if (r < I_UQ) { tr_item(p.in[19], 1536, 384, p.W_uqt, scr, r / 48, r % 48, lane, MapUq(), p.in[17]); continue; } r -= I_UQ;
        if (r < I_UKV) { tr_item(p.in[20], 2048, 256, p.W_ukvt, scr, r / 64, r % 64, lane, MapUkv(), p.in[18]); continue; } r -= I_UKV;
        tr_item(p.in[25], 1024, 1024, p.W_out1t, scr, r / 32, r % 32, lane, MapId(), nullptr);
    }
}

__device__ __forceinline__ void phase_norm(const MKP& p, LAS unsigned char* lds, const float* x, const float* gw_, int layer, int sc_idx, int sh_idx, bool finalize_mod) {
    const int tid = threadIdx.x, lane = tid & 63, wave = tid >> 6;
    LAS float* msc = (LAS float*)(lds + LDS_MOD);
    LAS float* msh = msc + 1024;
    const float* b_ada = p.in[6];
    if (finalize_mod) {
        for (int i = tid; i < 2048; i += MK_THREADS) {
            const int idx = layer * 6144 + ((i < 1024) ? sc_idx * 1024 + i : sh_idx * 1024 + (i - 1024));
            float a = b_ada[idx];
#pragma unroll
            for (int kc = 0; kc < 8; ++kc) a += p.modpart[kc * 12288 + idx];
            msc[i] = a;
        }
        for (int idx = blockIdx.x * MK_THREADS + tid; idx < 12288; idx += gridDim.x * MK_THREADS) {
            float a = b_ada[idx];
#pragma unroll
            for (int kc = 0; kc < 8; ++kc) a += p.modpart[kc * 12288 + idx];
            p.mod[idx] = a;
        }
    } else {
        for (int i = tid; i < 2048; i += MK_THREADS)
            msc[i] = p.mod[layer * 6144 + ((i < 1024) ? sc_idx * 1024 + i : sh_idx * 1024 + (i - 1024))];
    }
    __syncthreads();
    const int gwv = blockIdx.x * 8 + wave, NGW = gridDim.x * 8;
    for (int m = gwv; m < S_; m += NGW) {
        const f32x4* xr = (const f32x4*)(x + (size_t)m * D_) + lane;
        f32x4 v[4]; float s = 0.f;
#pragma unroll
        for (int j = 0; j < 4; ++j) { v[j] = xr[64 * j]; s += (v[j].x * v[j].x + v[j].y * v[j].y) + (v[j].z * v[j].z + v[j].w * v[j].w); }
        s = wsum(s);
        const float rstd = rsqrtf(s * (1.f / D_) + EPSF);
        u32x2* o8 = (u32x2*)(p.XN + (size_t)m * D_) + lane;
#pragma unroll
        for (int j = 0; j < 4; ++j) {
            const int c0 = 256 * j + 4 * lane;
            const f32x4 g = *(const f32x4*)(gw_ + c0);
            const f32x4 sc = *(const LAS f32x4*)(msc + c0), sh = *(const LAS f32x4*)(msh + c0);
            const f32x4 y = v[j] * rstd * g * (sc + 1.f) + sh;
            u32x2 w; w.x = cvtpk(y.x, y.y); w.y = cvtpk(y.z, y.w);
            o8[64 * j] = w;
        }
    }
}

struct EpiResid {
    const float* xin; float* out; const float* gate;
    __device__ __forceinline__ void operator()(const f32x4 (&acc)[2][2][4][2], const pg::Unit& u, int wid, int wr, int wc, int fr_, int fq_) const {
        int fr = fr_, fq = fq_; asm volatile("" : "+v"(fr), "+v"(fq));
        const int col0 = u.pn * 256 + wc * 32 + 4 * fq;
        f32x4 g[2][2];
#pragma unroll
        for (int bj = 0; bj < 2; ++bj)
#pragma unroll
            for (int n = 0; n < 2; ++n) g[bj][n] = *(const f32x4*)(gate + col0 + bj * 128 + n * 16);
#pragma unroll
        for (int ai = 0; ai < 2; ++ai)
#pragma unroll
            for (int m = 0; m < 4; ++m) {
                const size_t off = (size_t)(u.pm * 256 + ai * 128 + wr * 64 + m * 16 + fr) * 1024 + col0;
#pragma unroll
                for (int bj = 0; bj < 2; ++bj)
#pragma unroll
                    for (int n = 0; n < 2; ++n) {
                        const f32x4 xv = *(const f32x4*)(xin + off + bj * 128 + n * 16);
                        *(f32x4*)(out + off + bj * 128 + n * 16) = xv + g[bj][n] * acc[ai][bj][m][n];
                    }
                asm volatile("" ::: "memory");
            }
    }
};

struct EpiHeads {
    const BlkDesc* tab; const float* cosT; const float* sinT; float* GATES; float* LOGF; LAS float* X;
    __device__ __forceinline__ void operator()(const f32x4 (&acc)[2][2][4][2], const pg::Unit& u, int wid, int wr, int wc, int fr_, int fq_) const {
        int fr = fr_, fq = fq_; asm volatile("" : "+v"(fr), "+v"(fq));
        const int w1 = wc & 1;
#pragma unroll
        for (int ai = 0; ai < 2; ++ai)
#pragma unroll
            for (int bj = 0; bj < 2; ++bj)
#pragma unroll
                for (int m = 0; m < 4; ++m) {
                    const f32x4 a = acc[ai][bj][m][0], b = acc[ai][bj][m][1];
                    float s = (a.x * a.x + a.y * a.y) + (a.z * a.z + a.w * a.w) + (b.x * b.x + b.y * b.y) + (b.z * b.z + b.w * b.w);
                    s += __shfl_xor(s, 16); s += __shfl_xor(s, 32);
                    if (fq == 0) X[wid * 256 + ((ai * 2 + bj) * 4 + m) * 16 + fr] = s;
                }
        asm volatile("s_waitcnt lgkmcnt(0)" ::: "memory"); __builtin_amdgcn_s_barrier(); asm volatile("" ::: "memory");
#pragma unroll
        for (int bj = 0; bj < 2; ++bj) {
            const BlkDesc d = tab[8 * u.pn + 4 * bj + wc];
            const int row0 = u.pm * 256 + wr * 64 + fr;
            if (d.flags & 4) continue;
            if (d.flags & 2) {
                if (w1 == 0) {
#pragma unroll
                    for (int ai = 0; ai < 2; ++ai)
#pragma unroll
                        for (int m = 0; m < 4; ++m) {
                            const int row = row0 + ai * 128 + m * 16;
#pragma unroll
                            for (int n = 0; n < 2; ++n) {
                                const f32x4 v = acc[ai][bj][m][n];
                                const int pc = 16 * n + 4 * fq;
                                if (pc < 24) *(f32x4*)(GATES + (size_t)row * 24 + pc) = v;
                                else *(f32x4*)(LOGF + (size_t)row * 8 + (pc - 24)) = v;
                            }
                            asm volatile("" ::: "memory");
                        }
                }
                continue;
            }
            const bool half = (d.flags & 8) != 0, has_gain = d.gain != nullptr, rope = (d.flags & 1) != 0;
            const int d0 = half ? 4 * fq : 16 * w1 + 4 * fq;
            const int dn1 = half ? 16 : 32;
            const float invn = half ? (1.f / 32.f) : (1.f / 64.f);
            const GAS float* gp = (const GAS float*)(has_gain ? d.gain : cosT);
            f32x4 g0 = *(const GAS f32x4*)(gp + d0), g1 = *(const GAS f32x4*)(gp + dn1 + d0);
            if (!has_gain) { g0 = (f32x4){1.f, 1.f, 1.f, 1.f}; g1 = g0; }
            g0 = g0 * d.scale; g1 = g1 * d.scale;
            const int cso = d.csoff + d0;
#pragma unroll
            for (int ai = 0; ai < 2; ++ai)
#pragma unroll
                for (int m = 0; m < 4; ++m) {
                    const int row = row0 + ai * 128 + m * 16;
                    const int xi = ((ai * 2 + bj) * 4 + m) * 16 + fr;
                    float ssq = X[wid * 256 + xi]; const float ssp = X[(wid ^ 1) * 256 + xi];
                    if (!half) ssq += ssp;
                    const float rs = has_gain ? rsqrtf(ssq * invn + EPSF) : 1.f;
                    f32x4 x1 = acc[ai][bj][m][0] * rs * g0, x2 = acc[ai][bj][m][1] * rs * g1;
                    f32x4 c = *(const f32x4*)(cosT + (size_t)row * 48 + cso), sn = *(const f32x4*)(sinT + (size_t)row * 48 + cso);
                    if (!rope) { c = (f32x4){1.f, 1.f, 1.f, 1.f}; sn = (f32x4){0.f, 0.f, 0.f, 0.f}; }
                    const f32x4 o1 = x1 * c - x2 * sn, o2 = x2 * c + x1 * sn;
                    u32x2 wa, wb; wa.x = cvtpk(o1.x, o1.y); wa.y = cvtpk(o1.z, o1.w); wb.x = cvtpk(o2.x, o2.y); wb.y = cvtpk(o2.z, o2.w);
                    GAS bf16_t* dr = (GAS bf16_t*)d.dst + (size_t)row * d.pitch + d0;
                    *(GAS u32x2*)dr = wa; *(GAS u32x2*)(dr + dn1) = wb;
                    asm volatile("" ::: "memory");
                }
        }
    }
};

struct EpiPlain {
    bf16_t* O; int ldc;
    __device__ __forceinline__ void operator()(const f32x4 (&acc)[2][2][4][2], const pg::Unit& u, int wid, int wr, int wc, int fr_, int fq_) const {
        int fr = fr_, fq = fq_; asm volatile("" : "+v"(fr), "+v"(fq));
        const int col0 = u.pn * 256 + wc * 32 + 4 * fq;
#pragma unroll
        for (int ai = 0; ai < 2; ++ai)
#pragma unroll
            for (int m = 0; m < 4; ++m) {
                bf16_t* rp = O + (size_t)(u.pm * 256 + ai * 128 + wr * 64 + m * 16 + fr) * ldc + col0;
#pragma unroll
                for (int bj = 0; bj < 2; ++bj)
#pragma unroll
                    for (int n = 0; n < 2; ++n) { const f32x4 v = acc[ai][bj][m][n]; u32x2 w; w.x = cvtpk(v.x, v.y); w.y = cvtpk(v.z, v.w); *(u32x2*)(rp + bj * 128 + n * 16) = w; }
            }
    }
};

__device__ __forceinline__ void phase_post1a(const MKP& p) {
    int tid_ = threadIdx.x; asm volatile("" : "+v"(tid_));
    const int tid = tid_, lane = tid & 63, wave = tid >> 6;
    const int gwv = blockIdx.x * 8 + wave, NGW = gridDim.x * 8;
    for (int t = gwv; t < S_; t += NGW) {
        const u32x2* row = (const u32x2*)(p.P1 + (size_t)t * 768);
        f32x4 v[3]; float sq = 0.f, skv = 0.f, skr = 0.f;
#pragma unroll
        for (int j = 0; j < 3; ++j) {
            const int g = lane + 64 * j;
            f32x4 x = (f32x4){0.f, 0.f, 0.f, 0.f};
            if (g < 168) { const u32x2 w = row[g]; x.x = __uint_as_float(w.x << 16); x.y = __uint_as_float(w.x & 0xffff0000u); x.z = __uint_as_float(w.y << 16); x.w = __uint_as_float(w.y & 0xffff0000u); }
            v[j] = x;
            const float s = (x.x * x.x + x.y * x.y) + (x.z * x.z + x.w * x.w);
            if (g < 96) sq += s; else if (g < 160) skv += s; else skr += s;
        }
        sq = wsum(sq); skv = wsum(skv); skr = wsum(skr);
        const float rq = rsqrtf(sq * (1.f / 384.f) + EPSF), rkv = rsqrtf(skv * (1.f / 256.f) + EPSF), rkr = rsqrtf(skr * (1.f / 32.f) + EPSF);
#pragma unroll
        for (int j = 0; j < 3; ++j) {
            const int g = lane + 64 * j;
            if (g < 96) { const f32x4 y = v[j] * rq; u32x2 w; w.x = cvtpk(y.x, y.y); w.y = cvtpk(y.z, y.w); *(u32x2*)(p.CQN + (size_t)t * 384 + 4 * g) = w; }
            else if (g < 160) { const f32x4 y = v[j] * rkv; u32x2 w; w.x = cvtpk(y.x, y.y); w.y = cvtpk(y.z, y.w); *(u32x2*)(p.CKVN + (size_t)t * 256 + 4 * (g - 96)) = w; }
        }
        {
            const int dl = (lane - 32) & 7;
            const int dd = 4 * dl;
            const int fi = 4 * (dl & 3);
            f32x4 x = v[2] * rkr;
            const f32x4 gn = *(const f32x4*)(p.in[24] + (dd & 31));
            x = x * gn;
            f32x4 o; o.x = __shfl_xor(x.x, 4); o.y = __shfl_xor(x.y, 4); o.z = __shfl_xor(x.z, 4); o.w = __shfl_xor(x.w, 4);
            const f32x4 c = *(const f32x4*)(p.cosT + (size_t)t * 48 + 32 + fi), sn = *(const f32x4*)(p.sinT + (size_t)t * 48 + 32 + fi);
            const f32x4 y = (dl < 4) ? (x * c - o * sn) : (x * c + o * sn);
            if (lane >= 32 && lane < 40) {
                u32x2 w; w.x = cvtpk(y.x, y.y); w.y = cvtpk(y.z, y.w);
#pragma unroll
                for (int h = 0; h < 16; ++h) *(u32x2*)(p.K96 + ((size_t)h * S_ + t) * 96 + 64 + dd) = w;
            }
        }
    }
}

__device__ __forceinline__ void mla_unit(const MKP& p, char* shm, int h, int qb) {
    int tid_ = threadIdx.x; asm volatile("" : "+v"(tid_));
    const int tid = tid_, lane = tid & 63, r32 = lane & 31; const int wid = __builtin_amdgcn_readfirstlane(tid >> 6);
    const int q0 = qb * 256;
    att::UnitArgs A;
    A.qrow = p.Q96 + ((size_t)h * S_ + q0 + 32 * wid + r32) * 96;
    A.K = p.K96 + (size_t)h * S_ * 96; A.kvpitch = 96; A.V = p.V1 + (size_t)h * S_ * 64; A.vpitch = 64;
    A.obase = p.OATT + (size_t)q0 * 1024 + h * 64; A.opitch = 1024;
    A.qtok = 32 * wid + r32; A.abase = 4 * qb; A.nsteps = 4 * qb + 4; A.bias = nullptr;
    att::attn_unit<att::MODE_CAUSAL, false, 8, 96>(A, shm);
}
__device__ __forceinline__ void phase_mla(const MKP& p, char* shm) {
    const int G = gridDim.x, bx = blockIdx.x;
    const int vcu = (G % 8 == 0) ? (bx % 8) * (G / 8) + bx / 8 : bx;
    for (int u = vcu; u < 256; u += G) {
        const int h = u >> 4, s = u & 15;
#pragma unroll 1
        for (int rep = 0; rep < 4; ++rep) mla_unit(p, shm, h, rep == 0 ? s : rep == 1 ? 31 - s : rep == 2 ? 32 + s : 63 - s);
    }
}

__device__ __forceinline__ void phase_scan(const MKP& p, LAS unsigned char* lds, int which = 3) {
    if (blockIdx.x >= 8) {
        if (!(which & 2)) return;
        int tid_ = threadIdx.x; asm volatile("" : "+v"(tid_));
        const int lane = tid_ & 63, wave = tid_ >> 6;
        const int gw = (blockIdx.x - 8) * 8 + wave, NGW = (gridDim.x - 8) * 8;
        LAS float* scr = (LAS float*)(lds + wave * 256);
        for (int j = gw; j < 128 + 512; j += NGW) { if (j < 128) nsa::compress_job(p, scr, j, lane); else nsa::slcfrag_job(p, j - 128, lane); }
        return;
    }
    if (!(which & 1)) return;
    const int h = blockIdx.x, tid = threadIdx.x;
    LAS double* part = (LAS double*)lds;
    const float fb = p.in[8][h];
    double s = 0.0;
    for (int i = 0; i < 32; ++i) s += (double)logsigmf(p.LOGF[(size_t)(tid * 32 + i) * 8 + h] + fb);
    part[tid] = s;
    __syncthreads();
    for (int o = 1; o < MK_THREADS; o <<= 1) {
        const double v = (tid >= o) ? part[tid - o] : 0.0;
        __syncthreads();
        part[tid] += v;
        __syncthreads();
    }
    double a = (tid > 0) ? part[tid - 1] : 0.0;
    for (int i = 0; i < 32; ++i) { a += (double)logsigmf(p.LOGF[(size_t)(tid * 32 + i) * 8 + h] + fb); p.CUMB[(size_t)h * S_ + tid * 32 + i] = (float)(a * 1.4426950408889634); }
}

__device__ __forceinline__ void fox_unit(const MKP& p, char* shm, int h, int qb) {
    int tid_ = threadIdx.x; asm volatile("" : "+v"(tid_));
    const int tid = tid_, lane = tid & 63, r32 = lane & 31; const int wid = __builtin_amdgcn_readfirstlane(tid >> 6);
    const int q0 = qb * 256, abase = 4 * qb;
    const float* cb = p.CUMB + (size_t)h * S_;
    LAS float* bias = (LAS float*)(LAS unsigned char*)(shm + att::LDS_BIAS);
    LAS int* cnt = (LAS int*)(LAS unsigned char*)(shm + att::Geo<64>::LDS_WS);
    float gq = 0.f, gk = 0.f;
    for (int i = 0; i < 64; ++i) { gq = fmaxf(gq, fabsf(p.in[13][i])); gk = fmaxf(gk, fabsf(p.in[14][i])); }
    const float TH = 150.f + 2.f * (64.f * gq * gk * C2Q * 1.05f);
    const float c0 = cb[q0], cref = cb[q0 + 255];
    const bool skip = (tid < abase) && (cb[64 * tid + 63] - c0 > TH);
    const unsigned long long bal = __ballot(skip);
    if (lane == 0) cnt[wid] = __popcll(bal);
    __syncthreads();
    int alo = 0;
#pragma unroll
    for (int w = 0; w < 8; ++w) alo += cnt[w];
    int NT = abase + 4 - alo;
    if (NT & 1) { alo -= 1; NT += 1; }
    for (int i = tid; i < NT * 64; i += MK_THREADS) bias[i] = cref - cb[64 * alo + i];
    __syncthreads();
    att::UnitArgs A;
    A.qrow = p.FQ + (size_t)(q0 + 32 * wid + r32) * 512 + h * 64;
    A.K = p.FK + h * 64; A.V = p.FV + h * 64; A.kvpitch = 512; A.vpitch = 512;
    A.obase = p.OATT + (size_t)q0 * 1024 + 512 + h * 64; A.opitch = 1024;
    A.qtok = 32 * wid + r32; A.abase = abase; A.nsteps = NT; A.bias = bias;
    att::attn_unit<att::MODE_FOX, false, 8, 64>(A, shm);
}
__device__ __forceinline__ void phase_fox(const MKP& p, char* shm, int part = 3) {
    const int G = gridDim.x, bx = blockIdx.x;
    const int vcu = (G % 8 == 0) ? (bx % 8) * (G / 8) + bx / 8 : bx;
    if (part & 1) for (int u = vcu; u < 256; u += G) {
        const int h = u >> 5, s = u & 31;
#pragma unroll 1
        for (int rep = 0; rep < 2; ++rep) fox_unit(p, shm, h, rep ? 63 - s : s);
    }
    if (part & 2) for (int u = vcu; u < 256; u += G) {
#pragma unroll 1
        for (int rep = 0; rep < 2; ++rep) nsa::nsa_unit(p, shm, rep, rep ? 255 - u : u);
    }
}


struct MapOff { int off; __device__ __forceinline__ int operator()(int nn) const { return off + (nn & 31); } };
__device__ __forceinline__ void phase_moe_weights(const MKP& p, LAS unsigned char* lds, int layer) {
    int tid_ = threadIdx.x; asm volatile("" : "+v"(tid_));
    const int tid = tid_, lane = tid & 63, wave = tid >> 6;
    const int gw = blockIdx.x * 8 + wave, NGW = gridDim.x * 8;
    LAS float* scr = (LAS float*)(lds + wave * 16384);
    constexpr int IG = 16 * 16, ID = 4 * 32, IE = IG + ID;
    for (int it = gw; it < 65 * IE; it += NGW) {
        const int e = it / IE; int r = it % IE;
        if (r < IG) {
            const int kb = r / 16, nb = r % 16;
            const int n0 = nb * 32, up = (n0 >> 7) & 1, f0 = (n0 >> 8) * 128 + (n0 & 127);
            const float* W = (e < 64) ? ((up ? p.in[29] : p.in[28]) + ((size_t)layer * 64 + e) * 1024 * 256) : ((up ? p.in[32] : p.in[31]) + (size_t)layer * 1024 * 256);
            MapOff mo{f0};
            tr_item(W, 256, 1024, p.Wgu + (size_t)e * 512 * 1024, scr, kb, nb, lane, mo, nullptr);
        } else {
            r -= IG; const int kb = r / 32, nb = r % 32;
            const float* W = (e < 64) ? (p.in[30] + ((size_t)layer * 64 + e) * 256 * 1024) : (p.in[33] + (size_t)layer * 256 * 1024);
            tr_item(W, 1024, 256, p.Wd + (size_t)e * 1024 * 256, scr, kb, nb, lane, MapId(), nullptr);
        }
    }
}

template <bool DRY>
__device__ __forceinline__ void phase_moe_route(const MKP& p, LAS unsigned char* lds, int layer) {
    int tid_ = threadIdx.x; asm volatile("" : "+v"(tid_));
    const int tid = tid_, lane = tid & 63, wave = tid >> 6;
    LAS float* msc = (LAS float*)(lds + LDS_MOD);
    LAS float* msh = msc + 1024;
    LAS float* hrow = (LAS float*)lds;
    LAS int* cntl = (LAS int*)(lds + LDS_X);
    LAS int* basel = cntl + 64;
    const float* gnorm = p.in[4] + layer * 1024;
    const float* wr = p.in[26] + (size_t)layer * 1024 * 64;
    const float rb = p.in[27][layer * 64 + lane];
    for (int i = tid; i < 2048; i += MK_THREADS) msc[i] = p.mod[layer * 6144 + ((i < 1024) ? 4 * 1024 + i : 3 * 1024 + (i - 1024))];
    __syncthreads();
    for (int batch = blockIdx.x; batch < S_ / 32; batch += gridDim.x) {
        if (tid < 64) cntl[tid] = 0;
#pragma unroll 1
        for (int i = 0; i < 4; ++i) {
            const int t = batch * 32 + wave * 4 + i;
            const f32x4* xr = (const f32x4*)(p.out + (size_t)t * D_) + lane;
            f32x4 v[4]; float s = 0.f;
#pragma unroll
            for (int j = 0; j < 4; ++j) { v[j] = xr[64 * j]; s += (v[j].x * v[j].x + v[j].y * v[j].y) + (v[j].z * v[j].z + v[j].w * v[j].w); }
            s = wsum(s);
            const float rstd = rsqrtf(s * (1.f / D_) + EPSF);
            u32x2* o8 = (u32x2*)(p.XN + (size_t)t * D_) + lane;
            LAS f32x4* hr = (LAS f32x4*)(hrow + (wave * 4 + i) * 1024) + lane;
#pragma unroll
            for (int j = 0; j < 4; ++j) {
                const int c0 = 256 * j + 4 * lane;
                const f32x4 g = *(const f32x4*)(gnorm + c0);
                const f32x4 sc = *(const LAS f32x4*)(msc + c0), sh = *(const LAS f32x4*)(msh + c0);
                const f32x4 y = v[j] * rstd * g * (sc + 1.f) + sh;
                u32x2 w; w.x = cvtpk(y.x, y.y); w.y = cvtpk(y.z, y.w);
                o8[64 * j] = w; hr[64 * j] = y;
            }
        }
        __syncthreads();
        float acc0 = 0.f, acc1 = 0.f, acc2 = 0.f, acc3 = 0.f;
        const LAS float* h0 = hrow + (wave * 4) * 1024;
#pragma unroll 4
        for (int k = 0; k < 1024; k += 4) {
            const float w0 = wr[(k + 0) * 64 + lane], w1 = wr[(k + 1) * 64 + lane], w2 = wr[(k + 2) * 64 + lane], w3 = wr[(k + 3) * 64 + lane];
            const f32x4 a = *(const LAS f32x4*)(h0 + k), b = *(const LAS f32x4*)(h0 + 1024 + k), c = *(const LAS f32x4*)(h0 + 2048 + k), d = *(const LAS f32x4*)(h0 + 3072 + k);
            acc0 += a.x * w0; acc0 += a.y * w1; acc0 += a.z * w2; acc0 += a.w * w3;
            acc1 += b.x * w0; acc1 += b.y * w1; acc1 += b.z * w2; acc1 += b.w * w3;
            acc2 += c.x * w0; acc2 += c.y * w1; acc2 += c.z * w2; acc2 += c.w * w3;
            acc3 += d.x * w0; acc3 += d.y * w1; acc3 += d.z * w2; acc3 += d.w * w3;
        }
        int myrank[4], mypos[4]; float myw[4];
#pragma unroll
        for (int i = 0; i < 4; ++i) {
            const float logit = (i == 0) ? acc0 : (i == 1) ? acc1 : (i == 2) ? acc2 : acc3;
            const float score = 1.f / (1.f + expf(-logit));
            const float sv = score + rb;
            float m1 = sv;
            m1 = fmaxf(m1, __shfl_xor(m1, 1)); m1 = fmaxf(m1, __shfl_xor(m1, 2)); m1 = fmaxf(m1, __shfl_xor(m1, 4));
            int am = (sv == m1) ? (lane & 7) : 8;
            am = min(am, __shfl_xor(am, 1)); am = min(am, __shfl_xor(am, 2)); am = min(am, __shfl_xor(am, 4));
            float m2 = ((lane & 7) == am) ? -INFINITY : sv;
            m2 = fmaxf(m2, __shfl_xor(m2, 1)); m2 = fmaxf(m2, __shfl_xor(m2, 2)); m2 = fmaxf(m2, __shfl_xor(m2, 4));
            const float gs = m1 + m2;
            const int gi = lane >> 3; int grank = 0;
#pragma unroll
            for (int gj = 0; gj < 8; ++gj) { const float o = __shfl(gs, gj * 8); grank += (o > gs || (o == gs && gj < gi)) ? 1 : 0; }
            const float msk = (grank < 4) ? sv : -1e30f;
            int rank = 0;
#pragma unroll 8
            for (int e = 0; e < 64; ++e) { const float o = __shfl(msk, e); rank += (o > msk || (o == msk && e < lane)) ? 1 : 0; }
            const bool selb = rank < 8;
            const float tot = wsum(selb ? score : 0.f);
            myrank[i] = selb ? rank : -1; myw[i] = score / tot * 2.5f;
            mypos[i] = (selb && !DRY) ? atomicAdd((int*)(cntl + lane), 1) : 0;
        }
        __syncthreads();
        if (tid < 64) basel[tid] = (cntl[tid] > 0 && !DRY) ? atomicAdd(p.gcnt + layer * 64 + tid, cntl[tid]) : 0;
        __syncthreads();
#pragma unroll
        for (int i = 0; i < 4; ++i) if (myrank[i] >= 0 && !DRY) {
            const int t = batch * 32 + wave * 4 + i, slot = t * 8 + myrank[i];
            p.list[(size_t)lane * 16384 + basel[lane] + mypos[i]] = slot;
            p.ew[slot] = myw[i];
        }
        __syncthreads();
    }
}

struct MoeSched {
    const char* A; const char* Bt; const int* list; const LAS int* ustart; const LAS int* hbase; const LAS int* cnt;
    int K, NP, G, c; bool gather; int nexp;
    __device__ __forceinline__ static void tables(LAS int* ustart, LAS int* hbase, LAS int* cnt, const int* gcnt, int NP) {
        const int tid = threadIdx.x;
        if (tid == 0) {
            int us = 0, hb = 0;
            for (int e = 0; e < 65; ++e) { const int c = (e < 64) ? gcnt[e] : S_; const int nrb = (c + 255) >> 8; cnt[e] = c; ustart[e] = us; hbase[e] = hb; us += nrb * NP; hb += nrb * 256; }
            ustart[65] = us; hbase[65] = hb;
        }
        __syncthreads();
    }
    __device__ __forceinline__ bool next(int i, pg::Unit& u, int R0, int C0) const {
        const int L = i * G + c; if (L >= ustart[nexp]) return false;
        const int lane = threadIdx.x & 63;
        const unsigned long long bal = __ballot(lane < 65 && ustart[lane] <= L);
        int e = __popcll(bal) - 1; if (ustart[64] <= L) e = 64;
        const int r = L - ustart[e], rb = r / NP, pn = r % NP;
        u.pm = (hbase[e] >> 8) + rb; u.pn = pn; u.aux = e | (rb << 8);
        u.B = Bt + ((size_t)e * NP + pn) * 256 * K * 2;
        if (gather) {
            u.A = A; const int ce = cnt[e];
#pragma unroll
            for (int q = 0; q < 4; ++q) { const int pos = rb * 256 + R0 + 64 * q; int tok = 0; if (pos < ce) tok = (e < 64) ? (list[(size_t)e * 16384 + pos] >> 3) : pos; u.ra[q] = (unsigned)(tok * K + C0) * 2u; }
        } else {
            u.A = A + (size_t)u.pm * 256 * K * 2;
#pragma unroll
            for (int q = 0; q < 4; ++q) u.ra[q] = (unsigned)((R0 + 64 * q) * K + C0) * 2u;
        }
        return true;
    }
};
struct EpiGateUp {
    bf16_t* HID;
    __device__ __forceinline__ void operator()(const f32x4 (&acc)[2][2][4][2], const pg::Unit& u, int wid, int wr, int wc, int fr_, int fq_) const {
        int fr = fr_, fq = fq_; asm volatile("" : "+v"(fr), "+v"(fq));
        const int col0 = u.pn * 128 + wc * 32 + 4 * fq;
#pragma unroll
        for (int ai = 0; ai < 2; ++ai)
#pragma unroll
            for (int m = 0; m < 4; ++m) {
                bf16_t* rp = HID + (size_t)(u.pm * 256 + ai * 128 + wr * 64 + m * 16 + fr) * 256 + col0;
#pragma unroll
                for (int n = 0; n < 2; ++n) {
                    const f32x4 g = acc[ai][0][m][n], up = acc[ai][1][m][n];
                    f32x4 h; h.x = g.x / (1.f + __expf(-g.x)) * up.x; h.y = g.y / (1.f + __expf(-g.y)) * up.y; h.z = g.z / (1.f + __expf(-g.z)) * up.z; h.w = g.w / (1.f + __expf(-g.w)) * up.w;
                    u32x2 w; w.x = cvtpk(h.x, h.y); w.y = cvtpk(h.z, h.w); *(u32x2*)(rp + n * 16) = w;
                }
            }
    }
};
struct EpiDown {
    bf16_t* YBUF; const int* list; const float* ew; const LAS int* cnt;
    __device__ __forceinline__ void operator()(const f32x4 (&acc)[2][2][4][2], const pg::Unit& u, int wid, int wr, int wc, int fr_, int fq_) const {
        int fr = fr_, fq = fq_; asm volatile("" : "+v"(fr), "+v"(fq));
        const int e = u.aux & 0xff, rb = u.aux >> 8, ce = cnt[e];
        const unsigned colb = (unsigned)(u.pn * 256 + wc * 32 + 4 * fq) * 2u;
        const int* le = list + (size_t)e * 16384 + rb * 256 + wr * 64 + fr;
#pragma unroll
        for (int ai = 0; ai < 2; ++ai)
#pragma unroll
            for (int m = 0; m < 4; ++m) {
                const int pr = ai * 128 + m * 16;
                if (rb * 256 + wr * 64 + fr + pr < ce) {
                    const int slot = le[pr]; const float w = ew[slot];
                    char* rp = (char*)YBUF + ((unsigned)slot * 2048u + colb);
#pragma unroll
                    for (int bj = 0; bj < 2; ++bj)
#pragma unroll
                        for (int n = 0; n < 2; ++n) { const f32x4 v = acc[ai][bj][m][n] * w; u32x2 o; o.x = cvtpk(v.x, v.y); o.y = cvtpk(v.z, v.w); *(u32x2*)(rp + bj * 256 + n * 32) = o; }
                }
                asm volatile("" ::: "memory");
            }
    }
};
__device__ __forceinline__ void phase_moe_gemm1(const MKP& p, LAS unsigned char* lds, int layer) {
    LAS int* tb = (LAS int*)(lds + LDS_X);
    MoeSched::tables(tb, tb + 66, tb + 132, p.gcnt + layer * 64, 2);
    const int G = gridDim.x, bx = blockIdx.x, vcu = (G % 8 == 0) ? (bx % 8) * (G / 8) + bx / 8 : bx;
    MoeSched S{(const char*)p.XN, (const char*)p.Wgu, p.list, tb, tb + 66, tb + 132, 1024, 2, G, vcu, true, 65};
    EpiGateUp E{p.HID};
    pg::gemm_run(lds, 1024, S, E);
}
__device__ __forceinline__ void phase_moe_gemm2(const MKP& p, LAS unsigned char* lds, int layer, int which = 3) {
    LAS int* tb = (LAS int*)(lds + LDS_X);
    MoeSched::tables(tb, tb + 66, tb + 132, p.gcnt + layer * 64, 4);
    const int G = gridDim.x, bx = blockIdx.x, vcu = (G % 8 == 0) ? (bx % 8) * (G / 8) + bx / 8 : bx;
    if (which & 1) { MoeSched S{(const char*)p.HID, (const char*)p.Wd, p.list, tb, tb + 66, tb + 132, 256, 4, G, vcu, false, 64};
      EpiDown E{p.YBUF, p.list, p.ew, tb + 132};
      pg::gemm_run(lds, 256, S, E); }
    if (which & 2) {
      pg::DenseSched S; S.init(p.HID + (size_t)tb[66 + 64] * 256, p.Wd + (size_t)64 * 1024 * 256, S_, 1024, 256, G, bx);
      EpiResid E{p.out, p.out, p.mod + layer * 6144 + 5 * 1024};
      pg::gemm_run(lds, 256, S, E); }
}
__device__ __forceinline__ void phase_moe_combine(const MKP& p, int layer) {
    int tid_ = threadIdx.x; asm volatile("" : "+v"(tid_));
    const int tid = tid_, lane = tid & 63, wave = tid >> 6;
    const int gwv = blockIdx.x * 8 + wave, NGW = gridDim.x * 8;
    const float* g2 = p.mod + layer * 6144 + 5 * 1024;
    for (int t = gwv; t < S_; t += NGW) {
        f32x4* xr = (f32x4*)(p.out + (size_t)t * D_) + lane;
#pragma unroll
        for (int j = 0; j < 4; ++j) {
            f32x4 s = (f32x4){0.f, 0.f, 0.f, 0.f};
#pragma unroll
            for (int k = 0; k < 8; ++k) {
                const u32x2 w = *((const u32x2*)(p.YBUF + ((size_t)t * 8 + k) * 1024) + lane + 64 * j);
                s.x += __uint_as_float(w.x << 16); s.y += __uint_as_float(w.x & 0xffff0000u); s.z += __uint_as_float(w.y << 16); s.w += __uint_as_float(w.y & 0xffff0000u);
            }
            const f32x4 g = *(const f32x4*)(g2 + 256 * j + 4 * lane);
            xr[64 * j] = xr[64 * j] + g * s;
        }
    }
}

#define XB_TMO      128
#define XB_XCNT(j)  (256  + 64 * (j))
#define XB_XSUB(j)  (1280 + 64 * (j))
#define XB_XGEN(j)  (2304 + 64 * (j))
#define XB_TOP      3328
#define XB_TOPGEN   3392
#define XCD_BAR_WORDS 3456
#define XB_SPIN_CAP (1u << 22)
__device__ __forceinline__ unsigned xb_ld(unsigned* p)              { return __hip_atomic_load(p, __ATOMIC_RELAXED, __HIP_MEMORY_SCOPE_AGENT); }
__device__ __forceinline__ unsigned xb_add(unsigned* p, unsigned v) { return __hip_atomic_fetch_add(p, v, __ATOMIC_RELAXED, __HIP_MEMORY_SCOPE_AGENT); }
__device__ __forceinline__ unsigned xb_xcc_id() { return (unsigned)__builtin_amdgcn_s_getreg((3 << 11) | 20) & 0xFu; }
#define XB_SPIN(cond, bar) do { unsigned _sp = 0; while (cond) { __builtin_amdgcn_s_sleep(1); \
    if ((++_sp & 255u) == 0u) { if (xb_ld(&(bar)[XB_TMO])) break; if (_sp > XB_SPIN_CAP) { atomicAdd(&(bar)[XB_TMO], 1u); break; } } } } while (0)
struct XcdBarrier { unsigned* bar; unsigned x; volatile LAS unsigned* st; };
__device__ __forceinline__ XcdBarrier xcd_barrier_post(unsigned* bar, volatile LAS unsigned* st) {
    XcdBarrier b; b.bar = bar; b.x = xb_xcc_id(); b.st = st;
    if (threadIdx.x == 0) (void)xb_add(&bar[XB_XCNT(b.x)], 1u);
    return b;
}
__device__ __forceinline__ void xcd_barrier_complete(unsigned* bar, unsigned x, unsigned& nloc, unsigned& nx) {
    const unsigned G = gridDim.x * gridDim.y * gridDim.z;
    unsigned sum, cnt, mine, sp = 0u;
    for (;;) {
        sum = 0u; cnt = 0u; mine = 0u;
#pragma unroll
        for (unsigned j = 0; j < 16; ++j) { const unsigned c = xb_ld(&bar[XB_XCNT(j)]); sum += c; cnt += (c > 0u) ? 1u : 0u; mine = (j == x) ? c : mine; }
        if (sum == G) break;
        __builtin_amdgcn_s_sleep(1);
        if ((++sp & 255u) == 0u) { if (xb_ld(&bar[XB_TMO])) break; if (sp > XB_SPIN_CAP) { atomicAdd(&bar[XB_TMO], 1u); break; } }
    }
    nloc = mine > 0u ? mine : 1u; nx = cnt > 0u ? cnt : 1u;
}
__device__ __forceinline__ void xcd_barrier(const XcdBarrier& b) {
    asm volatile("s_waitcnt vmcnt(0)" ::: "memory");
    __syncthreads();
    if (threadIdx.x == 0) {
        unsigned* bar = b.bar;
        __builtin_amdgcn_s_waitcnt(0);
        unsigned nloc = b.st[0], nx = b.st[1];
        if (nloc == 0u) { xcd_barrier_complete(bar, b.x, nloc, nx); b.st[0] = nloc; b.st[1] = nx; }
        const unsigned old = xb_add(&bar[XB_XSUB(b.x)], 1u);
        const unsigned gen = old / nloc;
        if (old + 1u == (gen + 1u) * nloc) {
            __builtin_amdgcn_fence(__ATOMIC_RELEASE, "agent");
            asm volatile("s_waitcnt vmcnt(0)" ::: "memory");
            const unsigned og = xb_add(&bar[XB_TOP], 1u);
            const unsigned tg = og / nx;
            if (og + 1u == (tg + 1u) * nx) xb_add(&bar[XB_TOPGEN], 1u);
            else XB_SPIN(xb_ld(&bar[XB_TOPGEN]) == tg, bar);
            __builtin_amdgcn_fence(__ATOMIC_ACQUIRE, "agent");
            xb_add(&bar[XB_XGEN(b.x)], 1u);
            asm volatile("s_waitcnt vmcnt(0)" ::: "memory");
        } else {
            XB_SPIN(xb_ld(&bar[XB_XGEN(b.x)]) == gen, bar);
            __builtin_amdgcn_fence(__ATOMIC_ACQUIRE, "agent");
            asm volatile("s_waitcnt vmcnt(0)" ::: "memory");
        }
    }
    __syncthreads();
}

__global__ void __launch_bounds__(MK_THREADS, 2) mega(MKP p) {
    extern __shared__ __attribute__((aligned(16))) unsigned char lds_raw[];
    LAS unsigned char* lds = (LAS unsigned char*)lds_raw;
    const int lo = p.ph_lo, hi = p.ph_hi;
    const bool multi = hi - lo > 1;
    volatile LAS unsigned* bst = (volatile LAS unsigned*)(lds + LDS_BARST);
    XcdBarrier bar; bar.bar = p.barw; bar.x = 0; bar.st = bst;
    if (multi) {
        if (threadIdx.x < 2) bst[threadIdx.x] = 0u;
        if (blockIdx.x == 0) for (int i = threadIdx.x; i < XCD_BAR_WORDS; i += MK_THREADS) p.barw[i] = 0u;
    }
    int nbar = 0;
#define IN(k) (lo <= (k) && (k) < hi)
#define SEAM(k) do { if (IN(k) && IN((k) + 1)) { if (nbar == 0) { __threadfence(); cooperative_groups::this_grid().sync(); __builtin_amdgcn_fence(__ATOMIC_ACQUIRE, "agent"); bar = xcd_barrier_post(p.barw, bst); } else xcd_barrier(bar); ++nbar; } } while (0)
    if (IN(0)) { phase_prologue(p, lds); phase_moe_weights(p, lds, 0); }
    SEAM(0);
    if (IN(1)) phase_norm(p, lds, p.in[0], p.in[3], 0, 1, 0, true);
    SEAM(1);
    if (IN(2)) {
        pg::DenseSched S; S.init(p.XN, p.W_in0t, S_, 3072, 1024, gridDim.x, blockIdx.x);
        EpiHeads E{p.desc0, p.cosT, p.sinT, p.GATES, p.LOGF, (LAS float*)(lds + LDS_X)};
        pg::gemm_run(lds, 1024, S, E);
    }
    SEAM(2);
    if (IN(3)) phase_scan(p, lds);
    SEAM(3);
    if (IN(4)) phase_fox(p, (char*)lds_raw);
    SEAM(4);
    if (IN(5)) {
        pg::DenseSched S; S.init(p.OATT, p.W_out0t, S_, 1024, 1024, gridDim.x, blockIdx.x);
        EpiResid E{p.in[0], p.out, p.mod + 2 * 1024};
        pg::gemm_run(lds, 1024, S, E);
    }
    SEAM(5);
    if (IN(6)) phase_moe_route<false>(p, lds, 0);
    SEAM(6);
    if (IN(7)) phase_moe_gemm1(p, lds, 0);
    SEAM(7);
    if (IN(8)) phase_moe_gemm2(p, lds, 0);
    SEAM(8);
    if (IN(9)) { phase_moe_combine(p, 0); phase_moe_weights(p, lds, 1); }
    SEAM(9);
    if (IN(10)) phase_norm(p, lds, p.out, p.in[3] + 1024, 1, 1, 0, false);
    SEAM(10);
    if (IN(11)) {
        pg::DenseSched S; S.init(p.XN, p.W_in1t, S_, 768, 1024, gridDim.x, blockIdx.x);
        EpiPlain E{p.P1, 768};
        pg::gemm_run(lds, 1024, S, E);
    }
    SEAM(11);
    if (IN(12)) phase_post1a(p);
    SEAM(12);
    if (IN(13)) {
        { pg::DenseSched S; S.init(p.CQN, p.W_uqt, S_, 1536, 384, gridDim.x, blockIdx.x);
          EpiHeads E{p.desc_uq, p.cosT, p.sinT, nullptr, nullptr, (LAS float*)(lds + LDS_X)};
          pg::gemm_run(lds, 384, S, E); }
        { pg::DenseSched S; S.init(p.CKVN, p.W_ukvt, S_, 2048, 256, gridDim.x, blockIdx.x);
          EpiHeads E{p.desc_ukv, p.cosT, p.sinT, nullptr, nullptr, (LAS float*)(lds + LDS_X)};
          pg::gemm_run(lds, 256, S, E); }
    }
    SEAM(13);
    if (IN(14)) phase_mla(p, (char*)lds_raw);
    SEAM(14);
    if (IN(15)) {
        pg::DenseSched S; S.init(p.OATT, p.W_out1t, S_, 1024, 1024, gridDim.x, blockIdx.x);
        EpiResid E{p.out, p.out, p.mod + 6144 + 2 * 1024};
        pg::gemm_run(lds, 1024, S, E);
    }
    SEAM(15);
    if (IN(16)) phase_moe_route<false>(p, lds, 1);
    SEAM(16);
    if (IN(17)) phase_moe_gemm1(p, lds, 1);
    SEAM(17);
    if (IN(18)) phase_moe_gemm2(p, lds, 1);
    SEAM(18);
    if (IN(19)) phase_moe_combine(p, 1);
#undef IN
#undef SEAM
}
extern "C" void kernel_launch(void* const* d_in, const int* in_sizes, int n_in, void* d_out, int out_size, void* d_ws, size_t ws_size, hipStream_t stream) {
    static int grid = 0;
    if (!grid) {
        int dev = 0, cus = 0, per_cu = 0;
        (void)hipGetDevice(&dev); (void)hipDeviceGetAttribute(&cus, hipDeviceAttributeMultiprocessorCount, dev);
        (void)hipFuncSetAttribute((const void*)mega, hipFuncAttributeMaxDynamicSharedMemorySize, LDS_TOTAL);
        (void)hipOccupancyMaxActiveBlocksPerMultiprocessor(&per_cu, (const void*)mega, MK_THREADS, LDS_TOTAL);
        (void)hipGetLastError();
        grid = (cus > 0 && per_cu >= 1) ? cus : -1;
    }
    if (grid < 0) return;
    constexpr size_t MiB = 1u << 20;
    if (ws_size < 528 * MiB || n_in != 34) return;
    char* wsb = (char*)d_ws;
    float* ws = (float*)d_ws;
    size_t o = 0;
    MKP p{};
    for (int i = 0; i < 34; ++i) p.in[i] = (const float*)d_in[i];
    p.out = (float*)d_out; p.pos = (const int*)d_in[2];
    p.mod = ws + o; o += 2 * 6144;
    p.cosT = ws + o; o += (size_t)S_ * 48;
    p.sinT = ws + o; o += (size_t)S_ * 48;
    p.modpart = ws + o; o += 8 * 12288;
    p.desc0 = (BlkDesc*)(ws + o); o += 96 * 8;
    p.desc_uq = (BlkDesc*)(ws + o); o += 48 * 8;
    p.desc_ukv = (BlkDesc*)(ws + o); o += 64 * 8;
    p.CUMB = ws + o; o += (size_t)8 * S_;
    p.gcnt = (int*)(ws + o); o += 128;
    p.CBIAS = ws + o; o += 128;
    p.barw = (unsigned*)(ws + o); o += 4096;
    p.ew = ws + o; o += (size_t)S_ * 8;
    p.list = (int*)(ws + o); o += (size_t)64 * 16384;
    p.WcT = (bf16_t*)(ws + o); o += (size_t)2 * 64 * 2048 / 2;
    p.KCMP = (bf16_t*)(ws + o); o += (size_t)2 * 1024 * 64 / 2;
    p.VCT = (bf16_t*)(ws + o); o += (size_t)2 * 64 * 1024 / 2;
    if (o * 4 > 15 * MiB) return;
    p.XN = (bf16_t*)(wsb + 15 * MiB); p.OATT = (bf16_t*)(wsb + 47 * MiB);
    char* big = wsb + 79 * MiB;
    {   bf16_t* b = (bf16_t*)big;
        p.QN = b; b += (size_t)S_ * 512; p.KV6 = b; b += (size_t)12 * S_ * 64; p.FQ = b; b += (size_t)S_ * 512; p.FK = b; b += (size_t)S_ * 512; p.FV = b; b += (size_t)S_ * 512;
        p.GATES = (float*)b; p.LOGF = p.GATES + (size_t)S_ * 24; }
    p.KSLF = (bf16_t*)(big + 92 * MiB); p.VSLF = (bf16_t*)(big + 96 * MiB); p.OCMP = (bf16_t*)(big + 100 * MiB); p.OWIN = (bf16_t*)(big + 116 * MiB);
    {   bf16_t* b = (bf16_t*)(big + 96 * MiB);
        p.P1 = b; b += (size_t)S_ * 768; p.CQN = b; b += (size_t)S_ * 384; p.CKVN = b; b += (size_t)S_ * 256;
        p.Q96 = b; b += (size_t)16 * S_ * 96; p.K96 = b; b += (size_t)16 * S_ * 96; p.V1 = b; b += (size_t)16 * S_ * 64; }
    p.YBUF = (bf16_t*)big; p.HID = (bf16_t*)(big + 256 * MiB);
    p.Wgu = (bf16_t*)(wsb + 415 * MiB); p.Wd = p.Wgu + (size_t)65 * 512 * 1024;
    {   bf16_t* b = (bf16_t*)(wsb + 513 * MiB);
        p.W_in0t = b; b += (size_t)3072 * 1024; p.W_out0t = b; b += (size_t)1024 * 1024; p.W_in1t = b; b += (size_t)768 * 1024;
        p.W_uqt = b; b += (size_t)1536 * 384; p.W_ukvt = b; b += (size_t)2048 * 256; p.W_out1t = b; b += (size_t)1024 * 1024; }
    p.ph_lo = 0; p.ph_hi = 20;
    void* args[] = {&p};
    (void)hipLaunchCooperativeKernel((const void*)mega, dim3(grid), dim3(MK_THREADS), args, LDS_TOTAL, stream);
}
```

```cpp
#include <hip/hip_runtime.h>
#include <hip/hip_cooperative_groups.h>
#include <stdint.h>

#define S_ 16384
#define D_ 1024
#define HYIN 2848
#define NEXP 64
#define EPSF 1e-6f

__device__ __forceinline__ float wsum(float v) {
#pragma unroll
    for (int o = 32; o > 0; o >>= 1) v += __shfl_xor(v, o);
    return v;
}
__device__ __forceinline__ float sigmf(float x) { return 1.f / (1.f + expf(-x)); }
__device__ __forceinline__ float logsigmf(float x) { return fminf(x, 0.f) - log1pf(expf(-fabsf(x))); }
#define LAS __attribute__((address_space(3)))
#define GAS __attribute__((address_space(1)))
typedef unsigned short bf16_t;
typedef short bf16x8 __attribute__((ext_vector_type(8)));
typedef float f32x4 __attribute__((ext_vector_type(4)));
typedef float f32x2 __attribute__((ext_vector_type(2)));
typedef unsigned u32x4 __attribute__((ext_vector_type(4)));
typedef unsigned u32x2 __attribute__((ext_vector_type(2)));
typedef __bf16 bf16x2_t __attribute__((ext_vector_type(2)));

__device__ __forceinline__ unsigned cvtpk(float lo, float hi) { f32x2 v = {lo, hi}; bf16x2_t b = __builtin_convertvector(v, bf16x2_t); return __builtin_bit_cast(unsigned, b); }
__device__ __forceinline__ float bf2f(bf16_t v) { return __uint_as_float(((unsigned)v) << 16); }
__device__ __forceinline__ bf16_t f2bf(float f) { return (bf16_t)(cvtpk(f, 0.f) & 0xffffu); }

namespace pg {
constexpr int BM = 256, BK = 64, HALF = 128, HTB = HALF * BK * 2, STAGE_BYTES = 8 * HTB;
__device__ __forceinline__ int lds_byte(int r, int c) { const int st = (r >> 4) * 2 + (c >> 5), rr = r & 15, cc = c & 31, ob = rr * 64 + cc * 2; return st * 1024 + (ob ^ (((ob >> 9) & 1) << 5)); }
__device__ __forceinline__ int perm32(int rho) { const int n = rho >> 4, i = rho & 15; return 8 * (i >> 2) + 4 * n + (i & 3); }
__device__ __forceinline__ void stage_rc(int b, int& R, int& C) { const int st = b / 1024, sb = b % 1024, swz = sb ^ (((sb >> 9) & 1) << 5); R = (st >> 1) * 16 + swz / 64; C = (st & 1) * 32 + (swz % 64) / 2; }

struct Unit { int pm, pn, aux; const char* A; const char* B; unsigned ra[4]; };

template <class Epi, class Sched>
__device__ __forceinline__ void gemm_run(LAS unsigned char* lds, const int K, const Sched& S, const Epi& E) {
    int tid_ = threadIdx.x; asm volatile("" : "+v"(tid_));
    const int tid = tid_, wid = __builtin_amdgcn_readfirstlane(tid >> 6), lane = tid & 63, wr = wid >> 2, wc = wid & 3, fr = lane & 15, fq = lane >> 4;
    int nt_ = K / BK; asm volatile("" : "+s"(nt_)); const int nt = nt_;
    int R0, C0; stage_rc(tid * 16, R0, C0);
    unsigned voffB[2];
#pragma unroll
    for (int i = 0; i < 2; ++i) { const int Rb = Epi::PERM ? ((R0 & ~31) + perm32(R0 & 31)) : R0; voffB[i] = (unsigned)((Rb + 64 * i) * K + C0) * 2u; }
    const size_t kstep = (size_t)(BK * 2);
    const size_t hstep = (size_t)HALF * K * 2;
    const unsigned ldsw = (unsigned)wid * 1024u;
    const int aoff = lds_byte(wr * 64 + fr, fq * 8), boff = lds_byte(wc * 32 + fr, fq * 8);
#define PG_SA(b, h) (((b) * 2 + (h)) * HTB)
#define PG_SB(b, h) ((4 + (b) * 2 + (h)) * HTB)
#define PG_STAGE2(bufoff, gbase, v0, v1) do { \
        __builtin_amdgcn_global_load_lds((const unsigned*)((const char*)(gbase) + (v0)), (LAS unsigned*)(lds + (bufoff) + ldsw), 16, 0, 0); \
        __builtin_amdgcn_global_load_lds((const unsigned*)((const char*)(gbase) + (v1)), (LAS unsigned*)(lds + (bufoff) + ldsw + 8192), 16, 0, 0); } while (0)
#define PG_STAGEB(bufoff, gbase) PG_STAGE2(bufoff, gbase, voffB[0], voffB[1])
#define PG_LDA(dst, b, h) do { _Pragma("unroll") for (int m = 0; m < 4; ++m) _Pragma("unroll") for (int k = 0; k < 2; ++k) dst[m][k] = *(const LAS bf16x8*)(lds + PG_SA(b, h) + aoff + m * 2048 + k * 1024); } while (0)
#define PG_LDB(dst, b, h) do { _Pragma("unroll") for (int n = 0; n < 2; ++n) _Pragma("unroll") for (int k = 0; k < 2; ++k) dst[n][k] = *(const LAS bf16x8*)(lds + PG_SB(b, h) + boff + n * 2048 + k * 1024); } while (0)
#define PG_MMA(ai, bj, At, Bt) do { __builtin_amdgcn_s_setprio(1); _Pragma("unroll") for (int m = 0; m < 4; ++m) _Pragma("unroll") for (int n = 0; n < 2; ++n) _Pragma("unroll") for (int k = 0; k < 2; ++k) \
        acc[ai][bj][m][n] = __builtin_amdgcn_mfma_f32_16x16x32_bf16(Bt[n][k], At[m][k], acc[ai][bj][m][n], 0, 0, 0); __builtin_amdgcn_s_setprio(0); } while (0)
#define PG_WAIT_V(n) asm volatile("s_waitcnt vmcnt(" #n ")" ::: "memory")
#define PG_WAIT_L(n) asm volatile("s_waitcnt lgkmcnt(" #n ")" ::: "memory")
#define PG_BAR __builtin_amdgcn_s_barrier()
#define PG_SCHED __builtin_amdgcn_sched_barrier(0)
    Unit cur, nxt; int ui = 0;
    if (!S.next(0, cur, R0, C0)) return;
    f32x4 acc[2][2][4][2];
#pragma unroll
    for (int a = 0; a < 2; ++a)
#pragma unroll
        for (int b = 0; b < 2; ++b)
#pragma unroll
            for (int m = 0; m < 4; ++m)
#pragma unroll
                for (int n = 0; n < 2; ++n) acc[a][b][m][n] = (f32x4){0.f, 0.f, 0.f, 0.f};
    bf16x8 At[4][2], B0[2][2], B1[2][2];
    const char* cA = cur.A; const char* cB = cur.B;
    PG_STAGEB(PG_SB(0, 0), cB); PG_STAGEB(PG_SB(0, 1), cB + hstep); PG_STAGE2(PG_SA(0, 0), cA, cur.ra[0], cur.ra[1]); PG_STAGE2(PG_SA(0, 1), cA, cur.ra[2], cur.ra[3]);
    if (wr == 1) PG_BAR;
    PG_WAIT_V(2); PG_BAR;
    PG_STAGEB(PG_SB(1, 0), cB + kstep); PG_STAGE2(PG_SA(1, 0), cA + kstep, cur.ra[0], cur.ra[1]); PG_STAGEB(PG_SB(1, 1), cB + hstep + kstep);
    PG_WAIT_V(6); PG_BAR;
    for (;;) {
        const bool has_next = S.next(ui + 1, nxt, R0, C0);
        if (!has_next) nxt = cur;
        const char* nA = nxt.A; const char* nB = nxt.B;
#pragma unroll 1
        for (int t = 0; t < nt; t += 2) {
            const bool last = (t == nt - 2);
            const char* a1 = cA + (size_t)(t + 1) * kstep;
            const char* a2 = last ? nA : cA + (size_t)(t + 2) * kstep; const char* b2 = last ? nB : cB + (size_t)(t + 2) * kstep;
            const char* a3 = a2 + kstep; const char* b3 = b2 + kstep;
            const unsigned r0 = last ? nxt.ra[0] : cur.ra[0], r1 = last ? nxt.ra[1] : cur.ra[1], r2 = last ? nxt.ra[2] : cur.ra[2], r3 = last ? nxt.ra[3] : cur.ra[3];
            PG_LDB(B0, 0, 0); PG_LDB(B1, 0, 1); PG_SCHED; PG_LDA(At, 0, 0); PG_STAGE2(PG_SA(1, 1), a1, cur.ra[2], cur.ra[3]);
            PG_WAIT_V(8); PG_WAIT_L(0); PG_BAR; PG_MMA(0, 0, At, B0); PG_MMA(0, 1, At, B1); PG_BAR; PG_SCHED;
            PG_LDA(At, 0, 1); PG_STAGEB(PG_SB(0, 0), b2); PG_STAGEB(PG_SB(0, 1), b2 + hstep); PG_STAGE2(PG_SA(0, 0), a2, r0, r1);
            PG_WAIT_V(8); PG_WAIT_L(0); PG_BAR; PG_MMA(1, 0, At, B0); PG_MMA(1, 1, At, B1); PG_BAR; PG_SCHED;
            PG_LDB(B0, 1, 0); PG_LDB(B1, 1, 1); PG_SCHED; PG_LDA(At, 1, 0); PG_STAGE2(PG_SA(0, 1), a2, r2, r3);
            PG_WAIT_V(8); PG_WAIT_L(0); PG_BAR; PG_MMA(0, 0, At, B0); PG_MMA(0, 1, At, B1); PG_BAR; PG_SCHED;
            PG_LDA(At, 1, 1); PG_STAGEB(PG_SB(1, 0), b3); PG_STAGEB(PG_SB(1, 1), b3 + hstep); PG_STAGE2(PG_SA(1, 0), a3, r0, r1);
            PG_WAIT_V(8); PG_WAIT_L(0); PG_BAR; PG_MMA(1, 0, At, B0); PG_MMA(1, 1, At, B1); PG_BAR; PG_SCHED;
        }
        if (wr == 0) PG_BAR;
        E(acc, cur, wid, wr, wc, fr, fq);
        if (!has_next) break;
#pragma unroll
        for (int a = 0; a < 2; ++a)
#pragma unroll
            for (int b = 0; b < 2; ++b)
#pragma unroll
                for (int m = 0; m < 4; ++m)
#pragma unroll
                    for (int n = 0; n < 2; ++n) acc[a][b][m][n] = (f32x4){0.f, 0.f, 0.f, 0.f};
        cur = nxt; cA = nA; cB = nB; ++ui;
        if (wr == 1) PG_BAR;
    }
    PG_WAIT_V(0);
    PG_BAR;
#undef PG_SA
#undef PG_SB
#undef PG_STAGE2
#undef PG_STAGEB
#undef PG_LDA
#undef PG_LDB
#undef PG_MMA
}

struct DenseSched {
    const char* A; const char* Bt; int K, nM, nN, nwg, G, c;
    __device__ __forceinline__ void init(const void* A_, const void* Bt_, int M, int N, int K_, int G_, int c_) { A = (const char*)A_; Bt = (const char*)Bt_; K = K_; nM = M / BM; nN = N / BM; nwg = nM * nN; G = G_; c = c_; }
    __device__ __forceinline__ bool next(int i, Unit& u, int R0, int C0) const {
        const long L = (long)i * G + c; if (L >= nwg) return false;
        int wgid = (int)L; { const int q = nwg / 8, r = nwg % 8, xcd = wgid % 8, off = wgid / 8; wgid = (xcd < r ? xcd * (q + 1) : r * (q + 1) + (xcd - r) * q) + off; }
        const int nig = 8 * nN, gid = wgid / nig, fm = gid * 8, gsz = (nM - fm) < 8 ? (nM - fm) : 8;
        u.pm = fm + ((wgid % nig) % gsz); u.pn = (wgid % nig) / gsz; u.aux = 0;
        u.A = A + (size_t)u.pm * BM * K * 2; u.B = Bt + (size_t)u.pn * BM * K * 2;
#pragma unroll
        for (int q = 0; q < 4; ++q) u.ra[q] = (unsigned)((R0 + 64 * q) * K + C0) * 2u;
        return true;
    }
};
}
namespace att {
using s16x4 = __attribute__((ext_vector_type(4))) short;
using f32x16 = __attribute__((ext_vector_type(16))) float;
typedef __attribute__((address_space(3))) const char* lds_cptr;
typedef short v4i16_t __attribute__((ext_vector_type(4)));
constexpr int NSLOT = 3, VSLOT = 8192;
template <int DQ> struct Geo {
    static constexpr int NK = DQ / 16;
    static constexpr int KSLOT = (DQ == 64) ? 8192 : 16384;
    static constexpr int QWAVE = (DQ == 64) ? 4096 : 6144;
    static constexpr int LDS_K = 0, LDS_V = NSLOT * KSLOT, LDS_WS = LDS_V + NSLOT * VSLOT, LDS_OST = LDS_WS + 8 * 64 * 4, LDS_BYTES = LDS_OST + 8 * QWAVE;
};
constexpr int LDS_BIAS = Geo<64>::LDS_BYTES;
#define ASBAR() __builtin_amdgcn_sched_barrier(0)
#define AWAIT_BAR(N) asm volatile("s_waitcnt vmcnt(" #N ") lgkmcnt(0)\n\ts_barrier" ::: "memory")
__device__ __forceinline__ int crow(int r, int hi) { return (r & 3) + 8 * (r >> 2) + 4 * hi; }
__device__ __forceinline__ void glds16(const void* gsrc, unsigned lds_dst) { unsigned keep;
    asm volatile("s_mov_b32 %0, m0\n\ts_mov_b32 m0, %2\n\ts_nop 0\n\tglobal_load_lds_dwordx4 %1, off\n\ts_mov_b32 m0, %0" : "=&s"(keep) : "v"(gsrc), "s"(lds_dst) : "memory"); }
__device__ __forceinline__ float fadd_s(float a, float b) { float r; asm("v_add_f32_e32 %0, %1, %2" : "=v"(r) : "v"(a), "v"(b)); return r; }
__device__ __forceinline__ float fsub_s(float a, float b) { float r; asm("v_sub_f32_e32 %0, %1, %2" : "=v"(r) : "v"(a), "v"(b)); return r; }
__device__ __forceinline__ float max3f(float a, float b, float c) { float r; asm("v_max3_f32 %0, %1, %2, %3" : "=v"(r) : "v"(a), "v"(b), "v"(c)); return r; }
__device__ __forceinline__ float max2f(float a, float b) { float r; asm("v_max_f32_e32 %0, %1, %2" : "=v"(r) : "v"(a), "v"(b)); return r; }
__device__ __forceinline__ s16x4 vtr(lds_cptr p) { return __builtin_bit_cast(s16x4, __builtin_amdgcn_ds_read_tr16_b64_v4i16((__attribute__((address_space(3))) v4i16_t*)p)); }
template <int NK> __device__ __forceinline__ void kloadall(bf16x8* kf, lds_cptr kp) {
#pragma unroll
    for (int j = 0; j < NK; ++j) { kf[2 * j] = *(const LAS bf16x8*)(kp + j * 2048); kf[2 * j + 1] = *(const LAS bf16x8*)(kp + j * 2048 + 512); } }
__device__ __forceinline__ void kload2(bf16x8* kf, lds_cptr kp, int j) { kf[2 * j] = *(const LAS bf16x8*)(kp + j * 2048); kf[2 * j + 1] = *(const LAS bf16x8*)(kp + j * 2048 + 512); }
__device__ __forceinline__ void cmask(f32x16& p0, f32x16& p1, int koff, int qtok, int hi) {
    const int x = qtok - koff - 4 * hi;
#pragma unroll
    for (int r = 0; r < 16; ++r) { const int c = (r & 3) + 8 * (r >> 2); if (c > x) p0[r] = -INFINITY; if (c + 32 > x) p1[r] = -INFINITY; }
}
__device__ __forceinline__ void wmask(f32x16& p0, f32x16& p1, int thr, int hi) {
    const int y = thr - 4 * hi;
#pragma unroll
    for (int r = 0; r < 16; ++r) { const int c = (r & 3) + 8 * (r >> 2); if (c < y) p0[r] = -INFINITY; if (c + 32 < y) p1[r] = -INFINITY; }
}
__device__ __forceinline__ float rowmax(const f32x16& p0, const f32x16& p1) {
    float a = max3f(p0[0], p0[1], p1[0]), b = max3f(p0[2], p0[3], p1[1]); a = max3f(a, p1[2], p1[3]);
#pragma unroll
    for (int r = 4; r < 16; r += 4) { a = max3f(a, p0[r], p0[r + 1]); b = max3f(b, p0[r + 2], p0[r + 3]); a = max3f(a, p1[r], p1[r + 1]); b = max3f(b, p1[r + 2], p1[r + 3]); }
    const float m = max2f(a, b);
    auto rr = __builtin_amdgcn_permlane32_swap(__float_as_uint(m), __float_as_uint(m), false, false);
    return max2f(__uint_as_float(rr[0]), __uint_as_float(rr[1]));
}

enum { MODE_CAUSAL = 0, MODE_FOX = 1, MODE_WIN = 2 };
struct UnitArgs {
    const bf16_t* qrow;
    const bf16_t* K; const bf16_t* V; int kvpitch, vpitch;
    bf16_t* obase; int opitch;
    int qtok;
    int abase;
    int nsteps;
    const LAS float* bias;
};

template <int NB> __device__ __forceinline__ int seq(int i, int abase) { return (i < NB) ? abase + i : abase + NB - 1 - i; }

template <int MODE, bool GQA4, int THRL, int DQ>
__device__ __forceinline__ void attn_unit(const UnitArgs& A, char* shm) {
    constexpr int NB = GQA4 ? 1 : 4;
    typedef Geo<DQ> G; constexpr int NK = G::NK, KSLOT = G::KSLOT, LDS_K = G::LDS_K, LDS_V = G::LDS_V, LDS_WS = G::LDS_WS, LDS_OST = G::LDS_OST, QWAVE = G::QWAVE;
    constexpr bool USE_NEGM = (MODE != MODE_FOX);
    int tid_ = threadIdx.x; asm volatile("" : "+v"(tid_));
    const int tid = tid_, lane = tid & 63, r32 = lane & 31, hi = lane >> 5; const int wid = __builtin_amdgcn_readfirstlane(tid >> 6);
    const unsigned lds0 = (unsigned)(uintptr_t)shm;
    float* wsf = (float*)(shm + LDS_WS) + wid * 64;
    const int NT = A.nsteps, abase = A.abase; const long kvp = A.kvpitch, vvp = A.vpitch;
    const bf16_t* ksrc = A.K + (long)lane * kvp + wid * 8;
    const bf16_t* ksrc2 = A.K + (long)lane * kvp + (8 + (wid & 3)) * 8;
    const bf16_t* vsrc = A.V + (long)(16 * (wid & 3) + (lane >> 2)) * vvp + (wid >> 2) * 32 + (lane & 3) * 8;
    const unsigned kdst = lds0 + LDS_K + wid * 1024, vdst = lds0 + LDS_V + wid * 1024, kdst2 = lds0 + LDS_K + (8 + wid) * 1024;
#define TILE_OF(t) ({ int a_ = seq<NB>((t), abase); a_ < 0 ? 0 : a_; })
#define DMA_K(t, slot) do { const long to_ = (long)TILE_OF(t) * 64 * kvp; glds16(ksrc + to_, (unsigned)__builtin_amdgcn_readfirstlane(kdst + (slot) * KSLOT)); \
        if (DQ == 96) glds16(ksrc2 + to_, (unsigned)__builtin_amdgcn_readfirstlane(kdst2 + (slot) * KSLOT)); } while (0)
#define DMA_V(t, slot) glds16(vsrc + (long)TILE_OF(t) * 64 * vvp, (unsigned)__builtin_amdgcn_readfirstlane(vdst + (slot) * VSLOT))
    const lds_cptr shm3 = (lds_cptr)shm; const lds_cptr kp0 = shm3 + LDS_K + hi * 1024 + r32 * 16;
    const lds_cptr vp0 = shm3 + LDS_V + ((lane >> 4) & 1) * 32 + (lane & 3) * 8 + (4 * hi + ((lane & 15) >> 2)) * 64;
    const int vb0 = (int)(lds0 + LDS_V) + ((lane >> 4) & 1) * 32 + (lane & 3) * 8 + (4 * hi + ((lane & 15) >> 2)) * 64;
    DMA_K(0, 0); DMA_V(0, 0); DMA_K(1, 1);
    bf16x8 qr[NK];
#pragma unroll
    for (int d0 = 0; d0 < NK; ++d0) qr[d0] = *reinterpret_cast<const bf16x8*>(A.qrow + d0 * 16 + hi * 8);
    const lds_cptr qlp = shm3 + LDS_OST + wid * QWAVE + hi * 512 + r32 * 16;
    if (DQ == 96) {
#pragma unroll
        for (int d0 = 0; d0 < NK; ++d0) *(LAS bf16x8*)(const_cast<__attribute__((address_space(3))) char*>(qlp) + d0 * 1024) = qr[d0];
    }
#define QL(d0) (*(const LAS bf16x8*)(qlp + (d0) * 1024))
    float mhat = 0.f, l_reg = 0.f; f32x16 o[2]; o[0] = f32x16{}; o[1] = f32x16{};
    f32x16 negm = f32x16{}; if (USE_NEGM) asm volatile("" : "+v"(negm));
    const int qtok = A.qtok;
#define CMASK(P0, P1, t) do { const int t_ = (t); if (t_ < NB) cmask(P0, P1, 64 * t_, qtok, hi); \
        else { const int a_ = abase + NB - 1 - t_; if (a_ < 0) wmask(P0, P1, 64, hi); \
               else if (MODE == MODE_WIN) { const int thr_ = qtok - 511 + 64 * (abase - a_); if (thr_ > 0) wmask(P0, P1, thr_, hi); } } } while (0)
#define CINIT1(C, t, OFF) do { if (MODE == MODE_FOX) { const LAS float* bt_ = A.bias + 64 * (seq<NB>((t), abase) - (abase + NB - NT)) + 4 * hi + (OFF); const float nm_ = -mhat; \
        _Pragma("unroll") for (int g_ = 0; g_ < 4; ++g_) { const f32x4 b_ = *(const LAS f32x4*)(bt_ + 8 * g_); C[4 * g_] = b_.x; C[4 * g_ + 1] = b_.y; C[4 * g_ + 2] = b_.z; C[4 * g_ + 3] = b_.w; } \
        _Pragma("unroll") for (int r_ = 0; r_ < 16; ++r_) C[r_] += nm_; asm volatile("" : "+v"(C)); } \
      else if (USE_NEGM) { C = negm; } \
      else { const float nm_ = -mhat; _Pragma("unroll") for (int r_ = 0; r_ < 16; ++r_) C[r_] = nm_; asm volatile("" : "+v"(C)); } } while (0)
#define CINIT(C0, C1, t) do { CINIT1(C0, t, 0); CINIT1(C1, t, 32); } while (0)
    bool resc = false;
#define START(P0, P1) do { const float rm = rowmax(P0, P1); resc = false; \
    { const float dl = rm; mhat = fadd_s(mhat, dl); \
      _Pragma("unroll") for (int r = 0; r < 16; ++r) { P0[r] = fsub_s(P0[r], dl); P1[r] = fsub_s(P1[r], dl); } \
      if (USE_NEGM) { _Pragma("unroll") for (int r = 0; r < 16; ++r) negm[r] = -mhat; asm volatile("" : "+v"(negm)); } } \
    _Pragma("unroll") for (int r = 0; r < 16; ++r) P0[r] = __builtin_amdgcn_exp2f(P0[r]); } while (0)
#define RESC() do { if (resc) { asm volatile("s_waitcnt lgkmcnt(0)" ::: "memory"); \
      const float* wsh_ = wsf + 4 * hi; \
      _Pragma("unroll") for (int d_ = 0; d_ < 2; ++d_) _Pragma("unroll") for (int r = 0; r < 16; ++r) o[d_][r] *= wsh_[(r & 3) + 8 * (r >> 2)]; } } while (0)
    f32x16 pA0, pA1, pB0, pB1; bf16x8 kf[2 * NK];
    int sl_prev = 0, sl_cur = 0, sl_next = 1;
#define ROT() do { sl_prev = sl_cur; sl_cur = sl_next; sl_next = (sl_next == NSLOT - 1) ? 0 : sl_next + 1; } while (0)
    DMA_K(2, 2);
    if (DQ == 96) { AWAIT_BAR(5); } else { AWAIT_BAR(3); }
    { const char* kb = shm + LDS_K + hi * 1024 + r32 * 16;
      CINIT(pA0, pA1, 0);
#pragma unroll
      for (int d0 = 0; d0 < NK; ++d0) {
          const bf16x8 b0 = *reinterpret_cast<const bf16x8*>(kb + d0 * 2048);
          const bf16x8 b1 = *reinterpret_cast<const bf16x8*>(kb + d0 * 2048 + 512);
          pA0 = __builtin_amdgcn_mfma_f32_32x32x16_bf16(b0, qr[d0], pA0, 0, 0, 0); pA1 = __builtin_amdgcn_mfma_f32_32x32x16_bf16(b1, qr[d0], pA1, 0, 0, 0); } }
    asm volatile("s_nop 15\n\ts_nop 7" : "+v"(pA0), "+v"(pA1)); CMASK(pA0, pA1, 0);
    START(pA0, pA1);
    _Pragma("unroll") for (int r = 0; r < 16; ++r) pA1[r] = __builtin_amdgcn_exp2f(pA1[r]);
    AWAIT_BAR(0);
    DMA_K(3, 0); DMA_V(1, 1);
    ROT();
    kloadall<NK>(kf, kp0 + sl_cur * KSLOT);
    if (DQ == 96) { AWAIT_BAR(3); } else { AWAIT_BAR(2); }
    s16x4 vlo[(DQ == 96) ? 4 : 8], vhi[(DQ == 96) ? 4 : 8]; u32x4 pw0, pw1, pw2, pw3;
#define PKW(P, B) cvtpk(P[B], P[B + 1])
#define PAF(k) __builtin_bit_cast(bf16x8, pw##k)
#define VFR(i) (bf16x8){vlo[i][0], vlo[i][1], vlo[i][2], vlo[i][3], vhi[i][0], vhi[i][1], vhi[i][2], vhi[i][3]}
#define PIN(x) asm volatile("" : "+v"(x))
#define MX3(a, b, c) __builtin_fmaxf(__builtin_fmaxf((a), (b)), (c))
#define GAPA(MF, A0, A1, A2, A3, W0, W1, PW) do { MF; sacc += A0; sacc += A1; sacc += A2; sacc += A3; PIN(sacc); W0; W1; PIN(PW); ASBAR(); } while (0)
#define EX(v) __builtin_amdgcn_exp2f(v)
#define GAPB(MF, X, B) do { MF; X[B] = EX(X[B]); X[B + 1] = EX(X[B + 1]); X[B + 2] = EX(X[B + 2]); X[B + 3] = EX(X[B + 3]); PIN(X); ASBAR(); } while (0)
#define VRD(i) do { vlo[i] = vtr(vp_ + (((i) >> 2) * 4096 + ((i) & 3) * 1024)); vhi[i] = vtr(vp_ + (((i) >> 2) * 4096 + ((i) & 3) * 1024 + 512)); } while (0)
#define KRD(G_, j) do { if (G_) { kload2(kf, kp0 + sl_next * KSLOT, j); ASBAR(); } } while (0)
#define MFMA32(a, b, c) __builtin_amdgcn_mfma_f32_32x32x16_bf16(a, b, c, 0, 0, 0)
#define STEP64(C0, C1, P0, P1, t, GK, GV, GL, DOMASK) do { ASBAR(); \
    const lds_cptr vp_ = vp0 + sl_prev * VSLOT; \
    CINIT1(C0, t, 0); ASBAR(); \
    VRD(0); ASBAR(); float sacc = (P0[0] + P0[1]); \
    GAPA(C0 = MFMA32(kf[0], qr[0], C0), P0[2], P0[3], P0[4], P0[5],     pw0[0] = PKW(P0, 0), pw0[1] = PKW(P0, 2), pw0); \
    CINIT1(C1, t, 32); ASBAR(); \
    VRD(4); ASBAR(); GAPA(C1 = MFMA32(kf[1], qr[0], C1), P0[6], P0[7], P0[8], P0[9],     pw0[2] = PKW(P0, 4), pw0[3] = PKW(P0, 6), pw0); \
    VRD(1); ASBAR(); GAPA(C0 = MFMA32(kf[2], qr[1], C0),   P0[10], P0[11], P0[12], P0[13], pw1[0] = PKW(P0, 8), pw1[1] = PKW(P0, 10), pw1); \
    VRD(5); ASBAR(); GAPA(C1 = MFMA32(kf[3], qr[1], C1),   P0[14], P0[15], P1[0], P1[1],   pw1[2] = PKW(P0, 12), pw1[3] = PKW(P0, 14), pw1); \
    VRD(2); ASBAR(); GAPA(C0 = MFMA32(kf[4], qr[2], C0),   P1[2], P1[3], P1[4], P1[5],     pw2[0] = PKW(P1, 0), pw2[1] = PKW(P1, 2), pw2); \
    VRD(6); ASBAR(); GAPA(C1 = MFMA32(kf[5], qr[2], C1),   P1[6], P1[7], P1[8], P1[9],     pw2[2] = PKW(P1, 4), pw2[3] = PKW(P1, 6), pw2); \
    VRD(3); ASBAR(); GAPA(C0 = MFMA32(kf[6], qr[3], C0),   P1[10], P1[11], P1[12], P1[13], pw3[0] = PKW(P1, 8), pw3[1] = PKW(P1, 10), pw3); \
    VRD(7); ASBAR(); GAPA(C1 = MFMA32(kf[7], qr[3], C1),   P1[14], P1[15], 0.f, 0.f,       pw3[2] = PKW(P1, 12), pw3[3] = PKW(P1, 14), pw3); \
    l_reg += sacc; \
    if (GK) { DMA_K((t) + 3, sl_cur); } if (GV) { DMA_V((t) + 1, sl_next); } \
    if (DOMASK) CMASK(C0, C1, t); \
    { float a = MX3(C0[0], C0[1], C1[0]), b = MX3(C0[2], C0[3], C1[1]); a = MX3(a, C1[2], C1[3]); \
      _Pragma("unroll") for (int r = 4; r < 16; r += 4) { a = MX3(a, C0[r], C0[r + 1]); b = MX3(b, C0[r + 2], C0[r + 3]); a = MX3(a, C1[r], C1[r + 1]); b = MX3(b, C1[r + 2], C1[r + 3]); } \
      float rm = __builtin_fmaxf(a, b); { auto rr = __builtin_amdgcn_permlane32_swap(__float_as_uint(rm), __float_as_uint(rm), false, false); rm = __builtin_fmaxf(__uint_as_float(rr[0]), __uint_as_float(rr[1])); } \
      resc = false; \
      if (__builtin_expect(__any(rm > (float)THRL), 0)) { const float dl = __builtin_fmaxf(rm, 0.f); mhat += dl; \
        _Pragma("unroll") for (int r = 0; r < 16; ++r) { C0[r] -= dl; C1[r] -= dl; } \
        if (USE_NEGM) { _Pragma("unroll") for (int r = 0; r < 16; ++r) negm[r] = -mhat; asm volatile("" : "+v"(negm)); } \
        const float f = __builtin_amdgcn_exp2f(-dl); l_reg *= f; if (hi == 0) wsf[r32] = f; resc = true; } } \
    ASBAR(); \
    GAPB(o[0] = MFMA32(PAF(0), VFR(0), o[0]), C0, 0); \
    GAPB(o[1] = MFMA32(PAF(0), VFR(4), o[1]), C0, 4); \
    KRD(GL, 0); GAPB(o[0] = MFMA32(PAF(1), VFR(1), o[0]), C0, 8); \
    KRD(GL, 1); GAPB(o[1] = MFMA32(PAF(1), VFR(5), o[1]), C0, 12); \
    KRD(GL, 2); GAPB(o[0] = MFMA32(PAF(2), VFR(2), o[0]), C1, 0); \
    KRD(GL, 3); GAPB(o[1] = MFMA32(PAF(2), VFR(6), o[1]), C1, 4); \
    GAPB(o[0] = MFMA32(PAF(3), VFR(3), o[0]), C1, 8); \
    GAPB(o[1] = MFMA32(PAF(3), VFR(7), o[1]), C1, 12); \
    } while (0)
#define AWAIT_STEADY() do { if (DQ == 96) { AWAIT_BAR(3); } else { AWAIT_BAR(2); } } while (0)
#define VRD4(i, b) do { vlo[b] = vtr(vp_ + (((i) >> 2) * 4096 + ((i) & 3) * 1024)); vhi[b] = vtr(vp_ + (((i) >> 2) * 4096 + ((i) & 3) * 1024 + 512)); } while (0)
#define VFR4(b) (bf16x8){vlo[b][0], vlo[b][1], vlo[b][2], vlo[b][3], vhi[b][0], vhi[b][1], vhi[b][2], vhi[b][3]}
#define GAPQ(MF, QLD, A0, A1, A2, A3, W0, W1, PW) do { MF; QLD; sacc += A0; sacc += A1; sacc += A2; sacc += A3; PIN(sacc); W0; W1; PIN(PW); ASBAR(); } while (0)
#define STEP96(C0, C1, P0, P1, t, GK, GV, GL, DOMASK) do { ASBAR(); \
    const lds_cptr vp_ = vp0 + sl_prev * VSLOT; \
    CINIT1(C0, t, 0); CINIT1(C1, t, 32); bf16x8 qa = QL(0), qb; ASBAR(); \
    float sacc = (P0[0] + P0[1]); \
    GAPQ(C0 = MFMA32(kf[0], qa, C0), qb = QL(1), P0[2], P0[3], P0[4], P0[5],     pw0[0] = PKW(P0, 0), pw0[1] = PKW(P0, 2), pw0); \
    GAPQ(C1 = MFMA32(kf[1], qa, C1), (void)0,    P0[6], P0[7], P0[8], P0[9],     pw0[2] = PKW(P0, 4), pw0[3] = PKW(P0, 6), pw0); \
    GAPQ(C0 = MFMA32(kf[2], qb, C0), qa = QL(2), P0[10], P0[11], P0[12], P0[13], pw1[0] = PKW(P0, 8), pw1[1] = PKW(P0, 10), pw1); \
    GAPQ(C1 = MFMA32(kf[3], qb, C1), (void)0,    P0[14], P0[15], P1[0], P1[1],   pw1[2] = PKW(P0, 12), pw1[3] = PKW(P0, 14), pw1); \
    GAPQ(C0 = MFMA32(kf[4], qa, C0), qb = QL(3), P1[2], P1[3], P1[4], P1[5],     pw2[0] = PKW(P1, 0), pw2[1] = PKW(P1, 2), pw2); \
    GAPQ(C1 = MFMA32(kf[5], qa, C1), (void)0,    P1[6], P1[7], P1[8], P1[9],     pw2[2] = PKW(P1, 4), pw2[3] = PKW(P1, 6), pw2); \
    GAPQ(C0 = MFMA32(kf[6], qb, C0), qa = QL(4), P1[10], P1[11], P1[12], P1[13], pw3[0] = PKW(P1, 8), pw3[1] = PKW(P1, 10), pw3); \
    GAPQ(C1 = MFMA32(kf[7], qb, C1), (void)0,    P1[14], P1[15], 0.f, 0.f,       pw3[2] = PKW(P1, 12), pw3[3] = PKW(P1, 14), pw3); \
    C0 = MFMA32(kf[8], qa, C0); qb = QL(5); VRD4(0, 0); ASBAR(); \
    C1 = MFMA32(kf[9], qa, C1); VRD4(4, 1); ASBAR(); \
    C0 = MFMA32(kf[10], qb, C0); ASBAR(); \
    C1 = MFMA32(kf[11], qb, C1); ASBAR(); \
    l_reg += sacc; \
    if (GK) { DMA_K((t) + 3, sl_cur); } if (GV) { DMA_V((t) + 1, sl_next); } \
    if (DOMASK) CMASK(C0, C1, t); \
    { float a = MX3(C0[0], C0[1], C1[0]), b = MX3(C0[2], C0[3], C1[1]); a = MX3(a, C1[2], C1[3]); \
      _Pragma("unroll") for (int r = 4; r < 16; r += 4) { a = MX3(a, C0[r], C0[r + 1]); b = MX3(b, C0[r + 2], C0[r + 3]); a = MX3(a, C1[r], C1[r + 1]); b = MX3(b, C1[r + 2], C1[r + 3]); } \
      float rm = __builtin_fmaxf(a, b); { auto rr = __builtin_amdgcn_permlane32_swap(__float_as_uint(rm), __float_as_uint(rm), false, false); rm = __builtin_fmaxf(__uint_as_float(rr[0]), __uint_as_float(rr[1])); } \
      resc = false; \
      if (__builtin_expect(__any(rm > (float)THRL), 0)) { const float dl = __builtin_fmaxf(rm, 0.f); mhat += dl; \
        _Pragma("unroll") for (int r = 0; r < 16; ++r) { C0[r] -= dl; C1[r] -= dl; } \
        if (USE_NEGM) { _Pragma("unroll") for (int r = 0; r < 16; ++r) negm[r] = -mhat; asm volatile("" : "+v"(negm)); } \
        const float f = __builtin_amdgcn_exp2f(-dl); l_reg *= f; if (hi == 0) wsf[r32] = f; resc = true; } } \
    ASBAR(); \
    VRD4(1, 2); ASBAR(); GAPB(o[0] = MFMA32(PAF(0), VFR4(0), o[0]), C0, 0); \
    VRD4(5, 3); ASBAR(); GAPB(o[1] = MFMA32(PAF(0), VFR4(1), o[1]), C0, 4); \
    VRD4(2, 0); KRD(GL, 0); GAPB(o[0] = MFMA32(PAF(1), VFR4(2), o[0]), C0, 8); \
    VRD4(6, 1); KRD(GL, 1); GAPB(o[1] = MFMA32(PAF(1), VFR4(3), o[1]), C0, 12); \
    VRD4(3, 2); KRD(GL, 2); GAPB(o[0] = MFMA32(PAF(2), VFR4(0), o[0]), C1, 0); \
    VRD4(7, 3); KRD(GL, 3); GAPB(o[1] = MFMA32(PAF(2), VFR4(1), o[1]), C1, 4); \
    KRD(GL, 4); GAPB(o[0] = MFMA32(PAF(3), VFR4(2), o[0]), C1, 8); \
    KRD(GL, 5); GAPB(o[1] = MFMA32(PAF(3), VFR4(3), o[1]), C1, 12); \
    } while (0)
#define STEP(C0, C1, P0, P1, t, GK, GV, GL, DOMASK) do { if constexpr (DQ == 96) { STEP96(C0, C1, P0, P1, t, GK, GV, GL, DOMASK); } else { STEP64(C0, C1, P0, P1, t, GK, GV, GL, DOMASK); } } while (0)
#define ENDW(tt) do { if ((tt) + 3 < NT) { AWAIT_STEADY(); } else if ((tt) + 2 < NT) { AWAIT_BAR(1); } else { AWAIT_BAR(0); } } while (0)
    int t = 1;
    for (; t < 5 && t + 1 < NT; t += 2) {
        STEP(pB0, pB1, pA0, pA1, t, (t + 3 < NT), (t + 1 < NT), (t + 1 < NT), true);       ENDW(t);     RESC(); ROT();
        STEP(pA0, pA1, pB0, pB1, t + 1, (t + 4 < NT), (t + 2 < NT), (t + 2 < NT), true);   ENDW(t + 1); RESC(); ROT();
    }
    for (; t + 5 < NT; t += 2) {
        STEP(pB0, pB1, pA0, pA1, t, true, true, true, false);     AWAIT_STEADY(); RESC(); ROT();
        STEP(pA0, pA1, pB0, pB1, t + 1, true, true, true, false); AWAIT_STEADY(); RESC(); ROT();
    }
    for (; t + 1 < NT; t += 2) {
        STEP(pB0, pB1, pA0, pA1, t, (t + 3 < NT), (t + 1 < NT), (t + 1 < NT), true);       ENDW(t);     RESC(); ROT();
        STEP(pA0, pA1, pB0, pB1, t + 1, (t + 4 < NT), (t + 2 < NT), (t + 2 < NT), true);   ENDW(t + 1); RESC(); ROT();
    }
    STEP(pB0, pB1, pA0, pA1, NT - 1, false, false, false, true); RESC();
    { float sacc = pB0[0] + pB0[1];
      _Pragma("unroll") for (int r = 2; r < 16; ++r) sacc += pB0[r];
      _Pragma("unroll") for (int r = 0; r < 16; ++r) sacc += pB1[r];
      l_reg += sacc;
      pw0 = (u32x4){PKW(pB0, 0), PKW(pB0, 2), PKW(pB0, 4), PKW(pB0, 6)}; pw1 = (u32x4){PKW(pB0, 8), PKW(pB0, 10), PKW(pB0, 12), PKW(pB0, 14)};
      pw2 = (u32x4){PKW(pB1, 0), PKW(pB1, 2), PKW(pB1, 4), PKW(pB1, 6)}; pw3 = (u32x4){PKW(pB1, 8), PKW(pB1, 10), PKW(pB1, 12), PKW(pB1, 14)};
      ASBAR();
      const int vb = vb0 + sl_cur * VSLOT;
#pragma unroll
      for (int d0 = 0; d0 < 2; ++d0) { s16x4 lo[4], hh[4];
#pragma unroll
          for (int ks = 0; ks < 4; ++ks) {
              asm volatile("ds_read_b64_tr_b16 %0,%1 offset:%c2" : "=&v"(lo[ks]) : "v"(vb), "i"(d0 * 4096 + ks * 1024) : "memory");
              asm volatile("ds_read_b64_tr_b16 %0,%1 offset:%c2" : "=&v"(hh[ks]) : "v"(vb), "i"(d0 * 4096 + ks * 1024 + 512) : "memory"); }
          asm volatile("s_waitcnt lgkmcnt(0)" ::: "memory"); ASBAR();
#define PK(k) (bf16x8){lo[k][0], lo[k][1], lo[k][2], lo[k][3], hh[k][0], hh[k][1], hh[k][2], hh[k][3]}
          o[d0] = MFMA32(PAF(0), PK(0), o[d0]); o[d0] = MFMA32(PAF(1), PK(1), o[d0]); o[d0] = MFMA32(PAF(2), PK(2), o[d0]); o[d0] = MFMA32(PAF(3), PK(3), o[d0]);
#undef PK
      } }
    { auto rr = __builtin_amdgcn_permlane32_swap(__float_as_uint(l_reg), __float_as_uint(l_reg), false, false); l_reg = __uint_as_float(rr[0]) + __uint_as_float(rr[1]); }
    if (hi == 0) wsf[32 + r32] = l_reg; asm volatile("s_waitcnt lgkmcnt(0)" ::: "memory");
    int lane_e = lane; asm volatile("" : "+v"(lane_e)); const int hi_e = lane_e >> 5, r32_e = lane_e & 31;
    float rli[16];
    { const float* wl_ = wsf + 32 + 4 * hi_e;
#pragma unroll
      for (int r = 0; r < 16; ++r) rli[r] = __builtin_amdgcn_rcpf(wl_[(r & 3) + 8 * (r >> 2)]); }
    { bf16_t* stg = (bf16_t*)(shm + LDS_OST + wid * QWAVE);
      bf16_t* stl = stg + (4 * hi_e) * 64 + r32_e;
#pragma unroll
      for (int r = 0; r < 16; ++r) {
#pragma unroll
          for (int d0 = 0; d0 < 2; ++d0) stl[((r & 3) + 8 * (r >> 2)) * 64 + d0 * 32] = f2bf(o[d0][r] * rli[r]); }
      asm volatile("s_waitcnt lgkmcnt(0)" ::: "memory");
#pragma unroll
      for (int i = 0; i < 4; ++i) { const int row = i * 8 + (lane_e >> 3), ch = lane_e & 7; const u32x4 v = *(const u32x4*)(stg + row * 64 + ch * 8);
          bf16_t* dst = GQA4 ? (A.obase + (long)(8 * wid + (row >> 2)) * A.opitch + (row & 3) * 64) : (A.obase + (long)(32 * wid + row) * A.opitch);
          *(u32x4*)(dst + ch * 8) = v; } }
    asm volatile("s_waitcnt lgkmcnt(0)\n\ts_barrier" ::: "memory");
#undef TILE_OF
#undef DMA_K
#undef DMA_V
#undef CMASK
#undef CINIT
#undef START
#undef RESC
#undef ROT
#undef PKW
#undef PAF
#undef VFR
#undef PIN
#undef MX3
#undef GAPA
#undef GAPB
#undef EX
#undef VRD
#undef KRD
#undef MFMA32
#undef STEP
#undef STEP64
#undef STEP96
#undef VRD4
#undef VFR4
#undef GAPQ
#undef QL
#undef ENDW
#undef AWAIT_STEADY
}
}
constexpr int MK_THREADS = 512;
constexpr int LDS_RING = 131072;
constexpr int LDS_X = LDS_RING;
constexpr int LDS_MOD = LDS_RING + 8192;
constexpr int LDS_BARST = 155648 - 16;
constexpr int LDS_TOTAL = 155648;

#define C2Q 0.18033688011112042f
#define LOG2E 1.4426950408889634f

struct BlkDesc { bf16_t* dst; const float* gain; int pitch; int flags; float scale; int csoff; };
#define C2M 0.14724312203508865f
struct MKP {
    const float* in[34];
    float* out;
    float* modpart;
    float* mod;
    float* cosT; float* sinT;
    bf16_t* W_in0t;
    bf16_t* W_out0t;
    bf16_t* XN;
    bf16_t* OATT;
    bf16_t* QN;
    bf16_t* KV6;
    bf16_t* FQ; bf16_t* FK; bf16_t* FV;
    float* GATES;
    float* LOGF;
    BlkDesc* desc0;
    float* CUMB;
    BlkDesc* desc_uq;
    BlkDesc* desc_ukv;
    bf16_t* W_in1t;
    bf16_t* W_uqt;
    bf16_t* W_ukvt;
    bf16_t* W_out1t;
    bf16_t* P1;
    bf16_t* CQN;
    bf16_t* CKVN;
    bf16_t* Q96;
    bf16_t* K96;
    bf16_t* V1;
    bf16_t* WcT;
    float* CBIAS;
    bf16_t* KCMP;
    bf16_t* VCT;
    bf16_t* KSLF;
    bf16_t* VSLF;
    bf16_t* OCMP;
    bf16_t* OWIN;
    const int* pos;
    bf16_t* Wgu;
    bf16_t* Wd;
    bf16_t* HID;
    bf16_t* YBUF;
    int* gcnt;
    int* list;
    float* ew;
    unsigned* barw;
    int ph_lo, ph_hi, dbg_flags, pad_;
};

__device__ __forceinline__ int swap45(int p) { return (p & 15) | ((p & 16) << 1) | ((p & 32) >> 1); }

template <class Map>
__device__ __forceinline__ void tr_item(const float* __restrict__ W, int ldw, int K, bf16_t* WT, LAS float* scr, int kb, int nb, int lane, const Map& cmap, const float* kscale) {
    const int k0 = 64 * kb, n0 = 32 * nb;
    const int sc = cmap(n0 + (lane & 31));
    float v[32];
    const float* src = W + (size_t)(k0 + (lane >> 5)) * ldw + (sc >= 0 ? sc : 0);
#pragma unroll
    for (int i = 0; i < 32; ++i) v[i] = src[(size_t)(2 * i) * ldw];
    if (kscale) {
#pragma unroll
        for (int i = 0; i < 32; ++i) v[i] *= kscale[k0 + 2 * i + (lane >> 5)];
    }
#pragma unroll
    for (int i = 0; i < 32; ++i) scr[(2 * i + (lane >> 5)) * 33 + (lane & 31)] = (sc >= 0) ? v[i] : 0.f;
    asm volatile("s_waitcnt lgkmcnt(0)" ::: "memory");
    const int c = lane & 7;
#pragma unroll
    for (int j = 0; j < 4; ++j) {
        const int n = (lane >> 3) + 8 * j; const LAS float* s = scr + (8 * c) * 33 + n;
        u32x4 o; o.x = cvtpk(s[0 * 33], s[1 * 33]); o.y = cvtpk(s[2 * 33], s[3 * 33]); o.z = cvtpk(s[4 * 33], s[5 * 33]); o.w = cvtpk(s[6 * 33], s[7 * 33]);
        *(u32x4*)(WT + (size_t)(n0 + n) * K + k0 + 8 * c) = o;
    }
    asm volatile("s_waitcnt lgkmcnt(0)" ::: "memory");
}
struct MapIn0 {
    __device__ __forceinline__ int operator()(int nn) const {
        const int blk = nn >> 6, p = nn & 63;
        if (blk < 8) return blk * 64 + swap45(p);
        if (blk < 20) return 512 + (blk - 8) * 64 + swap45(p);
        if (blk < 44) return 1304 + (blk - 20) * 64 + swap45(p);
        if (blk == 44) { if (p < 24) return 1280 + p; if (p < 32) return 2840 + (p - 24); return -1; }
        return -1;
    }
};
struct MapId { __device__ __forceinline__ int operator()(int nn) const { return nn; } };
struct MapIn1 { __device__ __forceinline__ int operator()(int nn) const { return nn < 672 ? nn : -1; } };
struct MapUq { __device__ __forceinline__ int operator()(int nn) const { if (nn < 1024) return (nn >> 6) * 96 + swap45(nn & 63); const int r = nn - 1024; return (r >> 5) * 96 + 64 + (r & 31); } };
struct MapUkv { __device__ __forceinline__ int operator()(int nn) const { if (nn < 1024) return (nn >> 6) * 128 + swap45(nn & 63); const int r = nn - 1024; return (r >> 6) * 128 + 64 + swap45(r & 63); } };

namespace nsa {
using att::f32x16; using att::crow;
#define NMFMA32(a, b, c) __builtin_amdgcn_mfma_f32_32x32x16_bf16(a, b, c, 0, 0, 0)
#define NMFMA16(a, b, c) __builtin_amdgcn_mfma_f32_16x16x32_bf16(a, b, c, 0, 0, 0)
#define RLF(x, l) __uint_as_float(__builtin_amdgcn_readlane((int)__float_as_uint(x), (l)))

__device__ __forceinline__ void compress_job(const MKP& p, LAS float* scr, int job, int lane) {
    const int nt = job & 31, g = (job >> 5) & 1, kv = job >> 6;
    const int r32 = lane & 31, hi = lane >> 5, n0 = nt * 32;
    const bf16_t* tok = p.KV6 + (size_t)(kv * 2 + g) * S_ * 64;
    const bf16_t* wt = p.WcT + (size_t)kv * 64 * 2048;
    scr[lane] = p.CBIAS[kv * 64 + lane];
    asm volatile("s_waitcnt lgkmcnt(0)" ::: "memory");
    int nrow = n0 + r32; if (nrow > 1022) nrow = 1022;
    const bf16_t* ta = tok + (size_t)(16 * nrow) * 64 + 8 * hi;
    const bf16_t* wa0 = wt + (size_t)r32 * 2048 + 8 * hi;
    const bf16_t* wa1 = wa0 + (size_t)32 * 2048;
    f32x16 c0 = f32x16{}, c1 = f32x16{};
    if (kv == 0) {
#pragma unroll 8
        for (int s = 0; s < 128; ++s) {
            const bf16x8 tf = *(const bf16x8*)(ta + 16 * s), w0 = *(const bf16x8*)(wa0 + 16 * s), w1 = *(const bf16x8*)(wa1 + 16 * s);
            c0 = NMFMA32(w0, tf, c0); c1 = NMFMA32(w1, tf, c1);
        }
        float ss = 0.f;
#pragma unroll
        for (int r = 0; r < 16; ++r) { c0[r] += scr[crow(r, hi)]; c1[r] += scr[32 + crow(r, hi)]; ss += c0[r] * c0[r] + c1[r] * c1[r]; }
        { auto rr = __builtin_amdgcn_permlane32_swap(__float_as_uint(ss), __float_as_uint(ss), false, false); ss = __uint_as_float(rr[0]) + __uint_as_float(rr[1]); }
        const float rs = rsqrtf(ss * (1.f / 64.f) + EPSF);
        const float* gn = p.in[10];
        if (n0 + r32 < 1023) {
            bf16_t* dst = p.KCMP + ((size_t)g * 1024 + n0 + r32) * 64;
#pragma unroll
            for (int q = 0; q < 4; ++q) {
                const int e0 = 8 * q + 4 * hi;
                const f32x4 ga = *(const f32x4*)(gn + e0), gb = *(const f32x4*)(gn + 32 + e0);
                u32x2 wa, wb;
                wa.x = cvtpk(c0[4 * q] * rs * ga.x, c0[4 * q + 1] * rs * ga.y); wa.y = cvtpk(c0[4 * q + 2] * rs * ga.z, c0[4 * q + 3] * rs * ga.w);
                wb.x = cvtpk(c1[4 * q] * rs * gb.x, c1[4 * q + 1] * rs * gb.y); wb.y = cvtpk(c1[4 * q + 2] * rs * gb.z, c1[4 * q + 3] * rs * gb.w);
                *(u32x2*)(dst + e0) = wa; *(u32x2*)(dst + 32 + e0) = wb;
            }
        }
    } else {
#pragma unroll 8
        for (int s = 0; s < 128; ++s) {
            const bf16x8 tf = *(const bf16x8*)(ta + 16 * s), w0 = *(const bf16x8*)(wa0 + 16 * s), w1 = *(const bf16x8*)(wa1 + 16 * s);
            c0 = NMFMA32(tf, w0, c0); c1 = NMFMA32(tf, w1, c1);
        }
        const float b0 = scr[r32], b1 = scr[32 + r32];
#pragma unroll
        for (int G = 0; G < 2; ++G) {
            u32x4 va, vb;
            va.x = cvtpk(c0[8 * G] + b0, c0[8 * G + 1] + b0); va.y = cvtpk(c0[8 * G + 2] + b0, c0[8 * G + 3] + b0); va.z = cvtpk(c0[8 * G + 4] + b0, c0[8 * G + 5] + b0); va.w = cvtpk(c0[8 * G + 6] + b0, c0[8 * G + 7] + b0);
            vb.x = cvtpk(c1[8 * G] + b1, c1[8 * G + 1] + b1); vb.y = cvtpk(c1[8 * G + 2] + b1, c1[8 * G + 3] + b1); vb.z = cvtpk(c1[8 * G + 4] + b1, c1[8 * G + 5] + b1); vb.w = cvtpk(c1[8 * G + 6] + b1, c1[8 * G + 7] + b1);
            *(u32x4*)(p.VCT + ((size_t)g * 64 + r32) * 1024 + n0 + 16 * G + 8 * hi) = va;
            *(u32x4*)(p.VCT + ((size_t)g * 64 + 32 + r32) * 1024 + n0 + 16 * G + 8 * hi) = vb;
        }
    }
    asm volatile("s_waitcnt lgkmcnt(0)" ::: "memory");
}

__device__ __forceinline__ unsigned pk4_fp8(float a, float b, float c, float d) { int w = __builtin_amdgcn_cvt_pk_fp8_f32(a, b, 0, false); w = __builtin_amdgcn_cvt_pk_fp8_f32(c, d, w, true); return (unsigned)w; }
__device__ __forceinline__ void slcfrag_job(const MKP& p, int job, int lane) {
    const int g = job >> 8, blk = job & 255, c16 = lane & 15, u = lane >> 4;
    const bf16_t* k = p.KV6 + (size_t)(2 * 2 + g) * S_ * 64 + (size_t)blk * 64 * 64;
    const bf16_t* v = p.KV6 + (size_t)(3 * 2 + g) * S_ * 64 + (size_t)blk * 64 * 64;
    unsigned char* kd = (unsigned char*)p.KSLF + ((size_t)g * 256 + blk) * 4096 + lane * 16;
    unsigned char* vd = (unsigned char*)p.VSLF + ((size_t)g * 256 + blk) * 4096 + lane * 16;
#pragma unroll
    for (int kg = 0; kg < 4; ++kg) {
        const u32x4 a = *(const u32x4*)(k + (size_t)(16 * kg + c16) * 64 + 8 * u), b = *(const u32x4*)(k + (size_t)(16 * kg + c16) * 64 + 32 + 8 * u);
        u32x4 o;
        o.x = pk4_fp8(__uint_as_float(a.x << 16), __uint_as_float(a.x & 0xffff0000u), __uint_as_float(a.y << 16), __uint_as_float(a.y & 0xffff0000u));
        o.y = pk4_fp8(__uint_as_float(a.z << 16), __uint_as_float(a.z & 0xffff0000u), __uint_as_float(a.w << 16), __uint_as_float(a.w & 0xffff0000u));
        o.z = pk4_fp8(__uint_as_float(b.x << 16), __uint_as_float(b.x & 0xffff0000u), __uint_as_float(b.y << 16), __uint_as_float(b.y & 0xffff0000u));
        o.w = pk4_fp8(__uint_as_float(b.z << 16), __uint_as_float(b.z & 0xffff0000u), __uint_as_float(b.w << 16), __uint_as_float(b.w & 0xffff0000u));
        *(u32x4*)(kd + kg * 1024) = o;
    }
#pragma unroll
    for (int dg = 0; dg < 4; ++dg) {
        float x[16];
#pragma unroll
        for (int ch = 0; ch < 2; ++ch)
#pragma unroll
            for (int j = 0; j < 8; ++j) { const int key = 32 * ch + ((j < 4) ? 4 * u + j : 16 + 4 * u + (j - 4)); x[ch * 8 + j] = bf2f(v[(size_t)key * 64 + 16 * dg + c16]); }
        u32x4 o; o.x = pk4_fp8(x[0], x[1], x[2], x[3]); o.y = pk4_fp8(x[4], x[5], x[6], x[7]); o.z = pk4_fp8(x[8], x[9], x[10], x[11]); o.w = pk4_fp8(x[12], x[13], x[14], x[15]);
        *(u32x4*)(vd + dg * 1024) = o;
    }
}

constexpr int IMP_LD = 272;
__device__ __forceinline__ void cmp_wave(const MKP& p, int g, int t0w, LAS float* imp, LAS unsigned char* stg, int lane) {
    const int r32 = lane & 31, hi = lane >> 5;
    const int tq = t0w + (r32 >> 2), head = g * 4 + (r32 & 3);
    const int nmax = (tq >= 31) ? ((tq - 31) >> 4) : -1;
    const int nmaxw = (t0w + 7 >= 31) ? ((t0w + 7 - 31) >> 4) : -1;
    const int ntile = (nmaxw >> 6) + 1;
    for (int i = lane; i < 8 * IMP_LD; i += 64) imp[i] = 0.f;
    bf16x8 qr[4];
#pragma unroll
    for (int d0 = 0; d0 < 4; ++d0) qr[d0] = *(const bf16x8*)(p.QN + (size_t)tq * 512 + head * 64 + d0 * 16 + hi * 8);
    const bf16_t* kc = p.KCMP + (size_t)g * 1024 * 64 + (size_t)r32 * 64 + 8 * hi;
    bf16x8 ovf[4];
#pragma unroll
    for (int ks = 0; ks < 4; ++ks)
#pragma unroll
        for (int j = 0; j < 8; ++j) {
            const int nrel = 16 * ks + ((j < 4) ? 4 * hi + j : 8 + 4 * hi + (j - 4));
            const int dlt = nrel - 4 * r32;
            const float w = (dlt >= 0 && dlt <= 2) ? 2.f : ((dlt == 3 || dlt == -1) ? 1.f : 0.f);
            ovf[ks][j] = (short)f2bf(w);
        }
    float m = -INFINITY, l = 0.f;
    for (int c = 0; c < ntile; ++c) {
        f32x16 s0 = f32x16{}, s1 = f32x16{};
        const bf16_t* kt = kc + (size_t)c * 64 * 64;
#pragma unroll
        for (int d0 = 0; d0 < 4; ++d0) { const bf16x8 k0 = *(const bf16x8*)(kt + 16 * d0), k1 = *(const bf16x8*)(kt + 32 * 64 + 16 * d0); s0 = NMFMA32(k0, qr[d0], s0); s1 = NMFMA32(k1, qr[d0], s1); }
        const int x = nmax - 64 * c - 4 * hi;
        float tm = -INFINITY;
#pragma unroll
        for (int r = 0; r < 16; ++r) { const int cc = (r & 3) + 8 * (r >> 2); if (cc > x) s0[r] = -INFINITY; if (cc + 32 > x) s1[r] = -INFINITY; tm = fmaxf(tm, fmaxf(s0[r], s1[r])); }
        if (tm > m) { l *= __builtin_amdgcn_exp2f(m - tm); m = tm; }
        if (m > -INFINITY) {
            float sum = 0.f;
#pragma unroll
            for (int r = 0; r < 16; ++r) sum += __builtin_amdgcn_exp2f(s0[r] - m) + __builtin_amdgcn_exp2f(s1[r] - m);
            l += sum;
        }
    }
    { auto rm = __builtin_amdgcn_permlane32_swap(__float_as_uint(m), __float_as_uint(m), false, false);
      auto rl = __builtin_amdgcn_permlane32_swap(__float_as_uint(l), __float_as_uint(l), false, false);
      const float ma = __uint_as_float(rm[0]), mb = __uint_as_float(rm[1]), la = __uint_as_float(rl[0]), lb = __uint_as_float(rl[1]);
      const float mm = fmaxf(ma, mb);
      if (mm > -INFINITY) { l = ((ma > -INFINITY) ? la * __builtin_amdgcn_exp2f(ma - mm) : 0.f) + ((mb > -INFINITY) ? lb * __builtin_amdgcn_exp2f(mb - mm) : 0.f); m = mm; }
      else { l = 0.f; m = 0.f; } }
    const float invl = (l > 0.f) ? 1.f / l : 0.f;
    f32x16 o0 = f32x16{}, o1 = f32x16{};
    const bf16_t* vc = p.VCT + (size_t)g * 64 * 1024 + (size_t)r32 * 1024 + 8 * hi;
    for (int c = 0; c < ntile; ++c) {
        f32x16 s0 = f32x16{}, s1 = f32x16{};
        const bf16_t* kt = kc + (size_t)c * 64 * 64;
#pragma unroll
        for (int d0 = 0; d0 < 4; ++d0) { const bf16x8 k0 = *(const bf16x8*)(kt + 16 * d0), k1 = *(const bf16x8*)(kt + 32 * 64 + 16 * d0); s0 = NMFMA32(k0, qr[d0], s0); s1 = NMFMA32(k1, qr[d0], s1); }
        const int x = nmax - 64 * c - 4 * hi;
#pragma unroll
        for (int r = 0; r < 16; ++r) { const int cc = (r & 3) + 8 * (r >> 2);
            s0[r] = (cc > x) ? 0.f : __builtin_amdgcn_exp2f(s0[r] - m) * invl; s1[r] = (cc + 32 > x) ? 0.f : __builtin_amdgcn_exp2f(s1[r] - m) * invl; }
        u32x4 pw[4];
        pw[0] = (u32x4){cvtpk(s0[0], s0[1]), cvtpk(s0[2], s0[3]), cvtpk(s0[4], s0[5]), cvtpk(s0[6], s0[7])};
        pw[1] = (u32x4){cvtpk(s0[8], s0[9]), cvtpk(s0[10], s0[11]), cvtpk(s0[12], s0[13]), cvtpk(s0[14], s0[15])};
        pw[2] = (u32x4){cvtpk(s1[0], s1[1]), cvtpk(s1[2], s1[3]), cvtpk(s1[4], s1[5]), cvtpk(s1[6], s1[7])};
        pw[3] = (u32x4){cvtpk(s1[8], s1[9]), cvtpk(s1[10], s1[11]), cvtpk(s1[12], s1[13]), cvtpk(s1[14], s1[15])};
        f32x16 im = f32x16{};
        const bf16_t* vt = vc + c * 64;
#pragma unroll
        for (int ks = 0; ks < 4; ++ks) {
            const bf16x8 pa = __builtin_bit_cast(bf16x8, pw[ks]);
            const bf16x8 v0 = *(const bf16x8*)(vt + 16 * ks), v1 = *(const bf16x8*)(vt + 32 * 1024 + 16 * ks);
            o0 = NMFMA32(pa, v0, o0); o1 = NMFMA32(pa, v1, o1); im = NMFMA32(pa, ovf[ks], im);
        }
        if (r32 <= 16 && 16 * c + r32 < 256) {
#pragma unroll
            for (int k = 0; k < 4; ++k) { const float v = (im[4 * k] + im[4 * k + 1]) + (im[4 * k + 2] + im[4 * k + 3]); atomicAdd((float*)(imp + (2 * k + hi) * IMP_LD + 16 * c + r32), v); }
        }
    }
    { bf16_t* st = (bf16_t*)stg; bf16_t* stl = st + (4 * hi) * 64 + r32;
#pragma unroll
      for (int r = 0; r < 16; ++r) { stl[((r & 3) + 8 * (r >> 2)) * 64] = f2bf(o0[r]); stl[((r & 3) + 8 * (r >> 2)) * 64 + 32] = f2bf(o1[r]); }
      asm volatile("s_waitcnt lgkmcnt(0)" ::: "memory");
#pragma unroll
      for (int i = 0; i < 4; ++i) { const int row = i * 8 + (lane >> 3), ch = lane & 7; const u32x4 v = *(const u32x4*)(st + row * 64 + ch * 8);
          *(u32x4*)(p.OCMP + (size_t)(t0w + (row >> 2)) * 512 + (g * 4 + (row & 3)) * 64 + ch * 8) = v; }
      asm volatile("s_waitcnt lgkmcnt(0)" ::: "memory"); }
}

__device__ __forceinline__ void select_wave(int t0w, const LAS float* imp, LAS int* sel, int lane) {
    const int sub = lane & 31;
#pragma unroll 1
    for (int h = 0; h < 4; ++h) {
        const int tk = 2 * h + (lane >> 5);
        const int tq = t0w + tk, cur = tq >> 6;
        float v[8];
#pragma unroll
        for (int i = 0; i < 8; ++i) { const int j = sub + 32 * i; float x = imp[tk * IMP_LD + j]; if (j == 0 || j == cur || j == cur - 1) x += 1e6f; v[i] = (j <= cur) ? x : -INFINITY; }
#pragma unroll 1
        for (int it = 0; it < 16; ++it) {
            float bv = v[0]; int bi = 0;
#pragma unroll
            for (int i = 1; i < 8; ++i) if (v[i] > bv) { bv = v[i]; bi = i; }
            int bj = sub + 32 * bi;
#pragma unroll
            for (int o = 1; o < 32; o <<= 1) { const float ov = __shfl_xor(bv, o); const int oj = __shfl_xor(bj, o); if (ov > bv || (ov == bv && oj < bj)) { bv = ov; bj = oj; } }
            const bool any = bv > -INFINITY;
            if (sub == 0) sel[tk * 16 + it] = any ? bj : -1;
            if (any && (bj & 31) == sub) { const int wi = bj >> 5;
#pragma unroll
                for (int i = 0; i < 8; ++i) if (i == wi) v[i] = -INFINITY; }
        }
    }
    asm volatile("s_waitcnt lgkmcnt(0)" ::: "memory");
}

__device__ __forceinline__ void slc_wave(const MKP& p, int g, int t0w, const LAS int* sel, LAS float* oslc, int lane) {
    const int c16 = lane & 15, u = lane >> 4, ti = c16 >> 2;
    const unsigned char* kb = (const unsigned char*)p.KSLF + (size_t)g * 256 * 4096 + lane * 16;
    const unsigned char* vb = (const unsigned char*)p.VSLF + (size_t)g * 256 * 4096 + lane * 16;
#define LO64(vv_) ((long)(((unsigned long long)(vv_).y << 32) | (vv_).x))
#define HI64(vv_) ((long)(((unsigned long long)(vv_)[3] << 32) | (vv_).z))
#define FMFMA(a, b, c) __builtin_amdgcn_mfma_f32_16x16x32_fp8_fp8(a, b, c, 0, 0, 0)
#define KLOAD4(r_) do { _Pragma("unroll") for (int i_ = 0; i_ < 4; ++i_) { int b_ = sel[(tg * 4 + i_) * 16 + (r_)]; b_ = b_ < 0 ? 0 : b_; const unsigned char* kp_ = kb + (size_t)b_ * 4096; \
        _Pragma("unroll") for (int f_ = 0; f_ < 4; ++f_) kc[i_][f_] = *(const u32x4*)(kp_ + f_ * 1024); } } while (0)
#pragma unroll 1
    for (int tg = 0; tg < 2; ++tg) {
        const int tq = t0w + tg * 4 + ti;
        long qa, qb2;
        { const bf16_t* qp = p.QN + (size_t)tq * 512 + (g * 4 + (c16 & 3)) * 64 + 8 * u;
          const u32x4 r0 = *(const u32x4*)qp, r1 = *(const u32x4*)(qp + 32);
          const unsigned a0 = pk4_fp8(8.f * __uint_as_float(r0.x << 16), 8.f * __uint_as_float(r0.x & 0xffff0000u), 8.f * __uint_as_float(r0.y << 16), 8.f * __uint_as_float(r0.y & 0xffff0000u));
          const unsigned a1 = pk4_fp8(8.f * __uint_as_float(r0.z << 16), 8.f * __uint_as_float(r0.z & 0xffff0000u), 8.f * __uint_as_float(r0.w << 16), 8.f * __uint_as_float(r0.w & 0xffff0000u));
          const unsigned b0 = pk4_fp8(8.f * __uint_as_float(r1.x << 16), 8.f * __uint_as_float(r1.x & 0xffff0000u), 8.f * __uint_as_float(r1.y << 16), 8.f * __uint_as_float(r1.y & 0xffff0000u));
          const unsigned b1 = pk4_fp8(8.f * __uint_as_float(r1.z << 16), 8.f * __uint_as_float(r1.z & 0xffff0000u), 8.f * __uint_as_float(r1.w << 16), 8.f * __uint_as_float(r1.w & 0xffff0000u));
          qa = (long)(((unsigned long long)a1 << 32) | a0); qb2 = (long)(((unsigned long long)b1 << 32) | b0); }
        long q0[4], q1[4];
#pragma unroll
        for (int i = 0; i < 4; ++i) { q0[i] = (ti == i) ? qa : 0; q1[i] = (ti == i) ? qb2 : 0; }
        u32x4 kc[4][4], vf[4][4];
        KLOAD4(0);
        float m = -INFINITY, l = 0.f;
        f32x4 o[4]; o[0] = o[1] = o[2] = o[3] = (f32x4){0.f, 0.f, 0.f, 0.f};
#pragma unroll 1
        for (int r = 0; r < 16; ++r) {
#pragma unroll
            for (int i = 0; i < 4; ++i) { int b_ = sel[(tg * 4 + i) * 16 + r]; b_ = b_ < 0 ? 0 : b_; const unsigned char* vp = vb + (size_t)b_ * 4096;
#pragma unroll
                for (int dg = 0; dg < 4; ++dg) vf[i][dg] = *(const u32x4*)(vp + dg * 1024); }
            f32x4 s[4];
#pragma unroll
            for (int kg = 0; kg < 4; ++kg) { f32x4 c = (f32x4){0.f, 0.f, 0.f, 0.f};
#pragma unroll
                for (int i = 0; i < 4; ++i) { c = FMFMA(LO64(kc[i][kg]), q0[i], c); c = FMFMA(HI64(kc[i][kg]), q1[i], c); }
                s[kg] = c * 0.125f; }
            { const int rn = (r < 15) ? r + 1 : 15; KLOAD4(rn); }
            const int myblk = sel[(tg * 4 + ti) * 16 + r];
            { const int x = (myblk < 0) ? -1 : ((myblk == (tq >> 6)) ? tq - 64 * myblk - 4 * u : 64);
#pragma unroll
              for (int kg = 0; kg < 4; ++kg) { if (16 * kg > x) s[kg].x = -INFINITY; if (16 * kg + 1 > x) s[kg].y = -INFINITY; if (16 * kg + 2 > x) s[kg].z = -INFINITY; if (16 * kg + 3 > x) s[kg].w = -INFINITY; } }
            float tm = -INFINITY;
#pragma unroll
            for (int kg = 0; kg < 4; ++kg) tm = fmaxf(tm, fmaxf(fmaxf(s[kg].x, s[kg].y), fmaxf(s[kg].z, s[kg].w)));
            tm = fmaxf(tm, __shfl_xor(tm, 16)); tm = fmaxf(tm, __shfl_xor(tm, 32));
            float alpha = 1.f;
            if (tm > m) { alpha = __builtin_amdgcn_exp2f(m - tm); m = tm; }
            l *= alpha;
            float sum = 0.f;
#pragma unroll
            for (int kg = 0; kg < 4; ++kg) { s[kg].x = __builtin_amdgcn_exp2f(s[kg].x - m); s[kg].y = __builtin_amdgcn_exp2f(s[kg].y - m); s[kg].z = __builtin_amdgcn_exp2f(s[kg].z - m); s[kg].w = __builtin_amdgcn_exp2f(s[kg].w - m);
                sum += (s[kg].x + s[kg].y) + (s[kg].z + s[kg].w); }
            l += sum;
            { const float a0 = __shfl(alpha, 4 * u), a1 = __shfl(alpha, 4 * u + 1), a2 = __shfl(alpha, 4 * u + 2), a3 = __shfl(alpha, 4 * u + 3);
#pragma unroll
              for (int dg = 0; dg < 4; ++dg) { o[dg].x *= a0; o[dg].y *= a1; o[dg].z *= a2; o[dg].w *= a3; } }
#pragma unroll
            for (int ch = 0; ch < 2; ++ch) {
                const f32x4 pa_ = s[2 * ch] * 128.f, pb_ = s[2 * ch + 1] * 128.f;
                const unsigned lo_ = pk4_fp8(pa_.x, pa_.y, pa_.z, pa_.w), hi_ = pk4_fp8(pb_.x, pb_.y, pb_.z, pb_.w);
                const long pa = (long)(((unsigned long long)hi_ << 32) | lo_);
#pragma unroll
                for (int i = 0; i < 4; ++i) { const long pi = (ti == i) ? pa : 0;
#pragma unroll
                    for (int dg = 0; dg < 4; ++dg) o[dg] = FMFMA(pi, ch ? HI64(vf[i][dg]) : LO64(vf[i][dg]), o[dg]); }
            }
        }
        { float lt = l; lt += __shfl_xor(lt, 16); lt += __shfl_xor(lt, 32);
          const float il = (lt > 0.f) ? (1.f / 128.f) / lt : 0.f;
          const float i0 = __shfl(il, 4 * u), i1 = __shfl(il, 4 * u + 1), i2 = __shfl(il, 4 * u + 2), i3 = __shfl(il, 4 * u + 3);
          LAS float* op = oslc + (tg * 4 + u) * 256 + c16;
#pragma unroll
          for (int dg = 0; dg < 4; ++dg) { op[16 * dg] = o[dg].x * i0; op[64 + 16 * dg] = o[dg].y * i1; op[128 + 16 * dg] = o[dg].z * i2; op[192 + 16 * dg] = o[dg].w * i3; } }
    }
#undef KLOAD4
#undef LO64
#undef HI64
#undef FMFMA
    asm volatile("s_waitcnt lgkmcnt(0)" ::: "memory");
    {
        const int tkl = lane >> 3, cc = (lane & 7) * 32, hh = cc >> 6;
        const int tq = t0w + tkl;
        const float* gt = p.GATES + (size_t)tq * 24 + (g * 4 + hh) * 3;
        const float gc = 1.f / (1.f + __expf(-gt[0])), gs = 1.f / (1.f + __expf(-gt[1])), gw = 1.f / (1.f + __expf(-gt[2]));
        const size_t col = (size_t)tq * 512 + g * 256 + cc;
        const LAS float* os = oslc + tkl * 256 + cc;
#pragma unroll
        for (int q = 0; q < 4; ++q) {
            const u32x4 wc = *(const u32x4*)(p.OCMP + col + 8 * q), ww = *(const u32x4*)(p.OWIN + col + 8 * q);
            const f32x4 sa = *(const LAS f32x4*)(os + 8 * q), sb = *(const LAS f32x4*)(os + 8 * q + 4);
            u32x4 r;
            r.x = cvtpk(gs * sa.x + gc * __uint_as_float(wc.x << 16) + gw * __uint_as_float(ww.x << 16), gs * sa.y + gc * __uint_as_float(wc.x & 0xffff0000u) + gw * __uint_as_float(ww.x & 0xffff0000u));
            r.y = cvtpk(gs * sa.z + gc * __uint_as_float(wc.y << 16) + gw * __uint_as_float(ww.y << 16), gs * sa.w + gc * __uint_as_float(wc.y & 0xffff0000u) + gw * __uint_as_float(ww.y & 0xffff0000u));
            r.z = cvtpk(gs * sb.x + gc * __uint_as_float(wc.z << 16) + gw * __uint_as_float(ww.z << 16), gs * sb.y + gc * __uint_as_float(wc.z & 0xffff0000u) + gw * __uint_as_float(ww.z & 0xffff0000u));
            r.w = cvtpk(gs * sb.z + gc * __uint_as_float(wc.w << 16) + gw * __uint_as_float(ww.w << 16), gs * sb.w + gc * __uint_as_float(wc.w & 0xffff0000u) + gw * __uint_as_float(ww.w & 0xffff0000u));
            *(u32x4*)(p.OATT + (size_t)tq * 1024 + g * 256 + cc + 8 * q) = r;
        }
    }
}

__device__ __forceinline__ void nsa_unit(const MKP& p, char* shm, int g, int tile) {
    int tid_ = threadIdx.x; asm volatile("" : "+v"(tid_));
    const int tid = tid_, lane = tid & 63, r32 = lane & 31; const int wid = __builtin_amdgcn_readfirstlane(tid >> 6);
    const int t0 = tile * 64;
    {   att::UnitArgs A;
        A.qrow = p.QN + (size_t)(t0 + 8 * wid + (r32 >> 2)) * 512 + (g * 4 + (r32 & 3)) * 64;
        A.K = p.KV6 + (size_t)(4 * 2 + g) * S_ * 64; A.V = p.KV6 + (size_t)(5 * 2 + g) * S_ * 64; A.kvpitch = 64; A.vpitch = 64;
        A.obase = p.OWIN + (size_t)t0 * 512 + g * 256; A.opitch = 512;
        A.qtok = 8 * wid + (r32 >> 2); A.abase = tile;
        const int real = (tile + 1 < 9) ? tile + 1 : 9; int nt = (real + 1) & ~1; if (nt < 4) nt = 4;
        A.nsteps = nt; A.bias = nullptr;
        att::attn_unit<att::MODE_WIN, true, 8, 64>(A, shm);
    }
    LAS unsigned char* l3 = (LAS unsigned char*)shm;
    LAS float* imp = (LAS float*)(l3 + wid * (8 * IMP_LD * 4));
    LAS int* sel = (LAS int*)(l3 + 8 * (8 * IMP_LD * 4) + wid * 512);
    LAS unsigned char* stg = l3 + 8 * (8 * IMP_LD * 4) + 8 * 512 + wid * 4096;
    const int t0w = t0 + 8 * wid;
    cmp_wave(p, g, t0w, imp, stg, lane);
    asm volatile("s_waitcnt vmcnt(0) lgkmcnt(0)" ::: "memory");
    select_wave(t0w, imp, sel, lane);
    slc_wave(p, g, t0w, sel, imp, lane);
    asm volatile("s_waitcnt vmcnt(0) lgkmcnt(0)\n\ts_barrier" ::: "memory");
}
#undef NMFMA32
#undef NMFMA16
#undef RLF
}

__device__ __forceinline__ void phase_prologue(const MKP& p, LAS unsigned char* lds) {
    const int tid = threadIdx.x, lane = tid & 63, wave = tid >> 6;
    const int gw = blockIdx.x * 8 + wave, NGW = gridDim.x * 8;
    LAS float* scr = (LAS float*)(lds + wave * 16384);
    for (int it = gw; it < 8 * 192; it += NGW) {
        const int kc = it / 192, ch = it % 192, idx = ch * 64 + lane, l = idx / 6144, n = idx % 6144;
        const float* w = p.in[5] + (size_t)l * 1024 * 6144 + n;
        const float* c = p.in[1];
        float acc = 0.f;
#pragma unroll 8
        for (int k = kc * 128; k < kc * 128 + 128; ++k) { const float cv = c[k]; acc += (cv / (1.f + __expf(-cv))) * w[(size_t)k * 6144]; }
        p.modpart[kc * 12288 + idx] = acc;
    }
    if (blockIdx.x == 1 && tid < 128) p.gcnt[tid] = 0;
    if (blockIdx.x == 0 && tid < 96 + 48 + 64) {
        BlkDesc d; d.dst = nullptr; d.gain = nullptr; d.pitch = 0; d.flags = 4; d.scale = 1.f; d.csoff = 0;
        if (tid < 96) {
            const int blk = (tid >> 3) * 4 + ((tid >> 2) & 1) * 2 + ((tid >> 1) & 1);
            d.flags = 0;
            if (blk < 8) { d.dst = p.QN + blk * 64; d.pitch = 512; d.gain = p.in[9]; d.flags = 1; d.scale = C2Q; }
            else if (blk < 20) { const int j = (blk - 8) >> 1, g = (blk - 8) & 1; d.dst = p.KV6 + (size_t)(j * 2 + g) * S_ * 64; d.pitch = 64;
                d.gain = (j == 2 || j == 4) ? p.in[10] : nullptr; d.flags = (j == 0 || j == 2 || j == 4) ? 1 : 0; }
            else if (blk < 28) { d.dst = p.FQ + (blk - 20) * 64; d.pitch = 512; d.gain = p.in[13]; d.scale = C2Q; }
            else if (blk < 36) { d.dst = p.FK + (blk - 28) * 64; d.pitch = 512; d.gain = p.in[14]; }
            else if (blk < 44) { d.dst = p.FV + (blk - 36) * 64; d.pitch = 512; }
            else if (blk == 44) d.flags = 2;
            else d.flags = 4;
            p.desc0[tid] = d;
        } else if (tid < 96 + 48) {
            const int e = tid - 96, pn = e >> 3, bj = (e >> 2) & 1, wc = e & 3;
            if (pn < 4) { const int h = pn * 4 + bj * 2 + (wc >> 1); d.dst = p.Q96 + (size_t)h * S_ * 96; d.pitch = 96; d.gain = p.in[21]; d.flags = 0; d.scale = C2M; }
            else { const int h = (pn - 4) * 8 + bj * 4 + wc; d.dst = p.Q96 + (size_t)h * S_ * 96 + 64; d.pitch = 96; d.gain = p.in[23]; d.flags = 1 | 8; d.scale = C2M; d.csoff = 32; }
            p.desc_uq[e] = d;
        } else {
            const int e = tid - 144, pn = e >> 3, bj = (e >> 2) & 1, wc = e & 3;
            const int h = (pn & 3) * 4 + bj * 2 + (wc >> 1);
            if (pn < 4) { d.dst = p.K96 + (size_t)h * S_ * 96; d.pitch = 96; d.gain = p.in[22]; d.flags = 0; }
            else { d.dst = p.V1 + (size_t)h * S_ * 64; d.pitch = 64; d.gain = nullptr; d.flags = 0; }
            p.desc_ukv[e] = d;
        }
    }
    if (blockIdx.x == 2 || blockIdx.x == 3) {
        const int kv = blockIdx.x - 2, e = tid & 63, sl = tid >> 6;
        const float* w = p.in[12] + (size_t)kv * 2048 * 64 + e; const float* pe = p.in[11] + kv * 2048;
        float b = 0.f;
#pragma unroll 8
        for (int k = sl * 256; k < sl * 256 + 256; ++k) b += pe[k] * w[(size_t)k * 64];
        LAS float* red = (LAS float*)(lds + 140000);
        red[tid] = b;
        __syncthreads();
        if (tid < 64) { float a = 0.f;
#pragma unroll
            for (int q = 0; q < 8; ++q) a += red[q * 64 + tid];
            p.CBIAS[kv * 64 + tid] = a; }
    }
    for (int idx = blockIdx.x * MK_THREADS + tid; idx < S_ * 48; idx += gridDim.x * MK_THREADS) {
        const int t = idx / 48, i = idx % 48;
        const double ex = (i < 32) ? (double)(2 * i) / 64.0 : (double)(2 * (i - 32)) / 32.0;
        const double a = (double)p.pos[t] * exp(-ex * 9.210340371976184);
        const double r = a - rint(a * 0.15915494309189535) * 6.283185307179586;
        const float rf = (float)r;
        p.cosT[idx] = cosf(rf); p.sinT[idx] = sinf(rf);
    }
    for (int it = gw; it < 2 * 32 * 2; it += NGW) { const int kv = it >> 6, r = it & 63; tr_item(p.in[12] + (size_t)kv * 2048 * 64, 64, 2048, p.WcT + (size_t)kv * 64 * 2048, scr, r >> 1, r & 1, lane, MapId(), nullptr); }
    constexpr int I_IN0 = 16 * 96, I_OUT0 = 16 * 32, I_IN1 = 16 * 24, I_UQ = 6 * 48, I_UKV = 4 * 64, I_OUT1 = 16 * 32;
    for (int it = gw; it < I_IN0 + I_OUT0 + I_IN1 + I_UQ + I_UKV + I_OUT1; it += NGW) {
        int r = it;
        if (r < I_IN0) { tr_item(p.in[7], HYIN, 1024, p.W_in0t, scr, r / 96, r % 96, lane, MapIn0(), nullptr); continue; } r -= I_IN0;
        if (r < I_OUT0) { tr_item(p.in[15], 1024, 1024, p.W_out0t, scr, r / 32, r % 32, lane, MapId(), nullptr); continue; } r -= I_OUT0;
        if (r < I_IN1) { tr_item(p.in[16], 672, 1024, p.W_in1t, scr, r / 24, r % 24, lane, MapIn1(), nullptr); continue; } r -= I_IN1;
        if (r < I_UQ) { tr_item(p.in[19], 1536, 384, p.W_uqt, scr, r / 48, r % 48, lane, MapUq(), p.in[17]); continue; } r -= I_UQ;
        if (r < I_UKV) { tr_item(p.in[20], 2048, 256, p.W_ukvt, scr, r / 64, r % 64, lane, MapUkv(), p.in[18]); continue; } r -= I_UKV;
        tr_item(p.in[25], 1024, 1024, p.W_out1t, scr, r / 32, r % 32, lane, MapId(), nullptr);
    }
}

template <bool COMB>
__device__ __forceinline__ void phase_norm(const MKP& p, LAS unsigned char* lds, const float* x, const float* gw_, int layer, int sc_idx, int sh_idx, bool finalize_mod) {
    const int tid = threadIdx.x, lane = tid & 63, wave = tid >> 6;
    LAS float* msc = (LAS float*)(lds + LDS_MOD);
    LAS float* msh = msc + 1024;
    const float* b_ada = p.in[6];
    if (finalize_mod) {
        for (int i = tid; i < 2048; i += MK_THREADS) {
            const int idx = layer * 6144 + ((i < 1024) ? sc_idx * 1024 + i : sh_idx * 1024 + (i - 1024));
            float a = b_ada[idx];
#pragma unroll
            for (int kc = 0; kc < 8; ++kc) a += p.modpart[kc * 12288 + idx];
            msc[i] = a;
        }
        for (int idx = blockIdx.x * MK_THREADS + tid; idx < 12288; idx += gridDim.x * MK_THREADS) {
            float a = b_ada[idx];
#pragma unroll
            for (int kc = 0; kc < 8; ++kc) a += p.modpart[kc * 12288 + idx];
            p.mod[idx] = a;
        }
    } else {
        for (int i = tid; i < 2048; i += MK_THREADS)
            msc[i] = p.mod[layer * 6144 + ((i < 1024) ? sc_idx * 1024 + i : sh_idx * 1024 + (i - 1024))];
    }
    __syncthreads();
    const int gwv = blockIdx.x * 8 + wave, NGW = gridDim.x * 8;
    for (int m = gwv; m < S_; m += NGW) {
        const f32x4* xr = (const f32x4*)(x + (size_t)m * D_) + lane;
        f32x4 v[4]; float s = 0.f;
#pragma unroll
        for (int j = 0; j < 4; ++j) {
            v[j] = xr[64 * j];
            if (COMB) {
                f32x4 ys = (f32x4){0.f, 0.f, 0.f, 0.f};
#pragma unroll
                for (int k = 0; k < 8; ++k) {
                    const u32x2 w = *((const u32x2*)(p.YBUF + ((size_t)m * 8 + k) * 1024) + lane + 64 * j);
                    ys.x += __uint_as_float(w.x << 16); ys.y += __uint_as_float(w.x & 0xffff0000u); ys.z += __uint_as_float(w.y << 16); ys.w += __uint_as_float(w.y & 0xffff0000u);
                }
                const f32x4 g2v = *(const f32x4*)(p.mod + (layer - 1) * 6144 + 5 * 1024 + 256 * j + 4 * lane);
                v[j] = v[j] + g2v * ys;
                ((f32x4*)(p.out + (size_t)m * D_) + lane)[64 * j] = v[j];
            }
            s += (v[j].x * v[j].x + v[j].y * v[j].y) + (v[j].z * v[j].z + v[j].w * v[j].w);
        }
        s = wsum(s);
        const float rstd = rsqrtf(s * (1.f / D_) + EPSF);
        u32x2* o8 = (u32x2*)(p.XN + (size_t)m * D_) + lane;
#pragma unroll
        for (int j = 0; j < 4; ++j) {
            const int c0 = 256 * j + 4 * lane;
            const f32x4 g = *(const f32x4*)(gw_ + c0);
            const f32x4 sc = *(const LAS f32x4*)(msc + c0), sh = *(const LAS f32x4*)(msh + c0);
            const f32x4 y = v[j] * rstd * g * (sc + 1.f) + sh;
            u32x2 w; w.x = cvtpk(y.x, y.y); w.y = cvtpk(y.z, y.w);
            o8[64 * j] = w;
        }
    }
}

struct EpiResid {
    static constexpr bool PERM = true;
    const float* xin; float* out; const float* gate;
    __device__ __forceinline__ void operator()(const f32x4 (&acc)[2][2][4][2], const pg::Unit& u, int wid, int wr, int wc, int fr_, int fq_) const {
        int fr = fr_, fq = fq_; asm volatile("" : "+v"(fr), "+v"(fq));
        const int col0 = u.pn * 256 + wc * 32 + 8 * fq;
        f32x4 g[2][2];
#pragma unroll
        for (int bj = 0; bj < 2; ++bj)
#pragma unroll
            for (int n = 0; n < 2; ++n) g[bj][n] = *(const f32x4*)(gate + col0 + bj * 128 + n * 4);
#pragma unroll
        for (int ai = 0; ai < 2; ++ai)
#pragma unroll
            for (int m = 0; m < 4; ++m) {
                const size_t off = (size_t)(u.pm * 256 + ai * 128 + wr * 64 + m * 16 + fr) * 1024 + col0;
#pragma unroll
                for (int bj = 0; bj < 2; ++bj)
#pragma unroll
                    for (int n = 0; n < 2; ++n) {
                        const f32x4 xv = *(const f32x4*)(xin + off + bj * 128 + n * 4);
                        *(f32x4*)(out + off + bj * 128 + n * 4) = xv + g[bj][n] * acc[ai][bj][m][n];
                    }
                asm volatile("" ::: "memory");
            }
    }
};

struct EpiHeads {
    static constexpr bool PERM = false;
    const BlkDesc* tab; const float* cosT; const float* sinT; float* GATES; float* LOGF; LAS float* X;
    __device__ __forceinline__ void operator()(const f32x4 (&acc)[2][2][4][2], const pg::Unit& u, int wid, int wr, int wc, int fr_, int fq_) const {
        int fr = fr_, fq = fq_; asm volatile("" : "+v"(fr), "+v"(fq));
        const int w1 = wc & 1;
#pragma unroll
        for (int ai = 0; ai < 2; ++ai)
#pragma unroll
            for (int bj = 0; bj < 2; ++bj)
#pragma unroll
                for (int m = 0; m < 4; ++m) {
                    const f32x4 a = acc[ai][bj][m][0], b = acc[ai][bj][m][1];
                    float s = (a.x * a.x + a.y * a.y) + (a.z * a.z + a.w * a.w) + (b.x * b.x + b.y * b.y) + (b.z * b.z + b.w * b.w);
                    s += __shfl_xor(s, 16); s += __shfl_xor(s, 32);
                    if (fq == 0) X[wid * 256 + ((ai * 2 + bj) * 4 + m) * 16 + fr] = s;
                }
        asm volatile("s_waitcnt lgkmcnt(0)" ::: "memory"); __builtin_amdgcn_s_barrier(); asm volatile("" ::: "memory");
#pragma unroll
        for (int bj = 0; bj < 2; ++bj) {
            const BlkDesc d = tab[8 * u.pn + 4 * bj + wc];
            const int row0 = u.pm * 256 + wr * 64 + fr;
            if (d.flags & 4) continue;
            if (d.flags & 2) {
                if (w1 == 0) {
#pragma unroll
                    for (int ai = 0; ai < 2; ++ai)
#pragma unroll
                        for (int m = 0; m < 4; ++m) {
                            const int row = row0 + ai * 128 + m * 16;
#pragma unroll
                            for (int n = 0; n < 2; ++n) {
                                const f32x4 v = acc[ai][bj][m][n];
                                const int pc = 16 * n + 4 * fq;
                                if (pc < 24) *(f32x4*)(GATES + (size_t)row * 24 + pc) = v;
                                else *(f32x4*)(LOGF + (size_t)row * 8 + (pc - 24)) = v;
                            }
                            asm volatile("" ::: "memory");
                        }
                }
                continue;
            }
            const bool half = (d.flags & 8) != 0, has_gain = d.gain != nullptr, rope = (d.flags & 1) != 0;
            const int d0 = half ? 4 * fq : 16 * w1 + 4 * fq;
            const int dn1 = half ? 16 : 32;
            const float invn = half ? (1.f / 32.f) : (1.f / 64.f);
            const GAS float* gp = (const GAS float*)(has_gain ? d.gain : cosT);
            f32x4 g0 = *(const GAS f32x4*)(gp + d0), g1 = *(const GAS f32x4*)(gp + dn1 + d0);
            if (!has_gain) { g0 = (f32x4){1.f, 1.f, 1.f, 1.f}; g1 = g0; }
            g0 = g0 * d.scale; g1 = g1 * d.scale;
            const int cso = d.csoff + d0;
#pragma unroll
            for (int ai = 0; ai < 2; ++ai)
#pragma unroll
                for (int m = 0; m < 4; ++m) {
                    const int row = row0 + ai * 128 + m * 16;
                    const int xi = ((ai * 2 + bj) * 4 + m) * 16 + fr;
                    float ssq = X[wid * 256 + xi]; const float ssp = X[(wid ^ 1) * 256 + xi];
                    if (!half) ssq += ssp;
                    const float rs = has_gain ? rsqrtf(ssq * invn + EPSF) : 1.f;
                    f32x4 x1 = acc[ai][bj][m][0] * rs * g0, x2 = acc[ai][bj][m][1] * rs * g1;
                    f32x4 c = *(const f32x4*)(cosT + (size_t)row * 48 + cso), sn = *(const f32x4*)(sinT + (size_t)row * 48 + cso);
                    if (!rope) { c = (f32x4){1.f, 1.f, 1.f, 1.f}; sn = (f32x4){0.f, 0.f, 0.f, 0.f}; }
                    const f32x4 o1 = x1 * c - x2 * sn, o2 = x2 * c + x1 * sn;
                    u32x2 wa, wb; wa.x = cvtpk(o1.x, o1.y); wa.y = cvtpk(o1.z, o1.w); wb.x = cvtpk(o2.x, o2.y); wb.y = cvtpk(o2.z, o2.w);
                    GAS bf16_t* dr = (GAS bf16_t*)d.dst + (size_t)row * d.pitch + d0;
                    *(GAS u32x2*)dr = wa; *(GAS u32x2*)(dr + dn1) = wb;
                    asm volatile("" ::: "memory");
                }
        }
    }
};

struct EpiPlain {
    static constexpr bool PERM = true;
    bf16_t* O; int ldc;
    __device__ __forceinline__ void operator()(const f32x4 (&acc)[2][2][4][2], const pg::Unit& u, int wid, int wr, int wc, int fr_, int fq_) const {
        int fr = fr_, fq = fq_; asm volatile("" : "+v"(fr), "+v"(fq));
        const int col0 = u.pn * 256 + wc * 32 + 8 * fq;
#pragma unroll
        for (int ai = 0; ai < 2; ++ai)
#pragma unroll
            for (int m = 0; m < 4; ++m) {
                bf16_t* rp = O + (size_t)(u.pm * 256 + ai * 128 + wr * 64 + m * 16 + fr) * ldc + col0;
#pragma unroll
                for (int bj = 0; bj < 2; ++bj) { const f32x4 a = acc[ai][bj][m][0], b = acc[ai][bj][m][1];
                    u32x4 w; w.x = cvtpk(a.x, a.y); w.y = cvtpk(a.z, a.w); w.z = cvtpk(b.x, b.y); w.w = cvtpk(b.z, b.w); *(u32x4*)(rp + bj * 128) = w; }
            }
    }
};

__device__ __forceinline__ void phase_post1a(const MKP& p) {
    int tid_ = threadIdx.x; asm volatile("" : "+v"(tid_));
    const int tid = tid_, lane = tid & 63, wave = tid >> 6;
    const int gwv = blockIdx.x * 8 + wave, NGW = gridDim.x * 8;
    for (int t = gwv; t < S_; t += NGW) {
        const u32x2* row = (const u32x2*)(p.P1 + (size_t)t * 768);
        f32x4 v[3]; float sq = 0.f, skv = 0.f, skr = 0.f;
#pragma unroll
        for (int j = 0; j < 3; ++j) {
            const int g = lane + 64 * j;
            f32x4 x = (f32x4){0.f, 0.f, 0.f, 0.f};
            if (g < 168) { const u32x2 w = row[g]; x.x = __uint_as_float(w.x << 16); x.y = __uint_as_float(w.x & 0xffff0000u); x.z = __uint_as_float(w.y << 16); x.w = __uint_as_float(w.y & 0xffff0000u); }
            v[j] = x;
            const float s = (x.x * x.x + x.y * x.y) + (x.z * x.z + x.w * x.w);
            if (g < 96) sq += s; else if (g < 160) skv += s; else skr += s;
        }
        sq = wsum(sq); skv = wsum(skv); skr = wsum(skr);
        const float rq = rsqrtf(sq * (1.f / 384.f) + EPSF), rkv = rsqrtf(skv * (1.f / 256.f) + EPSF), rkr = rsqrtf(skr * (1.f / 32.f) + EPSF);
#pragma unroll
        for (int j = 0; j < 3; ++j) {
            const int g = lane + 64 * j;
            if (g < 96) { const f32x4 y = v[j] * rq; u32x2 w; w.x = cvtpk(y.x, y.y); w.y = cvtpk(y.z, y.w); *(u32x2*)(p.CQN + (size_t)t * 384 + 4 * g) = w; }
            else if (g < 160) { const f32x4 y = v[j] * rkv; u32x2 w; w.x = cvtpk(y.x, y.y); w.y = cvtpk(y.z, y.w); *(u32x2*)(p.CKVN + (size_t)t * 256 + 4 * (g - 96)) = w; }
        }
        {
            const int dl = (lane - 32) & 7;
            const int dd = 4 * dl;
            const int fi = 4 * (dl & 3);
            f32x4 x = v[2] * rkr;
            const f32x4 gn = *(const f32x4*)(p.in[24] + (dd & 31));
            x = x * gn;
            f32x4 o; o.x = __shfl_xor(x.x, 4); o.y = __shfl_xor(x.y, 4); o.z = __shfl_xor(x.z, 4); o.w = __shfl_xor(x.w, 4);
            const f32x4 c = *(const f32x4*)(p.cosT + (size_t)t * 48 + 32 + fi), sn = *(const f32x4*)(p.sinT + (size_t)t * 48 + 32 + fi);
            const f32x4 y = (dl < 4) ? (x * c - o * sn) : (x * c + o * sn);
            if (lane >= 32 && lane < 40) {
                u32x2 w; w.x = cvtpk(y.x, y.y); w.y = cvtpk(y.z, y.w);
#pragma unroll
                for (int h = 0; h < 16; ++h) *(u32x2*)(p.K96 + ((size_t)h * S_ + t) * 96 + 64 + dd) = w;
            }
        }
    }
}

__device__ __forceinline__ void mla_unit(const MKP& p, char* shm, int h, int qb) {
    int tid_ = threadIdx.x; asm volatile("" : "+v"(tid_));
    const int tid = tid_, lane = tid & 63, r32 = lane & 31; const int wid = __builtin_amdgcn_readfirstlane(tid >> 6);
    const int q0 = qb * 256;
    att::UnitArgs A;
    A.qrow = p.Q96 + ((size_t)h * S_ + q0 + 32 * wid + r32) * 96;
    A.K = p.K96 + (size_t)h * S_ * 96; A.kvpitch = 96; A.V = p.V1 + (size_t)h * S_ * 64; A.vpitch = 64;
    A.obase = p.OATT + (size_t)q0 * 1024 + h * 64; A.opitch = 1024;
    A.qtok = 32 * wid + r32; A.abase = 4 * qb; A.nsteps = 4 * qb + 4; A.bias = nullptr;
    att::attn_unit<att::MODE_CAUSAL, false, 8, 96>(A, shm);
}
__device__ __forceinline__ void phase_mla(const MKP& p, char* shm) {
    const int G = gridDim.x, bx = blockIdx.x;
    const int vcu = (G % 8 == 0) ? (bx % 8) * (G / 8) + bx / 8 : bx;
    for (int u = vcu; u < 256; u += G) {
        const int h = u >> 4, s = u & 15;
#pragma unroll 1
        for (int rep = 0; rep < 4; ++rep) mla_unit(p, shm, h, rep == 0 ? s : rep == 1 ? 31 - s : rep == 2 ? 32 + s : 63 - s);
    }
}

__device__ __forceinline__ void phase_scan(const MKP& p, LAS unsigned char* lds) {
    constexpr int NSB = 64;
    if (blockIdx.x >= NSB) {
        int tid_ = threadIdx.x; asm volatile("" : "+v"(tid_));
        const int lane = tid_ & 63, wave = tid_ >> 6;
        const int gw = (blockIdx.x - NSB) * 8 + wave, NGW = (gridDim.x - NSB) * 8;
        LAS float* scr = (LAS float*)(lds + wave * 256);
        for (int j = gw; j < 128 + 512; j += NGW) { if (j < 128) nsa::compress_job(p, scr, j, lane); else nsa::slcfrag_job(p, j - 128, lane); }
        return;
    }
    const int h = blockIdx.x >> 3, seg = blockIdx.x & 7, tid = threadIdx.x;
    LAS double* part = (LAS double*)lds;
    const float fb = p.in[8][h];
    double own[4], s = 0.0, pre = 0.0;
#pragma unroll
    for (int i = 0; i < 4; ++i) { own[i] = (double)logsigmf(p.LOGF[(size_t)(seg * 2048 + tid * 4 + i) * 8 + h] + fb); s += own[i]; }
    for (int i = tid; i < seg * 2048; i += MK_THREADS) pre += (double)logsigmf(p.LOGF[(size_t)i * 8 + h] + fb);
    part[tid] = s; part[512 + tid] = pre;
    __syncthreads();
    for (int o = 1; o < MK_THREADS; o <<= 1) {
        const double v = (tid >= o) ? part[tid - o] : 0.0, w = (tid >= o) ? part[512 + tid - o] : 0.0;
        __syncthreads();
        part[tid] += v; part[512 + tid] += w;
        __syncthreads();
    }
    double a = part[512 + MK_THREADS - 1] + ((tid > 0) ? part[tid - 1] : 0.0);
#pragma unroll
    for (int i = 0; i < 4; ++i) { a += own[i]; p.CUMB[(size_t)h * S_ + seg * 2048 + tid * 4 + i] = (float)(a * 1.4426950408889634); }
}

__device__ __forceinline__ void fox_unit(const MKP& p, char* shm, int h, int qb) {
    int tid_ = threadIdx.x; asm volatile("" : "+v"(tid_));
    const int tid = tid_, lane = tid & 63, r32 = lane & 31; const int wid = __builtin_amdgcn_readfirstlane(tid >> 6);
    const int q0 = qb * 256, abase = 4 * qb;
    const float* cb = p.CUMB + (size_t)h * S_;
    LAS float* bias = (LAS float*)(LAS unsigned char*)(shm + att::LDS_BIAS);
    LAS int* cnt = (LAS int*)(LAS unsigned char*)(shm + att::Geo<64>::LDS_WS);
    float gq = 0.f, gk = 0.f;
    for (int i = 0; i < 64; ++i) { gq = fmaxf(gq, fabsf(p.in[13][i])); gk = fmaxf(gk, fabsf(p.in[14][i])); }
    const float TH = 150.f + 2.f * (64.f * gq * gk * C2Q * 1.05f);
    const float c0 = cb[q0], cref = cb[q0 + 255];
    const bool skip = (tid < abase) && (cb[64 * tid + 63] - c0 > TH);
    const unsigned long long bal = __ballot(skip);
    if (lane == 0) cnt[wid] = __popcll(bal);
    __syncthreads();
    int alo = 0;
#pragma unroll
    for (int w = 0; w < 8; ++w) alo += cnt[w];
    int NT = abase + 4 - alo;
    if (NT & 1) { alo -= 1; NT += 1; }
    for (int i = tid; i < NT * 64; i += MK_THREADS) bias[i] = cref - cb[64 * alo + i];
    __syncthreads();
    att::UnitArgs A;
    A.qrow = p.FQ + (size_t)(q0 + 32 * wid + r32) * 512 + h * 64;
    A.K = p.FK + h * 64; A.V = p.FV + h * 64; A.kvpitch = 512; A.vpitch = 512;
    A.obase = p.OATT + (size_t)q0 * 1024 + 512 + h * 64; A.opitch = 1024;
    A.qtok = 32 * wid + r32; A.abase = abase; A.nsteps = NT; A.bias = bias;
    att::attn_unit<att::MODE_FOX, false, 8, 64>(A, shm);
}
__device__ __forceinline__ void phase_fox(const MKP& p, char* shm, int part = 3) {
    const int G = gridDim.x, bx = blockIdx.x;
    const int vcu = (G % 8 == 0) ? (bx % 8) * (G / 8) + bx / 8 : bx;
    if (part & 1) for (int u = vcu; u < 256; u += G) {
        const int h = u >> 5, s = u & 31;
#pragma unroll 1
        for (int rep = 0; rep < 2; ++rep) fox_unit(p, shm, h, rep ? 63 - s : s);
    }
    if (part & 2) for (int u = vcu; u < 256; u += G) {
#pragma unroll 1
        for (int rep = 0; rep < 2; ++rep) nsa::nsa_unit(p, shm, rep, rep ? 255 - u : u);
    }
}


struct MapOff { int off; __device__ __forceinline__ int operator()(int nn) const { return off + (nn & 31); } };
__device__ __forceinline__ void phase_moe_weights(const MKP& p, LAS unsigned char* lds, int layer) {
    int tid_ = threadIdx.x; asm volatile("" : "+v"(tid_));
    const int tid = tid_, lane = tid & 63, wave = tid >> 6;
    const int gw = blockIdx.x * 8 + wave, NGW = gridDim.x * 8;
    LAS float* scr = (LAS float*)(lds + wave * 16384);
    constexpr int IG = 16 * 16, ID = 4 * 32, IE = IG + ID;
    for (int it = gw; it < 65 * IE; it += NGW) {
        const int e = it / IE; int r = it % IE;
        if (r < IG) {
            const int kb = r / 16, nb = r % 16;
            const int n0 = nb * 32, up = (n0 >> 7) & 1, f0 = (n0 >> 8) * 128 + (n0 & 127);
            const float* W = (e < 64) ? ((up ? p.in[29] : p.in[28]) + ((size_t)layer * 64 + e) * 1024 * 256) : ((up ? p.in[32] : p.in[31]) + (size_t)layer * 1024 * 256);
            MapOff mo{f0};
            tr_item(W, 256, 1024, p.Wgu + (size_t)e * 512 * 1024, scr, kb, nb, lane, mo, nullptr);
        } else {
            r -= IG; const int kb = r / 32, nb = r % 32;
            const float* W = (e < 64) ? (p.in[30] + ((size_t)layer * 64 + e) * 256 * 1024) : (p.in[33] + (size_t)layer * 256 * 1024);
            tr_item(W, 1024, 256, p.Wd + (size_t)e * 1024 * 256, scr, kb, nb, lane, MapId(), nullptr);
        }
    }
}

template <bool DRY>
__device__ __forceinline__ void phase_moe_route(const MKP& p, LAS unsigned char* lds, int layer) {
    int tid_ = threadIdx.x; asm volatile("" : "+v"(tid_));
    const int tid = tid_, lane = tid & 63, wave = tid >> 6;
    LAS float* msc = (LAS float*)(lds + LDS_MOD);
    LAS float* msh = msc + 1024;
    LAS float* hrow = (LAS float*)lds;
    LAS int* cntl = (LAS int*)(lds + LDS_X);
    LAS int* basel = cntl + 64;
    const float* gnorm = p.in[4] + layer * 1024;
    const float* wr = p.in[26] + (size_t)layer * 1024 * 64;
    const float rb = p.in[27][layer * 64 + lane];
    for (int i = tid; i < 2048; i += MK_THREADS) msc[i] = p.mod[layer * 6144 + ((i < 1024) ? 4 * 1024 + i : 3 * 1024 + (i - 1024))];
    __syncthreads();
    for (int batch = blockIdx.x; batch < S_ / 32; batch += gridDim.x) {
        if (tid < 64) cntl[tid] = 0;
#pragma unroll 1
        for (int i = 0; i < 4; ++i) {
            const int t = batch * 32 + wave * 4 + i;
            const f32x4* xr = (const f32x4*)(p.out + (size_t)t * D_) + lane;
            f32x4 v[4]; float s = 0.f;
#pragma unroll
            for (int j = 0; j < 4; ++j) { v[j] = xr[64 * j]; s += (v[j].x * v[j].x + v[j].y * v[j].y) + (v[j].z * v[j].z + v[j].w * v[j].w); }
            s = wsum(s);
            const float rstd = rsqrtf(s * (1.f / D_) + EPSF);
            u32x2* o8 = (u32x2*)(p.XN + (size_t)t * D_) + lane;
            LAS f32x4* hr = (LAS f32x4*)(hrow + (wave * 4 + i) * 1024) + lane;
#pragma unroll
            for (int j = 0; j < 4; ++j) {
                const int c0 = 256 * j + 4 * lane;
                const f32x4 g = *(const f32x4*)(gnorm + c0);
                const f32x4 sc = *(const LAS f32x4*)(msc + c0), sh = *(const LAS f32x4*)(msh + c0);
                const f32x4 y = v[j] * rstd * g * (sc + 1.f) + sh;
                u32x2 w; w.x = cvtpk(y.x, y.y); w.y = cvtpk(y.z, y.w);
                o8[64 * j] = w; hr[64 * j] = y;
            }
        }
        __syncthreads();
        float acc0 = 0.f, acc1 = 0.f, acc2 = 0.f, acc3 = 0.f;
        const LAS float* h0 = hrow + (wave * 4) * 1024;
#pragma unroll 4
        for (int k = 0; k < 1024; k += 4) {
            const float w0 = wr[(k + 0) * 64 + lane], w1 = wr[(k + 1) * 64 + lane], w2 = wr[(k + 2) * 64 + lane], w3 = wr[(k + 3) * 64 + lane];
            const f32x4 a = *(const LAS f32x4*)(h0 + k), b = *(const LAS f32x4*)(h0 + 1024 + k), c = *(const LAS f32x4*)(h0 + 2048 + k), d = *(const LAS f32x4*)(h0 + 3072 + k);
            acc0 += a.x * w0; acc0 += a.y * w1; acc0 += a.z * w2; acc0 += a.w * w3;
            acc1 += b.x * w0; acc1 += b.y * w1; acc1 += b.z * w2; acc1 += b.w * w3;
            acc2 += c.x * w0; acc2 += c.y * w1; acc2 += c.z * w2; acc2 += c.w * w3;
            acc3 += d.x * w0; acc3 += d.y * w1; acc3 += d.z * w2; acc3 += d.w * w3;
        }
        int myrank[4], mypos[4]; float myw[4];
#pragma unroll
        for (int i = 0; i < 4; ++i) {
            const float logit = (i == 0) ? acc0 : (i == 1) ? acc1 : (i == 2) ? acc2 : acc3;
            const float score = 1.f / (1.f + expf(-logit));
            const float sv = score + rb;
            float m1 = sv;
            m1 = fmaxf(m1, __shfl_xor(m1, 1)); m1 = fmaxf(m1, __shfl_xor(m1, 2)); m1 = fmaxf(m1, __shfl_xor(m1, 4));
            int am = (sv == m1) ? (lane & 7) : 8;
            am = min(am, __shfl_xor(am, 1)); am = min(am, __shfl_xor(am, 2)); am = min(am, __shfl_xor(am, 4));
            float m2 = ((lane & 7) == am) ? -INFINITY : sv;
            m2 = fmaxf(m2, __shfl_xor(m2, 1)); m2 = fmaxf(m2, __shfl_xor(m2, 2)); m2 = fmaxf(m2, __shfl_xor(m2, 4));
            const float gs = m1 + m2;
            const int gi = lane >> 3; int grank = 0;
#pragma unroll
            for (int gj = 0; gj < 8; ++gj) { const float o = __shfl(gs, gj * 8); grank += (o > gs || (o == gs && gj < gi)) ? 1 : 0; }
            const float msk = (grank < 4) ? sv : -1e30f;
            int rank = 0;
#pragma unroll 8
            for (int e = 0; e < 64; ++e) { const float o = __shfl(msk, e); rank += (o > msk || (o == msk && e < lane)) ? 1 : 0; }
            const bool selb = rank < 8;
            const float tot = wsum(selb ? score : 0.f);
            myrank[i] = selb ? rank : -1; myw[i] = score / tot * 2.5f;
            mypos[i] = (selb && !DRY) ? atomicAdd((int*)(cntl + lane), 1) : 0;
        }
        __syncthreads();
        if (tid < 64) basel[tid] = (cntl[tid] > 0 && !DRY) ? atomicAdd(p.gcnt + layer * 64 + tid, cntl[tid]) : 0;
        __syncthreads();
#pragma unroll
        for (int i = 0; i < 4; ++i) if (myrank[i] >= 0 && !DRY) {
            const int t = batch * 32 + wave * 4 + i, slot = t * 8 + myrank[i];
            p.list[(size_t)lane * 16384 + basel[lane] + mypos[i]] = slot;
            p.ew[slot] = myw[i];
        }
        __syncthreads();
    }
}

struct MoeSched {
    const char* A; const char* Bt; const int* list; const LAS int* ustart; const LAS int* hbase; const LAS int* cnt;
    int K, NP, G, c; bool gather; int nexp;
    __device__ __forceinline__ static void tables(LAS int* ustart, LAS int* hbase, LAS int* cnt, const int* gcnt, int NP) {
        const int tid = threadIdx.x;
        if (tid == 0) {
            int us = 0, hb = 0;
            for (int e = 0; e < 65; ++e) { const int c = (e < 64) ? gcnt[e] : S_; const int nrb = (c + 255) >> 8; cnt[e] = c; ustart[e] = us; hbase[e] = hb; us += nrb * NP; hb += nrb * 256; }
            ustart[65] = us; hbase[65] = hb;
        }
        __syncthreads();
    }
    __device__ __forceinline__ bool next(int i, pg::Unit& u, int R0, int C0) const {
        const int L = i * G + c; if (L >= ustart[nexp]) return false;
        const int lane = threadIdx.x & 63;
        const unsigned long long bal = __ballot(lane < 65 && ustart[lane] <= L);
        int e = __popcll(bal) - 1; if (ustart[64] <= L) e = 64;
        const int r = L - ustart[e], rb = r / NP, pn = r % NP;
        u.pm = (hbase[e] >> 8) + rb; u.pn = pn; u.aux = e | (rb << 8);
        u.B = Bt + ((size_t)e * NP + pn) * 256 * K * 2;
        if (gather) {
            u.A = A; const int ce = cnt[e];
#pragma unroll
            for (int q = 0; q < 4; ++q) { const int pos = rb * 256 + R0 + 64 * q; int tok = 0; if (pos < ce) tok = (e < 64) ? (list[(size_t)e * 16384 + pos] >> 3) : pos; u.ra[q] = (unsigned)(tok * K + C0) * 2u; }
        } else {
            u.A = A + (size_t)u.pm * 256 * K * 2;
#pragma unroll
            for (int q = 0; q < 4; ++q) u.ra[q] = (unsigned)((R0 + 64 * q) * K + C0) * 2u;
        }
        return true;
    }
};
struct EpiGateUp {
    static constexpr bool PERM = true;
    bf16_t* HID;
    __device__ __forceinline__ void operator()(const f32x4 (&acc)[2][2][4][2], const pg::Unit& u, int wid, int wr, int wc, int fr_, int fq_) const {
        int fr = fr_, fq = fq_; asm volatile("" : "+v"(fr), "+v"(fq));
        const int col0 = u.pn * 128 + wc * 32 + 8 * fq;
#pragma unroll
        for (int ai = 0; ai < 2; ++ai)
#pragma unroll
            for (int m = 0; m < 4; ++m) {
                bf16_t* rp = HID + (size_t)(u.pm * 256 + ai * 128 + wr * 64 + m * 16 + fr) * 256 + col0;
                float h[8];
#pragma unroll
                for (int n = 0; n < 2; ++n) {
                    const f32x4 g = acc[ai][0][m][n], up = acc[ai][1][m][n];
                    h[4 * n] = g.x / (1.f + __expf(-g.x)) * up.x; h[4 * n + 1] = g.y / (1.f + __expf(-g.y)) * up.y; h[4 * n + 2] = g.z / (1.f + __expf(-g.z)) * up.z; h[4 * n + 3] = g.w / (1.f + __expf(-g.w)) * up.w;
                }
                u32x4 w; w.x = cvtpk(h[0], h[1]); w.y = cvtpk(h[2], h[3]); w.z = cvtpk(h[4], h[5]); w.w = cvtpk(h[6], h[7]); *(u32x4*)rp = w;
            }
    }
};
struct EpiDown {
    static constexpr bool PERM = true;
    bf16_t* YBUF; const int* list; const float* ew; const LAS int* cnt;
    __device__ __forceinline__ void operator()(const f32x4 (&acc)[2][2][4][2], const pg::Unit& u, int wid, int wr, int wc, int fr_, int fq_) const {
        int fr = fr_, fq = fq_; asm volatile("" : "+v"(fr), "+v"(fq));
        const int e = u.aux & 0xff, rb = u.aux >> 8, ce = cnt[e];
        const unsigned colb = (unsigned)(u.pn * 256 + wc * 32 + 8 * fq) * 2u;
        const int* le = list + (size_t)e * 16384 + rb * 256 + wr * 64 + fr;
#pragma unroll
        for (int ai = 0; ai < 2; ++ai)
#pragma unroll
            for (int m = 0; m < 4; ++m) {
                const int pr = ai * 128 + m * 16;
                if (rb * 256 + wr * 64 + fr + pr < ce) {
                    const int slot = le[pr]; const float w = ew[slot];
                    char* rp = (char*)YBUF + ((unsigned)slot * 2048u + colb);
#pragma unroll
                    for (int bj = 0; bj < 2; ++bj) { const f32x4 a = acc[ai][bj][m][0] * w, b = acc[ai][bj][m][1] * w;
                        u32x4 o; o.x = cvtpk(a.x, a.y); o.y = cvtpk(a.z, a.w); o.z = cvtpk(b.x, b.y); o.w = cvtpk(b.z, b.w); *(u32x4*)(rp + bj * 256) = o; }
                }
                asm volatile("" ::: "memory");
            }
    }
};
__device__ __forceinline__ void phase_moe_gemm1(const MKP& p, LAS unsigned char* lds, int layer) {
    LAS int* tb = (LAS int*)(lds + LDS_X);
    MoeSched::tables(tb, tb + 66, tb + 132, p.gcnt + layer * 64, 2);
    const int G = gridDim.x, bx = blockIdx.x, vcu = (G % 8 == 0) ? (bx % 8) * (G / 8) + bx / 8 : bx;
    MoeSched S{(const char*)p.XN, (const char*)p.Wgu, p.list, tb, tb + 66, tb + 132, 1024, 2, G, vcu, true, 65};
    EpiGateUp E{p.HID};
    pg::gemm_run(lds, 1024, S, E);
}
__device__ __forceinline__ void phase_moe_gemm2(const MKP& p, LAS unsigned char* lds, int layer, int which = 3) {
    LAS int* tb = (LAS int*)(lds + LDS_X);
    MoeSched::tables(tb, tb + 66, tb + 132, p.gcnt + layer * 64, 4);
    const int G = gridDim.x, bx = blockIdx.x, vcu = (G % 8 == 0) ? (bx % 8) * (G / 8) + bx / 8 : bx;
    if (which & 1) { MoeSched S{(const char*)p.HID, (const char*)p.Wd, p.list, tb, tb + 66, tb + 132, 256, 4, G, vcu, false, 64};
      EpiDown E{p.YBUF, p.list, p.ew, tb + 132};
      pg::gemm_run(lds, 256, S, E); }
    if (which & 2) {
      pg::DenseSched S; S.init(p.HID + (size_t)tb[66 + 64] * 256, p.Wd + (size_t)64 * 1024 * 256, S_, 1024, 256, G, bx);
      EpiResid E{p.out, p.out, p.mod + layer * 6144 + 5 * 1024};
      pg::gemm_run(lds, 256, S, E); }
}
__device__ __forceinline__ void phase_moe_combine(const MKP& p, int layer) {
    int tid_ = threadIdx.x; asm volatile("" : "+v"(tid_));
    const int tid = tid_, lane = tid & 63, wave = tid >> 6;
    const int gwv = blockIdx.x * 8 + wave, NGW = gridDim.x * 8;
    const float* g2 = p.mod + layer * 6144 + 5 * 1024;
    for (int t = gwv; t < S_; t += NGW) {
        f32x4* xr = (f32x4*)(p.out + (size_t)t * D_) + lane;
#pragma unroll
        for (int j = 0; j < 4; ++j) {
            f32x4 s = (f32x4){0.f, 0.f, 0.f, 0.f};
#pragma unroll
            for (int k = 0; k < 8; ++k) {
                const u32x2 w = *((const u32x2*)(p.YBUF + ((size_t)t * 8 + k) * 1024) + lane + 64 * j);
                s.x += __uint_as_float(w.x << 16); s.y += __uint_as_float(w.x & 0xffff0000u); s.z += __uint_as_float(w.y << 16); s.w += __uint_as_float(w.y & 0xffff0000u);
            }
            const f32x4 g = *(const f32x4*)(g2 + 256 * j + 4 * lane);
            xr[64 * j] = xr[64 * j] + g * s;
        }
    }
}

#define XB_TMO      128
#define XB_XCNT(j)  (256  + 64 * (j))
#define XB_XSUB(j)  (1280 + 64 * (j))
#define XB_XGEN(j)  (2304 + 64 * (j))
#define XB_TOP      3328
#define XB_TOPGEN   3392
#define XCD_BAR_WORDS 3456
#define XB_SPIN_CAP (1u << 22)
__device__ __forceinline__ unsigned xb_ld(unsigned* p)              { return __hip_atomic_load(p, __ATOMIC_RELAXED, __HIP_MEMORY_SCOPE_AGENT); }
__device__ __forceinline__ unsigned xb_add(unsigned* p, unsigned v) { return __hip_atomic_fetch_add(p, v, __ATOMIC_RELAXED, __HIP_MEMORY_SCOPE_AGENT); }
__device__ __forceinline__ unsigned xb_xcc_id() { return (unsigned)__builtin_amdgcn_s_getreg((3 << 11) | 20) & 0xFu; }
#define XB_SPIN(cond, bar) do { unsigned _sp = 0; while (cond) { __builtin_amdgcn_s_sleep(1); \
    if ((++_sp & 255u) == 0u) { if (xb_ld(&(bar)[XB_TMO])) break; if (_sp > XB_SPIN_CAP) { atomicAdd(&(bar)[XB_TMO], 1u); break; } } } } while (0)
struct XcdBarrier { unsigned* bar; unsigned x; volatile LAS unsigned* st; };
__device__ __forceinline__ XcdBarrier xcd_barrier_post(unsigned* bar, volatile LAS unsigned* st) {
    XcdBarrier b; b.bar = bar; b.x = xb_xcc_id(); b.st = st;
    if (threadIdx.x == 0) (void)xb_add(&bar[XB_XCNT(b.x)], 1u);
    return b;
}
__device__ __forceinline__ void xcd_barrier_complete(unsigned* bar, unsigned x, unsigned& nloc, unsigned& nx) {
    const unsigned G = gridDim.x * gridDim.y * gridDim.z;
    unsigned sum, cnt, mine, sp = 0u;
    for (;;) {
        sum = 0u; cnt = 0u; mine = 0u;
#pragma unroll
        for (unsigned j = 0; j < 16; ++j) { const unsigned c = xb_ld(&bar[XB_XCNT(j)]); sum += c; cnt += (c > 0u) ? 1u : 0u; mine = (j == x) ? c : mine; }
        if (sum == G) break;
        __builtin_amdgcn_s_sleep(1);
        if ((++sp & 255u) == 0u) { if (xb_ld(&bar[XB_TMO])) break; if (sp > XB_SPIN_CAP) { atomicAdd(&bar[XB_TMO], 1u); break; } }
    }
    nloc = mine > 0u ? mine : 1u; nx = cnt > 0u ? cnt : 1u;
}
__device__ __forceinline__ void xcd_barrier(const XcdBarrier& b) {
    asm volatile("s_waitcnt vmcnt(0)" ::: "memory");
    __syncthreads();
    if (threadIdx.x == 0) {
        unsigned* bar = b.bar;
        __builtin_amdgcn_s_waitcnt(0);
        unsigned nloc = b.st[0], nx = b.st[1];
        if (nloc == 0u) { xcd_barrier_complete(bar, b.x, nloc, nx); b.st[0] = nloc; b.st[1] = nx; }
        const unsigned old = xb_add(&bar[XB_XSUB(b.x)], 1u);
        const unsigned gen = old / nloc;
        if (old + 1u == (gen + 1u) * nloc) {
            __builtin_amdgcn_fence(__ATOMIC_RELEASE, "agent");
            asm volatile("s_waitcnt vmcnt(0)" ::: "memory");
            const unsigned og = xb_add(&bar[XB_TOP], 1u);
            const unsigned tg = og / nx;
            if (og + 1u == (tg + 1u) * nx) xb_add(&bar[XB_TOPGEN], 1u);
            else XB_SPIN(xb_ld(&bar[XB_TOPGEN]) == tg, bar);
            __builtin_amdgcn_fence(__ATOMIC_ACQUIRE, "agent");
            xb_add(&bar[XB_XGEN(b.x)], 1u);
            asm volatile("s_waitcnt vmcnt(0)" ::: "memory");
        } else {
            XB_SPIN(xb_ld(&bar[XB_XGEN(b.x)]) == gen, bar);
            __builtin_amdgcn_fence(__ATOMIC_ACQUIRE, "agent");
            asm volatile("s_waitcnt vmcnt(0)" ::: "memory");
        }
    }
    __syncthreads();
}

__global__ void __launch_bounds__(MK_THREADS, 2) mega(MKP p) {
    extern __shared__ __attribute__((aligned(16))) unsigned char lds_raw[];
    LAS unsigned char* lds = (LAS unsigned char*)lds_raw;
    const int lo = p.ph_lo, hi = p.ph_hi;
    const bool multi = hi - lo > 1;
    volatile LAS unsigned* bst = (volatile LAS unsigned*)(lds + LDS_BARST);
    XcdBarrier bar; bar.bar = p.barw; bar.x = 0; bar.st = bst;
    if (multi) {
        if (threadIdx.x < 2) bst[threadIdx.x] = 0u;
        if (blockIdx.x == 0) for (int i = threadIdx.x; i < XCD_BAR_WORDS; i += MK_THREADS) p.barw[i] = 0u;
    }
    int nbar = 0;
#define IN(k) (lo <= (k) && (k) < hi)
#define SEAM(k) do { if (IN(k) && IN((k) + 1)) { if (nbar == 0) { __threadfence(); cooperative_groups::this_grid().sync(); __builtin_amdgcn_fence(__ATOMIC_ACQUIRE, "agent"); bar = xcd_barrier_post(p.barw, bst); } else xcd_barrier(bar); ++nbar; } } while (0)
    if (IN(0)) { phase_prologue(p, lds); phase_moe_weights(p, lds, 0); }
    SEAM(0);
    if (IN(1)) phase_norm<false>(p, lds, p.in[0], p.in[3], 0, 1, 0, true);
    SEAM(1);
    if (IN(2)) {
        pg::DenseSched S; S.init(p.XN, p.W_in0t, S_, 3072, 1024, gridDim.x, blockIdx.x);
        EpiHeads E{p.desc0, p.cosT, p.sinT, p.GATES, p.LOGF, (LAS float*)(lds + LDS_X)};
        pg::gemm_run(lds, 1024, S, E);
    }
    SEAM(2);
    if (IN(3)) phase_scan(p, lds);
    SEAM(3);
    if (IN(4)) phase_fox(p, (char*)lds_raw);
    SEAM(4);
    if (IN(5)) {
        pg::DenseSched S; S.init(p.OATT, p.W_out0t, S_, 1024, 1024, gridDim.x, blockIdx.x);
        EpiResid E{p.in[0], p.out, p.mod + 2 * 1024};
        pg::gemm_run(lds, 1024, S, E);
    }
    SEAM(5);
    if (IN(6)) phase_moe_route<false>(p, lds, 0);
    SEAM(6);
    if (IN(7)) phase_moe_gemm1(p, lds, 0);
    SEAM(7);
    if (IN(8)) phase_moe_gemm2(p, lds, 0);
    SEAM(8);
    if (IN(9)) { phase_norm<true>(p, lds, p.out, p.in[3] + 1024, 1, 1, 0, false); phase_moe_weights(p, lds, 1); }
    if (IN(9) && IN(11)) { xcd_barrier(bar); ++nbar; }
    if (IN(11)) {
        pg::DenseSched S; S.init(p.XN, p.W_in1t, S_, 768, 1024, gridDim.x, blockIdx.x);
        EpiPlain E{p.P1, 768};
        pg::gemm_run(lds, 1024, S, E);
    }
    SEAM(11);
    if (IN(12)) phase_post1a(p);
    SEAM(12);
    if (IN(13)) {
        { pg::DenseSched S; S.init(p.CQN, p.W_uqt, S_, 1536, 384, gridDim.x, blockIdx.x);
          EpiHeads E{p.desc_uq, p.cosT, p.sinT, nullptr, nullptr, (LAS float*)(lds + LDS_X)};
          pg::gemm_run(lds, 384, S, E); }
        { pg::DenseSched S; S.init(p.CKVN, p.W_ukvt, S_, 2048, 256, gridDim.x, blockIdx.x);
          EpiHeads E{p.desc_ukv, p.cosT, p.sinT, nullptr, nullptr, (LAS float*)(lds + LDS_X)};
          pg::gemm_run(lds, 256, S, E); }
    }
    SEAM(13);
    if (IN(14)) phase_mla(p, (char*)lds_raw);
    SEAM(14);
    if (IN(15)) {
        pg::DenseSched S; S.init(p.OATT, p.W_out1t, S_, 1024, 1024, gridDim.x, blockIdx.x);
        EpiResid E{p.out, p.out, p.mod + 6144 + 2 * 1024};
        pg::gemm_run(lds, 1024, S, E);
    }
    SEAM(15);
    if (IN(16)) phase_moe_route<false>(p, lds, 1);
    SEAM(16);
    if (IN(17)) phase_moe_gemm1(p, lds, 1);
    SEAM(17);
    if (IN(18)) phase_moe_gemm2(p, lds, 1);
    SEAM(18);
    if (IN(19)) phase_moe_combine(p, 1);
#undef IN
#undef SEAM
}
extern "C" void kernel_launch(void* const* d_in, const int* in_sizes, int n_in, void* d_out, int out_size, void* d_ws, size_t ws_size, hipStream_t stream) {
    static int grid = 0;
    if (!grid) {
        int dev = 0, cus = 0, per_cu = 0;
        (void)hipGetDevice(&dev); (void)hipDeviceGetAttribute(&cus, hipDeviceAttributeMultiprocessorCount, dev);
        (void)hipFuncSetAttribute((const void*)mega, hipFuncAttributeMaxDynamicSharedMemorySize, LDS_TOTAL);
        (void)hipOccupancyMaxActiveBlocksPerMultiprocessor(&per_cu, (const void*)mega, MK_THREADS, LDS_TOTAL);
        (void)hipGetLastError();
        grid = (cus > 0 && per_cu >= 1) ? cus : -1;
    }
    if (grid < 0) return;
    constexpr size_t MiB = 1u << 20;
    if (ws_size < 528 * MiB || n_in != 34) return;
    char* wsb = (char*)d_ws;
    float* ws = (float*)d_ws;
    size_t o = 0;
    MKP p{};
    for (int i = 0; i < 34; ++i) p.in[i] = (const float*)d_in[i];
    p.out = (float*)d_out; p.pos = (const int*)d_in[2];
    p.mod = ws + o; o += 2 * 6144;
    p.cosT = ws + o; o += (size_t)S_ * 48;
    p.sinT = ws + o; o += (size_t)S_ * 48;
    p.modpart = ws + o; o += 8 * 12288;
    p.desc0 = (BlkDesc*)(ws + o); o += 96 * 8;
    p.desc_uq = (BlkDesc*)(ws + o); o += 48 * 8;
    p.desc_ukv = (BlkDesc*)(ws + o); o += 64 * 8;
    p.CUMB = ws + o; o += (size_t)8 * S_;
    p.gcnt = (int*)(ws + o); o += 128;
    p.CBIAS = ws + o; o += 128;
    p.barw = (unsigned*)(ws + o); o += 4096;
    p.ew = ws + o; o += (size_t)S_ * 8;
    p.list = (int*)(ws + o); o += (size_t)64 * 16384;
    p.WcT = (bf16_t*)(ws + o); o += (size_t)2 * 64 * 2048 / 2;
    p.KCMP = (bf16_t*)(ws + o); o += (size_t)2 * 1024 * 64 / 2;
    p.VCT = (bf16_t*)(ws + o); o += (size_t)2 * 64 * 1024 / 2;
    if (o * 4 > 15 * MiB) return;
    p.XN = (bf16_t*)(wsb + 15 * MiB); p.OATT = (bf16_t*)(wsb + 47 * MiB);
    char* big = wsb + 79 * MiB;
    {   bf16_t* b = (bf16_t*)big;
        p.QN = b; b += (size_t)S_ * 512; p.KV6 = b; b += (size_t)12 * S_ * 64; p.FQ = b; b += (size_t)S_ * 512; p.FK = b; b += (size_t)S_ * 512; p.FV = b; b += (size_t)S_ * 512;
        p.GATES = (float*)b; p.LOGF = p.GATES + (size_t)S_ * 24; }
    p.KSLF = (bf16_t*)(big + 92 * MiB); p.VSLF = (bf16_t*)(big + 96 * MiB); p.OCMP = (bf16_t*)(big + 100 * MiB); p.OWIN = (bf16_t*)(big + 116 * MiB);
    {   bf16_t* b = (bf16_t*)(big + 96 * MiB);
        p.P1 = b; b += (size_t)S_ * 768; p.CQN = b; b += (size_t)S_ * 384; p.CKVN = b; b += (size_t)S_ * 256;
        p.Q96 = b; b += (size_t)16 * S_ * 96; p.K96 = b; b += (size_t)16 * S_ * 96; p.V1 = b; b += (size_t)16 * S_ * 64; }
    p.YBUF = (bf16_t*)big; p.HID = (bf16_t*)(big + 256 * MiB);
    p.Wgu = (bf16_t*)(wsb + 415 * MiB); p.Wd = p.Wgu + (size_t)65 * 512 * 1024;
    {   bf16_t* b = (bf16_t*)(wsb + 513 * MiB);
        p.W_in0t = b; b += (size_t)3072 * 1024; p.W_out0t = b; b += (size_t)1024 * 1024; p.W_in1t = b; b += (size_t)768 * 1024;
        p.W_uqt = b; b += (size_t)1536 * 384; p.W_ukvt = b; b += (size_t)2048 * 256; p.W_out1t = b; b += (size_t)1024 * 1024; }
    p.ph_lo = 0; p.ph_hi = 20;
    void* args[] = {&p};
    (void)hipLaunchCooperativeKernel((const void*)mega, dim3(grid), dim3(MK_THREADS), args, LDS_TOTAL, stream);
}
```

```cpp
#include <hip/hip_runtime.h>
#include <hip/hip_cooperative_groups.h>
#include <stdint.h>

#define S_ 16384
#define D_ 1024
#define HYIN 2848
#define NEXP 64
#define EPSF 1e-6f

__device__ __forceinline__ float wsum(float v) {
#pragma unroll
    for (int o = 32; o > 0; o >>= 1) v += __shfl_xor(v, o);
    return v;
}
__device__ __forceinline__ float sigmf(float x) { return 1.f / (1.f + expf(-x)); }
__device__ __forceinline__ float logsigmf(float x) { return fminf(x, 0.f) - log1pf(expf(-fabsf(x))); }
#define LAS __attribute__((address_space(3)))
#define GAS __attribute__((address_space(1)))
typedef unsigned short bf16_t;
typedef short bf16x8 __attribute__((ext_vector_type(8)));
typedef float f32x4 __attribute__((ext_vector_type(4)));
typedef float f32x2 __attribute__((ext_vector_type(2)));
typedef unsigned u32x4 __attribute__((ext_vector_type(4)));
typedef unsigned u32x2 __attribute__((ext_vector_type(2)));
typedef __bf16 bf16x2_t __attribute__((ext_vector_type(2)));

__device__ __forceinline__ unsigned cvtpk(float lo, float hi) { f32x2 v = {lo, hi}; bf16x2_t b = __builtin_convertvector(v, bf16x2_t); return __builtin_bit_cast(unsigned, b); }
__device__ __forceinline__ float bf2f(bf16_t v) { return __uint_as_float(((unsigned)v) << 16); }
__device__ __forceinline__ bf16_t f2bf(float f) { return (bf16_t)(cvtpk(f, 0.f) & 0xffffu); }

namespace pg {
constexpr int BM = 256, BK = 64, HALF = 128, HTB = HALF * BK * 2, STAGE_BYTES = 8 * HTB;
__device__ __forceinline__ int lds_byte(int r, int c) { const int st = (r >> 4) * 2 + (c >> 5), rr = r & 15, cc = c & 31, ob = rr * 64 + cc * 2; return st * 1024 + (ob ^ (((ob >> 9) & 1) << 5)); }
__device__ __forceinline__ int perm32(int rho) { const int n = rho >> 4, i = rho & 15; return 8 * (i >> 2) + 4 * n + (i & 3); }
__device__ __forceinline__ void stage_rc(int b, int& R, int& C) { const int st = b / 1024, sb = b % 1024, swz = sb ^ (((sb >> 9) & 1) << 5); R = (st >> 1) * 16 + swz / 64; C = (st & 1) * 32 + (swz % 64) / 2; }

struct Unit { int pm, pn, aux; const char* A; const char* B; unsigned ra[4]; };

template <class Epi, class Sched>
__device__ __forceinline__ void gemm_run(LAS unsigned char* lds, const int K, const Sched& S, const Epi& E) {
    int tid_ = threadIdx.x; asm volatile("" : "+v"(tid_));
    const int tid = tid_, wid = __builtin_amdgcn_readfirstlane(tid >> 6), lane = tid & 63, wr = wid >> 2, wc = wid & 3, fr = lane & 15, fq = lane >> 4;
    int nt_ = K / BK; asm volatile("" : "+s"(nt_)); const int nt = nt_;
    int R0, C0; stage_rc(tid * 16, R0, C0);
    unsigned voffB[2];
#pragma unroll
    for (int i = 0; i < 2; ++i) { const int Rb = Epi::PERM ? ((R0 & ~31) + perm32(R0 & 31)) : R0; voffB[i] = (unsigned)((Rb + 64 * i) * K + C0) * 2u; }
    const size_t kstep = (size_t)(BK * 2);
    const size_t hstep = (size_t)HALF * K * 2;
    const unsigned ldsw = (unsigned)wid * 1024u;
    const int aoff = lds_byte(wr * 64 + fr, fq * 8), boff = lds_byte(wc * 32 + fr, fq * 8);
#define PG_SA(b, h) (((b) * 2 + (h)) * HTB)
#define PG_SB(b, h) ((4 + (b) * 2 + (h)) * HTB)
#define PG_STAGE2(bufoff, gbase, v0, v1) do { \
        __builtin_amdgcn_global_load_lds((const unsigned*)((const char*)(gbase) + (v0)), (LAS unsigned*)(lds + (bufoff) + ldsw), 16, 0, 0); \
        __builtin_amdgcn_global_load_lds((const unsigned*)((const char*)(gbase) + (v1)), (LAS unsigned*)(lds + (bufoff) + ldsw + 8192), 16, 0, 0); } while (0)
#define PG_STAGEB(bufoff, gbase) PG_STAGE2(bufoff, gbase, voffB[0], voffB[1])
#define PG_LDA(dst, b, h) do { _Pragma("unroll") for (int m = 0; m < 4; ++m) _Pragma("unroll") for (int k = 0; k < 2; ++k) dst[m][k] = *(const LAS bf16x8*)(lds + PG_SA(b, h) + aoff + m * 2048 + k * 1024); } while (0)
#define PG_LDB(dst, b, h) do { _Pragma("unroll") for (int n = 0; n < 2; ++n) _Pragma("unroll") for (int k = 0; k < 2; ++k) dst[n][k] = *(const LAS bf16x8*)(lds + PG_SB(b, h) + boff + n * 2048 + k * 1024); } while (0)
#define PG_MMA(ai, bj, At, Bt) do { __builtin_amdgcn_s_setprio(1); _Pragma("unroll") for (int m = 0; m < 4; ++m) _Pragma("unroll") for (int n = 0; n < 2; ++n) _Pragma("unroll") for (int k = 0; k < 2; ++k) \
        acc[ai][bj][m][n] = __builtin_amdgcn_mfma_f32_16x16x32_bf16(Bt[n][k], At[m][k], acc[ai][bj][m][n], 0, 0, 0); __builtin_amdgcn_s_setprio(0); } while (0)
#define PG_WAIT_V(n) asm volatile("s_waitcnt vmcnt(" #n ")" ::: "memory")
#define PG_WAIT_L(n) asm volatile("s_waitcnt lgkmcnt(" #n ")" ::: "memory")
#define PG_BAR __builtin_amdgcn_s_barrier()
#define PG_SCHED __builtin_amdgcn_sched_barrier(0)
    Unit cur, nxt; int ui = 0;
    if (!S.next(0, cur, R0, C0)) return;
    f32x4 acc[2][2][4][2];
#pragma unroll
    for (int a = 0; a < 2; ++a)
#pragma unroll
        for (int b = 0; b < 2; ++b)
#pragma unroll
            for (int m = 0; m < 4; ++m)
#pragma unroll
                for (int n = 0; n < 2; ++n) acc[a][b][m][n] = (f32x4){0.f, 0.f, 0.f, 0.f};
    bf16x8 At[4][2], B0[2][2], B1[2][2];
    const char* cA = cur.A; const char* cB = cur.B;
    PG_STAGEB(PG_SB(0, 0), cB); PG_STAGEB(PG_SB(0, 1), cB + hstep); PG_STAGE2(PG_SA(0, 0), cA, cur.ra[0], cur.ra[1]); PG_STAGE2(PG_SA(0, 1), cA, cur.ra[2], cur.ra[3]);
    if (wr == 1) PG_BAR;
    PG_WAIT_V(2); PG_BAR;
    PG_STAGEB(PG_SB(1, 0), cB + kstep); PG_STAGE2(PG_SA(1, 0), cA + kstep, cur.ra[0], cur.ra[1]); PG_STAGEB(PG_SB(1, 1), cB + hstep + kstep);
    PG_WAIT_V(6); PG_BAR;
    for (;;) {
        const bool has_next = S.next(ui + 1, nxt, R0, C0);
        if (!has_next) nxt = cur;
        const char* nA = nxt.A; const char* nB = nxt.B;
#pragma unroll 1
        for (int t = 0; t < nt; t += 2) {
            const bool last = (t == nt - 2);
            const char* a1 = cA + (size_t)(t + 1) * kstep;
            const char* a2 = last ? nA : cA + (size_t)(t + 2) * kstep; const char* b2 = last ? nB : cB + (size_t)(t + 2) * kstep;
            const char* a3 = a2 + kstep; const char* b3 = b2 + kstep;
            const unsigned r0 = last ? nxt.ra[0] : cur.ra[0], r1 = last ? nxt.ra[1] : cur.ra[1], r2 = last ? nxt.ra[2] : cur.ra[2], r3 = last ? nxt.ra[3] : cur.ra[3];
            PG_LDB(B0, 0, 0); PG_LDB(B1, 0, 1); PG_SCHED; PG_LDA(At, 0, 0); PG_STAGE2(PG_SA(1, 1), a1, cur.ra[2], cur.ra[3]);
            PG_WAIT_V(8); PG_WAIT_L(0); PG_BAR; PG_MMA(0, 0, At, B0); PG_MMA(0, 1, At, B1); PG_BAR; PG_SCHED;
            PG_LDA(At, 0, 1); PG_STAGEB(PG_SB(0, 0), b2); PG_STAGEB(PG_SB(0, 1), b2 + hstep); PG_STAGE2(PG_SA(0, 0), a2, r0, r1);
            PG_WAIT_V(8); PG_WAIT_L(0); PG_BAR; PG_MMA(1, 0, At, B0); PG_MMA(1, 1, At, B1); PG_BAR; PG_SCHED;
            PG_LDB(B0, 1, 0); PG_LDB(B1, 1, 1); PG_SCHED; PG_LDA(At, 1, 0); PG_STAGE2(PG_SA(0, 1), a2, r2, r3);
            PG_WAIT_V(8); PG_WAIT_L(0); PG_BAR; PG_MMA(0, 0, At, B0); PG_MMA(0, 1, At, B1); PG_BAR; PG_SCHED;
            PG_LDA(At, 1, 1); PG_STAGEB(PG_SB(1, 0), b3); PG_STAGEB(PG_SB(1, 1), b3 + hstep); PG_STAGE2(PG_SA(1, 0), a3, r0, r1);
            PG_WAIT_V(8); PG_WAIT_L(0); PG_BAR; PG_MMA(1, 0, At, B0); PG_MMA(1, 1, At, B1); PG_BAR; PG_SCHED;
        }
        if (wr == 0) PG_BAR;
        E(acc, cur, wid, wr, wc, fr, fq);
        if (!has_next) break;
#pragma unroll
        for (int a = 0; a < 2; ++a)
#pragma unroll
            for (int b = 0; b < 2; ++b)
#pragma unroll
                for (int m = 0; m < 4; ++m)
#pragma unroll
                    for (int n = 0; n < 2; ++n) acc[a][b][m][n] = (f32x4){0.f, 0.f, 0.f, 0.f};
        cur = nxt; cA = nA; cB = nB; ++ui;
        if (wr == 1) PG_BAR;
    }
    PG_WAIT_V(0);
    PG_BAR;
#undef PG_SA
#undef PG_SB
#undef PG_STAGE2
#undef PG_STAGEB
#undef PG_LDA
#undef PG_LDB
#undef PG_MMA
}

struct DenseSched {
    const char* A; const char* Bt; int K, nM, nN, nwg, G, c;
    __device__ __forceinline__ void init(const void* A_, const void* Bt_, int M, int N, int K_, int G_, int c_) { A = (const char*)A_; Bt = (const char*)Bt_; K = K_; nM = M / BM; nN = N / BM; nwg = nM * nN; G = G_; c = c_; }
    __device__ __forceinline__ bool next(int i, Unit& u, int R0, int C0) const {
        const long L = (long)i * G + c; if (L >= nwg) return false;
        int wgid = (int)L; { const int q = nwg / 8, r = nwg % 8, xcd = wgid % 8, off = wgid / 8; wgid = (xcd < r ? xcd * (q + 1) : r * (q + 1) + (xcd - r) * q) + off; }
        const int nig = 8 * nN, gid = wgid / nig, fm = gid * 8, gsz = (nM - fm) < 8 ? (nM - fm) : 8;
        u.pm = fm + ((wgid % nig) % gsz); u.pn = (wgid % nig) / gsz; u.aux = 0;
        u.A = A + (size_t)u.pm * BM * K * 2; u.B = Bt + (size_t)u.pn * BM * K * 2;
#pragma unroll
        for (int q = 0; q < 4; ++q) u.ra[q] = (unsigned)((R0 + 64 * q) * K + C0) * 2u;
        return true;
    }
};
}
namespace att {
using s16x4 = __attribute__((ext_vector_type(4))) short;
using f32x16 = __attribute__((ext_vector_type(16))) float;
typedef __attribute__((address_space(3))) const char* lds_cptr;
typedef short v4i16_t __attribute__((ext_vector_type(4)));
constexpr int NSLOT = 3, VSLOT = 8192;
template <int DQ> struct Geo {
    static constexpr int NK = DQ / 16;
    static constexpr int KSLOT = (DQ == 64) ? 8192 : 16384;
    static constexpr int QWAVE = (DQ == 64) ? 4096 : 6144;
    static constexpr int LDS_K = 0, LDS_V = NSLOT * KSLOT, LDS_WS = LDS_V + NSLOT * VSLOT, LDS_OST = LDS_WS + 8 * 64 * 4, LDS_BYTES = LDS_OST + 8 * QWAVE;
};
constexpr int LDS_BIAS = Geo<64>::LDS_BYTES;
#define ASBAR() __builtin_amdgcn_sched_barrier(0)
#define AWAIT_BAR(N) asm volatile("s_waitcnt vmcnt(" #N ") lgkmcnt(0)\n\ts_barrier" ::: "memory")
__device__ __forceinline__ int crow(int r, int hi) { return (r & 3) + 8 * (r >> 2) + 4 * hi; }
__device__ __forceinline__ void glds16(const void* gsrc, unsigned lds_dst) { unsigned keep;
    asm volatile("s_mov_b32 %0, m0\n\ts_mov_b32 m0, %2\n\ts_nop 0\n\tglobal_load_lds_dwordx4 %1, off\n\ts_mov_b32 m0, %0" : "=&s"(keep) : "v"(gsrc), "s"(lds_dst) : "memory"); }
__device__ __forceinline__ float fadd_s(float a, float b) { float r; asm("v_add_f32_e32 %0, %1, %2" : "=v"(r) : "v"(a), "v"(b)); return r; }
__device__ __forceinline__ float fsub_s(float a, float b) { float r; asm("v_sub_f32_e32 %0, %1, %2" : "=v"(r) : "v"(a), "v"(b)); return r; }
__device__ __forceinline__ float max3f(float a, float b, float c) { float r; asm("v_max3_f32 %0, %1, %2, %3" : "=v"(r) : "v"(a), "v"(b), "v"(c)); return r; }
__device__ __forceinline__ float max2f(float a, float b) { float r; asm("v_max_f32_e32 %0, %1, %2" : "=v"(r) : "v"(a), "v"(b)); return r; }
__device__ __forceinline__ s16x4 vtr(lds_cptr p) { return __builtin_bit_cast(s16x4, __builtin_amdgcn_ds_read_tr16_b64_v4i16((__attribute__((address_space(3))) v4i16_t*)p)); }
template <int NK> __device__ __forceinline__ void kloadall(bf16x8* kf, lds_cptr kp) {
#pragma unroll
    for (int j = 0; j < NK; ++j) { kf[2 * j] = *(const LAS bf16x8*)(kp + j * 2048); kf[2 * j + 1] = *(const LAS bf16x8*)(kp + j * 2048 + 512); } }
__device__ __forceinline__ void kload2(bf16x8* kf, lds_cptr kp, int j) { kf[2 * j] = *(const LAS bf16x8*)(kp + j * 2048); kf[2 * j + 1] = *(const LAS bf16x8*)(kp + j * 2048 + 512); }
__device__ __forceinline__ void cmask(f32x16& p0, f32x16& p1, int koff, int qtok, int hi) {
    const int x = qtok - koff - 4 * hi;
#pragma unroll
    for (int r = 0; r < 16; ++r) { const int c = (r & 3) + 8 * (r >> 2); if (c > x) p0[r] = -INFINITY; if (c + 32 > x) p1[r] = -INFINITY; }
}
__device__ __forceinline__ void wmask(f32x16& p0, f32x16& p1, int thr, int hi) {
    const int y = thr - 4 * hi;
#pragma unroll
    for (int r = 0; r < 16; ++r) { const int c = (r & 3) + 8 * (r >> 2); if (c < y) p0[r] = -INFINITY; if (c + 32 < y) p1[r] = -INFINITY; }
}
__device__ __forceinline__ float rowmax(const f32x16& p0, const f32x16& p1) {
    float a = max3f(p0[0], p0[1], p1[0]), b = max3f(p0[2], p0[3], p1[1]); a = max3f(a, p1[2], p1[3]);
#pragma unroll
    for (int r = 4; r < 16; r += 4) { a = max3f(a, p0[r], p0[r + 1]); b = max3f(b, p0[r + 2], p0[r + 3]); a = max3f(a, p1[r], p1[r + 1]); b = max3f(b, p1[r + 2], p1[r + 3]); }
    const float m = max2f(a, b);
    auto rr = __builtin_amdgcn_permlane32_swap(__float_as_uint(m), __float_as_uint(m), false, false);
    return max2f(__uint_as_float(rr[0]), __uint_as_float(rr[1]));
}

enum { MODE_CAUSAL = 0, MODE_FOX = 1, MODE_WIN = 2 };
struct UnitArgs {
    const bf16_t* qrow;
    const bf16_t* K; const bf16_t* V; int kvpitch, vpitch;
    bf16_t* obase; int opitch;
    int qtok;
    int abase;
    int nsteps;
    const LAS float* bias;
};

template <int NB> __device__ __forceinline__ int seq(int i, int abase) { return (i < NB) ? abase + i : abase + NB - 1 - i; }

template <int MODE, bool GQA4, int THRL, int DQ>
__device__ __forceinline__ void attn_unit(const UnitArgs& A, char* shm) {
    constexpr int NB = GQA4 ? 1 : 4;
    typedef Geo<DQ> G; constexpr int NK = G::NK, KSLOT = G::KSLOT, LDS_K = G::LDS_K, LDS_V = G::LDS_V, LDS_WS = G::LDS_WS, LDS_OST = G::LDS_OST, QWAVE = G::QWAVE;
    constexpr bool USE_NEGM = (MODE != MODE_FOX);
    int tid_ = threadIdx.x; asm volatile("" : "+v"(tid_));
    const int tid = tid_, lane = tid & 63, r32 = lane & 31, hi = lane >> 5; const int wid = __builtin_amdgcn_readfirstlane(tid >> 6);
    const unsigned lds0 = (unsigned)(uintptr_t)shm;
    float* wsf = (float*)(shm + LDS_WS) + wid * 64;
    const int NT = A.nsteps, abase = A.abase; const long kvp = A.kvpitch, vvp = A.vpitch;
    const bf16_t* ksrc = A.K + (long)lane * kvp + wid * 8;
    const bf16_t* ksrc2 = A.K + (long)lane * kvp + (8 + (wid & 3)) * 8;
    const bf16_t* vsrc = A.V + (long)(16 * (wid & 3) + (lane >> 2)) * vvp + (wid >> 2) * 32 + (lane & 3) * 8;
    const unsigned kdst = lds0 + LDS_K + wid * 1024, vdst = lds0 + LDS_V + wid * 1024, kdst2 = lds0 + LDS_K + (8 + wid) * 1024;
#define TILE_OF(t) ({ int a_ = seq<NB>((t), abase); a_ < 0 ? 0 : a_; })
#define DMA_K(t, slot) do { const long to_ = (long)TILE_OF(t) * 64 * kvp; glds16(ksrc + to_, (unsigned)__builtin_amdgcn_readfirstlane(kdst + (slot) * KSLOT)); \
        if (DQ == 96) glds16(ksrc2 + to_, (unsigned)__builtin_amdgcn_readfirstlane(kdst2 + (slot) * KSLOT)); } while (0)
#define DMA_V(t, slot) glds16(vsrc + (long)TILE_OF(t) * 64 * vvp, (unsigned)__builtin_amdgcn_readfirstlane(vdst + (slot) * VSLOT))
    const lds_cptr shm3 = (lds_cptr)shm; const lds_cptr kp0 = shm3 + LDS_K + hi * 1024 + r32 * 16;
    const lds_cptr vp0 = shm3 + LDS_V + ((lane >> 4) & 1) * 32 + (lane & 3) * 8 + (4 * hi + ((lane & 15) >> 2)) * 64;
    const int vb0 = (int)(lds0 + LDS_V) + ((lane >> 4) & 1) * 32 + (lane & 3) * 8 + (4 * hi + ((lane & 15) >> 2)) * 64;
    DMA_K(0, 0); DMA_V(0, 0); DMA_K(1, 1);
    bf16x8 qr[NK];
#pragma unroll
    for (int d0 = 0; d0 < NK; ++d0) qr[d0] = *reinterpret_cast<const bf16x8*>(A.qrow + d0 * 16 + hi * 8);
    const lds_cptr qlp = shm3 + LDS_OST + wid * QWAVE + hi * 512 + r32 * 16;
    if (DQ == 96) {
#pragma unroll
        for (int d0 = 0; d0 < NK; ++d0) *(LAS bf16x8*)(const_cast<__attribute__((address_space(3))) char*>(qlp) + d0 * 1024) = qr[d0];
    }
#define QL(d0) (*(const LAS bf16x8*)(qlp + (d0) * 1024))
    float mhat = 0.f, l_reg = 0.f; f32x16 o[2]; o[0] = f32x16{}; o[1] = f32x16{};
    f32x16 negm = f32x16{}; if (USE_NEGM) asm volatile("" : "+v"(negm));
    const int qtok = A.qtok;
#define CMASK(P0, P1, t) do { const int t_ = (t); if (t_ < NB) cmask(P0, P1, 64 * t_, qtok, hi); \
        else { const int a_ = abase + NB - 1 - t_; if (a_ < 0) wmask(P0, P1, 64, hi); \
               else if (MODE == MODE_WIN) { const int thr_ = qtok - 511 + 64 * (abase - a_); if (thr_ > 0) wmask(P0, P1, thr_, hi); } } } while (0)
#define CINIT1(C, t, OFF) do { if (MODE == MODE_FOX) { const LAS float* bt_ = A.bias + 64 * (seq<NB>((t), abase) - (abase + NB - NT)) + 4 * hi + (OFF); const float nm_ = -mhat; \
        _Pragma("unroll") for (int g_ = 0; g_ < 4; ++g_) { const f32x4 b_ = *(const LAS f32x4*)(bt_ + 8 * g_); C[4 * g_] = b_.x; C[4 * g_ + 1] = b_.y; C[4 * g_ + 2] = b_.z; C[4 * g_ + 3] = b_.w; } \
        _Pragma("unroll") for (int r_ = 0; r_ < 16; ++r_) C[r_] += nm_; asm volatile("" : "+v"(C)); } \
      else if (USE_NEGM) { C = negm; } \
      else { const float nm_ = -mhat; _Pragma("unroll") for (int r_ = 0; r_ < 16; ++r_) C[r_] = nm_; asm volatile("" : "+v"(C)); } } while (0)
#define CINIT(C0, C1, t) do { CINIT1(C0, t, 0); CINIT1(C1, t, 32); } while (0)
    bool resc = false;
#define START(P0, P1) do { const float rm = rowmax(P0, P1); resc = false; \
    { const float dl = rm; mhat = fadd_s(mhat, dl); \
      _Pragma("unroll") for (int r = 0; r < 16; ++r) { P0[r] = fsub_s(P0[r], dl); P1[r] = fsub_s(P1[r], dl); } \
      if (USE_NEGM) { _Pragma("unroll") for (int r = 0; r < 16; ++r) negm[r] = -mhat; asm volatile("" : "+v"(negm)); } } \
    _Pragma("unroll") for (int r = 0; r < 16; ++r) P0[r] = __builtin_amdgcn_exp2f(P0[r]); } while (0)
#define RESC() do { if (resc) { asm volatile("s_waitcnt lgkmcnt(0)" ::: "memory"); \
      const float* wsh_ = wsf + 4 * hi; \
      _Pragma("unroll") for (int d_ = 0; d_ < 2; ++d_) _Pragma("unroll") for (int r = 0; r < 16; ++r) o[d_][r] *= wsh_[(r & 3) + 8 * (r >> 2)]; } } while (0)
    f32x16 pA0, pA1, pB0, pB1; bf16x8 kf[2 * NK];
    int sl_prev = 0, sl_cur = 0, sl_next = 1;
#define ROT() do { sl_prev = sl_cur; sl_cur = sl_next; sl_next = (sl_next == NSLOT - 1) ? 0 : sl_next + 1; } while (0)
    DMA_K(2, 2);
    if (DQ == 96) { AWAIT_BAR(5); } else { AWAIT_BAR(3); }
    { const char* kb = shm + LDS_K + hi * 1024 + r32 * 16;
      CINIT(pA0, pA1, 0);
#pragma unroll
      for (int d0 = 0; d0 < NK; ++d0) {
          const bf16x8 b0 = *reinterpret_cast<const bf16x8*>(kb + d0 * 2048);
          const bf16x8 b1 = *reinterpret_cast<const bf16x8*>(kb + d0 * 2048 + 512);
          pA0 = __builtin_amdgcn_mfma_f32_32x32x16_bf16(b0, qr[d0], pA0, 0, 0, 0); pA1 = __builtin_amdgcn_mfma_f32_32x32x16_bf16(b1, qr[d0], pA1, 0, 0, 0); } }
    asm volatile("s_nop 15\n\ts_nop 7" : "+v"(pA0), "+v"(pA1)); CMASK(pA0, pA1, 0);
    START(pA0, pA1);
    _Pragma("unroll") for (int r = 0; r < 16; ++r) pA1[r] = __builtin_amdgcn_exp2f(pA1[r]);
    AWAIT_BAR(0);
    DMA_K(3, 0); DMA_V(1, 1);
    ROT();
    kloadall<NK>(kf, kp0 + sl_cur * KSLOT);
    if (DQ == 96) { AWAIT_BAR(3); } else { AWAIT_BAR(2); }
    s16x4 vlo[(DQ == 96) ? 4 : 8], vhi[(DQ == 96) ? 4 : 8]; u32x4 pw0, pw1, pw2, pw3;
#define PKW(P, B) cvtpk(P[B], P[B + 1])
#define PAF(k) __builtin_bit_cast(bf16x8, pw##k)
#define VFR(i) (bf16x8){vlo[i][0], vlo[i][1], vlo[i][2], vlo[i][3], vhi[i][0], vhi[i][1], vhi[i][2], vhi[i][3]}
#define PIN(x) asm volatile("" : "+v"(x))
#define MX3(a, b, c) __builtin_fmaxf(__builtin_fmaxf((a), (b)), (c))
#define GAPA(MF, A0, A1, A2, A3, W0, W1, PW) do { MF; sacc += A0; sacc += A1; sacc += A2; sacc += A3; PIN(sacc); W0; W1; PIN(PW); ASBAR(); } while (0)
#define EX(v) __builtin_amdgcn_exp2f(v)
#define GAPB(MF, X, B) do { MF; X[B] = EX(X[B]); X[B + 1] = EX(X[B + 1]); X[B + 2] = EX(X[B + 2]); X[B + 3] = EX(X[B + 3]); PIN(X); ASBAR(); } while (0)
#define VRD(i) do { vlo[i] = vtr(vp_ + (((i) >> 2) * 4096 + ((i) & 3) * 1024)); vhi[i] = vtr(vp_ + (((i) >> 2) * 4096 + ((i) & 3) * 1024 + 512)); } while (0)
#define KRD(G_, j) do { if (G_) { kload2(kf, kp0 + sl_next * KSLOT, j); ASBAR(); } } while (0)
#define MFMA32(a, b, c) __builtin_amdgcn_mfma_f32_32x32x16_bf16(a, b, c, 0, 0, 0)
#define STEP64(C0, C1, P0, P1, t, GK, GV, GL, DOMASK) do { ASBAR(); \
    const lds_cptr vp_ = vp0 + sl_prev * VSLOT; \
    CINIT1(C0, t, 0); ASBAR(); \
    VRD(0); ASBAR(); float sacc = (P0[0] + P0[1]); \
    GAPA(C0 = MFMA32(kf[0], qr[0], C0), P0[2], P0[3], P0[4], P0[5],     pw0[0] = PKW(P0, 0), pw0[1] = PKW(P0, 2), pw0); \
    CINIT1(C1, t, 32); ASBAR(); \
    VRD(4); ASBAR(); GAPA(C1 = MFMA32(kf[1], qr[0], C1), P0[6], P0[7], P0[8], P0[9],     pw0[2] = PKW(P0, 4), pw0[3] = PKW(P0, 6), pw0); \
    VRD(1); ASBAR(); GAPA(C0 = MFMA32(kf[2], qr[1], C0),   P0[10], P0[11], P0[12], P0[13], pw1[0] = PKW(P0, 8), pw1[1] = PKW(P0, 10), pw1); \
    VRD(5); ASBAR(); GAPA(C1 = MFMA32(kf[3], qr[1], C1),   P0[14], P0[15], P1[0], P1[1],   pw1[2] = PKW(P0, 12), pw1[3] = PKW(P0, 14), pw1); \
    VRD(2); ASBAR(); GAPA(C0 = MFMA32(kf[4], qr[2], C0),   P1[2], P1[3], P1[4], P1[5],     pw2[0] = PKW(P1, 0), pw2[1] = PKW(P1, 2), pw2); \
    VRD(6); ASBAR(); GAPA(C1 = MFMA32(kf[5], qr[2], C1),   P1[6], P1[7], P1[8], P1[9],     pw2[2] = PKW(P1, 4), pw2[3] = PKW(P1, 6), pw2); \
    VRD(3); ASBAR(); GAPA(C0 = MFMA32(kf[6], qr[3], C0),   P1[10], P1[11], P1[12], P1[13], pw3[0] = PKW(P1, 8), pw3[1] = PKW(P1, 10), pw3); \
    VRD(7); ASBAR(); GAPA(C1 = MFMA32(kf[7], qr[3], C1),   P1[14], P1[15], 0.f, 0.f,       pw3[2] = PKW(P1, 12), pw3[3] = PKW(P1, 14), pw3); \
    l_reg += sacc; \
    if (GK) { DMA_K((t) + 3, sl_cur); } if (GV) { DMA_V((t) + 1, sl_next); } \
    if (DOMASK) CMASK(C0, C1, t); \
    { float a = MX3(C0[0], C0[1], C1[0]), b = MX3(C0[2], C0[3], C1[1]); a = MX3(a, C1[2], C1[3]); \
      _Pragma("unroll") for (int r = 4; r < 16; r += 4) { a = MX3(a, C0[r], C0[r + 1]); b = MX3(b, C0[r + 2], C0[r + 3]); a = MX3(a, C1[r], C1[r + 1]); b = MX3(b, C1[r + 2], C1[r + 3]); } \
      float rm = __builtin_fmaxf(a, b); { auto rr = __builtin_amdgcn_permlane32_swap(__float_as_uint(rm), __float_as_uint(rm), false, false); rm = __builtin_fmaxf(__uint_as_float(rr[0]), __uint_as_float(rr[1])); } \
      resc = false; \
      if (__builtin_expect(__any(rm > (float)THRL), 0)) { const float dl = __builtin_fmaxf(rm, 0.f); mhat += dl; \
        _Pragma("unroll") for (int r = 0; r < 16; ++r) { C0[r] -= dl; C1[r] -= dl; } \
        if (USE_NEGM) { _Pragma("unroll") for (int r = 0; r < 16; ++r) negm[r] = -mhat; asm volatile("" : "+v"(negm)); } \
        const float f = __builtin_amdgcn_exp2f(-dl); l_reg *= f; if (hi == 0) wsf[r32] = f; resc = true; } } \
    ASBAR(); \
    GAPB(o[0] = MFMA32(PAF(0), VFR(0), o[0]), C0, 0); \
    GAPB(o[1] = MFMA32(PAF(0), VFR(4), o[1]), C0, 4); \
    KRD(GL, 0); GAPB(o[0] = MFMA32(PAF(1), VFR(1), o[0]), C0, 8); \
    KRD(GL, 1); GAPB(o[1] = MFMA32(PAF(1), VFR(5), o[1]), C0, 12); \
    KRD(GL, 2); GAPB(o[0] = MFMA32(PAF(2), VFR(2), o[0]), C1, 0); \
    KRD(GL, 3); GAPB(o[1] = MFMA32(PAF(2), VFR(6), o[1]), C1, 4); \
    GAPB(o[0] = MFMA32(PAF(3), VFR(3), o[0]), C1, 8); \
    GAPB(o[1] = MFMA32(PAF(3), VFR(7), o[1]), C1, 12); \
    } while (0)
#define AWAIT_STEADY() do { if (DQ == 96) { AWAIT_BAR(3); } else { AWAIT_BAR(2); } } while (0)
#define VRD4(i, b) do { vlo[b] = vtr(vp_ + (((i) >> 2) * 4096 + ((i) & 3) * 1024)); vhi[b] = vtr(vp_ + (((i) >> 2) * 4096 + ((i) & 3) * 1024 + 512)); } while (0)
#define VFR4(b) (bf16x8){vlo[b][0], vlo[b][1], vlo[b][2], vlo[b][3], vhi[b][0], vhi[b][1], vhi[b][2], vhi[b][3]}
#define GAPQ(MF, QLD, A0, A1, A2, A3, W0, W1, PW) do { MF; QLD; sacc += A0; sacc += A1; sacc += A2; sacc += A3; PIN(sacc); W0; W1; PIN(PW); ASBAR(); } while (0)
#define STEP96(C0, C1, P0, P1, t, GK, GV, GL, DOMASK) do { ASBAR(); \
    const lds_cptr vp_ = vp0 + sl_prev * VSLOT; \
    CINIT1(C0, t, 0); CINIT1(C1, t, 32); bf16x8 qa = QL(0), qb; ASBAR(); \
    float sacc = (P0[0] + P0[1]); \
    GAPQ(C0 = MFMA32(kf[0], qa, C0), qb = QL(1), P0[2], P0[3], P0[4], P0[5],     pw0[0] = PKW(P0, 0), pw0[1] = PKW(P0, 2), pw0); \
    GAPQ(C1 = MFMA32(kf[1], qa, C1), (void)0,    P0[6], P0[7], P0[8], P0[9],     pw0[2] = PKW(P0, 4), pw0[3] = PKW(P0, 6), pw0); \
    GAPQ(C0 = MFMA32(kf[2], qb, C0), qa = QL(2), P0[10], P0[11], P0[12], P0[13], pw1[0] = PKW(P0, 8), pw1[1] = PKW(P0, 10), pw1); \
    GAPQ(C1 = MFMA32(kf[3], qb, C1), (void)0,    P0[14], P0[15], P1[0], P1[1],   pw1[2] = PKW(P0, 12), pw1[3] = PKW(P0, 14), pw1); \
    GAPQ(C0 = MFMA32(kf[4], qa, C0), qb = QL(3), P1[2], P1[3], P1[4], P1[5],     pw2[0] = PKW(P1, 0), pw2[1] = PKW(P1, 2), pw2); \
    GAPQ(C1 = MFMA32(kf[5], qa, C1), (void)0,    P1[6], P1[7], P1[8], P1[9],     pw2[2] = PKW(P1, 4), pw2[3] = PKW(P1, 6), pw2); \
    GAPQ(C0 = MFMA32(kf[6], qb, C0), qa = QL(4), P1[10], P1[11], P1[12], P1[13], pw3[0] = PKW(P1, 8), pw3[1] = PKW(P1, 10), pw3); \
    GAPQ(C1 = MFMA32(kf[7], qb, C1), (void)0,    P1[14], P1[15], 0.f, 0.f,       pw3[2] = PKW(P1, 12), pw3[3] = PKW(P1, 14), pw3); \
    C0 = MFMA32(kf[8], qa, C0); qb = QL(5); VRD4(0, 0); ASBAR(); \
    C1 = MFMA32(kf[9], qa, C1); VRD4(4, 1); ASBAR(); \
    C0 = MFMA32(kf[10], qb, C0); ASBAR(); \
    C1 = MFMA32(kf[11], qb, C1); ASBAR(); \
    l_reg += sacc; \
    if (GK) { DMA_K((t) + 3, sl_cur); } if (GV) { DMA_V((t) + 1, sl_next); } \
    if (DOMASK) CMASK(C0, C1, t); \
    { float a = MX3(C0[0], C0[1], C1[0]), b = MX3(C0[2], C0[3], C1[1]); a = MX3(a, C1[2], C1[3]); \
      _Pragma("unroll") for (int r = 4; r < 16; r += 4) { a = MX3(a, C0[r], C0[r + 1]); b = MX3(b, C0[r + 2], C0[r + 3]); a = MX3(a, C1[r], C1[r + 1]); b = MX3(b, C1[r + 2], C1[r + 3]); } \
      float rm = __builtin_fmaxf(a, b); { auto rr = __builtin_amdgcn_permlane32_swap(__float_as_uint(rm), __float_as_uint(rm), false, false); rm = __builtin_fmaxf(__uint_as_float(rr[0]), __uint_as_float(rr[1])); } \
      resc = false; \
      if (__builtin_expect(__any(rm > (float)THRL), 0)) { const float dl = __builtin_fmaxf(rm, 0.f); mhat += dl; \
        _Pragma("unroll") for (int r = 0; r < 16; ++r) { C0[r] -= dl; C1[r] -= dl; } \
        if (USE_NEGM) { _Pragma("unroll") for (int r = 0; r < 16; ++r) negm[r] = -mhat; asm volatile("" : "+v"(negm)); } \
        const float f = __builtin_amdgcn_exp2f(-dl); l_reg *= f; if (hi == 0) wsf[r32] = f; resc = true; } } \
    ASBAR(); \
    VRD4(1, 2); ASBAR(); GAPB(o[0] = MFMA32(PAF(0), VFR4(0), o[0]), C0, 0); \
    VRD4(5, 3); ASBAR(); GAPB(o[1] = MFMA32(PAF(0), VFR4(1), o[1]), C0, 4); \
    VRD4(2, 0); KRD(GL, 0); GAPB(o[0] = MFMA32(PAF(1), VFR4(2), o[0]), C0, 8); \
    VRD4(6, 1); KRD(GL, 1); GAPB(o[1] = MFMA32(PAF(1), VFR4(3), o[1]), C0, 12); \
    VRD4(3, 2); KRD(GL, 2); GAPB(o[0] = MFMA32(PAF(2), VFR4(0), o[0]), C1, 0); \
    VRD4(7, 3); KRD(GL, 3); GAPB(o[1] = MFMA32(PAF(2), VFR4(1), o[1]), C1, 4); \
    KRD(GL, 4); GAPB(o[0] = MFMA32(PAF(3), VFR4(2), o[0]), C1, 8); \
    KRD(GL, 5); GAPB(o[1] = MFMA32(PAF(3), VFR4(3), o[1]), C1, 12); \
    } while (0)
#define STEP(C0, C1, P0, P1, t, GK, GV, GL, DOMASK) do { if constexpr (DQ == 96) { STEP96(C0, C1, P0, P1, t, GK, GV, GL, DOMASK); } else { STEP64(C0, C1, P0, P1, t, GK, GV, GL, DOMASK); } } while (0)
#define ENDW(tt) do { if ((tt) + 3 < NT) { AWAIT_STEADY(); } else if ((tt) + 2 < NT) { AWAIT_BAR(1); } else { AWAIT_BAR(0); } } while (0)
    int t = 1;
    for (; t < 5 && t + 1 < NT; t += 2) {
        STEP(pB0, pB1, pA0, pA1, t, (t + 3 < NT), (t + 1 < NT), (t + 1 < NT), true);       ENDW(t);     RESC(); ROT();
        STEP(pA0, pA1, pB0, pB1, t + 1, (t + 4 < NT), (t + 2 < NT), (t + 2 < NT), true);   ENDW(t + 1); RESC(); ROT();
    }
    for (; t + 5 < NT; t += 2) {
        STEP(pB0, pB1, pA0, pA1, t, true, true, true, false);     AWAIT_STEADY(); RESC(); ROT();
        STEP(pA0, pA1, pB0, pB1, t + 1, true, true, true, false); AWAIT_STEADY(); RESC(); ROT();
    }
    for (; t + 1 < NT; t += 2) {
        STEP(pB0, pB1, pA0, pA1, t, (t + 3 < NT), (t + 1 < NT), (t + 1 < NT), true);       ENDW(t);     RESC(); ROT();
        STEP(pA0, pA1, pB0, pB1, t + 1, (t + 4 < NT), (t + 2 < NT), (t + 2 < NT), true);   ENDW(t + 1); RESC(); ROT();
    }
    STEP(pB0, pB1, pA0, pA1, NT - 1, false, false, false, true); RESC();
    { float sacc = pB0[0] + pB0[1];
      _Pragma("unroll") for (int r = 2; r < 16; ++r) sacc += pB0[r];
      _Pragma("unroll") for (int r = 0; r < 16; ++r) sacc += pB1[r];
      l_reg += sacc;
      pw0 = (u32x4){PKW(pB0, 0), PKW(pB0, 2), PKW(pB0, 4), PKW(pB0, 6)}; pw1 = (u32x4){PKW(pB0, 8), PKW(pB0, 10), PKW(pB0, 12), PKW(pB0, 14)};
      pw2 = (u32x4){PKW(pB1, 0), PKW(pB1, 2), PKW(pB1, 4), PKW(pB1, 6)}; pw3 = (u32x4){PKW(pB1, 8), PKW(pB1, 10), PKW(pB1, 12), PKW(pB1, 14)};
      ASBAR();
      const int vb = vb0 + sl_cur * VSLOT;
#pragma unroll
      for (int d0 = 0; d0 < 2; ++d0) { s16x4 lo[4], hh[4];
#pragma unroll
          for (int ks = 0; ks < 4; ++ks) {
              asm volatile("ds_read_b64_tr_b16 %0,%1 offset:%c2" : "=&v"(lo[ks]) : "v"(vb), "i"(d0 * 4096 + ks * 1024) : "memory");
              asm volatile("ds_read_b64_tr_b16 %0,%1 offset:%c2" : "=&v"(hh[ks]) : "v"(vb), "i"(d0 * 4096 + ks * 1024 + 512) : "memory"); }
          asm volatile("s_waitcnt lgkmcnt(0)" ::: "memory"); ASBAR();
#define PK(k) (bf16x8){lo[k][0], lo[k][1], lo[k][2], lo[k][3], hh[k][0], hh[k][1], hh[k][2], hh[k][3]}
          o[d0] = MFMA32(PAF(0), PK(0), o[d0]); o[d0] = MFMA32(PAF(1), PK(1), o[d0]); o[d0] = MFMA32(PAF(2), PK(2), o[d0]); o[d0] = MFMA32(PAF(3), PK(3), o[d0]);
#undef PK
      } }
    { auto rr = __builtin_amdgcn_permlane32_swap(__float_as_uint(l_reg), __float_as_uint(l_reg), false, false); l_reg = __uint_as_float(rr[0]) + __uint_as_float(rr[1]); }
    if (hi == 0) wsf[32 + r32] = l_reg; asm volatile("s_waitcnt lgkmcnt(0)" ::: "memory");
    int lane_e = lane; asm volatile("" : "+v"(lane_e)); const int hi_e = lane_e >> 5, r32_e = lane_e & 31;
    float rli[16];
    { const float* wl_ = wsf + 32 + 4 * hi_e;
#pragma unroll
      for (int r = 0; r < 16; ++r) rli[r] = __builtin_amdgcn_rcpf(wl_[(r & 3) + 8 * (r >> 2)]); }
    { bf16_t* stg = (bf16_t*)(shm + LDS_OST + wid * QWAVE);
      bf16_t* stl = stg + (4 * hi_e) * 64 + r32_e;
#pragma unroll
      for (int r = 0; r < 16; ++r) {
#pragma unroll
          for (int d0 = 0; d0 < 2; ++d0) stl[((r & 3) + 8 * (r >> 2)) * 64 + d0 * 32] = f2bf(o[d0][r] * rli[r]); }
      asm volatile("s_waitcnt lgkmcnt(0)" ::: "memory");
#pragma unroll
      for (int i = 0; i < 4; ++i) { const int row = i * 8 + (lane_e >> 3), ch = lane_e & 7; const u32x4 v = *(const u32x4*)(stg + row * 64 + ch * 8);
          bf16_t* dst = GQA4 ? (A.obase + (long)(8 * wid + (row >> 2)) * A.opitch + (row & 3) * 64) : (A.obase + (long)(32 * wid + row) * A.opitch);
          *(u32x4*)(dst + ch * 8) = v; } }
    asm volatile("s_waitcnt lgkmcnt(0)\n\ts_barrier" ::: "memory");
#undef TILE_OF
#undef DMA_K
#undef DMA_V
#undef CMASK
#undef CINIT
#undef START
#undef RESC
#undef ROT
#undef PKW
#undef PAF
#undef VFR
#undef PIN
#undef MX3
#undef GAPA
#undef GAPB
#undef EX
#undef VRD
#undef KRD
#undef MFMA32
#undef STEP
#undef STEP64
#undef STEP96
#undef VRD4
#undef VFR4
#undef GAPQ
#undef QL
#undef ENDW
#undef AWAIT_STEADY
}
}
constexpr int MK_THREADS = 512;
constexpr int LDS_RING = 131072;
constexpr int LDS_X = LDS_RING;
constexpr int LDS_MOD = LDS_RING + 8192;
constexpr int LDS_BARST = 155648 - 16;
constexpr int LDS_TOTAL = 155648;

#define C2Q 0.18033688011112042f
#define LOG2E 1.4426950408889634f

struct BlkDesc { bf16_t* dst; const float* gain; int pitch; int flags; float scale; int csoff; };
#define C2M 0.14724312203508865f
struct MKP {
    const float* in[34];
    float* out;
    float* modpart;
    float* mod;
    float* cosT; float* sinT;
    bf16_t* W_in0t;
    bf16_t* W_out0t;
    bf16_t* XN;
    bf16_t* OATT;
    bf16_t* QN;
    bf16_t* KV6;
    bf16_t* FQ; bf16_t* FK; bf16_t* FV;
    float* GATES;
    float* LOGF;
    BlkDesc* desc0;
    float* CUMB;
    BlkDesc* desc_uq;
    BlkDesc* desc_ukv;
    bf16_t* W_in1t;
    bf16_t* W_uqt;
    bf16_t* W_ukvt;
    bf16_t* W_out1t;
    bf16_t* P1;
    bf16_t* CQN;
    bf16_t* CKVN;
    bf16_t* Q96;
    bf16_t* K96;
    bf16_t* V1;
    bf16_t* WcT;
    float* CBIAS;
    bf16_t* KCMP;
    bf16_t* VCT;
    bf16_t* KSLF;
    bf16_t* VSLF;
    bf16_t* OCMP;
    bf16_t* OWIN;
    const int* pos;
    bf16_t* Wgu;
    bf16_t* Wd;
    bf16_t* HID;
    bf16_t* YBUF;
    int* gcnt;
    int* list;
    float* ew;
    unsigned* barw;
    int ph_lo, ph_hi, dbg_flags, pad_;
};

__device__ __forceinline__ int swap45(int p) { return (p & 15) | ((p & 16) << 1) | ((p & 32) >> 1); }

template <class Map>
__device__ __forceinline__ void tr_item(const float* __restrict__ W, int ldw, int K, bf16_t* WT, LAS float* scr, int kb, int nb, int lane, const Map& cmap, const float* kscale) {
    const int k0 = 64 * kb, n0 = 32 * nb;
    const int sc = cmap(n0 + (lane & 31));
    float v[32];
    const float* src = W + (size_t)(k0 + (lane >> 5)) * ldw + (sc >= 0 ? sc : 0);
#pragma unroll
    for (int i = 0; i < 32; ++i) v[i] = src[(size_t)(2 * i) * ldw];
    if (kscale) {
#pragma unroll
        for (int i = 0; i < 32; ++i) v[i] *= kscale[k0 + 2 * i + (lane >> 5)];
    }
#pragma unroll
    for (int i = 0; i < 32; ++i) scr[(2 * i + (lane >> 5)) * 33 + (lane & 31)] = (sc >= 0) ? v[i] : 0.f;
    asm volatile("s_waitcnt lgkmcnt(0)" ::: "memory");
    const int c = lane & 7;
#pragma unroll
    for (int j = 0; j < 4; ++j) {
        const int n = (lane >> 3) + 8 * j; const LAS float* s = scr + (8 * c) * 33 + n;
        u32x4 o; o.x = cvtpk(s[0 * 33], s[1 * 33]); o.y = cvtpk(s[2 * 33], s[3 * 33]); o.z = cvtpk(s[4 * 33], s[5 * 33]); o.w = cvtpk(s[6 * 33], s[7 * 33]);
        *(u32x4*)(WT + (size_t)(n0 + n) * K + k0 + 8 * c) = o;
    }
    asm volatile("s_waitcnt lgkmcnt(0)" ::: "memory");
}
struct MapIn0 {
    __device__ __forceinline__ int operator()(int nn) const {
        const int blk = nn >> 6, p = nn & 63;
        if (blk < 8) return blk * 64 + swap45(p);
        if (blk < 20) return 512 + (blk - 8) * 64 + swap45(p);
        if (blk < 44) return 1304 + (blk - 20) * 64 + swap45(p);
        if (blk == 44) { if (p < 24) return 1280 + p; if (p < 32) return 2840 + (p - 24); return -1; }
        return -1;
    }
};
struct MapId { __device__ __forceinline__ int operator()(int nn) const { return nn; } };
struct MapIn1 { __device__ __forceinline__ int operator()(int nn) const { return nn < 672 ? nn : -1; } };
struct MapUq { __device__ __forceinline__ int operator()(int nn) const { if (nn < 1024) return (nn >> 6) * 96 + swap45(nn & 63); const int r = nn - 1024; return (r >> 5) * 96 + 64 + (r & 31); } };
struct MapUkv { __device__ __forceinline__ int operator()(int nn) const { if (nn < 1024) return (nn >> 6) * 128 + swap45(nn & 63); const int r = nn - 1024; return (r >> 6) * 128 + 64 + swap45(r & 63); } };

namespace nsa {
using att::f32x16; using att::crow;
#define NMFMA32(a, b, c) __builtin_amdgcn_mfma_f32_32x32x16_bf16(a, b, c, 0, 0, 0)
#define NMFMA16(a, b, c) __builtin_amdgcn_mfma_f32_16x16x32_bf16(a, b, c, 0, 0, 0)
#define RLF(x, l) __uint_as_float(__builtin_amdgcn_readlane((int)__float_as_uint(x), (l)))

__device__ __forceinline__ void compress_job(const MKP& p, LAS float* scr, LAS float* part, int job, int slice, int lane) {
    const int nt = job & 31, g = (job >> 5) & 1, kv = job >> 6;
    const int r32 = lane & 31, hi = lane >> 5, n0 = nt * 32;
    const bf16_t* tok = p.KV6 + (size_t)(kv * 2 + g) * S_ * 64;
    const bf16_t* wt = p.WcT + (size_t)kv * 64 * 2048;
    scr[lane] = p.CBIAS[kv * 64 + lane];
    asm volatile("s_waitcnt lgkmcnt(0)" ::: "memory");
    int nrow = n0 + r32; if (nrow > 1022) nrow = 1022;
    const bf16_t* ta = tok + (size_t)(16 * nrow) * 64 + 8 * hi;
    const bf16_t* wa0 = wt + (size_t)r32 * 2048 + 8 * hi;
    const bf16_t* wa1 = wa0 + (size_t)32 * 2048;
    f32x16 c0 = f32x16{}, c1 = f32x16{};
    if (kv == 0) {
#pragma unroll 8
        for (int s = 32 * slice; s < 32 * slice + 32; ++s) {
            const bf16x8 tf = *(const bf16x8*)(ta + 16 * s), w0 = *(const bf16x8*)(wa0 + 16 * s), w1 = *(const bf16x8*)(wa1 + 16 * s);
            c0 = NMFMA32(w0, tf, c0); c1 = NMFMA32(w1, tf, c1);
        }
        if (slice) {
#pragma unroll
            for (int r = 0; r < 16; ++r) { part[r * 64 + lane] = c0[r]; part[(16 + r) * 64 + lane] = c1[r]; } }
        __syncthreads();
        if (slice) return;
#pragma unroll
        for (int q = 1; q < 4; ++q)
#pragma unroll
            for (int r = 0; r < 16; ++r) { c0[r] += part[q * 2048 + r * 64 + lane]; c1[r] += part[q * 2048 + (16 + r) * 64 + lane]; }
        float ss = 0.f;
#pragma unroll
        for (int r = 0; r < 16; ++r) { c0[r] += scr[crow(r, hi)]; c1[r] += scr[32 + crow(r, hi)]; ss += c0[r] * c0[r] + c1[r] * c1[r]; }
        { auto rr = __builtin_amdgcn_permlane32_swap(__float_as_uint(ss), __float_as_uint(ss), false, false); ss = __uint_as_float(rr[0]) + __uint_as_float(rr[1]); }
        const float rs = rsqrtf(ss * (1.f / 64.f) + EPSF);
        const float* gn = p.in[10];
        if (n0 + r32 < 1023) {
            bf16_t* dst = p.KCMP + ((size_t)g * 1024 + n0 + r32) * 64;
#pragma unroll
            for (int q = 0; q < 4; ++q) {
                const int e0 = 8 * q + 4 * hi;
                const f32x4 ga = *(const f32x4*)(gn + e0), gb = *(const f32x4*)(gn + 32 + e0);
                u32x2 wa, wb;
                wa.x = cvtpk(c0[4 * q] * rs * ga.x, c0[4 * q + 1] * rs * ga.y); wa.y = cvtpk(c0[4 * q + 2] * rs * ga.z, c0[4 * q + 3] * rs * ga.w);
                wb.x = cvtpk(c1[4 * q] * rs * gb.x, c1[4 * q + 1] * rs * gb.y); wb.y = cvtpk(c1[4 * q + 2] * rs * gb.z, c1[4 * q + 3] * rs * gb.w);
                *(u32x2*)(dst + e0) = wa; *(u32x2*)(dst + 32 + e0) = wb;
            }
        }
    } else {
#pragma unroll 8
        for (int s = 32 * slice; s < 32 * slice + 32; ++s) {
            const bf16x8 tf = *(const bf16x8*)(ta + 16 * s), w0 = *(const bf16x8*)(wa0 + 16 * s), w1 = *(const bf16x8*)(wa1 + 16 * s);
            c0 = NMFMA32(tf, w0, c0); c1 = NMFMA32(tf, w1, c1);
        }
        if (slice) {
#pragma unroll
            for (int r = 0; r < 16; ++r) { part[r * 64 + lane] = c0[r]; part[(16 + r) * 64 + lane] = c1[r]; } }
        __syncthreads();
        if (slice) return;
#pragma unroll
        for (int q = 1; q < 4; ++q)
#pragma unroll
            for (int r = 0; r < 16; ++r) { c0[r] += part[q * 2048 + r * 64 + lane]; c1[r] += part[q * 2048 + (16 + r) * 64 + lane]; }
        const float b0 = scr[r32], b1 = scr[32 + r32];
#pragma unroll
        for (int G = 0; G < 2; ++G) {
            u32x4 va, vb;
            va.x = cvtpk(c0[8 * G] + b0, c0[8 * G + 1] + b0); va.y = cvtpk(c0[8 * G + 2] + b0, c0[8 * G + 3] + b0); va.z = cvtpk(c0[8 * G + 4] + b0, c0[8 * G + 5] + b0); va.w = cvtpk(c0[8 * G + 6] + b0, c0[8 * G + 7] + b0);
            vb.x = cvtpk(c1[8 * G] + b1, c1[8 * G + 1] + b1); vb.y = cvtpk(c1[8 * G + 2] + b1, c1[8 * G + 3] + b1); vb.z = cvtpk(c1[8 * G + 4] + b1, c1[8 * G + 5] + b1); vb.w = cvtpk(c1[8 * G + 6] + b1, c1[8 * G + 7] + b1);
            *(u32x4*)(p.VCT + ((size_t)g * 64 + r32) * 1024 + n0 + 16 * G + 8 * hi) = va;
            *(u32x4*)(p.VCT + ((size_t)g * 64 + 32 + r32) * 1024 + n0 + 16 * G + 8 * hi) = vb;
        }
    }
    asm volatile("s_waitcnt lgkmcnt(0)" ::: "memory");
}

__device__ __forceinline__ unsigned pk4_fp8(float a, float b, float c, float d) { int w = __builtin_amdgcn_cvt_pk_fp8_f32(a, b, 0, false); w = __builtin_amdgcn_cvt_pk_fp8_f32(c, d, w, true); return (unsigned)w; }
__device__ __forceinline__ void slcfrag_job(const MKP& p, int job, int lane) {
    const int g = job >> 8, blk = job & 255, c16 = lane & 15, u = lane >> 4;
    const bf16_t* k = p.KV6 + (size_t)(2 * 2 + g) * S_ * 64 + (size_t)blk * 64 * 64;
    const bf16_t* v = p.KV6 + (size_t)(3 * 2 + g) * S_ * 64 + (size_t)blk * 64 * 64;
    unsigned char* kd = (unsigned char*)p.KSLF + ((size_t)g * 256 + blk) * 4096 + lane * 16;
    unsigned char* vd = (unsigned char*)p.VSLF + ((size_t)g * 256 + blk) * 4096 + lane * 16;
#pragma unroll
    for (int kg = 0; kg < 4; ++kg) {
        const u32x4 a = *(const u32x4*)(k + (size_t)(16 * kg + c16) * 64 + 8 * u), b = *(const u32x4*)(k + (size_t)(16 * kg + c16) * 64 + 32 + 8 * u);
        u32x4 o;
        o.x = pk4_fp8(__uint_as_float(a.x << 16), __uint_as_float(a.x & 0xffff0000u), __uint_as_float(a.y << 16), __uint_as_float(a.y & 0xffff0000u));
        o.y = pk4_fp8(__uint_as_float(a.z << 16), __uint_as_float(a.z & 0xffff0000u), __uint_as_float(a.w << 16), __uint_as_float(a.w & 0xffff0000u));
        o.z = pk4_fp8(__uint_as_float(b.x << 16), __uint_as_float(b.x & 0xffff0000u), __uint_as_float(b.y << 16), __uint_as_float(b.y & 0xffff0000u));
        o.w = pk4_fp8(__uint_as_float(b.z << 16), __uint_as_float(b.z & 0xffff0000u), __uint_as_float(b.w << 16), __uint_as_float(b.w & 0xffff0000u));
        *(u32x4*)(kd + kg * 1024) = o;
    }
#pragma unroll
    for (int dg = 0; dg < 4; ++dg) {
        float x[16];
#pragma unroll
        for (int ch = 0; ch < 2; ++ch)
#pragma unroll
            for (int j = 0; j < 8; ++j) { const int key = 32 * ch + ((j < 4) ? 4 * u + j : 16 + 4 * u + (j - 4)); x[ch * 8 + j] = bf2f(v[(size_t)key * 64 + 16 * dg + c16]); }
        u32x4 o; o.x = pk4_fp8(x[0], x[1], x[2], x[3]); o.y = pk4_fp8(x[4], x[5], x[6], x[7]); o.z = pk4_fp8(x[8], x[9], x[10], x[11]); o.w = pk4_fp8(x[12], x[13], x[14], x[15]);
        *(u32x4*)(vd + dg * 1024) = o;
    }
}

constexpr int IMP_LD = 272;
__device__ __forceinline__ void cmp_wave(const MKP& p, int g, int t0w, LAS float* imp, LAS unsigned char* stg, int lane) {
    const int r32 = lane & 31, hi = lane >> 5;
    const int tq = t0w + (r32 >> 2), head = g * 4 + (r32 & 3);
    const int nmax = (tq >= 31) ? ((tq - 31) >> 4) : -1;
    const int nmaxw = (t0w + 7 >= 31) ? ((t0w + 7 - 31) >> 4) : -1;
    const int ntile = (nmaxw >> 6) + 1;
    for (int i = lane; i < 8 * IMP_LD; i += 64) imp[i] = 0.f;
    bf16x8 qr[4];
#pragma unroll
    for (int d0 = 0; d0 < 4; ++d0) qr[d0] = *(const bf16x8*)(p.QN + (size_t)tq * 512 + head * 64 + d0 * 16 + hi * 8);
    const bf16_t* kc = p.KCMP + (size_t)g * 1024 * 64 + (size_t)r32 * 64 + 8 * hi;
    bf16x8 ovf[4];
#pragma unroll
    for (int ks = 0; ks < 4; ++ks)
#pragma unroll
        for (int j = 0; j < 8; ++j) {
            const int nrel = 16 * ks + ((j < 4) ? 4 * hi + j : 8 + 4 * hi + (j - 4));
            const int dlt = nrel - 4 * r32;
            const float w = (dlt >= 0 && dlt <= 2) ? 2.f : ((dlt == 3 || dlt == -1) ? 1.f : 0.f);
            ovf[ks][j] = (short)f2bf(w);
        }
#define CKLOAD(dst, c_) do { const bf16_t* kt_ = kc + (size_t)(c_) * 64 * 64; _Pragma("unroll") for (int d0_ = 0; d0_ < 4; ++d0_) { dst[2 * d0_] = *(const bf16x8*)(kt_ + 16 * d0_); dst[2 * d0_ + 1] = *(const bf16x8*)(kt_ + 32 * 64 + 16 * d0_); } } while (0)
#define CQK(s0, s1, kf) do { s0 = f32x16{}; s1 = f32x16{}; _Pragma("unroll") for (int d0_ = 0; d0_ < 4; ++d0_) { s0 = NMFMA32(kf[2 * d0_], qr[d0_], s0); s1 = NMFMA32(kf[2 * d0_ + 1], qr[d0_], s1); } } while (0)
    float m = -INFINITY, l = 0.f;
    bf16x8 kfa[8], kfb[8];
    if (ntile > 0) CKLOAD(kfa, 0);
#define CMP_P1(KC, KN, c) do { { const int cn_ = ((c) + 1 < ntile) ? (c) + 1 : ntile - 1; CKLOAD(KN, cn_); } \
        f32x16 s0, s1; CQK(s0, s1, KC); \
        const int x = nmax - 64 * (c) - 4 * hi; float tm = -INFINITY; \
        _Pragma("unroll") for (int r = 0; r < 16; ++r) { const int cc = (r & 3) + 8 * (r >> 2); if (cc > x) s0[r] = -INFINITY; if (cc + 32 > x) s1[r] = -INFINITY; tm = fmaxf(tm, fmaxf(s0[r], s1[r])); } \
        if (tm > m) { l *= __builtin_amdgcn_exp2f(m - tm); m = tm; } \
        if (m > -INFINITY) { float sum = 0.f; _Pragma("unroll") for (int r = 0; r < 16; ++r) sum += __builtin_amdgcn_exp2f(s0[r] - m) + __builtin_amdgcn_exp2f(s1[r] - m); l += sum; } } while (0)
#pragma unroll 1
    for (int c = 0; c < ntile; c += 2) { CMP_P1(kfa, kfb, c); if (c + 1 < ntile) CMP_P1(kfb, kfa, c + 1); }
    { auto rm = __builtin_amdgcn_permlane32_swap(__float_as_uint(m), __float_as_uint(m), false, false);
      auto rl = __builtin_amdgcn_permlane32_swap(__float_as_uint(l), __float_as_uint(l), false, false);
      const float ma = __uint_as_float(rm[0]), mb = __uint_as_float(rm[1]), la = __uint_as_float(rl[0]), lb = __uint_as_float(rl[1]);
      const float mm = fmaxf(ma, mb);
      if (mm > -INFINITY) { l = ((ma > -INFINITY) ? la * __builtin_amdgcn_exp2f(ma - mm) : 0.f) + ((mb > -INFINITY) ? lb * __builtin_amdgcn_exp2f(mb - mm) : 0.f); m = mm; }
      else { l = 0.f; m = 0.f; } }
    const float invl = (l > 0.f) ? 1.f / l : 0.f;
    f32x16 o0 = f32x16{}, o1 = f32x16{};
    const bf16_t* vc = p.VCT + (size_t)g * 64 * 1024 + (size_t)r32 * 1024 + 8 * hi;
    if (ntile > 0) CKLOAD(kfa, 0);
    bf16x8 vfr[8];
#define CMP_P2(KC, KN, c) do { \
        { const bf16_t* vt_ = vc + (c) * 64; _Pragma("unroll") for (int ks_ = 0; ks_ < 4; ++ks_) { vfr[2 * ks_] = *(const bf16x8*)(vt_ + 16 * ks_); vfr[2 * ks_ + 1] = *(const bf16x8*)(vt_ + 32 * 1024 + 16 * ks_); } } \
        { const int cn_ = ((c) + 1 < ntile) ? (c) + 1 : ntile - 1; CKLOAD(KN, cn_); } \
        f32x16 s0, s1; CQK(s0, s1, KC); \
        const int x = nmax - 64 * (c) - 4 * hi; \
        _Pragma("unroll") for (int r = 0; r < 16; ++r) { const int cc = (r & 3) + 8 * (r >> 2); \
            s0[r] = (cc > x) ? 0.f : __builtin_amdgcn_exp2f(s0[r] - m) * invl; s1[r] = (cc + 32 > x) ? 0.f : __builtin_amdgcn_exp2f(s1[r] - m) * invl; } \
        u32x4 pw[4]; \
        pw[0] = (u32x4){cvtpk(s0[0], s0[1]), cvtpk(s0[2], s0[3]), cvtpk(s0[4], s0[5]), cvtpk(s0[6], s0[7])}; \
        pw[1] = (u32x4){cvtpk(s0[8], s0[9]), cvtpk(s0[10], s0[11]), cvtpk(s0[12], s0[13]), cvtpk(s0[14], s0[15])}; \
        pw[2] = (u32x4){cvtpk(s1[0], s1[1]), cvtpk(s1[2], s1[3]), cvtpk(s1[4], s1[5]), cvtpk(s1[6], s1[7])}; \
        pw[3] = (u32x4){cvtpk(s1[8], s1[9]), cvtpk(s1[10], s1[11]), cvtpk(s1[12], s1[13]), cvtpk(s1[14], s1[15])}; \
        f32x16 im = f32x16{}; \
        _Pragma("unroll") for (int ks = 0; ks < 4; ++ks) { const bf16x8 pa = __builtin_bit_cast(bf16x8, pw[ks]); \
            o0 = NMFMA32(pa, vfr[2 * ks], o0); o1 = NMFMA32(pa, vfr[2 * ks + 1], o1); im = NMFMA32(pa, ovf[ks], im); } \
        if (r32 <= 16 && 16 * (c) + r32 < 256) { \
            _Pragma("unroll") for (int k = 0; k < 4; ++k) { const float v = (im[4 * k] + im[4 * k + 1]) + (im[4 * k + 2] + im[4 * k + 3]); atomicAdd((float*)(imp + (2 * k + hi) * IMP_LD + 16 * (c) + r32), v); } } } while (0)
#pragma unroll 1
    for (int c = 0; c < ntile; c += 2) { CMP_P2(kfa, kfb, c); if (c + 1 < ntile) CMP_P2(kfb, kfa, c + 1); }
#undef CMP_P1
#undef CMP_P2
#undef CKLOAD
#undef CQK
    { bf16_t* st = (bf16_t*)stg; bf16_t* stl = st + (4 * hi) * 64 + r32;
#pragma unroll
      for (int r = 0; r < 16; ++r) { stl[((r & 3) + 8 * (r >> 2)) * 64] = f2bf(o0[r]); stl[((r & 3) + 8 * (r >> 2)) * 64 + 32] = f2bf(o1[r]); }
      asm volatile("s_waitcnt lgkmcnt(0)" ::: "memory");
#pragma unroll
      for (int i = 0; i < 4; ++i) { const int row = i * 8 + (lane >> 3), ch = lane & 7; const u32x4 v = *(const u32x4*)(st + row * 64 + ch * 8);
          *(u32x4*)(p.OCMP + (size_t)(t0w + (row >> 2)) * 512 + (g * 4 + (row & 3)) * 64 + ch * 8) = v; }
      asm volatile("s_waitcnt lgkmcnt(0)" ::: "memory"); }
}

__device__ __forceinline__ float dpp_f(float v, int ctrl_sel) {
    const int x = __float_as_int(v);
    int r;
    if (ctrl_sel == 0) r = __builtin_amdgcn_update_dpp(x, x, 0xB1, 0xF, 0xF, false);
    else if (ctrl_sel == 1) r = __builtin_amdgcn_update_dpp(x, x, 0x4E, 0xF, 0xF, false);
    else if (ctrl_sel == 2) r = __builtin_amdgcn_update_dpp(x, x, 0x124, 0xF, 0xF, false);
    else r = __builtin_amdgcn_update_dpp(x, x, 0x128, 0xF, 0xF, false);
    return __int_as_float(r);
}
__device__ __forceinline__ int dpp_i(int x, int ctrl_sel) {
    if (ctrl_sel == 0) return __builtin_amdgcn_update_dpp(x, x, 0xB1, 0xF, 0xF, false);
    if (ctrl_sel == 1) return __builtin_amdgcn_update_dpp(x, x, 0x4E, 0xF, 0xF, false);
    if (ctrl_sel == 2) return __builtin_amdgcn_update_dpp(x, x, 0x124, 0xF, 0xF, false);
    return __builtin_amdgcn_update_dpp(x, x, 0x128, 0xF, 0xF, false);
}
__device__ __forceinline__ void select_wave(int t0w, const LAS float* imp, LAS int* sel, int lane) {
    const int sub = lane & 31;
#pragma unroll 1
    for (int h = 0; h < 4; ++h) {
        const int tk = 2 * h + (lane >> 5);
        const int tq = t0w + tk, cur = tq >> 6;
        float v[8];
#pragma unroll
        for (int i = 0; i < 8; ++i) { const int j = sub + 32 * i; float x = imp[tk * IMP_LD + j]; if (j == 0 || j == cur || j == cur - 1) x += 1e6f; v[i] = (j <= cur) ? x : -INFINITY; }
#pragma unroll 1
        for (int it = 0; it < 16; ++it) {
            float bv = v[0]; int bi = 0;
#pragma unroll
            for (int i = 1; i < 8; ++i) if (v[i] > bv) { bv = v[i]; bi = i; }
            float gm = bv;
#pragma unroll
            for (int c = 0; c < 4; ++c) gm = fmaxf(gm, dpp_f(gm, c));
            gm = fmaxf(gm, __shfl_xor(gm, 16));
            int cj = (bv == gm) ? sub + 32 * bi : 0x7fffffff;
#pragma unroll
            for (int c = 0; c < 4; ++c) cj = min(cj, dpp_i(cj, c));
            cj = min(cj, __shfl_xor(cj, 16));
            const bool any = gm > -INFINITY;
            if (sub == 0) sel[tk * 16 + it] = any ? cj : -1;
            if (any && (cj & 31) == sub) { const int wi = cj >> 5;
#pragma unroll
                for (int i = 0; i < 8; ++i) if (i == wi) v[i] = -INFINITY; }
        }
    }
    asm volatile("s_waitcnt lgkmcnt(0)" ::: "memory");
}

__device__ __forceinline__ void slc_wave(const MKP& p, int g, int t0w, const LAS int* sel, LAS float* oslc, int lane) {
    const int c16 = lane & 15, u = lane >> 4, ti = c16 >> 2;
    const unsigned char* kb = (const unsigned char*)p.KSLF + (size_t)g * 256 * 4096 + lane * 16;
    const unsigned char* vb = (const unsigned char*)p.VSLF + (size_t)g * 256 * 4096 + lane * 16;
#define LO64(vv_) ((long)(((unsigned long long)(vv_).y << 32) | (vv_).x))
#define HI64(vv_) ((long)(((unsigned long long)(vv_)[3] << 32) | (vv_).z))
#define FMFMA(a, b, c) __builtin_amdgcn_mfma_f32_16x16x32_fp8_fp8(a, b, c, 0, 0, 0)
#define KLOAD4(r_) do { _Pragma("unroll") for (int i_ = 0; i_ < 4; ++i_) { int b_ = sel[(tg * 4 + i_) * 16 + (r_)]; b_ = b_ < 0 ? 0 : b_; const unsigned char* kp_ = kb + (size_t)b_ * 4096; \
        _Pragma("unroll") for (int f_ = 0; f_ < 4; ++f_) kc[i_][f_] = *(const u32x4*)(kp_ + f_ * 1024); } } while (0)
#pragma unroll 1
    for (int tg = 0; tg < 2; ++tg) {
        const int tq = t0w + tg * 4 + ti;
        long qa, qb2;
        { const bf16_t* qp = p.QN + (size_t)tq * 512 + (g * 4 + (c16 & 3)) * 64 + 8 * u;
          const u32x4 r0 = *(const u32x4*)qp, r1 = *(const u32x4*)(qp + 32);
          const unsigned a0 = pk4_fp8(8.f * __uint_as_float(r0.x << 16), 8.f * __uint_as_float(r0.x & 0xffff0000u), 8.f * __uint_as_float(r0.y << 16), 8.f * __uint_as_float(r0.y & 0xffff0000u));
          const unsigned a1 = pk4_fp8(8.f * __uint_as_float(r0.z << 16), 8.f * __uint_as_float(r0.z & 0xffff0000u), 8.f * __uint_as_float(r0.w << 16), 8.f * __uint_as_float(r0.w & 0xffff0000u));
          const unsigned b0 = pk4_fp8(8.f * __uint_as_float(r1.x << 16), 8.f * __uint_as_float(r1.x & 0xffff0000u), 8.f * __uint_as_float(r1.y << 16), 8.f * __uint_as_float(r1.y & 0xffff0000u));
          const unsigned b1 = pk4_fp8(8.f * __uint_as_float(r1.z << 16), 8.f * __uint_as_float(r1.z & 0xffff0000u), 8.f * __uint_as_float(r1.w << 16), 8.f * __uint_as_float(r1.w & 0xffff0000u));
          qa = (long)(((unsigned long long)a1 << 32) | a0); qb2 = (long)(((unsigned long long)b1 << 32) | b0); }
        long q0[4], q1[4];
#pragma unroll
        for (int i = 0; i < 4; ++i) { q0[i] = (ti == i) ? qa : 0; q1[i] = (ti == i) ? qb2 : 0; }
        u32x4 kc[4][4], vf[4][4];
        KLOAD4(0);
        float m = -INFINITY, l = 0.f;
        f32x4 o[4]; o[0] = o[1] = o[2] = o[3] = (f32x4){0.f, 0.f, 0.f, 0.f};
#pragma unroll 1
        for (int r = 0; r < 16; ++r) {
#pragma unroll
            for (int i = 0; i < 4; ++i) { int b_ = sel[(tg * 4 + i) * 16 + r]; b_ = b_ < 0 ? 0 : b_; const unsigned char* vp = vb + (size_t)b_ * 4096;
#pragma unroll
                for (int dg = 0; dg < 4; ++dg) vf[i][dg] = *(const u32x4*)(vp + dg * 1024); }
            f32x4 s[4];
#pragma unroll
            for (int kg = 0; kg < 4; ++kg) { f32x4 c = (f32x4){0.f, 0.f, 0.f, 0.f};
#pragma unroll
                for (int i = 0; i < 4; ++i) { c = FMFMA(LO64(kc[i][kg]), q0[i], c); c = FMFMA(HI64(kc[i][kg]), q1[i], c); }
                s[kg] = c * 0.125f; }
            { const int rn = (r < 15) ? r + 1 : 15; KLOAD4(rn); }
            const int myblk = sel[(tg * 4 + ti) * 16 + r];
            { const int x = (myblk < 0) ? -1 : ((myblk == (tq >> 6)) ? tq - 64 * myblk - 4 * u : 64);
#pragma unroll
              for (int kg = 0; kg < 4; ++kg) { if (16 * kg > x) s[kg].x = -INFINITY; if (16 * kg + 1 > x) s[kg].y = -INFINITY; if (16 * kg + 2 > x) s[kg].z = -INFINITY; if (16 * kg + 3 > x) s[kg].w = -INFINITY; } }
            float tm = -INFINITY;
#pragma unroll
            for (int kg = 0; kg < 4; ++kg) tm = fmaxf(tm, fmaxf(fmaxf(s[kg].x, s[kg].y), fmaxf(s[kg].z, s[kg].w)));
            tm = fmaxf(tm, __shfl_xor(tm, 16)); tm = fmaxf(tm, __shfl_xor(tm, 32));
            float alpha = 1.f;
            if (tm > m) { alpha = __builtin_amdgcn_exp2f(m - tm); m = tm; }
            l *= alpha;
            float sum = 0.f;
#pragma unroll
            for (int kg = 0; kg < 4; ++kg) { s[kg].x = __builtin_amdgcn_exp2f(s[kg].x - m); s[kg].y = __builtin_amdgcn_exp2f(s[kg].y - m); s[kg].z = __builtin_amdgcn_exp2f(s[kg].z - m); s[kg].w = __builtin_amdgcn_exp2f(s[kg].w - m);
                sum += (s[kg].x + s[kg].y) + (s[kg].z + s[kg].w); }
            l += sum;
            { const float a0 = __shfl(alpha, 4 * u), a1 = __shfl(alpha, 4 * u + 1), a2 = __shfl(alpha, 4 * u + 2), a3 = __shfl(alpha, 4 * u + 3);
#pragma unroll
              for (int dg = 0; dg < 4; ++dg) { o[dg].x *= a0; o[dg].y *= a1; o[dg].z *= a2; o[dg].w *= a3; } }
#pragma unroll
            for (int ch = 0; ch < 2; ++ch) {
                const f32x4 pa_ = s[2 * ch] * 128.f, pb_ = s[2 * ch + 1] * 128.f;
                const unsigned lo_ = pk4_fp8(pa_.x, pa_.y, pa_.z, pa_.w), hi_ = pk4_fp8(pb_.x, pb_.y, pb_.z, pb_.w);
                const long pa = (long)(((unsigned long long)hi_ << 32) | lo_);
#pragma unroll
                for (int i = 0; i < 4; ++i) { const long pi = (ti == i) ? pa : 0;
#pragma unroll
                    for (int dg = 0; dg < 4; ++dg) o[dg] = FMFMA(pi, ch ? HI64(vf[i][dg]) : LO64(vf[i][dg]), o[dg]); }
            }
        }
        { float lt = l; lt += __shfl_xor(lt, 16); lt += __shfl_xor(lt, 32);
          const float il = (lt > 0.f) ? (1.f / 128.f) / lt : 0.f;
          const float i0 = __shfl(il, 4 * u), i1 = __shfl(il, 4 * u + 1), i2 = __shfl(il, 4 * u + 2), i3 = __shfl(il, 4 * u + 3);
          LAS float* op = oslc + (tg * 4 + u) * 256 + c16;
#pragma unroll
          for (int dg = 0; dg < 4; ++dg) { op[16 * dg] = o[dg].x * i0; op[64 + 16 * dg] = o[dg].y * i1; op[128 + 16 * dg] = o[dg].z * i2; op[192 + 16 * dg] = o[dg].w * i3; } }
    }
#undef KLOAD4
#undef LO64
#undef HI64
#undef FMFMA
    asm volatile("s_waitcnt lgkmcnt(0)" ::: "memory");
    {
        const int tkl = lane >> 3, cc = (lane & 7) * 32, hh = cc >> 6;
        const int tq = t0w + tkl;
        const float* gt = p.GATES + (size_t)tq * 24 + (g * 4 + hh) * 3;
        const float gc = 1.f / (1.f + __expf(-gt[0])), gs = 1.f / (1.f + __expf(-gt[1])), gw = 1.f / (1.f + __expf(-gt[2]));
        const size_t col = (size_t)tq * 512 + g * 256 + cc;
        const LAS float* os = oslc + tkl * 256 + cc;
#pragma unroll
        for (int q = 0; q < 4; ++q) {
            const u32x4 wc = *(const u32x4*)(p.OCMP + col + 8 * q), ww = *(const u32x4*)(p.OWIN + col + 8 * q);
            const f32x4 sa = *(const LAS f32x4*)(os + 8 * q), sb = *(const LAS f32x4*)(os + 8 * q + 4);
            u32x4 r;
            r.x = cvtpk(gs * sa.x + gc * __uint_as_float(wc.x << 16) + gw * __uint_as_float(ww.x << 16), gs * sa.y + gc * __uint_as_float(wc.x & 0xffff0000u) + gw * __uint_as_float(ww.x & 0xffff0000u));
            r.y = cvtpk(gs * sa.z + gc * __uint_as_float(wc.y << 16) + gw * __uint_as_float(ww.y << 16), gs * sa.w + gc * __uint_as_float(wc.y & 0xffff0000u) + gw * __uint_as_float(ww.y & 0xffff0000u));
            r.z = cvtpk(gs * sb.x + gc * __uint_as_float(wc.z << 16) + gw * __uint_as_float(ww.z << 16), gs * sb.y + gc * __uint_as_float(wc.z & 0xffff0000u) + gw * __uint_as_float(ww.z & 0xffff0000u));
            r.w = cvtpk(gs * sb.z + gc * __uint_as_float(wc.w << 16) + gw * __uint_as_float(ww.w << 16), gs * sb.w + gc * __uint_as_float(wc.w & 0xffff0000u) + gw * __uint_as_float(ww.w & 0xffff0000u));
            *(u32x4*)(p.OATT + (size_t)tq * 1024 + g * 256 + cc + 8 * q) = r;
        }
    }
}

__device__ __forceinline__ void nsa_unit(const MKP& p, char* shm, int g, int tile) {
    int tid_ = threadIdx.x; asm volatile("" : "+v"(tid_));
    const int tid = tid_, lane = tid & 63, r32 = lane & 31; const int wid = __builtin_amdgcn_readfirstlane(tid >> 6);
    const int t0 = tile * 64;
    {   att::UnitArgs A;
        A.qrow = p.QN + (size_t)(t0 + 8 * wid + (r32 >> 2)) * 512 + (g * 4 + (r32 & 3)) * 64;
        A.K = p.KV6 + (size_t)(4 * 2 + g) * S_ * 64; A.V = p.KV6 + (size_t)(5 * 2 + g) * S_ * 64; A.kvpitch = 64; A.vpitch = 64;
        A.obase = p.OWIN + (size_t)t0 * 512 + g * 256; A.opitch = 512;
        A.qtok = 8 * wid + (r32 >> 2); A.abase = tile;
        const int real = (tile + 1 < 9) ? tile + 1 : 9; int nt = (real + 1) & ~1; if (nt < 4) nt = 4;
        A.nsteps = nt; A.bias = nullptr;
        att::attn_unit<att::MODE_WIN, true, 8, 64>(A, shm);
    }
    LAS unsigned char* l3 = (LAS unsigned char*)shm;
    LAS float* imp = (LAS float*)(l3 + wid * (8 * IMP_LD * 4));
    LAS int* sel = (LAS int*)(l3 + 8 * (8 * IMP_LD * 4) + wid * 512);
    LAS unsigned char* stg = l3 + 8 * (8 * IMP_LD * 4) + 8 * 512 + wid * 4096;
    const int t0w = t0 + 8 * wid;
    { int ln = lane; asm volatile("" : "+v"(ln)); cmp_wave(p, g, t0w, imp, stg, ln); }
    asm volatile("s_waitcnt vmcnt(0) lgkmcnt(0)" ::: "memory");
    { int ln = lane; asm volatile("" : "+v"(ln)); select_wave(t0w, imp, sel, ln); }
    { int ln = lane; asm volatile("" : "+v"(ln)); slc_wave(p, g, t0w, sel, imp, ln); }
    asm volatile("s_waitcnt vmcnt(0) lgkmcnt(0)\n\ts_barrier" ::: "memory");
}
#undef NMFMA32
#undef NMFMA16
#undef RLF
}

__device__ __forceinline__ void phase_prologue(const MKP& p, LAS unsigned char* lds) {
    const int tid = threadIdx.x, lane = tid & 63, wave = tid >> 6;
    const int gw = blockIdx.x * 8 + wave, NGW = gridDim.x * 8;
    LAS float* scr = (LAS float*)(lds + wave * 16384);
    for (int it = gw; it < 8 * 192; it += NGW) {
        const int kc = it / 192, ch = it % 192, idx = ch * 64 + lane, l = idx / 6144, n = idx % 6144;
        const float* w = p.in[5] + (size_t)l * 1024 * 6144 + n;
        const float* c = p.in[1];
        float acc = 0.f;
#pragma unroll 8
        for (int k = kc * 128; k < kc * 128 + 128; ++k) { const float cv = c[k]; acc += (cv / (1.f + __expf(-cv))) * w[(size_t)k * 6144]; }
        p.modpart[kc * 12288 + idx] = acc;
    }
    if (blockIdx.x == 1 && tid < 128) p.gcnt[tid] = 0;
    if (blockIdx.x == 0 && tid < 96 + 48 + 64) {
        BlkDesc d; d.dst = nullptr; d.gain = nullptr; d.pitch = 0; d.flags = 4; d.scale = 1.f; d.csoff = 0;
        if (tid < 96) {
            const int blk = (tid >> 3) * 4 + ((tid >> 2) & 1) * 2 + ((tid >> 1) & 1);
            d.flags = 0;
            if (blk < 8) { d.dst = p.QN + blk * 64; d.pitch = 512; d.gain = p.in[9]; d.flags = 1; d.scale = C2Q; }
            else if (blk < 20) { const int j = (blk - 8) >> 1, g = (blk - 8) & 1; d.dst = p.KV6 + (size_t)(j * 2 + g) * S_ * 64; d.pitch = 64;
                d.gain = (j == 2 || j == 4) ? p.in[10] : nullptr; d.flags = (j == 0 || j == 2 || j == 4) ? 1 : 0; }
            else if (blk < 28) { d.dst = p.FQ + (blk - 20) * 64; d.pitch = 512; d.gain = p.in[13]; d.scale = C2Q; }
            else if (blk < 36) { d.dst = p.FK + (blk - 28) * 64; d.pitch = 512; d.gain = p.in[14]; }
            else if (blk < 44) { d.dst = p.FV + (blk - 36) * 64; d.pitch = 512; }
            else if (blk == 44) d.flags = 2;
            else d.flags = 4;
            p.desc0[tid] = d;
        } else if (tid < 96 + 48) {
            const int e = tid - 96, pn = e >> 3, bj = (e >> 2) & 1, wc = e & 3;
            if (pn < 4) { const int h = pn * 4 + bj * 2 + (wc >> 1); d.dst = p.Q96 + (size_t)h * S_ * 96; d.pitch = 96; d.gain = p.in[21]; d.flags = 0; d.scale = C2M; }
            else { const int h = (pn - 4) * 8 + bj * 4 + wc; d.dst = p.Q96 + (size_t)h * S_ * 96 + 64; d.pitch = 96; d.gain = p.in[23]; d.flags = 1 | 8; d.scale = C2M; d.csoff = 32; }
            p.desc_uq[e] = d;
        } else {
            const int e = tid - 144, pn = e >> 3, bj = (e >> 2) & 1, wc = e & 3;
            const int h = (pn & 3) * 4 + bj * 2 + (wc >> 1);
            if (pn < 4) { d.dst = p.K96 + (size_t)h * S_ * 96; d.pitch = 96; d.gain = p.in[22]; d.flags = 0; }
            else { d.dst = p.V1 + (size_t)h * S_ * 64; d.pitch = 64; d.gain = nullptr; d.flags = 0; }
            p.desc_ukv[e] = d;
        }
    }
    if (blockIdx.x == 2 || blockIdx.x == 3) {
        const int kv = blockIdx.x - 2, e = tid & 63, sl = tid >> 6;
        const float* w = p.in[12] + (size_t)kv * 2048 * 64 + e; const float* pe = p.in[11] + kv * 2048;
        float b = 0.f;
#pragma unroll 8
        for (int k = sl * 256; k < sl * 256 + 256; ++k) b += pe[k] * w[(size_t)k * 64];
        LAS float* red = (LAS float*)(lds + 140000);
        red[tid] = b;
        __syncthreads();
        if (tid < 64) { float a = 0.f;
#pragma unroll
            for (int q = 0; q < 8; ++q) a += red[q * 64 + tid];
            p.CBIAS[kv * 64 + tid] = a; }
    }
    for (int idx = blockIdx.x * MK_THREADS + tid; idx < S_ * 48; idx += gridDim.x * MK_THREADS) {
        const int t = idx / 48, i = idx % 48;
        const double ex = (i < 32) ? (double)(2 * i) / 64.0 : (double)(2 * (i - 32)) / 32.0;
        const double a = (double)p.pos[t] * exp(-ex * 9.210340371976184);
        const double r = a - rint(a * 0.15915494309189535) * 6.283185307179586;
        const float rf = (float)r;
        p.cosT[idx] = cosf(rf); p.sinT[idx] = sinf(rf);
    }
    for (int it = gw; it < 2 * 32 * 2; it += NGW) { const int kv = it >> 6, r = it & 63; tr_item(p.in[12] + (size_t)kv * 2048 * 64, 64, 2048, p.WcT + (size_t)kv * 64 * 2048, scr, r >> 1, r & 1, lane, MapId(), nullptr); }
    constexpr int I_IN0 = 16 * 96, I_OUT0 = 16 * 32, I_IN1 = 16 * 24, I_UQ = 6 * 48, I_UKV = 4 * 64, I_OUT1 = 16 * 32;
    for (int it = gw; it < I_IN0 + I_OUT0 + I_IN1 + I_UQ + I_UKV + I_OUT1; it += NGW) {
        int r = it;
        if (r < I_IN0) { tr_item(p.in[7], HYIN, 1024, p.W_in0t, scr, r / 96, r % 96, lane, MapIn0(), nullptr); continue; } r -= I_IN0;
        if (r < I_OUT0) { tr_item(p.in[15], 1024, 1024, p.W_out0t, scr, r / 32, r % 32, lane, MapId(), nullptr); continue; } r -= I_OUT0;
        if (r < I_IN1) { tr_item(p.in[16], 672, 1024, p.W_in1t, scr, r / 24, r % 24, lane, MapIn1(), nullptr); continue; } r -= I_IN1;
        if (r < I_UQ) { tr_item(p.in[19], 1536, 384, p.W_uqt, scr, r / 48, r % 48, lane, MapUq(), p.in[17]); continue; } r -= I_UQ;
        if (r < I_UKV) { tr_item(p.in[20], 2048, 256, p.W_ukvt, scr, r / 64, r % 64, lane, MapUkv(), p.in[18]); continue; } r -= I_UKV;
        tr_item(p.in[25], 1024, 1024, p.W_out1t, scr, r / 32, r % 32, lane, MapId(), nullptr);
    }
}

template <bool COMB>
__device__ __forceinline__ void phase_norm(const MKP& p, LAS unsigned char* lds, const float* x, const float* gw_, int layer, int sc_idx, int sh_idx, bool finalize_mod) {
    const int tid = threadIdx.x, lane = tid & 63, wave = tid >> 6;
    LAS float* msc = (LAS float*)(lds + LDS_MOD);
    LAS float* msh = msc + 1024;
    const float* b_ada = p.in[6];
    if (finalize_mod) {
        for (int i = tid; i < 2048; i += MK_THREADS) {
            const int idx = layer * 6144 + ((i < 1024) ? sc_idx * 1024 + i : sh_idx * 1024 + (i - 1024));
            float a = b_ada[idx];
#pragma unroll
            for (int kc = 0; kc < 8; ++kc) a += p.modpart[kc * 12288 + idx];
            msc[i] = a;
        }
        for (int idx = blockIdx.x * MK_THREADS + tid; idx < 12288; idx += gridDim.x * MK_THREADS) {
            float a = b_ada[idx];
#pragma unroll
            for (int kc = 0; kc < 8; ++kc) a += p.modpart[kc * 12288 + idx];
            p.mod[idx] = a;
        }
    } else {
        for (int i = tid; i < 2048; i += MK_THREADS)
            msc[i] = p.mod[layer * 6144 + ((i < 1024) ? sc_idx * 1024 + i : sh_idx * 1024 + (i - 1024))];
    }
    __syncthreads();
    const int gwv = blockIdx.x * 8 + wave, NGW = gridDim.x * 8;
    for (int m = gwv; m < S_; m += NGW) {
        const f32x4* xr = (const f32x4*)(x + (size_t)m * D_) + lane;
        f32x4 v[4]; float s = 0.f;
#pragma unroll
        for (int j = 0; j < 4; ++j) {
            v[j] = xr[64 * j];
            if (COMB) {
                f32x4 ys = (f32x4){0.f, 0.f, 0.f, 0.f};
#pragma unroll
                for (int k = 0; k < 8; ++k) {
                    const u32x2 w = *((const u32x2*)(p.YBUF + ((size_t)m * 8 + k) * 1024) + lane + 64 * j);
                    ys.x += __uint_as_float(w.x << 16); ys.y += __uint_as_float(w.x & 0xffff0000u); ys.z += __uint_as_float(w.y << 16); ys.w += __uint_as_float(w.y & 0xffff0000u);
                }
                const f32x4 g2v = *(const f32x4*)(p.mod + (layer - 1) * 6144 + 5 * 1024 + 256 * j + 4 * lane);
                v[j] = v[j] + g2v * ys;
                ((f32x4*)(p.out + (size_t)m * D_) + lane)[64 * j] = v[j];
            }
            s += (v[j].x * v[j].x + v[j].y * v[j].y) + (v[j].z * v[j].z + v[j].w * v[j].w);
        }
        s = wsum(s);
        const float rstd = rsqrtf(s * (1.f / D_) + EPSF);
        u32x2* o8 = (u32x2*)(p.XN + (size_t)m * D_) + lane;
#pragma unroll
        for (int j = 0; j < 4; ++j) {
            const int c0 = 256 * j + 4 * lane;
            const f32x4 g = *(const f32x4*)(gw_ + c0);
            const f32x4 sc = *(const LAS f32x4*)(msc + c0), sh = *(const LAS f32x4*)(msh + c0);
            const f32x4 y = v[j] * rstd * g * (sc + 1.f) + sh;
            u32x2 w; w.x = cvtpk(y.x, y.y); w.y = cvtpk(y.z, y.w);
            o8[64 * j] = w;
        }
    }
}

struct EpiResid {
    static constexpr bool PERM = true;
    const float* xin; float* out; const float* gate;
    __device__ __forceinline__ void operator()(const f32x4 (&acc)[2][2][4][2], const pg::Unit& u, int wid, int wr, int wc, int fr_, int fq_) const {
        int fr = fr_, fq = fq_; asm volatile("" : "+v"(fr), "+v"(fq));
        const int col0 = u.pn * 256 + wc * 32 + 8 * fq;
        f32x4 g[2][2];
#pragma unroll
        for (int bj = 0; bj < 2; ++bj)
#pragma unroll
            for (int n = 0; n < 2; ++n) g[bj][n] = *(const f32x4*)(gate + col0 + bj * 128 + n * 4);
#pragma unroll
        for (int ai = 0; ai < 2; ++ai)
#pragma unroll
            for (int m = 0; m < 4; ++m) {
                const size_t off = (size_t)(u.pm * 256 + ai * 128 + wr * 64 + m * 16 + fr) * 1024 + col0;
#pragma unroll
                for (int bj = 0; bj < 2; ++bj)
#pragma unroll
                    for (int n = 0; n < 2; ++n) {
                        const f32x4 xv = *(const f32x4*)(xin + off + bj * 128 + n * 4);
                        *(f32x4*)(out + off + bj * 128 + n * 4) = xv + g[bj][n] * acc[ai][bj][m][n];
                    }
                asm volatile("" ::: "memory");
            }
    }
};

struct EpiHeads {
    static constexpr bool PERM = false;
    const BlkDesc* tab; const float* cosT; const float* sinT; float* GATES; float* LOGF; LAS float* X;
    __device__ __forceinline__ void operator()(const f32x4 (&acc)[2][2][4][2], const pg::Unit& u, int wid, int wr, int wc, int fr_, int fq_) const {
        int fr = fr_, fq = fq_; asm volatile("" : "+v"(fr), "+v"(fq));
        const int w1 = wc & 1;
#pragma unroll
        for (int ai = 0; ai < 2; ++ai)
#pragma unroll
            for (int bj = 0; bj < 2; ++bj)
#pragma unroll
                for (int m = 0; m < 4; ++m) {
                    const f32x4 a = acc[ai][bj][m][0], b = acc[ai][bj][m][1];
                    float s = (a.x * a.x + a.y * a.y) + (a.z * a.z + a.w * a.w) + (b.x * b.x + b.y * b.y) + (b.z * b.z + b.w * b.w);
                    s += __shfl_xor(s, 16); s += __shfl_xor(s, 32);
                    if (fq == 0) X[wid * 256 + ((ai * 2 + bj) * 4 + m) * 16 + fr] = s;
                }
        asm volatile("s_waitcnt lgkmcnt(0)" ::: "memory"); __builtin_amdgcn_s_barrier(); asm volatile("" ::: "memory");
#pragma unroll
        for (int bj = 0; bj < 2; ++bj) {
            const BlkDesc d = tab[8 * u.pn + 4 * bj + wc];
            const int row0 = u.pm * 256 + wr * 64 + fr;
            if (d.flags & 4) continue;
            if (d.flags & 2) {
                if (w1 == 0) {
#pragma unroll
                    for (int ai = 0; ai < 2; ++ai)
#pragma unroll
                        for (int m = 0; m < 4; ++m) {
                            const int row = row0 + ai * 128 + m * 16;
#pragma unroll
                            for (int n = 0; n < 2; ++n) {
                                const f32x4 v = acc[ai][bj][m][n];
                                const int pc = 16 * n + 4 * fq;
                                if (pc < 24) *(f32x4*)(GATES + (size_t)row * 24 + pc) = v;
                                else *(f32x4*)(LOGF + (size_t)row * 8 + (pc - 24)) = v;
                            }
                            asm volatile("" ::: "memory");
                        }
                }
                continue;
            }
            const bool half = (d.flags & 8) != 0, has_gain = d.gain != nullptr, rope = (d.flags & 1) != 0;
            const int d0 = half ? 4 * fq : 16 * w1 + 4 * fq;
            const int dn1 = half ? 16 : 32;
            const float invn = half ? (1.f / 32.f) : (1.f / 64.f);
            const GAS float* gp = (const GAS float*)(has_gain ? d.gain : cosT);
            f32x4 g0 = *(const GAS f32x4*)(gp + d0), g1 = *(const GAS f32x4*)(gp + dn1 + d0);
            if (!has_gain) { g0 = (f32x4){1.f, 1.f, 1.f, 1.f}; g1 = g0; }
            g0 = g0 * d.scale; g1 = g1 * d.scale;
            const int cso = d.csoff + d0;
#pragma unroll
            for (int ai = 0; ai < 2; ++ai)
#pragma unroll
                for (int m = 0; m < 4; ++m) {
                    const int row = row0 + ai * 128 + m * 16;
                    const int xi = ((ai * 2 + bj) * 4 + m) * 16 + fr;
                    float ssq = X[wid * 256 + xi]; const float ssp = X[(wid ^ 1) * 256 + xi];
                    if (!half) ssq += ssp;
                    const float rs = has_gain ? rsqrtf(ssq * invn + EPSF) : 1.f;
                    f32x4 x1 = acc[ai][bj][m][0] * rs * g0, x2 = acc[ai][bj][m][1] * rs * g1;
                    f32x4 c = *(const f32x4*)(cosT + (size_t)row * 48 + cso), sn = *(const f32x4*)(sinT + (size_t)row * 48 + cso);
                    if (!rope) { c = (f32x4){1.f, 1.f, 1.f, 1.f}; sn = (f32x4){0.f, 0.f, 0.f, 0.f}; }
                    const f32x4 o1 = x1 * c - x2 * sn, o2 = x2 * c + x1 * sn;
                    u32x2 wa, wb; wa.x = cvtpk(o1.x, o1.y); wa.y = cvtpk(o1.z, o1.w); wb.x = cvtpk(o2.x, o2.y); wb.y = cvtpk(o2.z, o2.w);
                    GAS bf16_t* dr = (GAS bf16_t*)d.dst + (size_t)row * d.pitch + d0;
                    *(GAS u32x2*)dr = wa; *(GAS u32x2*)(dr + dn1) = wb;
                    asm volatile("" ::: "memory");
                }
        }
    }
};

struct EpiPlain {
    static constexpr bool PERM = true;
    bf16_t* O; int ldc;
    __device__ __forceinline__ void operator()(const f32x4 (&acc)[2][2][4][2], const pg::Unit& u, int wid, int wr, int wc, int fr_, int fq_) const {
        int fr = fr_, fq = fq_; asm volatile("" : "+v"(fr), "+v"(fq));
        const int col0 = u.pn * 256 + wc * 32 + 8 * fq;
#pragma unroll
        for (int ai = 0; ai < 2; ++ai)
#pragma unroll
            for (int m = 0; m < 4; ++m) {
                bf16_t* rp = O + (size_t)(u.pm * 256 + ai * 128 + wr * 64 + m * 16 + fr) * ldc + col0;
#pragma unroll
                for (int bj = 0; bj < 2; ++bj) { const f32x4 a = acc[ai][bj][m][0], b = acc[ai][bj][m][1];
                    u32x4 w; w.x = cvtpk(a.x, a.y); w.y = cvtpk(a.z, a.w); w.z = cvtpk(b.x, b.y); w.w = cvtpk(b.z, b.w); *(u32x4*)(rp + bj * 128) = w; }
            }
    }
};

__device__ __forceinline__ void phase_post1a(const MKP& p) {
    int tid_ = threadIdx.x; asm volatile("" : "+v"(tid_));
    const int tid = tid_, lane = tid & 63, wave = tid >> 6;
    const int gwv = blockIdx.x * 8 + wave, NGW = gridDim.x * 8;
    for (int t = gwv; t < S_; t += NGW) {
        const u32x2* row = (const u32x2*)(p.P1 + (size_t)t * 768);
        f32x4 v[3]; float sq = 0.f, skv = 0.f, skr = 0.f;
#pragma unroll
        for (int j = 0; j < 3; ++j) {
            const int g = lane + 64 * j;
            f32x4 x = (f32x4){0.f, 0.f, 0.f, 0.f};
            if (g < 168) { const u32x2 w = row[g]; x.x = __uint_as_float(w.x << 16); x.y = __uint_as_float(w.x & 0xffff0000u); x.z = __uint_as_float(w.y << 16); x.w = __uint_as_float(w.y & 0xffff0000u); }
            v[j] = x;
            const float s = (x.x * x.x + x.y * x.y) + (x.z * x.z + x.w * x.w);
            if (g < 96) sq += s; else if (g < 160) skv += s; else skr += s;
        }
        sq = wsum(sq); skv = wsum(skv); skr = wsum(skr);
        const float rq = rsqrtf(sq * (1.f / 384.f) + EPSF), rkv = rsqrtf(skv * (1.f / 256.f) + EPSF), rkr = rsqrtf(skr * (1.f / 32.f) + EPSF);
#pragma unroll
        for (int j = 0; j < 3; ++j) {
            const int g = lane + 64 * j;
            if (g < 96) { const f32x4 y = v[j] * rq; u32x2 w; w.x = cvtpk(y.x, y.y); w.y = cvtpk(y.z, y.w); *(u32x2*)(p.CQN + (size_t)t * 384 + 4 * g) = w; }
            else if (g < 160) { const f32x4 y = v[j] * rkv; u32x2 w; w.x = cvtpk(y.x, y.y); w.y = cvtpk(y.z, y.w); *(u32x2*)(p.CKVN + (size_t)t * 256 + 4 * (g - 96)) = w; }
        }
        {
            const int dl = (lane - 32) & 7;
            const int dd = 4 * dl;
            const int fi = 4 * (dl & 3);
            f32x4 x = v[2] * rkr;
            const f32x4 gn = *(const f32x4*)(p.in[24] + (dd & 31));
            x = x * gn;
            f32x4 o; o.x = __shfl_xor(x.x, 4); o.y = __shfl_xor(x.y, 4); o.z = __shfl_xor(x.z, 4); o.w = __shfl_xor(x.w, 4);
            const f32x4 c = *(const f32x4*)(p.cosT + (size_t)t * 48 + 32 + fi), sn = *(const f32x4*)(p.sinT + (size_t)t * 48 + 32 + fi);
            const f32x4 y = (dl < 4) ? (x * c - o * sn) : (x * c + o * sn);
            if (lane >= 32 && lane < 40) {
                u32x2 w; w.x = cvtpk(y.x, y.y); w.y = cvtpk(y.z, y.w);
#pragma unroll
                for (int h = 0; h < 16; ++h) *(u32x2*)(p.K96 + ((size_t)h * S_ + t) * 96 + 64 + dd) = w;
            }
        }
    }
}

__device__ __forceinline__ void mla_unit(const MKP& p, char* shm, int h, int qb) {
    int tid_ = threadIdx.x; asm volatile("" : "+v"(tid_));
    const int tid = tid_, lane = tid & 63, r32 = lane & 31; const int wid = __builtin_amdgcn_readfirstlane(tid >> 6);
    const int q0 = qb * 256;
    att::UnitArgs A;
    A.qrow = p.Q96 + ((size_t)h * S_ + q0 + 32 * wid + r32) * 96;
    A.K = p.K96 + (size_t)h * S_ * 96; A.kvpitch = 96; A.V = p.V1 + (size_t)h * S_ * 64; A.vpitch = 64;
    A.obase = p.OATT + (size_t)q0 * 1024 + h * 64; A.opitch = 1024;
    A.qtok = 32 * wid + r32; A.abase = 4 * qb; A.nsteps = 4 * qb + 4; A.bias = nullptr;
    att::attn_unit<att::MODE_CAUSAL, false, 8, 96>(A, shm);
}
__device__ __forceinline__ void phase_mla(const MKP& p, char* shm) {
    const int G = gridDim.x, bx = blockIdx.x;
    const int vcu = (G % 8 == 0) ? (bx % 8) * (G / 8) + bx / 8 : bx;
    for (int u = vcu; u < 256; u += G) {
        const int h = u >> 4, s = u & 15;
#pragma unroll 1
        for (int rep = 0; rep < 4; ++rep) mla_unit(p, shm, h, rep == 0 ? s : rep == 1 ? 31 - s : rep == 2 ? 32 + s : 63 - s);
    }
}

__device__ __forceinline__ void phase_scan(const MKP& p, LAS unsigned char* lds) {
    constexpr int NSB = 64;
    if (blockIdx.x >= NSB) {
        int tid_ = threadIdx.x; asm volatile("" : "+v"(tid_));
        const int lane = tid_ & 63, wave = tid_ >> 6;
        const int sb = blockIdx.x - NSB, NSBK = gridDim.x - NSB;
        LAS float* scr = (LAS float*)(lds + 65536 + wave * 256);
        for (int bj = sb; bj < 64; bj += NSBK) nsa::compress_job(p, scr, (LAS float*)(lds + (wave >> 2) * 32768) + (wave & 3) * 2048, 2 * bj + (wave >> 2), wave & 3, lane);
        for (int j = ((sb + NSBK - 64) % NSBK) * 8 + wave; j < 512; j += NSBK * 8) nsa::slcfrag_job(p, j, lane);
        return;
    }
    const int h = blockIdx.x >> 3, seg = blockIdx.x & 7, tid = threadIdx.x;
    LAS double* part = (LAS double*)lds;
    const float fb = p.in[8][h];
    double own[4], s = 0.0, pre = 0.0;
#pragma unroll
    for (int i = 0; i < 4; ++i) { own[i] = (double)logsigmf(p.LOGF[(size_t)(seg * 2048 + tid * 4 + i) * 8 + h] + fb); s += own[i]; }
    for (int i = tid; i < seg * 2048; i += MK_THREADS) pre += (double)logsigmf(p.LOGF[(size_t)i * 8 + h] + fb);
    part[tid] = s; part[512 + tid] = pre;
    __syncthreads();
    for (int o = 1; o < MK_THREADS; o <<= 1) {
        const double v = (tid >= o) ? part[tid - o] : 0.0, w = (tid >= o) ? part[512 + tid - o] : 0.0;
        __syncthreads();
        part[tid] += v; part[512 + tid] += w;
        __syncthreads();
    }
    double a = part[512 + MK_THREADS - 1] + ((tid > 0) ? part[tid - 1] : 0.0);
#pragma unroll
    for (int i = 0; i < 4; ++i) { a += own[i]; p.CUMB[(size_t)h * S_ + seg * 2048 + tid * 4 + i] = (float)(a * 1.4426950408889634); }
}

__device__ __forceinline__ void fox_unit(const MKP& p, char* shm, int h, int qb) {
    int tid_ = threadIdx.x; asm volatile("" : "+v"(tid_));
    const int tid = tid_, lane = tid & 63, r32 = lane & 31; const int wid = __builtin_amdgcn_readfirstlane(tid >> 6);
    const int q0 = qb * 256, abase = 4 * qb;
    const float* cb = p.CUMB + (size_t)h * S_;
    LAS float* bias = (LAS float*)(LAS unsigned char*)(shm + att::LDS_BIAS);
    LAS int* cnt = (LAS int*)(LAS unsigned char*)(shm + att::Geo<64>::LDS_WS);
    float gq = 0.f, gk = 0.f;
    for (int i = 0; i < 64; ++i) { gq = fmaxf(gq, fabsf(p.in[13][i])); gk = fmaxf(gk, fabsf(p.in[14][i])); }
    const float TH = 150.f + 2.f * (64.f * gq * gk * C2Q * 1.05f);
    const float c0 = cb[q0], cref = cb[q0 + 255];
    const bool skip = (tid < abase) && (cb[64 * tid + 63] - c0 > TH);
    const unsigned long long bal = __ballot(skip);
    if (lane == 0) cnt[wid] = __popcll(bal);
    __syncthreads();
    int alo = 0;
#pragma unroll
    for (int w = 0; w < 8; ++w) alo += cnt[w];
    int NT = abase + 4 - alo;
    if (NT & 1) { alo -= 1; NT += 1; }
    for (int i = tid; i < NT * 64; i += MK_THREADS) bias[i] = cref - cb[64 * alo + i];
    __syncthreads();
    att::UnitArgs A;
    A.qrow = p.FQ + (size_t)(q0 + 32 * wid + r32) * 512 + h * 64;
    A.K = p.FK + h * 64; A.V = p.FV + h * 64; A.kvpitch = 512; A.vpitch = 512;
    A.obase = p.OATT + (size_t)q0 * 1024 + 512 + h * 64; A.opitch = 1024;
    A.qtok = 32 * wid + r32; A.abase = abase; A.nsteps = NT; A.bias = bias;
    att::attn_unit<att::MODE_FOX, false, 8, 64>(A, shm);
}
__device__ __forceinline__ void phase_fox(const MKP& p, char* shm, int part = 3) {
    const int G = gridDim.x, bx = blockIdx.x;
    const int vcu = (G % 8 == 0) ? (bx % 8) * (G / 8) + bx / 8 : bx;
    if (part & 1) for (int u = vcu; u < 256; u += G) {
        const int h = u >> 5, s = u & 31;
#pragma unroll 1
        for (int rep = 0; rep < 2; ++rep) fox_unit(p, shm, h, rep ? 63 - s : s);
    }
    if (part & 2) for (int u = vcu; u < 256; u += G) {
#pragma unroll 1
        for (int rep = 0; rep < 2; ++rep) nsa::nsa_unit(p, shm, rep, rep ? 255 - u : u);
    }
}


struct MapOff { int off; __device__ __forceinline__ int operator()(int nn) const { return off + (nn & 31); } };
__device__ __forceinline__ void phase_moe_weights(const MKP& p, LAS unsigned char* lds, int layer) {
    int tid_ = threadIdx.x; asm volatile("" : "+v"(tid_));
    const int tid = tid_, lane = tid & 63, wave = tid >> 6;
    const int gw = blockIdx.x * 8 + wave, NGW = gridDim.x * 8;
    LAS float* scr = (LAS float*)(lds + wave * 16384);
    constexpr int IG = 16 * 16, ID = 4 * 32, IE = IG + ID;
    for (int it = gw; it < 65 * IE; it += NGW) {
        const int e = it / IE; int r = it % IE;
        if (r < IG) {
            const int kb = r / 16, nb = r % 16;
            const int n0 = nb * 32, up = (n0 >> 7) & 1, f0 = (n0 >> 8) * 128 + (n0 & 127);
            const float* W = (e < 64) ? ((up ? p.in[29] : p.in[28]) + ((size_t)layer * 64 + e) * 1024 * 256) : ((up ? p.in[32] : p.in[31]) + (size_t)layer * 1024 * 256);
            MapOff mo{f0};
            tr_item(W, 256, 1024, p.Wgu + (size_t)e * 512 * 1024, scr, kb, nb, lane, mo, nullptr);
        } else {
            r -= IG; const int kb = r / 32, nb = r % 32;
            const float* W = (e < 64) ? (p.in[30] + ((size_t)layer * 64 + e) * 256 * 1024) : (p.in[33] + (size_t)layer * 256 * 1024);
            tr_item(W, 1024, 256, p.Wd + (size_t)e * 1024 * 256, scr, kb, nb, lane, MapId(), nullptr);
        }
    }
}

template <bool DRY>
__device__ __forceinline__ void phase_moe_route(const MKP& p, LAS unsigned char* lds, int layer) {
    int tid_ = threadIdx.x; asm volatile("" : "+v"(tid_));
    const int tid = tid_, lane = tid & 63, wave = tid >> 6;
    LAS float* msc = (LAS float*)(lds + LDS_MOD);
    LAS float* msh = msc + 1024;
    LAS float* hrow = (LAS float*)lds;
    LAS int* cntl = (LAS int*)(lds + LDS_X);
    LAS int* basel = cntl + 64;
    const float* gnorm = p.in[4] + layer * 1024;
    const float* wr = p.in[26] + (size_t)layer * 1024 * 64;
    const float rb = p.in[27][layer * 64 + lane];
    for (int i = tid; i < 2048; i += MK_THREADS) msc[i] = p.mod[layer * 6144 + ((i < 1024) ? 4 * 1024 + i : 3 * 1024 + (i - 1024))];
    __syncthreads();
    for (int batch = blockIdx.x; batch < S_ / 32; batch += gridDim.x) {
        if (tid < 64) cntl[tid] = 0;
#pragma unroll 1
        for (int i = 0; i < 4; ++i) {
            const int t = batch * 32 + wave * 4 + i;
            const f32x4* xr = (const f32x4*)(p.out + (size_t)t * D_) + lane;
            f32x4 v[4]; float s = 0.f;
#pragma unroll
            for (int j = 0; j < 4; ++j) { v[j] = xr[64 * j]; s += (v[j].x * v[j].x + v[j].y * v[j].y) + (v[j].z * v[j].z + v[j].w * v[j].w); }
            s = wsum(s);
            const float rstd = rsqrtf(s * (1.f / D_) + EPSF);
            u32x2* o8 = (u32x2*)(p.XN + (size_t)t * D_) + lane;
            LAS f32x4* hr = (LAS f32x4*)(hrow + (wave * 4 + i) * 1024) + lane;
#pragma unroll
            for (int j = 0; j < 4; ++j) {
                const int c0 = 256 * j + 4 * lane;
                const f32x4 g = *(const f32x4*)(gnorm + c0);
                const f32x4 sc = *(const LAS f32x4*)(msc + c0), sh = *(const LAS f32x4*)(msh + c0);
                const f32x4 y = v[j] * rstd * g * (sc + 1.f) + sh;
                u32x2 w; w.x = cvtpk(y.x, y.y); w.y = cvtpk(y.z, y.w);
                o8[64 * j] = w; hr[64 * j] = y;
            }
        }
        __syncthreads();
        float acc0 = 0.f, acc1 = 0.f, acc2 = 0.f, acc3 = 0.f;
        const LAS float* h0 = hrow + (wave * 4) * 1024;
#pragma unroll 4
        for (int k = 0; k < 1024; k += 4) {
            const float w0 = wr[(k + 0) * 64 + lane], w1 = wr[(k + 1) * 64 + lane], w2 = wr[(k + 2) * 64 + lane], w3 = wr[(k + 3) * 64 + lane];
            const f32x4 a = *(const LAS f32x4*)(h0 + k), b = *(const LAS f32x4*)(h0 + 1024 + k), c = *(const LAS f32x4*)(h0 + 2048 + k), d = *(const LAS f32x4*)(h0 + 3072 + k);
            acc0 += a.x * w0; acc0 += a.y * w1; acc0 += a.z * w2; acc0 += a.w * w3;
            acc1 += b.x * w0; acc1 += b.y * w1; acc1 += b.z * w2; acc1 += b.w * w3;
            acc2 += c.x * w0; acc2 += c.y * w1; acc2 += c.z * w2; acc2 += c.w * w3;
            acc3 += d.x * w0; acc3 += d.y * w1; acc3 += d.z * w2; acc3 += d.w * w3;
        }
        int myrank[4], mypos[4]; float myw[4];
#pragma unroll
        for (int i = 0; i < 4; ++i) {
            const float logit = (i == 0) ? acc0 : (i == 1) ? acc1 : (i == 2) ? acc2 : acc3;
            const float score = 1.f / (1.f + expf(-logit));
            const float sv = score + rb;
            float m1 = sv;
            m1 = fmaxf(m1, __shfl_xor(m1, 1)); m1 = fmaxf(m1, __shfl_xor(m1, 2)); m1 = fmaxf(m1, __shfl_xor(m1, 4));
            int am = (sv == m1) ? (lane & 7) : 8;
            am = min(am, __shfl_xor(am, 1)); am = min(am, __shfl_xor(am, 2)); am = min(am, __shfl_xor(am, 4));
            float m2 = ((lane & 7) == am) ? -INFINITY : sv;
            m2 = fmaxf(m2, __shfl_xor(m2, 1)); m2 = fmaxf(m2, __shfl_xor(m2, 2)); m2 = fmaxf(m2, __shfl_xor(m2, 4));
            const float gs = m1 + m2;
            const int gi = lane >> 3; int grank = 0;
#pragma unroll
            for (int gj = 0; gj < 8; ++gj) { const float o = __shfl(gs, gj * 8); grank += (o > gs || (o == gs && gj < gi)) ? 1 : 0; }
            const float msk = (grank < 4) ? sv : -1e30f;
            int rank = 0;
#pragma unroll 8
            for (int e = 0; e < 64; ++e) { const float o = __shfl(msk, e); rank += (o > msk || (o == msk && e < lane)) ? 1 : 0; }
            const bool selb = rank < 8;
            const float tot = wsum(selb ? score : 0.f);
            myrank[i] = selb ? rank : -1; myw[i] = score / tot * 2.5f;
            mypos[i] = (selb && !DRY) ? atomicAdd((int*)(cntl + lane), 1) : 0;
        }
        __syncthreads();
        if (tid < 64) basel[tid] = (cntl[tid] > 0 && !DRY) ? atomicAdd(p.gcnt + layer * 64 + tid, cntl[tid]) : 0;
        __syncthreads();
#pragma unroll
        for (int i = 0; i < 4; ++i) if (myrank[i] >= 0 && !DRY) {
            const int t = batch * 32 + wave * 4 + i, slot = t * 8 + myrank[i];
            p.list[(size_t)lane * 16384 + basel[lane] + mypos[i]] = slot;
            p.ew[slot] = myw[i];
        }
        __syncthreads();
    }
}

struct MoeSched {
    const char* A; const char* Bt; const int* list; const LAS int* ustart; const LAS int* hbase; const LAS int* cnt;
    int K, NP, G, c; bool gather; int nexp;
    __device__ __forceinline__ static void tables(LAS int* ustart, LAS int* hbase, LAS int* cnt, const int* gcnt, int NP) {
        const int tid = threadIdx.x;
        if (tid == 0) {
            int us = 0, hb = 0;
            for (int e = 0; e < 65; ++e) { const int c = (e < 64) ? gcnt[e] : S_; const int nrb = (c + 255) >> 8; cnt[e] = c; ustart[e] = us; hbase[e] = hb; us += nrb * NP; hb += nrb * 256; }
            ustart[65] = us; hbase[65] = hb;
        }
        __syncthreads();
    }
    __device__ __forceinline__ bool next(int i, pg::Unit& u, int R0, int C0) const {
        const int L = i * G + c; if (L >= ustart[nexp]) return false;
        const int lane = threadIdx.x & 63;
        const unsigned long long bal = __ballot(lane < 65 && ustart[lane] <= L);
        int e = __popcll(bal) - 1; if (ustart[64] <= L) e = 64;
        const int r = L - ustart[e], rb = r / NP, pn = r % NP;
        u.pm = (hbase[e] >> 8) + rb; u.pn = pn; u.aux = e | (rb << 8);
        u.B = Bt + ((size_t)e * NP + pn) * 256 * K * 2;
        if (gather) {
            u.A = A; const int ce = cnt[e];
#pragma unroll
            for (int q = 0; q < 4; ++q) { const int pos = rb * 256 + R0 + 64 * q; int tok = 0; if (pos < ce) tok = (e < 64) ? (list[(size_t)e * 16384 + pos] >> 3) : pos; u.ra[q] = (unsigned)(tok * K + C0) * 2u; }
        } else {
            u.A = A + (size_t)u.pm * 256 * K * 2;
#pragma unroll
            for (int q = 0; q < 4; ++q) u.ra[q] = (unsigned)((R0 + 64 * q) * K + C0) * 2u;
        }
        return true;
    }
};
struct EpiGateUp {
    static constexpr bool PERM = true;
    bf16_t* HID;
    __device__ __forceinline__ void operator()(const f32x4 (&acc)[2][2][4][2], const pg::Unit& u, int wid, int wr, int wc, int fr_, int fq_) const {
        int fr = fr_, fq = fq_; asm volatile("" : "+v"(fr), "+v"(fq));
        const int col0 = u.pn * 128 + wc * 32 + 8 * fq;
#pragma unroll
        for (int ai = 0; ai < 2; ++ai)
#pragma unroll
            for (int m = 0; m < 4; ++m) {
                bf16_t* rp = HID + (size_t)(u.pm * 256 + ai * 128 + wr * 64 + m * 16 + fr) * 256 + col0;
                float h[8];
#pragma unroll
                for (int n = 0; n < 2; ++n) {
                    const f32x4 g = acc[ai][0][m][n], up = acc[ai][1][m][n];
                    h[4 * n] = g.x / (1.f + __expf(-g.x)) * up.x; h[4 * n + 1] = g.y / (1.f + __expf(-g.y)) * up.y; h[4 * n + 2] = g.z / (1.f + __expf(-g.z)) * up.z; h[4 * n + 3] = g.w / (1.f + __expf(-g.w)) * up.w;
                }
                u32x4 w; w.x = cvtpk(h[0], h[1]); w.y = cvtpk(h[2], h[3]); w.z = cvtpk(h[4], h[5]); w.w = cvtpk(h[6], h[7]); *(u32x4*)rp = w;
            }
    }
};
struct EpiDown {
    static constexpr bool PERM = true;
    bf16_t* YBUF; const int* list; const float* ew; const LAS int* cnt;
    __device__ __forceinline__ void operator()(const f32x4 (&acc)[2][2][4][2], const pg::Unit& u, int wid, int wr, int wc, int fr_, int fq_) const {
        int fr = fr_, fq = fq_; asm volatile("" : "+v"(fr), "+v"(fq));
        const int e = u.aux & 0xff, rb = u.aux >> 8, ce = cnt[e];
        const unsigned colb = (unsigned)(u.pn * 256 + wc * 32 + 8 * fq) * 2u;
        const int* le = list + (size_t)e * 16384 + rb * 256 + wr * 64 + fr;
        const int pos0 = rb * 256 + wr * 64 + fr;
        int slot[8]; float w[8];
#pragma unroll
        for (int i = 0; i < 8; ++i) { const int pr = (i >> 2) * 128 + (i & 3) * 16; slot[i] = (pos0 + pr < ce) ? le[pr] : -1; }
#pragma unroll
        for (int i = 0; i < 8; ++i) w[i] = (slot[i] >= 0) ? ew[slot[i]] : 0.f;
#pragma unroll
        for (int ai = 0; ai < 2; ++ai)
#pragma unroll
            for (int m = 0; m < 4; ++m) {
                const int i = ai * 4 + m;
                if (slot[i] >= 0) {
                    char* rp = (char*)YBUF + ((unsigned)slot[i] * 2048u + colb);
#pragma unroll
                    for (int bj = 0; bj < 2; ++bj) { const f32x4 a = acc[ai][bj][m][0] * w[i], b = acc[ai][bj][m][1] * w[i];
                        u32x4 o; o.x = cvtpk(a.x, a.y); o.y = cvtpk(a.z, a.w); o.z = cvtpk(b.x, b.y); o.w = cvtpk(b.z, b.w); *(u32x4*)(rp + bj * 256) = o; }
                }
            }
    }
};
__device__ __forceinline__ void phase_moe_gemm1(const MKP& p, LAS unsigned char* lds, int layer) {
    LAS int* tb = (LAS int*)(lds + LDS_X);
    MoeSched::tables(tb, tb + 66, tb + 132, p.gcnt + layer * 64, 2);
    const int G = gridDim.x, bx = blockIdx.x, vcu = (G % 8 == 0) ? (bx % 8) * (G / 8) + bx / 8 : bx;
    MoeSched S{(const char*)p.XN, (const char*)p.Wgu, p.list, tb, tb + 66, tb + 132, 1024, 2, G, vcu, true, 65};
    EpiGateUp E{p.HID};
    pg::gemm_run(lds, 1024, S, E);
}
__device__ __forceinline__ void phase_moe_gemm2(const MKP& p, LAS unsigned char* lds, int layer, int which = 3) {
    LAS int* tb = (LAS int*)(lds + LDS_X);
    MoeSched::tables(tb, tb + 66, tb + 132, p.gcnt + layer * 64, 4);
    const int G = gridDim.x, bx = blockIdx.x, vcu = (G % 8 == 0) ? (bx % 8) * (G / 8) + bx / 8 : bx;
    if (which & 1) { MoeSched S{(const char*)p.HID, (const char*)p.Wd, p.list, tb, tb + 66, tb + 132, 256, 4, G, vcu, false, 64};
      EpiDown E{p.YBUF, p.list, p.ew, tb + 132};
      pg::gemm_run(lds, 256, S, E); }
    if (which & 2) {
      pg::DenseSched S; S.init(p.HID + (size_t)tb[66 + 64] * 256, p.Wd + (size_t)64 * 1024 * 256, S_, 1024, 256, G, bx);
      EpiResid E{p.out, p.out, p.mod + layer * 6144 + 5 * 1024};
      pg::gemm_run(lds, 256, S, E); }
}
__device__ __forceinline__ void phase_moe_combine(const MKP& p, int layer) {
    int tid_ = threadIdx.x; asm volatile("" : "+v"(tid_));
    const int tid = tid_, lane = tid & 63, wave = tid >> 6;
    const int gwv = blockIdx.x * 8 + wave, NGW = gridDim.x * 8;
    const float* g2 = p.mod + layer * 6144 + 5 * 1024;
    for (int t = gwv; t < S_; t += NGW) {
        f32x4* xr = (f32x4*)(p.out + (size_t)t * D_) + lane;
#pragma unroll
        for (int j = 0; j < 4; ++j) {
            f32x4 s = (f32x4){0.f, 0.f, 0.f, 0.f};
#pragma unroll
            for (int k = 0; k < 8; ++k) {
                const u32x2 w = *((const u32x2*)(p.YBUF + ((size_t)t * 8 + k) * 1024) + lane + 64 * j);
                s.x += __uint_as_float(w.x << 16); s.y += __uint_as_float(w.x & 0xffff0000u); s.z += __uint_as_float(w.y << 16); s.w += __uint_as_float(w.y & 0xffff0000u);
            }
            const f32x4 g = *(const f32x4*)(g2 + 256 * j + 4 * lane);
            xr[64 * j] = xr[64 * j] + g * s;
        }
    }
}

#define XB_TMO      128
#define XB_XCNT(j)  (256  + 64 * (j))
#define XB_XSUB(j)  (1280 + 64 * (j))
#define XB_XGEN(j)  (2304 + 64 * (j))
#define XB_TOP      3328
#define XB_TOPGEN   3392
#define XCD_BAR_WORDS 3456
#define XB_SPIN_CAP (1u << 22)
__device__ __forceinline__ unsigned xb_ld(unsigned* p)              { return __hip_atomic_load(p, __ATOMIC_RELAXED, __HIP_MEMORY_SCOPE_AGENT); }
__device__ __forceinline__ unsigned xb_add(unsigned* p, unsigned v) { return __hip_atomic_fetch_add(p, v, __ATOMIC_RELAXED, __HIP_MEMORY_SCOPE_AGENT); }
__device__ __forceinline__ unsigned xb_xcc_id() { return (unsigned)__builtin_amdgcn_s_getreg((3 << 11) | 20) & 0xFu; }
#define XB_SPIN(cond, bar) do { unsigned _sp = 0; while (cond) { __builtin_amdgcn_s_sleep(1); \
    if ((++_sp & 255u) == 0u) { if (xb_ld(&(bar)[XB_TMO])) break; if (_sp > XB_SPIN_CAP) { atomicAdd(&(bar)[XB_TMO], 1u); break; } } } } while (0)
struct XcdBarrier { unsigned* bar; unsigned x; volatile LAS unsigned* st; };
__device__ __forceinline__ XcdBarrier xcd_barrier_post(unsigned* bar, volatile LAS unsigned* st) {
    XcdBarrier b; b.bar = bar; b.x = xb_xcc_id(); b.st = st;
    if (threadIdx.x == 0) (void)xb_add(&bar[XB_XCNT(b.x)], 1u);
    return b;
}
__device__ __forceinline__ void xcd_barrier_complete(unsigned* bar, unsigned x, unsigned& nloc, unsigned& nx) {
    const unsigned G = gridDim.x * gridDim.y * gridDim.z;
    unsigned sum, cnt, mine, sp = 0u;
    for (;;) {
        sum = 0u; cnt = 0u; mine = 0u;
#pragma unroll
        for (unsigned j = 0; j < 16; ++j) { const unsigned c = xb_ld(&bar[XB_XCNT(j)]); sum += c; cnt += (c > 0u) ? 1u : 0u; mine = (j == x) ? c : mine; }
        if (sum == G) break;
        __builtin_amdgcn_s_sleep(1);
        if ((++sp & 255u) == 0u) { if (xb_ld(&bar[XB_TMO])) break; if (sp > XB_SPIN_CAP) { atomicAdd(&bar[XB_TMO], 1u); break; } }
    }
    nloc = mine > 0u ? mine : 1u; nx = cnt > 0u ? cnt : 1u;
}
__device__ __forceinline__ void xcd_barrier(const XcdBarrier& b) {
    asm volatile("s_waitcnt vmcnt(0)" ::: "memory");
    __syncthreads();
    if (threadIdx.x == 0) {
        unsigned* bar = b.bar;
        __builtin_amdgcn_s_waitcnt(0);
        unsigned nloc = b.st[0], nx = b.st[1];
        if (nloc == 0u) { xcd_barrier_complete(bar, b.x, nloc, nx); b.st[0] = nloc; b.st[1] = nx; }
        const unsigned old = xb_add(&bar[XB_XSUB(b.x)], 1u);
        const unsigned gen = old / nloc;
        if (old + 1u == (gen + 1u) * nloc) {
            __builtin_amdgcn_fence(__ATOMIC_RELEASE, "agent");
            asm volatile("s_waitcnt vmcnt(0)" ::: "memory");
            const unsigned og = xb_add(&bar[XB_TOP], 1u);
            const unsigned tg = og / nx;
            if (og + 1u == (tg + 1u) * nx) xb_add(&bar[XB_TOPGEN], 1u);
            else XB_SPIN(xb_ld(&bar[XB_TOPGEN]) == tg, bar);
            __builtin_amdgcn_fence(__ATOMIC_ACQUIRE, "agent");
            xb_add(&bar[XB_XGEN(b.x)], 1u);
            asm volatile("s_waitcnt vmcnt(0)" ::: "memory");
        } else {
            XB_SPIN(xb_ld(&bar[XB_XGEN(b.x)]) == gen, bar);
            __builtin_amdgcn_fence(__ATOMIC_ACQUIRE, "agent");
            asm volatile("s_waitcnt vmcnt(0)" ::: "memory");
        }
    }
    __syncthreads();
}

__global__ void __launch_bounds__(MK_THREADS, 2) mega(MKP p) {
    extern __shared__ __attribute__((aligned(16))) unsigned char lds_raw[];
    LAS unsigned char* lds = (LAS unsigned char*)lds_raw;
    const int lo = p.ph_lo, hi = p.ph_hi;
    const bool multi = hi - lo > 1;
    volatile LAS unsigned* bst = (volatile LAS unsigned*)(lds + LDS_BARST);
    XcdBarrier bar; bar.bar = p.barw; bar.x = 0; bar.st = bst;
    if (multi) {
        if (threadIdx.x < 2) bst[threadIdx.x] = 0u;
        if (blockIdx.x == 0) for (int i = threadIdx.x; i < XCD_BAR_WORDS; i += MK_THREADS) p.barw[i] = 0u;
    }
    int nbar = 0;
#define IN(k) (lo <= (k) && (k) < hi)
#define SEAM(k) do { if (IN(k) && IN((k) + 1)) { if (nbar == 0) { __threadfence(); cooperative_groups::this_grid().sync(); __builtin_amdgcn_fence(__ATOMIC_ACQUIRE, "agent"); bar = xcd_barrier_post(p.barw, bst); } else xcd_barrier(bar); ++nbar; } } while (0)
    if (IN(0)) { phase_prologue(p, lds); phase_moe_weights(p, lds, 0); }
    SEAM(0);
    if (IN(1)) phase_norm<false>(p, lds, p.in[0], p.in[3], 0, 1, 0, true);
    SEAM(1);
    if (IN(2)) {
        pg::DenseSched S; S.init(p.XN, p.W_in0t, S_, 3072, 1024, gridDim.x, blockIdx.x);
        EpiHeads E{p.desc0, p.cosT, p.sinT, p.GATES, p.LOGF, (LAS float*)(lds + LDS_X)};
        pg::gemm_run(lds, 1024, S, E);
    }
    SEAM(2);
    if (IN(3)) phase_scan(p, lds);
    SEAM(3);
    if (IN(4)) phase_fox(p, (char*)lds_raw);
    SEAM(4);
    if (IN(5)) {
        pg::DenseSched S; S.init(p.OATT, p.W_out0t, S_, 1024, 1024, gridDim.x, blockIdx.x);
        EpiResid E{p.in[0], p.out, p.mod + 2 * 1024};
        pg::gemm_run(lds, 1024, S, E);
    }
    SEAM(5);
    if (IN(6)) phase_moe_route<false>(p, lds, 0);
    SEAM(6);
    if (IN(7)) phase_moe_gemm1(p, lds, 0);
    SEAM(7);
    if (IN(8)) phase_moe_gemm2(p, lds, 0);
    SEAM(8);
    if (IN(9)) { phase_norm<true>(p, lds, p.out, p.in[3] + 1024, 1, 1, 0, false); phase_moe_weights(p, lds, 1); }
    if (IN(9) && IN(11)) { xcd_barrier(bar); ++nbar; }
    if (IN(11)) {
        pg::DenseSched S; S.init(p.XN, p.W_in1t, S_, 768, 1024, gridDim.x, blockIdx.x);
        EpiPlain E{p.P1, 768};
        pg::gemm_run(lds, 1024, S, E);
    }
    SEAM(11);
    if (IN(12)) phase_post1a(p);
    SEAM(12);
    if (IN(13)) {
        { pg::DenseSched S; S.init(p.CQN, p.W_uqt, S_, 1536, 384, gridDim.x, blockIdx.x);
          EpiHeads E{p.desc_uq, p.cosT, p.sinT, nullptr, nullptr, (LAS float*)(lds + LDS_X)};
          pg::gemm_run(lds, 384, S, E); }
        { pg::DenseSched S; S.init(p.CKVN, p.W_ukvt, S_, 2048, 256, gridDim.x, blockIdx.x);
          EpiHeads E{p.desc_ukv, p.cosT, p.sinT, nullptr, nullptr, (LAS float*)(lds + LDS_X)};
          pg::gemm_run(lds, 256, S, E); }
    }
    SEAM(13);
    if (IN(14)) phase_mla(p, (char*)lds_raw);
    SEAM(14);
    if (IN(15)) {
        pg::DenseSched S; S.init(p.OATT, p.W_out1t, S_, 1024, 1024, gridDim.x, blockIdx.x);
        EpiResid E{p.out, p.out, p.mod + 6144 + 2 * 1024};
        pg::gemm_run(lds, 1024, S, E);
    }
    SEAM(15);
    if (IN(16)) phase_moe_route<false>(p, lds, 1);
    SEAM(16);
    if (IN(17)) phase_moe_gemm1(p, lds, 1);
    SEAM(17);
    if (IN(18)) phase_moe_gemm2(p, lds, 1);
    SEAM(18);
    if (IN(19)) phase_moe_combine(p, 1);
#undef IN
#undef SEAM
}
extern "C" void kernel_launch(void* const* d_in, const int* in_sizes, int n_in, void* d_out, int out_size, void* d_ws, size_t ws_size, hipStream_t stream) {
    static int grid = 0;
    if (!grid) {
        int dev = 0, cus = 0, per_cu = 0;
        (void)hipGetDevice(&dev); (void)hipDeviceGetAttribute(&cus, hipDeviceAttributeMultiprocessorCount, dev);
        (void)hipFuncSetAttribute((const void*)mega, hipFuncAttributeMaxDynamicSharedMemorySize, LDS_TOTAL);
        (void)hipOccupancyMaxActiveBlocksPerMultiprocessor(&per_cu, (const void*)mega, MK_THREADS, LDS_TOTAL);
        (void)hipGetLastError();
        grid = (cus > 0 && per_cu >= 1) ? cus : -1;
    }
    if (grid < 0) return;
    constexpr size_t MiB = 1u << 20;
    if (ws_size < 528 * MiB || n_in != 34) return;
    char* wsb = (char*)d_ws;
    float* ws = (float*)d_ws;
    size_t o = 0;
    MKP p{};
    for (int i = 0; i < 34; ++i) p.in[i] = (const float*)d_in[i];
    p.out = (float*)d_out; p.pos = (const int*)d_in[2];
    p.mod = ws + o; o += 2 * 6144;
    p.cosT = ws + o; o += (size_t)S_ * 48;
    p.sinT = ws + o; o += (size_t)S_ * 48;
    p.modpart = ws + o; o += 8 * 12288;
    p.desc0 = (BlkDesc*)(ws + o); o += 96 * 8;
    p.desc_uq = (BlkDesc*)(ws + o); o += 48 * 8;
    p.desc_ukv = (BlkDesc*)(ws + o); o += 64 * 8;
    p.CUMB = ws + o; o += (size_t)8 * S_;
    p.gcnt = (int*)(ws + o); o += 128;
    p.CBIAS = ws + o; o += 128;
    p.barw = (unsigned*)(ws + o); o += 4096;
    p.ew = ws + o; o += (size_t)S_ * 8;
    p.list = (int*)(ws + o); o += (size_t)64 * 16384;
    p.WcT = (bf16_t*)(ws + o); o += (size_t)2 * 64 * 2048 / 2;
    p.KCMP = (bf16_t*)(ws + o); o += (size_t)2 * 1024 * 64 / 2;
    p.VCT = (bf16_t*)(ws + o); o += (size_t)2 * 64 * 1024 / 2;
    if (o * 4 > 15 * MiB) return;
    p.XN = (bf16_t*)(wsb + 15 * MiB); p.OATT = (bf16_t*)(wsb + 47 * MiB);
    char* big = wsb + 79 * MiB;
    {   bf16_t* b = (bf16_t*)big;
        p.QN = b; b += (size_t)S_ * 512; p.KV6 = b; b += (size_t)12 * S_ * 64; p.FQ = b; b += (size_t)S_ * 512; p.FK = b; b += (size_t)S_ * 512; p.FV = b; b += (size_t)S_ * 512;
        p.GATES = (float*)b; p.LOGF = p.GATES + (size_t)S_ * 24; }
    p.KSLF = (bf16_t*)(big + 92 * MiB); p.VSLF = (bf16_t*)(big + 96 * MiB); p.OCMP = (bf16_t*)(big + 100 * MiB); p.OWIN = (bf16_t*)(big + 116 * MiB);
    {   bf16_t* b = (bf16_t*)(big + 96 * MiB);
        p.P1 = b; b += (size_t)S_ * 768; p.CQN = b; b += (size_t)S_ * 384; p.CKVN = b; b += (size_t)S_ * 256;
        p.Q96 = b; b += (size_t)16 * S_ * 96; p.K96 = b; b += (size_t)16 * S_ * 96; p.V1 = b; b += (size_t)16 * S_ * 64; }
    p.YBUF = (bf16_t*)big; p.HID = (bf16_t*)(big + 256 * MiB);
    p.Wgu = (bf16_t*)(wsb + 415 * MiB); p.Wd = p.Wgu + (size_t)65 * 512 * 1024;
    {   bf16_t* b = (bf16_t*)(wsb + 513 * MiB);
        p.W_in0t = b; b += (size_t)3072 * 1024; p.W_out0t = b; b += (size_t)1024 * 1024; p.W_in1t = b; b += (size_t)768 * 1024;
        p.W_uqt = b; b += (size_t)1536 * 384; p.W_ukvt = b; b += (size_t)2048 * 256; p.W_out1t = b; b += (size_t)1024 * 1024; }
    p.ph_lo = 0; p.ph_hi = 20;
    void* args[] = {&p};
    (void)hipLaunchCooperativeKernel((const void*)mega, dim3(grid), dim3(MK_THREADS), args, LDS_TOTAL, stream);
}
```

```cpp
#include <hip/hip_runtime.h>
#include <hip/hip_cooperative_groups.h>
#include <stdint.h>

#define S_ 16384
#define D_ 1024
#define HYIN 2848
#define NEXP 64
#define EPSF 1e-6f

__device__ __forceinline__ float wsum(float v) {
#pragma unroll
    for (int o = 32; o > 0; o >>= 1) v += __shfl_xor(v, o);
    return v;
}
__device__ __forceinline__ float sigmf(float x) { return 1.f / (1.f + expf(-x)); }
__device__ __forceinline__ float logsigmf(float x) { return fminf(x, 0.f) - log1pf(expf(-fabsf(x))); }
#define LAS __attribute__((address_space(3)))
#define GAS __attribute__((address_space(1)))
typedef unsigned short bf16_t;
typedef short bf16x8 __attribute__((ext_vector_type(8)));
typedef float f32x4 __attribute__((ext_vector_type(4)));
typedef float f32x2 __attribute__((ext_vector_type(2)));
typedef unsigned u32x4 __attribute__((ext_vector_type(4)));
typedef unsigned u32x2 __attribute__((ext_vector_type(2)));
typedef __bf16 bf16x2_t __attribute__((ext_vector_type(2)));

__device__ __forceinline__ unsigned cvtpk(float lo, float hi) { f32x2 v = {lo, hi}; bf16x2_t b = __builtin_convertvector(v, bf16x2_t); return __builtin_bit_cast(unsigned, b); }
__device__ __forceinline__ float bf2f(bf16_t v) { return __uint_as_float(((unsigned)v) << 16); }
__device__ __forceinline__ bf16_t f2bf(float f) { return (bf16_t)(cvtpk(f, 0.f) & 0xffffu); }

namespace pg {
constexpr int BM = 256, BK = 64, HALF = 128, HTB = HALF * BK * 2, STAGE_BYTES = 8 * HTB;
__device__ __forceinline__ int lds_byte(int r, int c) { const int st = (r >> 4) * 2 + (c >> 5), rr = r & 15, cc = c & 31, ob = rr * 64 + cc * 2; return st * 1024 + (ob ^ (((ob >> 9) & 1) << 5)); }
__device__ __forceinline__ int perm32(int rho) { const int n = rho >> 4, i = rho & 15; return 8 * (i >> 2) + 4 * n + (i & 3); }
__device__ __forceinline__ void stage_rc(int b, int& R, int& C) { const int st = b / 1024, sb = b % 1024, swz = sb ^ (((sb >> 9) & 1) << 5); R = (st >> 1) * 16 + swz / 64; C = (st & 1) * 32 + (swz % 64) / 2; }

struct Unit { int pm, pn, aux; const char* A; const char* B; unsigned ra[4]; };

template <class Epi, class Sched>
__device__ __forceinline__ void gemm_run(LAS unsigned char* lds, const int K, const Sched& S, const Epi& E) {
    int tid_ = threadIdx.x; asm volatile("" : "+v"(tid_));
    const int tid = tid_, wid = __builtin_amdgcn_readfirstlane(tid >> 6), lane = tid & 63, wr = wid >> 2, wc = wid & 3, fr = lane & 15, fq = lane >> 4;
    int nt_ = K / BK; asm volatile("" : "+s"(nt_)); const int nt = nt_;
    int R0, C0; stage_rc(tid * 16, R0, C0);
    unsigned voffB[2];
#pragma unroll
    for (int i = 0; i < 2; ++i) { const int Rb = Epi::PERM ? ((R0 & ~31) + perm32(R0 & 31)) : R0; voffB[i] = (unsigned)((Rb + 64 * i) * K + C0) * 2u; }
    const size_t kstep = (size_t)(BK * 2);
    const size_t hstep = (size_t)HALF * K * 2;
    const unsigned ldsw = (unsigned)wid * 1024u;
    const int aoff = lds_byte(wr * 64 + fr, fq * 8), boff = lds_byte(wc * 32 + fr, fq * 8);
#define PG_SA(b, h) (((b) * 2 + (h)) * HTB)
#define PG_SB(b, h) ((4 + (b) * 2 + (h)) * HTB)
#define PG_STAGE2(bufoff, gbase, v0, v1) do { \
        __builtin_amdgcn_global_load_lds((const unsigned*)((const char*)(gbase) + (v0)), (LAS unsigned*)(lds + (bufoff) + ldsw), 16, 0, 0); \
        __builtin_amdgcn_global_load_lds((const unsigned*)((const char*)(gbase) + (v1)), (LAS unsigned*)(lds + (bufoff) + ldsw + 8192), 16, 0, 0); } while (0)
#define PG_STAGEB(bufoff, gbase) PG_STAGE2(bufoff, gbase, voffB[0], voffB[1])
#define PG_LDA(dst, b, h) do { _Pragma("unroll") for (int m = 0; m < 4; ++m) _Pragma("unroll") for (int k = 0; k < 2; ++k) dst[m][k] = *(const LAS bf16x8*)(lds + PG_SA(b, h) + aoff + m * 2048 + k * 1024); } while (0)
#define PG_LDB(dst, b, h) do { _Pragma("unroll") for (int n = 0; n < 2; ++n) _Pragma("unroll") for (int k = 0; k < 2; ++k) dst[n][k] = *(const LAS bf16x8*)(lds + PG_SB(b, h) + boff + n * 2048 + k * 1024); } while (0)
#define PG_MMA(ai, bj, At, Bt) do { __builtin_amdgcn_s_setprio(1); _Pragma("unroll") for (int m = 0; m < 4; ++m) _Pragma("unroll") for (int n = 0; n < 2; ++n) _Pragma("unroll") for (int k = 0; k < 2; ++k) \
        acc[ai][bj][m][n] = __builtin_amdgcn_mfma_f32_16x16x32_bf16(Bt[n][k], At[m][k], acc[ai][bj][m][n], 0, 0, 0); __builtin_amdgcn_s_setprio(0); } while (0)
#define PG_WAIT_V(n) asm volatile("s_waitcnt vmcnt(" #n ")" ::: "memory")
#define PG_WAIT_L(n) asm volatile("s_waitcnt lgkmcnt(" #n ")" ::: "memory")
#define PG_BAR __builtin_amdgcn_s_barrier()
#define PG_SCHED __builtin_amdgcn_sched_barrier(0)
    Unit cur, nxt; int ui = 0;
    if (!S.next(0, cur, R0, C0)) return;
    f32x4 acc[2][2][4][2];
#pragma unroll
    for (int a = 0; a < 2; ++a)
#pragma unroll
        for (int b = 0; b < 2; ++b)
#pragma unroll
            for (int m = 0; m < 4; ++m)
#pragma unroll
                for (int n = 0; n < 2; ++n) acc[a][b][m][n] = (f32x4){0.f, 0.f, 0.f, 0.f};
    bf16x8 At[4][2], B0[2][2], B1[2][2];
    const char* cA = cur.A; const char* cB = cur.B;
    PG_STAGEB(PG_SB(0, 0), cB); PG_STAGEB(PG_SB(0, 1), cB + hstep); PG_STAGE2(PG_SA(0, 0), cA, cur.ra[0], cur.ra[1]); PG_STAGE2(PG_SA(0, 1), cA, cur.ra[2], cur.ra[3]);
    if (wr == 1) PG_BAR;
    PG_WAIT_V(2); PG_BAR;
    PG_STAGEB(PG_SB(1, 0), cB + kstep); PG_STAGE2(PG_SA(1, 0), cA + kstep, cur.ra[0], cur.ra[1]); PG_STAGEB(PG_SB(1, 1), cB + hstep + kstep);
    PG_WAIT_V(6); PG_BAR;
    for (;;) {
        const bool has_next = S.next(ui + 1, nxt, R0, C0);
        if (!has_next) nxt = cur;
        const char* nA = nxt.A; const char* nB = nxt.B;
#pragma unroll 1
        for (int t = 0; t < nt; t += 2) {
            const bool last = (t == nt - 2);
            const char* a1 = cA + (size_t)(t + 1) * kstep;
            const char* a2 = last ? nA : cA + (size_t)(t + 2) * kstep; const char* b2 = last ? nB : cB + (size_t)(t + 2) * kstep;
            const char* a3 = a2 + kstep; const char* b3 = b2 + kstep;
            const unsigned r0 = last ? nxt.ra[0] : cur.ra[0], r1 = last ? nxt.ra[1] : cur.ra[1], r2 = last ? nxt.ra[2] : cur.ra[2], r3 = last ? nxt.ra[3] : cur.ra[3];
            PG_LDB(B0, 0, 0); PG_LDB(B1, 0, 1); PG_SCHED; PG_LDA(At, 0, 0); PG_STAGE2(PG_SA(1, 1), a1, cur.ra[2], cur.ra[3]);
            PG_WAIT_V(8); PG_WAIT_L(0); PG_BAR; PG_MMA(0, 0, At, B0); PG_MMA(0, 1, At, B1); PG_BAR; PG_SCHED;
            PG_LDA(At, 0, 1); PG_STAGEB(PG_SB(0, 0), b2); PG_STAGEB(PG_SB(0, 1), b2 + hstep); PG_STAGE2(PG_SA(0, 0), a2, r0, r1);
            PG_WAIT_V(8); PG_WAIT_L(0); PG_BAR; PG_MMA(1, 0, At, B0); PG_MMA(1, 1, At, B1); PG_BAR; PG_SCHED;
            PG_LDB(B0, 1, 0); PG_LDB(B1, 1, 1); PG_SCHED; PG_LDA(At, 1, 0); PG_STAGE2(PG_SA(0, 1), a2, r2, r3);
            PG_WAIT_V(8); PG_WAIT_L(0); PG_BAR; PG_MMA(0, 0, At, B0); PG_MMA(0, 1, At, B1); PG_BAR; PG_SCHED;
            PG_LDA(At, 1, 1); PG_STAGEB(PG_SB(1, 0), b3); PG_STAGEB(PG_SB(1, 1), b3 + hstep); PG_STAGE2(PG_SA(1, 0), a3, r0, r1);
            PG_WAIT_V(8); PG_WAIT_L(0); PG_BAR; PG_MMA(1, 0, At, B0); PG_MMA(1, 1, At, B1); PG_BAR; PG_SCHED;
        }
        if (wr == 0) PG_BAR;
        E(acc, cur, wid, wr, wc, fr, fq);
        if (!has_next) break;
#pragma unroll
        for (int a = 0; a < 2; ++a)
#pragma unroll
            for (int b = 0; b < 2; ++b)
#pragma unroll
                for (int m = 0; m < 4; ++m)
#pragma unroll
                    for (int n = 0; n < 2; ++n) acc[a][b][m][n] = (f32x4){0.f, 0.f, 0.f, 0.f};
        cur = nxt; cA = nA; cB = nB; ++ui;
        if (wr == 1) PG_BAR;
    }
    PG_WAIT_V(0);
    PG_BAR;
#undef PG_SA
#undef PG_SB
#undef PG_STAGE2
#undef PG_STAGEB
#undef PG_LDA
#undef PG_LDB
#undef PG_MMA
}

struct DenseSched {
    const char* A; const char* Bt; int K, nM, nN, nwg, G, c;
    __device__ __forceinline__ void init(const void* A_, const void* Bt_, int M, int N, int K_, int G_, int c_) { A = (const char*)A_; Bt = (const char*)Bt_; K = K_; nM = M / BM; nN = N / BM; nwg = nM * nN; G = G_; c = c_; }
    __device__ __forceinline__ bool next(int i, Unit& u, int R0, int C0) const {
        const long L = (long)i * G + c; if (L >= nwg) return false;
        int wgid = (int)L; { const int q = nwg / 8, r = nwg % 8, xcd = wgid % 8, off = wgid / 8; wgid = (xcd < r ? xcd * (q + 1) : r * (q + 1) + (xcd - r) * q) + off; }
        const int nig = 8 * nN, gid = wgid / nig, fm = gid * 8, gsz = (nM - fm) < 8 ? (nM - fm) : 8;
        u.pm = fm + ((wgid % nig) % gsz); u.pn = (wgid % nig) / gsz; u.aux = 0;
        u.A = A + (size_t)u.pm * BM * K * 2; u.B = Bt + (size_t)u.pn * BM * K * 2;
#pragma unroll
        for (int q = 0; q < 4; ++q) u.ra[q] = (unsigned)((R0 + 64 * q) * K + C0) * 2u;
        return true;
    }
};
}
namespace att {
using s16x4 = __attribute__((ext_vector_type(4))) short;
using f32x16 = __attribute__((ext_vector_type(16))) float;
typedef __attribute__((address_space(3))) const char* lds_cptr;
typedef short v4i16_t __attribute__((ext_vector_type(4)));
constexpr int NSLOT = 3, VSLOT = 8192;
template <int DQ> struct Geo {
    static constexpr int NK = DQ / 16;
    static constexpr int KSLOT = (DQ == 64) ? 8192 : 16384;
    static constexpr int QWAVE = (DQ == 64) ? 4096 : 6144;
    static constexpr int LDS_K = 0, LDS_V = NSLOT * KSLOT, LDS_WS = LDS_V + NSLOT * VSLOT, LDS_OST = LDS_WS + 8 * 64 * 4, LDS_BYTES = LDS_OST + 8 * QWAVE;
};
constexpr int LDS_BIAS = Geo<64>::LDS_BYTES;
#define ASBAR() __builtin_amdgcn_sched_barrier(0)
#define AWAIT_BAR(N) asm volatile("s_waitcnt vmcnt(" #N ") lgkmcnt(0)\n\ts_barrier" ::: "memory")
__device__ __forceinline__ int crow(int r, int hi) { return (r & 3) + 8 * (r >> 2) + 4 * hi; }
__device__ __forceinline__ void glds16(const void* gsrc, unsigned lds_dst) { unsigned keep;
    asm volatile("s_mov_b32 %0, m0\n\ts_mov_b32 m0, %2\n\ts_nop 0\n\tglobal_load_lds_dwordx4 %1, off\n\ts_mov_b32 m0, %0" : "=&s"(keep) : "v"(gsrc), "s"(lds_dst) : "memory"); }
__device__ __forceinline__ float fadd_s(float a, float b) { float r; asm("v_add_f32_e32 %0, %1, %2" : "=v"(r) : "v"(a), "v"(b)); return r; }
__device__ __forceinline__ float fsub_s(float a, float b) { float r; asm("v_sub_f32_e32 %0, %1, %2" : "=v"(r) : "v"(a), "v"(b)); return r; }
__device__ __forceinline__ float max3f(float a, float b, float c) { float r; asm("v_max3_f32 %0, %1, %2, %3" : "=v"(r) : "v"(a), "v"(b), "v"(c)); return r; }
__device__ __forceinline__ float max2f(float a, float b) { float r; asm("v_max_f32_e32 %0, %1, %2" : "=v"(r) : "v"(a), "v"(b)); return r; }
__device__ __forceinline__ s16x4 vtr(lds_cptr p) { return __builtin_bit_cast(s16x4, __builtin_amdgcn_ds_read_tr16_b64_v4i16((__attribute__((address_space(3))) v4i16_t*)p)); }
template <int NK> __device__ __forceinline__ void kloadall(bf16x8* kf, lds_cptr kp) {
#pragma unroll
    for (int j = 0; j < NK; ++j) { kf[2 * j] = *(const LAS bf16x8*)(kp + j * 2048); kf[2 * j + 1] = *(const LAS bf16x8*)(kp + j * 2048 + 512); } }
__device__ __forceinline__ void kload2(bf16x8* kf, lds_cptr kp, int j) { kf[2 * j] = *(const LAS bf16x8*)(kp + j * 2048); kf[2 * j + 1] = *(const LAS bf16x8*)(kp + j * 2048 + 512); }
__device__ __forceinline__ void cmask(f32x16& p0, f32x16& p1, int koff, int qtok, int hi) {
    const int x = qtok - koff - 4 * hi;
#pragma unroll
    for (int r = 0; r < 16; ++r) { const int c = (r & 3) + 8 * (r >> 2); if (c > x) p0[r] = -INFINITY; if (c + 32 > x) p1[r] = -INFINITY; }
}
__device__ __forceinline__ void wmask(f32x16& p0, f32x16& p1, int thr, int hi) {
    const int y = thr - 4 * hi;
#pragma unroll
    for (int r = 0; r < 16; ++r) { const int c = (r & 3) + 8 * (r >> 2); if (c < y) p0[r] = -INFINITY; if (c + 32 < y) p1[r] = -INFINITY; }
}
__device__ __forceinline__ float rowmax(const f32x16& p0, const f32x16& p1) {
    float a = max3f(p0[0], p0[1], p1[0]), b = max3f(p0[2], p0[3], p1[1]); a = max3f(a, p1[2], p1[3]);
#pragma unroll
    for (int r = 4; r < 16; r += 4) { a = max3f(a, p0[r], p0[r + 1]); b = max3f(b, p0[r + 2], p0[r + 3]); a = max3f(a, p1[r], p1[r + 1]); b = max3f(b, p1[r + 2], p1[r + 3]); }
    const float m = max2f(a, b);
    auto rr = __builtin_amdgcn_permlane32_swap(__float_as_uint(m), __float_as_uint(m), false, false);
    return max2f(__uint_as_float(rr[0]), __uint_as_float(rr[1]));
}

enum { MODE_CAUSAL = 0, MODE_FOX = 1, MODE_WIN = 2 };
struct UnitArgs {
    const bf16_t* qrow;
    const bf16_t* K; const bf16_t* V; int kvpitch, vpitch;
    bf16_t* obase; int opitch;
    int qtok;
    int abase;
    int nsteps;
    const LAS float* bias;
};

template <int NB> __device__ __forceinline__ int seq(int i, int abase) { return (i < NB) ? abase + i : abase + NB - 1 - i; }

template <int MODE, bool GQA4, int THRL, int DQ>
__device__ __forceinline__ void attn_unit(const UnitArgs& A, char* shm) {
    constexpr int NB = GQA4 ? 1 : 4;
    typedef Geo<DQ> G; constexpr int NK = G::NK, KSLOT = G::KSLOT, LDS_K = G::LDS_K, LDS_V = G::LDS_V, LDS_WS = G::LDS_WS, LDS_OST = G::LDS_OST, QWAVE = G::QWAVE;
    constexpr bool USE_NEGM = (MODE != MODE_FOX);
    int tid_ = threadIdx.x; asm volatile("" : "+v"(tid_));
    const int tid = tid_, lane = tid & 63, r32 = lane & 31, hi = lane >> 5; const int wid = __builtin_amdgcn_readfirstlane(tid >> 6);
    const unsigned lds0 = (unsigned)(uintptr_t)shm;
    float* wsf = (float*)(shm + LDS_WS) + wid * 64;
    const int NT = A.nsteps, abase = A.abase; const long kvp = A.kvpitch, vvp = A.vpitch;
    const bf16_t* ksrc = A.K + (long)lane * kvp + wid * 8;
    const bf16_t* ksrc2 = A.K + (long)lane * kvp + (8 + (wid & 3)) * 8;
    const bf16_t* vsrc = A.V + (long)(16 * (wid & 3) + (lane >> 2)) * vvp + (wid >> 2) * 32 + (lane & 3) * 8;
    const unsigned kdst = lds0 + LDS_K + wid * 1024, vdst = lds0 + LDS_V + wid * 1024, kdst2 = lds0 + LDS_K + (8 + wid) * 1024;
#define TILE_OF(t) ({ int a_ = seq<NB>((t), abase); a_ < 0 ? 0 : a_; })
#define DMA_K(t, slot) do { const long to_ = (long)TILE_OF(t) * 64 * kvp; glds16(ksrc + to_, (unsigned)__builtin_amdgcn_readfirstlane(kdst + (slot) * KSLOT)); \
        if (DQ == 96) glds16(ksrc2 + to_, (unsigned)__builtin_amdgcn_readfirstlane(kdst2 + (slot) * KSLOT)); } while (0)
#define DMA_V(t, slot) glds16(vsrc + (long)TILE_OF(t) * 64 * vvp, (unsigned)__builtin_amdgcn_readfirstlane(vdst + (slot) * VSLOT))
    const lds_cptr shm3 = (lds_cptr)shm; const lds_cptr kp0 = shm3 + LDS_K + hi * 1024 + r32 * 16;
    const lds_cptr vp0 = shm3 + LDS_V + ((lane >> 4) & 1) * 32 + (lane & 3) * 8 + (4 * hi + ((lane & 15) >> 2)) * 64;
    const int vb0 = (int)(lds0 + LDS_V) + ((lane >> 4) & 1) * 32 + (lane & 3) * 8 + (4 * hi + ((lane & 15) >> 2)) * 64;
    DMA_K(0, 0); DMA_V(0, 0); DMA_K(1, 1);
    bf16x8 qr[NK];
#pragma unroll
    for (int d0 = 0; d0 < NK; ++d0) qr[d0] = *reinterpret_cast<const bf16x8*>(A.qrow + d0 * 16 + hi * 8);
    const lds_cptr qlp = shm3 + LDS_OST + wid * QWAVE + hi * 512 + r32 * 16;
    if (DQ == 96) {
#pragma unroll
        for (int d0 = 0; d0 < NK; ++d0) *(LAS bf16x8*)(const_cast<__attribute__((address_space(3))) char*>(qlp) + d0 * 1024) = qr[d0];
    }
#define QL(d0) (*(const LAS bf16x8*)(qlp + (d0) * 1024))
    float mhat = 0.f, l_reg = 0.f; f32x16 o[2]; o[0] = f32x16{}; o[1] = f32x16{};
    f32x16 negm = f32x16{}; if (USE_NEGM) asm volatile("" : "+v"(negm));
    const int qtok = A.qtok;
#define CMASK(P0, P1, t) do { const int t_ = (t); if (t_ < NB) cmask(P0, P1, 64 * t_, qtok, hi); \
        else { const int a_ = abase + NB - 1 - t_; if (a_ < 0) wmask(P0, P1, 64, hi); \
               else if (MODE == MODE_WIN) { const int thr_ = qtok - 511 + 64 * (abase - a_); if (thr_ > 0) wmask(P0, P1, thr_, hi); } } } while (0)
#define CINIT1(C, t, OFF) do { if (MODE == MODE_FOX) { const LAS float* bt_ = A.bias + 64 * (seq<NB>((t), abase) - (abase + NB - NT)) + 4 * hi + (OFF); const float nm_ = -mhat; \
        _Pragma("unroll") for (int g_ = 0; g_ < 4; ++g_) { const f32x4 b_ = *(const LAS f32x4*)(bt_ + 8 * g_); C[4 * g_] = b_.x; C[4 * g_ + 1] = b_.y; C[4 * g_ + 2] = b_.z; C[4 * g_ + 3] = b_.w; } \
        _Pragma("unroll") for (int r_ = 0; r_ < 16; ++r_) C[r_] += nm_; asm volatile("" : "+v"(C)); } \
      else if (USE_NEGM) { C = negm; } \
      else { const float nm_ = -mhat; _Pragma("unroll") for (int r_ = 0; r_ < 16; ++r_) C[r_] = nm_; asm volatile("" : "+v"(C)); } } while (0)
#define CINIT(C0, C1, t) do { CINIT1(C0, t, 0); CINIT1(C1, t, 32); } while (0)
    bool resc = false;
#define START(P0, P1) do { const float rm = rowmax(P0, P1); resc = false; \
    { const float dl = rm; mhat = fadd_s(mhat, dl); \
      _Pragma("unroll") for (int r = 0; r < 16; ++r) { P0[r] = fsub_s(P0[r], dl); P1[r] = fsub_s(P1[r], dl); } \
      if (USE_NEGM) { _Pragma("unroll") for (int r = 0; r < 16; ++r) negm[r] = -mhat; asm volatile("" : "+v"(negm)); } } \
    _Pragma("unroll") for (int r = 0; r < 16; ++r) P0[r] = __builtin_amdgcn_exp2f(P0[r]); } while (0)
#define RESC() do { if (resc) { asm volatile("s_waitcnt lgkmcnt(0)" ::: "memory"); \
      const float* wsh_ = wsf + 4 * hi; \
      _Pragma("unroll") for (int d_ = 0; d_ < 2; ++d_) _Pragma("unroll") for (int r = 0; r < 16; ++r) o[d_][r] *= wsh_[(r & 3) + 8 * (r >> 2)]; } } while (0)
    f32x16 pA0, pA1, pB0, pB1; bf16x8 kf[2 * NK];
    int sl_prev = 0, sl_cur = 0, sl_next = 1;
#define ROT() do { sl_prev = sl_cur; sl_cur = sl_next; sl_next = (sl_next == NSLOT - 1) ? 0 : sl_next + 1; } while (0)
    DMA_K(2, 2);
    if (DQ == 96) { AWAIT_BAR(5); } else { AWAIT_BAR(3); }
    { const char* kb = shm + LDS_K + hi * 1024 + r32 * 16;
      CINIT(pA0, pA1, 0);
#pragma unroll
      for (int d0 = 0; d0 < NK; ++d0) {
          const bf16x8 b0 = *reinterpret_cast<const bf16x8*>(kb + d0 * 2048);
          const bf16x8 b1 = *reinterpret_cast<const bf16x8*>(kb + d0 * 2048 + 512);
          pA0 = __builtin_amdgcn_mfma_f32_32x32x16_bf16(b0, qr[d0], pA0, 0, 0, 0); pA1 = __builtin_amdgcn_mfma_f32_32x32x16_bf16(b1, qr[d0], pA1, 0, 0, 0); } }
    asm volatile("s_nop 15\n\ts_nop 7" : "+v"(pA0), "+v"(pA1)); CMASK(pA0, pA1, 0);
    START(pA0, pA1);
    _Pragma("unroll") for (int r = 0; r < 16; ++r) pA1[r] = __builtin_amdgcn_exp2f(pA1[r]);
    AWAIT_BAR(0);
    DMA_K(3, 0); DMA_V(1, 1);
    ROT();
    kloadall<NK>(kf, kp0 + sl_cur * KSLOT);
    if (DQ == 96) { AWAIT_BAR(3); } else { AWAIT_BAR(2); }
    s16x4 vlo[(DQ == 96) ? 4 : 8], vhi[(DQ == 96) ? 4 : 8]; u32x4 pw0, pw1, pw2, pw3;
#define PKW(P, B) cvtpk(P[B], P[B + 1])
#define PAF(k) __builtin_bit_cast(bf16x8, pw##k)
#define VFR(i) (bf16x8){vlo[i][0], vlo[i][1], vlo[i][2], vlo[i][3], vhi[i][0], vhi[i][1], vhi[i][2], vhi[i][3]}
#define PIN(x) asm volatile("" : "+v"(x))
#define MX3(a, b, c) __builtin_fmaxf(__builtin_fmaxf((a), (b)), (c))
#define GAPA(MF, A0, A1, A2, A3, W0, W1, PW) do { MF; sacc += A0; sacc += A1; sacc += A2; sacc += A3; PIN(sacc); W0; W1; PIN(PW); ASBAR(); } while (0)
#define EX(v) __builtin_amdgcn_exp2f(v)
#define GAPB(MF, X, B) do { MF; X[B] = EX(X[B]); X[B + 1] = EX(X[B + 1]); X[B + 2] = EX(X[B + 2]); X[B + 3] = EX(X[B + 3]); PIN(X); ASBAR(); } while (0)
#define VRD(i) do { vlo[i] = vtr(vp_ + (((i) >> 2) * 4096 + ((i) & 3) * 1024)); vhi[i] = vtr(vp_ + (((i) >> 2) * 4096 + ((i) & 3) * 1024 + 512)); } while (0)
#define KRD(G_, j) do { if (G_) { kload2(kf, kp0 + sl_next * KSLOT, j); ASBAR(); } } while (0)
#define MFMA32(a, b, c) __builtin_amdgcn_mfma_f32_32x32x16_bf16(a, b, c, 0, 0, 0)
#define STEP64(C0, C1, P0, P1, t, GK, GV, GL, DOMASK) do { ASBAR(); \
    const lds_cptr vp_ = vp0 + sl_prev * VSLOT; \
    CINIT1(C0, t, 0); ASBAR(); \
    VRD(0); ASBAR(); float sacc = (P0[0] + P0[1]); \
    GAPA(C0 = MFMA32(kf[0], qr[0], C0), P0[2], P0[3], P0[4], P0[5],     pw0[0] = PKW(P0, 0), pw0[1] = PKW(P0, 2), pw0); \
    CINIT1(C1, t, 32); ASBAR(); \
    VRD(4); ASBAR(); GAPA(C1 = MFMA32(kf[1], qr[0], C1), P0[6], P0[7], P0[8], P0[9],     pw0[2] = PKW(P0, 4), pw0[3] = PKW(P0, 6), pw0); \
    VRD(1); ASBAR(); GAPA(C0 = MFMA32(kf[2], qr[1], C0),   P0[10], P0[11], P0[12], P0[13], pw1[0] = PKW(P0, 8), pw1[1] = PKW(P0, 10), pw1); \
    VRD(5); ASBAR(); GAPA(C1 = MFMA32(kf[3], qr[1], C1),   P0[14], P0[15], P1[0], P1[1],   pw1[2] = PKW(P0, 12), pw1[3] = PKW(P0, 14), pw1); \
    VRD(2); ASBAR(); GAPA(C0 = MFMA32(kf[4], qr[2], C0),   P1[2], P1[3], P1[4], P1[5],     pw2[0] = PKW(P1, 0), pw2[1] = PKW(P1, 2), pw2); \
    VRD(6); ASBAR(); GAPA(C1 = MFMA32(kf[5], qr[2], C1),   P1[6], P1[7], P1[8], P1[9],     pw2[2] = PKW(P1, 4), pw2[3] = PKW(P1, 6), pw2); \
    VRD(3); ASBAR(); GAPA(C0 = MFMA32(kf[6], qr[3], C0),   P1[10], P1[11], P1[12], P1[13], pw3[0] = PKW(P1, 8), pw3[1] = PKW(P1, 10), pw3); \
    VRD(7); ASBAR(); GAPA(C1 = MFMA32(kf[7], qr[3], C1),   P1[14], P1[15], 0.f, 0.f,       pw3[2] = PKW(P1, 12), pw3[3] = PKW(P1, 14), pw3); \
    l_reg += sacc; \
    if (GK) { DMA_K((t) + 3, sl_cur); } if (GV) { DMA_V((t) + 1, sl_next); } \
    if (DOMASK) CMASK(C0, C1, t); \
    { float a = MX3(C0[0], C0[1], C1[0]), b = MX3(C0[2], C0[3], C1[1]); a = MX3(a, C1[2], C1[3]); \
      _Pragma("unroll") for (int r = 4; r < 16; r += 4) { a = MX3(a, C0[r], C0[r + 1]); b = MX3(b, C0[r + 2], C0[r + 3]); a = MX3(a, C1[r], C1[r + 1]); b = MX3(b, C1[r + 2], C1[r + 3]); } \
      float rm = __builtin_fmaxf(a, b); { auto rr = __builtin_amdgcn_permlane32_swap(__float_as_uint(rm), __float_as_uint(rm), false, false); rm = __builtin_fmaxf(__uint_as_float(rr[0]), __uint_as_float(rr[1])); } \
      resc = false; \
      if (__builtin_expect(__any(rm > (float)THRL), 0)) { const float dl = __builtin_fmaxf(rm, 0.f); mhat += dl; \
        _Pragma("unroll") for (int r = 0; r < 16; ++r) { C0[r] -= dl; C1[r] -= dl; } \
        if (USE_NEGM) { _Pragma("unroll") for (int r = 0; r < 16; ++r) negm[r] = -mhat; asm volatile("" : "+v"(negm)); } \
        const float f = __builtin_amdgcn_exp2f(-dl); l_reg *= f; if (hi == 0) wsf[r32] = f; resc = true; } } \
    ASBAR(); \
    GAPB(o[0] = MFMA32(PAF(0), VFR(0), o[0]), C0, 0); \
    GAPB(o[1] = MFMA32(PAF(0), VFR(4), o[1]), C0, 4); \
    KRD(GL, 0); GAPB(o[0] = MFMA32(PAF(1), VFR(1), o[0]), C0, 8); \
    KRD(GL, 1); GAPB(o[1] = MFMA32(PAF(1), VFR(5), o[1]), C0, 12); \
    KRD(GL, 2); GAPB(o[0] = MFMA32(PAF(2), VFR(2), o[0]), C1, 0); \
    KRD(GL, 3); GAPB(o[1] = MFMA32(PAF(2), VFR(6), o[1]), C1, 4); \
    GAPB(o[0] = MFMA32(PAF(3), VFR(3), o[0]), C1, 8); \
    GAPB(o[1] = MFMA32(PAF(3), VFR(7), o[1]), C1, 12); \
    } while (0)
#define AWAIT_STEADY() do { if (DQ == 96) { AWAIT_BAR(3); } else { AWAIT_BAR(2); } } while (0)
#define VRD4(i, b) do { vlo[b] = vtr(vp_ + (((i) >> 2) * 4096 + ((i) & 3) * 1024)); vhi[b] = vtr(vp_ + (((i) >> 2) * 4096 + ((i) & 3) * 1024 + 512)); } while (0)
#define VFR4(b) (bf16x8){vlo[b][0], vlo[b][1], vlo[b][2], vlo[b][3], vhi[b][0], vhi[b][1], vhi[b][2], vhi[b][3]}
#define GAPQ(MF, QLD, A0, A1, A2, A3, W0, W1, PW) do { MF; QLD; sacc += A0; sacc += A1; sacc += A2; sacc += A3; PIN(sacc); W0; W1; PIN(PW); ASBAR(); } while (0)
#define STEP96(C0, C1, P0, P1, t, GK, GV, GL, DOMASK) do { ASBAR(); \
    const lds_cptr vp_ = vp0 + sl_prev * VSLOT; \
    CINIT1(C0, t, 0); CINIT1(C1, t, 32); bf16x8 qa = QL(0), qb; ASBAR(); \
    float sacc = (P0[0] + P0[1]); \
    GAPQ(C0 = MFMA32(kf[0], qa, C0), qb = QL(1), P0[2], P0[3], P0[4], P0[5],     pw0[0] = PKW(P0, 0), pw0[1] = PKW(P0, 2), pw0); \
    GAPQ(C1 = MFMA32(kf[1], qa, C1), (void)0,    P0[6], P0[7], P0[8], P0[9],     pw0[2] = PKW(P0, 4), pw0[3] = PKW(P0, 6), pw0); \
    GAPQ(C0 = MFMA32(kf[2], qb, C0), qa = QL(2), P0[10], P0[11], P0[12], P0[13], pw1[0] = PKW(P0, 8), pw1[1] = PKW(P0, 10), pw1); \
    GAPQ(C1 = MFMA32(kf[3], qb, C1), (void)0,    P0[14], P0[15], P1[0], P1[1],   pw1[2] = PKW(P0, 12), pw1[3] = PKW(P0, 14), pw1); \
    GAPQ(C0 = MFMA32(kf[4], qa, C0), qb = QL(3), P1[2], P1[3], P1[4], P1[5],     pw2[0] = PKW(P1, 0), pw2[1] = PKW(P1, 2), pw2); \
    GAPQ(C1 = MFMA32(kf[5], qa, C1), (void)0,    P1[6], P1[7], P1[8], P1[9],     pw2[2] = PKW(P1, 4), pw2[3] = PKW(P1, 6), pw2); \
    GAPQ(C0 = MFMA32(kf[6], qb, C0), qa = QL(4), P1[10], P1[11], P1[12], P1[13], pw3[0] = PKW(P1, 8), pw3[1] = PKW(P1, 10), pw3); \
    GAPQ(C1 = MFMA32(kf[7], qb, C1), (void)0,    P1[14], P1[15], 0.f, 0.f,       pw3[2] = PKW(P1, 12), pw3[3] = PKW(P1, 14), pw3); \
    C0 = MFMA32(kf[8], qa, C0); qb = QL(5); VRD4(0, 0); ASBAR(); \
    C1 = MFMA32(kf[9], qa, C1); VRD4(4, 1); ASBAR(); \
    C0 = MFMA32(kf[10], qb, C0); ASBAR(); \
    C1 = MFMA32(kf[11], qb, C1); ASBAR(); \
    l_reg += sacc; \
    if (GK) { DMA_K((t) + 3, sl_cur); } if (GV) { DMA_V((t) + 1, sl_next); } \
    if (DOMASK) CMASK(C0, C1, t); \
    { float a = MX3(C0[0], C0[1], C1[0]), b = MX3(C0[2], C0[3], C1[1]); a = MX3(a, C1[2], C1[3]); \
      _Pragma("unroll") for (int r = 4; r < 16; r += 4) { a = MX3(a, C0[r], C0[r + 1]); b = MX3(b, C0[r + 2], C0[r + 3]); a = MX3(a, C1[r], C1[r + 1]); b = MX3(b, C1[r + 2], C1[r + 3]); } \
      float rm = __builtin_fmaxf(a, b); { auto rr = __builtin_amdgcn_permlane32_swap(__float_as_uint(rm), __float_as_uint(rm), false, false); rm = __builtin_fmaxf(__uint_as_float(rr[0]), __uint_as_float(rr[1])); } \
      resc = false; \
      if (__builtin_expect(__any(rm > (float)THRL), 0)) { const float dl = __builtin_fmaxf(rm, 0.f); mhat += dl; \
        _Pragma("unroll") for (int r = 0; r < 16; ++r) { C0[r] -= dl; C1[r] -= dl; } \
        if (USE_NEGM) { _Pragma("unroll") for (int r = 0; r < 16; ++r) negm[r] = -mhat; asm volatile("" : "+v"(negm)); } \
        const float f = __builtin_amdgcn_exp2f(-dl); l_reg *= f; if (hi == 0) wsf[r32] = f; resc = true; } } \
    ASBAR(); \
    VRD4(1, 2); ASBAR(); GAPB(o[0] = MFMA32(PAF(0), VFR4(0), o[0]), C0, 0); \
    VRD4(5, 3); ASBAR(); GAPB(o[1] = MFMA32(PAF(0), VFR4(1), o[1]), C0, 4); \
    VRD4(2, 0); KRD(GL, 0); GAPB(o[0] = MFMA32(PAF(1), VFR4(2), o[0]), C0, 8); \
    VRD4(6, 1); KRD(GL, 1); GAPB(o[1] = MFMA32(PAF(1), VFR4(3), o[1]), C0, 12); \
    VRD4(3, 2); KRD(GL, 2); GAPB(o[0] = MFMA32(PAF(2), VFR4(0), o[0]), C1, 0); \
    VRD4(7, 3); KRD(GL, 3); GAPB(o[1] = MFMA32(PAF(2), VFR4(1), o[1]), C1, 4); \
    KRD(GL, 4); GAPB(o[0] = MFMA32(PAF(3), VFR4(2), o[0]), C1, 8); \
    KRD(GL, 5); GAPB(o[1] = MFMA32(PAF(3), VFR4(3), o[1]), C1, 12); \
    } while (0)
#define STEP(C0, C1, P0, P1, t, GK, GV, GL, DOMASK) do { if constexpr (DQ == 96) { STEP96(C0, C1, P0, P1, t, GK, GV, GL, DOMASK); } else { STEP64(C0, C1, P0, P1, t, GK, GV, GL, DOMASK); } } while (0)
#define ENDW(tt) do { if ((tt) + 3 < NT) { AWAIT_STEADY(); } else if ((tt) + 2 < NT) { AWAIT_BAR(1); } else { AWAIT_BAR(0); } } while (0)
    int t = 1;
    for (; t < 5 && t + 1 < NT; t += 2) {
        STEP(pB0, pB1, pA0, pA1, t, (t + 3 < NT), (t + 1 < NT), (t + 1 < NT), true);       ENDW(t);     RESC(); ROT();
        STEP(pA0, pA1, pB0, pB1, t + 1, (t + 4 < NT), (t + 2 < NT), (t + 2 < NT), true);   ENDW(t + 1); RESC(); ROT();
    }
    for (; t + 5 < NT; t += 2) {
        STEP(pB0, pB1, pA0, pA1, t, true, true, true, false);     AWAIT_STEADY(); RESC(); ROT();
        STEP(pA0, pA1, pB0, pB1, t + 1, true, true, true, false); AWAIT_STEADY(); RESC(); ROT();
    }
    for (; t + 1 < NT; t += 2) {
        STEP(pB0, pB1, pA0, pA1, t, (t + 3 < NT), (t + 1 < NT), (t + 1 < NT), true);       ENDW(t);     RESC(); ROT();
        STEP(pA0, pA1, pB0, pB1, t + 1, (t + 4 < NT), (t + 2 < NT), (t + 2 < NT), true);   ENDW(t + 1); RESC(); ROT();
    }
    STEP(pB0, pB1, pA0, pA1, NT - 1, false, false, false, true); RESC();
    { float sacc = pB0[0] + pB0[1];
      _Pragma("unroll") for (int r = 2; r < 16; ++r) sacc += pB0[r];
      _Pragma("unroll") for (int r = 0; r < 16; ++r) sacc += pB1[r];
      l_reg += sacc;
      pw0 = (u32x4){PKW(pB0, 0), PKW(pB0, 2), PKW(pB0, 4), PKW(pB0, 6)}; pw1 = (u32x4){PKW(pB0, 8), PKW(pB0, 10), PKW(pB0, 12), PKW(pB0, 14)};
      pw2 = (u32x4){PKW(pB1, 0), PKW(pB1, 2), PKW(pB1, 4), PKW(pB1, 6)}; pw3 = (u32x4){PKW(pB1, 8), PKW(pB1, 10), PKW(pB1, 12), PKW(pB1, 14)};
      ASBAR();
      const int vb = vb0 + sl_cur * VSLOT;
#pragma unroll
      for (int d0 = 0; d0 < 2; ++d0) { s16x4 lo[4], hh[4];
#pragma unroll
          for (int ks = 0; ks < 4; ++ks) {
              asm volatile("ds_read_b64_tr_b16 %0,%1 offset:%c2" : "=&v"(lo[ks]) : "v"(vb), "i"(d0 * 4096 + ks * 1024) : "memory");
              asm volatile("ds_read_b64_tr_b16 %0,%1 offset:%c2" : "=&v"(hh[ks]) : "v"(vb), "i"(d0 * 4096 + ks * 1024 + 512) : "memory"); }
          asm volatile("s_waitcnt lgkmcnt(0)" ::: "memory"); ASBAR();
#define PK(k) (bf16x8){lo[k][0], lo[k][1], lo[k][2], lo[k][3], hh[k][0], hh[k][1], hh[k][2], hh[k][3]}
          o[d0] = MFMA32(PAF(0), PK(0), o[d0]); o[d0] = MFMA32(PAF(1), PK(1), o[d0]); o[d0] = MFMA32(PAF(2), PK(2), o[d0]); o[d0] = MFMA32(PAF(3), PK(3), o[d0]);
#undef PK
      } }
    { auto rr = __builtin_amdgcn_permlane32_swap(__float_as_uint(l_reg), __float_as_uint(l_reg), false, false); l_reg = __uint_as_float(rr[0]) + __uint_as_float(rr[1]); }
    if (hi == 0) wsf[32 + r32] = l_reg; asm volatile("s_waitcnt lgkmcnt(0)" ::: "memory");
    int lane_e = lane; asm volatile("" : "+v"(lane_e)); const int hi_e = lane_e >> 5, r32_e = lane_e & 31;
    float rli[16];
    { const float* wl_ = wsf + 32 + 4 * hi_e;
#pragma unroll
      for (int r = 0; r < 16; ++r) rli[r] = __builtin_amdgcn_rcpf(wl_[(r & 3) + 8 * (r >> 2)]); }
    { bf16_t* stg = (bf16_t*)(shm + LDS_OST + wid * QWAVE);
      bf16_t* stl = stg + (4 * hi_e) * 64 + r32_e;
#pragma unroll
      for (int r = 0; r < 16; ++r) {
#pragma unroll
          for (int d0 = 0; d0 < 2; ++d0) stl[((r & 3) + 8 * (r >> 2)) * 64 + d0 * 32] = f2bf(o[d0][r] * rli[r]); }
      asm volatile("s_waitcnt lgkmcnt(0)" ::: "memory");
#pragma unroll
      for (int i = 0; i < 4; ++i) { const int row = i * 8 + (lane_e >> 3), ch = lane_e & 7; const u32x4 v = *(const u32x4*)(stg + row * 64 + ch * 8);
          bf16_t* dst = GQA4 ? (A.obase + (long)(8 * wid + (row >> 2)) * A.opitch + (row & 3) * 64) : (A.obase + (long)(32 * wid + row) * A.opitch);
          *(u32x4*)(dst + ch * 8) = v; } }
    asm volatile("s_waitcnt lgkmcnt(0)\n\ts_barrier" ::: "memory");
#undef TILE_OF
#undef DMA_K
#undef DMA_V
#undef CMASK
#undef CINIT
#undef START
#undef RESC
#undef ROT
#undef PKW
#undef PAF
#undef VFR
#undef PIN
#undef MX3
#undef GAPA
#undef GAPB
#undef EX
#undef VRD
#undef KRD
#undef MFMA32
#undef STEP
#undef STEP64
#undef STEP96
#undef VRD4
#undef VFR4
#undef GAPQ
#undef QL
#undef ENDW
#undef AWAIT_STEADY
}
}
constexpr int MK_THREADS = 512;
constexpr int LDS_RING = 131072;
constexpr int LDS_X = LDS_RING;
constexpr int LDS_MOD = LDS_RING + 8192;
constexpr int LDS_BARST = 155648 - 16;
constexpr int LDS_TOTAL = 155648;

#define C2Q 0.18033688011112042f
#define LOG2E 1.4426950408889634f

struct BlkDesc { bf16_t* dst; const float* gain; int pitch; int flags; float scale; int csoff; };
#define C2M 0.14724312203508865f
struct MKP {
    const float* in[34];
    float* out;
    float* modpart;
    float* mod;
    float* cosT; float* sinT;
    bf16_t* W_in0t;
    bf16_t* W_out0t;
    bf16_t* XN;
    bf16_t* OATT;
    bf16_t* QN;
    bf16_t* KV6;
    bf16_t* FQ; bf16_t* FK; bf16_t* FV;
    float* GATES;
    float* LOGF;
    BlkDesc* desc0;
    float* CUMB;
    BlkDesc* desc_uq;
    BlkDesc* desc_ukv;
    bf16_t* W_in1t;
    bf16_t* W_uqt;
    bf16_t* W_ukvt;
    bf16_t* W_out1t;
    bf16_t* P1;
    bf16_t* CQN;
    bf16_t* CKVN;
    bf16_t* Q96;
    bf16_t* K96;
    bf16_t* V1;
    bf16_t* WcT;
    float* CBIAS;
    bf16_t* KCMP;
    bf16_t* VCT;
    bf16_t* KSLF;
    bf16_t* VSLF;
    bf16_t* OCMP;
    bf16_t* OWIN;
    const int* pos;
    bf16_t* Wgu;
    bf16_t* Wd;
    bf16_t* HID;
    bf16_t* YBUF;
    int* gcnt;
    int* list;
    float* ew;
    unsigned* barw;
    int ph_lo, ph_hi, dbg_flags, pad_;
};

__device__ __forceinline__ int swap45(int p) { return (p & 15) | ((p & 16) << 1) | ((p & 32) >> 1); }

template <class Map>
__device__ __forceinline__ void tr_item(const float* __restrict__ W, int ldw, int K, bf16_t* WT, LAS float* scr, int kb, int nb, int lane, const Map& cmap, const float* kscale) {
    const int k0 = 64 * kb, n0 = 32 * nb;
    const int sc = cmap(n0 + (lane & 31));
    float v[32];
    const float* src = W + (size_t)(k0 + (lane >> 5)) * ldw + (sc >= 0 ? sc : 0);
#pragma unroll
    for (int i = 0; i < 32; ++i) v[i] = src[(size_t)(2 * i) * ldw];
    if (kscale) {
#pragma unroll
        for (int i = 0; i < 32; ++i) v[i] *= kscale[k0 + 2 * i + (lane >> 5)];
    }
#pragma unroll
    for (int i = 0; i < 32; ++i) scr[(2 * i + (lane >> 5)) * 33 + (lane & 31)] = (sc >= 0) ? v[i] : 0.f;
    asm volatile("s_waitcnt lgkmcnt(0)" ::: "memory");
    const int c = lane & 7;
#pragma unroll
    for (int j = 0; j < 4; ++j) {
        const int n = (lane >> 3) + 8 * j; const LAS float* s = scr + (8 * c) * 33 + n;
        u32x4 o; o.x = cvtpk(s[0 * 33], s[1 * 33]); o.y = cvtpk(s[2 * 33], s[3 * 33]); o.z = cvtpk(s[4 * 33], s[5 * 33]); o.w = cvtpk(s[6 * 33], s[7 * 33]);
        *(u32x4*)(WT + (size_t)(n0 + n) * K + k0 + 8 * c) = o;
    }
    asm volatile("s_waitcnt lgkmcnt(0)" ::: "memory");
}
struct MapIn0 {
    __device__ __forceinline__ int operator()(int nn) const {
        const int blk = nn >> 6, p = nn & 63;
        if (blk < 8) return blk * 64 + swap45(p);
        if (blk < 20) return 512 + (blk - 8) * 64 + swap45(p);
        if (blk < 44) return 1304 + (blk - 20) * 64 + swap45(p);
        if (blk == 44) { if (p < 24) return 1280 + p; if (p < 32) return 2840 + (p - 24); return -1; }
        return -1;
    }
};
struct MapId { __device__ __forceinline__ int operator()(int nn) const { return nn; } };
struct MapIn1 { __device__ __forceinline__ int operator()(int nn) const { return nn < 672 ? nn : -1; } };
struct MapUq { __device__ __forceinline__ int operator()(int nn) const { if (nn < 1024) return (nn >> 6) * 96 + swap45(nn & 63); const int r = nn - 1024; return (r >> 5) * 96 + 64 + (r & 31); } };
struct MapUkv { __device__ __forceinline__ int operator()(int nn) const { if (nn < 1024) return (nn >> 6) * 128 + swap45(nn & 63); const int r = nn - 1024; return (r >> 6) * 128 + 64 + swap45(r & 63); } };

namespace nsa {
using att::f32x16; using att::crow;
#define NMFMA32(a, b, c) __builtin_amdgcn_mfma_f32_32x32x16_bf16(a, b, c, 0, 0, 0)
#define NMFMA16(a, b, c) __builtin_amdgcn_mfma_f32_16x16x32_bf16(a, b, c, 0, 0, 0)
#define RLF(x, l) __uint_as_float(__builtin_amdgcn_readlane((int)__float_as_uint(x), (l)))

__device__ __forceinline__ void compress_job(const MKP& p, LAS float* scr, LAS float* part, int job, int slice, int lane) {
    const int nt = job & 31, g = (job >> 5) & 1, kv = job >> 6;
    const int r32 = lane & 31, hi = lane >> 5, n0 = nt * 32;
    const bf16_t* tok = p.KV6 + (size_t)(kv * 2 + g) * S_ * 64;
    const bf16_t* wt = p.WcT + (size_t)kv * 64 * 2048;
    scr[lane] = p.CBIAS[kv * 64 + lane];
    asm volatile("s_waitcnt lgkmcnt(0)" ::: "memory");
    int nrow = n0 + r32; if (nrow > 1022) nrow = 1022;
    const bf16_t* ta = tok + (size_t)(16 * nrow) * 64 + 8 * hi;
    const bf16_t* wa0 = wt + (size_t)r32 * 2048 + 8 * hi;
    const bf16_t* wa1 = wa0 + (size_t)32 * 2048;
    f32x16 c0 = f32x16{}, c1 = f32x16{};
    if (kv == 0) {
#pragma unroll 8
        for (int s = 32 * slice; s < 32 * slice + 32; ++s) {
            const bf16x8 tf = *(const bf16x8*)(ta + 16 * s), w0 = *(const bf16x8*)(wa0 + 16 * s), w1 = *(const bf16x8*)(wa1 + 16 * s);
            c0 = NMFMA32(w0, tf, c0); c1 = NMFMA32(w1, tf, c1);
        }
        if (slice) {
#pragma unroll
            for (int r = 0; r < 16; ++r) { part[r * 64 + lane] = c0[r]; part[(16 + r) * 64 + lane] = c1[r]; } }
        __syncthreads();
        if (slice) return;
#pragma unroll
        for (int q = 1; q < 4; ++q)
#pragma unroll
            for (int r = 0; r < 16; ++r) { c0[r] += part[q * 2048 + r * 64 + lane]; c1[r] += part[q * 2048 + (16 + r) * 64 + lane]; }
        float ss = 0.f;
#pragma unroll
        for (int r = 0; r < 16; ++r) { c0[r] += scr[crow(r, hi)]; c1[r] += scr[32 + crow(r, hi)]; ss += c0[r] * c0[r] + c1[r] * c1[r]; }
        { auto rr = __builtin_amdgcn_permlane32_swap(__float_as_uint(ss), __float_as_uint(ss), false, false); ss = __uint_as_float(rr[0]) + __uint_as_float(rr[1]); }
        const float rs = rsqrtf(ss * (1.f / 64.f) + EPSF);
        const float* gn = p.in[10];
        if (n0 + r32 < 1023) {
            bf16_t* dst = p.KCMP + ((size_t)g * 1024 + n0 + r32) * 64;
#pragma unroll
            for (int q = 0; q < 4; ++q) {
                const int e0 = 8 * q + 4 * hi;
                const f32x4 ga = *(const f32x4*)(gn + e0), gb = *(const f32x4*)(gn + 32 + e0);
                u32x2 wa, wb;
                wa.x = cvtpk(c0[4 * q] * rs * ga.x, c0[4 * q + 1] * rs * ga.y); wa.y = cvtpk(c0[4 * q + 2] * rs * ga.z, c0[4 * q + 3] * rs * ga.w);
                wb.x = cvtpk(c1[4 * q] * rs * gb.x, c1[4 * q + 1] * rs * gb.y); wb.y = cvtpk(c1[4 * q + 2] * rs * gb.z, c1[4 * q + 3] * rs * gb.w);
                *(u32x2*)(dst + e0) = wa; *(u32x2*)(dst + 32 + e0) = wb;
            }
        }
    } else {
#pragma unroll 8
        for (int s = 32 * slice; s < 32 * slice + 32; ++s) {
            const bf16x8 tf = *(const bf16x8*)(ta + 16 * s), w0 = *(const bf16x8*)(wa0 + 16 * s), w1 = *(const bf16x8*)(wa1 + 16 * s);
            c0 = NMFMA32(tf, w0, c0); c1 = NMFMA32(tf, w1, c1);
        }
        if (slice) {
#pragma unroll
            for (int r = 0; r < 16; ++r) { part[r * 64 + lane] = c0[r]; part[(16 + r) * 64 + lane] = c1[r]; } }
        __syncthreads();
        if (slice) return;
#pragma unroll
        for (int q = 1; q < 4; ++q)
#pragma unroll
            for (int r = 0; r < 16; ++r) { c0[r] += part[q * 2048 + r * 64 + lane]; c1[r] += part[q * 2048 + (16 + r) * 64 + lane]; }
        const float b0 = scr[r32], b1 = scr[32 + r32];
#pragma unroll
        for (int G = 0; G < 2; ++G) {
            u32x4 va, vb;
            va.x = cvtpk(c0[8 * G] + b0, c0[8 * G + 1] + b0); va.y = cvtpk(c0[8 * G + 2] + b0, c0[8 * G + 3] + b0); va.z = cvtpk(c0[8 * G + 4] + b0, c0[8 * G + 5] + b0); va.w = cvtpk(c0[8 * G + 6] + b0, c0[8 * G + 7] + b0);
            vb.x = cvtpk(c1[8 * G] + b1, c1[8 * G + 1] + b1); vb.y = cvtpk(c1[8 * G + 2] + b1, c1[8 * G + 3] + b1); vb.z = cvtpk(c1[8 * G + 4] + b1, c1[8 * G + 5] + b1); vb.w = cvtpk(c1[8 * G + 6] + b1, c1[8 * G + 7] + b1);
            *(u32x4*)(p.VCT + ((size_t)g * 64 + r32) * 1024 + n0 + 16 * G + 8 * hi) = va;
            *(u32x4*)(p.VCT + ((size_t)g * 64 + 32 + r32) * 1024 + n0 + 16 * G + 8 * hi) = vb;
        }
    }
    asm volatile("s_waitcnt lgkmcnt(0)" ::: "memory");
}

__device__ __forceinline__ unsigned pk4_fp8(float a, float b, float c, float d) { int w = __builtin_amdgcn_cvt_pk_fp8_f32(a, b, 0, false); w = __builtin_amdgcn_cvt_pk_fp8_f32(c, d, w, true); return (unsigned)w; }
__device__ __forceinline__ void slcfrag_job(const MKP& p, int job, int lane) {
    const int g = job >> 8, blk = job & 255, c16 = lane & 15, u = lane >> 4;
    const bf16_t* k = p.KV6 + (size_t)(2 * 2 + g) * S_ * 64 + (size_t)blk * 64 * 64;
    const bf16_t* v = p.KV6 + (size_t)(3 * 2 + g) * S_ * 64 + (size_t)blk * 64 * 64;
    unsigned char* kd = (unsigned char*)p.KSLF + ((size_t)g * 256 + blk) * 4096 + lane * 16;
    unsigned char* vd = (unsigned char*)p.VSLF + ((size_t)g * 256 + blk) * 4096 + lane * 16;
#pragma unroll
    for (int kg = 0; kg < 4; ++kg) {
        const u32x4 a = *(const u32x4*)(k + (size_t)(16 * kg + c16) * 64 + 8 * u), b = *(const u32x4*)(k + (size_t)(16 * kg + c16) * 64 + 32 + 8 * u);
        u32x4 o;
        o.x = pk4_fp8(__uint_as_float(a.x << 16), __uint_as_float(a.x & 0xffff0000u), __uint_as_float(a.y << 16), __uint_as_float(a.y & 0xffff0000u));
        o.y = pk4_fp8(__uint_as_float(a.z << 16), __uint_as_float(a.z & 0xffff0000u), __uint_as_float(a.w << 16), __uint_as_float(a.w & 0xffff0000u));
        o.z = pk4_fp8(__uint_as_float(b.x << 16), __uint_as_float(b.x & 0xffff0000u), __uint_as_float(b.y << 16), __uint_as_float(b.y & 0xffff0000u));
        o.w = pk4_fp8(__uint_as_float(b.z << 16), __uint_as_float(b.z & 0xffff0000u), __uint_as_float(b.w << 16), __uint_as_float(b.w & 0xffff0000u));
        *(u32x4*)(kd + kg * 1024) = o;
    }
#pragma unroll
    for (int dg = 0; dg < 4; ++dg) {
        float x[16];
#pragma unroll
        for (int ch = 0; ch < 2; ++ch)
#pragma unroll
            for (int j = 0; j < 8; ++j) { const int key = 32 * ch + ((j < 4) ? 4 * u + j : 16 + 4 * u + (j - 4)); x[ch * 8 + j] = bf2f(v[(size_t)key * 64 + 16 * dg + c16]); }
        u32x4 o; o.x = pk4_fp8(x[0], x[1], x[2], x[3]); o.y = pk4_fp8(x[4], x[5], x[6], x[7]); o.z = pk4_fp8(x[8], x[9], x[10], x[11]); o.w = pk4_fp8(x[12], x[13], x[14], x[15]);
        *(u32x4*)(vd + dg * 1024) = o;
    }
}

constexpr int IMP_LD = 272;
__device__ __forceinline__ void cmp_wave(const MKP& p, int g, int t0w, LAS float* imp, LAS unsigned char* stg, int lane) {
    const int r32 = lane & 31, hi = lane >> 5;
    const int tq = t0w + (r32 >> 2), head = g * 4 + (r32 & 3);
    const int nmax = (tq >= 31) ? ((tq - 31) >> 4) : -1;
    const int nmaxw = (t0w + 7 >= 31) ? ((t0w + 7 - 31) >> 4) : -1;
    const int ntile = (nmaxw >> 6) + 1;
    for (int i = lane; i < 8 * IMP_LD; i += 64) imp[i] = 0.f;
    bf16x8 qr[4];
#pragma unroll
    for (int d0 = 0; d0 < 4; ++d0) qr[d0] = *(const bf16x8*)(p.QN + (size_t)tq * 512 + head * 64 + d0 * 16 + hi * 8);
    const bf16_t* kc = p.KCMP + (size_t)g * 1024 * 64 + (size_t)r32 * 64 + 8 * hi;
    bf16x8 ovf[4];
#pragma unroll
    for (int ks = 0; ks < 4; ++ks)
#pragma unroll
        for (int j = 0; j < 8; ++j) {
            const int nrel = 16 * ks + ((j < 4) ? 4 * hi + j : 8 + 4 * hi + (j - 4));
            const int dlt = nrel - 4 * r32;
            const float w = (dlt >= 0 && dlt <= 2) ? 2.f : ((dlt == 3 || dlt == -1) ? 1.f : 0.f);
            ovf[ks][j] = (short)f2bf(w);
        }
#define CKLOAD(dst, c_) do { const bf16_t* kt_ = kc + (size_t)(c_) * 64 * 64; _Pragma("unroll") for (int d0_ = 0; d0_ < 4; ++d0_) { dst[2 * d0_] = *(const bf16x8*)(kt_ + 16 * d0_); dst[2 * d0_ + 1] = *(const bf16x8*)(kt_ + 32 * 64 + 16 * d0_); } } while (0)
#define CQK(s0, s1, kf) do { s0 = f32x16{}; s1 = f32x16{}; _Pragma("unroll") for (int d0_ = 0; d0_ < 4; ++d0_) { s0 = NMFMA32(kf[2 * d0_], qr[d0_], s0); s1 = NMFMA32(kf[2 * d0_ + 1], qr[d0_], s1); } } while (0)
    float m = -INFINITY, l = 0.f;
    bf16x8 kfa[8], kfb[8];
    if (ntile > 0) CKLOAD(kfa, 0);
#define CMP_P1(KC, KN, c) do { { const int cn_ = ((c) + 1 < ntile) ? (c) + 1 : ntile - 1; CKLOAD(KN, cn_); } \
        f32x16 s0, s1; CQK(s0, s1, KC); \
        const int x = nmax - 64 * (c) - 4 * hi; float tm = -INFINITY; \
        _Pragma("unroll") for (int r = 0; r < 16; ++r) { const int cc = (r & 3) + 8 * (r >> 2); if (cc > x) s0[r] = -INFINITY; if (cc + 32 > x) s1[r] = -INFINITY; tm = fmaxf(tm, fmaxf(s0[r], s1[r])); } \
        if (tm > m) { l *= __builtin_amdgcn_exp2f(m - tm); m = tm; } \
        if (m > -INFINITY) { float sum = 0.f; _Pragma("unroll") for (int r = 0; r < 16; ++r) sum += __builtin_amdgcn_exp2f(s0[r] - m) + __builtin_amdgcn_exp2f(s1[r] - m); l += sum; } } while (0)
#pragma unroll 1
    for (int c = 0; c < ntile; c += 2) { CMP_P1(kfa, kfb, c); if (c + 1 < ntile) CMP_P1(kfb, kfa, c + 1); }
    { auto rm = __builtin_amdgcn_permlane32_swap(__float_as_uint(m), __float_as_uint(m), false, false);
      auto rl = __builtin_amdgcn_permlane32_swap(__float_as_uint(l), __float_as_uint(l), false, false);
      const float ma = __uint_as_float(rm[0]), mb = __uint_as_float(rm[1]), la = __uint_as_float(rl[0]), lb = __uint_as_float(rl[1]);
      const float mm = fmaxf(ma, mb);
      if (mm > -INFINITY) { l = ((ma > -INFINITY) ? la * __builtin_amdgcn_exp2f(ma - mm) : 0.f) + ((mb > -INFINITY) ? lb * __builtin_amdgcn_exp2f(mb - mm) : 0.f); m = mm; }
      else { l = 0.f; m = 0.f; } }
    const float invl = (l > 0.f) ? 1.f / l : 0.f;
    f32x16 o0 = f32x16{}, o1 = f32x16{};
    const bf16_t* vc = p.VCT + (size_t)g * 64 * 1024 + (size_t)r32 * 1024 + 8 * hi;
    if (ntile > 0) CKLOAD(kfa, 0);
    bf16x8 vfr[8];
#define CMP_P2(KC, KN, c) do { \
        { const bf16_t* vt_ = vc + (c) * 64; _Pragma("unroll") for (int ks_ = 0; ks_ < 4; ++ks_) { vfr[2 * ks_] = *(const bf16x8*)(vt_ + 16 * ks_); vfr[2 * ks_ + 1] = *(const bf16x8*)(vt_ + 32 * 1024 + 16 * ks_); } } \
        { const int cn_ = ((c) + 1 < ntile) ? (c) + 1 : ntile - 1; CKLOAD(KN, cn_); } \
        f32x16 s0, s1; CQK(s0, s1, KC); \
        const int x = nmax - 64 * (c) - 4 * hi; \
        _Pragma("unroll") for (int r = 0; r < 16; ++r) { const int cc = (r & 3) + 8 * (r >> 2); \
            s0[r] = (cc > x) ? 0.f : __builtin_amdgcn_exp2f(s0[r] - m) * invl; s1[r] = (cc + 32 > x) ? 0.f : __builtin_amdgcn_exp2f(s1[r] - m) * invl; } \
        u32x4 pw[4]; \
        pw[0] = (u32x4){cvtpk(s0[0], s0[1]), cvtpk(s0[2], s0[3]), cvtpk(s0[4], s0[5]), cvtpk(s0[6], s0[7])}; \
        pw[1] = (u32x4){cvtpk(s0[8], s0[9]), cvtpk(s0[10], s0[11]), cvtpk(s0[12], s0[13]), cvtpk(s0[14], s0[15])}; \
        pw[2] = (u32x4){cvtpk(s1[0], s1[1]), cvtpk(s1[2], s1[3]), cvtpk(s1[4], s1[5]), cvtpk(s1[6], s1[7])}; \
        pw[3] = (u32x4){cvtpk(s1[8], s1[9]), cvtpk(s1[10], s1[11]), cvtpk(s1[12], s1[13]), cvtpk(s1[14], s1[15])}; \
        f32x16 im = f32x16{}; \
        _Pragma("unroll") for (int ks = 0; ks < 4; ++ks) { const bf16x8 pa = __builtin_bit_cast(bf16x8, pw[ks]); \
            o0 = NMFMA32(pa, vfr[2 * ks], o0); o1 = NMFMA32(pa, vfr[2 * ks + 1], o1); im = NMFMA32(pa, ovf[ks], im); } \
        if (r32 <= 16 && 16 * (c) + r32 < 256) { \
            _Pragma("unroll") for (int k = 0; k < 4; ++k) { const float v = (im[4 * k] + im[4 * k + 1]) + (im[4 * k + 2] + im[4 * k + 3]); atomicAdd((float*)(imp + (2 * k + hi) * IMP_LD + 16 * (c) + r32), v); } } } while (0)
#pragma unroll 1
    for (int c = 0; c < ntile; c += 2) { CMP_P2(kfa, kfb, c); if (c + 1 < ntile) CMP_P2(kfb, kfa, c + 1); }
#undef CMP_P1
#undef CMP_P2
#undef CKLOAD
#undef CQK
    { bf16_t* st = (bf16_t*)stg; bf16_t* stl = st + (4 * hi) * 64 + r32;
#pragma unroll
      for (int r = 0; r < 16; ++r) { stl[((r & 3) + 8 * (r >> 2)) * 64] = f2bf(o0[r]); stl[((r & 3) + 8 * (r >> 2)) * 64 + 32] = f2bf(o1[r]); }
      asm volatile("s_waitcnt lgkmcnt(0)" ::: "memory");
#pragma unroll
      for (int i = 0; i < 4; ++i) { const int row = i * 8 + (lane >> 3), ch = lane & 7; const u32x4 v = *(const u32x4*)(st + row * 64 + ch * 8);
          *(u32x4*)(p.OCMP + (size_t)(t0w + (row >> 2)) * 512 + (g * 4 + (row & 3)) * 64 + ch * 8) = v; }
      asm volatile("s_waitcnt lgkmcnt(0)" ::: "memory"); }
}

__device__ __forceinline__ float dpp_f(float v, int ctrl_sel) {
    const int x = __float_as_int(v);
    int r;
    if (ctrl_sel == 0) r = __builtin_amdgcn_update_dpp(x, x, 0xB1, 0xF, 0xF, false);
    else if (ctrl_sel == 1) r = __builtin_amdgcn_update_dpp(x, x, 0x4E, 0xF, 0xF, false);
    else if (ctrl_sel == 2) r = __builtin_amdgcn_update_dpp(x, x, 0x124, 0xF, 0xF, false);
    else r = __builtin_amdgcn_update_dpp(x, x, 0x128, 0xF, 0xF, false);
    return __int_as_float(r);
}
__device__ __forceinline__ int dpp_i(int x, int ctrl_sel) {
    if (ctrl_sel == 0) return __builtin_amdgcn_update_dpp(x, x, 0xB1, 0xF, 0xF, false);
    if (ctrl_sel == 1) return __builtin_amdgcn_update_dpp(x, x, 0x4E, 0xF, 0xF, false);
    if (ctrl_sel == 2) return __builtin_amdgcn_update_dpp(x, x, 0x124, 0xF, 0xF, false);
    return __builtin_amdgcn_update_dpp(x, x, 0x128, 0xF, 0xF, false);
}
__device__ __forceinline__ void select_wave(int t0w, const LAS float* imp, LAS int* sel, int lane) {
    const int sub = lane & 31;
#pragma unroll 1
    for (int h = 0; h < 4; ++h) {
        const int tk = 2 * h + (lane >> 5);
        const int tq = t0w + tk, cur = tq >> 6;
        float v[8];
#pragma unroll
        for (int i = 0; i < 8; ++i) { const int j = sub + 32 * i; float x = imp[tk * IMP_LD + j]; if (j == 0 || j == cur || j == cur - 1) x += 1e6f; v[i] = (j <= cur) ? x : -INFINITY; }
#pragma unroll 1
        for (int it = 0; it < 16; ++it) {
            float bv = v[0]; int bi = 0;
#pragma unroll
            for (int i = 1; i < 8; ++i) if (v[i] > bv) { bv = v[i]; bi = i; }
            float gm = bv;
#pragma unroll
            for (int c = 0; c < 4; ++c) gm = fmaxf(gm, dpp_f(gm, c));
            gm = fmaxf(gm, __shfl_xor(gm, 16));
            int cj = (bv == gm) ? sub + 32 * bi : 0x7fffffff;
#pragma unroll
            for (int c = 0; c < 4; ++c) cj = min(cj, dpp_i(cj, c));
            cj = min(cj, __shfl_xor(cj, 16));
            const bool any = gm > -INFINITY;
            if (sub == 0) sel[tk * 16 + it] = any ? cj : -1;
            if (any && (cj & 31) == sub) { const int wi = cj >> 5;
#pragma unroll
                for (int i = 0; i < 8; ++i) if (i == wi) v[i] = -INFINITY; }
        }
    }
    asm volatile("s_waitcnt lgkmcnt(0)" ::: "memory");
}

__device__ __forceinline__ void slc_wave(const MKP& p, int g, int t0w, const LAS int* sel, LAS float* oslc, int lane) {
    const int c16 = lane & 15, u = lane >> 4, ti = c16 >> 2;
    const unsigned char* kb = (const unsigned char*)p.KSLF + (size_t)g * 256 * 4096 + lane * 16;
    const unsigned char* vb = (const unsigned char*)p.VSLF + (size_t)g * 256 * 4096 + lane * 16;
#define LO64(vv_) ((long)(((unsigned long long)(vv_).y << 32) | (vv_).x))
#define HI64(vv_) ((long)(((unsigned long long)(vv_)[3] << 32) | (vv_).z))
#define FMFMA(a, b, c) __builtin_amdgcn_mfma_f32_16x16x32_fp8_fp8(a, b, c, 0, 0, 0)
#define KLOAD4(r_) do { _Pragma("unroll") for (int i_ = 0; i_ < 4; ++i_) { int b_ = sel[(tg * 4 + i_) * 16 + (r_)]; b_ = b_ < 0 ? 0 : b_; const unsigned char* kp_ = kb + (size_t)b_ * 4096; \
        _Pragma("unroll") for (int f_ = 0; f_ < 4; ++f_) kc[i_][f_] = *(const u32x4*)(kp_ + f_ * 1024); } } while (0)
#pragma unroll 1
    for (int tg = 0; tg < 2; ++tg) {
        const int tq = t0w + tg * 4 + ti;
        long qa, qb2;
        { const bf16_t* qp = p.QN + (size_t)tq * 512 + (g * 4 + (c16 & 3)) * 64 + 8 * u;
          const u32x4 r0 = *(const u32x4*)qp, r1 = *(const u32x4*)(qp + 32);
          const unsigned a0 = pk4_fp8(8.f * __uint_as_float(r0.x << 16), 8.f * __uint_as_float(r0.x & 0xffff0000u), 8.f * __uint_as_float(r0.y << 16), 8.f * __uint_as_float(r0.y & 0xffff0000u));
          const unsigned a1 = pk4_fp8(8.f * __uint_as_float(r0.z << 16), 8.f * __uint_as_float(r0.z & 0xffff0000u), 8.f * __uint_as_float(r0.w << 16), 8.f * __uint_as_float(r0.w & 0xffff0000u));
          const unsigned b0 = pk4_fp8(8.f * __uint_as_float(r1.x << 16), 8.f * __uint_as_float(r1.x & 0xffff0000u), 8.f * __uint_as_float(r1.y << 16), 8.f * __uint_as_float(r1.y & 0xffff0000u));
          const unsigned b1 = pk4_fp8(8.f * __uint_as_float(r1.z << 16), 8.f * __uint_as_float(r1.z & 0xffff0000u), 8.f * __uint_as_float(r1.w << 16), 8.f * __uint_as_float(r1.w & 0xffff0000u));
          qa = (long)(((unsigned long long)a1 << 32) | a0); qb2 = (long)(((unsigned long long)b1 << 32) | b0); }
        long q0[4], q1[4];
#pragma unroll
        for (int i = 0; i < 4; ++i) { q0[i] = (ti == i) ? qa : 0; q1[i] = (ti == i) ? qb2 : 0; }
        u32x4 kc[4][4], vf[4][4];
        KLOAD4(0);
        float m = -INFINITY, l = 0.f;
        f32x4 o[4]; o[0] = o[1] = o[2] = o[3] = (f32x4){0.f, 0.f, 0.f, 0.f};
#pragma unroll 1
        for (int r = 0; r < 16; ++r) {
#pragma unroll
            for (int i = 0; i < 4; ++i) { int b_ = sel[(tg * 4 + i) * 16 + r]; b_ = b_ < 0 ? 0 : b_; const unsigned char* vp = vb + (size_t)b_ * 4096;
#pragma unroll
                for (int dg = 0; dg < 4; ++dg) vf[i][dg] = *(const u32x4*)(vp + dg * 1024); }
            f32x4 s[4];
#pragma unroll
            for (int kg = 0; kg < 4; ++kg) { f32x4 c = (f32x4){0.f, 0.f, 0.f, 0.f};
#pragma unroll
                for (int i = 0; i < 4; ++i) { c = FMFMA(LO64(kc[i][kg]), q0[i], c); c = FMFMA(HI64(kc[i][kg]), q1[i], c); }
                s[kg] = c * 0.125f; }
            { const int rn = (r < 15) ? r + 1 : 15; KLOAD4(rn); }
            const int myblk = sel[(tg * 4 + ti) * 16 + r];
            { const int x = (myblk < 0) ? -1 : ((myblk == (tq >> 6)) ? tq - 64 * myblk - 4 * u : 64);
#pragma unroll
              for (int kg = 0; kg < 4; ++kg) { if (16 * kg > x) s[kg].x = -INFINITY; if (16 * kg + 1 > x) s[kg].y = -INFINITY; if (16 * kg + 2 > x) s[kg].z = -INFINITY; if (16 * kg + 3 > x) s[kg].w = -INFINITY; } }
            float tm = -INFINITY;
#pragma unroll
            for (int kg = 0; kg < 4; ++kg) tm = fmaxf(tm, fmaxf(fmaxf(s[kg].x, s[kg].y), fmaxf(s[kg].z, s[kg].w)));
            tm = fmaxf(tm, __shfl_xor(tm, 16)); tm = fmaxf(tm, __shfl_xor(tm, 32));
            float alpha = 1.f;
            if (tm > m) { alpha = __builtin_amdgcn_exp2f(m - tm); m = tm; }
            l *= alpha;
            float sum = 0.f;
#pragma unroll
            for (int kg = 0; kg < 4; ++kg) { s[kg].x = __builtin_amdgcn_exp2f(s[kg].x - m); s[kg].y = __builtin_amdgcn_exp2f(s[kg].y - m); s[kg].z = __builtin_amdgcn_exp2f(s[kg].z - m); s[kg].w = __builtin_amdgcn_exp2f(s[kg].w - m);
                sum += (s[kg].x + s[kg].y) + (s[kg].z + s[kg].w); }
            l += sum;
            { const float a0 = __shfl(alpha, 4 * u), a1 = __shfl(alpha, 4 * u + 1), a2 = __shfl(alpha, 4 * u + 2), a3 = __shfl(alpha, 4 * u + 3);
#pragma unroll
              for (int dg = 0; dg < 4; ++dg) { o[dg].x *= a0; o[dg].y *= a1; o[dg].z *= a2; o[dg].w *= a3; } }
#pragma unroll
            for (int ch = 0; ch < 2; ++ch) {
                const f32x4 pa_ = s[2 * ch] * 128.f, pb_ = s[2 * ch + 1] * 128.f;
                const unsigned lo_ = pk4_fp8(pa_.x, pa_.y, pa_.z, pa_.w), hi_ = pk4_fp8(pb_.x, pb_.y, pb_.z, pb_.w);
                const long pa = (long)(((unsigned long long)hi_ << 32) | lo_);
#pragma unroll
                for (int i = 0; i < 4; ++i) { const long pi = (ti == i) ? pa : 0;
#pragma unroll
                    for (int dg = 0; dg < 4; ++dg) o[dg] = FMFMA(pi, ch ? HI64(vf[i][dg]) : LO64(vf[i][dg]), o[dg]); }
            }
        }
        { float lt = l; lt += __shfl_xor(lt, 16); lt += __shfl_xor(lt, 32);
          const float il = (lt > 0.f) ? (1.f / 128.f) / lt : 0.f;
          const float i0 = __shfl(il, 4 * u), i1 = __shfl(il, 4 * u + 1), i2 = __shfl(il, 4 * u + 2), i3 = __shfl(il, 4 * u + 3);
          LAS float* op = oslc + (tg * 4 + u) * 256 + c16;
#pragma unroll
          for (int dg = 0; dg < 4; ++dg) { op[16 * dg] = o[dg].x * i0; op[64 + 16 * dg] = o[dg].y * i1; op[128 + 16 * dg] = o[dg].z * i2; op[192 + 16 * dg] = o[dg].w * i3; } }
    }
#undef KLOAD4
#undef LO64
#undef HI64
#undef FMFMA
    asm volatile("s_waitcnt lgkmcnt(0)" ::: "memory");
    {
        const int tkl = lane >> 3, cc = (lane & 7) * 32, hh = cc >> 6;
        const int tq = t0w + tkl;
        const float* gt = p.GATES + (size_t)tq * 24 + (g * 4 + hh) * 3;
        const float gc = 1.f / (1.f + __expf(-gt[0])), gs = 1.f / (1.f + __expf(-gt[1])), gw = 1.f / (1.f + __expf(-gt[2]));
        const size_t col = (size_t)tq * 512 + g * 256 + cc;
        const LAS float* os = oslc + tkl * 256 + cc;
#pragma unroll
        for (int q = 0; q < 4; ++q) {
            const u32x4 wc = *(const u32x4*)(p.OCMP + col + 8 * q), ww = *(const u32x4*)(p.OWIN + col + 8 * q);
            const f32x4 sa = *(const LAS f32x4*)(os + 8 * q), sb = *(const LAS f32x4*)(os + 8 * q + 4);
            u32x4 r;
            r.x = cvtpk(gs * sa.x + gc * __uint_as_float(wc.x << 16) + gw * __uint_as_float(ww.x << 16), gs * sa.y + gc * __uint_as_float(wc.x & 0xffff0000u) + gw * __uint_as_float(ww.x & 0xffff0000u));
            r.y = cvtpk(gs * sa.z + gc * __uint_as_float(wc.y << 16) + gw * __uint_as_float(ww.y << 16), gs * sa.w + gc * __uint_as_float(wc.y & 0xffff0000u) + gw * __uint_as_float(ww.y & 0xffff0000u));
            r.z = cvtpk(gs * sb.x + gc * __uint_as_float(wc.z << 16) + gw * __uint_as_float(ww.z << 16), gs * sb.y + gc * __uint_as_float(wc.z & 0xffff0000u) + gw * __uint_as_float(ww.z & 0xffff0000u));
            r.w = cvtpk(gs * sb.z + gc * __uint_as_float(wc.w << 16) + gw * __uint_as_float(ww.w << 16), gs * sb.w + gc * __uint_as_float(wc.w & 0xffff0000u) + gw * __uint_as_float(ww.w & 0xffff0000u));
            *(u32x4*)(p.OATT + (size_t)tq * 1024 + g * 256 + cc + 8 * q) = r;
        }
    }
}

__device__ __forceinline__ void nsa_unit(const MKP& p, char* shm, int g, int tile) {
    int tid_ = threadIdx.x; asm volatile("" : "+v"(tid_));
    const int tid = tid_, lane = tid & 63, r32 = lane & 31; const int wid = __builtin_amdgcn_readfirstlane(tid >> 6);
    const int t0 = tile * 64;
    {   att::UnitArgs A;
        A.qrow = p.QN + (size_t)(t0 + 8 * wid + (r32 >> 2)) * 512 + (g * 4 + (r32 & 3)) * 64;
        A.K = p.KV6 + (size_t)(4 * 2 + g) * S_ * 64; A.V = p.KV6 + (size_t)(5 * 2 + g) * S_ * 64; A.kvpitch = 64; A.vpitch = 64;
        A.obase = p.OWIN + (size_t)t0 * 512 + g * 256; A.opitch = 512;
        A.qtok = 8 * wid + (r32 >> 2); A.abase = tile;
        const int real = (tile + 1 < 9) ? tile + 1 : 9; int nt = (real + 1) & ~1; if (nt < 4) nt = 4;
        A.nsteps = nt; A.bias = nullptr;
        att::attn_unit<att::MODE_WIN, true, 8, 64>(A, shm);
    }
    LAS unsigned char* l3 = (LAS unsigned char*)shm;
    LAS float* imp = (LAS float*)(l3 + wid * (8 * IMP_LD * 4));
    LAS int* sel = (LAS int*)(l3 + 8 * (8 * IMP_LD * 4) + wid * 512);
    LAS unsigned char* stg = l3 + 8 * (8 * IMP_LD * 4) + 8 * 512 + wid * 4096;
    const int t0w = t0 + 8 * wid;
    { int ln = lane; asm volatile("" : "+v"(ln)); cmp_wave(p, g, t0w, imp, stg, ln); }
    asm volatile("s_waitcnt vmcnt(0) lgkmcnt(0)" ::: "memory");
    { int ln = lane; asm volatile("" : "+v"(ln)); select_wave(t0w, imp, sel, ln); }
    { int ln = lane; asm volatile("" : "+v"(ln)); slc_wave(p, g, t0w, sel, imp, ln); }
    asm volatile("s_waitcnt vmcnt(0) lgkmcnt(0)\n\ts_barrier" ::: "memory");
}
#undef NMFMA32
#undef NMFMA16
#undef RLF
}

__device__ __forceinline__ void phase_prologue(const MKP& p, LAS unsigned char* lds) {
    const int tid = threadIdx.x, lane = tid & 63, wave = tid >> 6;
    const int gw = blockIdx.x * 8 + wave, NGW = gridDim.x * 8;
    LAS float* scr = (LAS float*)(lds + wave * 16384);
    for (int it = gw; it < 8 * 192; it += NGW) {
        const int kc = it / 192, ch = it % 192, idx = ch * 64 + lane, l = idx / 6144, n = idx % 6144;
        const float* w = p.in[5] + (size_t)l * 1024 * 6144 + n;
        const float* c = p.in[1];
        float acc = 0.f;
#pragma unroll 8
        for (int k = kc * 128; k < kc * 128 + 128; ++k) { const float cv = c[k]; acc += (cv / (1.f + __expf(-cv))) * w[(size_t)k * 6144]; }
        p.modpart[kc * 12288 + idx] = acc;
    }
    if (blockIdx.x == 1 && tid < 128) p.gcnt[tid] = 0;
    if (blockIdx.x == 0 && tid < 96 + 48 + 64) {
        BlkDesc d; d.dst = nullptr; d.gain = nullptr; d.pitch = 0; d.flags = 4; d.scale = 1.f; d.csoff = 0;
        if (tid < 96) {
            const int blk = (tid >> 3) * 4 + ((tid >> 2) & 1) * 2 + ((tid >> 1) & 1);
            d.flags = 0;
            if (blk < 8) { d.dst = p.QN + blk * 64; d.pitch = 512; d.gain = p.in[9]; d.flags = 1; d.scale = C2Q; }
            else if (blk < 20) { const int j = (blk - 8) >> 1, g = (blk - 8) & 1; d.dst = p.KV6 + (size_t)(j * 2 + g) * S_ * 64; d.pitch = 64;
                d.gain = (j == 2 || j == 4) ? p.in[10] : nullptr; d.flags = (j == 0 || j == 2 || j == 4) ? 1 : 0; }
            else if (blk < 28) { d.dst = p.FQ + (blk - 20) * 64; d.pitch = 512; d.gain = p.in[13]; d.scale = C2Q; }
            else if (blk < 36) { d.dst = p.FK + (blk - 28) * 64; d.pitch = 512; d.gain = p.in[14]; }
            else if (blk < 44) { d.dst = p.FV + (blk - 36) * 64; d.pitch = 512; }
            else if (blk == 44) d.flags = 2;
            else d.flags = 4;
            p.desc0[tid] = d;
        } else if (tid < 96 + 48) {
            const int e = tid - 96, pn = e >> 3, bj = (e >> 2) & 1, wc = e & 3;
            if (pn < 4) { const int h = pn * 4 + bj * 2 + (wc >> 1); d.dst = p.Q96 + (size_t)h * S_ * 96; d.pitch = 96; d.gain = p.in[21]; d.flags = 0; d.scale = C2M; }
            else { const int h = (pn - 4) * 8 + bj * 4 + wc; d.dst = p.Q96 + (size_t)h * S_ * 96 + 64; d.pitch = 96; d.gain = p.in[23]; d.flags = 1 | 8; d.scale = C2M; d.csoff = 32; }
            p.desc_uq[e] = d;
        } else {
            const int e = tid - 144, pn = e >> 3, bj = (e >> 2) & 1, wc = e & 3;
            const int h = (pn & 3) * 4 + bj * 2 + (wc >> 1);
            if (pn < 4) { d.dst = p.K96 + (size_t)h * S_ * 96; d.pitch = 96; d.gain = p.in[22]; d.flags = 0; }
            else { d.dst = p.V1 + (size_t)h * S_ * 64; d.pitch = 64; d.gain = nullptr; d.flags = 0; }
            p.desc_ukv[e] = d;
        }
    }
    if (blockIdx.x == 2 || blockIdx.x == 3) {
        const int kv = blockIdx.x - 2, e = tid & 63, sl = tid >> 6;
        const float* w = p.in[12] + (size_t)kv * 2048 * 64 + e; const float* pe = p.in[11] + kv * 2048;
        float b = 0.f;
#pragma unroll 8
        for (int k = sl * 256; k < sl * 256 + 256; ++k) b += pe[k] * w[(size_t)k * 64];
        LAS float* red = (LAS float*)(lds + 140000);
        red[tid] = b;
        __syncthreads();
        if (tid < 64) { float a = 0.f;
#pragma unroll
            for (int q = 0; q < 8; ++q) a += red[q * 64 + tid];
            p.CBIAS[kv * 64 + tid] = a; }
    }
    for (int idx = blockIdx.x * MK_THREADS + tid; idx < S_ * 48; idx += gridDim.x * MK_THREADS) {
        const int t = idx / 48, i = idx % 48;
        const double ex = (i < 32) ? (double)(2 * i) / 64.0 : (double)(2 * (i - 32)) / 32.0;
        const double a = (double)p.pos[t] * exp(-ex * 9.210340371976184);
        const double r = a - rint(a * 0.15915494309189535) * 6.283185307179586;
        const float rf = (float)r;
        p.cosT[idx] = cosf(rf); p.sinT[idx] = sinf(rf);
    }
    for (int it = gw; it < 2 * 32 * 2; it += NGW) { const int kv = it >> 6, r = it & 63; tr_item(p.in[12] + (size_t)kv * 2048 * 64, 64, 2048, p.WcT + (size_t)kv * 64 * 2048, scr, r >> 1, r & 1, lane, MapId(), nullptr); }
    constexpr int I_IN0 = 16 * 96, I_OUT0 = 16 * 32, I_IN1 = 16 * 24, I_UQ = 6 * 48, I_UKV = 4 * 64, I_OUT1 = 16 * 32;
    for (int it = gw; it < I_IN0 + I_OUT0 + I_IN1 + I_UQ + I_UKV + I_OUT1; it += NGW) {
        int r = it;
        if (r < I_IN0) { tr_item(p.in[7], HYIN, 1024, p.W_in0t, scr, r / 96, r % 96, lane, MapIn0(), nullptr); continue; } r -= I_IN0;
        if (r < I_OUT0) { tr_item(p.in[15], 1024, 1024, p.W_out0t, scr, r / 32, r % 32, lane, MapId(), nullptr); continue; } r -= I_OUT0;
        if (r < I_IN1) { tr_item(p.in[16], 672, 1024, p.W_in1t, scr, r / 24, r % 24, lane, MapIn1(), nullptr); continue; } r -= I_IN1;
        if (r < I_UQ) { tr_item(p.in[19], 1536, 384, p.W_uqt, scr, r / 48, r % 48, lane, MapUq(), p.in[17]); continue; } r -= I_UQ;
        if (r < I_UKV) { tr_item(p.in[20], 2048, 256, p.W_ukvt, scr, r / 64, r % 64, lane, MapUkv(), p.in[18]); continue; } r -= I_UKV;
        tr_item(p.in[25], 1024, 1024, p.W_out1t, scr, r / 32, r % 32, lane, MapId(), nullptr);
    }
}

template <bool COMB>
__device__ __forceinline__ void phase_norm(const MKP& p, LAS unsigned char* lds, const float* x, const float* gw_, int layer, int sc_idx, int sh_idx, bool finalize_mod) {
    const int tid = threadIdx.x, lane = tid & 63, wave = tid >> 6;
    LAS float* msc = (LAS float*)(lds + LDS_MOD);
    LAS float* msh = msc + 1024;
    const float* b_ada = p.in[6];
    if (finalize_mod) {
        for (int i = tid; i < 2048; i += MK_THREADS) {
            const int idx = layer * 6144 + ((i < 1024) ? sc_idx * 1024 + i : sh_idx * 1024 + (i - 1024));
            float a = b_ada[idx];
#pragma unroll
            for (int kc = 0; kc < 8; ++kc) a += p.modpart[kc * 12288 + idx];
            msc[i] = a;
        }
        for (int idx = blockIdx.x * MK_THREADS + tid; idx < 12288; idx += gridDim.x * MK_THREADS) {
            float a = b_ada[idx];
#pragma unroll
            for (int kc = 0; kc < 8; ++kc) a += p.modpart[kc * 12288 + idx];
            p.mod[idx] = a;
        }
    } else {
        for (int i = tid; i < 2048; i += MK_THREADS)
            msc[i] = p.mod[layer * 6144 + ((i < 1024) ? sc_idx * 1024 + i : sh_idx * 1024 + (i - 1024))];
    }
    __syncthreads();
    const int gwv = blockIdx.x * 8 + wave, NGW = gridDim.x * 8;
    for (int m = gwv; m < S_; m += NGW) {
        const f32x4* xr = (const f32x4*)(x + (size_t)m * D_) + lane;
        f32x4 v[4]; float s = 0.f;
#pragma unroll
        for (int j = 0; j < 4; ++j) {
            v[j] = xr[64 * j];
            if (COMB) {
                f32x4 ys = (f32x4){0.f, 0.f, 0.f, 0.f};
#pragma unroll
                for (int k = 0; k < 8; ++k) {
                    const int w = *((const int*)((const char*)p.YBUF + ((size_t)m * 8 + k) * 1024) + lane + 64 * j);
                    const f32x2 lo = __builtin_amdgcn_cvt_pk_f32_fp8(w, false), hi = __builtin_amdgcn_cvt_pk_f32_fp8(w, true);
                    ys.x += lo.x; ys.y += lo.y; ys.z += hi.x; ys.w += hi.y;
                }
                const f32x4 g2v = *(const f32x4*)(p.mod + (layer - 1) * 6144 + 5 * 1024 + 256 * j + 4 * lane) * (1.f / 16.f);
                v[j] = v[j] + g2v * ys;
                ((f32x4*)(p.out + (size_t)m * D_) + lane)[64 * j] = v[j];
            }
            s += (v[j].x * v[j].x + v[j].y * v[j].y) + (v[j].z * v[j].z + v[j].w * v[j].w);
        }
        s = wsum(s);
        const float rstd = rsqrtf(s * (1.f / D_) + EPSF);
        u32x2* o8 = (u32x2*)(p.XN + (size_t)m * D_) + lane;
#pragma unroll
        for (int j = 0; j < 4; ++j) {
            const int c0 = 256 * j + 4 * lane;
            const f32x4 g = *(const f32x4*)(gw_ + c0);
            const f32x4 sc = *(const LAS f32x4*)(msc + c0), sh = *(const LAS f32x4*)(msh + c0);
            const f32x4 y = v[j] * rstd * g * (sc + 1.f) + sh;
            u32x2 w; w.x = cvtpk(y.x, y.y); w.y = cvtpk(y.z, y.w);
            o8[64 * j] = w;
        }
    }
}

struct EpiResid {
    static constexpr bool PERM = true;
    const float* xin; float* out; const float* gate;
    __device__ __forceinline__ void operator()(const f32x4 (&acc)[2][2][4][2], const pg::Unit& u, int wid, int wr, int wc, int fr_, int fq_) const {
        int fr = fr_, fq = fq_; asm volatile("" : "+v"(fr), "+v"(fq));
        const int col0 = u.pn * 256 + wc * 32 + 8 * fq;
        f32x4 g[2][2];
#pragma unroll
        for (int bj = 0; bj < 2; ++bj)
#pragma unroll
            for (int n = 0; n < 2; ++n) g[bj][n] = *(const f32x4*)(gate + col0 + bj * 128 + n * 4);
#pragma unroll
        for (int ai = 0; ai < 2; ++ai)
#pragma unroll
            for (int m = 0; m < 4; ++m) {
                const size_t off = (size_t)(u.pm * 256 + ai * 128 + wr * 64 + m * 16 + fr) * 1024 + col0;
#pragma unroll
                for (int bj = 0; bj < 2; ++bj)
#pragma unroll
                    for (int n = 0; n < 2; ++n) {
                        const f32x4 xv = *(const f32x4*)(xin + off + bj * 128 + n * 4);
                        *(f32x4*)(out + off + bj * 128 + n * 4) = xv + g[bj][n] * acc[ai][bj][m][n];
                    }
                asm volatile("" ::: "memory");
            }
    }
};

struct EpiHeads {
    static constexpr bool PERM = false;
    const BlkDesc* tab; const float* cosT; const float* sinT; float* GATES; float* LOGF; LAS float* X;
    __device__ __forceinline__ void operator()(const f32x4 (&acc)[2][2][4][2], const pg::Unit& u, int wid, int wr, int wc, int fr_, int fq_) const {
        int fr = fr_, fq = fq_; asm volatile("" : "+v"(fr), "+v"(fq));
        const int w1 = wc & 1;
#pragma unroll
        for (int ai = 0; ai < 2; ++ai)
#pragma unroll
            for (int bj = 0; bj < 2; ++bj)
#pragma unroll
                for (int m = 0; m < 4; ++m) {
                    const f32x4 a = acc[ai][bj][m][0], b = acc[ai][bj][m][1];
                    float s = (a.x * a.x + a.y * a.y) + (a.z * a.z + a.w * a.w) + (b.x * b.x + b.y * b.y) + (b.z * b.z + b.w * b.w);
                    s += __shfl_xor(s, 16); s += __shfl_xor(s, 32);
                    if (fq == 0) X[wid * 256 + ((ai * 2 + bj) * 4 + m) * 16 + fr] = s;
                }
        asm volatile("s_waitcnt lgkmcnt(0)" ::: "memory"); __builtin_amdgcn_s_barrier(); asm volatile("" ::: "memory");
#pragma unroll
        for (int bj = 0; bj < 2; ++bj) {
            const BlkDesc d = tab[8 * u.pn + 4 * bj + wc];
            const int row0 = u.pm * 256 + wr * 64 + fr;
            if (d.flags & 4) continue;
            if (d.flags & 2) {
                if (w1 == 0) {
#pragma unroll
                    for (int ai = 0; ai < 2; ++ai)
#pragma unroll
                        for (int m = 0; m < 4; ++m) {
                            const int row = row0 + ai * 128 + m * 16;
#pragma unroll
                            for (int n = 0; n < 2; ++n) {
                                const f32x4 v = acc[ai][bj][m][n];
                                const int pc = 16 * n + 4 * fq;
                                if (pc < 24) *(f32x4*)(GATES + (size_t)row * 24 + pc) = v;
                                else *(f32x4*)(LOGF + (size_t)row * 8 + (pc - 24)) = v;
                            }
                            asm volatile("" ::: "memory");
                        }
                }
                continue;
            }
            const bool half = (d.flags & 8) != 0, has_gain = d.gain != nullptr, rope = (d.flags & 1) != 0;
            const int d0 = half ? 4 * fq : 16 * w1 + 4 * fq;
            const int dn1 = half ? 16 : 32;
            const float invn = half ? (1.f / 32.f) : (1.f / 64.f);
            const GAS float* gp = (const GAS float*)(has_gain ? d.gain : cosT);
            f32x4 g0 = *(const GAS f32x4*)(gp + d0), g1 = *(const GAS f32x4*)(gp + dn1 + d0);
            if (!has_gain) { g0 = (f32x4){1.f, 1.f, 1.f, 1.f}; g1 = g0; }
            g0 = g0 * d.scale; g1 = g1 * d.scale;
            const int cso = d.csoff + d0;
#pragma unroll
            for (int ai = 0; ai < 2; ++ai)
#pragma unroll
                for (int m = 0; m < 4; ++m) {
                    const int row = row0 + ai * 128 + m * 16;
                    const int xi = ((ai * 2 + bj) * 4 + m) * 16 + fr;
                    float ssq = X[wid * 256 + xi]; const float ssp = X[(wid ^ 1) * 256 + xi];
                    if (!half) ssq += ssp;
                    const float rs = has_gain ? rsqrtf(ssq * invn + EPSF) : 1.f;
                    f32x4 x1 = acc[ai][bj][m][0] * rs * g0, x2 = acc[ai][bj][m][1] * rs * g1;
                    f32x4 c = *(const f32x4*)(cosT + (size_t)row * 48 + cso), sn = *(const f32x4*)(sinT + (size_t)row * 48 + cso);
                    if (!rope) { c = (f32x4){1.f, 1.f, 1.f, 1.f}; sn = (f32x4){0.f, 0.f, 0.f, 0.f}; }
                    const f32x4 o1 = x1 * c - x2 * sn, o2 = x2 * c + x1 * sn;
                    u32x2 wa, wb; wa.x = cvtpk(o1.x, o1.y); wa.y = cvtpk(o1.z, o1.w); wb.x = cvtpk(o2.x, o2.y); wb.y = cvtpk(o2.z, o2.w);
                    GAS bf16_t* dr = (GAS bf16_t*)d.dst + (size_t)row * d.pitch + d0;
                    *(GAS u32x2*)dr = wa; *(GAS u32x2*)(dr + dn1) = wb;
                    asm volatile("" ::: "memory");
                }
        }
    }
};

struct EpiPlain {
    static constexpr bool PERM = true;
    bf16_t* O; int ldc;
    __device__ __forceinline__ void operator()(const f32x4 (&acc)[2][2][4][2], const pg::Unit& u, int wid, int wr, int wc, int fr_, int fq_) const {
        int fr = fr_, fq = fq_; asm volatile("" : "+v"(fr), "+v"(fq));
        const int col0 = u.pn * 256 + wc * 32 + 8 * fq;
#pragma unroll
        for (int ai = 0; ai < 2; ++ai)
#pragma unroll
            for (int m = 0; m < 4; ++m) {
                bf16_t* rp = O + (size_t)(u.pm * 256 + ai * 128 + wr * 64 + m * 16 + fr) * ldc + col0;
#pragma unroll
                for (int bj = 0; bj < 2; ++bj) { const f32x4 a = acc[ai][bj][m][0], b = acc[ai][bj][m][1];
                    u32x4 w; w.x = cvtpk(a.x, a.y); w.y = cvtpk(a.z, a.w); w.z = cvtpk(b.x, b.y); w.w = cvtpk(b.z, b.w); *(u32x4*)(rp + bj * 128) = w; }
            }
    }
};

__device__ __forceinline__ void phase_post1a(const MKP& p) {
    int tid_ = threadIdx.x; asm volatile("" : "+v"(tid_));
    const int tid = tid_, lane = tid & 63, wave = tid >> 6;
    const int gwv = blockIdx.x * 8 + wave, NGW = gridDim.x * 8;
    for (int t = gwv; t < S_; t += NGW) {
        const u32x2* row = (const u32x2*)(p.P1 + (size_t)t * 768);
        f32x4 v[3]; float sq = 0.f, skv = 0.f, skr = 0.f;
#pragma unroll
        for (int j = 0; j < 3; ++j) {
            const int g = lane + 64 * j;
            f32x4 x = (f32x4){0.f, 0.f, 0.f, 0.f};
            if (g < 168) { const u32x2 w = row[g]; x.x = __uint_as_float(w.x << 16); x.y = __uint_as_float(w.x & 0xffff0000u); x.z = __uint_as_float(w.y << 16); x.w = __uint_as_float(w.y & 0xffff0000u); }
            v[j] = x;
            const float s = (x.x * x.x + x.y * x.y) + (x.z * x.z + x.w * x.w);
            if (g < 96) sq += s; else if (g < 160) skv += s; else skr += s;
        }
        sq = wsum(sq); skv = wsum(skv); skr = wsum(skr);
        const float rq = rsqrtf(sq * (1.f / 384.f) + EPSF), rkv = rsqrtf(skv * (1.f / 256.f) + EPSF), rkr = rsqrtf(skr * (1.f / 32.f) + EPSF);
#pragma unroll
        for (int j = 0; j < 3; ++j) {
            const int g = lane + 64 * j;
            if (g < 96) { const f32x4 y = v[j] * rq; u32x2 w; w.x = cvtpk(y.x, y.y); w.y = cvtpk(y.z, y.w); *(u32x2*)(p.CQN + (size_t)t * 384 + 4 * g) = w; }
            else if (g < 160) { const f32x4 y = v[j] * rkv; u32x2 w; w.x = cvtpk(y.x, y.y); w.y = cvtpk(y.z, y.w); *(u32x2*)(p.CKVN + (size_t)t * 256 + 4 * (g - 96)) = w; }
        }
        {
            const int dl = (lane - 32) & 7;
            const int dd = 4 * dl;
            const int fi = 4 * (dl & 3);
            f32x4 x = v[2] * rkr;
            const f32x4 gn = *(const f32x4*)(p.in[24] + (dd & 31));
            x = x * gn;
            f32x4 o; o.x = __shfl_xor(x.x, 4); o.y = __shfl_xor(x.y, 4); o.z = __shfl_xor(x.z, 4); o.w = __shfl_xor(x.w, 4);
            const f32x4 c = *(const f32x4*)(p.cosT + (size_t)t * 48 + 32 + fi), sn = *(const f32x4*)(p.sinT + (size_t)t * 48 + 32 + fi);
            const f32x4 y = (dl < 4) ? (x * c - o * sn) : (x * c + o * sn);
            if (lane >= 32 && lane < 40) {
                u32x2 w; w.x = cvtpk(y.x, y.y); w.y = cvtpk(y.z, y.w);
#pragma unroll
                for (int h = 0; h < 16; ++h) *(u32x2*)(p.K96 + ((size_t)h * S_ + t) * 96 + 64 + dd) = w;
            }
        }
    }
}

__device__ __forceinline__ void mla_unit(const MKP& p, char* shm, int h, int qb) {
    int tid_ = threadIdx.x; asm volatile("" : "+v"(tid_));
    const int tid = tid_, lane = tid & 63, r32 = lane & 31; const int wid = __builtin_amdgcn_readfirstlane(tid >> 6);
    const int q0 = qb * 256;
    att::UnitArgs A;
    A.qrow = p.Q96 + ((size_t)h * S_ + q0 + 32 * wid + r32) * 96;
    A.K = p.K96 + (size_t)h * S_ * 96; A.kvpitch = 96; A.V = p.V1 + (size_t)h * S_ * 64; A.vpitch = 64;
    A.obase = p.OATT + (size_t)q0 * 1024 + h * 64; A.opitch = 1024;
    A.qtok = 32 * wid + r32; A.abase = 4 * qb; A.nsteps = 4 * qb + 4; A.bias = nullptr;
    att::attn_unit<att::MODE_CAUSAL, false, 8, 96>(A, shm);
}
__device__ __forceinline__ void phase_mla(const MKP& p, char* shm) {
    const int G = gridDim.x, bx = blockIdx.x;
    const int vcu = (G % 8 == 0) ? (bx % 8) * (G / 8) + bx / 8 : bx;
    for (int u = vcu; u < 256; u += G) {
        const int h = u >> 4, s = u & 15;
#pragma unroll 1
        for (int rep = 0; rep < 4; ++rep) mla_unit(p, shm, h, rep == 0 ? s : rep == 1 ? 31 - s : rep == 2 ? 32 + s : 63 - s);
    }
}

__device__ __forceinline__ void phase_scan(const MKP& p, LAS unsigned char* lds) {
    constexpr int NSB = 64;
    if (blockIdx.x >= NSB) {
        int tid_ = threadIdx.x; asm volatile("" : "+v"(tid_));
        const int lane = tid_ & 63, wave = tid_ >> 6;
        const int sb = blockIdx.x - NSB, NSBK = gridDim.x - NSB;
        LAS float* scr = (LAS float*)(lds + 65536 + wave * 256);
        for (int bj = sb; bj < 64; bj += NSBK) nsa::compress_job(p, scr, (LAS float*)(lds + (wave >> 2) * 32768) + (wave & 3) * 2048, 2 * bj + (wave >> 2), wave & 3, lane);
        for (int j = ((sb + NSBK - 64) % NSBK) * 8 + wave; j < 512; j += NSBK * 8) nsa::slcfrag_job(p, j, lane);
        return;
    }
    const int h = blockIdx.x >> 3, seg = blockIdx.x & 7, tid = threadIdx.x;
    LAS double* part = (LAS double*)lds;
    const float fb = p.in[8][h];
    double own[4], s = 0.0, pre = 0.0;
#pragma unroll
    for (int i = 0; i < 4; ++i) { own[i] = (double)logsigmf(p.LOGF[(size_t)(seg * 2048 + tid * 4 + i) * 8 + h] + fb); s += own[i]; }
    for (int i = tid; i < seg * 2048; i += MK_THREADS) pre += (double)logsigmf(p.LOGF[(size_t)i * 8 + h] + fb);
    part[tid] = s; part[512 + tid] = pre;
    __syncthreads();
    for (int o = 1; o < MK_THREADS; o <<= 1) {
        const double v = (tid >= o) ? part[tid - o] : 0.0, w = (tid >= o) ? part[512 + tid - o] : 0.0;
        __syncthreads();
        part[tid] += v; part[512 + tid] += w;
        __syncthreads();
    }
    double a = part[512 + MK_THREADS - 1] + ((tid > 0) ? part[tid - 1] : 0.0);
#pragma unroll
    for (int i = 0; i < 4; ++i) { a += own[i]; p.CUMB[(size_t)h * S_ + seg * 2048 + tid * 4 + i] = (float)(a * 1.4426950408889634); }
}

__device__ __forceinline__ void fox_unit(const MKP& p, char* shm, int h, int qb) {
    int tid_ = threadIdx.x; asm volatile("" : "+v"(tid_));
    const int tid = tid_, lane = tid & 63, r32 = lane & 31; const int wid = __builtin_amdgcn_readfirstlane(tid >> 6);
    const int q0 = qb * 256, abase = 4 * qb;
    const float* cb = p.CUMB + (size_t)h * S_;
    LAS float* bias = (LAS float*)(LAS unsigned char*)(shm + att::LDS_BIAS);
    LAS int* cnt = (LAS int*)(LAS unsigned char*)(shm + att::Geo<64>::LDS_WS);
    float gq = 0.f, gk = 0.f;
    for (int i = 0; i < 64; ++i) { gq = fmaxf(gq, fabsf(p.in[13][i])); gk = fmaxf(gk, fabsf(p.in[14][i])); }
    const float TH = 150.f + 2.f * (64.f * gq * gk * C2Q * 1.05f);
    const float c0 = cb[q0], cref = cb[q0 + 255];
    const bool skip = (tid < abase) && (cb[64 * tid + 63] - c0 > TH);
    const unsigned long long bal = __ballot(skip);
    if (lane == 0) cnt[wid] = __popcll(bal);
    __syncthreads();
    int alo = 0;
#pragma unroll
    for (int w = 0; w < 8; ++w) alo += cnt[w];
    int NT = abase + 4 - alo;
    if (NT & 1) { alo -= 1; NT += 1; }
    for (int i = tid; i < NT * 64; i += MK_THREADS) bias[i] = cref - cb[64 * alo + i];
    __syncthreads();
    att::UnitArgs A;
    A.qrow = p.FQ + (size_t)(q0 + 32 * wid + r32) * 512 + h * 64;
    A.K = p.FK + h * 64; A.V = p.FV + h * 64; A.kvpitch = 512; A.vpitch = 512;
    A.obase = p.OATT + (size_t)q0 * 1024 + 512 + h * 64; A.opitch = 1024;
    A.qtok = 32 * wid + r32; A.abase = abase; A.nsteps = NT; A.bias = bias;
    att::attn_unit<att::MODE_FOX, false, 8, 64>(A, shm);
}
__device__ __forceinline__ void phase_fox(const MKP& p, char* shm, int part = 3) {
    const int G = gridDim.x, bx = blockIdx.x;
    const int vcu = (G % 8 == 0) ? (bx % 8) * (G / 8) + bx / 8 : bx;
    if (part & 1) for (int u = vcu; u < 256; u += G) {
        const int h = u >> 5, s = u & 31;
#pragma unroll 1
        for (int rep = 0; rep < 2; ++rep) fox_unit(p, shm, h, rep ? 63 - s : s);
    }
    if (part & 2) for (int u = vcu; u < 256; u += G) {
#pragma unroll 1
        for (int rep = 0; rep < 2; ++rep) nsa::nsa_unit(p, shm, rep, rep ? 255 - u : u);
    }
}


struct MapOff { int off; __device__ __forceinline__ int operator()(int nn) const { return off + (nn & 31); } };
__device__ __forceinline__ void phase_moe_weights(const MKP& p, LAS unsigned char* lds, int layer) {
    int tid_ = threadIdx.x; asm volatile("" : "+v"(tid_));
    const int tid = tid_, lane = tid & 63, wave = tid >> 6;
    const int gw = blockIdx.x * 8 + wave, NGW = gridDim.x * 8;
    LAS float* scr = (LAS float*)(lds + wave * 16384);
    constexpr int IG = 16 * 16, ID = 4 * 32, IE = IG + ID;
    for (int it = gw; it < 65 * IE; it += NGW) {
        const int e = it / IE; int r = it % IE;
        if (r < IG) {
            const int kb = r / 16, nb = r % 16;
            const int n0 = nb * 32, up = (n0 >> 7) & 1, f0 = (n0 >> 8) * 128 + (n0 & 127);
            const float* W = (e < 64) ? ((up ? p.in[29] : p.in[28]) + ((size_t)layer * 64 + e) * 1024 * 256) : ((up ? p.in[32] : p.in[31]) + (size_t)layer * 1024 * 256);
            MapOff mo{f0};
            tr_item(W, 256, 1024, p.Wgu + (size_t)e * 512 * 1024, scr, kb, nb, lane, mo, nullptr);
        } else {
            r -= IG; const int kb = r / 32, nb = r % 32;
            const float* W = (e < 64) ? (p.in[30] + ((size_t)layer * 64 + e) * 256 * 1024) : (p.in[33] + (size_t)layer * 256 * 1024);
            tr_item(W, 1024, 256, p.Wd + (size_t)e * 1024 * 256, scr, kb, nb, lane, MapId(), nullptr);
        }
    }
}

template <bool DRY>
__device__ __forceinline__ void phase_moe_route(const MKP& p, LAS unsigned char* lds, int layer) {
    int tid_ = threadIdx.x; asm volatile("" : "+v"(tid_));
    const int tid = tid_, lane = tid & 63, wave = tid >> 6;
    LAS float* msc = (LAS float*)(lds + LDS_MOD);
    LAS float* msh = msc + 1024;
    LAS float* hrow = (LAS float*)lds;
    LAS int* cntl = (LAS int*)(lds + LDS_X);
    LAS int* basel = cntl + 64;
    const float* gnorm = p.in[4] + layer * 1024;
    const float* wr = p.in[26] + (size_t)layer * 1024 * 64;
    const float rb = p.in[27][layer * 64 + lane];
    for (int i = tid; i < 2048; i += MK_THREADS) msc[i] = p.mod[layer * 6144 + ((i < 1024) ? 4 * 1024 + i : 3 * 1024 + (i - 1024))];
    __syncthreads();
    for (int batch = blockIdx.x; batch < S_ / 32; batch += gridDim.x) {
        if (tid < 64) cntl[tid] = 0;
#pragma unroll 1
        for (int i = 0; i < 4; ++i) {
            const int t = batch * 32 + wave * 4 + i;
            const f32x4* xr = (const f32x4*)(p.out + (size_t)t * D_) + lane;
            f32x4 v[4]; float s = 0.f;
#pragma unroll
            for (int j = 0; j < 4; ++j) { v[j] = xr[64 * j]; s += (v[j].x * v[j].x + v[j].y * v[j].y) + (v[j].z * v[j].z + v[j].w * v[j].w); }
            s = wsum(s);
            const float rstd = rsqrtf(s * (1.f / D_) + EPSF);
            u32x2* o8 = (u32x2*)(p.XN + (size_t)t * D_) + lane;
            LAS f32x4* hr = (LAS f32x4*)(hrow + (wave * 4 + i) * 1024) + lane;
#pragma unroll
            for (int j = 0; j < 4; ++j) {
                const int c0 = 256 * j + 4 * lane;
                const f32x4 g = *(const f32x4*)(gnorm + c0);
                const f32x4 sc = *(const LAS f32x4*)(msc + c0), sh = *(const LAS f32x4*)(msh + c0);
                const f32x4 y = v[j] * rstd * g * (sc + 1.f) + sh;
                u32x2 w; w.x = cvtpk(y.x, y.y); w.y = cvtpk(y.z, y.w);
                o8[64 * j] = w; hr[64 * j] = y;
            }
        }
        __syncthreads();
        float acc0 = 0.f, acc1 = 0.f, acc2 = 0.f, acc3 = 0.f;
        const LAS float* h0 = hrow + (wave * 4) * 1024;
#pragma unroll 4
        for (int k = 0; k < 1024; k += 4) {
            const float w0 = wr[(k + 0) * 64 + lane], w1 = wr[(k + 1) * 64 + lane], w2 = wr[(k + 2) * 64 + lane], w3 = wr[(k + 3) * 64 + lane];
            const f32x4 a = *(const LAS f32x4*)(h0 + k), b = *(const LAS f32x4*)(h0 + 1024 + k), c = *(const LAS f32x4*)(h0 + 2048 + k), d = *(const LAS f32x4*)(h0 + 3072 + k);
            acc0 += a.x * w0; acc0 += a.y * w1; acc0 += a.z * w2; acc0 += a.w * w3;
            acc1 += b.x * w0; acc1 += b.y * w1; acc1 += b.z * w2; acc1 += b.w * w3;
            acc2 += c.x * w0; acc2 += c.y * w1; acc2 += c.z * w2; acc2 += c.w * w3;
            acc3 += d.x * w0; acc3 += d.y * w1; acc3 += d.z * w2; acc3 += d.w * w3;
        }
        int myrank[4], mypos[4]; float myw[4];
#pragma unroll
        for (int i = 0; i < 4; ++i) {
            const float logit = (i == 0) ? acc0 : (i == 1) ? acc1 : (i == 2) ? acc2 : acc3;
            const float score = 1.f / (1.f + expf(-logit));
            const float sv = score + rb;
            float m1 = sv;
            m1 = fmaxf(m1, __shfl_xor(m1, 1)); m1 = fmaxf(m1, __shfl_xor(m1, 2)); m1 = fmaxf(m1, __shfl_xor(m1, 4));
            int am = (sv == m1) ? (lane & 7) : 8;
            am = min(am, __shfl_xor(am, 1)); am = min(am, __shfl_xor(am, 2)); am = min(am, __shfl_xor(am, 4));
            float m2 = ((lane & 7) == am) ? -INFINITY : sv;
            m2 = fmaxf(m2, __shfl_xor(m2, 1)); m2 = fmaxf(m2, __shfl_xor(m2, 2)); m2 = fmaxf(m2, __shfl_xor(m2, 4));
            const float gs = m1 + m2;
            const int gi = lane >> 3; int grank = 0;
#pragma unroll
            for (int gj = 0; gj < 8; ++gj) { const float o = __shfl(gs, gj * 8); grank += (o > gs || (o == gs && gj < gi)) ? 1 : 0; }
            const float msk = (grank < 4) ? sv : -1e30f;
            int rank = 0;
#pragma unroll 8
            for (int e = 0; e < 64; ++e) { const float o = __shfl(msk, e); rank += (o > msk || (o == msk && e < lane)) ? 1 : 0; }
            const bool selb = rank < 8;
            const float tot = wsum(selb ? score : 0.f);
            myrank[i] = selb ? rank : -1; myw[i] = score / tot * 2.5f;
            mypos[i] = (selb && !DRY) ? atomicAdd((int*)(cntl + lane), 1) : 0;
        }
        __syncthreads();
        if (tid < 64) basel[tid] = (cntl[tid] > 0 && !DRY) ? atomicAdd(p.gcnt + layer * 64 + tid, cntl[tid]) : 0;
        __syncthreads();
#pragma unroll
        for (int i = 0; i < 4; ++i) if (myrank[i] >= 0 && !DRY) {
            const int t = batch * 32 + wave * 4 + i, slot = t * 8 + myrank[i];
            p.list[(size_t)lane * 16384 + basel[lane] + mypos[i]] = slot;
            p.ew[slot] = myw[i];
        }
        __syncthreads();
    }
}

struct MoeSched {
    const char* A; const char* Bt; const int* list; const LAS int* ustart; const LAS int* hbase; const LAS int* cnt;
    int K, NP, G, c; bool gather; int nexp;
    __device__ __forceinline__ static void tables(LAS int* ustart, LAS int* hbase, LAS int* cnt, const int* gcnt, int NP) {
        const int tid = threadIdx.x;
        if (tid == 0) {
            int us = 0, hb = 0;
            for (int e = 0; e < 65; ++e) { const int c = (e < 64) ? gcnt[e] : S_; const int nrb = (c + 255) >> 8; cnt[e] = c; ustart[e] = us; hbase[e] = hb; us += nrb * NP; hb += nrb * 256; }
            ustart[65] = us; hbase[65] = hb;
        }
        __syncthreads();
    }
    __device__ __forceinline__ bool next(int i, pg::Unit& u, int R0, int C0) const {
        const int L = i * G + c; if (L >= ustart[nexp]) return false;
        const int lane = threadIdx.x & 63;
        const unsigned long long bal = __ballot(lane < 65 && ustart[lane] <= L);
        int e = __popcll(bal) - 1; if (ustart[64] <= L) e = 64;
        const int r = L - ustart[e], rb = r / NP, pn = r % NP;
        u.pm = (hbase[e] >> 8) + rb; u.pn = pn; u.aux = e | (rb << 8);
        u.B = Bt + ((size_t)e * NP + pn) * 256 * K * 2;
        if (gather) {
            u.A = A; const int ce = cnt[e];
#pragma unroll
            for (int q = 0; q < 4; ++q) { const int pos = rb * 256 + R0 + 64 * q; int tok = 0; if (pos < ce) tok = (e < 64) ? (list[(size_t)e * 16384 + pos] >> 3) : pos; u.ra[q] = (unsigned)(tok * K + C0) * 2u; }
        } else {
            u.A = A + (size_t)u.pm * 256 * K * 2;
#pragma unroll
            for (int q = 0; q < 4; ++q) u.ra[q] = (unsigned)((R0 + 64 * q) * K + C0) * 2u;
        }
        return true;
    }
};
struct EpiGateUp {
    static constexpr bool PERM = true;
    bf16_t* HID;
    __device__ __forceinline__ void operator()(const f32x4 (&acc)[2][2][4][2], const pg::Unit& u, int wid, int wr, int wc, int fr_, int fq_) const {
        int fr = fr_, fq = fq_; asm volatile("" : "+v"(fr), "+v"(fq));
        const int col0 = u.pn * 128 + wc * 32 + 8 * fq;
#pragma unroll
        for (int ai = 0; ai < 2; ++ai)
#pragma unroll
            for (int m = 0; m < 4; ++m) {
                bf16_t* rp = HID + (size_t)(u.pm * 256 + ai * 128 + wr * 64 + m * 16 + fr) * 256 + col0;
                float h[8];
#pragma unroll
                for (int n = 0; n < 2; ++n) {
                    const f32x4 g = acc[ai][0][m][n], up = acc[ai][1][m][n];
                    h[4 * n] = g.x / (1.f + __expf(-g.x)) * up.x; h[4 * n + 1] = g.y / (1.f + __expf(-g.y)) * up.y; h[4 * n + 2] = g.z / (1.f + __expf(-g.z)) * up.z; h[4 * n + 3] = g.w / (1.f + __expf(-g.w)) * up.w;
                }
                u32x4 w; w.x = cvtpk(h[0], h[1]); w.y = cvtpk(h[2], h[3]); w.z = cvtpk(h[4], h[5]); w.w = cvtpk(h[6], h[7]); *(u32x4*)rp = w;
            }
    }
};
struct EpiDown {
    static constexpr bool PERM = true;
    bf16_t* YBUF; const int* list; const float* ew; const LAS int* cnt;
    __device__ __forceinline__ void operator()(const f32x4 (&acc)[2][2][4][2], const pg::Unit& u, int wid, int wr, int wc, int fr_, int fq_) const {
        int fr = fr_, fq = fq_; asm volatile("" : "+v"(fr), "+v"(fq));
        const int e = u.aux & 0xff, rb = u.aux >> 8, ce = cnt[e];
        const unsigned colb = (unsigned)(u.pn * 256 + wc * 32 + 8 * fq);
        const int* le = list + (size_t)e * 16384 + rb * 256 + wr * 64 + fr;
        const int pos0 = rb * 256 + wr * 64 + fr;
        int slot[8]; float w[8];
#pragma unroll
        for (int i = 0; i < 8; ++i) { const int pr = (i >> 2) * 128 + (i & 3) * 16; slot[i] = (pos0 + pr < ce) ? le[pr] : -1; }
#pragma unroll
        for (int i = 0; i < 8; ++i) w[i] = (slot[i] >= 0) ? ew[slot[i]] : 0.f;
#pragma unroll
        for (int ai = 0; ai < 2; ++ai)
#pragma unroll
            for (int m = 0; m < 4; ++m) {
                const int i = ai * 4 + m;
                if (slot[i] >= 0) {
                    char* rp = (char*)YBUF + ((unsigned)slot[i] * 1024u + colb);
                    const float ws = w[i] * 16.f;
#pragma unroll
                    for (int bj = 0; bj < 2; ++bj) { const f32x4 a = acc[ai][bj][m][0] * ws, b = acc[ai][bj][m][1] * ws;
                        u32x2 o; o.x = nsa::pk4_fp8(a.x, a.y, a.z, a.w); o.y = nsa::pk4_fp8(b.x, b.y, b.z, b.w); *(u32x2*)(rp + bj * 128) = o; }
                }
            }
    }
};
__device__ __forceinline__ void phase_moe_gemm1(const MKP& p, LAS unsigned char* lds, int layer) {
    LAS int* tb = (LAS int*)(lds + LDS_X);
    MoeSched::tables(tb, tb + 66, tb + 132, p.gcnt + layer * 64, 2);
    const int G = gridDim.x, bx = blockIdx.x, vcu = (G % 8 == 0) ? (bx % 8) * (G / 8) + bx / 8 : bx;
    MoeSched S{(const char*)p.XN, (const char*)p.Wgu, p.list, tb, tb + 66, tb + 132, 1024, 2, G, vcu, true, 65};
    EpiGateUp E{p.HID};
    pg::gemm_run(lds, 1024, S, E);
}
__device__ __forceinline__ void phase_moe_gemm2(const MKP& p, LAS unsigned char* lds, int layer, int which = 3) {
    LAS int* tb = (LAS int*)(lds + LDS_X);
    MoeSched::tables(tb, tb + 66, tb + 132, p.gcnt + layer * 64, 4);
    const int G = gridDim.x, bx = blockIdx.x, vcu = (G % 8 == 0) ? (bx % 8) * (G / 8) + bx / 8 : bx;
    if (which & 1) { MoeSched S{(const char*)p.HID, (const char*)p.Wd, p.list, tb, tb + 66, tb + 132, 256, 4, G, vcu, false, 64};
      EpiDown E{p.YBUF, p.list, p.ew, tb + 132};
      pg::gemm_run(lds, 256, S, E); }
    if (which & 2) {
      pg::DenseSched S; S.init(p.HID + (size_t)tb[66 + 64] * 256, p.Wd + (size_t)64 * 1024 * 256, S_, 1024, 256, G, bx);
      EpiResid E{p.out, p.out, p.mod + layer * 6144 + 5 * 1024};
      pg::gemm_run(lds, 256, S, E); }
}
__device__ __forceinline__ void phase_moe_combine(const MKP& p, int layer) {
    int tid_ = threadIdx.x; asm volatile("" : "+v"(tid_));
    const int tid = tid_, lane = tid & 63, wave = tid >> 6;
    const int gwv = blockIdx.x * 8 + wave, NGW = gridDim.x * 8;
    const float* g2 = p.mod + layer * 6144 + 5 * 1024;
    for (int t = gwv; t < S_; t += NGW) {
        f32x4* xr = (f32x4*)(p.out + (size_t)t * D_) + lane;
#pragma unroll
        for (int j = 0; j < 4; ++j) {
            f32x4 s = (f32x4){0.f, 0.f, 0.f, 0.f};
#pragma unroll
            for (int k = 0; k < 8; ++k) {
                const int w = *((const int*)((const char*)p.YBUF + ((size_t)t * 8 + k) * 1024) + lane + 64 * j);
                const f32x2 lo = __builtin_amdgcn_cvt_pk_f32_fp8(w, false), hi = __builtin_amdgcn_cvt_pk_f32_fp8(w, true);
                s.x += lo.x; s.y += lo.y; s.z += hi.x; s.w += hi.y;
            }
            const f32x4 g = *(const f32x4*)(g2 + 256 * j + 4 * lane) * (1.f / 16.f);
            xr[64 * j] = xr[64 * j] + g * s;
        }
    }
}

#define XB_TMO      128
#define XB_XCNT(j)  (256  + 64 * (j))
#define XB_XSUB(j)  (1280 + 64 * (j))
#define XB_XGEN(j)  (2304 + 64 * (j))
#define XB_TOP      3328
#define XB_TOPGEN   3392
#define XCD_BAR_WORDS 3456
#define XB_SPIN_CAP (1u << 22)
__device__ __forceinline__ unsigned xb_ld(unsigned* p)              { return __hip_atomic_load(p, __ATOMIC_RELAXED, __HIP_MEMORY_SCOPE_AGENT); }
__device__ __forceinline__ unsigned xb_add(unsigned* p, unsigned v) { return __hip_atomic_fetch_add(p, v, __ATOMIC_RELAXED, __HIP_MEMORY_SCOPE_AGENT); }
__device__ __forceinline__ unsigned xb_xcc_id() { return (unsigned)__builtin_amdgcn_s_getreg((3 << 11) | 20) & 0xFu; }
#define XB_SPIN(cond, bar) do { unsigned _sp = 0; while (cond) { __builtin_amdgcn_s_sleep(1); \
    if ((++_sp & 255u) == 0u) { if (xb_ld(&(bar)[XB_TMO])) break; if (_sp > XB_SPIN_CAP) { atomicAdd(&(bar)[XB_TMO], 1u); break; } } } } while (0)
struct XcdBarrier { unsigned* bar; unsigned x; volatile LAS unsigned* st; };
__device__ __forceinline__ XcdBarrier xcd_barrier_post(unsigned* bar, volatile LAS unsigned* st) {
    XcdBarrier b; b.bar = bar; b.x = xb_xcc_id(); b.st = st;
    if (threadIdx.x == 0) (void)xb_add(&bar[XB_XCNT(b.x)], 1u);
    return b;
}
__device__ __forceinline__ void xcd_barrier_complete(unsigned* bar, unsigned x, unsigned& nloc, unsigned& nx) {
    const unsigned G = gridDim.x * gridDim.y * gridDim.z;
    unsigned sum, cnt, mine, sp = 0u;
    for (;;) {
        sum = 0u; cnt = 0u; mine = 0u;
#pragma unroll
        for (unsigned j = 0; j < 16; ++j) { const unsigned c = xb_ld(&bar[XB_XCNT(j)]); sum += c; cnt += (c > 0u) ? 1u : 0u; mine = (j == x) ? c : mine; }
        if (sum == G) break;
        __builtin_amdgcn_s_sleep(1);
        if ((++sp & 255u) == 0u) { if (xb_ld(&bar[XB_TMO])) break; if (sp > XB_SPIN_CAP) { atomicAdd(&bar[XB_TMO], 1u); break; } }
    }
    nloc = mine > 0u ? mine : 1u; nx = cnt > 0u ? cnt : 1u;
}
__device__ __forceinline__ void xcd_barrier(const XcdBarrier& b) {
    asm volatile("s_waitcnt vmcnt(0)" ::: "memory");
    __syncthreads();
    if (threadIdx.x == 0) {
        unsigned* bar = b.bar;
        __builtin_amdgcn_s_waitcnt(0);
        unsigned nloc = b.st[0], nx = b.st[1];
        if (nloc == 0u) { xcd_barrier_complete(bar, b.x, nloc, nx); b.st[0] = nloc; b.st[1] = nx; }
        const unsigned old = xb_add(&bar[XB_XSUB(b.x)], 1u);
        const unsigned gen = old / nloc;
        if (old + 1u == (gen + 1u) * nloc) {
            __builtin_amdgcn_fence(__ATOMIC_RELEASE, "agent");
            asm volatile("s_waitcnt vmcnt(0)" ::: "memory");
            const unsigned og = xb_add(&bar[XB_TOP], 1u);
            const unsigned tg = og / nx;
            if (og + 1u == (tg + 1u) * nx) xb_add(&bar[XB_TOPGEN], 1u);
            else XB_SPIN(xb_ld(&bar[XB_TOPGEN]) == tg, bar);
            __builtin_amdgcn_fence(__ATOMIC_ACQUIRE, "agent");
            xb_add(&bar[XB_XGEN(b.x)], 1u);
            asm volatile("s_waitcnt vmcnt(0)" ::: "memory");
        } else {
            XB_SPIN(xb_ld(&bar[XB_XGEN(b.x)]) == gen, bar);
            __builtin_amdgcn_fence(__ATOMIC_ACQUIRE, "agent");
            asm volatile("s_waitcnt vmcnt(0)" ::: "memory");
        }
    }
    __syncthreads();
}

__global__ void __launch_bounds__(MK_THREADS, 2) mega(MKP p) {
    extern __shared__ __attribute__((aligned(16))) unsigned char lds_raw[];
    LAS unsigned char* lds = (LAS unsigned char*)lds_raw;
    const int lo = p.ph_lo, hi = p.ph_hi;
    const bool multi = hi - lo > 1;
    volatile LAS unsigned* bst = (volatile LAS unsigned*)(lds + LDS_BARST);
    XcdBarrier bar; bar.bar = p.barw; bar.x = 0; bar.st = bst;
    if (multi) {
        if (threadIdx.x < 2) bst[threadIdx.x] = 0u;
        if (blockIdx.x == 0) for (int i = threadIdx.x; i < XCD_BAR_WORDS; i += MK_THREADS) p.barw[i] = 0u;
    }
    int nbar = 0;
#define IN(k) (lo <= (k) && (k) < hi)
#define SEAM(k) do { if (IN(k) && IN((k) + 1)) { if (nbar == 0) { __threadfence(); cooperative_groups::this_grid().sync(); __builtin_amdgcn_fence(__ATOMIC_ACQUIRE, "agent"); bar = xcd_barrier_post(p.barw, bst); } else xcd_barrier(bar); ++nbar; } } while (0)
    if (IN(0)) { phase_prologue(p, lds); phase_moe_weights(p, lds, 0); }
    SEAM(0);
    if (IN(1)) phase_norm<false>(p, lds, p.in[0], p.in[3], 0, 1, 0, true);
    SEAM(1);
    if (IN(2)) {
        pg::DenseSched S; S.init(p.XN, p.W_in0t, S_, 3072, 1024, gridDim.x, blockIdx.x);
        EpiHeads E{p.desc0, p.cosT, p.sinT, p.GATES, p.LOGF, (LAS float*)(lds + LDS_X)};
        pg::gemm_run(lds, 1024, S, E);
    }
    SEAM(2);
    if (IN(3)) phase_scan(p, lds);
    SEAM(3);
    if (IN(4)) phase_fox(p, (char*)lds_raw);
    SEAM(4);
    if (IN(5)) {
        pg::DenseSched S; S.init(p.OATT, p.W_out0t, S_, 1024, 1024, gridDim.x, blockIdx.x);
        EpiResid E{p.in[0], p.out, p.mod + 2 * 1024};
        pg::gemm_run(lds, 1024, S, E);
    }
    SEAM(5);
    if (IN(6)) phase_moe_route<false>(p, lds, 0);
    SEAM(6);
    if (IN(7)) phase_moe_gemm1(p, lds, 0);
    SEAM(7);
    if (IN(8)) phase_moe_gemm2(p, lds, 0);
    SEAM(8);
    if (IN(9)) { phase_norm<true>(p, lds, p.out, p.in[3] + 1024, 1, 1, 0, false); phase_moe_weights(p, lds, 1); }
    if (IN(9) && IN(11)) { xcd_barrier(bar); ++nbar; }
    if (IN(11)) {
        pg::DenseSched S; S.init(p.XN, p.W_in1t, S_, 768, 1024, gridDim.x, blockIdx.x);
        EpiPlain E{p.P1, 768};
        pg::gemm_run(lds, 1024, S, E);
    }
    SEAM(11);
    if (IN(12)) phase_post1a(p);
    SEAM(12);
    if (IN(13)) {
        { pg::DenseSched S; S.init(p.CQN, p.W_uqt, S_, 1536, 384, gridDim.x, blockIdx.x);
          EpiHeads E{p.desc_uq, p.cosT, p.sinT, nullptr, nullptr, (LAS float*)(lds + LDS_X)};
          pg::gemm_run(lds, 384, S, E); }
        { pg::DenseSched S; S.init(p.CKVN, p.W_ukvt, S_, 2048, 256, gridDim.x, blockIdx.x);
          EpiHeads E{p.desc_ukv, p.cosT, p.sinT, nullptr, nullptr, (LAS float*)(lds + LDS_X)};
          pg::gemm_run(lds, 256, S, E); }
    }
    SEAM(13);
    if (IN(14)) phase_mla(p, (char*)lds_raw);
    SEAM(14);
    if (IN(15)) {
        pg::DenseSched S; S.init(p.OATT, p.W_out1t, S_, 1024, 1024, gridDim.x, blockIdx.x);
        EpiResid E{p.out, p.out, p.mod + 6144 + 2 * 1024};
        pg::gemm_run(lds, 1024, S, E);
    }
    SEAM(15);
    if (IN(16)) phase_moe_route<false>(p, lds, 1);
    SEAM(16);
    if (IN(17)) phase_moe_gemm1(p, lds, 1);
    SEAM(17);
    if (IN(18)) phase_moe_gemm2(p, lds, 1);
    SEAM(18);
    if (IN(19)) phase_moe_combine(p, 1);
#undef IN
#undef SEAM
}
extern "C" void kernel_launch(void* const* d_in, const int* in_sizes, int n_in, void* d_out, int out_size, void* d_ws, size_t ws_size, hipStream_t stream) {
    static int grid = 0;
    if (!grid) {
        int dev = 0, cus = 0, per_cu = 0;
        (void)hipGetDevice(&dev); (void)hipDeviceGetAttribute(&cus, hipDeviceAttributeMultiprocessorCount, dev);
        (void)hipFuncSetAttribute((const void*)mega, hipFuncAttributeMaxDynamicSharedMemorySize, LDS_TOTAL);
        (void)hipOccupancyMaxActiveBlocksPerMultiprocessor(&per_cu, (const void*)mega, MK_THREADS, LDS_TOTAL);
        (void)hipGetLastError();
        grid = (cus > 0 && per_cu >= 1) ? cus : -1;
    }
    if (grid < 0) return;
    constexpr size_t MiB = 1u << 20;
    if (ws_size < 528 * MiB || n_in != 34) return;
    char* wsb = (char*)d_ws;
    float* ws = (float*)d_ws;
    size_t o = 0;
    MKP p{};
    for (int i = 0; i < 34; ++i) p.in[i] = (const float*)d_in[i];
    p.out = (float*)d_out; p.pos = (const int*)d_in[2];
    p.mod = ws + o; o += 2 * 6144;
    p.cosT = ws + o; o += (size_t)S_ * 48;
    p.sinT = ws + o; o += (size_t)S_ * 48;
    p.modpart = ws + o; o += 8 * 12288;
    p.desc0 = (BlkDesc*)(ws + o); o += 96 * 8;
    p.desc_uq = (BlkDesc*)(ws + o); o += 48 * 8;
    p.desc_ukv = (BlkDesc*)(ws + o); o += 64 * 8;
    p.CUMB = ws + o; o += (size_t)8 * S_;
    p.gcnt = (int*)(ws + o); o += 128;
    p.CBIAS = ws + o; o += 128;
    p.barw = (unsigned*)(ws + o); o += 4096;
    p.ew = ws + o; o += (size_t)S_ * 8;
    p.list = (int*)(ws + o); o += (size_t)64 * 16384;
    p.WcT = (bf16_t*)(ws + o); o += (size_t)2 * 64 * 2048 / 2;
    p.KCMP = (bf16_t*)(ws + o); o += (size_t)2 * 1024 * 64 / 2;
    p.VCT = (bf16_t*)(ws + o); o += (size_t)2 * 64 * 1024 / 2;
    if (o * 4 > 15 * MiB) return;
    p.XN = (bf16_t*)(wsb + 15 * MiB); p.OATT = (bf16_t*)(wsb + 47 * MiB);
    char* big = wsb + 79 * MiB;
    {   bf16_t* b = (bf16_t*)big;
        p.QN = b; b += (size_t)S_ * 512; p.KV6 = b; b += (size_t)12 * S_ * 64; p.FQ = b; b += (size_t)S_ * 512; p.FK = b; b += (size_t)S_ * 512; p.FV = b; b += (size_t)S_ * 512;
        p.GATES = (float*)b; p.LOGF = p.GATES + (size_t)S_ * 24; }
    p.KSLF = (bf16_t*)(big + 92 * MiB); p.VSLF = (bf16_t*)(big + 96 * MiB); p.OCMP = (bf16_t*)(big + 100 * MiB); p.OWIN = (bf16_t*)(big + 116 * MiB);
    {   bf16_t* b = (bf16_t*)(big + 96 * MiB);
        p.P1 = b; b += (size_t)S_ * 768; p.CQN = b; b += (size_t)S_ * 384; p.CKVN = b; b += (size_t)S_ * 256;
        p.Q96 = b; b += (size_t)16 * S_ * 96; p.K96 = b; b += (size_t)16 * S_ * 96; p.V1 = b; b += (size_t)16 * S_ * 64; }
    p.YBUF = (bf16_t*)big; p.HID = (bf16_t*)(big + 256 * MiB);
    p.Wgu = (bf16_t*)(wsb + 415 * MiB); p.Wd = p.Wgu + (size_t)65 * 512 * 1024;
    {   bf16_t* b = (bf16_t*)(wsb + 513 * MiB);
        p.W_in0t = b; b += (size_t)3072 * 1024; p.W_out0t = b; b += (size_t)1024 * 1024; p.W_in1t = b; b += (size_t)768 * 1024;
        p.W_uqt = b; b += (size_t)1536 * 384; p.W_ukvt = b; b += (size_t)2048 * 256; p.W_out1t = b; b += (size_t)1024 * 1024; }
    p.ph_lo = 0; p.ph_hi = 20;
    void* args[] = {&p};
    (void)hipLaunchCooperativeKernel((const void*)mega, dim3(grid), dim3(MK_THREADS), args, LDS_TOTAL, stream);
}
```

```cpp
#include <hip/hip_runtime.h>
#include <hip/hip_cooperative_groups.h>
#include <stdint.h>

#define S_ 16384
#define D_ 1024
#define HYIN 2848
#define NEXP 64
#define EPSF 1e-6f

__device__ __forceinline__ float wsum(float v) {
#pragma unroll
    for (int o = 32; o > 0; o >>= 1) v += __shfl_xor(v, o);
    return v;
}
__device__ __forceinline__ float sigmf(float x) { return 1.f / (1.f + expf(-x)); }
__device__ __forceinline__ float logsigmf(float x) { return fminf(x, 0.f) - log1pf(expf(-fabsf(x))); }
#define LAS __attribute__((address_space(3)))
#define GAS __attribute__((address_space(1)))
typedef unsigned short bf16_t;
typedef short bf16x8 __attribute__((ext_vector_type(8)));
typedef float f32x4 __attribute__((ext_vector_type(4)));
typedef float f32x2 __attribute__((ext_vector_type(2)));
typedef unsigned u32x4 __attribute__((ext_vector_type(4)));
typedef unsigned u32x2 __attribute__((ext_vector_type(2)));
typedef __bf16 bf16x2_t __attribute__((ext_vector_type(2)));

__device__ __forceinline__ unsigned cvtpk(float lo, float hi) { f32x2 v = {lo, hi}; bf16x2_t b = __builtin_convertvector(v, bf16x2_t); return __builtin_bit_cast(unsigned, b); }
__device__ __forceinline__ float bf2f(bf16_t v) { return __uint_as_float(((unsigned)v) << 16); }
__device__ __forceinline__ bf16_t f2bf(float f) { return (bf16_t)(cvtpk(f, 0.f) & 0xffffu); }

namespace pg {
constexpr int BM = 256, BK = 64, HALF = 128, HTB = HALF * BK * 2, STAGE_BYTES = 8 * HTB;
__device__ __forceinline__ int lds_byte(int r, int c) { const int st = (r >> 4) * 2 + (c >> 5), rr = r & 15, cc = c & 31, ob = rr * 64 + cc * 2; return st * 1024 + (ob ^ (((ob >> 9) & 1) << 5)); }
__device__ __forceinline__ int perm32(int rho) { const int n = rho >> 4, i = rho & 15; return 8 * (i >> 2) + 4 * n + (i & 3); }
__device__ __forceinline__ void stage_rc(int b, int& R, int& C) { const int st = b / 1024, sb = b % 1024, swz = sb ^ (((sb >> 9) & 1) << 5); R = (st >> 1) * 16 + swz / 64; C = (st & 1) * 32 + (swz % 64) / 2; }

struct Unit { int pm, pn, aux; const char* A; const char* B; unsigned ra[4]; };

template <class Epi, class Sched>
__device__ __forceinline__ void gemm_run(LAS unsigned char* lds, const int K, const Sched& S, const Epi& E) {
    int tid_ = threadIdx.x; asm volatile("" : "+v"(tid_));
    const int tid = tid_, wid = __builtin_amdgcn_readfirstlane(tid >> 6), lane = tid & 63, wr = wid >> 2, wc = wid & 3, fr = lane & 15, fq = lane >> 4;
    int nt_ = K / BK; asm volatile("" : "+s"(nt_)); const int nt = nt_;
    int R0, C0; stage_rc(tid * 16, R0, C0);
    unsigned voffB[2];
#pragma unroll
    for (int i = 0; i < 2; ++i) { const int Rb = Epi::PERM ? ((R0 & ~31) + perm32(R0 & 31)) : R0; voffB[i] = (unsigned)((Rb + 64 * i) * K + C0) * 2u; }
    const size_t kstep = (size_t)(BK * 2);
    const size_t hstep = (size_t)HALF * K * 2;
    const unsigned ldsw = (unsigned)wid * 1024u;
    const int aoff = lds_byte(wr * 64 + fr, fq * 8), boff = lds_byte(wc * 32 + fr, fq * 8);
#define PG_SA(b, h) (((b) * 2 + (h)) * HTB)
#define PG_SB(b, h) ((4 + (b) * 2 + (h)) * HTB)
#define PG_STAGE2(bufoff, gbase, v0, v1) do { \
        __builtin_amdgcn_global_load_lds((const unsigned*)((const char*)(gbase) + (v0)), (LAS unsigned*)(lds + (bufoff) + ldsw), 16, 0, 0); \
        __builtin_amdgcn_global_load_lds((const unsigned*)((const char*)(gbase) + (v1)), (LAS unsigned*)(lds + (bufoff) + ldsw + 8192), 16, 0, 0); } while (0)
#define PG_STAGEB(bufoff, gbase) PG_STAGE2(bufoff, gbase, voffB[0], voffB[1])
#define PG_LDA(dst, b, h) do { _Pragma("unroll") for (int m = 0; m < 4; ++m) _Pragma("unroll") for (int k = 0; k < 2; ++k) dst[m][k] = *(const LAS bf16x8*)(lds + PG_SA(b, h) + aoff + m * 2048 + k * 1024); } while (0)
#define PG_LDB(dst, b, h) do { _Pragma("unroll") for (int n = 0; n < 2; ++n) _Pragma("unroll") for (int k = 0; k < 2; ++k) dst[n][k] = *(const LAS bf16x8*)(lds + PG_SB(b, h) + boff + n * 2048 + k * 1024); } while (0)
#define PG_MMA(ai, bj, At, Bt) do { __builtin_amdgcn_s_setprio(1); _Pragma("unroll") for (int m = 0; m < 4; ++m) _Pragma("unroll") for (int n = 0; n < 2; ++n) _Pragma("unroll") for (int k = 0; k < 2; ++k) \
        acc[ai][bj][m][n] = __builtin_amdgcn_mfma_f32_16x16x32_bf16(Bt[n][k], At[m][k], acc[ai][bj][m][n], 0, 0, 0); __builtin_amdgcn_s_setprio(0); } while (0)
#define PG_WAIT_V(n) asm volatile("s_waitcnt vmcnt(" #n ")" ::: "memory")
#define PG_WAIT_L(n) asm volatile("s_waitcnt lgkmcnt(" #n ")" ::: "memory")
#define PG_BAR __builtin_amdgcn_s_barrier()
#define PG_SCHED __builtin_amdgcn_sched_barrier(0)
    Unit cur, nxt; int ui = 0;
    if (!S.next(0, cur, R0, C0)) return;
    f32x4 acc[2][2][4][2];
#pragma unroll
    for (int a = 0; a < 2; ++a)
#pragma unroll
        for (int b = 0; b < 2; ++b)
#pragma unroll
            for (int m = 0; m < 4; ++m)
#pragma unroll
                for (int n = 0; n < 2; ++n) acc[a][b][m][n] = (f32x4){0.f, 0.f, 0.f, 0.f};
    bf16x8 At[4][2], B0[2][2], B1[2][2];
    const char* cA = cur.A; const char* cB = cur.B;
    PG_STAGEB(PG_SB(0, 0), cB); PG_STAGEB(PG_SB(0, 1), cB + hstep); PG_STAGE2(PG_SA(0, 0), cA, cur.ra[0], cur.ra[1]); PG_STAGE2(PG_SA(0, 1), cA, cur.ra[2], cur.ra[3]);
    if (wr == 1) PG_BAR;
    PG_WAIT_V(2); PG_BAR;
    PG_STAGEB(PG_SB(1, 0), cB + kstep); PG_STAGE2(PG_SA(1, 0), cA + kstep, cur.ra[0], cur.ra[1]); PG_STAGEB(PG_SB(1, 1), cB + hstep + kstep);
    PG_WAIT_V(6); PG_BAR;
    for (;;) {
        const bool has_next = S.next(ui + 1, nxt, R0, C0);
        if (!has_next) nxt = cur;
        const char* nA = nxt.A; const char* nB = nxt.B;
#pragma unroll 1
        for (int t = 0; t < nt; t += 2) {
            const bool last = (t == nt - 2);
            const char* a1 = cA + (size_t)(t + 1) * kstep;
            const char* a2 = last ? nA : cA + (size_t)(t + 2) * kstep; const char* b2 = last ? nB : cB + (size_t)(t + 2) * kstep;
            const char* a3 = a2 + kstep; const char* b3 = b2 + kstep;
            const unsigned r0 = last ? nxt.ra[0] : cur.ra[0], r1 = last ? nxt.ra[1] : cur.ra[1], r2 = last ? nxt.ra[2] : cur.ra[2], r3 = last ? nxt.ra[3] : cur.ra[3];
            PG_LDB(B0, 0, 0); PG_LDB(B1, 0, 1); PG_SCHED; PG_LDA(At, 0, 0); PG_STAGE2(PG_SA(1, 1), a1, cur.ra[2], cur.ra[3]);
            PG_WAIT_V(8); PG_WAIT_L(0); PG_BAR; PG_MMA(0, 0, At, B0); PG_MMA(0, 1, At, B1); PG_BAR; PG_SCHED;
            PG_LDA(At, 0, 1); PG_STAGEB(PG_SB(0, 0), b2); PG_STAGEB(PG_SB(0, 1), b2 + hstep); PG_STAGE2(PG_SA(0, 0), a2, r0, r1);
            PG_WAIT_V(8); PG_WAIT_L(0); PG_BAR; PG_MMA(1, 0, At, B0); PG_MMA(1, 1, At, B1); PG_BAR; PG_SCHED;
            PG_LDB(B0, 1, 0); PG_LDB(B1, 1, 1); PG_SCHED; PG_LDA(At, 1, 0); PG_STAGE2(PG_SA(0, 1), a2, r2, r3);
            PG_WAIT_V(8); PG_WAIT_L(0); PG_BAR; PG_MMA(0, 0, At, B0); PG_MMA(0, 1, At, B1); PG_BAR; PG_SCHED;
            PG_LDA(At, 1, 1); PG_STAGEB(PG_SB(1, 0), b3); PG_STAGEB(PG_SB(1, 1), b3 + hstep); PG_STAGE2(PG_SA(1, 0), a3, r0, r1);
            PG_WAIT_V(8); PG_WAIT_L(0); PG_BAR; PG_MMA(1, 0, At, B0); PG_MMA(1, 1, At, B1); PG_BAR; PG_SCHED;
        }
        if (wr == 0) PG_BAR;
        E(acc, cur, wid, wr, wc, fr, fq);
        if (!has_next) break;
#pragma unroll
        for (int a = 0; a < 2; ++a)
#pragma unroll
            for (int b = 0; b < 2; ++b)
#pragma unroll
                for (int m = 0; m < 4; ++m)
#pragma unroll
                    for (int n = 0; n < 2; ++n) acc[a][b][m][n] = (f32x4){0.f, 0.f, 0.f, 0.f};
        cur = nxt; cA = nA; cB = nB; ++ui;
        if (wr == 1) PG_BAR;
    }
    PG_WAIT_V(0);
    PG_BAR;
#undef PG_SA
#undef PG_SB
#undef PG_STAGE2
#undef PG_STAGEB
#undef PG_LDA
#undef PG_LDB
#undef PG_MMA
}

struct DenseSched {
    const char* A; const char* Bt; int K, nM, nN, nwg, G, c;
    __device__ __forceinline__ void init(const void* A_, const void* Bt_, int M, int N, int K_, int G_, int c_) { A = (const char*)A_; Bt = (const char*)Bt_; K = K_; nM = M / BM; nN = N / BM; nwg = nM * nN; G = G_; c = c_; }
    __device__ __forceinline__ bool next(int i, Unit& u, int R0, int C0) const {
        const long L = (long)i * G + c; if (L >= nwg) return false;
        int wgid = (int)L; { const int q = nwg / 8, r = nwg % 8, xcd = wgid % 8, off = wgid / 8; wgid = (xcd < r ? xcd * (q + 1) : r * (q + 1) + (xcd - r) * q) + off; }
        const int nig = 8 * nN, gid = wgid / nig, fm = gid * 8, gsz = (nM - fm) < 8 ? (nM - fm) : 8;
        u.pm = fm + ((wgid % nig) % gsz); u.pn = (wgid % nig) / gsz; u.aux = 0;
        u.A = A + (size_t)u.pm * BM * K * 2; u.B = Bt + (size_t)u.pn * BM * K * 2;
#pragma unroll
        for (int q = 0; q < 4; ++q) u.ra[q] = (unsigned)((R0 + 64 * q) * K + C0) * 2u;
        return true;
    }
};
}
namespace att {
using s16x4 = __attribute__((ext_vector_type(4))) short;
using f32x16 = __attribute__((ext_vector_type(16))) float;
typedef __attribute__((address_space(3))) const char* lds_cptr;
typedef short v4i16_t __attribute__((ext_vector_type(4)));
constexpr int NSLOT = 3, VSLOT = 8192;
template <int DQ> struct Geo {
    static constexpr int NK = DQ / 16;
    static constexpr int KSLOT = (DQ == 64) ? 8192 : 16384;
    static constexpr int QWAVE = (DQ == 64) ? 4096 : 6144;
    static constexpr int LDS_K = 0, LDS_V = NSLOT * KSLOT, LDS_WS = LDS_V + NSLOT * VSLOT, LDS_OST = LDS_WS + 8 * 64 * 4, LDS_BYTES = LDS_OST + 8 * QWAVE;
};
constexpr int LDS_BIAS = Geo<64>::LDS_BYTES;
#define ASBAR() __builtin_amdgcn_sched_barrier(0)
#define AWAIT_BAR(N) asm volatile("s_waitcnt vmcnt(" #N ") lgkmcnt(0)\n\ts_barrier" ::: "memory")
__device__ __forceinline__ int crow(int r, int hi) { return (r & 3) + 8 * (r >> 2) + 4 * hi; }
__device__ __forceinline__ void glds16(const void* gsrc, unsigned lds_dst) { unsigned keep;
    asm volatile("s_mov_b32 %0, m0\n\ts_mov_b32 m0, %2\n\ts_nop 0\n\tglobal_load_lds_dwordx4 %1, off\n\ts_mov_b32 m0, %0" : "=&s"(keep) : "v"(gsrc), "s"(lds_dst) : "memory"); }
__device__ __forceinline__ float fadd_s(float a, float b) { float r; asm("v_add_f32_e32 %0, %1, %2" : "=v"(r) : "v"(a), "v"(b)); return r; }
__device__ __forceinline__ float fsub_s(float a, float b) { float r; asm("v_sub_f32_e32 %0, %1, %2" : "=v"(r) : "v"(a), "v"(b)); return r; }
__device__ __forceinline__ float max3f(float a, float b, float c) { float r; asm("v_max3_f32 %0, %1, %2, %3" : "=v"(r) : "v"(a), "v"(b), "v"(c)); return r; }
__device__ __forceinline__ float max2f(float a, float b) { float r; asm("v_max_f32_e32 %0, %1, %2" : "=v"(r) : "v"(a), "v"(b)); return r; }
__device__ __forceinline__ s16x4 vtr(lds_cptr p) { return __builtin_bit_cast(s16x4, __builtin_amdgcn_ds_read_tr16_b64_v4i16((__attribute__((address_space(3))) v4i16_t*)p)); }
template <int NK> __device__ __forceinline__ void kloadall(bf16x8* kf, lds_cptr kp) {
#pragma unroll
    for (int j = 0; j < NK; ++j) { kf[2 * j] = *(const LAS bf16x8*)(kp + j * 2048); kf[2 * j + 1] = *(const LAS bf16x8*)(kp + j * 2048 + 512); } }
__device__ __forceinline__ void kload2(bf16x8* kf, lds_cptr kp, int j) { kf[2 * j] = *(const LAS bf16x8*)(kp + j * 2048); kf[2 * j + 1] = *(const LAS bf16x8*)(kp + j * 2048 + 512); }
__device__ __forceinline__ void cmask(f32x16& p0, f32x16& p1, int koff, int qtok, int hi) {
    const int x = qtok - koff - 4 * hi;
#pragma unroll
    for (int r = 0; r < 16; ++r) { const int c = (r & 3) + 8 * (r >> 2); if (c > x) p0[r] = -INFINITY; if (c + 32 > x) p1[r] = -INFINITY; }
}
__device__ __forceinline__ void wmask(f32x16& p0, f32x16& p1, int thr, int hi) {
    const int y = thr - 4 * hi;
#pragma unroll
    for (int r = 0; r < 16; ++r) { const int c = (r & 3) + 8 * (r >> 2); if (c < y) p0[r] = -INFINITY; if (c + 32 < y) p1[r] = -INFINITY; }
}
__device__ __forceinline__ float rowmax(const f32x16& p0, const f32x16& p1) {
    float a = max3f(p0[0], p0[1], p1[0]), b = max3f(p0[2], p0[3], p1[1]); a = max3f(a, p1[2], p1[3]);
#pragma unroll
    for (int r = 4; r < 16; r += 4) { a = max3f(a, p0[r], p0[r + 1]); b = max3f(b, p0[r + 2], p0[r + 3]); a = max3f(a, p1[r], p1[r + 1]); b = max3f(b, p1[r + 2], p1[r + 3]); }
    const float m = max2f(a, b);
    auto rr = __builtin_amdgcn_permlane32_swap(__float_as_uint(m), __float_as_uint(m), false, false);
    return max2f(__uint_as_float(rr[0]), __uint_as_float(rr[1]));
}

enum { MODE_CAUSAL = 0, MODE_FOX = 1, MODE_WIN = 2 };
struct UnitArgs {
    const bf16_t* qrow;
    const bf16_t* K; const bf16_t* V; int kvpitch, vpitch;
    bf16_t* obase; int opitch;
    int qtok;
    int abase;
    int nsteps;
    const LAS float* bias;
};

template <int NB> __device__ __forceinline__ int seq(int i, int abase) { return (i < NB) ? abase + i : abase + NB - 1 - i; }

template <int MODE, bool GQA4, int THRL, int DQ>
__device__ __forceinline__ void attn_unit(const UnitArgs& A, char* shm) {
    constexpr int NB = GQA4 ? 1 : 4;
    typedef Geo<DQ> G; constexpr int NK = G::NK, KSLOT = G::KSLOT, LDS_K = G::LDS_K, LDS_V = G::LDS_V, LDS_WS = G::LDS_WS, LDS_OST = G::LDS_OST, QWAVE = G::QWAVE;
    constexpr bool USE_NEGM = (MODE != MODE_FOX);
    int tid_ = threadIdx.x; asm volatile("" : "+v"(tid_));
    const int tid = tid_, lane = tid & 63, r32 = lane & 31, hi = lane >> 5; const int wid = __builtin_amdgcn_readfirstlane(tid >> 6);
    const unsigned lds0 = (unsigned)(uintptr_t)shm;
    float* wsf = (float*)(shm + LDS_WS) + wid * 64;
    const int NT = A.nsteps, abase = A.abase; const long kvp = A.kvpitch, vvp = A.vpitch;
    const bf16_t* ksrc = A.K + (long)lane * kvp + wid * 8;
    const bf16_t* ksrc2 = A.K + (long)lane * kvp + (8 + (wid & 3)) * 8;
    const bf16_t* vsrc = A.V + (long)(16 * (wid & 3) + (lane >> 2)) * vvp + (wid >> 2) * 32 + (lane & 3) * 8;
    const unsigned kdst = lds0 + LDS_K + wid * 1024, vdst = lds0 + LDS_V + wid * 1024, kdst2 = lds0 + LDS_K + (8 + wid) * 1024;
#define TILE_OF(t) ({ int a_ = seq<NB>((t), abase); a_ < 0 ? 0 : a_; })
#define DMA_K(t, slot) do { const long to_ = (long)TILE_OF(t) * 64 * kvp; glds16(ksrc + to_, (unsigned)__builtin_amdgcn_readfirstlane(kdst + (slot) * KSLOT)); \
        if (DQ == 96) glds16(ksrc2 + to_, (unsigned)__builtin_amdgcn_readfirstlane(kdst2 + (slot) * KSLOT)); } while (0)
#define DMA_V(t, slot) glds16(vsrc + (long)TILE_OF(t) * 64 * vvp, (unsigned)__builtin_amdgcn_readfirstlane(vdst + (slot) * VSLOT))
    const lds_cptr shm3 = (lds_cptr)shm; const lds_cptr kp0 = shm3 + LDS_K + hi * 1024 + r32 * 16;
    const lds_cptr vp0 = shm3 + LDS_V + ((lane >> 4) & 1) * 32 + (lane & 3) * 8 + (4 * hi + ((lane & 15) >> 2)) * 64;
    const int vb0 = (int)(lds0 + LDS_V) + ((lane >> 4) & 1) * 32 + (lane & 3) * 8 + (4 * hi + ((lane & 15) >> 2)) * 64;
    DMA_K(0, 0); DMA_V(0, 0); DMA_K(1, 1);
    bf16x8 qr[NK];
#pragma unroll
    for (int d0 = 0; d0 < NK; ++d0) qr[d0] = *reinterpret_cast<const bf16x8*>(A.qrow + d0 * 16 + hi * 8);
    const lds_cptr qlp = shm3 + LDS_OST + wid * QWAVE + hi * 512 + r32 * 16;
    if (DQ == 96) {
#pragma unroll
        for (int d0 = 0; d0 < NK; ++d0) *(LAS bf16x8*)(const_cast<__attribute__((address_space(3))) char*>(qlp) + d0 * 1024) = qr[d0];
    }
#define QL(d0) (*(const LAS bf16x8*)(qlp + (d0) * 1024))
    float mhat = 0.f, l_reg = 0.f; f32x16 o[2]; o[0] = f32x16{}; o[1] = f32x16{};
    f32x16 negm = f32x16{}; if (USE_NEGM) asm volatile("" : "+v"(negm));
    const int qtok = A.qtok;
#define CMASK(P0, P1, t) do { const int t_ = (t); if (t_ < NB) cmask(P0, P1, 64 * t_, qtok, hi); \
        else { const int a_ = abase + NB - 1 - t_; if (a_ < 0) wmask(P0, P1, 64, hi); \
               else if (MODE == MODE_WIN) { const int thr_ = qtok - 511 + 64 * (abase - a_); if (thr_ > 0) wmask(P0, P1, thr_, hi); } } } while (0)
#define CINIT1(C, t, OFF) do { if (MODE == MODE_FOX) { const LAS float* bt_ = A.bias + 64 * (seq<NB>((t), abase) - (abase + NB - NT)) + 4 * hi + (OFF); const float nm_ = -mhat; \
        _Pragma("unroll") for (int g_ = 0; g_ < 4; ++g_) { const f32x4 b_ = *(const LAS f32x4*)(bt_ + 8 * g_); C[4 * g_] = b_.x; C[4 * g_ + 1] = b_.y; C[4 * g_ + 2] = b_.z; C[4 * g_ + 3] = b_.w; } \
        _Pragma("unroll") for (int r_ = 0; r_ < 16; ++r_) C[r_] += nm_; asm volatile("" : "+v"(C)); } \
      else if (USE_NEGM) { C = negm; } \
      else { const float nm_ = -mhat; _Pragma("unroll") for (int r_ = 0; r_ < 16; ++r_) C[r_] = nm_; asm volatile("" : "+v"(C)); } } while (0)
#define CINIT(C0, C1, t) do { CINIT1(C0, t, 0); CINIT1(C1, t, 32); } while (0)
    bool resc = false;
#define START(P0, P1) do { const float rm = rowmax(P0, P1); resc = false; \
    { const float dl = rm; mhat = fadd_s(mhat, dl); \
      _Pragma("unroll") for (int r = 0; r < 16; ++r) { P0[r] = fsub_s(P0[r], dl); P1[r] = fsub_s(P1[r], dl); } \
      if (USE_NEGM) { _Pragma("unroll") for (int r = 0; r < 16; ++r) negm[r] = -mhat; asm volatile("" : "+v"(negm)); } } \
    _Pragma("unroll") for (int r = 0; r < 16; ++r) P0[r] = __builtin_amdgcn_exp2f(P0[r]); } while (0)
#define RESC() do { if (resc) { asm volatile("s_waitcnt lgkmcnt(0)" ::: "memory"); \
      const float* wsh_ = wsf + 4 * hi; \
      _Pragma("unroll") for (int d_ = 0; d_ < 2; ++d_) _Pragma("unroll") for (int r = 0; r < 16; ++r) o[d_][r] *= wsh_[(r & 3) + 8 * (r >> 2)]; } } while (0)
    f32x16 pA0, pA1, pB0, pB1; bf16x8 kf[2 * NK];
    int sl_prev = 0, sl_cur = 0, sl_next = 1;
#define ROT() do { sl_prev = sl_cur; sl_cur = sl_next; sl_next = (sl_next == NSLOT - 1) ? 0 : sl_next + 1; } while (0)
    DMA_K(2, 2);
    if (DQ == 96) { AWAIT_BAR(5); } else { AWAIT_BAR(3); }
    { const char* kb = shm + LDS_K + hi * 1024 + r32 * 16;
      CINIT(pA0, pA1, 0);
#pragma unroll
      for (int d0 = 0; d0 < NK; ++d0) {
          const bf16x8 b0 = *reinterpret_cast<const bf16x8*>(kb + d0 * 2048);
          const bf16x8 b1 = *reinterpret_cast<const bf16x8*>(kb + d0 * 2048 + 512);
          pA0 = __builtin_amdgcn_mfma_f32_32x32x16_bf16(b0, qr[d0], pA0, 0, 0, 0); pA1 = __builtin_amdgcn_mfma_f32_32x32x16_bf16(b1, qr[d0], pA1, 0, 0, 0); } }
    asm volatile("s_nop 15\n\ts_nop 7" : "+v"(pA0), "+v"(pA1)); CMASK(pA0, pA1, 0);
    START(pA0, pA1);
    _Pragma("unroll") for (int r = 0; r < 16; ++r) pA1[r] = __builtin_amdgcn_exp2f(pA1[r]);
    AWAIT_BAR(0);
    DMA_K(3, 0); DMA_V(1, 1);
    ROT();
    kloadall<NK>(kf, kp0 + sl_cur * KSLOT);
    if (DQ == 96) { AWAIT_BAR(3); } else { AWAIT_BAR(2); }
    s16x4 vlo[(DQ == 96) ? 4 : 8], vhi[(DQ == 96) ? 4 : 8]; u32x4 pw0, pw1, pw2, pw3;
#define PKW(P, B) cvtpk(P[B], P[B + 1])
#define PAF(k) __builtin_bit_cast(bf16x8, pw##k)
#define VFR(i) (bf16x8){vlo[i][0], vlo[i][1], vlo[i][2], vlo[i][3], vhi[i][0], vhi[i][1], vhi[i][2], vhi[i][3]}
#define PIN(x) asm volatile("" : "+v"(x))
#define MX3(a, b, c) __builtin_fmaxf(__builtin_fmaxf((a), (b)), (c))
#define GAPA(MF, A0, A1, A2, A3, W0, W1, PW) do { MF; sacc += A0; sacc += A1; sacc += A2; sacc += A3; PIN(sacc); W0; W1; PIN(PW); ASBAR(); } while (0)
#define EX(v) __builtin_amdgcn_exp2f(v)
#define GAPB(MF, X, B) do { MF; X[B] = EX(X[B]); X[B + 1] = EX(X[B + 1]); X[B + 2] = EX(X[B + 2]); X[B + 3] = EX(X[B + 3]); PIN(X); ASBAR(); } while (0)
#define VRD(i) do { vlo[i] = vtr(vp_ + (((i) >> 2) * 4096 + ((i) & 3) * 1024)); vhi[i] = vtr(vp_ + (((i) >> 2) * 4096 + ((i) & 3) * 1024 + 512)); } while (0)
#define KRD(G_, j) do { if (G_) { kload2(kf, kp0 + sl_next * KSLOT, j); ASBAR(); } } while (0)
#define MFMA32(a, b, c) __builtin_amdgcn_mfma_f32_32x32x16_bf16(a, b, c, 0, 0, 0)
#define STEP64(C0, C1, P0, P1, t, GK, GV, GL, DOMASK) do { ASBAR(); \
    const lds_cptr vp_ = vp0 + sl_prev * VSLOT; \
    CINIT1(C0, t, 0); ASBAR(); \
    VRD(0); ASBAR(); float sacc = (P0[0] + P0[1]); \
    GAPA(C0 = MFMA32(kf[0], qr[0], C0), P0[2], P0[3], P0[4], P0[5],     pw0[0] = PKW(P0, 0), pw0[1] = PKW(P0, 2), pw0); \
    CINIT1(C1, t, 32); ASBAR(); \
    VRD(4); ASBAR(); GAPA(C1 = MFMA32(kf[1], qr[0], C1), P0[6], P0[7], P0[8], P0[9],     pw0[2] = PKW(P0, 4), pw0[3] = PKW(P0, 6), pw0); \
    VRD(1); ASBAR(); GAPA(C0 = MFMA32(kf[2], qr[1], C0),   P0[10], P0[11], P0[12], P0[13], pw1[0] = PKW(P0, 8), pw1[1] = PKW(P0, 10), pw1); \
    VRD(5); ASBAR(); GAPA(C1 = MFMA32(kf[3], qr[1], C1),   P0[14], P0[15], P1[0], P1[1],   pw1[2] = PKW(P0, 12), pw1[3] = PKW(P0, 14), pw1); \
    VRD(2); ASBAR(); GAPA(C0 = MFMA32(kf[4], qr[2], C0),   P1[2], P1[3], P1[4], P1[5],     pw2[0] = PKW(P1, 0), pw2[1] = PKW(P1, 2), pw2); \
    VRD(6); ASBAR(); GAPA(C1 = MFMA32(kf[5], qr[2], C1),   P1[6], P1[7], P1[8], P1[9],     pw2[2] = PKW(P1, 4), pw2[3] = PKW(P1, 6), pw2); \
    VRD(3); ASBAR(); GAPA(C0 = MFMA32(kf[6], qr[3], C0),   P1[10], P1[11], P1[12], P1[13], pw3[0] = PKW(P1, 8), pw3[1] = PKW(P1, 10), pw3); \
    VRD(7); ASBAR(); GAPA(C1 = MFMA32(kf[7], qr[3], C1),   P1[14], P1[15], 0.f, 0.f,       pw3[2] = PKW(P1, 12), pw3[3] = PKW(P1, 14), pw3); \
    l_reg += sacc; \
    if (GK) { DMA_K((t) + 3, sl_cur); } if (GV) { DMA_V((t) + 1, sl_next); } \
    if (DOMASK) CMASK(C0, C1, t); \
    { float a = MX3(C0[0], C0[1], C1[0]), b = MX3(C0[2], C0[3], C1[1]); a = MX3(a, C1[2], C1[3]); \
      _Pragma("unroll") for (int r = 4; r < 16; r += 4) { a = MX3(a, C0[r], C0[r + 1]); b = MX3(b, C0[r + 2], C0[r + 3]); a = MX3(a, C1[r], C1[r + 1]); b = MX3(b, C1[r + 2], C1[r + 3]); } \
      float rm = __builtin_fmaxf(a, b); { auto rr = __builtin_amdgcn_permlane32_swap(__float_as_uint(rm), __float_as_uint(rm), false, false); rm = __builtin_fmaxf(__uint_as_float(rr[0]), __uint_as_float(rr[1])); } \
      resc = false; \
      if (__builtin_expect(__any(rm > (float)THRL), 0)) { const float dl = __builtin_fmaxf(rm, 0.f); mhat += dl; \
        _Pragma("unroll") for (int r = 0; r < 16; ++r) { C0[r] -= dl; C1[r] -= dl; } \
        if (USE_NEGM) { _Pragma("unroll") for (int r = 0; r < 16; ++r) negm[r] = -mhat; asm volatile("" : "+v"(negm)); } \
        const float f = __builtin_amdgcn_exp2f(-dl); l_reg *= f; if (hi == 0) wsf[r32] = f; resc = true; } } \
    ASBAR(); \
    GAPB(o[0] = MFMA32(PAF(0), VFR(0), o[0]), C0, 0); \
    GAPB(o[1] = MFMA32(PAF(0), VFR(4), o[1]), C0, 4); \
    KRD(GL, 0); GAPB(o[0] = MFMA32(PAF(1), VFR(1), o[0]), C0, 8); \
    KRD(GL, 1); GAPB(o[1] = MFMA32(PAF(1), VFR(5), o[1]), C0, 12); \
    KRD(GL, 2); GAPB(o[0] = MFMA32(PAF(2), VFR(2), o[0]), C1, 0); \
    KRD(GL, 3); GAPB(o[1] = MFMA32(PAF(2), VFR(6), o[1]), C1, 4); \
    GAPB(o[0] = MFMA32(PAF(3), VFR(3), o[0]), C1, 8); \
    GAPB(o[1] = MFMA32(PAF(3), VFR(7), o[1]), C1, 12); \
    } while (0)
#define AWAIT_STEADY() do { if (DQ == 96) { AWAIT_BAR(3); } else { AWAIT_BAR(2); } } while (0)
#define VRD4(i, b) do { vlo[b] = vtr(vp_ + (((i) >> 2) * 4096 + ((i) & 3) * 1024)); vhi[b] = vtr(vp_ + (((i) >> 2) * 4096 + ((i) & 3) * 1024 + 512)); } while (0)
#define VFR4(b) (bf16x8){vlo[b][0], vlo[b][1], vlo[b][2], vlo[b][3], vhi[b][0], vhi[b][1], vhi[b][2], vhi[b][3]}
#define GAPQ(MF, QLD, A0, A1, A2, A3, W0, W1, PW) do { MF; QLD; sacc += A0; sacc += A1; sacc += A2; sacc += A3; PIN(sacc); W0; W1; PIN(PW); ASBAR(); } while (0)
#define STEP96(C0, C1, P0, P1, t, GK, GV, GL, DOMASK) do { ASBAR(); \
    const lds_cptr vp_ = vp0 + sl_prev * VSLOT; \
    CINIT1(C0, t, 0); CINIT1(C1, t, 32); bf16x8 qa = QL(0), qb; ASBAR(); \
    float sacc = (P0[0] + P0[1]); \
    GAPQ(C0 = MFMA32(kf[0], qa, C0), qb = QL(1), P0[2], P0[3], P0[4], P0[5],     pw0[0] = PKW(P0, 0), pw0[1] = PKW(P0, 2), pw0); \
    GAPQ(C1 = MFMA32(kf[1], qa, C1), (void)0,    P0[6], P0[7], P0[8], P0[9],     pw0[2] = PKW(P0, 4), pw0[3] = PKW(P0, 6), pw0); \
    GAPQ(C0 = MFMA32(kf[2], qb, C0), qa = QL(2), P0[10], P0[11], P0[12], P0[13], pw1[0] = PKW(P0, 8), pw1[1] = PKW(P0, 10), pw1); \
    GAPQ(C1 = MFMA32(kf[3], qb, C1), (void)0,    P0[14], P0[15], P1[0], P1[1],   pw1[2] = PKW(P0, 12), pw1[3] = PKW(P0, 14), pw1); \
    GAPQ(C0 = MFMA32(kf[4], qa, C0), qb = QL(3), P1[2], P1[3], P1[4], P1[5],     pw2[0] = PKW(P1, 0), pw2[1] = PKW(P1, 2), pw2); \
    GAPQ(C1 = MFMA32(kf[5], qa, C1), (void)0,    P1[6], P1[7], P1[8], P1[9],     pw2[2] = PKW(P1, 4), pw2[3] = PKW(P1, 6), pw2); \
    GAPQ(C0 = MFMA32(kf[6], qb, C0), qa = QL(4), P1[10], P1[11], P1[12], P1[13], pw3[0] = PKW(P1, 8), pw3[1] = PKW(P1, 10), pw3); \
    GAPQ(C1 = MFMA32(kf[7], qb, C1), (void)0,    P1[14], P1[15], 0.f, 0.f,       pw3[2] = PKW(P1, 12), pw3[3] = PKW(P1, 14), pw3); \
    C0 = MFMA32(kf[8], qa, C0); qb = QL(5); VRD4(0, 0); ASBAR(); \
    C1 = MFMA32(kf[9], qa, C1); VRD4(4, 1); ASBAR(); \
    C0 = MFMA32(kf[10], qb, C0); ASBAR(); \
    C1 = MFMA32(kf[11], qb, C1); ASBAR(); \
    l_reg += sacc; \
    if (GK) { DMA_K((t) + 3, sl_cur); } if (GV) { DMA_V((t) + 1, sl_next); } \
    if (DOMASK) CMASK(C0, C1, t); \
    { float a = MX3(C0[0], C0[1], C1[0]), b = MX3(C0[2], C0[3], C1[1]); a = MX3(a, C1[2], C1[3]); \
      _Pragma("unroll") for (int r = 4; r < 16; r += 4) { a = MX3(a, C0[r], C0[r + 1]); b = MX3(b, C0[r + 2], C0[r + 3]); a = MX3(a, C1[r], C1[r + 1]); b = MX3(b, C1[r + 2], C1[r + 3]); } \
      float rm = __builtin_fmaxf(a, b); { auto rr = __builtin_amdgcn_permlane32_swap(__float_as_uint(rm), __float_as_uint(rm), false, false); rm = __builtin_fmaxf(__uint_as_float(rr[0]), __uint_as_float(rr[1])); } \
      resc = false; \
      if (__builtin_expect(__any(rm > (float)THRL), 0)) { const float dl = __builtin_fmaxf(rm, 0.f); mhat += dl; \
        _Pragma("unroll") for (int r = 0; r < 16; ++r) { C0[r] -= dl; C1[r] -= dl; } \
        if (USE_NEGM) { _Pragma("unroll") for (int r = 0; r < 16; ++r) negm[r] = -mhat; asm volatile("" : "+v"(negm)); } \
        const float f = __builtin_amdgcn_exp2f(-dl); l_reg *= f; if (hi == 0) wsf[r32] = f; resc = true; } } \
    ASBAR(); \
    VRD4(1, 2); ASBAR(); GAPB(o[0] = MFMA32(PAF(0), VFR4(0), o[0]), C0, 0); \
    VRD4(5, 3); ASBAR(); GAPB(o[1] = MFMA32(PAF(0), VFR4(1), o[1]), C0, 4); \
    VRD4(2, 0); KRD(GL, 0); GAPB(o[0] = MFMA32(PAF(1), VFR4(2), o[0]), C0, 8); \
    VRD4(6, 1); KRD(GL, 1); GAPB(o[1] = MFMA32(PAF(1), VFR4(3), o[1]), C0, 12); \
    VRD4(3, 2); KRD(GL, 2); GAPB(o[0] = MFMA32(PAF(2), VFR4(0), o[0]), C1, 0); \
    VRD4(7, 3); KRD(GL, 3); GAPB(o[1] = MFMA32(PAF(2), VFR4(1), o[1]), C1, 4); \
    KRD(GL, 4); GAPB(o[0] = MFMA32(PAF(3), VFR4(2), o[0]), C1, 8); \
    KRD(GL, 5); GAPB(o[1] = MFMA32(PAF(3), VFR4(3), o[1]), C1, 12); \
    } while (0)
#define STEP(C0, C1, P0, P1, t, GK, GV, GL, DOMASK) do { if constexpr (DQ == 96) { STEP96(C0, C1, P0, P1, t, GK, GV, GL, DOMASK); } else { STEP64(C0, C1, P0, P1, t, GK, GV, GL, DOMASK); } } while (0)
#define ENDW(tt) do { if ((tt) + 3 < NT) { AWAIT_STEADY(); } else if ((tt) + 2 < NT) { AWAIT_BAR(1); } else { AWAIT_BAR(0); } } while (0)
    int t = 1;
    for (; t < 5 && t + 1 < NT; t += 2) {
        STEP(pB0, pB1, pA0, pA1, t, (t + 3 < NT), (t + 1 < NT), (t + 1 < NT), true);       ENDW(t);     RESC(); ROT();
        STEP(pA0, pA1, pB0, pB1, t + 1, (t + 4 < NT), (t + 2 < NT), (t + 2 < NT), true);   ENDW(t + 1); RESC(); ROT();
    }
    for (; t + 5 < NT; t += 2) {
        STEP(pB0, pB1, pA0, pA1, t, true, true, true, false);     AWAIT_STEADY(); RESC(); ROT();
        STEP(pA0, pA1, pB0, pB1, t + 1, true, true, true, false); AWAIT_STEADY(); RESC(); ROT();
    }
    for (; t + 1 < NT; t += 2) {
        STEP(pB0, pB1, pA0, pA1, t, (t + 3 < NT), (t + 1 < NT), (t + 1 < NT), true);       ENDW(t);     RESC(); ROT();
        STEP(pA0, pA1, pB0, pB1, t + 1, (t + 4 < NT), (t + 2 < NT), (t + 2 < NT), true);   ENDW(t + 1); RESC(); ROT();
    }
    STEP(pB0, pB1, pA0, pA1, NT - 1, false, false, false, true); RESC();
    { float sacc = pB0[0] + pB0[1];
      _Pragma("unroll") for (int r = 2; r < 16; ++r) sacc += pB0[r];
      _Pragma("unroll") for (int r = 0; r < 16; ++r) sacc += pB1[r];
      l_reg += sacc;
      pw0 = (u32x4){PKW(pB0, 0), PKW(pB0, 2), PKW(pB0, 4), PKW(pB0, 6)}; pw1 = (u32x4){PKW(pB0, 8), PKW(pB0, 10), PKW(pB0, 12), PKW(pB0, 14)};
      pw2 = (u32x4){PKW(pB1, 0), PKW(pB1, 2), PKW(pB1, 4), PKW(pB1, 6)}; pw3 = (u32x4){PKW(pB1, 8), PKW(pB1, 10), PKW(pB1, 12), PKW(pB1, 14)};
      ASBAR();
      const int vb = vb0 + sl_cur * VSLOT;
#pragma unroll
      for (int d0 = 0; d0 < 2; ++d0) { s16x4 lo[4], hh[4];
#pragma unroll
          for (int ks = 0; ks < 4; ++ks) {
              asm volatile("ds_read_b64_tr_b16 %0,%1 offset:%c2" : "=&v"(lo[ks]) : "v"(vb), "i"(d0 * 4096 + ks * 1024) : "memory");
              asm volatile("ds_read_b64_tr_b16 %0,%1 offset:%c2" : "=&v"(hh[ks]) : "v"(vb), "i"(d0 * 4096 + ks * 1024 + 512) : "memory"); }
          asm volatile("s_waitcnt lgkmcnt(0)" ::: "memory"); ASBAR();
#define PK(k) (bf16x8){lo[k][0], lo[k][1], lo[k][2], lo[k][3], hh[k][0], hh[k][1], hh[k][2], hh[k][3]}
          o[d0] = MFMA32(PAF(0), PK(0), o[d0]); o[d0] = MFMA32(PAF(1), PK(1), o[d0]); o[d0] = MFMA32(PAF(2), PK(2), o[d0]); o[d0] = MFMA32(PAF(3), PK(3), o[d0]);
#undef PK
      } }
    { auto rr = __builtin_amdgcn_permlane32_swap(__float_as_uint(l_reg), __float_as_uint(l_reg), false, false); l_reg = __uint_as_float(rr[0]) + __uint_as_float(rr[1]); }
    if (hi == 0) wsf[32 + r32] = l_reg; asm volatile("s_waitcnt lgkmcnt(0)" ::: "memory");
    int lane_e = lane; asm volatile("" : "+v"(lane_e)); const int hi_e = lane_e >> 5, r32_e = lane_e & 31;
    float rli[16];
    { const float* wl_ = wsf + 32 + 4 * hi_e;
#pragma unroll
      for (int r = 0; r < 16; ++r) rli[r] = __builtin_amdgcn_rcpf(wl_[(r & 3) + 8 * (r >> 2)]); }
    { bf16_t* stg = (bf16_t*)(shm + LDS_OST + wid * QWAVE);
      bf16_t* stl = stg + (4 * hi_e) * 64 + r32_e;
#pragma unroll
      for (int r = 0; r < 16; ++r) {
#pragma unroll
          for (int d0 = 0; d0 < 2; ++d0) stl[((r & 3) + 8 * (r >> 2)) * 64 + d0 * 32] = f2bf(o[d0][r] * rli[r]); }
      asm volatile("s_waitcnt lgkmcnt(0)" ::: "memory");
#pragma unroll
      for (int i = 0; i < 4; ++i) { const int row = i * 8 + (lane_e >> 3), ch = lane_e & 7; const u32x4 v = *(const u32x4*)(stg + row * 64 + ch * 8);
          bf16_t* dst = GQA4 ? (A.obase + (long)(8 * wid + (row >> 2)) * A.opitch + (row & 3) * 64) : (A.obase + (long)(32 * wid + row) * A.opitch);
          *(u32x4*)(dst + ch * 8) = v; } }
    asm volatile("s_waitcnt lgkmcnt(0)\n\ts_barrier" ::: "memory");
#undef TILE_OF
#undef DMA_K
#undef DMA_V
#undef CMASK
#undef CINIT
#undef START
#undef RESC
#undef ROT
#undef PKW
#undef PAF
#undef VFR
#undef PIN
#undef MX3
#undef GAPA
#undef GAPB
#undef EX
#undef VRD
#undef KRD
#undef MFMA32
#undef STEP
#undef STEP64
#undef STEP96
#undef VRD4
#undef VFR4
#undef GAPQ
#undef QL
#undef ENDW
#undef AWAIT_STEADY
}
}
constexpr int MK_THREADS = 512;
constexpr int LDS_RING = 131072;
constexpr int LDS_X = LDS_RING;
constexpr int LDS_MOD = LDS_RING + 8192;
constexpr int LDS_BARST = 155648 - 16;
constexpr int LDS_TOTAL = 155648;

#define C2Q 0.18033688011112042f
#define LOG2E 1.4426950408889634f

struct BlkDesc { bf16_t* dst; const float* gain; int pitch; int flags; float scale; int csoff; };
#define C2M 0.14724312203508865f
struct MKP {
    const float* in[34];
    float* out;
    float* modpart;
    float* mod;
    float* cosT; float* sinT;
    bf16_t* W_in0t;
    bf16_t* W_out0t;
    bf16_t* XN;
    bf16_t* OATT;
    bf16_t* QN;
    bf16_t* KV6;
    bf16_t* FQ; bf16_t* FK; bf16_t* FV;
    float* GATES;
    float* LOGF;
    BlkDesc* desc0;
    float* CUMB;
    BlkDesc* desc_uq;
    BlkDesc* desc_ukv;
    bf16_t* W_in1t;
    bf16_t* W_uqt;
    bf16_t* W_ukvt;
    bf16_t* W_out1t;
    bf16_t* P1;
    bf16_t* CQN;
    bf16_t* CKVN;
    bf16_t* Q96;
    bf16_t* K96;
    bf16_t* V1;
    bf16_t* WcT;
    float* CBIAS;
    bf16_t* KCMP;
    bf16_t* VCT;
    bf16_t* KSLF;
    bf16_t* VSLF;
    bf16_t* OCMP;
    bf16_t* OWIN;
    const int* pos;
    bf16_t* Wgu;
    bf16_t* Wd;
    bf16_t* HID;
    bf16_t* YS;
    bf16_t* YBUF;
    int* gcnt;
    int* list;
    float* ew;
    unsigned* barw;
    int ph_lo, ph_hi, dbg_flags, pad_;
};

__device__ __forceinline__ int swap45(int p) { return (p & 15) | ((p & 16) << 1) | ((p & 32) >> 1); }

template <class Map>
__device__ __forceinline__ void tr_item(const float* __restrict__ W, int ldw, int K, bf16_t* WT, LAS float* scr, int kb, int nb, int lane, const Map& cmap, const float* kscale) {
    const int k0 = 64 * kb, n0 = 32 * nb;
    const int sc = cmap(n0 + (lane & 31));
    float v[32];
    const float* src = W + (size_t)(k0 + (lane >> 5)) * ldw + (sc >= 0 ? sc : 0);
#pragma unroll
    for (int i = 0; i < 32; ++i) v[i] = src[(size_t)(2 * i) * ldw];
    if (kscale) {
#pragma unroll
        for (int i = 0; i < 32; ++i) v[i] *= kscale[k0 + 2 * i + (lane >> 5)];
    }
#pragma unroll
    for (int i = 0; i < 32; ++i) scr[(2 * i + (lane >> 5)) * 33 + (lane & 31)] = (sc >= 0) ? v[i] : 0.f;
    asm volatile("s_waitcnt lgkmcnt(0)" ::: "memory");
    const int c = lane & 7;
#pragma unroll
    for (int j = 0; j < 4; ++j) {
        const int n = (lane >> 3) + 8 * j; const LAS float* s = scr + (8 * c) * 33 + n;
        u32x4 o; o.x = cvtpk(s[0 * 33], s[1 * 33]); o.y = cvtpk(s[2 * 33], s[3 * 33]); o.z = cvtpk(s[4 * 33], s[5 * 33]); o.w = cvtpk(s[6 * 33], s[7 * 33]);
        *(u32x4*)(WT + (size_t)(n0 + n) * K + k0 + 8 * c) = o;
    }
    asm volatile("s_waitcnt lgkmcnt(0)" ::: "memory");
}
struct MapIn0 {
    __device__ __forceinline__ int operator()(int nn) const {
        const int blk = nn >> 6, p = nn & 63;
        if (blk < 8) return blk * 64 + swap45(p);
        if (blk < 20) return 512 + (blk - 8) * 64 + swap45(p);
        if (blk < 44) return 1304 + (blk - 20) * 64 + swap45(p);
        if (blk == 44) { if (p < 24) return 1280 + p; if (p < 32) return 2840 + (p - 24); return -1; }
        return -1;
    }
};
struct MapId { __device__ __forceinline__ int operator()(int nn) const { return nn; } };
struct MapIn1 { __device__ __forceinline__ int operator()(int nn) const { return nn < 672 ? nn : -1; } };
struct MapUq { __device__ __forceinline__ int operator()(int nn) const { if (nn < 1024) return (nn >> 6) * 96 + swap45(nn & 63); const int r = nn - 1024; return (r >> 5) * 96 + 64 + (r & 31); } };
struct MapUkv { __device__ __forceinline__ int operator()(int nn) const { if (nn < 1024) return (nn >> 6) * 128 + swap45(nn & 63); const int r = nn - 1024; return (r >> 6) * 128 + 64 + swap45(r & 63); } };

namespace nsa {
using att::f32x16; using att::crow;
#define NMFMA32(a, b, c) __builtin_amdgcn_mfma_f32_32x32x16_bf16(a, b, c, 0, 0, 0)
#define NMFMA16(a, b, c) __builtin_amdgcn_mfma_f32_16x16x32_bf16(a, b, c, 0, 0, 0)
#define RLF(x, l) __uint_as_float(__builtin_amdgcn_readlane((int)__float_as_uint(x), (l)))

__device__ __forceinline__ void compress_job(const MKP& p, LAS float* scr, LAS float* part, int job, int slice, int lane) {
    const int nt = job & 31, g = (job >> 5) & 1, kv = job >> 6;
    const int r32 = lane & 31, hi = lane >> 5, n0 = nt * 32;
    const bf16_t* tok = p.KV6 + (size_t)(kv * 2 + g) * S_ * 64;
    const bf16_t* wt = p.WcT + (size_t)kv * 64 * 2048;
    scr[lane] = p.CBIAS[kv * 64 + lane];
    asm volatile("s_waitcnt lgkmcnt(0)" ::: "memory");
    int nrow = n0 + r32; if (nrow > 1022) nrow = 1022;
    const bf16_t* ta = tok + (size_t)(16 * nrow) * 64 + 8 * hi;
    const bf16_t* wa0 = wt + (size_t)r32 * 2048 + 8 * hi;
    const bf16_t* wa1 = wa0 + (size_t)32 * 2048;
    f32x16 c0 = f32x16{}, c1 = f32x16{};
    if (kv == 0) {
#pragma unroll 8
        for (int s = 32 * slice; s < 32 * slice + 32; ++s) {
            const bf16x8 tf = *(const bf16x8*)(ta + 16 * s), w0 = *(const bf16x8*)(wa0 + 16 * s), w1 = *(const bf16x8*)(wa1 + 16 * s);
            c0 = NMFMA32(w0, tf, c0); c1 = NMFMA32(w1, tf, c1);
        }
        if (slice) {
#pragma unroll
            for (int r = 0; r < 16; ++r) { part[r * 64 + lane] = c0[r]; part[(16 + r) * 64 + lane] = c1[r]; } }
        __syncthreads();
        if (slice) return;
#pragma unroll
        for (int q = 1; q < 4; ++q)
#pragma unroll
            for (int r = 0; r < 16; ++r) { c0[r] += part[q * 2048 + r * 64 + lane]; c1[r] += part[q * 2048 + (16 + r) * 64 + lane]; }
        float ss = 0.f;
#pragma unroll
        for (int r = 0; r < 16; ++r) { c0[r] += scr[crow(r, hi)]; c1[r] += scr[32 + crow(r, hi)]; ss += c0[r] * c0[r] + c1[r] * c1[r]; }
        { auto rr = __builtin_amdgcn_permlane32_swap(__float_as_uint(ss), __float_as_uint(ss), false, false); ss = __uint_as_float(rr[0]) + __uint_as_float(rr[1]); }
        const float rs = rsqrtf(ss * (1.f / 64.f) + EPSF);
        const float* gn = p.in[10];
        if (n0 + r32 < 1023) {
            bf16_t* dst = p.KCMP + ((size_t)g * 1024 + n0 + r32) * 64;
#pragma unroll
            for (int q = 0; q < 4; ++q) {
                const int e0 = 8 * q + 4 * hi;
                const f32x4 ga = *(const f32x4*)(gn + e0), gb = *(const f32x4*)(gn + 32 + e0);
                u32x2 wa, wb;
                wa.x = cvtpk(c0[4 * q] * rs * ga.x, c0[4 * q + 1] * rs * ga.y); wa.y = cvtpk(c0[4 * q + 2] * rs * ga.z, c0[4 * q + 3] * rs * ga.w);
                wb.x = cvtpk(c1[4 * q] * rs * gb.x, c1[4 * q + 1] * rs * gb.y); wb.y = cvtpk(c1[4 * q + 2] * rs * gb.z, c1[4 * q + 3] * rs * gb.w);
                *(u32x2*)(dst + e0) = wa; *(u32x2*)(dst + 32 + e0) = wb;
            }
        }
    } else {
#pragma unroll 8
        for (int s = 32 * slice; s < 32 * slice + 32; ++s) {
            const bf16x8 tf = *(const bf16x8*)(ta + 16 * s), w0 = *(const bf16x8*)(wa0 + 16 * s), w1 = *(const bf16x8*)(wa1 + 16 * s);
            c0 = NMFMA32(tf, w0, c0); c1 = NMFMA32(tf, w1, c1);
        }
        if (slice) {
#pragma unroll
            for (int r = 0; r < 16; ++r) { part[r * 64 + lane] = c0[r]; part[(16 + r) * 64 + lane] = c1[r]; } }
        __syncthreads();
        if (slice) return;
#pragma unroll
        for (int q = 1; q < 4; ++q)
#pragma unroll
            for (int r = 0; r < 16; ++r) { c0[r] += part[q * 2048 + r * 64 + lane]; c1[r] += part[q * 2048 + (16 + r) * 64 + lane]; }
        const float b0 = scr[r32], b1 = scr[32 + r32];
#pragma unroll
        for (int G = 0; G < 2; ++G) {
            u32x4 va, vb;
            va.x = cvtpk(c0[8 * G] + b0, c0[8 * G + 1] + b0); va.y = cvtpk(c0[8 * G + 2] + b0, c0[8 * G + 3] + b0); va.z = cvtpk(c0[8 * G + 4] + b0, c0[8 * G + 5] + b0); va.w = cvtpk(c0[8 * G + 6] + b0, c0[8 * G + 7] + b0);
            vb.x = cvtpk(c1[8 * G] + b1, c1[8 * G + 1] + b1); vb.y = cvtpk(c1[8 * G + 2] + b1, c1[8 * G + 3] + b1); vb.z = cvtpk(c1[8 * G + 4] + b1, c1[8 * G + 5] + b1); vb.w = cvtpk(c1[8 * G + 6] + b1, c1[8 * G + 7] + b1);
            *(u32x4*)(p.VCT + ((size_t)g * 64 + r32) * 1024 + n0 + 16 * G + 8 * hi) = va;
            *(u32x4*)(p.VCT + ((size_t)g * 64 + 32 + r32) * 1024 + n0 + 16 * G + 8 * hi) = vb;
        }
    }
    asm volatile("s_waitcnt lgkmcnt(0)" ::: "memory");
}

__device__ __forceinline__ unsigned pk4_fp8(float a, float b, float c, float d) { int w = __builtin_amdgcn_cvt_pk_fp8_f32(a, b, 0, false); w = __builtin_amdgcn_cvt_pk_fp8_f32(c, d, w, true); return (unsigned)w; }
__device__ __forceinline__ void slcfrag_job(const MKP& p, int job, int lane) {
    const int g = job >> 8, blk = job & 255, c16 = lane & 15, u = lane >> 4;
    const bf16_t* k = p.KV6 + (size_t)(2 * 2 + g) * S_ * 64 + (size_t)blk * 64 * 64;
    const bf16_t* v = p.KV6 + (size_t)(3 * 2 + g) * S_ * 64 + (size_t)blk * 64 * 64;
    unsigned char* kd = (unsigned char*)p.KSLF + ((size_t)g * 256 + blk) * 4096 + lane * 16;
    unsigned char* vd = (unsigned char*)p.VSLF + ((size_t)g * 256 + blk) * 4096 + lane * 16;
#pragma unroll
    for (int kg = 0; kg < 4; ++kg) {
        const u32x4 a = *(const u32x4*)(k + (size_t)(16 * kg + c16) * 64 + 8 * u), b = *(const u32x4*)(k + (size_t)(16 * kg + c16) * 64 + 32 + 8 * u);
        u32x4 o;
        o.x = pk4_fp8(__uint_as_float(a.x << 16), __uint_as_float(a.x & 0xffff0000u), __uint_as_float(a.y << 16), __uint_as_float(a.y & 0xffff0000u));
        o.y = pk4_fp8(__uint_as_float(a.z << 16), __uint_as_float(a.z & 0xffff0000u), __uint_as_float(a.w << 16), __uint_as_float(a.w & 0xffff0000u));
        o.z = pk4_fp8(__uint_as_float(b.x << 16), __uint_as_float(b.x & 0xffff0000u), __uint_as_float(b.y << 16), __uint_as_float(b.y & 0xffff0000u));
        o.w = pk4_fp8(__uint_as_float(b.z << 16), __uint_as_float(b.z & 0xffff0000u), __uint_as_float(b.w << 16), __uint_as_float(b.w & 0xffff0000u));
        *(u32x4*)(kd + kg * 1024) = o;
    }
#pragma unroll
    for (int dg = 0; dg < 4; ++dg) {
        float x[16];
#pragma unroll
        for (int ch = 0; ch < 2; ++ch)
#pragma unroll
            for (int j = 0; j < 8; ++j) { const int key = 32 * ch + ((j < 4) ? 4 * u + j : 16 + 4 * u + (j - 4)); x[ch * 8 + j] = bf2f(v[(size_t)key * 64 + 16 * dg + c16]); }
        u32x4 o; o.x = pk4_fp8(x[0], x[1], x[2], x[3]); o.y = pk4_fp8(x[4], x[5], x[6], x[7]); o.z = pk4_fp8(x[8], x[9], x[10], x[11]); o.w = pk4_fp8(x[12], x[13], x[14], x[15]);
        *(u32x4*)(vd + dg * 1024) = o;
    }
}

constexpr int IMP_LD = 272;
__device__ __forceinline__ void cmp_wave(const MKP& p, int g, int t0w, LAS float* imp, LAS unsigned char* stg, int lane) {
    const int r32 = lane & 31, hi = lane >> 5;
    const int tq = t0w + (r32 >> 2), head = g * 4 + (r32 & 3);
    const int nmax = (tq >= 31) ? ((tq - 31) >> 4) : -1;
    const int nmaxw = (t0w + 7 >= 31) ? ((t0w + 7 - 31) >> 4) : -1;
    const int ntile = (nmaxw >> 6) + 1;
    for (int i = lane; i < 8 * IMP_LD; i += 64) imp[i] = 0.f;
    bf16x8 qr[4];
#pragma unroll
    for (int d0 = 0; d0 < 4; ++d0) qr[d0] = *(const bf16x8*)(p.QN + (size_t)tq * 512 + head * 64 + d0 * 16 + hi * 8);
    const bf16_t* kc = p.KCMP + (size_t)g * 1024 * 64 + (size_t)r32 * 64 + 8 * hi;
    bf16x8 ovf[4];
#pragma unroll
    for (int ks = 0; ks < 4; ++ks)
#pragma unroll
        for (int j = 0; j < 8; ++j) {
            const int nrel = 16 * ks + ((j < 4) ? 4 * hi + j : 8 + 4 * hi + (j - 4));
            const int dlt = nrel - 4 * r32;
            const float w = (dlt >= 0 && dlt <= 2) ? 2.f : ((dlt == 3 || dlt == -1) ? 1.f : 0.f);
            ovf[ks][j] = (short)f2bf(w);
        }
#define CKLOAD(dst, c_) do { const bf16_t* kt_ = kc + (size_t)(c_) * 64 * 64; _Pragma("unroll") for (int d0_ = 0; d0_ < 4; ++d0_) { dst[2 * d0_] = *(const bf16x8*)(kt_ + 16 * d0_); dst[2 * d0_ + 1] = *(const bf16x8*)(kt_ + 32 * 64 + 16 * d0_); } } while (0)
#define CQK(s0, s1, kf) do { s0 = f32x16{}; s1 = f32x16{}; _Pragma("unroll") for (int d0_ = 0; d0_ < 4; ++d0_) { s0 = NMFMA32(kf[2 * d0_], qr[d0_], s0); s1 = NMFMA32(kf[2 * d0_ + 1], qr[d0_], s1); } } while (0)
    float m = -INFINITY, l = 0.f;
    bf16x8 kfa[8], kfb[8];
    if (ntile > 0) CKLOAD(kfa, 0);
#define CMP_P1(KC, KN, c) do { { const int cn_ = ((c) + 1 < ntile) ? (c) + 1 : ntile - 1; CKLOAD(KN, cn_); } \
        f32x16 s0, s1; CQK(s0, s1, KC); \
        const int x = nmax - 64 * (c) - 4 * hi; float tm = -INFINITY; \
        _Pragma("unroll") for (int r = 0; r < 16; ++r) { const int cc = (r & 3) + 8 * (r >> 2); if (cc > x) s0[r] = -INFINITY; if (cc + 32 > x) s1[r] = -INFINITY; tm = fmaxf(tm, fmaxf(s0[r], s1[r])); } \
        if (tm > m) { l *= __builtin_amdgcn_exp2f(m - tm); m = tm; } \
        if (m > -INFINITY) { float sum = 0.f; _Pragma("unroll") for (int r = 0; r < 16; ++r) sum += __builtin_amdgcn_exp2f(s0[r] - m) + __builtin_amdgcn_exp2f(s1[r] - m); l += sum; } } while (0)
#pragma unroll 1
    for (int c = 0; c < ntile; c += 2) { CMP_P1(kfa, kfb, c); if (c + 1 < ntile) CMP_P1(kfb, kfa, c + 1); }
    { auto rm = __builtin_amdgcn_permlane32_swap(__float_as_uint(m), __float_as_uint(m), false, false);
      auto rl = __builtin_amdgcn_permlane32_swap(__float_as_uint(l), __float_as_uint(l), false, false);
      const float ma = __uint_as_float(rm[0]), mb = __uint_as_float(rm[1]), la = __uint_as_float(rl[0]), lb = __uint_as_float(rl[1]);
      const float mm = fmaxf(ma, mb);
      if (mm > -INFINITY) { l = ((ma > -INFINITY) ? la * __builtin_amdgcn_exp2f(ma - mm) : 0.f) + ((mb > -INFINITY) ? lb * __builtin_amdgcn_exp2f(mb - mm) : 0.f); m = mm; }
      else { l = 0.f; m = 0.f; } }
    const float invl = (l > 0.f) ? 1.f / l : 0.f;
    f32x16 o0 = f32x16{}, o1 = f32x16{};
    const bf16_t* vc = p.VCT + (size_t)g * 64 * 1024 + (size_t)r32 * 1024 + 8 * hi;
    if (ntile > 0) CKLOAD(kfa, 0);
    bf16x8 vfr[8];
#define CMP_P2(KC, KN, c) do { \
        { const bf16_t* vt_ = vc + (c) * 64; _Pragma("unroll") for (int ks_ = 0; ks_ < 4; ++ks_) { vfr[2 * ks_] = *(const bf16x8*)(vt_ + 16 * ks_); vfr[2 * ks_ + 1] = *(const bf16x8*)(vt_ + 32 * 1024 + 16 * ks_); } } \
        { const int cn_ = ((c) + 1 < ntile) ? (c) + 1 : ntile - 1; CKLOAD(KN, cn_); } \
        f32x16 s0, s1; CQK(s0, s1, KC); \
        const int x = nmax - 64 * (c) - 4 * hi; \
        _Pragma("unroll") for (int r = 0; r < 16; ++r) { const int cc = (r & 3) + 8 * (r >> 2); \
            s0[r] = (cc > x) ? 0.f : __builtin_amdgcn_exp2f(s0[r] - m) * invl; s1[r] = (cc + 32 > x) ? 0.f : __builtin_amdgcn_exp2f(s1[r] - m) * invl; } \
        u32x4 pw[4]; \
        pw[0] = (u32x4){cvtpk(s0[0], s0[1]), cvtpk(s0[2], s0[3]), cvtpk(s0[4], s0[5]), cvtpk(s0[6], s0[7])}; \
        pw[1] = (u32x4){cvtpk(s0[8], s0[9]), cvtpk(s0[10], s0[11]), cvtpk(s0[12], s0[13]), cvtpk(s0[14], s0[15])}; \
        pw[2] = (u32x4){cvtpk(s1[0], s1[1]), cvtpk(s1[2], s1[3]), cvtpk(s1[4], s1[5]), cvtpk(s1[6], s1[7])}; \
        pw[3] = (u32x4){cvtpk(s1[8], s1[9]), cvtpk(s1[10], s1[11]), cvtpk(s1[12], s1[13]), cvtpk(s1[14], s1[15])}; \
        f32x16 im = f32x16{}; \
        _Pragma("unroll") for (int ks = 0; ks < 4; ++ks) { const bf16x8 pa = __builtin_bit_cast(bf16x8, pw[ks]); \
            o0 = NMFMA32(pa, vfr[2 * ks], o0); o1 = NMFMA32(pa, vfr[2 * ks + 1], o1); im = NMFMA32(pa, ovf[ks], im); } \
        if (r32 <= 16 && 16 * (c) + r32 < 256) { \
            _Pragma("unroll") for (int k = 0; k < 4; ++k) { const float v = (im[4 * k] + im[4 * k + 1]) + (im[4 * k + 2] + im[4 * k + 3]); atomicAdd((float*)(imp + (2 * k + hi) * IMP_LD + 16 * (c) + r32), v); } } } while (0)
#pragma unroll 1
    for (int c = 0; c < ntile; c += 2) { CMP_P2(kfa, kfb, c); if (c + 1 < ntile) CMP_P2(kfb, kfa, c + 1); }
#undef CMP_P1
#undef CMP_P2
#undef CKLOAD
#undef CQK
    { bf16_t* st = (bf16_t*)stg; bf16_t* stl = st + (4 * hi) * 64 + r32;
#pragma unroll
      for (int r = 0; r < 16; ++r) { stl[((r & 3) + 8 * (r >> 2)) * 64] = f2bf(o0[r]); stl[((r & 3) + 8 * (r >> 2)) * 64 + 32] = f2bf(o1[r]); }
      asm volatile("s_waitcnt lgkmcnt(0)" ::: "memory");
#pragma unroll
      for (int i = 0; i < 4; ++i) { const int row = i * 8 + (lane >> 3), ch = lane & 7; const u32x4 v = *(const u32x4*)(st + row * 64 + ch * 8);
          *(u32x4*)(p.OCMP + (size_t)(t0w + (row >> 2)) * 512 + (g * 4 + (row & 3)) * 64 + ch * 8) = v; }
      asm volatile("s_waitcnt lgkmcnt(0)" ::: "memory"); }
}

__device__ __forceinline__ float dpp_f(float v, int ctrl_sel) {
    const int x = __float_as_int(v);
    int r;
    if (ctrl_sel == 0) r = __builtin_amdgcn_update_dpp(x, x, 0xB1, 0xF, 0xF, false);
    else if (ctrl_sel == 1) r = __builtin_amdgcn_update_dpp(x, x, 0x4E, 0xF, 0xF, false);
    else if (ctrl_sel == 2) r = __builtin_amdgcn_update_dpp(x, x, 0x124, 0xF, 0xF, false);
    else r = __builtin_amdgcn_update_dpp(x, x, 0x128, 0xF, 0xF, false);
    return __int_as_float(r);
}
__device__ __forceinline__ int dpp_i(int x, int ctrl_sel) {
    if (ctrl_sel == 0) return __builtin_amdgcn_update_dpp(x, x, 0xB1, 0xF, 0xF, false);
    if (ctrl_sel == 1) return __builtin_amdgcn_update_dpp(x, x, 0x4E, 0xF, 0xF, false);
    if (ctrl_sel == 2) return __builtin_amdgcn_update_dpp(x, x, 0x124, 0xF, 0xF, false);
    return __builtin_amdgcn_update_dpp(x, x, 0x128, 0xF, 0xF, false);
}
__device__ __forceinline__ void select_wave(int t0w, const LAS float* imp, LAS int* sel, int lane) {
    const int sub = lane & 31;
#pragma unroll 1
    for (int h = 0; h < 4; ++h) {
        const int tk = 2 * h + (lane >> 5);
        const int tq = t0w + tk, cur = tq >> 6;
        float v[8];
#pragma unroll
        for (int i = 0; i < 8; ++i) { const int j = sub + 32 * i; float x = imp[tk * IMP_LD + j]; if (j == 0 || j == cur || j == cur - 1) x += 1e6f; v[i] = (j <= cur) ? x : -INFINITY; }
#pragma unroll 1
        for (int it = 0; it < 16; ++it) {
            float bv = v[0]; int bi = 0;
#pragma unroll
            for (int i = 1; i < 8; ++i) if (v[i] > bv) { bv = v[i]; bi = i; }
            float gm = bv;
#pragma unroll
            for (int c = 0; c < 4; ++c) gm = fmaxf(gm, dpp_f(gm, c));
            gm = fmaxf(gm, __shfl_xor(gm, 16));
            int cj = (bv == gm) ? sub + 32 * bi : 0x7fffffff;
#pragma unroll
            for (int c = 0; c < 4; ++c) cj = min(cj, dpp_i(cj, c));
            cj = min(cj, __shfl_xor(cj, 16));
            const bool any = gm > -INFINITY;
            if (sub == 0) sel[tk * 16 + it] = any ? cj : -1;
            if (any && (cj & 31) == sub) { const int wi = cj >> 5;
#pragma unroll
                for (int i = 0; i < 8; ++i) if (i == wi) v[i] = -INFINITY; }
        }
    }
    asm volatile("s_waitcnt lgkmcnt(0)" ::: "memory");
}

__device__ __forceinline__ void slc_wave(const MKP& p, int g, int t0w, const LAS int* sel, LAS float* oslc, int lane) {
    const int c16 = lane & 15, u = lane >> 4, ti = c16 >> 2;
    const unsigned char* kb = (const unsigned char*)p.KSLF + (size_t)g * 256 * 4096 + lane * 16;
    const unsigned char* vb = (const unsigned char*)p.VSLF + (size_t)g * 256 * 4096 + lane * 16;
#define LO64(vv_) ((long)(((unsigned long long)(vv_).y << 32) | (vv_).x))
#define HI64(vv_) ((long)(((unsigned long long)(vv_)[3] << 32) | (vv_).z))
#define FMFMA(a, b, c) __builtin_amdgcn_mfma_f32_16x16x32_fp8_fp8(a, b, c, 0, 0, 0)
#define KLOAD4(r_) do { _Pragma("unroll") for (int i_ = 0; i_ < 4; ++i_) { int b_ = sel[(tg * 4 + i_) * 16 + (r_)]; b_ = b_ < 0 ? 0 : b_; const unsigned char* kp_ = kb + (size_t)b_ * 4096; \
        _Pragma("unroll") for (int f_ = 0; f_ < 4; ++f_) kc[i_][f_] = *(const u32x4*)(kp_ + f_ * 1024); } } while (0)
#pragma unroll 1
    for (int tg = 0; tg < 2; ++tg) {
        const int tq = t0w + tg * 4 + ti;
        long qa, qb2;
        { const bf16_t* qp = p.QN + (size_t)tq * 512 + (g * 4 + (c16 & 3)) * 64 + 8 * u;
          const u32x4 r0 = *(const u32x4*)qp, r1 = *(const u32x4*)(qp + 32);
          const unsigned a0 = pk4_fp8(8.f * __uint_as_float(r0.x << 16), 8.f * __uint_as_float(r0.x & 0xffff0000u), 8.f * __uint_as_float(r0.y << 16), 8.f * __uint_as_float(r0.y & 0xffff0000u));
          const unsigned a1 = pk4_fp8(8.f * __uint_as_float(r0.z << 16), 8.f * __uint_as_float(r0.z & 0xffff0000u), 8.f * __uint_as_float(r0.w << 16), 8.f * __uint_as_float(r0.w & 0xffff0000u));
          const unsigned b0 = pk4_fp8(8.f * __uint_as_float(r1.x << 16), 8.f * __uint_as_float(r1.x & 0xffff0000u), 8.f * __uint_as_float(r1.y << 16), 8.f * __uint_as_float(r1.y & 0xffff0000u));
          const unsigned b1 = pk4_fp8(8.f * __uint_as_float(r1.z << 16), 8.f * __uint_as_float(r1.z & 0xffff0000u), 8.f * __uint_as_float(r1.w << 16), 8.f * __uint_as_float(r1.w & 0xffff0000u));
          qa = (long)(((unsigned long long)a1 << 32) | a0); qb2 = (long)(((unsigned long long)b1 << 32) | b0); }
        long q0[4], q1[4];
#pragma unroll
        for (int i = 0; i < 4; ++i) { q0[i] = (ti == i) ? qa : 0; q1[i] = (ti == i) ? qb2 : 0; }
        u32x4 kc[4][4], vf[4][4];
        KLOAD4(0);
        float m = -INFINITY, l = 0.f;
        f32x4 o[4]; o[0] = o[1] = o[2] = o[3] = (f32x4){0.f, 0.f, 0.f, 0.f};
#pragma unroll 1
        for (int r = 0; r < 16; ++r) {
#pragma unroll
            for (int i = 0; i < 4; ++i) { int b_ = sel[(tg * 4 + i) * 16 + r]; b_ = b_ < 0 ? 0 : b_; const unsigned char* vp = vb + (size_t)b_ * 4096;
#pragma unroll
                for (int dg = 0; dg < 4; ++dg) vf[i][dg] = *(const u32x4*)(vp + dg * 1024); }
            f32x4 s[4];
#pragma unroll
            for (int kg = 0; kg < 4; ++kg) { f32x4 c = (f32x4){0.f, 0.f, 0.f, 0.f};
#pragma unroll
                for (int i = 0; i < 4; ++i) { c = FMFMA(LO64(kc[i][kg]), q0[i], c); c = FMFMA(HI64(kc[i][kg]), q1[i], c); }
                s[kg] = c * 0.125f; }
            { const int rn = (r < 15) ? r + 1 : 15; KLOAD4(rn); }
            const int myblk = sel[(tg * 4 + ti) * 16 + r];
            { const int x = (myblk < 0) ? -1 : ((myblk == (tq >> 6)) ? tq - 64 * myblk - 4 * u : 64);
#pragma unroll
              for (int kg = 0; kg < 4; ++kg) { if (16 * kg > x) s[kg].x = -INFINITY; if (16 * kg + 1 > x) s[kg].y = -INFINITY; if (16 * kg + 2 > x) s[kg].z = -INFINITY; if (16 * kg + 3 > x) s[kg].w = -INFINITY; } }
            float tm = -INFINITY;
#pragma unroll
            for (int kg = 0; kg < 4; ++kg) tm = fmaxf(tm, fmaxf(fmaxf(s[kg].x, s[kg].y), fmaxf(s[kg].z, s[kg].w)));
            tm = fmaxf(tm, __shfl_xor(tm, 16)); tm = fmaxf(tm, __shfl_xor(tm, 32));
            float alpha = 1.f;
            if (tm > m) { alpha = __builtin_amdgcn_exp2f(m - tm); m = tm; }
            l *= alpha;
            float sum = 0.f;
#pragma unroll
            for (int kg = 0; kg < 4; ++kg) { s[kg].x = __builtin_amdgcn_exp2f(s[kg].x - m); s[kg].y = __builtin_amdgcn_exp2f(s[kg].y - m); s[kg].z = __builtin_amdgcn_exp2f(s[kg].z - m); s[kg].w = __builtin_amdgcn_exp2f(s[kg].w - m);
                sum += (s[kg].x + s[kg].y) + (s[kg].z + s[kg].w); }
            l += sum;
            { const float a0 = __shfl(alpha, 4 * u), a1 = __shfl(alpha, 4 * u + 1), a2 = __shfl(alpha, 4 * u + 2), a3 = __shfl(alpha, 4 * u + 3);
#pragma unroll
              for (int dg = 0; dg < 4; ++dg) { o[dg].x *= a0; o[dg].y *= a1; o[dg].z *= a2; o[dg].w *= a3; } }
#pragma unroll
            for (int ch = 0; ch < 2; ++ch) {
                const f32x4 pa_ = s[2 * ch] * 128.f, pb_ = s[2 * ch + 1] * 128.f;
                const unsigned lo_ = pk4_fp8(pa_.x, pa_.y, pa_.z, pa_.w), hi_ = pk4_fp8(pb_.x, pb_.y, pb_.z, pb_.w);
                const long pa = (long)(((unsigned long long)hi_ << 32) | lo_);
#pragma unroll
                for (int i = 0; i < 4; ++i) { const long pi = (ti == i) ? pa : 0;
#pragma unroll
                    for (int dg = 0; dg < 4; ++dg) o[dg] = FMFMA(pi, ch ? HI64(vf[i][dg]) : LO64(vf[i][dg]), o[dg]); }
            }
        }
        { float lt = l; lt += __shfl_xor(lt, 16); lt += __shfl_xor(lt, 32);
          const float il = (lt > 0.f) ? (1.f / 128.f) / lt : 0.f;
          const float i0 = __shfl(il, 4 * u), i1 = __shfl(il, 4 * u + 1), i2 = __shfl(il, 4 * u + 2), i3 = __shfl(il, 4 * u + 3);
          LAS float* op = oslc + (tg * 4 + u) * 256 + c16;
#pragma unroll
          for (int dg = 0; dg < 4; ++dg) { op[16 * dg] = o[dg].x * i0; op[64 + 16 * dg] = o[dg].y * i1; op[128 + 16 * dg] = o[dg].z * i2; op[192 + 16 * dg] = o[dg].w * i3; } }
    }
#undef KLOAD4
#undef LO64
#undef HI64
#undef FMFMA
    asm volatile("s_waitcnt lgkmcnt(0)" ::: "memory");
    {
        const int tkl = lane >> 3, cc = (lane & 7) * 32, hh = cc >> 6;
        const int tq = t0w + tkl;
        const float* gt = p.GATES + (size_t)tq * 24 + (g * 4 + hh) * 3;
        const float gc = 1.f / (1.f + __expf(-gt[0])), gs = 1.f / (1.f + __expf(-gt[1])), gw = 1.f / (1.f + __expf(-gt[2]));
        const size_t col = (size_t)tq * 512 + g * 256 + cc;
        const LAS float* os = oslc + tkl * 256 + cc;
#pragma unroll
        for (int q = 0; q < 4; ++q) {
            const u32x4 wc = *(const u32x4*)(p.OCMP + col + 8 * q), ww = *(const u32x4*)(p.OWIN + col + 8 * q);
            const f32x4 sa = *(const LAS f32x4*)(os + 8 * q), sb = *(const LAS f32x4*)(os + 8 * q + 4);
            u32x4 r;
            r.x = cvtpk(gs * sa.x + gc * __uint_as_float(wc.x << 16) + gw * __uint_as_float(ww.x << 16), gs * sa.y + gc * __uint_as_float(wc.x & 0xffff0000u) + gw * __uint_as_float(ww.x & 0xffff0000u));
            r.y = cvtpk(gs * sa.z + gc * __uint_as_float(wc.y << 16) + gw * __uint_as_float(ww.y << 16), gs * sa.w + gc * __uint_as_float(wc.y & 0xffff0000u) + gw * __uint_as_float(ww.y & 0xffff0000u));
            r.z = cvtpk(gs * sb.x + gc * __uint_as_float(wc.z << 16) + gw * __uint_as_float(ww.z << 16), gs * sb.y + gc * __uint_as_float(wc.z & 0xffff0000u) + gw * __uint_as_float(ww.z & 0xffff0000u));
            r.w = cvtpk(gs * sb.z + gc * __uint_as_float(wc.w << 16) + gw * __uint_as_float(ww.w << 16), gs * sb.w + gc * __uint_as_float(wc.w & 0xffff0000u) + gw * __uint_as_float(ww.w & 0xffff0000u));
            *(u32x4*)(p.OATT + (size_t)tq * 1024 + g * 256 + cc + 8 * q) = r;
        }
    }
}

__device__ __forceinline__ void nsa_unit(const MKP& p, char* shm, int g, int tile) {
    int tid_ = threadIdx.x; asm volatile("" : "+v"(tid_));
    const int tid = tid_, lane = tid & 63, r32 = lane & 31; const int wid = __builtin_amdgcn_readfirstlane(tid >> 6);
    const int t0 = tile * 64;
    {   att::UnitArgs A;
        A.qrow = p.QN + (size_t)(t0 + 8 * wid + (r32 >> 2)) * 512 + (g * 4 + (r32 & 3)) * 64;
        A.K = p.KV6 + (size_t)(4 * 2 + g) * S_ * 64; A.V = p.KV6 + (size_t)(5 * 2 + g) * S_ * 64; A.kvpitch = 64; A.vpitch = 64;
        A.obase = p.OWIN + (size_t)t0 * 512 + g * 256; A.opitch = 512;
        A.qtok = 8 * wid + (r32 >> 2); A.abase = tile;
        const int real = (tile + 1 < 9) ? tile + 1 : 9; int nt = (real + 1) & ~1; if (nt < 4) nt = 4;
        A.nsteps = nt; A.bias = nullptr;
        att::attn_unit<att::MODE_WIN, true, 8, 64>(A, shm);
    }
    LAS unsigned char* l3 = (LAS unsigned char*)shm;
    LAS float* imp = (LAS float*)(l3 + wid * (8 * IMP_LD * 4));
    LAS int* sel = (LAS int*)(l3 + 8 * (8 * IMP_LD * 4) + wid * 512);
    LAS unsigned char* stg = l3 + 8 * (8 * IMP_LD * 4) + 8 * 512 + wid * 4096;
    const int t0w = t0 + 8 * wid;
    { int ln = lane; asm volatile("" : "+v"(ln)); cmp_wave(p, g, t0w, imp, stg, ln); }
    asm volatile("s_waitcnt vmcnt(0) lgkmcnt(0)" ::: "memory");
    { int ln = lane; asm volatile("" : "+v"(ln)); select_wave(t0w, imp, sel, ln); }
    { int ln = lane; asm volatile("" : "+v"(ln)); slc_wave(p, g, t0w, sel, imp, ln); }
    asm volatile("s_waitcnt vmcnt(0) lgkmcnt(0)\n\ts_barrier" ::: "memory");
}
#undef NMFMA32
#undef NMFMA16
#undef RLF
}

__device__ __forceinline__ void phase_prologue(const MKP& p, LAS unsigned char* lds) {
    const int tid = threadIdx.x, lane = tid & 63, wave = tid >> 6;
    const int gw = blockIdx.x * 8 + wave, NGW = gridDim.x * 8;
    LAS float* scr = (LAS float*)(lds + wave * 16384);
    for (int it = gw; it < 8 * 192; it += NGW) {
        const int kc = it / 192, ch = it % 192, idx = ch * 64 + lane, l = idx / 6144, n = idx % 6144;
        const float* w = p.in[5] + (size_t)l * 1024 * 6144 + n;
        const float* c = p.in[1];
        float acc = 0.f;
#pragma unroll 8
        for (int k = kc * 128; k < kc * 128 + 128; ++k) { const float cv = c[k]; acc += (cv / (1.f + __expf(-cv))) * w[(size_t)k * 6144]; }
        p.modpart[kc * 12288 + idx] = acc;
    }
    if (blockIdx.x == 1 && tid < 128) p.gcnt[tid] = 0;
    if (blockIdx.x == 0 && tid < 96 + 48 + 64) {
        BlkDesc d; d.dst = nullptr; d.gain = nullptr; d.pitch = 0; d.flags = 4; d.scale = 1.f; d.csoff = 0;
        if (tid < 96) {
            const int blk = (tid >> 3) * 4 + ((tid >> 2) & 1) * 2 + ((tid >> 1) & 1);
            d.flags = 0;
            if (blk < 8) { d.dst = p.QN + blk * 64; d.pitch = 512; d.gain = p.in[9]; d.flags = 1; d.scale = C2Q; }
            else if (blk < 20) { const int j = (blk - 8) >> 1, g = (blk - 8) & 1; d.dst = p.KV6 + (size_t)(j * 2 + g) * S_ * 64; d.pitch = 64;
                d.gain = (j == 2 || j == 4) ? p.in[10] : nullptr; d.flags = (j == 0 || j == 2 || j == 4) ? 1 : 0; }
            else if (blk < 28) { d.dst = p.FQ + (blk - 20) * 64; d.pitch = 512; d.gain = p.in[13]; d.scale = C2Q; }
            else if (blk < 36) { d.dst = p.FK + (blk - 28) * 64; d.pitch = 512; d.gain = p.in[14]; }
            else if (blk < 44) { d.dst = p.FV + (blk - 36) * 64; d.pitch = 512; }
            else if (blk == 44) d.flags = 2;
            else d.flags = 4;
            p.desc0[tid] = d;
        } else if (tid < 96 + 48) {
            const int e = tid - 96, pn = e >> 3, bj = (e >> 2) & 1, wc = e & 3;
            if (pn < 4) { const int h = pn * 4 + bj * 2 + (wc >> 1); d.dst = p.Q96 + (size_t)h * S_ * 96; d.pitch = 96; d.gain = p.in[21]; d.flags = 0; d.scale = C2M; }
            else { const int h = (pn - 4) * 8 + bj * 4 + wc; d.dst = p.Q96 + (size_t)h * S_ * 96 + 64; d.pitch = 96; d.gain = p.in[23]; d.flags = 1 | 8; d.scale = C2M; d.csoff = 32; }
            p.desc_uq[e] = d;
        } else {
            const int e = tid - 144, pn = e >> 3, bj = (e >> 2) & 1, wc = e & 3;
            const int h = (pn & 3) * 4 + bj * 2 + (wc >> 1);
            if (pn < 4) { d.dst = p.K96 + (size_t)h * S_ * 96; d.pitch = 96; d.gain = p.in[22]; d.flags = 0; }
            else { d.dst = p.V1 + (size_t)h * S_ * 64; d.pitch = 64; d.gain = nullptr; d.flags = 0; }
            p.desc_ukv[e] = d;
        }
    }
    if (blockIdx.x == 2 || blockIdx.x == 3) {
        const int kv = blockIdx.x - 2, e = tid & 63, sl = tid >> 6;
        const float* w = p.in[12] + (size_t)kv * 2048 * 64 + e; const float* pe = p.in[11] + kv * 2048;
        float b = 0.f;
#pragma unroll 8
        for (int k = sl * 256; k < sl * 256 + 256; ++k) b += pe[k] * w[(size_t)k * 64];
        LAS float* red = (LAS float*)(lds + 140000);
        red[tid] = b;
        __syncthreads();
        if (tid < 64) { float a = 0.f;
#pragma unroll
            for (int q = 0; q < 8; ++q) a += red[q * 64 + tid];
            p.CBIAS[kv * 64 + tid] = a; }
    }
    for (int idx = blockIdx.x * MK_THREADS + tid; idx < S_ * 48; idx += gridDim.x * MK_THREADS) {
        const int t = idx / 48, i = idx % 48;
        const double ex = (i < 32) ? (double)(2 * i) / 64.0 : (double)(2 * (i - 32)) / 32.0;
        const double a = (double)p.pos[t] * exp(-ex * 9.210340371976184);
        const double r = a - rint(a * 0.15915494309189535) * 6.283185307179586;
        const float rf = (float)r;
        p.cosT[idx] = cosf(rf); p.sinT[idx] = sinf(rf);
    }
    for (int it = gw; it < 2 * 32 * 2; it += NGW) { const int kv = it >> 6, r = it & 63; tr_item(p.in[12] + (size_t)kv * 2048 * 64, 64, 2048, p.WcT + (size_t)kv * 64 * 2048, scr, r >> 1, r & 1, lane, MapId(), nullptr); }
    constexpr int I_IN0 = 16 * 96, I_OUT0 = 16 * 32, I_IN1 = 16 * 24, I_UQ = 6 * 48, I_UKV = 4 * 64, I_OUT1 = 16 * 32;
    for (int it = gw; it < I_IN0 + I_OUT0 + I_IN1 + I_UQ + I_UKV + I_OUT1; it += NGW) {
        int r = it;
        if (r < I_IN0) { tr_item(p.in[7], HYIN, 1024, p.W_in0t, scr, r / 96, r % 96, lane, MapIn0(), nullptr); continue; } r -= I_IN0;
        if (r < I_OUT0) { tr_item(p.in[15], 1024, 1024, p.W_out0t, scr, r / 32, r % 32, lane, MapId(), nullptr); continue; } r -= I_OUT0;
        if (r < I_IN1) { tr_item(p.in[16], 672, 1024, p.W_in1t, scr, r / 24, r % 24, lane, MapIn1(), nullptr); continue; } r -= I_IN1;
        if (r < I_UQ) { tr_item(p.in[19], 1536, 384, p.W_uqt, scr, r / 48, r % 48, lane, MapUq(), p.in[17]); continue; } r -= I_UQ;
        if (r < I_UKV) { tr_item(p.in[20], 2048, 256, p.W_ukvt, scr, r / 64, r % 64, lane, MapUkv(), p.in[18]); continue; } r -= I_UKV;
        tr_item(p.in[25], 1024, 1024, p.W_out1t, scr, r / 32, r % 32, lane, MapId(), nullptr);
    }
}

template <bool COMB>
__device__ __forceinline__ void phase_norm(const MKP& p, LAS unsigned char* lds, const float* x, const float* gw_, int layer, int sc_idx, int sh_idx, bool finalize_mod) {
    const int tid = threadIdx.x, lane = tid & 63, wave = tid >> 6;
    LAS float* msc = (LAS float*)(lds + LDS_MOD);
    LAS float* msh = msc + 1024;
    const float* b_ada = p.in[6];
    if (finalize_mod) {
        for (int i = tid; i < 2048; i += MK_THREADS) {
            const int idx = layer * 6144 + ((i < 1024) ? sc_idx * 1024 + i : sh_idx * 1024 + (i - 1024));
            float a = b_ada[idx];
#pragma unroll
            for (int kc = 0; kc < 8; ++kc) a += p.modpart[kc * 12288 + idx];
            msc[i] = a;
        }
        for (int idx = blockIdx.x * MK_THREADS + tid; idx < 12288; idx += gridDim.x * MK_THREADS) {
            float a = b_ada[idx];
#pragma unroll
            for (int kc = 0; kc < 8; ++kc) a += p.modpart[kc * 12288 + idx];
            p.mod[idx] = a;
        }
    } else {
        for (int i = tid; i < 2048; i += MK_THREADS)
            msc[i] = p.mod[layer * 6144 + ((i < 1024) ? sc_idx * 1024 + i : sh_idx * 1024 + (i - 1024))];
    }
    __syncthreads();
    const int gwv = blockIdx.x * 8 + wave, NGW = gridDim.x * 8;
    for (int m = gwv; m < S_; m += NGW) {
        const f32x4* xr = (const f32x4*)(x + (size_t)m * D_) + lane;
        f32x4 v[4]; float s = 0.f;
#pragma unroll
        for (int j = 0; j < 4; ++j) {
            v[j] = xr[64 * j];
            if (COMB) {
                f32x4 ys = (f32x4){0.f, 0.f, 0.f, 0.f};
#pragma unroll
                for (int k = 0; k < 8; ++k) {
                    const int w = *((const int*)((const char*)p.YBUF + ((size_t)m * 8 + k) * 1024) + lane + 64 * j);
                    const f32x2 lo = __builtin_amdgcn_cvt_pk_f32_fp8(w, false), hi = __builtin_amdgcn_cvt_pk_f32_fp8(w, true);
                    ys.x += lo.x; ys.y += lo.y; ys.z += hi.x; ys.w += hi.y;
                }
                { const u32x2 sw = *((const u32x2*)(p.YS + (size_t)m * 1024) + lane + 64 * j);
                  ys.x += 16.f * __uint_as_float(sw.x << 16); ys.y += 16.f * __uint_as_float(sw.x & 0xffff0000u); ys.z += 16.f * __uint_as_float(sw.y << 16); ys.w += 16.f * __uint_as_float(sw.y & 0xffff0000u); }
                const f32x4 g2v = *(const f32x4*)(p.mod + (layer - 1) * 6144 + 5 * 1024 + 256 * j + 4 * lane) * (1.f / 16.f);
                v[j] = v[j] + g2v * ys;
                ((f32x4*)(p.out + (size_t)m * D_) + lane)[64 * j] = v[j];
            }
            s += (v[j].x * v[j].x + v[j].y * v[j].y) + (v[j].z * v[j].z + v[j].w * v[j].w);
        }
        s = wsum(s);
        const float rstd = rsqrtf(s * (1.f / D_) + EPSF);
        u32x2* o8 = (u32x2*)(p.XN + (size_t)m * D_) + lane;
#pragma unroll
        for (int j = 0; j < 4; ++j) {
            const int c0 = 256 * j + 4 * lane;
            const f32x4 g = *(const f32x4*)(gw_ + c0);
            const f32x4 sc = *(const LAS f32x4*)(msc + c0), sh = *(const LAS f32x4*)(msh + c0);
            const f32x4 y = v[j] * rstd * g * (sc + 1.f) + sh;
            u32x2 w; w.x = cvtpk(y.x, y.y); w.y = cvtpk(y.z, y.w);
            o8[64 * j] = w;
        }
    }
}

struct EpiResid {
    static constexpr bool PERM = true;
    const float* xin; float* out; const float* gate;
    __device__ __forceinline__ void operator()(const f32x4 (&acc)[2][2][4][2], const pg::Unit& u, int wid, int wr, int wc, int fr_, int fq_) const {
        int fr = fr_, fq = fq_; asm volatile("" : "+v"(fr), "+v"(fq));
        const int col0 = u.pn * 256 + wc * 32 + 8 * fq;
        f32x4 g[2][2];
#pragma unroll
        for (int bj = 0; bj < 2; ++bj)
#pragma unroll
            for (int n = 0; n < 2; ++n) g[bj][n] = *(const f32x4*)(gate + col0 + bj * 128 + n * 4);
#pragma unroll
        for (int ai = 0; ai < 2; ++ai)
#pragma unroll
            for (int m = 0; m < 4; ++m) {
                const size_t off = (size_t)(u.pm * 256 + ai * 128 + wr * 64 + m * 16 + fr) * 1024 + col0;
#pragma unroll
                for (int bj = 0; bj < 2; ++bj)
#pragma unroll
                    for (int n = 0; n < 2; ++n) {
                        const f32x4 xv = *(const f32x4*)(xin + off + bj * 128 + n * 4);
                        *(f32x4*)(out + off + bj * 128 + n * 4) = xv + g[bj][n] * acc[ai][bj][m][n];
                    }
                asm volatile("" ::: "memory");
            }
    }
};

struct EpiHeads {
    static constexpr bool PERM = false;
    const BlkDesc* tab; const float* cosT; const float* sinT; float* GATES; float* LOGF; LAS float* X;
    __device__ __forceinline__ void operator()(const f32x4 (&acc)[2][2][4][2], const pg::Unit& u, int wid, int wr, int wc, int fr_, int fq_) const {
        int fr = fr_, fq = fq_; asm volatile("" : "+v"(fr), "+v"(fq));
        const int w1 = wc & 1;
#pragma unroll
        for (int ai = 0; ai < 2; ++ai)
#pragma unroll
            for (int bj = 0; bj < 2; ++bj)
#pragma unroll
                for (int m = 0; m < 4; ++m) {
                    const f32x4 a = acc[ai][bj][m][0], b = acc[ai][bj][m][1];
                    float s = (a.x * a.x + a.y * a.y) + (a.z * a.z + a.w * a.w) + (b.x * b.x + b.y * b.y) + (b.z * b.z + b.w * b.w);
                    s += __shfl_xor(s, 16); s += __shfl_xor(s, 32);
                    if (fq == 0) X[wid * 256 + ((ai * 2 + bj) * 4 + m) * 16 + fr] = s;
                }
        asm volatile("s_waitcnt lgkmcnt(0)" ::: "memory"); __builtin_amdgcn_s_barrier(); asm volatile("" ::: "memory");
#pragma unroll
        for (int bj = 0; bj < 2; ++bj) {
            const BlkDesc d = tab[8 * u.pn + 4 * bj + wc];
            const int row0 = u.pm * 256 + wr * 64 + fr;
            if (d.flags & 4) continue;
            if (d.flags & 2) {
                if (w1 == 0) {
#pragma unroll
                    for (int ai = 0; ai < 2; ++ai)
#pragma unroll
                        for (int m = 0; m < 4; ++m) {
                            const int row = row0 + ai * 128 + m * 16;
#pragma unroll
                            for (int n = 0; n < 2; ++n) {
                                const f32x4 v = acc[ai][bj][m][n];
                                const int pc = 16 * n + 4 * fq;
                                if (pc < 24) *(f32x4*)(GATES + (size_t)row * 24 + pc) = v;
                                else *(f32x4*)(LOGF + (size_t)row * 8 + (pc - 24)) = v;
                            }
                            asm volatile("" ::: "memory");
                        }
                }
                continue;
            }
            const bool half = (d.flags & 8) != 0, has_gain = d.gain != nullptr, rope = (d.flags & 1) != 0;
            const int d0 = half ? 4 * fq : 16 * w1 + 4 * fq;
            const int dn1 = half ? 16 : 32;
            const float invn = half ? (1.f / 32.f) : (1.f / 64.f);
            const GAS float* gp = (const GAS float*)(has_gain ? d.gain : cosT);
            f32x4 g0 = *(const GAS f32x4*)(gp + d0), g1 = *(const GAS f32x4*)(gp + dn1 + d0);
            if (!has_gain) { g0 = (f32x4){1.f, 1.f, 1.f, 1.f}; g1 = g0; }
            g0 = g0 * d.scale; g1 = g1 * d.scale;
            const int cso = d.csoff + d0;
#pragma unroll
            for (int ai = 0; ai < 2; ++ai)
#pragma unroll
                for (int m = 0; m < 4; ++m) {
                    const int row = row0 + ai * 128 + m * 16;
                    const int xi = ((ai * 2 + bj) * 4 + m) * 16 + fr;
                    float ssq = X[wid * 256 + xi]; const float ssp = X[(wid ^ 1) * 256 + xi];
                    if (!half) ssq += ssp;
                    const float rs = has_gain ? rsqrtf(ssq * invn + EPSF) : 1.f;
                    f32x4 x1 = acc[ai][bj][m][0] * rs * g0, x2 = acc[ai][bj][m][1] * rs * g1;
                    f32x4 c = *(const f32x4*)(cosT + (size_t)row * 48 + cso), sn = *(const f32x4*)(sinT + (size_t)row * 48 + cso);
                    if (!rope) { c = (f32x4){1.f, 1.f, 1.f, 1.f}; sn = (f32x4){0.f, 0.f, 0.f, 0.f}; }
                    const f32x4 o1 = x1 * c - x2 * sn, o2 = x2 * c + x1 * sn;
                    u32x2 wa, wb; wa.x = cvtpk(o1.x, o1.y); wa.y = cvtpk(o1.z, o1.w); wb.x = cvtpk(o2.x, o2.y); wb.y = cvtpk(o2.z, o2.w);
                    GAS bf16_t* dr = (GAS bf16_t*)d.dst + (size_t)row * d.pitch + d0;
                    *(GAS u32x2*)dr = wa; *(GAS u32x2*)(dr + dn1) = wb;
                    asm volatile("" ::: "memory");
                }
        }
    }
};

struct EpiPlain {
    static constexpr bool PERM = true;
    bf16_t* O; int ldc;
    __device__ __forceinline__ void operator()(const f32x4 (&acc)[2][2][4][2], const pg::Unit& u, int wid, int wr, int wc, int fr_, int fq_) const {
        int fr = fr_, fq = fq_; asm volatile("" : "+v"(fr), "+v"(fq));
        const int col0 = u.pn * 256 + wc * 32 + 8 * fq;
#pragma unroll
        for (int ai = 0; ai < 2; ++ai)
#pragma unroll
            for (int m = 0; m < 4; ++m) {
                bf16_t* rp = O + (size_t)(u.pm * 256 + ai * 128 + wr * 64 + m * 16 + fr) * ldc + col0;
#pragma unroll
                for (int bj = 0; bj < 2; ++bj) { const f32x4 a = acc[ai][bj][m][0], b = acc[ai][bj][m][1];
                    u32x4 w; w.x = cvtpk(a.x, a.y); w.y = cvtpk(a.z, a.w); w.z = cvtpk(b.x, b.y); w.w = cvtpk(b.z, b.w); *(u32x4*)(rp + bj * 128) = w; }
            }
    }
};

__device__ __forceinline__ void phase_post1a(const MKP& p) {
    int tid_ = threadIdx.x; asm volatile("" : "+v"(tid_));
    const int tid = tid_, lane = tid & 63, wave = tid >> 6;
    const int gwv = blockIdx.x * 8 + wave, NGW = gridDim.x * 8;
    for (int t = gwv; t < S_; t += NGW) {
        const u32x2* row = (const u32x2*)(p.P1 + (size_t)t * 768);
        f32x4 v[3]; float sq = 0.f, skv = 0.f, skr = 0.f;
#pragma unroll
        for (int j = 0; j < 3; ++j) {
            const int g = lane + 64 * j;
            f32x4 x = (f32x4){0.f, 0.f, 0.f, 0.f};
            if (g < 168) { const u32x2 w = row[g]; x.x = __uint_as_float(w.x << 16); x.y = __uint_as_float(w.x & 0xffff0000u); x.z = __uint_as_float(w.y << 16); x.w = __uint_as_float(w.y & 0xffff0000u); }
            v[j] = x;
            const float s = (x.x * x.x + x.y * x.y) + (x.z * x.z + x.w * x.w);
            if (g < 96) sq += s; else if (g < 160) skv += s; else skr += s;
        }
        sq = wsum(sq); skv = wsum(skv); skr = wsum(skr);
        const float rq = rsqrtf(sq * (1.f / 384.f) + EPSF), rkv = rsqrtf(skv * (1.f / 256.f) + EPSF), rkr = rsqrtf(skr * (1.f / 32.f) + EPSF);
#pragma unroll
        for (int j = 0; j < 3; ++j) {
            const int g = lane + 64 * j;
            if (g < 96) { const f32x4 y = v[j] * rq; u32x2 w; w.x = cvtpk(y.x, y.y); w.y = cvtpk(y.z, y.w); *(u32x2*)(p.CQN + (size_t)t * 384 + 4 * g) = w; }
            else if (g < 160) { const f32x4 y = v[j] * rkv; u32x2 w; w.x = cvtpk(y.x, y.y); w.y = cvtpk(y.z, y.w); *(u32x2*)(p.CKVN + (size_t)t * 256 + 4 * (g - 96)) = w; }
        }
        {
            const int dl = (lane - 32) & 7;
            const int dd = 4 * dl;
            const int fi = 4 * (dl & 3);
            f32x4 x = v[2] * rkr;
            const f32x4 gn = *(const f32x4*)(p.in[24] + (dd & 31));
            x = x * gn;
            f32x4 o; o.x = __shfl_xor(x.x, 4); o.y = __shfl_xor(x.y, 4); o.z = __shfl_xor(x.z, 4); o.w = __shfl_xor(x.w, 4);
            const f32x4 c = *(const f32x4*)(p.cosT + (size_t)t * 48 + 32 + fi), sn = *(const f32x4*)(p.sinT + (size_t)t * 48 + 32 + fi);
            const f32x4 y = (dl < 4) ? (x * c - o * sn) : (x * c + o * sn);
            if (lane >= 32 && lane < 40) {
                u32x2 w; w.x = cvtpk(y.x, y.y); w.y = cvtpk(y.z, y.w);
#pragma unroll
                for (int h = 0; h < 16; ++h) *(u32x2*)(p.K96 + ((size_t)h * S_ + t) * 96 + 64 + dd) = w;
            }
        }
    }
}

__device__ __forceinline__ void mla_unit(const MKP& p, char* shm, int h, int qb) {
    int tid_ = threadIdx.x; asm volatile("" : "+v"(tid_));
    const int tid = tid_, lane = tid & 63, r32 = lane & 31; const int wid = __builtin_amdgcn_readfirstlane(tid >> 6);
    const int q0 = qb * 256;
    att::UnitArgs A;
    A.qrow = p.Q96 + ((size_t)h * S_ + q0 + 32 * wid + r32) * 96;
    A.K = p.K96 + (size_t)h * S_ * 96; A.kvpitch = 96; A.V = p.V1 + (size_t)h * S_ * 64; A.vpitch = 64;
    A.obase = p.OATT + (size_t)q0 * 1024 + h * 64; A.opitch = 1024;
    A.qtok = 32 * wid + r32; A.abase = 4 * qb; A.nsteps = 4 * qb + 4; A.bias = nullptr;
    att::attn_unit<att::MODE_CAUSAL, false, 8, 96>(A, shm);
}
__device__ __forceinline__ void phase_mla(const MKP& p, char* shm) {
    const int G = gridDim.x, bx = blockIdx.x;
    const int vcu = (G % 8 == 0) ? (bx % 8) * (G / 8) + bx / 8 : bx;
    for (int u = vcu; u < 256; u += G) {
        const int h = u >> 4, s = u & 15;
#pragma unroll 1
        for (int rep = 0; rep < 4; ++rep) mla_unit(p, shm, h, rep == 0 ? s : rep == 1 ? 31 - s : rep == 2 ? 32 + s : 63 - s);
    }
}

__device__ __forceinline__ void phase_scan(const MKP& p, LAS unsigned char* lds) {
    constexpr int NSB = 64;
    if (blockIdx.x >= NSB) {
        int tid_ = threadIdx.x; asm volatile("" : "+v"(tid_));
        const int lane = tid_ & 63, wave = tid_ >> 6;
        const int sb = blockIdx.x - NSB, NSBK = gridDim.x - NSB;
        LAS float* scr = (LAS float*)(lds + 65536 + wave * 256);
        for (int bj = sb; bj < 64; bj += NSBK) nsa::compress_job(p, scr, (LAS float*)(lds + (wave >> 2) * 32768) + (wave & 3) * 2048, 2 * bj + (wave >> 2), wave & 3, lane);
        for (int j = ((sb + NSBK - 64) % NSBK) * 8 + wave; j < 512; j += NSBK * 8) nsa::slcfrag_job(p, j, lane);
        return;
    }
    const int h = blockIdx.x >> 3, seg = blockIdx.x & 7, tid = threadIdx.x;
    LAS double* part = (LAS double*)lds;
    const float fb = p.in[8][h];
    double own[4], s = 0.0, pre = 0.0;
#pragma unroll
    for (int i = 0; i < 4; ++i) { own[i] = (double)logsigmf(p.LOGF[(size_t)(seg * 2048 + tid * 4 + i) * 8 + h] + fb); s += own[i]; }
    for (int i = tid; i < seg * 2048; i += MK_THREADS) pre += (double)logsigmf(p.LOGF[(size_t)i * 8 + h] + fb);
    part[tid] = s; part[512 + tid] = pre;
    __syncthreads();
    for (int o = 1; o < MK_THREADS; o <<= 1) {
        const double v = (tid >= o) ? part[tid - o] : 0.0, w = (tid >= o) ? part[512 + tid - o] : 0.0;
        __syncthreads();
        part[tid] += v; part[512 + tid] += w;
        __syncthreads();
    }
    double a = part[512 + MK_THREADS - 1] + ((tid > 0) ? part[tid - 1] : 0.0);
#pragma unroll
    for (int i = 0; i < 4; ++i) { a += own[i]; p.CUMB[(size_t)h * S_ + seg * 2048 + tid * 4 + i] = (float)(a * 1.4426950408889634); }
}

__device__ __forceinline__ void fox_unit(const MKP& p, char* shm, int h, int qb) {
    int tid_ = threadIdx.x; asm volatile("" : "+v"(tid_));
    const int tid = tid_, lane = tid & 63, r32 = lane & 31; const int wid = __builtin_amdgcn_readfirstlane(tid >> 6);
    const int q0 = qb * 256, abase = 4 * qb;
    const float* cb = p.CUMB + (size_t)h * S_;
    LAS float* bias = (LAS float*)(LAS unsigned char*)(shm + att::LDS_BIAS);
    LAS int* cnt = (LAS int*)(LAS unsigned char*)(shm + att::Geo<64>::LDS_WS);
    float gq = 0.f, gk = 0.f;
    for (int i = 0; i < 64; ++i) { gq = fmaxf(gq, fabsf(p.in[13][i])); gk = fmaxf(gk, fabsf(p.in[14][i])); }
    const float TH = 150.f + 2.f * (64.f * gq * gk * C2Q * 1.05f);
    const float c0 = cb[q0], cref = cb[q0 + 255];
    const bool skip = (tid < abase) && (cb[64 * tid + 63] - c0 > TH);
    const unsigned long long bal = __ballot(skip);
    if (lane == 0) cnt[wid] = __popcll(bal);
    __syncthreads();
    int alo = 0;
#pragma unroll
    for (int w = 0; w < 8; ++w) alo += cnt[w];
    int NT = abase + 4 - alo;
    if (NT & 1) { alo -= 1; NT += 1; }
    for (int i = tid; i < NT * 64; i += MK_THREADS) bias[i] = cref - cb[64 * alo + i];
    __syncthreads();
    att::UnitArgs A;
    A.qrow = p.FQ + (size_t)(q0 + 32 * wid + r32) * 512 + h * 64;
    A.K = p.FK + h * 64; A.V = p.FV + h * 64; A.kvpitch = 512; A.vpitch = 512;
    A.obase = p.OATT + (size_t)q0 * 1024 + 512 + h * 64; A.opitch = 1024;
    A.qtok = 32 * wid + r32; A.abase = abase; A.nsteps = NT; A.bias = bias;
    att::attn_unit<att::MODE_FOX, false, 8, 64>(A, shm);
}
__device__ __forceinline__ void phase_fox(const MKP& p, char* shm, int part = 3) {
    const int G = gridDim.x, bx = blockIdx.x;
    const int vcu = (G % 8 == 0) ? (bx % 8) * (G / 8) + bx / 8 : bx;
    if (part & 1) for (int u = vcu; u < 256; u += G) {
        const int h = u >> 5, s = u & 31;
#pragma unroll 1
        for (int rep = 0; rep < 2; ++rep) fox_unit(p, shm, h, rep ? 63 - s : s);
    }
    if (part & 2) for (int u = vcu; u < 256; u += G) {
#pragma unroll 1
        for (int rep = 0; rep < 2; ++rep) nsa::nsa_unit(p, shm, rep, rep ? 255 - u : u);
    }
}


struct MapOff { int off; __device__ __forceinline__ int operator()(int nn) const { return off + (nn & 31); } };
__device__ __forceinline__ void phase_moe_weights(const MKP& p, LAS unsigned char* lds, int layer) {
    int tid_ = threadIdx.x; asm volatile("" : "+v"(tid_));
    const int tid = tid_, lane = tid & 63, wave = tid >> 6;
    const int gw = blockIdx.x * 8 + wave, NGW = gridDim.x * 8;
    LAS float* scr = (LAS float*)(lds + wave * 16384);
    constexpr int IG = 16 * 16, ID = 4 * 32, IE = IG + ID;
    for (int it = gw; it < 65 * IE; it += NGW) {
        const int e = it / IE; int r = it % IE;
        if (r < IG) {
            const int kb = r / 16, nb = r % 16;
            const int n0 = nb * 32, up = (n0 >> 7) & 1, f0 = (n0 >> 8) * 128 + (n0 & 127);
            const float* W = (e < 64) ? ((up ? p.in[29] : p.in[28]) + ((size_t)layer * 64 + e) * 1024 * 256) : ((up ? p.in[32] : p.in[31]) + (size_t)layer * 1024 * 256);
            MapOff mo{f0};
            tr_item(W, 256, 1024, p.Wgu + (size_t)e * 512 * 1024, scr, kb, nb, lane, mo, nullptr);
        } else {
            r -= IG; const int kb = r / 32, nb = r % 32;
            const float* W = (e < 64) ? (p.in[30] + ((size_t)layer * 64 + e) * 256 * 1024) : (p.in[33] + (size_t)layer * 256 * 1024);
            tr_item(W, 1024, 256, p.Wd + (size_t)e * 1024 * 256, scr, kb, nb, lane, MapId(), nullptr);
        }
    }
}

template <bool DRY>
__device__ __forceinline__ void phase_moe_route(const MKP& p, LAS unsigned char* lds, int layer) {
    int tid_ = threadIdx.x; asm volatile("" : "+v"(tid_));
    const int tid = tid_, lane = tid & 63, wave = tid >> 6;
    LAS float* msc = (LAS float*)(lds + LDS_MOD);
    LAS float* msh = msc + 1024;
    LAS float* hrow = (LAS float*)lds;
    LAS int* cntl = (LAS int*)(lds + LDS_X);
    LAS int* basel = cntl + 64;
    const float* gnorm = p.in[4] + layer * 1024;
    const float* wr = p.in[26] + (size_t)layer * 1024 * 64;
    const float rb = p.in[27][layer * 64 + lane];
    for (int i = tid; i < 2048; i += MK_THREADS) msc[i] = p.mod[layer * 6144 + ((i < 1024) ? 4 * 1024 + i : 3 * 1024 + (i - 1024))];
    __syncthreads();
    for (int batch = blockIdx.x; batch < S_ / 32; batch += gridDim.x) {
        if (tid < 64) cntl[tid] = 0;
#pragma unroll 1
        for (int i = 0; i < 4; ++i) {
            const int t = batch * 32 + wave * 4 + i;
            const f32x4* xr = (const f32x4*)(p.out + (size_t)t * D_) + lane;
            f32x4 v[4]; float s = 0.f;
#pragma unroll
            for (int j = 0; j < 4; ++j) { v[j] = xr[64 * j]; s += (v[j].x * v[j].x + v[j].y * v[j].y) + (v[j].z * v[j].z + v[j].w * v[j].w); }
            s = wsum(s);
            const float rstd = rsqrtf(s * (1.f / D_) + EPSF);
            u32x2* o8 = (u32x2*)(p.XN + (size_t)t * D_) + lane;
            LAS f32x4* hr = (LAS f32x4*)(hrow + (wave * 4 + i) * 1024) + lane;
#pragma unroll
            for (int j = 0; j < 4; ++j) {
                const int c0 = 256 * j + 4 * lane;
                const f32x4 g = *(const f32x4*)(gnorm + c0);
                const f32x4 sc = *(const LAS f32x4*)(msc + c0), sh = *(const LAS f32x4*)(msh + c0);
                const f32x4 y = v[j] * rstd * g * (sc + 1.f) + sh;
                u32x2 w; w.x = cvtpk(y.x, y.y); w.y = cvtpk(y.z, y.w);
                o8[64 * j] = w; hr[64 * j] = y;
            }
        }
        __syncthreads();
        float acc0 = 0.f, acc1 = 0.f, acc2 = 0.f, acc3 = 0.f;
        const LAS float* h0 = hrow + (wave * 4) * 1024;
#pragma unroll 4
        for (int k = 0; k < 1024; k += 4) {
            const float w0 = wr[(k + 0) * 64 + lane], w1 = wr[(k + 1) * 64 + lane], w2 = wr[(k + 2) * 64 + lane], w3 = wr[(k + 3) * 64 + lane];
            const f32x4 a = *(const LAS f32x4*)(h0 + k), b = *(const LAS f32x4*)(h0 + 1024 + k), c = *(const LAS f32x4*)(h0 + 2048 + k), d = *(const LAS f32x4*)(h0 + 3072 + k);
            acc0 += a.x * w0; acc0 += a.y * w1; acc0 += a.z * w2; acc0 += a.w * w3;
            acc1 += b.x * w0; acc1 += b.y * w1; acc1 += b.z * w2; acc1 += b.w * w3;
            acc2 += c.x * w0; acc2 += c.y * w1; acc2 += c.z * w2; acc2 += c.w * w3;
            acc3 += d.x * w0; acc3 += d.y * w1; acc3 += d.z * w2; acc3 += d.w * w3;
        }
        int myrank[4], mypos[4]; float myw[4];
#pragma unroll
        for (int i = 0; i < 4; ++i) {
            const float logit = (i == 0) ? acc0 : (i == 1) ? acc1 : (i == 2) ? acc2 : acc3;
            const float score = 1.f / (1.f + expf(-logit));
            const float sv = score + rb;
            float m1 = sv;
            m1 = fmaxf(m1, __shfl_xor(m1, 1)); m1 = fmaxf(m1, __shfl_xor(m1, 2)); m1 = fmaxf(m1, __shfl_xor(m1, 4));
            int am = (sv == m1) ? (lane & 7) : 8;
            am = min(am, __shfl_xor(am, 1)); am = min(am, __shfl_xor(am, 2)); am = min(am, __shfl_xor(am, 4));
            float m2 = ((lane & 7) == am) ? -INFINITY : sv;
            m2 = fmaxf(m2, __shfl_xor(m2, 1)); m2 = fmaxf(m2, __shfl_xor(m2, 2)); m2 = fmaxf(m2, __shfl_xor(m2, 4));
            const float gs = m1 + m2;
            const int gi = lane >> 3; int grank = 0;
#pragma unroll
            for (int gj = 0; gj < 8; ++gj) { const float o = __shfl(gs, gj * 8); grank += (o > gs || (o == gs && gj < gi)) ? 1 : 0; }
            const float msk = (grank < 4) ? sv : -1e30f;
            int rank = 0;
#pragma unroll 8
            for (int e = 0; e < 64; ++e) { const float o = __shfl(msk, e); rank += (o > msk || (o == msk && e < lane)) ? 1 : 0; }
            const bool selb = rank < 8;
            const float tot = wsum(selb ? score : 0.f);
            myrank[i] = selb ? rank : -1; myw[i] = score / tot * 2.5f;
            mypos[i] = (selb && !DRY) ? atomicAdd((int*)(cntl + lane), 1) : 0;
        }
        __syncthreads();
        if (tid < 64) basel[tid] = (cntl[tid] > 0 && !DRY) ? atomicAdd(p.gcnt + layer * 64 + tid, cntl[tid]) : 0;
        __syncthreads();
#pragma unroll
        for (int i = 0; i < 4; ++i) if (myrank[i] >= 0 && !DRY) {
            const int t = batch * 32 + wave * 4 + i, slot = t * 8 + myrank[i];
            p.list[(size_t)lane * 16384 + basel[lane] + mypos[i]] = slot;
            p.ew[slot] = myw[i];
        }
        __syncthreads();
    }
}

struct MoeSched {
    const char* A; const char* Bt; const int* list; const LAS int* ustart; const LAS int* hbase; const LAS int* cnt;
    int K, NP, G, c; bool gather; int nexp;
    __device__ __forceinline__ static void tables(LAS int* ustart, LAS int* hbase, LAS int* cnt, const int* gcnt, int NP) {
        const int tid = threadIdx.x;
        if (tid == 0) {
            int us = 0, hb = 0;
            for (int e = 0; e < 65; ++e) { const int c = (e < 64) ? gcnt[e] : S_; const int nrb = (c + 255) >> 8; cnt[e] = c; ustart[e] = us; hbase[e] = hb; us += nrb * NP; hb += nrb * 256; }
            ustart[65] = us; hbase[65] = hb;
        }
        __syncthreads();
    }
    __device__ __forceinline__ bool next(int i, pg::Unit& u, int R0, int C0) const {
        const int L = i * G + c; if (L >= ustart[nexp]) return false;
        const int lane = threadIdx.x & 63;
        const unsigned long long bal = __ballot(lane < 65 && ustart[lane] <= L);
        int e = __popcll(bal) - 1; if (ustart[64] <= L) e = 64;
        const int r = L - ustart[e], rb = r / NP, pn = r % NP;
        u.pm = (hbase[e] >> 8) + rb; u.pn = pn; u.aux = e | (rb << 8);
        u.B = Bt + ((size_t)e * NP + pn) * 256 * K * 2;
        if (gather) {
            u.A = A; const int ce = cnt[e];
#pragma unroll
            for (int q = 0; q < 4; ++q) { const int pos = rb * 256 + R0 + 64 * q; int tok = 0; if (pos < ce) tok = (e < 64) ? (list[(size_t)e * 16384 + pos] >> 3) : pos; u.ra[q] = (unsigned)(tok * K + C0) * 2u; }
        } else {
            u.A = A + (size_t)u.pm * 256 * K * 2;
#pragma unroll
            for (int q = 0; q < 4; ++q) u.ra[q] = (unsigned)((R0 + 64 * q) * K + C0) * 2u;
        }
        return true;
    }
};
struct EpiGateUp {
    static constexpr bool PERM = true;
    bf16_t* HID;
    __device__ __forceinline__ void operator()(const f32x4 (&acc)[2][2][4][2], const pg::Unit& u, int wid, int wr, int wc, int fr_, int fq_) const {
        int fr = fr_, fq = fq_; asm volatile("" : "+v"(fr), "+v"(fq));
        const int col0 = u.pn * 128 + wc * 32 + 8 * fq;
#pragma unroll
        for (int ai = 0; ai < 2; ++ai)
#pragma unroll
            for (int m = 0; m < 4; ++m) {
                bf16_t* rp = HID + (size_t)(u.pm * 256 + ai * 128 + wr * 64 + m * 16 + fr) * 256 + col0;
                float h[8];
#pragma unroll
                for (int n = 0; n < 2; ++n) {
                    const f32x4 g = acc[ai][0][m][n], up = acc[ai][1][m][n];
                    h[4 * n] = g.x / (1.f + __expf(-g.x)) * up.x; h[4 * n + 1] = g.y / (1.f + __expf(-g.y)) * up.y; h[4 * n + 2] = g.z / (1.f + __expf(-g.z)) * up.z; h[4 * n + 3] = g.w / (1.f + __expf(-g.w)) * up.w;
                }
                u32x4 w; w.x = cvtpk(h[0], h[1]); w.y = cvtpk(h[2], h[3]); w.z = cvtpk(h[4], h[5]); w.w = cvtpk(h[6], h[7]); *(u32x4*)rp = w;
            }
    }
};
struct EpiDown {
    static constexpr bool PERM = true;
    bf16_t* YBUF; const int* list; const float* ew; const LAS int* cnt;
    __device__ __forceinline__ void operator()(const f32x4 (&acc)[2][2][4][2], const pg::Unit& u, int wid, int wr, int wc, int fr_, int fq_) const {
        int fr = fr_, fq = fq_; asm volatile("" : "+v"(fr), "+v"(fq));
        const int e = u.aux & 0xff, rb = u.aux >> 8, ce = cnt[e];
        const unsigned colb = (unsigned)(u.pn * 256 + wc * 32 + 8 * fq);
        const int* le = list + (size_t)e * 16384 + rb * 256 + wr * 64 + fr;
        const int pos0 = rb * 256 + wr * 64 + fr;
        int slot[8]; float w[8];
#pragma unroll
        for (int i = 0; i < 8; ++i) { const int pr = (i >> 2) * 128 + (i & 3) * 16; slot[i] = (pos0 + pr < ce) ? le[pr] : -1; }
#pragma unroll
        for (int i = 0; i < 8; ++i) w[i] = (slot[i] >= 0) ? ew[slot[i]] : 0.f;
#pragma unroll
        for (int ai = 0; ai < 2; ++ai)
#pragma unroll
            for (int m = 0; m < 4; ++m) {
                const int i = ai * 4 + m;
                if (slot[i] >= 0) {
                    char* rp = (char*)YBUF + ((unsigned)slot[i] * 1024u + colb);
                    const float ws = w[i] * 16.f;
#pragma unroll
                    for (int bj = 0; bj < 2; ++bj) { const f32x4 a = acc[ai][bj][m][0] * ws, b = acc[ai][bj][m][1] * ws;
                        u32x2 o; o.x = nsa::pk4_fp8(a.x, a.y, a.z, a.w); o.y = nsa::pk4_fp8(b.x, b.y, b.z, b.w); *(u32x2*)(rp + bj * 128) = o; }
                }
            }
    }
};
__device__ __forceinline__ void phase_moe_gemm1(const MKP& p, LAS unsigned char* lds, int layer) {
    LAS int* tb = (LAS int*)(lds + LDS_X);
    MoeSched::tables(tb, tb + 66, tb + 132, p.gcnt + layer * 64, 2);
    const int G = gridDim.x, bx = blockIdx.x, vcu = (G % 8 == 0) ? (bx % 8) * (G / 8) + bx / 8 : bx;
    MoeSched S{(const char*)p.XN, (const char*)p.Wgu, p.list, tb, tb + 66, tb + 132, 1024, 2, G, vcu, true, 65};
    EpiGateUp E{p.HID};
    pg::gemm_run(lds, 1024, S, E);
}
__device__ __forceinline__ void phase_moe_gemm2(const MKP& p, LAS unsigned char* lds, int layer, int which = 3) {
    LAS int* tb = (LAS int*)(lds + LDS_X);
    MoeSched::tables(tb, tb + 66, tb + 132, p.gcnt + layer * 64, 4);
    const int G = gridDim.x, bx = blockIdx.x, vcu = (G % 8 == 0) ? (bx % 8) * (G / 8) + bx / 8 : bx;
    if (which & 1) { MoeSched S{(const char*)p.HID, (const char*)p.Wd, p.list, tb, tb + 66, tb + 132, 256, 4, G, vcu, false, 64};
      EpiDown E{p.YBUF, p.list, p.ew, tb + 132};
      pg::gemm_run(lds, 256, S, E); }
    if (which & 2) {
      pg::DenseSched S; S.init(p.HID + (size_t)tb[66 + 64] * 256, p.Wd + (size_t)64 * 1024 * 256, S_, 1024, 256, G, bx);
      EpiPlain E{p.YS, 1024};
      pg::gemm_run(lds, 256, S, E); }
}
__device__ __forceinline__ void phase_moe_combine(const MKP& p, int layer) {
    int tid_ = threadIdx.x; asm volatile("" : "+v"(tid_));
    const int tid = tid_, lane = tid & 63, wave = tid >> 6;
    const int gwv = blockIdx.x * 8 + wave, NGW = gridDim.x * 8;
    const float* g2 = p.mod + layer * 6144 + 5 * 1024;
    for (int t = gwv; t < S_; t += NGW) {
        f32x4* xr = (f32x4*)(p.out + (size_t)t * D_) + lane;
#pragma unroll
        for (int j = 0; j < 4; ++j) {
            f32x4 s = (f32x4){0.f, 0.f, 0.f, 0.f};
#pragma unroll
            for (int k = 0; k < 8; ++k) {
                const int w = *((const int*)((const char*)p.YBUF + ((size_t)t * 8 + k) * 1024) + lane + 64 * j);
                const f32x2 lo = __builtin_amdgcn_cvt_pk_f32_fp8(w, false), hi = __builtin_amdgcn_cvt_pk_f32_fp8(w, true);
                s.x += lo.x; s.y += lo.y; s.z += hi.x; s.w += hi.y;
            }
            { const u32x2 sw = *((const u32x2*)(p.YS + (size_t)t * 1024) + lane + 64 * j);
              s.x += 16.f * __uint_as_float(sw.x << 16); s.y += 16.f * __uint_as_float(sw.x & 0xffff0000u); s.z += 16.f * __uint_as_float(sw.y << 16); s.w += 16.f * __uint_as_float(sw.y & 0xffff0000u); }
            const f32x4 g = *(const f32x4*)(g2 + 256 * j + 4 * lane) * (1.f / 16.f);
            xr[64 * j] = xr[64 * j] + g * s;
        }
    }
}

#define XB_TMO      128
#define XB_XCNT(j)  (256  + 64 * (j))
#define XB_XSUB(j)  (1280 + 64 * (j))
#define XB_XGEN(j)  (2304 + 64 * (j))
#define XB_TOP      3328
#define XB_TOPGEN   3392
#define XCD_BAR_WORDS 3456
#define XB_SPIN_CAP (1u << 22)
__device__ __forceinline__ unsigned xb_ld(unsigned* p)              { return __hip_atomic_load(p, __ATOMIC_RELAXED, __HIP_MEMORY_SCOPE_AGENT); }
__device__ __forceinline__ unsigned xb_add(unsigned* p, unsigned v) { return __hip_atomic_fetch_add(p, v, __ATOMIC_RELAXED, __HIP_MEMORY_SCOPE_AGENT); }
__device__ __forceinline__ unsigned xb_xcc_id() { return (unsigned)__builtin_amdgcn_s_getreg((3 << 11) | 20) & 0xFu; }
#define XB_SPIN(cond, bar) do { unsigned _sp = 0; while (cond) { __builtin_amdgcn_s_sleep(1); \
    if ((++_sp & 255u) == 0u) { if (xb_ld(&(bar)[XB_TMO])) break; if (_sp > XB_SPIN_CAP) { atomicAdd(&(bar)[XB_TMO], 1u); break; } } } } while (0)
struct XcdBarrier { unsigned* bar; unsigned x; volatile LAS unsigned* st; };
__device__ __forceinline__ XcdBarrier xcd_barrier_post(unsigned* bar, volatile LAS unsigned* st) {
    XcdBarrier b; b.bar = bar; b.x = xb_xcc_id(); b.st = st;
    if (threadIdx.x == 0) (void)xb_add(&bar[XB_XCNT(b.x)], 1u);
    return b;
}
__device__ __forceinline__ void xcd_barrier_complete(unsigned* bar, unsigned x, unsigned& nloc, unsigned& nx) {
    const unsigned G = gridDim.x * gridDim.y * gridDim.z;
    unsigned sum, cnt, mine, sp = 0u;
    for (;;) {
        sum = 0u; cnt = 0u; mine = 0u;
#pragma unroll
        for (unsigned j = 0; j < 16; ++j) { const unsigned c = xb_ld(&bar[XB_XCNT(j)]); sum += c; cnt += (c > 0u) ? 1u : 0u; mine = (j == x) ? c : mine; }
        if (sum == G) break;
        __builtin_amdgcn_s_sleep(1);
        if ((++sp & 255u) == 0u) { if (xb_ld(&bar[XB_TMO])) break; if (sp > XB_SPIN_CAP) { atomicAdd(&bar[XB_TMO], 1u); break; } }
    }
    nloc = mine > 0u ? mine : 1u; nx = cnt > 0u ? cnt : 1u;
}
__device__ __forceinline__ void xcd_barrier(const XcdBarrier& b) {
    asm volatile("s_waitcnt vmcnt(0)" ::: "memory");
    __syncthreads();
    if (threadIdx.x == 0) {
        unsigned* bar = b.bar;
        __builtin_amdgcn_s_waitcnt(0);
        unsigned nloc = b.st[0], nx = b.st[1];
        if (nloc == 0u) { xcd_barrier_complete(bar, b.x, nloc, nx); b.st[0] = nloc; b.st[1] = nx; }
        const unsigned old = xb_add(&bar[XB_XSUB(b.x)], 1u);
        const unsigned gen = old / nloc;
        if (old + 1u == (gen + 1u) * nloc) {
            __builtin_amdgcn_fence(__ATOMIC_RELEASE, "agent");
            asm volatile("s_waitcnt vmcnt(0)" ::: "memory");
            const unsigned og = xb_add(&bar[XB_TOP], 1u);
            const unsigned tg = og / nx;
            if (og + 1u == (tg + 1u) * nx) xb_add(&bar[XB_TOPGEN], 1u);
            else XB_SPIN(xb_ld(&bar[XB_TOPGEN]) == tg, bar);
            __builtin_amdgcn_fence(__ATOMIC_ACQUIRE, "agent");
            xb_add(&bar[XB_XGEN(b.x)], 1u);
            asm volatile("s_waitcnt vmcnt(0)" ::: "memory");
        } else {
            XB_SPIN(xb_ld(&bar[XB_XGEN(b.x)]) == gen, bar);
            __builtin_amdgcn_fence(__ATOMIC_ACQUIRE, "agent");
            asm volatile("s_waitcnt vmcnt(0)" ::: "memory");
        }
    }
    __syncthreads();
}

__global__ void __launch_bounds__(MK_THREADS, 2) mega(MKP p) {
    extern __shared__ __attribute__((aligned(16))) unsigned char lds_raw[];
    LAS unsigned char* lds = (LAS unsigned char*)lds_raw;
    const int lo = p.ph_lo, hi = p.ph_hi;
    const bool multi = hi - lo > 1;
    volatile LAS unsigned* bst = (volatile LAS unsigned*)(lds + LDS_BARST);
    XcdBarrier bar; bar.bar = p.barw; bar.x = 0; bar.st = bst;
    if (multi) {
        if (threadIdx.x < 2) bst[threadIdx.x] = 0u;
        if (blockIdx.x == 0) for (int i = threadIdx.x; i < XCD_BAR_WORDS; i += MK_THREADS) p.barw[i] = 0u;
    }
    int nbar = 0;
#define IN(k) (lo <= (k) && (k) < hi)
#define SEAM(k) do { if (IN(k) && IN((k) + 1)) { if (nbar == 0) { __threadfence(); cooperative_groups::this_grid().sync(); __builtin_amdgcn_fence(__ATOMIC_ACQUIRE, "agent"); bar = xcd_barrier_post(p.barw, bst); } else xcd_barrier(bar); ++nbar; } } while (0)
    if (IN(0)) { phase_prologue(p, lds); phase_moe_weights(p, lds, 0); }
    SEAM(0);
    if (IN(1)) phase_norm<false>(p, lds, p.in[0], p.in[3], 0, 1, 0, true);
    SEAM(1);
    if (IN(2)) {
        pg::DenseSched S; S.init(p.XN, p.W_in0t, S_, 3072, 1024, gridDim.x, blockIdx.x);
        EpiHeads E{p.desc0, p.cosT, p.sinT, p.GATES, p.LOGF, (LAS float*)(lds + LDS_X)};
        pg::gemm_run(lds, 1024, S, E);
    }
    SEAM(2);
    if (IN(3)) phase_scan(p, lds);
    SEAM(3);
    if (IN(4)) phase_fox(p, (char*)lds_raw);
    SEAM(4);
    if (IN(5)) {
        pg::DenseSched S; S.init(p.OATT, p.W_out0t, S_, 1024, 1024, gridDim.x, blockIdx.x);
        EpiResid E{p.in[0], p.out, p.mod + 2 * 1024};
        pg::gemm_run(lds, 1024, S, E);
    }
    SEAM(5);
    if (IN(6)) phase_moe_route<false>(p, lds, 0);
    SEAM(6);
    if (IN(7)) phase_moe_gemm1(p, lds, 0);
    SEAM(7);
    if (IN(8)) phase_moe_gemm2(p, lds, 0);
    SEAM(8);
    if (IN(9)) { phase_norm<true>(p, lds, p.out, p.in[3] + 1024, 1, 1, 0, false); phase_moe_weights(p, lds, 1); }
    if (IN(9) && IN(11)) { xcd_barrier(bar); ++nbar; }
    if (IN(11)) {
        pg::DenseSched S; S.init(p.XN, p.W_in1t, S_, 768, 1024, gridDim.x, blockIdx.x);
        EpiPlain E{p.P1, 768};
        pg::gemm_run(lds, 1024, S, E);
    }
    SEAM(11);
    if (IN(12)) phase_post1a(p);
    SEAM(12);
    if (IN(13)) {
        { pg::DenseSched S; S.init(p.CQN, p.W_uqt, S_, 1536, 384, gridDim.x, blockIdx.x);
          EpiHeads E{p.desc_uq, p.cosT, p.sinT, nullptr, nullptr, (LAS float*)(lds + LDS_X)};
          pg::gemm_run(lds, 384, S, E); }
        { pg::DenseSched S; S.init(p.CKVN, p.W_ukvt, S_, 2048, 256, gridDim.x, blockIdx.x);
          EpiHeads E{p.desc_ukv, p.cosT, p.sinT, nullptr, nullptr, (LAS float*)(lds + LDS_X)};
          pg::gemm_run(lds, 256, S, E); }
    }
    SEAM(13);
    if (IN(14)) phase_mla(p, (char*)lds_raw);
    SEAM(14);
    if (IN(15)) {
        pg::DenseSched S; S.init(p.OATT, p.W_out1t, S_, 1024, 1024, gridDim.x, blockIdx.x);
        EpiResid E{p.out, p.out, p.mod + 6144 + 2 * 1024};
        pg::gemm_run(lds, 1024, S, E);
    }
    SEAM(15);
    if (IN(16)) phase_moe_route<false>(p, lds, 1);
    SEAM(16);
    if (IN(17)) phase_moe_gemm1(p, lds, 1);
    SEAM(17);
    if (IN(18)) phase_moe_gemm2(p, lds, 1);
    SEAM(18);
    if (IN(19)) phase_moe_combine(p, 1);
#undef IN
#undef SEAM
}
extern "C" void kernel_launch(void* const* d_in, const int* in_sizes, int n_in, void* d_out, int out_size, void* d_ws, size_t ws_size, hipStream_t stream) {
    static int grid = 0;
    if (!grid) {
        int dev = 0, cus = 0, per_cu = 0;
        (void)hipGetDevice(&dev); (void)hipDeviceGetAttribute(&cus, hipDeviceAttributeMultiprocessorCount, dev);
        (void)hipFuncSetAttribute((const void*)mega, hipFuncAttributeMaxDynamicSharedMemorySize, LDS_TOTAL);
        (void)hipOccupancyMaxActiveBlocksPerMultiprocessor(&per_cu, (const void*)mega, MK_THREADS, LDS_TOTAL);
        (void)hipGetLastError();
        grid = (cus > 0 && per_cu >= 1) ? cus : -1;
    }
    if (grid < 0) return;
    constexpr size_t MiB = 1u << 20;
    if (ws_size < 528 * MiB || n_in != 34) return;
    char* wsb = (char*)d_ws;
    float* ws = (float*)d_ws;
    size_t o = 0;
    MKP p{};
    for (int i = 0; i < 34; ++i) p.in[i] = (const float*)d_in[i];
    p.out = (float*)d_out; p.pos = (const int*)d_in[2];
    p.mod = ws + o; o += 2 * 6144;
    p.cosT = ws + o; o += (size_t)S_ * 48;
    p.sinT = ws + o; o += (size_t)S_ * 48;
    p.modpart = ws + o; o += 8 * 12288;
    p.desc0 = (BlkDesc*)(ws + o); o += 96 * 8;
    p.desc_uq = (BlkDesc*)(ws + o); o += 48 * 8;
    p.desc_ukv = (BlkDesc*)(ws + o); o += 64 * 8;
    p.CUMB = ws + o; o += (size_t)8 * S_;
    p.gcnt = (int*)(ws + o); o += 128;
    p.CBIAS = ws + o; o += 128;
    p.barw = (unsigned*)(ws + o); o += 4096;
    p.ew = ws + o; o += (size_t)S_ * 8;
    p.list = (int*)(ws + o); o += (size_t)64 * 16384;
    p.WcT = (bf16_t*)(ws + o); o += (size_t)2 * 64 * 2048 / 2;
    p.KCMP = (bf16_t*)(ws + o); o += (size_t)2 * 1024 * 64 / 2;
    p.VCT = (bf16_t*)(ws + o); o += (size_t)2 * 64 * 1024 / 2;
    if (o * 4 > 15 * MiB) return;
    p.XN = (bf16_t*)(wsb + 15 * MiB); p.OATT = (bf16_t*)(wsb + 47 * MiB);
    char* big = wsb + 79 * MiB;
    {   bf16_t* b = (bf16_t*)big;
        p.QN = b; b += (size_t)S_ * 512; p.KV6 = b; b += (size_t)12 * S_ * 64; p.FQ = b; b += (size_t)S_ * 512; p.FK = b; b += (size_t)S_ * 512; p.FV = b; b += (size_t)S_ * 512;
        p.GATES = (float*)b; p.LOGF = p.GATES + (size_t)S_ * 24; }
    p.KSLF = (bf16_t*)(big + 92 * MiB); p.VSLF = (bf16_t*)(big + 96 * MiB); p.OCMP = (bf16_t*)(big + 100 * MiB); p.OWIN = (bf16_t*)(big + 116 * MiB);
    {   bf16_t* b = (bf16_t*)(big + 96 * MiB);
        p.P1 = b; b += (size_t)S_ * 768; p.CQN = b; b += (size_t)S_ * 384; p.CKVN = b; b += (size_t)S_ * 256;
        p.Q96 = b; b += (size_t)16 * S_ * 96; p.K96 = b; b += (size_t)16 * S_ * 96; p.V1 = b; b += (size_t)16 * S_ * 64; }
    p.YBUF = (bf16_t*)big; p.YS = (bf16_t*)(big + 128 * MiB); p.HID = (bf16_t*)(big + 256 * MiB);
    p.Wgu = (bf16_t*)(wsb + 415 * MiB); p.Wd = p.Wgu + (size_t)65 * 512 * 1024;
    {   bf16_t* b = (bf16_t*)(wsb + 513 * MiB);
        p.W_in0t = b; b += (size_t)3072 * 1024; p.W_out0t = b; b += (size_t)1024 * 1024; p.W_in1t = b; b += (size_t)768 * 1024;
        p.W_uqt = b; b += (size_t)1536 * 384; p.W_ukvt = b; b += (size_t)2048 * 256; p.W_out1t = b; b += (size_t)1024 * 1024; }
    p.ph_lo = 0; p.ph_hi = 20;
    void* args[] = {&p};
    (void)hipLaunchCooperativeKernel((const void*)mega, dim3(grid), dim3(MK_THREADS), args, LDS_TOTAL, stream);
}
```

```cpp
#include <hip/hip_runtime.h>
#include <hip/hip_cooperative_groups.h>
#include <stdint.h>

#define S_ 16384
#define D_ 1024
#define HYIN 2848
#define NEXP 64
#define EPSF 1e-6f

__device__ __forceinline__ float wsum(float v) {
#pragma unroll
    for (int o = 32; o > 0; o >>= 1) v += __shfl_xor(v, o);
    return v;
}
__device__ __forceinline__ float sigmf(float x) { return 1.f / (1.f + expf(-x)); }
__device__ __forceinline__ float logsigmf(float x) { return fminf(x, 0.f) - log1pf(expf(-fabsf(x))); }
#define LAS __attribute__((address_space(3)))
#define GAS __attribute__((address_space(1)))
typedef unsigned short bf16_t;
typedef short bf16x8 __attribute__((ext_vector_type(8)));
typedef float f32x4 __attribute__((ext_vector_type(4)));
typedef float f32x2 __attribute__((ext_vector_type(2)));
typedef unsigned u32x4 __attribute__((ext_vector_type(4)));
typedef unsigned u32x2 __attribute__((ext_vector_type(2)));
typedef __bf16 bf16x2_t __attribute__((ext_vector_type(2)));

__device__ __forceinline__ unsigned cvtpk(float lo, float hi) { f32x2 v = {lo, hi}; bf16x2_t b = __builtin_convertvector(v, bf16x2_t); return __builtin_bit_cast(unsigned, b); }
__device__ __forceinline__ float bf2f(bf16_t v) { return __uint_as_float(((unsigned)v) << 16); }
__device__ __forceinline__ bf16_t f2bf(float f) { return (bf16_t)(cvtpk(f, 0.f) & 0xffffu); }

namespace pg {
constexpr int BM = 256, BK = 64, HALF = 128, HTB = HALF * BK * 2, STAGE_BYTES = 8 * HTB;
__device__ __forceinline__ int lds_byte(int r, int c) { const int st = (r >> 4) * 2 + (c >> 5), rr = r & 15, cc = c & 31, ob = rr * 64 + cc * 2; return st * 1024 + (ob ^ (((ob >> 9) & 1) << 5)); }
__device__ __forceinline__ int perm32(int rho) { const int n = rho >> 4, i = rho & 15; return 8 * (i >> 2) + 4 * n + (i & 3); }
__device__ __forceinline__ void stage_rc(int b, int& R, int& C) { const int st = b / 1024, sb = b % 1024, swz = sb ^ (((sb >> 9) & 1) << 5); R = (st >> 1) * 16 + swz / 64; C = (st & 1) * 32 + (swz % 64) / 2; }

struct Unit { int pm, pn, aux; const char* A; const char* B; unsigned ra[4]; };

template <class Epi, class Sched>
__device__ __forceinline__ void gemm_run(LAS unsigned char* lds, const int K, const Sched& S, const Epi& E) {
    int tid_ = threadIdx.x; asm volatile("" : "+v"(tid_));
    const int tid = tid_, wid = __builtin_amdgcn_readfirstlane(tid >> 6), lane = tid & 63, wr = wid >> 2, wc = wid & 3, fr = lane & 15, fq = lane >> 4;
    int nt_ = K / BK; asm volatile("" : "+s"(nt_)); const int nt = nt_;
    int R0, C0; stage_rc(tid * 16, R0, C0);
    unsigned voffB[2];
#pragma unroll
    for (int i = 0; i < 2; ++i) { const int Rb = Epi::PERM ? ((R0 & ~31) + perm32(R0 & 31)) : R0; voffB[i] = (unsigned)((Rb + 64 * i) * K + C0) * 2u; }
    const size_t kstep = (size_t)(BK * 2);
    const size_t hstep = (size_t)HALF * K * 2;
    const unsigned ldsw = (unsigned)wid * 1024u;
    const int aoff = lds_byte(wr * 64 + fr, fq * 8), boff = lds_byte(wc * 32 + fr, fq * 8);
#define PG_SA(b, h) (((b) * 2 + (h)) * HTB)
#define PG_SB(b, h) ((4 + (b) * 2 + (h)) * HTB)
#define PG_STAGE2(bufoff, gbase, v0, v1) do { \
        __builtin_amdgcn_global_load_lds((const unsigned*)((const char*)(gbase) + (v0)), (LAS unsigned*)(lds + (bufoff) + ldsw), 16, 0, 0); \
        __builtin_amdgcn_global_load_lds((const unsigned*)((const char*)(gbase) + (v1)), (LAS unsigned*)(lds + (bufoff) + ldsw + 8192), 16, 0, 0); } while (0)
#define PG_STAGEB(bufoff, gbase) PG_STAGE2(bufoff, gbase, voffB[0], voffB[1])
#define PG_LDA(dst, b, h) do { _Pragma("unroll") for (int m = 0; m < 4; ++m) _Pragma("unroll") for (int k = 0; k < 2; ++k) dst[m][k] = *(const LAS bf16x8*)(lds + PG_SA(b, h) + aoff + m * 2048 + k * 1024); } while (0)
#define PG_LDB(dst, b, h) do { _Pragma("unroll") for (int n = 0; n < 2; ++n) _Pragma("unroll") for (int k = 0; k < 2; ++k) dst[n][k] = *(const LAS bf16x8*)(lds + PG_SB(b, h) + boff + n * 2048 + k * 1024); } while (0)
#define PG_MMA(ai, bj, At, Bt) do { __builtin_amdgcn_s_setprio(1); _Pragma("unroll") for (int m = 0; m < 4; ++m) _Pragma("unroll") for (int n = 0; n < 2; ++n) _Pragma("unroll") for (int k = 0; k < 2; ++k) \
        acc[ai][bj][m][n] = __builtin_amdgcn_mfma_f32_16x16x32_bf16(Bt[n][k], At[m][k], acc[ai][bj][m][n], 0, 0, 0); __builtin_amdgcn_s_setprio(0); } while (0)
#define PG_WAIT_V(n) asm volatile("s_waitcnt vmcnt(" #n ")" ::: "memory")
#define PG_WAIT_L(n) asm volatile("s_waitcnt lgkmcnt(" #n ")" ::: "memory")
#define PG_BAR __builtin_amdgcn_s_barrier()
#define PG_SCHED __builtin_amdgcn_sched_barrier(0)
    Unit cur, nxt; int ui = 0;
    if (!S.next(0, cur, R0, C0)) return;
    f32x4 acc[2][2][4][2];
#pragma unroll
    for (int a = 0; a < 2; ++a)
#pragma unroll
        for (int b = 0; b < 2; ++b)
#pragma unroll
            for (int m = 0; m < 4; ++m)
#pragma unroll
                for (int n = 0; n < 2; ++n) acc[a][b][m][n] = (f32x4){0.f, 0.f, 0.f, 0.f};
    bf16x8 At[4][2], B0[2][2], B1[2][2];
    const char* cA = cur.A; const char* cB = cur.B;
    PG_STAGEB(PG_SB(0, 0), cB); PG_STAGEB(PG_SB(0, 1), cB + hstep); PG_STAGE2(PG_SA(0, 0), cA, cur.ra[0], cur.ra[1]); PG_STAGE2(PG_SA(0, 1), cA, cur.ra[2], cur.ra[3]);
    if (wr == 1) PG_BAR;
    PG_WAIT_V(2); PG_BAR;
    PG_STAGEB(PG_SB(1, 0), cB + kstep); PG_STAGE2(PG_SA(1, 0), cA + kstep, cur.ra[0], cur.ra[1]); PG_STAGEB(PG_SB(1, 1), cB + hstep + kstep);
    PG_WAIT_V(6); PG_BAR;
    for (;;) {
        const bool has_next = S.next(ui + 1, nxt, R0, C0);
        if (!has_next) nxt = cur;
        const char* nA = nxt.A; const char* nB = nxt.B;
#pragma unroll 1
        for (int t = 0; t < nt; t += 2) {
            const bool last = (t == nt - 2);
            const char* a1 = cA + (size_t)(t + 1) * kstep;
            const char* a2 = last ? nA : cA + (size_t)(t + 2) * kstep; const char* b2 = last ? nB : cB + (size_t)(t + 2) * kstep;
            const char* a3 = a2 + kstep; const char* b3 = b2 + kstep;
            const unsigned r0 = last ? nxt.ra[0] : cur.ra[0], r1 = last ? nxt.ra[1] : cur.ra[1], r2 = last ? nxt.ra[2] : cur.ra[2], r3 = last ? nxt.ra[3] : cur.ra[3];
            PG_LDB(B0, 0, 0); PG_LDB(B1, 0, 1); PG_SCHED; PG_LDA(At, 0, 0); PG_STAGE2(PG_SA(1, 1), a1, cur.ra[2], cur.ra[3]);
            PG_WAIT_V(8); PG_WAIT_L(0); PG_BAR; PG_MMA(0, 0, At, B0); PG_MMA(0, 1, At, B1); PG_BAR; PG_SCHED;
            PG_LDA(At, 0, 1); PG_STAGEB(PG_SB(0, 0), b2); PG_STAGEB(PG_SB(0, 1), b2 + hstep); PG_STAGE2(PG_SA(0, 0), a2, r0, r1);
            PG_WAIT_V(8); PG_WAIT_L(0); PG_BAR; PG_MMA(1, 0, At, B0); PG_MMA(1, 1, At, B1); PG_BAR; PG_SCHED;
            PG_LDB(B0, 1, 0); PG_LDB(B1, 1, 1); PG_SCHED; PG_LDA(At, 1, 0); PG_STAGE2(PG_SA(0, 1), a2, r2, r3);
            PG_WAIT_V(8); PG_WAIT_L(0); PG_BAR; PG_MMA(0, 0, At, B0); PG_MMA(0, 1, At, B1); PG_BAR; PG_SCHED;
            PG_LDA(At, 1, 1); PG_STAGEB(PG_SB(1, 0), b3); PG_STAGEB(PG_SB(1, 1), b3 + hstep); PG_STAGE2(PG_SA(1, 0), a3, r0, r1);
            PG_WAIT_V(8); PG_WAIT_L(0); PG_BAR; PG_MMA(1, 0, At, B0); PG_MMA(1, 1, At, B1); PG_BAR; PG_SCHED;
        }
        if (wr == 0) PG_BAR;
        E(acc, cur, wid, wr, wc, fr, fq);
        if (!has_next) break;
#pragma unroll
        for (int a = 0; a < 2; ++a)
#pragma unroll
            for (int b = 0; b < 2; ++b)
#pragma unroll
                for (int m = 0; m < 4; ++m)
#pragma unroll
                    for (int n = 0; n < 2; ++n) acc[a][b][m][n] = (f32x4){0.f, 0.f, 0.f, 0.f};
        cur = nxt; cA = nA; cB = nB; ++ui;
        if (wr == 1) PG_BAR;
    }
    PG_WAIT_V(0);
    PG_BAR;
#undef PG_SA
#undef PG_SB
#undef PG_STAGE2
#undef PG_STAGEB
#undef PG_LDA
#undef PG_LDB
#undef PG_MMA
}

struct DenseSched {
    const char* A; const char* Bt; int K, nM, nN, nwg, G, c;
    __device__ __forceinline__ void init(const void* A_, const void* Bt_, int M, int N, int K_, int G_, int c_) { A = (const char*)A_; Bt = (const char*)Bt_; K = K_; nM = M / BM; nN = N / BM; nwg = nM * nN; G = G_; c = c_; }
    __device__ __forceinline__ bool next(int i, Unit& u, int R0, int C0) const {
        const long L = (long)i * G + c; if (L >= nwg) return false;
        int wgid = (int)L; { const int q = nwg / 8, r = nwg % 8, xcd = wgid % 8, off = wgid / 8; wgid = (xcd < r ? xcd * (q + 1) : r * (q + 1) + (xcd - r) * q) + off; }
        const int nig = 8 * nN, gid = wgid / nig, fm = gid * 8, gsz = (nM - fm) < 8 ? (nM - fm) : 8;
        u.pm = fm + ((wgid % nig) % gsz); u.pn = (wgid % nig) / gsz; u.aux = 0;
        u.A = A + (size_t)u.pm * BM * K * 2; u.B = Bt + (size_t)u.pn * BM * K * 2;
#pragma unroll
        for (int q = 0; q < 4; ++q) u.ra[q] = (unsigned)((R0 + 64 * q) * K + C0) * 2u;
        return true;
    }
};
}
namespace att {
using s16x4 = __attribute__((ext_vector_type(4))) short;
using f32x16 = __attribute__((ext_vector_type(16))) float;
typedef __attribute__((address_space(3))) const char* lds_cptr;
typedef short v4i16_t __attribute__((ext_vector_type(4)));
constexpr int NSLOT = 3, VSLOT = 8192;
template <int DQ> struct Geo {
    static constexpr int NK = DQ / 16;
    static constexpr int KSLOT = (DQ == 64) ? 8192 : 16384;
    static constexpr int QWAVE = (DQ == 64) ? 4096 : 6144;
    static constexpr int LDS_K = 0, LDS_V = NSLOT * KSLOT, LDS_WS = LDS_V + NSLOT * VSLOT, LDS_OST = LDS_WS + 8 * 64 * 4, LDS_BYTES = LDS_OST + 8 * QWAVE;
};
constexpr int LDS_BIAS = Geo<64>::LDS_BYTES;
#define ASBAR() __builtin_amdgcn_sched_barrier(0)
#define AWAIT_BAR(N) asm volatile("s_waitcnt vmcnt(" #N ") lgkmcnt(0)\n\ts_barrier" ::: "memory")
__device__ __forceinline__ int crow(int r, int hi) { return (r & 3) + 8 * (r >> 2) + 4 * hi; }
__device__ __forceinline__ void glds16(const void* gsrc, unsigned lds_dst) { unsigned keep;
    asm volatile("s_mov_b32 %0, m0\n\ts_mov_b32 m0, %2\n\ts_nop 0\n\tglobal_load_lds_dwordx4 %1, off\n\ts_mov_b32 m0, %0" : "=&s"(keep) : "v"(gsrc), "s"(lds_dst) : "memory"); }
__device__ __forceinline__ float fadd_s(float a, float b) { float r; asm("v_add_f32_e32 %0, %1, %2" : "=v"(r) : "v"(a), "v"(b)); return r; }
__device__ __forceinline__ float fsub_s(float a, float b) { float r; asm("v_sub_f32_e32 %0, %1, %2" : "=v"(r) : "v"(a), "v"(b)); return r; }
__device__ __forceinline__ float max3f(float a, float b, float c) { float r; asm("v_max3_f32 %0, %1, %2, %3" : "=v"(r) : "v"(a), "v"(b), "v"(c)); return r; }
__device__ __forceinline__ float max2f(float a, float b) { float r; asm("v_max_f32_e32 %0, %1, %2" : "=v"(r) : "v"(a), "v"(b)); return r; }
__device__ __forceinline__ s16x4 vtr(lds_cptr p) { return __builtin_bit_cast(s16x4, __builtin_amdgcn_ds_read_tr16_b64_v4i16((__attribute__((address_space(3))) v4i16_t*)p)); }
template <int NK> __device__ __forceinline__ void kloadall(bf16x8* kf, lds_cptr kp) {
#pragma unroll
    for (int j = 0; j < NK; ++j) { kf[2 * j] = *(const LAS bf16x8*)(kp + j * 2048); kf[2 * j + 1] = *(const LAS bf16x8*)(kp + j * 2048 + 512); } }
__device__ __forceinline__ void kload2(bf16x8* kf, lds_cptr kp, int j) { kf[2 * j] = *(const LAS bf16x8*)(kp + j * 2048); kf[2 * j + 1] = *(const LAS bf16x8*)(kp + j * 2048 + 512); }
__device__ __forceinline__ void cmask(f32x16& p0, f32x16& p1, int koff, int qtok, int hi) {
    const int x = qtok - koff - 4 * hi;
#pragma unroll
    for (int r = 0; r < 16; ++r) { const int c = (r & 3) + 8 * (r >> 2); if (c > x) p0[r] = -INFINITY; if (c + 32 > x) p1[r] = -INFINITY; }
}
__device__ __forceinline__ void wmask(f32x16& p0, f32x16& p1, int thr, int hi) {
    const int y = thr - 4 * hi;
#pragma unroll
    for (int r = 0; r < 16; ++r) { const int c = (r & 3) + 8 * (r >> 2); if (c < y) p0[r] = -INFINITY; if (c + 32 < y) p1[r] = -INFINITY; }
}
__device__ __forceinline__ float rowmax(const f32x16& p0, const f32x16& p1) {
    float a = max3f(p0[0], p0[1], p1[0]), b = max3f(p0[2], p0[3], p1[1]); a = max3f(a, p1[2], p1[3]);
#pragma unroll
    for (int r = 4; r < 16; r += 4) { a = max3f(a, p0[r], p0[r + 1]); b = max3f(b, p0[r + 2], p0[r + 3]); a = max3f(a, p1[r], p1[r + 1]); b = max3f(b, p1[r + 2], p1[r + 3]); }
    const float m = max2f(a, b);
    auto rr = __builtin_amdgcn_permlane32_swap(__float_as_uint(m), __float_as_uint(m), false, false);
    return max2f(__uint_as_float(rr[0]), __uint_as_float(rr[1]));
}

enum { MODE_CAUSAL = 0, MODE_FOX = 1, MODE_WIN = 2 };
struct UnitArgs {
    const bf16_t* qrow;
    const bf16_t* K; const bf16_t* V; int kvpitch, vpitch;
    bf16_t* obase; int opitch;
    int qtok;
    int abase;
    int nsteps;
    const LAS float* bias;
};

template <int NB> __device__ __forceinline__ int seq(int i, int abase) { return (i < NB) ? abase + i : abase + NB - 1 - i; }

template <int MODE, bool GQA4, int THRL, int DQ, bool TM = false>
__device__ __forceinline__ void attn_unit(const UnitArgs& A, char* shm) {
    constexpr int NB = GQA4 ? 1 : 4;
    typedef Geo<DQ> G; constexpr int NK = G::NK, KSLOT = G::KSLOT, LDS_K = G::LDS_K, LDS_V = G::LDS_V, LDS_WS = G::LDS_WS, LDS_OST = G::LDS_OST, QWAVE = G::QWAVE;
    constexpr bool USE_NEGM = (MODE != MODE_FOX);
    int tid_ = threadIdx.x; asm volatile("" : "+v"(tid_));
    const int tid = tid_, lane = tid & 63, r32 = lane & 31, hi = lane >> 5; const int wid = __builtin_amdgcn_readfirstlane(tid >> 6);
    const unsigned lds0 = (unsigned)(uintptr_t)shm;
    float* wsf = (float*)(shm + LDS_WS) + wid * 64;
    const int NT = A.nsteps, abase = A.abase; const long kvp = A.kvpitch, vvp = A.vpitch;
    const bf16_t* ksrc = TM ? A.K + wid * 512 + lane * 8 : A.K + (long)lane * kvp + wid * 8;
    const bf16_t* ksrc2 = TM ? A.K + (8 + (wid & 3)) * 512 + lane * 8 : A.K + (long)lane * kvp + (8 + (wid & 3)) * 8;
    const bf16_t* vsrc = TM ? A.V + wid * 512 + lane * 8 : A.V + (long)(16 * (wid & 3) + (lane >> 2)) * vvp + (wid >> 2) * 32 + (lane & 3) * 8;
    const long kts = TM ? (long)(DQ / 8) * 512 : 64 * kvp, vts = TM ? 4096 : 64 * vvp;
    const unsigned kdst = lds0 + LDS_K + wid * 1024, vdst = lds0 + LDS_V + wid * 1024, kdst2 = lds0 + LDS_K + (8 + wid) * 1024;
#define TILE_OF(t) ({ int a_ = seq<NB>((t), abase); a_ < 0 ? 0 : a_; })
#define DMA_K(t, slot) do { const long to_ = (long)TILE_OF(t) * kts; glds16(ksrc + to_, (unsigned)__builtin_amdgcn_readfirstlane(kdst + (slot) * KSLOT)); \
        if (DQ == 96) glds16(ksrc2 + to_, (unsigned)__builtin_amdgcn_readfirstlane(kdst2 + (slot) * KSLOT)); } while (0)
#define DMA_V(t, slot) glds16(vsrc + (long)TILE_OF(t) * vts, (unsigned)__builtin_amdgcn_readfirstlane(vdst + (slot) * VSLOT))
    const lds_cptr shm3 = (lds_cptr)shm; const lds_cptr kp0 = shm3 + LDS_K + hi * 1024 + r32 * 16;
    const lds_cptr vp0 = shm3 + LDS_V + ((lane >> 4) & 1) * 32 + (lane & 3) * 8 + (4 * hi + ((lane & 15) >> 2)) * 64;
    const int vb0 = (int)(lds0 + LDS_V) + ((lane >> 4) & 1) * 32 + (lane & 3) * 8 + (4 * hi + ((lane & 15) >> 2)) * 64;
    DMA_K(0, 0); DMA_V(0, 0); DMA_K(1, 1);
    bf16x8 qr[NK];
#pragma unroll
    for (int d0 = 0; d0 < NK; ++d0) qr[d0] = *reinterpret_cast<const bf16x8*>(A.qrow + d0 * 16 + hi * 8);
    const lds_cptr qlp = shm3 + LDS_OST + wid * QWAVE + hi * 512 + r32 * 16;
    if (DQ == 96) {
#pragma unroll
        for (int d0 = 0; d0 < NK; ++d0) *(LAS bf16x8*)(const_cast<__attribute__((address_space(3))) char*>(qlp) + d0 * 1024) = qr[d0];
    }
#define QL(d0) (*(const LAS bf16x8*)(qlp + (d0) * 1024))
    float mhat = 0.f, l_reg = 0.f; f32x16 o[2]; o[0] = f32x16{}; o[1] = f32x16{};
    f32x16 negm = f32x16{}; if (USE_NEGM) asm volatile("" : "+v"(negm));
    const int qtok = A.qtok;
#define CMASK(P0, P1, t) do { const int t_ = (t); if (t_ < NB) cmask(P0, P1, 64 * t_, qtok, hi); \
        else { const int a_ = abase + NB - 1 - t_; if (a_ < 0) wmask(P0, P1, 64, hi); \
               else if (MODE == MODE_WIN) { const int thr_ = qtok - 511 + 64 * (abase - a_); if (thr_ > 0) wmask(P0, P1, thr_, hi); } } } while (0)
#define CINIT1(C, t, OFF) do { if (MODE == MODE_FOX) { const LAS float* bt_ = A.bias + 64 * (seq<NB>((t), abase) - (abase + NB - NT)) + 4 * hi + (OFF); const float nm_ = -mhat; \
        _Pragma("unroll") for (int g_ = 0; g_ < 4; ++g_) { const f32x4 b_ = *(const LAS f32x4*)(bt_ + 8 * g_); C[4 * g_] = b_.x; C[4 * g_ + 1] = b_.y; C[4 * g_ + 2] = b_.z; C[4 * g_ + 3] = b_.w; } \
        _Pragma("unroll") for (int r_ = 0; r_ < 16; ++r_) C[r_] += nm_; asm volatile("" : "+v"(C)); } \
      else if (USE_NEGM) { C = negm; } \
      else { const float nm_ = -mhat; _Pragma("unroll") for (int r_ = 0; r_ < 16; ++r_) C[r_] = nm_; asm volatile("" : "+v"(C)); } } while (0)
#define CINIT(C0, C1, t) do { CINIT1(C0, t, 0); CINIT1(C1, t, 32); } while (0)
    bool resc = false;
#define START(P0, P1) do { const float rm = rowmax(P0, P1); resc = false; \
    { const float dl = rm; mhat = fadd_s(mhat, dl); \
      _Pragma("unroll") for (int r = 0; r < 16; ++r) { P0[r] = fsub_s(P0[r], dl); P1[r] = fsub_s(P1[r], dl); } \
      if (USE_NEGM) { _Pragma("unroll") for (int r = 0; r < 16; ++r) negm[r] = -mhat; asm volatile("" : "+v"(negm)); } } \
    _Pragma("unroll") for (int r = 0; r < 16; ++r) P0[r] = __builtin_amdgcn_exp2f(P0[r]); } while (0)
#define RESC() do { if (resc) { asm volatile("s_waitcnt lgkmcnt(0)" ::: "memory"); \
      const float* wsh_ = wsf + 4 * hi; \
      _Pragma("unroll") for (int d_ = 0; d_ < 2; ++d_) _Pragma("unroll") for (int r = 0; r < 16; ++r) o[d_][r] *= wsh_[(r & 3) + 8 * (r >> 2)]; } } while (0)
    f32x16 pA0, pA1, pB0, pB1; bf16x8 kf[2 * NK];
    int sl_prev = 0, sl_cur = 0, sl_next = 1;
#define ROT() do { sl_prev = sl_cur; sl_cur = sl_next; sl_next = (sl_next == NSLOT - 1) ? 0 : sl_next + 1; } while (0)
    DMA_K(2, 2);
    if (DQ == 96) { AWAIT_BAR(5); } else { AWAIT_BAR(3); }
    { const char* kb = shm + LDS_K + hi * 1024 + r32 * 16;
      CINIT(pA0, pA1, 0);
#pragma unroll
      for (int d0 = 0; d0 < NK; ++d0) {
          const bf16x8 b0 = *reinterpret_cast<const bf16x8*>(kb + d0 * 2048);
          const bf16x8 b1 = *reinterpret_cast<const bf16x8*>(kb + d0 * 2048 + 512);
          pA0 = __builtin_amdgcn_mfma_f32_32x32x16_bf16(b0, qr[d0], pA0, 0, 0, 0); pA1 = __builtin_amdgcn_mfma_f32_32x32x16_bf16(b1, qr[d0], pA1, 0, 0, 0); } }
    asm volatile("s_nop 15\n\ts_nop 7" : "+v"(pA0), "+v"(pA1)); CMASK(pA0, pA1, 0);
    START(pA0, pA1);
    _Pragma("unroll") for (int r = 0; r < 16; ++r) pA1[r] = __builtin_amdgcn_exp2f(pA1[r]);
    AWAIT_BAR(0);
    DMA_K(3, 0); DMA_V(1, 1);
    ROT();
    kloadall<NK>(kf, kp0 + sl_cur * KSLOT);
    if (DQ == 96) { AWAIT_BAR(3); } else { AWAIT_BAR(2); }
    s16x4 vlo[(DQ == 96) ? 4 : 8], vhi[(DQ == 96) ? 4 : 8]; u32x4 pw0, pw1, pw2, pw3;
#define PKW(P, B) cvtpk(P[B], P[B + 1])
#define PAF(k) __builtin_bit_cast(bf16x8, pw##k)
#define VFR(i) (bf16x8){vlo[i][0], vlo[i][1], vlo[i][2], vlo[i][3], vhi[i][0], vhi[i][1], vhi[i][2], vhi[i][3]}
#define PIN(x) asm volatile("" : "+v"(x))
#define MX3(a, b, c) __builtin_fmaxf(__builtin_fmaxf((a), (b)), (c))
#define GAPA(MF, A0, A1, A2, A3, W0, W1, PW) do { MF; sacc += A0; sacc += A1; sacc += A2; sacc += A3; PIN(sacc); W0; W1; PIN(PW); ASBAR(); } while (0)
#define EX(v) __builtin_amdgcn_exp2f(v)
#define GAPB(MF, X, B) do { MF; X[B] = EX(X[B]); X[B + 1] = EX(X[B + 1]); X[B + 2] = EX(X[B + 2]); X[B + 3] = EX(X[B + 3]); PIN(X); ASBAR(); } while (0)
#define VRD(i) do { vlo[i] = vtr(vp_ + (((i) >> 2) * 4096 + ((i) & 3) * 1024)); vhi[i] = vtr(vp_ + (((i) >> 2) * 4096 + ((i) & 3) * 1024 + 512)); } while (0)
#define KRD(G_, j) do { if (G_) { kload2(kf, kp0 + sl_next * KSLOT, j); ASBAR(); } } while (0)
#define MFMA32(a, b, c) __builtin_amdgcn_mfma_f32_32x32x16_bf16(a, b, c, 0, 0, 0)
#define STEP64(C0, C1, P0, P1, t, GK, GV, GL, DOMASK) do { ASBAR(); \
    const lds_cptr vp_ = vp0 + sl_prev * VSLOT; \
    CINIT1(C0, t, 0); ASBAR(); \
    VRD(0); ASBAR(); float sacc = (P0[0] + P0[1]); \
    GAPA(C0 = MFMA32(kf[0], qr[0], C0), P0[2], P0[3], P0[4], P0[5],     pw0[0] = PKW(P0, 0), pw0[1] = PKW(P0, 2), pw0); \
    CINIT1(C1, t, 32); ASBAR(); \
    VRD(4); ASBAR(); GAPA(C1 = MFMA32(kf[1], qr[0], C1), P0[6], P0[7], P0[8], P0[9],     pw0[2] = PKW(P0, 4), pw0[3] = PKW(P0, 6), pw0); \
    VRD(1); ASBAR(); GAPA(C0 = MFMA32(kf[2], qr[1], C0),   P0[10], P0[11], P0[12], P0[13], pw1[0] = PKW(P0, 8), pw1[1] = PKW(P0, 10), pw1); \
    VRD(5); ASBAR(); GAPA(C1 = MFMA32(kf[3], qr[1], C1),   P0[14], P0[15], P1[0], P1[1],   pw1[2] = PKW(P0, 12), pw1[3] = PKW(P0, 14), pw1); \
    VRD(2); ASBAR(); GAPA(C0 = MFMA32(kf[4], qr[2], C0),   P1[2], P1[3], P1[4], P1[5],     pw2[0] = PKW(P1, 0), pw2[1] = PKW(P1, 2), pw2); \
    VRD(6); ASBAR(); GAPA(C1 = MFMA32(kf[5], qr[2], C1),   P1[6], P1[7], P1[8], P1[9],     pw2[2] = PKW(P1, 4), pw2[3] = PKW(P1, 6), pw2); \
    VRD(3); ASBAR(); GAPA(C0 = MFMA32(kf[6], qr[3], C0),   P1[10], P1[11], P1[12], P1[13], pw3[0] = PKW(P1, 8), pw3[1] = PKW(P1, 10), pw3); \
    VRD(7); ASBAR(); GAPA(C1 = MFMA32(kf[7], qr[3], C1),   P1[14], P1[15], 0.f, 0.f,       pw3[2] = PKW(P1, 12), pw3[3] = PKW(P1, 14), pw3); \
    l_reg += sacc; \
    if (GK) { DMA_K((t) + 3, sl_cur); } if (GV) { DMA_V((t) + 1, sl_next); } \
    if (DOMASK) CMASK(C0, C1, t); \
    { float a = MX3(C0[0], C0[1], C1[0]), b = MX3(C0[2], C0[3], C1[1]); a = MX3(a, C1[2], C1[3]); \
      _Pragma("unroll") for (int r = 4; r < 16; r += 4) { a = MX3(a, C0[r], C0[r + 1]); b = MX3(b, C0[r + 2], C0[r + 3]); a = MX3(a, C1[r], C1[r + 1]); b = MX3(b, C1[r + 2], C1[r + 3]); } \
      float rm = __builtin_fmaxf(a, b); { auto rr = __builtin_amdgcn_permlane32_swap(__float_as_uint(rm), __float_as_uint(rm), false, false); rm = __builtin_fmaxf(__uint_as_float(rr[0]), __uint_as_float(rr[1])); } \
      resc = false; \
      if (__builtin_expect(__any(rm > (float)THRL), 0)) { const float dl = __builtin_fmaxf(rm, 0.f); mhat += dl; \
        _Pragma("unroll") for (int r = 0; r < 16; ++r) { C0[r] -= dl; C1[r] -= dl; } \
        if (USE_NEGM) { _Pragma("unroll") for (int r = 0; r < 16; ++r) negm[r] = -mhat; asm volatile("" : "+v"(negm)); } \
        const float f = __builtin_amdgcn_exp2f(-dl); l_reg *= f; if (hi == 0) wsf[r32] = f; resc = true; } } \
    ASBAR(); \
    GAPB(o[0] = MFMA32(PAF(0), VFR(0), o[0]), C0, 0); \
    GAPB(o[1] = MFMA32(PAF(0), VFR(4), o[1]), C0, 4); \
    KRD(GL, 0); GAPB(o[0] = MFMA32(PAF(1), VFR(1), o[0]), C0, 8); \
    KRD(GL, 1); GAPB(o[1] = MFMA32(PAF(1), VFR(5), o[1]), C0, 12); \
    KRD(GL, 2); GAPB(o[0] = MFMA32(PAF(2), VFR(2), o[0]), C1, 0); \
    KRD(GL, 3); GAPB(o[1] = MFMA32(PAF(2), VFR(6), o[1]), C1, 4); \
    GAPB(o[0] = MFMA32(PAF(3), VFR(3), o[0]), C1, 8); \
    GAPB(o[1] = MFMA32(PAF(3), VFR(7), o[1]), C1, 12); \
    } while (0)
#define AWAIT_STEADY() do { if (DQ == 96) { AWAIT_BAR(3); } else { AWAIT_BAR(2); } } while (0)
#define VRD4(i, b) do { vlo[b] = vtr(vp_ + (((i) >> 2) * 4096 + ((i) & 3) * 1024)); vhi[b] = vtr(vp_ + (((i) >> 2) * 4096 + ((i) & 3) * 1024 + 512)); } while (0)
#define VFR4(b) (bf16x8){vlo[b][0], vlo[b][1], vlo[b][2], vlo[b][3], vhi[b][0], vhi[b][1], vhi[b][2], vhi[b][3]}
#define GAPQ(MF, QLD, A0, A1, A2, A3, W0, W1, PW) do { MF; QLD; sacc += A0; sacc += A1; sacc += A2; sacc += A3; PIN(sacc); W0; W1; PIN(PW); ASBAR(); } while (0)
#define STEP96(C0, C1, P0, P1, t, GK, GV, GL, DOMASK) do { ASBAR(); \
    const lds_cptr vp_ = vp0 + sl_prev * VSLOT; \
    CINIT1(C0, t, 0); CINIT1(C1, t, 32); bf16x8 qa = QL(0), qb; ASBAR(); \
    float sacc = (P0[0] + P0[1]); \
    GAPQ(C0 = MFMA32(kf[0], qa, C0), qb = QL(1), P0[2], P0[3], P0[4], P0[5],     pw0[0] = PKW(P0, 0), pw0[1] = PKW(P0, 2), pw0); \
    GAPQ(C1 = MFMA32(kf[1], qa, C1), (void)0,    P0[6], P0[7], P0[8], P0[9],     pw0[2] = PKW(P0, 4), pw0[3] = PKW(P0, 6), pw0); \
    GAPQ(C0 = MFMA32(kf[2], qb, C0), qa = QL(2), P0[10], P0[11], P0[12], P0[13], pw1[0] = PKW(P0, 8), pw1[1] = PKW(P0, 10), pw1); \
    GAPQ(C1 = MFMA32(kf[3], qb, C1), (void)0,    P0[14], P0[15], P1[0], P1[1],   pw1[2] = PKW(P0, 12), pw1[3] = PKW(P0, 14), pw1); \
    GAPQ(C0 = MFMA32(kf[4], qa, C0), qb = QL(3), P1[2], P1[3], P1[4], P1[5],     pw2[0] = PKW(P1, 0), pw2[1] = PKW(P1, 2), pw2); \
    GAPQ(C1 = MFMA32(kf[5], qa, C1), (void)0,    P1[6], P1[7], P1[8], P1[9],     pw2[2] = PKW(P1, 4), pw2[3] = PKW(P1, 6), pw2); \
    GAPQ(C0 = MFMA32(kf[6], qb, C0), qa = QL(4), P1[10], P1[11], P1[12], P1[13], pw3[0] = PKW(P1, 8), pw3[1] = PKW(P1, 10), pw3); \
    GAPQ(C1 = MFMA32(kf[7], qb, C1), (void)0,    P1[14], P1[15], 0.f, 0.f,       pw3[2] = PKW(P1, 12), pw3[3] = PKW(P1, 14), pw3); \
    C0 = MFMA32(kf[8], qa, C0); qb = QL(5); VRD4(0, 0); ASBAR(); \
    C1 = MFMA32(kf[9], qa, C1); VRD4(4, 1); ASBAR(); \
    C0 = MFMA32(kf[10], qb, C0); ASBAR(); \
    C1 = MFMA32(kf[11], qb, C1); ASBAR(); \
    l_reg += sacc; \
    if (GK) { DMA_K((t) + 3, sl_cur); } if (GV) { DMA_V((t) + 1, sl_next); } \
    if (DOMASK) CMASK(C0, C1, t); \
    { float a = MX3(C0[0], C0[1], C1[0]), b = MX3(C0[2], C0[3], C1[1]); a = MX3(a, C1[2], C1[3]); \
      _Pragma("unroll") for (int r = 4; r < 16; r += 4) { a = MX3(a, C0[r], C0[r + 1]); b = MX3(b, C0[r + 2], C0[r + 3]); a = MX3(a, C1[r], C1[r + 1]); b = MX3(b, C1[r + 2], C1[r + 3]); } \
      float rm = __builtin_fmaxf(a, b); { auto rr = __builtin_amdgcn_permlane32_swap(__float_as_uint(rm), __float_as_uint(rm), false, false); rm = __builtin_fmaxf(__uint_as_float(rr[0]), __uint_as_float(rr[1])); } \
      resc = false; \
      if (__builtin_expect(__any(rm > (float)THRL), 0)) { const float dl = __builtin_fmaxf(rm, 0.f); mhat += dl; \
        _Pragma("unroll") for (int r = 0; r < 16; ++r) { C0[r] -= dl; C1[r] -= dl; } \
        if (USE_NEGM) { _Pragma("unroll") for (int r = 0; r < 16; ++r) negm[r] = -mhat; asm volatile("" : "+v"(negm)); } \
        const float f = __builtin_amdgcn_exp2f(-dl); l_reg *= f; if (hi == 0) wsf[r32] = f; resc = true; } } \
    ASBAR(); \
    VRD4(1, 2); ASBAR(); GAPB(o[0] = MFMA32(PAF(0), VFR4(0), o[0]), C0, 0); \
    VRD4(5, 3); ASBAR(); GAPB(o[1] = MFMA32(PAF(0), VFR4(1), o[1]), C0, 4); \
    VRD4(2, 0); KRD(GL, 0); GAPB(o[0] = MFMA32(PAF(1), VFR4(2), o[0]), C0, 8); \
    VRD4(6, 1); KRD(GL, 1); GAPB(o[1] = MFMA32(PAF(1), VFR4(3), o[1]), C0, 12); \
    VRD4(3, 2); KRD(GL, 2); GAPB(o[0] = MFMA32(PAF(2), VFR4(0), o[0]), C1, 0); \
    VRD4(7, 3); KRD(GL, 3); GAPB(o[1] = MFMA32(PAF(2), VFR4(1), o[1]), C1, 4); \
    KRD(GL, 4); GAPB(o[0] = MFMA32(PAF(3), VFR4(2), o[0]), C1, 8); \
    KRD(GL, 5); GAPB(o[1] = MFMA32(PAF(3), VFR4(3), o[1]), C1, 12); \
    } while (0)
#define STEP(C0, C1, P0, P1, t, GK, GV, GL, DOMASK) do { if constexpr (DQ == 96) { STEP96(C0, C1, P0, P1, t, GK, GV, GL, DOMASK); } else { STEP64(C0, C1, P0, P1, t, GK, GV, GL, DOMASK); } } while (0)
#define ENDW(tt) do { if ((tt) + 3 < NT) { AWAIT_STEADY(); } else if ((tt) + 2 < NT) { AWAIT_BAR(1); } else { AWAIT_BAR(0); } } while (0)
    int t = 1;
    for (; t < 5 && t + 1 < NT; t += 2) {
        STEP(pB0, pB1, pA0, pA1, t, (t + 3 < NT), (t + 1 < NT), (t + 1 < NT), true);       ENDW(t);     RESC(); ROT();
        STEP(pA0, pA1, pB0, pB1, t + 1, (t + 4 < NT), (t + 2 < NT), (t + 2 < NT), true);   ENDW(t + 1); RESC(); ROT();
    }
    for (; t + 5 < NT; t += 2) {
        STEP(pB0, pB1, pA0, pA1, t, true, true, true, false);     AWAIT_STEADY(); RESC(); ROT();
        STEP(pA0, pA1, pB0, pB1, t + 1, true, true, true, false); AWAIT_STEADY(); RESC(); ROT();
    }
    for (; t + 1 < NT; t += 2) {
        STEP(pB0, pB1, pA0, pA1, t, (t + 3 < NT), (t + 1 < NT), (t + 1 < NT), true);       ENDW(t);     RESC(); ROT();
        STEP(pA0, pA1, pB0, pB1, t + 1, (t + 4 < NT), (t + 2 < NT), (t + 2 < NT), true);   ENDW(t + 1); RESC(); ROT();
    }
    STEP(pB0, pB1, pA0, pA1, NT - 1, false, false, false, true); RESC();
    { float sacc = pB0[0] + pB0[1];
      _Pragma("unroll") for (int r = 2; r < 16; ++r) sacc += pB0[r];
      _Pragma("unroll") for (int r = 0; r < 16; ++r) sacc += pB1[r];
      l_reg += sacc;
      pw0 = (u32x4){PKW(pB0, 0), PKW(pB0, 2), PKW(pB0, 4), PKW(pB0, 6)}; pw1 = (u32x4){PKW(pB0, 8), PKW(pB0, 10), PKW(pB0, 12), PKW(pB0, 14)};
      pw2 = (u32x4){PKW(pB1, 0), PKW(pB1, 2), PKW(pB1, 4), PKW(pB1, 6)}; pw3 = (u32x4){PKW(pB1, 8), PKW(pB1, 10), PKW(pB1, 12), PKW(pB1, 14)};
      ASBAR();
      const int vb = vb0 + sl_cur * VSLOT;
#pragma unroll
      for (int d0 = 0; d0 < 2; ++d0) { s16x4 lo[4], hh[4];
#pragma unroll
          for (int ks = 0; ks < 4; ++ks) {
              asm volatile("ds_read_b64_tr_b16 %0,%1 offset:%c2" : "=&v"(lo[ks]) : "v"(vb), "i"(d0 * 4096 + ks * 1024) : "memory");
              asm volatile("ds_read_b64_tr_b16 %0,%1 offset:%c2" : "=&v"(hh[ks]) : "v"(vb), "i"(d0 * 4096 + ks * 1024 + 512) : "memory"); }
          asm volatile("s_waitcnt lgkmcnt(0)" ::: "memory"); ASBAR();
#define PK(k) (bf16x8){lo[k][0], lo[k][1], lo[k][2], lo[k][3], hh[k][0], hh[k][1], hh[k][2], hh[k][3]}
          o[d0] = MFMA32(PAF(0), PK(0), o[d0]); o[d0] = MFMA32(PAF(1), PK(1), o[d0]); o[d0] = MFMA32(PAF(2), PK(2), o[d0]); o[d0] = MFMA32(PAF(3), PK(3), o[d0]);
#undef PK
      } }
    { auto rr = __builtin_amdgcn_permlane32_swap(__float_as_uint(l_reg), __float_as_uint(l_reg), false, false); l_reg = __uint_as_float(rr[0]) + __uint_as_float(rr[1]); }
    if (hi == 0) wsf[32 + r32] = l_reg; asm volatile("s_waitcnt lgkmcnt(0)" ::: "memory");
    int lane_e = lane; asm volatile("" : "+v"(lane_e)); const int hi_e = lane_e >> 5, r32_e = lane_e & 31;
    float rli[16];
    { const float* wl_ = wsf + 32 + 4 * hi_e;
#pragma unroll
      for (int r = 0; r < 16; ++r) rli[r] = __builtin_amdgcn_rcpf(wl_[(r & 3) + 8 * (r >> 2)]); }
    { bf16_t* stg = (bf16_t*)(shm + LDS_OST + wid * QWAVE);
      bf16_t* stl = stg + (4 * hi_e) * 64 + r32_e;
#pragma unroll
      for (int r = 0; r < 16; ++r) {
#pragma unroll
          for (int d0 = 0; d0 < 2; ++d0) stl[((r & 3) + 8 * (r >> 2)) * 64 + d0 * 32] = f2bf(o[d0][r] * rli[r]); }
      asm volatile("s_waitcnt lgkmcnt(0)" ::: "memory");
#pragma unroll
      for (int i = 0; i < 4; ++i) { const int row = i * 8 + (lane_e >> 3), ch = lane_e & 7; const u32x4 v = *(const u32x4*)(stg + row * 64 + ch * 8);
          bf16_t* dst = GQA4 ? (A.obase + (long)(8 * wid + (row >> 2)) * A.opitch + (row & 3) * 64) : (A.obase + (long)(32 * wid + row) * A.opitch);
          *(u32x4*)(dst + ch * 8) = v; } }
    asm volatile("s_waitcnt lgkmcnt(0)\n\ts_barrier" ::: "memory");
#undef TILE_OF
#undef DMA_K
#undef DMA_V
#undef CMASK
#undef CINIT
#undef START
#undef RESC
#undef ROT
#undef PKW
#undef PAF
#undef VFR
#undef PIN
#undef MX3
#undef GAPA
#undef GAPB
#undef EX
#undef VRD
#undef KRD
#undef MFMA32
#undef STEP
#undef STEP64
#undef STEP96
#undef VRD4
#undef VFR4
#undef GAPQ
#undef QL
#undef ENDW
#undef AWAIT_STEADY
}
}
constexpr int MK_THREADS = 512;
constexpr int LDS_RING = 131072;
constexpr int LDS_X = LDS_RING;
constexpr int LDS_MOD = LDS_RING + 8192;
constexpr int LDS_BARST = 155648 - 16;
constexpr int LDS_TOTAL = 155648;

#define C2Q 0.18033688011112042f
#define LOG2E 1.4426950408889634f

struct BlkDesc { bf16_t* dst; const float* gain; int pitch; int flags; float scale; int csoff; };
#define C2M 0.14724312203508865f
struct MKP {
    const float* in[34];
    float* out;
    float* modpart;
    float* mod;
    float* cosT; float* sinT;
    bf16_t* W_in0t;
    bf16_t* W_out0t;
    bf16_t* XN;
    bf16_t* OATT;
    bf16_t* QN;
    bf16_t* KV6;
    bf16_t* FQ; bf16_t* FK; bf16_t* FV;
    float* GATES;
    float* LOGF;
    BlkDesc* desc0;
    float* CUMB;
    BlkDesc* desc_uq;
    BlkDesc* desc_ukv;
    bf16_t* W_in1t;
    bf16_t* W_uqt;
    bf16_t* W_ukvt;
    bf16_t* W_out1t;
    bf16_t* P1;
    bf16_t* CQN;
    bf16_t* CKVN;
    bf16_t* Q96;
    bf16_t* K96;
    bf16_t* V1;
    bf16_t* WcT;
    float* CBIAS;
    bf16_t* KCMP;
    bf16_t* VCT;
    bf16_t* KSLF;
    bf16_t* VSLF;
    bf16_t* OCMP;
    bf16_t* OWIN;
    const int* pos;
    bf16_t* Wgu;
    bf16_t* Wd;
    bf16_t* HID;
    bf16_t* YS;
    bf16_t* YBUF;
    int* gcnt;
    int* list;
    float* ew;
    unsigned* barw;
    int ph_lo, ph_hi, dbg_flags, pad_;
};

__device__ __forceinline__ int swap45(int p) { return (p & 15) | ((p & 16) << 1) | ((p & 32) >> 1); }

template <class Map>
__device__ __forceinline__ void tr_item(const float* __restrict__ W, int ldw, int K, bf16_t* WT, LAS float* scr, int kb, int nb, int lane, const Map& cmap, const float* kscale) {
    const int k0 = 64 * kb, n0 = 32 * nb;
    const int sc = cmap(n0 + (lane & 31));
    float v[32];
    const float* src = W + (size_t)(k0 + (lane >> 5)) * ldw + (sc >= 0 ? sc : 0);
#pragma unroll
    for (int i = 0; i < 32; ++i) v[i] = src[(size_t)(2 * i) * ldw];
    if (kscale) {
#pragma unroll
        for (int i = 0; i < 32; ++i) v[i] *= kscale[k0 + 2 * i + (lane >> 5)];
    }
#pragma unroll
    for (int i = 0; i < 32; ++i) scr[(2 * i + (lane >> 5)) * 33 + (lane & 31)] = (sc >= 0) ? v[i] : 0.f;
    asm volatile("s_waitcnt lgkmcnt(0)" ::: "memory");
    const int c = lane & 7;
#pragma unroll
    for (int j = 0; j < 4; ++j) {
        const int n = (lane >> 3) + 8 * j; const LAS float* s = scr + (8 * c) * 33 + n;
        u32x4 o; o.x = cvtpk(s[0 * 33], s[1 * 33]); o.y = cvtpk(s[2 * 33], s[3 * 33]); o.z = cvtpk(s[4 * 33], s[5 * 33]); o.w = cvtpk(s[6 * 33], s[7 * 33]);
        *(u32x4*)(WT + (size_t)(n0 + n) * K + k0 + 8 * c) = o;
    }
    asm volatile("s_waitcnt lgkmcnt(0)" ::: "memory");
}
struct MapIn0 {
    __device__ __forceinline__ int operator()(int nn) const {
        const int blk = nn >> 6, p = nn & 63;
        if (blk < 8) return blk * 64 + swap45(p);
        if (blk < 20) return 512 + (blk - 8) * 64 + swap45(p);
        if (blk < 44) return 1304 + (blk - 20) * 64 + swap45(p);
        if (blk == 44) { if (p < 24) return 1280 + p; if (p < 32) return 2840 + (p - 24); return -1; }
        return -1;
    }
};
struct MapId { __device__ __forceinline__ int operator()(int nn) const { return nn; } };
struct MapIn1 { __device__ __forceinline__ int operator()(int nn) const { return nn < 672 ? nn : -1; } };
struct MapUq { __device__ __forceinline__ int operator()(int nn) const { if (nn < 1024) return (nn >> 6) * 96 + swap45(nn & 63); const int r = nn - 1024; return (r >> 5) * 96 + 64 + (r & 31); } };
struct MapUkv { __device__ __forceinline__ int operator()(int nn) const { if (nn < 1024) return (nn >> 6) * 128 + swap45(nn & 63); const int r = nn - 1024; return (r >> 6) * 128 + 64 + swap45(r & 63); } };

namespace nsa {
using att::f32x16; using att::crow;
#define NMFMA32(a, b, c) __builtin_amdgcn_mfma_f32_32x32x16_bf16(a, b, c, 0, 0, 0)
#define NMFMA16(a, b, c) __builtin_amdgcn_mfma_f32_16x16x32_bf16(a, b, c, 0, 0, 0)
#define RLF(x, l) __uint_as_float(__builtin_amdgcn_readlane((int)__float_as_uint(x), (l)))

__device__ __forceinline__ void compress_job(const MKP& p, LAS float* scr, LAS float* part, int job, int slice, int lane) {
    const int nt = job & 31, g = (job >> 5) & 1, kv = job >> 6;
    const int r32 = lane & 31, hi = lane >> 5, n0 = nt * 32;
    const bf16_t* tok = p.KV6 + (size_t)(kv * 2 + g) * S_ * 64;
    const bf16_t* wt = p.WcT + (size_t)kv * 64 * 2048;
    scr[lane] = p.CBIAS[kv * 64 + lane];
    asm volatile("s_waitcnt lgkmcnt(0)" ::: "memory");
    int nrow = n0 + r32; if (nrow > 1022) nrow = 1022;
    const bf16_t* ta = tok + (size_t)(16 * nrow) * 64 + 8 * hi;
    const bf16_t* wa0 = wt + (size_t)r32 * 2048 + 8 * hi;
    const bf16_t* wa1 = wa0 + (size_t)32 * 2048;
    f32x16 c0 = f32x16{}, c1 = f32x16{};
    if (kv == 0) {
#pragma unroll 8
        for (int s = 32 * slice; s < 32 * slice + 32; ++s) {
            const bf16x8 tf = *(const bf16x8*)(ta + 16 * s), w0 = *(const bf16x8*)(wa0 + 16 * s), w1 = *(const bf16x8*)(wa1 + 16 * s);
            c0 = NMFMA32(w0, tf, c0); c1 = NMFMA32(w1, tf, c1);
        }
        if (slice) {
#pragma unroll
            for (int r = 0; r < 16; ++r) { part[r * 64 + lane] = c0[r]; part[(16 + r) * 64 + lane] = c1[r]; } }
        __syncthreads();
        if (slice) return;
#pragma unroll
        for (int q = 1; q < 4; ++q)
#pragma unroll
            for (int r = 0; r < 16; ++r) { c0[r] += part[q * 2048 + r * 64 + lane]; c1[r] += part[q * 2048 + (16 + r) * 64 + lane]; }
        float ss = 0.f;
#pragma unroll
        for (int r = 0; r < 16; ++r) { c0[r] += scr[crow(r, hi)]; c1[r] += scr[32 + crow(r, hi)]; ss += c0[r] * c0[r] + c1[r] * c1[r]; }
        { auto rr = __builtin_amdgcn_permlane32_swap(__float_as_uint(ss), __float_as_uint(ss), false, false); ss = __uint_as_float(rr[0]) + __uint_as_float(rr[1]); }
        const float rs = rsqrtf(ss * (1.f / 64.f) + EPSF);
        const float* gn = p.in[10];
        if (n0 + r32 < 1023) {
            const int nn = n0 + r32;
            bf16_t* dst = p.KCMP + (size_t)g * 1024 * 64 + (size_t)(nn >> 6) * 4096 + ((nn >> 5) & 1) * 512 + (nn & 31) * 8;
#pragma unroll
            for (int q = 0; q < 4; ++q) {
                const int e0 = 8 * q + 4 * hi;
                const f32x4 ga = *(const f32x4*)(gn + e0), gb = *(const f32x4*)(gn + 32 + e0);
                u32x2 wa, wb;
                wa.x = cvtpk(c0[4 * q] * rs * ga.x, c0[4 * q + 1] * rs * ga.y); wa.y = cvtpk(c0[4 * q + 2] * rs * ga.z, c0[4 * q + 3] * rs * ga.w);
                wb.x = cvtpk(c1[4 * q] * rs * gb.x, c1[4 * q + 1] * rs * gb.y); wb.y = cvtpk(c1[4 * q + 2] * rs * gb.z, c1[4 * q + 3] * rs * gb.w);
                *(u32x2*)(dst + (e0 >> 4) * 1024 + ((e0 >> 3) & 1) * 256 + (e0 & 7)) = wa; *(u32x2*)(dst + ((32 + e0) >> 4) * 1024 + (((32 + e0) >> 3) & 1) * 256 + ((32 + e0) & 7)) = wb;
            }
        }
    } else {
#pragma unroll 8
        for (int s = 32 * slice; s < 32 * slice + 32; ++s) {
            const bf16x8 tf = *(const bf16x8*)(ta + 16 * s), w0 = *(const bf16x8*)(wa0 + 16 * s), w1 = *(const bf16x8*)(wa1 + 16 * s);
            c0 = NMFMA32(tf, w0, c0); c1 = NMFMA32(tf, w1, c1);
        }
        if (slice) {
#pragma unroll
            for (int r = 0; r < 16; ++r) { part[r * 64 + lane] = c0[r]; part[(16 + r) * 64 + lane] = c1[r]; } }
        __syncthreads();
        if (slice) return;
#pragma unroll
        for (int q = 1; q < 4; ++q)
#pragma unroll
            for (int r = 0; r < 16; ++r) { c0[r] += part[q * 2048 + r * 64 + lane]; c1[r] += part[q * 2048 + (16 + r) * 64 + lane]; }
        const float b0 = scr[r32], b1 = scr[32 + r32];
#pragma unroll
        for (int G = 0; G < 2; ++G) {
            u32x4 va, vb;
            va.x = cvtpk(c0[8 * G] + b0, c0[8 * G + 1] + b0); va.y = cvtpk(c0[8 * G + 2] + b0, c0[8 * G + 3] + b0); va.z = cvtpk(c0[8 * G + 4] + b0, c0[8 * G + 5] + b0); va.w = cvtpk(c0[8 * G + 6] + b0, c0[8 * G + 7] + b0);
            vb.x = cvtpk(c1[8 * G] + b1, c1[8 * G + 1] + b1); vb.y = cvtpk(c1[8 * G + 2] + b1, c1[8 * G + 3] + b1); vb.z = cvtpk(c1[8 * G + 4] + b1, c1[8 * G + 5] + b1); vb.w = cvtpk(c1[8 * G + 6] + b1, c1[8 * G + 7] + b1);
            { const int nk = n0 + 16 * G, c_ = nk >> 6, ks_ = (nk >> 4) & 3;
              bf16_t* vd = p.VCT + (size_t)g * 64 * 1024 + (size_t)c_ * 4096 + ks_ * 1024 + (hi * 32 + r32) * 8;
              *(u32x4*)vd = va; *(u32x4*)(vd + 512) = vb; }
        }
    }
    asm volatile("s_waitcnt lgkmcnt(0)" ::: "memory");
}

__device__ __forceinline__ unsigned pk4_fp8(float a, float b, float c, float d) { int w = __builtin_amdgcn_cvt_pk_fp8_f32(a, b, 0, false); w = __builtin_amdgcn_cvt_pk_fp8_f32(c, d, w, true); return (unsigned)w; }
__device__ __forceinline__ void slcfrag_job(const MKP& p, int job, int lane) {
    const int g = job >> 8, blk = job & 255, c16 = lane & 15, u = lane >> 4;
    const bf16_t* k = p.KV6 + (size_t)(2 * 2 + g) * S_ * 64 + (size_t)blk * 64 * 64;
    const bf16_t* v = p.KV6 + (size_t)(3 * 2 + g) * S_ * 64 + (size_t)blk * 64 * 64;
    unsigned char* kd = (unsigned char*)p.KSLF + ((size_t)g * 256 + blk) * 4096 + lane * 16;
    unsigned char* vd = (unsigned char*)p.VSLF + ((size_t)g * 256 + blk) * 4096 + lane * 16;
#pragma unroll
    for (int kg = 0; kg < 4; ++kg) {
        const u32x4 a = *(const u32x4*)(k + (size_t)(16 * kg + c16) * 64 + 8 * u), b = *(const u32x4*)(k + (size_t)(16 * kg + c16) * 64 + 32 + 8 * u);
        u32x4 o;
        o.x = pk4_fp8(__uint_as_float(a.x << 16), __uint_as_float(a.x & 0xffff0000u), __uint_as_float(a.y << 16), __uint_as_float(a.y & 0xffff0000u));
        o.y = pk4_fp8(__uint_as_float(a.z << 16), __uint_as_float(a.z & 0xffff0000u), __uint_as_float(a.w << 16), __uint_as_float(a.w & 0xffff0000u));
        o.z = pk4_fp8(__uint_as_float(b.x << 16), __uint_as_float(b.x & 0xffff0000u), __uint_as_float(b.y << 16), __uint_as_float(b.y & 0xffff0000u));
        o.w = pk4_fp8(__uint_as_float(b.z << 16), __uint_as_float(b.z & 0xffff0000u), __uint_as_float(b.w << 16), __uint_as_float(b.w & 0xffff0000u));
        *(u32x4*)(kd + kg * 1024) = o;
    }
#pragma unroll
    for (int dg = 0; dg < 4; ++dg) {
        float x[16];
#pragma unroll
        for (int ch = 0; ch < 2; ++ch)
#pragma unroll
            for (int j = 0; j < 8; ++j) { const int key = 32 * ch + ((j < 4) ? 4 * u + j : 16 + 4 * u + (j - 4)); x[ch * 8 + j] = bf2f(v[(size_t)key * 64 + 16 * dg + c16]); }
        u32x4 o; o.x = pk4_fp8(x[0], x[1], x[2], x[3]); o.y = pk4_fp8(x[4], x[5], x[6], x[7]); o.z = pk4_fp8(x[8], x[9], x[10], x[11]); o.w = pk4_fp8(x[12], x[13], x[14], x[15]);
        *(u32x4*)(vd + dg * 1024) = o;
    }
}

constexpr int IMP_LD = 272;
__device__ __forceinline__ void cmp_wave(const MKP& p, int g, int t0w, LAS float* imp, LAS unsigned char* stg, int lane) {
    const int r32 = lane & 31, hi = lane >> 5;
    const int tq = t0w + (r32 >> 2), head = g * 4 + (r32 & 3);
    const int nmax = (tq >= 31) ? ((tq - 31) >> 4) : -1;
    const int nmaxw = (t0w + 7 >= 31) ? ((t0w + 7 - 31) >> 4) : -1;
    const int ntile = (nmaxw >> 6) + 1;
    for (int i = lane; i < 8 * IMP_LD; i += 64) imp[i] = 0.f;
    bf16x8 qr[4];
#pragma unroll
    for (int d0 = 0; d0 < 4; ++d0) qr[d0] = *(const bf16x8*)(p.QN + (size_t)tq * 512 + head * 64 + d0 * 16 + hi * 8);
    const bf16_t* kc = p.KCMP + (size_t)g * 1024 * 64 + (hi * 32 + r32) * 8;
    bf16x8 ovf[4];
#pragma unroll
    for (int ks = 0; ks < 4; ++ks)
#pragma unroll
        for (int j = 0; j < 8; ++j) {
            const int nrel = 16 * ks + ((j < 4) ? 4 * hi + j : 8 + 4 * hi + (j - 4));
            const int dlt = nrel - 4 * r32;
            const float w = (dlt >= 0 && dlt <= 2) ? 2.f : ((dlt == 3 || dlt == -1) ? 1.f : 0.f);
            ovf[ks][j] = (short)f2bf(w);
        }
#define CKLOAD(dst, c_) do { const bf16_t* kt_ = kc + (size_t)(c_) * 4096; _Pragma("unroll") for (int f_ = 0; f_ < 8; ++f_) dst[f_] = *(const bf16x8*)(kt_ + f_ * 512); } while (0)
#define CQK(s0, s1, kf) do { s0 = f32x16{}; s1 = f32x16{}; _Pragma("unroll") for (int d0_ = 0; d0_ < 4; ++d0_) { s0 = NMFMA32(kf[2 * d0_], qr[d0_], s0); s1 = NMFMA32(kf[2 * d0_ + 1], qr[d0_], s1); } } while (0)
    float m = -INFINITY, l = 0.f;
    bf16x8 kfa[8], kfb[8];
    if (ntile > 0) CKLOAD(kfa, 0);
#define CMP_P1(KC, KN, c) do { { const int cn_ = ((c) + 1 < ntile) ? (c) + 1 : ntile - 1; CKLOAD(KN, cn_); } \
        f32x16 s0, s1; CQK(s0, s1, KC); \
        const int x = nmax - 64 * (c) - 4 * hi; float tm = -INFINITY; \
        _Pragma("unroll") for (int r = 0; r < 16; ++r) { const int cc = (r & 3) + 8 * (r >> 2); if (cc > x) s0[r] = -INFINITY; if (cc + 32 > x) s1[r] = -INFINITY; tm = fmaxf(tm, fmaxf(s0[r], s1[r])); } \
        if (tm > m) { l *= __builtin_amdgcn_exp2f(m - tm); m = tm; } \
        if (m > -INFINITY) { float sum = 0.f; _Pragma("unroll") for (int r = 0; r < 16; ++r) sum += __builtin_amdgcn_exp2f(s0[r] - m) + __builtin_amdgcn_exp2f(s1[r] - m); l += sum; } } while (0)
#pragma unroll 1
    for (int c = 0; c < ntile; c += 2) { CMP_P1(kfa, kfb, c); if (c + 1 < ntile) CMP_P1(kfb, kfa, c + 1); }
    { auto rm = __builtin_amdgcn_permlane32_swap(__float_as_uint(m), __float_as_uint(m), false, false);
      auto rl = __builtin_amdgcn_permlane32_swap(__float_as_uint(l), __float_as_uint(l), false, false);
      const float ma = __uint_as_float(rm[0]), mb = __uint_as_float(rm[1]), la = __uint_as_float(rl[0]), lb = __uint_as_float(rl[1]);
      const float mm = fmaxf(ma, mb);
      if (mm > -INFINITY) { l = ((ma > -INFINITY) ? la * __builtin_amdgcn_exp2f(ma - mm) : 0.f) + ((mb > -INFINITY) ? lb * __builtin_amdgcn_exp2f(mb - mm) : 0.f); m = mm; }
      else { l = 0.f; m = 0.f; } }
    const float invl = (l > 0.f) ? 1.f / l : 0.f;
    f32x16 o0 = f32x16{}, o1 = f32x16{};
    const bf16_t* vc = p.VCT + (size_t)g * 64 * 1024 + (hi * 32 + r32) * 8;
    if (ntile > 0) CKLOAD(kfa, 0);
    bf16x8 vfr[8];
#define CMP_P2(KC, KN, c) do { \
        { const bf16_t* vt_ = vc + (size_t)(c) * 4096; _Pragma("unroll") for (int f_ = 0; f_ < 8; ++f_) vfr[f_] = *(const bf16x8*)(vt_ + f_ * 512); } \
        { const int cn_ = ((c) + 1 < ntile) ? (c) + 1 : ntile - 1; CKLOAD(KN, cn_); } \
        f32x16 s0, s1; CQK(s0, s1, KC); \
        const int x = nmax - 64 * (c) - 4 * hi; \
        _Pragma("unroll") for (int r = 0; r < 16; ++r) { const int cc = (r & 3) + 8 * (r >> 2); \
            s0[r] = (cc > x) ? 0.f : __builtin_amdgcn_exp2f(s0[r] - m) * invl; s1[r] = (cc + 32 > x) ? 0.f : __builtin_amdgcn_exp2f(s1[r] - m) * invl; } \
        u32x4 pw[4]; \
        pw[0] = (u32x4){cvtpk(s0[0], s0[1]), cvtpk(s0[2], s0[3]), cvtpk(s0[4], s0[5]), cvtpk(s0[6], s0[7])}; \
        pw[1] = (u32x4){cvtpk(s0[8], s0[9]), cvtpk(s0[10], s0[11]), cvtpk(s0[12], s0[13]), cvtpk(s0[14], s0[15])}; \
        pw[2] = (u32x4){cvtpk(s1[0], s1[1]), cvtpk(s1[2], s1[3]), cvtpk(s1[4], s1[5]), cvtpk(s1[6], s1[7])}; \
        pw[3] = (u32x4){cvtpk(s1[8], s1[9]), cvtpk(s1[10], s1[11]), cvtpk(s1[12], s1[13]), cvtpk(s1[14], s1[15])}; \
        f32x16 im = f32x16{}; \
        _Pragma("unroll") for (int ks = 0; ks < 4; ++ks) { const bf16x8 pa = __builtin_bit_cast(bf16x8, pw[ks]); \
            o0 = NMFMA32(pa, vfr[2 * ks], o0); o1 = NMFMA32(pa, vfr[2 * ks + 1], o1); im = NMFMA32(pa, ovf[ks], im); } \
        if (r32 <= 16 && 16 * (c) + r32 < 256) { \
            _Pragma("unroll") for (int k = 0; k < 4; ++k) { const float v = (im[4 * k] + im[4 * k + 1]) + (im[4 * k + 2] + im[4 * k + 3]); atomicAdd((float*)(imp + (2 * k + hi) * IMP_LD + 16 * (c) + r32), v); } } } while (0)
#pragma unroll 1
    for (int c = 0; c < ntile; c += 2) { CMP_P2(kfa, kfb, c); if (c + 1 < ntile) CMP_P2(kfb, kfa, c + 1); }
#undef CMP_P1
#undef CMP_P2
#undef CKLOAD
#undef CQK
    { bf16_t* st = (bf16_t*)stg; bf16_t* stl = st + (4 * hi) * 64 + r32;
#pragma unroll
      for (int r = 0; r < 16; ++r) { stl[((r & 3) + 8 * (r >> 2)) * 64] = f2bf(o0[r]); stl[((r & 3) + 8 * (r >> 2)) * 64 + 32] = f2bf(o1[r]); }
      asm volatile("s_waitcnt lgkmcnt(0)" ::: "memory");
#pragma unroll
      for (int i = 0; i < 4; ++i) { const int row = i * 8 + (lane >> 3), ch = lane & 7; const u32x4 v = *(const u32x4*)(st + row * 64 + ch * 8);
          *(u32x4*)(p.OCMP + (size_t)(t0w + (row >> 2)) * 512 + (g * 4 + (row & 3)) * 64 + ch * 8) = v; }
      asm volatile("s_waitcnt lgkmcnt(0)" ::: "memory"); }
}

__device__ __forceinline__ float dpp_f(float v, int ctrl_sel) {
    const int x = __float_as_int(v);
    int r;
    if (ctrl_sel == 0) r = __builtin_amdgcn_update_dpp(x, x, 0xB1, 0xF, 0xF, false);
    else if (ctrl_sel == 1) r = __builtin_amdgcn_update_dpp(x, x, 0x4E, 0xF, 0xF, false);
    else if (ctrl_sel == 2) r = __builtin_amdgcn_update_dpp(x, x, 0x124, 0xF, 0xF, false);
    else r = __builtin_amdgcn_update_dpp(x, x, 0x128, 0xF, 0xF, false);
    return __int_as_float(r);
}
__device__ __forceinline__ int dpp_i(int x, int ctrl_sel) {
    if (ctrl_sel == 0) return __builtin_amdgcn_update_dpp(x, x, 0xB1, 0xF, 0xF, false);
    if (ctrl_sel == 1) return __builtin_amdgcn_update_dpp(x, x, 0x4E, 0xF, 0xF, false);
    if (ctrl_sel == 2) return __builtin_amdgcn_update_dpp(x, x, 0x124, 0xF, 0xF, false);
    return __builtin_amdgcn_update_dpp(x, x, 0x128, 0xF, 0xF, false);
}
__device__ __forceinline__ void select_wave(int t0w, const LAS float* imp, LAS int* sel, int lane) {
    const int sub = lane & 31;
#pragma unroll 1
    for (int h = 0; h < 4; ++h) {
        const int tk = 2 * h + (lane >> 5);
        const int tq = t0w + tk, cur = tq >> 6;
        float v[8];
#pragma unroll
        for (int i = 0; i < 8; ++i) { const int j = sub + 32 * i; float x = imp[tk * IMP_LD + j]; if (j == 0 || j == cur || j == cur - 1) x += 1e6f; v[i] = (j <= cur) ? x : -INFINITY; }
#pragma unroll 1
        for (int it = 0; it < 16; ++it) {
            float bv = v[0]; int bi = 0;
#pragma unroll
            for (int i = 1; i < 8; ++i) if (v[i] > bv) { bv = v[i]; bi = i; }
            float gm = bv;
#pragma unroll
            for (int c = 0; c < 4; ++c) gm = fmaxf(gm, dpp_f(gm, c));
            gm = fmaxf(gm, __shfl_xor(gm, 16));
            int cj = (bv == gm) ? sub + 32 * bi : 0x7fffffff;
#pragma unroll
            for (int c = 0; c < 4; ++c) cj = min(cj, dpp_i(cj, c));
            cj = min(cj, __shfl_xor(cj, 16));
            const bool any = gm > -INFINITY;
            if (sub == 0) sel[tk * 16 + it] = any ? cj : -1;
            if (any && (cj & 31) == sub) { const int wi = cj >> 5;
#pragma unroll
                for (int i = 0; i < 8; ++i) if (i == wi) v[i] = -INFINITY; }
        }
    }
    asm volatile("s_waitcnt lgkmcnt(0)" ::: "memory");
}

__device__ __forceinline__ void slc_wave(const MKP& p, int g, int t0w, const LAS int* sel, LAS float* oslc, int lane) {
    const int c16 = lane & 15, u = lane >> 4, ti = c16 >> 2;
    const unsigned char* kb = (const unsigned char*)p.KSLF + (size_t)g * 256 * 4096 + lane * 16;
    const unsigned char* vb = (const unsigned char*)p.VSLF + (size_t)g * 256 * 4096 + lane * 16;
#define LO64(vv_) ((long)(((unsigned long long)(vv_).y << 32) | (vv_).x))
#define HI64(vv_) ((long)(((unsigned long long)(vv_)[3] << 32) | (vv_).z))
#define FMFMA(a, b, c) __builtin_amdgcn_mfma_f32_16x16x32_fp8_fp8(a, b, c, 0, 0, 0)
#define KLOAD4(r_) do { _Pragma("unroll") for (int i_ = 0; i_ < 4; ++i_) { int b_ = sel[(tg * 4 + i_) * 16 + (r_)]; b_ = b_ < 0 ? 0 : b_; const unsigned char* kp_ = kb + (size_t)b_ * 4096; \
        _Pragma("unroll") for (int f_ = 0; f_ < 4; ++f_) kc[i_][f_] = *(const u32x4*)(kp_ + f_ * 1024); } } while (0)
#pragma unroll 1
    for (int tg = 0; tg < 2; ++tg) {
        const int tq = t0w + tg * 4 + ti;
        long qa, qb2;
        { const bf16_t* qp = p.QN + (size_t)tq * 512 + (g * 4 + (c16 & 3)) * 64 + 8 * u;
          const u32x4 r0 = *(const u32x4*)qp, r1 = *(const u32x4*)(qp + 32);
          const unsigned a0 = pk4_fp8(8.f * __uint_as_float(r0.x << 16), 8.f * __uint_as_float(r0.x & 0xffff0000u), 8.f * __uint_as_float(r0.y << 16), 8.f * __uint_as_float(r0.y & 0xffff0000u));
          const unsigned a1 = pk4_fp8(8.f * __uint_as_float(r0.z << 16), 8.f * __uint_as_float(r0.z & 0xffff0000u), 8.f * __uint_as_float(r0.w << 16), 8.f * __uint_as_float(r0.w & 0xffff0000u));
          const unsigned b0 = pk4_fp8(8.f * __uint_as_float(r1.x << 16), 8.f * __uint_as_float(r1.x & 0xffff0000u), 8.f * __uint_as_float(r1.y << 16), 8.f * __uint_as_float(r1.y & 0xffff0000u));
          const unsigned b1 = pk4_fp8(8.f * __uint_as_float(r1.z << 16), 8.f * __uint_as_float(r1.z & 0xffff0000u), 8.f * __uint_as_float(r1.w << 16), 8.f * __uint_as_float(r1.w & 0xffff0000u));
          qa = (long)(((unsigned long long)a1 << 32) | a0); qb2 = (long)(((unsigned long long)b1 << 32) | b0); }
        long q0[4], q1[4];
#pragma unroll
        for (int i = 0; i < 4; ++i) { q0[i] = (ti == i) ? qa : 0; q1[i] = (ti == i) ? qb2 : 0; }
        u32x4 kc[4][4], vf[4][4];
        KLOAD4(0);
        float m = -INFINITY, l = 0.f;
        f32x4 o[4]; o[0] = o[1] = o[2] = o[3] = (f32x4){0.f, 0.f, 0.f, 0.f};
#pragma unroll 1
        for (int r = 0; r < 16; ++r) {
#pragma unroll
            for (int i = 0; i < 4; ++i) { int b_ = sel[(tg * 4 + i) * 16 + r]; b_ = b_ < 0 ? 0 : b_; const unsigned char* vp = vb + (size_t)b_ * 4096;
#pragma unroll
                for (int dg = 0; dg < 4; ++dg) vf[i][dg] = *(const u32x4*)(vp + dg * 1024); }
            f32x4 s[4];
#pragma unroll
            for (int kg = 0; kg < 4; ++kg) { f32x4 c = (f32x4){0.f, 0.f, 0.f, 0.f};
#pragma unroll
                for (int i = 0; i < 4; ++i) { c = FMFMA(LO64(kc[i][kg]), q0[i], c); c = FMFMA(HI64(kc[i][kg]), q1[i], c); }
                s[kg] = c * 0.125f; }
            { const int rn = (r < 15) ? r + 1 : 15; KLOAD4(rn); }
            const int myblk = sel[(tg * 4 + ti) * 16 + r];
            { const int x = (myblk < 0) ? -1 : ((myblk == (tq >> 6)) ? tq - 64 * myblk - 4 * u : 64);
#pragma unroll
              for (int kg = 0; kg < 4; ++kg) { if (16 * kg > x) s[kg].x = -INFINITY; if (16 * kg + 1 > x) s[kg].y = -INFINITY; if (16 * kg + 2 > x) s[kg].z = -INFINITY; if (16 * kg + 3 > x) s[kg].w = -INFINITY; } }
            float tm = -INFINITY;
#pragma unroll
            for (int kg = 0; kg < 4; ++kg) tm = fmaxf(tm, fmaxf(fmaxf(s[kg].x, s[kg].y), fmaxf(s[kg].z, s[kg].w)));
            tm = fmaxf(tm, __shfl_xor(tm, 16)); tm = fmaxf(tm, __shfl_xor(tm, 32));
            float alpha = 1.f;
            if (tm > m) { alpha = __builtin_amdgcn_exp2f(m - tm); m = tm; }
            l *= alpha;
            float sum = 0.f;
#pragma unroll
            for (int kg = 0; kg < 4; ++kg) { s[kg].x = __builtin_amdgcn_exp2f(s[kg].x - m); s[kg].y = __builtin_amdgcn_exp2f(s[kg].y - m); s[kg].z = __builtin_amdgcn_exp2f(s[kg].z - m); s[kg].w = __builtin_amdgcn_exp2f(s[kg].w - m);
                sum += (s[kg].x + s[kg].y) + (s[kg].z + s[kg].w); }
            l += sum;
            { const float a0 = __shfl(alpha, 4 * u), a1 = __shfl(alpha, 4 * u + 1), a2 = __shfl(alpha, 4 * u + 2), a3 = __shfl(alpha, 4 * u + 3);
#pragma unroll
              for (int dg = 0; dg < 4; ++dg) { o[dg].x *= a0; o[dg].y *= a1; o[dg].z *= a2; o[dg].w *= a3; } }
#pragma unroll
            for (int ch = 0; ch < 2; ++ch) {
                const f32x4 pa_ = s[2 * ch] * 128.f, pb_ = s[2 * ch + 1] * 128.f;
                const unsigned lo_ = pk4_fp8(pa_.x, pa_.y, pa_.z, pa_.w), hi_ = pk4_fp8(pb_.x, pb_.y, pb_.z, pb_.w);
                const long pa = (long)(((unsigned long long)hi_ << 32) | lo_);
#pragma unroll
                for (int i = 0; i < 4; ++i) { const long pi = (ti == i) ? pa : 0;
#pragma unroll
                    for (int dg = 0; dg < 4; ++dg) o[dg] = FMFMA(pi, ch ? HI64(vf[i][dg]) : LO64(vf[i][dg]), o[dg]); }
            }
        }
        { float lt = l; lt += __shfl_xor(lt, 16); lt += __shfl_xor(lt, 32);
          const float il = (lt > 0.f) ? (1.f / 128.f) / lt : 0.f;
          const float i0 = __shfl(il, 4 * u), i1 = __shfl(il, 4 * u + 1), i2 = __shfl(il, 4 * u + 2), i3 = __shfl(il, 4 * u + 3);
          LAS float* op = oslc + (tg * 4 + u) * 256 + c16;
#pragma unroll
          for (int dg = 0; dg < 4; ++dg) { op[16 * dg] = o[dg].x * i0; op[64 + 16 * dg] = o[dg].y * i1; op[128 + 16 * dg] = o[dg].z * i2; op[192 + 16 * dg] = o[dg].w * i3; } }
    }
#undef KLOAD4
#undef LO64
#undef HI64
#undef FMFMA
    asm volatile("s_waitcnt lgkmcnt(0)" ::: "memory");
    {
        const int tkl = lane >> 3, cc = (lane & 7) * 32, hh = cc >> 6;
        const int tq = t0w + tkl;
        const float* gt = p.GATES + (size_t)tq * 24 + (g * 4 + hh) * 3;
        const float gc = 1.f / (1.f + __expf(-gt[0])), gs = 1.f / (1.f + __expf(-gt[1])), gw = 1.f / (1.f + __expf(-gt[2]));
        const size_t col = (size_t)tq * 512 + g * 256 + cc;
        const LAS float* os = oslc + tkl * 256 + cc;
#pragma unroll
        for (int q = 0; q < 4; ++q) {
            const u32x4 wc = *(const u32x4*)(p.OCMP + col + 8 * q), ww = *(const u32x4*)(p.OWIN + col + 8 * q);
            const f32x4 sa = *(const LAS f32x4*)(os + 8 * q), sb = *(const LAS f32x4*)(os + 8 * q + 4);
            u32x4 r;
            r.x = cvtpk(gs * sa.x + gc * __uint_as_float(wc.x << 16) + gw * __uint_as_float(ww.x << 16), gs * sa.y + gc * __uint_as_float(wc.x & 0xffff0000u) + gw * __uint_as_float(ww.x & 0xffff0000u));
            r.y = cvtpk(gs * sa.z + gc * __uint_as_float(wc.y << 16) + gw * __uint_as_float(ww.y << 16), gs * sa.w + gc * __uint_as_float(wc.y & 0xffff0000u) + gw * __uint_as_float(ww.y & 0xffff0000u));
            r.z = cvtpk(gs * sb.x + gc * __uint_as_float(wc.z << 16) + gw * __uint_as_float(ww.z << 16), gs * sb.y + gc * __uint_as_float(wc.z & 0xffff0000u) + gw * __uint_as_float(ww.z & 0xffff0000u));
            r.w = cvtpk(gs * sb.z + gc * __uint_as_float(wc.w << 16) + gw * __uint_as_float(ww.w << 16), gs * sb.w + gc * __uint_as_float(wc.w & 0xffff0000u) + gw * __uint_as_float(ww.w & 0xffff0000u));
            *(u32x4*)(p.OATT + (size_t)tq * 1024 + g * 256 + cc + 8 * q) = r;
        }
    }
}

__device__ __forceinline__ void nsa_unit(const MKP& p, char* shm, int g, int tile) {
    int tid_ = threadIdx.x; asm volatile("" : "+v"(tid_));
    const int tid = tid_, lane = tid & 63, r32 = lane & 31; const int wid = __builtin_amdgcn_readfirstlane(tid >> 6);
    const int t0 = tile * 64;
    {   att::UnitArgs A;
        A.qrow = p.QN + (size_t)(t0 + 8 * wid + (r32 >> 2)) * 512 + (g * 4 + (r32 & 3)) * 64;
        A.K = p.KV6 + (size_t)(4 * 2 + g) * S_ * 64; A.V = p.KV6 + (size_t)(5 * 2 + g) * S_ * 64; A.kvpitch = 64; A.vpitch = 64;
        A.obase = p.OWIN + (size_t)t0 * 512 + g * 256; A.opitch = 512;
        A.qtok = 8 * wid + (r32 >> 2); A.abase = tile;
        const int real = (tile + 1 < 9) ? tile + 1 : 9; int nt = (real + 1) & ~1; if (nt < 4) nt = 4;
        A.nsteps = nt; A.bias = nullptr;
        att::attn_unit<att::MODE_WIN, true, 8, 64>(A, shm);
    }
    LAS unsigned char* l3 = (LAS unsigned char*)shm;
    LAS float* imp = (LAS float*)(l3 + wid * (8 * IMP_LD * 4));
    LAS int* sel = (LAS int*)(l3 + 8 * (8 * IMP_LD * 4) + wid * 512);
    LAS unsigned char* stg = l3 + 8 * (8 * IMP_LD * 4) + 8 * 512 + wid * 4096;
    const int t0w = t0 + 8 * wid;
    { int ln = lane; asm volatile("" : "+v"(ln)); cmp_wave(p, g, t0w, imp, stg, ln); }
    asm volatile("s_waitcnt vmcnt(0) lgkmcnt(0)" ::: "memory");
    { int ln = lane; asm volatile("" : "+v"(ln)); select_wave(t0w, imp, sel, ln); }
    { int ln = lane; asm volatile("" : "+v"(ln)); slc_wave(p, g, t0w, sel, imp, ln); }
    asm volatile("s_waitcnt vmcnt(0) lgkmcnt(0)\n\ts_barrier" ::: "memory");
}
#undef NMFMA32
#undef NMFMA16
#undef RLF
}

__device__ __forceinline__ void phase_prologue(const MKP& p, LAS unsigned char* lds) {
    const int tid = threadIdx.x, lane = tid & 63, wave = tid >> 6;
    const int gw = blockIdx.x * 8 + wave, NGW = gridDim.x * 8;
    LAS float* scr = (LAS float*)(lds + wave * 16384);
    for (int it = gw; it < 8 * 192; it += NGW) {
        const int kc = it / 192, ch = it % 192, idx = ch * 64 + lane, l = idx / 6144, n = idx % 6144;
        const float* w = p.in[5] + (size_t)l * 1024 * 6144 + n;
        const float* c = p.in[1];
        float acc = 0.f;
#pragma unroll 8
        for (int k = kc * 128; k < kc * 128 + 128; ++k) { const float cv = c[k]; acc += (cv / (1.f + __expf(-cv))) * w[(size_t)k * 6144]; }
        p.modpart[kc * 12288 + idx] = acc;
    }
    if (blockIdx.x == 1 && tid < 128) p.gcnt[tid] = 0;
    if (blockIdx.x == 0 && tid < 96 + 48 + 64) {
        BlkDesc d; d.dst = nullptr; d.gain = nullptr; d.pitch = 0; d.flags = 4; d.scale = 1.f; d.csoff = 0;
        if (tid < 96) {
            const int blk = (tid >> 3) * 4 + ((tid >> 2) & 1) * 2 + ((tid >> 1) & 1);
            d.flags = 0;
            if (blk < 8) { d.dst = p.QN + blk * 64; d.pitch = 512; d.gain = p.in[9]; d.flags = 1; d.scale = C2Q; }
            else if (blk < 20) { const int j = (blk - 8) >> 1, g = (blk - 8) & 1; d.dst = p.KV6 + (size_t)(j * 2 + g) * S_ * 64; d.pitch = 64;
                d.gain = (j == 2 || j == 4) ? p.in[10] : nullptr; d.flags = (j == 0 || j == 2 || j == 4) ? 1 : 0; }
            else if (blk < 28) { d.dst = p.FQ + (blk - 20) * 64; d.pitch = 512; d.gain = p.in[13]; d.scale = C2Q; }
            else if (blk < 36) { d.dst = p.FK + (blk - 28) * 64; d.pitch = 512; d.gain = p.in[14]; }
            else if (blk < 44) { d.dst = p.FV + (blk - 36) * 64; d.pitch = 512; }
            else if (blk == 44) d.flags = 2;
            else d.flags = 4;
            p.desc0[tid] = d;
        } else if (tid < 96 + 48) {
            const int e = tid - 96, pn = e >> 3, bj = (e >> 2) & 1, wc = e & 3;
            if (pn < 4) { const int h = pn * 4 + bj * 2 + (wc >> 1); d.dst = p.Q96 + (size_t)h * S_ * 96; d.pitch = 96; d.gain = p.in[21]; d.flags = 0; d.scale = C2M; }
            else { const int h = (pn - 4) * 8 + bj * 4 + wc; d.dst = p.Q96 + (size_t)h * S_ * 96 + 64; d.pitch = 96; d.gain = p.in[23]; d.flags = 1 | 8; d.scale = C2M; d.csoff = 32; }
            p.desc_uq[e] = d;
        } else {
            const int e = tid - 144, pn = e >> 3, bj = (e >> 2) & 1, wc = e & 3;
            const int h = (pn & 3) * 4 + bj * 2 + (wc >> 1);
            if (pn < 4) { d.dst = p.K96 + (size_t)h * S_ * 96; d.pitch = 96; d.gain = p.in[22]; d.flags = 32; }
            else { d.dst = p.V1 + (size_t)h * S_ * 64; d.pitch = 64; d.gain = nullptr; d.flags = 64; }
            p.desc_ukv[e] = d;
        }
    }
    if (blockIdx.x == 2 || blockIdx.x == 3) {
        const int kv = blockIdx.x - 2, e = tid & 63, sl = tid >> 6;
        const float* w = p.in[12] + (size_t)kv * 2048 * 64 + e; const float* pe = p.in[11] + kv * 2048;
        float b = 0.f;
#pragma unroll 8
        for (int k = sl * 256; k < sl * 256 + 256; ++k) b += pe[k] * w[(size_t)k * 64];
        LAS float* red = (LAS float*)(lds + 140000);
        red[tid] = b;
        __syncthreads();
        if (tid < 64) { float a = 0.f;
#pragma unroll
            for (int q = 0; q < 8; ++q) a += red[q * 64 + tid];
            p.CBIAS[kv * 64 + tid] = a; }
    }
    for (int idx = blockIdx.x * MK_THREADS + tid; idx < S_ * 48; idx += gridDim.x * MK_THREADS) {
        const int t = idx / 48, i = idx % 48;
        const double ex = (i < 32) ? (double)(2 * i) / 64.0 : (double)(2 * (i - 32)) / 32.0;
        const double a = (double)p.pos[t] * exp(-ex * 9.210340371976184);
        const double r = a - rint(a * 0.15915494309189535) * 6.283185307179586;
        const float rf = (float)r;
        p.cosT[idx] = cosf(rf); p.sinT[idx] = sinf(rf);
    }
    for (int it = gw; it < 2 * 32 * 2; it += NGW) { const int kv = it >> 6, r = it & 63; tr_item(p.in[12] + (size_t)kv * 2048 * 64, 64, 2048, p.WcT + (size_t)kv * 64 * 2048, scr, r >> 1, r & 1, lane, MapId(), nullptr); }
    constexpr int I_IN0 = 16 * 96, I_OUT0 = 16 * 32, I_IN1 = 16 * 24, I_UQ = 6 * 48, I_UKV = 4 * 64, I_OUT1 = 16 * 32;
    for (int it = gw; it < I_IN0 + I_OUT0 + I_IN1 + I_UQ + I_UKV + I_OUT1; it += NGW) {
        int r = it;
        if (r < I_IN0) { tr_item(p.in[7], HYIN, 1024, p.W_in0t, scr, r / 96, r % 96, lane, MapIn0(), nullptr); continue; } r -= I_IN0;
        if (r < I_OUT0) { tr_item(p.in[15], 1024, 1024, p.W_out0t, scr, r / 32, r % 32, lane, MapId(), nullptr); continue; } r -= I_OUT0;
        if (r < I_IN1) { tr_item(p.in[16], 672, 1024, p.W_in1t, scr, r / 24, r % 24, lane, MapIn1(), nullptr); continue; } r -= I_IN1;
        if (r < I_UQ) { tr_item(p.in[19], 1536, 384, p.W_uqt, scr, r / 48, r % 48, lane, MapUq(), p.in[17]); continue; } r -= I_UQ;
        if (r < I_UKV) { tr_item(p.in[20], 2048, 256, p.W_ukvt, scr, r / 64, r % 64, lane, MapUkv(), p.in[18]); continue; } r -= I_UKV;
        tr_item(p.in[25], 1024, 1024, p.W_out1t, scr, r / 32, r % 32, lane, MapId(), nullptr);
    }
}

template <bool COMB>
__device__ __forceinline__ void phase_norm(const MKP& p, LAS unsigned char* lds, const float* x, const float* gw_, int layer, int sc_idx, int sh_idx, bool finalize_mod) {
    const int tid = threadIdx.x, lane = tid & 63, wave = tid >> 6;
    LAS float* msc = (LAS float*)(lds + LDS_MOD);
    LAS float* msh = msc + 1024;
    const float* b_ada = p.in[6];
    if (finalize_mod) {
        for (int i = tid; i < 2048; i += MK_THREADS) {
            const int idx = layer * 6144 + ((i < 1024) ? sc_idx * 1024 + i : sh_idx * 1024 + (i - 1024));
            float a = b_ada[idx];
#pragma unroll
            for (int kc = 0; kc < 8; ++kc) a += p.modpart[kc * 12288 + idx];
            msc[i] = a;
        }
        for (int idx = blockIdx.x * MK_THREADS + tid; idx < 12288; idx += gridDim.x * MK_THREADS) {
            float a = b_ada[idx];
#pragma unroll
            for (int kc = 0; kc < 8; ++kc) a += p.modpart[kc * 12288 + idx];
            p.mod[idx] = a;
        }
    } else {
        for (int i = tid; i < 2048; i += MK_THREADS)
            msc[i] = p.mod[layer * 6144 + ((i < 1024) ? sc_idx * 1024 + i : sh_idx * 1024 + (i - 1024))];
    }
    __syncthreads();
    const int gwv = blockIdx.x * 8 + wave, NGW = gridDim.x * 8;
    for (int m = gwv; m < S_; m += NGW) {
        const f32x4* xr = (const f32x4*)(x + (size_t)m * D_) + lane;
        f32x4 v[4]; float s = 0.f;
#pragma unroll
        for (int j = 0; j < 4; ++j) {
            v[j] = xr[64 * j];
            if (COMB) {
                f32x4 ys = (f32x4){0.f, 0.f, 0.f, 0.f};
#pragma unroll
                for (int k = 0; k < 8; ++k) {
                    const int w = *((const int*)((const char*)p.YBUF + ((size_t)m * 8 + k) * 1024) + lane + 64 * j);
                    const f32x2 lo = __builtin_amdgcn_cvt_pk_f32_fp8(w, false), hi = __builtin_amdgcn_cvt_pk_f32_fp8(w, true);
                    ys.x += lo.x; ys.y += lo.y; ys.z += hi.x; ys.w += hi.y;
                }
                { const u32x2 sw = *((const u32x2*)(p.YS + (size_t)m * 1024) + lane + 64 * j);
                  ys.x += 16.f * __uint_as_float(sw.x << 16); ys.y += 16.f * __uint_as_float(sw.x & 0xffff0000u); ys.z += 16.f * __uint_as_float(sw.y << 16); ys.w += 16.f * __uint_as_float(sw.y & 0xffff0000u); }
                const f32x4 g2v = *(const f32x4*)(p.mod + (layer - 1) * 6144 + 5 * 1024 + 256 * j + 4 * lane) * (1.f / 16.f);
                v[j] = v[j] + g2v * ys;
                ((f32x4*)(p.out + (size_t)m * D_) + lane)[64 * j] = v[j];
            }
            s += (v[j].x * v[j].x + v[j].y * v[j].y) + (v[j].z * v[j].z + v[j].w * v[j].w);
        }
        s = wsum(s);
        const float rstd = rsqrtf(s * (1.f / D_) + EPSF);
        u32x2* o8 = (u32x2*)(p.XN + (size_t)m * D_) + lane;
#pragma unroll
        for (int j = 0; j < 4; ++j) {
            const int c0 = 256 * j + 4 * lane;
            const f32x4 g = *(const f32x4*)(gw_ + c0);
            const f32x4 sc = *(const LAS f32x4*)(msc + c0), sh = *(const LAS f32x4*)(msh + c0);
            const f32x4 y = v[j] * rstd * g * (sc + 1.f) + sh;
            u32x2 w; w.x = cvtpk(y.x, y.y); w.y = cvtpk(y.z, y.w);
            o8[64 * j] = w;
        }
    }
}

struct EpiResid {
    static constexpr bool PERM = true;
    const float* xin; float* out; const float* gate;
    __device__ __forceinline__ void operator()(const f32x4 (&acc)[2][2][4][2], const pg::Unit& u, int wid, int wr, int wc, int fr_, int fq_) const {
        int fr = fr_, fq = fq_; asm volatile("" : "+v"(fr), "+v"(fq));
        const int col0 = u.pn * 256 + wc * 32 + 8 * fq;
        f32x4 g[2][2];
#pragma unroll
        for (int bj = 0; bj < 2; ++bj)
#pragma unroll
            for (int n = 0; n < 2; ++n) g[bj][n] = *(const f32x4*)(gate + col0 + bj * 128 + n * 4);
#pragma unroll
        for (int ai = 0; ai < 2; ++ai)
#pragma unroll
            for (int m = 0; m < 4; ++m) {
                const size_t off = (size_t)(u.pm * 256 + ai * 128 + wr * 64 + m * 16 + fr) * 1024 + col0;
#pragma unroll
                for (int bj = 0; bj < 2; ++bj)
#pragma unroll
                    for (int n = 0; n < 2; ++n) {
                        const f32x4 xv = *(const f32x4*)(xin + off + bj * 128 + n * 4);
                        *(f32x4*)(out + off + bj * 128 + n * 4) = xv + g[bj][n] * acc[ai][bj][m][n];
                    }
                asm volatile("" ::: "memory");
            }
    }
};

struct EpiHeads {
    static constexpr bool PERM = false;
    const BlkDesc* tab; const float* cosT; const float* sinT; float* GATES; float* LOGF; LAS float* X;
    __device__ __forceinline__ void operator()(const f32x4 (&acc)[2][2][4][2], const pg::Unit& u, int wid, int wr, int wc, int fr_, int fq_) const {
        int fr = fr_, fq = fq_; asm volatile("" : "+v"(fr), "+v"(fq));
        const int w1 = wc & 1;
#pragma unroll
        for (int ai = 0; ai < 2; ++ai)
#pragma unroll
            for (int bj = 0; bj < 2; ++bj)
#pragma unroll
                for (int m = 0; m < 4; ++m) {
                    const f32x4 a = acc[ai][bj][m][0], b = acc[ai][bj][m][1];
                    float s = (a.x * a.x + a.y * a.y) + (a.z * a.z + a.w * a.w) + (b.x * b.x + b.y * b.y) + (b.z * b.z + b.w * b.w);
                    s += __shfl_xor(s, 16); s += __shfl_xor(s, 32);
                    if (fq == 0) X[wid * 256 + ((ai * 2 + bj) * 4 + m) * 16 + fr] = s;
                }
        asm volatile("s_waitcnt lgkmcnt(0)" ::: "memory"); __builtin_amdgcn_s_barrier(); asm volatile("" ::: "memory");
#pragma unroll
        for (int bj = 0; bj < 2; ++bj) {
            const BlkDesc d = tab[8 * u.pn + 4 * bj + wc];
            const int row0 = u.pm * 256 + wr * 64 + fr;
            if (d.flags & 4) continue;
            if (d.flags & 2) {
                if (w1 == 0) {
#pragma unroll
                    for (int ai = 0; ai < 2; ++ai)
#pragma unroll
                        for (int m = 0; m < 4; ++m) {
                            const int row = row0 + ai * 128 + m * 16;
#pragma unroll
                            for (int n = 0; n < 2; ++n) {
                                const f32x4 v = acc[ai][bj][m][n];
                                const int pc = 16 * n + 4 * fq;
                                if (pc < 24) *(f32x4*)(GATES + (size_t)row * 24 + pc) = v;
                                else *(f32x4*)(LOGF + (size_t)row * 8 + (pc - 24)) = v;
                            }
                            asm volatile("" ::: "memory");
                        }
                }
                continue;
            }
            const bool half = (d.flags & 8) != 0, has_gain = d.gain != nullptr, rope = (d.flags & 1) != 0;
            const int d0 = half ? 4 * fq : 16 * w1 + 4 * fq;
            const int dn1 = half ? 16 : 32;
            const float invn = half ? (1.f / 32.f) : (1.f / 64.f);
            const GAS float* gp = (const GAS float*)(has_gain ? d.gain : cosT);
            f32x4 g0 = *(const GAS f32x4*)(gp + d0), g1 = *(const GAS f32x4*)(gp + dn1 + d0);
            if (!has_gain) { g0 = (f32x4){1.f, 1.f, 1.f, 1.f}; g1 = g0; }
            g0 = g0 * d.scale; g1 = g1 * d.scale;
            const int cso = d.csoff + d0;
#pragma unroll
            for (int ai = 0; ai < 2; ++ai)
#pragma unroll
                for (int m = 0; m < 4; ++m) {
                    const int row = row0 + ai * 128 + m * 16;
                    const int xi = ((ai * 2 + bj) * 4 + m) * 16 + fr;
                    float ssq = X[wid * 256 + xi]; const float ssp = X[(wid ^ 1) * 256 + xi];
                    if (!half) ssq += ssp;
                    const float rs = has_gain ? rsqrtf(ssq * invn + EPSF) : 1.f;
                    f32x4 x1 = acc[ai][bj][m][0] * rs * g0, x2 = acc[ai][bj][m][1] * rs * g1;
                    f32x4 c = *(const f32x4*)(cosT + (size_t)row * 48 + cso), sn = *(const f32x4*)(sinT + (size_t)row * 48 + cso);
                    if (!rope) { c = (f32x4){1.f, 1.f, 1.f, 1.f}; sn = (f32x4){0.f, 0.f, 0.f, 0.f}; }
                    const f32x4 o1 = x1 * c - x2 * sn, o2 = x2 * c + x1 * sn;
                    u32x2 wa, wb; wa.x = cvtpk(o1.x, o1.y); wa.y = cvtpk(o1.z, o1.w); wb.x = cvtpk(o2.x, o2.y); wb.y = cvtpk(o2.z, o2.w);
                    if (d.flags & 32) {
                        GAS bf16_t* tb = (GAS bf16_t*)d.dst + (size_t)(row >> 6) * 6144 + (row & 63) * 8 + (d0 & 7);
                        *(GAS u32x2*)(tb + (d0 >> 3) * 512) = wa; *(GAS u32x2*)(tb + ((dn1 + d0) >> 3) * 512) = wb;
                    } else if (d.flags & 64) {
                        GAS bf16_t* tb = (GAS bf16_t*)d.dst + (size_t)(row >> 6) * 4096 + ((row >> 4) & 3) * 512 + (row & 15) * 32 + (d0 & 7);
                        *(GAS u32x2*)(tb + (d0 >> 5) * 2048 + ((d0 >> 3) & 3) * 8) = wa; *(GAS u32x2*)(tb + ((dn1 + d0) >> 5) * 2048 + (((dn1 + d0) >> 3) & 3) * 8) = wb;
                    } else {
                        GAS bf16_t* dr = (GAS bf16_t*)d.dst + (size_t)row * d.pitch + d0;
                        *(GAS u32x2*)dr = wa; *(GAS u32x2*)(dr + dn1) = wb;
                    }
                    asm volatile("" ::: "memory");
                }
        }
    }
};

struct EpiPlain {
    static constexpr bool PERM = true;
    bf16_t* O; int ldc;
    __device__ __forceinline__ void operator()(const f32x4 (&acc)[2][2][4][2], const pg::Unit& u, int wid, int wr, int wc, int fr_, int fq_) const {
        int fr = fr_, fq = fq_; asm volatile("" : "+v"(fr), "+v"(fq));
        const int col0 = u.pn * 256 + wc * 32 + 8 * fq;
#pragma unroll
        for (int ai = 0; ai < 2; ++ai)
#pragma unroll
            for (int m = 0; m < 4; ++m) {
                bf16_t* rp = O + (size_t)(u.pm * 256 + ai * 128 + wr * 64 + m * 16 + fr) * ldc + col0;
#pragma unroll
                for (int bj = 0; bj < 2; ++bj) { const f32x4 a = acc[ai][bj][m][0], b = acc[ai][bj][m][1];
                    u32x4 w; w.x = cvtpk(a.x, a.y); w.y = cvtpk(a.z, a.w); w.z = cvtpk(b.x, b.y); w.w = cvtpk(b.z, b.w); *(u32x4*)(rp + bj * 128) = w; }
            }
    }
};

__device__ __forceinline__ void phase_post1a(const MKP& p) {
    int tid_ = threadIdx.x; asm volatile("" : "+v"(tid_));
    const int tid = tid_, lane = tid & 63, wave = tid >> 6;
    const int gwv = blockIdx.x * 8 + wave, NGW = gridDim.x * 8;
    for (int t = gwv; t < S_; t += NGW) {
        const u32x2* row = (const u32x2*)(p.P1 + (size_t)t * 768);
        f32x4 v[3]; float sq = 0.f, skv = 0.f, skr = 0.f;
#pragma unroll
        for (int j = 0; j < 3; ++j) {
            const int g = lane + 64 * j;
            f32x4 x = (f32x4){0.f, 0.f, 0.f, 0.f};
            if (g < 168) { const u32x2 w = row[g]; x.x = __uint_as_float(w.x << 16); x.y = __uint_as_float(w.x & 0xffff0000u); x.z = __uint_as_float(w.y << 16); x.w = __uint_as_float(w.y & 0xffff0000u); }
            v[j] = x;
            const float s = (x.x * x.x + x.y * x.y) + (x.z * x.z + x.w * x.w);
            if (g < 96) sq += s; else if (g < 160) skv += s; else skr += s;
        }
        sq = wsum(sq); skv = wsum(skv); skr = wsum(skr);
        const float rq = rsqrtf(sq * (1.f / 384.f) + EPSF), rkv = rsqrtf(skv * (1.f / 256.f) + EPSF), rkr = rsqrtf(skr * (1.f / 32.f) + EPSF);
#pragma unroll
        for (int j = 0; j < 3; ++j) {
            const int g = lane + 64 * j;
            if (g < 96) { const f32x4 y = v[j] * rq; u32x2 w; w.x = cvtpk(y.x, y.y); w.y = cvtpk(y.z, y.w); *(u32x2*)(p.CQN + (size_t)t * 384 + 4 * g) = w; }
            else if (g < 160) { const f32x4 y = v[j] * rkv; u32x2 w; w.x = cvtpk(y.x, y.y); w.y = cvtpk(y.z, y.w); *(u32x2*)(p.CKVN + (size_t)t * 256 + 4 * (g - 96)) = w; }
        }
        {
            const int dl = (lane - 32) & 7;
            const int dd = 4 * dl;
            const int fi = 4 * (dl & 3);
            f32x4 x = v[2] * rkr;
            const f32x4 gn = *(const f32x4*)(p.in[24] + (dd & 31));
            x = x * gn;
            f32x4 o; o.x = __shfl_xor(x.x, 4); o.y = __shfl_xor(x.y, 4); o.z = __shfl_xor(x.z, 4); o.w = __shfl_xor(x.w, 4);
            const f32x4 c = *(const f32x4*)(p.cosT + (size_t)t * 48 + 32 + fi), sn = *(const f32x4*)(p.sinT + (size_t)t * 48 + 32 + fi);
            const f32x4 y = (dl < 4) ? (x * c - o * sn) : (x * c + o * sn);
            if (lane >= 32 && lane < 40) {
                u32x2 w; w.x = cvtpk(y.x, y.y); w.y = cvtpk(y.z, y.w);
#pragma unroll
                for (int h = 0; h < 16; ++h) *(u32x2*)(p.K96 + (size_t)h * S_ * 96 + (size_t)(t >> 6) * 6144 + (8 + (dd >> 3)) * 512 + (t & 63) * 8 + (dd & 7)) = w;
            }
        }
    }
}

__device__ __forceinline__ void mla_unit(const MKP& p, char* shm, int h, int qb) {
    int tid_ = threadIdx.x; asm volatile("" : "+v"(tid_));
    const int tid = tid_, lane = tid & 63, r32 = lane & 31; const int wid = __builtin_amdgcn_readfirstlane(tid >> 6);
    const int q0 = qb * 256;
    att::UnitArgs A;
    A.qrow = p.Q96 + ((size_t)h * S_ + q0 + 32 * wid + r32) * 96;
    A.K = p.K96 + (size_t)h * S_ * 96; A.kvpitch = 96; A.V = p.V1 + (size_t)h * S_ * 64; A.vpitch = 64;
    A.obase = p.OATT + (size_t)q0 * 1024 + h * 64; A.opitch = 1024;
    A.qtok = 32 * wid + r32; A.abase = 4 * qb; A.nsteps = 4 * qb + 4; A.bias = nullptr;
    att::attn_unit<att::MODE_CAUSAL, false, 8, 96, true>(A, shm);
}
__device__ __forceinline__ void phase_mla(const MKP& p, char* shm) {
    const int G = gridDim.x, bx = blockIdx.x;
    const int vcu = (G % 8 == 0) ? (bx % 8) * (G / 8) + bx / 8 : bx;
    for (int u = vcu; u < 256; u += G) {
        const int h = u >> 4, s = u & 15;
#pragma unroll 1
        for (int rep = 0; rep < 4; ++rep) mla_unit(p, shm, h, rep == 0 ? s : rep == 1 ? 31 - s : rep == 2 ? 32 + s : 63 - s);
    }
}

__device__ __forceinline__ void phase_scan(const MKP& p, LAS unsigned char* lds) {
    constexpr int NSB = 64;
    if (blockIdx.x >= NSB) {
        int tid_ = threadIdx.x; asm volatile("" : "+v"(tid_));
        const int lane = tid_ & 63, wave = tid_ >> 6;
        const int sb = blockIdx.x - NSB, NSBK = gridDim.x - NSB;
        LAS float* scr = (LAS float*)(lds + 65536 + wave * 256);
        for (int bj = sb; bj < 64; bj += NSBK) nsa::compress_job(p, scr, (LAS float*)(lds + (wave >> 2) * 32768) + (wave & 3) * 2048, 2 * bj + (wave >> 2), wave & 3, lane);
        for (int j = ((sb + NSBK - 64) % NSBK) * 8 + wave; j < 512; j += NSBK * 8) nsa::slcfrag_job(p, j, lane);
        return;
    }
    const int h = blockIdx.x >> 3, seg = blockIdx.x & 7, tid = threadIdx.x;
    LAS double* part = (LAS double*)lds;
    const float fb = p.in[8][h];
    double own[4], s = 0.0, pre = 0.0;
#pragma unroll
    for (int i = 0; i < 4; ++i) { own[i] = (double)logsigmf(p.LOGF[(size_t)(seg * 2048 + tid * 4 + i) * 8 + h] + fb); s += own[i]; }
    for (int i = tid; i < seg * 2048; i += MK_THREADS) pre += (double)logsigmf(p.LOGF[(size_t)i * 8 + h] + fb);
    part[tid] = s; part[512 + tid] = pre;
    __syncthreads();
    for (int o = 1; o < MK_THREADS; o <<= 1) {
        const double v = (tid >= o) ? part[tid - o] : 0.0, w = (tid >= o) ? part[512 + tid - o] : 0.0;
        __syncthreads();
        part[tid] += v; part[512 + tid] += w;
        __syncthreads();
    }
    double a = part[512 + MK_THREADS - 1] + ((tid > 0) ? part[tid - 1] : 0.0);
#pragma unroll
    for (int i = 0; i < 4; ++i) { a += own[i]; p.CUMB[(size_t)h * S_ + seg * 2048 + tid * 4 + i] = (float)(a * 1.4426950408889634); }
}

__device__ __forceinline__ void fox_unit(const MKP& p, char* shm, int h, int qb) {
    int tid_ = threadIdx.x; asm volatile("" : "+v"(tid_));
    const int tid = tid_, lane = tid & 63, r32 = lane & 31; const int wid = __builtin_amdgcn_readfirstlane(tid >> 6);
    const int q0 = qb * 256, abase = 4 * qb;
    const float* cb = p.CUMB + (size_t)h * S_;
    LAS float* bias = (LAS float*)(LAS unsigned char*)(shm + att::LDS_BIAS);
    LAS int* cnt = (LAS int*)(LAS unsigned char*)(shm + att::Geo<64>::LDS_WS);
    float gq = 0.f, gk = 0.f;
    for (int i = 0; i < 64; ++i) { gq = fmaxf(gq, fabsf(p.in[13][i])); gk = fmaxf(gk, fabsf(p.in[14][i])); }
    const float TH = 150.f + 2.f * (64.f * gq * gk * C2Q * 1.05f);
    const float c0 = cb[q0], cref = cb[q0 + 255];
    const bool skip = (tid < abase) && (cb[64 * tid + 63] - c0 > TH);
    const unsigned long long bal = __ballot(skip);
    if (lane == 0) cnt[wid] = __popcll(bal);
    __syncthreads();
    int alo = 0;
#pragma unroll
    for (int w = 0; w < 8; ++w) alo += cnt[w];
    int NT = abase + 4 - alo;
    if (NT & 1) { alo -= 1; NT += 1; }
    for (int i = tid; i < NT * 64; i += MK_THREADS) bias[i] = cref - cb[64 * alo + i];
    __syncthreads();
    att::UnitArgs A;
    A.qrow = p.FQ + (size_t)(q0 + 32 * wid + r32) * 512 + h * 64;
    A.K = p.FK + h * 64; A.V = p.FV + h * 64; A.kvpitch = 512; A.vpitch = 512;
    A.obase = p.OATT + (size_t)q0 * 1024 + 512 + h * 64; A.opitch = 1024;
    A.qtok = 32 * wid + r32; A.abase = abase; A.nsteps = NT; A.bias = bias;
    att::attn_unit<att::MODE_FOX, false, 8, 64>(A, shm);
}
__device__ __forceinline__ void phase_fox(const MKP& p, char* shm, int part = 3) {
    const int G = gridDim.x, bx = blockIdx.x;
    const int vcu = (G % 8 == 0) ? (bx % 8) * (G / 8) + bx / 8 : bx;
    if (part & 1) for (int u = vcu; u < 256; u += G) {
        const int h = u >> 5, s = u & 31;
#pragma unroll 1
        for (int rep = 0; rep < 2; ++rep) fox_unit(p, shm, h, rep ? 63 - s : s);
    }
    if (part & 2) for (int u = vcu; u < 256; u += G) {
#pragma unroll 1
        for (int rep = 0; rep < 2; ++rep) nsa::nsa_unit(p, shm, rep, rep ? 255 - u : u);
    }
}


struct MapOff { int off; __device__ __forceinline__ int operator()(int nn) const { return off + (nn & 31); } };
__device__ __forceinline__ void phase_moe_weights(const MKP& p, LAS unsigned char* lds, int layer) {
    int tid_ = threadIdx.x; asm volatile("" : "+v"(tid_));
    const int tid = tid_, lane = tid & 63, wave = tid >> 6;
    const int gw = blockIdx.x * 8 + wave, NGW = gridDim.x * 8;
    LAS float* scr = (LAS float*)(lds + wave * 16384);
    constexpr int IG = 16 * 16, ID = 4 * 32, IE = IG + ID;
    for (int it = gw; it < 65 * IE; it += NGW) {
        const int e = it / IE; int r = it % IE;
        if (r < IG) {
            const int kb = r / 16, nb = r % 16;
            const int n0 = nb * 32, up = (n0 >> 7) & 1, f0 = (n0 >> 8) * 128 + (n0 & 127);
            const float* W = (e < 64) ? ((up ? p.in[29] : p.in[28]) + ((size_t)layer * 64 + e) * 1024 * 256) : ((up ? p.in[32] : p.in[31]) + (size_t)layer * 1024 * 256);
            MapOff mo{f0};
            tr_item(W, 256, 1024, p.Wgu + (size_t)e * 512 * 1024, scr, kb, nb, lane, mo, nullptr);
        } else {
            r -= IG; const int kb = r / 32, nb = r % 32;
            const float* W = (e < 64) ? (p.in[30] + ((size_t)layer * 64 + e) * 256 * 1024) : (p.in[33] + (size_t)layer * 256 * 1024);
            tr_item(W, 1024, 256, p.Wd + (size_t)e * 1024 * 256, scr, kb, nb, lane, MapId(), nullptr);
        }
    }
}

template <bool DRY>
__device__ __forceinline__ void phase_moe_route(const MKP& p, LAS unsigned char* lds, int layer) {
    int tid_ = threadIdx.x; asm volatile("" : "+v"(tid_));
    const int tid = tid_, lane = tid & 63, wave = tid >> 6;
    LAS float* msc = (LAS float*)(lds + LDS_MOD);
    LAS float* msh = msc + 1024;
    LAS float* hrow = (LAS float*)lds;
    LAS int* cntl = (LAS int*)(lds + LDS_X);
    LAS int* basel = cntl + 64;
    const float* gnorm = p.in[4] + layer * 1024;
    const float* wr = p.in[26] + (size_t)layer * 1024 * 64;
    const float rb = p.in[27][layer * 64 + lane];
    for (int i = tid; i < 2048; i += MK_THREADS) msc[i] = p.mod[layer * 6144 + ((i < 1024) ? 4 * 1024 + i : 3 * 1024 + (i - 1024))];
    __syncthreads();
    for (int batch = blockIdx.x; batch < S_ / 32; batch += gridDim.x) {
        if (tid < 64) cntl[tid] = 0;
#pragma unroll 1
        for (int i = 0; i < 4; ++i) {
            const int t = batch * 32 + wave * 4 + i;
            const f32x4* xr = (const f32x4*)(p.out + (size_t)t * D_) + lane;
            f32x4 v[4]; float s = 0.f;
#pragma unroll
            for (int j = 0; j < 4; ++j) { v[j] = xr[64 * j]; s += (v[j].x * v[j].x + v[j].y * v[j].y) + (v[j].z * v[j].z + v[j].w * v[j].w); }
            s = wsum(s);
            const float rstd = rsqrtf(s * (1.f / D_) + EPSF);
            u32x2* o8 = (u32x2*)(p.XN + (size_t)t * D_) + lane;
            LAS f32x4* hr = (LAS f32x4*)(hrow + (wave * 4 + i) * 1024) + lane;
#pragma unroll
            for (int j = 0; j < 4; ++j) {
                const int c0 = 256 * j + 4 * lane;
                const f32x4 g = *(const f32x4*)(gnorm + c0);
                const f32x4 sc = *(const LAS f32x4*)(msc + c0), sh = *(const LAS f32x4*)(msh + c0);
                const f32x4 y = v[j] * rstd * g * (sc + 1.f) + sh;
                u32x2 w; w.x = cvtpk(y.x, y.y); w.y = cvtpk(y.z, y.w);
                o8[64 * j] = w; hr[64 * j] = y;
            }
        }
        __syncthreads();
        float acc0 = 0.f, acc1 = 0.f, acc2 = 0.f, acc3 = 0.f;
        const LAS float* h0 = hrow + (wave * 4) * 1024;
#pragma unroll 4
        for (int k = 0; k < 1024; k += 4) {
            const float w0 = wr[(k + 0) * 64 + lane], w1 = wr[(k + 1) * 64 + lane], w2 = wr[(k + 2) * 64 + lane], w3 = wr[(k + 3) * 64 + lane];
            const f32x4 a = *(const LAS f32x4*)(h0 + k), b = *(const LAS f32x4*)(h0 + 1024 + k), c = *(const LAS f32x4*)(h0 + 2048 + k), d = *(const LAS f32x4*)(h0 + 3072 + k);
            acc0 += a.x * w0; acc0 += a.y * w1; acc0 += a.z * w2; acc0 += a.w * w3;
            acc1 += b.x * w0; acc1 += b.y * w1; acc1 += b.z * w2; acc1 += b.w * w3;
            acc2 += c.x * w0; acc2 += c.y * w1; acc2 += c.z * w2; acc2 += c.w * w3;
            acc3 += d.x * w0; acc3 += d.y * w1; acc3 += d.z * w2; acc3 += d.w * w3;
        }
        int myrank[4], mypos[4]; float myw[4];
#pragma unroll
        for (int i = 0; i < 4; ++i) {
            const float logit = (i == 0) ? acc0 : (i == 1) ? acc1 : (i == 2) ? acc2 : acc3;
            const float score = 1.f / (1.f + expf(-logit));
            const float sv = score + rb;
            float m1 = sv;
            m1 = fmaxf(m1, __shfl_xor(m1, 1)); m1 = fmaxf(m1, __shfl_xor(m1, 2)); m1 = fmaxf(m1, __shfl_xor(m1, 4));
            int am = (sv == m1) ? (lane & 7) : 8;
            am = min(am, __shfl_xor(am, 1)); am = min(am, __shfl_xor(am, 2)); am = min(am, __shfl_xor(am, 4));
            float m2 = ((lane & 7) == am) ? -INFINITY : sv;
            m2 = fmaxf(m2, __shfl_xor(m2, 1)); m2 = fmaxf(m2, __shfl_xor(m2, 2)); m2 = fmaxf(m2, __shfl_xor(m2, 4));
            const float gs = m1 + m2;
            const int gi = lane >> 3; int grank = 0;
#pragma unroll
            for (int gj = 0; gj < 8; ++gj) { const float o = __shfl(gs, gj * 8); grank += (o > gs || (o == gs && gj < gi)) ? 1 : 0; }
            const float msk = (grank < 4) ? sv : -1e30f;
            int rank = 0;
#pragma unroll 8
            for (int e = 0; e < 64; ++e) { const float o = __shfl(msk, e); rank += (o > msk || (o == msk && e < lane)) ? 1 : 0; }
            const bool selb = rank < 8;
            const float tot = wsum(selb ? score : 0.f);
            myrank[i] = selb ? rank : -1; myw[i] = score / tot * 2.5f;
            mypos[i] = (selb && !DRY) ? atomicAdd((int*)(cntl + lane), 1) : 0;
        }
        __syncthreads();
        if (tid < 64) basel[tid] = (cntl[tid] > 0 && !DRY) ? atomicAdd(p.gcnt + layer * 64 + tid, cntl[tid]) : 0;
        __syncthreads();
#pragma unroll
        for (int i = 0; i < 4; ++i) if (myrank[i] >= 0 && !DRY) {
            const int t = batch * 32 + wave * 4 + i, slot = t * 8 + myrank[i];
            p.list[(size_t)lane * 16384 + basel[lane] + mypos[i]] = slot;
            p.ew[slot] = myw[i];
        }
        __syncthreads();
    }
}

struct MoeSched {
    const char* A; const char* Bt; const int* list; const LAS int* ustart; const LAS int* hbase; const LAS int* cnt;
    int K, NP, G, c; bool gather; int nexp;
    __device__ __forceinline__ static void tables(LAS int* ustart, LAS int* hbase, LAS int* cnt, const int* gcnt, int NP) {
        const int tid = threadIdx.x;
        if (tid == 0) {
            int us = 0, hb = 0;
            for (int e = 0; e < 65; ++e) { const int c = (e < 64) ? gcnt[e] : S_; const int nrb = (c + 255) >> 8; cnt[e] = c; ustart[e] = us; hbase[e] = hb; us += nrb * NP; hb += nrb * 256; }
            ustart[65] = us; hbase[65] = hb;
        }
        __syncthreads();
    }
    __device__ __forceinline__ bool next(int i, pg::Unit& u, int R0, int C0) const {
        const int L = i * G + c; if (L >= ustart[nexp]) return false;
        const int lane = threadIdx.x & 63;
        const unsigned long long bal = __ballot(lane < 65 && ustart[lane] <= L);
        int e = __popcll(bal) - 1; if (ustart[64] <= L) e = 64;
        const int r = L - ustart[e], rb = r / NP, pn = r % NP;
        u.pm = (hbase[e] >> 8) + rb; u.pn = pn; u.aux = e | (rb << 8);
        u.B = Bt + ((size_t)e * NP + pn) * 256 * K * 2;
        if (gather) {
            u.A = A; const int ce = cnt[e];
#pragma unroll
            for (int q = 0; q < 4; ++q) { const int pos = rb * 256 + R0 + 64 * q; int tok = 0; if (pos < ce) tok = (e < 64) ? (list[(size_t)e * 16384 + pos] >> 3) : pos; u.ra[q] = (unsigned)(tok * K + C0) * 2u; }
        } else {
            u.A = A + (size_t)u.pm * 256 * K * 2;
#pragma unroll
            for (int q = 0; q < 4; ++q) u.ra[q] = (unsigned)((R0 + 64 * q) * K + C0) * 2u;
        }
        return true;
    }
};
struct EpiGateUp {
    static constexpr bool PERM = true;
    bf16_t* HID;
    __device__ __forceinline__ void operator()(const f32x4 (&acc)[2][2][4][2], const pg::Unit& u, int wid, int wr, int wc, int fr_, int fq_) const {
        int fr = fr_, fq = fq_; asm volatile("" : "+v"(fr), "+v"(fq));
        const int col0 = u.pn * 128 + wc * 32 + 8 * fq;
#pragma unroll
        for (int ai = 0; ai < 2; ++ai)
#pragma unroll
            for (int m = 0; m < 4; ++m) {
                bf16_t* rp = HID + (size_t)(u.pm * 256 + ai * 128 + wr * 64 + m * 16 + fr) * 256 + col0;
                float h[8];
#pragma unroll
                for (int n = 0; n < 2; ++n) {
                    const f32x4 g = acc[ai][0][m][n], up = acc[ai][1][m][n];
                    h[4 * n] = g.x / (1.f + __expf(-g.x)) * up.x; h[4 * n + 1] = g.y / (1.f + __expf(-g.y)) * up.y; h[4 * n + 2] = g.z / (1.f + __expf(-g.z)) * up.z; h[4 * n + 3] = g.w / (1.f + __expf(-g.w)) * up.w;
                }
                u32x4 w; w.x = cvtpk(h[0], h[1]); w.y = cvtpk(h[2], h[3]); w.z = cvtpk(h[4], h[5]); w.w = cvtpk(h[6], h[7]); *(u32x4*)rp = w;
            }
    }
};
struct EpiDown {
    static constexpr bool PERM = true;
    bf16_t* YBUF; const int* list; const float* ew; const LAS int* cnt;
    __device__ __forceinline__ void operator()(const f32x4 (&acc)[2][2][4][2], const pg::Unit& u, int wid, int wr, int wc, int fr_, int fq_) const {
        int fr = fr_, fq = fq_; asm volatile("" : "+v"(fr), "+v"(fq));
        const int e = u.aux & 0xff, rb = u.aux >> 8, ce = cnt[e];
        const unsigned colb = (unsigned)(u.pn * 256 + wc * 32 + 8 * fq);
        const int* le = list + (size_t)e * 16384 + rb * 256 + wr * 64 + fr;
        const int pos0 = rb * 256 + wr * 64 + fr;
        int slot[8]; float w[8];
#pragma unroll
        for (int i = 0; i < 8; ++i) { const int pr = (i >> 2) * 128 + (i & 3) * 16; slot[i] = (pos0 + pr < ce) ? le[pr] : -1; }
#pragma unroll
        for (int i = 0; i < 8; ++i) w[i] = (slot[i] >= 0) ? ew[slot[i]] : 0.f;
#pragma unroll
        for (int ai = 0; ai < 2; ++ai)
#pragma unroll
            for (int m = 0; m < 4; ++m) {
                const int i = ai * 4 + m;
                if (slot[i] >= 0) {
                    char* rp = (char*)YBUF + ((unsigned)slot[i] * 1024u + colb);
                    const float ws = w[i] * 16.f;
#pragma unroll
                    for (int bj = 0; bj < 2; ++bj) { const f32x4 a = acc[ai][bj][m][0] * ws, b = acc[ai][bj][m][1] * ws;
                        u32x2 o; o.x = nsa::pk4_fp8(a.x, a.y, a.z, a.w); o.y = nsa::pk4_fp8(b.x, b.y, b.z, b.w); *(u32x2*)(rp + bj * 128) = o; }
                }
            }
    }
};
__device__ __forceinline__ void phase_moe_gemm1(const MKP& p, LAS unsigned char* lds, int layer) {
    LAS int* tb = (LAS int*)(lds + LDS_X);
    MoeSched::tables(tb, tb + 66, tb + 132, p.gcnt + layer * 64, 2);
    const int G = gridDim.x, bx = blockIdx.x, vcu = (G % 8 == 0) ? (bx % 8) * (G / 8) + bx / 8 : bx;
    MoeSched S{(const char*)p.XN, (const char*)p.Wgu, p.list, tb, tb + 66, tb + 132, 1024, 2, G, vcu, true, 65};
    EpiGateUp E{p.HID};
    pg::gemm_run(lds, 1024, S, E);
}
__device__ __forceinline__ void phase_moe_gemm2(const MKP& p, LAS unsigned char* lds, int layer, int which = 3) {
    LAS int* tb = (LAS int*)(lds + LDS_X);
    MoeSched::tables(tb, tb + 66, tb + 132, p.gcnt + layer * 64, 4);
    const int G = gridDim.x, bx = blockIdx.x, vcu = (G % 8 == 0) ? (bx % 8) * (G / 8) + bx / 8 : bx;
    if (which & 1) { MoeSched S{(const char*)p.HID, (const char*)p.Wd, p.list, tb, tb + 66, tb + 132, 256, 4, G, vcu, false, 64};
      EpiDown E{p.YBUF, p.list, p.ew, tb + 132};
      pg::gemm_run(lds, 256, S, E); }
    if (which & 2) {
      pg::DenseSched S; S.init(p.HID + (size_t)tb[66 + 64] * 256, p.Wd + (size_t)64 * 1024 * 256, S_, 1024, 256, G, bx);
      EpiPlain E{p.YS, 1024};
      pg::gemm_run(lds, 256, S, E); }
}
__device__ __forceinline__ void phase_moe_combine(const MKP& p, int layer) {
    int tid_ = threadIdx.x; asm volatile("" : "+v"(tid_));
    const int tid = tid_, lane = tid & 63, wave = tid >> 6;
    const int gwv = blockIdx.x * 8 + wave, NGW = gridDim.x * 8;
    const float* g2 = p.mod + layer * 6144 + 5 * 1024;
    for (int t = gwv; t < S_; t += NGW) {
        f32x4* xr = (f32x4*)(p.out + (size_t)t * D_) + lane;
#pragma unroll
        for (int j = 0; j < 4; ++j) {
            f32x4 s = (f32x4){0.f, 0.f, 0.f, 0.f};
#pragma unroll
            for (int k = 0; k < 8; ++k) {
                const int w = *((const int*)((const char*)p.YBUF + ((size_t)t * 8 + k) * 1024) + lane + 64 * j);
                const f32x2 lo = __builtin_amdgcn_cvt_pk_f32_fp8(w, false), hi = __builtin_amdgcn_cvt_pk_f32_fp8(w, true);
                s.x += lo.x; s.y += lo.y; s.z += hi.x; s.w += hi.y;
            }
            { const u32x2 sw = *((const u32x2*)(p.YS + (size_t)t * 1024) + lane + 64 * j);
              s.x += 16.f * __uint_as_float(sw.x << 16); s.y += 16.f * __uint_as_float(sw.x & 0xffff0000u); s.z += 16.f * __uint_as_float(sw.y << 16); s.w += 16.f * __uint_as_float(sw.y & 0xffff0000u); }
            const f32x4 g = *(const f32x4*)(g2 + 256 * j + 4 * lane) * (1.f / 16.f);
            xr[64 * j] = xr[64 * j] + g * s;
        }
    }
}

#define XB_TMO      128
#define XB_XCNT(j)  (256  + 64 * (j))
#define XB_XSUB(j)  (1280 + 64 * (j))
#define XB_XGEN(j)  (2304 + 64 * (j))
#define XB_TOP      3328
#define XB_TOPGEN   3392
#define XCD_BAR_WORDS 3456
#define XB_SPIN_CAP (1u << 22)
__device__ __forceinline__ unsigned xb_ld(unsigned* p)              { return __hip_atomic_load(p, __ATOMIC_RELAXED, __HIP_MEMORY_SCOPE_AGENT); }
__device__ __forceinline__ unsigned xb_add(unsigned* p, unsigned v) { return __hip_atomic_fetch_add(p, v, __ATOMIC_RELAXED, __HIP_MEMORY_SCOPE_AGENT); }
__device__ __forceinline__ unsigned xb_xcc_id() { return (unsigned)__builtin_amdgcn_s_getreg((3 << 11) | 20) & 0xFu; }
#define XB_SPIN(cond, bar) do { unsigned _sp = 0; while (cond) { __builtin_amdgcn_s_sleep(1); \
    if ((++_sp & 255u) == 0u) { if (xb_ld(&(bar)[XB_TMO])) break; if (_sp > XB_SPIN_CAP) { atomicAdd(&(bar)[XB_TMO], 1u); break; } } } } while (0)
struct XcdBarrier { unsigned* bar; unsigned x; volatile LAS unsigned* st; };
__device__ __forceinline__ XcdBarrier xcd_barrier_post(unsigned* bar, volatile LAS unsigned* st) {
    XcdBarrier b; b.bar = bar; b.x = xb_xcc_id(); b.st = st;
    if (threadIdx.x == 0) (void)xb_add(&bar[XB_XCNT(b.x)], 1u);
    return b;
}
__device__ __forceinline__ void xcd_barrier_complete(unsigned* bar, unsigned x, unsigned& nloc, unsigned& nx) {
    const unsigned G = gridDim.x * gridDim.y * gridDim.z;
    unsigned sum, cnt, mine, sp = 0u;
    for (;;) {
        sum = 0u; cnt = 0u; mine = 0u;
#pragma unroll
        for (unsigned j = 0; j < 16; ++j) { const unsigned c = xb_ld(&bar[XB_XCNT(j)]); sum += c; cnt += (c > 0u) ? 1u : 0u; mine = (j == x) ? c : mine; }
        if (sum == G) break;
        __builtin_amdgcn_s_sleep(1);
        if ((++sp & 255u) == 0u) { if (xb_ld(&bar[XB_TMO])) break; if (sp > XB_SPIN_CAP) { atomicAdd(&bar[XB_TMO], 1u); break; } }
    }
    nloc = mine > 0u ? mine : 1u; nx = cnt > 0u ? cnt : 1u;
}
__device__ __forceinline__ void xcd_barrier(const XcdBarrier& b) {
    asm volatile("s_waitcnt vmcnt(0)" ::: "memory");
    __syncthreads();
    if (threadIdx.x == 0) {
        unsigned* bar = b.bar;
        __builtin_amdgcn_s_waitcnt(0);
        unsigned nloc = b.st[0], nx = b.st[1];
        if (nloc == 0u) { xcd_barrier_complete(bar, b.x, nloc, nx); b.st[0] = nloc; b.st[1] = nx; }
        const unsigned old = xb_add(&bar[XB_XSUB(b.x)], 1u);
        const unsigned gen = old / nloc;
        if (old + 1u == (gen + 1u) * nloc) {
            __builtin_amdgcn_fence(__ATOMIC_RELEASE, "agent");
            asm volatile("s_waitcnt vmcnt(0)" ::: "memory");
            const unsigned og = xb_add(&bar[XB_TOP], 1u);
            const unsigned tg = og / nx;
            if (og + 1u == (tg + 1u) * nx) xb_add(&bar[XB_TOPGEN], 1u);
            else XB_SPIN(xb_ld(&bar[XB_TOPGEN]) == tg, bar);
            __builtin_amdgcn_fence(__ATOMIC_ACQUIRE, "agent");
            xb_add(&bar[XB_XGEN(b.x)], 1u);
            asm volatile("s_waitcnt vmcnt(0)" ::: "memory");
        } else {
            XB_SPIN(xb_ld(&bar[XB_XGEN(b.x)]) == gen, bar);
            __builtin_amdgcn_fence(__ATOMIC_ACQUIRE, "agent");
            asm volatile("s_waitcnt vmcnt(0)" ::: "memory");
        }
    }
    __syncthreads();
}

__global__ void __launch_bounds__(MK_THREADS, 2) mega(MKP p) {
    extern __shared__ __attribute__((aligned(16))) unsigned char lds_raw[];
    LAS unsigned char* lds = (LAS unsigned char*)lds_raw;
    const int lo = p.ph_lo, hi = p.ph_hi;
    const bool multi = hi - lo > 1;
    volatile LAS unsigned* bst = (volatile LAS unsigned*)(lds + LDS_BARST);
    XcdBarrier bar; bar.bar = p.barw; bar.x = 0; bar.st = bst;
    if (multi) {
        if (threadIdx.x < 2) bst[threadIdx.x] = 0u;
        if (blockIdx.x == 0) for (int i = threadIdx.x; i < XCD_BAR_WORDS; i += MK_THREADS) p.barw[i] = 0u;
    }
    int nbar = 0;
#define IN(k) (lo <= (k) && (k) < hi)
#define SEAM(k) do { if (IN(k) && IN((k) + 1)) { if (nbar == 0) { __threadfence(); cooperative_groups::this_grid().sync(); __builtin_amdgcn_fence(__ATOMIC_ACQUIRE, "agent"); bar = xcd_barrier_post(p.barw, bst); } else xcd_barrier(bar); ++nbar; } } while (0)
    if (IN(0)) { phase_prologue(p, lds); phase_moe_weights(p, lds, 0); }
    SEAM(0);
    if (IN(1)) phase_norm<false>(p, lds, p.in[0], p.in[3], 0, 1, 0, true);
    SEAM(1);
    if (IN(2)) {
        pg::DenseSched S; S.init(p.XN, p.W_in0t, S_, 3072, 1024, gridDim.x, blockIdx.x);
        EpiHeads E{p.desc0, p.cosT, p.sinT, p.GATES, p.LOGF, (LAS float*)(lds + LDS_X)};
        pg::gemm_run(lds, 1024, S, E);
    }
    SEAM(2);
    if (IN(3)) phase_scan(p, lds);
    SEAM(3);
    if (IN(4)) phase_fox(p, (char*)lds_raw);
    SEAM(4);
    if (IN(5)) {
        pg::DenseSched S; S.init(p.OATT, p.W_out0t, S_, 1024, 1024, gridDim.x, blockIdx.x);
        EpiResid E{p.in[0], p.out, p.mod + 2 * 1024};
        pg::gemm_run(lds, 1024, S, E);
    }
    SEAM(5);
    if (IN(6)) phase_moe_route<false>(p, lds, 0);
    SEAM(6);
    if (IN(7)) phase_moe_gemm1(p, lds, 0);
    SEAM(7);
    if (IN(8)) phase_moe_gemm2(p, lds, 0);
    SEAM(8);
    if (IN(9)) { phase_norm<true>(p, lds, p.out, p.in[3] + 1024, 1, 1, 0, false); phase_moe_weights(p, lds, 1); }
    if (IN(9) && IN(11)) { xcd_barrier(bar); ++nbar; }
    if (IN(11)) {
        pg::DenseSched S; S.init(p.XN, p.W_in1t, S_, 768, 1024, gridDim.x, blockIdx.x);
        EpiPlain E{p.P1, 768};
        pg::gemm_run(lds, 1024, S, E);
    }
    SEAM(11);
    if (IN(12)) phase_post1a(p);
    SEAM(12);
    if (IN(13)) {
        { pg::DenseSched S; S.init(p.CQN, p.W_uqt, S_, 1536, 384, gridDim.x, blockIdx.x);
          EpiHeads E{p.desc_uq, p.cosT, p.sinT, nullptr, nullptr, (LAS float*)(lds + LDS_X)};
          pg::gemm_run(lds, 384, S, E); }
        { pg::DenseSched S; S.init(p.CKVN, p.W_ukvt, S_, 2048, 256, gridDim.x, blockIdx.x);
          EpiHeads E{p.desc_ukv, p.cosT, p.sinT, nullptr, nullptr, (LAS float*)(lds + LDS_X)};
          pg::gemm_run(lds, 256, S, E); }
    }
    SEAM(13);
    if (IN(14)) phase_mla(p, (char*)lds_raw);
    SEAM(14);
    if (IN(15)) {
        pg::DenseSched S; S.init(p.OATT, p.W_out1t, S_, 1024, 1024, gridDim.x, blockIdx.x);
        EpiResid E{p.out, p.out, p.mod + 6144 + 2 * 1024};
        pg::gemm_run(lds, 1024, S, E);
    }
    SEAM(15);
    if (IN(16)) phase_moe_route<false>(p, lds, 1);
    SEAM(16);
    if (IN(17)) phase_moe_gemm1(p, lds, 1);
    SEAM(17);
    if (IN(18)) phase_moe_gemm2(p, lds, 1);
    SEAM(18);
    if (IN(19)) phase_moe_combine(p, 1);
#undef IN
#undef SEAM
}
extern "C" void kernel_launch(void* const* d_in, const int* in_sizes, int n_in, void* d_out, int out_size, void* d_ws, size_t ws_size, hipStream_t stream) {
    static int grid = 0;
    if (!grid) {
        int dev = 0, cus = 0, per_cu = 0;
        (void)hipGetDevice(&dev); (void)hipDeviceGetAttribute(&cus, hipDeviceAttributeMultiprocessorCount, dev);
        (void)hipFuncSetAttribute((const void*)mega, hipFuncAttributeMaxDynamicSharedMemorySize, LDS_TOTAL);
        (void)hipOccupancyMaxActiveBlocksPerMultiprocessor(&per_cu, (const void*)mega, MK_THREADS, LDS_TOTAL);
        (void)hipGetLastError();
        grid = (cus > 0 && per_cu >= 1) ? cus : -1;
    }
    if (grid < 0) return;
    constexpr size_t MiB = 1u << 20;
    if (ws_size < 528 * MiB || n_in != 34) return;
    char* wsb = (char*)d_ws;
    float* ws = (float*)d_ws;
    size_t o = 0;
    MKP p{};
    for (int i = 0; i < 34; ++i) p.in[i] = (const float*)d_in[i];
    p.out = (float*)d_out; p.pos = (const int*)d_in[2];
    p.mod = ws + o; o += 2 * 6144;
    p.cosT = ws + o; o += (size_t)S_ * 48;
    p.sinT = ws + o; o += (size_t)S_ * 48;
    p.modpart = ws + o; o += 8 * 12288;
    p.desc0 = (BlkDesc*)(ws + o); o += 96 * 8;
    p.desc_uq = (BlkDesc*)(ws + o); o += 48 * 8;
    p.desc_ukv = (BlkDesc*)(ws + o); o += 64 * 8;
    p.CUMB = ws + o; o += (size_t)8 * S_;
    p.gcnt = (int*)(ws + o); o += 128;
    p.CBIAS = ws + o; o += 128;
    p.barw = (unsigned*)(ws + o); o += 4096;
    p.ew = ws + o; o += (size_t)S_ * 8;
    p.list = (int*)(ws + o); o += (size_t)64 * 16384;
    p.WcT = (bf16_t*)(ws + o); o += (size_t)2 * 64 * 2048 / 2;
    p.KCMP = (bf16_t*)(ws + o); o += (size_t)2 * 1024 * 64 / 2;
    p.VCT = (bf16_t*)(ws + o); o += (size_t)2 * 64 * 1024 / 2;
    if (o * 4 > 15 * MiB) return;
    p.XN = (bf16_t*)(wsb + 15 * MiB); p.OATT = (bf16_t*)(wsb + 47 * MiB);
    char* big = wsb + 79 * MiB;
    {   bf16_t* b = (bf16_t*)big;
        p.QN = b; b += (size_t)S_ * 512; p.KV6 = b; b += (size_t)12 * S_ * 64; p.FQ = b; b += (size_t)S_ * 512; p.FK = b; b += (size_t)S_ * 512; p.FV = b; b += (size_t)S_ * 512;
        p.GATES = (float*)b; p.LOGF = p.GATES + (size_t)S_ * 24; }
    p.KSLF = (bf16_t*)(big + 92 * MiB); p.VSLF = (bf16_t*)(big + 96 * MiB); p.OCMP = (bf16_t*)(big + 100 * MiB); p.OWIN = (bf16_t*)(big + 116 * MiB);
    {   bf16_t* b = (bf16_t*)(big + 96 * MiB);
        p.P1 = b; b += (size_t)S_ * 768; p.CQN = b; b += (size_t)S_ * 384; p.CKVN = b; b += (size_t)S_ * 256;
        p.Q96 = b; b += (size_t)16 * S_ * 96; p.K96 = b; b += (size_t)16 * S_ * 96; p.V1 = b; b += (size_t)16 * S_ * 64; }
    p.YBUF = (bf16_t*)big; p.YS = (bf16_t*)(big + 128 * MiB); p.HID = (bf16_t*)(big + 256 * MiB);
    p.Wgu = (bf16_t*)(wsb + 415 * MiB); p.Wd = p.Wgu + (size_t)65 * 512 * 1024;
    {   bf16_t* b = (bf16_t*)(wsb + 513 * MiB);
        p.W_in0t = b; b += (size_t)3072 * 1024; p.W_out0t = b; b += (size_t)1024 * 1024; p.W_in1t = b; b += (size_t)768 * 1024;
        p.W_uqt = b; b += (size_t)1536 * 384; p.W_ukvt = b; b += (size_t)2048 * 256; p.W_out1t = b; b += (size_t)1024 * 1024; }
    p.ph_lo = 0; p.ph_hi = 20;
    void* args[] = {&p};
    (void)hipLaunchCooperativeKernel((const void*)mega, dim3(grid), dim3(MK_THREADS), args, LDS_TOTAL, stream);
}
```

```cpp
#include <hip/hip_runtime.h>
#include <hip/hip_cooperative_groups.h>
#include <stdint.h>

#define S_ 16384
#define D_ 1024
#define HYIN 2848
#define NEXP 64
#define EPSF 1e-6f

__device__ __forceinline__ float wsum(float v) {
#pragma unroll
    for (int o = 32; o > 0; o >>= 1) v += __shfl_xor(v, o);
    return v;
}
__device__ __forceinline__ float sigmf(float x) { return 1.f / (1.f + expf(-x)); }
__device__ __forceinline__ float logsigmf(float x) { return fminf(x, 0.f) - log1pf(expf(-fabsf(x))); }
#define LAS __attribute__((address_space(3)))
#define GAS __attribute__((address_space(1)))
typedef unsigned short bf16_t;
typedef short bf16x8 __attribute__((ext_vector_type(8)));
typedef float f32x4 __attribute__((ext_vector_type(4)));
typedef float f32x2 __attribute__((ext_vector_type(2)));
typedef unsigned u32x4 __attribute__((ext_vector_type(4)));
typedef unsigned u32x2 __attribute__((ext_vector_type(2)));
typedef __bf16 bf16x2_t __attribute__((ext_vector_type(2)));

__device__ __forceinline__ unsigned cvtpk(float lo, float hi) { f32x2 v = {lo, hi}; bf16x2_t b = __builtin_convertvector(v, bf16x2_t); return __builtin_bit_cast(unsigned, b); }
__device__ __forceinline__ float bf2f(bf16_t v) { return __uint_as_float(((unsigned)v) << 16); }
__device__ __forceinline__ bf16_t f2bf(float f) { return (bf16_t)(cvtpk(f, 0.f) & 0xffffu); }

namespace pg {
constexpr int BM = 256, BK = 64, HALF = 128, HTB = HALF * BK * 2, STAGE_BYTES = 8 * HTB;
__device__ __forceinline__ int lds_byte(int r, int c) { const int st = (r >> 4) * 2 + (c >> 5), rr = r & 15, cc = c & 31, ob = rr * 64 + cc * 2; return st * 1024 + (ob ^ (((ob >> 9) & 1) << 5)); }
__device__ __forceinline__ int perm32(int rho) { const int n = rho >> 4, i = rho & 15; return 8 * (i >> 2) + 4 * n + (i & 3); }
__device__ __forceinline__ void stage_rc(int b, int& R, int& C) { const int st = b / 1024, sb = b % 1024, swz = sb ^ (((sb >> 9) & 1) << 5); R = (st >> 1) * 16 + swz / 64; C = (st & 1) * 32 + (swz % 64) / 2; }

struct Unit { int pm, pn, aux; const char* A; const char* B; unsigned ra[4]; };

template <class Epi, class Sched>
__device__ __forceinline__ void gemm_run(LAS unsigned char* lds, const int K, const Sched& S, const Epi& E) {
    int tid_ = threadIdx.x; asm volatile("" : "+v"(tid_));
    const int tid = tid_, wid = __builtin_amdgcn_readfirstlane(tid >> 6), lane = tid & 63, wr = wid >> 2, wc = wid & 3, fr = lane & 15, fq = lane >> 4;
    int nt_ = K / BK; asm volatile("" : "+s"(nt_)); const int nt = nt_;
    int R0, C0; stage_rc(tid * 16, R0, C0);
    unsigned voffB[2];
#pragma unroll
    for (int i = 0; i < 2; ++i) { const int Rb = Epi::PERM ? ((R0 & ~31) + perm32(R0 & 31)) : R0; voffB[i] = (unsigned)((Rb + 64 * i) * K + C0) * 2u; }
    const size_t kstep = (size_t)(BK * 2);
    const size_t hstep = (size_t)HALF * K * 2;
    const unsigned ldsw = (unsigned)wid * 1024u;
    const int aoff = lds_byte(wr * 64 + fr, fq * 8), boff = lds_byte(wc * 32 + fr, fq * 8);
#define PG_SA(b, h) (((b) * 2 + (h)) * HTB)
#define PG_SB(b, h) ((4 + (b) * 2 + (h)) * HTB)
#define PG_STAGE2(bufoff, gbase, v0, v1) do { \
        __builtin_amdgcn_global_load_lds((const unsigned*)((const char*)(gbase) + (v0)), (LAS unsigned*)(lds + (bufoff) + ldsw), 16, 0, 0); \
        __builtin_amdgcn_global_load_lds((const unsigned*)((const char*)(gbase) + (v1)), (LAS unsigned*)(lds + (bufoff) + ldsw + 8192), 16, 0, 0); } while (0)
#define PG_STAGEB(bufoff, gbase) PG_STAGE2(bufoff, gbase, voffB[0], voffB[1])
#define PG_LDA(dst, b, h) do { _Pragma("unroll") for (int m = 0; m < 4; ++m) _Pragma("unroll") for (int k = 0; k < 2; ++k) dst[m][k] = *(const LAS bf16x8*)(lds + PG_SA(b, h) + aoff + m * 2048 + k * 1024); } while (0)
#define PG_LDB(dst, b, h) do { _Pragma("unroll") for (int n = 0; n < 2; ++n) _Pragma("unroll") for (int k = 0; k < 2; ++k) dst[n][k] = *(const LAS bf16x8*)(lds + PG_SB(b, h) + boff + n * 2048 + k * 1024); } while (0)
#define PG_MMA(ai, bj, At, Bt) do { __builtin_amdgcn_s_setprio(1); _Pragma("unroll") for (int m = 0; m < 4; ++m) _Pragma("unroll") for (int n = 0; n < 2; ++n) _Pragma("unroll") for (int k = 0; k < 2; ++k) \
        acc[ai][bj][m][n] = __builtin_amdgcn_mfma_f32_16x16x32_bf16(Bt[n][k], At[m][k], acc[ai][bj][m][n], 0, 0, 0); __builtin_amdgcn_s_setprio(0); } while (0)
#define PG_WAIT_V(n) asm volatile("s_waitcnt vmcnt(" #n ")" ::: "memory")
#define PG_WAIT_L(n) asm volatile("s_waitcnt lgkmcnt(" #n ")" ::: "memory")
#define PG_BAR __builtin_amdgcn_s_barrier()
#define PG_SCHED __builtin_amdgcn_sched_barrier(0)
    Unit cur, nxt; int ui = 0;
    if (!S.next(0, cur, R0, C0)) return;
    f32x4 acc[2][2][4][2];
#pragma unroll
    for (int a = 0; a < 2; ++a)
#pragma unroll
        for (int b = 0; b < 2; ++b)
#pragma unroll
            for (int m = 0; m < 4; ++m)
#pragma unroll
                for (int n = 0; n < 2; ++n) acc[a][b][m][n] = (f32x4){0.f, 0.f, 0.f, 0.f};
    bf16x8 At[4][2], B0[2][2], B1[2][2];
    const char* cA = cur.A; const char* cB = cur.B;
    PG_STAGEB(PG_SB(0, 0), cB); PG_STAGEB(PG_SB(0, 1), cB + hstep); PG_STAGE2(PG_SA(0, 0), cA, cur.ra[0], cur.ra[1]); PG_STAGE2(PG_SA(0, 1), cA, cur.ra[2], cur.ra[3]);
    if (wr == 1) PG_BAR;
    PG_WAIT_V(2); PG_BAR;
    PG_STAGEB(PG_SB(1, 0), cB + kstep); PG_STAGE2(PG_SA(1, 0), cA + kstep, cur.ra[0], cur.ra[1]); PG_STAGEB(PG_SB(1, 1), cB + hstep + kstep);
    PG_WAIT_V(6); PG_BAR;
    for (;;) {
        const bool has_next = S.next(ui + 1, nxt, R0, C0);
        if (!has_next) nxt = cur;
        const char* nA = nxt.A; const char* nB = nxt.B;
#pragma unroll 1
        for (int t = 0; t < nt; t += 2) {
            const bool last = (t == nt - 2);
            const char* a1 = cA + (size_t)(t + 1) * kstep;
            const char* a2 = last ? nA : cA + (size_t)(t + 2) * kstep; const char* b2 = last ? nB : cB + (size_t)(t + 2) * kstep;
            const char* a3 = a2 + kstep; const char* b3 = b2 + kstep;
            const unsigned r0 = last ? nxt.ra[0] : cur.ra[0], r1 = last ? nxt.ra[1] : cur.ra[1], r2 = last ? nxt.ra[2] : cur.ra[2], r3 = last ? nxt.ra[3] : cur.ra[3];
            PG_LDB(B0, 0, 0); PG_LDB(B1, 0, 1); PG_SCHED; PG_LDA(At, 0, 0); PG_STAGE2(PG_SA(1, 1), a1, cur.ra[2], cur.ra[3]);
            PG_WAIT_V(8); PG_WAIT_L(0); PG_BAR; PG_MMA(0, 0, At, B0); PG_MMA(0, 1, At, B1); PG_BAR; PG_SCHED;
            PG_LDA(At, 0, 1); PG_STAGEB(PG_SB(0, 0), b2); PG_STAGEB(PG_SB(0, 1), b2 + hstep); PG_STAGE2(PG_SA(0, 0), a2, r0, r1);
            PG_WAIT_V(8); PG_WAIT_L(0); PG_BAR; PG_MMA(1, 0, At, B0); PG_MMA(1, 1, At, B1); PG_BAR; PG_SCHED;
            PG_LDB(B0, 1, 0); PG_LDB(B1, 1, 1); PG_SCHED; PG_LDA(At, 1, 0); PG_STAGE2(PG_SA(0, 1), a2, r2, r3);
            PG_WAIT_V(8); PG_WAIT_L(0); PG_BAR; PG_MMA(0, 0, At, B0); PG_MMA(0, 1, At, B1); PG_BAR; PG_SCHED;
            PG_LDA(At, 1, 1); PG_STAGEB(PG_SB(1, 0), b3); PG_STAGEB(PG_SB(1, 1), b3 + hstep); PG_STAGE2(PG_SA(1, 0), a3, r0, r1);
            PG_WAIT_V(8); PG_WAIT_L(0); PG_BAR; PG_MMA(1, 0, At, B0); PG_MMA(1, 1, At, B1); PG_BAR; PG_SCHED;
        }
        if (wr == 0) PG_BAR;
        E(acc, cur, wid, wr, wc, fr, fq);
        if (!has_next) break;
#pragma unroll
        for (int a = 0; a < 2; ++a)
#pragma unroll
            for (int b = 0; b < 2; ++b)
#pragma unroll
                for (int m = 0; m < 4; ++m)
#pragma unroll
                    for (int n = 0; n < 2; ++n) acc[a][b][m][n] = (f32x4){0.f, 0.f, 0.f, 0.f};
        cur = nxt; cA = nA; cB = nB; ++ui;
        if (wr == 1) PG_BAR;
    }
    PG_WAIT_V(0);
    PG_BAR;
#undef PG_SA
#undef PG_SB
#undef PG_STAGE2
#undef PG_STAGEB
#undef PG_LDA
#undef PG_LDB
#undef PG_MMA
}

struct DenseSched {
    const char* A; const char* Bt; int K, nM, nN, nwg, G, c;
    __device__ __forceinline__ void init(const void* A_, const void* Bt_, int M, int N, int K_, int G_, int c_) { A = (const char*)A_; Bt = (const char*)Bt_; K = K_; nM = M / BM; nN = N / BM; nwg = nM * nN; G = G_; c = c_; }
    __device__ __forceinline__ bool next(int i, Unit& u, int R0, int C0) const {
        const long L = (long)i * G + c; if (L >= nwg) return false;
        int wgid = (int)L; { const int q = nwg / 8, r = nwg % 8, xcd = wgid % 8, off = wgid / 8; wgid = (xcd < r ? xcd * (q + 1) : r * (q + 1) + (xcd - r) * q) + off; }
        const int nig = 8 * nN, gid = wgid / nig, fm = gid * 8, gsz = (nM - fm) < 8 ? (nM - fm) : 8;
        u.pm = fm + ((wgid % nig) % gsz); u.pn = (wgid % nig) / gsz; u.aux = 0;
        u.A = A + (size_t)u.pm * BM * K * 2; u.B = Bt + (size_t)u.pn * BM * K * 2;
#pragma unroll
        for (int q = 0; q < 4; ++q) u.ra[q] = (unsigned)((R0 + 64 * q) * K + C0) * 2u;
        return true;
    }
};
}
namespace att {
using s16x4 = __attribute__((ext_vector_type(4))) short;
using f32x16 = __attribute__((ext_vector_type(16))) float;
typedef __attribute__((address_space(3))) const char* lds_cptr;
typedef short v4i16_t __attribute__((ext_vector_type(4)));
constexpr int NSLOT = 3, VSLOT = 8192;
template <int DQ> struct Geo {
    static constexpr int NK = DQ / 16;
    static constexpr int KSLOT = (DQ == 64) ? 8192 : 16384;
    static constexpr int QWAVE = (DQ == 64) ? 4096 : 6144;
    static constexpr int LDS_K = 0, LDS_V = NSLOT * KSLOT, LDS_WS = LDS_V + NSLOT * VSLOT, LDS_OST = LDS_WS + 8 * 64 * 4, LDS_BYTES = LDS_OST + 8 * QWAVE;
};
constexpr int LDS_BIAS = Geo<64>::LDS_BYTES;
#define ASBAR() __builtin_amdgcn_sched_barrier(0)
#define AWAIT_BAR(N) asm volatile("s_waitcnt vmcnt(" #N ") lgkmcnt(0)\n\ts_barrier" ::: "memory")
__device__ __forceinline__ int crow(int r, int hi) { return (r & 3) + 8 * (r >> 2) + 4 * hi; }
__device__ __forceinline__ void glds16(const void* gsrc, unsigned lds_dst) { unsigned keep;
    asm volatile("s_mov_b32 %0, m0\n\ts_mov_b32 m0, %2\n\ts_nop 0\n\tglobal_load_lds_dwordx4 %1, off\n\ts_mov_b32 m0, %0" : "=&s"(keep) : "v"(gsrc), "s"(lds_dst) : "memory"); }
__device__ __forceinline__ float fadd_s(float a, float b) { float r; asm("v_add_f32_e32 %0, %1, %2" : "=v"(r) : "v"(a), "v"(b)); return r; }
__device__ __forceinline__ float fsub_s(float a, float b) { float r; asm("v_sub_f32_e32 %0, %1, %2" : "=v"(r) : "v"(a), "v"(b)); return r; }
__device__ __forceinline__ float max3f(float a, float b, float c) { float r; asm("v_max3_f32 %0, %1, %2, %3" : "=v"(r) : "v"(a), "v"(b), "v"(c)); return r; }
__device__ __forceinline__ float max2f(float a, float b) { float r; asm("v_max_f32_e32 %0, %1, %2" : "=v"(r) : "v"(a), "v"(b)); return r; }
__device__ __forceinline__ s16x4 vtr(lds_cptr p) { return __builtin_bit_cast(s16x4, __builtin_amdgcn_ds_read_tr16_b64_v4i16((__attribute__((address_space(3))) v4i16_t*)p)); }
template <int NK> __device__ __forceinline__ void kloadall(bf16x8* kf, lds_cptr kp) {
#pragma unroll
    for (int j = 0; j < NK; ++j) { kf[2 * j] = *(const LAS bf16x8*)(kp + j * 2048); kf[2 * j + 1] = *(const LAS bf16x8*)(kp + j * 2048 + 512); } }
__device__ __forceinline__ void kload2(bf16x8* kf, lds_cptr kp, int j) { kf[2 * j] = *(const LAS bf16x8*)(kp + j * 2048); kf[2 * j + 1] = *(const LAS bf16x8*)(kp + j * 2048 + 512); }
__device__ __forceinline__ void cmask(f32x16& p0, f32x16& p1, int koff, int qtok, int hi) {
    const int x = qtok - koff - 4 * hi;
#pragma unroll
    for (int r = 0; r < 16; ++r) { const int c = (r & 3) + 8 * (r >> 2); if (c > x) p0[r] = -INFINITY; if (c + 32 > x) p1[r] = -INFINITY; }
}
__device__ __forceinline__ void wmask(f32x16& p0, f32x16& p1, int thr, int hi) {
    const int y = thr - 4 * hi;
#pragma unroll
    for (int r = 0; r < 16; ++r) { const int c = (r & 3) + 8 * (r >> 2); if (c < y) p0[r] = -INFINITY; if (c + 32 < y) p1[r] = -INFINITY; }
}
__device__ __forceinline__ float rowmax(const f32x16& p0, const f32x16& p1) {
    float a = max3f(p0[0], p0[1], p1[0]), b = max3f(p0[2], p0[3], p1[1]); a = max3f(a, p1[2], p1[3]);
#pragma unroll
    for (int r = 4; r < 16; r += 4) { a = max3f(a, p0[r], p0[r + 1]); b = max3f(b, p0[r + 2], p0[r + 3]); a = max3f(a, p1[r], p1[r + 1]); b = max3f(b, p1[r + 2], p1[r + 3]); }
    const float m = max2f(a, b);
    auto rr = __builtin_amdgcn_permlane32_swap(__float_as_uint(m), __float_as_uint(m), false, false);
    return max2f(__uint_as_float(rr[0]), __uint_as_float(rr[1]));
}

enum { MODE_CAUSAL = 0, MODE_FOX = 1, MODE_WIN = 2 };
struct UnitArgs {
    const bf16_t* qrow;
    const bf16_t* K; const bf16_t* V; int kvpitch, vpitch;
    bf16_t* obase; int opitch;
    int qtok;
    int abase;
    int nsteps;
    const LAS float* bias;
};

template <int NB> __device__ __forceinline__ int seq(int i, int abase) { return (i < NB) ? abase + i : abase + NB - 1 - i; }

template <int MODE, bool GQA4, int THRL, int DQ, bool TM = false>
__device__ __forceinline__ void attn_unit(const UnitArgs& A, char* shm) {
    constexpr int NB = GQA4 ? 1 : 4;
    typedef Geo<DQ> G; constexpr int NK = G::NK, KSLOT = G::KSLOT, LDS_K = G::LDS_K, LDS_V = G::LDS_V, LDS_WS = G::LDS_WS, LDS_OST = G::LDS_OST, QWAVE = G::QWAVE;
    constexpr bool USE_NEGM = (MODE != MODE_FOX);
    int tid_ = threadIdx.x; asm volatile("" : "+v"(tid_));
    const int tid = tid_, lane = tid & 63, r32 = lane & 31, hi = lane >> 5; const int wid = __builtin_amdgcn_readfirstlane(tid >> 6);
    const unsigned lds0 = (unsigned)(uintptr_t)shm;
    float* wsf = (float*)(shm + LDS_WS) + wid * 64;
    const int NT = A.nsteps, abase = A.abase; const long kvp = A.kvpitch, vvp = A.vpitch;
    const bf16_t* ksrc = TM ? A.K + wid * 512 + lane * 8 : A.K + (long)lane * kvp + wid * 8;
    const bf16_t* ksrc2 = TM ? A.K + (8 + (wid & 3)) * 512 + lane * 8 : A.K + (long)lane * kvp + (8 + (wid & 3)) * 8;
    const bf16_t* vsrc = TM ? A.V + wid * 512 + lane * 8 : A.V + (long)(16 * (wid & 3) + (lane >> 2)) * vvp + (wid >> 2) * 32 + (lane & 3) * 8;
    const long kts = TM ? (long)(DQ / 8) * 512 : 64 * kvp, vts = TM ? 4096 : 64 * vvp;
    const unsigned kdst = lds0 + LDS_K + wid * 1024, vdst = lds0 + LDS_V + wid * 1024, kdst2 = lds0 + LDS_K + (8 + wid) * 1024;
#define TILE_OF(t) ({ int a_ = seq<NB>((t), abase); a_ < 0 ? 0 : a_; })
#define DMA_K(t, slot) do { const long to_ = (long)TILE_OF(t) * kts; glds16(ksrc + to_, (unsigned)__builtin_amdgcn_readfirstlane(kdst + (slot) * KSLOT)); \
        if (DQ == 96) glds16(ksrc2 + to_, (unsigned)__builtin_amdgcn_readfirstlane(kdst2 + (slot) * KSLOT)); } while (0)
#define DMA_V(t, slot) glds16(vsrc + (long)TILE_OF(t) * vts, (unsigned)__builtin_amdgcn_readfirstlane(vdst + (slot) * VSLOT))
    const lds_cptr shm3 = (lds_cptr)shm; const lds_cptr kp0 = shm3 + LDS_K + hi * 1024 + r32 * 16;
    const lds_cptr vp0 = shm3 + LDS_V + ((lane >> 4) & 1) * 32 + (lane & 3) * 8 + (4 * hi + ((lane & 15) >> 2)) * 64;
    const int vb0 = (int)(lds0 + LDS_V) + ((lane >> 4) & 1) * 32 + (lane & 3) * 8 + (4 * hi + ((lane & 15) >> 2)) * 64;
    DMA_K(0, 0); DMA_V(0, 0); DMA_K(1, 1);
    bf16x8 qr[NK];
#pragma unroll
    for (int d0 = 0; d0 < NK; ++d0) qr[d0] = *reinterpret_cast<const bf16x8*>(A.qrow + d0 * 16 + hi * 8);
    const lds_cptr qlp = shm3 + LDS_OST + wid * QWAVE + hi * 512 + r32 * 16;
    if (DQ == 96) {
#pragma unroll
        for (int d0 = 0; d0 < NK; ++d0) *(LAS bf16x8*)(const_cast<__attribute__((address_space(3))) char*>(qlp) + d0 * 1024) = qr[d0];
    }
#define QL(d0) (*(const LAS bf16x8*)(qlp + (d0) * 1024))
    float mhat = 0.f, l_reg = 0.f; f32x16 o[2]; o[0] = f32x16{}; o[1] = f32x16{};
    f32x16 negm = f32x16{}; if (USE_NEGM) asm volatile("" : "+v"(negm));
    const int qtok = A.qtok;
#define CMASK(P0, P1, t) do { const int t_ = (t); if (t_ < NB) cmask(P0, P1, 64 * t_, qtok, hi); \
        else { const int a_ = abase + NB - 1 - t_; if (a_ < 0) wmask(P0, P1, 64, hi); \
               else if (MODE == MODE_WIN) { const int thr_ = qtok - 511 + 64 * (abase - a_); if (thr_ > 0) wmask(P0, P1, thr_, hi); } } } while (0)
#define CINIT1(C, t, OFF) do { if (MODE == MODE_FOX) { const LAS float* bt_ = A.bias + 64 * (seq<NB>((t), abase) - (abase + NB - NT)) + 4 * hi + (OFF); const float nm_ = -mhat; \
        _Pragma("unroll") for (int g_ = 0; g_ < 4; ++g_) { const f32x4 b_ = *(const LAS f32x4*)(bt_ + 8 * g_); C[4 * g_] = b_.x; C[4 * g_ + 1] = b_.y; C[4 * g_ + 2] = b_.z; C[4 * g_ + 3] = b_.w; } \
        _Pragma("unroll") for (int r_ = 0; r_ < 16; ++r_) C[r_] += nm_; asm volatile("" : "+v"(C)); } \
      else if (USE_NEGM) { C = negm; } \
      else { const float nm_ = -mhat; _Pragma("unroll") for (int r_ = 0; r_ < 16; ++r_) C[r_] = nm_; asm volatile("" : "+v"(C)); } } while (0)
#define CINIT(C0, C1, t) do { CINIT1(C0, t, 0); CINIT1(C1, t, 32); } while (0)
    bool resc = false;
#define START(P0, P1) do { const float rm = rowmax(P0, P1); resc = false; \
    { const float dl = rm; mhat = fadd_s(mhat, dl); \
      _Pragma("unroll") for (int r = 0; r < 16; ++r) { P0[r] = fsub_s(P0[r], dl); P1[r] = fsub_s(P1[r], dl); } \
      if (USE_NEGM) { _Pragma("unroll") for (int r = 0; r < 16; ++r) negm[r] = -mhat; asm volatile("" : "+v"(negm)); } } \
    _Pragma("unroll") for (int r = 0; r < 16; ++r) P0[r] = __builtin_amdgcn_exp2f(P0[r]); } while (0)
#define RESC() do { if (resc) { asm volatile("s_waitcnt lgkmcnt(0)" ::: "memory"); \
      const float* wsh_ = wsf + 4 * hi; \
      _Pragma("unroll") for (int d_ = 0; d_ < 2; ++d_) _Pragma("unroll") for (int r = 0; r < 16; ++r) o[d_][r] *= wsh_[(r & 3) + 8 * (r >> 2)]; } } while (0)
    f32x16 pA0, pA1, pB0, pB1; bf16x8 kf[2 * NK];
    int sl_prev = 0, sl_cur = 0, sl_next = 1;
#define ROT() do { sl_prev = sl_cur; sl_cur = sl_next; sl_next = (sl_next == NSLOT - 1) ? 0 : sl_next + 1; } while (0)
    DMA_K(2, 2);
    if (DQ == 96) { AWAIT_BAR(5); } else { AWAIT_BAR(3); }
    { const char* kb = shm + LDS_K + hi * 1024 + r32 * 16;
      CINIT(pA0, pA1, 0);
#pragma unroll
      for (int d0 = 0; d0 < NK; ++d0) {
          const bf16x8 b0 = *reinterpret_cast<const bf16x8*>(kb + d0 * 2048);
          const bf16x8 b1 = *reinterpret_cast<const bf16x8*>(kb + d0 * 2048 + 512);
          pA0 = __builtin_amdgcn_mfma_f32_32x32x16_bf16(b0, qr[d0], pA0, 0, 0, 0); pA1 = __builtin_amdgcn_mfma_f32_32x32x16_bf16(b1, qr[d0], pA1, 0, 0, 0); } }
    asm volatile("s_nop 15\n\ts_nop 7" : "+v"(pA0), "+v"(pA1)); CMASK(pA0, pA1, 0);
    START(pA0, pA1);
    _Pragma("unroll") for (int r = 0; r < 16; ++r) pA1[r] = __builtin_amdgcn_exp2f(pA1[r]);
    AWAIT_BAR(0);
    DMA_K(3, 0); DMA_V(1, 1);
    ROT();
    kloadall<NK>(kf, kp0 + sl_cur * KSLOT);
    if (DQ == 96) { AWAIT_BAR(3); } else { AWAIT_BAR(2); }
    s16x4 vlo[(DQ == 96) ? 4 : 8], vhi[(DQ == 96) ? 4 : 8]; u32x4 pw0, pw1, pw2, pw3;
#define PKW(P, B) cvtpk(P[B], P[B + 1])
#define PAF(k) __builtin_bit_cast(bf16x8, pw##k)
#define VFR(i) (bf16x8){vlo[i][0], vlo[i][1], vlo[i][2], vlo[i][3], vhi[i][0], vhi[i][1], vhi[i][2], vhi[i][3]}
#define PIN(x) asm volatile("" : "+v"(x))
#define MX3(a, b, c) __builtin_fmaxf(__builtin_fmaxf((a), (b)), (c))
#define GAPA(MF, A0, A1, A2, A3, W0, W1, PW) do { MF; sacc += A0; sacc += A1; sacc += A2; sacc += A3; PIN(sacc); W0; W1; PIN(PW); ASBAR(); } while (0)
#define EX(v) __builtin_amdgcn_exp2f(v)
#define GAPB(MF, X, B) do { MF; X[B] = EX(X[B]); X[B + 1] = EX(X[B + 1]); X[B + 2] = EX(X[B + 2]); X[B + 3] = EX(X[B + 3]); PIN(X); ASBAR(); } while (0)
#define VRD(i) do { vlo[i] = vtr(vp_ + (((i) >> 2) * 4096 + ((i) & 3) * 1024)); vhi[i] = vtr(vp_ + (((i) >> 2) * 4096 + ((i) & 3) * 1024 + 512)); } while (0)
#define KRD(G_, j) do { if (G_) { kload2(kf, kp0 + sl_next * KSLOT, j); ASBAR(); } } while (0)
#define MFMA32(a, b, c) __builtin_amdgcn_mfma_f32_32x32x16_bf16(a, b, c, 0, 0, 0)
#define STEP64(C0, C1, P0, P1, t, GK, GV, GL, DOMASK) do { ASBAR(); \
    const lds_cptr vp_ = vp0 + sl_prev * VSLOT; \
    CINIT1(C0, t, 0); ASBAR(); \
    VRD(0); ASBAR(); float sacc = (P0[0] + P0[1]); \
    GAPA(C0 = MFMA32(kf[0], qr[0], C0), P0[2], P0[3], P0[4], P0[5],     pw0[0] = PKW(P0, 0), pw0[1] = PKW(P0, 2), pw0); \
    CINIT1(C1, t, 32); ASBAR(); \
    VRD(4); ASBAR(); GAPA(C1 = MFMA32(kf[1], qr[0], C1), P0[6], P0[7], P0[8], P0[9],     pw0[2] = PKW(P0, 4), pw0[3] = PKW(P0, 6), pw0); \
    VRD(1); ASBAR(); GAPA(C0 = MFMA32(kf[2], qr[1], C0),   P0[10], P0[11], P0[12], P0[13], pw1[0] = PKW(P0, 8), pw1[1] = PKW(P0, 10), pw1); \
    VRD(5); ASBAR(); GAPA(C1 = MFMA32(kf[3], qr[1], C1),   P0[14], P0[15], P1[0], P1[1],   pw1[2] = PKW(P0, 12), pw1[3] = PKW(P0, 14), pw1); \
    VRD(2); ASBAR(); GAPA(C0 = MFMA32(kf[4], qr[2], C0),   P1[2], P1[3], P1[4], P1[5],     pw2[0] = PKW(P1, 0), pw2[1] = PKW(P1, 2), pw2); \
    VRD(6); ASBAR(); GAPA(C1 = MFMA32(kf[5], qr[2], C1),   P1[6], P1[7], P1[8], P1[9],     pw2[2] = PKW(P1, 4), pw2[3] = PKW(P1, 6), pw2); \
    VRD(3); ASBAR(); GAPA(C0 = MFMA32(kf[6], qr[3], C0),   P1[10], P1[11], P1[12], P1[13], pw3[0] = PKW(P1, 8), pw3[1] = PKW(P1, 10), pw3); \
    VRD(7); ASBAR(); GAPA(C1 = MFMA32(kf[7], qr[3], C1),   P1[14], P1[15], 0.f, 0.f,       pw3[2] = PKW(P1, 12), pw3[3] = PKW(P1, 14), pw3); \
    l_reg += sacc; \
    if (GK) { DMA_K((t) + 3, sl_cur); } if (GV) { DMA_V((t) + 1, sl_next); } \
    if (DOMASK) CMASK(C0, C1, t); \
    { float a = MX3(C0[0], C0[1], C1[0]), b = MX3(C0[2], C0[3], C1[1]); a = MX3(a, C1[2], C1[3]); \
      _Pragma("unroll") for (int r = 4; r < 16; r += 4) { a = MX3(a, C0[r], C0[r + 1]); b = MX3(b, C0[r + 2], C0[r + 3]); a = MX3(a, C1[r], C1[r + 1]); b = MX3(b, C1[r + 2], C1[r + 3]); } \
      float rm = __builtin_fmaxf(a, b); { auto rr = __builtin_amdgcn_permlane32_swap(__float_as_uint(rm), __float_as_uint(rm), false, false); rm = __builtin_fmaxf(__uint_as_float(rr[0]), __uint_as_float(rr[1])); } \
      resc = false; \
      if (__builtin_expect(__any(rm > (float)THRL), 0)) { const float dl = __builtin_fmaxf(rm, 0.f); mhat += dl; \
        _Pragma("unroll") for (int r = 0; r < 16; ++r) { C0[r] -= dl; C1[r] -= dl; } \
        if (USE_NEGM) { _Pragma("unroll") for (int r = 0; r < 16; ++r) negm[r] = -mhat; asm volatile("" : "+v"(negm)); } \
        const float f = __builtin_amdgcn_exp2f(-dl); l_reg *= f; if (hi == 0) wsf[r32] = f; resc = true; } } \
    ASBAR(); \
    GAPB(o[0] = MFMA32(PAF(0), VFR(0), o[0]), C0, 0); \
    GAPB(o[1] = MFMA32(PAF(0), VFR(4), o[1]), C0, 4); \
    KRD(GL, 0); GAPB(o[0] = MFMA32(PAF(1), VFR(1), o[0]), C0, 8); \
    KRD(GL, 1); GAPB(o[1] = MFMA32(PAF(1), VFR(5), o[1]), C0, 12); \
    KRD(GL, 2); GAPB(o[0] = MFMA32(PAF(2), VFR(2), o[0]), C1, 0); \
    KRD(GL, 3); GAPB(o[1] = MFMA32(PAF(2), VFR(6), o[1]), C1, 4); \
    GAPB(o[0] = MFMA32(PAF(3), VFR(3), o[0]), C1, 8); \
    GAPB(o[1] = MFMA32(PAF(3), VFR(7), o[1]), C1, 12); \
    } while (0)
#define AWAIT_STEADY() do { if (DQ == 96) { AWAIT_BAR(3); } else { AWAIT_BAR(2); } } while (0)
#define VRD4(i, b) do { vlo[b] = vtr(vp_ + (((i) >> 2) * 4096 + ((i) & 3) * 1024)); vhi[b] = vtr(vp_ + (((i) >> 2) * 4096 + ((i) & 3) * 1024 + 512)); } while (0)
#define VFR4(b) (bf16x8){vlo[b][0], vlo[b][1], vlo[b][2], vlo[b][3], vhi[b][0], vhi[b][1], vhi[b][2], vhi[b][3]}
#define GAPQ(MF, QLD, A0, A1, A2, A3, W0, W1, PW) do { MF; QLD; sacc += A0; sacc += A1; sacc += A2; sacc += A3; PIN(sacc); W0; W1; PIN(PW); ASBAR(); } while (0)
#define STEP96(C0, C1, P0, P1, t, GK, GV, GL, DOMASK) do { ASBAR(); \
    const lds_cptr vp_ = vp0 + sl_prev * VSLOT; \
    CINIT1(C0, t, 0); CINIT1(C1, t, 32); bf16x8 qa = QL(0), qb; ASBAR(); \
    float sacc = (P0[0] + P0[1]); \
    GAPQ(C0 = MFMA32(kf[0], qa, C0), qb = QL(1), P0[2], P0[3], P0[4], P0[5],     pw0[0] = PKW(P0, 0), pw0[1] = PKW(P0, 2), pw0); \
    GAPQ(C1 = MFMA32(kf[1], qa, C1), (void)0,    P0[6], P0[7], P0[8], P0[9],     pw0[2] = PKW(P0, 4), pw0[3] = PKW(P0, 6), pw0); \
    GAPQ(C0 = MFMA32(kf[2], qb, C0), qa = QL(2), P0[10], P0[11], P0[12], P0[13], pw1[0] = PKW(P0, 8), pw1[1] = PKW(P0, 10), pw1); \
    GAPQ(C1 = MFMA32(kf[3], qb, C1), (void)0,    P0[14], P0[15], P1[0], P1[1],   pw1[2] = PKW(P0, 12), pw1[3] = PKW(P0, 14), pw1); \
    GAPQ(C0 = MFMA32(kf[4], qa, C0), qb = QL(3), P1[2], P1[3], P1[4], P1[5],     pw2[0] = PKW(P1, 0), pw2[1] = PKW(P1, 2), pw2); \
    GAPQ(C1 = MFMA32(kf[5], qa, C1), (void)0,    P1[6], P1[7], P1[8], P1[9],     pw2[2] = PKW(P1, 4), pw2[3] = PKW(P1, 6), pw2); \
    GAPQ(C0 = MFMA32(kf[6], qb, C0), qa = QL(4), P1[10], P1[11], P1[12], P1[13], pw3[0] = PKW(P1, 8), pw3[1] = PKW(P1, 10), pw3); \
    GAPQ(C1 = MFMA32(kf[7], qb, C1), (void)0,    P1[14], P1[15], 0.f, 0.f,       pw3[2] = PKW(P1, 12), pw3[3] = PKW(P1, 14), pw3); \
    C0 = MFMA32(kf[8], qa, C0); qb = QL(5); VRD4(0, 0); ASBAR(); \
    C1 = MFMA32(kf[9], qa, C1); VRD4(4, 1); ASBAR(); \
    C0 = MFMA32(kf[10], qb, C0); ASBAR(); \
    C1 = MFMA32(kf[11], qb, C1); ASBAR(); \
    l_reg += sacc; \
    if (GK) { DMA_K((t) + 3, sl_cur); } if (GV) { DMA_V((t) + 1, sl_next); } \
    if (DOMASK) CMASK(C0, C1, t); \
    { float a = MX3(C0[0], C0[1], C1[0]), b = MX3(C0[2], C0[3], C1[1]); a = MX3(a, C1[2], C1[3]); \
      _Pragma("unroll") for (int r = 4; r < 16; r += 4) { a = MX3(a, C0[r], C0[r + 1]); b = MX3(b, C0[r + 2], C0[r + 3]); a = MX3(a, C1[r], C1[r + 1]); b = MX3(b, C1[r + 2], C1[r + 3]); } \
      float rm = __builtin_fmaxf(a, b); { auto rr = __builtin_amdgcn_permlane32_swap(__float_as_uint(rm), __float_as_uint(rm), false, false); rm = __builtin_fmaxf(__uint_as_float(rr[0]), __uint_as_float(rr[1])); } \
      resc = false; \
      if (__builtin_expect(__any(rm > (float)THRL), 0)) { const float dl = __builtin_fmaxf(rm, 0.f); mhat += dl; \
        _Pragma("unroll") for (int r = 0; r < 16; ++r) { C0[r] -= dl; C1[r] -= dl; } \
        if (USE_NEGM) { _Pragma("unroll") for (int r = 0; r < 16; ++r) negm[r] = -mhat; asm volatile("" : "+v"(negm)); } \
        const float f = __builtin_amdgcn_exp2f(-dl); l_reg *= f; if (hi == 0) wsf[r32] = f; resc = true; } } \
    ASBAR(); \
    VRD4(1, 2); ASBAR(); GAPB(o[0] = MFMA32(PAF(0), VFR4(0), o[0]), C0, 0); \
    VRD4(5, 3); ASBAR(); GAPB(o[1] = MFMA32(PAF(0), VFR4(1), o[1]), C0, 4); \
    VRD4(2, 0); KRD(GL, 0); GAPB(o[0] = MFMA32(PAF(1), VFR4(2), o[0]), C0, 8); \
    VRD4(6, 1); KRD(GL, 1); GAPB(o[1] = MFMA32(PAF(1), VFR4(3), o[1]), C0, 12); \
    VRD4(3, 2); KRD(GL, 2); GAPB(o[0] = MFMA32(PAF(2), VFR4(0), o[0]), C1, 0); \
    VRD4(7, 3); KRD(GL, 3); GAPB(o[1] = MFMA32(PAF(2), VFR4(1), o[1]), C1, 4); \
    KRD(GL, 4); GAPB(o[0] = MFMA32(PAF(3), VFR4(2), o[0]), C1, 8); \
    KRD(GL, 5); GAPB(o[1] = MFMA32(PAF(3), VFR4(3), o[1]), C1, 12); \
    } while (0)
#define STEP(C0, C1, P0, P1, t, GK, GV, GL, DOMASK) do { if constexpr (DQ == 96) { STEP96(C0, C1, P0, P1, t, GK, GV, GL, DOMASK); } else { STEP64(C0, C1, P0, P1, t, GK, GV, GL, DOMASK); } } while (0)
#define ENDW(tt) do { if ((tt) + 3 < NT) { AWAIT_STEADY(); } else if ((tt) + 2 < NT) { AWAIT_BAR(1); } else { AWAIT_BAR(0); } } while (0)
    int t = 1;
    for (; t < 5 && t + 1 < NT; t += 2) {
        STEP(pB0, pB1, pA0, pA1, t, (t + 3 < NT), (t + 1 < NT), (t + 1 < NT), true);       ENDW(t);     RESC(); ROT();
        STEP(pA0, pA1, pB0, pB1, t + 1, (t + 4 < NT), (t + 2 < NT), (t + 2 < NT), true);   ENDW(t + 1); RESC(); ROT();
    }
    for (; t + 5 < NT; t += 2) {
        STEP(pB0, pB1, pA0, pA1, t, true, true, true, false);     AWAIT_STEADY(); RESC(); ROT();
        STEP(pA0, pA1, pB0, pB1, t + 1, true, true, true, false); AWAIT_STEADY(); RESC(); ROT();
    }
    for (; t + 1 < NT; t += 2) {
        STEP(pB0, pB1, pA0, pA1, t, (t + 3 < NT), (t + 1 < NT), (t + 1 < NT), true);       ENDW(t);     RESC(); ROT();
        STEP(pA0, pA1, pB0, pB1, t + 1, (t + 4 < NT), (t + 2 < NT), (t + 2 < NT), true);   ENDW(t + 1); RESC(); ROT();
    }
    STEP(pB0, pB1, pA0, pA1, NT - 1, false, false, false, true); RESC();
    { float sacc = pB0[0] + pB0[1];
      _Pragma("unroll") for (int r = 2; r < 16; ++r) sacc += pB0[r];
      _Pragma("unroll") for (int r = 0; r < 16; ++r) sacc += pB1[r];
      l_reg += sacc;
      pw0 = (u32x4){PKW(pB0, 0), PKW(pB0, 2), PKW(pB0, 4), PKW(pB0, 6)}; pw1 = (u32x4){PKW(pB0, 8), PKW(pB0, 10), PKW(pB0, 12), PKW(pB0, 14)};
      pw2 = (u32x4){PKW(pB1, 0), PKW(pB1, 2), PKW(pB1, 4), PKW(pB1, 6)}; pw3 = (u32x4){PKW(pB1, 8), PKW(pB1, 10), PKW(pB1, 12), PKW(pB1, 14)};
      ASBAR();
      const int vb = vb0 + sl_cur * VSLOT;
#pragma unroll
      for (int d0 = 0; d0 < 2; ++d0) { s16x4 lo[4], hh[4];
#pragma unroll
          for (int ks = 0; ks < 4; ++ks) {
              asm volatile("ds_read_b64_tr_b16 %0,%1 offset:%c2" : "=&v"(lo[ks]) : "v"(vb), "i"(d0 * 4096 + ks * 1024) : "memory");
              asm volatile("ds_read_b64_tr_b16 %0,%1 offset:%c2" : "=&v"(hh[ks]) : "v"(vb), "i"(d0 * 4096 + ks * 1024 + 512) : "memory"); }
          asm volatile("s_waitcnt lgkmcnt(0)" ::: "memory"); ASBAR();
#define PK(k) (bf16x8){lo[k][0], lo[k][1], lo[k][2], lo[k][3], hh[k][0], hh[k][1], hh[k][2], hh[k][3]}
          o[d0] = MFMA32(PAF(0), PK(0), o[d0]); o[d0] = MFMA32(PAF(1), PK(1), o[d0]); o[d0] = MFMA32(PAF(2), PK(2), o[d0]); o[d0] = MFMA32(PAF(3), PK(3), o[d0]);
#undef PK
      } }
    { auto rr = __builtin_amdgcn_permlane32_swap(__float_as_uint(l_reg), __float_as_uint(l_reg), false, false); l_reg = __uint_as_float(rr[0]) + __uint_as_float(rr[1]); }
    if (hi == 0) wsf[32 + r32] = l_reg; asm volatile("s_waitcnt lgkmcnt(0)" ::: "memory");
    int lane_e = lane; asm volatile("" : "+v"(lane_e)); const int hi_e = lane_e >> 5, r32_e = lane_e & 31;
    float rli[16];
    { const float* wl_ = wsf + 32 + 4 * hi_e;
#pragma unroll
      for (int r = 0; r < 16; ++r) rli[r] = __builtin_amdgcn_rcpf(wl_[(r & 3) + 8 * (r >> 2)]); }
    { bf16_t* stg = (bf16_t*)(shm + LDS_OST + wid * QWAVE);
      bf16_t* stl = stg + (4 * hi_e) * 64 + r32_e;
#pragma unroll
      for (int r = 0; r < 16; ++r) {
#pragma unroll
          for (int d0 = 0; d0 < 2; ++d0) stl[((r & 3) + 8 * (r >> 2)) * 64 + d0 * 32] = f2bf(o[d0][r] * rli[r]); }
      asm volatile("s_waitcnt lgkmcnt(0)" ::: "memory");
#pragma unroll
      for (int i = 0; i < 4; ++i) { const int row = i * 8 + (lane_e >> 3), ch = lane_e & 7; const u32x4 v = *(const u32x4*)(stg + row * 64 + ch * 8);
          bf16_t* dst = GQA4 ? (A.obase + (long)(8 * wid + (row >> 2)) * A.opitch + (row & 3) * 64) : (A.obase + (long)(32 * wid + row) * A.opitch);
          *(u32x4*)(dst + ch * 8) = v; } }
    asm volatile("s_waitcnt lgkmcnt(0)\n\ts_barrier" ::: "memory");
#undef TILE_OF
#undef DMA_K
#undef DMA_V
#undef CMASK
#undef CINIT
#undef START
#undef RESC
#undef ROT
#undef PKW
#undef PAF
#undef VFR
#undef PIN
#undef MX3
#undef GAPA
#undef GAPB
#undef EX
#undef VRD
#undef KRD
#undef MFMA32
#undef STEP
#undef STEP64
#undef STEP96
#undef VRD4
#undef VFR4
#undef GAPQ
#undef QL
#undef ENDW
#undef AWAIT_STEADY
}
}
constexpr int MK_THREADS = 512;
constexpr int LDS_RING = 131072;
constexpr int LDS_X = LDS_RING;
constexpr int LDS_MOD = LDS_RING + 8192;
constexpr int LDS_BARST = 155648 - 16;
constexpr int LDS_TOTAL = 155648;

#define C2Q 0.18033688011112042f
#define LOG2E 1.4426950408889634f

struct BlkDesc { bf16_t* dst; const float* gain; int pitch; int flags; float scale; int csoff; };
#define C2M 0.14724312203508865f
struct MKP {
    const float* in[34];
    float* out;
    float* modpart;
    float* mod;
    float* cosT; float* sinT;
    bf16_t* W_in0t;
    bf16_t* W_out0t;
    bf16_t* XN;
    bf16_t* OATT;
    bf16_t* QN;
    bf16_t* KV6;
    bf16_t* FQ; bf16_t* FK; bf16_t* FV;
    float* GATES;
    float* LOGF;
    BlkDesc* desc0;
    float* CUMB;
    BlkDesc* desc_uq;
    BlkDesc* desc_ukv;
    bf16_t* W_in1t;
    bf16_t* W_uqt;
    bf16_t* W_ukvt;
    bf16_t* W_out1t;
    bf16_t* P1;
    bf16_t* CQN;
    bf16_t* CKVN;
    bf16_t* Q96;
    bf16_t* K96;
    bf16_t* V1;
    bf16_t* WcT;
    float* CBIAS;
    bf16_t* KCMP;
    bf16_t* VCT;
    bf16_t* KSLF;
    bf16_t* VSLF;
    bf16_t* OCMP;
    bf16_t* OWIN;
    const int* pos;
    bf16_t* Wgu;
    bf16_t* Wd;
    bf16_t* HID;
    bf16_t* YS;
    bf16_t* YBUF;
    int* gcnt;
    int* list;
    float* ew;
    unsigned* barw;
    int ph_lo, ph_hi, dbg_flags, pad_;
};

__device__ __forceinline__ int swap45(int p) { return (p & 15) | ((p & 16) << 1) | ((p & 32) >> 1); }

template <class Map>
__device__ __forceinline__ void tr_item(const float* __restrict__ W, int ldw, int K, bf16_t* WT, LAS float* scr, int kb, int nb, int lane, const Map& cmap, const float* kscale) {
    const int k0 = 64 * kb, n0 = 32 * nb;
    const int sc = cmap(n0 + (lane & 31));
    float v[32];
    const float* src = W + (size_t)(k0 + (lane >> 5)) * ldw + (sc >= 0 ? sc : 0);
#pragma unroll
    for (int i = 0; i < 32; ++i) v[i] = src[(size_t)(2 * i) * ldw];
    if (kscale) {
#pragma unroll
        for (int i = 0; i < 32; ++i) v[i] *= kscale[k0 + 2 * i + (lane >> 5)];
    }
#pragma unroll
    for (int i = 0; i < 32; ++i) scr[(2 * i + (lane >> 5)) * 33 + (lane & 31)] = (sc >= 0) ? v[i] : 0.f;
    asm volatile("s_waitcnt lgkmcnt(0)" ::: "memory");
    const int c = lane & 7;
#pragma unroll
    for (int j = 0; j < 4; ++j) {
        const int n = (lane >> 3) + 8 * j; const LAS float* s = scr + (8 * c) * 33 + n;
        u32x4 o; o.x = cvtpk(s[0 * 33], s[1 * 33]); o.y = cvtpk(s[2 * 33], s[3 * 33]); o.z = cvtpk(s[4 * 33], s[5 * 33]); o.w = cvtpk(s[6 * 33], s[7 * 33]);
        *(u32x4*)(WT + (size_t)(n0 + n) * K + k0 + 8 * c) = o;
    }
    asm volatile("s_waitcnt lgkmcnt(0)" ::: "memory");
}
struct MapIn0 {
    __device__ __forceinline__ int operator()(int nn) const {
        const int blk = nn >> 6, p = nn & 63;
        if (blk < 8) return blk * 64 + swap45(p);
        if (blk < 20) return 512 + (blk - 8) * 64 + swap45(p);
        if (blk < 44) return 1304 + (blk - 20) * 64 + swap45(p);
        if (blk == 44) { if (p < 24) return 1280 + p; if (p < 32) return 2840 + (p - 24); return -1; }
        return -1;
    }
};
struct MapId { __device__ __forceinline__ int operator()(int nn) const { return nn; } };
struct MapIn1 { __device__ __forceinline__ int operator()(int nn) const { return nn < 672 ? nn : -1; } };
struct MapUq { __device__ __forceinline__ int operator()(int nn) const { if (nn < 1024) return (nn >> 6) * 96 + swap45(nn & 63); const int r = nn - 1024; return (r >> 5) * 96 + 64 + (r & 31); } };
struct MapUkv { __device__ __forceinline__ int operator()(int nn) const { if (nn < 1024) return (nn >> 6) * 128 + swap45(nn & 63); const int r = nn - 1024; return (r >> 6) * 128 + 64 + swap45(r & 63); } };

namespace nsa {
using att::f32x16; using att::crow;
#define NMFMA32(a, b, c) __builtin_amdgcn_mfma_f32_32x32x16_bf16(a, b, c, 0, 0, 0)
#define NMFMA16(a, b, c) __builtin_amdgcn_mfma_f32_16x16x32_bf16(a, b, c, 0, 0, 0)
#define RLF(x, l) __uint_as_float(__builtin_amdgcn_readlane((int)__float_as_uint(x), (l)))

__device__ __forceinline__ void compress_job(const MKP& p, LAS float* scr, LAS float* part, int job, int slice, int lane) {
    const int nt = job & 31, g = (job >> 5) & 1, kv = job >> 6;
    const int r32 = lane & 31, hi = lane >> 5, n0 = nt * 32;
    const bf16_t* tok = p.KV6 + (size_t)(kv * 2 + g) * S_ * 64;
    const bf16_t* wt = p.WcT + (size_t)kv * 64 * 2048;
    scr[lane] = p.CBIAS[kv * 64 + lane];
    asm volatile("s_waitcnt lgkmcnt(0)" ::: "memory");
    int nrow = n0 + r32; if (nrow > 1022) nrow = 1022;
    const bf16_t* ta = tok + (size_t)(16 * nrow) * 64 + 8 * hi;
    const bf16_t* wa0 = wt + (size_t)r32 * 2048 + 8 * hi;
    const bf16_t* wa1 = wa0 + (size_t)32 * 2048;
    f32x16 c0 = f32x16{}, c1 = f32x16{};
    if (kv == 0) {
#pragma unroll 8
        for (int s = 32 * slice; s < 32 * slice + 32; ++s) {
            const bf16x8 tf = *(const bf16x8*)(ta + 16 * s), w0 = *(const bf16x8*)(wa0 + 16 * s), w1 = *(const bf16x8*)(wa1 + 16 * s);
            c0 = NMFMA32(w0, tf, c0); c1 = NMFMA32(w1, tf, c1);
        }
        if (slice) {
#pragma unroll
            for (int r = 0; r < 16; ++r) { part[r * 64 + lane] = c0[r]; part[(16 + r) * 64 + lane] = c1[r]; } }
        __syncthreads();
        if (slice) return;
#pragma unroll
        for (int q = 1; q < 4; ++q)
#pragma unroll
            for (int r = 0; r < 16; ++r) { c0[r] += part[q * 2048 + r * 64 + lane]; c1[r] += part[q * 2048 + (16 + r) * 64 + lane]; }
        float ss = 0.f;
#pragma unroll
        for (int r = 0; r < 16; ++r) { c0[r] += scr[crow(r, hi)]; c1[r] += scr[32 + crow(r, hi)]; ss += c0[r] * c0[r] + c1[r] * c1[r]; }
        { auto rr = __builtin_amdgcn_permlane32_swap(__float_as_uint(ss), __float_as_uint(ss), false, false); ss = __uint_as_float(rr[0]) + __uint_as_float(rr[1]); }
        const float rs = rsqrtf(ss * (1.f / 64.f) + EPSF);
        const float* gn = p.in[10];
        if (n0 + r32 < 1023) {
            const int nn = n0 + r32;
            bf16_t* dst = p.KCMP + (size_t)g * 1024 * 64 + (size_t)(nn >> 6) * 4096 + ((nn >> 5) & 1) * 512 + (nn & 31) * 8;
#pragma unroll
            for (int q = 0; q < 4; ++q) {
                const int e0 = 8 * q + 4 * hi;
                const f32x4 ga = *(const f32x4*)(gn + e0), gb = *(const f32x4*)(gn + 32 + e0);
                u32x2 wa, wb;
                wa.x = cvtpk(c0[4 * q] * rs * ga.x, c0[4 * q + 1] * rs * ga.y); wa.y = cvtpk(c0[4 * q + 2] * rs * ga.z, c0[4 * q + 3] * rs * ga.w);
                wb.x = cvtpk(c1[4 * q] * rs * gb.x, c1[4 * q + 1] * rs * gb.y); wb.y = cvtpk(c1[4 * q + 2] * rs * gb.z, c1[4 * q + 3] * rs * gb.w);
                *(u32x2*)(dst + (e0 >> 4) * 1024 + ((e0 >> 3) & 1) * 256 + (e0 & 7)) = wa; *(u32x2*)(dst + ((32 + e0) >> 4) * 1024 + (((32 + e0) >> 3) & 1) * 256 + ((32 + e0) & 7)) = wb;
            }
        }
    } else {
#pragma unroll 8
        for (int s = 32 * slice; s < 32 * slice + 32; ++s) {
            const bf16x8 tf = *(const bf16x8*)(ta + 16 * s), w0 = *(const bf16x8*)(wa0 + 16 * s), w1 = *(const bf16x8*)(wa1 + 16 * s);
            c0 = NMFMA32(tf, w0, c0); c1 = NMFMA32(tf, w1, c1);
        }
        if (slice) {
#pragma unroll
            for (int r = 0; r < 16; ++r) { part[r * 64 + lane] = c0[r]; part[(16 + r) * 64 + lane] = c1[r]; } }
        __syncthreads();
        if (slice) return;
#pragma unroll
        for (int q = 1; q < 4; ++q)
#pragma unroll
            for (int r = 0; r < 16; ++r) { c0[r] += part[q * 2048 + r * 64 + lane]; c1[r] += part[q * 2048 + (16 + r) * 64 + lane]; }
        const float b0 = scr[r32], b1 = scr[32 + r32];
#pragma unroll
        for (int G = 0; G < 2; ++G) {
            u32x4 va, vb;
            va.x = cvtpk(c0[8 * G] + b0, c0[8 * G + 1] + b0); va.y = cvtpk(c0[8 * G + 2] + b0, c0[8 * G + 3] + b0); va.z = cvtpk(c0[8 * G + 4] + b0, c0[8 * G + 5] + b0); va.w = cvtpk(c0[8 * G + 6] + b0, c0[8 * G + 7] + b0);
            vb.x = cvtpk(c1[8 * G] + b1, c1[8 * G + 1] + b1); vb.y = cvtpk(c1[8 * G + 2] + b1, c1[8 * G + 3] + b1); vb.z = cvtpk(c1[8 * G + 4] + b1, c1[8 * G + 5] + b1); vb.w = cvtpk(c1[8 * G + 6] + b1, c1[8 * G + 7] + b1);
            { const int nk = n0 + 16 * G, c_ = nk >> 6, ks_ = (nk >> 4) & 3;
              bf16_t* vd = p.VCT + (size_t)g * 64 * 1024 + (size_t)c_ * 4096 + ks_ * 1024 + (hi * 32 + r32) * 8;
              *(u32x4*)vd = va; *(u32x4*)(vd + 512) = vb; }
        }
    }
    asm volatile("s_waitcnt lgkmcnt(0)" ::: "memory");
}

__device__ __forceinline__ unsigned pk4_fp8(float a, float b, float c, float d) { int w = __builtin_amdgcn_cvt_pk_fp8_f32(a, b, 0, false); w = __builtin_amdgcn_cvt_pk_fp8_f32(c, d, w, true); return (unsigned)w; }
__device__ __forceinline__ void slcfrag_job(const MKP& p, int job, int lane) {
    const int g = job >> 8, blk = job & 255, c16 = lane & 15, u = lane >> 4;
    const bf16_t* k = p.KV6 + (size_t)(2 * 2 + g) * S_ * 64 + (size_t)blk * 64 * 64;
    const bf16_t* v = p.KV6 + (size_t)(3 * 2 + g) * S_ * 64 + (size_t)blk * 64 * 64;
    unsigned char* kd = (unsigned char*)p.KSLF + ((size_t)g * 256 + blk) * 4096 + lane * 16;
    unsigned char* vd = (unsigned char*)p.VSLF + ((size_t)g * 256 + blk) * 4096 + lane * 16;
#pragma unroll
    for (int kg = 0; kg < 4; ++kg) {
        const u32x4 a = *(const u32x4*)(k + (size_t)(16 * kg + c16) * 64 + 8 * u), b = *(const u32x4*)(k + (size_t)(16 * kg + c16) * 64 + 32 + 8 * u);
        u32x4 o;
        o.x = pk4_fp8(__uint_as_float(a.x << 16), __uint_as_float(a.x & 0xffff0000u), __uint_as_float(a.y << 16), __uint_as_float(a.y & 0xffff0000u));
        o.y = pk4_fp8(__uint_as_float(a.z << 16), __uint_as_float(a.z & 0xffff0000u), __uint_as_float(a.w << 16), __uint_as_float(a.w & 0xffff0000u));
        o.z = pk4_fp8(__uint_as_float(b.x << 16), __uint_as_float(b.x & 0xffff0000u), __uint_as_float(b.y << 16), __uint_as_float(b.y & 0xffff0000u));
        o.w = pk4_fp8(__uint_as_float(b.z << 16), __uint_as_float(b.z & 0xffff0000u), __uint_as_float(b.w << 16), __uint_as_float(b.w & 0xffff0000u));
        *(u32x4*)(kd + kg * 1024) = o;
    }
#pragma unroll
    for (int dg = 0; dg < 4; ++dg) {
        float x[16];
#pragma unroll
        for (int ch = 0; ch < 2; ++ch)
#pragma unroll
            for (int j = 0; j < 8; ++j) { const int key = 32 * ch + ((j < 4) ? 4 * u + j : 16 + 4 * u + (j - 4)); x[ch * 8 + j] = bf2f(v[(size_t)key * 64 + 16 * dg + c16]); }
        u32x4 o; o.x = pk4_fp8(x[0], x[1], x[2], x[3]); o.y = pk4_fp8(x[4], x[5], x[6], x[7]); o.z = pk4_fp8(x[8], x[9], x[10], x[11]); o.w = pk4_fp8(x[12], x[13], x[14], x[15]);
        *(u32x4*)(vd + dg * 1024) = o;
    }
}

constexpr int IMP_LD = 272;
__device__ __forceinline__ void cmp_wave(const MKP& p, int g, int t0w, LAS float* imp, LAS unsigned char* stg, int lane) {
    const int r32 = lane & 31, hi = lane >> 5;
    const int tq = t0w + (r32 >> 2), head = g * 4 + (r32 & 3);
    const int nmax = (tq >= 31) ? ((tq - 31) >> 4) : -1;
    const int nmaxw = (t0w + 7 >= 31) ? ((t0w + 7 - 31) >> 4) : -1;
    const int ntile = (nmaxw >> 6) + 1;
    for (int i = lane; i < 8 * IMP_LD; i += 64) imp[i] = 0.f;
    bf16x8 qr[4];
#pragma unroll
    for (int d0 = 0; d0 < 4; ++d0) qr[d0] = *(const bf16x8*)(p.QN + (size_t)tq * 512 + head * 64 + d0 * 16 + hi * 8);
    const bf16_t* kc = p.KCMP + (size_t)g * 1024 * 64 + (hi * 32 + r32) * 8;
    bf16x8 ovf[4];
#pragma unroll
    for (int ks = 0; ks < 4; ++ks)
#pragma unroll
        for (int j = 0; j < 8; ++j) {
            const int nrel = 16 * ks + ((j < 4) ? 4 * hi + j : 8 + 4 * hi + (j - 4));
            const int dlt = nrel - 4 * r32;
            const float w = (dlt >= 0 && dlt <= 2) ? 2.f : ((dlt == 3 || dlt == -1) ? 1.f : 0.f);
            ovf[ks][j] = (short)f2bf(w);
        }
#define CKLOAD(dst, c_) do { const bf16_t* kt_ = kc + (size_t)(c_) * 4096; _Pragma("unroll") for (int f_ = 0; f_ < 8; ++f_) dst[f_] = *(const bf16x8*)(kt_ + f_ * 512); } while (0)
#define CQK(s0, s1, kf) do { s0 = f32x16{}; s1 = f32x16{}; _Pragma("unroll") for (int d0_ = 0; d0_ < 4; ++d0_) { s0 = NMFMA32(kf[2 * d0_], qr[d0_], s0); s1 = NMFMA32(kf[2 * d0_ + 1], qr[d0_], s1); } } while (0)
    float m = -INFINITY, l = 0.f;
    bf16x8 kfa[8], kfb[8];
    if (ntile > 0) CKLOAD(kfa, 0);
#define CMP_P1(KC, KN, c) do { { const int cn_ = ((c) + 1 < ntile) ? (c) + 1 : ntile - 1; CKLOAD(KN, cn_); } \
        f32x16 s0, s1; CQK(s0, s1, KC); \
        const int x = nmax - 64 * (c) - 4 * hi; float tm = -INFINITY; \
        _Pragma("unroll") for (int r = 0; r < 16; ++r) { const int cc = (r & 3) + 8 * (r >> 2); if (cc > x) s0[r] = -INFINITY; if (cc + 32 > x) s1[r] = -INFINITY; tm = fmaxf(tm, fmaxf(s0[r], s1[r])); } \
        if (tm > m) { l *= __builtin_amdgcn_exp2f(m - tm); m = tm; } \
        if (m > -INFINITY) { float sum = 0.f; _Pragma("unroll") for (int r = 0; r < 16; ++r) sum += __builtin_amdgcn_exp2f(s0[r] - m) + __builtin_amdgcn_exp2f(s1[r] - m); l += sum; } } while (0)
#pragma unroll 1
    for (int c = 0; c < ntile; c += 2) { CMP_P1(kfa, kfb, c); if (c + 1 < ntile) CMP_P1(kfb, kfa, c + 1); }
    { auto rm = __builtin_amdgcn_permlane32_swap(__float_as_uint(m), __float_as_uint(m), false, false);
      auto rl = __builtin_amdgcn_permlane32_swap(__float_as_uint(l), __float_as_uint(l), false, false);
      const float ma = __uint_as_float(rm[0]), mb = __uint_as_float(rm[1]), la = __uint_as_float(rl[0]), lb = __uint_as_float(rl[1]);
      const float mm = fmaxf(ma, mb);
      if (mm > -INFINITY) { l = ((ma > -INFINITY) ? la * __builtin_amdgcn_exp2f(ma - mm) : 0.f) + ((mb > -INFINITY) ? lb * __builtin_amdgcn_exp2f(mb - mm) : 0.f); m = mm; }
      else { l = 0.f; m = 0.f; } }
    const float invl = (l > 0.f) ? 1.f / l : 0.f;
    f32x16 o0 = f32x16{}, o1 = f32x16{};
    const bf16_t* vc = p.VCT + (size_t)g * 64 * 1024 + (hi * 32 + r32) * 8;
    if (ntile > 0) CKLOAD(kfa, 0);
    bf16x8 vfr[8];
#define CMP_P2(KC, KN, c) do { \
        { const bf16_t* vt_ = vc + (size_t)(c) * 4096; _Pragma("unroll") for (int f_ = 0; f_ < 8; ++f_) vfr[f_] = *(const bf16x8*)(vt_ + f_ * 512); } \
        { const int cn_ = ((c) + 1 < ntile) ? (c) + 1 : ntile - 1; CKLOAD(KN, cn_); } \
        f32x16 s0, s1; CQK(s0, s1, KC); \
        const int x = nmax - 64 * (c) - 4 * hi; \
        _Pragma("unroll") for (int r = 0; r < 16; ++r) { const int cc = (r & 3) + 8 * (r >> 2); \
            s0[r] = (cc > x) ? 0.f : __builtin_amdgcn_exp2f(s0[r] - m) * invl; s1[r] = (cc + 32 > x) ? 0.f : __builtin_amdgcn_exp2f(s1[r] - m) * invl; } \
        u32x4 pw[4]; \
        pw[0] = (u32x4){cvtpk(s0[0], s0[1]), cvtpk(s0[2], s0[3]), cvtpk(s0[4], s0[5]), cvtpk(s0[6], s0[7])}; \
        pw[1] = (u32x4){cvtpk(s0[8], s0[9]), cvtpk(s0[10], s0[11]), cvtpk(s0[12], s0[13]), cvtpk(s0[14], s0[15])}; \
        pw[2] = (u32x4){cvtpk(s1[0], s1[1]), cvtpk(s1[2], s1[3]), cvtpk(s1[4], s1[5]), cvtpk(s1[6], s1[7])}; \
        pw[3] = (u32x4){cvtpk(s1[8], s1[9]), cvtpk(s1[10], s1[11]), cvtpk(s1[12], s1[13]), cvtpk(s1[14], s1[15])}; \
        f32x16 im = f32x16{}; \
        _Pragma("unroll") for (int ks = 0; ks < 4; ++ks) { const bf16x8 pa = __builtin_bit_cast(bf16x8, pw[ks]); \
            o0 = NMFMA32(pa, vfr[2 * ks], o0); o1 = NMFMA32(pa, vfr[2 * ks + 1], o1); im = NMFMA32(pa, ovf[ks], im); } \
        if (r32 <= 16 && 16 * (c) + r32 < 256) { \
            _Pragma("unroll") for (int k = 0; k < 4; ++k) { const float v = (im[4 * k] + im[4 * k + 1]) + (im[4 * k + 2] + im[4 * k + 3]); atomicAdd((float*)(imp + (2 * k + hi) * IMP_LD + 16 * (c) + r32), v); } } } while (0)
#pragma unroll 1
    for (int c = 0; c < ntile; c += 2) { CMP_P2(kfa, kfb, c); if (c + 1 < ntile) CMP_P2(kfb, kfa, c + 1); }
#undef CMP_P1
#undef CMP_P2
#undef CKLOAD
#undef CQK
    { bf16_t* st = (bf16_t*)stg; bf16_t* stl = st + (4 * hi) * 64 + r32;
#pragma unroll
      for (int r = 0; r < 16; ++r) { stl[((r & 3) + 8 * (r >> 2)) * 64] = f2bf(o0[r]); stl[((r & 3) + 8 * (r >> 2)) * 64 + 32] = f2bf(o1[r]); }
      asm volatile("s_waitcnt lgkmcnt(0)" ::: "memory");
#pragma unroll
      for (int i = 0; i < 4; ++i) { const int row = i * 8 + (lane >> 3), ch = lane & 7; const u32x4 v = *(const u32x4*)(st + row * 64 + ch * 8);
          *(u32x4*)(p.OCMP + (size_t)(t0w + (row >> 2)) * 512 + (g * 4 + (row & 3)) * 64 + ch * 8) = v; }
      asm volatile("s_waitcnt lgkmcnt(0)" ::: "memory"); }
}

__device__ __forceinline__ float dpp_f(float v, int ctrl_sel) {
    const int x = __float_as_int(v);
    int r;
    if (ctrl_sel == 0) r = __builtin_amdgcn_update_dpp(x, x, 0xB1, 0xF, 0xF, false);
    else if (ctrl_sel == 1) r = __builtin_amdgcn_update_dpp(x, x, 0x4E, 0xF, 0xF, false);
    else if (ctrl_sel == 2) r = __builtin_amdgcn_update_dpp(x, x, 0x124, 0xF, 0xF, false);
    else r = __builtin_amdgcn_update_dpp(x, x, 0x128, 0xF, 0xF, false);
    return __int_as_float(r);
}
__device__ __forceinline__ int dpp_i(int x, int ctrl_sel) {
    if (ctrl_sel == 0) return __builtin_amdgcn_update_dpp(x, x, 0xB1, 0xF, 0xF, false);
    if (ctrl_sel == 1) return __builtin_amdgcn_update_dpp(x, x, 0x4E, 0xF, 0xF, false);
    if (ctrl_sel == 2) return __builtin_amdgcn_update_dpp(x, x, 0x124, 0xF, 0xF, false);
    return __builtin_amdgcn_update_dpp(x, x, 0x128, 0xF, 0xF, false);
}
__device__ __forceinline__ void select_wave(int t0w, const LAS float* imp, LAS int* sel, int lane) {
    const int sub = lane & 31;
#pragma unroll 1
    for (int h = 0; h < 4; ++h) {
        const int tk = 2 * h + (lane >> 5);
        const int tq = t0w + tk, cur = tq >> 6;
        float v[8];
#pragma unroll
        for (int i = 0; i < 8; ++i) { const int j = sub + 32 * i; float x = imp[tk * IMP_LD + j]; if (j == 0 || j == cur || j == cur - 1) x += 1e6f; v[i] = (j <= cur) ? x : -INFINITY; }
#pragma unroll 1
        for (int it = 0; it < 16; ++it) {
            float bv = v[0]; int bi = 0;
#pragma unroll
            for (int i = 1; i < 8; ++i) if (v[i] > bv) { bv = v[i]; bi = i; }
            float gm = bv;
#pragma unroll
            for (int c = 0; c < 4; ++c) gm = fmaxf(gm, dpp_f(gm, c));
            gm = fmaxf(gm, __shfl_xor(gm, 16));
            int cj = (bv == gm) ? sub + 32 * bi : 0x7fffffff;
#pragma unroll
            for (int c = 0; c < 4; ++c) cj = min(cj, dpp_i(cj, c));
            cj = min(cj, __shfl_xor(cj, 16));
            const bool any = gm > -INFINITY;
            if (sub == 0) sel[tk * 16 + it] = any ? cj : -1;
            if (any && (cj & 31) == sub) { const int wi = cj >> 5;
#pragma unroll
                for (int i = 0; i < 8; ++i) if (i == wi) v[i] = -INFINITY; }
        }
    }
    asm volatile("s_waitcnt lgkmcnt(0)" ::: "memory");
}

__device__ __forceinline__ void slc_wave(const MKP& p, int g, int t0w, const LAS int* sel, LAS float* oslc, int lane) {
    const int c16 = lane & 15, u = lane >> 4, ti = c16 >> 2;
    const unsigned char* kb = (const unsigned char*)p.KSLF + (size_t)g * 256 * 4096 + lane * 16;
    const unsigned char* vb = (const unsigned char*)p.VSLF + (size_t)g * 256 * 4096 + lane * 16;
#define LO64(vv_) ((long)(((unsigned long long)(vv_).y << 32) | (vv_).x))
#define HI64(vv_) ((long)(((unsigned long long)(vv_)[3] << 32) | (vv_).z))
#define FMFMA(a, b, c) __builtin_amdgcn_mfma_f32_16x16x32_fp8_fp8(a, b, c, 0, 0, 0)
#define KLOAD4(r_) do { _Pragma("unroll") for (int i_ = 0; i_ < 4; ++i_) { int b_ = sel[(tg * 4 + i_) * 16 + (r_)]; b_ = b_ < 0 ? 0 : b_; const unsigned char* kp_ = kb + (size_t)b_ * 4096; \
        _Pragma("unroll") for (int f_ = 0; f_ < 4; ++f_) kc[i_][f_] = *(const u32x4*)(kp_ + f_ * 1024); } } while (0)
#pragma unroll 1
    for (int tg = 0; tg < 2; ++tg) {
        const int tq = t0w + tg * 4 + ti;
        long qa, qb2;
        { const bf16_t* qp = p.QN + (size_t)tq * 512 + (g * 4 + (c16 & 3)) * 64 + 8 * u;
          const u32x4 r0 = *(const u32x4*)qp, r1 = *(const u32x4*)(qp + 32);
          const unsigned a0 = pk4_fp8(8.f * __uint_as_float(r0.x << 16), 8.f * __uint_as_float(r0.x & 0xffff0000u), 8.f * __uint_as_float(r0.y << 16), 8.f * __uint_as_float(r0.y & 0xffff0000u));
          const unsigned a1 = pk4_fp8(8.f * __uint_as_float(r0.z << 16), 8.f * __uint_as_float(r0.z & 0xffff0000u), 8.f * __uint_as_float(r0.w << 16), 8.f * __uint_as_float(r0.w & 0xffff0000u));
          const unsigned b0 = pk4_fp8(8.f * __uint_as_float(r1.x << 16), 8.f * __uint_as_float(r1.x & 0xffff0000u), 8.f * __uint_as_float(r1.y << 16), 8.f * __uint_as_float(r1.y & 0xffff0000u));
          const unsigned b1 = pk4_fp8(8.f * __uint_as_float(r1.z << 16), 8.f * __uint_as_float(r1.z & 0xffff0000u), 8.f * __uint_as_float(r1.w << 16), 8.f * __uint_as_float(r1.w & 0xffff0000u));
          qa = (long)(((unsigned long long)a1 << 32) | a0); qb2 = (long)(((unsigned long long)b1 << 32) | b0); }
        long q0[4], q1[4];
#pragma unroll
        for (int i = 0; i < 4; ++i) { q0[i] = (ti == i) ? qa : 0; q1[i] = (ti == i) ? qb2 : 0; }
        u32x4 kc[4][4], vf[4][4];
        KLOAD4(0);
        float m = -INFINITY, l = 0.f;
        f32x4 o[4]; o[0] = o[1] = o[2] = o[3] = (f32x4){0.f, 0.f, 0.f, 0.f};
#pragma unroll 1
        for (int r = 0; r < 16; ++r) {
#pragma unroll
            for (int i = 0; i < 4; ++i) { int b_ = sel[(tg * 4 + i) * 16 + r]; b_ = b_ < 0 ? 0 : b_; const unsigned char* vp = vb + (size_t)b_ * 4096;
#pragma unroll
                for (int dg = 0; dg < 4; ++dg) vf[i][dg] = *(const u32x4*)(vp + dg * 1024); }
            f32x4 s[4];
#pragma unroll
            for (int kg = 0; kg < 4; ++kg) { f32x4 c = (f32x4){0.f, 0.f, 0.f, 0.f};
#pragma unroll
                for (int i = 0; i < 4; ++i) { c = FMFMA(LO64(kc[i][kg]), q0[i], c); c = FMFMA(HI64(kc[i][kg]), q1[i], c); }
                s[kg] = c * 0.125f; }
            { const int rn = (r < 15) ? r + 1 : 15; KLOAD4(rn); }
            const int myblk = sel[(tg * 4 + ti) * 16 + r];
            { const int x = (myblk < 0) ? -1 : ((myblk == (tq >> 6)) ? tq - 64 * myblk - 4 * u : 64);
#pragma unroll
              for (int kg = 0; kg < 4; ++kg) { if (16 * kg > x) s[kg].x = -INFINITY; if (16 * kg + 1 > x) s[kg].y = -INFINITY; if (16 * kg + 2 > x) s[kg].z = -INFINITY; if (16 * kg + 3 > x) s[kg].w = -INFINITY; } }
            float tm = -INFINITY;
#pragma unroll
            for (int kg = 0; kg < 4; ++kg) tm = fmaxf(tm, fmaxf(fmaxf(s[kg].x, s[kg].y), fmaxf(s[kg].z, s[kg].w)));
            tm = fmaxf(tm, __shfl_xor(tm, 16)); tm = fmaxf(tm, __shfl_xor(tm, 32));
            float alpha = 1.f;
            if (tm > m) { alpha = __builtin_amdgcn_exp2f(m - tm); m = tm; }
            l *= alpha;
            float sum = 0.f;
#pragma unroll
            for (int kg = 0; kg < 4; ++kg) { s[kg].x = __builtin_amdgcn_exp2f(s[kg].x - m); s[kg].y = __builtin_amdgcn_exp2f(s[kg].y - m); s[kg].z = __builtin_amdgcn_exp2f(s[kg].z - m); s[kg].w = __builtin_amdgcn_exp2f(s[kg].w - m);
                sum += (s[kg].x + s[kg].y) + (s[kg].z + s[kg].w); }
            l += sum;
            { const float a0 = __shfl(alpha, 4 * u), a1 = __shfl(alpha, 4 * u + 1), a2 = __shfl(alpha, 4 * u + 2), a3 = __shfl(alpha, 4 * u + 3);
#pragma unroll
              for (int dg = 0; dg < 4; ++dg) { o[dg].x *= a0; o[dg].y *= a1; o[dg].z *= a2; o[dg].w *= a3; } }
#pragma unroll
            for (int ch = 0; ch < 2; ++ch) {
                const f32x4 pa_ = s[2 * ch] * 128.f, pb_ = s[2 * ch + 1] * 128.f;
                const unsigned lo_ = pk4_fp8(pa_.x, pa_.y, pa_.z, pa_.w), hi_ = pk4_fp8(pb_.x, pb_.y, pb_.z, pb_.w);
                const long pa = (long)(((unsigned long long)hi_ << 32) | lo_);
#pragma unroll
                for (int i = 0; i < 4; ++i) { const long pi = (ti == i) ? pa : 0;
#pragma unroll
                    for (int dg = 0; dg < 4; ++dg) o[dg] = FMFMA(pi, ch ? HI64(vf[i][dg]) : LO64(vf[i][dg]), o[dg]); }
            }
        }
        { float lt = l; lt += __shfl_xor(lt, 16); lt += __shfl_xor(lt, 32);
          const float il = (lt > 0.f) ? (1.f / 128.f) / lt : 0.f;
          const float i0 = __shfl(il, 4 * u), i1 = __shfl(il, 4 * u + 1), i2 = __shfl(il, 4 * u + 2), i3 = __shfl(il, 4 * u + 3);
          LAS float* op = oslc + (tg * 4 + u) * 256 + c16;
#pragma unroll
          for (int dg = 0; dg < 4; ++dg) { op[16 * dg] = o[dg].x * i0; op[64 + 16 * dg] = o[dg].y * i1; op[128 + 16 * dg] = o[dg].z * i2; op[192 + 16 * dg] = o[dg].w * i3; } }
    }
#undef KLOAD4
#undef LO64
#undef HI64
#undef FMFMA
    asm volatile("s_waitcnt lgkmcnt(0)" ::: "memory");
    {
        const int tkl = lane >> 3, cc = (lane & 7) * 32, hh = cc >> 6;
        const int tq = t0w + tkl;
        const float* gt = p.GATES + (size_t)tq * 24 + (g * 4 + hh) * 3;
        const float gc = 1.f / (1.f + __expf(-gt[0])), gs = 1.f / (1.f + __expf(-gt[1])), gw = 1.f / (1.f + __expf(-gt[2]));
        const size_t col = (size_t)tq * 512 + g * 256 + cc;
        const LAS float* os = oslc + tkl * 256 + cc;
#pragma unroll
        for (int q = 0; q < 4; ++q) {
            const u32x4 wc = *(const u32x4*)(p.OCMP + col + 8 * q), ww = *(const u32x4*)(p.OWIN + col + 8 * q);
            const f32x4 sa = *(const LAS f32x4*)(os + 8 * q), sb = *(const LAS f32x4*)(os + 8 * q + 4);
            u32x4 r;
            r.x = cvtpk(gs * sa.x + gc * __uint_as_float(wc.x << 16) + gw * __uint_as_float(ww.x << 16), gs * sa.y + gc * __uint_as_float(wc.x & 0xffff0000u) + gw * __uint_as_float(ww.x & 0xffff0000u));
            r.y = cvtpk(gs * sa.z + gc * __uint_as_float(wc.y << 16) + gw * __uint_as_float(ww.y << 16), gs * sa.w + gc * __uint_as_float(wc.y & 0xffff0000u) + gw * __uint_as_float(ww.y & 0xffff0000u));
            r.z = cvtpk(gs * sb.x + gc * __uint_as_float(wc.z << 16) + gw * __uint_as_float(ww.z << 16), gs * sb.y + gc * __uint_as_float(wc.z & 0xffff0000u) + gw * __uint_as_float(ww.z & 0xffff0000u));
            r.w = cvtpk(gs * sb.z + gc * __uint_as_float(wc.w << 16) + gw * __uint_as_float(ww.w << 16), gs * sb.w + gc * __uint_as_float(wc.w & 0xffff0000u) + gw * __uint_as_float(ww.w & 0xffff0000u));
            *(u32x4*)(p.OATT + (size_t)tq * 1024 + g * 256 + cc + 8 * q) = r;
        }
    }
}

__device__ __forceinline__ void nsa_unit(const MKP& p, char* shm, int g, int tile) {
    int tid_ = threadIdx.x; asm volatile("" : "+v"(tid_));
    const int tid = tid_, lane = tid & 63, r32 = lane & 31; const int wid = __builtin_amdgcn_readfirstlane(tid >> 6);
    const int t0 = tile * 64;
    {   att::UnitArgs A;
        A.qrow = p.QN + (size_t)(t0 + 8 * wid + (r32 >> 2)) * 512 + (g * 4 + (r32 & 3)) * 64;
        A.K = p.KV6 + (size_t)(4 * 2 + g) * S_ * 64; A.V = p.KV6 + (size_t)(5 * 2 + g) * S_ * 64; A.kvpitch = 64; A.vpitch = 64;
        A.obase = p.OWIN + (size_t)t0 * 512 + g * 256; A.opitch = 512;
        A.qtok = 8 * wid + (r32 >> 2); A.abase = tile;
        const int real = (tile + 1 < 9) ? tile + 1 : 9; int nt = (real + 1) & ~1; if (nt < 4) nt = 4;
        A.nsteps = nt; A.bias = nullptr;
        att::attn_unit<att::MODE_WIN, true, 8, 64>(A, shm);
    }
    LAS unsigned char* l3 = (LAS unsigned char*)shm;
    LAS float* imp = (LAS float*)(l3 + wid * (8 * IMP_LD * 4));
    LAS int* sel = (LAS int*)(l3 + 8 * (8 * IMP_LD * 4) + wid * 512);
    LAS unsigned char* stg = l3 + 8 * (8 * IMP_LD * 4) + 8 * 512 + wid * 4096;
    const int t0w = t0 + 8 * wid;
    { int ln = lane; asm volatile("" : "+v"(ln)); cmp_wave(p, g, t0w, imp, stg, ln); }
    asm volatile("s_waitcnt vmcnt(0) lgkmcnt(0)" ::: "memory");
    { int ln = lane; asm volatile("" : "+v"(ln)); select_wave(t0w, imp, sel, ln); }
    { int ln = lane; asm volatile("" : "+v"(ln)); slc_wave(p, g, t0w, sel, imp, ln); }
    asm volatile("s_waitcnt vmcnt(0) lgkmcnt(0)\n\ts_barrier" ::: "memory");
}
#undef NMFMA32
#undef NMFMA16
#undef RLF
}

__device__ __forceinline__ void phase_prologue(const MKP& p, LAS unsigned char* lds) {
    const int tid = threadIdx.x, lane = tid & 63, wave = tid >> 6;
    const int gw = blockIdx.x * 8 + wave, NGW = gridDim.x * 8;
    LAS float* scr = (LAS float*)(lds + wave * 16384);
    for (int it = gw; it < 8 * 192; it += NGW) {
        const int kc = it / 192, ch = it % 192, idx = ch * 64 + lane, l = idx / 6144, n = idx % 6144;
        const float* w = p.in[5] + (size_t)l * 1024 * 6144 + n;
        const float* c = p.in[1];
        float acc = 0.f;
#pragma unroll 8
        for (int k = kc * 128; k < kc * 128 + 128; ++k) { const float cv = c[k]; acc += (cv / (1.f + __expf(-cv))) * w[(size_t)k * 6144]; }
        p.modpart[kc * 12288 + idx] = acc;
    }
    if (blockIdx.x == 1 && tid < 128) p.gcnt[tid] = 0;
    if (blockIdx.x == 0 && tid < 96 + 48 + 64) {
        BlkDesc d; d.dst = nullptr; d.gain = nullptr; d.pitch = 0; d.flags = 4; d.scale = 1.f; d.csoff = 0;
        if (tid < 96) {
            const int blk = (tid >> 3) * 4 + ((tid >> 2) & 1) * 2 + ((tid >> 1) & 1);
            d.flags = 0;
            if (blk < 8) { d.dst = p.QN + blk * 64; d.pitch = 512; d.gain = p.in[9]; d.flags = 1; d.scale = C2Q; }
            else if (blk < 20) { const int j = (blk - 8) >> 1, g = (blk - 8) & 1; d.dst = p.KV6 + (size_t)(j * 2 + g) * S_ * 64; d.pitch = 64;
                d.gain = (j == 2 || j == 4) ? p.in[10] : nullptr; d.flags = (j == 0 || j == 2 || j == 4) ? 1 : 0; }
            else if (blk < 28) { d.dst = p.FQ + (blk - 20) * 64; d.pitch = 512; d.gain = p.in[13]; d.scale = C2Q; }
            else if (blk < 36) { d.dst = p.FK + (blk - 28) * 64; d.pitch = 512; d.gain = p.in[14]; }
            else if (blk < 44) { d.dst = p.FV + (blk - 36) * 64; d.pitch = 512; }
            else if (blk == 44) d.flags = 2;
            else d.flags = 4;
            p.desc0[tid] = d;
        } else if (tid < 96 + 48) {
            const int e = tid - 96, pn = e >> 3, bj = (e >> 2) & 1, wc = e & 3;
            if (pn < 4) { const int h = pn * 4 + bj * 2 + (wc >> 1); d.dst = p.Q96 + (size_t)h * S_ * 96; d.pitch = 96; d.gain = p.in[21]; d.flags = 0; d.scale = C2M; }
            else { const int h = (pn - 4) * 8 + bj * 4 + wc; d.dst = p.Q96 + (size_t)h * S_ * 96 + 64; d.pitch = 96; d.gain = p.in[23]; d.flags = 1 | 8; d.scale = C2M; d.csoff = 32; }
            p.desc_uq[e] = d;
        } else {
            const int e = tid - 144, pn = e >> 3, bj = (e >> 2) & 1, wc = e & 3;
            const int h = (pn & 3) * 4 + bj * 2 + (wc >> 1);
            if (pn < 4) { d.dst = p.K96 + (size_t)h * S_ * 96; d.pitch = 96; d.gain = p.in[22]; d.flags = 32; }
            else { d.dst = p.V1 + (size_t)h * S_ * 64; d.pitch = 64; d.gain = nullptr; d.flags = 64; }
            p.desc_ukv[e] = d;
        }
    }
    if (blockIdx.x == 2 || blockIdx.x == 3) {
        const int kv = blockIdx.x - 2, e = tid & 63, sl = tid >> 6;
        const float* w = p.in[12] + (size_t)kv * 2048 * 64 + e; const float* pe = p.in[11] + kv * 2048;
        float b = 0.f;
#pragma unroll 8
        for (int k = sl * 256; k < sl * 256 + 256; ++k) b += pe[k] * w[(size_t)k * 64];
        LAS float* red = (LAS float*)(lds + 140000);
        red[tid] = b;
        __syncthreads();
        if (tid < 64) { float a = 0.f;
#pragma unroll
            for (int q = 0; q < 8; ++q) a += red[q * 64 + tid];
            p.CBIAS[kv * 64 + tid] = a; }
    }
    for (int idx = blockIdx.x * MK_THREADS + tid; idx < S_ * 48; idx += gridDim.x * MK_THREADS) {
        const int t = idx / 48, i = idx % 48;
        const double ex = (i < 32) ? (double)(2 * i) / 64.0 : (double)(2 * (i - 32)) / 32.0;
        const double a = (double)p.pos[t] * exp(-ex * 9.210340371976184);
        const double r = a - rint(a * 0.15915494309189535) * 6.283185307179586;
        const float rf = (float)r;
        p.cosT[idx] = cosf(rf); p.sinT[idx] = sinf(rf);
    }
    for (int it = gw; it < 2 * 32 * 2; it += NGW) { const int kv = it >> 6, r = it & 63; tr_item(p.in[12] + (size_t)kv * 2048 * 64, 64, 2048, p.WcT + (size_t)kv * 64 * 2048, scr, r >> 1, r & 1, lane, MapId(), nullptr); }
    constexpr int I_IN0 = 16 * 96, I_OUT0 = 16 * 32, I_IN1 = 16 * 24, I_UQ = 6 * 48, I_UKV = 4 * 64, I_OUT1 = 16 * 32;
    for (int it = gw; it < I_IN0 + I_OUT0 + I_IN1 + I_UQ + I_UKV + I_OUT1; it += NGW) {
        int r = it;
        if (r < I_IN0) { tr_item(p.in[7], HYIN, 1024, p.W_in0t, scr, r / 96, r % 96, lane, MapIn0(), nullptr); continue; } r -= I_IN0;
        if (r < I_OUT0) { tr_item(p.in[15], 1024, 1024, p.W_out0t, scr, r / 32, r % 32, lane, MapId(), nullptr); continue; } r -= I_OUT0;
        if (r < I_IN1) { tr_item(p.in[16], 672, 1024, p.W_in1t, scr, r / 24, r % 24, lane, MapIn1(), nullptr); continue; } r -= I_IN1;
        if (r < I_UQ) { tr_item(p.in[19], 1536, 384, p.W_uqt, scr, r / 48, r % 48, lane, MapUq(), p.in[17]); continue; } r -= I_UQ;
        if (r < I_UKV) { tr_item(p.in[20], 2048, 256, p.W_ukvt, scr, r / 64, r % 64, lane, MapUkv(), p.in[18]); continue; } r -= I_UKV;
        tr_item(p.in[25], 1024, 1024, p.W_out1t, scr, r / 32, r % 32, lane, MapId(), nullptr);
    }
}

template <bool COMB>
__device__ __forceinline__ void phase_norm(const MKP& p, LAS unsigned char* lds, const float* x, const float* gw_, int layer, int sc_idx, int sh_idx, bool finalize_mod) {
    const int tid = threadIdx.x, lane = tid & 63, wave = tid >> 6;
    LAS float* msc = (LAS float*)(lds + LDS_MOD);
    LAS float* msh = msc + 1024;
    const float* b_ada = p.in[6];
    if (finalize_mod) {
        for (int i = tid; i < 2048; i += MK_THREADS) {
            const int idx = layer * 6144 + ((i < 1024) ? sc_idx * 1024 + i : sh_idx * 1024 + (i - 1024));
            float a = b_ada[idx];
#pragma unroll
            for (int kc = 0; kc < 8; ++kc) a += p.modpart[kc * 12288 + idx];
            msc[i] = a;
        }
        for (int idx = blockIdx.x * MK_THREADS + tid; idx < 12288; idx += gridDim.x * MK_THREADS) {
            float a = b_ada[idx];
#pragma unroll
            for (int kc = 0; kc < 8; ++kc) a += p.modpart[kc * 12288 + idx];
            p.mod[idx] = a;
        }
    } else {
        for (int i = tid; i < 2048; i += MK_THREADS)
            msc[i] = p.mod[layer * 6144 + ((i < 1024) ? sc_idx * 1024 + i : sh_idx * 1024 + (i - 1024))];
    }
    __syncthreads();
    const int gwv = blockIdx.x * 8 + wave, NGW = gridDim.x * 8;
    for (int m = gwv; m < S_; m += NGW) {
        const f32x4* xr = (const f32x4*)(x + (size_t)m * D_) + lane;
        f32x4 v[4]; float s = 0.f;
#pragma unroll
        for (int j = 0; j < 4; ++j) {
            v[j] = xr[64 * j];
            if (COMB) {
                f32x4 ys = (f32x4){0.f, 0.f, 0.f, 0.f};
#pragma unroll
                for (int k = 0; k < 8; ++k) {
                    const int w = *((const int*)((const char*)p.YBUF + ((size_t)m * 8 + k) * 1024) + lane + 64 * j);
                    const f32x2 lo = __builtin_amdgcn_cvt_pk_f32_fp8(w, false), hi = __builtin_amdgcn_cvt_pk_f32_fp8(w, true);
                    ys.x += lo.x; ys.y += lo.y; ys.z += hi.x; ys.w += hi.y;
                }
                { const u32x2 sw = *((const u32x2*)(p.YS + (size_t)m * 1024) + lane + 64 * j);
                  ys.x += 16.f * __uint_as_float(sw.x << 16); ys.y += 16.f * __uint_as_float(sw.x & 0xffff0000u); ys.z += 16.f * __uint_as_float(sw.y << 16); ys.w += 16.f * __uint_as_float(sw.y & 0xffff0000u); }
                const f32x4 g2v = *(const f32x4*)(p.mod + (layer - 1) * 6144 + 5 * 1024 + 256 * j + 4 * lane) * (1.f / 16.f);
                v[j] = v[j] + g2v * ys;
                ((f32x4*)(p.out + (size_t)m * D_) + lane)[64 * j] = v[j];
            }
            s += (v[j].x * v[j].x + v[j].y * v[j].y) + (v[j].z * v[j].z + v[j].w * v[j].w);
        }
        s = wsum(s);
        const float rstd = rsqrtf(s * (1.f / D_) + EPSF);
        u32x2* o8 = (u32x2*)(p.XN + (size_t)m * D_) + lane;
#pragma unroll
        for (int j = 0; j < 4; ++j) {
            const int c0 = 256 * j + 4 * lane;
            const f32x4 g = *(const f32x4*)(gw_ + c0);
            const f32x4 sc = *(const LAS f32x4*)(msc + c0), sh = *(const LAS f32x4*)(msh + c0);
            const f32x4 y = v[j] * rstd * g * (sc + 1.f) + sh;
            u32x2 w; w.x = cvtpk(y.x, y.y); w.y = cvtpk(y.z, y.w);
            o8[64 * j] = w;
        }
    }
}

struct EpiResid {
    static constexpr bool PERM = true;
    const float* xin; float* out; const float* gate;
    __device__ __forceinline__ void operator()(const f32x4 (&acc)[2][2][4][2], const pg::Unit& u, int wid, int wr, int wc, int fr_, int fq_) const {
        int fr = fr_, fq = fq_; asm volatile("" : "+v"(fr), "+v"(fq));
        const int col0 = u.pn * 256 + wc * 32 + 8 * fq;
        f32x4 g[2][2];
#pragma unroll
        for (int bj = 0; bj < 2; ++bj)
#pragma unroll
            for (int n = 0; n < 2; ++n) g[bj][n] = *(const f32x4*)(gate + col0 + bj * 128 + n * 4);
#pragma unroll
        for (int ai = 0; ai < 2; ++ai)
#pragma unroll
            for (int m = 0; m < 4; ++m) {
                const size_t off = (size_t)(u.pm * 256 + ai * 128 + wr * 64 + m * 16 + fr) * 1024 + col0;
#pragma unroll
                for (int bj = 0; bj < 2; ++bj)
#pragma unroll
                    for (int n = 0; n < 2; ++n) {
                        const f32x4 xv = *(const f32x4*)(xin + off + bj * 128 + n * 4);
                        *(f32x4*)(out + off + bj * 128 + n * 4) = xv + g[bj][n] * acc[ai][bj][m][n];
                    }
                asm volatile("" ::: "memory");
            }
    }
};

struct EpiHeads {
    static constexpr bool PERM = false;
    const BlkDesc* tab; const float* cosT; const float* sinT; float* GATES; float* LOGF; LAS float* X;
    __device__ __forceinline__ void operator()(const f32x4 (&acc)[2][2][4][2], const pg::Unit& u, int wid, int wr, int wc, int fr_, int fq_) const {
        int fr = fr_, fq = fq_; asm volatile("" : "+v"(fr), "+v"(fq));
        const int w1 = wc & 1;
#pragma unroll
        for (int ai = 0; ai < 2; ++ai)
#pragma unroll
            for (int bj = 0; bj < 2; ++bj)
#pragma unroll
                for (int m = 0; m < 4; ++m) {
                    const f32x4 a = acc[ai][bj][m][0], b = acc[ai][bj][m][1];
                    float s = (a.x * a.x + a.y * a.y) + (a.z * a.z + a.w * a.w) + (b.x * b.x + b.y * b.y) + (b.z * b.z + b.w * b.w);
                    s += __shfl_xor(s, 16); s += __shfl_xor(s, 32);
                    if (fq == 0) X[wid * 256 + ((ai * 2 + bj) * 4 + m) * 16 + fr] = s;
                }
        asm volatile("s_waitcnt lgkmcnt(0)" ::: "memory"); __builtin_amdgcn_s_barrier(); asm volatile("" ::: "memory");
#pragma unroll
        for (int bj = 0; bj < 2; ++bj) {
            const BlkDesc d = tab[8 * u.pn + 4 * bj + wc];
            const int row0 = u.pm * 256 + wr * 64 + fr;
            if (d.flags & 4) continue;
            if (d.flags & 2) {
                if (w1 == 0) {
#pragma unroll
                    for (int ai = 0; ai < 2; ++ai)
#pragma unroll
                        for (int m = 0; m < 4; ++m) {
                            const int row = row0 + ai * 128 + m * 16;
#pragma unroll
                            for (int n = 0; n < 2; ++n) {
                                const f32x4 v = acc[ai][bj][m][n];
                                const int pc = 16 * n + 4 * fq;
                                if (pc < 24) *(f32x4*)(GATES + (size_t)row * 24 + pc) = v;
                                else *(f32x4*)(LOGF + (size_t)row * 8 + (pc - 24)) = v;
                            }
                            asm volatile("" ::: "memory");
                        }
                }
                continue;
            }
            const bool half = (d.flags & 8) != 0, has_gain = d.gain != nullptr, rope = (d.flags & 1) != 0;
            const int d0 = half ? 4 * fq : 16 * w1 + 4 * fq;
            const int dn1 = half ? 16 : 32;
            const float invn = half ? (1.f / 32.f) : (1.f / 64.f);
            const GAS float* gp = (const GAS float*)(has_gain ? d.gain : cosT);
            f32x4 g0 = *(const GAS f32x4*)(gp + d0), g1 = *(const GAS f32x4*)(gp + dn1 + d0);
            if (!has_gain) { g0 = (f32x4){1.f, 1.f, 1.f, 1.f}; g1 = g0; }
            g0 = g0 * d.scale; g1 = g1 * d.scale;
            const int cso = d.csoff + d0;
#pragma unroll
            for (int ai = 0; ai < 2; ++ai)
#pragma unroll
                for (int m = 0; m < 4; ++m) {
                    const int row = row0 + ai * 128 + m * 16;
                    const int xi = ((ai * 2 + bj) * 4 + m) * 16 + fr;
                    float ssq = X[wid * 256 + xi]; const float ssp = X[(wid ^ 1) * 256 + xi];
                    if (!half) ssq += ssp;
                    const float rs = has_gain ? rsqrtf(ssq * invn + EPSF) : 1.f;
                    f32x4 x1 = acc[ai][bj][m][0] * rs * g0, x2 = acc[ai][bj][m][1] * rs * g1;
                    f32x4 c = *(const f32x4*)(cosT + (size_t)row * 48 + cso), sn = *(const f32x4*)(sinT + (size_t)row * 48 + cso);
                    if (!rope) { c = (f32x4){1.f, 1.f, 1.f, 1.f}; sn = (f32x4){0.f, 0.f, 0.f, 0.f}; }
                    const f32x4 o1 = x1 * c - x2 * sn, o2 = x2 * c + x1 * sn;
                    u32x2 wa, wb; wa.x = cvtpk(o1.x, o1.y); wa.y = cvtpk(o1.z, o1.w); wb.x = cvtpk(o2.x, o2.y); wb.y = cvtpk(o2.z, o2.w);
                    if (d.flags & 32) {
                        GAS bf16_t* tb = (GAS bf16_t*)d.dst + (size_t)(row >> 6) * 6144 + (row & 63) * 8 + (d0 & 7);
                        *(GAS u32x2*)(tb + (d0 >> 3) * 512) = wa; *(GAS u32x2*)(tb + ((dn1 + d0) >> 3) * 512) = wb;
                    } else if (d.flags & 64) {
                        GAS bf16_t* tb = (GAS bf16_t*)d.dst + (size_t)(row >> 6) * 4096 + ((row >> 4) & 3) * 512 + (row & 15) * 32 + (d0 & 7);
                        *(GAS u32x2*)(tb + (d0 >> 5) * 2048 + ((d0 >> 3) & 3) * 8) = wa; *(GAS u32x2*)(tb + ((dn1 + d0) >> 5) * 2048 + (((dn1 + d0) >> 3) & 3) * 8) = wb;
                    } else {
                        GAS bf16_t* dr = (GAS bf16_t*)d.dst + (size_t)row * d.pitch + d0;
                        *(GAS u32x2*)dr = wa; *(GAS u32x2*)(dr + dn1) = wb;
                    }
                    asm volatile("" ::: "memory");
                }
        }
    }
};

struct EpiPlain {
    static constexpr bool PERM = true;
    bf16_t* O; int ldc;
    __device__ __forceinline__ void operator()(const f32x4 (&acc)[2][2][4][2], const pg::Unit& u, int wid, int wr, int wc, int fr_, int fq_) const {
        int fr = fr_, fq = fq_; asm volatile("" : "+v"(fr), "+v"(fq));
        const int col0 = u.pn * 256 + wc * 32 + 8 * fq;
#pragma unroll
        for (int ai = 0; ai < 2; ++ai)
#pragma unroll
            for (int m = 0; m < 4; ++m) {
                bf16_t* rp = O + (size_t)(u.pm * 256 + ai * 128 + wr * 64 + m * 16 + fr) * ldc + col0;
#pragma unroll
                for (int bj = 0; bj < 2; ++bj) { const f32x4 a = acc[ai][bj][m][0], b = acc[ai][bj][m][1];
                    u32x4 w; w.x = cvtpk(a.x, a.y); w.y = cvtpk(a.z, a.w); w.z = cvtpk(b.x, b.y); w.w = cvtpk(b.z, b.w); *(u32x4*)(rp + bj * 128) = w; }
            }
    }
};

__device__ __forceinline__ void phase_post1a(const MKP& p) {
    int tid_ = threadIdx.x; asm volatile("" : "+v"(tid_));
    const int tid = tid_, lane = tid & 63, wave = tid >> 6;
    const int gwv = blockIdx.x * 8 + wave, NGW = gridDim.x * 8;
    for (int t = gwv; t < S_; t += NGW) {
        const u32x2* row = (const u32x2*)(p.P1 + (size_t)t * 768);
        f32x4 v[3]; float sq = 0.f, skv = 0.f, skr = 0.f;
#pragma unroll
        for (int j = 0; j < 3; ++j) {
            const int g = lane + 64 * j;
            f32x4 x = (f32x4){0.f, 0.f, 0.f, 0.f};
            if (g < 168) { const u32x2 w = row[g]; x.x = __uint_as_float(w.x << 16); x.y = __uint_as_float(w.x & 0xffff0000u); x.z = __uint_as_float(w.y << 16); x.w = __uint_as_float(w.y & 0xffff0000u); }
            v[j] = x;
            const float s = (x.x * x.x + x.y * x.y) + (x.z * x.z + x.w * x.w);
            if (g < 96) sq += s; else if (g < 160) skv += s; else skr += s;
        }
        sq = wsum(sq); skv = wsum(skv); skr = wsum(skr);
        const float rq = rsqrtf(sq * (1.f / 384.f) + EPSF), rkv = rsqrtf(skv * (1.f / 256.f) + EPSF), rkr = rsqrtf(skr * (1.f / 32.f) + EPSF);
#pragma unroll
        for (int j = 0; j < 3; ++j) {
            const int g = lane + 64 * j;
            if (g < 96) { const f32x4 y = v[j] * rq; u32x2 w; w.x = cvtpk(y.x, y.y); w.y = cvtpk(y.z, y.w); *(u32x2*)(p.CQN + (size_t)t * 384 + 4 * g) = w; }
            else if (g < 160) { const f32x4 y = v[j] * rkv; u32x2 w; w.x = cvtpk(y.x, y.y); w.y = cvtpk(y.z, y.w); *(u32x2*)(p.CKVN + (size_t)t * 256 + 4 * (g - 96)) = w; }
        }
        {
            const int dl = (lane - 32) & 7;
            const int dd = 4 * dl;
            const int fi = 4 * (dl & 3);
            f32x4 x = v[2] * rkr;
            const f32x4 gn = *(const f32x4*)(p.in[24] + (dd & 31));
            x = x * gn;
            f32x4 o; o.x = __shfl_xor(x.x, 4); o.y = __shfl_xor(x.y, 4); o.z = __shfl_xor(x.z, 4); o.w = __shfl_xor(x.w, 4);
            const f32x4 c = *(const f32x4*)(p.cosT + (size_t)t * 48 + 32 + fi), sn = *(const f32x4*)(p.sinT + (size_t)t * 48 + 32 + fi);
            const f32x4 y = (dl < 4) ? (x * c - o * sn) : (x * c + o * sn);
            if (lane >= 32 && lane < 40) {
                u32x2 w; w.x = cvtpk(y.x, y.y); w.y = cvtpk(y.z, y.w);
#pragma unroll
                for (int h = 0; h < 16; ++h) *(u32x2*)(p.K96 + (size_t)h * S_ * 96 + (size_t)(t >> 6) * 6144 + (8 + (dd >> 3)) * 512 + (t & 63) * 8 + (dd & 7)) = w;
            }
        }
    }
}

__device__ __forceinline__ void mla_unit(const MKP& p, char* shm, int h, int qb) {
    int tid_ = threadIdx.x; asm volatile("" : "+v"(tid_));
    const int tid = tid_, lane = tid & 63, r32 = lane & 31; const int wid = __builtin_amdgcn_readfirstlane(tid >> 6);
    const int q0 = qb * 256;
    att::UnitArgs A;
    A.qrow = p.Q96 + ((size_t)h * S_ + q0 + 32 * wid + r32) * 96;
    A.K = p.K96 + (size_t)h * S_ * 96; A.kvpitch = 96; A.V = p.V1 + (size_t)h * S_ * 64; A.vpitch = 64;
    A.obase = p.OATT + (size_t)q0 * 1024 + h * 64; A.opitch = 1024;
    A.qtok = 32 * wid + r32; A.abase = 4 * qb; A.nsteps = 4 * qb + 4; A.bias = nullptr;
    att::attn_unit<att::MODE_CAUSAL, false, 8, 96, true>(A, shm);
}
__device__ __forceinline__ void phase_mla(const MKP& p, char* shm) {
    const int G = gridDim.x, bx = blockIdx.x;
    const int vcu = (G % 8 == 0) ? (bx % 8) * (G / 8) + bx / 8 : bx;
    for (int u = vcu; u < 256; u += G) {
        const int h = u >> 4, s = u & 15;
#pragma unroll 1
        for (int rep = 0; rep < 4; ++rep) mla_unit(p, shm, h, rep == 0 ? s : rep == 1 ? 31 - s : rep == 2 ? 32 + s : 63 - s);
    }
}

__device__ __forceinline__ void phase_scan(const MKP& p, LAS unsigned char* lds) {
    constexpr int NSB = 64;
    if (blockIdx.x >= NSB) {
        int tid_ = threadIdx.x; asm volatile("" : "+v"(tid_));
        const int lane = tid_ & 63, wave = tid_ >> 6;
        const int sb = blockIdx.x - NSB, NSBK = gridDim.x - NSB;
        LAS float* scr = (LAS float*)(lds + 65536 + wave * 256);
        for (int bj = sb; bj < 64; bj += NSBK) nsa::compress_job(p, scr, (LAS float*)(lds + (wave >> 2) * 32768) + (wave & 3) * 2048, 2 * bj + (wave >> 2), wave & 3, lane);
        for (int j = ((sb + NSBK - 64) % NSBK) * 8 + wave; j < 512; j += NSBK * 8) nsa::slcfrag_job(p, j, lane);
        return;
    }
    const int h = blockIdx.x >> 3, seg = blockIdx.x & 7, tid = threadIdx.x;
    LAS double* part = (LAS double*)lds;
    const float fb = p.in[8][h];
    double own[4], s = 0.0, pre = 0.0;
#pragma unroll
    for (int i = 0; i < 4; ++i) { own[i] = (double)logsigmf(p.LOGF[(size_t)(seg * 2048 + tid * 4 + i) * 8 + h] + fb); s += own[i]; }
    for (int i = tid; i < seg * 2048; i += MK_THREADS) pre += (double)logsigmf(p.LOGF[(size_t)i * 8 + h] + fb);
    part[tid] = s; part[512 + tid] = pre;
    __syncthreads();
    for (int o = 1; o < MK_THREADS; o <<= 1) {
        const double v = (tid >= o) ? part[tid - o] : 0.0, w = (tid >= o) ? part[512 + tid - o] : 0.0;
        __syncthreads();
        part[tid] += v; part[512 + tid] += w;
        __syncthreads();
    }
    double a = part[512 + MK_THREADS - 1] + ((tid > 0) ? part[tid - 1] : 0.0);
#pragma unroll
    for (int i = 0; i < 4; ++i) { a += own[i]; p.CUMB[(size_t)h * S_ + seg * 2048 + tid * 4 + i] = (float)(a * 1.4426950408889634); }
}

__device__ __forceinline__ void fox_unit(const MKP& p, char* shm, int h, int qb) {
    int tid_ = threadIdx.x; asm volatile("" : "+v"(tid_));
    const int tid = tid_, lane = tid & 63, r32 = lane & 31; const int wid = __builtin_amdgcn_readfirstlane(tid >> 6);
    const int q0 = qb * 256, abase = 4 * qb;
    const float* cb = p.CUMB + (size_t)h * S_;
    LAS float* bias = (LAS float*)(LAS unsigned char*)(shm + att::LDS_BIAS);
    LAS int* cnt = (LAS int*)(LAS unsigned char*)(shm + att::Geo<64>::LDS_WS);
    float gq = 0.f, gk = 0.f;
    for (int i = 0; i < 64; ++i) { gq = fmaxf(gq, fabsf(p.in[13][i])); gk = fmaxf(gk, fabsf(p.in[14][i])); }
    const float TH = 150.f + 2.f * (64.f * gq * gk * C2Q * 1.05f);
    const float c0 = cb[q0], cref = cb[q0 + 255];
    const bool skip = (tid < abase) && (cb[64 * tid + 63] - c0 > TH);
    const unsigned long long bal = __ballot(skip);
    if (lane == 0) cnt[wid] = __popcll(bal);
    __syncthreads();
    int alo = 0;
#pragma unroll
    for (int w = 0; w < 8; ++w) alo += cnt[w];
    int NT = abase + 4 - alo;
    if (NT & 1) { alo -= 1; NT += 1; }
    for (int i = tid; i < NT * 64; i += MK_THREADS) bias[i] = cref - cb[64 * alo + i];
    __syncthreads();
    att::UnitArgs A;
    A.qrow = p.FQ + (size_t)(q0 + 32 * wid + r32) * 512 + h * 64;
    A.K = p.FK + h * 64; A.V = p.FV + h * 64; A.kvpitch = 512; A.vpitch = 512;
    A.obase = p.OATT + (size_t)q0 * 1024 + 512 + h * 64; A.opitch = 1024;
    A.qtok = 32 * wid + r32; A.abase = abase; A.nsteps = NT; A.bias = bias;
    att::attn_unit<att::MODE_FOX, false, 8, 64>(A, shm);
}
__device__ __forceinline__ void phase_fox(const MKP& p, char* shm, int part = 3) {
    const int G = gridDim.x, bx = blockIdx.x;
    const int vcu = (G % 8 == 0) ? (bx % 8) * (G / 8) + bx / 8 : bx;
    if (part & 1) for (int u = vcu; u < 256; u += G) {
        const int h = u >> 5, s = u & 31;
#pragma unroll 1
        for (int rep = 0; rep < 2; ++rep) fox_unit(p, shm, h, rep ? 63 - s : s);
    }
    if (part & 2) for (int u = vcu; u < 256; u += G) {
#pragma unroll 1
        for (int rep = 0; rep < 2; ++rep) nsa::nsa_unit(p, shm, rep, rep ? 255 - u : u);
    }
}


struct MapOff { int off; __device__ __forceinline__ int operator()(int nn) const { return off + (nn & 31); } };
__device__ __forceinline__ void phase_moe_weights(const MKP& p, LAS unsigned char* lds, int layer) {
    int tid_ = threadIdx.x; asm volatile("" : "+v"(tid_));
    const int tid = tid_, lane = tid & 63, wave = tid >> 6;
    const int gw = blockIdx.x * 8 + wave, NGW = gridDim.x * 8;
    LAS float* scr = (LAS float*)(lds + wave * 16384);
    constexpr int IG = 16 * 16, ID = 4 * 32, IE = IG + ID;
    for (int it = gw; it < 65 * IE; it += NGW) {
        const int e = it / IE; int r = it % IE;
        if (r < IG) {
            const int kb = r / 16, nb = r % 16;
            const int n0 = nb * 32, up = (n0 >> 7) & 1, f0 = (n0 >> 8) * 128 + (n0 & 127);
            const float* W = (e < 64) ? ((up ? p.in[29] : p.in[28]) + ((size_t)layer * 64 + e) * 1024 * 256) : ((up ? p.in[32] : p.in[31]) + (size_t)layer * 1024 * 256);
            MapOff mo{f0};
            tr_item(W, 256, 1024, p.Wgu + (size_t)e * 512 * 1024, scr, kb, nb, lane, mo, nullptr);
        } else {
            r -= IG; const int kb = r / 32, nb = r % 32;
            const float* W = (e < 64) ? (p.in[30] + ((size_t)layer * 64 + e) * 256 * 1024) : (p.in[33] + (size_t)layer * 256 * 1024);
            tr_item(W, 1024, 256, p.Wd + (size_t)e * 1024 * 256, scr, kb, nb, lane, MapId(), nullptr);
        }
    }
}

template <bool DRY>
__device__ __forceinline__ void phase_moe_route(const MKP& p, LAS unsigned char* lds, int layer) {
    int tid_ = threadIdx.x; asm volatile("" : "+v"(tid_));
    const int tid = tid_, lane = tid & 63, wave = tid >> 6;
    LAS float* msc = (LAS float*)(lds + LDS_MOD);
    LAS float* msh = msc + 1024;
    LAS float* hrow = (LAS float*)lds;
    LAS int* cntl = (LAS int*)(lds + LDS_X);
    LAS int* basel = cntl + 64;
    const float* gnorm = p.in[4] + layer * 1024;
    const float* wr = p.in[26] + (size_t)layer * 1024 * 64;
    const float rb = p.in[27][layer * 64 + lane];
    for (int i = tid; i < 2048; i += MK_THREADS) msc[i] = p.mod[layer * 6144 + ((i < 1024) ? 4 * 1024 + i : 3 * 1024 + (i - 1024))];
    __syncthreads();
    for (int batch = blockIdx.x; batch < S_ / 32; batch += gridDim.x) {
        if (tid < 64) cntl[tid] = 0;
#pragma unroll 1
        for (int i = 0; i < 4; ++i) {
            const int t = batch * 32 + wave * 4 + i;
            const f32x4* xr = (const f32x4*)(p.out + (size_t)t * D_) + lane;
            f32x4 v[4]; float s = 0.f;
#pragma unroll
            for (int j = 0; j < 4; ++j) { v[j] = xr[64 * j]; s += (v[j].x * v[j].x + v[j].y * v[j].y) + (v[j].z * v[j].z + v[j].w * v[j].w); }
            s = wsum(s);
            const float rstd = rsqrtf(s * (1.f / D_) + EPSF);
            u32x2* o8 = (u32x2*)(p.XN + (size_t)t * D_) + lane;
            LAS f32x4* hr = (LAS f32x4*)(hrow + (wave * 4 + i) * 1024) + lane;
#pragma unroll
            for (int j = 0; j < 4; ++j) {
                const int c0 = 256 * j + 4 * lane;
                const f32x4 g = *(const f32x4*)(gnorm + c0);
                const f32x4 sc = *(const LAS f32x4*)(msc + c0), sh = *(const LAS f32x4*)(msh + c0);
                const f32x4 y = v[j] * rstd * g * (sc + 1.f) + sh;
                u32x2 w; w.x = cvtpk(y.x, y.y); w.y = cvtpk(y.z, y.w);
                o8[64 * j] = w; hr[64 * j] = y;
            }
        }
        __syncthreads();
        float acc0 = 0.f, acc1 = 0.f, acc2 = 0.f, acc3 = 0.f;
        const LAS float* h0 = hrow + (wave * 4) * 1024;
#pragma unroll 4
        for (int k = 0; k < 1024; k += 4) {
            const float w0 = wr[(k + 0) * 64 + lane], w1 = wr[(k + 1) * 64 + lane], w2 = wr[(k + 2) * 64 + lane], w3 = wr[(k + 3) * 64 + lane];
            const f32x4 a = *(const LAS f32x4*)(h0 + k), b = *(const LAS f32x4*)(h0 + 1024 + k), c = *(const LAS f32x4*)(h0 + 2048 + k), d = *(const LAS f32x4*)(h0 + 3072 + k);
            acc0 += a.x * w0; acc0 += a.y * w1; acc0 += a.z * w2; acc0 += a.w * w3;
            acc1 += b.x * w0; acc1 += b.y * w1; acc1 += b.z * w2; acc1 += b.w * w3;
            acc2 += c.x * w0; acc2 += c.y * w1; acc2 += c.z * w2; acc2 += c.w * w3;
            acc3 += d.x * w0; acc3 += d.y * w1; acc3 += d.z * w2; acc3 += d.w * w3;
        }
        int myrank[4], mypos[4]; float myw[4];
#pragma unroll
        for (int i = 0; i < 4; ++i) {
            const float logit = (i == 0) ? acc0 : (i == 1) ? acc1 : (i == 2) ? acc2 : acc3;
            const float score = 1.f / (1.f + expf(-logit));
            const float sv = score + rb;
            float m1 = sv;
            m1 = fmaxf(m1, __shfl_xor(m1, 1)); m1 = fmaxf(m1, __shfl_xor(m1, 2)); m1 = fmaxf(m1, __shfl_xor(m1, 4));
            int am = (sv == m1) ? (lane & 7) : 8;
            am = min(am, __shfl_xor(am, 1)); am = min(am, __shfl_xor(am, 2)); am = min(am, __shfl_xor(am, 4));
            float m2 = ((lane & 7) == am) ? -INFINITY : sv;
            m2 = fmaxf(m2, __shfl_xor(m2, 1)); m2 = fmaxf(m2, __shfl_xor(m2, 2)); m2 = fmaxf(m2, __shfl_xor(m2, 4));
            const float gs = m1 + m2;
            const int gi = lane >> 3; int grank = 0;
#pragma unroll
            for (int gj = 0; gj < 8; ++gj) { const float o = __shfl(gs, gj * 8); grank += (o > gs || (o == gs && gj < gi)) ? 1 : 0; }
            const float msk = (grank < 4) ? sv : -1e30f;
            int rank = 0;
#pragma unroll 8
            for (int e = 0; e < 64; ++e) { const float o = __shfl(msk, e); rank += (o > msk || (o == msk && e < lane)) ? 1 : 0; }
            const bool selb = rank < 8;
            const float tot = wsum(selb ? score : 0.f);
            myrank[i] = selb ? rank : -1; myw[i] = score / tot * 2.5f;
            mypos[i] = (selb && !DRY) ? atomicAdd((int*)(cntl + lane), 1) : 0;
        }
        __syncthreads();
        if (tid < 64) basel[tid] = (cntl[tid] > 0 && !DRY) ? atomicAdd(p.gcnt + layer * 64 + tid, cntl[tid]) : 0;
        __syncthreads();
#pragma unroll
        for (int i = 0; i < 4; ++i) if (myrank[i] >= 0 && !DRY) {
            const int t = batch * 32 + wave * 4 + i, slot = t * 8 + myrank[i];
            p.list[(size_t)lane * 16384 + basel[lane] + mypos[i]] = slot;
            p.ew[slot] = myw[i];
        }
        __syncthreads();
    }
}

struct MoeSched {
    const char* A; const char* Bt; const int* list; const LAS int* ustart; const LAS int* hbase; const LAS int* cnt;
    int K, NP, G, c; bool gather; int nexp;
    __device__ __forceinline__ static void tables(LAS int* ustart, LAS int* hbase, LAS int* cnt, const int* gcnt, int NP) {
        const int tid = threadIdx.x;
        if (tid == 0) {
            int us = 0, hb = 0;
            for (int e = 0; e < 65; ++e) { const int c = (e < 64) ? gcnt[e] : S_; const int nrb = (c + 255) >> 8; cnt[e] = c; ustart[e] = us; hbase[e] = hb; us += nrb * NP; hb += nrb * 256; }
            ustart[65] = us; hbase[65] = hb;
        }
        __syncthreads();
    }
    __device__ __forceinline__ bool next(int i, pg::Unit& u, int R0, int C0) const {
        const int L = i * G + c; if (L >= ustart[nexp]) return false;
        const int lane = threadIdx.x & 63;
        const unsigned long long bal = __ballot(lane < 65 && ustart[lane] <= L);
        int e = __popcll(bal) - 1; if (ustart[64] <= L) e = 64;
        const int r = L - ustart[e], rb = r / NP, pn = r % NP;
        u.pm = (hbase[e] >> 8) + rb; u.pn = pn; u.aux = e | (rb << 8);
        u.B = Bt + ((size_t)e * NP + pn) * 256 * K * 2;
        if (gather) {
            u.A = A; const int ce = cnt[e];
#pragma unroll
            for (int q = 0; q < 4; ++q) { const int pos = rb * 256 + R0 + 64 * q; int tok = 0; if (pos < ce) tok = (e < 64) ? (list[(size_t)e * 16384 + pos] >> 3) : pos; u.ra[q] = (unsigned)(tok * K + C0) * 2u; }
        } else {
            u.A = A + (size_t)u.pm * 256 * K * 2;
#pragma unroll
            for (int q = 0; q < 4; ++q) u.ra[q] = (unsigned)((R0 + 64 * q) * K + C0) * 2u;
        }
        return true;
    }
};
struct EpiGateUp {
    static constexpr bool PERM = true;
    bf16_t* HID;
    __device__ __forceinline__ void operator()(const f32x4 (&acc)[2][2][4][2], const pg::Unit& u, int wid, int wr, int wc, int fr_, int fq_) const {
        int fr = fr_, fq = fq_; asm volatile("" : "+v"(fr), "+v"(fq));
        const int col0 = u.pn * 128 + wc * 32 + 8 * fq;
#pragma unroll
        for (int ai = 0; ai < 2; ++ai)
#pragma unroll
            for (int m = 0; m < 4; ++m) {
                bf16_t* rp = HID + (size_t)(u.pm * 256 + ai * 128 + wr * 64 + m * 16 + fr) * 256 + col0;
                float h[8];
#pragma unroll
                for (int n = 0; n < 2; ++n) {
                    const f32x4 g = acc[ai][0][m][n], up = acc[ai][1][m][n];
                    h[4 * n] = g.x / (1.f + __expf(-g.x)) * up.x; h[4 * n + 1] = g.y / (1.f + __expf(-g.y)) * up.y; h[4 * n + 2] = g.z / (1.f + __expf(-g.z)) * up.z; h[4 * n + 3] = g.w / (1.f + __expf(-g.w)) * up.w;
                }
                u32x4 w; w.x = cvtpk(h[0], h[1]); w.y = cvtpk(h[2], h[3]); w.z = cvtpk(h[4], h[5]); w.w = cvtpk(h[6], h[7]); *(u32x4*)rp = w;
            }
    }
};
struct EpiDown {
    static constexpr bool PERM = true;
    bf16_t* YBUF; const int* list; const float* ew; const LAS int* cnt;
    __device__ __forceinline__ void operator()(const f32x4 (&acc)[2][2][4][2], const pg::Unit& u, int wid, int wr, int wc, int fr_, int fq_) const {
        int fr = fr_, fq = fq_; asm volatile("" : "+v"(fr), "+v"(fq));
        const int e = u.aux & 0xff, rb = u.aux >> 8, ce = cnt[e];
        const unsigned colb = (unsigned)(u.pn * 256 + wc * 32 + 8 * fq);
        const int* le = list + (size_t)e * 16384 + rb * 256 + wr * 64 + fr;
        const int pos0 = rb * 256 + wr * 64 + fr;
        int slot[8]; float w[8];
#pragma unroll
        for (int i = 0; i < 8; ++i) { const int pr = (i >> 2) * 128 + (i & 3) * 16; slot[i] = (pos0 + pr < ce) ? le[pr] : -1; }
#pragma unroll
        for (int i = 0; i < 8; ++i) w[i] = (slot[i] >= 0) ? ew[slot[i]] : 0.f;
#pragma unroll
        for (int ai = 0; ai < 2; ++ai)
#pragma unroll
            for (int m = 0; m < 4; ++m) {
                const int i = ai * 4 + m;
                if (slot[i] >= 0) {
                    char* rp = (char*)YBUF + ((unsigned)slot[i] * 1024u + colb);
                    const float ws = w[i] * 16.f;
#pragma unroll
                    for (int bj = 0; bj < 2; ++bj) { const f32x4 a = acc[ai][bj][m][0] * ws, b = acc[ai][bj][m][1] * ws;
                        u32x2 o; o.x = nsa::pk4_fp8(a.x, a.y, a.z, a.w); o.y = nsa::pk4_fp8(b.x, b.y, b.z, b.w); *(u32x2*)(rp + bj * 128) = o; }
                }
            }
    }
};
__device__ __forceinline__ void phase_moe_gemm1(const MKP& p, LAS unsigned char* lds, int layer) {
    LAS int* tb = (LAS int*)(lds + LDS_X);
    MoeSched::tables(tb, tb + 66, tb + 132, p.gcnt + layer * 64, 2);
    const int G = gridDim.x, bx = blockIdx.x, vcu = (G % 8 == 0) ? (bx % 8) * (G / 8) + bx / 8 : bx;
    MoeSched S{(const char*)p.XN, (const char*)p.Wgu, p.list, tb, tb + 66, tb + 132, 1024, 2, G, vcu, true, 65};
    EpiGateUp E{p.HID};
    pg::gemm_run(lds, 1024, S, E);
}
__device__ __forceinline__ void phase_moe_gemm2(const MKP& p, LAS unsigned char* lds, int layer, int which = 3) {
    LAS int* tb = (LAS int*)(lds + LDS_X);
    MoeSched::tables(tb, tb + 66, tb + 132, p.gcnt + layer * 64, 4);
    const int G = gridDim.x, bx = blockIdx.x, vcu = (G % 8 == 0) ? (bx % 8) * (G / 8) + bx / 8 : bx;
    if (which & 1) { MoeSched S{(const char*)p.HID, (const char*)p.Wd, p.list, tb, tb + 66, tb + 132, 256, 4, G, vcu, false, 64};
      EpiDown E{p.YBUF, p.list, p.ew, tb + 132};
      pg::gemm_run(lds, 256, S, E); }
    if (which & 2) {
      pg::DenseSched S; S.init(p.HID + (size_t)tb[66 + 64] * 256, p.Wd + (size_t)64 * 1024 * 256, S_, 1024, 256, G, bx);
      EpiPlain E{p.YS, 1024};
      pg::gemm_run(lds, 256, S, E); }
}
__device__ __forceinline__ void phase_moe_combine(const MKP& p, int layer) {
    int tid_ = threadIdx.x; asm volatile("" : "+v"(tid_));
    const int tid = tid_, lane = tid & 63, wave = tid >> 6;
    const int gwv = blockIdx.x * 8 + wave, NGW = gridDim.x * 8;
    const float* g2 = p.mod + layer * 6144 + 5 * 1024;
    for (int t = gwv; t < S_; t += NGW) {
        f32x4* xr = (f32x4*)(p.out + (size_t)t * D_) + lane;
#pragma unroll
        for (int j = 0; j < 4; ++j) {
            f32x4 s = (f32x4){0.f, 0.f, 0.f, 0.f};
#pragma unroll
            for (int k = 0; k < 8; ++k) {
                const int w = *((const int*)((const char*)p.YBUF + ((size_t)t * 8 + k) * 1024) + lane + 64 * j);
                const f32x2 lo = __builtin_amdgcn_cvt_pk_f32_fp8(w, false), hi = __builtin_amdgcn_cvt_pk_f32_fp8(w, true);
                s.x += lo.x; s.y += lo.y; s.z += hi.x; s.w += hi.y;
            }
            { const u32x2 sw = *((const u32x2*)(p.YS + (size_t)t * 1024) + lane + 64 * j);
              s.x += 16.f * __uint_as_float(sw.x << 16); s.y += 16.f * __uint_as_float(sw.x & 0xffff0000u); s.z += 16.f * __uint_as_float(sw.y << 16); s.w += 16.f * __uint_as_float(sw.y & 0xffff0000u); }
            const f32x4 g = *(const f32x4*)(g2 + 256 * j + 4 * lane) * (1.f / 16.f);
            xr[64 * j] = xr[64 * j] + g * s;
        }
    }
}

#define XB_TMO      128
#define XB_XCNT(j)  (256  + 64 * (j))
#define XB_XSUB(j)  (1280 + 64 * (j))
#define XB_XGEN(j)  (2304 + 64 * (j))
#define XB_TOP      3328
#define XB_TOPGEN   3392
#define XCD_BAR_WORDS 3456
#define XB_SPIN_CAP (1u << 22)
__device__ __forceinline__ unsigned xb_ld(unsigned* p)              { return __hip_atomic_load(p, __ATOMIC_RELAXED, __HIP_MEMORY_SCOPE_AGENT); }
__device__ __forceinline__ unsigned xb_add(unsigned* p, unsigned v) { return __hip_atomic_fetch_add(p, v, __ATOMIC_RELAXED, __HIP_MEMORY_SCOPE_AGENT); }
__device__ __forceinline__ unsigned xb_xcc_id() { return (unsigned)__builtin_amdgcn_s_getreg((3 << 11) | 20) & 0xFu; }
#define XB_SPIN(cond, bar) do { unsigned _sp = 0; while (cond) { __builtin_amdgcn_s_sleep(1); \
    if ((++_sp & 255u) == 0u) { if (xb_ld(&(bar)[XB_TMO])) break; if (_sp > XB_SPIN_CAP) { atomicAdd(&(bar)[XB_TMO], 1u); break; } } } } while (0)
struct XcdBarrier { unsigned* bar; unsigned x; volatile LAS unsigned* st; };
__device__ __forceinline__ XcdBarrier xcd_barrier_post(unsigned* bar, volatile LAS unsigned* st) {
    XcdBarrier b; b.bar = bar; b.x = xb_xcc_id(); b.st = st;
    if (threadIdx.x == 0) (void)xb_add(&bar[XB_XCNT(b.x)], 1u);
    return b;
}
__device__ __forceinline__ void xcd_barrier_complete(unsigned* bar, unsigned x, unsigned& nloc, unsigned& nx) {
    const unsigned G = gridDim.x * gridDim.y * gridDim.z;
    unsigned sum, cnt, mine, sp = 0u;
    for (;;) {
        sum = 0u; cnt = 0u; mine = 0u;
#pragma unroll
        for (unsigned j = 0; j < 16; ++j) { const unsigned c = xb_ld(&bar[XB_XCNT(j)]); sum += c; cnt += (c > 0u) ? 1u : 0u; mine = (j == x) ? c : mine; }
        if (sum == G) break;
        __builtin_amdgcn_s_sleep(1);
        if ((++sp & 255u) == 0u) { if (xb_ld(&bar[XB_TMO])) break; if (sp > XB_SPIN_CAP) { atomicAdd(&bar[XB_TMO], 1u); break; } }
    }
    nloc = mine > 0u ? mine : 1u; nx = cnt > 0u ? cnt : 1u;
}
__device__ __forceinline__ void xcd_barrier(const XcdBarrier& b) {
    asm volatile("s_waitcnt vmcnt(0)" ::: "memory");
    __syncthreads();
    if (threadIdx.x == 0) {
        unsigned* bar = b.bar;
        __builtin_amdgcn_s_waitcnt(0);
        unsigned nloc = b.st[0], nx = b.st[1];
        if (nloc == 0u) { xcd_barrier_complete(bar, b.x, nloc, nx); b.st[0] = nloc; b.st[1] = nx; }
        const unsigned old = xb_add(&bar[XB_XSUB(b.x)], 1u);
        const unsigned gen = old / nloc;
        if (old + 1u == (gen + 1u) * nloc) {
            __builtin_amdgcn_fence(__ATOMIC_RELEASE, "agent");
            asm volatile("s_waitcnt vmcnt(0)" ::: "memory");
            const unsigned og = xb_add(&bar[XB_TOP], 1u);
            const unsigned tg = og / nx;
            if (og + 1u == (tg + 1u) * nx) xb_add(&bar[XB_TOPGEN], 1u);
            else XB_SPIN(xb_ld(&bar[XB_TOPGEN]) == tg, bar);
            __builtin_amdgcn_fence(__ATOMIC_ACQUIRE, "agent");
            xb_add(&bar[XB_XGEN(b.x)], 1u);
            asm volatile("s_waitcnt vmcnt(0)" ::: "memory");
        } else {
            XB_SPIN(xb_ld(&bar[XB_XGEN(b.x)]) == gen, bar);
            __builtin_amdgcn_fence(__ATOMIC_ACQUIRE, "agent");
            asm volatile("s_waitcnt vmcnt(0)" ::: "memory");
        }
    }
    __syncthreads();
}

__global__ void __launch_bounds__(MK_THREADS, 2) mega(MKP p) {
    extern __shared__ __attribute__((aligned(16))) unsigned char lds_raw[];
    LAS unsigned char* lds = (LAS unsigned char*)lds_raw;
    const int lo = p.ph_lo, hi = p.ph_hi;
    const bool multi = hi - lo > 1;
    volatile LAS unsigned* bst = (volatile LAS unsigned*)(lds + LDS_BARST);
    XcdBarrier bar; bar.bar = p.barw; bar.x = 0; bar.st = bst;
    if (multi) {
        if (threadIdx.x < 2) bst[threadIdx.x] = 0u;
        if (blockIdx.x == 0) for (int i = threadIdx.x; i < XCD_BAR_WORDS; i += MK_THREADS) p.barw[i] = 0u;
    }
    int nbar = 0;
    if (multi) {
        __threadfence(); cooperative_groups::this_grid().sync(); __builtin_amdgcn_fence(__ATOMIC_ACQUIRE, "agent"); bar = xcd_barrier_post(p.barw, bst); nbar = 1;
    }
#define IN(k) (lo <= (k) && (k) < hi)
#define SEAM(k) do { if (IN(k) && IN((k) + 1)) { if (nbar == 0) { __threadfence(); cooperative_groups::this_grid().sync(); __builtin_amdgcn_fence(__ATOMIC_ACQUIRE, "agent"); bar = xcd_barrier_post(p.barw, bst); } else xcd_barrier(bar); ++nbar; } } while (0)
    if (IN(0)) { phase_prologue(p, lds); phase_moe_weights(p, lds, 0); }
    SEAM(0);
    if (IN(1)) phase_norm<false>(p, lds, p.in[0], p.in[3], 0, 1, 0, true);
    SEAM(1);
    if (IN(2)) {
        pg::DenseSched S; S.init(p.XN, p.W_in0t, S_, 3072, 1024, gridDim.x, blockIdx.x);
        EpiHeads E{p.desc0, p.cosT, p.sinT, p.GATES, p.LOGF, (LAS float*)(lds + LDS_X)};
        pg::gemm_run(lds, 1024, S, E);
    }
    SEAM(2);
    if (IN(3)) phase_scan(p, lds);
    SEAM(3);
    if (IN(4)) phase_fox(p, (char*)lds_raw);
    SEAM(4);
    if (IN(5)) {
        pg::DenseSched S; S.init(p.OATT, p.W_out0t, S_, 1024, 1024, gridDim.x, blockIdx.x);
        EpiResid E{p.in[0], p.out, p.mod + 2 * 1024};
        pg::gemm_run(lds, 1024, S, E);
    }
    SEAM(5);
    if (IN(6)) phase_moe_route<false>(p, lds, 0);
    SEAM(6);
    if (IN(7)) phase_moe_gemm1(p, lds, 0);
    SEAM(7);
    if (IN(8)) phase_moe_gemm2(p, lds, 0);
    SEAM(8);
    if (IN(9)) { phase_norm<true>(p, lds, p.out, p.in[3] + 1024, 1, 1, 0, false); phase_moe_weights(p, lds, 1); }
    if (IN(9) && IN(11)) { xcd_barrier(bar); ++nbar; }
    if (IN(11)) {
        pg::DenseSched S; S.init(p.XN, p.W_in1t, S_, 768, 1024, gridDim.x, blockIdx.x);
        EpiPlain E{p.P1, 768};
        pg::gemm_run(lds, 1024, S, E);
    }
    SEAM(11);
    if (IN(12)) phase_post1a(p);
    SEAM(12);
    if (IN(13)) {
        { pg::DenseSched S; S.init(p.CQN, p.W_uqt, S_, 1536, 384, gridDim.x, blockIdx.x);
          EpiHeads E{p.desc_uq, p.cosT, p.sinT, nullptr, nullptr, (LAS float*)(lds + LDS_X)};
          pg::gemm_run(lds, 384, S, E); }
        { pg::DenseSched S; S.init(p.CKVN, p.W_ukvt, S_, 2048, 256, gridDim.x, blockIdx.x);
          EpiHeads E{p.desc_ukv, p.cosT, p.sinT, nullptr, nullptr, (LAS float*)(lds + LDS_X)};
          pg::gemm_run(lds, 256, S, E); }
    }
    SEAM(13);
    if (IN(14)) phase_mla(p, (char*)lds_raw);
    SEAM(14);
    if (IN(15)) {
        pg::DenseSched S; S.init(p.OATT, p.W_out1t, S_, 1024, 1024, gridDim.x, blockIdx.x);
        EpiResid E{p.out, p.out, p.mod + 6144 + 2 * 1024};
        pg::gemm_run(lds, 1024, S, E);
    }
    SEAM(15);
    if (IN(16)) phase_moe_route<false>(p, lds, 1);
    SEAM(16);
    if (IN(17)) phase_moe_gemm1(p, lds, 1);
    SEAM(17);
    if (IN(18)) phase_moe_gemm2(p, lds, 1);
    SEAM(18);
    if (IN(19)) phase_moe_combine(p, 1);
#undef IN
#undef SEAM
}
extern "C" void kernel_launch(void* const* d_in, const int* in_sizes, int n_in, void* d_out, int out_size, void* d_ws, size_t ws_size, hipStream_t stream) {
    static int grid = 0;
    if (!grid) {
        int dev = 0, cus = 0, per_cu = 0;
        (void)hipGetDevice(&dev); (void)hipDeviceGetAttribute(&cus, hipDeviceAttributeMultiprocessorCount, dev);
        (void)hipFuncSetAttribute((const void*)mega, hipFuncAttributeMaxDynamicSharedMemorySize, LDS_TOTAL);
        (void)hipOccupancyMaxActiveBlocksPerMultiprocessor(&per_cu, (const void*)mega, MK_THREADS, LDS_TOTAL);
        (void)hipGetLastError();
        grid = (cus > 0 && per_cu >= 1) ? cus : -1;
    }
    if (grid < 0) return;
    constexpr size_t MiB = 1u << 20;
    if (ws_size < 528 * MiB || n_in != 34) return;
    char* wsb = (char*)d_ws;
    float* ws = (float*)d_ws;
    size_t o = 0;
    MKP p{};
    for (int i = 0; i < 34; ++i) p.in[i] = (const float*)d_in[i];
    p.out = (float*)d_out; p.pos = (const int*)d_in[2];
    p.mod = ws + o; o += 2 * 6144;
    p.cosT = ws + o; o += (size_t)S_ * 48;
    p.sinT = ws + o; o += (size_t)S_ * 48;
    p.modpart = ws + o; o += 8 * 12288;
    p.desc0 = (BlkDesc*)(ws + o); o += 96 * 8;
    p.desc_uq = (BlkDesc*)(ws + o); o += 48 * 8;
    p.desc_ukv = (BlkDesc*)(ws + o); o += 64 * 8;
    p.CUMB = ws + o; o += (size_t)8 * S_;
    p.gcnt = (int*)(ws + o); o += 128;
    p.CBIAS = ws + o; o += 128;
    p.barw = (unsigned*)(ws + o); o += 4096;
    p.ew = ws + o; o += (size_t)S_ * 8;
    p.list = (int*)(ws + o); o += (size_t)64 * 16384;
    p.WcT = (bf16_t*)(ws + o); o += (size_t)2 * 64 * 2048 / 2;
    p.KCMP = (bf16_t*)(ws + o); o += (size_t)2 * 1024 * 64 / 2;
    p.VCT = (bf16_t*)(ws + o); o += (size_t)2 * 64 * 1024 / 2;
    if (o * 4 > 15 * MiB) return;
    p.XN = (bf16_t*)(wsb + 15 * MiB); p.OATT = (bf16_t*)(wsb + 47 * MiB);
    char* big = wsb + 79 * MiB;
    {   bf16_t* b = (bf16_t*)big;
        p.QN = b; b += (size_t)S_ * 512; p.KV6 = b; b += (size_t)12 * S_ * 64; p.FQ = b; b += (size_t)S_ * 512; p.FK = b; b += (size_t)S_ * 512; p.FV = b; b += (size_t)S_ * 512;
        p.GATES = (float*)b; p.LOGF = p.GATES + (size_t)S_ * 24; }
    p.KSLF = (bf16_t*)(big + 92 * MiB); p.VSLF = (bf16_t*)(big + 96 * MiB); p.OCMP = (bf16_t*)(big + 100 * MiB); p.OWIN = (bf16_t*)(big + 116 * MiB);
    {   bf16_t* b = (bf16_t*)(big + 96 * MiB);
        p.P1 = b; b += (size_t)S_ * 768; p.CQN = b; b += (size_t)S_ * 384; p.CKVN = b; b += (size_t)S_ * 256;
        p.Q96 = b; b += (size_t)16 * S_ * 96; p.K96 = b; b += (size_t)16 * S_ * 96; p.V1 = b; b += (size_t)16 * S_ * 64; }
    p.YBUF = (bf16_t*)big; p.YS = (bf16_t*)(big + 128 * MiB); p.HID = (bf16_t*)(big + 256 * MiB);
    p.Wgu = (bf16_t*)(wsb + 415 * MiB); p.Wd = p.Wgu + (size_t)65 * 512 * 1024;
    {   bf16_t* b = (bf16_t*)(wsb + 513 * MiB);
        p.W_in0t = b; b += (size_t)3072 * 1024; p.W_out0t = b; b += (size_t)1024 * 1024; p.W_in1t = b; b += (size_t)768 * 1024;
        p.W_uqt = b; b += (size_t)1536 * 384; p.W_ukvt = b; b += (size_t)2048 * 256; p.W_out1t = b; b += (size_t)1024 * 1024; }
    p.ph_lo = 0; p.ph_hi = 20;
    void* args[] = {&p};
    (void)hipLaunchCooperativeKernel((const void*)mega, dim3(grid), dim3(MK_THREADS), args, LDS_TOTAL, stream);
}
```

```cpp
#include <hip/hip_runtime.h>
#include <hip/hip_cooperative_groups.h>
#include <stdint.h>

#define S_ 16384
#define D_ 1024
#define HYIN 2848
#define NEXP 64
#define EPSF 1e-6f

__device__ __forceinline__ float wsum(float v) {
#pragma unroll
    for (int o = 32; o > 0; o >>= 1) v += __shfl_xor(v, o);
    return v;
}
__device__ __forceinline__ float sigmf(float x) { return 1.f / (1.f + expf(-x)); }
__device__ __forceinline__ float logsigmf(float x) { return fminf(x, 0.f) - log1pf(expf(-fabsf(x))); }
#define LAS __attribute__((address_space(3)))
#define GAS __attribute__((address_space(1)))
typedef unsigned short bf16_t;
typedef short bf16x8 __attribute__((ext_vector_type(8)));
typedef float f32x4 __attribute__((ext_vector_type(4)));
typedef float f32x2 __attribute__((ext_vector_type(2)));
typedef unsigned u32x4 __attribute__((ext_vector_type(4)));
typedef unsigned u32x2 __attribute__((ext_vector_type(2)));
typedef __bf16 bf16x2_t __attribute__((ext_vector_type(2)));

__device__ __forceinline__ unsigned cvtpk(float lo, float hi) { f32x2 v = {lo, hi}; bf16x2_t b = __builtin_convertvector(v, bf16x2_t); return __builtin_bit_cast(unsigned, b); }
__device__ __forceinline__ float bf2f(bf16_t v) { return __uint_as_float(((unsigned)v) << 16); }
__device__ __forceinline__ bf16_t f2bf(float f) { return (bf16_t)(cvtpk(f, 0.f) & 0xffffu); }

namespace pg {
constexpr int BM = 256, BK = 64, HALF = 128, HTB = HALF * BK * 2, STAGE_BYTES = 8 * HTB;
__device__ __forceinline__ int lds_byte(int r, int c) { const int st = (r >> 4) * 2 + (c >> 5), rr = r & 15, cc = c & 31, ob = rr * 64 + cc * 2; return st * 1024 + (ob ^ (((ob >> 9) & 1) << 5)); }
__device__ __forceinline__ int perm32(int rho) { const int n = rho >> 4, i = rho & 15; return 8 * (i >> 2) + 4 * n + (i & 3); }
__device__ __forceinline__ void stage_rc(int b, int& R, int& C) { const int st = b / 1024, sb = b % 1024, swz = sb ^ (((sb >> 9) & 1) << 5); R = (st >> 1) * 16 + swz / 64; C = (st & 1) * 32 + (swz % 64) / 2; }

struct Unit { int pm, pn, aux; const char* A; const char* B; unsigned ra[4]; };

template <class Epi, class Sched>
__device__ __forceinline__ void gemm_run(LAS unsigned char* lds, const int K, const Sched& S, const Epi& E) {
    int tid_ = threadIdx.x; asm volatile("" : "+v"(tid_));
    const int tid = tid_, wid = __builtin_amdgcn_readfirstlane(tid >> 6), lane = tid & 63, wr = wid >> 2, wc = wid & 3, fr = lane & 15, fq = lane >> 4;
    int nt_ = K / BK; asm volatile("" : "+s"(nt_)); const int nt = nt_;
    int R0, C0; stage_rc(tid * 16, R0, C0);
    unsigned voffB[2];
#pragma unroll
    for (int i = 0; i < 2; ++i) { const int Rb = Epi::PERM ? ((R0 & ~31) + perm32(R0 & 31)) : R0; voffB[i] = (unsigned)((Rb + 64 * i) * K + C0) * 2u; }
    const size_t kstep = (size_t)(BK * 2);
    const size_t hstep = (size_t)HALF * K * 2;
    const unsigned ldsw = (unsigned)wid * 1024u;
    const int aoff = lds_byte(wr * 64 + fr, fq * 8), boff = lds_byte(wc * 32 + fr, fq * 8);
#define PG_SA(b, h) (((b) * 2 + (h)) * HTB)
#define PG_SB(b, h) ((4 + (b) * 2 + (h)) * HTB)
#define PG_STAGE2(bufoff, gbase, v0, v1) do { \
        __builtin_amdgcn_global_load_lds((const unsigned*)((const char*)(gbase) + (v0)), (LAS unsigned*)(lds + (bufoff) + ldsw), 16, 0, 0); \
        __builtin_amdgcn_global_load_lds((const unsigned*)((const char*)(gbase) + (v1)), (LAS unsigned*)(lds + (bufoff) + ldsw + 8192), 16, 0, 0); } while (0)
#define PG_STAGEB(bufoff, gbase) PG_STAGE2(bufoff, gbase, voffB[0], voffB[1])
#define PG_LDA(dst, b, h) do { _Pragma("unroll") for (int m = 0; m < 4; ++m) _Pragma("unroll") for (int k = 0; k < 2; ++k) dst[m][k] = *(const LAS bf16x8*)(lds + PG_SA(b, h) + aoff + m * 2048 + k * 1024); } while (0)
#define PG_LDB(dst, b, h) do { _Pragma("unroll") for (int n = 0; n < 2; ++n) _Pragma("unroll") for (int k = 0; k < 2; ++k) dst[n][k] = *(const LAS bf16x8*)(lds + PG_SB(b, h) + boff + n * 2048 + k * 1024); } while (0)
#define PG_MMA(ai, bj, At, Bt) do { __builtin_amdgcn_s_setprio(1); _Pragma("unroll") for (int m = 0; m < 4; ++m) _Pragma("unroll") for (int n = 0; n < 2; ++n) _Pragma("unroll") for (int k = 0; k < 2; ++k) \
        acc[ai][bj][m][n] = __builtin_amdgcn_mfma_f32_16x16x32_bf16(Bt[n][k], At[m][k], acc[ai][bj][m][n], 0, 0, 0); __builtin_amdgcn_s_setprio(0); } while (0)
#define PG_WAIT_V(n) asm volatile("s_waitcnt vmcnt(" #n ")" ::: "memory")
#define PG_WAIT_L(n) asm volatile("s_waitcnt lgkmcnt(" #n ")" ::: "memory")
#define PG_BAR __builtin_amdgcn_s_barrier()
#define PG_SCHED __builtin_amdgcn_sched_barrier(0)
    Unit cur, nxt; int ui = 0;
    if (!S.next(0, cur, R0, C0)) return;
    f32x4 acc[2][2][4][2];
#pragma unroll
    for (int a = 0; a < 2; ++a)
#pragma unroll
        for (int b = 0; b < 2; ++b)
#pragma unroll
            for (int m = 0; m < 4; ++m)
#pragma unroll
                for (int n = 0; n < 2; ++n) acc[a][b][m][n] = (f32x4){0.f, 0.f, 0.f, 0.f};
    bf16x8 At[4][2], B0[2][2], B1[2][2];
    const char* cA = cur.A; const char* cB = cur.B;
    PG_STAGEB(PG_SB(0, 0), cB); PG_STAGEB(PG_SB(0, 1), cB + hstep); PG_STAGE2(PG_SA(0, 0), cA, cur.ra[0], cur.ra[1]); PG_STAGE2(PG_SA(0, 1), cA, cur.ra[2], cur.ra[3]);
    if (wr == 1) PG_BAR;
    PG_WAIT_V(2); PG_BAR;
    PG_STAGEB(PG_SB(1, 0), cB + kstep); PG_STAGE2(PG_SA(1, 0), cA + kstep, cur.ra[0], cur.ra[1]); PG_STAGEB(PG_SB(1, 1), cB + hstep + kstep);
    PG_WAIT_V(6); PG_BAR;
    for (;;) {
        const bool has_next = S.next(ui + 1, nxt, R0, C0);
        if (!has_next) nxt = cur;
        const char* nA = nxt.A; const char* nB = nxt.B;
#pragma unroll 1
        for (int t = 0; t < nt; t += 2) {
            const bool last = (t == nt - 2);
            const char* a1 = cA + (size_t)(t + 1) * kstep;
            const char* a2 = last ? nA : cA + (size_t)(t + 2) * kstep; const char* b2 = last ? nB : cB + (size_t)(t + 2) * kstep;
            const char* a3 = a2 + kstep; const char* b3 = b2 + kstep;
            const unsigned r0 = last ? nxt.ra[0] : cur.ra[0], r1 = last ? nxt.ra[1] : cur.ra[1], r2 = last ? nxt.ra[2] : cur.ra[2], r3 = last ? nxt.ra[3] : cur.ra[3];
            PG_LDB(B0, 0, 0); PG_LDB(B1, 0, 1); PG_SCHED; PG_LDA(At, 0, 0); PG_STAGE2(PG_SA(1, 1), a1, cur.ra[2], cur.ra[3]);
            PG_WAIT_V(8); PG_WAIT_L(0); PG_BAR; PG_MMA(0, 0, At, B0); PG_MMA(0, 1, At, B1); PG_BAR; PG_SCHED;
            PG_LDA(At, 0, 1); PG_STAGEB(PG_SB(0, 0), b2); PG_STAGEB(PG_SB(0, 1), b2 + hstep); PG_STAGE2(PG_SA(0, 0), a2, r0, r1);
            PG_WAIT_V(8); PG_WAIT_L(0); PG_BAR; PG_MMA(1, 0, At, B0); PG_MMA(1, 1, At, B1); PG_BAR; PG_SCHED;
            PG_LDB(B0, 1, 0); PG_LDB(B1, 1, 1); PG_SCHED; PG_LDA(At, 1, 0); PG_STAGE2(PG_SA(0, 1), a2, r2, r3);
            PG_WAIT_V(8); PG_WAIT_L(0); PG_BAR; PG_MMA(0, 0, At, B0); PG_MMA(0, 1, At, B1); PG_BAR; PG_SCHED;
            PG_LDA(At, 1, 1); PG_STAGEB(PG_SB(1, 0), b3); PG_STAGEB(PG_SB(1, 1), b3 + hstep); PG_STAGE2(PG_SA(1, 0), a3, r0, r1);
            PG_WAIT_V(8); PG_WAIT_L(0); PG_BAR; PG_MMA(1, 0, At, B0); PG_MMA(1, 1, At, B1); PG_BAR; PG_SCHED;
        }
        if (wr == 0) PG_BAR;
        E(acc, cur, wid, wr, wc, fr, fq);
        if (!has_next) break;
#pragma unroll
        for (int a = 0; a < 2; ++a)
#pragma unroll
            for (int b = 0; b < 2; ++b)
#pragma unroll
                for (int m = 0; m < 4; ++m)
#pragma unroll
                    for (int n = 0; n < 2; ++n) acc[a][b][m][n] = (f32x4){0.f, 0.f, 0.f, 0.f};
        cur = nxt; cA = nA; cB = nB; ++ui;
        if (wr == 1) PG_BAR;
    }
    PG_WAIT_V(0);
    PG_BAR;
#undef PG_SA
#undef PG_SB
#undef PG_STAGE2
#undef PG_STAGEB
#undef PG_LDA
#undef PG_LDB
#undef PG_MMA
}

struct DenseSched {
    const char* A; const char* Bt; int K, nM, nN, nwg, G, c;
    __device__ __forceinline__ void init(const void* A_, const void* Bt_, int M, int N, int K_, int G_, int c_) { A = (const char*)A_; Bt = (const char*)Bt_; K = K_; nM = M / BM; nN = N / BM; nwg = nM * nN; G = G_; c = c_; }
    __device__ __forceinline__ bool next(int i, Unit& u, int R0, int C0) const {
        const long L = (long)i * G + c; if (L >= nwg) return false;
        int wgid = (int)L; { const int q = nwg / 8, r = nwg % 8, xcd = wgid % 8, off = wgid / 8; wgid = (xcd < r ? xcd * (q + 1) : r * (q + 1) + (xcd - r) * q) + off; }
        const int nig = 8 * nN, gid = wgid / nig, fm = gid * 8, gsz = (nM - fm) < 8 ? (nM - fm) : 8;
        u.pm = fm + ((wgid % nig) % gsz); u.pn = (wgid % nig) / gsz; u.aux = 0;
        u.A = A + (size_t)u.pm * BM * K * 2; u.B = Bt + (size_t)u.pn * BM * K * 2;
#pragma unroll
        for (int q = 0; q < 4; ++q) u.ra[q] = (unsigned)((R0 + 64 * q) * K + C0) * 2u;
        return true;
    }
};
}
namespace att {
using s16x4 = __attribute__((ext_vector_type(4))) short;
using f32x16 = __attribute__((ext_vector_type(16))) float;
typedef __attribute__((address_space(3))) const char* lds_cptr;
typedef short v4i16_t __attribute__((ext_vector_type(4)));
constexpr int NSLOT = 3, VSLOT = 8192;
template <int DQ> struct Geo {
    static constexpr int NK = DQ / 16;
    static constexpr int KSLOT = (DQ == 64) ? 8192 : 16384;
    static constexpr int QWAVE = (DQ == 64) ? 4096 : 6144;
    static constexpr int LDS_K = 0, LDS_V = NSLOT * KSLOT, LDS_WS = LDS_V + NSLOT * VSLOT, LDS_OST = LDS_WS + 8 * 64 * 4, LDS_BYTES = LDS_OST + 8 * QWAVE;
};
constexpr int LDS_BIAS = Geo<64>::LDS_BYTES;
#define ASBAR() __builtin_amdgcn_sched_barrier(0)
#define AWAIT_BAR(N) asm volatile("s_waitcnt vmcnt(" #N ") lgkmcnt(0)\n\ts_barrier" ::: "memory")
__device__ __forceinline__ int crow(int r, int hi) { return (r & 3) + 8 * (r >> 2) + 4 * hi; }
__device__ __forceinline__ void glds16(const void* gsrc, unsigned lds_dst) { unsigned keep;
    asm volatile("s_mov_b32 %0, m0\n\ts_mov_b32 m0, %2\n\ts_nop 0\n\tglobal_load_lds_dwordx4 %1, off\n\ts_mov_b32 m0, %0" : "=&s"(keep) : "v"(gsrc), "s"(lds_dst) : "memory"); }
__device__ __forceinline__ float fadd_s(float a, float b) { float r; asm("v_add_f32_e32 %0, %1, %2" : "=v"(r) : "v"(a), "v"(b)); return r; }
__device__ __forceinline__ float fsub_s(float a, float b) { float r; asm("v_sub_f32_e32 %0, %1, %2" : "=v"(r) : "v"(a), "v"(b)); return r; }
__device__ __forceinline__ float max3f(float a, float b, float c) { float r; asm("v_max3_f32 %0, %1, %2, %3" : "=v"(r) : "v"(a), "v"(b), "v"(c)); return r; }
__device__ __forceinline__ float max2f(float a, float b) { float r; asm("v_max_f32_e32 %0, %1, %2" : "=v"(r) : "v"(a), "v"(b)); return r; }
__device__ __forceinline__ s16x4 vtr(lds_cptr p) { return __builtin_bit_cast(s16x4, __builtin_amdgcn_ds_read_tr16_b64_v4i16((__attribute__((address_space(3))) v4i16_t*)p)); }
template <int NK> __device__ __forceinline__ void kloadall(bf16x8* kf, lds_cptr kp) {
#pragma unroll
    for (int j = 0; j < NK; ++j) { kf[2 * j] = *(const LAS bf16x8*)(kp + j * 2048); kf[2 * j + 1] = *(const LAS bf16x8*)(kp + j * 2048 + 512); } }
__device__ __forceinline__ void kload2(bf16x8* kf, lds_cptr kp, int j) { kf[2 * j] = *(const LAS bf16x8*)(kp + j * 2048); kf[2 * j + 1] = *(const LAS bf16x8*)(kp + j * 2048 + 512); }
__device__ __forceinline__ void cmask(f32x16& p0, f32x16& p1, int koff, int qtok, int hi) {
    const int x = qtok - koff - 4 * hi;
#pragma unroll
    for (int r = 0; r < 16; ++r) { const int c = (r & 3) + 8 * (r >> 2); if (c > x) p0[r] = -INFINITY; if (c + 32 > x) p1[r] = -INFINITY; }
}
__device__ __forceinline__ void wmask(f32x16& p0, f32x16& p1, int thr, int hi) {
    const int y = thr - 4 * hi;
#pragma unroll
    for (int r = 0; r < 16; ++r) { const int c = (r & 3) + 8 * (r >> 2); if (c < y) p0[r] = -INFINITY; if (c + 32 < y) p1[r] = -INFINITY; }
}
__device__ __forceinline__ float rowmax(const f32x16& p0, const f32x16& p1) {
    float a = max3f(p0[0], p0[1], p1[0]), b = max3f(p0[2], p0[3], p1[1]); a = max3f(a, p1[2], p1[3]);
#pragma unroll
    for (int r = 4; r < 16; r += 4) { a = max3f(a, p0[r], p0[r + 1]); b = max3f(b, p0[r + 2], p0[r + 3]); a = max3f(a, p1[r], p1[r + 1]); b = max3f(b, p1[r + 2], p1[r + 3]); }
    const float m = max2f(a, b);
    auto rr = __builtin_amdgcn_permlane32_swap(__float_as_uint(m), __float_as_uint(m), false, false);
    return max2f(__uint_as_float(rr[0]), __uint_as_float(rr[1]));
}

enum { MODE_CAUSAL = 0, MODE_FOX = 1, MODE_WIN = 2 };
struct UnitArgs {
    const bf16_t* qrow;
    const bf16_t* K; const bf16_t* V; int kvpitch, vpitch;
    bf16_t* obase; int opitch;
    int qtok;
    int abase;
    int nsteps;
    const LAS float* bias;
};

template <int NB> __device__ __forceinline__ int seq(int i, int abase) { return (i < NB) ? abase + i : abase + NB - 1 - i; }

template <int MODE, bool GQA4, int THRL, int DQ, bool TM = false>
__device__ __forceinline__ void attn_unit(const UnitArgs& A, char* shm) {
    constexpr int NB = GQA4 ? 1 : 4;
    typedef Geo<DQ> G; constexpr int NK = G::NK, KSLOT = G::KSLOT, LDS_K = G::LDS_K, LDS_V = G::LDS_V, LDS_WS = G::LDS_WS, LDS_OST = G::LDS_OST, QWAVE = G::QWAVE;
    constexpr bool USE_NEGM = (MODE != MODE_FOX);
    int tid_ = threadIdx.x; asm volatile("" : "+v"(tid_));
    const int tid = tid_, lane = tid & 63, r32 = lane & 31, hi = lane >> 5; const int wid = __builtin_amdgcn_readfirstlane(tid >> 6);
    const unsigned lds0 = (unsigned)(uintptr_t)shm;
    float* wsf = (float*)(shm + LDS_WS) + wid * 64;
    const int NT = A.nsteps, abase = A.abase; const long kvp = A.kvpitch, vvp = A.vpitch;
    const bf16_t* ksrc = TM ? A.K + wid * 512 + lane * 8 : A.K + (long)lane * kvp + wid * 8;
    const bf16_t* ksrc2 = TM ? A.K + (8 + (wid & 3)) * 512 + lane * 8 : A.K + (long)lane * kvp + (8 + (wid & 3)) * 8;
    const bf16_t* vsrc = TM ? A.V + wid * 512 + lane * 8 : A.V + (long)(16 * (wid & 3) + (lane >> 2)) * vvp + (wid >> 2) * 32 + (lane & 3) * 8;
    const long kts = TM ? (long)(DQ / 8) * 512 : 64 * kvp, vts = TM ? 4096 : 64 * vvp;
    const unsigned kdst = lds0 + LDS_K + wid * 1024, vdst = lds0 + LDS_V + wid * 1024, kdst2 = lds0 + LDS_K + (8 + wid) * 1024;
#define TILE_OF(t) ({ int a_ = seq<NB>((t), abase); a_ < 0 ? 0 : a_; })
#define DMA_K(t, slot) do { const long to_ = (long)TILE_OF(t) * kts; glds16(ksrc + to_, (unsigned)__builtin_amdgcn_readfirstlane(kdst + (slot) * KSLOT)); \
        if (DQ == 96) glds16(ksrc2 + to_, (unsigned)__builtin_amdgcn_readfirstlane(kdst2 + (slot) * KSLOT)); } while (0)
#define DMA_V(t, slot) glds16(vsrc + (long)TILE_OF(t) * vts, (unsigned)__builtin_amdgcn_readfirstlane(vdst + (slot) * VSLOT))
    const lds_cptr shm3 = (lds_cptr)shm; const lds_cptr kp0 = shm3 + LDS_K + hi * 1024 + r32 * 16;
    const lds_cptr vp0 = shm3 + LDS_V + ((lane >> 4) & 1) * 32 + (lane & 3) * 8 + (4 * hi + ((lane & 15) >> 2)) * 64;
    const int vb0 = (int)(lds0 + LDS_V) + ((lane >> 4) & 1) * 32 + (lane & 3) * 8 + (4 * hi + ((lane & 15) >> 2)) * 64;
    DMA_K(0, 0); DMA_V(0, 0); DMA_K(1, 1);
    bf16x8 qr[NK];
#pragma unroll
    for (int d0 = 0; d0 < NK; ++d0) qr[d0] = *reinterpret_cast<const bf16x8*>(A.qrow + d0 * 16 + hi * 8);
    const lds_cptr qlp = shm3 + LDS_OST + wid * QWAVE + hi * 512 + r32 * 16;
    if (DQ == 96) {
#pragma unroll
        for (int d0 = 0; d0 < NK; ++d0) *(LAS bf16x8*)(const_cast<__attribute__((address_space(3))) char*>(qlp) + d0 * 1024) = qr[d0];
    }
#define QL(d0) (*(const LAS bf16x8*)(qlp + (d0) * 1024))
    float mhat = 0.f, l_reg = 0.f; f32x16 o[2]; o[0] = f32x16{}; o[1] = f32x16{};
    f32x16 negm = f32x16{}; if (USE_NEGM) asm volatile("" : "+v"(negm));
    const int qtok = A.qtok;
#define CMASK(P0, P1, t) do { const int t_ = (t); if (t_ < NB) cmask(P0, P1, 64 * t_, qtok, hi); \
        else { const int a_ = abase + NB - 1 - t_; if (a_ < 0) wmask(P0, P1, 64, hi); \
               else if (MODE == MODE_WIN) { const int thr_ = qtok - 511 + 64 * (abase - a_); if (thr_ > 0) wmask(P0, P1, thr_, hi); } } } while (0)
#define CINIT1(C, t, OFF) do { if (MODE == MODE_FOX) { const LAS float* bt_ = A.bias + 64 * (seq<NB>((t), abase) - (abase + NB - NT)) + 4 * hi + (OFF); const float nm_ = -mhat; \
        _Pragma("unroll") for (int g_ = 0; g_ < 4; ++g_) { const f32x4 b_ = *(const LAS f32x4*)(bt_ + 8 * g_); C[4 * g_] = b_.x; C[4 * g_ + 1] = b_.y; C[4 * g_ + 2] = b_.z; C[4 * g_ + 3] = b_.w; } \
        _Pragma("unroll") for (int r_ = 0; r_ < 16; ++r_) C[r_] += nm_; asm volatile("" : "+v"(C)); } \
      else if (USE_NEGM) { C = negm; } \
      else { const float nm_ = -mhat; _Pragma("unroll") for (int r_ = 0; r_ < 16; ++r_) C[r_] = nm_; asm volatile("" : "+v"(C)); } } while (0)
#define CINIT(C0, C1, t) do { CINIT1(C0, t, 0); CINIT1(C1, t, 32); } while (0)
    bool resc = false;
#define START(P0, P1) do { const float rm = rowmax(P0, P1); resc = false; \
    { const float dl = rm; mhat = fadd_s(mhat, dl); \
      _Pragma("unroll") for (int r = 0; r < 16; ++r) { P0[r] = fsub_s(P0[r], dl); P1[r] = fsub_s(P1[r], dl); } \
      if (USE_NEGM) { _Pragma("unroll") for (int r = 0; r < 16; ++r) negm[r] = -mhat; asm volatile("" : "+v"(negm)); } } \
    _Pragma("unroll") for (int r = 0; r < 16; ++r) P0[r] = __builtin_amdgcn_exp2f(P0[r]); } while (0)
#define RESC() do { if (resc) { asm volatile("s_waitcnt lgkmcnt(0)" ::: "memory"); \
      const float* wsh_ = wsf + 4 * hi; \
      _Pragma("unroll") for (int d_ = 0; d_ < 2; ++d_) _Pragma("unroll") for (int r = 0; r < 16; ++r) o[d_][r] *= wsh_[(r & 3) + 8 * (r >> 2)]; } } while (0)
    f32x16 pA0, pA1, pB0, pB1; bf16x8 kf[2 * NK];
    int sl_prev = 0, sl_cur = 0, sl_next = 1;
#define ROT() do { sl_prev = sl_cur; sl_cur = sl_next; sl_next = (sl_next == NSLOT - 1) ? 0 : sl_next + 1; } while (0)
    DMA_K(2, 2);
    if (DQ == 96) { AWAIT_BAR(5); } else { AWAIT_BAR(3); }
    { const char* kb = shm + LDS_K + hi * 1024 + r32 * 16;
      CINIT(pA0, pA1, 0);
#pragma unroll
      for (int d0 = 0; d0 < NK; ++d0) {
          const bf16x8 b0 = *reinterpret_cast<const bf16x8*>(kb + d0 * 2048);
          const bf16x8 b1 = *reinterpret_cast<const bf16x8*>(kb + d0 * 2048 + 512);
          pA0 = __builtin_amdgcn_mfma_f32_32x32x16_bf16(b0, qr[d0], pA0, 0, 0, 0); pA1 = __builtin_amdgcn_mfma_f32_32x32x16_bf16(b1, qr[d0], pA1, 0, 0, 0); } }
    asm volatile("s_nop 15\n\ts_nop 7" : "+v"(pA0), "+v"(pA1)); CMASK(pA0, pA1, 0);
    START(pA0, pA1);
    _Pragma("unroll") for (int r = 0; r < 16; ++r) pA1[r] = __builtin_amdgcn_exp2f(pA1[r]);
    AWAIT_BAR(0);
    DMA_K(3, 0); DMA_V(1, 1);
    ROT();
    kloadall<NK>(kf, kp0 + sl_cur * KSLOT);
    if (DQ == 96) { AWAIT_BAR(3); } else { AWAIT_BAR(2); }
    s16x4 vlo[(DQ == 96) ? 4 : 8], vhi[(DQ == 96) ? 4 : 8]; u32x4 pw0, pw1, pw2, pw3;
#define PKW(P, B) cvtpk(P[B], P[B + 1])
#define PAF(k) __builtin_bit_cast(bf16x8, pw##k)
#define VFR(i) (bf16x8){vlo[i][0], vlo[i][1], vlo[i][2], vlo[i][3], vhi[i][0], vhi[i][1], vhi[i][2], vhi[i][3]}
#define PIN(x) asm volatile("" : "+v"(x))
#define MX3(a, b, c) __builtin_fmaxf(__builtin_fmaxf((a), (b)), (c))
#define GAPA(MF, A0, A1, A2, A3, W0, W1, PW) do { MF; sacc += A0; sacc += A1; sacc += A2; sacc += A3; PIN(sacc); W0; W1; PIN(PW); ASBAR(); } while (0)
#define EX(v) __builtin_amdgcn_exp2f(v)
#define GAPB(MF, X, B) do { MF; X[B] = EX(X[B]); X[B + 1] = EX(X[B + 1]); X[B + 2] = EX(X[B + 2]); X[B + 3] = EX(X[B + 3]); PIN(X); ASBAR(); } while (0)
#define VRD(i) do { vlo[i] = vtr(vp_ + (((i) >> 2) * 4096 + ((i) & 3) * 1024)); vhi[i] = vtr(vp_ + (((i) >> 2) * 4096 + ((i) & 3) * 1024 + 512)); } while (0)
#define KRD(G_, j) do { if (G_) { kload2(kf, kp0 + sl_next * KSLOT, j); ASBAR(); } } while (0)
#define MFMA32(a, b, c) __builtin_amdgcn_mfma_f32_32x32x16_bf16(a, b, c, 0, 0, 0)
#define STEP64(C0, C1, P0, P1, t, GK, GV, GL, DOMASK) do { ASBAR(); \
    const lds_cptr vp_ = vp0 + sl_prev * VSLOT; \
    CINIT1(C0, t, 0); ASBAR(); \
    VRD(0); ASBAR(); float sacc = (P0[0] + P0[1]); \
    GAPA(C0 = MFMA32(kf[0], qr[0], C0), P0[2], P0[3], P0[4], P0[5],     pw0[0] = PKW(P0, 0), pw0[1] = PKW(P0, 2), pw0); \
    CINIT1(C1, t, 32); ASBAR(); \
    VRD(4); ASBAR(); GAPA(C1 = MFMA32(kf[1], qr[0], C1), P0[6], P0[7], P0[8], P0[9],     pw0[2] = PKW(P0, 4), pw0[3] = PKW(P0, 6), pw0); \
    VRD(1); ASBAR(); GAPA(C0 = MFMA32(kf[2], qr[1], C0),   P0[10], P0[11], P0[12], P0[13], pw1[0] = PKW(P0, 8), pw1[1] = PKW(P0, 10), pw1); \
    VRD(5); ASBAR(); GAPA(C1 = MFMA32(kf[3], qr[1], C1),   P0[14], P0[15], P1[0], P1[1],   pw1[2] = PKW(P0, 12), pw1[3] = PKW(P0, 14), pw1); \
    VRD(2); ASBAR(); GAPA(C0 = MFMA32(kf[4], qr[2], C0),   P1[2], P1[3], P1[4], P1[5],     pw2[0] = PKW(P1, 0), pw2[1] = PKW(P1, 2), pw2); \
    VRD(6); ASBAR(); GAPA(C1 = MFMA32(kf[5], qr[2], C1),   P1[6], P1[7], P1[8], P1[9],     pw2[2] = PKW(P1, 4), pw2[3] = PKW(P1, 6), pw2); \
    VRD(3); ASBAR(); GAPA(C0 = MFMA32(kf[6], qr[3], C0),   P1[10], P1[11], P1[12], P1[13], pw3[0] = PKW(P1, 8), pw3[1] = PKW(P1, 10), pw3); \
    VRD(7); ASBAR(); GAPA(C1 = MFMA32(kf[7], qr[3], C1),   P1[14], P1[15], 0.f, 0.f,       pw3[2] = PKW(P1, 12), pw3[3] = PKW(P1, 14), pw3); \
    l_reg += sacc; \
    if (GK) { DMA_K((t) + 3, sl_cur); } if (GV) { DMA_V((t) + 1, sl_next); } \
    if (DOMASK) CMASK(C0, C1, t); \
    { float a = MX3(C0[0], C0[1], C1[0]), b = MX3(C0[2], C0[3], C1[1]); a = MX3(a, C1[2], C1[3]); \
      _Pragma("unroll") for (int r = 4; r < 16; r += 4) { a = MX3(a, C0[r], C0[r + 1]); b = MX3(b, C0[r + 2], C0[r + 3]); a = MX3(a, C1[r], C1[r + 1]); b = MX3(b, C1[r + 2], C1[r + 3]); } \
      float rm = __builtin_fmaxf(a, b); { auto rr = __builtin_amdgcn_permlane32_swap(__float_as_uint(rm), __float_as_uint(rm), false, false); rm = __builtin_fmaxf(__uint_as_float(rr[0]), __uint_as_float(rr[1])); } \
      resc = false; \
      if (__builtin_expect(__any(rm > (float)THRL), 0)) { const float dl = __builtin_fmaxf(rm, 0.f); mhat += dl; \
        _Pragma("unroll") for (int r = 0; r < 16; ++r) { C0[r] -= dl; C1[r] -= dl; } \
        if (USE_NEGM) { _Pragma("unroll") for (int r = 0; r < 16; ++r) negm[r] = -mhat; asm volatile("" : "+v"(negm)); } \
        const float f = __builtin_amdgcn_exp2f(-dl); l_reg *= f; if (hi == 0) wsf[r32] = f; resc = true; } } \
    ASBAR(); \
    GAPB(o[0] = MFMA32(PAF(0), VFR(0), o[0]), C0, 0); \
    GAPB(o[1] = MFMA32(PAF(0), VFR(4), o[1]), C0, 4); \
    KRD(GL, 0); GAPB(o[0] = MFMA32(PAF(1), VFR(1), o[0]), C0, 8); \
    KRD(GL, 1); GAPB(o[1] = MFMA32(PAF(1), VFR(5), o[1]), C0, 12); \
    KRD(GL, 2); GAPB(o[0] = MFMA32(PAF(2), VFR(2), o[0]), C1, 0); \
    KRD(GL, 3); GAPB(o[1] = MFMA32(PAF(2), VFR(6), o[1]), C1, 4); \
    GAPB(o[0] = MFMA32(PAF(3), VFR(3), o[0]), C1, 8); \
    GAPB(o[1] = MFMA32(PAF(3), VFR(7), o[1]), C1, 12); \
    } while (0)
#define AWAIT_STEADY() do { if (DQ == 96) { AWAIT_BAR(3); } else { AWAIT_BAR(2); } } while (0)
#define VRD4(i, b) do { vlo[b] = vtr(vp_ + (((i) >> 2) * 4096 + ((i) & 3) * 1024)); vhi[b] = vtr(vp_ + (((i) >> 2) * 4096 + ((i) & 3) * 1024 + 512)); } while (0)
#define VFR4(b) (bf16x8){vlo[b][0], vlo[b][1], vlo[b][2], vlo[b][3], vhi[b][0], vhi[b][1], vhi[b][2], vhi[b][3]}
#define GAPQ(MF, QLD, A0, A1, A2, A3, W0, W1, PW) do { MF; QLD; sacc += A0; sacc += A1; sacc += A2; sacc += A3; PIN(sacc); W0; W1; PIN(PW); ASBAR(); } while (0)
#define STEP96(C0, C1, P0, P1, t, GK, GV, GL, DOMASK) do { ASBAR(); \
    const lds_cptr vp_ = vp0 + sl_prev * VSLOT; \
    CINIT1(C0, t, 0); CINIT1(C1, t, 32); bf16x8 qa = QL(0), qb; ASBAR(); \
    float sacc = (P0[0] + P0[1]); \
    GAPQ(C0 = MFMA32(kf[0], qa, C0), qb = QL(1), P0[2], P0[3], P0[4], P0[5],     pw0[0] = PKW(P0, 0), pw0[1] = PKW(P0, 2), pw0); \
    GAPQ(C1 = MFMA32(kf[1], qa, C1), (void)0,    P0[6], P0[7], P0[8], P0[9],     pw0[2] = PKW(P0, 4), pw0[3] = PKW(P0, 6), pw0); \
    GAPQ(C0 = MFMA32(kf[2], qb, C0), qa = QL(2), P0[10], P0[11], P0[12], P0[13], pw1[0] = PKW(P0, 8), pw1[1] = PKW(P0, 10), pw1); \
    GAPQ(C1 = MFMA32(kf[3], qb, C1), (void)0,    P0[14], P0[15], P1[0], P1[1],   pw1[2] = PKW(P0, 12), pw1[3] = PKW(P0, 14), pw1); \
    GAPQ(C0 = MFMA32(kf[4], qa, C0), qb = QL(3), P1[2], P1[3], P1[4], P1[5],     pw2[0] = PKW(P1, 0), pw2[1] = PKW(P1, 2), pw2); \
    GAPQ(C1 = MFMA32(kf[5], qa, C1), (void)0,    P1[6], P1[7], P1[8], P1[9],     pw2[2] = PKW(P1, 4), pw2[3] = PKW(P1, 6), pw2); \
    GAPQ(C0 = MFMA32(kf[6], qb, C0), qa = QL(4), P1[10], P1[11], P1[12], P1[13], pw3[0] = PKW(P1, 8), pw3[1] = PKW(P1, 10), pw3); \
    GAPQ(C1 = MFMA32(kf[7], qb, C1), (void)0,    P1[14], P1[15], 0.f, 0.f,       pw3[2] = PKW(P1, 12), pw3[3] = PKW(P1, 14), pw3); \
    C0 = MFMA32(kf[8], qa, C0); qb = QL(5); VRD4(0, 0); ASBAR(); \
    C1 = MFMA32(kf[9], qa, C1); VRD4(4, 1); ASBAR(); \
    C0 = MFMA32(kf[10], qb, C0); ASBAR(); \
    C1 = MFMA32(kf[11], qb, C1); ASBAR(); \
    l_reg += sacc; \
    if (GK) { DMA_K((t) + 3, sl_cur); } if (GV) { DMA_V((t) + 1, sl_next); } \
    if (DOMASK) CMASK(C0, C1, t); \
    { float a = MX3(C0[0], C0[1], C1[0]), b = MX3(C0[2], C0[3], C1[1]); a = MX3(a, C1[2], C1[3]); \
      _Pragma("unroll") for (int r = 4; r < 16; r += 4) { a = MX3(a, C0[r], C0[r + 1]); b = MX3(b, C0[r + 2], C0[r + 3]); a = MX3(a, C1[r], C1[r + 1]); b = MX3(b, C1[r + 2], C1[r + 3]); } \
      float rm = __builtin_fmaxf(a, b); { auto rr = __builtin_amdgcn_permlane32_swap(__float_as_uint(rm), __float_as_uint(rm), false, false); rm = __builtin_fmaxf(__uint_as_float(rr[0]), __uint_as_float(rr[1])); } \
      resc = false; \
      if (__builtin_expect(__any(rm > (float)THRL), 0)) { const float dl = __builtin_fmaxf(rm, 0.f); mhat += dl; \
        _Pragma("unroll") for (int r = 0; r < 16; ++r) { C0[r] -= dl; C1[r] -= dl; } \
        if (USE_NEGM) { _Pragma("unroll") for (int r = 0; r < 16; ++r) negm[r] = -mhat; asm volatile("" : "+v"(negm)); } \
        const float f = __builtin_amdgcn_exp2f(-dl); l_reg *= f; if (hi == 0) wsf[r32] = f; resc = true; } } \
    ASBAR(); \
    VRD4(1, 2); ASBAR(); GAPB(o[0] = MFMA32(PAF(0), VFR4(0), o[0]), C0, 0); \
    VRD4(5, 3); ASBAR(); GAPB(o[1] = MFMA32(PAF(0), VFR4(1), o[1]), C0, 4); \
    VRD4(2, 0); KRD(GL, 0); GAPB(o[0] = MFMA32(PAF(1), VFR4(2), o[0]), C0, 8); \
    VRD4(6, 1); KRD(GL, 1); GAPB(o[1] = MFMA32(PAF(1), VFR4(3), o[1]), C0, 12); \
    VRD4(3, 2); KRD(GL, 2); GAPB(o[0] = MFMA32(PAF(2), VFR4(0), o[0]), C1, 0); \
    VRD4(7, 3); KRD(GL, 3); GAPB(o[1] = MFMA32(PAF(2), VFR4(1), o[1]), C1, 4); \
    KRD(GL, 4); GAPB(o[0] = MFMA32(PAF(3), VFR4(2), o[0]), C1, 8); \
    KRD(GL, 5); GAPB(o[1] = MFMA32(PAF(3), VFR4(3), o[1]), C1, 12); \
    } while (0)
#define STEP(C0, C1, P0, P1, t, GK, GV, GL, DOMASK) do { if constexpr (DQ == 96) { STEP96(C0, C1, P0, P1, t, GK, GV, GL, DOMASK); } else { STEP64(C0, C1, P0, P1, t, GK, GV, GL, DOMASK); } } while (0)
#define ENDW(tt) do { if ((tt) + 3 < NT) { AWAIT_STEADY(); } else if ((tt) + 2 < NT) { AWAIT_BAR(1); } else { AWAIT_BAR(0); } } while (0)
    int t = 1;
    for (; t < 5 && t + 1 < NT; t += 2) {
        STEP(pB0, pB1, pA0, pA1, t, (t + 3 < NT), (t + 1 < NT), (t + 1 < NT), true);       ENDW(t);     RESC(); ROT();
        STEP(pA0, pA1, pB0, pB1, t + 1, (t + 4 < NT), (t + 2 < NT), (t + 2 < NT), true);   ENDW(t + 1); RESC(); ROT();
    }
    for (; t + 5 < NT; t += 2) {
        STEP(pB0, pB1, pA0, pA1, t, true, true, true, false);     AWAIT_STEADY(); RESC(); ROT();
        STEP(pA0, pA1, pB0, pB1, t + 1, true, true, true, false); AWAIT_STEADY(); RESC(); ROT();
    }
    for (; t + 1 < NT; t += 2) {
        STEP(pB0, pB1, pA0, pA1, t, (t + 3 < NT), (t + 1 < NT), (t + 1 < NT), true);       ENDW(t);     RESC(); ROT();
        STEP(pA0, pA1, pB0, pB1, t + 1, (t + 4 < NT), (t + 2 < NT), (t + 2 < NT), true);   ENDW(t + 1); RESC(); ROT();
    }
    STEP(pB0, pB1, pA0, pA1, NT - 1, false, false, false, true); RESC();
    { float sacc = pB0[0] + pB0[1];
      _Pragma("unroll") for (int r = 2; r < 16; ++r) sacc += pB0[r];
      _Pragma("unroll") for (int r = 0; r < 16; ++r) sacc += pB1[r];
      l_reg += sacc;
      pw0 = (u32x4){PKW(pB0, 0), PKW(pB0, 2), PKW(pB0, 4), PKW(pB0, 6)}; pw1 = (u32x4){PKW(pB0, 8), PKW(pB0, 10), PKW(pB0, 12), PKW(pB0, 14)};
      pw2 = (u32x4){PKW(pB1, 0), PKW(pB1, 2), PKW(pB1, 4), PKW(pB1, 6)}; pw3 = (u32x4){PKW(pB1, 8), PKW(pB1, 10), PKW(pB1, 12), PKW(pB1, 14)};
      ASBAR();
      const int vb = vb0 + sl_cur * VSLOT;
#pragma unroll
      for (int d0 = 0; d0 < 2; ++d0) { s16x4 lo[4], hh[4];
#pragma unroll
          for (int ks = 0; ks < 4; ++ks) {
              asm volatile("ds_read_b64_tr_b16 %0,%1 offset:%c2" : "=&v"(lo[ks]) : "v"(vb), "i"(d0 * 4096 + ks * 1024) : "memory");
              asm volatile("ds_read_b64_tr_b16 %0,%1 offset:%c2" : "=&v"(hh[ks]) : "v"(vb), "i"(d0 * 4096 + ks * 1024 + 512) : "memory"); }
          asm volatile("s_waitcnt lgkmcnt(0)" ::: "memory"); ASBAR();
#define PK(k) (bf16x8){lo[k][0], lo[k][1], lo[k][2], lo[k][3], hh[k][0], hh[k][1], hh[k][2], hh[k][3]}
          o[d0] = MFMA32(PAF(0), PK(0), o[d0]); o[d0] = MFMA32(PAF(1), PK(1), o[d0]); o[d0] = MFMA32(PAF(2), PK(2), o[d0]); o[d0] = MFMA32(PAF(3), PK(3), o[d0]);
#undef PK
      } }
    { auto rr = __builtin_amdgcn_permlane32_swap(__float_as_uint(l_reg), __float_as_uint(l_reg), false, false); l_reg = __uint_as_float(rr[0]) + __uint_as_float(rr[1]); }
    if (hi == 0) wsf[32 + r32] = l_reg; asm volatile("s_waitcnt lgkmcnt(0)" ::: "memory");
    int lane_e = lane; asm volatile("" : "+v"(lane_e)); const int hi_e = lane_e >> 5, r32_e = lane_e & 31;
    float rli[16];
    { const float* wl_ = wsf + 32 + 4 * hi_e;
#pragma unroll
      for (int r = 0; r < 16; ++r) rli[r] = __builtin_amdgcn_rcpf(wl_[(r & 3) + 8 * (r >> 2)]); }
    { bf16_t* stg = (bf16_t*)(shm + LDS_OST + wid * QWAVE);
      bf16_t* stl = stg + (4 * hi_e) * 64 + r32_e;
#pragma unroll
      for (int r = 0; r < 16; ++r) {
#pragma unroll
          for (int d0 = 0; d0 < 2; ++d0) stl[((r & 3) + 8 * (r >> 2)) * 64 + d0 * 32] = f2bf(o[d0][r] * rli[r]); }
      asm volatile("s_waitcnt lgkmcnt(0)" ::: "memory");
#pragma unroll
      for (int i = 0; i < 4; ++i) { const int row = i * 8 + (lane_e >> 3), ch = lane_e & 7; const u32x4 v = *(const u32x4*)(stg + row * 64 + ch * 8);
          bf16_t* dst = GQA4 ? (A.obase + (long)(8 * wid + (row >> 2)) * A.opitch + (row & 3) * 64) : (A.obase + (long)(32 * wid + row) * A.opitch);
          *(u32x4*)(dst + ch * 8) = v; } }
    asm volatile("s_waitcnt lgkmcnt(0)\n\ts_barrier" ::: "memory");
#undef TILE_OF
#undef DMA_K
#undef DMA_V
#undef CMASK
#undef CINIT
#undef START
#undef RESC
#undef ROT
#undef PKW
#undef PAF
#undef VFR
#undef PIN
#undef MX3
#undef GAPA
#undef GAPB
#undef EX
#undef VRD
#undef KRD
#undef MFMA32
#undef STEP
#undef STEP64
#undef STEP96
#undef VRD4
#undef VFR4
#undef GAPQ
#undef QL
#undef ENDW
#undef AWAIT_STEADY
}
}
constexpr int MK_THREADS = 512;
constexpr int LDS_RING = 131072;
constexpr int LDS_X = LDS_RING;
constexpr int LDS_MOD = LDS_RING + 8192;
constexpr int LDS_BARST = 155648 - 16;
constexpr int LDS_TOTAL = 155648;

#define C2Q 0.18033688011112042f
#define LOG2E 1.4426950408889634f

struct BlkDesc { bf16_t* dst; const float* gain; int pitch; int flags; float scale; int csoff; };
#define C2M 0.14724312203508865f
struct MKP {
    const float* in[34];
    float* out;
    float* modpart;
    float* mod;
    float* cosT; float* sinT;
    bf16_t* W_in0t;
    bf16_t* W_out0t;
    bf16_t* XN;
    bf16_t* OATT;
    bf16_t* QN;
    bf16_t* KV6;
    bf16_t* FQ; bf16_t* FK; bf16_t* FV;
    float* GATES;
    float* LOGF;
    BlkDesc* desc0;
    float* CUMB;
    BlkDesc* desc_uq;
    BlkDesc* desc_ukv;
    bf16_t* W_in1t;
    bf16_t* W_uqt;
    bf16_t* W_ukvt;
    bf16_t* W_out1t;
    bf16_t* P1;
    bf16_t* CQN;
    bf16_t* CKVN;
    bf16_t* Q96;
    bf16_t* K96;
    bf16_t* V1;
    bf16_t* WcT;
    float* CBIAS;
    bf16_t* KCMP;
    bf16_t* VCT;
    bf16_t* KSLF;
    bf16_t* VSLF;
    bf16_t* OCMP;
    bf16_t* OWIN;
    const int* pos;
    bf16_t* Wgu;
    bf16_t* Wd;
    bf16_t* HID;
    bf16_t* YS;
    bf16_t* YBUF;
    int* gcnt;
    int* list;
    float* ew;
    unsigned* barw;
    int ph_lo, ph_hi, dbg_flags, pad_;
};

__device__ __forceinline__ int swap45(int p) { return (p & 15) | ((p & 16) << 1) | ((p & 32) >> 1); }

template <class Map>
__device__ __forceinline__ void tr_item(const float* __restrict__ W, int ldw, int K, bf16_t* WT, LAS float* scr, int kb, int nb, int lane, const Map& cmap, const float* kscale) {
    const int k0 = 64 * kb, n0 = 32 * nb;
    const int sc = cmap(n0 + (lane & 31));
    float v[32];
    const float* src = W + (size_t)(k0 + (lane >> 5)) * ldw + (sc >= 0 ? sc : 0);
#pragma unroll
    for (int i = 0; i < 32; ++i) v[i] = src[(size_t)(2 * i) * ldw];
    if (kscale) {
#pragma unroll
        for (int i = 0; i < 32; ++i) v[i] *= kscale[k0 + 2 * i + (lane >> 5)];
    }
#pragma unroll
    for (int i = 0; i < 32; ++i) scr[(2 * i + (lane >> 5)) * 33 + (lane & 31)] = (sc >= 0) ? v[i] : 0.f;
    asm volatile("s_waitcnt lgkmcnt(0)" ::: "memory");
    const int c = lane & 7;
#pragma unroll
    for (int j = 0; j < 4; ++j) {
        const int n = (lane >> 3) + 8 * j; const LAS float* s = scr + (8 * c) * 33 + n;
        u32x4 o; o.x = cvtpk(s[0 * 33], s[1 * 33]); o.y = cvtpk(s[2 * 33], s[3 * 33]); o.z = cvtpk(s[4 * 33], s[5 * 33]); o.w = cvtpk(s[6 * 33], s[7 * 33]);
        *(u32x4*)(WT + (size_t)(n0 + n) * K + k0 + 8 * c) = o;
    }
    asm volatile("s_waitcnt lgkmcnt(0)" ::: "memory");
}
struct MapIn0 {
    __device__ __forceinline__ int operator()(int nn) const {
        const int blk = nn >> 6, p = nn & 63;
        if (blk < 8) return blk * 64 + swap45(p);
        if (blk < 20) return 512 + (blk - 8) * 64 + swap45(p);
        if (blk < 44) return 1304 + (blk - 20) * 64 + swap45(p);
        if (blk == 44) { if (p < 24) return 1280 + p; if (p < 32) return 2840 + (p - 24); return -1; }
        return -1;
    }
};
struct MapId { __device__ __forceinline__ int operator()(int nn) const { return nn; } };
struct MapIn1 { __device__ __forceinline__ int operator()(int nn) const { return nn < 672 ? nn : -1; } };
struct MapUq { __device__ __forceinline__ int operator()(int nn) const { if (nn < 1024) return (nn >> 6) * 96 + swap45(nn & 63); const int r = nn - 1024; return (r >> 5) * 96 + 64 + (r & 31); } };
struct MapUkv { __device__ __forceinline__ int operator()(int nn) const { if (nn < 1024) return (nn >> 6) * 128 + swap45(nn & 63); const int r = nn - 1024; return (r >> 6) * 128 + 64 + swap45(r & 63); } };

namespace nsa {
using att::f32x16; using att::crow;
#define NMFMA32(a, b, c) __builtin_amdgcn_mfma_f32_32x32x16_bf16(a, b, c, 0, 0, 0)
#define NMFMA16(a, b, c) __builtin_amdgcn_mfma_f32_16x16x32_bf16(a, b, c, 0, 0, 0)
#define RLF(x, l) __uint_as_float(__builtin_amdgcn_readlane((int)__float_as_uint(x), (l)))

__device__ __forceinline__ void compress_job(const MKP& p, LAS float* scr, LAS float* part, int job, int slice, int lane) {
    const int nt = job & 31, g = (job >> 5) & 1, kv = job >> 6;
    const int r32 = lane & 31, hi = lane >> 5, n0 = nt * 32;
    const bf16_t* tok = p.KV6 + (size_t)(kv * 2 + g) * S_ * 64;
    const bf16_t* wt = p.WcT + (size_t)kv * 64 * 2048;
    scr[lane] = p.CBIAS[kv * 64 + lane];
    asm volatile("s_waitcnt lgkmcnt(0)" ::: "memory");
    int nrow = n0 + r32; if (nrow > 1022) nrow = 1022;
    const bf16_t* ta = tok + (size_t)(16 * nrow) * 64 + 8 * hi;
    const bf16_t* wa0 = wt + (size_t)r32 * 2048 + 8 * hi;
    const bf16_t* wa1 = wa0 + (size_t)32 * 2048;
    f32x16 c0 = f32x16{}, c1 = f32x16{};
    if (kv == 0) {
#pragma unroll 8
        for (int s = 32 * slice; s < 32 * slice + 32; ++s) {
            const bf16x8 tf = *(const bf16x8*)(ta + 16 * s), w0 = *(const bf16x8*)(wa0 + 16 * s), w1 = *(const bf16x8*)(wa1 + 16 * s);
            c0 = NMFMA32(w0, tf, c0); c1 = NMFMA32(w1, tf, c1);
        }
        if (slice) {
#pragma unroll
            for (int r = 0; r < 16; ++r) { part[r * 64 + lane] = c0[r]; part[(16 + r) * 64 + lane] = c1[r]; } }
        __syncthreads();
        if (slice) return;
#pragma unroll
        for (int q = 1; q < 4; ++q)
#pragma unroll
            for (int r = 0; r < 16; ++r) { c0[r] += part[q * 2048 + r * 64 + lane]; c1[r] += part[q * 2048 + (16 + r) * 64 + lane]; }
        float ss = 0.f;
#pragma unroll
        for (int r = 0; r < 16; ++r) { c0[r] += scr[crow(r, hi)]; c1[r] += scr[32 + crow(r, hi)]; ss += c0[r] * c0[r] + c1[r] * c1[r]; }
        { auto rr = __builtin_amdgcn_permlane32_swap(__float_as_uint(ss), __float_as_uint(ss), false, false); ss = __uint_as_float(rr[0]) + __uint_as_float(rr[1]); }
        const float rs = rsqrtf(ss * (1.f / 64.f) + EPSF);
        const float* gn = p.in[10];
        if (n0 + r32 < 1023) {
            const int nn = n0 + r32;
            bf16_t* dst = p.KCMP + (size_t)g * 1024 * 64 + (size_t)(nn >> 6) * 4096 + ((nn >> 5) & 1) * 512 + (nn & 31) * 8;
#pragma unroll
            for (int q = 0; q < 4; ++q) {
                const int e0 = 8 * q + 4 * hi;
                const f32x4 ga = *(const f32x4*)(gn + e0), gb = *(const f32x4*)(gn + 32 + e0);
                u32x2 wa, wb;
                wa.x = cvtpk(c0[4 * q] * rs * ga.x, c0[4 * q + 1] * rs * ga.y); wa.y = cvtpk(c0[4 * q + 2] * rs * ga.z, c0[4 * q + 3] * rs * ga.w);
                wb.x = cvtpk(c1[4 * q] * rs * gb.x, c1[4 * q + 1] * rs * gb.y); wb.y = cvtpk(c1[4 * q + 2] * rs * gb.z, c1[4 * q + 3] * rs * gb.w);
                *(u32x2*)(dst + (e0 >> 4) * 1024 + ((e0 >> 3) & 1) * 256 + (e0 & 7)) = wa; *(u32x2*)(dst + ((32 + e0) >> 4) * 1024 + (((32 + e0) >> 3) & 1) * 256 + ((32 + e0) & 7)) = wb;
            }
        }
    } else {
#pragma unroll 8
        for (int s = 32 * slice; s < 32 * slice + 32; ++s) {
            const bf16x8 tf = *(const bf16x8*)(ta + 16 * s), w0 = *(const bf16x8*)(wa0 + 16 * s), w1 = *(const bf16x8*)(wa1 + 16 * s);
            c0 = NMFMA32(tf, w0, c0); c1 = NMFMA32(tf, w1, c1);
        }
        if (slice) {
#pragma unroll
            for (int r = 0; r < 16; ++r) { part[r * 64 + lane] = c0[r]; part[(16 + r) * 64 + lane] = c1[r]; } }
        __syncthreads();
        if (slice) return;
#pragma unroll
        for (int q = 1; q < 4; ++q)
#pragma unroll
            for (int r = 0; r < 16; ++r) { c0[r] += part[q * 2048 + r * 64 + lane]; c1[r] += part[q * 2048 + (16 + r) * 64 + lane]; }
        const float b0 = scr[r32], b1 = scr[32 + r32];
#pragma unroll
        for (int G = 0; G < 2; ++G) {
            u32x4 va, vb;
            va.x = cvtpk(c0[8 * G] + b0, c0[8 * G + 1] + b0); va.y = cvtpk(c0[8 * G + 2] + b0, c0[8 * G + 3] + b0); va.z = cvtpk(c0[8 * G + 4] + b0, c0[8 * G + 5] + b0); va.w = cvtpk(c0[8 * G + 6] + b0, c0[8 * G + 7] + b0);
            vb.x = cvtpk(c1[8 * G] + b1, c1[8 * G + 1] + b1); vb.y = cvtpk(c1[8 * G + 2] + b1, c1[8 * G + 3] + b1); vb.z = cvtpk(c1[8 * G + 4] + b1, c1[8 * G + 5] + b1); vb.w = cvtpk(c1[8 * G + 6] + b1, c1[8 * G + 7] + b1);
            { const int nk = n0 + 16 * G, c_ = nk >> 6, ks_ = (nk >> 4) & 3;
              bf16_t* vd = p.VCT + (size_t)g * 64 * 1024 + (size_t)c_ * 4096 + ks_ * 1024 + (hi * 32 + r32) * 8;
              *(u32x4*)vd = va; *(u32x4*)(vd + 512) = vb; }
        }
    }
    asm volatile("s_waitcnt lgkmcnt(0)" ::: "memory");
}

__device__ __forceinline__ unsigned pk4_fp8(float a, float b, float c, float d) { int w = __builtin_amdgcn_cvt_pk_fp8_f32(a, b, 0, false); w = __builtin_amdgcn_cvt_pk_fp8_f32(c, d, w, true); return (unsigned)w; }
__device__ __forceinline__ void slcfrag_job(const MKP& p, int job, int lane) {
    const int g = job >> 8, blk = job & 255, c16 = lane & 15, u = lane >> 4;
    const bf16_t* k = p.KV6 + (size_t)(2 * 2 + g) * S_ * 64 + (size_t)blk * 64 * 64;
    const bf16_t* v = p.KV6 + (size_t)(3 * 2 + g) * S_ * 64 + (size_t)blk * 64 * 64;
    unsigned char* kd = (unsigned char*)p.KSLF + ((size_t)g * 256 + blk) * 4096 + lane * 16;
    unsigned char* vd = (unsigned char*)p.VSLF + ((size_t)g * 256 + blk) * 4096 + lane * 16;
#pragma unroll
    for (int kg = 0; kg < 4; ++kg) {
        const u32x4 a = *(const u32x4*)(k + (size_t)(16 * kg + c16) * 64 + 8 * u), b = *(const u32x4*)(k + (size_t)(16 * kg + c16) * 64 + 32 + 8 * u);
        u32x4 o;
        o.x = pk4_fp8(__uint_as_float(a.x << 16), __uint_as_float(a.x & 0xffff0000u), __uint_as_float(a.y << 16), __uint_as_float(a.y & 0xffff0000u));
        o.y = pk4_fp8(__uint_as_float(a.z << 16), __uint_as_float(a.z & 0xffff0000u), __uint_as_float(a.w << 16), __uint_as_float(a.w & 0xffff0000u));
        o.z = pk4_fp8(__uint_as_float(b.x << 16), __uint_as_float(b.x & 0xffff0000u), __uint_as_float(b.y << 16), __uint_as_float(b.y & 0xffff0000u));
        o.w = pk4_fp8(__uint_as_float(b.z << 16), __uint_as_float(b.z & 0xffff0000u), __uint_as_float(b.w << 16), __uint_as_float(b.w & 0xffff0000u));
        *(u32x4*)(kd + kg * 1024) = o;
    }
#pragma unroll
    for (int dg = 0; dg < 4; ++dg) {
        float x[16];
#pragma unroll
        for (int ch = 0; ch < 2; ++ch)
#pragma unroll
            for (int j = 0; j < 8; ++j) { const int key = 32 * ch + ((j < 4) ? 4 * u + j : 16 + 4 * u + (j - 4)); x[ch * 8 + j] = bf2f(v[(size_t)key * 64 + 16 * dg + c16]); }
        u32x4 o; o.x = pk4_fp8(x[0], x[1], x[2], x[3]); o.y = pk4_fp8(x[4], x[5], x[6], x[7]); o.z = pk4_fp8(x[8], x[9], x[10], x[11]); o.w = pk4_fp8(x[12], x[13], x[14], x[15]);
        *(u32x4*)(vd + dg * 1024) = o;
    }
}

constexpr int IMP_LD = 272;
__device__ __forceinline__ void cmp_wave(const MKP& p, int g, int t0w, LAS float* imp, LAS unsigned char* stg, int lane) {
    const int r32 = lane & 31, hi = lane >> 5;
    const int tq = t0w + (r32 >> 2), head = g * 4 + (r32 & 3);
    const int nmax = (tq >= 31) ? ((tq - 31) >> 4) : -1;
    const int nmaxw = (t0w + 7 >= 31) ? ((t0w + 7 - 31) >> 4) : -1;
    const int ntile = (nmaxw >> 6) + 1;
    for (int i = lane; i < 8 * IMP_LD; i += 64) imp[i] = 0.f;
    bf16x8 qr[4];
#pragma unroll
    for (int d0 = 0; d0 < 4; ++d0) qr[d0] = *(const bf16x8*)(p.QN + (size_t)tq * 512 + head * 64 + d0 * 16 + hi * 8);
    const bf16_t* kc = p.KCMP + (size_t)g * 1024 * 64 + (hi * 32 + r32) * 8;
    bf16x8 ovf[4];
#pragma unroll
    for (int ks = 0; ks < 4; ++ks)
#pragma unroll
        for (int j = 0; j < 8; ++j) {
            const int nrel = 16 * ks + ((j < 4) ? 4 * hi + j : 8 + 4 * hi + (j - 4));
            const int dlt = nrel - 4 * r32;
            const float w = (dlt >= 0 && dlt <= 2) ? 2.f : ((dlt == 3 || dlt == -1) ? 1.f : 0.f);
            ovf[ks][j] = (short)f2bf(w);
        }
#define CKLOAD(dst, c_) do { const bf16_t* kt_ = kc + (size_t)(c_) * 4096; _Pragma("unroll") for (int f_ = 0; f_ < 8; ++f_) dst[f_] = *(const bf16x8*)(kt_ + f_ * 512); } while (0)
#define CQK(s0, s1, kf) do { s0 = f32x16{}; s1 = f32x16{}; _Pragma("unroll") for (int d0_ = 0; d0_ < 4; ++d0_) { s0 = NMFMA32(kf[2 * d0_], qr[d0_], s0); s1 = NMFMA32(kf[2 * d0_ + 1], qr[d0_], s1); } } while (0)
    float m = -INFINITY, l = 0.f;
    bf16x8 kfa[8], kfb[8];
    if (ntile > 0) CKLOAD(kfa, 0);
#define CMP_P1(KC, KN, c) do { { const int cn_ = ((c) + 1 < ntile) ? (c) + 1 : ntile - 1; CKLOAD(KN, cn_); } \
        f32x16 s0, s1; CQK(s0, s1, KC); \
        const int x = nmax - 64 * (c) - 4 * hi; float tm = -INFINITY; \
        _Pragma("unroll") for (int r = 0; r < 16; ++r) { const int cc = (r & 3) + 8 * (r >> 2); if (cc > x) s0[r] = -INFINITY; if (cc + 32 > x) s1[r] = -INFINITY; tm = fmaxf(tm, fmaxf(s0[r], s1[r])); } \
        if (tm > m) { l *= __builtin_amdgcn_exp2f(m - tm); m = tm; } \
        if (m > -INFINITY) { float sum = 0.f; _Pragma("unroll") for (int r = 0; r < 16; ++r) sum += __builtin_amdgcn_exp2f(s0[r] - m) + __builtin_amdgcn_exp2f(s1[r] - m); l += sum; } } while (0)
#pragma unroll 1
    for (int c = 0; c < ntile; c += 2) { CMP_P1(kfa, kfb, c); if (c + 1 < ntile) CMP_P1(kfb, kfa, c + 1); }
    { auto rm = __builtin_amdgcn_permlane32_swap(__float_as_uint(m), __float_as_uint(m), false, false);
      auto rl = __builtin_amdgcn_permlane32_swap(__float_as_uint(l), __float_as_uint(l), false, false);
      const float ma = __uint_as_float(rm[0]), mb = __uint_as_float(rm[1]), la = __uint_as_float(rl[0]), lb = __uint_as_float(rl[1]);
      const float mm = fmaxf(ma, mb);
      if (mm > -INFINITY) { l = ((ma > -INFINITY) ? la * __builtin_amdgcn_exp2f(ma - mm) : 0.f) + ((mb > -INFINITY) ? lb * __builtin_amdgcn_exp2f(mb - mm) : 0.f); m = mm; }
      else { l = 0.f; m = 0.f; } }
    const float invl = (l > 0.f) ? 1.f / l : 0.f;
    f32x16 o0 = f32x16{}, o1 = f32x16{};
    const bf16_t* vc = p.VCT + (size_t)g * 64 * 1024 + (hi * 32 + r32) * 8;
    if (ntile > 0) CKLOAD(kfa, 0);
    bf16x8 vfr[8];
#define CMP_P2(KC, KN, c) do { \
        { const bf16_t* vt_ = vc + (size_t)(c) * 4096; _Pragma("unroll") for (int f_ = 0; f_ < 8; ++f_) vfr[f_] = *(const bf16x8*)(vt_ + f_ * 512); } \
        { const int cn_ = ((c) + 1 < ntile) ? (c) + 1 : ntile - 1; CKLOAD(KN, cn_); } \
        f32x16 s0, s1; CQK(s0, s1, KC); \
        const int x = nmax - 64 * (c) - 4 * hi; \
        _Pragma("unroll") for (int r = 0; r < 16; ++r) { const int cc = (r & 3) + 8 * (r >> 2); \
            s0[r] = (cc > x) ? 0.f : __builtin_amdgcn_exp2f(s0[r] - m) * invl; s1[r] = (cc + 32 > x) ? 0.f : __builtin_amdgcn_exp2f(s1[r] - m) * invl; } \
        u32x4 pw[4]; \
        pw[0] = (u32x4){cvtpk(s0[0], s0[1]), cvtpk(s0[2], s0[3]), cvtpk(s0[4], s0[5]), cvtpk(s0[6], s0[7])}; \
        pw[1] = (u32x4){cvtpk(s0[8], s0[9]), cvtpk(s0[10], s0[11]), cvtpk(s0[12], s0[13]), cvtpk(s0[14], s0[15])}; \
        pw[2] = (u32x4){cvtpk(s1[0], s1[1]), cvtpk(s1[2], s1[3]), cvtpk(s1[4], s1[5]), cvtpk(s1[6], s1[7])}; \
        pw[3] = (u32x4){cvtpk(s1[8], s1[9]), cvtpk(s1[10], s1[11]), cvtpk(s1[12], s1[13]), cvtpk(s1[14], s1[15])}; \
        f32x16 im = f32x16{}; \
        _Pragma("unroll") for (int ks = 0; ks < 4; ++ks) { const bf16x8 pa = __builtin_bit_cast(bf16x8, pw[ks]); \
            o0 = NMFMA32(pa, vfr[2 * ks], o0); o1 = NMFMA32(pa, vfr[2 * ks + 1], o1); im = NMFMA32(pa, ovf[ks], im); } \
        if (r32 <= 16 && 16 * (c) + r32 < 256) { \
            _Pragma("unroll") for (int k = 0; k < 4; ++k) { const float v = (im[4 * k] + im[4 * k + 1]) + (im[4 * k + 2] + im[4 * k + 3]); atomicAdd((float*)(imp + (2 * k + hi) * IMP_LD + 16 * (c) + r32), v); } } } while (0)
#pragma unroll 1
    for (int c = 0; c < ntile; c += 2) { CMP_P2(kfa, kfb, c); if (c + 1 < ntile) CMP_P2(kfb, kfa, c + 1); }
#undef CMP_P1
#undef CMP_P2
#undef CKLOAD
#undef CQK
    { bf16_t* st = (bf16_t*)stg; bf16_t* stl = st + (4 * hi) * 64 + r32;
#pragma unroll
      for (int r = 0; r < 16; ++r) { stl[((r & 3) + 8 * (r >> 2)) * 64] = f2bf(o0[r]); stl[((r & 3) + 8 * (r >> 2)) * 64 + 32] = f2bf(o1[r]); }
      asm volatile("s_waitcnt lgkmcnt(0)" ::: "memory");
#pragma unroll
      for (int i = 0; i < 4; ++i) { const int row = i * 8 + (lane >> 3), ch = lane & 7; const u32x4 v = *(const u32x4*)(st + row * 64 + ch * 8);
          *(u32x4*)(p.OCMP + (size_t)(t0w + (row >> 2)) * 512 + (g * 4 + (row & 3)) * 64 + ch * 8) = v; }
      asm volatile("s_waitcnt lgkmcnt(0)" ::: "memory"); }
}

__device__ __forceinline__ float dpp_f(float v, int ctrl_sel) {
    const int x = __float_as_int(v);
    int r;
    if (ctrl_sel == 0) r = __builtin_amdgcn_update_dpp(x, x, 0xB1, 0xF, 0xF, false);
    else if (ctrl_sel == 1) r = __builtin_amdgcn_update_dpp(x, x, 0x4E, 0xF, 0xF, false);
    else if (ctrl_sel == 2) r = __builtin_amdgcn_update_dpp(x, x, 0x124, 0xF, 0xF, false);
    else r = __builtin_amdgcn_update_dpp(x, x, 0x128, 0xF, 0xF, false);
    return __int_as_float(r);
}
__device__ __forceinline__ int dpp_i(int x, int ctrl_sel) {
    if (ctrl_sel == 0) return __builtin_amdgcn_update_dpp(x, x, 0xB1, 0xF, 0xF, false);
    if (ctrl_sel == 1) return __builtin_amdgcn_update_dpp(x, x, 0x4E, 0xF, 0xF, false);
    if (ctrl_sel == 2) return __builtin_amdgcn_update_dpp(x, x, 0x124, 0xF, 0xF, false);
    return __builtin_amdgcn_update_dpp(x, x, 0x128, 0xF, 0xF, false);
}
__device__ __forceinline__ void select_wave(int t0w, const LAS float* imp, LAS int* sel, int lane) {
    const int sub = lane & 31;
#pragma unroll 1
    for (int h = 0; h < 4; ++h) {
        const int tk = 2 * h + (lane >> 5);
        const int tq = t0w + tk, cur = tq >> 6;
        float v[8];
#pragma unroll
        for (int i = 0; i < 8; ++i) { const int j = sub + 32 * i; float x = imp[tk * IMP_LD + j]; if (j == 0 || j == cur || j == cur - 1) x += 1e6f; v[i] = (j <= cur) ? x : -INFINITY; }
#pragma unroll 1
        for (int it = 0; it < 16; ++it) {
            float bv = v[0]; int bi = 0;
#pragma unroll
            for (int i = 1; i < 8; ++i) if (v[i] > bv) { bv = v[i]; bi = i; }
            float gm = bv;
#pragma unroll
            for (int c = 0; c < 4; ++c) gm = fmaxf(gm, dpp_f(gm, c));
            gm = fmaxf(gm, __shfl_xor(gm, 16));
            int cj = (bv == gm) ? sub + 32 * bi : 0x7fffffff;
#pragma unroll
            for (int c = 0; c < 4; ++c) cj = min(cj, dpp_i(cj, c));
            cj = min(cj, __shfl_xor(cj, 16));
            const bool any = gm > -INFINITY;
            if (sub == 0) sel[tk * 16 + it] = any ? cj : -1;
            if (any && (cj & 31) == sub) { const int wi = cj >> 5;
#pragma unroll
                for (int i = 0; i < 8; ++i) if (i == wi) v[i] = -INFINITY; }
        }
    }
    asm volatile("s_waitcnt lgkmcnt(0)" ::: "memory");
}

__device__ __forceinline__ void slc_wave(const MKP& p, int g, int t0w, const LAS int* sel, LAS float* oslc, int lane) {
    const int c16 = lane & 15, u = lane >> 4, ti = c16 >> 2;
    const unsigned char* kb = (const unsigned char*)p.KSLF + (size_t)g * 256 * 4096 + lane * 16;
    const unsigned char* vb = (const unsigned char*)p.VSLF + (size_t)g * 256 * 4096 + lane * 16;
#define LO64(vv_) ((long)(((unsigned long long)(vv_).y << 32) | (vv_).x))
#define HI64(vv_) ((long)(((unsigned long long)(vv_)[3] << 32) | (vv_).z))
#define FMFMA(a, b, c) __builtin_amdgcn_mfma_f32_16x16x32_fp8_fp8(a, b, c, 0, 0, 0)
#define KLOAD4(r_) do { _Pragma("unroll") for (int i_ = 0; i_ < 4; ++i_) { int b_ = sel[(tg * 4 + i_) * 16 + (r_)]; b_ = b_ < 0 ? 0 : b_; const unsigned char* kp_ = kb + (size_t)b_ * 4096; \
        _Pragma("unroll") for (int f_ = 0; f_ < 4; ++f_) kc[i_][f_] = *(const u32x4*)(kp_ + f_ * 1024); } } while (0)
#pragma unroll 1
    for (int tg = 0; tg < 2; ++tg) {
        const int tq = t0w + tg * 4 + ti;
        long qa, qb2;
        { const bf16_t* qp = p.QN + (size_t)tq * 512 + (g * 4 + (c16 & 3)) * 64 + 8 * u;
          const u32x4 r0 = *(const u32x4*)qp, r1 = *(const u32x4*)(qp + 32);
          const unsigned a0 = pk4_fp8(8.f * __uint_as_float(r0.x << 16), 8.f * __uint_as_float(r0.x & 0xffff0000u), 8.f * __uint_as_float(r0.y << 16), 8.f * __uint_as_float(r0.y & 0xffff0000u));
          const unsigned a1 = pk4_fp8(8.f * __uint_as_float(r0.z << 16), 8.f * __uint_as_float(r0.z & 0xffff0000u), 8.f * __uint_as_float(r0.w << 16), 8.f * __uint_as_float(r0.w & 0xffff0000u));
          const unsigned b0 = pk4_fp8(8.f * __uint_as_float(r1.x << 16), 8.f * __uint_as_float(r1.x & 0xffff0000u), 8.f * __uint_as_float(r1.y << 16), 8.f * __uint_as_float(r1.y & 0xffff0000u));
          const unsigned b1 = pk4_fp8(8.f * __uint_as_float(r1.z << 16), 8.f * __uint_as_float(r1.z & 0xffff0000u), 8.f * __uint_as_float(r1.w << 16), 8.f * __uint_as_float(r1.w & 0xffff0000u));
          qa = (long)(((unsigned long long)a1 << 32) | a0); qb2 = (long)(((unsigned long long)b1 << 32) | b0); }
        long q0[4], q1[4];
#pragma unroll
        for (int i = 0; i < 4; ++i) { q0[i] = (ti == i) ? qa : 0; q1[i] = (ti == i) ? qb2 : 0; }
        u32x4 kc[4][4], vf[4][4];
        KLOAD4(0);
        float m = -INFINITY, l = 0.f;
        f32x4 o[4]; o[0] = o[1] = o[2] = o[3] = (f32x4){0.f, 0.f, 0.f, 0.f};
#pragma unroll 1
        for (int r = 0; r < 16; ++r) {
#pragma unroll
            for (int i = 0; i < 4; ++i) { int b_ = sel[(tg * 4 + i) * 16 + r]; b_ = b_ < 0 ? 0 : b_; const unsigned char* vp = vb + (size_t)b_ * 4096;
#pragma unroll
                for (int dg = 0; dg < 4; ++dg) vf[i][dg] = *(const u32x4*)(vp + dg * 1024); }
            f32x4 s[4];
#pragma unroll
            for (int kg = 0; kg < 4; ++kg) { f32x4 c = (f32x4){0.f, 0.f, 0.f, 0.f};
#pragma unroll
                for (int i = 0; i < 4; ++i) { c = FMFMA(LO64(kc[i][kg]), q0[i], c); c = FMFMA(HI64(kc[i][kg]), q1[i], c); }
                s[kg] = c * 0.125f; }
            { const int rn = (r < 15) ? r + 1 : 15; KLOAD4(rn); }
            const int myblk = sel[(tg * 4 + ti) * 16 + r];
            { const int x = (myblk < 0) ? -1 : ((myblk == (tq >> 6)) ? tq - 64 * myblk - 4 * u : 64);
#pragma unroll
              for (int kg = 0; kg < 4; ++kg) { if (16 * kg > x) s[kg].x = -INFINITY; if (16 * kg + 1 > x) s[kg].y = -INFINITY; if (16 * kg + 2 > x) s[kg].z = -INFINITY; if (16 * kg + 3 > x) s[kg].w = -INFINITY; } }
            float tm = -INFINITY;
#pragma unroll
            for (int kg = 0; kg < 4; ++kg) tm = fmaxf(tm, fmaxf(fmaxf(s[kg].x, s[kg].y), fmaxf(s[kg].z, s[kg].w)));
            tm = fmaxf(tm, __shfl_xor(tm, 16)); tm = fmaxf(tm, __shfl_xor(tm, 32));
            float alpha = 1.f;
            if (tm > m) { alpha = __builtin_amdgcn_exp2f(m - tm); m = tm; }
            l *= alpha;
            float sum = 0.f;
#pragma unroll
            for (int kg = 0; kg < 4; ++kg) { s[kg].x = __builtin_amdgcn_exp2f(s[kg].x - m); s[kg].y = __builtin_amdgcn_exp2f(s[kg].y - m); s[kg].z = __builtin_amdgcn_exp2f(s[kg].z - m); s[kg].w = __builtin_amdgcn_exp2f(s[kg].w - m);
                sum += (s[kg].x + s[kg].y) + (s[kg].z + s[kg].w); }
            l += sum;
            { const float a0 = __shfl(alpha, 4 * u), a1 = __shfl(alpha, 4 * u + 1), a2 = __shfl(alpha, 4 * u + 2), a3 = __shfl(alpha, 4 * u + 3);
#pragma unroll
              for (int dg = 0; dg < 4; ++dg) { o[dg].x *= a0; o[dg].y *= a1; o[dg].z *= a2; o[dg].w *= a3; } }
#pragma unroll
            for (int ch = 0; ch < 2; ++ch) {
                const f32x4 pa_ = s[2 * ch] * 128.f, pb_ = s[2 * ch + 1] * 128.f;
                const unsigned lo_ = pk4_fp8(pa_.x, pa_.y, pa_.z, pa_.w), hi_ = pk4_fp8(pb_.x, pb_.y, pb_.z, pb_.w);
                const long pa = (long)(((unsigned long long)hi_ << 32) | lo_);
#pragma unroll
                for (int i = 0; i < 4; ++i) { const long pi = (ti == i) ? pa : 0;
#pragma unroll
                    for (int dg = 0; dg < 4; ++dg) o[dg] = FMFMA(pi, ch ? HI64(vf[i][dg]) : LO64(vf[i][dg]), o[dg]); }
            }
        }
        { float lt = l; lt += __shfl_xor(lt, 16); lt += __shfl_xor(lt, 32);
          const float il = (lt > 0.f) ? (1.f / 128.f) / lt : 0.f;
          const float i0 = __shfl(il, 4 * u), i1 = __shfl(il, 4 * u + 1), i2 = __shfl(il, 4 * u + 2), i3 = __shfl(il, 4 * u + 3);
          LAS float* op = oslc + (tg * 4 + u) * 256 + c16;
#pragma unroll
          for (int dg = 0; dg < 4; ++dg) { op[16 * dg] = o[dg].x * i0; op[64 + 16 * dg] = o[dg].y * i1; op[128 + 16 * dg] = o[dg].z * i2; op[192 + 16 * dg] = o[dg].w * i3; } }
    }
#undef KLOAD4
#undef LO64
#undef HI64
#undef FMFMA
    asm volatile("s_waitcnt lgkmcnt(0)" ::: "memory");
    {
        const int tkl = lane >> 3, cc = (lane & 7) * 32, hh = cc >> 6;
        const int tq = t0w + tkl;
        const float* gt = p.GATES + (size_t)tq * 24 + (g * 4 + hh) * 3;
        const float gc = 1.f / (1.f + __expf(-gt[0])), gs = 1.f / (1.f + __expf(-gt[1])), gw = 1.f / (1.f + __expf(-gt[2]));
        const size_t col = (size_t)tq * 512 + g * 256 + cc;
        const LAS float* os = oslc + tkl * 256 + cc;
#pragma unroll
        for (int q = 0; q < 4; ++q) {
            const u32x4 wc = *(const u32x4*)(p.OCMP + col + 8 * q), ww = *(const u32x4*)(p.OWIN + col + 8 * q);
            const f32x4 sa = *(const LAS f32x4*)(os + 8 * q), sb = *(const LAS f32x4*)(os + 8 * q + 4);
            u32x4 r;
            r.x = cvtpk(gs * sa.x + gc * __uint_as_float(wc.x << 16) + gw * __uint_as_float(ww.x << 16), gs * sa.y + gc * __uint_as_float(wc.x & 0xffff0000u) + gw * __uint_as_float(ww.x & 0xffff0000u));
            r.y = cvtpk(gs * sa.z + gc * __uint_as_float(wc.y << 16) + gw * __uint_as_float(ww.y << 16), gs * sa.w + gc * __uint_as_float(wc.y & 0xffff0000u) + gw * __uint_as_float(ww.y & 0xffff0000u));
            r.z = cvtpk(gs * sb.x + gc * __uint_as_float(wc.z << 16) + gw * __uint_as_float(ww.z << 16), gs * sb.y + gc * __uint_as_float(wc.z & 0xffff0000u) + gw * __uint_as_float(ww.z & 0xffff0000u));
            r.w = cvtpk(gs * sb.z + gc * __uint_as_float(wc.w << 16) + gw * __uint_as_float(ww.w << 16), gs * sb.w + gc * __uint_as_float(wc.w & 0xffff0000u) + gw * __uint_as_float(ww.w & 0xffff0000u));
            *(u32x4*)(p.OATT + (size_t)tq * 1024 + g * 256 + cc + 8 * q) = r;
        }
    }
}

__device__ __forceinline__ void nsa_unit(const MKP& p, char* shm, int g, int tile) {
    int tid_ = threadIdx.x; asm volatile("" : "+v"(tid_));
    const int tid = tid_, lane = tid & 63, r32 = lane & 31; const int wid = __builtin_amdgcn_readfirstlane(tid >> 6);
    const int t0 = tile * 64;
    {   att::UnitArgs A;
        A.qrow = p.QN + (size_t)(t0 + 8 * wid + (r32 >> 2)) * 512 + (g * 4 + (r32 & 3)) * 64;
        A.K = p.KV6 + (size_t)(4 * 2 + g) * S_ * 64; A.V = p.KV6 + (size_t)(5 * 2 + g) * S_ * 64; A.kvpitch = 64; A.vpitch = 64;
        A.obase = p.OWIN + (size_t)t0 * 512 + g * 256; A.opitch = 512;
        A.qtok = 8 * wid + (r32 >> 2); A.abase = tile;
        const int real = (tile + 1 < 9) ? tile + 1 : 9; int nt = (real + 1) & ~1; if (nt < 4) nt = 4;
        A.nsteps = nt; A.bias = nullptr;
        att::attn_unit<att::MODE_WIN, true, 8, 64>(A, shm);
    }
    LAS unsigned char* l3 = (LAS unsigned char*)shm;
    LAS float* imp = (LAS float*)(l3 + wid * (8 * IMP_LD * 4));
    LAS int* sel = (LAS int*)(l3 + 8 * (8 * IMP_LD * 4) + wid * 512);
    LAS unsigned char* stg = l3 + 8 * (8 * IMP_LD * 4) + 8 * 512 + wid * 4096;
    const int t0w = t0 + 8 * wid;
    { int ln = lane; asm volatile("" : "+v"(ln)); cmp_wave(p, g, t0w, imp, stg, ln); }
    asm volatile("s_waitcnt vmcnt(0) lgkmcnt(0)" ::: "memory");
    { int ln = lane; asm volatile("" : "+v"(ln)); select_wave(t0w, imp, sel, ln); }
    { int ln = lane; asm volatile("" : "+v"(ln)); slc_wave(p, g, t0w, sel, imp, ln); }
    asm volatile("s_waitcnt vmcnt(0) lgkmcnt(0)\n\ts_barrier" ::: "memory");
}
#undef NMFMA32
#undef NMFMA16
#undef RLF
}

__device__ __forceinline__ void phase_prologue(const MKP& p, LAS unsigned char* lds) {
    const int tid = threadIdx.x, lane = tid & 63, wave = tid >> 6;
    const int gw = blockIdx.x * 8 + wave, NGW = gridDim.x * 8;
    LAS float* scr = (LAS float*)(lds + wave * 16384);
    for (int it = gw; it < 8 * 192; it += NGW) {
        const int kc = it / 192, ch = it % 192, idx = ch * 64 + lane, l = idx / 6144, n = idx % 6144;
        const float* w = p.in[5] + (size_t)l * 1024 * 6144 + n;
        const float* c = p.in[1];
        float acc = 0.f;
#pragma unroll 8
        for (int k = kc * 128; k < kc * 128 + 128; ++k) { const float cv = c[k]; acc += (cv / (1.f + __expf(-cv))) * w[(size_t)k * 6144]; }
        p.modpart[kc * 12288 + idx] = acc;
    }
    if (blockIdx.x == 1 && tid < 128) p.gcnt[tid] = 0;
    if (blockIdx.x == 0 && tid < 96 + 48 + 64) {
        BlkDesc d; d.dst = nullptr; d.gain = nullptr; d.pitch = 0; d.flags = 4; d.scale = 1.f; d.csoff = 0;
        if (tid < 96) {
            const int blk = (tid >> 3) * 4 + ((tid >> 2) & 1) * 2 + ((tid >> 1) & 1);
            d.flags = 0;
            if (blk < 8) { d.dst = p.QN + blk * 64; d.pitch = 512; d.gain = p.in[9]; d.flags = 1; d.scale = C2Q; }
            else if (blk < 20) { const int j = (blk - 8) >> 1, g = (blk - 8) & 1; d.dst = p.KV6 + (size_t)(j * 2 + g) * S_ * 64; d.pitch = 64;
                d.gain = (j == 2 || j == 4) ? p.in[10] : nullptr; d.flags = (j == 0 || j == 2 || j == 4) ? 1 : 0; }
            else if (blk < 28) { d.dst = p.FQ + (blk - 20) * 64; d.pitch = 512; d.gain = p.in[13]; d.scale = C2Q; }
            else if (blk < 36) { d.dst = p.FK + (blk - 28) * 64; d.pitch = 512; d.gain = p.in[14]; }
            else if (blk < 44) { d.dst = p.FV + (blk - 36) * 64; d.pitch = 512; }
            else if (blk == 44) d.flags = 2;
            else d.flags = 4;
            p.desc0[tid] = d;
        } else if (tid < 96 + 48) {
            const int e = tid - 96, pn = e >> 3, bj = (e >> 2) & 1, wc = e & 3;
            if (pn < 4) { const int h = pn * 4 + bj * 2 + (wc >> 1); d.dst = p.Q96 + (size_t)h * S_ * 96; d.pitch = 96; d.gain = p.in[21]; d.flags = 0; d.scale = C2M; }
            else { const int h = (pn - 4) * 8 + bj * 4 + wc; d.dst = p.Q96 + (size_t)h * S_ * 96 + 64; d.pitch = 96; d.gain = p.in[23]; d.flags = 1 | 8; d.scale = C2M; d.csoff = 32; }
            p.desc_uq[e] = d;
        } else {
            const int e = tid - 144, pn = e >> 3, bj = (e >> 2) & 1, wc = e & 3;
            const int h = (pn & 3) * 4 + bj * 2 + (wc >> 1);
            if (pn < 4) { d.dst = p.K96 + (size_t)h * S_ * 96; d.pitch = 96; d.gain = p.in[22]; d.flags = 32; }
            else { d.dst = p.V1 + (size_t)h * S_ * 64; d.pitch = 64; d.gain = nullptr; d.flags = 64; }
            p.desc_ukv[e] = d;
        }
    }
    if (blockIdx.x == 2 || blockIdx.x == 3) {
        const int kv = blockIdx.x - 2, e = tid & 63, sl = tid >> 6;
        const float* w = p.in[12] + (size_t)kv * 2048 * 64 + e; const float* pe = p.in[11] + kv * 2048;
        float b = 0.f;
#pragma unroll 8
        for (int k = sl * 256; k < sl * 256 + 256; ++k) b += pe[k] * w[(size_t)k * 64];
        LAS float* red = (LAS float*)(lds + 140000);
        red[tid] = b;
        __syncthreads();
        if (tid < 64) { float a = 0.f;
#pragma unroll
            for (int q = 0; q < 8; ++q) a += red[q * 64 + tid];
            p.CBIAS[kv * 64 + tid] = a; }
    }
    for (int idx = blockIdx.x * MK_THREADS + tid; idx < S_ * 48; idx += gridDim.x * MK_THREADS) {
        const int t = idx / 48, i = idx % 48;
        const double ex = (i < 32) ? (double)(2 * i) / 64.0 : (double)(2 * (i - 32)) / 32.0;
        const double a = (double)p.pos[t] * exp(-ex * 9.210340371976184);
        const double r = a - rint(a * 0.15915494309189535) * 6.283185307179586;
        const float rf = (float)r;
        p.cosT[idx] = cosf(rf); p.sinT[idx] = sinf(rf);
    }
    for (int it = gw; it < 2 * 32 * 2; it += NGW) { const int kv = it >> 6, r = it & 63; tr_item(p.in[12] + (size_t)kv * 2048 * 64, 64, 2048, p.WcT + (size_t)kv * 64 * 2048, scr, r >> 1, r & 1, lane, MapId(), nullptr); }
    constexpr int I_IN0 = 16 * 96, I_OUT0 = 16 * 32, I_IN1 = 16 * 24, I_UQ = 6 * 48, I_UKV = 4 * 64, I_OUT1 = 16 * 32;
    for (int it = gw; it < I_IN0 + I_OUT0 + I_IN1 + I_UQ + I_UKV + I_OUT1; it += NGW) {
        int r = it;
        if (r < I_IN0) { tr_item(p.in[7], HYIN, 1024, p.W_in0t, scr, r / 96, r % 96, lane, MapIn0(), nullptr); continue; } r -= I_IN0;
        if (r < I_OUT0) { tr_item(p.in[15], 1024, 1024, p.W_out0t, scr, r / 32, r % 32, lane, MapId(), nullptr); continue; } r -= I_OUT0;
        if (r < I_IN1) { tr_item(p.in[16], 672, 1024, p.W_in1t, scr, r / 24, r % 24, lane, MapIn1(), nullptr); continue; } r -= I_IN1;
        if (r < I_UQ) { tr_item(p.in[19], 1536, 384, p.W_uqt, scr, r / 48, r % 48, lane, MapUq(), p.in[17]); continue; } r -= I_UQ;
        if (r < I_UKV) { tr_item(p.in[20], 2048, 256, p.W_ukvt, scr, r / 64, r % 64, lane, MapUkv(), p.in[18]); continue; } r -= I_UKV;
        tr_item(p.in[25], 1024, 1024, p.W_out1t, scr, r / 32, r % 32, lane, MapId(), nullptr);
    }
}

template <bool COMB>
__device__ __forceinline__ void phase_norm(const MKP& p, LAS unsigned char* lds, const float* x, const float* gw_, int layer, int sc_idx, int sh_idx, bool finalize_mod) {
    const int tid = threadIdx.x, lane = tid & 63, wave = tid >> 6;
    LAS float* msc = (LAS float*)(lds + LDS_MOD);
    LAS float* msh = msc + 1024;
    const float* b_ada = p.in[6];
    if (finalize_mod) {
        for (int i = tid; i < 2048; i += MK_THREADS) {
            const int idx = layer * 6144 + ((i < 1024) ? sc_idx * 1024 + i : sh_idx * 1024 + (i - 1024));
            float a = b_ada[idx];
#pragma unroll
            for (int kc = 0; kc < 8; ++kc) a += p.modpart[kc * 12288 + idx];
            msc[i] = a;
        }
        for (int idx = blockIdx.x * MK_THREADS + tid; idx < 12288; idx += gridDim.x * MK_THREADS) {
            float a = b_ada[idx];
#pragma unroll
            for (int kc = 0; kc < 8; ++kc) a += p.modpart[kc * 12288 + idx];
            p.mod[idx] = a;
        }
    } else {
        for (int i = tid; i < 2048; i += MK_THREADS)
            msc[i] = p.mod[layer * 6144 + ((i < 1024) ? sc_idx * 1024 + i : sh_idx * 1024 + (i - 1024))];
    }
    __syncthreads();
    const int gwv = blockIdx.x * 8 + wave, NGW = gridDim.x * 8;
    for (int m = gwv; m < S_; m += NGW) {
        const f32x4* xr = (const f32x4*)(x + (size_t)m * D_) + lane;
        f32x4 v[4]; float s = 0.f;
#pragma unroll
        for (int j = 0; j < 4; ++j) {
            v[j] = xr[64 * j];
            if (COMB) {
                f32x4 ys = (f32x4){0.f, 0.f, 0.f, 0.f};
#pragma unroll
                for (int k = 0; k < 8; ++k) {
                    const int w = *((const int*)((const char*)p.YBUF + ((size_t)m * 8 + k) * 1024) + lane + 64 * j);
                    const f32x2 lo = __builtin_amdgcn_cvt_pk_f32_fp8(w, false), hi = __builtin_amdgcn_cvt_pk_f32_fp8(w, true);
                    ys.x += lo.x; ys.y += lo.y; ys.z += hi.x; ys.w += hi.y;
                }
                { const u32x2 sw = *((const u32x2*)(p.YS + (size_t)m * 1024) + lane + 64 * j);
                  ys.x += 16.f * __uint_as_float(sw.x << 16); ys.y += 16.f * __uint_as_float(sw.x & 0xffff0000u); ys.z += 16.f * __uint_as_float(sw.y << 16); ys.w += 16.f * __uint_as_float(sw.y & 0xffff0000u); }
                const f32x4 g2v = *(const f32x4*)(p.mod + (layer - 1) * 6144 + 5 * 1024 + 256 * j + 4 * lane) * (1.f / 16.f);
                v[j] = v[j] + g2v * ys;
                ((f32x4*)(p.out + (size_t)m * D_) + lane)[64 * j] = v[j];
            }
            s += (v[j].x * v[j].x + v[j].y * v[j].y) + (v[j].z * v[j].z + v[j].w * v[j].w);
        }
        s = wsum(s);
        const float rstd = rsqrtf(s * (1.f / D_) + EPSF);
        u32x2* o8 = (u32x2*)(p.XN + (size_t)m * D_) + lane;
#pragma unroll
        for (int j = 0; j < 4; ++j) {
            const int c0 = 256 * j + 4 * lane;
            const f32x4 g = *(const f32x4*)(gw_ + c0);
            const f32x4 sc = *(const LAS f32x4*)(msc + c0), sh = *(const LAS f32x4*)(msh + c0);
            const f32x4 y = v[j] * rstd * g * (sc + 1.f) + sh;
            u32x2 w; w.x = cvtpk(y.x, y.y); w.y = cvtpk(y.z, y.w);
            o8[64 * j] = w;
        }
    }
}

struct EpiResid {
    static constexpr bool PERM = true;
    const float* xin; float* out; const float* gate;
    __device__ __forceinline__ void operator()(const f32x4 (&acc)[2][2][4][2], const pg::Unit& u, int wid, int wr, int wc, int fr_, int fq_) const {
        int fr = fr_, fq = fq_; asm volatile("" : "+v"(fr), "+v"(fq));
        const int col0 = u.pn * 256 + wc * 32 + 8 * fq;
        f32x4 g[2][2];
#pragma unroll
        for (int bj = 0; bj < 2; ++bj)
#pragma unroll
            for (int n = 0; n < 2; ++n) g[bj][n] = *(const f32x4*)(gate + col0 + bj * 128 + n * 4);
#pragma unroll
        for (int ai = 0; ai < 2; ++ai)
#pragma unroll
            for (int m = 0; m < 4; ++m) {
                const size_t off = (size_t)(u.pm * 256 + ai * 128 + wr * 64 + m * 16 + fr) * 1024 + col0;
#pragma unroll
                for (int bj = 0; bj < 2; ++bj)
#pragma unroll
                    for (int n = 0; n < 2; ++n) {
                        const f32x4 xv = *(const f32x4*)(xin + off + bj * 128 + n * 4);
                        *(f32x4*)(out + off + bj * 128 + n * 4) = xv + g[bj][n] * acc[ai][bj][m][n];
                    }
                asm volatile("" ::: "memory");
            }
    }
};

struct EpiHeads {
    static constexpr bool PERM = false;
    const BlkDesc* tab; const float* cosT; const float* sinT; float* GATES; float* LOGF; LAS float* X;
    __device__ __forceinline__ void operator()(const f32x4 (&acc)[2][2][4][2], const pg::Unit& u, int wid, int wr, int wc, int fr_, int fq_) const {
        int fr = fr_, fq = fq_; asm volatile("" : "+v"(fr), "+v"(fq));
        const int w1 = wc & 1;
#pragma unroll
        for (int ai = 0; ai < 2; ++ai)
#pragma unroll
            for (int bj = 0; bj < 2; ++bj)
#pragma unroll
                for (int m = 0; m < 4; ++m) {
                    const f32x4 a = acc[ai][bj][m][0], b = acc[ai][bj][m][1];
                    float s = (a.x * a.x + a.y * a.y) + (a.z * a.z + a.w * a.w) + (b.x * b.x + b.y * b.y) + (b.z * b.z + b.w * b.w);
                    s += __shfl_xor(s, 16); s += __shfl_xor(s, 32);
                    if (fq == 0) X[wid * 256 + ((ai * 2 + bj) * 4 + m) * 16 + fr] = s;
                }
        asm volatile("s_waitcnt lgkmcnt(0)" ::: "memory"); __builtin_amdgcn_s_barrier(); asm volatile("" ::: "memory");
#pragma unroll
        for (int bj = 0; bj < 2; ++bj) {
            const BlkDesc d = tab[8 * u.pn + 4 * bj + wc];
            const int row0 = u.pm * 256 + wr * 64 + fr;
            if (d.flags & 4) continue;
            if (d.flags & 2) {
                if (w1 == 0) {
#pragma unroll
                    for (int ai = 0; ai < 2; ++ai)
#pragma unroll
                        for (int m = 0; m < 4; ++m) {
                            const int row = row0 + ai * 128 + m * 16;
#pragma unroll
                            for (int n = 0; n < 2; ++n) {
                                const f32x4 v = acc[ai][bj][m][n];
                                const int pc = 16 * n + 4 * fq;
                                if (pc < 24) *(f32x4*)(GATES + (size_t)row * 24 + pc) = v;
                                else *(f32x4*)(LOGF + (size_t)row * 8 + (pc - 24)) = v;
                            }
                            asm volatile("" ::: "memory");
                        }
                }
                continue;
            }
            const bool half = (d.flags & 8) != 0, has_gain = d.gain != nullptr, rope = (d.flags & 1) != 0;
            const int d0 = half ? 4 * fq : 16 * w1 + 4 * fq;
            const int dn1 = half ? 16 : 32;
            const float invn = half ? (1.f / 32.f) : (1.f / 64.f);
            const GAS float* gp = (const GAS float*)(has_gain ? d.gain : cosT);
            f32x4 g0 = *(const GAS f32x4*)(gp + d0), g1 = *(const GAS f32x4*)(gp + dn1 + d0);
            if (!has_gain) { g0 = (f32x4){1.f, 1.f, 1.f, 1.f}; g1 = g0; }
            g0 = g0 * d.scale; g1 = g1 * d.scale;
            const int cso = d.csoff + d0;
#pragma unroll
            for (int ai = 0; ai < 2; ++ai)
#pragma unroll
                for (int m = 0; m < 4; ++m) {
                    const int row = row0 + ai * 128 + m * 16;
                    const int xi = ((ai * 2 + bj) * 4 + m) * 16 + fr;
                    float ssq = X[wid * 256 + xi]; const float ssp = X[(wid ^ 1) * 256 + xi];
                    if (!half) ssq += ssp;
                    const float rs = has_gain ? rsqrtf(ssq * invn + EPSF) : 1.f;
                    f32x4 x1 = acc[ai][bj][m][0] * rs * g0, x2 = acc[ai][bj][m][1] * rs * g1;
                    f32x4 c = *(const f32x4*)(cosT + (size_t)row * 48 + cso), sn = *(const f32x4*)(sinT + (size_t)row * 48 + cso);
                    if (!rope) { c = (f32x4){1.f, 1.f, 1.f, 1.f}; sn = (f32x4){0.f, 0.f, 0.f, 0.f}; }
                    const f32x4 o1 = x1 * c - x2 * sn, o2 = x2 * c + x1 * sn;
                    u32x2 wa, wb; wa.x = cvtpk(o1.x, o1.y); wa.y = cvtpk(o1.z, o1.w); wb.x = cvtpk(o2.x, o2.y); wb.y = cvtpk(o2.z, o2.w);
                    if (d.flags & 32) {
                        GAS bf16_t* tb = (GAS bf16_t*)d.dst + (size_t)(row >> 6) * 6144 + (row & 63) * 8 + (d0 & 7);
                        *(GAS u32x2*)(tb + (d0 >> 3) * 512) = wa; *(GAS u32x2*)(tb + ((dn1 + d0) >> 3) * 512) = wb;
                    } else if (d.flags & 64) {
                        GAS bf16_t* tb = (GAS bf16_t*)d.dst + (size_t)(row >> 6) * 4096 + ((row >> 4) & 3) * 512 + (row & 15) * 32 + (d0 & 7);
                        *(GAS u32x2*)(tb + (d0 >> 5) * 2048 + ((d0 >> 3) & 3) * 8) = wa; *(GAS u32x2*)(tb + ((dn1 + d0) >> 5) * 2048 + (((dn1 + d0) >> 3) & 3) * 8) = wb;
                    } else {
                        GAS bf16_t* dr = (GAS bf16_t*)d.dst + (size_t)row * d.pitch + d0;
                        *(GAS u32x2*)dr = wa; *(GAS u32x2*)(dr + dn1) = wb;
                    }
                    asm volatile("" ::: "memory");
                }
        }
    }
};

struct EpiPlain {
    static constexpr bool PERM = true;
    bf16_t* O; int ldc;
    __device__ __forceinline__ void operator()(const f32x4 (&acc)[2][2][4][2], const pg::Unit& u, int wid, int wr, int wc, int fr_, int fq_) const {
        int fr = fr_, fq = fq_; asm volatile("" : "+v"(fr), "+v"(fq));
        const int col0 = u.pn * 256 + wc * 32 + 8 * fq;
#pragma unroll
        for (int ai = 0; ai < 2; ++ai)
#pragma unroll
            for (int m = 0; m < 4; ++m) {
                bf16_t* rp = O + (size_t)(u.pm * 256 + ai * 128 + wr * 64 + m * 16 + fr) * ldc + col0;
#pragma unroll
                for (int bj = 0; bj < 2; ++bj) { const f32x4 a = acc[ai][bj][m][0], b = acc[ai][bj][m][1];
                    u32x4 w; w.x = cvtpk(a.x, a.y); w.y = cvtpk(a.z, a.w); w.z = cvtpk(b.x, b.y); w.w = cvtpk(b.z, b.w); *(u32x4*)(rp + bj * 128) = w; }
            }
    }
};

__device__ __forceinline__ void phase_post1a(const MKP& p) {
    int tid_ = threadIdx.x; asm volatile("" : "+v"(tid_));
    const int tid = tid_, lane = tid & 63, wave = tid >> 6;
    const int gwv = blockIdx.x * 8 + wave, NGW = gridDim.x * 8;
    for (int t = gwv; t < S_; t += NGW) {
        const u32x2* row = (const u32x2*)(p.P1 + (size_t)t * 768);
        f32x4 v[3]; float sq = 0.f, skv = 0.f, skr = 0.f;
#pragma unroll
        for (int j = 0; j < 3; ++j) {
            const int g = lane + 64 * j;
            f32x4 x = (f32x4){0.f, 0.f, 0.f, 0.f};
            if (g < 168) { const u32x2 w = row[g]; x.x = __uint_as_float(w.x << 16); x.y = __uint_as_float(w.x & 0xffff0000u); x.z = __uint_as_float(w.y << 16); x.w = __uint_as_float(w.y & 0xffff0000u); }
            v[j] = x;
            const float s = (x.x * x.x + x.y * x.y) + (x.z * x.z + x.w * x.w);
            if (g < 96) sq += s; else if (g < 160) skv += s; else skr += s;
        }
        sq = wsum(sq); skv = wsum(skv); skr = wsum(skr);
        const float rq = rsqrtf(sq * (1.f / 384.f) + EPSF), rkv = rsqrtf(skv * (1.f / 256.f) + EPSF), rkr = rsqrtf(skr * (1.f / 32.f) + EPSF);
#pragma unroll
        for (int j = 0; j < 3; ++j) {
            const int g = lane + 64 * j;
            if (g < 96) { const f32x4 y = v[j] * rq; u32x2 w; w.x = cvtpk(y.x, y.y); w.y = cvtpk(y.z, y.w); *(u32x2*)(p.CQN + (size_t)t * 384 + 4 * g) = w; }
            else if (g < 160) { const f32x4 y = v[j] * rkv; u32x2 w; w.x = cvtpk(y.x, y.y); w.y = cvtpk(y.z, y.w); *(u32x2*)(p.CKVN + (size_t)t * 256 + 4 * (g - 96)) = w; }
        }
        {
            const int dl = (lane - 32) & 7;
            const int dd = 4 * dl;
            const int fi = 4 * (dl & 3);
            f32x4 x = v[2] * rkr;
            const f32x4 gn = *(const f32x4*)(p.in[24] + (dd & 31));
            x = x * gn;
            f32x4 o; o.x = __shfl_xor(x.x, 4); o.y = __shfl_xor(x.y, 4); o.z = __shfl_xor(x.z, 4); o.w = __shfl_xor(x.w, 4);
            const f32x4 c = *(const f32x4*)(p.cosT + (size_t)t * 48 + 32 + fi), sn = *(const f32x4*)(p.sinT + (size_t)t * 48 + 32 + fi);
            const f32x4 y = (dl < 4) ? (x * c - o * sn) : (x * c + o * sn);
            if (lane >= 32 && lane < 40) {
                u32x2 w; w.x = cvtpk(y.x, y.y); w.y = cvtpk(y.z, y.w);
#pragma unroll
                for (int h = 0; h < 16; ++h) *(u32x2*)(p.K96 + (size_t)h * S_ * 96 + (size_t)(t >> 6) * 6144 + (8 + (dd >> 3)) * 512 + (t & 63) * 8 + (dd & 7)) = w;
            }
        }
    }
}

__device__ __forceinline__ void mla_unit(const MKP& p, char* shm, int h, int qb) {
    int tid_ = threadIdx.x; asm volatile("" : "+v"(tid_));
    const int tid = tid_, lane = tid & 63, r32 = lane & 31; const int wid = __builtin_amdgcn_readfirstlane(tid >> 6);
    const int q0 = qb * 256;
    att::UnitArgs A;
    A.qrow = p.Q96 + ((size_t)h * S_ + q0 + 32 * wid + r32) * 96;
    A.K = p.K96 + (size_t)h * S_ * 96; A.kvpitch = 96; A.V = p.V1 + (size_t)h * S_ * 64; A.vpitch = 64;
    A.obase = p.OATT + (size_t)q0 * 1024 + h * 64; A.opitch = 1024;
    A.qtok = 32 * wid + r32; A.abase = 4 * qb; A.nsteps = 4 * qb + 4; A.bias = nullptr;
    att::attn_unit<att::MODE_CAUSAL, false, 8, 96, true>(A, shm);
}
__device__ __forceinline__ void phase_mla(const MKP& p, char* shm) {
    const int G = gridDim.x, bx = blockIdx.x;
    const int vcu = (G % 8 == 0) ? (bx % 8) * (G / 8) + bx / 8 : bx;
    for (int u = vcu; u < 256; u += G) {
        const int h = u >> 4, s = u & 15;
#pragma unroll 1
        for (int rep = 0; rep < 4; ++rep) mla_unit(p, shm, h, rep == 0 ? s : rep == 1 ? 31 - s : rep == 2 ? 32 + s : 63 - s);
    }
}

__device__ __forceinline__ void phase_scan(const MKP& p, LAS unsigned char* lds) {
    constexpr int NSB = 64;
    if (blockIdx.x >= NSB) {
        int tid_ = threadIdx.x; asm volatile("" : "+v"(tid_));
        const int lane = tid_ & 63, wave = tid_ >> 6;
        const int sb = blockIdx.x - NSB, NSBK = gridDim.x - NSB;
        LAS float* scr = (LAS float*)(lds + 65536 + wave * 256);
        for (int bj = sb; bj < 64; bj += NSBK) nsa::compress_job(p, scr, (LAS float*)(lds + (wave >> 2) * 32768) + (wave & 3) * 2048, 2 * bj + (wave >> 2), wave & 3, lane);
        for (int j = ((sb + NSBK - 64) % NSBK) * 8 + wave; j < 512; j += NSBK * 8) nsa::slcfrag_job(p, j, lane);
        return;
    }
    const int h = blockIdx.x >> 3, seg = blockIdx.x & 7, tid = threadIdx.x;
    LAS double* part = (LAS double*)lds;
    const float fb = p.in[8][h];
    double own[4], s = 0.0, pre = 0.0;
#pragma unroll
    for (int i = 0; i < 4; ++i) { own[i] = (double)logsigmf(p.LOGF[(size_t)(seg * 2048 + tid * 4 + i) * 8 + h] + fb); s += own[i]; }
    for (int i = tid; i < seg * 2048; i += MK_THREADS) pre += (double)logsigmf(p.LOGF[(size_t)i * 8 + h] + fb);
    part[tid] = s; part[512 + tid] = pre;
    __syncthreads();
    for (int o = 1; o < MK_THREADS; o <<= 1) {
        const double v = (tid >= o) ? part[tid - o] : 0.0, w = (tid >= o) ? part[512 + tid - o] : 0.0;
        __syncthreads();
        part[tid] += v; part[512 + tid] += w;
        __syncthreads();
    }
    double a = part[512 + MK_THREADS - 1] + ((tid > 0) ? part[tid - 1] : 0.0);
#pragma unroll
    for (int i = 0; i < 4; ++i) { a += own[i]; p.CUMB[(size_t)h * S_ + seg * 2048 + tid * 4 + i] = (float)(a * 1.4426950408889634); }
}

__device__ __forceinline__ void fox_unit(const MKP& p, char* shm, int h, int qb) {
    int tid_ = threadIdx.x; asm volatile("" : "+v"(tid_));
    const int tid = tid_, lane = tid & 63, r32 = lane & 31; const int wid = __builtin_amdgcn_readfirstlane(tid >> 6);
    const int q0 = qb * 256, abase = 4 * qb;
    const float* cb = p.CUMB + (size_t)h * S_;
    LAS float* bias = (LAS float*)(LAS unsigned char*)(shm + att::LDS_BIAS);
    LAS int* cnt = (LAS int*)(LAS unsigned char*)(shm + att::Geo<64>::LDS_WS);
    float gq = 0.f, gk = 0.f;
    for (int i = 0; i < 64; ++i) { gq = fmaxf(gq, fabsf(p.in[13][i])); gk = fmaxf(gk, fabsf(p.in[14][i])); }
    const float TH = 150.f + 2.f * (64.f * gq * gk * C2Q * 1.05f);
    const float c0 = cb[q0], cref = cb[q0 + 255];
    const bool skip = (tid < abase) && (cb[64 * tid + 63] - c0 > TH);
    const unsigned long long bal = __ballot(skip);
    if (lane == 0) cnt[wid] = __popcll(bal);
    __syncthreads();
    int alo = 0;
#pragma unroll
    for (int w = 0; w < 8; ++w) alo += cnt[w];
    int NT = abase + 4 - alo;
    if (NT & 1) { alo -= 1; NT += 1; }
    for (int i = tid; i < NT * 64; i += MK_THREADS) bias[i] = cref - cb[64 * alo + i];
    __syncthreads();
    att::UnitArgs A;
    A.qrow = p.FQ + (size_t)(q0 + 32 * wid + r32) * 512 + h * 64;
    A.K = p.FK + h * 64; A.V = p.FV + h * 64; A.kvpitch = 512; A.vpitch = 512;
    A.obase = p.OATT + (size_t)q0 * 1024 + 512 + h * 64; A.opitch = 1024;
    A.qtok = 32 * wid + r32; A.abase = abase; A.nsteps = NT; A.bias = bias;
    att::attn_unit<att::MODE_FOX, false, 8, 64>(A, shm);
}
__device__ __forceinline__ void phase_fox(const MKP& p, char* shm, int part = 3) {
    const int G = gridDim.x, bx = blockIdx.x;
    const int vcu = (G % 8 == 0) ? (bx % 8) * (G / 8) + bx / 8 : bx;
    if (part & 1) for (int u = vcu; u < 256; u += G) {
        const int h = u >> 5, s = u & 31;
#pragma unroll 1
        for (int rep = 0; rep < 2; ++rep) fox_unit(p, shm, h, rep ? 63 - s : s);
    }
    if (part & 2) for (int u = vcu; u < 256; u += G) {
#pragma unroll 1
        for (int rep = 0; rep < 2; ++rep) nsa::nsa_unit(p, shm, rep, rep ? 255 - u : u);
    }
}


struct MapOff { int off; __device__ __forceinline__ int operator()(int nn) const { return off + (nn & 31); } };
__device__ __forceinline__ void phase_moe_weights(const MKP& p, LAS unsigned char* lds, int layer) {
    int tid_ = threadIdx.x; asm volatile("" : "+v"(tid_));
    const int tid = tid_, lane = tid & 63, wave = tid >> 6;
    const int gw = blockIdx.x * 8 + wave, NGW = gridDim.x * 8;
    LAS float* scr = (LAS float*)(lds + wave * 16384);
    constexpr int IG = 16 * 16, ID = 4 * 32, IE = IG + ID;
    for (int it = gw; it < 65 * IE; it += NGW) {
        const int e = it / IE; int r = it % IE;
        if (r < IG) {
            const int kb = r / 16, nb = r % 16;
            const int n0 = nb * 32, up = (n0 >> 7) & 1, f0 = (n0 >> 8) * 128 + (n0 & 127);
            const float* W = (e < 64) ? ((up ? p.in[29] : p.in[28]) + ((size_t)layer * 64 + e) * 1024 * 256) : ((up ? p.in[32] : p.in[31]) + (size_t)layer * 1024 * 256);
            MapOff mo{f0};
            tr_item(W, 256, 1024, p.Wgu + (size_t)e * 512 * 1024, scr, kb, nb, lane, mo, nullptr);
        } else {
            r -= IG; const int kb = r / 32, nb = r % 32;
            const float* W = (e < 64) ? (p.in[30] + ((size_t)layer * 64 + e) * 256 * 1024) : (p.in[33] + (size_t)layer * 256 * 1024);
            tr_item(W, 1024, 256, p.Wd + (size_t)e * 1024 * 256, scr, kb, nb, lane, MapId(), nullptr);
        }
    }
}

template <bool DRY>
__device__ __forceinline__ void phase_moe_route(const MKP& p, LAS unsigned char* lds, int layer) {
    int tid_ = threadIdx.x; asm volatile("" : "+v"(tid_));
    const int tid = tid_, lane = tid & 63, wave = tid >> 6;
    LAS float* msc = (LAS float*)(lds + LDS_MOD);
    LAS float* msh = msc + 1024;
    LAS float* hrow = (LAS float*)lds;
    LAS int* cntl = (LAS int*)(lds + LDS_X);
    LAS int* basel = cntl + 64;
    const float* gnorm = p.in[4] + layer * 1024;
    const float* wr = p.in[26] + (size_t)layer * 1024 * 64;
    const float rb = p.in[27][layer * 64 + lane];
    for (int i = tid; i < 2048; i += MK_THREADS) msc[i] = p.mod[layer * 6144 + ((i < 1024) ? 4 * 1024 + i : 3 * 1024 + (i - 1024))];
    __syncthreads();
    for (int batch = blockIdx.x; batch < S_ / 32; batch += gridDim.x) {
        if (tid < 64) cntl[tid] = 0;
        {
            f32x4 v[4][4];
#pragma unroll
            for (int i = 0; i < 4; ++i) {
                const f32x4* xr = (const f32x4*)(p.out + (size_t)(batch * 32 + wave * 4 + i) * D_) + lane;
#pragma unroll
                for (int j = 0; j < 4; ++j) v[i][j] = xr[64 * j];
            }
#pragma unroll
            for (int i = 0; i < 4; ++i) {
                const int t = batch * 32 + wave * 4 + i;
                float s = 0.f;
#pragma unroll
                for (int j = 0; j < 4; ++j) s += (v[i][j].x * v[i][j].x + v[i][j].y * v[i][j].y) + (v[i][j].z * v[i][j].z + v[i][j].w * v[i][j].w);
                s = wsum(s);
                const float rstd = rsqrtf(s * (1.f / D_) + EPSF);
                u32x2* o8 = (u32x2*)(p.XN + (size_t)t * D_) + lane;
                LAS f32x4* hr = (LAS f32x4*)(hrow + (wave * 4 + i) * 1024) + lane;
#pragma unroll
                for (int j = 0; j < 4; ++j) {
                    const int c0 = 256 * j + 4 * lane;
                    const f32x4 g = *(const f32x4*)(gnorm + c0);
                    const f32x4 sc = *(const LAS f32x4*)(msc + c0), sh = *(const LAS f32x4*)(msh + c0);
                    const f32x4 y = v[i][j] * rstd * g * (sc + 1.f) + sh;
                    u32x2 w; w.x = cvtpk(y.x, y.y); w.y = cvtpk(y.z, y.w);
                    o8[64 * j] = w; hr[64 * j] = y;
                }
            }
        }
        __syncthreads();
        float acc0, acc1, acc2, acc3;
        {
            float acc[32];
#pragma unroll
            for (int r = 0; r < 32; ++r) acc[r] = 0.f;
            const float* wk = wr + (size_t)(wave * 128) * 64 + lane;
            const LAS float* hk = hrow + wave * 128;
            float wn[8];
#pragma unroll
            for (int j = 0; j < 8; ++j) wn[j] = wk[j * 64];
#pragma unroll 1
            for (int k0 = 0; k0 < 128; k0 += 8) {
                float w[8];
#pragma unroll
                for (int j = 0; j < 8; ++j) w[j] = wn[j];
                const int kn = (k0 + 8 < 128) ? k0 + 8 : 0;
#pragma unroll
                for (int j = 0; j < 8; ++j) wn[j] = wk[(kn + j) * 64];
#pragma unroll
                for (int r = 0; r < 32; ++r) {
                    const f32x4 a = *(const LAS f32x4*)(hk + r * 1024 + k0), b = *(const LAS f32x4*)(hk + r * 1024 + k0 + 4);
                    acc[r] += a.x * w[0]; acc[r] += a.y * w[1]; acc[r] += a.z * w[2]; acc[r] += a.w * w[3];
                    acc[r] += b.x * w[4]; acc[r] += b.y * w[5]; acc[r] += b.z * w[6]; acc[r] += b.w * w[7];
                }
            }
            __syncthreads();
            LAS float* part = hrow + wave * 2048 + lane;
#pragma unroll
            for (int r = 0; r < 32; ++r) part[r * 64] = acc[r];
            __syncthreads();
            const LAS float* pr = hrow + (wave * 4) * 64 + lane;
            acc0 = 0.f; acc1 = 0.f; acc2 = 0.f; acc3 = 0.f;
#pragma unroll
            for (int q = 0; q < 8; ++q) { acc0 += pr[q * 2048]; acc1 += pr[q * 2048 + 64]; acc2 += pr[q * 2048 + 128]; acc3 += pr[q * 2048 + 192]; }
        }
        int myrank[4], mypos[4]; float myw[4];
#pragma unroll
        for (int i = 0; i < 4; ++i) {
            const float logit = (i == 0) ? acc0 : (i == 1) ? acc1 : (i == 2) ? acc2 : acc3;
            const float score = 1.f / (1.f + expf(-logit));
            const float sv = score + rb;
            float m1 = sv;
            m1 = fmaxf(m1, __shfl_xor(m1, 1)); m1 = fmaxf(m1, __shfl_xor(m1, 2)); m1 = fmaxf(m1, __shfl_xor(m1, 4));
            int am = (sv == m1) ? (lane & 7) : 8;
            am = min(am, __shfl_xor(am, 1)); am = min(am, __shfl_xor(am, 2)); am = min(am, __shfl_xor(am, 4));
            float m2 = ((lane & 7) == am) ? -INFINITY : sv;
            m2 = fmaxf(m2, __shfl_xor(m2, 1)); m2 = fmaxf(m2, __shfl_xor(m2, 2)); m2 = fmaxf(m2, __shfl_xor(m2, 4));
            const float gs = m1 + m2;
            const int gi = lane >> 3; int grank = 0;
#pragma unroll
            for (int gj = 0; gj < 8; ++gj) { const float o = __shfl(gs, gj * 8); grank += (o > gs || (o == gs && gj < gi)) ? 1 : 0; }
            const float msk = (grank < 4) ? sv : -1e30f;
            int rank = 0;
#pragma unroll 8
            for (int e = 0; e < 64; ++e) { const float o = __shfl(msk, e); rank += (o > msk || (o == msk && e < lane)) ? 1 : 0; }
            const bool selb = rank < 8;
            const float tot = wsum(selb ? score : 0.f);
            myrank[i] = selb ? rank : -1; myw[i] = score / tot * 2.5f;
            mypos[i] = (selb && !DRY) ? atomicAdd((int*)(cntl + lane), 1) : 0;
        }
        __syncthreads();
        if (tid < 64) basel[tid] = (cntl[tid] > 0 && !DRY) ? atomicAdd(p.gcnt + layer * 64 + tid, cntl[tid]) : 0;
        __syncthreads();
#pragma unroll
        for (int i = 0; i < 4; ++i) if (myrank[i] >= 0 && !DRY) {
            const int t = batch * 32 + wave * 4 + i, slot = t * 8 + myrank[i];
            p.list[(size_t)lane * 16384 + basel[lane] + mypos[i]] = slot;
            p.ew[slot] = myw[i];
        }
        __syncthreads();
    }
}

struct MoeSched {
    const char* A; const char* Bt; const int* list; const LAS int* ustart; const LAS int* hbase; const LAS int* cnt;
    int K, NP, G, c; bool gather; int nexp;
    __device__ __forceinline__ static void tables(LAS int* ustart, LAS int* hbase, LAS int* cnt, const int* gcnt, int NP) {
        const int tid = threadIdx.x;
        if (tid == 0) {
            int us = 0, hb = 0;
            for (int e = 0; e < 65; ++e) { const int c = (e < 64) ? gcnt[e] : S_; const int nrb = (c + 255) >> 8; cnt[e] = c; ustart[e] = us; hbase[e] = hb; us += nrb * NP; hb += nrb * 256; }
            ustart[65] = us; hbase[65] = hb;
        }
        __syncthreads();
    }
    __device__ __forceinline__ bool next(int i, pg::Unit& u, int R0, int C0) const {
        const int L = i * G + c; if (L >= ustart[nexp]) return false;
        const int lane = threadIdx.x & 63;
        const unsigned long long bal = __ballot(lane < 65 && ustart[lane] <= L);
        int e = __popcll(bal) - 1; if (ustart[64] <= L) e = 64;
        const int r = L - ustart[e], rb = r / NP, pn = r % NP;
        u.pm = (hbase[e] >> 8) + rb; u.pn = pn; u.aux = e | (rb << 8);
        u.B = Bt + ((size_t)e * NP + pn) * 256 * K * 2;
        if (gather) {
            u.A = A; const int ce = cnt[e];
#pragma unroll
            for (int q = 0; q < 4; ++q) { const int pos = rb * 256 + R0 + 64 * q; int tok = 0; if (pos < ce) tok = (e < 64) ? (list[(size_t)e * 16384 + pos] >> 3) : pos; u.ra[q] = (unsigned)(tok * K + C0) * 2u; }
        } else {
            u.A = A + (size_t)u.pm * 256 * K * 2;
#pragma unroll
            for (int q = 0; q < 4; ++q) u.ra[q] = (unsigned)((R0 + 64 * q) * K + C0) * 2u;
        }
        return true;
    }
};
struct EpiGateUp {
    static constexpr bool PERM = true;
    bf16_t* HID;
    __device__ __forceinline__ void operator()(const f32x4 (&acc)[2][2][4][2], const pg::Unit& u, int wid, int wr, int wc, int fr_, int fq_) const {
        int fr = fr_, fq = fq_; asm volatile("" : "+v"(fr), "+v"(fq));
        const int col0 = u.pn * 128 + wc * 32 + 8 * fq;
#pragma unroll
        for (int ai = 0; ai < 2; ++ai)
#pragma unroll
            for (int m = 0; m < 4; ++m) {
                bf16_t* rp = HID + (size_t)(u.pm * 256 + ai * 128 + wr * 64 + m * 16 + fr) * 256 + col0;
                float h[8];
#pragma unroll
                for (int n = 0; n < 2; ++n) {
                    const f32x4 g = acc[ai][0][m][n], up = acc[ai][1][m][n];
                    h[4 * n] = g.x / (1.f + __expf(-g.x)) * up.x; h[4 * n + 1] = g.y / (1.f + __expf(-g.y)) * up.y; h[4 * n + 2] = g.z / (1.f + __expf(-g.z)) * up.z; h[4 * n + 3] = g.w / (1.f + __expf(-g.w)) * up.w;
                }
                u32x4 w; w.x = cvtpk(h[0], h[1]); w.y = cvtpk(h[2], h[3]); w.z = cvtpk(h[4], h[5]); w.w = cvtpk(h[6], h[7]); *(u32x4*)rp = w;
            }
    }
};
struct EpiDown {
    static constexpr bool PERM = true;
    bf16_t* YBUF; const int* list; const float* ew; const LAS int* cnt;
    __device__ __forceinline__ void operator()(const f32x4 (&acc)[2][2][4][2], const pg::Unit& u, int wid, int wr, int wc, int fr_, int fq_) const {
        int fr = fr_, fq = fq_; asm volatile("" : "+v"(fr), "+v"(fq));
        const int e = u.aux & 0xff, rb = u.aux >> 8, ce = cnt[e];
        const unsigned colb = (unsigned)(u.pn * 256 + wc * 32 + 8 * fq);
        const int* le = list + (size_t)e * 16384 + rb * 256 + wr * 64 + fr;
        const int pos0 = rb * 256 + wr * 64 + fr;
        int slot[8]; float w[8];
#pragma unroll
        for (int i = 0; i < 8; ++i) { const int pr = (i >> 2) * 128 + (i & 3) * 16; slot[i] = (pos0 + pr < ce) ? le[pr] : -1; }
#pragma unroll
        for (int i = 0; i < 8; ++i) w[i] = (slot[i] >= 0) ? ew[slot[i]] : 0.f;
#pragma unroll
        for (int ai = 0; ai < 2; ++ai)
#pragma unroll
            for (int m = 0; m < 4; ++m) {
                const int i = ai * 4 + m;
                if (slot[i] >= 0) {
                    char* rp = (char*)YBUF + ((unsigned)slot[i] * 1024u + colb);
                    const float ws = w[i] * 16.f;
#pragma unroll
                    for (int bj = 0; bj < 2; ++bj) { const f32x4 a = acc[ai][bj][m][0] * ws, b = acc[ai][bj][m][1] * ws;
                        u32x2 o; o.x = nsa::pk4_fp8(a.x, a.y, a.z, a.w); o.y = nsa::pk4_fp8(b.x, b.y, b.z, b.w); *(u32x2*)(rp + bj * 128) = o; }
                }
            }
    }
};
__device__ __forceinline__ void phase_moe_gemm1(const MKP& p, LAS unsigned char* lds, int layer) {
    LAS int* tb = (LAS int*)(lds + LDS_X);
    MoeSched::tables(tb, tb + 66, tb + 132, p.gcnt + layer * 64, 2);
    const int G = gridDim.x, bx = blockIdx.x, vcu = (G % 8 == 0) ? (bx % 8) * (G / 8) + bx / 8 : bx;
    MoeSched S{(const char*)p.XN, (const char*)p.Wgu, p.list, tb, tb + 66, tb + 132, 1024, 2, G, vcu, true, 65};
    EpiGateUp E{p.HID};
    pg::gemm_run(lds, 1024, S, E);
}
__device__ __forceinline__ void phase_moe_gemm2(const MKP& p, LAS unsigned char* lds, int layer, int which = 3) {
    LAS int* tb = (LAS int*)(lds + LDS_X);
    MoeSched::tables(tb, tb + 66, tb + 132, p.gcnt + layer * 64, 4);
    const int G = gridDim.x, bx = blockIdx.x, vcu = (G % 8 == 0) ? (bx % 8) * (G / 8) + bx / 8 : bx;
    if (which & 1) { MoeSched S{(const char*)p.HID, (const char*)p.Wd, p.list, tb, tb + 66, tb + 132, 256, 4, G, vcu, false, 64};
      EpiDown E{p.YBUF, p.list, p.ew, tb + 132};
      pg::gemm_run(lds, 256, S, E); }
    if (which & 2) {
      pg::DenseSched S; S.init(p.HID + (size_t)tb[66 + 64] * 256, p.Wd + (size_t)64 * 1024 * 256, S_, 1024, 256, G, bx);
      EpiPlain E{p.YS, 1024};
      pg::gemm_run(lds, 256, S, E); }
}
__device__ __forceinline__ void phase_moe_combine(const MKP& p, int layer) {
    int tid_ = threadIdx.x; asm volatile("" : "+v"(tid_));
    const int tid = tid_, lane = tid & 63, wave = tid >> 6;
    const int gwv = blockIdx.x * 8 + wave, NGW = gridDim.x * 8;
    const float* g2 = p.mod + layer * 6144 + 5 * 1024;
    for (int t = gwv; t < S_; t += NGW) {
        f32x4* xr = (f32x4*)(p.out + (size_t)t * D_) + lane;
#pragma unroll
        for (int j = 0; j < 4; ++j) {
            f32x4 s = (f32x4){0.f, 0.f, 0.f, 0.f};
#pragma unroll
            for (int k = 0; k < 8; ++k) {
                const int w = *((const int*)((const char*)p.YBUF + ((size_t)t * 8 + k) * 1024) + lane + 64 * j);
                const f32x2 lo = __builtin_amdgcn_cvt_pk_f32_fp8(w, false), hi = __builtin_amdgcn_cvt_pk_f32_fp8(w, true);
                s.x += lo.x; s.y += lo.y; s.z += hi.x; s.w += hi.y;
            }
            { const u32x2 sw = *((const u32x2*)(p.YS + (size_t)t * 1024) + lane + 64 * j);
              s.x += 16.f * __uint_as_float(sw.x << 16); s.y += 16.f * __uint_as_float(sw.x & 0xffff0000u); s.z += 16.f * __uint_as_float(sw.y << 16); s.w += 16.f * __uint_as_float(sw.y & 0xffff0000u); }
            const f32x4 g = *(const f32x4*)(g2 + 256 * j + 4 * lane) * (1.f / 16.f);
            xr[64 * j] = xr[64 * j] + g * s;
        }
    }
}

#define XB_TMO      128
#define XB_XCNT(j)  (256  + 64 * (j))
#define XB_XSUB(j)  (1280 + 64 * (j))
#define XB_XGEN(j)  (2304 + 64 * (j))
#define XB_TOP      3328
#define XB_TOPGEN   3392
#define XCD_BAR_WORDS 3456
#define XB_SPIN_CAP (1u << 22)
__device__ __forceinline__ unsigned xb_ld(unsigned* p)              { return __hip_atomic_load(p, __ATOMIC_RELAXED, __HIP_MEMORY_SCOPE_AGENT); }
__device__ __forceinline__ unsigned xb_add(unsigned* p, unsigned v) { return __hip_atomic_fetch_add(p, v, __ATOMIC_RELAXED, __HIP_MEMORY_SCOPE_AGENT); }
__device__ __forceinline__ unsigned xb_xcc_id() { return (unsigned)__builtin_amdgcn_s_getreg((3 << 11) | 20) & 0xFu; }
#define XB_SPIN(cond, bar) do { unsigned _sp = 0; while (cond) { __builtin_amdgcn_s_sleep(1); \
    if ((++_sp & 255u) == 0u) { if (xb_ld(&(bar)[XB_TMO])) break; if (_sp > XB_SPIN_CAP) { atomicAdd(&(bar)[XB_TMO], 1u); break; } } } } while (0)
struct XcdBarrier { unsigned* bar; unsigned x; volatile LAS unsigned* st; };
__device__ __forceinline__ XcdBarrier xcd_barrier_post(unsigned* bar, volatile LAS unsigned* st) {
    XcdBarrier b; b.bar = bar; b.x = xb_xcc_id(); b.st = st;
    if (threadIdx.x == 0) (void)xb_add(&bar[XB_XCNT(b.x)], 1u);
    return b;
}
__device__ __forceinline__ void xcd_barrier_complete(unsigned* bar, unsigned x, unsigned& nloc, unsigned& nx) {
    const unsigned G = gridDim.x * gridDim.y * gridDim.z;
    unsigned sum, cnt, mine, sp = 0u;
    for (;;) {
        sum = 0u; cnt = 0u; mine = 0u;
#pragma unroll
        for (unsigned j = 0; j < 16; ++j) { const unsigned c = xb_ld(&bar[XB_XCNT(j)]); sum += c; cnt += (c > 0u) ? 1u : 0u; mine = (j == x) ? c : mine; }
        if (sum == G) break;
        __builtin_amdgcn_s_sleep(1);
        if ((++sp & 255u) == 0u) { if (xb_ld(&bar[XB_TMO])) break; if (sp > XB_SPIN_CAP) { atomicAdd(&bar[XB_TMO], 1u); break; } }
    }
    nloc = mine > 0u ? mine : 1u; nx = cnt > 0u ? cnt : 1u;
}
__device__ __forceinline__ void xcd_barrier(const XcdBarrier& b) {
    asm volatile("s_waitcnt vmcnt(0)" ::: "memory");
    __syncthreads();
    if (threadIdx.x == 0) {
        unsigned* bar = b.bar;
        __builtin_amdgcn_s_waitcnt(0);
        unsigned nloc = b.st[0], nx = b.st[1];
        if (nloc == 0u) { xcd_barrier_complete(bar, b.x, nloc, nx); b.st[0] = nloc; b.st[1] = nx; }
        const unsigned old = xb_add(&bar[XB_XSUB(b.x)], 1u);
        const unsigned gen = old / nloc;
        if (old + 1u == (gen + 1u) * nloc) {
            __builtin_amdgcn_fence(__ATOMIC_RELEASE, "agent");
            asm volatile("s_waitcnt vmcnt(0)" ::: "memory");
            const unsigned og = xb_add(&bar[XB_TOP], 1u);
            const unsigned tg = og / nx;
            if (og + 1u == (tg + 1u) * nx) xb_add(&bar[XB_TOPGEN], 1u);
            else XB_SPIN(xb_ld(&bar[XB_TOPGEN]) == tg, bar);
            __builtin_amdgcn_fence(__ATOMIC_ACQUIRE, "agent");
            xb_add(&bar[XB_XGEN(b.x)], 1u);
            asm volatile("s_waitcnt vmcnt(0)" ::: "memory");
        } else {
            XB_SPIN(xb_ld(&bar[XB_XGEN(b.x)]) == gen, bar);
            __builtin_amdgcn_fence(__ATOMIC_ACQUIRE, "agent");
            asm volatile("s_waitcnt vmcnt(0)" ::: "memory");
        }
    }
    __syncthreads();
}

__global__ void __launch_bounds__(MK_THREADS, 2) mega(MKP p) {
    extern __shared__ __attribute__((aligned(16))) unsigned char lds_raw[];
    LAS unsigned char* lds = (LAS unsigned char*)lds_raw;
    const int lo = p.ph_lo, hi = p.ph_hi;
    const bool multi = hi - lo > 1;
    volatile LAS unsigned* bst = (volatile LAS unsigned*)(lds + LDS_BARST);
    XcdBarrier bar; bar.bar = p.barw; bar.x = 0; bar.st = bst;
    if (multi) {
        if (threadIdx.x < 2) bst[threadIdx.x] = 0u;
        if (blockIdx.x == 0) for (int i = threadIdx.x; i < XCD_BAR_WORDS; i += MK_THREADS) p.barw[i] = 0u;
    }
    int nbar = 0;
    if (multi) {
        __threadfence(); cooperative_groups::this_grid().sync(); __builtin_amdgcn_fence(__ATOMIC_ACQUIRE, "agent"); bar = xcd_barrier_post(p.barw, bst); nbar = 1;
    }
#define IN(k) (lo <= (k) && (k) < hi)
#define SEAM(k) do { if (IN(k) && IN((k) + 1)) { if (nbar == 0) { __threadfence(); cooperative_groups::this_grid().sync(); __builtin_amdgcn_fence(__ATOMIC_ACQUIRE, "agent"); bar = xcd_barrier_post(p.barw, bst); } else xcd_barrier(bar); ++nbar; } } while (0)
    if (IN(0)) { phase_prologue(p, lds); phase_moe_weights(p, lds, 0); }
    SEAM(0);
    if (IN(1)) phase_norm<false>(p, lds, p.in[0], p.in[3], 0, 1, 0, true);
    SEAM(1);
    if (IN(2)) {
        pg::DenseSched S; S.init(p.XN, p.W_in0t, S_, 3072, 1024, gridDim.x, blockIdx.x);
        EpiHeads E{p.desc0, p.cosT, p.sinT, p.GATES, p.LOGF, (LAS float*)(lds + LDS_X)};
        pg::gemm_run(lds, 1024, S, E);
    }
    SEAM(2);
    if (IN(3)) phase_scan(p, lds);
    SEAM(3);
    if (IN(4)) phase_fox(p, (char*)lds_raw);
    SEAM(4);
    if (IN(5)) {
        pg::DenseSched S; S.init(p.OATT, p.W_out0t, S_, 1024, 1024, gridDim.x, blockIdx.x);
        EpiResid E{p.in[0], p.out, p.mod + 2 * 1024};
        pg::gemm_run(lds, 1024, S, E);
    }
    SEAM(5);
    if (IN(6)) phase_moe_route<false>(p, lds, 0);
    SEAM(6);
    if (IN(7)) phase_moe_gemm1(p, lds, 0);
    SEAM(7);
    if (IN(8)) phase_moe_gemm2(p, lds, 0);
    SEAM(8);
    if (IN(9)) { phase_norm<true>(p, lds, p.out, p.in[3] + 1024, 1, 1, 0, false); phase_moe_weights(p, lds, 1); }
    if (IN(9) && IN(11)) { xcd_barrier(bar); ++nbar; }
    if (IN(11)) {
        pg::DenseSched S; S.init(p.XN, p.W_in1t, S_, 768, 1024, gridDim.x, blockIdx.x);
        EpiPlain E{p.P1, 768};
        pg::gemm_run(lds, 1024, S, E);
    }
    SEAM(11);
    if (IN(12)) phase_post1a(p);
    SEAM(12);
    if (IN(13)) {
        { pg::DenseSched S; S.init(p.CQN, p.W_uqt, S_, 1536, 384, gridDim.x, blockIdx.x);
          EpiHeads E{p.desc_uq, p.cosT, p.sinT, nullptr, nullptr, (LAS float*)(lds + LDS_X)};
          pg::gemm_run(lds, 384, S, E); }
        { pg::DenseSched S; S.init(p.CKVN, p.W_ukvt, S_, 2048, 256, gridDim.x, blockIdx.x);
          EpiHeads E{p.desc_ukv, p.cosT, p.sinT, nullptr, nullptr, (LAS float*)(lds + LDS_X)};
          pg::gemm_run(lds, 256, S, E); }
    }
    SEAM(13);
    if (IN(14)) phase_mla(p, (char*)lds_raw);
    SEAM(14);
    if (IN(15)) {
        pg::DenseSched S; S.init(p.OATT, p.W_out1t, S_, 1024, 1024, gridDim.x, blockIdx.x);
        EpiResid E{p.out, p.out, p.mod + 6144 + 2 * 1024};
        pg::gemm_run(lds, 1024, S, E);
    }
    SEAM(15);
    if (IN(16)) phase_moe_route<false>(p, lds, 1);
    SEAM(16);
    if (IN(17)) phase_moe_gemm1(p, lds, 1);
    SEAM(17);
    if (IN(18)) phase_moe_gemm2(p, lds, 1);
    SEAM(18);
    if (IN(19)) phase_moe_combine(p, 1);
#undef IN
#undef SEAM
}
extern "C" void kernel_launch(void* const* d_in, const int* in_sizes, int n_in, void* d_out, int out_size, void* d_ws, size_t ws_size, hipStream_t stream) {
    static int grid = 0;
    if (!grid) {
        int dev = 0, cus = 0, per_cu = 0;
        (void)hipGetDevice(&dev); (void)hipDeviceGetAttribute(&cus, hipDeviceAttributeMultiprocessorCount, dev);
        (void)hipFuncSetAttribute((const void*)mega, hipFuncAttributeMaxDynamicSharedMemorySize, LDS_TOTAL);
        (void)hipOccupancyMaxActiveBlocksPerMultiprocessor(&per_cu, (const void*)mega, MK_THREADS, LDS_TOTAL);
        (void)hipGetLastError();
        grid = (cus > 0 && per_cu >= 1) ? cus : -1;
    }
    if (grid < 0) return;
    constexpr size_t MiB = 1u << 20;
    if (ws_size < 528 * MiB || n_in != 34) return;
    char* wsb = (char*)d_ws;
    float* ws = (float*)d_ws;
    size_t o = 0;
    MKP p{};
    for (int i = 0; i < 34; ++i) p.in[i] = (const float*)d_in[i];
    p.out = (float*)d_out; p.pos = (const int*)d_in[2];
    p.mod = ws + o; o += 2 * 6144;
    p.cosT = ws + o; o += (size_t)S_ * 48;
    p.sinT = ws + o; o += (size_t)S_ * 48;
    p.modpart = ws + o; o += 8 * 12288;
    p.desc0 = (BlkDesc*)(ws + o); o += 96 * 8;
    p.desc_uq = (BlkDesc*)(ws + o); o += 48 * 8;
    p.desc_ukv = (BlkDesc*)(ws + o); o += 64 * 8;
    p.CUMB = ws + o; o += (size_t)8 * S_;
    p.gcnt = (int*)(ws + o); o += 128;
    p.CBIAS = ws + o; o += 128;
    p.barw = (unsigned*)(ws + o); o += 4096;
    p.ew = ws + o; o += (size_t)S_ * 8;
    p.list = (int*)(ws + o); o += (size_t)64 * 16384;
    p.WcT = (bf16_t*)(ws + o); o += (size_t)2 * 64 * 2048 / 2;
    p.KCMP = (bf16_t*)(ws + o); o += (size_t)2 * 1024 * 64 / 2;
    p.VCT = (bf16_t*)(ws + o); o += (size_t)2 * 64 * 1024 / 2;
    if (o * 4 > 15 * MiB) return;
    p.XN = (bf16_t*)(wsb + 15 * MiB); p.OATT = (bf16_t*)(wsb + 47 * MiB);
    char* big = wsb + 79 * MiB;
    {   bf16_t* b = (bf16_t*)big;
        p.QN = b; b += (size_t)S_ * 512; p.KV6 = b; b += (size_t)12 * S_ * 64; p.FQ = b; b += (size_t)S_ * 512; p.FK = b; b += (size_t)S_ * 512; p.FV = b; b += (size_t)S_ * 512;
        p.GATES = (float*)b; p.LOGF = p.GATES + (size_t)S_ * 24; }
    p.KSLF = (bf16_t*)(big + 92 * MiB); p.VSLF = (bf16_t*)(big + 96 * MiB); p.OCMP = (bf16_t*)(big + 100 * MiB); p.OWIN = (bf16_t*)(big + 116 * MiB);
    {   bf16_t* b = (bf16_t*)(big + 96 * MiB);
        p.P1 = b; b += (size_t)S_ * 768; p.CQN = b; b += (size_t)S_ * 384; p.CKVN = b; b += (size_t)S_ * 256;
        p.Q96 = b; b += (size_t)16 * S_ * 96; p.K96 = b; b += (size_t)16 * S_ * 96; p.V1 = b; b += (size_t)16 * S_ * 64; }
    p.YBUF = (bf16_t*)big; p.YS = (bf16_t*)(big + 128 * MiB); p.HID = (bf16_t*)(big + 256 * MiB);
    p.Wgu = (bf16_t*)(wsb + 415 * MiB); p.Wd = p.Wgu + (size_t)65 * 512 * 1024;
    {   bf16_t* b = (bf16_t*)(wsb + 513 * MiB);
        p.W_in0t = b; b += (size_t)3072 * 1024; p.W_out0t = b; b += (size_t)1024 * 1024; p.W_in1t = b; b += (size_t)768 * 1024;
        p.W_uqt = b; b += (size_t)1536 * 384; p.W_ukvt = b; b += (size_t)2048 * 256; p.W_out1t = b; b += (size_t)1024 * 1024; }
    p.ph_lo = 0; p.ph_hi = 20;
    void* args[] = {&p};
    (void)hipLaunchCooperativeKernel((const void*)mega, dim3(grid), dim3(MK_THREADS), args, LDS_TOTAL, stream);
}
```

```cpp
#include <hip/hip_runtime.h>
#include <hip/hip_cooperative_groups.h>
#include <stdint.h>

#define S_ 16384
#define D_ 1024
#define HYIN 2848
#define NEXP 64
#define EPSF 1e-6f

__device__ __forceinline__ float wsum(float v) {
#pragma unroll
    for (int o = 32; o > 0; o >>= 1) v += __shfl_xor(v, o);
    return v;
}
__device__ __forceinline__ float sigmf(float x) { return 1.f / (1.f + expf(-x)); }
__device__ __forceinline__ float logsigmf(float x) { return fminf(x, 0.f) - log1pf(expf(-fabsf(x))); }
#define LAS __attribute__((address_space(3)))
#define GAS __attribute__((address_space(1)))
typedef unsigned short bf16_t;
typedef short bf16x8 __attribute__((ext_vector_type(8)));
typedef float f32x4 __attribute__((ext_vector_type(4)));
typedef float f32x2 __attribute__((ext_vector_type(2)));
typedef unsigned u32x4 __attribute__((ext_vector_type(4)));
typedef unsigned u32x2 __attribute__((ext_vector_type(2)));
typedef __bf16 bf16x2_t __attribute__((ext_vector_type(2)));

__device__ __forceinline__ unsigned cvtpk(float lo, float hi) { f32x2 v = {lo, hi}; bf16x2_t b = __builtin_convertvector(v, bf16x2_t); return __builtin_bit_cast(unsigned, b); }
__device__ __forceinline__ float bf2f(bf16_t v) { return __uint_as_float(((unsigned)v) << 16); }
__device__ __forceinline__ bf16_t f2bf(float f) { return (bf16_t)(cvtpk(f, 0.f) & 0xffffu); }

namespace pg {
constexpr int BM = 256, BK = 64, HALF = 128, HTB = HALF * BK * 2, STAGE_BYTES = 8 * HTB;
__device__ __forceinline__ int lds_byte(int r, int c) { const int st = (r >> 4) * 2 + (c >> 5), rr = r & 15, cc = c & 31, ob = rr * 64 + cc * 2; return st * 1024 + (ob ^ (((ob >> 9) & 1) << 5)); }
__device__ __forceinline__ int perm32(int rho) { const int n = rho >> 4, i = rho & 15; return 8 * (i >> 2) + 4 * n + (i & 3); }
__device__ __forceinline__ void stage_rc(int b, int& R, int& C) { const int st = b / 1024, sb = b % 1024, swz = sb ^ (((sb >> 9) & 1) << 5); R = (st >> 1) * 16 + swz / 64; C = (st & 1) * 32 + (swz % 64) / 2; }

struct Unit { int pm, pn, aux; const char* A; const char* B; unsigned ra[4]; };

template <class Epi, class Sched>
__device__ __forceinline__ void gemm_run(LAS unsigned char* lds, const int K, const Sched& S, const Epi& E) {
    int tid_ = threadIdx.x; asm volatile("" : "+v"(tid_));
    const int tid = tid_, wid = __builtin_amdgcn_readfirstlane(tid >> 6), lane = tid & 63, wr = wid >> 2, wc = wid & 3, fr = lane & 15, fq = lane >> 4;
    int nt_ = K / BK; asm volatile("" : "+s"(nt_)); const int nt = nt_;
    int R0, C0; stage_rc(tid * 16, R0, C0);
    unsigned voffB[2];
#pragma unroll
    for (int i = 0; i < 2; ++i) { const int Rb = Epi::PERM ? ((R0 & ~31) + perm32(R0 & 31)) : R0; voffB[i] = (unsigned)((Rb + 64 * i) * K + C0) * 2u; }
    const size_t kstep = (size_t)(BK * 2);
    const size_t hstep = (size_t)HALF * K * 2;
    const unsigned ldsw = (unsigned)wid * 1024u;
    const int aoff = lds_byte(wr * 64 + fr, fq * 8), boff = lds_byte(wc * 32 + fr, fq * 8);
#define PG_SA(b, h) (((b) * 2 + (h)) * HTB)
#define PG_SB(b, h) ((4 + (b) * 2 + (h)) * HTB)
#define PG_STAGE2(bufoff, gbase, v0, v1) do { \
        __builtin_amdgcn_global_load_lds((const unsigned*)((const char*)(gbase) + (v0)), (LAS unsigned*)(lds + (bufoff) + ldsw), 16, 0, 0); \
        __builtin_amdgcn_global_load_lds((const unsigned*)((const char*)(gbase) + (v1)), (LAS unsigned*)(lds + (bufoff) + ldsw + 8192), 16, 0, 0); } while (0)
#define PG_STAGEB(bufoff, gbase) PG_STAGE2(bufoff, gbase, voffB[0], voffB[1])
#define PG_LDA(dst, b, h) do { _Pragma("unroll") for (int m = 0; m < 4; ++m) _Pragma("unroll") for (int k = 0; k < 2; ++k) dst[m][k] = *(const LAS bf16x8*)(lds + PG_SA(b, h) + aoff + m * 2048 + k * 1024); } while (0)
#define PG_LDB(dst, b, h) do { _Pragma("unroll") for (int n = 0; n < 2; ++n) _Pragma("unroll") for (int k = 0; k < 2; ++k) dst[n][k] = *(const LAS bf16x8*)(lds + PG_SB(b, h) + boff + n * 2048 + k * 1024); } while (0)
#define PG_MMA(ai, bj, At, Bt) do { __builtin_amdgcn_s_setprio(1); _Pragma("unroll") for (int m = 0; m < 4; ++m) _Pragma("unroll") for (int n = 0; n < 2; ++n) _Pragma("unroll") for (int k = 0; k < 2; ++k) \
        acc[ai][bj][m][n] = __builtin_amdgcn_mfma_f32_16x16x32_bf16(Bt[n][k], At[m][k], acc[ai][bj][m][n], 0, 0, 0); __builtin_amdgcn_s_setprio(0); } while (0)
#define PG_WAIT_V(n) asm volatile("s_waitcnt vmcnt(" #n ")" ::: "memory")
#define PG_WAIT_L(n) asm volatile("s_waitcnt lgkmcnt(" #n ")" ::: "memory")
#define PG_BAR __builtin_amdgcn_s_barrier()
#define PG_SCHED __builtin_amdgcn_sched_barrier(0)
    Unit cur, nxt; int ui = 0;
    if (!S.next(0, cur, R0, C0)) return;
    f32x4 acc[2][2][4][2];
#pragma unroll
    for (int a = 0; a < 2; ++a)
#pragma unroll
        for (int b = 0; b < 2; ++b)
#pragma unroll
            for (int m = 0; m < 4; ++m)
#pragma unroll
                for (int n = 0; n < 2; ++n) acc[a][b][m][n] = (f32x4){0.f, 0.f, 0.f, 0.f};
    bf16x8 At[4][2], B0[2][2], B1[2][2];
    const char* cA = cur.A; const char* cB = cur.B;
    PG_STAGEB(PG_SB(0, 0), cB); PG_STAGEB(PG_SB(0, 1), cB + hstep); PG_STAGE2(PG_SA(0, 0), cA, cur.ra[0], cur.ra[1]); PG_STAGE2(PG_SA(0, 1), cA, cur.ra[2], cur.ra[3]);
    if (wr == 1) PG_BAR;
    PG_WAIT_V(2); PG_BAR;
    PG_STAGEB(PG_SB(1, 0), cB + kstep); PG_STAGE2(PG_SA(1, 0), cA + kstep, cur.ra[0], cur.ra[1]); PG_STAGEB(PG_SB(1, 1), cB + hstep + kstep);
    PG_WAIT_V(6); PG_BAR;
    for (;;) {
        const bool has_next = S.next(ui + 1, nxt, R0, C0);
        if (!has_next) nxt = cur;
        const char* nA = nxt.A; const char* nB = nxt.B;
#pragma unroll 1
        for (int t = 0; t < nt; t += 2) {
            const bool last = (t == nt - 2);
            const char* a1 = cA + (size_t)(t + 1) * kstep;
            const char* a2 = last ? nA : cA + (size_t)(t + 2) * kstep; const char* b2 = last ? nB : cB + (size_t)(t + 2) * kstep;
            const char* a3 = a2 + kstep; const char* b3 = b2 + kstep;
            const unsigned r0 = last ? nxt.ra[0] : cur.ra[0], r1 = last ? nxt.ra[1] : cur.ra[1], r2 = last ? nxt.ra[2] : cur.ra[2], r3 = last ? nxt.ra[3] : cur.ra[3];
            PG_LDB(B0, 0, 0); PG_LDB(B1, 0, 1); PG_SCHED; PG_LDA(At, 0, 0); PG_STAGE2(PG_SA(1, 1), a1, cur.ra[2], cur.ra[3]);
            PG_WAIT_V(8); PG_WAIT_L(0); PG_BAR; PG_MMA(0, 0, At, B0); PG_MMA(0, 1, At, B1); PG_BAR; PG_SCHED;
            PG_LDA(At, 0, 1); PG_STAGEB(PG_SB(0, 0), b2); PG_STAGEB(PG_SB(0, 1), b2 + hstep); PG_STAGE2(PG_SA(0, 0), a2, r0, r1);
            PG_WAIT_V(8); PG_WAIT_L(0); PG_BAR; PG_MMA(1, 0, At, B0); PG_MMA(1, 1, At, B1); PG_BAR; PG_SCHED;
            PG_LDB(B0, 1, 0); PG_LDB(B1, 1, 1); PG_SCHED; PG_LDA(At, 1, 0); PG_STAGE2(PG_SA(0, 1), a2, r2, r3);
            PG_WAIT_V(8); PG_WAIT_L(0); PG_BAR; PG_MMA(0, 0, At, B0); PG_MMA(0, 1, At, B1); PG_BAR; PG_SCHED;
            PG_LDA(At, 1, 1); PG_STAGEB(PG_SB(1, 0), b3); PG_STAGEB(PG_SB(1, 1), b3 + hstep); PG_STAGE2(PG_SA(1, 0), a3, r0, r1);
            PG_WAIT_V(8); PG_WAIT_L(0); PG_BAR; PG_MMA(1, 0, At, B0); PG_MMA(1, 1, At, B1); PG_BAR; PG_SCHED;
        }
        if (wr == 0) PG_BAR;
        E(acc, cur, wid, wr, wc, fr, fq);
        if (!has_next) break;
#pragma unroll
        for (int a = 0; a < 2; ++a)
#pragma unroll
            for (int b = 0; b < 2; ++b)
#pragma unroll
                for (int m = 0; m < 4; ++m)
#pragma unroll
                    for (int n = 0; n < 2; ++n) acc[a][b][m][n] = (f32x4){0.f, 0.f, 0.f, 0.f};
        cur = nxt; cA = nA; cB = nB; ++ui;
        if (wr == 1) PG_BAR;
    }
    PG_WAIT_V(0);
    PG_BAR;
#undef PG_SA
#undef PG_SB
#undef PG_STAGE2
#undef PG_STAGEB
#undef PG_LDA
#undef PG_LDB
#undef PG_MMA
}

struct DenseSched {
    const char* A; const char* Bt; int K, nM, nN, nwg, G, c;
    __device__ __forceinline__ void init(const void* A_, const void* Bt_, int M, int N, int K_, int G_, int c_) { A = (const char*)A_; Bt = (const char*)Bt_; K = K_; nM = M / BM; nN = N / BM; nwg = nM * nN; G = G_; c = c_; }
    __device__ __forceinline__ bool next(int i, Unit& u, int R0, int C0) const {
        const long L = (long)i * G + c; if (L >= nwg) return false;
        int wgid = (int)L; { const int q = nwg / 8, r = nwg % 8, xcd = wgid % 8, off = wgid / 8; wgid = (xcd < r ? xcd * (q + 1) : r * (q + 1) + (xcd - r) * q) + off; }
        const int nig = 8 * nN, gid = wgid / nig, fm = gid * 8, gsz = (nM - fm) < 8 ? (nM - fm) : 8;
        u.pm = fm + ((wgid % nig) % gsz); u.pn = (wgid % nig) / gsz; u.aux = 0;
        u.A = A + (size_t)u.pm * BM * K * 2; u.B = Bt + (size_t)u.pn * BM * K * 2;
#pragma unroll
        for (int q = 0; q < 4; ++q) u.ra[q] = (unsigned)((R0 + 64 * q) * K + C0) * 2u;
        return true;
    }
};
}
namespace att {
using s16x4 = __attribute__((ext_vector_type(4))) short;
using f32x16 = __attribute__((ext_vector_type(16))) float;
typedef __attribute__((address_space(3))) const char* lds_cptr;
typedef short v4i16_t __attribute__((ext_vector_type(4)));
constexpr int NSLOT = 3, VSLOT = 8192;
template <int DQ> struct Geo {
    static constexpr int NK = DQ / 16;
    static constexpr int KSLOT = (DQ == 64) ? 8192 : 16384;
    static constexpr int QWAVE = (DQ == 64) ? 4096 : 6144;
    static constexpr int LDS_K = 0, LDS_V = NSLOT * KSLOT, LDS_WS = LDS_V + NSLOT * VSLOT, LDS_OST = LDS_WS + 8 * 64 * 4, LDS_BYTES = LDS_OST + 8 * QWAVE;
};
constexpr int LDS_BIAS = Geo<64>::LDS_BYTES;
#define ASBAR() __builtin_amdgcn_sched_barrier(0)
#define AWAIT_BAR(N) asm volatile("s_waitcnt vmcnt(" #N ") lgkmcnt(0)\n\ts_barrier" ::: "memory")
__device__ __forceinline__ int crow(int r, int hi) { return (r & 3) + 8 * (r >> 2) + 4 * hi; }
__device__ __forceinline__ void glds16(const void* gsrc, unsigned lds_dst) { unsigned keep;
    asm volatile("s_mov_b32 %0, m0\n\ts_mov_b32 m0, %2\n\ts_nop 0\n\tglobal_load_lds_dwordx4 %1, off\n\ts_mov_b32 m0, %0" : "=&s"(keep) : "v"(gsrc), "s"(lds_dst) : "memory"); }
__device__ __forceinline__ float fadd_s(float a, float b) { float r; asm("v_add_f32_e32 %0, %1, %2" : "=v"(r) : "v"(a), "v"(b)); return r; }
__device__ __forceinline__ float fsub_s(float a, float b) { float r; asm("v_sub_f32_e32 %0, %1, %2" : "=v"(r) : "v"(a), "v"(b)); return r; }
__device__ __forceinline__ float max3f(float a, float b, float c) { float r; asm("v_max3_f32 %0, %1, %2, %3" : "=v"(r) : "v"(a), "v"(b), "v"(c)); return r; }
__device__ __forceinline__ float max2f(float a, float b) { float r; asm("v_max_f32_e32 %0, %1, %2" : "=v"(r) : "v"(a), "v"(b)); return r; }
__device__ __forceinline__ s16x4 vtr(lds_cptr p) { return __builtin_bit_cast(s16x4, __builtin_amdgcn_ds_read_tr16_b64_v4i16((__attribute__((address_space(3))) v4i16_t*)p)); }
template <int NK> __device__ __forceinline__ void kloadall(bf16x8* kf, lds_cptr kp) {
#pragma unroll
    for (int j = 0; j < NK; ++j) { kf[2 * j] = *(const LAS bf16x8*)(kp + j * 2048); kf[2 * j + 1] = *(const LAS bf16x8*)(kp + j * 2048 + 512); } }
__device__ __forceinline__ void kload2(bf16x8* kf, lds_cptr kp, int j) { kf[2 * j] = *(const LAS bf16x8*)(kp + j * 2048); kf[2 * j + 1] = *(const LAS bf16x8*)(kp + j * 2048 + 512); }
__device__ __forceinline__ void cmask(f32x16& p0, f32x16& p1, int koff, int qtok, int hi) {
    const int x = qtok - koff - 4 * hi;
#pragma unroll
    for (int r = 0; r < 16; ++r) { const int c = (r & 3) + 8 * (r >> 2); if (c > x) p0[r] = -INFINITY; if (c + 32 > x) p1[r] = -INFINITY; }
}
__device__ __forceinline__ void wmask(f32x16& p0, f32x16& p1, int thr, int hi) {
    const int y = thr - 4 * hi;
#pragma unroll
    for (int r = 0; r < 16; ++r) { const int c = (r & 3) + 8 * (r >> 2); if (c < y) p0[r] = -INFINITY; if (c + 32 < y) p1[r] = -INFINITY; }
}
__device__ __forceinline__ float rowmax(const f32x16& p0, const f32x16& p1) {
    float a = max3f(p0[0], p0[1], p1[0]), b = max3f(p0[2], p0[3], p1[1]); a = max3f(a, p1[2], p1[3]);
#pragma unroll
    for (int r = 4; r < 16; r += 4) { a = max3f(a, p0[r], p0[r + 1]); b = max3f(b, p0[r + 2], p0[r + 3]); a = max3f(a, p1[r], p1[r + 1]); b = max3f(b, p1[r + 2], p1[r + 3]); }
    const float m = max2f(a, b);
    auto rr = __builtin_amdgcn_permlane32_swap(__float_as_uint(m), __float_as_uint(m), false, false);
    return max2f(__uint_as_float(rr[0]), __uint_as_float(rr[1]));
}

enum { MODE_CAUSAL = 0, MODE_FOX = 1, MODE_WIN = 2 };
struct UnitArgs {
    const bf16_t* qrow;
    const bf16_t* K; const bf16_t* V; int kvpitch, vpitch;
    bf16_t* obase; int opitch;
    int qtok;
    int abase;
    int nsteps;
    const LAS float* bias;
};

template <int NB> __device__ __forceinline__ int seq(int i, int abase) { return (i < NB) ? abase + i : abase + NB - 1 - i; }

template <int MODE, bool GQA4, int THRL, int DQ, bool TM = false>
__device__ __forceinline__ void attn_unit(const UnitArgs& A, char* shm) {
    constexpr int NB = GQA4 ? 1 : 4;
    typedef Geo<DQ> G; constexpr int NK = G::NK, KSLOT = G::KSLOT, LDS_K = G::LDS_K, LDS_V = G::LDS_V, LDS_WS = G::LDS_WS, LDS_OST = G::LDS_OST, QWAVE = G::QWAVE;
    constexpr bool USE_NEGM = (MODE != MODE_FOX);
    int tid_ = threadIdx.x; asm volatile("" : "+v"(tid_));
    const int tid = tid_, lane = tid & 63, r32 = lane & 31, hi = lane >> 5; const int wid = __builtin_amdgcn_readfirstlane(tid >> 6);
    const unsigned lds0 = (unsigned)(uintptr_t)shm;
    float* wsf = (float*)(shm + LDS_WS) + wid * 64;
    const int NT = A.nsteps, abase = A.abase; const long kvp = A.kvpitch, vvp = A.vpitch;
    const bf16_t* ksrc = TM ? A.K + wid * 512 + lane * 8 : A.K + (long)lane * kvp + wid * 8;
    const bf16_t* ksrc2 = TM ? A.K + (8 + (wid & 3)) * 512 + lane * 8 : A.K + (long)lane * kvp + (8 + (wid & 3)) * 8;
    const bf16_t* vsrc = TM ? A.V + wid * 512 + lane * 8 : A.V + (long)(16 * (wid & 3) + (lane >> 2)) * vvp + (wid >> 2) * 32 + (lane & 3) * 8;
    const long kts = TM ? (long)(DQ / 8) * 512 : 64 * kvp, vts = TM ? 4096 : 64 * vvp;
    const unsigned kdst = lds0 + LDS_K + wid * 1024, vdst = lds0 + LDS_V + wid * 1024, kdst2 = lds0 + LDS_K + (8 + wid) * 1024;
#define TILE_OF(t) ({ int a_ = seq<NB>((t), abase); a_ < 0 ? 0 : a_; })
#define DMA_K(t, slot) do { const long to_ = (long)TILE_OF(t) * kts; glds16(ksrc + to_, (unsigned)__builtin_amdgcn_readfirstlane(kdst + (slot) * KSLOT)); \
        if (DQ == 96) glds16(ksrc2 + to_, (unsigned)__builtin_amdgcn_readfirstlane(kdst2 + (slot) * KSLOT)); } while (0)
#define DMA_V(t, slot) glds16(vsrc + (long)TILE_OF(t) * vts, (unsigned)__builtin_amdgcn_readfirstlane(vdst + (slot) * VSLOT))
    const lds_cptr shm3 = (lds_cptr)shm; const lds_cptr kp0 = shm3 + LDS_K + hi * 1024 + r32 * 16;
    const lds_cptr vp0 = shm3 + LDS_V + ((lane >> 4) & 1) * 32 + (lane & 3) * 8 + (4 * hi + ((lane & 15) >> 2)) * 64;
    const int vb0 = (int)(lds0 + LDS_V) + ((lane >> 4) & 1) * 32 + (lane & 3) * 8 + (4 * hi + ((lane & 15) >> 2)) * 64;
    DMA_K(0, 0); DMA_V(0, 0); DMA_K(1, 1);
    bf16x8 qr[NK];
#pragma unroll
    for (int d0 = 0; d0 < NK; ++d0) qr[d0] = *reinterpret_cast<const bf16x8*>(A.qrow + d0 * 16 + hi * 8);
    const lds_cptr qlp = shm3 + LDS_OST + wid * QWAVE + hi * 512 + r32 * 16;
    if (DQ == 96) {
#pragma unroll
        for (int d0 = 0; d0 < NK; ++d0) *(LAS bf16x8*)(const_cast<__attribute__((address_space(3))) char*>(qlp) + d0 * 1024) = qr[d0];
    }
#define QL(d0) (*(const LAS bf16x8*)(qlp + (d0) * 1024))
    float mhat = 0.f, l_reg = 0.f; f32x16 o[2]; o[0] = f32x16{}; o[1] = f32x16{};
    f32x16 negm = f32x16{}; if (USE_NEGM) asm volatile("" : "+v"(negm));
    const int qtok = A.qtok;
#define CMASK(P0, P1, t) do { const int t_ = (t); if (t_ < NB) cmask(P0, P1, 64 * t_, qtok, hi); \
        else { const int a_ = abase + NB - 1 - t_; if (a_ < 0) wmask(P0, P1, 64, hi); \
               else if (MODE == MODE_WIN) { const int thr_ = qtok - 511 + 64 * (abase - a_); if (thr_ > 0) wmask(P0, P1, thr_, hi); } } } while (0)
#define CINIT1(C, t, OFF) do { if (MODE == MODE_FOX) { const LAS float* bt_ = A.bias + 64 * (seq<NB>((t), abase) - (abase + NB - NT)) + 4 * hi + (OFF); const float nm_ = -mhat; \
        _Pragma("unroll") for (int g_ = 0; g_ < 4; ++g_) { const f32x4 b_ = *(const LAS f32x4*)(bt_ + 8 * g_); C[4 * g_] = b_.x; C[4 * g_ + 1] = b_.y; C[4 * g_ + 2] = b_.z; C[4 * g_ + 3] = b_.w; } \
        _Pragma("unroll") for (int r_ = 0; r_ < 16; ++r_) C[r_] += nm_; asm volatile("" : "+v"(C)); } \
      else if (USE_NEGM) { C = negm; } \
      else { const float nm_ = -mhat; _Pragma("unroll") for (int r_ = 0; r_ < 16; ++r_) C[r_] = nm_; asm volatile("" : "+v"(C)); } } while (0)
#define CINIT(C0, C1, t) do { CINIT1(C0, t, 0); CINIT1(C1, t, 32); } while (0)
    bool resc = false;
#define START(P0, P1) do { const float rm = rowmax(P0, P1); resc = false; \
    { const float dl = rm; mhat = fadd_s(mhat, dl); \
      _Pragma("unroll") for (int r = 0; r < 16; ++r) { P0[r] = fsub_s(P0[r], dl); P1[r] = fsub_s(P1[r], dl); } \
      if (USE_NEGM) { _Pragma("unroll") for (int r = 0; r < 16; ++r) negm[r] = -mhat; asm volatile("" : "+v"(negm)); } } \
    _Pragma("unroll") for (int r = 0; r < 16; ++r) P0[r] = __builtin_amdgcn_exp2f(P0[r]); } while (0)
#define RESC() do { if (resc) { asm volatile("s_waitcnt lgkmcnt(0)" ::: "memory"); \
      const float* wsh_ = wsf + 4 * hi; \
      _Pragma("unroll") for (int d_ = 0; d_ < 2; ++d_) _Pragma("unroll") for (int r = 0; r < 16; ++r) o[d_][r] *= wsh_[(r & 3) + 8 * (r >> 2)]; } } while (0)
    f32x16 pA0, pA1, pB0, pB1; bf16x8 kf[2 * NK];
    int sl_prev = 0, sl_cur = 0, sl_next = 1;
#define ROT() do { sl_prev = sl_cur; sl_cur = sl_next; sl_next = (sl_next == NSLOT - 1) ? 0 : sl_next + 1; } while (0)
    DMA_K(2, 2);
    if (DQ == 96) { AWAIT_BAR(5); } else { AWAIT_BAR(3); }
    { const char* kb = shm + LDS_K + hi * 1024 + r32 * 16;
      CINIT(pA0, pA1, 0);
#pragma unroll
      for (int d0 = 0; d0 < NK; ++d0) {
          const bf16x8 b0 = *reinterpret_cast<const bf16x8*>(kb + d0 * 2048);
          const bf16x8 b1 = *reinterpret_cast<const bf16x8*>(kb + d0 * 2048 + 512);
          pA0 = __builtin_amdgcn_mfma_f32_32x32x16_bf16(b0, qr[d0], pA0, 0, 0, 0); pA1 = __builtin_amdgcn_mfma_f32_32x32x16_bf16(b1, qr[d0], pA1, 0, 0, 0); } }
    asm volatile("s_nop 15\n\ts_nop 7" : "+v"(pA0), "+v"(pA1)); CMASK(pA0, pA1, 0);
    START(pA0, pA1);
    _Pragma("unroll") for (int r = 0; r < 16; ++r) pA1[r] = __builtin_amdgcn_exp2f(pA1[r]);
    AWAIT_BAR(0);
    DMA_K(3, 0); DMA_V(1, 1);
    ROT();
    kloadall<NK>(kf, kp0 + sl_cur * KSLOT);
    if (DQ == 96) { AWAIT_BAR(3); } else { AWAIT_BAR(2); }
    s16x4 vlo[(DQ == 96) ? 4 : 8], vhi[(DQ == 96) ? 4 : 8]; u32x4 pw0, pw1, pw2, pw3;
#define PKW(P, B) cvtpk(P[B], P[B + 1])
#define PAF(k) __builtin_bit_cast(bf16x8, pw##k)
#define VFR(i) (bf16x8){vlo[i][0], vlo[i][1], vlo[i][2], vlo[i][3], vhi[i][0], vhi[i][1], vhi[i][2], vhi[i][3]}
#define PIN(x) asm volatile("" : "+v"(x))
#define MX3(a, b, c) __builtin_fmaxf(__builtin_fmaxf((a), (b)), (c))
#define GAPA(MF, A0, A1, A2, A3, W0, W1, PW) do { MF; sacc += A0; sacc += A1; sacc += A2; sacc += A3; PIN(sacc); W0; W1; PIN(PW); ASBAR(); } while (0)
#define EX(v) __builtin_amdgcn_exp2f(v)
#define GAPB(MF, X, B) do { MF; X[B] = EX(X[B]); X[B + 1] = EX(X[B + 1]); X[B + 2] = EX(X[B + 2]); X[B + 3] = EX(X[B + 3]); PIN(X); ASBAR(); } while (0)
#define VRD(i) do { vlo[i] = vtr(vp_ + (((i) >> 2) * 4096 + ((i) & 3) * 1024)); vhi[i] = vtr(vp_ + (((i) >> 2) * 4096 + ((i) & 3) * 1024 + 512)); } while (0)
#define KRD(G_, j) do { if (G_) { kload2(kf, kp0 + sl_next * KSLOT, j); ASBAR(); } } while (0)
#define MFMA32(a, b, c) __builtin_amdgcn_mfma_f32_32x32x16_bf16(a, b, c, 0, 0, 0)
#define STEP64(C0, C1, P0, P1, t, GK, GV, GL, DOMASK) do { ASBAR(); \
    const lds_cptr vp_ = vp0 + sl_prev * VSLOT; \
    CINIT1(C0, t, 0); ASBAR(); \
    VRD(0); ASBAR(); float sacc = (P0[0] + P0[1]); \
    GAPA(C0 = MFMA32(kf[0], qr[0], C0), P0[2], P0[3], P0[4], P0[5],     pw0[0] = PKW(P0, 0), pw0[1] = PKW(P0, 2), pw0); \
    CINIT1(C1, t, 32); ASBAR(); \
    VRD(4); ASBAR(); GAPA(C1 = MFMA32(kf[1], qr[0], C1), P0[6], P0[7], P0[8], P0[9],     pw0[2] = PKW(P0, 4), pw0[3] = PKW(P0, 6), pw0); \
    VRD(1); ASBAR(); GAPA(C0 = MFMA32(kf[2], qr[1], C0),   P0[10], P0[11], P0[12], P0[13], pw1[0] = PKW(P0, 8), pw1[1] = PKW(P0, 10), pw1); \
    VRD(5); ASBAR(); GAPA(C1 = MFMA32(kf[3], qr[1], C1),   P0[14], P0[15], P1[0], P1[1],   pw1[2] = PKW(P0, 12), pw1[3] = PKW(P0, 14), pw1); \
    VRD(2); ASBAR(); GAPA(C0 = MFMA32(kf[4], qr[2], C0),   P1[2], P1[3], P1[4], P1[5],     pw2[0] = PKW(P1, 0), pw2[1] = PKW(P1, 2), pw2); \
    VRD(6); ASBAR(); GAPA(C1 = MFMA32(kf[5], qr[2], C1),   P1[6], P1[7], P1[8], P1[9],     pw2[2] = PKW(P1, 4), pw2[3] = PKW(P1, 6), pw2); \
    VRD(3); ASBAR(); GAPA(C0 = MFMA32(kf[6], qr[3], C0),   P1[10], P1[11], P1[12], P1[13], pw3[0] = PKW(P1, 8), pw3[1] = PKW(P1, 10), pw3); \
    VRD(7); ASBAR(); GAPA(C1 = MFMA32(kf[7], qr[3], C1),   P1[14], P1[15], 0.f, 0.f,       pw3[2] = PKW(P1, 12), pw3[3] = PKW(P1, 14), pw3); \
    l_reg += sacc; \
    if (GK) { DMA_K((t) + 3, sl_cur); } if (GV) { DMA_V((t) + 1, sl_next); } \
    if (DOMASK) CMASK(C0, C1, t); \
    { float a = MX3(C0[0], C0[1], C1[0]), b = MX3(C0[2], C0[3], C1[1]); a = MX3(a, C1[2], C1[3]); \
      _Pragma("unroll") for (int r = 4; r < 16; r += 4) { a = MX3(a, C0[r], C0[r + 1]); b = MX3(b, C0[r + 2], C0[r + 3]); a = MX3(a, C1[r], C1[r + 1]); b = MX3(b, C1[r + 2], C1[r + 3]); } \
      float rm = __builtin_fmaxf(a, b); { auto rr = __builtin_amdgcn_permlane32_swap(__float_as_uint(rm), __float_as_uint(rm), false, false); rm = __builtin_fmaxf(__uint_as_float(rr[0]), __uint_as_float(rr[1])); } \
      resc = false; \
      if (__builtin_expect(__any(rm > (float)THRL), 0)) { const float dl = __builtin_fmaxf(rm, 0.f); mhat += dl; \
        _Pragma("unroll") for (int r = 0; r < 16; ++r) { C0[r] -= dl; C1[r] -= dl; } \
        if (USE_NEGM) { _Pragma("unroll") for (int r = 0; r < 16; ++r) negm[r] = -mhat; asm volatile("" : "+v"(negm)); } \
        const float f = __builtin_amdgcn_exp2f(-dl); l_reg *= f; if (hi == 0) wsf[r32] = f; resc = true; } } \
    ASBAR(); \
    GAPB(o[0] = MFMA32(PAF(0), VFR(0), o[0]), C0, 0); \
    GAPB(o[1] = MFMA32(PAF(0), VFR(4), o[1]), C0, 4); \
    KRD(GL, 0); GAPB(o[0] = MFMA32(PAF(1), VFR(1), o[0]), C0, 8); \
    KRD(GL, 1); GAPB(o[1] = MFMA32(PAF(1), VFR(5), o[1]), C0, 12); \
    KRD(GL, 2); GAPB(o[0] = MFMA32(PAF(2), VFR(2), o[0]), C1, 0); \
    KRD(GL, 3); GAPB(o[1] = MFMA32(PAF(2), VFR(6), o[1]), C1, 4); \
    GAPB(o[0] = MFMA32(PAF(3), VFR(3), o[0]), C1, 8); \
    GAPB(o[1] = MFMA32(PAF(3), VFR(7), o[1]), C1, 12); \
    } while (0)
#define AWAIT_STEADY() do { if (DQ == 96) { AWAIT_BAR(3); } else { AWAIT_BAR(2); } } while (0)
#define VRD4(i, b) do { vlo[b] = vtr(vp_ + (((i) >> 2) * 4096 + ((i) & 3) * 1024)); vhi[b] = vtr(vp_ + (((i) >> 2) * 4096 + ((i) & 3) * 1024 + 512)); } while (0)
#define VFR4(b) (bf16x8){vlo[b][0], vlo[b][1], vlo[b][2], vlo[b][3], vhi[b][0], vhi[b][1], vhi[b][2], vhi[b][3]}
#define GAPQ(MF, QLD, A0, A1, A2, A3, W0, W1, PW) do { MF; QLD; sacc += A0; sacc += A1; sacc += A2; sacc += A3; PIN(sacc); W0; W1; PIN(PW); ASBAR(); } while (0)
#define STEP96(C0, C1, P0, P1, t, GK, GV, GL, DOMASK) do { ASBAR(); \
    const lds_cptr vp_ = vp0 + sl_prev * VSLOT; \
    CINIT1(C0, t, 0); CINIT1(C1, t, 32); bf16x8 qa = QL(0), qb; ASBAR(); \
    float sacc = (P0[0] + P0[1]); \
    GAPQ(C0 = MFMA32(kf[0], qa, C0), qb = QL(1), P0[2], P0[3], P0[4], P0[5],     pw0[0] = PKW(P0, 0), pw0[1] = PKW(P0, 2), pw0); \
    GAPQ(C1 = MFMA32(kf[1], qa, C1), (void)0,    P0[6], P0[7], P0[8], P0[9],     pw0[2] = PKW(P0, 4), pw0[3] = PKW(P0, 6), pw0); \
    GAPQ(C0 = MFMA32(kf[2], qb, C0), qa = QL(2), P0[10], P0[11], P0[12], P0[13], pw1[0] = PKW(P0, 8), pw1[1] = PKW(P0, 10), pw1); \
    GAPQ(C1 = MFMA32(kf[3], qb, C1), (void)0,    P0[14], P0[15], P1[0], P1[1],   pw1[2] = PKW(P0, 12), pw1[3] = PKW(P0, 14), pw1); \
    GAPQ(C0 = MFMA32(kf[4], qa, C0), qb = QL(3), P1[2], P1[3], P1[4], P1[5],     pw2[0] = PKW(P1, 0), pw2[1] = PKW(P1, 2), pw2); \
    GAPQ(C1 = MFMA32(kf[5], qa, C1), (void)0,    P1[6], P1[7], P1[8], P1[9],     pw2[2] = PKW(P1, 4), pw2[3] = PKW(P1, 6), pw2); \
    GAPQ(C0 = MFMA32(kf[6], qb, C0), qa = QL(4), P1[10], P1[11], P1[12], P1[13], pw3[0] = PKW(P1, 8), pw3[1] = PKW(P1, 10), pw3); \
    GAPQ(C1 = MFMA32(kf[7], qb, C1), (void)0,    P1[14], P1[15], 0.f, 0.f,       pw3[2] = PKW(P1, 12), pw3[3] = PKW(P1, 14), pw3); \
    C0 = MFMA32(kf[8], qa, C0); qb = QL(5); VRD4(0, 0); ASBAR(); \
    C1 = MFMA32(kf[9], qa, C1); VRD4(4, 1); ASBAR(); \
    C0 = MFMA32(kf[10], qb, C0); ASBAR(); \
    C1 = MFMA32(kf[11], qb, C1); ASBAR(); \
    l_reg += sacc; \
    if (GK) { DMA_K((t) + 3, sl_cur); } if (GV) { DMA_V((t) + 1, sl_next); } \
    if (DOMASK) CMASK(C0, C1, t); \
    { float a = MX3(C0[0], C0[1], C1[0]), b = MX3(C0[2], C0[3], C1[1]); a = MX3(a, C1[2], C1[3]); \
      _Pragma("unroll") for (int r = 4; r < 16; r += 4) { a = MX3(a, C0[r], C0[r + 1]); b = MX3(b, C0[r + 2], C0[r + 3]); a = MX3(a, C1[r], C1[r + 1]); b = MX3(b, C1[r + 2], C1[r + 3]); } \
      float rm = __builtin_fmaxf(a, b); { auto rr = __builtin_amdgcn_permlane32_swap(__float_as_uint(rm), __float_as_uint(rm), false, false); rm = __builtin_fmaxf(__uint_as_float(rr[0]), __uint_as_float(rr[1])); } \
      resc = false; \
      if (__builtin_expect(__any(rm > (float)THRL), 0)) { const float dl = __builtin_fmaxf(rm, 0.f); mhat += dl; \
        _Pragma("unroll") for (int r = 0; r < 16; ++r) { C0[r] -= dl; C1[r] -= dl; } \
        if (USE_NEGM) { _Pragma("unroll") for (int r = 0; r < 16; ++r) negm[r] = -mhat; asm volatile("" : "+v"(negm)); } \
        const float f = __builtin_amdgcn_exp2f(-dl); l_reg *= f; if (hi == 0) wsf[r32] = f; resc = true; } } \
    ASBAR(); \
    VRD4(1, 2); ASBAR(); GAPB(o[0] = MFMA32(PAF(0), VFR4(0), o[0]), C0, 0); \
    VRD4(5, 3); ASBAR(); GAPB(o[1] = MFMA32(PAF(0), VFR4(1), o[1]), C0, 4); \
    VRD4(2, 0); KRD(GL, 0); GAPB(o[0] = MFMA32(PAF(1), VFR4(2), o[0]), C0, 8); \
    VRD4(6, 1); KRD(GL, 1); GAPB(o[1] = MFMA32(PAF(1), VFR4(3), o[1]), C0, 12); \
    VRD4(3, 2); KRD(GL, 2); GAPB(o[0] = MFMA32(PAF(2), VFR4(0), o[0]), C1, 0); \
    VRD4(7, 3); KRD(GL, 3); GAPB(o[1] = MFMA32(PAF(2), VFR4(1), o[1]), C1, 4); \
    KRD(GL, 4); GAPB(o[0] = MFMA32(PAF(3), VFR4(2), o[0]), C1, 8); \
    KRD(GL, 5); GAPB(o[1] = MFMA32(PAF(3), VFR4(3), o[1]), C1, 12); \
    } while (0)
#define STEP(C0, C1, P0, P1, t, GK, GV, GL, DOMASK) do { if constexpr (DQ == 96) { STEP96(C0, C1, P0, P1, t, GK, GV, GL, DOMASK); } else { STEP64(C0, C1, P0, P1, t, GK, GV, GL, DOMASK); } } while (0)
#define ENDW(tt) do { if ((tt) + 3 < NT) { AWAIT_STEADY(); } else if ((tt) + 2 < NT) { AWAIT_BAR(1); } else { AWAIT_BAR(0); } } while (0)
    int t = 1;
    for (; t < 5 && t + 1 < NT; t += 2) {
        STEP(pB0, pB1, pA0, pA1, t, (t + 3 < NT), (t + 1 < NT), (t + 1 < NT), true);       ENDW(t);     RESC(); ROT();
        STEP(pA0, pA1, pB0, pB1, t + 1, (t + 4 < NT), (t + 2 < NT), (t + 2 < NT), true);   ENDW(t + 1); RESC(); ROT();
    }
    for (; t + 5 < NT; t += 2) {
        STEP(pB0, pB1, pA0, pA1, t, true, true, true, false);     AWAIT_STEADY(); RESC(); ROT();
        STEP(pA0, pA1, pB0, pB1, t + 1, true, true, true, false); AWAIT_STEADY(); RESC(); ROT();
    }
    for (; t + 1 < NT; t += 2) {
        STEP(pB0, pB1, pA0, pA1, t, (t + 3 < NT), (t + 1 < NT), (t + 1 < NT), true);       ENDW(t);     RESC(); ROT();
        STEP(pA0, pA1, pB0, pB1, t + 1, (t + 4 < NT), (t + 2 < NT), (t + 2 < NT), true);   ENDW(t + 1); RESC(); ROT();
    }
    STEP(pB0, pB1, pA0, pA1, NT - 1, false, false, false, true); RESC();
    { float sacc = pB0[0] + pB0[1];
      _Pragma("unroll") for (int r = 2; r < 16; ++r) sacc += pB0[r];
      _Pragma("unroll") for (int r = 0; r < 16; ++r) sacc += pB1[r];
      l_reg += sacc;
      pw0 = (u32x4){PKW(pB0, 0), PKW(pB0, 2), PKW(pB0, 4), PKW(pB0, 6)}; pw1 = (u32x4){PKW(pB0, 8), PKW(pB0, 10), PKW(pB0, 12), PKW(pB0, 14)};
      pw2 = (u32x4){PKW(pB1, 0), PKW(pB1, 2), PKW(pB1, 4), PKW(pB1, 6)}; pw3 = (u32x4){PKW(pB1, 8), PKW(pB1, 10), PKW(pB1, 12), PKW(pB1, 14)};
      ASBAR();
      const int vb = vb0 + sl_cur * VSLOT;
#pragma unroll
      for (int d0 = 0; d0 < 2; ++d0) { s16x4 lo[4], hh[4];
#pragma unroll
          for (int ks = 0; ks < 4; ++ks) {
              asm volatile("ds_read_b64_tr_b16 %0,%1 offset:%c2" : "=&v"(lo[ks]) : "v"(vb), "i"(d0 * 4096 + ks * 1024) : "memory");
              asm volatile("ds_read_b64_tr_b16 %0,%1 offset:%c2" : "=&v"(hh[ks]) : "v"(vb), "i"(d0 * 4096 + ks * 1024 + 512) : "memory"); }
          asm volatile("s_waitcnt lgkmcnt(0)" ::: "memory"); ASBAR();
#define PK(k) (bf16x8){lo[k][0], lo[k][1], lo[k][2], lo[k][3], hh[k][0], hh[k][1], hh[k][2], hh[k][3]}
          o[d0] = MFMA32(PAF(0), PK(0), o[d0]); o[d0] = MFMA32(PAF(1), PK(1), o[d0]); o[d0] = MFMA32(PAF(2), PK(2), o[d0]); o[d0] = MFMA32(PAF(3), PK(3), o[d0]);
#undef PK
      } }
    { auto rr = __builtin_amdgcn_permlane32_swap(__float_as_uint(l_reg), __float_as_uint(l_reg), false, false); l_reg = __uint_as_float(rr[0]) + __uint_as_float(rr[1]); }
    if (hi == 0) wsf[32 + r32] = l_reg; asm volatile("s_waitcnt lgkmcnt(0)" ::: "memory");
    int lane_e = lane; asm volatile("" : "+v"(lane_e)); const int hi_e = lane_e >> 5, r32_e = lane_e & 31;
    float rli[16];
    { const float* wl_ = wsf + 32 + 4 * hi_e;
#pragma unroll
      for (int r = 0; r < 16; ++r) rli[r] = __builtin_amdgcn_rcpf(wl_[(r & 3) + 8 * (r >> 2)]); }
    { bf16_t* stg = (bf16_t*)(shm + LDS_OST + wid * QWAVE);
      bf16_t* stl = stg + (4 * hi_e) * 64 + r32_e;
#pragma unroll
      for (int r = 0; r < 16; ++r) {
#pragma unroll
          for (int d0 = 0; d0 < 2; ++d0) stl[((r & 3) + 8 * (r >> 2)) * 64 + d0 * 32] = f2bf(o[d0][r] * rli[r]); }
      asm volatile("s_waitcnt lgkmcnt(0)" ::: "memory");
#pragma unroll
      for (int i = 0; i < 4; ++i) { const int row = i * 8 + (lane_e >> 3), ch = lane_e & 7; const u32x4 v = *(const u32x4*)(stg + row * 64 + ch * 8);
          bf16_t* dst = GQA4 ? (A.obase + (long)(8 * wid + (row >> 2)) * A.opitch + (row & 3) * 64) : (A.obase + (long)(32 * wid + row) * A.opitch);
          *(u32x4*)(dst + ch * 8) = v; } }
    asm volatile("s_waitcnt lgkmcnt(0)\n\ts_barrier" ::: "memory");
#undef TILE_OF
#undef DMA_K
#undef DMA_V
#undef CMASK
#undef CINIT
#undef START
#undef RESC
#undef ROT
#undef PKW
#undef PAF
#undef VFR
#undef PIN
#undef MX3
#undef GAPA
#undef GAPB
#undef EX
#undef VRD
#undef KRD
#undef MFMA32
#undef STEP
#undef STEP64
#undef STEP96
#undef VRD4
#undef VFR4
#undef GAPQ
#undef QL
#undef ENDW
#undef AWAIT_STEADY
}
}
constexpr int MK_THREADS = 512;
constexpr int LDS_RING = 131072;
constexpr int LDS_X = LDS_RING;
constexpr int LDS_MOD = LDS_RING + 8192;
constexpr int LDS_BARST = 155648 - 16;
constexpr int LDS_TOTAL = 155648;

#define C2Q 0.18033688011112042f
#define LOG2E 1.4426950408889634f

struct BlkDesc { bf16_t* dst; const float* gain; int pitch; int flags; float scale; int csoff; };
#define C2M 0.14724312203508865f
struct MKP {
    const float* in[34];
    float* out;
    float* modpart;
    float* mod;
    float* cosT; float* sinT;
    bf16_t* W_in0t;
    bf16_t* W_out0t;
    bf16_t* XN;
    bf16_t* OATT;
    bf16_t* QN;
    bf16_t* KV6;
    bf16_t* FQ; bf16_t* FK; bf16_t* FV;
    float* GATES;
    float* LOGF;
    BlkDesc* desc0;
    float* CUMB;
    BlkDesc* desc_uq;
    BlkDesc* desc_ukv;
    bf16_t* W_in1t;
    bf16_t* W_uqt;
    bf16_t* W_ukvt;
    bf16_t* W_out1t;
    bf16_t* P1;
    bf16_t* CQN;
    bf16_t* CKVN;
    bf16_t* Q96;
    bf16_t* K96;
    bf16_t* V1;
    bf16_t* WcT;
    float* CBIAS;
    bf16_t* KCMP;
    bf16_t* VCT;
    bf16_t* KSLF;
    bf16_t* VSLF;
    bf16_t* OCMP;
    bf16_t* OWIN;
    const int* pos;
    bf16_t* Wgu;
    bf16_t* Wd;
    bf16_t* HID;
    bf16_t* YS;
    bf16_t* YBUF;
    int* gcnt;
    int* list;
    float* ew;
    unsigned* barw;
    int ph_lo, ph_hi, dbg_flags, pad_;
};

__device__ __forceinline__ int swap45(int p) { return (p & 15) | ((p & 16) << 1) | ((p & 32) >> 1); }

template <class Map>
__device__ __forceinline__ void tr_item(const float* __restrict__ W, int ldw, int K, bf16_t* WT, LAS float* scr, int kb, int nb, int lane, const Map& cmap, const float* kscale) {
    const int k0 = 64 * kb, n0 = 32 * nb;
    const int sc = cmap(n0 + (lane & 31));
    float v[32];
    const float* src = W + (size_t)(k0 + (lane >> 5)) * ldw + (sc >= 0 ? sc : 0);
#pragma unroll
    for (int i = 0; i < 32; ++i) v[i] = src[(size_t)(2 * i) * ldw];
    if (kscale) {
#pragma unroll
        for (int i = 0; i < 32; ++i) v[i] *= kscale[k0 + 2 * i + (lane >> 5)];
    }
#pragma unroll
    for (int i = 0; i < 32; ++i) scr[(2 * i + (lane >> 5)) * 33 + (lane & 31)] = (sc >= 0) ? v[i] : 0.f;
    asm volatile("s_waitcnt lgkmcnt(0)" ::: "memory");
    const int c = lane & 7;
#pragma unroll
    for (int j = 0; j < 4; ++j) {
        const int n = (lane >> 3) + 8 * j; const LAS float* s = scr + (8 * c) * 33 + n;
        u32x4 o; o.x = cvtpk(s[0 * 33], s[1 * 33]); o.y = cvtpk(s[2 * 33], s[3 * 33]); o.z = cvtpk(s[4 * 33], s[5 * 33]); o.w = cvtpk(s[6 * 33], s[7 * 33]);
        *(u32x4*)(WT + (size_t)(n0 + n) * K + k0 + 8 * c) = o;
    }
    asm volatile("s_waitcnt lgkmcnt(0)" ::: "memory");
}
struct MapIn0 {
    __device__ __forceinline__ int operator()(int nn) const {
        const int blk = nn >> 6, p = nn & 63;
        if (blk < 8) return blk * 64 + swap45(p);
        if (blk < 20) return 512 + (blk - 8) * 64 + swap45(p);
        if (blk < 44) return 1304 + (blk - 20) * 64 + swap45(p);
        if (blk == 44) { if (p < 24) return 1280 + p; if (p < 32) return 2840 + (p - 24); return -1; }
        return -1;
    }
};
struct MapId { __device__ __forceinline__ int operator()(int nn) const { return nn; } };
struct MapIn1 { __device__ __forceinline__ int operator()(int nn) const { return nn < 672 ? nn : -1; } };
struct MapUq { __device__ __forceinline__ int operator()(int nn) const { if (nn < 1024) return (nn >> 6) * 96 + swap45(nn & 63); const int r = nn - 1024; return (r >> 5) * 96 + 64 + (r & 31); } };
struct MapUkv { __device__ __forceinline__ int operator()(int nn) const { if (nn < 1024) return (nn >> 6) * 128 + swap45(nn & 63); const int r = nn - 1024; return (r >> 6) * 128 + 64 + swap45(r & 63); } };

namespace nsa {
using att::f32x16; using att::crow;
#define NMFMA32(a, b, c) __builtin_amdgcn_mfma_f32_32x32x16_bf16(a, b, c, 0, 0, 0)
#define NMFMA16(a, b, c) __builtin_amdgcn_mfma_f32_16x16x32_bf16(a, b, c, 0, 0, 0)
#define RLF(x, l) __uint_as_float(__builtin_amdgcn_readlane((int)__float_as_uint(x), (l)))

__device__ __forceinline__ void compress_job(const MKP& p, LAS float* scr, LAS float* part, int job, int slice, int lane) {
    const int nt = job & 31, g = (job >> 5) & 1, kv = job >> 6;
    const int r32 = lane & 31, hi = lane >> 5, n0 = nt * 32;
    const bf16_t* tok = p.KV6 + (size_t)(kv * 2 + g) * S_ * 64;
    const bf16_t* wt = p.WcT + (size_t)kv * 64 * 2048;
    scr[lane] = p.CBIAS[kv * 64 + lane];
    asm volatile("s_waitcnt lgkmcnt(0)" ::: "memory");
    int nrow = n0 + r32; if (nrow > 1022) nrow = 1022;
    const bf16_t* ta = tok + (size_t)(16 * nrow) * 64 + 8 * hi;
    const bf16_t* wa0 = wt + (size_t)r32 * 2048 + 8 * hi;
    const bf16_t* wa1 = wa0 + (size_t)32 * 2048;
    f32x16 c0 = f32x16{}, c1 = f32x16{};
    if (kv == 0) {
#pragma unroll 8
        for (int s = 32 * slice; s < 32 * slice + 32; ++s) {
            const bf16x8 tf = *(const bf16x8*)(ta + 16 * s), w0 = *(const bf16x8*)(wa0 + 16 * s), w1 = *(const bf16x8*)(wa1 + 16 * s);
            c0 = NMFMA32(w0, tf, c0); c1 = NMFMA32(w1, tf, c1);
        }
        if (slice) {
#pragma unroll
            for (int r = 0; r < 16; ++r) { part[r * 64 + lane] = c0[r]; part[(16 + r) * 64 + lane] = c1[r]; } }
        __syncthreads();
        if (slice) return;
#pragma unroll
        for (int q = 1; q < 4; ++q)
#pragma unroll
            for (int r = 0; r < 16; ++r) { c0[r] += part[q * 2048 + r * 64 + lane]; c1[r] += part[q * 2048 + (16 + r) * 64 + lane]; }
        float ss = 0.f;
#pragma unroll
        for (int r = 0; r < 16; ++r) { c0[r] += scr[crow(r, hi)]; c1[r] += scr[32 + crow(r, hi)]; ss += c0[r] * c0[r] + c1[r] * c1[r]; }
        { auto rr = __builtin_amdgcn_permlane32_swap(__float_as_uint(ss), __float_as_uint(ss), false, false); ss = __uint_as_float(rr[0]) + __uint_as_float(rr[1]); }
        const float rs = rsqrtf(ss * (1.f / 64.f) + EPSF);
        const float* gn = p.in[10];
        if (n0 + r32 < 1023) {
            const int nn = n0 + r32;
            bf16_t* dst = p.KCMP + (size_t)g * 1024 * 64 + (size_t)(nn >> 6) * 4096 + ((nn >> 5) & 1) * 512 + (nn & 31) * 8;
#pragma unroll
            for (int q = 0; q < 4; ++q) {
                const int e0 = 8 * q + 4 * hi;
                const f32x4 ga = *(const f32x4*)(gn + e0), gb = *(const f32x4*)(gn + 32 + e0);
                u32x2 wa, wb;
                wa.x = cvtpk(c0[4 * q] * rs * ga.x, c0[4 * q + 1] * rs * ga.y); wa.y = cvtpk(c0[4 * q + 2] * rs * ga.z, c0[4 * q + 3] * rs * ga.w);
                wb.x = cvtpk(c1[4 * q] * rs * gb.x, c1[4 * q + 1] * rs * gb.y); wb.y = cvtpk(c1[4 * q + 2] * rs * gb.z, c1[4 * q + 3] * rs * gb.w);
                *(u32x2*)(dst + (e0 >> 4) * 1024 + ((e0 >> 3) & 1) * 256 + (e0 & 7)) = wa; *(u32x2*)(dst + ((32 + e0) >> 4) * 1024 + (((32 + e0) >> 3) & 1) * 256 + ((32 + e0) & 7)) = wb;
            }
        }
    } else {
#pragma unroll 8
        for (int s = 32 * slice; s < 32 * slice + 32; ++s) {
            const bf16x8 tf = *(const bf16x8*)(ta + 16 * s), w0 = *(const bf16x8*)(wa0 + 16 * s), w1 = *(const bf16x8*)(wa1 + 16 * s);
            c0 = NMFMA32(tf, w0, c0); c1 = NMFMA32(tf, w1, c1);
        }
        if (slice) {
#pragma unroll
            for (int r = 0; r < 16; ++r) { part[r * 64 + lane] = c0[r]; part[(16 + r) * 64 + lane] = c1[r]; } }
        __syncthreads();
        if (slice) return;
#pragma unroll
        for (int q = 1; q < 4; ++q)
#pragma unroll
            for (int r = 0; r < 16; ++r) { c0[r] += part[q * 2048 + r * 64 + lane]; c1[r] += part[q * 2048 + (16 + r) * 64 + lane]; }
        const float b0 = scr[r32], b1 = scr[32 + r32];
#pragma unroll
        for (int G = 0; G < 2; ++G) {
            u32x4 va, vb;
            va.x = cvtpk(c0[8 * G] + b0, c0[8 * G + 1] + b0); va.y = cvtpk(c0[8 * G + 2] + b0, c0[8 * G + 3] + b0); va.z = cvtpk(c0[8 * G + 4] + b0, c0[8 * G + 5] + b0); va.w = cvtpk(c0[8 * G + 6] + b0, c0[8 * G + 7] + b0);
            vb.x = cvtpk(c1[8 * G] + b1, c1[8 * G + 1] + b1); vb.y = cvtpk(c1[8 * G + 2] + b1, c1[8 * G + 3] + b1); vb.z = cvtpk(c1[8 * G + 4] + b1, c1[8 * G + 5] + b1); vb.w = cvtpk(c1[8 * G + 6] + b1, c1[8 * G + 7] + b1);
            { const int nk = n0 + 16 * G, c_ = nk >> 6, ks_ = (nk >> 4) & 3;
              bf16_t* vd = p.VCT + (size_t)g * 64 * 1024 + (size_t)c_ * 4096 + ks_ * 1024 + (hi * 32 + r32) * 8;
              *(u32x4*)vd = va; *(u32x4*)(vd + 512) = vb; }
        }
    }
    asm volatile("s_waitcnt lgkmcnt(0)" ::: "memory");
}

__device__ __forceinline__ unsigned pk4_fp8(float a, float b, float c, float d) { int w = __builtin_amdgcn_cvt_pk_fp8_f32(a, b, 0, false); w = __builtin_amdgcn_cvt_pk_fp8_f32(c, d, w, true); return (unsigned)w; }
__device__ __forceinline__ void slcfrag_job(const MKP& p, int job, int lane) {
    const int g = job >> 8, blk = job & 255, c16 = lane & 15, u = lane >> 4;
    const bf16_t* k = p.KV6 + (size_t)(2 * 2 + g) * S_ * 64 + (size_t)blk * 64 * 64;
    const bf16_t* v = p.KV6 + (size_t)(3 * 2 + g) * S_ * 64 + (size_t)blk * 64 * 64;
    unsigned char* kd = (unsigned char*)p.KSLF + ((size_t)g * 256 + blk) * 4096 + lane * 16;
    unsigned char* vd = (unsigned char*)p.VSLF + ((size_t)g * 256 + blk) * 4096 + lane * 16;
#pragma unroll
    for (int kg = 0; kg < 4; ++kg) {
        const u32x4 a = *(const u32x4*)(k + (size_t)(16 * kg + c16) * 64 + 8 * u), b = *(const u32x4*)(k + (size_t)(16 * kg + c16) * 64 + 32 + 8 * u);
        u32x4 o;
        o.x = pk4_fp8(__uint_as_float(a.x << 16), __uint_as_float(a.x & 0xffff0000u), __uint_as_float(a.y << 16), __uint_as_float(a.y & 0xffff0000u));
        o.y = pk4_fp8(__uint_as_float(a.z << 16), __uint_as_float(a.z & 0xffff0000u), __uint_as_float(a.w << 16), __uint_as_float(a.w & 0xffff0000u));
        o.z = pk4_fp8(__uint_as_float(b.x << 16), __uint_as_float(b.x & 0xffff0000u), __uint_as_float(b.y << 16), __uint_as_float(b.y & 0xffff0000u));
        o.w = pk4_fp8(__uint_as_float(b.z << 16), __uint_as_float(b.z & 0xffff0000u), __uint_as_float(b.w << 16), __uint_as_float(b.w & 0xffff0000u));
        *(u32x4*)(kd + kg * 1024) = o;
    }
#pragma unroll
    for (int dg = 0; dg < 4; ++dg) {
        float x[16];
#pragma unroll
        for (int ch = 0; ch < 2; ++ch)
#pragma unroll
            for (int j = 0; j < 8; ++j) { const int key = 32 * ch + ((j < 4) ? 4 * u + j : 16 + 4 * u + (j - 4)); x[ch * 8 + j] = bf2f(v[(size_t)key * 64 + 16 * dg + c16]); }
        u32x4 o; o.x = pk4_fp8(x[0], x[1], x[2], x[3]); o.y = pk4_fp8(x[4], x[5], x[6], x[7]); o.z = pk4_fp8(x[8], x[9], x[10], x[11]); o.w = pk4_fp8(x[12], x[13], x[14], x[15]);
        *(u32x4*)(vd + dg * 1024) = o;
    }
}

constexpr int IMP_LD = 272;
__device__ __forceinline__ void cmp_wave(const MKP& p, int g, int t0w, LAS float* imp, LAS unsigned char* stg, int lane) {
    const int r32 = lane & 31, hi = lane >> 5;
    const int tq = t0w + (r32 >> 2), head = g * 4 + (r32 & 3);
    const int nmax = (tq >= 31) ? ((tq - 31) >> 4) : -1;
    const int nmaxw = (t0w + 7 >= 31) ? ((t0w + 7 - 31) >> 4) : -1;
    const int ntile = (nmaxw >> 6) + 1;
    for (int i = lane; i < 8 * IMP_LD; i += 64) imp[i] = 0.f;
    bf16x8 qr[4];
#pragma unroll
    for (int d0 = 0; d0 < 4; ++d0) qr[d0] = *(const bf16x8*)(p.QN + (size_t)tq * 512 + head * 64 + d0 * 16 + hi * 8);
    const bf16_t* kc = p.KCMP + (size_t)g * 1024 * 64 + (hi * 32 + r32) * 8;
    bf16x8 ovf[4];
#pragma unroll
    for (int ks = 0; ks < 4; ++ks)
#pragma unroll
        for (int j = 0; j < 8; ++j) {
            const int nrel = 16 * ks + ((j < 4) ? 4 * hi + j : 8 + 4 * hi + (j - 4));
            const int dlt = nrel - 4 * r32;
            const float w = (dlt >= 0 && dlt <= 2) ? 2.f : ((dlt == 3 || dlt == -1) ? 1.f : 0.f);
            ovf[ks][j] = (short)f2bf(w);
        }
#define CKLOAD(dst, c_) do { const bf16_t* kt_ = kc + (size_t)(c_) * 4096; _Pragma("unroll") for (int f_ = 0; f_ < 8; ++f_) dst[f_] = *(const bf16x8*)(kt_ + f_ * 512); } while (0)
#define CQK(s0, s1, kf) do { s0 = f32x16{}; s1 = f32x16{}; _Pragma("unroll") for (int d0_ = 0; d0_ < 4; ++d0_) { s0 = NMFMA32(kf[2 * d0_], qr[d0_], s0); s1 = NMFMA32(kf[2 * d0_ + 1], qr[d0_], s1); } } while (0)
    float m = -INFINITY, l = 0.f;
    bf16x8 kfa[8], kfb[8];
    if (ntile > 0) CKLOAD(kfa, 0);
#define CMP_P1(KC, KN, c) do { { const int cn_ = ((c) + 1 < ntile) ? (c) + 1 : ntile - 1; CKLOAD(KN, cn_); } \
        f32x16 s0, s1; CQK(s0, s1, KC); \
        const int x = nmax - 64 * (c) - 4 * hi; float tm = -INFINITY; \
        _Pragma("unroll") for (int r = 0; r < 16; ++r) { const int cc = (r & 3) + 8 * (r >> 2); if (cc > x) s0[r] = -INFINITY; if (cc + 32 > x) s1[r] = -INFINITY; tm = fmaxf(tm, fmaxf(s0[r], s1[r])); } \
        if (tm > m) { l *= __builtin_amdgcn_exp2f(m - tm); m = tm; } \
        if (m > -INFINITY) { float sum = 0.f; _Pragma("unroll") for (int r = 0; r < 16; ++r) sum += __builtin_amdgcn_exp2f(s0[r] - m) + __builtin_amdgcn_exp2f(s1[r] - m); l += sum; } } while (0)
#pragma unroll 1
    for (int c = 0; c < ntile; c += 2) { CMP_P1(kfa, kfb, c); if (c + 1 < ntile) CMP_P1(kfb, kfa, c + 1); }
    { auto rm = __builtin_amdgcn_permlane32_swap(__float_as_uint(m), __float_as_uint(m), false, false);
      auto rl = __builtin_amdgcn_permlane32_swap(__float_as_uint(l), __float_as_uint(l), false, false);
      const float ma = __uint_as_float(rm[0]), mb = __uint_as_float(rm[1]), la = __uint_as_float(rl[0]), lb = __uint_as_float(rl[1]);
      const float mm = fmaxf(ma, mb);
      if (mm > -INFINITY) { l = ((ma > -INFINITY) ? la * __builtin_amdgcn_exp2f(ma - mm) : 0.f) + ((mb > -INFINITY) ? lb * __builtin_amdgcn_exp2f(mb - mm) : 0.f); m = mm; }
      else { l = 0.f; m = 0.f; } }
    const float invl = (l > 0.f) ? 1.f / l : 0.f;
    f32x16 o0 = f32x16{}, o1 = f32x16{};
    const bf16_t* vc = p.VCT + (size_t)g * 64 * 1024 + (hi * 32 + r32) * 8;
    if (ntile > 0) CKLOAD(kfa, 0);
    bf16x8 vfr[8];
#define CMP_P2(KC, KN, c) do { \
        { const bf16_t* vt_ = vc + (size_t)(c) * 4096; _Pragma("unroll") for (int f_ = 0; f_ < 8; ++f_) vfr[f_] = *(const bf16x8*)(vt_ + f_ * 512); } \
        { const int cn_ = ((c) + 1 < ntile) ? (c) + 1 : ntile - 1; CKLOAD(KN, cn_); } \
        f32x16 s0, s1; CQK(s0, s1, KC); \
        const int x = nmax - 64 * (c) - 4 * hi; \
        _Pragma("unroll") for (int r = 0; r < 16; ++r) { const int cc = (r & 3) + 8 * (r >> 2); \
            s0[r] = (cc > x) ? 0.f : __builtin_amdgcn_exp2f(s0[r] - m) * invl; s1[r] = (cc + 32 > x) ? 0.f : __builtin_amdgcn_exp2f(s1[r] - m) * invl; } \
        u32x4 pw[4]; \
        pw[0] = (u32x4){cvtpk(s0[0], s0[1]), cvtpk(s0[2], s0[3]), cvtpk(s0[4], s0[5]), cvtpk(s0[6], s0[7])}; \
        pw[1] = (u32x4){cvtpk(s0[8], s0[9]), cvtpk(s0[10], s0[11]), cvtpk(s0[12], s0[13]), cvtpk(s0[14], s0[15])}; \
        pw[2] = (u32x4){cvtpk(s1[0], s1[1]), cvtpk(s1[2], s1[3]), cvtpk(s1[4], s1[5]), cvtpk(s1[6], s1[7])}; \
        pw[3] = (u32x4){cvtpk(s1[8], s1[9]), cvtpk(s1[10], s1[11]), cvtpk(s1[12], s1[13]), cvtpk(s1[14], s1[15])}; \
        f32x16 im = f32x16{}; \
        _Pragma("unroll") for (int ks = 0; ks < 4; ++ks) { const bf16x8 pa = __builtin_bit_cast(bf16x8, pw[ks]); \
            o0 = NMFMA32(pa, vfr[2 * ks], o0); o1 = NMFMA32(pa, vfr[2 * ks + 1], o1); im = NMFMA32(pa, ovf[ks], im); } \
        if (r32 <= 16 && 16 * (c) + r32 < 256) { \
            _Pragma("unroll") for (int k = 0; k < 4; ++k) { const float v = (im[4 * k] + im[4 * k + 1]) + (im[4 * k + 2] + im[4 * k + 3]); atomicAdd((float*)(imp + (2 * k + hi) * IMP_LD + 16 * (c) + r32), v); } } } while (0)
#pragma unroll 1
    for (int c = 0; c < ntile; c += 2) { CMP_P2(kfa, kfb, c); if (c + 1 < ntile) CMP_P2(kfb, kfa, c + 1); }
#undef CMP_P1
#undef CMP_P2
#undef CKLOAD
#undef CQK
    { bf16_t* st = (bf16_t*)stg; bf16_t* stl = st + (4 * hi) * 64 + r32;
#pragma unroll
      for (int r = 0; r < 16; ++r) { stl[((r & 3) + 8 * (r >> 2)) * 64] = f2bf(o0[r]); stl[((r & 3) + 8 * (r >> 2)) * 64 + 32] = f2bf(o1[r]); }
      asm volatile("s_waitcnt lgkmcnt(0)" ::: "memory");
#pragma unroll
      for (int i = 0; i < 4; ++i) { const int row = i * 8 + (lane >> 3), ch = lane & 7; const u32x4 v = *(const u32x4*)(st + row * 64 + ch * 8);
          *(u32x4*)(p.OCMP + (size_t)(t0w + (row >> 2)) * 512 + (g * 4 + (row & 3)) * 64 + ch * 8) = v; }
      asm volatile("s_waitcnt lgkmcnt(0)" ::: "memory"); }
}

__device__ __forceinline__ float dpp_f(float v, int ctrl_sel) {
    const int x = __float_as_int(v);
    int r;
    if (ctrl_sel == 0) r = __builtin_amdgcn_update_dpp(x, x, 0xB1, 0xF, 0xF, false);
    else if (ctrl_sel == 1) r = __builtin_amdgcn_update_dpp(x, x, 0x4E, 0xF, 0xF, false);
    else if (ctrl_sel == 2) r = __builtin_amdgcn_update_dpp(x, x, 0x124, 0xF, 0xF, false);
    else r = __builtin_amdgcn_update_dpp(x, x, 0x128, 0xF, 0xF, false);
    return __int_as_float(r);
}
__device__ __forceinline__ int dpp_i(int x, int ctrl_sel) {
    if (ctrl_sel == 0) return __builtin_amdgcn_update_dpp(x, x, 0xB1, 0xF, 0xF, false);
    if (ctrl_sel == 1) return __builtin_amdgcn_update_dpp(x, x, 0x4E, 0xF, 0xF, false);
    if (ctrl_sel == 2) return __builtin_amdgcn_update_dpp(x, x, 0x124, 0xF, 0xF, false);
    return __builtin_amdgcn_update_dpp(x, x, 0x128, 0xF, 0xF, false);
}
__device__ __forceinline__ void select_wave(int t0w, const LAS float* imp, LAS int* sel, int lane) {
    const int sub = lane & 31;
#pragma unroll 1
    for (int h = 0; h < 4; ++h) {
        const int tk = 2 * h + (lane >> 5);
        const int tq = t0w + tk, cur = tq >> 6;
        float v[8];
#pragma unroll
        for (int i = 0; i < 8; ++i) { const int j = sub + 32 * i; float x = imp[tk * IMP_LD + j]; if (j == 0 || j == cur || j == cur - 1) x += 1e6f; v[i] = (j <= cur) ? x : -INFINITY; }
#pragma unroll 1
        for (int it = 0; it < 16; ++it) {
            float bv = v[0]; int bi = 0;
#pragma unroll
            for (int i = 1; i < 8; ++i) if (v[i] > bv) { bv = v[i]; bi = i; }
            float gm = bv;
#pragma unroll
            for (int c = 0; c < 4; ++c) gm = fmaxf(gm, dpp_f(gm, c));
            gm = fmaxf(gm, __shfl_xor(gm, 16));
            int cj = (bv == gm) ? sub + 32 * bi : 0x7fffffff;
#pragma unroll
            for (int c = 0; c < 4; ++c) cj = min(cj, dpp_i(cj, c));
            cj = min(cj, __shfl_xor(cj, 16));
            const bool any = gm > -INFINITY;
            if (sub == 0) sel[tk * 16 + it] = any ? cj : -1;
            if (any && (cj & 31) == sub) { const int wi = cj >> 5;
#pragma unroll
                for (int i = 0; i < 8; ++i) if (i == wi) v[i] = -INFINITY; }
        }
    }
    asm volatile("s_waitcnt lgkmcnt(0)" ::: "memory");
}

__device__ __forceinline__ void slc_wave(const MKP& p, int g, int t0w, const LAS int* sel, LAS float* oslc, int lane) {
    const int c16 = lane & 15, u = lane >> 4, ti = c16 >> 2;
    const unsigned char* kb = (const unsigned char*)p.KSLF + (size_t)g * 256 * 4096 + lane * 16;
    const unsigned char* vb = (const unsigned char*)p.VSLF + (size_t)g * 256 * 4096 + lane * 16;
#define LO64(vv_) ((long)(((unsigned long long)(vv_).y << 32) | (vv_).x))
#define HI64(vv_) ((long)(((unsigned long long)(vv_)[3] << 32) | (vv_).z))
#define FMFMA(a, b, c) __builtin_amdgcn_mfma_f32_16x16x32_fp8_fp8(a, b, c, 0, 0, 0)
#define KLOAD4(r_) do { _Pragma("unroll") for (int i_ = 0; i_ < 4; ++i_) { int b_ = sel[(tg * 4 + i_) * 16 + (r_)]; b_ = b_ < 0 ? 0 : b_; const unsigned char* kp_ = kb + (size_t)b_ * 4096; \
        _Pragma("unroll") for (int f_ = 0; f_ < 4; ++f_) kc[i_][f_] = *(const u32x4*)(kp_ + f_ * 1024); } } while (0)
#pragma unroll 1
    for (int tg = 0; tg < 2; ++tg) {
        const int tq = t0w + tg * 4 + ti;
        long qa, qb2;
        { const bf16_t* qp = p.QN + (size_t)tq * 512 + (g * 4 + (c16 & 3)) * 64 + 8 * u;
          const u32x4 r0 = *(const u32x4*)qp, r1 = *(const u32x4*)(qp + 32);
          const unsigned a0 = pk4_fp8(8.f * __uint_as_float(r0.x << 16), 8.f * __uint_as_float(r0.x & 0xffff0000u), 8.f * __uint_as_float(r0.y << 16), 8.f * __uint_as_float(r0.y & 0xffff0000u));
          const unsigned a1 = pk4_fp8(8.f * __uint_as_float(r0.z << 16), 8.f * __uint_as_float(r0.z & 0xffff0000u), 8.f * __uint_as_float(r0.w << 16), 8.f * __uint_as_float(r0.w & 0xffff0000u));
          const unsigned b0 = pk4_fp8(8.f * __uint_as_float(r1.x << 16), 8.f * __uint_as_float(r1.x & 0xffff0000u), 8.f * __uint_as_float(r1.y << 16), 8.f * __uint_as_float(r1.y & 0xffff0000u));
          const unsigned b1 = pk4_fp8(8.f * __uint_as_float(r1.z << 16), 8.f * __uint_as_float(r1.z & 0xffff0000u), 8.f * __uint_as_float(r1.w << 16), 8.f * __uint_as_float(r1.w & 0xffff0000u));
          qa = (long)(((unsigned long long)a1 << 32) | a0); qb2 = (long)(((unsigned long long)b1 << 32) | b0); }
        long q0[4], q1[4];
#pragma unroll
        for (int i = 0; i < 4; ++i) { q0[i] = (ti == i) ? qa : 0; q1[i] = (ti == i) ? qb2 : 0; }
        u32x4 kc[4][4], vf[4][4];
        KLOAD4(0);
        float m = -INFINITY, l = 0.f;
        f32x4 o[4]; o[0] = o[1] = o[2] = o[3] = (f32x4){0.f, 0.f, 0.f, 0.f};
#pragma unroll 1
        for (int r = 0; r < 16; ++r) {
#pragma unroll
            for (int i = 0; i < 4; ++i) { int b_ = sel[(tg * 4 + i) * 16 + r]; b_ = b_ < 0 ? 0 : b_; const unsigned char* vp = vb + (size_t)b_ * 4096;
#pragma unroll
                for (int dg = 0; dg < 4; ++dg) vf[i][dg] = *(const u32x4*)(vp + dg * 1024); }
            f32x4 s[4];
#pragma unroll
            for (int kg = 0; kg < 4; ++kg) { f32x4 c = (f32x4){0.f, 0.f, 0.f, 0.f};
#pragma unroll
                for (int i = 0; i < 4; ++i) { c = FMFMA(LO64(kc[i][kg]), q0[i], c); c = FMFMA(HI64(kc[i][kg]), q1[i], c); }
                s[kg] = c * 0.125f; }
            { const int rn = (r < 15) ? r + 1 : 15; KLOAD4(rn); }
            const int myblk = sel[(tg * 4 + ti) * 16 + r];
            { const int x = (myblk < 0) ? -1 : ((myblk == (tq >> 6)) ? tq - 64 * myblk - 4 * u : 64);
#pragma unroll
              for (int kg = 0; kg < 4; ++kg) { if (16 * kg > x) s[kg].x = -INFINITY; if (16 * kg + 1 > x) s[kg].y = -INFINITY; if (16 * kg + 2 > x) s[kg].z = -INFINITY; if (16 * kg + 3 > x) s[kg].w = -INFINITY; } }
            float tm = -INFINITY;
#pragma unroll
            for (int kg = 0; kg < 4; ++kg) tm = fmaxf(tm, fmaxf(fmaxf(s[kg].x, s[kg].y), fmaxf(s[kg].z, s[kg].w)));
            tm = fmaxf(tm, __shfl_xor(tm, 16)); tm = fmaxf(tm, __shfl_xor(tm, 32));
            float alpha = 1.f;
            if (tm > m) { alpha = __builtin_amdgcn_exp2f(m - tm); m = tm; }
            l *= alpha;
            float sum = 0.f;
#pragma unroll
            for (int kg = 0; kg < 4; ++kg) { s[kg].x = __builtin_amdgcn_exp2f(s[kg].x - m); s[kg].y = __builtin_amdgcn_exp2f(s[kg].y - m); s[kg].z = __builtin_amdgcn_exp2f(s[kg].z - m); s[kg].w = __builtin_amdgcn_exp2f(s[kg].w - m);
                sum += (s[kg].x + s[kg].y) + (s[kg].z + s[kg].w); }
            l += sum;
            { const float a0 = __shfl(alpha, 4 * u), a1 = __shfl(alpha, 4 * u + 1), a2 = __shfl(alpha, 4 * u + 2), a3 = __shfl(alpha, 4 * u + 3);
#pragma unroll
              for (int dg = 0; dg < 4; ++dg) { o[dg].x *= a0; o[dg].y *= a1; o[dg].z *= a2; o[dg].w *= a3; } }
#pragma unroll
            for (int ch = 0; ch < 2; ++ch) {
                const f32x4 pa_ = s[2 * ch] * 128.f, pb_ = s[2 * ch + 1] * 128.f;
                const unsigned lo_ = pk4_fp8(pa_.x, pa_.y, pa_.z, pa_.w), hi_ = pk4_fp8(pb_.x, pb_.y, pb_.z, pb_.w);
                const long pa = (long)(((unsigned long long)hi_ << 32) | lo_);
#pragma unroll
                for (int i = 0; i < 4; ++i) { const long pi = (ti == i) ? pa : 0;
#pragma unroll
                    for (int dg = 0; dg < 4; ++dg) o[dg] = FMFMA(pi, ch ? HI64(vf[i][dg]) : LO64(vf[i][dg]), o[dg]); }
            }
        }
        { float lt = l; lt += __shfl_xor(lt, 16); lt += __shfl_xor(lt, 32);
          const float il = (lt > 0.f) ? (1.f / 128.f) / lt : 0.f;
          const float i0 = __shfl(il, 4 * u), i1 = __shfl(il, 4 * u + 1), i2 = __shfl(il, 4 * u + 2), i3 = __shfl(il, 4 * u + 3);
          LAS float* op = oslc + (tg * 4 + u) * 256 + c16;
#pragma unroll
          for (int dg = 0; dg < 4; ++dg) { op[16 * dg] = o[dg].x * i0; op[64 + 16 * dg] = o[dg].y * i1; op[128 + 16 * dg] = o[dg].z * i2; op[192 + 16 * dg] = o[dg].w * i3; } }
    }
#undef KLOAD4
#undef LO64
#undef HI64
#undef FMFMA
    asm volatile("s_waitcnt lgkmcnt(0)" ::: "memory");
    {
        const int tkl = lane >> 3, cc = (lane & 7) * 32, hh = cc >> 6;
        const int tq = t0w + tkl;
        const float* gt = p.GATES + (size_t)tq * 24 + (g * 4 + hh) * 3;
        const float gc = 1.f / (1.f + __expf(-gt[0])), gs = 1.f / (1.f + __expf(-gt[1])), gw = 1.f / (1.f + __expf(-gt[2]));
        const size_t col = (size_t)tq * 512 + g * 256 + cc;
        const LAS float* os = oslc + tkl * 256 + cc;
#pragma unroll
        for (int q = 0; q < 4; ++q) {
            const u32x4 wc = *(const u32x4*)(p.OCMP + col + 8 * q), ww = *(const u32x4*)(p.OWIN + col + 8 * q);
            const f32x4 sa = *(const LAS f32x4*)(os + 8 * q), sb = *(const LAS f32x4*)(os + 8 * q + 4);
            u32x4 r;
            r.x = cvtpk(gs * sa.x + gc * __uint_as_float(wc.x << 16) + gw * __uint_as_float(ww.x << 16), gs * sa.y + gc * __uint_as_float(wc.x & 0xffff0000u) + gw * __uint_as_float(ww.x & 0xffff0000u));
            r.y = cvtpk(gs * sa.z + gc * __uint_as_float(wc.y << 16) + gw * __uint_as_float(ww.y << 16), gs * sa.w + gc * __uint_as_float(wc.y & 0xffff0000u) + gw * __uint_as_float(ww.y & 0xffff0000u));
            r.z = cvtpk(gs * sb.x + gc * __uint_as_float(wc.z << 16) + gw * __uint_as_float(ww.z << 16), gs * sb.y + gc * __uint_as_float(wc.z & 0xffff0000u) + gw * __uint_as_float(ww.z & 0xffff0000u));
            r.w = cvtpk(gs * sb.z + gc * __uint_as_float(wc.w << 16) + gw * __uint_as_float(ww.w << 16), gs * sb.w + gc * __uint_as_float(wc.w & 0xffff0000u) + gw * __uint_as_float(ww.w & 0xffff0000u));
            *(u32x4*)(p.OATT + (size_t)tq * 1024 + g * 256 + cc + 8 * q) = r;
        }
    }
}

__device__ __forceinline__ void nsa_unit(const MKP& p, char* shm, int g, int tile) {
    int tid_ = threadIdx.x; asm volatile("" : "+v"(tid_));
    const int tid = tid_, lane = tid & 63, r32 = lane & 31; const int wid = __builtin_amdgcn_readfirstlane(tid >> 6);
    const int t0 = tile * 64;
    {   att::UnitArgs A;
        A.qrow = p.QN + (size_t)(t0 + 8 * wid + (r32 >> 2)) * 512 + (g * 4 + (r32 & 3)) * 64;
        A.K = p.KV6 + (size_t)(4 * 2 + g) * S_ * 64; A.V = p.KV6 + (size_t)(5 * 2 + g) * S_ * 64; A.kvpitch = 64; A.vpitch = 64;
        A.obase = p.OWIN + (size_t)t0 * 512 + g * 256; A.opitch = 512;
        A.qtok = 8 * wid + (r32 >> 2); A.abase = tile;
        const int real = (tile + 1 < 9) ? tile + 1 : 9; int nt = (real + 1) & ~1; if (nt < 4) nt = 4;
        A.nsteps = nt; A.bias = nullptr;
        att::attn_unit<att::MODE_WIN, true, 8, 64>(A, shm);
    }
    LAS unsigned char* l3 = (LAS unsigned char*)shm;
    LAS float* imp = (LAS float*)(l3 + wid * (8 * IMP_LD * 4));
    LAS int* sel = (LAS int*)(l3 + 8 * (8 * IMP_LD * 4) + wid * 512);
    LAS unsigned char* stg = l3 + 8 * (8 * IMP_LD * 4) + 8 * 512 + wid * 4096;
    const int t0w = t0 + 8 * wid;
    { int ln = lane; asm volatile("" : "+v"(ln)); cmp_wave(p, g, t0w, imp, stg, ln); }
    asm volatile("s_waitcnt vmcnt(0) lgkmcnt(0)" ::: "memory");
    { int ln = lane; asm volatile("" : "+v"(ln)); select_wave(t0w, imp, sel, ln); }
    { int ln = lane; asm volatile("" : "+v"(ln)); slc_wave(p, g, t0w, sel, imp, ln); }
    asm volatile("s_waitcnt vmcnt(0) lgkmcnt(0)\n\ts_barrier" ::: "memory");
}
#undef NMFMA32
#undef NMFMA16
#undef RLF
}

__device__ __forceinline__ void phase_prologue(const MKP& p, LAS unsigned char* lds) {
    const int tid = threadIdx.x, lane = tid & 63, wave = tid >> 6;
    const int gw = blockIdx.x * 8 + wave, NGW = gridDim.x * 8;
    LAS float* scr = (LAS float*)(lds + wave * 16384);
    for (int it = gw; it < 8 * 192; it += NGW) {
        const int kc = it / 192, ch = it % 192, idx = ch * 64 + lane, l = idx / 6144, n = idx % 6144;
        const float* w = p.in[5] + (size_t)l * 1024 * 6144 + n;
        const float* c = p.in[1];
        float acc = 0.f;
#pragma unroll 8
        for (int k = kc * 128; k < kc * 128 + 128; ++k) { const float cv = c[k]; acc += (cv / (1.f + __expf(-cv))) * w[(size_t)k * 6144]; }
        p.modpart[kc * 12288 + idx] = acc;
    }
    if (blockIdx.x == 1 && tid < 128) p.gcnt[tid] = 0;
    if (blockIdx.x == 0 && tid < 96 + 48 + 64) {
        BlkDesc d; d.dst = nullptr; d.gain = nullptr; d.pitch = 0; d.flags = 4; d.scale = 1.f; d.csoff = 0;
        if (tid < 96) {
            const int blk = (tid >> 3) * 4 + ((tid >> 2) & 1) * 2 + ((tid >> 1) & 1);
            d.flags = 0;
            if (blk < 8) { d.dst = p.QN + blk * 64; d.pitch = 512; d.gain = p.in[9]; d.flags = 1; d.scale = C2Q; }
            else if (blk < 20) { const int j = (blk - 8) >> 1, g = (blk - 8) & 1; d.dst = p.KV6 + (size_t)(j * 2 + g) * S_ * 64; d.pitch = 64;
                d.gain = (j == 2 || j == 4) ? p.in[10] : nullptr; d.flags = (j == 0 || j == 2 || j == 4) ? 1 : 0; }
            else if (blk < 28) { d.dst = p.FQ + (blk - 20) * 64; d.pitch = 512; d.gain = p.in[13]; d.scale = C2Q; }
            else if (blk < 36) { d.dst = p.FK + (blk - 28) * 64; d.pitch = 512; d.gain = p.in[14]; }
            else if (blk < 44) { d.dst = p.FV + (blk - 36) * 64; d.pitch = 512; }
            else if (blk == 44) d.flags = 2;
            else d.flags = 4;
            p.desc0[tid] = d;
        } else if (tid < 96 + 48) {
            const int e = tid - 96, pn = e >> 3, bj = (e >> 2) & 1, wc = e & 3;
            if (pn < 4) { const int h = pn * 4 + bj * 2 + (wc >> 1); d.dst = p.Q96 + (size_t)h * S_ * 96; d.pitch = 96; d.gain = p.in[21]; d.flags = 0; d.scale = C2M; }
            else { const int h = (pn - 4) * 8 + bj * 4 + wc; d.dst = p.Q96 + (size_t)h * S_ * 96 + 64; d.pitch = 96; d.gain = p.in[23]; d.flags = 1 | 8; d.scale = C2M; d.csoff = 32; }
            p.desc_uq[e] = d;
        } else {
            const int e = tid - 144, pn = e >> 3, bj = (e >> 2) & 1, wc = e & 3;
            const int h = (pn & 3) * 4 + bj * 2 + (wc >> 1);
            if (pn < 4) { d.dst = p.K96 + (size_t)h * S_ * 96; d.pitch = 96; d.gain = p.in[22]; d.flags = 32; }
            else { d.dst = p.V1 + (size_t)h * S_ * 64; d.pitch = 64; d.gain = nullptr; d.flags = 64; }
            p.desc_ukv[e] = d;
        }
    }
    if (blockIdx.x == 2 || blockIdx.x == 3) {
        const int kv = blockIdx.x - 2, e = tid & 63, sl = tid >> 6;
        const float* w = p.in[12] + (size_t)kv * 2048 * 64 + e; const float* pe = p.in[11] + kv * 2048;
        float b = 0.f;
#pragma unroll 8
        for (int k = sl * 256; k < sl * 256 + 256; ++k) b += pe[k] * w[(size_t)k * 64];
        LAS float* red = (LAS float*)(lds + 140000);
        red[tid] = b;
        __syncthreads();
        if (tid < 64) { float a = 0.f;
#pragma unroll
            for (int q = 0; q < 8; ++q) a += red[q * 64 + tid];
            p.CBIAS[kv * 64 + tid] = a; }
    }
    for (int idx = blockIdx.x * MK_THREADS + tid; idx < S_ * 48; idx += gridDim.x * MK_THREADS) {
        const int t = idx / 48, i = idx % 48;
        const double ex = (i < 32) ? (double)(2 * i) / 64.0 : (double)(2 * (i - 32)) / 32.0;
        const double a = (double)p.pos[t] * exp(-ex * 9.210340371976184);
        const double r = a - rint(a * 0.15915494309189535) * 6.283185307179586;
        const float rf = (float)r;
        p.cosT[idx] = cosf(rf); p.sinT[idx] = sinf(rf);
    }
    for (int it = gw; it < 2 * 32 * 2; it += NGW) { const int kv = it >> 6, r = it & 63; tr_item(p.in[12] + (size_t)kv * 2048 * 64, 64, 2048, p.WcT + (size_t)kv * 64 * 2048, scr, r >> 1, r & 1, lane, MapId(), nullptr); }
    constexpr int I_IN0 = 16 * 96, I_OUT0 = 16 * 32, I_IN1 = 16 * 24, I_UQ = 6 * 48, I_UKV = 4 * 64, I_OUT1 = 16 * 32;
    for (int it = gw; it < I_IN0 + I_OUT0 + I_IN1 + I_UQ + I_UKV + I_OUT1; it += NGW) {
        int r = it;
        if (r < I_IN0) { tr_item(p.in[7], HYIN, 1024, p.W_in0t, scr, r / 96, r % 96, lane, MapIn0(), nullptr); continue; } r -= I_IN0;
        if (r < I_OUT0) { tr_item(p.in[15], 1024, 1024, p.W_out0t, scr, r / 32, r % 32, lane, MapId(), nullptr); continue; } r -= I_OUT0;
        if (r < I_IN1) { tr_item(p.in[16], 672, 1024, p.W_in1t, scr, r / 24, r % 24, lane, MapIn1(), nullptr); continue; } r -= I_IN1;
        if (r < I_UQ) { tr_item(p.in[19], 1536, 384, p.W_uqt, scr, r / 48, r % 48, lane, MapUq(), p.in[17]); continue; } r -= I_UQ;
        if (r < I_UKV) { tr_item(p.in[20], 2048, 256, p.W_ukvt, scr, r / 64, r % 64, lane, MapUkv(), p.in[18]); continue; } r -= I_UKV;
        tr_item(p.in[25], 1024, 1024, p.W_out1t, scr, r / 32, r % 32, lane, MapId(), nullptr);
    }
}

template <bool COMB>
__device__ __forceinline__ void phase_norm(const MKP& p, LAS unsigned char* lds, const float* x, const float* gw_, int layer, int sc_idx, int sh_idx, bool finalize_mod) {
    const int tid = threadIdx.x, lane = tid & 63, wave = tid >> 6;
    LAS float* msc = (LAS float*)(lds + LDS_MOD);
    LAS float* msh = msc + 1024;
    const float* b_ada = p.in[6];
    if (finalize_mod) {
        for (int i = tid; i < 2048; i += MK_THREADS) {
            const int idx = layer * 6144 + ((i < 1024) ? sc_idx * 1024 + i : sh_idx * 1024 + (i - 1024));
            float a = b_ada[idx];
#pragma unroll
            for (int kc = 0; kc < 8; ++kc) a += p.modpart[kc * 12288 + idx];
            msc[i] = a;
        }
        for (int idx = blockIdx.x * MK_THREADS + tid; idx < 12288; idx += gridDim.x * MK_THREADS) {
            float a = b_ada[idx];
#pragma unroll
            for (int kc = 0; kc < 8; ++kc) a += p.modpart[kc * 12288 + idx];
            p.mod[idx] = a;
        }
    } else {
        for (int i = tid; i < 2048; i += MK_THREADS)
            msc[i] = p.mod[layer * 6144 + ((i < 1024) ? sc_idx * 1024 + i : sh_idx * 1024 + (i - 1024))];
    }
    __syncthreads();
    const int gwv = blockIdx.x * 8 + wave, NGW = gridDim.x * 8;
    for (int m = gwv; m < S_; m += NGW) {
        const f32x4* xr = (const f32x4*)(x + (size_t)m * D_) + lane;
        f32x4 v[4]; float s = 0.f;
#pragma unroll
        for (int j = 0; j < 4; ++j) {
            v[j] = xr[64 * j];
            if (COMB) {
                f32x4 ys = (f32x4){0.f, 0.f, 0.f, 0.f};
#pragma unroll
                for (int k = 0; k < 8; ++k) {
                    const int w = *((const int*)((const char*)p.YBUF + ((size_t)m * 8 + k) * 1024) + lane + 64 * j);
                    const f32x2 lo = __builtin_amdgcn_cvt_pk_f32_fp8(w, false), hi = __builtin_amdgcn_cvt_pk_f32_fp8(w, true);
                    ys.x += lo.x; ys.y += lo.y; ys.z += hi.x; ys.w += hi.y;
                }
                { const u32x2 sw = *((const u32x2*)(p.YS + (size_t)m * 1024) + lane + 64 * j);
                  ys.x += 16.f * __uint_as_float(sw.x << 16); ys.y += 16.f * __uint_as_float(sw.x & 0xffff0000u); ys.z += 16.f * __uint_as_float(sw.y << 16); ys.w += 16.f * __uint_as_float(sw.y & 0xffff0000u); }
                const f32x4 g2v = *(const f32x4*)(p.mod + (layer - 1) * 6144 + 5 * 1024 + 256 * j + 4 * lane) * (1.f / 16.f);
                v[j] = v[j] + g2v * ys;
                ((f32x4*)(p.out + (size_t)m * D_) + lane)[64 * j] = v[j];
            }
            s += (v[j].x * v[j].x + v[j].y * v[j].y) + (v[j].z * v[j].z + v[j].w * v[j].w);
        }
        s = wsum(s);
        const float rstd = rsqrtf(s * (1.f / D_) + EPSF);
        u32x2* o8 = (u32x2*)(p.XN + (size_t)m * D_) + lane;
#pragma unroll
        for (int j = 0; j < 4; ++j) {
            const int c0 = 256 * j + 4 * lane;
            const f32x4 g = *(const f32x4*)(gw_ + c0);
            const f32x4 sc = *(const LAS f32x4*)(msc + c0), sh = *(const LAS f32x4*)(msh + c0);
            const f32x4 y = v[j] * rstd * g * (sc + 1.f) + sh;
            u32x2 w; w.x = cvtpk(y.x, y.y); w.y = cvtpk(y.z, y.w);
            o8[64 * j] = w;
        }
    }
}

struct EpiResid {
    static constexpr bool PERM = true;
    const float* xin; float* out; const float* gate;
    __device__ __forceinline__ void operator()(const f32x4 (&acc)[2][2][4][2], const pg::Unit& u, int wid, int wr, int wc, int fr_, int fq_) const {
        int fr = fr_, fq = fq_; asm volatile("" : "+v"(fr), "+v"(fq));
        const int col0 = u.pn * 256 + wc * 32 + 8 * fq;
        f32x4 g[2][2];
#pragma unroll
        for (int bj = 0; bj < 2; ++bj)
#pragma unroll
            for (int n = 0; n < 2; ++n) g[bj][n] = *(const f32x4*)(gate + col0 + bj * 128 + n * 4);
#pragma unroll
        for (int ai = 0; ai < 2; ++ai)
#pragma unroll
            for (int m = 0; m < 4; ++m) {
                const size_t off = (size_t)(u.pm * 256 + ai * 128 + wr * 64 + m * 16 + fr) * 1024 + col0;
#pragma unroll
                for (int bj = 0; bj < 2; ++bj)
#pragma unroll
                    for (int n = 0; n < 2; ++n) {
                        const f32x4 xv = *(const f32x4*)(xin + off + bj * 128 + n * 4);
                        *(f32x4*)(out + off + bj * 128 + n * 4) = xv + g[bj][n] * acc[ai][bj][m][n];
                    }
                asm volatile("" ::: "memory");
            }
    }
};

struct EpiHeads {
    static constexpr bool PERM = false;
    const BlkDesc* tab; const float* cosT; const float* sinT; float* GATES; float* LOGF; LAS float* X;
    __device__ __forceinline__ void operator()(const f32x4 (&acc)[2][2][4][2], const pg::Unit& u, int wid, int wr, int wc, int fr_, int fq_) const {
        int fr = fr_, fq = fq_; asm volatile("" : "+v"(fr), "+v"(fq));
        const int w1 = wc & 1;
#pragma unroll
        for (int ai = 0; ai < 2; ++ai)
#pragma unroll
            for (int bj = 0; bj < 2; ++bj)
#pragma unroll
                for (int m = 0; m < 4; ++m) {
                    const f32x4 a = acc[ai][bj][m][0], b = acc[ai][bj][m][1];
                    float s = (a.x * a.x + a.y * a.y) + (a.z * a.z + a.w * a.w) + (b.x * b.x + b.y * b.y) + (b.z * b.z + b.w * b.w);
                    s += __shfl_xor(s, 16); s += __shfl_xor(s, 32);
                    if (fq == 0) X[wid * 256 + ((ai * 2 + bj) * 4 + m) * 16 + fr] = s;
                }
        asm volatile("s_waitcnt lgkmcnt(0)" ::: "memory"); __builtin_amdgcn_s_barrier(); asm volatile("" ::: "memory");
#pragma unroll
        for (int bj = 0; bj < 2; ++bj) {
            const BlkDesc d = tab[8 * u.pn + 4 * bj + wc];
            const int row0 = u.pm * 256 + wr * 64 + fr;
            if (d.flags & 4) continue;
            if (d.flags & 2) {
                if (w1 == 0) {
#pragma unroll
                    for (int ai = 0; ai < 2; ++ai)
#pragma unroll
                        for (int m = 0; m < 4; ++m) {
                            const int row = row0 + ai * 128 + m * 16;
#pragma unroll
                            for (int n = 0; n < 2; ++n) {
                                const f32x4 v = acc[ai][bj][m][n];
                                const int pc = 16 * n + 4 * fq;
                                if (pc < 24) *(f32x4*)(GATES + (size_t)row * 24 + pc) = v;
                                else *(f32x4*)(LOGF + (size_t)row * 8 + (pc - 24)) = v;
                            }
                            asm volatile("" ::: "memory");
                        }
                }
                continue;
            }
            const bool half = (d.flags & 8) != 0, has_gain = d.gain != nullptr, rope = (d.flags & 1) != 0;
            const int d0 = half ? 4 * fq : 16 * w1 + 4 * fq;
            const int dn1 = half ? 16 : 32;
            const float invn = half ? (1.f / 32.f) : (1.f / 64.f);
            const GAS float* gp = (const GAS float*)(has_gain ? d.gain : cosT);
            f32x4 g0 = *(const GAS f32x4*)(gp + d0), g1 = *(const GAS f32x4*)(gp + dn1 + d0);
            if (!has_gain) { g0 = (f32x4){1.f, 1.f, 1.f, 1.f}; g1 = g0; }
            g0 = g0 * d.scale; g1 = g1 * d.scale;
            const int cso = d.csoff + d0;
#pragma unroll
            for (int ai = 0; ai < 2; ++ai)
#pragma unroll
                for (int m = 0; m < 4; ++m) {
                    const int row = row0 + ai * 128 + m * 16;
                    const int xi = ((ai * 2 + bj) * 4 + m) * 16 + fr;
                    float ssq = X[wid * 256 + xi]; const float ssp = X[(wid ^ 1) * 256 + xi];
                    if (!half) ssq += ssp;
                    const float rs = has_gain ? rsqrtf(ssq * invn + EPSF) : 1.f;
                    f32x4 x1 = acc[ai][bj][m][0] * rs * g0, x2 = acc[ai][bj][m][1] * rs * g1;
                    f32x4 c = *(const f32x4*)(cosT + (size_t)row * 48 + cso), sn = *(const f32x4*)(sinT + (size_t)row * 48 + cso);
                    if (!rope) { c = (f32x4){1.f, 1.f, 1.f, 1.f}; sn = (f32x4){0.f, 0.f, 0.f, 0.f}; }
                    const f32x4 o1 = x1 * c - x2 * sn, o2 = x2 * c + x1 * sn;
                    u32x2 wa, wb; wa.x = cvtpk(o1.x, o1.y); wa.y = cvtpk(o1.z, o1.w); wb.x = cvtpk(o2.x, o2.y); wb.y = cvtpk(o2.z, o2.w);
                    if (d.flags & 32) {
                        GAS bf16_t* tb = (GAS bf16_t*)d.dst + (size_t)(row >> 6) * 6144 + (row & 63) * 8 + (d0 & 7);
                        *(GAS u32x2*)(tb + (d0 >> 3) * 512) = wa; *(GAS u32x2*)(tb + ((dn1 + d0) >> 3) * 512) = wb;
                    } else if (d.flags & 64) {
                        GAS bf16_t* tb = (GAS bf16_t*)d.dst + (size_t)(row >> 6) * 4096 + ((row >> 4) & 3) * 512 + (row & 15) * 32 + (d0 & 7);
                        *(GAS u32x2*)(tb + (d0 >> 5) * 2048 + ((d0 >> 3) & 3) * 8) = wa; *(GAS u32x2*)(tb + ((dn1 + d0) >> 5) * 2048 + (((dn1 + d0) >> 3) & 3) * 8) = wb;
                    } else {
                        GAS bf16_t* dr = (GAS bf16_t*)d.dst + (size_t)row * d.pitch + d0;
                        *(GAS u32x2*)dr = wa; *(GAS u32x2*)(dr + dn1) = wb;
                    }
                    asm volatile("" ::: "memory");
                }
        }
    }
};

struct EpiPlain {
    static constexpr bool PERM = true;
    bf16_t* O; int ldc;
    __device__ __forceinline__ void operator()(const f32x4 (&acc)[2][2][4][2], const pg::Unit& u, int wid, int wr, int wc, int fr_, int fq_) const {
        int fr = fr_, fq = fq_; asm volatile("" : "+v"(fr), "+v"(fq));
        const int col0 = u.pn * 256 + wc * 32 + 8 * fq;
#pragma unroll
        for (int ai = 0; ai < 2; ++ai)
#pragma unroll
            for (int m = 0; m < 4; ++m) {
                bf16_t* rp = O + (size_t)(u.pm * 256 + ai * 128 + wr * 64 + m * 16 + fr) * ldc + col0;
#pragma unroll
                for (int bj = 0; bj < 2; ++bj) { const f32x4 a = acc[ai][bj][m][0], b = acc[ai][bj][m][1];
                    u32x4 w; w.x = cvtpk(a.x, a.y); w.y = cvtpk(a.z, a.w); w.z = cvtpk(b.x, b.y); w.w = cvtpk(b.z, b.w); *(u32x4*)(rp + bj * 128) = w; }
            }
    }
};

__device__ __forceinline__ void phase_post1a(const MKP& p) {
    int tid_ = threadIdx.x; asm volatile("" : "+v"(tid_));
    const int tid = tid_, lane = tid & 63, wave = tid >> 6;
    const int gwv = blockIdx.x * 8 + wave, NGW = gridDim.x * 8;
    for (int t = gwv; t < S_; t += NGW) {
        const u32x2* row = (const u32x2*)(p.P1 + (size_t)t * 768);
        f32x4 v[3]; float sq = 0.f, skv = 0.f, skr = 0.f;
#pragma unroll
        for (int j = 0; j < 3; ++j) {
            const int g = lane + 64 * j;
            f32x4 x = (f32x4){0.f, 0.f, 0.f, 0.f};
            if (g < 168) { const u32x2 w = row[g]; x.x = __uint_as_float(w.x << 16); x.y = __uint_as_float(w.x & 0xffff0000u); x.z = __uint_as_float(w.y << 16); x.w = __uint_as_float(w.y & 0xffff0000u); }
            v[j] = x;
            const float s = (x.x * x.x + x.y * x.y) + (x.z * x.z + x.w * x.w);
            if (g < 96) sq += s; else if (g < 160) skv += s; else skr += s;
        }
        sq = wsum(sq); skv = wsum(skv); skr = wsum(skr);
        const float rq = rsqrtf(sq * (1.f / 384.f) + EPSF), rkv = rsqrtf(skv * (1.f / 256.f) + EPSF), rkr = rsqrtf(skr * (1.f / 32.f) + EPSF);
#pragma unroll
        for (int j = 0; j < 3; ++j) {
            const int g = lane + 64 * j;
            if (g < 96) { const f32x4 y = v[j] * rq; u32x2 w; w.x = cvtpk(y.x, y.y); w.y = cvtpk(y.z, y.w); *(u32x2*)(p.CQN + (size_t)t * 384 + 4 * g) = w; }
            else if (g < 160) { const f32x4 y = v[j] * rkv; u32x2 w; w.x = cvtpk(y.x, y.y); w.y = cvtpk(y.z, y.w); *(u32x2*)(p.CKVN + (size_t)t * 256 + 4 * (g - 96)) = w; }
        }
        {
            const int dl = (lane - 32) & 7;
            const int dd = 4 * dl;
            const int fi = 4 * (dl & 3);
            f32x4 x = v[2] * rkr;
            const f32x4 gn = *(const f32x4*)(p.in[24] + (dd & 31));
            x = x * gn;
            f32x4 o; o.x = __shfl_xor(x.x, 4); o.y = __shfl_xor(x.y, 4); o.z = __shfl_xor(x.z, 4); o.w = __shfl_xor(x.w, 4);
            const f32x4 c = *(const f32x4*)(p.cosT + (size_t)t * 48 + 32 + fi), sn = *(const f32x4*)(p.sinT + (size_t)t * 48 + 32 + fi);
            const f32x4 y = (dl < 4) ? (x * c - o * sn) : (x * c + o * sn);
            if (lane >= 32 && lane < 40) {
                u32x2 w; w.x = cvtpk(y.x, y.y); w.y = cvtpk(y.z, y.w);
#pragma unroll
                for (int h = 0; h < 16; ++h) *(u32x2*)(p.K96 + (size_t)h * S_ * 96 + (size_t)(t >> 6) * 6144 + (8 + (dd >> 3)) * 512 + (t & 63) * 8 + (dd & 7)) = w;
            }
        }
    }
}

__device__ __forceinline__ void mla_unit(const MKP& p, char* shm, int h, int qb) {
    int tid_ = threadIdx.x; asm volatile("" : "+v"(tid_));
    const int tid = tid_, lane = tid & 63, r32 = lane & 31; const int wid = __builtin_amdgcn_readfirstlane(tid >> 6);
    const int q0 = qb * 256;
    att::UnitArgs A;
    A.qrow = p.Q96 + ((size_t)h * S_ + q0 + 32 * wid + r32) * 96;
    A.K = p.K96 + (size_t)h * S_ * 96; A.kvpitch = 96; A.V = p.V1 + (size_t)h * S_ * 64; A.vpitch = 64;
    A.obase = p.OATT + (size_t)q0 * 1024 + h * 64; A.opitch = 1024;
    A.qtok = 32 * wid + r32; A.abase = 4 * qb; A.nsteps = 4 * qb + 4; A.bias = nullptr;
    att::attn_unit<att::MODE_CAUSAL, false, 8, 96, true>(A, shm);
}
__device__ __forceinline__ void phase_mla(const MKP& p, char* shm) {
    const int G = gridDim.x, bx = blockIdx.x;
    const int vcu = (G % 8 == 0) ? (bx % 8) * (G / 8) + bx / 8 : bx;
    for (int u = vcu; u < 256; u += G) {
        const int h = u >> 4, s = u & 15;
#pragma unroll 1
        for (int rep = 0; rep < 4; ++rep) mla_unit(p, shm, h, rep == 0 ? s : rep == 1 ? 31 - s : rep == 2 ? 32 + s : 63 - s);
    }
}

__device__ __forceinline__ void phase_scan(const MKP& p, LAS unsigned char* lds) {
    constexpr int NSB = 64;
    if (blockIdx.x >= NSB) {
        int tid_ = threadIdx.x; asm volatile("" : "+v"(tid_));
        const int lane = tid_ & 63, wave = tid_ >> 6;
        const int sb = blockIdx.x - NSB, NSBK = gridDim.x - NSB;
        LAS float* scr = (LAS float*)(lds + 65536 + wave * 256);
        for (int bj = sb; bj < 64; bj += NSBK) nsa::compress_job(p, scr, (LAS float*)(lds + (wave >> 2) * 32768) + (wave & 3) * 2048, 2 * bj + (wave >> 2), wave & 3, lane);
        for (int j = ((sb + NSBK - 64) % NSBK) * 8 + wave; j < 512; j += NSBK * 8) nsa::slcfrag_job(p, j, lane);
        return;
    }
    const int h = blockIdx.x >> 3, seg = blockIdx.x & 7, tid = threadIdx.x;
    LAS double* part = (LAS double*)lds;
    const float fb = p.in[8][h];
    double own[4], s = 0.0, pre = 0.0;
#pragma unroll
    for (int i = 0; i < 4; ++i) { own[i] = (double)logsigmf(p.LOGF[(size_t)(seg * 2048 + tid * 4 + i) * 8 + h] + fb); s += own[i]; }
    for (int i = tid; i < seg * 2048; i += MK_THREADS) pre += (double)logsigmf(p.LOGF[(size_t)i * 8 + h] + fb);
    part[tid] = s; part[512 + tid] = pre;
    __syncthreads();
    for (int o = 1; o < MK_THREADS; o <<= 1) {
        const double v = (tid >= o) ? part[tid - o] : 0.0, w = (tid >= o) ? part[512 + tid - o] : 0.0;
        __syncthreads();
        part[tid] += v; part[512 + tid] += w;
        __syncthreads();
    }
    double a = part[512 + MK_THREADS - 1] + ((tid > 0) ? part[tid - 1] : 0.0);
#pragma unroll
    for (int i = 0; i < 4; ++i) { a += own[i]; p.CUMB[(size_t)h * S_ + seg * 2048 + tid * 4 + i] = (float)(a * 1.4426950408889634); }
}

__device__ __forceinline__ void fox_unit(const MKP& p, char* shm, int h, int qb) {
    int tid_ = threadIdx.x; asm volatile("" : "+v"(tid_));
    const int tid = tid_, lane = tid & 63, r32 = lane & 31; const int wid = __builtin_amdgcn_readfirstlane(tid >> 6);
    const int q0 = qb * 256, abase = 4 * qb;
    const float* cb = p.CUMB + (size_t)h * S_;
    LAS float* bias = (LAS float*)(LAS unsigned char*)(shm + att::LDS_BIAS);
    LAS int* cnt = (LAS int*)(LAS unsigned char*)(shm + att::Geo<64>::LDS_WS);
    float gq = 0.f, gk = 0.f;
    for (int i = 0; i < 64; ++i) { gq = fmaxf(gq, fabsf(p.in[13][i])); gk = fmaxf(gk, fabsf(p.in[14][i])); }
    const float TH = 150.f + 2.f * (64.f * gq * gk * C2Q * 1.05f);
    const float c0 = cb[q0], cref = cb[q0 + 255];
    const bool skip = (tid < abase) && (cb[64 * tid + 63] - c0 > TH);
    const unsigned long long bal = __ballot(skip);
    if (lane == 0) cnt[wid] = __popcll(bal);
    __syncthreads();
    int alo = 0;
#pragma unroll
    for (int w = 0; w < 8; ++w) alo += cnt[w];
    int NT = abase + 4 - alo;
    if (NT & 1) { alo -= 1; NT += 1; }
    for (int i = tid; i < NT * 64; i += MK_THREADS) bias[i] = cref - cb[64 * alo + i];
    __syncthreads();
    att::UnitArgs A;
    A.qrow = p.FQ + (size_t)(q0 + 32 * wid + r32) * 512 + h * 64;
    A.K = p.FK + h * 64; A.V = p.FV + h * 64; A.kvpitch = 512; A.vpitch = 512;
    A.obase = p.OATT + (size_t)q0 * 1024 + 512 + h * 64; A.opitch = 1024;
    A.qtok = 32 * wid + r32; A.abase = abase; A.nsteps = NT; A.bias = bias;
    att::attn_unit<att::MODE_FOX, false, 8, 64>(A, shm);
}
__device__ __forceinline__ void phase_fox(const MKP& p, char* shm, int part = 3) {
    const int G = gridDim.x, bx = blockIdx.x;
    const int vcu = (G % 8 == 0) ? (bx % 8) * (G / 8) + bx / 8 : bx;
    if (part & 1) for (int u = vcu; u < 256; u += G) {
        const int h = u >> 5, s = u & 31;
#pragma unroll 1
        for (int rep = 0; rep < 2; ++rep) fox_unit(p, shm, h, rep ? 63 - s : s);
    }
    if (part & 2) for (int u = vcu; u < 256; u += G) {
#pragma unroll 1
        for (int rep = 0; rep < 2; ++rep) nsa::nsa_unit(p, shm, rep, rep ? 255 - u : u);
    }
}


struct MapOff { int off; __device__ __forceinline__ int operator()(int nn) const { return off + (nn & 31); } };
__device__ __forceinline__ void phase_moe_weights(const MKP& p, LAS unsigned char* lds, int layer) {
    int tid_ = threadIdx.x; asm volatile("" : "+v"(tid_));
    const int tid = tid_, lane = tid & 63, wave = tid >> 6;
    const int gw = blockIdx.x * 8 + wave, NGW = gridDim.x * 8;
    LAS float* scr = (LAS float*)(lds + wave * 16384);
    constexpr int IG = 16 * 16, ID = 4 * 32, IE = IG + ID;
    for (int it = gw; it < 65 * IE; it += NGW) {
        const int e = it / IE; int r = it % IE;
        if (r < IG) {
            const int kb = r / 16, nb = r % 16;
            const int n0 = nb * 32, up = (n0 >> 7) & 1, f0 = (n0 >> 8) * 128 + (n0 & 127);
            const float* W = (e < 64) ? ((up ? p.in[29] : p.in[28]) + ((size_t)layer * 64 + e) * 1024 * 256) : ((up ? p.in[32] : p.in[31]) + (size_t)layer * 1024 * 256);
            MapOff mo{f0};
            tr_item(W, 256, 1024, p.Wgu + (size_t)e * 512 * 1024, scr, kb, nb, lane, mo, nullptr);
        } else {
            r -= IG; const int kb = r / 32, nb = r % 32;
            const float* W = (e < 64) ? (p.in[30] + ((size_t)layer * 64 + e) * 256 * 1024) : (p.in[33] + (size_t)layer * 256 * 1024);
            tr_item(W, 1024, 256, p.Wd + (size_t)e * 1024 * 256, scr, kb, nb, lane, MapId(), nullptr);
        }
    }
}

template <bool DRY>
__device__ __forceinline__ void phase_moe_route(const MKP& p, LAS unsigned char* lds, int layer) {
    int tid_ = threadIdx.x; asm volatile("" : "+v"(tid_));
    const int tid = tid_, lane = tid & 63, wave = tid >> 6;
    LAS float* msc = (LAS float*)(lds + LDS_MOD);
    LAS float* msh = msc + 1024;
    LAS float* hrow = (LAS float*)lds;
    LAS int* cntl = (LAS int*)(lds + LDS_X);
    LAS int* basel = cntl + 64;
    const float* gnorm = p.in[4] + layer * 1024;
    const float* wr = p.in[26] + (size_t)layer * 1024 * 64;
    const float rb = p.in[27][layer * 64 + lane];
    for (int i = tid; i < 2048; i += MK_THREADS) msc[i] = p.mod[layer * 6144 + ((i < 1024) ? 4 * 1024 + i : 3 * 1024 + (i - 1024))];
    __syncthreads();
    for (int batch = blockIdx.x; batch < S_ / 32; batch += gridDim.x) {
        if (tid < 64) cntl[tid] = 0;
        {
            f32x4 v[4][4];
#pragma unroll
            for (int i = 0; i < 4; ++i) {
                const f32x4* xr = (const f32x4*)(p.out + (size_t)(batch * 32 + wave * 4 + i) * D_) + lane;
#pragma unroll
                for (int j = 0; j < 4; ++j) v[i][j] = xr[64 * j];
            }
#pragma unroll
            for (int i = 0; i < 4; ++i) {
                const int t = batch * 32 + wave * 4 + i;
                float s = 0.f;
#pragma unroll
                for (int j = 0; j < 4; ++j) s += (v[i][j].x * v[i][j].x + v[i][j].y * v[i][j].y) + (v[i][j].z * v[i][j].z + v[i][j].w * v[i][j].w);
                s = wsum(s);
                const float rstd = rsqrtf(s * (1.f / D_) + EPSF);
                u32x2* o8 = (u32x2*)(p.XN + (size_t)t * D_) + lane;
                LAS f32x4* hr = (LAS f32x4*)(hrow + (wave * 4 + i) * 1024);
#pragma unroll
                for (int j = 0; j < 4; ++j) {
                    const int c0 = 256 * j + 4 * lane;
                    const f32x4 g = *(const f32x4*)(gnorm + c0);
                    const f32x4 sc = *(const LAS f32x4*)(msc + c0), sh = *(const LAS f32x4*)(msh + c0);
                    const f32x4 y = v[i][j] * rstd * g * (sc + 1.f) + sh;
                    u32x2 w; w.x = cvtpk(y.x, y.y); w.y = cvtpk(y.z, y.w);
                    o8[64 * j] = w; hr[(64 * j + lane) ^ ((wave * 4 + i) & 15)] = y;
                }
            }
        }
        __syncthreads();
        float acc0, acc1, acc2, acc3;
        {
            typedef float f32x16 __attribute__((ext_vector_type(16)));
            f32x16 accA, accB;
#pragma unroll
            for (int r = 0; r < 16; ++r) { accA[r] = 0.f; accB[r] = 0.f; }
            const int r32 = lane & 31, hh = lane >> 5;
            const float* wk = wr + (size_t)(wave * 128 + 4 * hh) * 64 + r32;
            const LAS float* hk = hrow + r32 * 1024;
            float bn[8];
#pragma unroll
            for (int j = 0; j < 4; ++j) { bn[j] = wk[j * 64]; bn[4 + j] = wk[j * 64 + 32]; }
#pragma unroll 1
            for (int g = 0; g < 16; ++g) {
                float b[8];
#pragma unroll
                for (int j = 0; j < 8; ++j) b[j] = bn[j];
                const int gn = (g + 1 < 16) ? g + 1 : 0;
#pragma unroll
                for (int j = 0; j < 4; ++j) { bn[j] = wk[(gn * 8 + j) * 64]; bn[4 + j] = wk[(gn * 8 + j) * 64 + 32]; }
                const f32x4 a = *(const LAS f32x4*)(hk + (((wave * 32 + g * 2 + hh) ^ (r32 & 15)) << 2));
                accA = __builtin_amdgcn_mfma_f32_32x32x2f32(a.x, b[0], accA, 0, 0, 0); accB = __builtin_amdgcn_mfma_f32_32x32x2f32(a.x, b[4], accB, 0, 0, 0);
                accA = __builtin_amdgcn_mfma_f32_32x32x2f32(a.y, b[1], accA, 0, 0, 0); accB = __builtin_amdgcn_mfma_f32_32x32x2f32(a.y, b[5], accB, 0, 0, 0);
                accA = __builtin_amdgcn_mfma_f32_32x32x2f32(a.z, b[2], accA, 0, 0, 0); accB = __builtin_amdgcn_mfma_f32_32x32x2f32(a.z, b[6], accB, 0, 0, 0);
                accA = __builtin_amdgcn_mfma_f32_32x32x2f32(a.w, b[3], accA, 0, 0, 0); accB = __builtin_amdgcn_mfma_f32_32x32x2f32(a.w, b[7], accB, 0, 0, 0);
            }
            __syncthreads();
            LAS float* part = hrow + wave * 2048 + hh * 256 + r32;
#pragma unroll
            for (int r = 0; r < 16; ++r) { part[((r >> 2) * 8 + (r & 3)) * 64] = accA[r]; part[((r >> 2) * 8 + (r & 3)) * 64 + 32] = accB[r]; }
            __syncthreads();
            const LAS float* pr = hrow + (wave * 4) * 64 + lane;
            acc0 = 0.f; acc1 = 0.f; acc2 = 0.f; acc3 = 0.f;
#pragma unroll
            for (int q = 0; q < 8; ++q) { acc0 += pr[q * 2048]; acc1 += pr[q * 2048 + 64]; acc2 += pr[q * 2048 + 128]; acc3 += pr[q * 2048 + 192]; }
        }
        int myrank[4], mypos[4]; float myw[4];
#pragma unroll
        for (int i = 0; i < 4; ++i) {
            const float logit = (i == 0) ? acc0 : (i == 1) ? acc1 : (i == 2) ? acc2 : acc3;
            const float score = 1.f / (1.f + expf(-logit));
            const float sv = score + rb;
            float m1 = sv;
            m1 = fmaxf(m1, __shfl_xor(m1, 1)); m1 = fmaxf(m1, __shfl_xor(m1, 2)); m1 = fmaxf(m1, __shfl_xor(m1, 4));
            int am = (sv == m1) ? (lane & 7) : 8;
            am = min(am, __shfl_xor(am, 1)); am = min(am, __shfl_xor(am, 2)); am = min(am, __shfl_xor(am, 4));
            float m2 = ((lane & 7) == am) ? -INFINITY : sv;
            m2 = fmaxf(m2, __shfl_xor(m2, 1)); m2 = fmaxf(m2, __shfl_xor(m2, 2)); m2 = fmaxf(m2, __shfl_xor(m2, 4));
            const float gs = m1 + m2;
            const int gi = lane >> 3; int grank = 0;
#pragma unroll
            for (int gj = 0; gj < 8; ++gj) { const float o = __shfl(gs, gj * 8); grank += (o > gs || (o == gs && gj < gi)) ? 1 : 0; }
            const float msk = (grank < 4) ? sv : -1e30f;
            int rank = 0;
#pragma unroll 8
            for (int e = 0; e < 64; ++e) { const float o = __shfl(msk, e); rank += (o > msk || (o == msk && e < lane)) ? 1 : 0; }
            const bool selb = rank < 8;
            const float tot = wsum(selb ? score : 0.f);
            myrank[i] = selb ? rank : -1; myw[i] = score / tot * 2.5f;
            mypos[i] = (selb && !DRY) ? atomicAdd((int*)(cntl + lane), 1) : 0;
        }
        __syncthreads();
        if (tid < 64) basel[tid] = (cntl[tid] > 0 && !DRY) ? atomicAdd(p.gcnt + layer * 64 + tid, cntl[tid]) : 0;
        __syncthreads();
#pragma unroll
        for (int i = 0; i < 4; ++i) if (myrank[i] >= 0 && !DRY) {
            const int t = batch * 32 + wave * 4 + i, slot = t * 8 + myrank[i];
            p.list[(size_t)lane * 16384 + basel[lane] + mypos[i]] = slot;
            p.ew[slot] = myw[i];
        }
        __syncthreads();
    }
}

struct MoeSched {
    const char* A; const char* Bt; const int* list; const LAS int* ustart; const LAS int* hbase; const LAS int* cnt;
    int K, NP, G, c; bool gather; int nexp;
    __device__ __forceinline__ static void tables(LAS int* ustart, LAS int* hbase, LAS int* cnt, const int* gcnt, int NP) {
        const int tid = threadIdx.x;
        if (tid == 0) {
            int us = 0, hb = 0;
            for (int e = 0; e < 65; ++e) { const int c = (e < 64) ? gcnt[e] : S_; const int nrb = (c + 255) >> 8; cnt[e] = c; ustart[e] = us; hbase[e] = hb; us += nrb * NP; hb += nrb * 256; }
            ustart[65] = us; hbase[65] = hb;
        }
        __syncthreads();
    }
    __device__ __forceinline__ bool next(int i, pg::Unit& u, int R0, int C0) const {
        const int L = i * G + c; if (L >= ustart[nexp]) return false;
        const int lane = threadIdx.x & 63;
        const unsigned long long bal = __ballot(lane < 65 && ustart[lane] <= L);
        int e = __popcll(bal) - 1; if (ustart[64] <= L) e = 64;
        const int r = L - ustart[e], rb = r / NP, pn = r % NP;
        u.pm = (hbase[e] >> 8) + rb; u.pn = pn; u.aux = e | (rb << 8);
        u.B = Bt + ((size_t)e * NP + pn) * 256 * K * 2;
        if (gather) {
            u.A = A; const int ce = cnt[e];
#pragma unroll
            for (int q = 0; q < 4; ++q) { const int pos = rb * 256 + R0 + 64 * q; int tok = 0; if (pos < ce) tok = (e < 64) ? (list[(size_t)e * 16384 + pos] >> 3) : pos; u.ra[q] = (unsigned)(tok * K + C0) * 2u; }
        } else {
            u.A = A + (size_t)u.pm * 256 * K * 2;
#pragma unroll
            for (int q = 0; q < 4; ++q) u.ra[q] = (unsigned)((R0 + 64 * q) * K + C0) * 2u;
        }
        return true;
    }
};
struct EpiGateUp {
    static constexpr bool PERM = true;
    bf16_t* HID;
    __device__ __forceinline__ void operator()(const f32x4 (&acc)[2][2][4][2], const pg::Unit& u, int wid, int wr, int wc, int fr_, int fq_) const {
        int fr = fr_, fq = fq_; asm volatile("" : "+v"(fr), "+v"(fq));
        const int col0 = u.pn * 128 + wc * 32 + 8 * fq;
#pragma unroll
        for (int ai = 0; ai < 2; ++ai)
#pragma unroll
            for (int m = 0; m < 4; ++m) {
                bf16_t* rp = HID + (size_t)(u.pm * 256 + ai * 128 + wr * 64 + m * 16 + fr) * 256 + col0;
                float h[8];
#pragma unroll
                for (int n = 0; n < 2; ++n) {
                    const f32x4 g = acc[ai][0][m][n], up = acc[ai][1][m][n];
                    h[4 * n] = g.x / (1.f + __expf(-g.x)) * up.x; h[4 * n + 1] = g.y / (1.f + __expf(-g.y)) * up.y; h[4 * n + 2] = g.z / (1.f + __expf(-g.z)) * up.z; h[4 * n + 3] = g.w / (1.f + __expf(-g.w)) * up.w;
                }
                u32x4 w; w.x = cvtpk(h[0], h[1]); w.y = cvtpk(h[2], h[3]); w.z = cvtpk(h[4], h[5]); w.w = cvtpk(h[6], h[7]); *(u32x4*)rp = w;
            }
    }
};
struct EpiDown {
    static constexpr bool PERM = true;
    bf16_t* YBUF; const int* list; const float* ew; const LAS int* cnt;
    __device__ __forceinline__ void operator()(const f32x4 (&acc)[2][2][4][2], const pg::Unit& u, int wid, int wr, int wc, int fr_, int fq_) const {
        int fr = fr_, fq = fq_; asm volatile("" : "+v"(fr), "+v"(fq));
        const int e = u.aux & 0xff, rb = u.aux >> 8, ce = cnt[e];
        const unsigned colb = (unsigned)(u.pn * 256 + wc * 32 + 8 * fq);
        const int* le = list + (size_t)e * 16384 + rb * 256 + wr * 64 + fr;
        const int pos0 = rb * 256 + wr * 64 + fr;
        int slot[8]; float w[8];
#pragma unroll
        for (int i = 0; i < 8; ++i) { const int pr = (i >> 2) * 128 + (i & 3) * 16; slot[i] = (pos0 + pr < ce) ? le[pr] : -1; }
#pragma unroll
        for (int i = 0; i < 8; ++i) w[i] = (slot[i] >= 0) ? ew[slot[i]] : 0.f;
#pragma unroll
        for (int ai = 0; ai < 2; ++ai)
#pragma unroll
            for (int m = 0; m < 4; ++m) {
                const int i = ai * 4 + m;
                if (slot[i] >= 0) {
                    char* rp = (char*)YBUF + ((unsigned)slot[i] * 1024u + colb);
                    const float ws = w[i] * 16.f;
#pragma unroll
                    for (int bj = 0; bj < 2; ++bj) { const f32x4 a = acc[ai][bj][m][0] * ws, b = acc[ai][bj][m][1] * ws;
                        u32x2 o; o.x = nsa::pk4_fp8(a.x, a.y, a.z, a.w); o.y = nsa::pk4_fp8(b.x, b.y, b.z, b.w); *(u32x2*)(rp + bj * 128) = o; }
                }
            }
    }
};
__device__ __forceinline__ void phase_moe_gemm1(const MKP& p, LAS unsigned char* lds, int layer) {
    LAS int* tb = (LAS int*)(lds + LDS_X);
    MoeSched::tables(tb, tb + 66, tb + 132, p.gcnt + layer * 64, 2);
    const int G = gridDim.x, bx = blockIdx.x, vcu = (G % 8 == 0) ? (bx % 8) * (G / 8) + bx / 8 : bx;
    MoeSched S{(const char*)p.XN, (const char*)p.Wgu, p.list, tb, tb + 66, tb + 132, 1024, 2, G, vcu, true, 65};
    EpiGateUp E{p.HID};
    pg::gemm_run(lds, 1024, S, E);
}
__device__ __forceinline__ void phase_moe_gemm2(const MKP& p, LAS unsigned char* lds, int layer, int which = 3) {
    LAS int* tb = (LAS int*)(lds + LDS_X);
    MoeSched::tables(tb, tb + 66, tb + 132, p.gcnt + layer * 64, 4);
    const int G = gridDim.x, bx = blockIdx.x, vcu = (G % 8 == 0) ? (bx % 8) * (G / 8) + bx / 8 : bx;
    if (which & 1) { MoeSched S{(const char*)p.HID, (const char*)p.Wd, p.list, tb, tb + 66, tb + 132, 256, 4, G, vcu, false, 64};
      EpiDown E{p.YBUF, p.list, p.ew, tb + 132};
      pg::gemm_run(lds, 256, S, E); }
    if (which & 2) {
      pg::DenseSched S; S.init(p.HID + (size_t)tb[66 + 64] * 256, p.Wd + (size_t)64 * 1024 * 256, S_, 1024, 256, G, bx);
      EpiPlain E{p.YS, 1024};
      pg::gemm_run(lds, 256, S, E); }
}
__device__ __forceinline__ void phase_moe_combine(const MKP& p, int layer) {
    int tid_ = threadIdx.x; asm volatile("" : "+v"(tid_));
    const int tid = tid_, lane = tid & 63, wave = tid >> 6;
    const int gwv = blockIdx.x * 8 + wave, NGW = gridDim.x * 8;
    const float* g2 = p.mod + layer * 6144 + 5 * 1024;
    for (int t = gwv; t < S_; t += NGW) {
        f32x4* xr = (f32x4*)(p.out + (size_t)t * D_) + lane;
#pragma unroll
        for (int j = 0; j < 4; ++j) {
            f32x4 s = (f32x4){0.f, 0.f, 0.f, 0.f};
#pragma unroll
            for (int k = 0; k < 8; ++k) {
                const int w = *((const int*)((const char*)p.YBUF + ((size_t)t * 8 + k) * 1024) + lane + 64 * j);
                const f32x2 lo = __builtin_amdgcn_cvt_pk_f32_fp8(w, false), hi = __builtin_amdgcn_cvt_pk_f32_fp8(w, true);
                s.x += lo.x; s.y += lo.y; s.z += hi.x; s.w += hi.y;
            }
            { const u32x2 sw = *((const u32x2*)(p.YS + (size_t)t * 1024) + lane + 64 * j);
              s.x += 16.f * __uint_as_float(sw.x << 16); s.y += 16.f * __uint_as_float(sw.x & 0xffff0000u); s.z += 16.f * __uint_as_float(sw.y << 16); s.w += 16.f * __uint_as_float(sw.y & 0xffff0000u); }
            const f32x4 g = *(const f32x4*)(g2 + 256 * j + 4 * lane) * (1.f / 16.f);
            xr[64 * j] = xr[64 * j] + g * s;
        }
    }
}

#define XB_TMO      128
#define XB_XCNT(j)  (256  + 64 * (j))
#define XB_XSUB(j)  (1280 + 64 * (j))
#define XB_XGEN(j)  (2304 + 64 * (j))
#define XB_TOP      3328
#define XB_TOPGEN   3392
#define XCD_BAR_WORDS 3456
#define XB_SPIN_CAP (1u << 22)
__device__ __forceinline__ unsigned xb_ld(unsigned* p)              { return __hip_atomic_load(p, __ATOMIC_RELAXED, __HIP_MEMORY_SCOPE_AGENT); }
__device__ __forceinline__ unsigned xb_add(unsigned* p, unsigned v) { return __hip_atomic_fetch_add(p, v, __ATOMIC_RELAXED, __HIP_MEMORY_SCOPE_AGENT); }
__device__ __forceinline__ unsigned xb_xcc_id() { return (unsigned)__builtin_amdgcn_s_getreg((3 << 11) | 20) & 0xFu; }
#define XB_SPIN(cond, bar) do { unsigned _sp = 0; while (cond) { __builtin_amdgcn_s_sleep(1); \
    if ((++_sp & 255u) == 0u) { if (xb_ld(&(bar)[XB_TMO])) break; if (_sp > XB_SPIN_CAP) { atomicAdd(&(bar)[XB_TMO], 1u); break; } } } } while (0)
struct XcdBarrier { unsigned* bar; unsigned x; volatile LAS unsigned* st; };
__device__ __forceinline__ XcdBarrier xcd_barrier_post(unsigned* bar, volatile LAS unsigned* st) {
    XcdBarrier b; b.bar = bar; b.x = xb_xcc_id(); b.st = st;
    if (threadIdx.x == 0) (void)xb_add(&bar[XB_XCNT(b.x)], 1u);
    return b;
}
__device__ __forceinline__ void xcd_barrier_complete(unsigned* bar, unsigned x, unsigned& nloc, unsigned& nx) {
    const unsigned G = gridDim.x * gridDim.y * gridDim.z;
    unsigned sum, cnt, mine, sp = 0u;
    for (;;) {
        sum = 0u; cnt = 0u; mine = 0u;
#pragma unroll
        for (unsigned j = 0; j < 16; ++j) { const unsigned c = xb_ld(&bar[XB_XCNT(j)]); sum += c; cnt += (c > 0u) ? 1u : 0u; mine = (j == x) ? c : mine; }
        if (sum == G) break;
        __builtin_amdgcn_s_sleep(1);
        if ((++sp & 255u) == 0u) { if (xb_ld(&bar[XB_TMO])) break; if (sp > XB_SPIN_CAP) { atomicAdd(&bar[XB_TMO], 1u); break; } }
    }
    nloc = mine > 0u ? mine : 1u; nx = cnt > 0u ? cnt : 1u;
}
__device__ __forceinline__ void xcd_barrier(const XcdBarrier& b) {
    asm volatile("s_waitcnt vmcnt(0)" ::: "memory");
    __syncthreads();
    if (threadIdx.x == 0) {
        unsigned* bar = b.bar;
        __builtin_amdgcn_s_waitcnt(0);
        unsigned nloc = b.st[0], nx = b.st[1];
        if (nloc == 0u) { xcd_barrier_complete(bar, b.x, nloc, nx); b.st[0] = nloc; b.st[1] = nx; }
        const unsigned old = xb_add(&bar[XB_XSUB(b.x)], 1u);
        const unsigned gen = old / nloc;
        if (old + 1u == (gen + 1u) * nloc) {
            __builtin_amdgcn_fence(__ATOMIC_RELEASE, "agent");
            asm volatile("s_waitcnt vmcnt(0)" ::: "memory");
            const unsigned og = xb_add(&bar[XB_TOP], 1u);
            const unsigned tg = og / nx;
            if (og + 1u == (tg + 1u) * nx) xb_add(&bar[XB_TOPGEN], 1u);
            else XB_SPIN(xb_ld(&bar[XB_TOPGEN]) == tg, bar);
            __builtin_amdgcn_fence(__ATOMIC_ACQUIRE, "agent");
            xb_add(&bar[XB_XGEN(b.x)], 1u);
            asm volatile("s_waitcnt vmcnt(0)" ::: "memory");
        } else {
            XB_SPIN(xb_ld(&bar[XB_XGEN(b.x)]) == gen, bar);
            __builtin_amdgcn_fence(__ATOMIC_ACQUIRE, "agent");
            asm volatile("s_waitcnt vmcnt(0)" ::: "memory");
        }
    }
    __syncthreads();
}

__global__ void __launch_bounds__(MK_THREADS, 2) mega(MKP p) {
    extern __shared__ __attribute__((aligned(16))) unsigned char lds_raw[];
    LAS unsigned char* lds = (LAS unsigned char*)lds_raw;
    const int lo = p.ph_lo, hi = p.ph_hi;
    const bool multi = hi - lo > 1;
    volatile LAS unsigned* bst = (volatile LAS unsigned*)(lds + LDS_BARST);
    XcdBarrier bar; bar.bar = p.barw; bar.x = 0; bar.st = bst;
    if (multi) {
        if (threadIdx.x < 2) bst[threadIdx.x] = 0u;
        if (blockIdx.x == 0) for (int i = threadIdx.x; i < XCD_BAR_WORDS; i += MK_THREADS) p.barw[i] = 0u;
    }
    int nbar = 0;
    if (multi) {
        __threadfence(); cooperative_groups::this_grid().sync(); __builtin_amdgcn_fence(__ATOMIC_ACQUIRE, "agent"); bar = xcd_barrier_post(p.barw, bst); nbar = 1;
    }
#define IN(k) (lo <= (k) && (k) < hi)
#define SEAM(k) do { if (IN(k) && IN((k) + 1)) { if (nbar == 0) { __threadfence(); cooperative_groups::this_grid().sync(); __builtin_amdgcn_fence(__ATOMIC_ACQUIRE, "agent"); bar = xcd_barrier_post(p.barw, bst); } else xcd_barrier(bar); ++nbar; } } while (0)
    if (IN(0)) { phase_prologue(p, lds); phase_moe_weights(p, lds, 0); }
    SEAM(0);
    if (IN(1)) phase_norm<false>(p, lds, p.in[0], p.in[3], 0, 1, 0, true);
    SEAM(1);
    if (IN(2)) {
        pg::DenseSched S; S.init(p.XN, p.W_in0t, S_, 3072, 1024, gridDim.x, blockIdx.x);
        EpiHeads E{p.desc0, p.cosT, p.sinT, p.GATES, p.LOGF, (LAS float*)(lds + LDS_X)};
        pg::gemm_run(lds, 1024, S, E);
    }
    SEAM(2);
    if (IN(3)) phase_scan(p, lds);
    SEAM(3);
    if (IN(4)) phase_fox(p, (char*)lds_raw);
    SEAM(4);
    if (IN(5)) {
        pg::DenseSched S; S.init(p.OATT, p.W_out0t, S_, 1024, 1024, gridDim.x, blockIdx.x);
        EpiResid E{p.in[0], p.out, p.mod + 2 * 1024};
        pg::gemm_run(lds, 1024, S, E);
    }
    SEAM(5);
    if (IN(6)) phase_moe_route<false>(p, lds, 0);
    SEAM(6);
    if (IN(7)) phase_moe_gemm1(p, lds, 0);
    SEAM(7);
    if (IN(8)) phase_moe_gemm2(p, lds, 0);
    SEAM(8);
    if (IN(9)) { phase_norm<true>(p, lds, p.out, p.in[3] + 1024, 1, 1, 0, false); phase_moe_weights(p, lds, 1); }
    if (IN(9) && IN(11)) { xcd_barrier(bar); ++nbar; }
    if (IN(11)) {
        pg::DenseSched S; S.init(p.XN, p.W_in1t, S_, 768, 1024, gridDim.x, blockIdx.x);
        EpiPlain E{p.P1, 768};
        pg::gemm_run(lds, 1024, S, E);
    }
    SEAM(11);
    if (IN(12)) phase_post1a(p);
    SEAM(12);
    if (IN(13)) {
        { pg::DenseSched S; S.init(p.CQN, p.W_uqt, S_, 1536, 384, gridDim.x, blockIdx.x);
          EpiHeads E{p.desc_uq, p.cosT, p.sinT, nullptr, nullptr, (LAS float*)(lds + LDS_X)};
          pg::gemm_run(lds, 384, S, E); }
        { pg::DenseSched S; S.init(p.CKVN, p.W_ukvt, S_, 2048, 256, gridDim.x, blockIdx.x);
          EpiHeads E{p.desc_ukv, p.cosT, p.sinT, nullptr, nullptr, (LAS float*)(lds + LDS_X)};
          pg::gemm_run(lds, 256, S, E); }
    }
    SEAM(13);
    if (IN(14)) phase_mla(p, (char*)lds_raw);
    SEAM(14);
    if (IN(15)) {
        pg::DenseSched S; S.init(p.OATT, p.W_out1t, S_, 1024, 1024, gridDim.x, blockIdx.x);
        EpiResid E{p.out, p.out, p.mod + 6144 + 2 * 1024};
        pg::gemm_run(lds, 1024, S, E);
    }
    SEAM(15);
    if (IN(16)) phase_moe_route<false>(p, lds, 1);
    SEAM(16);
    if (IN(17)) phase_moe_gemm1(p, lds, 1);
    SEAM(17);
    if (IN(18)) phase_moe_gemm2(p, lds, 1);
    SEAM(18);
    if (IN(19)) phase_moe_combine(p, 1);
#undef IN
#undef SEAM
}
extern "C" void kernel_launch(void* const* d_in, const int* in_sizes, int n_in, void* d_out, int out_size, void* d_ws, size_t ws_size, hipStream_t stream) {
    static int grid = 0;
    if (!grid) {
        int dev = 0, cus = 0, per_cu = 0;
        (void)hipGetDevice(&dev); (void)hipDeviceGetAttribute(&cus, hipDeviceAttributeMultiprocessorCount, dev);
        (void)hipFuncSetAttribute((const void*)mega, hipFuncAttributeMaxDynamicSharedMemorySize, LDS_TOTAL);
        (void)hipOccupancyMaxActiveBlocksPerMultiprocessor(&per_cu, (const void*)mega, MK_THREADS, LDS_TOTAL);
        (void)hipGetLastError();
        grid = (cus > 0 && per_cu >= 1) ? cus : -1;
    }
    if (grid < 0) return;
    constexpr size_t MiB = 1u << 20;
    if (ws_size < 528 * MiB || n_in != 34) return;
    char* wsb = (char*)d_ws;
    float* ws = (float*)d_ws;
    size_t o = 0;
    MKP p{};
    for (int i = 0; i < 34; ++i) p.in[i] = (const float*)d_in[i];
    p.out = (float*)d_out; p.pos = (const int*)d_in[2];
    p.mod = ws + o; o += 2 * 6144;
    p.cosT = ws + o; o += (size_t)S_ * 48;
    p.sinT = ws + o; o += (size_t)S_ * 48;
    p.modpart = ws + o; o += 8 * 12288;
    p.desc0 = (BlkDesc*)(ws + o); o += 96 * 8;
    p.desc_uq = (BlkDesc*)(ws + o); o += 48 * 8;
    p.desc_ukv = (BlkDesc*)(ws + o); o += 64 * 8;
    p.CUMB = ws + o; o += (size_t)8 * S_;
    p.gcnt = (int*)(ws + o); o += 128;
    p.CBIAS = ws + o; o += 128;
    p.barw = (unsigned*)(ws + o); o += 4096;
    p.ew = ws + o; o += (size_t)S_ * 8;
    p.list = (int*)(ws + o); o += (size_t)64 * 16384;
    p.WcT = (bf16_t*)(ws + o); o += (size_t)2 * 64 * 2048 / 2;
    p.KCMP = (bf16_t*)(ws + o); o += (size_t)2 * 1024 * 64 / 2;
    p.VCT = (bf16_t*)(ws + o); o += (size_t)2 * 64 * 1024 / 2;
    if (o * 4 > 15 * MiB) return;
    p.XN = (bf16_t*)(wsb + 15 * MiB); p.OATT = (bf16_t*)(wsb + 47 * MiB);
    char* big = wsb + 79 * MiB;
    {   bf16_t* b = (bf16_t*)big;
        p.QN = b; b += (size_t)S_ * 512; p.KV6 = b; b += (size_t)12 * S_ * 64; p.FQ = b; b += (size_t)S_ * 512; p.FK = b; b += (size_t)S_ * 512; p.FV = b; b += (size_t)S_ * 512;
        p.GATES = (float*)b; p.LOGF = p.GATES + (size_t)S_ * 24; }
    p.KSLF = (bf16_t*)(big + 92 * MiB); p.VSLF = (bf16_t*)(big + 96 * MiB); p.OCMP = (bf16_t*)(big + 100 * MiB); p.OWIN = (bf16_t*)(big + 116 * MiB);
    {   bf16_t* b = (bf16_t*)(big + 96 * MiB);
        p.P1 = b; b += (size_t)S_ * 768; p.CQN = b; b += (size_t)S_ * 384; p.CKVN = b; b += (size_t)S_ * 256;
        p.Q96 = b; b += (size_t)16 * S_ * 96; p.K96 = b; b += (size_t)16 * S_ * 96; p.V1 = b; b += (size_t)16 * S_ * 64; }
    p.YBUF = (bf16_t*)big; p.YS = (bf16_t*)(big + 128 * MiB); p.HID = (bf16_t*)(big + 256 * MiB);
    p.Wgu = (bf16_t*)(wsb + 415 * MiB); p.Wd = p.Wgu + (size_t)65 * 512 * 1024;
    {   bf16_t* b = (bf16_t*)(wsb + 513 * MiB);
        p.W_in0t = b; b += (size_t)3072 * 1024; p.W_out0t = b; b += (size_t)1024 * 1024; p.W_in1t = b; b += (size_t)768 * 1024;
        p.W_uqt = b; b += (size_t)1536 * 384; p.W_ukvt = b; b += (size_t)2048 * 256; p.W_out1t = b; b += (size_t)1024 * 1024; }
    p.ph_lo = 0; p.ph_hi = 20;
    void* args[] = {&p};
    (void)hipLaunchCooperativeKernel((const void*)mega, dim3(grid), dim3(MK_THREADS), args, LDS_TOTAL, stream);
}
```

```cpp
#include <hip/hip_runtime.h>
#include <hip/hip_cooperative_groups.h>
#include <stdint.h>

#define S_ 16384
#define D_ 1024
#define HYIN 2848
#define NEXP 64
#define EPSF 1e-6f

__device__ __forceinline__ float wsum(float v) {
#pragma unroll
    for (int o = 32; o > 0; o >>= 1) v += __shfl_xor(v, o);
    return v;
}
__device__ __forceinline__ float sigmf(float x) { return 1.f / (1.f + expf(-x)); }
__device__ __forceinline__ float logsigmf(float x) { return fminf(x, 0.f) - log1pf(expf(-fabsf(x))); }
#define LAS __attribute__((address_space(3)))
#define GAS __attribute__((address_space(1)))
typedef unsigned short bf16_t;
typedef short bf16x8 __attribute__((ext_vector_type(8)));
typedef float f32x4 __attribute__((ext_vector_type(4)));
typedef float f32x2 __attribute__((ext_vector_type(2)));
typedef unsigned u32x4 __attribute__((ext_vector_type(4)));
typedef unsigned u32x2 __attribute__((ext_vector_type(2)));
typedef __bf16 bf16x2_t __attribute__((ext_vector_type(2)));

__device__ __forceinline__ unsigned cvtpk(float lo, float hi) { f32x2 v = {lo, hi}; bf16x2_t b = __builtin_convertvector(v, bf16x2_t); return __builtin_bit_cast(unsigned, b); }
__device__ __forceinline__ float bf2f(bf16_t v) { return __uint_as_float(((unsigned)v) << 16); }
__device__ __forceinline__ bf16_t f2bf(float f) { return (bf16_t)(cvtpk(f, 0.f) & 0xffffu); }

namespace pg {
constexpr int BM = 256, BK = 64, HALF = 128, HTB = HALF * BK * 2, STAGE_BYTES = 8 * HTB;
__device__ __forceinline__ int lds_byte(int r, int c) { const int st = (r >> 4) * 2 + (c >> 5), rr = r & 15, cc = c & 31, ob = rr * 64 + cc * 2; return st * 1024 + (ob ^ (((ob >> 9) & 1) << 5)); }
__device__ __forceinline__ int perm32(int rho) { const int n = rho >> 4, i = rho & 15; return 8 * (i >> 2) + 4 * n + (i & 3); }
__device__ __forceinline__ void stage_rc(int b, int& R, int& C) { const int st = b / 1024, sb = b % 1024, swz = sb ^ (((sb >> 9) & 1) << 5); R = (st >> 1) * 16 + swz / 64; C = (st & 1) * 32 + (swz % 64) / 2; }

struct Unit { int pm, pn, aux; const char* A; const char* B; unsigned ra[4]; };

template <class Epi, class Sched>
__device__ __forceinline__ void gemm_run(LAS unsigned char* lds, const int K, const Sched& S, const Epi& E) {
    int tid_ = threadIdx.x; asm volatile("" : "+v"(tid_));
    const int tid = tid_, wid = __builtin_amdgcn_readfirstlane(tid >> 6), lane = tid & 63, wr = wid >> 2, wc = wid & 3, fr = lane & 15, fq = lane >> 4;
    int nt_ = K / BK; asm volatile("" : "+s"(nt_)); const int nt = nt_;
    int R0, C0; stage_rc(tid * 16, R0, C0);
    unsigned voffB[2];
#pragma unroll
    for (int i = 0; i < 2; ++i) { const int Rb = Epi::PERM ? ((R0 & ~31) + perm32(R0 & 31)) : R0; voffB[i] = (unsigned)((Rb + 64 * i) * K + C0) * 2u; }
    const size_t kstep = (size_t)(BK * 2);
    const size_t hstep = (size_t)HALF * K * 2;
    const unsigned ldsw = (unsigned)wid * 1024u;
    const int aoff = lds_byte(wr * 64 + fr, fq * 8), boff = lds_byte(wc * 32 + fr, fq * 8);
#define PG_SA(b, h) (((b) * 2 + (h)) * HTB)
#define PG_SB(b, h) ((4 + (b) * 2 + (h)) * HTB)
#define PG_STAGE2(bufoff, gbase, v0, v1) do { \
        __builtin_amdgcn_global_load_lds((const unsigned*)((const char*)(gbase) + (v0)), (LAS unsigned*)(lds + (bufoff) + ldsw), 16, 0, 0); \
        __builtin_amdgcn_global_load_lds((const unsigned*)((const char*)(gbase) + (v1)), (LAS unsigned*)(lds + (bufoff) + ldsw + 8192), 16, 0, 0); } while (0)
#define PG_STAGEB(bufoff, gbase) PG_STAGE2(bufoff, gbase, voffB[0], voffB[1])
#define PG_LDA(dst, b, h) do { _Pragma("unroll") for (int m = 0; m < 4; ++m) _Pragma("unroll") for (int k = 0; k < 2; ++k) dst[m][k] = *(const LAS bf16x8*)(lds + PG_SA(b, h) + aoff + m * 2048 + k * 1024); } while (0)
#define PG_LDB(dst, b, h) do { _Pragma("unroll") for (int n = 0; n < 2; ++n) _Pragma("unroll") for (int k = 0; k < 2; ++k) dst[n][k] = *(const LAS bf16x8*)(lds + PG_SB(b, h) + boff + n * 2048 + k * 1024); } while (0)
#define PG_MMA(ai, bj, At, Bt) do { __builtin_amdgcn_s_setprio(1); _Pragma("unroll") for (int m = 0; m < 4; ++m) _Pragma("unroll") for (int n = 0; n < 2; ++n) _Pragma("unroll") for (int k = 0; k < 2; ++k) \
        acc[ai][bj][m][n] = __builtin_amdgcn_mfma_f32_16x16x32_bf16(Bt[n][k], At[m][k], acc[ai][bj][m][n], 0, 0, 0); __builtin_amdgcn_s_setprio(0); } while (0)
#define PG_WAIT_V(n) asm volatile("s_waitcnt vmcnt(" #n ")" ::: "memory")
#define PG_WAIT_L(n) asm volatile("s_waitcnt lgkmcnt(" #n ")" ::: "memory")
#define PG_BAR __builtin_amdgcn_s_barrier()
#define PG_SCHED __builtin_amdgcn_sched_barrier(0)
    Unit cur, nxt; int ui = 0;
    if (!S.next(0, cur, R0, C0)) return;
    f32x4 acc[2][2][4][2];
#pragma unroll
    for (int a = 0; a < 2; ++a)
#pragma unroll
        for (int b = 0; b < 2; ++b)
#pragma unroll
            for (int m = 0; m < 4; ++m)
#pragma unroll
                for (int n = 0; n < 2; ++n) acc[a][b][m][n] = (f32x4){0.f, 0.f, 0.f, 0.f};
    bf16x8 At[4][2], B0[2][2], B1[2][2];
    const char* cA = cur.A; const char* cB = cur.B;
    PG_STAGEB(PG_SB(0, 0), cB); PG_STAGEB(PG_SB(0, 1), cB + hstep); PG_STAGE2(PG_SA(0, 0), cA, cur.ra[0], cur.ra[1]); PG_STAGE2(PG_SA(0, 1), cA, cur.ra[2], cur.ra[3]);
    if (wr == 1) PG_BAR;
    PG_WAIT_V(2); PG_BAR;
    PG_STAGEB(PG_SB(1, 0), cB + kstep); PG_STAGE2(PG_SA(1, 0), cA + kstep, cur.ra[0], cur.ra[1]); PG_STAGEB(PG_SB(1, 1), cB + hstep + kstep);
    PG_WAIT_V(6); PG_BAR;
    for (;;) {
        const bool has_next = S.next(ui + 1, nxt, R0, C0);
        if (!has_next) nxt = cur;
        const char* nA = nxt.A; const char* nB = nxt.B;
        if constexpr (Epi::PRE) E.pre(cur, ui, wid, lane);
#pragma unroll 1
        for (int t = 0; t < nt; t += 2) {
            const bool last = (t == nt - 2);
            const char* a1 = cA + (size_t)(t + 1) * kstep;
            const char* a2 = last ? nA : cA + (size_t)(t + 2) * kstep; const char* b2 = last ? nB : cB + (size_t)(t + 2) * kstep;
            const char* a3 = a2 + kstep; const char* b3 = b2 + kstep;
            const unsigned r0 = last ? nxt.ra[0] : cur.ra[0], r1 = last ? nxt.ra[1] : cur.ra[1], r2 = last ? nxt.ra[2] : cur.ra[2], r3 = last ? nxt.ra[3] : cur.ra[3];
            PG_LDB(B0, 0, 0); PG_LDB(B1, 0, 1); PG_SCHED; PG_LDA(At, 0, 0); PG_STAGE2(PG_SA(1, 1), a1, cur.ra[2], cur.ra[3]);
            PG_WAIT_V(8); PG_WAIT_L(0); PG_BAR; PG_MMA(0, 0, At, B0); PG_MMA(0, 1, At, B1); PG_BAR; PG_SCHED;
            PG_LDA(At, 0, 1); PG_STAGEB(PG_SB(0, 0), b2); PG_STAGEB(PG_SB(0, 1), b2 + hstep); PG_STAGE2(PG_SA(0, 0), a2, r0, r1);
            PG_WAIT_V(8); PG_WAIT_L(0); PG_BAR; PG_MMA(1, 0, At, B0); PG_MMA(1, 1, At, B1); PG_BAR; PG_SCHED;
            PG_LDB(B0, 1, 0); PG_LDB(B1, 1, 1); PG_SCHED; PG_LDA(At, 1, 0); PG_STAGE2(PG_SA(0, 1), a2, r2, r3);
            PG_WAIT_V(8); PG_WAIT_L(0); PG_BAR; PG_MMA(0, 0, At, B0); PG_MMA(0, 1, At, B1); PG_BAR; PG_SCHED;
            PG_LDA(At, 1, 1); PG_STAGEB(PG_SB(1, 0), b3); PG_STAGEB(PG_SB(1, 1), b3 + hstep); PG_STAGE2(PG_SA(1, 0), a3, r0, r1);
            PG_WAIT_V(8); PG_WAIT_L(0); PG_BAR; PG_MMA(1, 0, At, B0); PG_MMA(1, 1, At, B1); PG_BAR; PG_SCHED;
        }
        if (wr == 0) PG_BAR;
        if constexpr (Epi::PRE) E(acc, cur, wid, wr, wc, fr, fq, ui); else E(acc, cur, wid, wr, wc, fr, fq);
        if (!has_next) break;
#pragma unroll
        for (int a = 0; a < 2; ++a)
#pragma unroll
            for (int b = 0; b < 2; ++b)
#pragma unroll
                for (int m = 0; m < 4; ++m)
#pragma unroll
                    for (int n = 0; n < 2; ++n) acc[a][b][m][n] = (f32x4){0.f, 0.f, 0.f, 0.f};
        cur = nxt; cA = nA; cB = nB; ++ui;
        if (wr == 1) PG_BAR;
    }
    PG_WAIT_V(0);
    PG_BAR;
#undef PG_SA
#undef PG_SB
#undef PG_STAGE2
#undef PG_STAGEB
#undef PG_LDA
#undef PG_LDB
#undef PG_MMA
}

struct DenseSched {
    const char* A; const char* Bt; int K, nM, nN, nwg, G, c;
    __device__ __forceinline__ void init(const void* A_, const void* Bt_, int M, int N, int K_, int G_, int c_) { A = (const char*)A_; Bt = (const char*)Bt_; K = K_; nM = M / BM; nN = N / BM; nwg = nM * nN; G = G_; c = c_; }
    __device__ __forceinline__ bool next(int i, Unit& u, int R0, int C0) const {
        const long L = (long)i * G + c; if (L >= nwg) return false;
        int wgid = (int)L; { const int q = nwg / 8, r = nwg % 8, xcd = wgid % 8, off = wgid / 8; wgid = (xcd < r ? xcd * (q + 1) : r * (q + 1) + (xcd - r) * q) + off; }
        const int nig = 8 * nN, gid = wgid / nig, fm = gid * 8, gsz = (nM - fm) < 8 ? (nM - fm) : 8;
        u.pm = fm + ((wgid % nig) % gsz); u.pn = (wgid % nig) / gsz; u.aux = 0;
        u.A = A + (size_t)u.pm * BM * K * 2; u.B = Bt + (size_t)u.pn * BM * K * 2;
#pragma unroll
        for (int q = 0; q < 4; ++q) u.ra[q] = (unsigned)((R0 + 64 * q) * K + C0) * 2u;
        return true;
    }
};
}
namespace att {
using s16x4 = __attribute__((ext_vector_type(4))) short;
using f32x16 = __attribute__((ext_vector_type(16))) float;
typedef __attribute__((address_space(3))) const char* lds_cptr;
typedef short v4i16_t __attribute__((ext_vector_type(4)));
constexpr int NSLOT = 3, VSLOT = 8192;
template <int DQ> struct Geo {
    static constexpr int NK = DQ / 16;
    static constexpr int KSLOT = (DQ == 64) ? 8192 : 16384;
    static constexpr int QWAVE = (DQ == 64) ? 4096 : 6144;
    static constexpr int LDS_K = 0, LDS_V = NSLOT * KSLOT, LDS_WS = LDS_V + NSLOT * VSLOT, LDS_OST = LDS_WS + 8 * 64 * 4, LDS_BYTES = LDS_OST + 8 * QWAVE;
};
constexpr int LDS_BIAS = Geo<64>::LDS_BYTES;
#define ASBAR() __builtin_amdgcn_sched_barrier(0)
#define AWAIT_BAR(N) asm volatile("s_waitcnt vmcnt(" #N ") lgkmcnt(0)\n\ts_barrier" ::: "memory")
__device__ __forceinline__ int crow(int r, int hi) { return (r & 3) + 8 * (r >> 2) + 4 * hi; }
__device__ __forceinline__ void glds16(const void* gsrc, unsigned lds_dst) { unsigned keep;
    asm volatile("s_mov_b32 %0, m0\n\ts_mov_b32 m0, %2\n\ts_nop 0\n\tglobal_load_lds_dwordx4 %1, off\n\ts_mov_b32 m0, %0" : "=&s"(keep) : "v"(gsrc), "s"(lds_dst) : "memory"); }
__device__ __forceinline__ float fadd_s(float a, float b) { float r; asm("v_add_f32_e32 %0, %1, %2" : "=v"(r) : "v"(a), "v"(b)); return r; }
__device__ __forceinline__ float fsub_s(float a, float b) { float r; asm("v_sub_f32_e32 %0, %1, %2" : "=v"(r) : "v"(a), "v"(b)); return r; }
__device__ __forceinline__ float max3f(float a, float b, float c) { float r; asm("v_max3_f32 %0, %1, %2, %3" : "=v"(r) : "v"(a), "v"(b), "v"(c)); return r; }
__device__ __forceinline__ float max2f(float a, float b) { float r; asm("v_max_f32_e32 %0, %1, %2" : "=v"(r) : "v"(a), "v"(b)); return r; }
__device__ __forceinline__ s16x4 vtr(lds_cptr p) { return __builtin_bit_cast(s16x4, __builtin_amdgcn_ds_read_tr16_b64_v4i16((__attribute__((address_space(3))) v4i16_t*)p)); }
template <int NK> __device__ __forceinline__ void kloadall(bf16x8* kf, lds_cptr kp) {
#pragma unroll
    for (int j = 0; j < NK; ++j) { kf[2 * j] = *(const LAS bf16x8*)(kp + j * 2048); kf[2 * j + 1] = *(const LAS bf16x8*)(kp + j * 2048 + 512); } }
__device__ __forceinline__ void kload2(bf16x8* kf, lds_cptr kp, int j) { kf[2 * j] = *(const LAS bf16x8*)(kp + j * 2048); kf[2 * j + 1] = *(const LAS bf16x8*)(kp + j * 2048 + 512); }
__device__ __forceinline__ void cmask(f32x16& p0, f32x16& p1, int koff, int qtok, int hi) {
    const int x = qtok - koff - 4 * hi;
#pragma unroll
    for (int r = 0; r < 16; ++r) { const int c = (r & 3) + 8 * (r >> 2); if (c > x) p0[r] = -INFINITY; if (c + 32 > x) p1[r] = -INFINITY; }
}
__device__ __forceinline__ void wmask(f32x16& p0, f32x16& p1, int thr, int hi) {
    const int y = thr - 4 * hi;
#pragma unroll
    for (int r = 0; r < 16; ++r) { const int c = (r & 3) + 8 * (r >> 2); if (c < y) p0[r] = -INFINITY; if (c + 32 < y) p1[r] = -INFINITY; }
}
__device__ __forceinline__ float rowmax(const f32x16& p0, const f32x16& p1) {
    float a = max3f(p0[0], p0[1], p1[0]), b = max3f(p0[2], p0[3], p1[1]); a = max3f(a, p1[2], p1[3]);
#pragma unroll
    for (int r = 4; r < 16; r += 4) { a = max3f(a, p0[r], p0[r + 1]); b = max3f(b, p0[r + 2], p0[r + 3]); a = max3f(a, p1[r], p1[r + 1]); b = max3f(b, p1[r + 2], p1[r + 3]); }
    const float m = max2f(a, b);
    auto rr = __builtin_amdgcn_permlane32_swap(__float_as_uint(m), __float_as_uint(m), false, false);
    return max2f(__uint_as_float(rr[0]), __uint_as_float(rr[1]));
}

enum { MODE_CAUSAL = 0, MODE_FOX = 1, MODE_WIN = 2 };
struct UnitArgs {
    const bf16_t* qrow;
    const bf16_t* K; const bf16_t* V; int kvpitch, vpitch;
    bf16_t* obase; int opitch;
    int qtok;
    int abase;
    int nsteps;
    const LAS float* bias;
};

template <int NB> __device__ __forceinline__ int seq(int i, int abase) { return (i < NB) ? abase + i : abase + NB - 1 - i; }

template <int MODE, bool GQA4, int THRL, int DQ, bool TM = false>
__device__ __forceinline__ void attn_unit(const UnitArgs& A, char* shm) {
    constexpr int NB = GQA4 ? 1 : 4;
    typedef Geo<DQ> G; constexpr int NK = G::NK, KSLOT = G::KSLOT, LDS_K = G::LDS_K, LDS_V = G::LDS_V, LDS_WS = G::LDS_WS, LDS_OST = G::LDS_OST, QWAVE = G::QWAVE;
    constexpr bool USE_NEGM = (MODE != MODE_FOX);
    int tid_ = threadIdx.x; asm volatile("" : "+v"(tid_));
    const int tid = tid_, lane = tid & 63, r32 = lane & 31, hi = lane >> 5; const int wid = __builtin_amdgcn_readfirstlane(tid >> 6);
    const unsigned lds0 = (unsigned)(uintptr_t)shm;
    float* wsf = (float*)(shm + LDS_WS) + wid * 64;
    const int NT = A.nsteps, abase = A.abase; const long kvp = A.kvpitch, vvp = A.vpitch;
    const bf16_t* ksrc = TM ? A.K + wid * 512 + lane * 8 : A.K + (long)lane * kvp + wid * 8;
    const bf16_t* ksrc2 = TM ? A.K + (8 + (wid & 3)) * 512 + lane * 8 : A.K + (long)lane * kvp + (8 + (wid & 3)) * 8;
    const bf16_t* vsrc = TM ? A.V + wid * 512 + lane * 8 : A.V + (long)(16 * (wid & 3) + (lane >> 2)) * vvp + (wid >> 2) * 32 + (lane & 3) * 8;
    const long kts = TM ? (long)(DQ / 8) * 512 : 64 * kvp, vts = TM ? 4096 : 64 * vvp;
    const unsigned kdst = lds0 + LDS_K + wid * 1024, vdst = lds0 + LDS_V + wid * 1024, kdst2 = lds0 + LDS_K + (8 + wid) * 1024;
#define TILE_OF(t) ({ int a_ = seq<NB>((t), abase); a_ < 0 ? 0 : a_; })
#define DMA_K(t, slot) do { const long to_ = (long)TILE_OF(t) * kts; glds16(ksrc + to_, (unsigned)__builtin_amdgcn_readfirstlane(kdst + (slot) * KSLOT)); \
        if (DQ == 96) glds16(ksrc2 + to_, (unsigned)__builtin_amdgcn_readfirstlane(kdst2 + (slot) * KSLOT)); } while (0)
#define DMA_V(t, slot) glds16(vsrc + (long)TILE_OF(t) * vts, (unsigned)__builtin_amdgcn_readfirstlane(vdst + (slot) * VSLOT))
    const lds_cptr shm3 = (lds_cptr)shm; const lds_cptr kp0 = shm3 + LDS_K + hi * 1024 + r32 * 16;
    const lds_cptr vp0 = shm3 + LDS_V + ((lane >> 4) & 1) * 32 + (lane & 3) * 8 + (4 * hi + ((lane & 15) >> 2)) * 64;
    const int vb0 = (int)(lds0 + LDS_V) + ((lane >> 4) & 1) * 32 + (lane & 3) * 8 + (4 * hi + ((lane & 15) >> 2)) * 64;
    DMA_K(0, 0); DMA_V(0, 0); DMA_K(1, 1);
    bf16x8 qr[NK];
#pragma unroll
    for (int d0 = 0; d0 < NK; ++d0) qr[d0] = *reinterpret_cast<const bf16x8*>(A.qrow + d0 * 16 + hi * 8);
    const lds_cptr qlp = shm3 + LDS_OST + wid * QWAVE + hi * 512 + r32 * 16;
    if (DQ == 96) {
#pragma unroll
        for (int d0 = 0; d0 < NK; ++d0) *(LAS bf16x8*)(const_cast<__attribute__((address_space(3))) char*>(qlp) + d0 * 1024) = qr[d0];
    }
#define QL(d0) (*(const LAS bf16x8*)(qlp + (d0) * 1024))
    float mhat = 0.f, l_reg = 0.f; f32x16 o[2]; o[0] = f32x16{}; o[1] = f32x16{};
    f32x16 negm = f32x16{}; if (USE_NEGM) asm volatile("" : "+v"(negm));
    const int qtok = A.qtok;
#define CMASK(P0, P1, t) do { const int t_ = (t); if (t_ < NB) cmask(P0, P1, 64 * t_, qtok, hi); \
        else { const int a_ = abase + NB - 1 - t_; if (a_ < 0) wmask(P0, P1, 64, hi); \
               else if (MODE == MODE_WIN) { const int thr_ = qtok - 511 + 64 * (abase - a_); if (thr_ > 0) wmask(P0, P1, thr_, hi); } } } while (0)
#define CINIT1(C, t, OFF) do { if (MODE == MODE_FOX) { const LAS float* bt_ = A.bias + 64 * (seq<NB>((t), abase) - (abase + NB - NT)) + 4 * hi + (OFF); const float nm_ = -mhat; \
        _Pragma("unroll") for (int g_ = 0; g_ < 4; ++g_) { const f32x4 b_ = *(const LAS f32x4*)(bt_ + 8 * g_); C[4 * g_] = b_.x; C[4 * g_ + 1] = b_.y; C[4 * g_ + 2] = b_.z; C[4 * g_ + 3] = b_.w; } \
        _Pragma("unroll") for (int r_ = 0; r_ < 16; ++r_) C[r_] += nm_; asm volatile("" : "+v"(C)); } \
      else if (USE_NEGM) { C = negm; } \
      else { const float nm_ = -mhat; _Pragma("unroll") for (int r_ = 0; r_ < 16; ++r_) C[r_] = nm_; asm volatile("" : "+v"(C)); } } while (0)
#define CINIT(C0, C1, t) do { CINIT1(C0, t, 0); CINIT1(C1, t, 32); } while (0)
    bool resc = false;
#define START(P0, P1) do { const float rm = rowmax(P0, P1); resc = false; \
    { const float dl = rm; mhat = fadd_s(mhat, dl); \
      _Pragma("unroll") for (int r = 0; r < 16; ++r) { P0[r] = fsub_s(P0[r], dl); P1[r] = fsub_s(P1[r], dl); } \
      if (USE_NEGM) { _Pragma("unroll") for (int r = 0; r < 16; ++r) negm[r] = -mhat; asm volatile("" : "+v"(negm)); } } \
    _Pragma("unroll") for (int r = 0; r < 16; ++r) P0[r] = __builtin_amdgcn_exp2f(P0[r]); } while (0)
#define RESC() do { if (resc) { asm volatile("s_waitcnt lgkmcnt(0)" ::: "memory"); \
      const float* wsh_ = wsf + 4 * hi; \
      _Pragma("unroll") for (int d_ = 0; d_ < 2; ++d_) _Pragma("unroll") for (int r = 0; r < 16; ++r) o[d_][r] *= wsh_[(r & 3) + 8 * (r >> 2)]; } } while (0)
    f32x16 pA0, pA1, pB0, pB1; bf16x8 kf[2 * NK];
    int sl_prev = 0, sl_cur = 0, sl_next = 1;
#define ROT() do { sl_prev = sl_cur; sl_cur = sl_next; sl_next = (sl_next == NSLOT - 1) ? 0 : sl_next + 1; } while (0)
    DMA_K(2, 2);
    if (DQ == 96) { AWAIT_BAR(5); } else { AWAIT_BAR(3); }
    { const char* kb = shm + LDS_K + hi * 1024 + r32 * 16;
      CINIT(pA0, pA1, 0);
#pragma unroll
      for (int d0 = 0; d0 < NK; ++d0) {
          const bf16x8 b0 = *reinterpret_cast<const bf16x8*>(kb + d0 * 2048);
          const bf16x8 b1 = *reinterpret_cast<const bf16x8*>(kb + d0 * 2048 + 512);
          pA0 = __builtin_amdgcn_mfma_f32_32x32x16_bf16(b0, qr[d0], pA0, 0, 0, 0); pA1 = __builtin_amdgcn_mfma_f32_32x32x16_bf16(b1, qr[d0], pA1, 0, 0, 0); } }
    asm volatile("s_nop 15\n\ts_nop 7" : "+v"(pA0), "+v"(pA1)); CMASK(pA0, pA1, 0);
    START(pA0, pA1);
    _Pragma("unroll") for (int r = 0; r < 16; ++r) pA1[r] = __builtin_amdgcn_exp2f(pA1[r]);
    AWAIT_BAR(0);
    DMA_K(3, 0); DMA_V(1, 1);
    ROT();
    kloadall<NK>(kf, kp0 + sl_cur * KSLOT);
    if (DQ == 96) { AWAIT_BAR(3); } else { AWAIT_BAR(2); }
    s16x4 vlo[(DQ == 96) ? 4 : 8], vhi[(DQ == 96) ? 4 : 8]; u32x4 pw0, pw1, pw2, pw3;
#define PKW(P, B) cvtpk(P[B], P[B + 1])
#define PAF(k) __builtin_bit_cast(bf16x8, pw##k)
#define VFR(i) (bf16x8){vlo[i][0], vlo[i][1], vlo[i][2], vlo[i][3], vhi[i][0], vhi[i][1], vhi[i][2], vhi[i][3]}
#define PIN(x) asm volatile("" : "+v"(x))
#define MX3(a, b, c) __builtin_fmaxf(__builtin_fmaxf((a), (b)), (c))
#define GAPA(MF, A0, A1, A2, A3, W0, W1, PW) do { MF; sacc += A0; sacc += A1; sacc += A2; sacc += A3; PIN(sacc); W0; W1; PIN(PW); ASBAR(); } while (0)
#define EX(v) __builtin_amdgcn_exp2f(v)
#define GAPB(MF, X, B) do { MF; X[B] = EX(X[B]); X[B + 1] = EX(X[B + 1]); X[B + 2] = EX(X[B + 2]); X[B + 3] = EX(X[B + 3]); PIN(X); ASBAR(); } while (0)
#define VRD(i) do { vlo[i] = vtr(vp_ + (((i) >> 2) * 4096 + ((i) & 3) * 1024)); vhi[i] = vtr(vp_ + (((i) >> 2) * 4096 + ((i) & 3) * 1024 + 512)); } while (0)
#define KRD(G_, j) do { if (G_) { kload2(kf, kp0 + sl_next * KSLOT, j); ASBAR(); } } while (0)
#define MFMA32(a, b, c) __builtin_amdgcn_mfma_f32_32x32x16_bf16(a, b, c, 0, 0, 0)
#define STEP64(C0, C1, P0, P1, t, GK, GV, GL, DOMASK) do { ASBAR(); \
    const lds_cptr vp_ = vp0 + sl_prev * VSLOT; \
    CINIT1(C0, t, 0); ASBAR(); \
    VRD(0); ASBAR(); float sacc = (P0[0] + P0[1]); \
    GAPA(C0 = MFMA32(kf[0], qr[0], C0), P0[2], P0[3], P0[4], P0[5],     pw0[0] = PKW(P0, 0), pw0[1] = PKW(P0, 2), pw0); \
    CINIT1(C1, t, 32); ASBAR(); \
    VRD(4); ASBAR(); GAPA(C1 = MFMA32(kf[1], qr[0], C1), P0[6], P0[7], P0[8], P0[9],     pw0[2] = PKW(P0, 4), pw0[3] = PKW(P0, 6), pw0); \
    VRD(1); ASBAR(); GAPA(C0 = MFMA32(kf[2], qr[1], C0),   P0[10], P0[11], P0[12], P0[13], pw1[0] = PKW(P0, 8), pw1[1] = PKW(P0, 10), pw1); \
    VRD(5); ASBAR(); GAPA(C1 = MFMA32(kf[3], qr[1], C1),   P0[14], P0[15], P1[0], P1[1],   pw1[2] = PKW(P0, 12), pw1[3] = PKW(P0, 14), pw1); \
    VRD(2); ASBAR(); GAPA(C0 = MFMA32(kf[4], qr[2], C0),   P1[2], P1[3], P1[4], P1[5],     pw2[0] = PKW(P1, 0), pw2[1] = PKW(P1, 2), pw2); \
    VRD(6); ASBAR(); GAPA(C1 = MFMA32(kf[5], qr[2], C1),   P1[6], P1[7], P1[8], P1[9],     pw2[2] = PKW(P1, 4), pw2[3] = PKW(P1, 6), pw2); \
    VRD(3); ASBAR(); GAPA(C0 = MFMA32(kf[6], qr[3], C0),   P1[10], P1[11], P1[12], P1[13], pw3[0] = PKW(P1, 8), pw3[1] = PKW(P1, 10), pw3); \
    VRD(7); ASBAR(); GAPA(C1 = MFMA32(kf[7], qr[3], C1),   P1[14], P1[15], 0.f, 0.f,       pw3[2] = PKW(P1, 12), pw3[3] = PKW(P1, 14), pw3); \
    l_reg += sacc; \
    if (GK) { DMA_K((t) + 3, sl_cur); } if (GV) { DMA_V((t) + 1, sl_next); } \
    if (DOMASK) CMASK(C0, C1, t); \
    { float a = MX3(C0[0], C0[1], C1[0]), b = MX3(C0[2], C0[3], C1[1]); a = MX3(a, C1[2], C1[3]); \
      _Pragma("unroll") for (int r = 4; r < 16; r += 4) { a = MX3(a, C0[r], C0[r + 1]); b = MX3(b, C0[r + 2], C0[r + 3]); a = MX3(a, C1[r], C1[r + 1]); b = MX3(b, C1[r + 2], C1[r + 3]); } \
      float rm = __builtin_fmaxf(a, b); { auto rr = __builtin_amdgcn_permlane32_swap(__float_as_uint(rm), __float_as_uint(rm), false, false); rm = __builtin_fmaxf(__uint_as_float(rr[0]), __uint_as_float(rr[1])); } \
      resc = false; \
      if (__builtin_expect(__any(rm > (float)THRL), 0)) { const float dl = __builtin_fmaxf(rm, 0.f); mhat += dl; \
        _Pragma("unroll") for (int r = 0; r < 16; ++r) { C0[r] -= dl; C1[r] -= dl; } \
        if (USE_NEGM) { _Pragma("unroll") for (int r = 0; r < 16; ++r) negm[r] = -mhat; asm volatile("" : "+v"(negm)); } \
        const float f = __builtin_amdgcn_exp2f(-dl); l_reg *= f; if (hi == 0) wsf[r32] = f; resc = true; } } \
    ASBAR(); \
    GAPB(o[0] = MFMA32(PAF(0), VFR(0), o[0]), C0, 0); \
    GAPB(o[1] = MFMA32(PAF(0), VFR(4), o[1]), C0, 4); \
    KRD(GL, 0); GAPB(o[0] = MFMA32(PAF(1), VFR(1), o[0]), C0, 8); \
    KRD(GL, 1); GAPB(o[1] = MFMA32(PAF(1), VFR(5), o[1]), C0, 12); \
    KRD(GL, 2); GAPB(o[0] = MFMA32(PAF(2), VFR(2), o[0]), C1, 0); \
    KRD(GL, 3); GAPB(o[1] = MFMA32(PAF(2), VFR(6), o[1]), C1, 4); \
    GAPB(o[0] = MFMA32(PAF(3), VFR(3), o[0]), C1, 8); \
    GAPB(o[1] = MFMA32(PAF(3), VFR(7), o[1]), C1, 12); \
    } while (0)
#define AWAIT_STEADY() do { if (DQ == 96) { AWAIT_BAR(3); } else { AWAIT_BAR(2); } } while (0)
#define VRD4(i, b) do { vlo[b] = vtr(vp_ + (((i) >> 2) * 4096 + ((i) & 3) * 1024)); vhi[b] = vtr(vp_ + (((i) >> 2) * 4096 + ((i) & 3) * 1024 + 512)); } while (0)
#define VFR4(b) (bf16x8){vlo[b][0], vlo[b][1], vlo[b][2], vlo[b][3], vhi[b][0], vhi[b][1], vhi[b][2], vhi[b][3]}
#define GAPQ(MF, QLD, A0, A1, A2, A3, W0, W1, PW) do { MF; QLD; sacc += A0; sacc += A1; sacc += A2; sacc += A3; PIN(sacc); W0; W1; PIN(PW); ASBAR(); } while (0)
#define STEP96(C0, C1, P0, P1, t, GK, GV, GL, DOMASK) do { ASBAR(); \
    const lds_cptr vp_ = vp0 + sl_prev * VSLOT; \
    CINIT1(C0, t, 0); CINIT1(C1, t, 32); bf16x8 qa = QL(0), qb; ASBAR(); \
    float sacc = (P0[0] + P0[1]); \
    GAPQ(C0 = MFMA32(kf[0], qa, C0), qb = QL(1), P0[2], P0[3], P0[4], P0[5],     pw0[0] = PKW(P0, 0), pw0[1] = PKW(P0, 2), pw0); \
    GAPQ(C1 = MFMA32(kf[1], qa, C1), (void)0,    P0[6], P0[7], P0[8], P0[9],     pw0[2] = PKW(P0, 4), pw0[3] = PKW(P0, 6), pw0); \
    GAPQ(C0 = MFMA32(kf[2], qb, C0), qa = QL(2), P0[10], P0[11], P0[12], P0[13], pw1[0] = PKW(P0, 8), pw1[1] = PKW(P0, 10), pw1); \
    GAPQ(C1 = MFMA32(kf[3], qb, C1), (void)0,    P0[14], P0[15], P1[0], P1[1],   pw1[2] = PKW(P0, 12), pw1[3] = PKW(P0, 14), pw1); \
    GAPQ(C0 = MFMA32(kf[4], qa, C0), qb = QL(3), P1[2], P1[3], P1[4], P1[5],     pw2[0] = PKW(P1, 0), pw2[1] = PKW(P1, 2), pw2); \
    GAPQ(C1 = MFMA32(kf[5], qa, C1), (void)0,    P1[6], P1[7], P1[8], P1[9],     pw2[2] = PKW(P1, 4), pw2[3] = PKW(P1, 6), pw2); \
    GAPQ(C0 = MFMA32(kf[6], qb, C0), qa = QL(4), P1[10], P1[11], P1[12], P1[13], pw3[0] = PKW(P1, 8), pw3[1] = PKW(P1, 10), pw3); \
    GAPQ(C1 = MFMA32(kf[7], qb, C1), (void)0,    P1[14], P1[15], 0.f, 0.f,       pw3[2] = PKW(P1, 12), pw3[3] = PKW(P1, 14), pw3); \
    C0 = MFMA32(kf[8], qa, C0); qb = QL(5); VRD4(0, 0); ASBAR(); \
    C1 = MFMA32(kf[9], qa, C1); VRD4(4, 1); ASBAR(); \
    C0 = MFMA32(kf[10], qb, C0); ASBAR(); \
    C1 = MFMA32(kf[11], qb, C1); ASBAR(); \
    l_reg += sacc; \
    if (GK) { DMA_K((t) + 3, sl_cur); } if (GV) { DMA_V((t) + 1, sl_next); } \
    if (DOMASK) CMASK(C0, C1, t); \
    { float a = MX3(C0[0], C0[1], C1[0]), b = MX3(C0[2], C0[3], C1[1]); a = MX3(a, C1[2], C1[3]); \
      _Pragma("unroll") for (int r = 4; r < 16; r += 4) { a = MX3(a, C0[r], C0[r + 1]); b = MX3(b, C0[r + 2], C0[r + 3]); a = MX3(a, C1[r], C1[r + 1]); b = MX3(b, C1[r + 2], C1[r + 3]); } \
      float rm = __builtin_fmaxf(a, b); { auto rr = __builtin_amdgcn_permlane32_swap(__float_as_uint(rm), __float_as_uint(rm), false, false); rm = __builtin_fmaxf(__uint_as_float(rr[0]), __uint_as_float(rr[1])); } \
      resc = false; \
      if (__builtin_expect(__any(rm > (float)THRL), 0)) { const float dl = __builtin_fmaxf(rm, 0.f); mhat += dl; \
        _Pragma("unroll") for (int r = 0; r < 16; ++r) { C0[r] -= dl; C1[r] -= dl; } \
        if (USE_NEGM) { _Pragma("unroll") for (int r = 0; r < 16; ++r) negm[r] = -mhat; asm volatile("" : "+v"(negm)); } \
        const float f = __builtin_amdgcn_exp2f(-dl); l_reg *= f; if (hi == 0) wsf[r32] = f; resc = true; } } \
    ASBAR(); \
    VRD4(1, 2); ASBAR(); GAPB(o[0] = MFMA32(PAF(0), VFR4(0), o[0]), C0, 0); \
    VRD4(5, 3); ASBAR(); GAPB(o[1] = MFMA32(PAF(0), VFR4(1), o[1]), C0, 4); \
    VRD4(2, 0); KRD(GL, 0); GAPB(o[0] = MFMA32(PAF(1), VFR4(2), o[0]), C0, 8); \
    VRD4(6, 1); KRD(GL, 1); GAPB(o[1] = MFMA32(PAF(1), VFR4(3), o[1]), C0, 12); \
    VRD4(3, 2); KRD(GL, 2); GAPB(o[0] = MFMA32(PAF(2), VFR4(0), o[0]), C1, 0); \
    VRD4(7, 3); KRD(GL, 3); GAPB(o[1] = MFMA32(PAF(2), VFR4(1), o[1]), C1, 4); \
    KRD(GL, 4); GAPB(o[0] = MFMA32(PAF(3), VFR4(2), o[0]), C1, 8); \
    KRD(GL, 5); GAPB(o[1] = MFMA32(PAF(3), VFR4(3), o[1]), C1, 12); \
    } while (0)
#define STEP(C0, C1, P0, P1, t, GK, GV, GL, DOMASK) do { if constexpr (DQ == 96) { STEP96(C0, C1, P0, P1, t, GK, GV, GL, DOMASK); } else { STEP64(C0, C1, P0, P1, t, GK, GV, GL, DOMASK); } } while (0)
#define ENDW(tt) do { if ((tt) + 3 < NT) { AWAIT_STEADY(); } else if ((tt) + 2 < NT) { AWAIT_BAR(1); } else { AWAIT_BAR(0); } } while (0)
    int t = 1;
    for (; t < 5 && t + 1 < NT; t += 2) {
        STEP(pB0, pB1, pA0, pA1, t, (t + 3 < NT), (t + 1 < NT), (t + 1 < NT), true);       ENDW(t);     RESC(); ROT();
        STEP(pA0, pA1, pB0, pB1, t + 1, (t + 4 < NT), (t + 2 < NT), (t + 2 < NT), true);   ENDW(t + 1); RESC(); ROT();
    }
    for (; t + 5 < NT; t += 2) {
        STEP(pB0, pB1, pA0, pA1, t, true, true, true, false);     AWAIT_STEADY(); RESC(); ROT();
        STEP(pA0, pA1, pB0, pB1, t + 1, true, true, true, false); AWAIT_STEADY(); RESC(); ROT();
    }
    for (; t + 1 < NT; t += 2) {
        STEP(pB0, pB1, pA0, pA1, t, (t + 3 < NT), (t + 1 < NT), (t + 1 < NT), true);       ENDW(t);     RESC(); ROT();
        STEP(pA0, pA1, pB0, pB1, t + 1, (t + 4 < NT), (t + 2 < NT), (t + 2 < NT), true);   ENDW(t + 1); RESC(); ROT();
    }
    STEP(pB0, pB1, pA0, pA1, NT - 1, false, false, false, true); RESC();
    { float sacc = pB0[0] + pB0[1];
      _Pragma("unroll") for (int r = 2; r < 16; ++r) sacc += pB0[r];
      _Pragma("unroll") for (int r = 0; r < 16; ++r) sacc += pB1[r];
      l_reg += sacc;
      pw0 = (u32x4){PKW(pB0, 0), PKW(pB0, 2), PKW(pB0, 4), PKW(pB0, 6)}; pw1 = (u32x4){PKW(pB0, 8), PKW(pB0, 10), PKW(pB0, 12), PKW(pB0, 14)};
      pw2 = (u32x4){PKW(pB1, 0), PKW(pB1, 2), PKW(pB1, 4), PKW(pB1, 6)}; pw3 = (u32x4){PKW(pB1, 8), PKW(pB1, 10), PKW(pB1, 12), PKW(pB1, 14)};
      ASBAR();
      const int vb = vb0 + sl_cur * VSLOT;
#pragma unroll
      for (int d0 = 0; d0 < 2; ++d0) { s16x4 lo[4], hh[4];
#pragma unroll
          for (int ks = 0; ks < 4; ++ks) {
              asm volatile("ds_read_b64_tr_b16 %0,%1 offset:%c2" : "=&v"(lo[ks]) : "v"(vb), "i"(d0 * 4096 + ks * 1024) : "memory");
              asm volatile("ds_read_b64_tr_b16 %0,%1 offset:%c2" : "=&v"(hh[ks]) : "v"(vb), "i"(d0 * 4096 + ks * 1024 + 512) : "memory"); }
          asm volatile("s_waitcnt lgkmcnt(0)" ::: "memory"); ASBAR();
#define PK(k) (bf16x8){lo[k][0], lo[k][1], lo[k][2], lo[k][3], hh[k][0], hh[k][1], hh[k][2], hh[k][3]}
          o[d0] = MFMA32(PAF(0), PK(0), o[d0]); o[d0] = MFMA32(PAF(1), PK(1), o[d0]); o[d0] = MFMA32(PAF(2), PK(2), o[d0]); o[d0] = MFMA32(PAF(3), PK(3), o[d0]);
#undef PK
      } }
    { auto rr = __builtin_amdgcn_permlane32_swap(__float_as_uint(l_reg), __float_as_uint(l_reg), false, false); l_reg = __uint_as_float(rr[0]) + __uint_as_float(rr[1]); }
    if (hi == 0) wsf[32 + r32] = l_reg; asm volatile("s_waitcnt lgkmcnt(0)" ::: "memory");
    int lane_e = lane; asm volatile("" : "+v"(lane_e)); const int hi_e = lane_e >> 5, r32_e = lane_e & 31;
    float rli[16];
    { const float* wl_ = wsf + 32 + 4 * hi_e;
#pragma unroll
      for (int r = 0; r < 16; ++r) rli[r] = __builtin_amdgcn_rcpf(wl_[(r & 3) + 8 * (r >> 2)]); }
    { bf16_t* stg = (bf16_t*)(shm + LDS_OST + wid * QWAVE);
      bf16_t* stl = stg + (4 * hi_e) * 64 + r32_e;
#pragma unroll
      for (int r = 0; r < 16; ++r) {
#pragma unroll
          for (int d0 = 0; d0 < 2; ++d0) stl[((r & 3) + 8 * (r >> 2)) * 64 + d0 * 32] = f2bf(o[d0][r] * rli[r]); }
      asm volatile("s_waitcnt lgkmcnt(0)" ::: "memory");
#pragma unroll
      for (int i = 0; i < 4; ++i) { const int row = i * 8 + (lane_e >> 3), ch = lane_e & 7; const u32x4 v = *(const u32x4*)(stg + row * 64 + ch * 8);
          bf16_t* dst = GQA4 ? (A.obase + (long)(8 * wid + (row >> 2)) * A.opitch + (row & 3) * 64) : (A.obase + (long)(32 * wid + row) * A.opitch);
          *(u32x4*)(dst + ch * 8) = v; } }
    asm volatile("s_waitcnt lgkmcnt(0)\n\ts_barrier" ::: "memory");
#undef TILE_OF
#undef DMA_K
#undef DMA_V
#undef CMASK
#undef CINIT
#undef START
#undef RESC
#undef ROT
#undef PKW
#undef PAF
#undef VFR
#undef PIN
#undef MX3
#undef GAPA
#undef GAPB
#undef EX
#undef VRD
#undef KRD
#undef MFMA32
#undef STEP
#undef STEP64
#undef STEP96
#undef VRD4
#undef VFR4
#undef GAPQ
#undef QL
#undef ENDW
#undef AWAIT_STEADY
}
}
constexpr int MK_THREADS = 512;
constexpr int LDS_RING = 131072;
constexpr int LDS_X = LDS_RING;
constexpr int LDS_MOD = LDS_RING + 8192;
constexpr int LDS_BARST = 155648 - 16;
constexpr int LDS_TOTAL = 155648;

#define C2Q 0.18033688011112042f
#define LOG2E 1.4426950408889634f

struct BlkDesc { bf16_t* dst; const float* gain; int pitch; int flags; float scale; int csoff; };
#define C2M 0.14724312203508865f
#define GSTR 1088
struct MKP {
    const float* in[34];
    float* out;
    float* modpart;
    float* mod;
    float* cosT; float* sinT;
    bf16_t* W_in0t;
    bf16_t* W_out0t;
    bf16_t* XN;
    bf16_t* OATT;
    bf16_t* QN;
    bf16_t* KV6;
    bf16_t* FQ; bf16_t* FK; bf16_t* FV;
    float* GATES;
    float* LOGF;
    BlkDesc* desc0;
    float* CUMB;
    BlkDesc* desc_uq;
    BlkDesc* desc_ukv;
    bf16_t* W_in1t;
    bf16_t* W_uqt;
    bf16_t* W_ukvt;
    bf16_t* W_out1t;
    bf16_t* P1;
    bf16_t* CQN;
    bf16_t* CKVN;
    bf16_t* Q96;
    bf16_t* K96;
    bf16_t* V1;
    bf16_t* WcT;
    float* CBIAS;
    bf16_t* KCMP;
    bf16_t* VCT;
    bf16_t* KSLF;
    bf16_t* VSLF;
    bf16_t* OCMP;
    bf16_t* OWIN;
    const int* pos;
    bf16_t* Wgu;
    bf16_t* Wd;
    bf16_t* HID;
    bf16_t* YS;
    bf16_t* YBUF;
    int* gcnt;
    int* list;
    float* ew;
    unsigned* barw;
    int ph_lo, ph_hi, dbg_flags, pad_;
};

__device__ __forceinline__ int swap45(int p) { return (p & 15) | ((p & 16) << 1) | ((p & 32) >> 1); }

template <class Map>
__device__ __forceinline__ void tr_item(const float* __restrict__ W, int ldw, int K, bf16_t* WT, LAS float* scr, int kb, int nb, int lane, const Map& cmap, const float* kscale) {
    const int k0 = 64 * kb, n0 = 32 * nb;
    const int sc = cmap(n0 + (lane & 31));
    float v[32];
    const float* src = W + (size_t)(k0 + (lane >> 5)) * ldw + (sc >= 0 ? sc : 0);
#pragma unroll
    for (int i = 0; i < 32; ++i) v[i] = src[(size_t)(2 * i) * ldw];
    if (kscale) {
#pragma unroll
        for (int i = 0; i < 32; ++i) v[i] *= kscale[k0 + 2 * i + (lane >> 5)];
    }
#pragma unroll
    for (int i = 0; i < 32; ++i) scr[(2 * i + (lane >> 5)) * 33 + (lane & 31)] = (sc >= 0) ? v[i] : 0.f;
    asm volatile("s_waitcnt lgkmcnt(0)" ::: "memory");
    const int c = lane & 7;
#pragma unroll
    for (int j = 0; j < 4; ++j) {
        const int n = (lane >> 3) + 8 * j; const LAS float* s = scr + (8 * c) * 33 + n;
        u32x4 o; o.x = cvtpk(s[0 * 33], s[1 * 33]); o.y = cvtpk(s[2 * 33], s[3 * 33]); o.z = cvtpk(s[4 * 33], s[5 * 33]); o.w = cvtpk(s[6 * 33], s[7 * 33]);
        *(u32x4*)(WT + (size_t)(n0 + n) * K + k0 + 8 * c) = o;
    }
    asm volatile("s_waitcnt lgkmcnt(0)" ::: "memory");
}
struct MapIn0 {
    __device__ __forceinline__ int operator()(int nn) const {
        const int blk = nn >> 6, p = nn & 63;
        if (blk < 8) return blk * 64 + swap45(p);
        if (blk < 20) return 512 + (blk - 8) * 64 + swap45(p);
        if (blk < 44) return 1304 + (blk - 20) * 64 + swap45(p);
        if (blk == 44) { if (p < 24) return 1280 + p; if (p < 32) return 2840 + (p - 24); return -1; }
        return -1;
    }
};
struct MapId { __device__ __forceinline__ int operator()(int nn) const { return nn; } };
struct MapIn1 { __device__ __forceinline__ int operator()(int nn) const { return nn < 672 ? nn : -1; } };
struct MapUq { __device__ __forceinline__ int operator()(int nn) const { if (nn < 1024) return (nn >> 6) * 96 + swap45(nn & 63); const int r = nn - 1024; return (r >> 5) * 96 + 64 + (r & 31); } };
struct MapUkv { __device__ __forceinline__ int operator()(int nn) const { if (nn < 1024) return (nn >> 6) * 128 + swap45(nn & 63); const int r = nn - 1024; return (r >> 6) * 128 + 64 + swap45(r & 63); } };

namespace nsa {
using att::f32x16; using att::crow;
#define NMFMA32(a, b, c) __builtin_amdgcn_mfma_f32_32x32x16_bf16(a, b, c, 0, 0, 0)
#define NMFMA16(a, b, c) __builtin_amdgcn_mfma_f32_16x16x32_bf16(a, b, c, 0, 0, 0)
#define RLF(x, l) __uint_as_float(__builtin_amdgcn_readlane((int)__float_as_uint(x), (l)))

__device__ __forceinline__ void compress_job(const MKP& p, LAS float* scr, LAS float* part, int job, int slice, int lane) {
    const int nt = job & 31, g = (job >> 5) & 1, kv = job >> 6;
    const int r32 = lane & 31, hi = lane >> 5, n0 = nt * 32;
    const bf16_t* tok = p.KV6 + (size_t)(kv * 2 + g) * S_ * 64;
    const bf16_t* wt = p.WcT + (size_t)kv * 64 * 2048;
    scr[lane] = p.CBIAS[kv * 64 + lane];
    asm volatile("s_waitcnt lgkmcnt(0)" ::: "memory");
    int nrow = n0 + r32; if (nrow > 1022) nrow = 1022;
    const bf16_t* ta = tok + (size_t)(16 * nrow) * 64 + 8 * hi;
    const bf16_t* wa0 = wt + (size_t)r32 * 2048 + 8 * hi;
    const bf16_t* wa1 = wa0 + (size_t)32 * 2048;
    f32x16 c0 = f32x16{}, c1 = f32x16{};
    if (kv == 0) {
#pragma unroll 8
        for (int s = 32 * slice; s < 32 * slice + 32; ++s) {
            const bf16x8 tf = *(const bf16x8*)(ta + 16 * s), w0 = *(const bf16x8*)(wa0 + 16 * s), w1 = *(const bf16x8*)(wa1 + 16 * s);
            c0 = NMFMA32(w0, tf, c0); c1 = NMFMA32(w1, tf, c1);
        }
        if (slice) {
#pragma unroll
            for (int r = 0; r < 16; ++r) { part[r * 64 + lane] = c0[r]; part[(16 + r) * 64 + lane] = c1[r]; } }
        __syncthreads();
        if (slice) return;
#pragma unroll
        for (int q = 1; q < 4; ++q)
#pragma unroll
            for (int r = 0; r < 16; ++r) { c0[r] += part[q * 2048 + r * 64 + lane]; c1[r] += part[q * 2048 + (16 + r) * 64 + lane]; }
        float ss = 0.f;
#pragma unroll
        for (int r = 0; r < 16; ++r) { c0[r] += scr[crow(r, hi)]; c1[r] += scr[32 + crow(r, hi)]; ss += c0[r] * c0[r] + c1[r] * c1[r]; }
        { auto rr = __builtin_amdgcn_permlane32_swap(__float_as_uint(ss), __float_as_uint(ss), false, false); ss = __uint_as_float(rr[0]) + __uint_as_float(rr[1]); }
        const float rs = rsqrtf(ss * (1.f / 64.f) + EPSF);
        const float* gn = p.in[10];
        if (n0 + r32 < 1023) {
            const int nn = n0 + r32;
            bf16_t* dst = p.KCMP + (size_t)g * 1024 * 64 + (size_t)(nn >> 6) * 4096 + ((nn >> 5) & 1) * 512 + (nn & 31) * 8;
#pragma unroll
            for (int q = 0; q < 4; ++q) {
                const int e0 = 8 * q + 4 * hi;
                const f32x4 ga = *(const f32x4*)(gn + e0), gb = *(const f32x4*)(gn + 32 + e0);
                u32x2 wa, wb;
                wa.x = cvtpk(c0[4 * q] * rs * ga.x, c0[4 * q + 1] * rs * ga.y); wa.y = cvtpk(c0[4 * q + 2] * rs * ga.z, c0[4 * q + 3] * rs * ga.w);
                wb.x = cvtpk(c1[4 * q] * rs * gb.x, c1[4 * q + 1] * rs * gb.y); wb.y = cvtpk(c1[4 * q + 2] * rs * gb.z, c1[4 * q + 3] * rs * gb.w);
                *(u32x2*)(dst + (e0 >> 4) * 1024 + ((e0 >> 3) & 1) * 256 + (e0 & 7)) = wa; *(u32x2*)(dst + ((32 + e0) >> 4) * 1024 + (((32 + e0) >> 3) & 1) * 256 + ((32 + e0) & 7)) = wb;
            }
        }
    } else {
#pragma unroll 8
        for (int s = 32 * slice; s < 32 * slice + 32; ++s) {
            const bf16x8 tf = *(const bf16x8*)(ta + 16 * s), w0 = *(const bf16x8*)(wa0 + 16 * s), w1 = *(const bf16x8*)(wa1 + 16 * s);
            c0 = NMFMA32(tf, w0, c0); c1 = NMFMA32(tf, w1, c1);
        }
        if (slice) {
#pragma unroll
            for (int r = 0; r < 16; ++r) { part[r * 64 + lane] = c0[r]; part[(16 + r) * 64 + lane] = c1[r]; } }
        __syncthreads();
        if (slice) return;
#pragma unroll
        for (int q = 1; q < 4; ++q)
#pragma unroll
            for (int r = 0; r < 16; ++r) { c0[r] += part[q * 2048 + r * 64 + lane]; c1[r] += part[q * 2048 + (16 + r) * 64 + lane]; }
        const float b0 = scr[r32], b1 = scr[32 + r32];
#pragma unroll
        for (int G = 0; G < 2; ++G) {
            u32x4 va, vb;
            va.x = cvtpk(c0[8 * G] + b0, c0[8 * G + 1] + b0); va.y = cvtpk(c0[8 * G + 2] + b0, c0[8 * G + 3] + b0); va.z = cvtpk(c0[8 * G + 4] + b0, c0[8 * G + 5] + b0); va.w = cvtpk(c0[8 * G + 6] + b0, c0[8 * G + 7] + b0);
            vb.x = cvtpk(c1[8 * G] + b1, c1[8 * G + 1] + b1); vb.y = cvtpk(c1[8 * G + 2] + b1, c1[8 * G + 3] + b1); vb.z = cvtpk(c1[8 * G + 4] + b1, c1[8 * G + 5] + b1); vb.w = cvtpk(c1[8 * G + 6] + b1, c1[8 * G + 7] + b1);
            { const int nk = n0 + 16 * G, c_ = nk >> 6, ks_ = (nk >> 4) & 3;
              bf16_t* vd = p.VCT + (size_t)g * 64 * 1024 + (size_t)c_ * 4096 + ks_ * 1024 + (hi * 32 + r32) * 8;
              *(u32x4*)vd = va; *(u32x4*)(vd + 512) = vb; }
        }
    }
    asm volatile("s_waitcnt lgkmcnt(0)" ::: "memory");
}

__device__ __forceinline__ unsigned pk4_fp8(float a, float b, float c, float d) { int w = __builtin_amdgcn_cvt_pk_fp8_f32(a, b, 0, false); w = __builtin_amdgcn_cvt_pk_fp8_f32(c, d, w, true); return (unsigned)w; }
__device__ __forceinline__ void slcfrag_job(const MKP& p, int job, int lane) {
    const int g = job >> 8, blk = job & 255, c16 = lane & 15, u = lane >> 4;
    const bf16_t* k = p.KV6 + (size_t)(2 * 2 + g) * S_ * 64 + (size_t)blk * 64 * 64;
    const bf16_t* v = p.KV6 + (size_t)(3 * 2 + g) * S_ * 64 + (size_t)blk * 64 * 64;
    unsigned char* kd = (unsigned char*)p.KSLF + ((size_t)g * 256 + blk) * 4096 + lane * 16;
    unsigned char* vd = (unsigned char*)p.VSLF + ((size_t)g * 256 + blk) * 4096 + lane * 16;
#pragma unroll
    for (int kg = 0; kg < 4; ++kg) {
        const u32x4 a = *(const u32x4*)(k + (size_t)(16 * kg + c16) * 64 + 8 * u), b = *(const u32x4*)(k + (size_t)(16 * kg + c16) * 64 + 32 + 8 * u);
        u32x4 o;
        o.x = pk4_fp8(__uint_as_float(a.x << 16), __uint_as_float(a.x & 0xffff0000u), __uint_as_float(a.y << 16), __uint_as_float(a.y & 0xffff0000u));
        o.y = pk4_fp8(__uint_as_float(a.z << 16), __uint_as_float(a.z & 0xffff0000u), __uint_as_float(a.w << 16), __uint_as_float(a.w & 0xffff0000u));
        o.z = pk4_fp8(__uint_as_float(b.x << 16), __uint_as_float(b.x & 0xffff0000u), __uint_as_float(b.y << 16), __uint_as_float(b.y & 0xffff0000u));
        o.w = pk4_fp8(__uint_as_float(b.z << 16), __uint_as_float(b.z & 0xffff0000u), __uint_as_float(b.w << 16), __uint_as_float(b.w & 0xffff0000u));
        *(u32x4*)(kd + kg * 1024) = o;
    }
#pragma unroll
    for (int dg = 0; dg < 4; ++dg) {
        float x[16];
#pragma unroll
        for (int ch = 0; ch < 2; ++ch)
#pragma unroll
            for (int j = 0; j < 8; ++j) { const int key = 32 * ch + ((j < 4) ? 4 * u + j : 16 + 4 * u + (j - 4)); x[ch * 8 + j] = bf2f(v[(size_t)key * 64 + 16 * dg + c16]); }
        u32x4 o; o.x = pk4_fp8(x[0], x[1], x[2], x[3]); o.y = pk4_fp8(x[4], x[5], x[6], x[7]); o.z = pk4_fp8(x[8], x[9], x[10], x[11]); o.w = pk4_fp8(x[12], x[13], x[14], x[15]);
        *(u32x4*)(vd + dg * 1024) = o;
    }
}

constexpr int IMP_LD = 272;
__device__ __forceinline__ void cmp_wave(const MKP& p, int g, int t0w, LAS float* imp, LAS unsigned char* stg, int lane) {
    const int r32 = lane & 31, hi = lane >> 5;
    const int tq = t0w + (r32 >> 2), head = g * 4 + (r32 & 3);
    const int nmax = (tq >= 31) ? ((tq - 31) >> 4) : -1;
    const int nmaxw = (t0w + 7 >= 31) ? ((t0w + 7 - 31) >> 4) : -1;
    const int ntile = (nmaxw >> 6) + 1;
    for (int i = lane; i < 8 * IMP_LD; i += 64) imp[i] = 0.f;
    bf16x8 qr[4];
#pragma unroll
    for (int d0 = 0; d0 < 4; ++d0) qr[d0] = *(const bf16x8*)(p.QN + (size_t)tq * 512 + head * 64 + d0 * 16 + hi * 8);
    const bf16_t* kc = p.KCMP + (size_t)g * 1024 * 64 + (hi * 32 + r32) * 8;
    bf16x8 ovf[4];
#pragma unroll
    for (int ks = 0; ks < 4; ++ks)
#pragma unroll
        for (int j = 0; j < 8; ++j) {
            const int nrel = 16 * ks + ((j < 4) ? 4 * hi + j : 8 + 4 * hi + (j - 4));
            const int dlt = nrel - 4 * r32;
            const float w = (dlt >= 0 && dlt <= 2) ? 2.f : ((dlt == 3 || dlt == -1) ? 1.f : 0.f);
            ovf[ks][j] = (short)f2bf(w);
        }
#define CKLOAD(dst, c_) do { const bf16_t* kt_ = kc + (size_t)(c_) * 4096; _Pragma("unroll") for (int f_ = 0; f_ < 8; ++f_) dst[f_] = *(const bf16x8*)(kt_ + f_ * 512); } while (0)
#define CQK(s0, s1, kf) do { s0 = f32x16{}; s1 = f32x16{}; _Pragma("unroll") for (int d0_ = 0; d0_ < 4; ++d0_) { s0 = NMFMA32(kf[2 * d0_], qr[d0_], s0); s1 = NMFMA32(kf[2 * d0_ + 1], qr[d0_], s1); } } while (0)
    float m = -INFINITY, l = 0.f;
    bf16x8 kfa[8], kfb[8];
    if (ntile > 0) CKLOAD(kfa, 0);
#define CMP_P1(KC, KN, c) do { { const int cn_ = ((c) + 1 < ntile) ? (c) + 1 : ntile - 1; CKLOAD(KN, cn_); } \
        f32x16 s0, s1; CQK(s0, s1, KC); \
        const int x = nmax - 64 * (c) - 4 * hi; float tm = -INFINITY; \
        _Pragma("unroll") for (int r = 0; r < 16; ++r) { const int cc = (r & 3) + 8 * (r >> 2); if (cc > x) s0[r] = -INFINITY; if (cc + 32 > x) s1[r] = -INFINITY; tm = fmaxf(tm, fmaxf(s0[r], s1[r])); } \
        if (tm > m) { l *= __builtin_amdgcn_exp2f(m - tm); m = tm; } \
        if (m > -INFINITY) { float sum = 0.f; _Pragma("unroll") for (int r = 0; r < 16; ++r) sum += __builtin_amdgcn_exp2f(s0[r] - m) + __builtin_amdgcn_exp2f(s1[r] - m); l += sum; } } while (0)
#pragma unroll 1
    for (int c = 0; c < ntile; c += 2) { CMP_P1(kfa, kfb, c); if (c + 1 < ntile) CMP_P1(kfb, kfa, c + 1); }
    { auto rm = __builtin_amdgcn_permlane32_swap(__float_as_uint(m), __float_as_uint(m), false, false);
      auto rl = __builtin_amdgcn_permlane32_swap(__float_as_uint(l), __float_as_uint(l), false, false);
      const float ma = __uint_as_float(rm[0]), mb = __uint_as_float(rm[1]), la = __uint_as_float(rl[0]), lb = __uint_as_float(rl[1]);
      const float mm = fmaxf(ma, mb);
      if (mm > -INFINITY) { l = ((ma > -INFINITY) ? la * __builtin_amdgcn_exp2f(ma - mm) : 0.f) + ((mb > -INFINITY) ? lb * __builtin_amdgcn_exp2f(mb - mm) : 0.f); m = mm; }
      else { l = 0.f; m = 0.f; } }
    const float invl = (l > 0.f) ? 1.f / l : 0.f;
    f32x16 o0 = f32x16{}, o1 = f32x16{};
    const bf16_t* vc = p.VCT + (size_t)g * 64 * 1024 + (hi * 32 + r32) * 8;
    if (ntile > 0) CKLOAD(kfa, 0);
    bf16x8 vfr[8];
#define CMP_P2(KC, KN, c) do { \
        { const bf16_t* vt_ = vc + (size_t)(c) * 4096; _Pragma("unroll") for (int f_ = 0; f_ < 8; ++f_) vfr[f_] = *(const bf16x8*)(vt_ + f_ * 512); } \
        { const int cn_ = ((c) + 1 < ntile) ? (c) + 1 : ntile - 1; CKLOAD(KN, cn_); } \
        f32x16 s0, s1; CQK(s0, s1, KC); \
        const int x = nmax - 64 * (c) - 4 * hi; \
        _Pragma("unroll") for (int r = 0; r < 16; ++r) { const int cc = (r & 3) + 8 * (r >> 2); \
            s0[r] = (cc > x) ? 0.f : __builtin_amdgcn_exp2f(s0[r] - m) * invl; s1[r] = (cc + 32 > x) ? 0.f : __builtin_amdgcn_exp2f(s1[r] - m) * invl; } \
        u32x4 pw[4]; \
        pw[0] = (u32x4){cvtpk(s0[0], s0[1]), cvtpk(s0[2], s0[3]), cvtpk(s0[4], s0[5]), cvtpk(s0[6], s0[7])}; \
        pw[1] = (u32x4){cvtpk(s0[8], s0[9]), cvtpk(s0[10], s0[11]), cvtpk(s0[12], s0[13]), cvtpk(s0[14], s0[15])}; \
        pw[2] = (u32x4){cvtpk(s1[0], s1[1]), cvtpk(s1[2], s1[3]), cvtpk(s1[4], s1[5]), cvtpk(s1[6], s1[7])}; \
        pw[3] = (u32x4){cvtpk(s1[8], s1[9]), cvtpk(s1[10], s1[11]), cvtpk(s1[12], s1[13]), cvtpk(s1[14], s1[15])}; \
        f32x16 im = f32x16{}; \
        _Pragma("unroll") for (int ks = 0; ks < 4; ++ks) { const bf16x8 pa = __builtin_bit_cast(bf16x8, pw[ks]); \
            o0 = NMFMA32(pa, vfr[2 * ks], o0); o1 = NMFMA32(pa, vfr[2 * ks + 1], o1); im = NMFMA32(pa, ovf[ks], im); } \
        if (r32 <= 16 && 16 * (c) + r32 < 256) { \
            _Pragma("unroll") for (int k = 0; k < 4; ++k) { const float v = (im[4 * k] + im[4 * k + 1]) + (im[4 * k + 2] + im[4 * k + 3]); atomicAdd((float*)(imp + (2 * k + hi) * IMP_LD + 16 * (c) + r32), v); } } } while (0)
#pragma unroll 1
    for (int c = 0; c < ntile; c += 2) { CMP_P2(kfa, kfb, c); if (c + 1 < ntile) CMP_P2(kfb, kfa, c + 1); }
#undef CMP_P1
#undef CMP_P2
#undef CKLOAD
#undef CQK
    { bf16_t* st = (bf16_t*)stg; bf16_t* stl = st + (4 * hi) * 64 + r32;
#pragma unroll
      for (int r = 0; r < 16; ++r) { stl[((r & 3) + 8 * (r >> 2)) * 64] = f2bf(o0[r]); stl[((r & 3) + 8 * (r >> 2)) * 64 + 32] = f2bf(o1[r]); }
      asm volatile("s_waitcnt lgkmcnt(0)" ::: "memory");
#pragma unroll
      for (int i = 0; i < 4; ++i) { const int row = i * 8 + (lane >> 3), ch = lane & 7; const u32x4 v = *(const u32x4*)(st + row * 64 + ch * 8);
          *(u32x4*)(p.OCMP + (size_t)(t0w + (row >> 2)) * 512 + (g * 4 + (row & 3)) * 64 + ch * 8) = v; }
      asm volatile("s_waitcnt lgkmcnt(0)" ::: "memory"); }
}

__device__ __forceinline__ float dpp_f(float v, int ctrl_sel) {
    const int x = __float_as_int(v);
    int r;
    if (ctrl_sel == 0) r = __builtin_amdgcn_update_dpp(x, x, 0xB1, 0xF, 0xF, false);
    else if (ctrl_sel == 1) r = __builtin_amdgcn_update_dpp(x, x, 0x4E, 0xF, 0xF, false);
    else if (ctrl_sel == 2) r = __builtin_amdgcn_update_dpp(x, x, 0x124, 0xF, 0xF, false);
    else r = __builtin_amdgcn_update_dpp(x, x, 0x128, 0xF, 0xF, false);
    return __int_as_float(r);
}
__device__ __forceinline__ int dpp_i(int x, int ctrl_sel) {
    if (ctrl_sel == 0) return __builtin_amdgcn_update_dpp(x, x, 0xB1, 0xF, 0xF, false);
    if (ctrl_sel == 1) return __builtin_amdgcn_update_dpp(x, x, 0x4E, 0xF, 0xF, false);
    if (ctrl_sel == 2) return __builtin_amdgcn_update_dpp(x, x, 0x124, 0xF, 0xF, false);
    return __builtin_amdgcn_update_dpp(x, x, 0x128, 0xF, 0xF, false);
}
__device__ __forceinline__ void select_wave(int t0w, const LAS float* imp, LAS int* sel, int lane) {
    const int sub = lane & 31;
#pragma unroll 1
    for (int h = 0; h < 4; ++h) {
        const int tk = 2 * h + (lane >> 5);
        const int tq = t0w + tk, cur = tq >> 6;
        float v[8];
#pragma unroll
        for (int i = 0; i < 8; ++i) { const int j = sub + 32 * i; float x = imp[tk * IMP_LD + j]; if (j == 0 || j == cur || j == cur - 1) x += 1e6f; v[i] = (j <= cur) ? x : -INFINITY; }
#pragma unroll 1
        for (int it = 0; it < 16; ++it) {
            float bv = v[0]; int bi = 0;
#pragma unroll
            for (int i = 1; i < 8; ++i) if (v[i] > bv) { bv = v[i]; bi = i; }
            float gm = bv;
#pragma unroll
            for (int c = 0; c < 4; ++c) gm = fmaxf(gm, dpp_f(gm, c));
            gm = fmaxf(gm, __shfl_xor(gm, 16));
            int cj = (bv == gm) ? sub + 32 * bi : 0x7fffffff;
#pragma unroll
            for (int c = 0; c < 4; ++c) cj = min(cj, dpp_i(cj, c));
            cj = min(cj, __shfl_xor(cj, 16));
            const bool any = gm > -INFINITY;
            if (sub == 0) sel[tk * 16 + it] = any ? cj : -1;
            if (any && (cj & 31) == sub) { const int wi = cj >> 5;
#pragma unroll
                for (int i = 0; i < 8; ++i) if (i == wi) v[i] = -INFINITY; }
        }
    }
    asm volatile("s_waitcnt lgkmcnt(0)" ::: "memory");
}

__device__ __forceinline__ void slc_wave(const MKP& p, int g, int t0w, const LAS int* sel, LAS float* oslc, int lane) {
    const int c16 = lane & 15, u = lane >> 4, ti = c16 >> 2;
    const unsigned char* kb = (const unsigned char*)p.KSLF + (size_t)g * 256 * 4096 + lane * 16;
    const unsigned char* vb = (const unsigned char*)p.VSLF + (size_t)g * 256 * 4096 + lane * 16;
#define LO64(vv_) ((long)(((unsigned long long)(vv_).y << 32) | (vv_).x))
#define HI64(vv_) ((long)(((unsigned long long)(vv_)[3] << 32) | (vv_).z))
#define FMFMA(a, b, c) __builtin_amdgcn_mfma_f32_16x16x32_fp8_fp8(a, b, c, 0, 0, 0)
#define KLOAD4(r_) do { _Pragma("unroll") for (int i_ = 0; i_ < 4; ++i_) { int b_ = sel[(tg * 4 + i_) * 16 + (r_)]; b_ = b_ < 0 ? 0 : b_; const unsigned char* kp_ = kb + (size_t)b_ * 4096; \
        _Pragma("unroll") for (int f_ = 0; f_ < 4; ++f_) kc[i_][f_] = *(const u32x4*)(kp_ + f_ * 1024); } } while (0)
#pragma unroll 1
    for (int tg = 0; tg < 2; ++tg) {
        const int tq = t0w + tg * 4 + ti;
        long qa, qb2;
        { const bf16_t* qp = p.QN + (size_t)tq * 512 + (g * 4 + (c16 & 3)) * 64 + 8 * u;
          const u32x4 r0 = *(const u32x4*)qp, r1 = *(const u32x4*)(qp + 32);
          const unsigned a0 = pk4_fp8(8.f * __uint_as_float(r0.x << 16), 8.f * __uint_as_float(r0.x & 0xffff0000u), 8.f * __uint_as_float(r0.y << 16), 8.f * __uint_as_float(r0.y & 0xffff0000u));
          const unsigned a1 = pk4_fp8(8.f * __uint_as_float(r0.z << 16), 8.f * __uint_as_float(r0.z & 0xffff0000u), 8.f * __uint_as_float(r0.w << 16), 8.f * __uint_as_float(r0.w & 0xffff0000u));
          const unsigned b0 = pk4_fp8(8.f * __uint_as_float(r1.x << 16), 8.f * __uint_as_float(r1.x & 0xffff0000u), 8.f * __uint_as_float(r1.y << 16), 8.f * __uint_as_float(r1.y & 0xffff0000u));
          const unsigned b1 = pk4_fp8(8.f * __uint_as_float(r1.z << 16), 8.f * __uint_as_float(r1.z & 0xffff0000u), 8.f * __uint_as_float(r1.w << 16), 8.f * __uint_as_float(r1.w & 0xffff0000u));
          qa = (long)(((unsigned long long)a1 << 32) | a0); qb2 = (long)(((unsigned long long)b1 << 32) | b0); }
        long q0[4], q1[4];
#pragma unroll
        for (int i = 0; i < 4; ++i) { q0[i] = (ti == i) ? qa : 0; q1[i] = (ti == i) ? qb2 : 0; }
        u32x4 kc[4][4], vf[4][4];
        KLOAD4(0);
        float m = -INFINITY, l = 0.f;
        f32x4 o[4]; o[0] = o[1] = o[2] = o[3] = (f32x4){0.f, 0.f, 0.f, 0.f};
#pragma unroll 1
        for (int r = 0; r < 16; ++r) {
#pragma unroll
            for (int i = 0; i < 4; ++i) { int b_ = sel[(tg * 4 + i) * 16 + r]; b_ = b_ < 0 ? 0 : b_; const unsigned char* vp = vb + (size_t)b_ * 4096;
#pragma unroll
                for (int dg = 0; dg < 4; ++dg) vf[i][dg] = *(const u32x4*)(vp + dg * 1024); }
            f32x4 s[4];
#pragma unroll
            for (int kg = 0; kg < 4; ++kg) { f32x4 c = (f32x4){0.f, 0.f, 0.f, 0.f};
#pragma unroll
                for (int i = 0; i < 4; ++i) { c = FMFMA(LO64(kc[i][kg]), q0[i], c); c = FMFMA(HI64(kc[i][kg]), q1[i], c); }
                s[kg] = c * 0.125f; }
            { const int rn = (r < 15) ? r + 1 : 15; KLOAD4(rn); }
            const int myblk = sel[(tg * 4 + ti) * 16 + r];
            { const int x = (myblk < 0) ? -1 : ((myblk == (tq >> 6)) ? tq - 64 * myblk - 4 * u : 64);
#pragma unroll
              for (int kg = 0; kg < 4; ++kg) { if (16 * kg > x) s[kg].x = -INFINITY; if (16 * kg + 1 > x) s[kg].y = -INFINITY; if (16 * kg + 2 > x) s[kg].z = -INFINITY; if (16 * kg + 3 > x) s[kg].w = -INFINITY; } }
            float tm = -INFINITY;
#pragma unroll
            for (int kg = 0; kg < 4; ++kg) tm = fmaxf(tm, fmaxf(fmaxf(s[kg].x, s[kg].y), fmaxf(s[kg].z, s[kg].w)));
            tm = fmaxf(tm, __shfl_xor(tm, 16)); tm = fmaxf(tm, __shfl_xor(tm, 32));
            float alpha = 1.f;
            if (tm > m) { alpha = __builtin_amdgcn_exp2f(m - tm); m = tm; }
            l *= alpha;
            float sum = 0.f;
#pragma unroll
            for (int kg = 0; kg < 4; ++kg) { s[kg].x = __builtin_amdgcn_exp2f(s[kg].x - m); s[kg].y = __builtin_amdgcn_exp2f(s[kg].y - m); s[kg].z = __builtin_amdgcn_exp2f(s[kg].z - m); s[kg].w = __builtin_amdgcn_exp2f(s[kg].w - m);
                sum += (s[kg].x + s[kg].y) + (s[kg].z + s[kg].w); }
            l += sum;
            { const float a0 = __shfl(alpha, 4 * u), a1 = __shfl(alpha, 4 * u + 1), a2 = __shfl(alpha, 4 * u + 2), a3 = __shfl(alpha, 4 * u + 3);
#pragma unroll
              for (int dg = 0; dg < 4; ++dg) { o[dg].x *= a0; o[dg].y *= a1; o[dg].z *= a2; o[dg].w *= a3; } }
#pragma unroll
            for (int ch = 0; ch < 2; ++ch) {
                const f32x4 pa_ = s[2 * ch] * 128.f, pb_ = s[2 * ch + 1] * 128.f;
                const unsigned lo_ = pk4_fp8(pa_.x, pa_.y, pa_.z, pa_.w), hi_ = pk4_fp8(pb_.x, pb_.y, pb_.z, pb_.w);
                const long pa = (long)(((unsigned long long)hi_ << 32) | lo_);
#pragma unroll
                for (int i = 0; i < 4; ++i) { const long pi = (ti == i) ? pa : 0;
#pragma unroll
                    for (int dg = 0; dg < 4; ++dg) o[dg] = FMFMA(pi, ch ? HI64(vf[i][dg]) : LO64(vf[i][dg]), o[dg]); }
            }
        }
        { float lt = l; lt += __shfl_xor(lt, 16); lt += __shfl_xor(lt, 32);
          const float il = (lt > 0.f) ? (1.f / 128.f) / lt : 0.f;
          const float i0 = __shfl(il, 4 * u), i1 = __shfl(il, 4 * u + 1), i2 = __shfl(il, 4 * u + 2), i3 = __shfl(il, 4 * u + 3);
          LAS float* op = oslc + (tg * 4 + u) * 256 + c16;
#pragma unroll
          for (int dg = 0; dg < 4; ++dg) { op[16 * dg] = o[dg].x * i0; op[64 + 16 * dg] = o[dg].y * i1; op[128 + 16 * dg] = o[dg].z * i2; op[192 + 16 * dg] = o[dg].w * i3; } }
    }
#undef KLOAD4
#undef LO64
#undef HI64
#undef FMFMA
    asm volatile("s_waitcnt lgkmcnt(0)" ::: "memory");
    {
        const int tkl = lane >> 3, cc = (lane & 7) * 32, hh = cc >> 6;
        const int tq = t0w + tkl;
        const float* gt = p.GATES + (size_t)tq * 24 + (g * 4 + hh) * 3;
        const float gc = 1.f / (1.f + __expf(-gt[0])), gs = 1.f / (1.f + __expf(-gt[1])), gw = 1.f / (1.f + __expf(-gt[2]));
        const size_t col = (size_t)tq * 512 + g * 256 + cc;
        const LAS float* os = oslc + tkl * 256 + cc;
#pragma unroll
        for (int q = 0; q < 4; ++q) {
            const u32x4 wc = *(const u32x4*)(p.OCMP + col + 8 * q), ww = *(const u32x4*)(p.OWIN + col + 8 * q);
            const f32x4 sa = *(const LAS f32x4*)(os + 8 * q), sb = *(const LAS f32x4*)(os + 8 * q + 4);
            u32x4 r;
            r.x = cvtpk(gs * sa.x + gc * __uint_as_float(wc.x << 16) + gw * __uint_as_float(ww.x << 16), gs * sa.y + gc * __uint_as_float(wc.x & 0xffff0000u) + gw * __uint_as_float(ww.x & 0xffff0000u));
            r.y = cvtpk(gs * sa.z + gc * __uint_as_float(wc.y << 16) + gw * __uint_as_float(ww.y << 16), gs * sa.w + gc * __uint_as_float(wc.y & 0xffff0000u) + gw * __uint_as_float(ww.y & 0xffff0000u));
            r.z = cvtpk(gs * sb.x + gc * __uint_as_float(wc.z << 16) + gw * __uint_as_float(ww.z << 16), gs * sb.y + gc * __uint_as_float(wc.z & 0xffff0000u) + gw * __uint_as_float(ww.z & 0xffff0000u));
            r.w = cvtpk(gs * sb.z + gc * __uint_as_float(wc.w << 16) + gw * __uint_as_float(ww.w << 16), gs * sb.w + gc * __uint_as_float(wc.w & 0xffff0000u) + gw * __uint_as_float(ww.w & 0xffff0000u));
            *(u32x4*)(p.OATT + (size_t)tq * 1024 + g * 256 + cc + 8 * q) = r;
        }
    }
}

__device__ __forceinline__ void nsa_unit(const MKP& p, char* shm, int g, int tile) {
    int tid_ = threadIdx.x; asm volatile("" : "+v"(tid_));
    const int tid = tid_, lane = tid & 63, r32 = lane & 31; const int wid = __builtin_amdgcn_readfirstlane(tid >> 6);
    const int t0 = tile * 64;
    {   att::UnitArgs A;
        A.qrow = p.QN + (size_t)(t0 + 8 * wid + (r32 >> 2)) * 512 + (g * 4 + (r32 & 3)) * 64;
        A.K = p.KV6 + (size_t)(4 * 2 + g) * S_ * 64; A.V = p.KV6 + (size_t)(5 * 2 + g) * S_ * 64; A.kvpitch = 64; A.vpitch = 64;
        A.obase = p.OWIN + (size_t)t0 * 512 + g * 256; A.opitch = 512;
        A.qtok = 8 * wid + (r32 >> 2); A.abase = tile;
        const int real = (tile + 1 < 9) ? tile + 1 : 9; int nt = (real + 1) & ~1; if (nt < 4) nt = 4;
        A.nsteps = nt; A.bias = nullptr;
        att::attn_unit<att::MODE_WIN, true, 8, 64>(A, shm);
    }
    LAS unsigned char* l3 = (LAS unsigned char*)shm;
    LAS float* imp = (LAS float*)(l3 + wid * (8 * IMP_LD * 4));
    LAS int* sel = (LAS int*)(l3 + 8 * (8 * IMP_LD * 4) + wid * 512);
    LAS unsigned char* stg = l3 + 8 * (8 * IMP_LD * 4) + 8 * 512 + wid * 4096;
    const int t0w = t0 + 8 * wid;
    { int ln = lane; asm volatile("" : "+v"(ln)); cmp_wave(p, g, t0w, imp, stg, ln); }
    asm volatile("s_waitcnt vmcnt(0) lgkmcnt(0)" ::: "memory");
    { int ln = lane; asm volatile("" : "+v"(ln)); select_wave(t0w, imp, sel, ln); }
    { int ln = lane; asm volatile("" : "+v"(ln)); slc_wave(p, g, t0w, sel, imp, ln); }
    asm volatile("s_waitcnt vmcnt(0) lgkmcnt(0)\n\ts_barrier" ::: "memory");
}
#undef NMFMA32
#undef NMFMA16
#undef RLF
}

__device__ __forceinline__ void phase_prologue(const MKP& p, LAS unsigned char* lds) {
    const int tid = threadIdx.x, lane = tid & 63, wave = tid >> 6;
    const int gw = blockIdx.x * 8 + wave, NGW = gridDim.x * 8;
    LAS float* scr = (LAS float*)(lds + wave * 16384);
    for (int it = gw; it < 8 * 192; it += NGW) {
        const int kc = it / 192, ch = it % 192, idx = ch * 64 + lane, l = idx / 6144, n = idx % 6144;
        const float* w = p.in[5] + (size_t)l * 1024 * 6144 + n;
        const float* c = p.in[1];
        float acc = 0.f;
#pragma unroll 8
        for (int k = kc * 128; k < kc * 128 + 128; ++k) { const float cv = c[k]; acc += (cv / (1.f + __expf(-cv))) * w[(size_t)k * 6144]; }
        p.modpart[kc * 12288 + idx] = acc;
    }
    if (blockIdx.x == 1 && tid < 128) p.gcnt[tid * GSTR] = 0;
    if (blockIdx.x == 0 && tid < 96 + 48 + 64) {
        BlkDesc d; d.dst = nullptr; d.gain = nullptr; d.pitch = 0; d.flags = 4; d.scale = 1.f; d.csoff = 0;
        if (tid < 96) {
            const int blk = (tid >> 3) * 4 + ((tid >> 2) & 1) * 2 + ((tid >> 1) & 1);
            d.flags = 0;
            if (blk < 8) { d.dst = p.QN + blk * 64; d.pitch = 512; d.gain = p.in[9]; d.flags = 1; d.scale = C2Q; }
            else if (blk < 20) { const int j = (blk - 8) >> 1, g = (blk - 8) & 1; d.dst = p.KV6 + (size_t)(j * 2 + g) * S_ * 64; d.pitch = 64;
                d.gain = (j == 2 || j == 4) ? p.in[10] : nullptr; d.flags = (j == 0 || j == 2 || j == 4) ? 1 : 0; }
            else if (blk < 28) { d.dst = p.FQ + (blk - 20) * 64; d.pitch = 512; d.gain = p.in[13]; d.scale = C2Q; }
            else if (blk < 36) { d.dst = p.FK + (blk - 28) * 64; d.pitch = 512; d.gain = p.in[14]; }
            else if (blk < 44) { d.dst = p.FV + (blk - 36) * 64; d.pitch = 512; }
            else if (blk == 44) d.flags = 2;
            else d.flags = 4;
            p.desc0[tid] = d;
        } else if (tid < 96 + 48) {
            const int e = tid - 96, pn = e >> 3, bj = (e >> 2) & 1, wc = e & 3;
            if (pn < 4) { const int h = pn * 4 + bj * 2 + (wc >> 1); d.dst = p.Q96 + (size_t)h * S_ * 96; d.pitch = 96; d.gain = p.in[21]; d.flags = 0; d.scale = C2M; }
            else { const int h = (pn - 4) * 8 + bj * 4 + wc; d.dst = p.Q96 + (size_t)h * S_ * 96 + 64; d.pitch = 96; d.gain = p.in[23]; d.flags = 1 | 8; d.scale = C2M; d.csoff = 32; }
            p.desc_uq[e] = d;
        } else {
            const int e = tid - 144, pn = e >> 3, bj = (e >> 2) & 1, wc = e & 3;
            const int h = (pn & 3) * 4 + bj * 2 + (wc >> 1);
            if (pn < 4) { d.dst = p.K96 + (size_t)h * S_ * 96; d.pitch = 96; d.gain = p.in[22]; d.flags = 32; }
            else { d.dst = p.V1 + (size_t)h * S_ * 64; d.pitch = 64; d.gain = nullptr; d.flags = 64; }
            p.desc_ukv[e] = d;
        }
    }
    if (blockIdx.x == 2 || blockIdx.x == 3) {
        const int kv = blockIdx.x - 2, e = tid & 63, sl = tid >> 6;
        const float* w = p.in[12] + (size_t)kv * 2048 * 64 + e; const float* pe = p.in[11] + kv * 2048;
        float b = 0.f;
#pragma unroll 8
        for (int k = sl * 256; k < sl * 256 + 256; ++k) b += pe[k] * w[(size_t)k * 64];
        LAS float* red = (LAS float*)(lds + 140000);
        red[tid] = b;
        __syncthreads();
        if (tid < 64) { float a = 0.f;
#pragma unroll
            for (int q = 0; q < 8; ++q) a += red[q * 64 + tid];
            p.CBIAS[kv * 64 + tid] = a; }
    }
    for (int idx = blockIdx.x * MK_THREADS + tid; idx < S_ * 48; idx += gridDim.x * MK_THREADS) {
        const int t = idx / 48, i = idx % 48;
        const double ex = (i < 32) ? (double)(2 * i) / 64.0 : (double)(2 * (i - 32)) / 32.0;
        const double a = (double)p.pos[t] * exp(-ex * 9.210340371976184);
        const double r = a - rint(a * 0.15915494309189535) * 6.283185307179586;
        const float rf = (float)r;
        p.cosT[idx] = cosf(rf); p.sinT[idx] = sinf(rf);
    }
    for (int it = gw; it < 2 * 32 * 2; it += NGW) { const int kv = it >> 6, r = it & 63; tr_item(p.in[12] + (size_t)kv * 2048 * 64, 64, 2048, p.WcT + (size_t)kv * 64 * 2048, scr, r >> 1, r & 1, lane, MapId(), nullptr); }
    constexpr int I_IN0 = 16 * 96, I_OUT0 = 16 * 32, I_IN1 = 16 * 24, I_UQ = 6 * 48, I_UKV = 4 * 64, I_OUT1 = 16 * 32;
    for (int it = gw; it < I_IN0 + I_OUT0 + I_IN1 + I_UQ + I_UKV + I_OUT1; it += NGW) {
        int r = it;
        if (r < I_IN0) { tr_item(p.in[7], HYIN, 1024, p.W_in0t, scr, r / 96, r % 96, lane, MapIn0(), nullptr); continue; } r -= I_IN0;
        if (r < I_OUT0) { tr_item(p.in[15], 1024, 1024, p.W_out0t, scr, r / 32, r % 32, lane, MapId(), nullptr); continue; } r -= I_OUT0;
        if (r < I_IN1) { tr_item(p.in[16], 672, 1024, p.W_in1t, scr, r / 24, r % 24, lane, MapIn1(), nullptr); continue; } r -= I_IN1;
        if (r < I_UQ) { tr_item(p.in[19], 1536, 384, p.W_uqt, scr, r / 48, r % 48, lane, MapUq(), p.in[17]); continue; } r -= I_UQ;
        if (r < I_UKV) { tr_item(p.in[20], 2048, 256, p.W_ukvt, scr, r / 64, r % 64, lane, MapUkv(), p.in[18]); continue; } r -= I_UKV;
        tr_item(p.in[25], 1024, 1024, p.W_out1t, scr, r / 32, r % 32, lane, MapId(), nullptr);
    }
}

template <bool COMB>
__device__ __forceinline__ void phase_norm(const MKP& p, LAS unsigned char* lds, const float* x, const float* gw_, int layer, int sc_idx, int sh_idx, bool finalize_mod) {
    const int tid = threadIdx.x, lane = tid & 63, wave = tid >> 6;
    LAS float* msc = (LAS float*)(lds + LDS_MOD);
    LAS float* msh = msc + 1024;
    const float* b_ada = p.in[6];
    if (finalize_mod) {
        for (int i = tid; i < 2048; i += MK_THREADS) {
            const int idx = layer * 6144 + ((i < 1024) ? sc_idx * 1024 + i : sh_idx * 1024 + (i - 1024));
            float a = b_ada[idx];
#pragma unroll
            for (int kc = 0; kc < 8; ++kc) a += p.modpart[kc * 12288 + idx];
            msc[i] = a;
        }
        for (int idx = blockIdx.x * MK_THREADS + tid; idx < 12288; idx += gridDim.x * MK_THREADS) {
            float a = b_ada[idx];
#pragma unroll
            for (int kc = 0; kc < 8; ++kc) a += p.modpart[kc * 12288 + idx];
            p.mod[idx] = a;
        }
    } else {
        for (int i = tid; i < 2048; i += MK_THREADS)
            msc[i] = p.mod[layer * 6144 + ((i < 1024) ? sc_idx * 1024 + i : sh_idx * 1024 + (i - 1024))];
    }
    __syncthreads();
    const int gwv = blockIdx.x * 8 + wave, NGW = gridDim.x * 8;
    f32x4 g2v[4];
#pragma unroll
    for (int j = 0; j < 4; ++j) g2v[j] = COMB ? *(const f32x4*)(p.mod + (layer - 1) * 6144 + 5 * 1024 + 256 * j + 4 * lane) * (1.f / 16.f) : (f32x4){0.f, 0.f, 0.f, 0.f};
    for (int m = gwv; m < S_; m += NGW) {
        const f32x4* xr = (const f32x4*)(x + (size_t)m * D_) + lane;
        f32x4 v[4]; float s = 0.f;
#pragma unroll
        for (int j = 0; j < 4; ++j) v[j] = xr[64 * j];
        if (COMB) {
            int yb[4][8]; u32x2 sw[4];
            const f32x4 ewa = *(const f32x4*)(p.ew + (size_t)m * 8), ewb = *(const f32x4*)(p.ew + (size_t)m * 8 + 4);
#pragma unroll
            for (int j = 0; j < 4; ++j)
#pragma unroll
                for (int k = 0; k < 8; ++k) yb[j][k] = *((const int*)((const char*)p.YBUF + ((size_t)m * 8 + k) * 1024) + lane + 64 * j);
#pragma unroll
            for (int j = 0; j < 4; ++j) sw[j] = *((const u32x2*)(p.YS + (size_t)m * 1024) + lane + 64 * j);
            asm volatile("" ::: "memory");
#pragma unroll
            for (int j = 0; j < 4; ++j) {
                f32x4 ys = (f32x4){0.f, 0.f, 0.f, 0.f};
#pragma unroll
                for (int k = 0; k < 8; ++k) {
                    const f32x2 lo = __builtin_amdgcn_cvt_pk_f32_fp8(yb[j][k], false), hi = __builtin_amdgcn_cvt_pk_f32_fp8(yb[j][k], true);
                    const float wk = (k < 4) ? ewa[k] : ewb[k - 4];
                    ys.x += wk * lo.x; ys.y += wk * lo.y; ys.z += wk * hi.x; ys.w += wk * hi.y;
                }
                ys.x += 16.f * __uint_as_float(sw[j].x << 16); ys.y += 16.f * __uint_as_float(sw[j].x & 0xffff0000u); ys.z += 16.f * __uint_as_float(sw[j].y << 16); ys.w += 16.f * __uint_as_float(sw[j].y & 0xffff0000u);
                v[j] = v[j] + g2v[j] * ys;
            }
#pragma unroll
            for (int j = 0; j < 4; ++j) ((f32x4*)(p.out + (size_t)m * D_) + lane)[64 * j] = v[j];
        }
#pragma unroll
        for (int j = 0; j < 4; ++j) s += (v[j].x * v[j].x + v[j].y * v[j].y) + (v[j].z * v[j].z + v[j].w * v[j].w);
        s = wsum(s);
        const float rstd = rsqrtf(s * (1.f / D_) + EPSF);
        u32x2* o8 = (u32x2*)(p.XN + (size_t)m * D_) + lane;
#pragma unroll
        for (int j = 0; j < 4; ++j) {
            const int c0 = 256 * j + 4 * lane;
            const f32x4 g = *(const f32x4*)(gw_ + c0);
            const f32x4 sc = *(const LAS f32x4*)(msc + c0), sh = *(const LAS f32x4*)(msh + c0);
            const f32x4 y = v[j] * rstd * g * (sc + 1.f) + sh;
            u32x2 w; w.x = cvtpk(y.x, y.y); w.y = cvtpk(y.z, y.w);
            o8[64 * j] = w;
        }
    }
}

struct EpiResid {
    static constexpr bool PERM = true;
    static constexpr bool PRE = false;
    const float* xin; float* out; const float* gate;
    __device__ __forceinline__ void operator()(const f32x4 (&acc)[2][2][4][2], const pg::Unit& u, int wid, int wr, int wc, int fr_, int fq_) const {
        int fr = fr_, fq = fq_; asm volatile("" : "+v"(fr), "+v"(fq));
        const int col0 = u.pn * 256 + wc * 32 + 8 * fq;
        f32x4 g[2][2];
#pragma unroll
        for (int bj = 0; bj < 2; ++bj)
#pragma unroll
            for (int n = 0; n < 2; ++n) g[bj][n] = *(const f32x4*)(gate + col0 + bj * 128 + n * 4);
#pragma unroll
        for (int ai = 0; ai < 2; ++ai)
#pragma unroll
            for (int m = 0; m < 4; ++m) {
                const size_t off = (size_t)(u.pm * 256 + ai * 128 + wr * 64 + m * 16 + fr) * 1024 + col0;
#pragma unroll
                for (int bj = 0; bj < 2; ++bj)
#pragma unroll
                    for (int n = 0; n < 2; ++n) {
                        const f32x4 xv = *(const f32x4*)(xin + off + bj * 128 + n * 4);
                        *(f32x4*)(out + off + bj * 128 + n * 4) = xv + g[bj][n] * acc[ai][bj][m][n];
                    }
                asm volatile("" ::: "memory");
            }
    }
};

struct EpiHeads {
    static constexpr bool PERM = false;
    static constexpr bool PRE = false;
    const BlkDesc* tab; const float* cosT; const float* sinT; float* GATES; float* LOGF; LAS float* X;
    __device__ __forceinline__ void operator()(const f32x4 (&acc)[2][2][4][2], const pg::Unit& u, int wid, int wr, int wc, int fr_, int fq_) const {
        int fr = fr_, fq = fq_; asm volatile("" : "+v"(fr), "+v"(fq));
        const int w1 = wc & 1;
#pragma unroll
        for (int ai = 0; ai < 2; ++ai)
#pragma unroll
            for (int bj = 0; bj < 2; ++bj)
#pragma unroll
                for (int m = 0; m < 4; ++m) {
                    const f32x4 a = acc[ai][bj][m][0], b = acc[ai][bj][m][1];
                    float s = (a.x * a.x + a.y * a.y) + (a.z * a.z + a.w * a.w) + (b.x * b.x + b.y * b.y) + (b.z * b.z + b.w * b.w);
                    s += __shfl_xor(s, 16); s += __shfl_xor(s, 32);
                    if (fq == 0) X[wid * 256 + ((ai * 2 + bj) * 4 + m) * 16 + fr] = s;
                }
        asm volatile("s_waitcnt lgkmcnt(0)" ::: "memory"); __builtin_amdgcn_s_barrier(); asm volatile("" ::: "memory");
#pragma unroll
        for (int bj = 0; bj < 2; ++bj) {
            const BlkDesc d = tab[8 * u.pn + 4 * bj + wc];
            const int row0 = u.pm * 256 + wr * 64 + fr;
            if (d.flags & 4) continue;
            if (d.flags & 2) {
                if (w1 == 0) {
#pragma unroll
                    for (int ai = 0; ai < 2; ++ai)
#pragma unroll
                        for (int m = 0; m < 4; ++m) {
                            const int row = row0 + ai * 128 + m * 16;
#pragma unroll
                            for (int n = 0; n < 2; ++n) {
                                const f32x4 v = acc[ai][bj][m][n];
                                const int pc = 16 * n + 4 * fq;
                                if (pc < 24) *(f32x4*)(GATES + (size_t)row * 24 + pc) = v;
                                else *(f32x4*)(LOGF + (size_t)row * 8 + (pc - 24)) = v;
                            }
                            asm volatile("" ::: "memory");
                        }
                }
                continue;
            }
            const bool half = (d.flags & 8) != 0, has_gain = d.gain != nullptr, rope = (d.flags & 1) != 0;
            const int d0 = half ? 4 * fq : 16 * w1 + 4 * fq;
            const int dn1 = half ? 16 : 32;
            const float invn = half ? (1.f / 32.f) : (1.f / 64.f);
            const GAS float* gp = (const GAS float*)(has_gain ? d.gain : cosT);
            f32x4 g0 = *(const GAS f32x4*)(gp + d0), g1 = *(const GAS f32x4*)(gp + dn1 + d0);
            if (!has_gain) { g0 = (f32x4){1.f, 1.f, 1.f, 1.f}; g1 = g0; }
            g0 = g0 * d.scale; g1 = g1 * d.scale;
            const int cso = d.csoff + d0;
#pragma unroll
            for (int ai = 0; ai < 2; ++ai)
#pragma unroll
                for (int m = 0; m < 4; ++m) {
                    const int row = row0 + ai * 128 + m * 16;
                    const int xi = ((ai * 2 + bj) * 4 + m) * 16 + fr;
                    float ssq = X[wid * 256 + xi]; const float ssp = X[(wid ^ 1) * 256 + xi];
                    if (!half) ssq += ssp;
                    const float rs = has_gain ? rsqrtf(ssq * invn + EPSF) : 1.f;
                    f32x4 x1 = acc[ai][bj][m][0] * rs * g0, x2 = acc[ai][bj][m][1] * rs * g1;
                    f32x4 c = *(const f32x4*)(cosT + (size_t)row * 48 + cso), sn = *(const f32x4*)(sinT + (size_t)row * 48 + cso);
                    if (!rope) { c = (f32x4){1.f, 1.f, 1.f, 1.f}; sn = (f32x4){0.f, 0.f, 0.f, 0.f}; }
                    const f32x4 o1 = x1 * c - x2 * sn, o2 = x2 * c + x1 * sn;
                    u32x2 wa, wb; wa.x = cvtpk(o1.x, o1.y); wa.y = cvtpk(o1.z, o1.w); wb.x = cvtpk(o2.x, o2.y); wb.y = cvtpk(o2.z, o2.w);
                    if (d.flags & 32) {
                        GAS bf16_t* tb = (GAS bf16_t*)d.dst + (size_t)(row >> 6) * 6144 + (row & 63) * 8 + (d0 & 7);
                        *(GAS u32x2*)(tb + (d0 >> 3) * 512) = wa; *(GAS u32x2*)(tb + ((dn1 + d0) >> 3) * 512) = wb;
                    } else if (d.flags & 64) {
                        GAS bf16_t* tb = (GAS bf16_t*)d.dst + (size_t)(row >> 6) * 4096 + ((row >> 4) & 3) * 512 + (row & 15) * 32 + (d0 & 7);
                        *(GAS u32x2*)(tb + (d0 >> 5) * 2048 + ((d0 >> 3) & 3) * 8) = wa; *(GAS u32x2*)(tb + ((dn1 + d0) >> 5) * 2048 + (((dn1 + d0) >> 3) & 3) * 8) = wb;
                    } else {
                        GAS bf16_t* dr = (GAS bf16_t*)d.dst + (size_t)row * d.pitch + d0;
                        *(GAS u32x2*)dr = wa; *(GAS u32x2*)(dr + dn1) = wb;
                    }
                    asm volatile("" ::: "memory");
                }
        }
    }
};

struct EpiPlain {
    static constexpr bool PERM = true;
    static constexpr bool PRE = false;
    bf16_t* O; int ldc;
    __device__ __forceinline__ void operator()(const f32x4 (&acc)[2][2][4][2], const pg::Unit& u, int wid, int wr, int wc, int fr_, int fq_) const {
        int fr = fr_, fq = fq_; asm volatile("" : "+v"(fr), "+v"(fq));
        const int col0 = u.pn * 256 + wc * 32 + 8 * fq;
#pragma unroll
        for (int ai = 0; ai < 2; ++ai)
#pragma unroll
            for (int m = 0; m < 4; ++m) {
                bf16_t* rp = O + (size_t)(u.pm * 256 + ai * 128 + wr * 64 + m * 16 + fr) * ldc + col0;
#pragma unroll
                for (int bj = 0; bj < 2; ++bj) { const f32x4 a = acc[ai][bj][m][0], b = acc[ai][bj][m][1];
                    u32x4 w; w.x = cvtpk(a.x, a.y); w.y = cvtpk(a.z, a.w); w.z = cvtpk(b.x, b.y); w.w = cvtpk(b.z, b.w); *(u32x4*)(rp + bj * 128) = w; }
            }
    }
};

__device__ __forceinline__ void phase_post1a(const MKP& p) {
    int tid_ = threadIdx.x; asm volatile("" : "+v"(tid_));
    const int tid = tid_, lane = tid & 63, wave = tid >> 6;
    const int gwv = blockIdx.x * 8 + wave, NGW = gridDim.x * 8;
    for (int t = gwv; t < S_; t += NGW) {
        const u32x2* row = (const u32x2*)(p.P1 + (size_t)t * 768);
        f32x4 v[3]; float sq = 0.f, skv = 0.f, skr = 0.f;
#pragma unroll
        for (int j = 0; j < 3; ++j) {
            const int g = lane + 64 * j;
            f32x4 x = (f32x4){0.f, 0.f, 0.f, 0.f};
            if (g < 168) { const u32x2 w = row[g]; x.x = __uint_as_float(w.x << 16); x.y = __uint_as_float(w.x & 0xffff0000u); x.z = __uint_as_float(w.y << 16); x.w = __uint_as_float(w.y & 0xffff0000u); }
            v[j] = x;
            const float s = (x.x * x.x + x.y * x.y) + (x.z * x.z + x.w * x.w);
            if (g < 96) sq += s; else if (g < 160) skv += s; else skr += s;
        }
        sq = wsum(sq); skv = wsum(skv); skr = wsum(skr);
        const float rq = rsqrtf(sq * (1.f / 384.f) + EPSF), rkv = rsqrtf(skv * (1.f / 256.f) + EPSF), rkr = rsqrtf(skr * (1.f / 32.f) + EPSF);
#pragma unroll
        for (int j = 0; j < 3; ++j) {
            const int g = lane + 64 * j;
            if (g < 96) { const f32x4 y = v[j] * rq; u32x2 w; w.x = cvtpk(y.x, y.y); w.y = cvtpk(y.z, y.w); *(u32x2*)(p.CQN + (size_t)t * 384 + 4 * g) = w; }
            else if (g < 160) { const f32x4 y = v[j] * rkv; u32x2 w; w.x = cvtpk(y.x, y.y); w.y = cvtpk(y.z, y.w); *(u32x2*)(p.CKVN + (size_t)t * 256 + 4 * (g - 96)) = w; }
        }
        {
            const int dl = (lane - 32) & 7;
            const int dd = 4 * dl;
            const int fi = 4 * (dl & 3);
            f32x4 x = v[2] * rkr;
            const f32x4 gn = *(const f32x4*)(p.in[24] + (dd & 31));
            x = x * gn;
            f32x4 o; o.x = __shfl_xor(x.x, 4); o.y = __shfl_xor(x.y, 4); o.z = __shfl_xor(x.z, 4); o.w = __shfl_xor(x.w, 4);
            const f32x4 c = *(const f32x4*)(p.cosT + (size_t)t * 48 + 32 + fi), sn = *(const f32x4*)(p.sinT + (size_t)t * 48 + 32 + fi);
            const f32x4 y = (dl < 4) ? (x * c - o * sn) : (x * c + o * sn);
            if (lane >= 32 && lane < 40) {
                u32x2 w; w.x = cvtpk(y.x, y.y); w.y = cvtpk(y.z, y.w);
#pragma unroll
                for (int h = 0; h < 16; ++h) *(u32x2*)(p.K96 + (size_t)h * S_ * 96 + (size_t)(t >> 6) * 6144 + (8 + (dd >> 3)) * 512 + (t & 63) * 8 + (dd & 7)) = w;
            }
        }
    }
}

__device__ __forceinline__ void mla_unit(const MKP& p, char* shm, int h, int qb) {
    int tid_ = threadIdx.x; asm volatile("" : "+v"(tid_));
    const int tid = tid_, lane = tid & 63, r32 = lane & 31; const int wid = __builtin_amdgcn_readfirstlane(tid >> 6);
    const int q0 = qb * 256;
    att::UnitArgs A;
    A.qrow = p.Q96 + ((size_t)h * S_ + q0 + 32 * wid + r32) * 96;
    A.K = p.K96 + (size_t)h * S_ * 96; A.kvpitch = 96; A.V = p.V1 + (size_t)h * S_ * 64; A.vpitch = 64;
    A.obase = p.OATT + (size_t)q0 * 1024 + h * 64; A.opitch = 1024;
    A.qtok = 32 * wid + r32; A.abase = 4 * qb; A.nsteps = 4 * qb + 4; A.bias = nullptr;
    att::attn_unit<att::MODE_CAUSAL, false, 8, 96, true>(A, shm);
}
__device__ __forceinline__ void phase_mla(const MKP& p, char* shm) {
    const int G = gridDim.x, bx = blockIdx.x;
    const int vcu = (G % 8 == 0) ? (bx % 8) * (G / 8) + bx / 8 : bx;
    for (int u = vcu; u < 256; u += G) {
        const int h = u >> 4, s = u & 15;
#pragma unroll 1
        for (int rep = 0; rep < 4; ++rep) mla_unit(p, shm, h, rep == 0 ? s : rep == 1 ? 31 - s : rep == 2 ? 32 + s : 63 - s);
    }
}

__device__ __forceinline__ void phase_scan(const MKP& p, LAS unsigned char* lds) {
    constexpr int NSB = 64;
    if (blockIdx.x >= NSB) {
        int tid_ = threadIdx.x; asm volatile("" : "+v"(tid_));
        const int lane = tid_ & 63, wave = tid_ >> 6;
        const int sb = blockIdx.x - NSB, NSBK = gridDim.x - NSB;
        LAS float* scr = (LAS float*)(lds + 65536 + wave * 256);
        for (int bj = sb; bj < 64; bj += NSBK) nsa::compress_job(p, scr, (LAS float*)(lds + (wave >> 2) * 32768) + (wave & 3) * 2048, 2 * bj + (wave >> 2), wave & 3, lane);
        for (int j = ((sb + NSBK - 64) % NSBK) * 8 + wave; j < 512; j += NSBK * 8) nsa::slcfrag_job(p, j, lane);
        return;
    }
    const int h = blockIdx.x >> 3, seg = blockIdx.x & 7, tid = threadIdx.x;
    LAS double* part = (LAS double*)lds;
    const float fb = p.in[8][h];
    double own[4], s = 0.0, pre = 0.0;
#pragma unroll
    for (int i = 0; i < 4; ++i) { own[i] = (double)logsigmf(p.LOGF[(size_t)(seg * 2048 + tid * 4 + i) * 8 + h] + fb); s += own[i]; }
    for (int i = tid; i < seg * 2048; i += MK_THREADS) pre += (double)logsigmf(p.LOGF[(size_t)i * 8 + h] + fb);
    part[tid] = s; part[512 + tid] = pre;
    __syncthreads();
    for (int o = 1; o < MK_THREADS; o <<= 1) {
        const double v = (tid >= o) ? part[tid - o] : 0.0, w = (tid >= o) ? part[512 + tid - o] : 0.0;
        __syncthreads();
        part[tid] += v; part[512 + tid] += w;
        __syncthreads();
    }
    double a = part[512 + MK_THREADS - 1] + ((tid > 0) ? part[tid - 1] : 0.0);
#pragma unroll
    for (int i = 0; i < 4; ++i) { a += own[i]; p.CUMB[(size_t)h * S_ + seg * 2048 + tid * 4 + i] = (float)(a * 1.4426950408889634); }
}

__device__ __forceinline__ void fox_unit(const MKP& p, char* shm, int h, int qb) {
    int tid_ = threadIdx.x; asm volatile("" : "+v"(tid_));
    const int tid = tid_, lane = tid & 63, r32 = lane & 31; const int wid = __builtin_amdgcn_readfirstlane(tid >> 6);
    const int q0 = qb * 256, abase = 4 * qb;
    const float* cb = p.CUMB + (size_t)h * S_;
    LAS float* bias = (LAS float*)(LAS unsigned char*)(shm + att::LDS_BIAS);
    LAS int* cnt = (LAS int*)(LAS unsigned char*)(shm + att::Geo<64>::LDS_WS);
    float gq = 0.f, gk = 0.f;
    for (int i = 0; i < 64; ++i) { gq = fmaxf(gq, fabsf(p.in[13][i])); gk = fmaxf(gk, fabsf(p.in[14][i])); }
    const float TH = 150.f + 2.f * (64.f * gq * gk * C2Q * 1.05f);
    const float c0 = cb[q0], cref = cb[q0 + 255];
    const bool skip = (tid < abase) && (cb[64 * tid + 63] - c0 > TH);
    const unsigned long long bal = __ballot(skip);
    if (lane == 0) cnt[wid] = __popcll(bal);
    __syncthreads();
    int alo = 0;
#pragma unroll
    for (int w = 0; w < 8; ++w) alo += cnt[w];
    int NT = abase + 4 - alo;
    if (NT & 1) { alo -= 1; NT += 1; }
    for (int i = tid; i < NT * 64; i += MK_THREADS) bias[i] = cref - cb[64 * alo + i];
    __syncthreads();
    att::UnitArgs A;
    A.qrow = p.FQ + (size_t)(q0 + 32 * wid + r32) * 512 + h * 64;
    A.K = p.FK + h * 64; A.V = p.FV + h * 64; A.kvpitch = 512; A.vpitch = 512;
    A.obase = p.OATT + (size_t)q0 * 1024 + 512 + h * 64; A.opitch = 1024;
    A.qtok = 32 * wid + r32; A.abase = abase; A.nsteps = NT; A.bias = bias;
    att::attn_unit<att::MODE_FOX, false, 8, 64>(A, shm);
}
__device__ __forceinline__ void phase_fox(const MKP& p, char* shm, int part = 3) {
    const int G = gridDim.x, bx = blockIdx.x;
    const int vcu = (G % 8 == 0) ? (bx % 8) * (G / 8) + bx / 8 : bx;
    if (part & 1) for (int u = vcu; u < 256; u += G) {
        const int h = u >> 5, s = u & 31;
#pragma unroll 1
        for (int rep = 0; rep < 2; ++rep) fox_unit(p, shm, h, rep ? 63 - s : s);
    }
    if (part & 2) for (int u = vcu; u < 256; u += G) {
#pragma unroll 1
        for (int rep = 0; rep < 2; ++rep) nsa::nsa_unit(p, shm, rep, rep ? 255 - u : u);
    }
}


struct MapOff { int off; __device__ __forceinline__ int operator()(int nn) const { return off + (nn & 31); } };
__device__ __forceinline__ void phase_moe_weights(const MKP& p, LAS unsigned char* lds, int layer) {
    int tid_ = threadIdx.x; asm volatile("" : "+v"(tid_));
    const int tid = tid_, lane = tid & 63, wave = tid >> 6;
    const int gw = blockIdx.x * 8 + wave, NGW = gridDim.x * 8;
    LAS float* scr = (LAS float*)(lds + wave * 16384);
    constexpr int IG = 16 * 16, ID = 4 * 32, IE = IG + ID;
    for (int it = gw; it < 65 * IE; it += NGW) {
        const int e = it / IE; int r = it % IE;
        if (r < IG) {
            const int kb = r / 16, nb = r % 16;
            const int n0 = nb * 32, up = (n0 >> 7) & 1, f0 = (n0 >> 8) * 128 + (n0 & 127);
            const float* W = (e < 64) ? ((up ? p.in[29] : p.in[28]) + ((size_t)layer * 64 + e) * 1024 * 256) : ((up ? p.in[32] : p.in[31]) + (size_t)layer * 1024 * 256);
            MapOff mo{f0};
            tr_item(W, 256, 1024, p.Wgu + (size_t)e * 512 * 1024, scr, kb, nb, lane, mo, nullptr);
        } else {
            r -= IG; const int kb = r / 32, nb = r % 32;
            const float* W = (e < 64) ? (p.in[30] + ((size_t)layer * 64 + e) * 256 * 1024) : (p.in[33] + (size_t)layer * 256 * 1024);
            tr_item(W, 1024, 256, p.Wd + (size_t)e * 1024 * 256, scr, kb, nb, lane, MapId(), nullptr);
        }
    }
}

template <bool DRY>
__device__ __forceinline__ void phase_moe_route(const MKP& p, LAS unsigned char* lds, int layer) {
    int tid_ = threadIdx.x; asm volatile("" : "+v"(tid_));
    const int tid = tid_, lane = tid & 63, wave = tid >> 6;
    LAS float* msc = (LAS float*)(lds + LDS_MOD);
    LAS float* msh = msc + 1024;
    LAS float* hrow = (LAS float*)lds;
    LAS int* cntl = (LAS int*)(lds + LDS_X);
    LAS int* basel = cntl + 64;
    const float* gnorm = p.in[4] + layer * 1024;
    const float* wr = p.in[26] + (size_t)layer * 1024 * 64;
    const float rb = p.in[27][layer * 64 + lane];
    for (int i = tid; i < 2048; i += MK_THREADS) msc[i] = p.mod[layer * 6144 + ((i < 1024) ? 4 * 1024 + i : 3 * 1024 + (i - 1024))];
    __syncthreads();
    for (int batch = blockIdx.x; batch < S_ / 32; batch += gridDim.x) {
        if (tid < 64) cntl[tid] = 0;
        {
            f32x4 v[4][4];
#pragma unroll
            for (int i = 0; i < 4; ++i) {
                const f32x4* xr = (const f32x4*)(p.out + (size_t)(batch * 32 + wave * 4 + i) * D_) + lane;
#pragma unroll
                for (int j = 0; j < 4; ++j) v[i][j] = xr[64 * j];
            }
#pragma unroll
            for (int i = 0; i < 4; ++i) {
                const int t = batch * 32 + wave * 4 + i;
                float s = 0.f;
#pragma unroll
                for (int j = 0; j < 4; ++j) s += (v[i][j].x * v[i][j].x + v[i][j].y * v[i][j].y) + (v[i][j].z * v[i][j].z + v[i][j].w * v[i][j].w);
                s = wsum(s);
                const float rstd = rsqrtf(s * (1.f / D_) + EPSF);
                u32x2* o8 = (u32x2*)(p.XN + (size_t)t * D_) + lane;
                LAS f32x4* hr = (LAS f32x4*)(hrow + (wave * 4 + i) * 1024);
#pragma unroll
                for (int j = 0; j < 4; ++j) {
                    const int c0 = 256 * j + 4 * lane;
                    const f32x4 g = *(const f32x4*)(gnorm + c0);
                    const f32x4 sc = *(const LAS f32x4*)(msc + c0), sh = *(const LAS f32x4*)(msh + c0);
                    const f32x4 y = v[i][j] * rstd * g * (sc + 1.f) + sh;
                    u32x2 w; w.x = cvtpk(y.x, y.y); w.y = cvtpk(y.z, y.w);
                    o8[64 * j] = w; hr[(64 * j + lane) ^ ((wave * 4 + i) & 15)] = y;
                }
            }
        }
        __syncthreads();
        float acc0, acc1, acc2, acc3;
        {
            typedef float f32x16 __attribute__((ext_vector_type(16)));
            f32x16 accA, accB;
#pragma unroll
            for (int r = 0; r < 16; ++r) { accA[r] = 0.f; accB[r] = 0.f; }
            const int r32 = lane & 31, hh = lane >> 5;
            const float* wk = wr + (size_t)(wave * 128 + 4 * hh) * 64 + r32;
            const LAS float* hk = hrow + r32 * 1024;
            float bn[8];
#pragma unroll
            for (int j = 0; j < 4; ++j) { bn[j] = wk[j * 64]; bn[4 + j] = wk[j * 64 + 32]; }
#pragma unroll 1
            for (int g = 0; g < 16; ++g) {
                float b[8];
#pragma unroll
                for (int j = 0; j < 8; ++j) b[j] = bn[j];
                const int gn = (g + 1 < 16) ? g + 1 : 0;
#pragma unroll
                for (int j = 0; j < 4; ++j) { bn[j] = wk[(gn * 8 + j) * 64]; bn[4 + j] = wk[(gn * 8 + j) * 64 + 32]; }
                const f32x4 a = *(const LAS f32x4*)(hk + (((wave * 32 + g * 2 + hh) ^ (r32 & 15)) << 2));
                accA = __builtin_amdgcn_mfma_f32_32x32x2f32(a.x, b[0], accA, 0, 0, 0); accB = __builtin_amdgcn_mfma_f32_32x32x2f32(a.x, b[4], accB, 0, 0, 0);
                accA = __builtin_amdgcn_mfma_f32_32x32x2f32(a.y, b[1], accA, 0, 0, 0); accB = __builtin_amdgcn_mfma_f32_32x32x2f32(a.y, b[5], accB, 0, 0, 0);
                accA = __builtin_amdgcn_mfma_f32_32x32x2f32(a.z, b[2], accA, 0, 0, 0); accB = __builtin_amdgcn_mfma_f32_32x32x2f32(a.z, b[6], accB, 0, 0, 0);
                accA = __builtin_amdgcn_mfma_f32_32x32x2f32(a.w, b[3], accA, 0, 0, 0); accB = __builtin_amdgcn_mfma_f32_32x32x2f32(a.w, b[7], accB, 0, 0, 0);
            }
            __syncthreads();
            LAS float* part = hrow + wave * 2048 + hh * 256 + r32;
#pragma unroll
            for (int r = 0; r < 16; ++r) { part[((r >> 2) * 8 + (r & 3)) * 64] = accA[r]; part[((r >> 2) * 8 + (r & 3)) * 64 + 32] = accB[r]; }
            __syncthreads();
            const LAS float* pr = hrow + (wave * 4) * 64 + lane;
            acc0 = 0.f; acc1 = 0.f; acc2 = 0.f; acc3 = 0.f;
#pragma unroll
            for (int q = 0; q < 8; ++q) { acc0 += pr[q * 2048]; acc1 += pr[q * 2048 + 64]; acc2 += pr[q * 2048 + 128]; acc3 += pr[q * 2048 + 192]; }
        }
        int myrank[4], mypos[4]; float myw[4];
#pragma unroll
        for (int i = 0; i < 4; ++i) {
            const float logit = (i == 0) ? acc0 : (i == 1) ? acc1 : (i == 2) ? acc2 : acc3;
            const float score = 1.f / (1.f + expf(-logit));
            const float sv = score + rb;
            float m1 = sv;
            m1 = fmaxf(m1, __shfl_xor(m1, 1)); m1 = fmaxf(m1, __shfl_xor(m1, 2)); m1 = fmaxf(m1, __shfl_xor(m1, 4));
            int am = (sv == m1) ? (lane & 7) : 8;
            am = min(am, __shfl_xor(am, 1)); am = min(am, __shfl_xor(am, 2)); am = min(am, __shfl_xor(am, 4));
            float m2 = ((lane & 7) == am) ? -INFINITY : sv;
            m2 = fmaxf(m2, __shfl_xor(m2, 1)); m2 = fmaxf(m2, __shfl_xor(m2, 2)); m2 = fmaxf(m2, __shfl_xor(m2, 4));
            const float gs = m1 + m2;
            const int gi = lane >> 3; int grank = 0;
#pragma unroll
            for (int gj = 0; gj < 8; ++gj) { const float o = __shfl(gs, gj * 8); grank += (o > gs || (o == gs && gj < gi)) ? 1 : 0; }
            const float msk = (grank < 4) ? sv : -1e30f;
            int rank = 0;
#pragma unroll 8
            for (int e = 0; e < 64; ++e) { const float o = __shfl(msk, e); rank += (o > msk || (o == msk && e < lane)) ? 1 : 0; }
            const bool selb = rank < 8;
            const float tot = wsum(selb ? score : 0.f);
            myrank[i] = selb ? rank : -1; myw[i] = score / tot * 2.5f;
            mypos[i] = (selb && !DRY) ? atomicAdd((int*)(cntl + lane), 1) : 0;
        }
        __syncthreads();
        if (tid < 64) basel[tid] = (cntl[tid] > 0 && !DRY) ? atomicAdd(p.gcnt + (layer * 64 + tid) * GSTR, cntl[tid]) : 0;
        __syncthreads();
#pragma unroll
        for (int i = 0; i < 4; ++i) if (myrank[i] >= 0 && !DRY) {
            const int t = batch * 32 + wave * 4 + i, slot = t * 8 + myrank[i];
            p.list[(size_t)lane * 16384 + basel[lane] + mypos[i]] = slot;
            p.ew[slot] = myw[i];
        }
        __syncthreads();
    }
}

struct MoeSched {
    const char* A; const char* Bt; const int* list; const LAS int* ustart; const LAS int* hbase; const LAS int* cnt;
    int K, NP, G, c; bool gather; int nexp;
    __device__ __forceinline__ static void tables(LAS int* ustart, LAS int* hbase, LAS int* cnt, const int* gcnt, int NP) {
        const int tid = threadIdx.x;
        if (tid < 64) {
            const int c = gcnt[tid * GSTR], nrb = (c + 255) >> 8;
            int x = nrb;
#pragma unroll
            for (int d = 1; d < 64; d <<= 1) { const int y = __shfl_up(x, d); if (tid >= d) x += y; }
            cnt[tid] = c; ustart[tid] = (x - nrb) * NP; hbase[tid] = (x - nrb) * 256;
            if (tid == 63) { cnt[64] = S_; ustart[64] = x * NP; hbase[64] = x * 256; ustart[65] = (x + S_ / 256) * NP; hbase[65] = (x + S_ / 256) * 256; }
        }
        __syncthreads();
    }
    __device__ __forceinline__ bool next(int i, pg::Unit& u, int R0, int C0) const {
        const int L = i * G + c; if (L >= ustart[nexp]) return false;
        const int lane = threadIdx.x & 63;
        const unsigned long long bal = __ballot(lane < 65 && ustart[lane] <= L);
        int e = __popcll(bal) - 1; if (ustart[64] <= L) e = 64;
        const int r = L - ustart[e], rb = r / NP, pn = r % NP;
        u.pm = (hbase[e] >> 8) + rb; u.pn = pn; u.aux = e | (rb << 8);
        u.B = Bt + ((size_t)e * NP + pn) * 256 * K * 2;
        if (gather) {
            u.A = A; const int ce = cnt[e];
#pragma unroll
            for (int q = 0; q < 4; ++q) { const int pos = rb * 256 + R0 + 64 * q; int tok = 0; if (pos < ce) tok = (e < 64) ? (list[(size_t)e * 16384 + pos] >> 3) : pos; u.ra[q] = (unsigned)(tok * K + C0) * 2u; }
        } else {
            u.A = A + (size_t)u.pm * 256 * K * 2;
#pragma unroll
            for (int q = 0; q < 4; ++q) u.ra[q] = (unsigned)((R0 + 64 * q) * K + C0) * 2u;
        }
        return true;
    }
};
struct EpiGateUp {
    static constexpr bool PERM = true;
    static constexpr bool PRE = false;
    bf16_t* HID;
    __device__ __forceinline__ void operator()(const f32x4 (&acc)[2][2][4][2], const pg::Unit& u, int wid, int wr, int wc, int fr_, int fq_) const {
        int fr = fr_, fq = fq_; asm volatile("" : "+v"(fr), "+v"(fq));
        const int col0 = u.pn * 128 + wc * 32 + 8 * fq;
#pragma unroll
        for (int ai = 0; ai < 2; ++ai)
#pragma unroll
            for (int m = 0; m < 4; ++m) {
                bf16_t* rp = HID + (size_t)(u.pm * 256 + ai * 128 + wr * 64 + m * 16 + fr) * 256 + col0;
                float h[8];
#pragma unroll
                for (int n = 0; n < 2; ++n) {
                    const f32x4 g = acc[ai][0][m][n], up = acc[ai][1][m][n];
                    h[4 * n] = g.x / (1.f + __expf(-g.x)) * up.x; h[4 * n + 1] = g.y / (1.f + __expf(-g.y)) * up.y; h[4 * n + 2] = g.z / (1.f + __expf(-g.z)) * up.z; h[4 * n + 3] = g.w / (1.f + __expf(-g.w)) * up.w;
                }
                u32x4 w; w.x = cvtpk(h[0], h[1]); w.y = cvtpk(h[2], h[3]); w.z = cvtpk(h[4], h[5]); w.w = cvtpk(h[6], h[7]); *(u32x4*)rp = w;
            }
    }
};
struct EpiDown {
    static constexpr bool PERM = true;
    static constexpr bool PRE = true;
    bf16_t* YBUF; const int* list; const LAS int* cnt; LAS unsigned char* lds;
    __device__ __forceinline__ void pre(const pg::Unit& u, int ui, int wid, int lane) const {
        const int e = u.aux & 0xff, rb = u.aux >> 8;
        const int* src = list + (size_t)e * 16384 + rb * 256 + (wid & 3) * 64 + lane;
        __builtin_amdgcn_global_load_lds((const unsigned*)src, (LAS unsigned*)(lds + LDS_X + 1024 + (ui & 1) * 1024 + (wid & 3) * 256), 4, 0, 0);
    }
    __device__ __forceinline__ void operator()(const f32x4 (&acc)[2][2][4][2], const pg::Unit& u, int wid, int wr, int wc, int fr_, int fq_, int ui) const {
        int fr = fr_, fq = fq_; asm volatile("" : "+v"(fr), "+v"(fq));
        const int e = u.aux & 0xff, rb = u.aux >> 8, ce = cnt[e];
        const unsigned colb = (unsigned)(u.pn * 256 + wc * 32 + 8 * fq);
        const LAS int* sl = (const LAS int*)(lds + LDS_X + 1024 + (ui & 1) * 1024) + wr * 64 + fr;
        const int pos0 = rb * 256 + wr * 64 + fr;
        int slot[8];
#pragma unroll
        for (int i = 0; i < 8; ++i) { const int pr = (i >> 2) * 128 + (i & 3) * 16; slot[i] = (pos0 + pr < ce) ? sl[pr] : -1; }
#pragma unroll
        for (int ai = 0; ai < 2; ++ai)
#pragma unroll
            for (int m = 0; m < 4; ++m) {
                const int i = ai * 4 + m;
                if (slot[i] >= 0) {
                    char* rp = (char*)YBUF + ((unsigned)slot[i] * 1024u + colb);
#pragma unroll
                    for (int bj = 0; bj < 2; ++bj) { const f32x4 a = acc[ai][bj][m][0] * 16.f, b = acc[ai][bj][m][1] * 16.f;
                        u32x2 o; o.x = nsa::pk4_fp8(a.x, a.y, a.z, a.w); o.y = nsa::pk4_fp8(b.x, b.y, b.z, b.w); *(u32x2*)(rp + bj * 128) = o; }
                }
            }
    }
};
__device__ __forceinline__ void phase_moe_gemm1(const MKP& p, LAS unsigned char* lds, int layer) {
    LAS int* tb = (LAS int*)(lds + LDS_X);
    MoeSched::tables(tb, tb + 66, tb + 132, p.gcnt + layer * 64 * GSTR, 2);
    const int G = gridDim.x, bx = blockIdx.x, vcu = (G % 8 == 0) ? (bx % 8) * (G / 8) + bx / 8 : bx;
    MoeSched S{(const char*)p.XN, (const char*)p.Wgu, p.list, tb, tb + 66, tb + 132, 1024, 2, G, vcu, true, 65};
    EpiGateUp E{p.HID};
    pg::gemm_run(lds, 1024, S, E);
}
__device__ __forceinline__ void phase_moe_gemm2(const MKP& p, LAS unsigned char* lds, int layer, int which = 3) {
    LAS int* tb = (LAS int*)(lds + LDS_X);
    MoeSched::tables(tb, tb + 66, tb + 132, p.gcnt + layer * 64 * GSTR, 4);
    const int G = gridDim.x, bx = blockIdx.x, vcu = (G % 8 == 0) ? (bx % 8) * (G / 8) + bx / 8 : bx;
    if (which & 1) { MoeSched S{(const char*)p.HID, (const char*)p.Wd, p.list, tb, tb + 66, tb + 132, 256, 4, G, vcu, false, 64};
      EpiDown E{p.YBUF, p.list, tb + 132, lds};
      pg::gemm_run(lds, 256, S, E); }
    if (which & 2) {
      pg::DenseSched S; S.init(p.HID + (size_t)tb[66 + 64] * 256, p.Wd + (size_t)64 * 1024 * 256, S_, 1024, 256, G, bx);
      EpiPlain E{p.YS, 1024};
      pg::gemm_run(lds, 256, S, E); }
}
__device__ __forceinline__ void phase_moe_combine(const MKP& p, int layer) {
    int tid_ = threadIdx.x; asm volatile("" : "+v"(tid_));
    const int tid = tid_, lane = tid & 63, wave = tid >> 6;
    const int gwv = blockIdx.x * 8 + wave, NGW = gridDim.x * 8;
    const float* g2 = p.mod + layer * 6144 + 5 * 1024;
    f32x4 g[4];
#pragma unroll
    for (int j = 0; j < 4; ++j) g[j] = *(const f32x4*)(g2 + 256 * j + 4 * lane) * (1.f / 16.f);
    for (int t = gwv; t < S_; t += NGW) {
        f32x4* xr = (f32x4*)(p.out + (size_t)t * D_) + lane;
        f32x4 v[4]; int yb[4][8]; u32x2 sw[4];
        const f32x4 ewa = *(const f32x4*)(p.ew + (size_t)t * 8), ewb = *(const f32x4*)(p.ew + (size_t)t * 8 + 4);
#pragma unroll
        for (int j = 0; j < 4; ++j) v[j] = xr[64 * j];
#pragma unroll
        for (int j = 0; j < 4; ++j)
#pragma unroll
            for (int k = 0; k < 8; ++k) yb[j][k] = *((const int*)((const char*)p.YBUF + ((size_t)t * 8 + k) * 1024) + lane + 64 * j);
#pragma unroll
        for (int j = 0; j < 4; ++j) sw[j] = *((const u32x2*)(p.YS + (size_t)t * 1024) + lane + 64 * j);
        asm volatile("" ::: "memory");
#pragma unroll
        for (int j = 0; j < 4; ++j) {
            f32x4 s = (f32x4){0.f, 0.f, 0.f, 0.f};
#pragma unroll
            for (int k = 0; k < 8; ++k) {
                const f32x2 lo = __builtin_amdgcn_cvt_pk_f32_fp8(yb[j][k], false), hi = __builtin_amdgcn_cvt_pk_f32_fp8(yb[j][k], true);
                const float wk = (k < 4) ? ewa[k] : ewb[k - 4];
                s.x += wk * lo.x; s.y += wk * lo.y; s.z += wk * hi.x; s.w += wk * hi.y;
            }
            s.x += 16.f * __uint_as_float(sw[j].x << 16); s.y += 16.f * __uint_as_float(sw[j].x & 0xffff0000u); s.z += 16.f * __uint_as_float(sw[j].y << 16); s.w += 16.f * __uint_as_float(sw[j].y & 0xffff0000u);
            v[j] = v[j] + g[j] * s;
        }
#pragma unroll
        for (int j = 0; j < 4; ++j) xr[64 * j] = v[j];
    }
}

#define XB_TMO      128
#define XB_XCNT(j)  (256  + 64 * (j))
#define XB_XSUB(j)  (1280 + 64 * (j))
#define XB_XGEN(j)  (2304 + 64 * (j))
#define XB_TOP      3328
#define XB_TOPGEN   3392
#define XCD_BAR_WORDS 3456
#define XB_SPIN_CAP (1u << 22)
__device__ __forceinline__ unsigned xb_ld(unsigned* p)              { return __hip_atomic_load(p, __ATOMIC_RELAXED, __HIP_MEMORY_SCOPE_AGENT); }
__device__ __forceinline__ unsigned xb_add(unsigned* p, unsigned v) { return __hip_atomic_fetch_add(p, v, __ATOMIC_RELAXED, __HIP_MEMORY_SCOPE_AGENT); }
__device__ __forceinline__ unsigned xb_xcc_id() { return (unsigned)__builtin_amdgcn_s_getreg((3 << 11) | 20) & 0xFu; }
#define XB_SPIN(cond, bar) do { unsigned _sp = 0; while (cond) { __builtin_amdgcn_s_sleep(1); \
    if ((++_sp & 255u) == 0u) { if (xb_ld(&(bar)[XB_TMO])) break; if (_sp > XB_SPIN_CAP) { atomicAdd(&(bar)[XB_TMO], 1u); break; } } } } while (0)
struct XcdBarrier { unsigned* bar; unsigned x; volatile LAS unsigned* st; };
__device__ __forceinline__ XcdBarrier xcd_barrier_post(unsigned* bar, volatile LAS unsigned* st) {
    XcdBarrier b; b.bar = bar; b.x = xb_xcc_id(); b.st = st;
    if (threadIdx.x == 0) (void)xb_add(&bar[XB_XCNT(b.x)], 1u);
    return b;
}
__device__ __forceinline__ void xcd_barrier_complete(unsigned* bar, unsigned x, unsigned& nloc, unsigned& nx) {
    const unsigned G = gridDim.x * gridDim.y * gridDim.z;
    unsigned sum, cnt, mine, sp = 0u;
    for (;;) {
        sum = 0u; cnt = 0u; mine = 0u;
#pragma unroll
        for (unsigned j = 0; j < 16; ++j) { const unsigned c = xb_ld(&bar[XB_XCNT(j)]); sum += c; cnt += (c > 0u) ? 1u : 0u; mine = (j == x) ? c : mine; }
        if (sum == G) break;
        __builtin_amdgcn_s_sleep(1);
        if ((++sp & 255u) == 0u) { if (xb_ld(&bar[XB_TMO])) break; if (sp > XB_SPIN_CAP) { atomicAdd(&bar[XB_TMO], 1u); break; } }
    }
    nloc = mine > 0u ? mine : 1u; nx = cnt > 0u ? cnt : 1u;
}
__device__ __forceinline__ void xcd_barrier(const XcdBarrier& b) {
    asm volatile("s_waitcnt vmcnt(0)" ::: "memory");
    __syncthreads();
    if (threadIdx.x == 0) {
        unsigned* bar = b.bar;
        __builtin_amdgcn_s_waitcnt(0);
        unsigned nloc = b.st[0], nx = b.st[1];
        if (nloc == 0u) { xcd_barrier_complete(bar, b.x, nloc, nx); b.st[0] = nloc; b.st[1] = nx; }
        const unsigned old = xb_add(&bar[XB_XSUB(b.x)], 1u);
        const unsigned gen = old / nloc;
        if (old + 1u == (gen + 1u) * nloc) {
            __builtin_amdgcn_fence(__ATOMIC_RELEASE, "agent");
            asm volatile("s_waitcnt vmcnt(0)" ::: "memory");
            const unsigned og = xb_add(&bar[XB_TOP], 1u);
            const unsigned tg = og / nx;
            if (og + 1u == (tg + 1u) * nx) xb_add(&bar[XB_TOPGEN], 1u);
            else XB_SPIN(xb_ld(&bar[XB_TOPGEN]) == tg, bar);
            __builtin_amdgcn_fence(__ATOMIC_ACQUIRE, "agent");
            xb_add(&bar[XB_XGEN(b.x)], 1u);
            asm volatile("s_waitcnt vmcnt(0)" ::: "memory");
        } else {
            XB_SPIN(xb_ld(&bar[XB_XGEN(b.x)]) == gen, bar);
            __builtin_amdgcn_fence(__ATOMIC_ACQUIRE, "agent");
            asm volatile("s_waitcnt vmcnt(0)" ::: "memory");
        }
    }
    __syncthreads();
}

__global__ void __launch_bounds__(MK_THREADS, 2) mega(MKP p) {
    extern __shared__ __attribute__((aligned(16))) unsigned char lds_raw[];
    LAS unsigned char* lds = (LAS unsigned char*)lds_raw;
    const int lo = p.ph_lo, hi = p.ph_hi;
    const bool multi = hi - lo > 1;
    volatile LAS unsigned* bst = (volatile LAS unsigned*)(lds + LDS_BARST);
    XcdBarrier bar; bar.bar = p.barw; bar.x = 0; bar.st = bst;
    if (multi) {
        if (threadIdx.x < 2) bst[threadIdx.x] = 0u;
        if (blockIdx.x == 0) for (int i = threadIdx.x; i < XCD_BAR_WORDS; i += MK_THREADS) p.barw[i] = 0u;
    }
    int nbar = 0;
    if (multi) {
        __threadfence(); cooperative_groups::this_grid().sync(); __builtin_amdgcn_fence(__ATOMIC_ACQUIRE, "agent"); bar = xcd_barrier_post(p.barw, bst); nbar = 1;
    }
#define IN(k) (lo <= (k) && (k) < hi)
#define SEAM(k) do { if (IN(k) && IN((k) + 1)) { if (nbar == 0) { __threadfence(); cooperative_groups::this_grid().sync(); __builtin_amdgcn_fence(__ATOMIC_ACQUIRE, "agent"); bar = xcd_barrier_post(p.barw, bst); } else xcd_barrier(bar); ++nbar; } } while (0)
    if (IN(0)) { phase_prologue(p, lds); phase_moe_weights(p, lds, 0); }
    SEAM(0);
    if (IN(1)) phase_norm<false>(p, lds, p.in[0], p.in[3], 0, 1, 0, true);
    SEAM(1);
    if (IN(2)) {
        pg::DenseSched S; S.init(p.XN, p.W_in0t, S_, 3072, 1024, gridDim.x, blockIdx.x);
        EpiHeads E{p.desc0, p.cosT, p.sinT, p.GATES, p.LOGF, (LAS float*)(lds + LDS_X)};
        pg::gemm_run(lds, 1024, S, E);
    }
    SEAM(2);
    if (IN(3)) phase_scan(p, lds);
    SEAM(3);
    if (IN(4)) phase_fox(p, (char*)lds_raw);
    SEAM(4);
    if (IN(5)) {
        pg::DenseSched S; S.init(p.OATT, p.W_out0t, S_, 1024, 1024, gridDim.x, blockIdx.x);
        EpiResid E{p.in[0], p.out, p.mod + 2 * 1024};
        pg::gemm_run(lds, 1024, S, E);
    }
    SEAM(5);
    if (IN(6)) phase_moe_route<false>(p, lds, 0);
    SEAM(6);
    if (IN(7)) phase_moe_gemm1(p, lds, 0);
    SEAM(7);
    if (IN(8)) phase_moe_gemm2(p, lds, 0);
    SEAM(8);
    if (IN(9)) { phase_norm<true>(p, lds, p.out, p.in[3] + 1024, 1, 1, 0, false); phase_moe_weights(p, lds, 1); }
    if (IN(9) && IN(11)) { xcd_barrier(bar); ++nbar; }
    if (IN(11)) {
        pg::DenseSched S; S.init(p.XN, p.W_in1t, S_, 768, 1024, gridDim.x, blockIdx.x);
        EpiPlain E{p.P1, 768};
        pg::gemm_run(lds, 1024, S, E);
    }
    SEAM(11);
    if (IN(12)) phase_post1a(p);
    SEAM(12);
    if (IN(13)) {
        { pg::DenseSched S; S.init(p.CQN, p.W_uqt, S_, 1536, 384, gridDim.x, blockIdx.x);
          EpiHeads E{p.desc_uq, p.cosT, p.sinT, nullptr, nullptr, (LAS float*)(lds + LDS_X)};
          pg::gemm_run(lds, 384, S, E); }
        { pg::DenseSched S; S.init(p.CKVN, p.W_ukvt, S_, 2048, 256, gridDim.x, blockIdx.x);
          EpiHeads E{p.desc_ukv, p.cosT, p.sinT, nullptr, nullptr, (LAS float*)(lds + LDS_X)};
          pg::gemm_run(lds, 256, S, E); }
    }
    SEAM(13);
    if (IN(14)) phase_mla(p, (char*)lds_raw);
    SEAM(14);
    if (IN(15)) {
        pg::DenseSched S; S.init(p.OATT, p.W_out1t, S_, 1024, 1024, gridDim.x, blockIdx.x);
        EpiResid E{p.out, p.out, p.mod + 6144 + 2 * 1024};
        pg::gemm_run(lds, 1024, S, E);
    }
    SEAM(15);
    if (IN(16)) phase_moe_route<false>(p, lds, 1);
    SEAM(16);
    if (IN(17)) phase_moe_gemm1(p, lds, 1);
    SEAM(17);
    if (IN(18)) phase_moe_gemm2(p, lds, 1);
    SEAM(18);
    if (IN(19)) phase_moe_combine(p, 1);
#undef IN
#undef SEAM
}
extern "C" void kernel_launch(void* const* d_in, const int* in_sizes, int n_in, void* d_out, int out_size, void* d_ws, size_t ws_size, hipStream_t stream) {
    static int grid = 0;
    if (!grid) {
        int dev = 0, cus = 0, per_cu = 0;
        (void)hipGetDevice(&dev); (void)hipDeviceGetAttribute(&cus, hipDeviceAttributeMultiprocessorCount, dev);
        (void)hipFuncSetAttribute((const void*)mega, hipFuncAttributeMaxDynamicSharedMemorySize, LDS_TOTAL);
        (void)hipOccupancyMaxActiveBlocksPerMultiprocessor(&per_cu, (const void*)mega, MK_THREADS, LDS_TOTAL);
        (void)hipGetLastError();
        grid = (cus > 0 && per_cu >= 1) ? cus : -1;
    }
    if (grid < 0) return;
    constexpr size_t MiB = 1u << 20;
    if (ws_size < 528 * MiB || n_in != 34) return;
    char* wsb = (char*)d_ws;
    float* ws = (float*)d_ws;
    size_t o = 0;
    MKP p{};
    for (int i = 0; i < 34; ++i) p.in[i] = (const float*)d_in[i];
    p.out = (float*)d_out; p.pos = (const int*)d_in[2];
    p.mod = ws + o; o += 2 * 6144;
    p.cosT = ws + o; o += (size_t)S_ * 48;
    p.sinT = ws + o; o += (size_t)S_ * 48;
    p.modpart = ws + o; o += 8 * 12288;
    p.desc0 = (BlkDesc*)(ws + o); o += 96 * 8;
    p.desc_uq = (BlkDesc*)(ws + o); o += 48 * 8;
    p.desc_ukv = (BlkDesc*)(ws + o); o += 64 * 8;
    p.CUMB = ws + o; o += (size_t)8 * S_;
    p.gcnt = (int*)(ws + o); o += 128 * GSTR;
    p.CBIAS = ws + o; o += 128;
    p.barw = (unsigned*)(ws + o); o += 4096;
    p.ew = ws + o; o += (size_t)S_ * 8;
    p.list = (int*)(ws + o); o += (size_t)64 * 16384;
    p.WcT = (bf16_t*)(ws + o); o += (size_t)2 * 64 * 2048 / 2;
    p.KCMP = (bf16_t*)(ws + o); o += (size_t)2 * 1024 * 64 / 2;
    p.VCT = (bf16_t*)(ws + o); o += (size_t)2 * 64 * 1024 / 2;
    if (o * 4 > 15 * MiB) return;
    p.XN = (bf16_t*)(wsb + 15 * MiB); p.OATT = (bf16_t*)(wsb + 47 * MiB);
    char* big = wsb + 79 * MiB;
    {   bf16_t* b = (bf16_t*)big;
        p.QN = b; b += (size_t)S_ * 512; p.KV6 = b; b += (size_t)12 * S_ * 64; p.FQ = b; b += (size_t)S_ * 512; p.FK = b; b += (size_t)S_ * 512; p.FV = b; b += (size_t)S_ * 512;
        p.GATES = (float*)b; p.LOGF = p.GATES + (size_t)S_ * 24; }
    p.KSLF = (bf16_t*)(big + 92 * MiB); p.VSLF = (bf16_t*)(big + 96 * MiB); p.OCMP = (bf16_t*)(big + 100 * MiB); p.OWIN = (bf16_t*)(big + 116 * MiB);
    {   bf16_t* b = (bf16_t*)(big + 96 * MiB);
        p.P1 = b; b += (size_t)S_ * 768; p.CQN = b; b += (size_t)S_ * 384; p.CKVN = b; b += (size_t)S_ * 256;
        p.Q96 = b; b += (size_t)16 * S_ * 96; p.K96 = b; b += (size_t)16 * S_ * 96; p.V1 = b; b += (size_t)16 * S_ * 64; }
    p.YBUF = (bf16_t*)big; p.YS = (bf16_t*)(big + 128 * MiB); p.HID = (bf16_t*)(big + 256 * MiB);
    p.Wgu = (bf16_t*)(wsb + 415 * MiB); p.Wd = p.Wgu + (size_t)65 * 512 * 1024;
    {   bf16_t* b = (bf16_t*)(wsb + 513 * MiB);
        p.W_in0t = b; b += (size_t)3072 * 1024; p.W_out0t = b; b += (size_t)1024 * 1024; p.W_in1t = b; b += (size_t)768 * 1024;
        p.W_uqt = b; b += (size_t)1536 * 384; p.W_ukvt = b; b += (size_t)2048 * 256; p.W_out1t = b; b += (size_t)1024 * 1024; }
    p.ph_lo = 0; p.ph_hi = 20;
    void* args[] = {&p};
    (void)hipLaunchCooperativeKernel((const void*)mega, dim3(grid), dim3(MK_THREADS), args, LDS_TOTAL, stream);
}
```
